# Optimizing an MI355X kernel written in HIP

```python
import math
import jax, jax.numpy as jnp
from jax import lax
import numpy as np

D_MODEL = 1024
BATCH = 16
SEQ = 2048
DEPTH = 4

GRID_W = 64
CTX_LEN = 256

N_HEADS_NA = 8
HEAD_DIM_NA = 64
D_NA = N_HEADS_NA * HEAD_DIM_NA
WIN_R = 8
WIN_C = 16
Q_BLK_C = 16
HALO_C = Q_BLK_C + WIN_C

N_HEADS_SSD = 8
HEAD_DIM_SSD = 64
D_SSD = N_HEADS_SSD * HEAD_DIM_SSD
N_GROUPS_SSD = 2
D_STATE = 128
D_CONV = 5
CHUNK = 128
DT_MIN = 1e-3
DT_MAX = 1e-1
ROPE_BASE = 10000.0

D_MIX = D_NA + D_SSD
GN = N_GROUPS_SSD * D_STATE
CONV_CH = D_SSD + 2 * GN
OFF_K = D_NA
OFF_V = 2 * D_NA
OFF_Z = 3 * D_NA
OFF_XBC = OFF_Z + D_SSD
OFF_DT = OFF_XBC + CONV_CH
D_IN_PROJ = OFF_DT + 2 * N_HEADS_SSD

D_FF = 2816
N_EXPERTS = 8
TOP_K = 2
D_FF_EXPERT = 3584
N_DENSE = (DEPTH + 1) // 2
N_MOE = DEPTH // 2

DEEPNORM_ALPHA = (2.0 * DEPTH) ** 0.25
DEEPNORM_BETA = (8.0 * DEPTH) ** -0.25
LN_EPS = 1e-5
RMS_EPS = 1e-5

kernel_name = 'hybrid_natten_ssd_moe_deepnorm_dit'


def _layernorm(x, g, b):
    xf = x.astype(jnp.float32)
    mu = jnp.mean(xf, axis=-1, keepdims=True)
    var = jnp.mean(jnp.square(xf - mu), axis=-1, keepdims=True)
    y = (xf - mu) * lax.rsqrt(var + LN_EPS) * g.astype(jnp.float32) + b.astype(jnp.float32)
    return y.astype(x.dtype)


def _split_proj(p):
    return (p[..., :OFF_K], p[..., OFF_K:OFF_V], p[..., OFF_V:OFF_Z],
            p[..., OFF_Z:OFF_XBC], p[..., OFF_XBC:OFF_DT], p[..., OFF_DT:])


def _heads(t):
    b, l, _ = t.shape
    return t.reshape(b, l, N_HEADS_NA, HEAD_DIM_NA)


def _context_attention(q, k, v):
    b, l = q.shape[0], q.shape[1]
    s = jnp.einsum('bqhd,bkhd->bhqk', q, k).astype(jnp.float32) * (HEAD_DIM_NA ** -0.5)
    p = jax.nn.softmax(s, axis=-1).astype(v.dtype)
    return jnp.einsum('bhqk,bkhd->bqhd', p, v).reshape(b, l, D_NA)


def _neighbourhood_attention(q, k, v, k_ctx, v_ctx, rpb, rows):
    b = q.shape[0]
    kr = min(WIN_R, rows)
    ncb = GRID_W // Q_BLK_C
    scale = HEAD_DIM_NA ** -0.5
    cols = np.arange(GRID_W)
    col_start = np.clip(cols - WIN_C // 2, 0, GRID_W - WIN_C).reshape(ncb, Q_BLK_C)
    halo_start = np.clip(np.arange(ncb) * Q_BLK_C - WIN_C // 2, 0, GRID_W - HALO_C)
    halo_cols = halo_start[:, None] + np.arange(HALO_C)
    key_col = halo_cols[:, None, :]
    in_win = jnp.asarray((key_col >= col_start[:, :, None]) & (key_col < col_start[:, :, None] + WIN_C))
    col_bias_idx = np.clip(key_col - cols.reshape(ncb, Q_BLK_C)[:, :, None] + WIN_C - 1, 0, 2 * WIN_C - 2)
    qg = q.reshape(b, rows, ncb, Q_BLK_C, N_HEADS_NA, HEAD_DIM_NA)
    kg = k.reshape(b, rows, GRID_W, N_HEADS_NA, HEAD_DIM_NA)
    vg = v.reshape(b, rows, GRID_W, N_HEADS_NA, HEAD_DIM_NA)
    n_loc = kr * HALO_C

    def row_block(i):
        r0 = jnp.clip(i - kr // 2, 0, rows - kr)
        k_rows = lax.dynamic_slice_in_dim(kg, r0, kr, axis=1)
        v_rows = lax.dynamic_slice_in_dim(vg, r0, kr, axis=1)
        k_halo = k_rows[:, :, halo_cols]
        v_halo = v_rows[:, :, halo_cols]
        q_row = lax.dynamic_index_in_dim(qg, i, axis=1, keepdims=False)
        s_loc = jnp.einsum('bcqhd,brckhd->bhcqrk', q_row, k_halo).astype(jnp.float32) * scale
        row_bias_idx = r0 + jnp.arange(kr) - i + WIN_R - 1
        bias = rpb[:, row_bias_idx][:, :, col_bias_idx].transpose(0, 2, 3, 1, 4)
        s_loc = jnp.where(in_win[:, :, None, :], s_loc + bias.astype(jnp.float32), -jnp.inf)
        s_ctx = jnp.einsum('bcqhd,bmhd->bhcqm', q_row, k_ctx).astype(jnp.float32) * scale
        s = jnp.concatenate([s_loc.reshape(s_loc.shape[:4] + (n_loc,)), s_ctx], axis=-1)
        p = jax.nn.softmax(s, axis=-1).astype(v.dtype)
        p_loc = p[..., :n_loc].reshape(s_loc.shape)
        o = (jnp.einsum('bhcqrk,brckhd->bcqhd', p_loc, v_halo)
             + jnp.einsum('bhcqm,bmhd->bcqhd', p[..., n_loc:], v_ctx))
        return o.reshape(b, GRID_W, N_HEADS_NA, HEAD_DIM_NA)

    out = lax.map(row_block, jnp.arange(rows))
    return out.transpose(1, 0, 2, 3, 4).reshape(b, rows * GRID_W, D_NA)


def _axial_rope(u):
    l = u.shape[1]
    t = jnp.arange(l)
    half = D_STATE // 2
    quarter = half // 2
    inv_freq = ROPE_BASE ** (-jnp.arange(quarter, dtype=jnp.float32) / quarter)
    ang_r = (t // GRID_W).astype(jnp.float32)[:, None] * inv_freq
    ang_c = (t % GRID_W).astype(jnp.float32)[:, None] * inv_freq

    def rot(w, ang):
        cos = jnp.cos(ang)[:, None, :].astype(w.dtype)
        sin = jnp.sin(ang)[:, None, :].astype(w.dtype)
        w1, w2 = w[..., :quarter], w[..., quarter:]
        return jnp.concatenate([w1 * cos - w2 * sin, w1 * sin + w2 * cos], axis=-1)

    return jnp.concatenate([rot(u[..., :half], ang_r), rot(u[..., half:], ang_c)], axis=-1)


def _dwconv(u, w, bias):
    k = w.shape[0]
    y = lax.conv_general_dilated(u, w[:, None, :].astype(u.dtype), window_strides=(1,),
                                 padding=[(k // 2, k // 2)], dimension_numbers=('NWC', 'WIO', 'NWC'),
                                 feature_group_count=u.shape[-1])
    return y + bias


def _segsum(a):
    t = a.shape[-1]
    cs = jnp.cumsum(a, axis=-1)
    diff = cs[..., :, None] - cs[..., None, :]
    return jnp.where(jnp.tril(jnp.ones((t, t), dtype=bool)), diff, -jnp.inf)


def _ssd_chunked(xh, da, bm, cm, h0):
    b, l, nh, p = xh.shape
    g, n = bm.shape[2], bm.shape[3]
    r = nh // g
    nc = l // CHUNK
    dtp = xh.dtype
    xc = xh.reshape(b, nc, CHUNK, g, r, p)
    bc = bm.reshape(b, nc, CHUNK, g, n)
    cc = cm.reshape(b, nc, CHUNK, g, n)
    a = da.reshape(b, nc, CHUNK, g, r).transpose(0, 3, 4, 1, 2)
    a_cs = jnp.cumsum(a, axis=-1)
    decay_in = jnp.exp(_segsum(a)).astype(dtp)
    cb = jnp.einsum('bclgn,bcsgn->bgcls', cc, bc)
    y_diag = jnp.einsum('bgrcls,bcsgrp->bclgrp', cb[:, :, None] * decay_in, xc)
    to_end = jnp.exp(a_cs[..., -1:] - a_cs).astype(dtp).transpose(0, 3, 4, 1, 2)[..., None]
    states = jnp.einsum('bclgn,bclgrp->bcgrpn', bc, xc * to_end)
    states = jnp.concatenate([h0.reshape(b, 1, g, r, p, n).astype(dtp), states], axis=1)
    totals = jnp.pad(a_cs[..., -1], ((0, 0), (0, 0), (0, 0), (1, 0)))
    decay_ch = jnp.exp(_segsum(totals)).astype(dtp)
    carried = jnp.einsum('bgrzc,bcgrpn->bzgrpn', decay_ch, states)
    from_start = jnp.exp(a_cs).astype(dtp).transpose(0, 3, 4, 1, 2)[..., None]
    y_off = jnp.einsum('bclgn,bcgrpn->bclgrp', cc, carried[:, :-1]) * from_start
    y = (y_diag + y_off).reshape(b, l, nh, p)
    return y, carried[:, -1].reshape(b, nh, p, n)


def _ssd_stream(z, xbc, dt_raw, conv_w, conv_b, dt_bias, a_log, d_skip, norm_w, h0_f, h0_b, rotary):
    b, l, _ = xbc.shape
    u = jax.nn.silu(_dwconv(xbc, conv_w, conv_b))
    xs = u[..., :D_SSD].reshape(b, l, N_HEADS_SSD, HEAD_DIM_SSD)
    bm = u[..., D_SSD:D_SSD + GN].reshape(b, l, N_GROUPS_SSD, D_STATE)
    cm = u[..., D_SSD + GN:].reshape(b, l, N_GROUPS_SSD, D_STATE)
    if rotary:
        bm = _axial_rope(bm)
        cm = _axial_rope(cm)
    dt = jax.nn.softplus(dt_raw.astype(jnp.float32).reshape(b, l, 2, N_HEADS_SSD) + dt_bias.astype(jnp.float32))
    da = dt * (-jnp.exp(a_log.astype(jnp.float32)))
    dtc = dt.astype(xs.dtype)
    y_f, h_f = _ssd_chunked(xs * dtc[:, :, 0, :, None], da[:, :, 0], bm, cm, h0_f)
    fl = lambda t: jnp.flip(t, axis=1)
    y_b, h_b = _ssd_chunked(fl(xs * dtc[:, :, 1, :, None]), fl(da[:, :, 1]), fl(bm), fl(cm), h0_b)
    y = y_f + fl(y_b) + d_skip[:, None] * xs
    yg = (y.reshape(b, l, D_SSD) * jax.nn.silu(z)).astype(jnp.float32)
    yg = yg.reshape(b, l, N_GROUPS_SSD, D_SSD // N_GROUPS_SSD)
    yg = yg * lax.rsqrt(jnp.mean(yg * yg, axis=-1, keepdims=True) + RMS_EPS)
    out = (yg.reshape(b, l, D_SSD) * norm_w.astype(jnp.float32)).astype(z.dtype)
    return out, h_f, h_b


def _swiglu(h, wg, wu, wd):
    return (jax.nn.silu(h @ wg) * (h @ wu)) @ wd


def _moe(h, router, wg, wu, wd):
    logits = (h @ router).astype(jnp.float32)
    top_v, top_i = lax.top_k(logits, TOP_K)
    gates = jax.nn.softmax(top_v, axis=-1)
    combine = jnp.sum(jax.nn.one_hot(top_i, N_EXPERTS, dtype=jnp.float32) * gates[..., None], axis=-2)
    combine = combine.astype(h.dtype)
    out = jnp.zeros_like(h)
    for e in range(N_EXPERTS):
        out = out + combine[..., e:e + 1] * _swiglu(h, wg[e], wu[e], wd[e])
    return out


def setup_inputs(seed: int = 0) -> dict:
    key = jax.random.key(seed)
    ks = jax.random.split(key, 24)
    f32 = jnp.float32
    nrm = lambda k, shape, s: jax.random.normal(k, shape, f32) * s
    dt0 = jnp.exp(jax.random.uniform(ks[11], (DEPTH, 2, N_HEADS_SSD), f32, math.log(DT_MIN), math.log(DT_MAX)))
    return {
        'x': nrm(ks[0], (BATCH, SEQ, D_MODEL), 1.0),
        'c': nrm(ks[1], (BATCH, D_MODEL), 1.0),
        'ctx': nrm(ks[2], (BATCH, CTX_LEN, D_MODEL), 1.0),
        'c_ctx': nrm(ks[3], (D_MODEL,), 1.0),
        'w_mod': nrm(ks[4], (DEPTH, D_MODEL, 6 * D_MODEL), 0.5 * D_MODEL ** -0.5),
        'b_mod': nrm(ks[5], (DEPTH, 6 * D_MODEL), 0.01),
        'w_in': nrm(ks[6], (DEPTH, D_MODEL, D_IN_PROJ), D_MODEL ** -0.5),
        'w_out': nrm(ks[7], (DEPTH, D_MIX, D_MODEL), DEEPNORM_BETA * D_MIX ** -0.5),
        'na_rpb': nrm(ks[8], (DEPTH, N_HEADS_NA, 2 * WIN_R - 1, 2 * WIN_C - 1), 0.1),
        'conv_w': nrm(ks[9], (DEPTH, D_CONV, CONV_CH), D_CONV ** -0.5),
        'conv_b': nrm(ks[10], (DEPTH, CONV_CH), 0.01),
        'dt_bias': dt0 + jnp.log(-jnp.expm1(-dt0)),
        'a_log': jnp.log(jax.random.uniform(ks[12], (DEPTH, 2, N_HEADS_SSD), f32, 1.0, 16.0)),
        'd_skip': 1.0 + nrm(ks[13], (DEPTH, N_HEADS_SSD), 0.01),
        'ssd_norm_w': 1.0 + nrm(ks[14], (DEPTH, D_SSD), 0.01),
        'ln_g': 1.0 + nrm(ks[15], (DEPTH, 2, D_MODEL), 0.01),
        'ln_b': nrm(ks[16], (DEPTH, 2, D_MODEL), 0.01),
        'ffn_w_gate': nrm(ks[17], (N_DENSE, D_MODEL, D_FF), D_MODEL ** -0.5),
        'ffn_w_up': nrm(ks[18], (N_DENSE, D_MODEL, D_FF), D_MODEL ** -0.5),
        'ffn_w_down': nrm(ks[19], (N_DENSE, D_FF, D_MODEL), DEEPNORM_BETA * D_FF ** -0.5),
        'router_w': nrm(ks[20], (N_MOE, D_MODEL, N_EXPERTS), D_MODEL ** -0.5),
        'moe_w_gate': nrm(ks[21], (N_MOE, N_EXPERTS, D_MODEL, D_FF_EXPERT), D_MODEL ** -0.5),
        'moe_w_up': nrm(ks[22], (N_MOE, N_EXPERTS, D_MODEL, D_FF_EXPERT), D_MODEL ** -0.5),
        'moe_w_down': nrm(ks[23], (N_MOE, N_EXPERTS, D_FF_EXPERT, D_MODEL), DEEPNORM_BETA * D_FF_EXPERT ** -0.5),
    }


def reference(x, c, ctx, c_ctx, w_mod, b_mod, w_in, w_out, na_rpb, conv_w, conv_b, dt_bias, a_log,
              d_skip, ssd_norm_w, ln_g, ln_b, ffn_w_gate, ffn_w_up, ffn_w_down, router_w,
              moe_w_gate, moe_w_up, moe_w_down):
    b, seq, _ = x.shape
    rows = seq // GRID_W
    xc = ctx
    for layer in range(DEPTH):
        last = layer == DEPTH - 1
        mod = (jax.nn.silu(c) @ w_mod[layer] + b_mod[layer])[:, None, :]
        mod_c = (jax.nn.silu(c_ctx) @ w_mod[layer] + b_mod[layer])[None, None, :]
        sh1, sc1, g1, sh2, sc2, g2 = jnp.split(mod, 6, axis=-1)
        sh1c, sc1c, g1c, sh2c, sc2c, g2c = jnp.split(mod_c, 6, axis=-1)
        q, k, v, z, xbc, dtr = _split_proj((x * (1.0 + sc1) + sh1) @ w_in[layer])
        qc, kc, vc, zc, xbcc, dtrc = _split_proj((xc * (1.0 + sc1c) + sh1c) @ w_in[layer])
        kc_h, vc_h = _heads(kc), _heads(vc)
        a_lat = _neighbourhood_attention(_heads(q), _heads(k), _heads(v), kc_h, vc_h, na_rpb[layer], rows)
        h_zero = jnp.zeros((b, N_HEADS_SSD, HEAD_DIM_SSD, D_STATE), x.dtype)
        s_ctx, hf, hb = _ssd_stream(zc, xbcc, dtrc, conv_w[layer], conv_b[layer], dt_bias[layer], a_log[layer],
                                    d_skip[layer], ssd_norm_w[layer], h_zero, h_zero, False)
        s_lat, _, _ = _ssd_stream(z, xbc, dtr, conv_w[layer], conv_b[layer], dt_bias[layer], a_log[layer],
                                  d_skip[layer], ssd_norm_w[layer], hf, hb, True)
        mix = jnp.concatenate([a_lat, s_lat], axis=-1) @ w_out[layer]
        x = _layernorm(DEEPNORM_ALPHA * x + (1.0 + g1) * mix, ln_g[layer, 0], ln_b[layer, 0])
        h2 = x * (1.0 + sc2) + sh2
        if layer % 2 == 0:
            wg, wu, wd = ffn_w_gate[layer // 2], ffn_w_up[layer // 2], ffn_w_down[layer // 2]
            chan = lambda t: _swiglu(t, wg, wu, wd)
        else:
            rw, eg, eu, ed = router_w[layer // 2], moe_w_gate[layer // 2], moe_w_up[layer // 2], moe_w_down[layer // 2]
            chan = lambda t: _moe(t, rw, eg, eu, ed)
        x = _layernorm(DEEPNORM_ALPHA * x + (1.0 + g2) * chan(h2), ln_g[layer, 1], ln_b[layer, 1])
        if not last:
            a_c = _context_attention(_heads(qc), kc_h, vc_h)
            mix_c = jnp.concatenate([a_c, s_ctx], axis=-1) @ w_out[layer]
            xc = _layernorm(DEEPNORM_ALPHA * xc + (1.0 + g1c) * mix_c, ln_g[layer, 0], ln_b[layer, 0])
            xc = _layernorm(DEEPNORM_ALPHA * xc + (1.0 + g2c) * chan(xc * (1.0 + sc2c) + sh2c),
                            ln_g[layer, 1], ln_b[layer, 1])
    return x
```

```cpp
#include <hip/hip_runtime.h>
#include <cstdio>
#include <cstdint>

#ifndef MK_SINGLE
#define MK_SINGLE 1
#endif

#define GAS __attribute__((address_space(1)))
#define LAS __attribute__((address_space(3)))
typedef unsigned short bf16_t;
typedef short bf16x8 __attribute__((ext_vector_type(8)));
typedef float f32x4 __attribute__((ext_vector_type(4)));
typedef float f32x2 __attribute__((ext_vector_type(2)));
typedef unsigned u32x4 __attribute__((ext_vector_type(4)));
typedef unsigned u32x2 __attribute__((ext_vector_type(2)));

constexpr int D = 1024, BATCH = 16, SEQ = 2048, DEPTH = 4, GRID_W = 64, CTX = 256;
constexpr int NLAT = BATCH * SEQ;
constexpr int NCTX = BATCH * CTX;
constexpr int NTOK = NLAT + NCTX;
constexpr int NPROJ = 3072;
constexpr int OFF_K = 512, OFF_V = 1024, OFF_Z = 1536, OFF_XBC = 2048;
constexpr int D_IN_PROJ = 3088;
constexpr int DFF = 2816, DFFE = 3584, NEXP = 8;
constexpr float ALPHA = 1.6817928305074290f;
constexpr float LN_EPS = 1e-5f, RMS_EPS = 1e-5f;
constexpr int MODW = 6 * D;

constexpr size_t MiB = 1u << 20;
constexpr size_t WS_CTL = 0, CTL_BYTES = 1 * MiB;
constexpr size_t WS_MOD = 1 * MiB;
constexpr size_t WS_ROUTE = 3 * MiB;
constexpr size_t WS_GATES = 4 * MiB;
constexpr size_t WS_LIST = 5 * MiB;
constexpr size_t WS_WDT = 7 * MiB;
constexpr size_t WS_WIN = 8 * MiB;
constexpr size_t WS_WOUT = 32 * MiB;
constexpr size_t WS_WFGU = 40 * MiB;
constexpr size_t WS_WFD = 62 * MiB;
constexpr size_t WS_WMGU = 73 * MiB;
constexpr size_t WS_WMD = 185 * MiB;
constexpr size_t WS_X = 241 * MiB;
constexpr size_t WS_H = 385 * MiB;
constexpr size_t WS_R = 457 * MiB;
constexpr size_t WS_PROJ = WS_R;
constexpr size_t WS_DT = WS_R + 216 * MiB;
constexpr size_t WS_YF = WS_R + 219 * MiB;
constexpr size_t WS_YB = WS_R + 291 * MiB;
constexpr size_t WS_MIX = WS_R + 363 * MiB;
constexpr size_t WS_HID = WS_R;
constexpr size_t WS_YP = WS_R + 270 * MiB;
constexpr size_t WS_END = WS_R + 435 * MiB;
constexpr int HALF_PAD = 2 * 18432 + 2048;
static_assert(WS_HID + (size_t)HALF_PAD * 3584 * 2 <= WS_YP && WS_YP + (size_t)2 * HALF_PAD * 1024 * 2 <= WS_END, "MoE buffers");

constexpr int CW_TMO = 0;
constexpr int CW_BAR = 4096;
constexpr int CW_CNT = 16384;

constexpr int LDS_STAGE = 131072;
constexpr int LDS_ROWOFF = 131072;
constexpr int LDS_MISC = 131072 + 18432;
constexpr int LDS_BYTES = 155648;

__device__ __forceinline__ unsigned f2bf(float f) { unsigned u = __builtin_bit_cast(unsigned, f); return (u + 0x7fffu + ((u >> 16) & 1u)) >> 16; }
__device__ __forceinline__ unsigned pk2(float lo, float hi) { return f2bf(lo) | (f2bf(hi) << 16); }
__device__ __forceinline__ float bf2f(unsigned short b) { return __builtin_bit_cast(float, ((unsigned)b) << 16); }
__device__ __forceinline__ float bflo(unsigned w) { return __builtin_bit_cast(float, w << 16); }
__device__ __forceinline__ float bfhi(unsigned w) { return __builtin_bit_cast(float, w & 0xffff0000u); }
__device__ __forceinline__ float silu_f(float v) { return v / (1.0f + __expf(-v)); }
__device__ __forceinline__ float wave_sum(float v) {
#pragma unroll
    for (int o = 1; o < 64; o <<= 1) v += __shfl_xor(v, o);
    return v;
}

namespace pg8 {
constexpr int BM = 256, BK = 64, HALF = 128, HTB = HALF * BK * 2, STAGE_BYTES = 8 * HTB, NXCD = 8, WGM = 8;
__host__ __device__ __forceinline__ int lds_byte(int r, int c) { const int st = (r >> 4) * 2 + (c >> 5), rr = r & 15, cc = c & 31, ob = rr * 64 + cc * 2; return st * 1024 + (ob ^ (((ob >> 9) & 1) << 5)); }
__host__ __device__ __forceinline__ void stage_rc(int b, int& R, int& C) { const int st = b / 1024, sb = b % 1024, swz = sb ^ (((sb >> 9) & 1) << 5); R = (st >> 1) * 16 + swz / 64; C = (st & 1) * 32 + (swz % 64) / 2; }
__host__ __device__ __forceinline__ int perm32(int rho) { const int n = rho >> 4, i = rho & 15; return 8 * (i >> 2) + 4 * n + (i & 3); }

struct Unit { int pm, pn; long bofs; };
struct Gemm { const bf16_t* A; const bf16_t* Bt; int K; };

__device__ __forceinline__ unsigned cvt_pk_bf16(float lo, float hi) { unsigned r; asm volatile("v_cvt_pk_bf16_f32 %0, %1, %2" : "=v"(r) : "v"(lo), "v"(hi)); return r; }

__device__ __forceinline__ bool static_tile(int i, int G, int c, int nM, int nN, int& pm, int& pn) {
    const int nwg = nM * nN; const long L = (long)i * G + c; if (L >= nwg) return false;
    int wgid = (int)L; { const int q = nwg / NXCD, r = nwg % NXCD, xcd = wgid % NXCD, off = wgid / NXCD; wgid = (xcd < r ? xcd * (q + 1) : r * (q + 1) + (xcd - r) * q) + off; }
    const int nig = WGM * nN, gid = wgid / nig, fm = gid * WGM, gsz = (nM - fm) < WGM ? (nM - fm) : WGM;
    pm = fm + ((wgid % nig) % gsz); pn = (wgid % nig) / gsz; return true;
}
struct DenseOrder {
    int nM, nN, G, c, K;
    __device__ __forceinline__ void init(int M, int N, int K_, int G_, int c_) { nM = M / BM; nN = N / BM; G = G_; c = c_; K = K_; }
    __device__ __forceinline__ bool next(int i, Unit& u) const { if (!static_tile(i, G, c, nM, nN, u.pm, u.pn)) return false; u.bofs = (long)u.pn * BM * K * 2; return true; }
    static constexpr bool GATHER = false;
    __device__ __forceinline__ long a_base(const Unit& u) const { return (long)u.pm * BM * K * 2; }
    __device__ __forceinline__ void a_offs(int, const Unit&, int, unsigned (&)[2][2]) const {}
};
template <bool GATHER_> struct MoeOrder {
    int nM, nN, G, c, K; int ts[9]; long estride; const LAS unsigned* rowoff;
    __device__ __forceinline__ int expert_of(int pm) const { int e = 0;
#pragma unroll
        for (int j = 1; j < 8; ++j) e += (pm >= ts[j]) ? 1 : 0; return e; }
    __device__ __forceinline__ bool next(int i, Unit& u) const { if (!static_tile(i, G, c, nM, nN, u.pm, u.pn)) return false; u.bofs = (long)expert_of(u.pm) * estride + (long)u.pn * BM * K * 2; return true; }
    static constexpr bool GATHER = GATHER_;
    __device__ __forceinline__ long a_base(const Unit& u) const { return GATHER_ ? 0l : (long)u.pm * BM * K * 2; }
    __device__ __forceinline__ void a_offs(int ui, const Unit&, int tid, unsigned (&o)[2][2]) const {
        if (GATHER_) {
#pragma unroll
            for (int i = 0; i < 2; ++i) { int R, C; stage_rc(tid * 16 + i * 8192, R, C);
#pragma unroll
                for (int h = 0; h < 2; ++h) o[h][i] = rowoff[ui * 256 + h * HALF + R] + (unsigned)(C * 2); }
        }
    }
};

struct EpiBf16 {
    static constexpr bool PERM = true;
    bf16_t* O; int ldc;
    __device__ __forceinline__ void operator()(const f32x4 (&acc)[2][2][4][2], const Unit& u, int wr, int wc, int fr, int fq) const {
        const int row0 = u.pm * BM + wr * 64 + fr; const int col0 = u.pn * BM + wc * 32 + 8 * fq;
#pragma unroll
        for (int ai = 0; ai < 2; ++ai)
#pragma unroll
            for (int m = 0; m < 4; ++m) { bf16_t* rowp = O + (size_t)(row0 + ai * HALF + m * 16) * ldc + col0;
#pragma unroll
                for (int bj = 0; bj < 2; ++bj) { const f32x4 v0 = acc[ai][bj][m][0], v1 = acc[ai][bj][m][1];
                    u32x4 w; w.x = cvt_pk_bf16(v0[0], v0[1]); w.y = cvt_pk_bf16(v0[2], v0[3]); w.z = cvt_pk_bf16(v1[0], v1[1]); w.w = cvt_pk_bf16(v1[2], v1[3]);
                    *(u32x4*)(rowp + bj * HALF) = w; } }
    }
};
struct EpiSwiGLU {
    static constexpr bool PERM = true;
    bf16_t* O; int ldc;
    __device__ __forceinline__ void operator()(const f32x4 (&acc)[2][2][4][2], const Unit& u, int wr, int wc, int fr, int fq) const {
        const int row0 = u.pm * BM + wr * 64 + fr; const int col0 = u.pn * HALF + wc * 32 + 8 * fq;
#pragma unroll
        for (int ai = 0; ai < 2; ++ai)
#pragma unroll
            for (int m = 0; m < 4; ++m) { bf16_t* rowp = O + (size_t)(row0 + ai * HALF + m * 16) * ldc + col0;
                float h[8];
#pragma unroll
                for (int n = 0; n < 2; ++n)
#pragma unroll
                    for (int j = 0; j < 4; ++j) { const float g = acc[ai][0][m][n][j], up = acc[ai][1][m][n][j]; h[n * 4 + j] = g * __builtin_amdgcn_rcpf(1.0f + __expf(-g)) * up; }
                u32x4 w; w.x = cvt_pk_bf16(h[0], h[1]); w.y = cvt_pk_bf16(h[2], h[3]); w.z = cvt_pk_bf16(h[4], h[5]); w.w = cvt_pk_bf16(h[6], h[7]);
                *(u32x4*)rowp = w; }
    }
};
struct EpiResid {
    static constexpr bool PERM = false;
    const float* base_lat; const float* base_ctx; float* out; const float* mod; int gate_off;
    __device__ __forceinline__ void operator()(const f32x4 (&acc)[2][2][4][2], const Unit& u, int wr, int wc, int fr, int fq) const {
        const int rt = u.pm * BM; const bool isctx = rt >= NLAT; const int bi = isctx ? 16 : (rt >> 11);
        const float* base = isctx ? base_ctx + (size_t)(rt - NLAT) * D : base_lat + (size_t)rt * D;
        float* o = out + (size_t)rt * D; const float* gt = mod + bi * MODW + gate_off;
        const int r0 = wr * 64 + fr, col0 = u.pn * BM + wc * 32 + 4 * fq;
        f32x4 gv[2][2];
#pragma unroll
        for (int bj = 0; bj < 2; ++bj)
#pragma unroll
            for (int n = 0; n < 2; ++n) gv[bj][n] = *(const f32x4*)(gt + col0 + bj * HALF + n * 16) + 1.0f;
#pragma unroll
        for (int ai = 0; ai < 2; ++ai)
#pragma unroll
            for (int m = 0; m < 4; ++m) { const size_t off = (size_t)(r0 + ai * HALF + m * 16) * D + col0;
#pragma unroll
                for (int bj = 0; bj < 2; ++bj)
#pragma unroll
                    for (int n = 0; n < 2; ++n) { const f32x4 bs = *(const f32x4*)(base + off + bj * HALF + n * 16);
                        *(f32x4*)(o + off + bj * HALF + n * 16) = bs * ALPHA + gv[bj][n] * acc[ai][bj][m][n]; }
                if (m & 1) asm volatile("" ::: "memory"); }
    }
};

template <class Epi, class Sched, bool ALIGN_EPI, bool SP2>
__device__ __forceinline__ void gemm_phase(LAS unsigned char* lds, const Gemm g, const Sched& S, const Epi& E) {
    int tid_ = threadIdx.x; asm volatile("" : "+v"(tid_));
    const int tid = tid_, wid = __builtin_amdgcn_readfirstlane(tid >> 6), lane = tid & 63, wr = wid >> 2, wc = wid & 3, fr = lane & 15, fq = lane >> 4;
    const int K = g.K, nt = K / BK;
    constexpr bool GA = Sched::GATHER;
    unsigned voffA[2], voffB[2];
#pragma unroll
    for (int i = 0; i < 2; ++i) { int R, C; stage_rc(tid * 16 + i * 8192, R, C); const int Rb = Epi::PERM ? ((R & ~31) + perm32(R & 31)) : R;
        voffA[i] = (unsigned)(R * K + C) * 2u; voffB[i] = (unsigned)(Rb * K + C) * 2u; }
    const size_t kstep = (size_t)(BK * 2);
    const size_t hstep = (size_t)HALF * K * 2;
    const unsigned ldsw = (unsigned)wid * 1024u;
    const int aoff = lds_byte(wr * 64 + fr, fq * 8), boff = lds_byte(wc * 32 + fr, fq * 8);
#define PG8_SA(b, h) (((b) * 2 + (h)) * HTB)
#define PG8_SB(b, h) ((4 + (b) * 2 + (h)) * HTB)
#define PG8_STAGE(bufoff, gbase, voff) do { _Pragma("unroll") for (int _i = 0; _i < 2; ++_i) \
        __builtin_amdgcn_global_load_lds((const unsigned*)((const char*)(gbase) + (voff)[_i]), (LAS unsigned*)(lds + (bufoff) + ldsw + _i * 8192), 16, 0, 0); } while (0)
#define PG8_LDA(dst, b, h) do { _Pragma("unroll") for (int m = 0; m < 4; ++m) _Pragma("unroll") for (int k = 0; k < 2; ++k) dst[m][k] = *(const LAS bf16x8*)(lds + PG8_SA(b, h) + aoff + m * 2048 + k * 1024); } while (0)
#define PG8_LDB(dst, b, h) do { _Pragma("unroll") for (int n = 0; n < 2; ++n) _Pragma("unroll") for (int k = 0; k < 2; ++k) dst[n][k] = *(const LAS bf16x8*)(lds + PG8_SB(b, h) + boff + n * 2048 + k * 1024); } while (0)
#define PG8_MMA(ai, bj, At, Bt) do { __builtin_amdgcn_s_setprio(1); _Pragma("unroll") for (int m = 0; m < 4; ++m) _Pragma("unroll") for (int n = 0; n < 2; ++n) _Pragma("unroll") for (int k = 0; k < 2; ++k) \
        acc[ai][bj][m][n] = __builtin_amdgcn_mfma_f32_16x16x32_bf16(Bt[n][k], At[m][k], acc[ai][bj][m][n], 0, 0, 0); __builtin_amdgcn_s_setprio(0); } while (0)
#define PG8_WAIT_V(n) asm volatile("s_waitcnt vmcnt(" #n ")" ::: "memory")
#define PG8_WAIT_L(n) asm volatile("s_waitcnt lgkmcnt(" #n ")" ::: "memory")
#define PG8_BAR __builtin_amdgcn_s_barrier()
#define PG8_SCHED __builtin_amdgcn_sched_barrier(0)
    Unit cur, nxt; int ui = 0;
    if (!S.next(0, cur)) return;
    f32x4 acc[2][2][4][2];
#pragma unroll
    for (int a = 0; a < 2; ++a)
#pragma unroll
        for (int b = 0; b < 2; ++b)
#pragma unroll
            for (int m = 0; m < 4; ++m)
#pragma unroll
                for (int n = 0; n < 2; ++n) acc[a][b][m][n] = (f32x4){0.f, 0.f, 0.f, 0.f};
    bf16x8 At[4][2], B0[2][2], B1[2][2];
    const char* Ab = (const char*)g.A + S.a_base(cur);
    unsigned oc[2][2];
    S.a_offs(0, cur, tid, oc);
    const size_t hsA = GA ? (size_t)0 : hstep;
#define PG8_STAGE_A(bufoff, gbase, h) do { if constexpr (GA) PG8_STAGE(bufoff, gbase, oc[h]); else PG8_STAGE(bufoff, (gbase) + (h) * hsA, voffA); } while (0)
    const char* cB = (const char*)g.Bt + cur.bofs;
    if constexpr (SP2) {
        PG8_STAGE(PG8_SB(0, 0), cB, voffB); PG8_STAGE(PG8_SB(0, 1), cB + hstep, voffB); PG8_STAGE_A(PG8_SA(0, 0), Ab, 0); PG8_STAGE_A(PG8_SA(0, 1), Ab, 1);
        if (wr == 1) PG8_BAR;
        PG8_WAIT_V(2); PG8_BAR;
        PG8_STAGE(PG8_SB(1, 0), cB + kstep, voffB); PG8_STAGE_A(PG8_SA(1, 0), Ab + kstep, 0); PG8_STAGE(PG8_SB(1, 1), cB + hstep + kstep, voffB);
        PG8_WAIT_V(6); PG8_BAR;
    } else {
        PG8_STAGE(PG8_SB(0, 0), cB, voffB); PG8_STAGE_A(PG8_SA(0, 0), Ab, 0); PG8_STAGE(PG8_SB(0, 1), cB + hstep, voffB); PG8_STAGE_A(PG8_SA(0, 1), Ab, 1);
        if (wr == 1) PG8_BAR;
        PG8_WAIT_V(4); PG8_BAR;
        PG8_STAGE(PG8_SB(1, 0), cB + kstep, voffB); PG8_STAGE_A(PG8_SA(1, 0), Ab + kstep, 0); PG8_STAGE(PG8_SB(1, 1), cB + hstep + kstep, voffB);
        PG8_WAIT_V(6); PG8_BAR;
    }
    for (;;) {
        const bool has_next = S.next(ui + 1, nxt);
        const char* nB = has_next ? (const char*)g.Bt + nxt.bofs : cB;
        for (int t = 0; t < nt; t += 2) {
            const bool last = (t == nt - 2);
            const char* a1 = Ab + (size_t)(t + 1) * kstep;
            const char* b2 = last ? nB : cB + (size_t)(t + 2) * kstep; const char* b3 = b2 + kstep;
            if constexpr (SP2) {
            PG8_LDB(B0, 0, 0); PG8_LDB(B1, 0, 1); PG8_SCHED; PG8_LDA(At, 0, 0); PG8_STAGE_A(PG8_SA(1, 1), a1, 1);
            if (last && has_next) { S.a_offs(ui + 1, nxt, tid, oc); Ab = (const char*)g.A + S.a_base(nxt); }
            const char* a2 = last ? Ab : Ab + (size_t)(t + 2) * kstep; const char* a3 = a2 + kstep;
            PG8_WAIT_V(8); PG8_WAIT_L(0); PG8_BAR; PG8_MMA(0, 0, At, B0); PG8_MMA(0, 1, At, B1); PG8_BAR; PG8_SCHED;
            PG8_LDA(At, 0, 1); PG8_STAGE(PG8_SB(0, 0), b2, voffB); PG8_STAGE(PG8_SB(0, 1), b2 + hstep, voffB); PG8_STAGE_A(PG8_SA(0, 0), a2, 0);
            PG8_WAIT_V(8); PG8_WAIT_L(0); PG8_BAR; PG8_MMA(1, 0, At, B0); PG8_MMA(1, 1, At, B1); PG8_BAR; PG8_SCHED;
            PG8_LDB(B0, 1, 0); PG8_LDB(B1, 1, 1); PG8_SCHED; PG8_LDA(At, 1, 0); PG8_STAGE_A(PG8_SA(0, 1), a2, 1);
            PG8_WAIT_V(8); PG8_WAIT_L(0); PG8_BAR; PG8_MMA(0, 0, At, B0); PG8_MMA(0, 1, At, B1); PG8_BAR; PG8_SCHED;
            PG8_LDA(At, 1, 1); PG8_STAGE(PG8_SB(1, 0), b3, voffB); PG8_STAGE(PG8_SB(1, 1), b3 + hstep, voffB); PG8_STAGE_A(PG8_SA(1, 0), a3, 0);
            PG8_WAIT_V(8); PG8_WAIT_L(0); PG8_BAR; PG8_MMA(1, 0, At, B0); PG8_MMA(1, 1, At, B1); PG8_BAR; PG8_SCHED;
            } else {
            PG8_LDB(B0, 0, 0); PG8_SCHED; PG8_LDA(At, 0, 0); PG8_STAGE_A(PG8_SA(1, 1), a1, 1);
            if (last && has_next) { S.a_offs(ui + 1, nxt, tid, oc); Ab = (const char*)g.A + S.a_base(nxt); }
            const char* a2 = last ? Ab : Ab + (size_t)(t + 2) * kstep; const char* a3 = a2 + kstep;
            PG8_WAIT_L(8); PG8_BAR; PG8_WAIT_L(0); PG8_MMA(0, 0, At, B0); PG8_BAR; PG8_SCHED;
            PG8_LDB(B1, 0, 1); PG8_STAGE(PG8_SB(0, 0), b2, voffB);
            PG8_BAR; PG8_WAIT_L(0); PG8_MMA(0, 1, At, B1); PG8_BAR;
            PG8_LDA(At, 0, 1); PG8_STAGE_A(PG8_SA(0, 0), a2, 0);
            PG8_BAR; PG8_WAIT_L(0); PG8_MMA(1, 0, At, B0); PG8_BAR; PG8_SCHED;
            PG8_STAGE(PG8_SB(0, 1), b2 + hstep, voffB);
            PG8_WAIT_V(6); PG8_BAR; PG8_MMA(1, 1, At, B1); PG8_BAR;
            PG8_LDB(B0, 1, 0); PG8_SCHED; PG8_LDA(At, 1, 0); PG8_STAGE_A(PG8_SA(0, 1), a2, 1);
            PG8_WAIT_L(8); PG8_BAR; PG8_WAIT_L(0); PG8_MMA(0, 0, At, B0); PG8_BAR; PG8_SCHED;
            PG8_LDB(B1, 1, 1); PG8_STAGE(PG8_SB(1, 0), b3, voffB);
            PG8_BAR; PG8_WAIT_L(0); PG8_MMA(0, 1, At, B1); PG8_BAR;
            PG8_LDA(At, 1, 1); PG8_STAGE_A(PG8_SA(1, 0), a3, 0);
            PG8_BAR; PG8_WAIT_L(0); PG8_MMA(1, 0, At, B0); PG8_BAR; PG8_SCHED;
            PG8_STAGE(PG8_SB(1, 1), b3 + hstep, voffB);
            PG8_WAIT_V(6); PG8_BAR; PG8_MMA(1, 1, At, B1); PG8_BAR;
            }
        }
        if constexpr (ALIGN_EPI) { if (wr == 0) PG8_BAR; }
        E(acc, cur, wr, wc, fr, fq);
        if (!has_next) break;
#pragma unroll
        for (int a = 0; a < 2; ++a)
#pragma unroll
            for (int b = 0; b < 2; ++b)
#pragma unroll
                for (int m = 0; m < 4; ++m)
#pragma unroll
                    for (int n = 0; n < 2; ++n) acc[a][b][m][n] = (f32x4){0.f, 0.f, 0.f, 0.f};
        cur = nxt; cB = nB; ++ui;
        if constexpr (ALIGN_EPI) { if (wr == 1) PG8_BAR; }
    }
    PG8_WAIT_V(0);
    if constexpr (!ALIGN_EPI) { if (wr == 0) PG8_BAR; }
    PG8_BAR;
#undef PG8_SA
#undef PG8_SB
#undef PG8_STAGE
#undef PG8_STAGE_A
#undef PG8_LDA
#undef PG8_LDB
#undef PG8_MMA
#undef PG8_WAIT_V
#undef PG8_WAIT_L
#undef PG8_BAR
#undef PG8_SCHED
}
}

#define XB_TMO      128
#define XB_XCNT(j)  (256  + 64 * (j))
#define XB_XSUB(j)  (1280 + 64 * (j))
#define XB_XGEN(j)  (2304 + 64 * (j))
#define XB_TOP      3328
#define XB_TOPGEN   3392
#define XCD_BAR_WORDS 3456
#define XB_SPIN_CAP (1u << 18)
__device__ __forceinline__ unsigned xb_ld(unsigned* p)              { return __hip_atomic_load(p, __ATOMIC_RELAXED, __HIP_MEMORY_SCOPE_AGENT); }
__device__ __forceinline__ unsigned xb_add(unsigned* p, unsigned v) { return __hip_atomic_fetch_add(p, v, __ATOMIC_RELAXED, __HIP_MEMORY_SCOPE_AGENT); }
__device__ __forceinline__ unsigned xb_xcc_id() { return (unsigned)__builtin_amdgcn_s_getreg((3 << 11) | 20) & 0xFu; }
#define XB_SPIN(cond, bar) do { unsigned _sp = 0; while (cond) { __builtin_amdgcn_s_sleep(1); \
    if ((++_sp & 255u) == 0u) { if (xb_ld(&(bar)[XB_TMO])) break; if (_sp > XB_SPIN_CAP) { atomicAdd(&(bar)[XB_TMO], 1u); break; } } } } while (0)
struct XcdBarrier { unsigned* bar; unsigned x; volatile LAS unsigned* st; };
__device__ __forceinline__ XcdBarrier xcd_barrier_post(unsigned* bar, volatile LAS unsigned* st) {
    XcdBarrier b; b.bar = bar; b.x = xb_xcc_id(); b.st = st;
    if (threadIdx.x == 0) (void)xb_add(&bar[XB_XCNT(b.x)], 1u);
    return b;
}
__device__ __forceinline__ void xcd_barrier_complete(unsigned* bar, unsigned x, unsigned& nloc, unsigned& nx) {
    const unsigned G = gridDim.x * gridDim.y * gridDim.z;
    unsigned sum, cnt, mine, sp = 0u;
    for (;;) {
        sum = 0u; cnt = 0u; mine = 0u;
#pragma unroll
        for (unsigned j = 0; j < 16; ++j) { const unsigned c = xb_ld(&bar[XB_XCNT(j)]); sum += c; cnt += (c > 0u) ? 1u : 0u; mine = (j == x) ? c : mine; }
        if (sum == G) break;
        __builtin_amdgcn_s_sleep(1);
        if ((++sp & 255u) == 0u) { if (xb_ld(&bar[XB_TMO])) break; if (sp > XB_SPIN_CAP) { atomicAdd(&bar[XB_TMO], 1u); break; } }
    }
    nloc = mine > 0u ? mine : 1u; nx = cnt > 0u ? cnt : 1u;
}
__device__ __forceinline__ void xcd_barrier(const XcdBarrier& b) {
    asm volatile("s_waitcnt vmcnt(0)" ::: "memory");
    __syncthreads();
    if (threadIdx.x == 0) {
        unsigned* bar = b.bar;
        __builtin_amdgcn_s_waitcnt(0);
        unsigned nloc = b.st[0], nx = b.st[1];
        if (nloc == 0u) { xcd_barrier_complete(bar, b.x, nloc, nx); b.st[0] = nloc; b.st[1] = nx; }
        const unsigned old = xb_add(&bar[XB_XSUB(b.x)], 1u);
        const unsigned gen = old / nloc;
        if (old + 1u == (gen + 1u) * nloc) {
            __builtin_amdgcn_fence(__ATOMIC_RELEASE, "agent");
            asm volatile("s_waitcnt vmcnt(0)" ::: "memory");
            const unsigned og = xb_add(&bar[XB_TOP], 1u);
            const unsigned tg = og / nx;
            if (og + 1u == (tg + 1u) * nx) xb_add(&bar[XB_TOPGEN], 1u);
            else XB_SPIN(xb_ld(&bar[XB_TOPGEN]) == tg, bar);
            __builtin_amdgcn_fence(__ATOMIC_ACQUIRE, "agent");
            xb_add(&bar[XB_XGEN(b.x)], 1u);
            asm volatile("s_waitcnt vmcnt(0)" ::: "memory");
        } else {
            XB_SPIN(xb_ld(&bar[XB_XGEN(b.x)]) == gen, bar);
            __builtin_amdgcn_fence(__ATOMIC_ACQUIRE, "agent");
            asm volatile("s_waitcnt vmcnt(0)" ::: "memory");
        }
    }
    __syncthreads();
}

constexpr int NT = 512, NWAVES = 8;
struct Args { const float* in[24]; float* out; unsigned char* ws; int ph_lo, ph_hi; };
enum { I_X = 0, I_C, I_CTX, I_CCTX, I_WMOD, I_BMOD, I_WIN, I_WOUT, I_RPB, I_CONVW, I_CONVB, I_DTB, I_ALOG, I_DSKIP, I_NORMW, I_LNG, I_LNB, I_FG, I_FU, I_FD, I_RW, I_MG, I_MU, I_MD };
struct Frame {
    LAS unsigned char* lds;
    const float* const* in; float* out; unsigned char* ws;
    int tid, lane, wave, bid, G, gw, NGW;
};
#define LDS_WAIT() asm volatile("s_waitcnt lgkmcnt(0)" ::: "memory")
__device__ __forceinline__ Frame fresh(const Frame& F0) {
    Frame F = F0; int z; asm volatile("s_mov_b32 %0, 0" : "=s"(z)); F.ws = F0.ws + z; F.in = F0.in + z; F.out = F0.out + z;
    int t = F0.tid; asm volatile("" : "+v"(t)); F.tid = t; F.lane = t & 63; return F;
}

__device__ __forceinline__ void conv_item(const float* W, int ldn, int k0, int n0, bf16_t* dst, int K, int drow0, LAS float* scr, int lane) {
#pragma unroll 8
    for (int i = 0; i < 32; ++i) { const int kk = 2 * i + (lane >> 5); scr[kk * 33 + (lane & 31)] = W[(size_t)(k0 + kk) * ldn + n0 + (lane & 31)]; }
    LDS_WAIT(); asm volatile("" ::: "memory");
    const int c = lane & 7;
#pragma unroll
    for (int j = 0; j < 4; ++j) { const int n = (lane >> 3) + 8 * j; const LAS float* s = scr + (8 * c) * 33 + n;
        u32x4 o; o.x = pk2(s[0 * 33], s[1 * 33]); o.y = pk2(s[2 * 33], s[3 * 33]); o.z = pk2(s[4 * 33], s[5 * 33]); o.w = pk2(s[6 * 33], s[7 * 33]);
        *(u32x4*)(dst + (size_t)(drow0 + n) * K + k0 + 8 * c) = o; }
    LDS_WAIT(); asm volatile("" ::: "memory");
}
__device__ __forceinline__ void conv_seg(const Frame& F, const float* W, int K, int ldn, int ncols, bf16_t* dst, int mode, int& rot) {
    LAS float* scr = (LAS float*)(F.lds + F.wave * 16384);
    const int nblk = ncols / 32, nitems = (K / 64) * nblk;
    int start = F.gw - rot; if (start < 0) start += F.NGW;
    for (int it = start; it < nitems; it += F.NGW) {
        const int kb = it / nblk, nb = it % nblk, n0 = nb * 32;
        const int drow0 = (mode == 0) ? n0 : ((n0 >> 7) * 256 + (n0 & 127) + (mode == 2 ? 128 : 0));
        conv_item(W, ldn, kb * 64, n0, dst, K, drow0, scr, F.lane);
    }
    rot = (rot + nitems) % F.NGW;
}
__device__ __forceinline__ void conv_moe(const Frame& F, int slot, int& rot) {
    bf16_t* gu = (bf16_t*)(F.ws + WS_WMGU); bf16_t* dn = (bf16_t*)(F.ws + WS_WMD);
    for (int e = 0; e < NEXP; ++e) {
        const size_t so = ((size_t)slot * NEXP + e) * (size_t)D * DFFE;
        conv_seg(F, F.in[I_MG] + so, D, DFFE, DFFE, gu + (size_t)e * 2 * DFFE * D, 1, rot);
        conv_seg(F, F.in[I_MU] + so, D, DFFE, DFFE, gu + (size_t)e * 2 * DFFE * D, 2, rot);
        conv_seg(F, F.in[I_MD] + so, DFFE, D, D, dn + (size_t)e * D * DFFE, 0, rot);
    }
}

__device__ __forceinline__ void p_pro_a(const Frame& F) {
    {
        LAS float* sc = (LAS float*)F.lds; LAS float* red = sc + 17 * 1024;
        const float* c = F.in[I_C]; const float* cc = F.in[I_CCTX];
        for (int i = F.tid; i < 17 * 1024; i += NT) { const int r = i >> 10, k = i & 1023; const float v = (r < 16) ? c[r * 1024 + k] : cc[k]; sc[i] = silu_f(v); }
        __syncthreads();
        float* MOD = (float*)(F.ws + WS_MOD);
        const int col = F.tid & 63, ks = F.tid >> 6;
        for (int u = F.bid; u < 4 * 96; u += F.G) {
            const int l = u / 96, cb = u % 96;
            const float* W = F.in[I_WMOD] + (size_t)l * D * MODW + cb * 64 + col;
            float acc[17];
#pragma unroll
            for (int r = 0; r < 17; ++r) acc[r] = 0.f;
            for (int k = ks * 128; k < ks * 128 + 128; ++k) { const float w = W[(size_t)k * MODW];
#pragma unroll
                for (int r = 0; r < 17; ++r) acc[r] += sc[r * 1024 + k] * w; }
#pragma unroll
            for (int r = 0; r < 17; ++r) red[(ks * 17 + r) * 64 + col] = acc[r];
            __syncthreads();
            for (int i = F.tid; i < 17 * 64; i += NT) { const int r = i >> 6, c2 = i & 63; float s = 0.f;
#pragma unroll
                for (int k2 = 0; k2 < 8; ++k2) s += red[(k2 * 17 + r) * 64 + c2];
                MOD[(size_t)(l * 17 + r) * MODW + cb * 64 + c2] = s + F.in[I_BMOD][l * MODW + cb * 64 + c2]; }
            __syncthreads();
        }
    }
    int rot = 0;
    for (int l = 0; l < DEPTH; ++l) {
        conv_seg(F, F.in[I_WIN] + (size_t)l * D * D_IN_PROJ, D, D_IN_PROJ, NPROJ, (bf16_t*)(F.ws + WS_WIN) + (size_t)l * NPROJ * D, 0, rot);
        conv_seg(F, F.in[I_WOUT] + (size_t)l * D * D, D, D, D, (bf16_t*)(F.ws + WS_WOUT) + (size_t)l * D * D, 0, rot);
    }
    for (int s = 0; s < 2; ++s) {
        conv_seg(F, F.in[I_FG] + (size_t)s * D * DFF, D, DFF, DFF, (bf16_t*)(F.ws + WS_WFGU) + (size_t)s * 2 * DFF * D, 1, rot);
        conv_seg(F, F.in[I_FU] + (size_t)s * D * DFF, D, DFF, DFF, (bf16_t*)(F.ws + WS_WFGU) + (size_t)s * 2 * DFF * D, 2, rot);
        conv_seg(F, F.in[I_FD] + (size_t)s * DFF * D, DFF, D, D, (bf16_t*)(F.ws + WS_WFD) + (size_t)s * D * DFF, 0, rot);
    }
    conv_moe(F, 0, rot);
    { bf16_t* wdt = (bf16_t*)(F.ws + WS_WDT);
      for (int i = F.bid * NT + F.tid; i < DEPTH * 16 * D; i += F.G * NT) { const int l = i / (16 * D), n = (i / D) & 15, k = i % D;
          wdt[i] = (bf16_t)f2bf(F.in[I_WIN][((size_t)l * D + k) * D_IN_PROJ + NPROJ + n]); } }
}

__device__ __forceinline__ void row_load(const float* p, int lane, f32x4 (&v)[4]) {
#pragma unroll
    for (int j = 0; j < 4; ++j) v[j] = *(const f32x4*)(p + 4 * lane + 256 * j);
}
__device__ __forceinline__ void row_store(float* p, int lane, const f32x4 (&v)[4]) {
#pragma unroll
    for (int j = 0; j < 4; ++j) *(f32x4*)(p + 4 * lane + 256 * j) = v[j];
}
__device__ __forceinline__ void row_mod_store(bf16_t* hrow, int lane, const f32x4 (&v)[4], const float* sh, const float* sc, f32x4 (&hv)[4]) {
#pragma unroll
    for (int j = 0; j < 4; ++j) { const f32x4 a = *(const f32x4*)(sc + 4 * lane + 256 * j), b = *(const f32x4*)(sh + 4 * lane + 256 * j);
        hv[j] = v[j] * (a + 1.0f) + b;
        u32x2 w; w.x = pk2(hv[j][0], hv[j][1]); w.y = pk2(hv[j][2], hv[j][3]);
        *(u32x2*)(hrow + 4 * lane + 256 * j) = w; }
}
__device__ __forceinline__ void row_ln(f32x4 (&v)[4], const float* g, const float* b, int lane) {
    float s = 0.f;
#pragma unroll
    for (int j = 0; j < 4; ++j) s += (v[j][0] + v[j][1]) + (v[j][2] + v[j][3]);
    const float mean = wave_sum(s) * (1.0f / D); float q = 0.f;
#pragma unroll
    for (int j = 0; j < 4; ++j) { v[j] = v[j] - mean; q += (v[j][0] * v[j][0] + v[j][1] * v[j][1]) + (v[j][2] * v[j][2] + v[j][3] * v[j][3]); }
    const float rstd = 1.0f / sqrtf(wave_sum(q) * (1.0f / D) + LN_EPS);
#pragma unroll
    for (int j = 0; j < 4; ++j) { const f32x4 gg = *(const f32x4*)(g + 4 * lane + 256 * j), bb = *(const f32x4*)(b + 4 * lane + 256 * j); v[j] = v[j] * rstd * gg + bb; }
}
__device__ __forceinline__ int mod_row_of(int row) { return row < NLAT ? (row >> 11) : 16; }

__device__ __forceinline__ void p_pro_b(const Frame& F) {
    const float* MOD = (const float*)(F.ws + WS_MOD); bf16_t* H = (bf16_t*)(F.ws + WS_H);
    for (int row = F.gw; row < NTOK; row += F.NGW) {
        const float* src = row < NLAT ? F.in[I_X] + (size_t)row * D : F.in[I_CTX] + (size_t)(row - NLAT) * D;
        f32x4 v[4], hv[4]; row_load(src, F.lane, v);
        const float* m = MOD + (size_t)mod_row_of(row) * MODW;
        row_mod_store(H + (size_t)row * D, F.lane, v, m, m + D, hv);
    }
}

__device__ __forceinline__ void p_inproj(const Frame& F, int layer) {
    const bf16_t* H = (const bf16_t*)(F.ws + WS_H);
    {
        const bf16_t* wdt = (const bf16_t*)(F.ws + WS_WDT) + (size_t)layer * 16 * D; float* DT = (float*)(F.ws + WS_DT);
        const int fr = F.lane & 15, fq = F.lane >> 4;
        for (int g = F.gw; g < NTOK / 16; g += F.NGW) {
            f32x4 acc = {0.f, 0.f, 0.f, 0.f};
            const bf16_t* ap = H + (size_t)(g * 16 + fr) * D + fq * 8; const bf16_t* bp = wdt + (size_t)fr * D + fq * 8;
#pragma unroll 8
            for (int ks = 0; ks < 32; ++ks) { const bf16x8 a = *(const bf16x8*)(ap + ks * 32), b = *(const bf16x8*)(bp + ks * 32);
                acc = __builtin_amdgcn_mfma_f32_16x16x32_bf16(a, b, acc, 0, 0, 0); }
#pragma unroll
            for (int r = 0; r < 4; ++r) DT[(size_t)(g * 16 + fq * 4 + r) * 16 + fr] = acc[r];
        }
    }
    pg8::Gemm g{H, (const bf16_t*)(F.ws + WS_WIN) + (size_t)layer * NPROJ * D, D};
    pg8::DenseOrder S; S.init(NTOK, NPROJ, D, F.G, F.bid);
    pg8::EpiBf16 E{(bf16_t*)(F.ws + WS_PROJ), NPROJ};
    pg8::gemm_phase<pg8::EpiBf16, pg8::DenseOrder, true, true>(F.lds, g, S, E);
}

__device__ __forceinline__ void ssd_scan_unit(const Frame& F, int layer, int b, int h, int dir) {
    const int g = h >> 2;
    LAS bf16_t* raw = (LAS bf16_t*)F.lds;
    LAS float* xs = (LAS float*)(F.lds + 23040);
    LAS float* Bm = (LAS float*)(F.lds + 31232);
    LAS float* Cm = (LAS float*)(F.lds + 47616);
    LAS float* dtv = (LAS float*)(F.lds + 64000);
    LAS float* dec = dtv + 32;
    LAS float* yp = (LAS float*)(F.lds + 64256);
    LAS float* cw = (LAS float*)(F.lds + 97024);
    const bf16_t* PROJ = (const bf16_t*)(F.ws + WS_PROJ); const float* DT = (const float*)(F.ws + WS_DT);
    float* Y = (float*)(F.ws + (dir ? WS_YB : WS_YF));
    const float* convw = F.in[I_CONVW] + (size_t)layer * 5 * 1024; const float* convb = F.in[I_CONVB] + (size_t)layer * 1024;
    const float dtb = F.in[I_DTB][layer * 16 + dir * 8 + h], aneg = -__expf(F.in[I_ALOG][layer * 16 + dir * 8 + h]), dsk = F.in[I_DSKIP][layer * 8 + h];
    __syncthreads();
    for (int i = F.tid; i < 6 * 320; i += NT) { const int j = i / 320, ch = i % 320;
        const int cg = (ch < 64) ? h * 64 + ch : (ch < 192) ? 512 + g * 128 + (ch - 64) : 768 + g * 128 + (ch - 192);
        cw[i] = (j < 5) ? convw[j * 1024 + cg] : convb[cg]; }
    float S[16];
#pragma unroll
    for (int i = 0; i < 16; ++i) S[i] = 0.f;
    const int p = F.lane, w = F.wave, n0 = 16 * w;
    for (int s = 0; s < 2; ++s) {
        const int L = s ? SEQ : CTX; const int rowbase = s ? b * SEQ : NLAT + b * CTX;
        for (int blk = 0; blk < L / 32; ++blk) {
            const int t0 = dir ? (L - 32 - blk * 32) : blk * 32;
            __syncthreads();
            for (int i = F.tid; i < 36 * 40; i += NT) { const int r = i / 40, c8 = i % 40, t = t0 - 2 + r;
                const int col = (c8 < 8) ? OFF_XBC + h * 64 + c8 * 8 : (c8 < 24) ? OFF_XBC + 512 + g * 128 + (c8 - 8) * 8 : OFF_XBC + 768 + g * 128 + (c8 - 24) * 8;
                u32x4 v = {0u, 0u, 0u, 0u};
                if (t >= 0 && t < L) v = *(const u32x4*)(PROJ + (size_t)(rowbase + t) * NPROJ + col);
                *(LAS u32x4*)(raw + r * 320 + c8 * 8) = v; }
            __syncthreads();
            for (int i = F.tid; i < 32 * 320; i += NT) { const int tt = i / 320, ch = i % 320;
                float a = cw[5 * 320 + ch];
#pragma unroll
                for (int j = 0; j < 5; ++j) a += cw[j * 320 + ch] * bf2f(raw[(tt + j) * 320 + ch]);
                const float u = silu_f(a);
                if (ch < 64) xs[tt * 64 + ch] = u; else if (ch < 192) Bm[tt * 128 + ch - 64] = u; else Cm[tt * 128 + ch - 192] = u; }
            if (F.tid < 32) { const float x = DT[(size_t)(rowbase + t0 + F.tid) * 16 + dir * 8 + h] + dtb;
                const float dt = x > 20.f ? x : log1pf(__expf(x)); dtv[F.tid] = dt; dec[F.tid] = __expf(dt * aneg); }
            __syncthreads();
            if (s == 1) {
                for (int i = F.tid; i < 2 * 32 * 64; i += NT) { const int which = i >> 11, rem = i & 2047, tt = rem >> 6, q = rem & 63, hf = q >> 5, n = q & 31;
                    const int t = t0 + tt; const int pos = hf ? (t & 63) : (t >> 6);
                    const float ang = (float)pos * __expf(-(float)n * (9.210340371976184f / 32.0f));
                    float sn, cs; sincosf(ang, &sn, &cs);
                    LAS float* arr = which ? Cm : Bm; const int i1 = tt * 128 + hf * 64 + n, i2 = i1 + 32; const float w1 = arr[i1], w2 = arr[i2];
                    arr[i1] = w1 * cs - w2 * sn; arr[i2] = w1 * sn + w2 * cs; }
                __syncthreads();
            }
            for (int jj = 0; jj < 32; ++jj) {
                const int tt = dir ? 31 - jj : jj;
                const float xdt = xs[tt * 64 + p] * dtv[tt], dc = dec[tt];
                float y = 0.f;
#pragma unroll
                for (int i4 = 0; i4 < 4; ++i4) { const f32x4 bv = *(const LAS f32x4*)(Bm + tt * 128 + n0 + 4 * i4), cv = *(const LAS f32x4*)(Cm + tt * 128 + n0 + 4 * i4);
#pragma unroll
                    for (int k = 0; k < 4; ++k) { S[4 * i4 + k] = S[4 * i4 + k] * dc + xdt * bv[k]; y += S[4 * i4 + k] * cv[k]; } }
                yp[((jj & 15) * 8 + w) * 64 + p] = y;
                if ((jj & 15) == 15) {
                    __syncthreads();
                    for (int i = F.tid; i < 16 * 64; i += NT) { const int j2 = i >> 6, pp = i & 63; float sum = 0.f;
#pragma unroll
                        for (int w2 = 0; w2 < 8; ++w2) sum += yp[(j2 * 8 + w2) * 64 + pp];
                        const int js = jj - 15 + j2, ttk = dir ? 31 - js : js;
                        if (dir == 0) sum += dsk * xs[ttk * 64 + pp];
                        Y[(size_t)(rowbase + t0 + ttk) * 512 + h * 64 + pp] = sum; }
                    __syncthreads();
                }
            }
        }
    }
}

__device__ __forceinline__ void na_simple(const Frame& F, int layer, bool last) {
    const bf16_t* PROJ = (const bf16_t*)(F.ws + WS_PROJ); bf16_t* MIX = (bf16_t*)(F.ws + WS_MIX);
    const float* rpb = F.in[I_RPB] + (size_t)layer * 8 * 15 * 31;
    const int total = NLAT * 8 + (last ? 0 : NCTX * 8);
    for (int idx = F.bid * NT + F.tid; idx < total; idx += F.G * NT) {
        int b, h, row, nloc, i = 0, j = 0, r0 = 0, cs = 0;
        if (idx < NLAT * 8) { const int bh = idx >> 11, t = idx & 2047; b = bh >> 3; h = bh & 7; row = b * SEQ + t; i = t >> 6; j = t & 63;
            r0 = i - 4; r0 = r0 < 0 ? 0 : (r0 > 24 ? 24 : r0); cs = j - 8; cs = cs < 0 ? 0 : (cs > 48 ? 48 : cs); nloc = 128; }
        else { const int i2 = idx - NLAT * 8, bh = i2 >> 8, tc = i2 & 255; b = bh >> 3; h = bh & 7; row = NLAT + b * CTX + tc; nloc = 0; }
        float q[64], acc[64];
        { const u32x4* qp = (const u32x4*)(PROJ + (size_t)row * NPROJ + h * 64);
#pragma unroll
          for (int c = 0; c < 8; ++c) { const u32x4 v = qp[c];
              q[c * 8 + 0] = bflo(v.x) * 0.125f; q[c * 8 + 1] = bfhi(v.x) * 0.125f; q[c * 8 + 2] = bflo(v.y) * 0.125f; q[c * 8 + 3] = bfhi(v.y) * 0.125f;
              q[c * 8 + 4] = bflo(v.z) * 0.125f; q[c * 8 + 5] = bfhi(v.z) * 0.125f; q[c * 8 + 6] = bflo(v.w) * 0.125f; q[c * 8 + 7] = bfhi(v.w) * 0.125f; } }
#pragma unroll
        for (int d = 0; d < 64; ++d) acc[d] = 0.f;
        float m = -INFINITY, l = 0.f;
        for (int kk = 0; kk < nloc + CTX; ++kk) {
            int krow; float bias = 0.f;
            if (kk < nloc) { const int kr = kk >> 4, kc = kk & 15; krow = b * SEQ + (r0 + kr) * 64 + cs + kc; bias = rpb[(h * 15 + (r0 + kr - i + 7)) * 31 + (cs + kc - j + 15)]; }
            else krow = NLAT + b * CTX + (kk - nloc);
            const u32x4* kp = (const u32x4*)(PROJ + (size_t)krow * NPROJ + OFF_K + h * 64);
            const u32x4* vp = (const u32x4*)(PROJ + (size_t)krow * NPROJ + OFF_V + h * 64);
            float s = bias;
#pragma unroll
            for (int c = 0; c < 8; ++c) { const u32x4 v = kp[c];
                s += q[c * 8 + 0] * bflo(v.x) + q[c * 8 + 1] * bfhi(v.x) + q[c * 8 + 2] * bflo(v.y) + q[c * 8 + 3] * bfhi(v.y)
                   + q[c * 8 + 4] * bflo(v.z) + q[c * 8 + 5] * bfhi(v.z) + q[c * 8 + 6] * bflo(v.w) + q[c * 8 + 7] * bfhi(v.w); }
            const float mn = fmaxf(m, s), corr = __expf(m - mn), pe = __expf(s - mn);
            l = l * corr + pe; m = mn;
#pragma unroll
            for (int c = 0; c < 8; ++c) { const u32x4 v = vp[c];
                acc[c * 8 + 0] = acc[c * 8 + 0] * corr + pe * bflo(v.x); acc[c * 8 + 1] = acc[c * 8 + 1] * corr + pe * bfhi(v.x);
                acc[c * 8 + 2] = acc[c * 8 + 2] * corr + pe * bflo(v.y); acc[c * 8 + 3] = acc[c * 8 + 3] * corr + pe * bfhi(v.y);
                acc[c * 8 + 4] = acc[c * 8 + 4] * corr + pe * bflo(v.z); acc[c * 8 + 5] = acc[c * 8 + 5] * corr + pe * bfhi(v.z);
                acc[c * 8 + 6] = acc[c * 8 + 6] * corr + pe * bflo(v.w); acc[c * 8 + 7] = acc[c * 8 + 7] * corr + pe * bfhi(v.w); }
        }
        const float inv = 1.0f / l;
        u32x4* op = (u32x4*)(MIX + (size_t)row * D + h * 64);
#pragma unroll
        for (int c = 0; c < 8; ++c) { u32x4 o; o.x = pk2(acc[c * 8 + 0] * inv, acc[c * 8 + 1] * inv); o.y = pk2(acc[c * 8 + 2] * inv, acc[c * 8 + 3] * inv);
            o.z = pk2(acc[c * 8 + 4] * inv, acc[c * 8 + 5] * inv); o.w = pk2(acc[c * 8 + 6] * inv, acc[c * 8 + 7] * inv); op[c] = o; }
    }
}
__device__ __forceinline__ void p_mixer(const Frame& F, int layer, bool last) {
    for (int u = F.bid; u < 256; u += F.G) ssd_scan_unit(F, layer, u >> 4, (u >> 1) & 7, u & 1);
    __syncthreads();
    na_simple(F, layer, last);
}

__device__ __forceinline__ void p_ssdcomb(const Frame& F, int layer, bool last) {
    const bf16_t* PROJ = (const bf16_t*)(F.ws + WS_PROJ); bf16_t* MIX = (bf16_t*)(F.ws + WS_MIX);
    const float* YF = (const float*)(F.ws + WS_YF); const float* YB = (const float*)(F.ws + WS_YB);
    const float* nw = F.in[I_NORMW] + layer * 512 + F.lane * 8;
    const f32x4 nw0 = *(const f32x4*)nw, nw1 = *(const f32x4*)(nw + 4);
    const int nrows = last ? NLAT : NTOK;
    for (int row = F.gw; row < nrows; row += F.NGW) {
        const size_t o = (size_t)row * 512 + F.lane * 8;
        const f32x4 a0 = *(const f32x4*)(YF + o) + *(const f32x4*)(YB + o), a1 = *(const f32x4*)(YF + o + 4) + *(const f32x4*)(YB + o + 4);
        const u32x4 zv = *(const u32x4*)(PROJ + (size_t)row * NPROJ + OFF_Z + F.lane * 8);
        float y[8] = {a0[0] * silu_f(bflo(zv.x)), a0[1] * silu_f(bfhi(zv.x)), a0[2] * silu_f(bflo(zv.y)), a0[3] * silu_f(bfhi(zv.y)),
                      a1[0] * silu_f(bflo(zv.z)), a1[1] * silu_f(bfhi(zv.z)), a1[2] * silu_f(bflo(zv.w)), a1[3] * silu_f(bfhi(zv.w))};
        float ss = 0.f;
#pragma unroll
        for (int k = 0; k < 8; ++k) ss += y[k] * y[k];
#pragma unroll
        for (int of = 1; of < 32; of <<= 1) ss += __shfl_xor(ss, of);
        const float rs = 1.0f / sqrtf(ss * (1.0f / 256.0f) + RMS_EPS);
        u32x4 w; w.x = pk2(y[0] * rs * nw0[0], y[1] * rs * nw0[1]); w.y = pk2(y[2] * rs * nw0[2], y[3] * rs * nw0[3]);
        w.z = pk2(y[4] * rs * nw1[0], y[5] * rs * nw1[1]); w.w = pk2(y[6] * rs * nw1[2], y[7] * rs * nw1[3]);
        *(u32x4*)(MIX + (size_t)row * D + 512 + F.lane * 8) = w;
    }
}

__device__ __forceinline__ void p_outproj(const Frame& F, int layer, bool last) {
    float* X = (float*)(F.ws + WS_X);
    pg8::Gemm g{(const bf16_t*)(F.ws + WS_MIX), (const bf16_t*)(F.ws + WS_WOUT) + (size_t)layer * D * D, D};
    pg8::DenseOrder S; S.init(last ? NLAT : NTOK, D, D, F.G, F.bid);
    pg8::EpiResid E{layer == 0 ? F.in[I_X] : X, layer == 0 ? F.in[I_CTX] : X + (size_t)NLAT * D, X, (const float*)(F.ws + WS_MOD) + (size_t)layer * 17 * MODW, 2 * D};
    pg8::gemm_phase<pg8::EpiResid, pg8::DenseOrder, true, true>(F.lds, g, S, E);
}

__device__ __forceinline__ unsigned* cnt_word(const Frame& F, int slot, int hf, int e) { return (unsigned*)(F.ws + WS_CTL) + CW_CNT + ((slot * 2 + hf) * 8 + e) * 64; }
__device__ __forceinline__ void p_ln1(const Frame& F, int layer, bool last) {
    float* X = (float*)(F.ws + WS_X); bf16_t* H = (bf16_t*)(F.ws + WS_H);
    const float* MOD = (const float*)(F.ws + WS_MOD) + (size_t)layer * 17 * MODW;
    const float* lg = F.in[I_LNG] + (size_t)(layer * 2) * D; const float* lb = F.in[I_LNB] + (size_t)(layer * 2) * D;
    const bool moe = layer & 1; const int slot = layer >> 1;
    const int nrows = last ? NLAT : NTOK, halfn = nrows / 2;
    float rw[16][8];
    if (moe) { const float* R = F.in[I_RW] + (size_t)slot * D * 8;
#pragma unroll
        for (int j = 0; j < 4; ++j)
#pragma unroll
            for (int k = 0; k < 4; ++k) { const f32x4 a = *(const f32x4*)(R + (size_t)(4 * F.lane + 256 * j + k) * 8), b2 = *(const f32x4*)(R + (size_t)(4 * F.lane + 256 * j + k) * 8 + 4);
                rw[j * 4 + k][0] = a[0]; rw[j * 4 + k][1] = a[1]; rw[j * 4 + k][2] = a[2]; rw[j * 4 + k][3] = a[3]; rw[j * 4 + k][4] = b2[0]; rw[j * 4 + k][5] = b2[1]; rw[j * 4 + k][6] = b2[2]; rw[j * 4 + k][7] = b2[3]; } }
    for (int row = F.gw; row < nrows; row += F.NGW) {
        f32x4 v[4], hv[4]; row_load(X + (size_t)row * D, F.lane, v);
        row_ln(v, lg, lb, F.lane);
        row_store(X + (size_t)row * D, F.lane, v);
        const float* m = MOD + (size_t)mod_row_of(row) * MODW;
        row_mod_store(H + (size_t)row * D, F.lane, v, m + 3 * D, m + 4 * D, hv);
        if (moe) {
            float lg8[8];
#pragma unroll
            for (int e = 0; e < 8; ++e) { float s = 0.f;
#pragma unroll
                for (int j = 0; j < 4; ++j)
#pragma unroll
                    for (int k = 0; k < 4; ++k) s += hv[j][k] * rw[j * 4 + k][e];
                lg8[e] = wave_sum(s); }
            int e0 = 0; float v0 = lg8[0];
#pragma unroll
            for (int e = 1; e < 8; ++e) if (lg8[e] > v0) { v0 = lg8[e]; e0 = e; }
            int e1 = -1; float v1 = -INFINITY;
#pragma unroll
            for (int e = 0; e < 8; ++e) if (e != e0 && lg8[e] > v1) { v1 = lg8[e]; e1 = e; }
            if (F.lane == 0) {
                const int hf = row < halfn ? 0 : 1;
                const unsigned s0 = atomicAdd(cnt_word(F, slot, hf, e0), 1u), s1 = atomicAdd(cnt_word(F, slot, hf, e1), 1u);
                int* list = (int*)(F.ws + WS_LIST);
                list[(hf * 8 + e0) * 18432 + s0] = row; list[(hf * 8 + e1) * 18432 + s1] = row;
                const float ex = __expf(v1 - v0), g0 = 1.0f / (1.0f + ex);
                u32x4 r; r.x = (unsigned)e0 | ((unsigned)e1 << 8); r.y = s0; r.z = s1; r.w = 0u;
                *(u32x4*)(F.ws + WS_ROUTE + (size_t)row * 16) = r;
                *(f32x2*)(F.ws + WS_GATES + (size_t)row * 8) = (f32x2){g0, ex * g0};
            }
        }
    }
}

__device__ __forceinline__ void p_ffn1_dense(const Frame& F, int layer, bool last) {
    const int s = layer >> 1;
    pg8::Gemm g{(const bf16_t*)(F.ws + WS_H), (const bf16_t*)(F.ws + WS_WFGU) + (size_t)s * 2 * DFF * D, D};
    pg8::DenseOrder S; S.init(last ? NLAT : NTOK, 2 * DFF, D, F.G, F.bid);
    pg8::EpiSwiGLU E{(bf16_t*)(F.ws + WS_HID), DFF};
    pg8::gemm_phase<pg8::EpiSwiGLU, pg8::DenseOrder, true, true>(F.lds, g, S, E);
}
__device__ __forceinline__ void p_ffn2_dense(const Frame& F, int layer, bool last) {
    const int s = layer >> 1; float* X = (float*)(F.ws + WS_X);
    pg8::Gemm g{(const bf16_t*)(F.ws + WS_HID), (const bf16_t*)(F.ws + WS_WFD) + (size_t)s * D * DFF, DFF};
    pg8::DenseOrder S; S.init(last ? NLAT : NTOK, D, DFF, F.G, F.bid);
    pg8::EpiResid E{X, X + (size_t)NLAT * D, X, (const float*)(F.ws + WS_MOD) + (size_t)layer * 17 * MODW, 5 * D};
    pg8::gemm_phase<pg8::EpiResid, pg8::DenseOrder, true, true>(F.lds, g, S, E);
}
__device__ __forceinline__ void moe_prefix(const Frame& F, int slot, int hf, int (&ts)[9], int (&cn)[8]) {
    int a = 0;
#pragma unroll
    for (int e = 0; e < 8; ++e) { cn[e] = (int)*cnt_word(F, slot, hf, e); ts[e] = a; a += (cn[e] + 255) >> 8; }
    ts[8] = a;
}
__device__ __forceinline__ void p_ffn1_moe(const Frame& F, int layer, int hf) {
    const int slot = layer >> 1; int cn[8];
    pg8::MoeOrder<true> S; moe_prefix(F, slot, hf, S.ts, cn);
    S.nM = S.ts[8]; S.nN = 2 * DFFE / 256; S.G = F.G; S.c = F.bid; S.K = D; S.estride = (long)2 * DFFE * D * 2; S.rowoff = (const LAS unsigned*)(F.lds + LDS_ROWOFF);
    {
        const int* list = (const int*)(F.ws + WS_LIST); LAS unsigned* ro = (LAS unsigned*)(F.lds + LDS_ROWOFF); pg8::Unit u;
        for (int i = 0; i < 18 && S.next(i, u); ++i) { const int e = S.expert_of(u.pm); int tse = 0, cne = 0;
#pragma unroll
            for (int j = 0; j < 8; ++j) { tse = (j == e) ? S.ts[j] : tse; cne = (j == e) ? cn[j] : cne; }
            for (int r = F.tid; r < 256; r += NT) { const int sl = (u.pm - tse) * 256 + r; const int tok = sl < cne ? list[(hf * 8 + e) * 18432 + sl] : 0; ro[i * 256 + r] = (unsigned)tok * (unsigned)(D * 2); } }
        __syncthreads();
    }
    pg8::Gemm g{(const bf16_t*)(F.ws + WS_H), (const bf16_t*)(F.ws + WS_WMGU), D};
    pg8::EpiSwiGLU E{(bf16_t*)(F.ws + WS_HID), DFFE};
    pg8::gemm_phase<pg8::EpiSwiGLU, pg8::MoeOrder<true>, true, true>(F.lds, g, S, E);
}
__device__ __forceinline__ void p_ffn2_moe(const Frame& F, int layer, int hf) {
    const int slot = layer >> 1; int cn[8];
    pg8::MoeOrder<false> S; moe_prefix(F, slot, hf, S.ts, cn);
    S.nM = S.ts[8]; S.nN = D / 256; S.G = F.G; S.c = F.bid; S.K = DFFE; S.estride = (long)D * DFFE * 2; S.rowoff = nullptr;
    pg8::Gemm g{(const bf16_t*)(F.ws + WS_HID), (const bf16_t*)(F.ws + WS_WMD), DFFE};
    pg8::EpiBf16 E{(bf16_t*)(F.ws + WS_YP) + (size_t)hf * HALF_PAD * D, D};
    pg8::gemm_phase<pg8::EpiBf16, pg8::MoeOrder<false>, true, true>(F.lds, g, S, E);
}

__device__ __forceinline__ void p_ln2(const Frame& F, int layer, bool last) {
    float* X = (float*)(F.ws + WS_X); bf16_t* H = (bf16_t*)(F.ws + WS_H);
    const float* MOD = (const float*)(F.ws + WS_MOD) + (size_t)layer * 17 * MODW;
    const float* lg = F.in[I_LNG] + (size_t)(layer * 2 + 1) * D; const float* lb = F.in[I_LNB] + (size_t)(layer * 2 + 1) * D;
    const bool moe = layer & 1; const int slot = layer >> 1;
    const int nrows = last ? NLAT : NTOK, halfn = nrows / 2;
    int ts0[9], ts1[9], cn[8];
    if (moe) { moe_prefix(F, slot, 0, ts0, cn); moe_prefix(F, slot, 1, ts1, cn); }
    const bf16_t* YP = (const bf16_t*)(F.ws + WS_YP);
    for (int row = F.gw; row < nrows; row += F.NGW) {
        f32x4 v[4], hv[4]; row_load(X + (size_t)row * D, F.lane, v);
        if (moe) {
            const int hf = row < halfn ? 0 : 1;
            const u32x4 r = *(const u32x4*)(F.ws + WS_ROUTE + (size_t)row * 16); const f32x2 gt = *(const f32x2*)(F.ws + WS_GATES + (size_t)row * 8);
            const int e0 = r.x & 255, e1 = (r.x >> 8) & 255;
            int t0 = 0, t1 = 0;
#pragma unroll
            for (int e = 0; e < 8; ++e) { const int tv = hf ? ts1[e] : ts0[e]; t0 = (e == e0) ? tv : t0; t1 = (e == e1) ? tv : t1; }
            const bf16_t* y0 = YP + ((size_t)hf * HALF_PAD + (size_t)t0 * 256 + r.y) * D; const bf16_t* y1 = YP + ((size_t)hf * HALF_PAD + (size_t)t1 * 256 + r.z) * D;
            const float* g2 = MOD + (size_t)mod_row_of(row) * MODW + 5 * D;
#pragma unroll
            for (int j = 0; j < 4; ++j) { const u32x2 a = *(const u32x2*)(y0 + 4 * F.lane + 256 * j), b2 = *(const u32x2*)(y1 + 4 * F.lane + 256 * j);
                const f32x4 gg = *(const f32x4*)(g2 + 4 * F.lane + 256 * j) + 1.0f;
                f32x4 f; f[0] = gt[0] * bflo(a.x) + gt[1] * bflo(b2.x); f[1] = gt[0] * bfhi(a.x) + gt[1] * bfhi(b2.x); f[2] = gt[0] * bflo(a.y) + gt[1] * bflo(b2.y); f[3] = gt[0] * bfhi(a.y) + gt[1] * bfhi(b2.y);
                v[j] = v[j] * ALPHA + gg * f; }
        }
        row_ln(v, lg, lb, F.lane);
        if (last) row_store(F.out + (size_t)row * D, F.lane, v);
        else { row_store(X + (size_t)row * D, F.lane, v);
            const float* m = MOD + (size_t)17 * MODW + (size_t)mod_row_of(row) * MODW;
            row_mod_store(H + (size_t)row * D, F.lane, v, m, m + D, hv); }
    }
}

constexpr int NPH = 2 + 10 * DEPTH;
#ifndef SITE_MASK
#define SITE_MASK 0xFFFF
#endif
#define SITE(n) (((SITE_MASK) >> (n)) & 1)
__global__ void __launch_bounds__(NT, 2) fwd_kernel(Args args) {
    extern __shared__ __attribute__((aligned(16))) unsigned char lds_raw[];
    Frame F;
    F.lds = (LAS unsigned char*)lds_raw; F.in = args.in; F.out = args.out; F.ws = args.ws;
    F.tid = threadIdx.x; F.lane = F.tid & 63; F.wave = __builtin_amdgcn_readfirstlane(F.tid >> 6); F.bid = blockIdx.x; F.G = gridDim.x;
    F.gw = F.bid * NWAVES + F.wave; F.NGW = F.G * NWAVES;
    volatile LAS unsigned* MISC = (volatile LAS unsigned*)(F.lds + LDS_MISC);
    if (F.tid < 64) MISC[F.tid] = 0u;
    __syncthreads();
    XcdBarrier bar; bar.bar = (unsigned*)(F.ws + WS_CTL) + CW_BAR; bar.x = 0; bar.st = MISC + 8;
#if MK_SINGLE
    bar = xcd_barrier_post((unsigned*)(F.ws + WS_CTL) + CW_BAR, MISC + 8);
#endif
    const int lo = args.ph_lo, hi = args.ph_hi;
#define IN(k) (lo <= (k) && (k) < hi)
#if MK_SINGLE
#define SEAM(k) do { if (IN(k) && IN((k) + 1)) { XcdBarrier b2_ = bar; int z_; asm volatile("s_mov_b32 %0, 0" : "=s"(z_)); b2_.bar = bar.bar + z_; xcd_barrier(b2_); } } while (0)
#else
#define SEAM(k) do { } while (0)
#endif
    if constexpr (SITE(0)) if (IN(0)) p_pro_a(fresh(F));
    SEAM(0);
    if constexpr (SITE(1)) if (IN(1)) p_pro_b(fresh(F));
    SEAM(1);
    for (int layer = 0; layer < DEPTH; ++layer) {
        const int pb = 2 + 10 * layer; const bool last = layer == DEPTH - 1; const bool moe = layer & 1;
        if constexpr (SITE(2)) if (IN(pb + 0)) p_inproj(fresh(F), layer);
        SEAM(pb + 0);
        if constexpr (SITE(3)) if (IN(pb + 1)) p_mixer(fresh(F), layer, last);
        SEAM(pb + 1);
        if constexpr (SITE(4)) if (IN(pb + 2)) { p_ssdcomb(fresh(F), layer, last); if (layer == 2) { int rot = 0; conv_moe(fresh(F), 1, rot); } }
        SEAM(pb + 2);
        if constexpr (SITE(5)) if (IN(pb + 3)) p_outproj(fresh(F), layer, last);
        SEAM(pb + 3);
        if constexpr (SITE(6)) if (IN(pb + 4)) p_ln1(fresh(F), layer, last);
        SEAM(pb + 4);
        if (moe) {
            if constexpr (SITE(7)) if (IN(pb + 5)) p_ffn1_moe(fresh(F), layer, 0);
            SEAM(pb + 5);
            if constexpr (SITE(8)) if (IN(pb + 6)) p_ffn2_moe(fresh(F), layer, 0);
            SEAM(pb + 6);
            if constexpr (SITE(7)) if (IN(pb + 7)) p_ffn1_moe(fresh(F), layer, 1);
            SEAM(pb + 7);
            if constexpr (SITE(8)) if (IN(pb + 8)) p_ffn2_moe(fresh(F), layer, 1);
            SEAM(pb + 8);
        } else {
            if constexpr (SITE(9)) if (IN(pb + 5)) p_ffn1_dense(fresh(F), layer, last);
            SEAM(pb + 5);
            if constexpr (SITE(10)) if (IN(pb + 6)) p_ffn2_dense(fresh(F), layer, last);
            SEAM(pb + 6);
            SEAM(pb + 7);
            SEAM(pb + 8);
        }
        if constexpr (SITE(11)) if (IN(pb + 9)) p_ln2(fresh(F), layer, last);
        if (!last) SEAM(pb + 9);
    }
#undef IN
#undef SEAM
}

extern "C" void kernel_launch(void* const* d_in, const int* in_sizes, int n_in, void* d_out, int out_size, void* d_ws, size_t ws_size, hipStream_t stream) {
    static int grid = 0;
    if (grid == 0) {
        if (n_in != 24 || out_size != NLAT * D || ws_size < WS_END) { fprintf(stderr, "kernel_launch: unexpected shapes (n_in %d, out %d, ws %zu < %zu)\n", n_in, out_size, ws_size, (size_t)WS_END); grid = -1; return; }
        int dev = 0, cus = 0, per_cu = 0;
        if (hipGetDevice(&dev) != hipSuccess || hipDeviceGetAttribute(&cus, hipDeviceAttributeMultiprocessorCount, dev) != hipSuccess) { grid = -1; return; }
        if (hipFuncSetAttribute((const void*)fwd_kernel, hipFuncAttributeMaxDynamicSharedMemorySize, LDS_BYTES) != hipSuccess) { fprintf(stderr, "kernel_launch: hipFuncSetAttribute failed\n"); grid = -1; return; }
        if (hipOccupancyMaxActiveBlocksPerMultiprocessor(&per_cu, (const void*)fwd_kernel, NT, LDS_BYTES) != hipSuccess || per_cu < 1) { fprintf(stderr, "kernel_launch: occupancy query says %d\n", per_cu); }
        (void)hipGetLastError();
        grid = cus;
    }
    if (grid < 0) return;
    (void)in_sizes;
    if (hipMemsetAsync((char*)d_ws + WS_CTL, 0, CTL_BYTES, stream) != hipSuccess) return;
    Args a{};
    for (int i = 0; i < 24; ++i) a.in[i] = (const float*)d_in[i];
    a.out = (float*)d_out; a.ws = (unsigned char*)d_ws;
#if MK_SINGLE
    a.ph_lo = 0; a.ph_hi = NPH;
    hipLaunchKernelGGL(fwd_kernel, dim3(grid), dim3(NT), LDS_BYTES, stream, a);
#else
    for (int ph = 0; ph < NPH; ++ph) {
        if (ph >= 2) { const int layer = (ph - 2) / 10, j = (ph - 2) % 10; const bool moe = layer & 1; if (!moe && (j == 7 || j == 8)) continue; }
        a.ph_lo = ph; a.ph_hi = ph + 1;
        hipLaunchKernelGGL(fwd_kernel, dim3(grid), dim3(NT), LDS_BYTES, stream, a);
    }
#endif
}
```

```cpp
#include <hip/hip_runtime.h>
#include <cstdio>
#include <cstdint>

#ifndef MK_SINGLE
#define MK_SINGLE 1
#endif

#ifndef REP_SSD
#define REP_SSD 1
#endif
#ifndef REP_NA
#define REP_NA 1
#endif
#ifndef REP_GEMM
#define REP_GEMM 1
#endif
#define GAS __attribute__((address_space(1)))
#define LAS __attribute__((address_space(3)))
typedef unsigned short bf16_t;
typedef short bf16x8 __attribute__((ext_vector_type(8)));
typedef float f32x4 __attribute__((ext_vector_type(4)));
typedef float f32x2 __attribute__((ext_vector_type(2)));
typedef unsigned u32x4 __attribute__((ext_vector_type(4)));
typedef unsigned u32x2 __attribute__((ext_vector_type(2)));

constexpr int D = 1024, BATCH = 16, SEQ = 2048, DEPTH = 4, GRID_W = 64, CTX = 256;
constexpr int NLAT = BATCH * SEQ;
constexpr int NCTX = BATCH * CTX;
constexpr int NTOK = NLAT + NCTX;
constexpr int NPROJ = 3072;
constexpr int OFF_K = 512, OFF_V = 1024, OFF_Z = 1536, OFF_XBC = 2048;
constexpr int D_IN_PROJ = 3088;
constexpr int DFF = 2816, DFFE = 3584, NEXP = 8;
constexpr float ALPHA = 1.6817928305074290f;
constexpr float LN_EPS = 1e-5f, RMS_EPS = 1e-5f;
constexpr int MODW = 6 * D;

constexpr size_t MiB = 1u << 20;
constexpr size_t WS_CTL = 0, CTL_BYTES = 1 * MiB;
constexpr size_t WS_MOD = 1 * MiB;
constexpr size_t WS_ROUTE = 3 * MiB;
constexpr size_t WS_GATES = 4 * MiB;
constexpr size_t WS_LIST = 5 * MiB;
constexpr size_t WS_WDT = 7 * MiB;
constexpr size_t WS_WIN = 8 * MiB;
constexpr size_t WS_WOUT = 32 * MiB;
constexpr size_t WS_WFGU = 40 * MiB;
constexpr size_t WS_WFD = 62 * MiB;
constexpr size_t WS_WMGU = 73 * MiB;
constexpr size_t WS_WMD = 185 * MiB;
constexpr size_t WS_X = 241 * MiB;
constexpr size_t WS_H = 385 * MiB;
constexpr size_t WS_R = 457 * MiB;
constexpr size_t WS_PROJ = WS_R;
constexpr size_t WS_DT = WS_R + 216 * MiB;
constexpr size_t WS_YF = WS_R + 219 * MiB;
constexpr size_t WS_YB = WS_R + 291 * MiB;
constexpr size_t WS_MIX = WS_R + 363 * MiB;
constexpr size_t WS_HID = WS_R;
constexpr size_t WS_YP = WS_R + 270 * MiB;
constexpr size_t WS_END = WS_R + 435 * MiB;
constexpr int HALF_PAD = 2 * 18432 + 2048;
static_assert(WS_HID + (size_t)HALF_PAD * 3584 * 2 <= WS_YP && WS_YP + (size_t)2 * HALF_PAD * 1024 * 2 <= WS_END, "MoE buffers");

constexpr int CW_TMO = 0;
constexpr int CW_BAR = 4096;
constexpr int CW_CNT = 16384;

constexpr int LDS_STAGE = 131072;
constexpr int LDS_ROWOFF = 131072;
constexpr int LDS_MISC = 131072 + 18432;
constexpr int LDS_BYTES = 155648;

__device__ __forceinline__ unsigned f2bf(float f) { unsigned u = __builtin_bit_cast(unsigned, f); return (u + 0x7fffu + ((u >> 16) & 1u)) >> 16; }
__device__ __forceinline__ unsigned pk2(float lo, float hi) { return f2bf(lo) | (f2bf(hi) << 16); }
__device__ __forceinline__ float bf2f(unsigned short b) { return __builtin_bit_cast(float, ((unsigned)b) << 16); }
__device__ __forceinline__ float bflo(unsigned w) { return __builtin_bit_cast(float, w << 16); }
__device__ __forceinline__ float bfhi(unsigned w) { return __builtin_bit_cast(float, w & 0xffff0000u); }
__device__ __forceinline__ float silu_f(float v) { return v / (1.0f + __expf(-v)); }
__device__ __forceinline__ float wave_sum(float v) {
#pragma unroll
    for (int o = 1; o < 64; o <<= 1) v += __shfl_xor(v, o);
    return v;
}

namespace pg8 {
constexpr int BM = 256, BK = 64, HALF = 128, HTB = HALF * BK * 2, STAGE_BYTES = 8 * HTB, NXCD = 8, WGM = 8;
__host__ __device__ __forceinline__ int lds_byte(int r, int c) { const int st = (r >> 4) * 2 + (c >> 5), rr = r & 15, cc = c & 31, ob = rr * 64 + cc * 2; return st * 1024 + (ob ^ (((ob >> 9) & 1) << 5)); }
__host__ __device__ __forceinline__ void stage_rc(int b, int& R, int& C) { const int st = b / 1024, sb = b % 1024, swz = sb ^ (((sb >> 9) & 1) << 5); R = (st >> 1) * 16 + swz / 64; C = (st & 1) * 32 + (swz % 64) / 2; }
__host__ __device__ __forceinline__ int perm32(int rho) { const int n = rho >> 4, i = rho & 15; return 8 * (i >> 2) + 4 * n + (i & 3); }

struct Unit { int pm, pn; long bofs; };
struct Gemm { const bf16_t* A; const bf16_t* Bt; int K; };

__device__ __forceinline__ unsigned cvt_pk_bf16(float lo, float hi) { unsigned r; asm volatile("v_cvt_pk_bf16_f32 %0, %1, %2" : "=v"(r) : "v"(lo), "v"(hi)); return r; }

__device__ __forceinline__ bool static_tile(int i, int G, int c, int nM, int nN, int& pm, int& pn) {
    const int nwg = nM * nN; const long L = (long)i * G + c; if (L >= nwg) return false;
    int wgid = (int)L; { const int q = nwg / NXCD, r = nwg % NXCD, xcd = wgid % NXCD, off = wgid / NXCD; wgid = (xcd < r ? xcd * (q + 1) : r * (q + 1) + (xcd - r) * q) + off; }
    const int nig = WGM * nN, gid = wgid / nig, fm = gid * WGM, gsz = (nM - fm) < WGM ? (nM - fm) : WGM;
    pm = fm + ((wgid % nig) % gsz); pn = (wgid % nig) / gsz; return true;
}
struct DenseOrder {
    int nM, nN, G, c, K;
    __device__ __forceinline__ void init(int M, int N, int K_, int G_, int c_) { nM = M / BM; nN = N / BM; G = G_; c = c_; K = K_; }
    __device__ __forceinline__ bool next(int i, Unit& u) const { if (!static_tile(i, G, c, nM, nN, u.pm, u.pn)) return false; u.bofs = (long)u.pn * BM * K * 2; return true; }
    static constexpr bool GATHER = false;
    __device__ __forceinline__ long a_base(const Unit& u) const { return (long)u.pm * BM * K * 2; }
    __device__ __forceinline__ void a_offs(int, const Unit&, int, unsigned (&)[2][2]) const {}
};
template <bool GATHER_> struct MoeOrder {
    int nM, nN, G, c, K; int ts[9]; long estride; const LAS unsigned* rowoff;
    __device__ __forceinline__ int expert_of(int pm) const { int e = 0;
#pragma unroll
        for (int j = 1; j < 8; ++j) e += (pm >= ts[j]) ? 1 : 0; return e; }
    __device__ __forceinline__ bool next(int i, Unit& u) const { if (!static_tile(i, G, c, nM, nN, u.pm, u.pn)) return false; u.bofs = (long)expert_of(u.pm) * estride + (long)u.pn * BM * K * 2; return true; }
    static constexpr bool GATHER = GATHER_;
    __device__ __forceinline__ long a_base(const Unit& u) const { return GATHER_ ? 0l : (long)u.pm * BM * K * 2; }
    __device__ __forceinline__ void a_offs(int ui, const Unit&, int tid, unsigned (&o)[2][2]) const {
        if (GATHER_) {
#pragma unroll
            for (int i = 0; i < 2; ++i) { int R, C; stage_rc(tid * 16 + i * 8192, R, C);
#pragma unroll
                for (int h = 0; h < 2; ++h) o[h][i] = rowoff[ui * 256 + h * HALF + R] + (unsigned)(C * 2); }
        }
    }
};

struct EpiBf16 {
    static constexpr bool PERM = true;
    bf16_t* O; int ldc;
    __device__ __forceinline__ void operator()(const f32x4 (&acc)[2][2][4][2], const Unit& u, int wr, int wc, int fr, int fq) const {
        const int row0 = u.pm * BM + wr * 64 + fr; const int col0 = u.pn * BM + wc * 32 + 8 * fq;
#pragma unroll
        for (int ai = 0; ai < 2; ++ai)
#pragma unroll
            for (int m = 0; m < 4; ++m) { bf16_t* rowp = O + (size_t)(row0 + ai * HALF + m * 16) * ldc + col0;
#pragma unroll
                for (int bj = 0; bj < 2; ++bj) { const f32x4 v0 = acc[ai][bj][m][0], v1 = acc[ai][bj][m][1];
                    u32x4 w; w.x = cvt_pk_bf16(v0[0], v0[1]); w.y = cvt_pk_bf16(v0[2], v0[3]); w.z = cvt_pk_bf16(v1[0], v1[1]); w.w = cvt_pk_bf16(v1[2], v1[3]);
                    *(u32x4*)(rowp + bj * HALF) = w; } }
    }
};
struct EpiSwiGLU {
    static constexpr bool PERM = true;
    bf16_t* O; int ldc;
    __device__ __forceinline__ void operator()(const f32x4 (&acc)[2][2][4][2], const Unit& u, int wr, int wc, int fr, int fq) const {
        const int row0 = u.pm * BM + wr * 64 + fr; const int col0 = u.pn * HALF + wc * 32 + 8 * fq;
#pragma unroll
        for (int ai = 0; ai < 2; ++ai)
#pragma unroll
            for (int m = 0; m < 4; ++m) { bf16_t* rowp = O + (size_t)(row0 + ai * HALF + m * 16) * ldc + col0;
                float h[8];
#pragma unroll
                for (int n = 0; n < 2; ++n)
#pragma unroll
                    for (int j = 0; j < 4; ++j) { const float g = acc[ai][0][m][n][j], up = acc[ai][1][m][n][j]; h[n * 4 + j] = g * __builtin_amdgcn_rcpf(1.0f + __expf(-g)) * up; }
                u32x4 w; w.x = cvt_pk_bf16(h[0], h[1]); w.y = cvt_pk_bf16(h[2], h[3]); w.z = cvt_pk_bf16(h[4], h[5]); w.w = cvt_pk_bf16(h[6], h[7]);
                *(u32x4*)rowp = w; }
    }
};
struct EpiResid {
    static constexpr bool PERM = false;
    const float* base_lat; const float* base_ctx; float* out; const float* mod; int gate_off;
    __device__ __forceinline__ void operator()(const f32x4 (&acc)[2][2][4][2], const Unit& u, int wr, int wc, int fr, int fq) const {
        const int rt = u.pm * BM; const bool isctx = rt >= NLAT; const int bi = isctx ? 16 : (rt >> 11);
        const float* base = isctx ? base_ctx + (size_t)(rt - NLAT) * D : base_lat + (size_t)rt * D;
        float* o = out + (size_t)rt * D; const float* gt = mod + bi * MODW + gate_off;
        const int r0 = wr * 64 + fr, col0 = u.pn * BM + wc * 32 + 4 * fq;
        f32x4 gv[2][2];
#pragma unroll
        for (int bj = 0; bj < 2; ++bj)
#pragma unroll
            for (int n = 0; n < 2; ++n) gv[bj][n] = *(const f32x4*)(gt + col0 + bj * HALF + n * 16) + 1.0f;
#pragma unroll
        for (int ai = 0; ai < 2; ++ai)
#pragma unroll
            for (int m = 0; m < 4; ++m) { const size_t off = (size_t)(r0 + ai * HALF + m * 16) * D + col0;
#pragma unroll
                for (int bj = 0; bj < 2; ++bj)
#pragma unroll
                    for (int n = 0; n < 2; ++n) { const f32x4 bs = *(const f32x4*)(base + off + bj * HALF + n * 16);
                        *(f32x4*)(o + off + bj * HALF + n * 16) = bs * ALPHA + gv[bj][n] * acc[ai][bj][m][n]; }
                if (m & 1) asm volatile("" ::: "memory"); }
    }
};

template <class Epi, class Sched, bool ALIGN_EPI, bool SP2>
__device__ __forceinline__ void gemm_phase(LAS unsigned char* lds, const Gemm g, const Sched& S, const Epi& E) {
    int tid_ = threadIdx.x; asm volatile("" : "+v"(tid_));
    const int tid = tid_, wid = __builtin_amdgcn_readfirstlane(tid >> 6), lane = tid & 63, wr = wid >> 2, wc = wid & 3, fr = lane & 15, fq = lane >> 4;
    const int K = g.K, nt = K / BK;
    constexpr bool GA = Sched::GATHER;
    unsigned voffA[2], voffB[2];
#pragma unroll
    for (int i = 0; i < 2; ++i) { int R, C; stage_rc(tid * 16 + i * 8192, R, C); const int Rb = Epi::PERM ? ((R & ~31) + perm32(R & 31)) : R;
        voffA[i] = (unsigned)(R * K + C) * 2u; voffB[i] = (unsigned)(Rb * K + C) * 2u; }
    const size_t kstep = (size_t)(BK * 2);
    const size_t hstep = (size_t)HALF * K * 2;
    const unsigned ldsw = (unsigned)wid * 1024u;
    const int aoff = lds_byte(wr * 64 + fr, fq * 8), boff = lds_byte(wc * 32 + fr, fq * 8);
#define PG8_SA(b, h) (((b) * 2 + (h)) * HTB)
#define PG8_SB(b, h) ((4 + (b) * 2 + (h)) * HTB)
#define PG8_STAGE(bufoff, gbase, voff) do { _Pragma("unroll") for (int _i = 0; _i < 2; ++_i) \
        __builtin_amdgcn_global_load_lds((const unsigned*)((const char*)(gbase) + (voff)[_i]), (LAS unsigned*)(lds + (bufoff) + ldsw + _i * 8192), 16, 0, 0); } while (0)
#define PG8_LDA(dst, b, h) do { _Pragma("unroll") for (int m = 0; m < 4; ++m) _Pragma("unroll") for (int k = 0; k < 2; ++k) dst[m][k] = *(const LAS bf16x8*)(lds + PG8_SA(b, h) + aoff + m * 2048 + k * 1024); } while (0)
#define PG8_LDB(dst, b, h) do { _Pragma("unroll") for (int n = 0; n < 2; ++n) _Pragma("unroll") for (int k = 0; k < 2; ++k) dst[n][k] = *(const LAS bf16x8*)(lds + PG8_SB(b, h) + boff + n * 2048 + k * 1024); } while (0)
#define PG8_MMA(ai, bj, At, Bt) do { __builtin_amdgcn_s_setprio(1); _Pragma("unroll") for (int m = 0; m < 4; ++m) _Pragma("unroll") for (int n = 0; n < 2; ++n) _Pragma("unroll") for (int k = 0; k < 2; ++k) \
        acc[ai][bj][m][n] = __builtin_amdgcn_mfma_f32_16x16x32_bf16(Bt[n][k], At[m][k], acc[ai][bj][m][n], 0, 0, 0); __builtin_amdgcn_s_setprio(0); } while (0)
#define PG8_WAIT_V(n) asm volatile("s_waitcnt vmcnt(" #n ")" ::: "memory")
#define PG8_WAIT_L(n) asm volatile("s_waitcnt lgkmcnt(" #n ")" ::: "memory")
#define PG8_BAR __builtin_amdgcn_s_barrier()
#define PG8_SCHED __builtin_amdgcn_sched_barrier(0)
    Unit cur, nxt; int ui = 0;
    if (!S.next(0, cur)) return;
    f32x4 acc[2][2][4][2];
#pragma unroll
    for (int a = 0; a < 2; ++a)
#pragma unroll
        for (int b = 0; b < 2; ++b)
#pragma unroll
            for (int m = 0; m < 4; ++m)
#pragma unroll
                for (int n = 0; n < 2; ++n) acc[a][b][m][n] = (f32x4){0.f, 0.f, 0.f, 0.f};
    bf16x8 At[4][2], B0[2][2], B1[2][2];
    const char* Ab = (const char*)g.A + S.a_base(cur);
    unsigned oc[2][2];
    S.a_offs(0, cur, tid, oc);
    const size_t hsA = GA ? (size_t)0 : hstep;
#define PG8_STAGE_A(bufoff, gbase, h) do { if constexpr (GA) PG8_STAGE(bufoff, gbase, oc[h]); else PG8_STAGE(bufoff, (gbase) + (h) * hsA, voffA); } while (0)
    const char* cB = (const char*)g.Bt + cur.bofs;
    if constexpr (SP2) {
        PG8_STAGE(PG8_SB(0, 0), cB, voffB); PG8_STAGE(PG8_SB(0, 1), cB + hstep, voffB); PG8_STAGE_A(PG8_SA(0, 0), Ab, 0); PG8_STAGE_A(PG8_SA(0, 1), Ab, 1);
        if (wr == 1) PG8_BAR;
        PG8_WAIT_V(2); PG8_BAR;
        PG8_STAGE(PG8_SB(1, 0), cB + kstep, voffB); PG8_STAGE_A(PG8_SA(1, 0), Ab + kstep, 0); PG8_STAGE(PG8_SB(1, 1), cB + hstep + kstep, voffB);
        PG8_WAIT_V(6); PG8_BAR;
    } else {
        PG8_STAGE(PG8_SB(0, 0), cB, voffB); PG8_STAGE_A(PG8_SA(0, 0), Ab, 0); PG8_STAGE(PG8_SB(0, 1), cB + hstep, voffB); PG8_STAGE_A(PG8_SA(0, 1), Ab, 1);
        if (wr == 1) PG8_BAR;
        PG8_WAIT_V(4); PG8_BAR;
        PG8_STAGE(PG8_SB(1, 0), cB + kstep, voffB); PG8_STAGE_A(PG8_SA(1, 0), Ab + kstep, 0); PG8_STAGE(PG8_SB(1, 1), cB + hstep + kstep, voffB);
        PG8_WAIT_V(6); PG8_BAR;
    }
    for (;;) {
        const bool has_next = S.next(ui + 1, nxt);
        const char* nB = has_next ? (const char*)g.Bt + nxt.bofs : cB;
        for (int t = 0; t < nt; t += 2) {
            const bool last = (t == nt - 2);
            const char* a1 = Ab + (size_t)(t + 1) * kstep;
            const char* b2 = last ? nB : cB + (size_t)(t + 2) * kstep; const char* b3 = b2 + kstep;
            if constexpr (SP2) {
            PG8_LDB(B0, 0, 0); PG8_LDB(B1, 0, 1); PG8_SCHED; PG8_LDA(At, 0, 0); PG8_STAGE_A(PG8_SA(1, 1), a1, 1);
            if (last && has_next) { S.a_offs(ui + 1, nxt, tid, oc); Ab = (const char*)g.A + S.a_base(nxt); }
            const char* a2 = last ? Ab : Ab + (size_t)(t + 2) * kstep; const char* a3 = a2 + kstep;
            PG8_WAIT_V(8); PG8_WAIT_L(0); PG8_BAR; PG8_MMA(0, 0, At, B0); PG8_MMA(0, 1, At, B1); PG8_BAR; PG8_SCHED;
            PG8_LDA(At, 0, 1); PG8_STAGE(PG8_SB(0, 0), b2, voffB); PG8_STAGE(PG8_SB(0, 1), b2 + hstep, voffB); PG8_STAGE_A(PG8_SA(0, 0), a2, 0);
            PG8_WAIT_V(8); PG8_WAIT_L(0); PG8_BAR; PG8_MMA(1, 0, At, B0); PG8_MMA(1, 1, At, B1); PG8_BAR; PG8_SCHED;
            PG8_LDB(B0, 1, 0); PG8_LDB(B1, 1, 1); PG8_SCHED; PG8_LDA(At, 1, 0); PG8_STAGE_A(PG8_SA(0, 1), a2, 1);
            PG8_WAIT_V(8); PG8_WAIT_L(0); PG8_BAR; PG8_MMA(0, 0, At, B0); PG8_MMA(0, 1, At, B1); PG8_BAR; PG8_SCHED;
            PG8_LDA(At, 1, 1); PG8_STAGE(PG8_SB(1, 0), b3, voffB); PG8_STAGE(PG8_SB(1, 1), b3 + hstep, voffB); PG8_STAGE_A(PG8_SA(1, 0), a3, 0);
            PG8_WAIT_V(8); PG8_WAIT_L(0); PG8_BAR; PG8_MMA(1, 0, At, B0); PG8_MMA(1, 1, At, B1); PG8_BAR; PG8_SCHED;
            } else {
            PG8_LDB(B0, 0, 0); PG8_SCHED; PG8_LDA(At, 0, 0); PG8_STAGE_A(PG8_SA(1, 1), a1, 1);
            if (last && has_next) { S.a_offs(ui + 1, nxt, tid, oc); Ab = (const char*)g.A + S.a_base(nxt); }
            const char* a2 = last ? Ab : Ab + (size_t)(t + 2) * kstep; const char* a3 = a2 + kstep;
            PG8_WAIT_L(8); PG8_BAR; PG8_WAIT_L(0); PG8_MMA(0, 0, At, B0); PG8_BAR; PG8_SCHED;
            PG8_LDB(B1, 0, 1); PG8_STAGE(PG8_SB(0, 0), b2, voffB);
            PG8_BAR; PG8_WAIT_L(0); PG8_MMA(0, 1, At, B1); PG8_BAR;
            PG8_LDA(At, 0, 1); PG8_STAGE_A(PG8_SA(0, 0), a2, 0);
            PG8_BAR; PG8_WAIT_L(0); PG8_MMA(1, 0, At, B0); PG8_BAR; PG8_SCHED;
            PG8_STAGE(PG8_SB(0, 1), b2 + hstep, voffB);
            PG8_WAIT_V(6); PG8_BAR; PG8_MMA(1, 1, At, B1); PG8_BAR;
            PG8_LDB(B0, 1, 0); PG8_SCHED; PG8_LDA(At, 1, 0); PG8_STAGE_A(PG8_SA(0, 1), a2, 1);
            PG8_WAIT_L(8); PG8_BAR; PG8_WAIT_L(0); PG8_MMA(0, 0, At, B0); PG8_BAR; PG8_SCHED;
            PG8_LDB(B1, 1, 1); PG8_STAGE(PG8_SB(1, 0), b3, voffB);
            PG8_BAR; PG8_WAIT_L(0); PG8_MMA(0, 1, At, B1); PG8_BAR;
            PG8_LDA(At, 1, 1); PG8_STAGE_A(PG8_SA(1, 0), a3, 0);
            PG8_BAR; PG8_WAIT_L(0); PG8_MMA(1, 0, At, B0); PG8_BAR; PG8_SCHED;
            PG8_STAGE(PG8_SB(1, 1), b3 + hstep, voffB);
            PG8_WAIT_V(6); PG8_BAR; PG8_MMA(1, 1, At, B1); PG8_BAR;
            }
        }
        if constexpr (ALIGN_EPI) { if (wr == 0) PG8_BAR; }
        E(acc, cur, wr, wc, fr, fq);
        if (!has_next) break;
#pragma unroll
        for (int a = 0; a < 2; ++a)
#pragma unroll
            for (int b = 0; b < 2; ++b)
#pragma unroll
                for (int m = 0; m < 4; ++m)
#pragma unroll
                    for (int n = 0; n < 2; ++n) acc[a][b][m][n] = (f32x4){0.f, 0.f, 0.f, 0.f};
        cur = nxt; cB = nB; ++ui;
        if constexpr (ALIGN_EPI) { if (wr == 1) PG8_BAR; }
    }
    PG8_WAIT_V(0);
    if constexpr (!ALIGN_EPI) { if (wr == 0) PG8_BAR; }
    PG8_BAR;
#undef PG8_SA
#undef PG8_SB
#undef PG8_STAGE
#undef PG8_STAGE_A
#undef PG8_LDA
#undef PG8_LDB
#undef PG8_MMA
#undef PG8_WAIT_V
#undef PG8_WAIT_L
#undef PG8_BAR
#undef PG8_SCHED
}
}

#define XB_TMO      128
#define XB_XCNT(j)  (256  + 64 * (j))
#define XB_XSUB(j)  (1280 + 64 * (j))
#define XB_XGEN(j)  (2304 + 64 * (j))
#define XB_TOP      3328
#define XB_TOPGEN   3392
#define XCD_BAR_WORDS 3456
#define XB_SPIN_CAP (1u << 18)
__device__ __forceinline__ unsigned xb_ld(unsigned* p)              { return __hip_atomic_load(p, __ATOMIC_RELAXED, __HIP_MEMORY_SCOPE_AGENT); }
__device__ __forceinline__ unsigned xb_add(unsigned* p, unsigned v) { return __hip_atomic_fetch_add(p, v, __ATOMIC_RELAXED, __HIP_MEMORY_SCOPE_AGENT); }
__device__ __forceinline__ unsigned xb_xcc_id() { return (unsigned)__builtin_amdgcn_s_getreg((3 << 11) | 20) & 0xFu; }
#define XB_SPIN(cond, bar) do { unsigned _sp = 0; while (cond) { __builtin_amdgcn_s_sleep(1); \
    if ((++_sp & 255u) == 0u) { if (xb_ld(&(bar)[XB_TMO])) break; if (_sp > XB_SPIN_CAP) { atomicAdd(&(bar)[XB_TMO], 1u); break; } } } } while (0)
struct XcdBarrier { unsigned* bar; unsigned x; volatile LAS unsigned* st; };
__device__ __forceinline__ XcdBarrier xcd_barrier_post(unsigned* bar, volatile LAS unsigned* st) {
    XcdBarrier b; b.bar = bar; b.x = xb_xcc_id(); b.st = st;
    if (threadIdx.x == 0) (void)xb_add(&bar[XB_XCNT(b.x)], 1u);
    return b;
}
__device__ __forceinline__ void xcd_barrier_complete(unsigned* bar, unsigned x, unsigned& nloc, unsigned& nx) {
    const unsigned G = gridDim.x * gridDim.y * gridDim.z;
    unsigned sum, cnt, mine, sp = 0u;
    for (;;) {
        sum = 0u; cnt = 0u; mine = 0u;
#pragma unroll
        for (unsigned j = 0; j < 16; ++j) { const unsigned c = xb_ld(&bar[XB_XCNT(j)]); sum += c; cnt += (c > 0u) ? 1u : 0u; mine = (j == x) ? c : mine; }
        if (sum == G) break;
        __builtin_amdgcn_s_sleep(1);
        if ((++sp & 255u) == 0u) { if (xb_ld(&bar[XB_TMO])) break; if (sp > XB_SPIN_CAP) { atomicAdd(&bar[XB_TMO], 1u); break; } }
    }
    nloc = mine > 0u ? mine : 1u; nx = cnt > 0u ? cnt : 1u;
}
__device__ __forceinline__ void xcd_barrier(const XcdBarrier& b) {
    asm volatile("s_waitcnt vmcnt(0)" ::: "memory");
    __syncthreads();
    if (threadIdx.x == 0) {
        unsigned* bar = b.bar;
        __builtin_amdgcn_s_waitcnt(0);
        unsigned nloc = b.st[0], nx = b.st[1];
        if (nloc == 0u) { xcd_barrier_complete(bar, b.x, nloc, nx); b.st[0] = nloc; b.st[1] = nx; }
        const unsigned old = xb_add(&bar[XB_XSUB(b.x)], 1u);
        const unsigned gen = old / nloc;
        if (old + 1u == (gen + 1u) * nloc) {
            __builtin_amdgcn_fence(__ATOMIC_RELEASE, "agent");
            asm volatile("s_waitcnt vmcnt(0)" ::: "memory");
            const unsigned og = xb_add(&bar[XB_TOP], 1u);
            const unsigned tg = og / nx;
            if (og + 1u == (tg + 1u) * nx) xb_add(&bar[XB_TOPGEN], 1u);
            else XB_SPIN(xb_ld(&bar[XB_TOPGEN]) == tg, bar);
            __builtin_amdgcn_fence(__ATOMIC_ACQUIRE, "agent");
            xb_add(&bar[XB_XGEN(b.x)], 1u);
            asm volatile("s_waitcnt vmcnt(0)" ::: "memory");
        } else {
            XB_SPIN(xb_ld(&bar[XB_XGEN(b.x)]) == gen, bar);
            __builtin_amdgcn_fence(__ATOMIC_ACQUIRE, "agent");
            asm volatile("s_waitcnt vmcnt(0)" ::: "memory");
        }
    }
    __syncthreads();
}

constexpr int NT = 512, NWAVES = 8;
struct Args { const float* in[24]; float* out; unsigned char* ws; int ph_lo, ph_hi; };
enum { I_X = 0, I_C, I_CTX, I_CCTX, I_WMOD, I_BMOD, I_WIN, I_WOUT, I_RPB, I_CONVW, I_CONVB, I_DTB, I_ALOG, I_DSKIP, I_NORMW, I_LNG, I_LNB, I_FG, I_FU, I_FD, I_RW, I_MG, I_MU, I_MD };
struct Frame {
    LAS unsigned char* lds;
    const float* const* in; float* out; unsigned char* ws;
    int tid, lane, wave, bid, G, gw, NGW;
};
#define LDS_WAIT() asm volatile("s_waitcnt lgkmcnt(0)" ::: "memory")
__device__ __forceinline__ Frame fresh(const Frame& F0) {
    Frame F = F0; int z; asm volatile("s_mov_b32 %0, 0" : "=s"(z)); F.ws = F0.ws + z; F.in = F0.in + z; F.out = F0.out + z;
    int t = F0.tid; asm volatile("" : "+v"(t)); F.tid = t; F.lane = t & 63; return F;
}

__device__ __forceinline__ void conv_item(const float* W, int ldn, int k0, int n0, bf16_t* dst, int K, int drow0, LAS float* scr, int lane) {
#pragma unroll 8
    for (int i = 0; i < 32; ++i) { const int kk = 2 * i + (lane >> 5); scr[kk * 33 + (lane & 31)] = W[(size_t)(k0 + kk) * ldn + n0 + (lane & 31)]; }
    LDS_WAIT(); asm volatile("" ::: "memory");
    const int c = lane & 7;
#pragma unroll
    for (int j = 0; j < 4; ++j) { const int n = (lane >> 3) + 8 * j; const LAS float* s = scr + (8 * c) * 33 + n;
        u32x4 o; o.x = pk2(s[0 * 33], s[1 * 33]); o.y = pk2(s[2 * 33], s[3 * 33]); o.z = pk2(s[4 * 33], s[5 * 33]); o.w = pk2(s[6 * 33], s[7 * 33]);
        *(u32x4*)(dst + (size_t)(drow0 + n) * K + k0 + 8 * c) = o; }
    LDS_WAIT(); asm volatile("" ::: "memory");
}
__device__ __forceinline__ void conv_seg(const Frame& F, const float* W, int K, int ldn, int ncols, bf16_t* dst, int mode, int& rot) {
    LAS float* scr = (LAS float*)(F.lds + F.wave * 16384);
    const int nblk = ncols / 32, nitems = (K / 64) * nblk;
    int start = F.gw - rot; if (start < 0) start += F.NGW;
    for (int it = start; it < nitems; it += F.NGW) {
        const int kb = it / nblk, nb = it % nblk, n0 = nb * 32;
        const int drow0 = (mode == 0) ? n0 : ((n0 >> 7) * 256 + (n0 & 127) + (mode == 2 ? 128 : 0));
        conv_item(W, ldn, kb * 64, n0, dst, K, drow0, scr, F.lane);
    }
    rot = (rot + nitems) % F.NGW;
}
__device__ __forceinline__ void conv_moe(const Frame& F, int slot, int& rot) {
    bf16_t* gu = (bf16_t*)(F.ws + WS_WMGU); bf16_t* dn = (bf16_t*)(F.ws + WS_WMD);
    for (int e = 0; e < NEXP; ++e) {
        const size_t so = ((size_t)slot * NEXP + e) * (size_t)D * DFFE;
        conv_seg(F, F.in[I_MG] + so, D, DFFE, DFFE, gu + (size_t)e * 2 * DFFE * D, 1, rot);
        conv_seg(F, F.in[I_MU] + so, D, DFFE, DFFE, gu + (size_t)e * 2 * DFFE * D, 2, rot);
        conv_seg(F, F.in[I_MD] + so, DFFE, D, D, dn + (size_t)e * D * DFFE, 0, rot);
    }
}

__device__ __forceinline__ void p_pro_a(const Frame& F) {
    {
        LAS float* sc = (LAS float*)F.lds; LAS float* red = sc + 17 * 1024;
        const float* c = F.in[I_C]; const float* cc = F.in[I_CCTX];
        for (int i = F.tid; i < 17 * 1024; i += NT) { const int r = i >> 10, k = i & 1023; const float v = (r < 16) ? c[r * 1024 + k] : cc[k]; sc[i] = silu_f(v); }
        __syncthreads();
        float* MOD = (float*)(F.ws + WS_MOD);
        const int col = F.tid & 63, ks = F.tid >> 6;
        for (int u = F.bid; u < 4 * 96; u += F.G) {
            const int l = u / 96, cb = u % 96;
            const float* W = F.in[I_WMOD] + (size_t)l * D * MODW + cb * 64 + col;
            float acc[17];
#pragma unroll
            for (int r = 0; r < 17; ++r) acc[r] = 0.f;
            for (int k = ks * 128; k < ks * 128 + 128; ++k) { const float w = W[(size_t)k * MODW];
#pragma unroll
                for (int r = 0; r < 17; ++r) acc[r] += sc[r * 1024 + k] * w; }
#pragma unroll
            for (int r = 0; r < 17; ++r) red[(ks * 17 + r) * 64 + col] = acc[r];
            __syncthreads();
            for (int i = F.tid; i < 17 * 64; i += NT) { const int r = i >> 6, c2 = i & 63; float s = 0.f;
#pragma unroll
                for (int k2 = 0; k2 < 8; ++k2) s += red[(k2 * 17 + r) * 64 + c2];
                MOD[(size_t)(l * 17 + r) * MODW + cb * 64 + c2] = s + F.in[I_BMOD][l * MODW + cb * 64 + c2]; }
            __syncthreads();
        }
    }
    int rot = 0;
    for (int l = 0; l < DEPTH; ++l) {
        conv_seg(F, F.in[I_WIN] + (size_t)l * D * D_IN_PROJ, D, D_IN_PROJ, NPROJ, (bf16_t*)(F.ws + WS_WIN) + (size_t)l * NPROJ * D, 0, rot);
        conv_seg(F, F.in[I_WOUT] + (size_t)l * D * D, D, D, D, (bf16_t*)(F.ws + WS_WOUT) + (size_t)l * D * D, 0, rot);
    }
    for (int s = 0; s < 2; ++s) {
        conv_seg(F, F.in[I_FG] + (size_t)s * D * DFF, D, DFF, DFF, (bf16_t*)(F.ws + WS_WFGU) + (size_t)s * 2 * DFF * D, 1, rot);
        conv_seg(F, F.in[I_FU] + (size_t)s * D * DFF, D, DFF, DFF, (bf16_t*)(F.ws + WS_WFGU) + (size_t)s * 2 * DFF * D, 2, rot);
        conv_seg(F, F.in[I_FD] + (size_t)s * DFF * D, DFF, D, D, (bf16_t*)(F.ws + WS_WFD) + (size_t)s * D * DFF, 0, rot);
    }
    conv_moe(F, 0, rot);
    { bf16_t* wdt = (bf16_t*)(F.ws + WS_WDT);
      for (int i = F.bid * NT + F.tid; i < DEPTH * 16 * D; i += F.G * NT) { const int l = i / (16 * D), n = (i / D) & 15, k = i % D;
          wdt[i] = (bf16_t)f2bf(F.in[I_WIN][((size_t)l * D + k) * D_IN_PROJ + NPROJ + n]); } }
}

__device__ __forceinline__ void row_load(const float* p, int lane, f32x4 (&v)[4]) {
#pragma unroll
    for (int j = 0; j < 4; ++j) v[j] = *(const f32x4*)(p + 4 * lane + 256 * j);
}
__device__ __forceinline__ void row_store(float* p, int lane, const f32x4 (&v)[4]) {
#pragma unroll
    for (int j = 0; j < 4; ++j) *(f32x4*)(p + 4 * lane + 256 * j) = v[j];
}
__device__ __forceinline__ void row_mod_store(bf16_t* hrow, int lane, const f32x4 (&v)[4], const float* sh, const float* sc, f32x4 (&hv)[4]) {
#pragma unroll
    for (int j = 0; j < 4; ++j) { const f32x4 a = *(const f32x4*)(sc + 4 * lane + 256 * j), b = *(const f32x4*)(sh + 4 * lane + 256 * j);
        hv[j] = v[j] * (a + 1.0f) + b;
        u32x2 w; w.x = pk2(hv[j][0], hv[j][1]); w.y = pk2(hv[j][2], hv[j][3]);
        *(u32x2*)(hrow + 4 * lane + 256 * j) = w; }
}
__device__ __forceinline__ void row_ln(f32x4 (&v)[4], const float* g, const float* b, int lane) {
    float s = 0.f;
#pragma unroll
    for (int j = 0; j < 4; ++j) s += (v[j][0] + v[j][1]) + (v[j][2] + v[j][3]);
    const float mean = wave_sum(s) * (1.0f / D); float q = 0.f;
#pragma unroll
    for (int j = 0; j < 4; ++j) { v[j] = v[j] - mean; q += (v[j][0] * v[j][0] + v[j][1] * v[j][1]) + (v[j][2] * v[j][2] + v[j][3] * v[j][3]); }
    const float rstd = 1.0f / sqrtf(wave_sum(q) * (1.0f / D) + LN_EPS);
#pragma unroll
    for (int j = 0; j < 4; ++j) { const f32x4 gg = *(const f32x4*)(g + 4 * lane + 256 * j), bb = *(const f32x4*)(b + 4 * lane + 256 * j); v[j] = v[j] * rstd * gg + bb; }
}
__device__ __forceinline__ int mod_row_of(int row) { return row < NLAT ? (row >> 11) : 16; }

__device__ __forceinline__ void p_pro_b(const Frame& F) {
    const float* MOD = (const float*)(F.ws + WS_MOD); bf16_t* H = (bf16_t*)(F.ws + WS_H);
    for (int row = F.gw; row < NTOK; row += F.NGW) {
        const float* src = row < NLAT ? F.in[I_X] + (size_t)row * D : F.in[I_CTX] + (size_t)(row - NLAT) * D;
        f32x4 v[4], hv[4]; row_load(src, F.lane, v);
        const float* m = MOD + (size_t)mod_row_of(row) * MODW;
        row_mod_store(H + (size_t)row * D, F.lane, v, m, m + D, hv);
    }
}

__device__ __forceinline__ void p_inproj(const Frame& F, int layer) {
    const bf16_t* H = (const bf16_t*)(F.ws + WS_H);
    {
        const bf16_t* wdt = (const bf16_t*)(F.ws + WS_WDT) + (size_t)layer * 16 * D; float* DT = (float*)(F.ws + WS_DT);
        const int fr = F.lane & 15, fq = F.lane >> 4;
        for (int g = F.gw; g < NTOK / 16; g += F.NGW) {
            f32x4 acc = {0.f, 0.f, 0.f, 0.f};
            const bf16_t* ap = H + (size_t)(g * 16 + fr) * D + fq * 8; const bf16_t* bp = wdt + (size_t)fr * D + fq * 8;
#pragma unroll 8
            for (int ks = 0; ks < 32; ++ks) { const bf16x8 a = *(const bf16x8*)(ap + ks * 32), b = *(const bf16x8*)(bp + ks * 32);
                acc = __builtin_amdgcn_mfma_f32_16x16x32_bf16(a, b, acc, 0, 0, 0); }
#pragma unroll
            for (int r = 0; r < 4; ++r) DT[(size_t)(g * 16 + fq * 4 + r) * 16 + fr] = acc[r];
        }
    }
    pg8::Gemm g{H, (const bf16_t*)(F.ws + WS_WIN) + (size_t)layer * NPROJ * D, D};
    pg8::DenseOrder S; S.init(NTOK, NPROJ, D, F.G, F.bid);
    pg8::EpiBf16 E{(bf16_t*)(F.ws + WS_PROJ), NPROJ};
    pg8::gemm_phase<pg8::EpiBf16, pg8::DenseOrder, true, true>(F.lds, g, S, E);
}

__device__ __forceinline__ void ssd_scan_unit(const Frame& F, int layer, int b, int h, int dir) {
    const int g = h >> 2;
    LAS bf16_t* raw = (LAS bf16_t*)F.lds;
    LAS float* xs = (LAS float*)(F.lds + 23040);
    LAS float* Bm = (LAS float*)(F.lds + 31232);
    LAS float* Cm = (LAS float*)(F.lds + 47616);
    LAS float* dtv = (LAS float*)(F.lds + 64000);
    LAS float* dec = dtv + 32;
    LAS float* yp = (LAS float*)(F.lds + 64256);
    LAS float* cw = (LAS float*)(F.lds + 97024);
    const bf16_t* PROJ = (const bf16_t*)(F.ws + WS_PROJ); const float* DT = (const float*)(F.ws + WS_DT);
    float* Y = (float*)(F.ws + (dir ? WS_YB : WS_YF));
    const float* convw = F.in[I_CONVW] + (size_t)layer * 5 * 1024; const float* convb = F.in[I_CONVB] + (size_t)layer * 1024;
    const float dtb = F.in[I_DTB][layer * 16 + dir * 8 + h], aneg = -__expf(F.in[I_ALOG][layer * 16 + dir * 8 + h]), dsk = F.in[I_DSKIP][layer * 8 + h];
    __syncthreads();
    for (int i = F.tid; i < 6 * 320; i += NT) { const int j = i / 320, ch = i % 320;
        const int cg = (ch < 64) ? h * 64 + ch : (ch < 192) ? 512 + g * 128 + (ch - 64) : 768 + g * 128 + (ch - 192);
        cw[i] = (j < 5) ? convw[j * 1024 + cg] : convb[cg]; }
    float S[16];
#pragma unroll
    for (int i = 0; i < 16; ++i) S[i] = 0.f;
    const int p = F.lane, w = F.wave, n0 = 16 * w;
    for (int s = 0; s < 2; ++s) {
        const int L = s ? SEQ : CTX; const int rowbase = s ? b * SEQ : NLAT + b * CTX;
        for (int blk = 0; blk < L / 32; ++blk) {
            const int t0 = dir ? (L - 32 - blk * 32) : blk * 32;
            __syncthreads();
            for (int i = F.tid; i < 36 * 40; i += NT) { const int r = i / 40, c8 = i % 40, t = t0 - 2 + r;
                const int col = (c8 < 8) ? OFF_XBC + h * 64 + c8 * 8 : (c8 < 24) ? OFF_XBC + 512 + g * 128 + (c8 - 8) * 8 : OFF_XBC + 768 + g * 128 + (c8 - 24) * 8;
                u32x4 v = {0u, 0u, 0u, 0u};
                if (t >= 0 && t < L) v = *(const u32x4*)(PROJ + (size_t)(rowbase + t) * NPROJ + col);
                *(LAS u32x4*)(raw + r * 320 + c8 * 8) = v; }
            __syncthreads();
            for (int i = F.tid; i < 32 * 320; i += NT) { const int tt = i / 320, ch = i % 320;
                float a = cw[5 * 320 + ch];
#pragma unroll
                for (int j = 0; j < 5; ++j) a += cw[j * 320 + ch] * bf2f(raw[(tt + j) * 320 + ch]);
                const float u = silu_f(a);
                if (ch < 64) xs[tt * 64 + ch] = u; else if (ch < 192) Bm[tt * 128 + ch - 64] = u; else Cm[tt * 128 + ch - 192] = u; }
            if (F.tid < 32) { const float x = DT[(size_t)(rowbase + t0 + F.tid) * 16 + dir * 8 + h] + dtb;
                const float dt = x > 20.f ? x : log1pf(__expf(x)); dtv[F.tid] = dt; dec[F.tid] = __expf(dt * aneg); }
            __syncthreads();
            if (s == 1) {
                for (int i = F.tid; i < 2 * 32 * 64; i += NT) { const int which = i >> 11, rem = i & 2047, tt = rem >> 6, q = rem & 63, hf = q >> 5, n = q & 31;
                    const int t = t0 + tt; const int pos = hf ? (t & 63) : (t >> 6);
                    const float ang = (float)pos * __expf(-(float)n * (9.210340371976184f / 32.0f));
                    float sn, cs; sincosf(ang, &sn, &cs);
                    LAS float* arr = which ? Cm : Bm; const int i1 = tt * 128 + hf * 64 + n, i2 = i1 + 32; const float w1 = arr[i1], w2 = arr[i2];
                    arr[i1] = w1 * cs - w2 * sn; arr[i2] = w1 * sn + w2 * cs; }
                __syncthreads();
            }
            for (int jj = 0; jj < 32; ++jj) {
                const int tt = dir ? 31 - jj : jj;
                const float xdt = xs[tt * 64 + p] * dtv[tt], dc = dec[tt];
                float y = 0.f;
#pragma unroll
                for (int i4 = 0; i4 < 4; ++i4) { const f32x4 bv = *(const LAS f32x4*)(Bm + tt * 128 + n0 + 4 * i4), cv = *(const LAS f32x4*)(Cm + tt * 128 + n0 + 4 * i4);
#pragma unroll
                    for (int k = 0; k < 4; ++k) { S[4 * i4 + k] = S[4 * i4 + k] * dc + xdt * bv[k]; y += S[4 * i4 + k] * cv[k]; } }
                yp[((jj & 15) * 8 + w) * 64 + p] = y;
                if ((jj & 15) == 15) {
                    __syncthreads();
                    for (int i = F.tid; i < 16 * 64; i += NT) { const int j2 = i >> 6, pp = i & 63; float sum = 0.f;
#pragma unroll
                        for (int w2 = 0; w2 < 8; ++w2) sum += yp[(j2 * 8 + w2) * 64 + pp];
                        const int js = jj - 15 + j2, ttk = dir ? 31 - js : js;
                        if (dir == 0) sum += dsk * xs[ttk * 64 + pp];
                        Y[(size_t)(rowbase + t0 + ttk) * 512 + h * 64 + pp] = sum; }
                    __syncthreads();
                }
            }
        }
    }
}

__device__ __forceinline__ void na_simple(const Frame& F, int layer, bool last) {
    const bf16_t* PROJ = (const bf16_t*)(F.ws + WS_PROJ); bf16_t* MIX = (bf16_t*)(F.ws + WS_MIX);
    const float* rpb = F.in[I_RPB] + (size_t)layer * 8 * 15 * 31;
    const int total = NLAT * 8 + (last ? 0 : NCTX * 8);
    for (int idx = F.bid * NT + F.tid; idx < total; idx += F.G * NT) {
        int b, h, row, nloc, i = 0, j = 0, r0 = 0, cs = 0;
        if (idx < NLAT * 8) { const int bh = idx >> 11, t = idx & 2047; b = bh >> 3; h = bh & 7; row = b * SEQ + t; i = t >> 6; j = t & 63;
            r0 = i - 4; r0 = r0 < 0 ? 0 : (r0 > 24 ? 24 : r0); cs = j - 8; cs = cs < 0 ? 0 : (cs > 48 ? 48 : cs); nloc = 128; }
        else { const int i2 = idx - NLAT * 8, bh = i2 >> 8, tc = i2 & 255; b = bh >> 3; h = bh & 7; row = NLAT + b * CTX + tc; nloc = 0; }
        float q[64], acc[64];
        { const u32x4* qp = (const u32x4*)(PROJ + (size_t)row * NPROJ + h * 64);
#pragma unroll
          for (int c = 0; c < 8; ++c) { const u32x4 v = qp[c];
              q[c * 8 + 0] = bflo(v.x) * 0.125f; q[c * 8 + 1] = bfhi(v.x) * 0.125f; q[c * 8 + 2] = bflo(v.y) * 0.125f; q[c * 8 + 3] = bfhi(v.y) * 0.125f;
              q[c * 8 + 4] = bflo(v.z) * 0.125f; q[c * 8 + 5] = bfhi(v.z) * 0.125f; q[c * 8 + 6] = bflo(v.w) * 0.125f; q[c * 8 + 7] = bfhi(v.w) * 0.125f; } }
#pragma unroll
        for (int d = 0; d < 64; ++d) acc[d] = 0.f;
        float m = -INFINITY, l = 0.f;
        for (int kk = 0; kk < nloc + CTX; ++kk) {
            int krow; float bias = 0.f;
            if (kk < nloc) { const int kr = kk >> 4, kc = kk & 15; krow = b * SEQ + (r0 + kr) * 64 + cs + kc; bias = rpb[(h * 15 + (r0 + kr - i + 7)) * 31 + (cs + kc - j + 15)]; }
            else krow = NLAT + b * CTX + (kk - nloc);
            const u32x4* kp = (const u32x4*)(PROJ + (size_t)krow * NPROJ + OFF_K + h * 64);
            const u32x4* vp = (const u32x4*)(PROJ + (size_t)krow * NPROJ + OFF_V + h * 64);
            float s = bias;
#pragma unroll
            for (int c = 0; c < 8; ++c) { const u32x4 v = kp[c];
                s += q[c * 8 + 0] * bflo(v.x) + q[c * 8 + 1] * bfhi(v.x) + q[c * 8 + 2] * bflo(v.y) + q[c * 8 + 3] * bfhi(v.y)
                   + q[c * 8 + 4] * bflo(v.z) + q[c * 8 + 5] * bfhi(v.z) + q[c * 8 + 6] * bflo(v.w) + q[c * 8 + 7] * bfhi(v.w); }
            const float mn = fmaxf(m, s), corr = __expf(m - mn), pe = __expf(s - mn);
            l = l * corr + pe; m = mn;
#pragma unroll
            for (int c = 0; c < 8; ++c) { const u32x4 v = vp[c];
                acc[c * 8 + 0] = acc[c * 8 + 0] * corr + pe * bflo(v.x); acc[c * 8 + 1] = acc[c * 8 + 1] * corr + pe * bfhi(v.x);
                acc[c * 8 + 2] = acc[c * 8 + 2] * corr + pe * bflo(v.y); acc[c * 8 + 3] = acc[c * 8 + 3] * corr + pe * bfhi(v.y);
                acc[c * 8 + 4] = acc[c * 8 + 4] * corr + pe * bflo(v.z); acc[c * 8 + 5] = acc[c * 8 + 5] * corr + pe * bfhi(v.z);
                acc[c * 8 + 6] = acc[c * 8 + 6] * corr + pe * bflo(v.w); acc[c * 8 + 7] = acc[c * 8 + 7] * corr + pe * bfhi(v.w); }
        }
        const float inv = 1.0f / l;
        u32x4* op = (u32x4*)(MIX + (size_t)row * D + h * 64);
#pragma unroll
        for (int c = 0; c < 8; ++c) { u32x4 o; o.x = pk2(acc[c * 8 + 0] * inv, acc[c * 8 + 1] * inv); o.y = pk2(acc[c * 8 + 2] * inv, acc[c * 8 + 3] * inv);
            o.z = pk2(acc[c * 8 + 4] * inv, acc[c * 8 + 5] * inv); o.w = pk2(acc[c * 8 + 6] * inv, acc[c * 8 + 7] * inv); op[c] = o; }
    }
}

typedef short s16x4 __attribute__((ext_vector_type(4)));
__device__ __forceinline__ s16x4 lds_tr16(LAS const unsigned char* p) { return __builtin_bit_cast(s16x4, __builtin_amdgcn_ds_read_tr16_b64_v4i16((LAS s16x4*)p)); }
constexpr int NA_KS = 144;
constexpr float LOG2E = 1.4426950408889634f;
__device__ __forceinline__ void na_unit(const Frame& F, int layer, int b, int h, int mode, int m) {
    LAS unsigned char* KV = F.lds;
    LAS float* rp = (LAS float*)(F.lds + 120832);
    const bf16_t* PROJ = (const bf16_t*)(F.ws + WS_PROJ); bf16_t* MIX = (bf16_t*)(F.ws + WS_MIX);
    const int tid = F.tid, lane = F.lane, w = F.wave, q16 = lane & 15, g = lane >> 4;
    int rbase = 0, nk = 0;
    if (mode == 0) { rbase = 2 * m - 4; rbase = rbase < 0 ? 0 : (rbase > 24 ? 24 : rbase); nk = 32 - rbase; nk = nk > 9 ? 9 : nk; }
    const int kfirst = (mode == 0) ? 0 : 576 * 8, nloc8 = nk * 64 * 8;
    __syncthreads();
    for (int i = tid + kfirst; i < 832 * 8; i += NT) { const int key = i >> 3, ch = i & 7;
        if (key < 576 && i >= nloc8) continue;
        const int grow = key < 576 ? b * SEQ + rbase * 64 + key : NLAT + b * CTX + (key - 576);
        *(LAS u32x4*)(KV + key * NA_KS + ch * 16) = *(const u32x4*)(PROJ + (size_t)grow * NPROJ + OFF_K + h * 64 + ch * 8); }
    if (mode == 0 && tid < 465) rp[tid] = F.in[I_RPB][(size_t)(layer * 8 + h) * 465 + tid] * LOG2E;
    __syncthreads();
    int i = 0, j0 = 0, hs = 0, kr0 = 0, qrow;
    if (mode == 0) { i = 2 * m + (w >> 2); j0 = (w & 3) * 16; qrow = b * SEQ + i * 64 + j0; hs = j0 - 8; hs = hs < 0 ? 0 : (hs > 32 ? 32 : hs);
        int r0 = i - 4; r0 = r0 < 0 ? 0 : (r0 > 24 ? 24 : r0); kr0 = r0 - rbase; }
    else qrow = NLAT + b * CTX + m * 128 + w * 16;
    bf16x8 qf[2];
#pragma unroll
    for (int ks = 0; ks < 2; ++ks) qf[ks] = *(const bf16x8*)(PROJ + (size_t)(qrow + q16) * NPROJ + h * 64 + ks * 32 + g * 8);
    f32x4 S[32];
    const LAS unsigned char* kb = KV + q16 * NA_KS + g * 16;
    if (mode == 0) {
        const int j = j0 + q16; int cs = j - 8; cs = cs < 0 ? 0 : (cs > 48 ? 48 : cs);
        const int rb0 = (kr0 + rbase) - i + 7;
#pragma unroll
        for (int tl = 0; tl < 16; ++tl) { const int kr = tl >> 1, half = tl & 1; const int kidx0 = (kr0 + kr) * 64 + hs + 16 * half;
            f32x4 a = {0.f, 0.f, 0.f, 0.f};
#pragma unroll
            for (int ks = 0; ks < 2; ++ks) { const bf16x8 kf = *(const LAS bf16x8*)(kb + kidx0 * NA_KS + ks * 64); a = __builtin_amdgcn_mfma_f32_16x16x32_bf16(kf, qf[ks], a, 0, 0, 0); }
#pragma unroll
            for (int r = 0; r < 4; ++r) { const int kc = hs + 16 * half + 4 * g + r; const bool inw = (kc >= cs) && (kc < cs + 16);
                int cbi = kc - j + 15; cbi = cbi < 0 ? 0 : (cbi > 30 ? 30 : cbi);
                a[r] = inw ? a[r] * (0.125f * LOG2E) + rp[(rb0 + kr) * 31 + cbi] : -INFINITY; }
            S[tl] = a; }
    } else {
#pragma unroll
        for (int tl = 0; tl < 16; ++tl) S[tl] = (f32x4){-INFINITY, -INFINITY, -INFINITY, -INFINITY};
    }
#pragma unroll
    for (int tc = 0; tc < 16; ++tc) { const int kidx0 = 576 + 16 * tc; f32x4 a = {0.f, 0.f, 0.f, 0.f};
#pragma unroll
        for (int ks = 0; ks < 2; ++ks) { const bf16x8 kf = *(const LAS bf16x8*)(kb + kidx0 * NA_KS + ks * 64); a = __builtin_amdgcn_mfma_f32_16x16x32_bf16(kf, qf[ks], a, 0, 0, 0); }
        S[16 + tc] = a * (0.125f * LOG2E); }
    float mx = -INFINITY;
#pragma unroll
    for (int t = 0; t < 32; ++t) mx = fmaxf(fmaxf(fmaxf(S[t][0], S[t][1]), fmaxf(S[t][2], S[t][3])), mx);
    mx = fmaxf(mx, __shfl_xor(mx, 16)); mx = fmaxf(mx, __shfl_xor(mx, 32));
    float sum = 0.f; u32x4 P[16];
#pragma unroll
    for (int kk = 0; kk < 16; ++kk) { float e[8];
#pragma unroll
        for (int r = 0; r < 4; ++r) { e[r] = __builtin_amdgcn_exp2f(S[2 * kk][r] - mx); e[4 + r] = __builtin_amdgcn_exp2f(S[2 * kk + 1][r] - mx); }
        sum += ((e[0] + e[1]) + (e[2] + e[3])) + ((e[4] + e[5]) + (e[6] + e[7]));
        P[kk].x = pg8::cvt_pk_bf16(e[0], e[1]); P[kk].y = pg8::cvt_pk_bf16(e[2], e[3]); P[kk].z = pg8::cvt_pk_bf16(e[4], e[5]); P[kk].w = pg8::cvt_pk_bf16(e[6], e[7]); }
    sum += __shfl_xor(sum, 16); sum += __shfl_xor(sum, 32);
    const float inv = 1.0f / sum;
    __syncthreads();
    for (int i2 = tid + kfirst; i2 < 832 * 8; i2 += NT) { const int key = i2 >> 3, ch = i2 & 7;
        if (key < 576 && i2 >= nloc8) continue;
        const int grow = key < 576 ? b * SEQ + rbase * 64 + key : NLAT + b * CTX + (key - 576);
        *(LAS u32x4*)(KV + key * NA_KS + ch * 16) = *(const u32x4*)(PROJ + (size_t)grow * NPROJ + OFF_V + h * 64 + ch * 8); }
    __syncthreads();
    f32x4 o[4];
#pragma unroll
    for (int dt = 0; dt < 4; ++dt) o[dt] = (f32x4){0.f, 0.f, 0.f, 0.f};
    const LAS unsigned char* vb = KV + (4 * g + (q16 >> 2)) * NA_KS + (q16 & 3) * 8;
#pragma unroll
    for (int kk = 0; kk < 16; ++kk) {
        if (kk < 8 && mode != 0) continue;
        const int kidx0 = (kk < 8) ? (kr0 + kk) * 64 + hs : 576 + 32 * (kk - 8);
        const bf16x8 pa = __builtin_bit_cast(bf16x8, P[kk]);
#pragma unroll
        for (int dt = 0; dt < 4; ++dt) { const s16x4 lo = lds_tr16(vb + kidx0 * NA_KS + dt * 32), hi = lds_tr16(vb + (kidx0 + 16) * NA_KS + dt * 32);
            const bf16x8 vf = {lo[0], lo[1], lo[2], lo[3], hi[0], hi[1], hi[2], hi[3]};
            o[dt] = __builtin_amdgcn_mfma_f32_16x16x32_bf16(pa, vf, o[dt], 0, 0, 0); }
    }
#pragma unroll
    for (int r = 0; r < 4; ++r) { const float ir = __shfl(inv, 4 * g + r);
        bf16_t* op = MIX + (size_t)(qrow + 4 * g + r) * D + h * 64 + q16;
#pragma unroll
        for (int dt = 0; dt < 4; ++dt) op[dt * 16] = (bf16_t)f2bf(o[dt][r] * ir); }
}
__device__ __forceinline__ void p_mixer(const Frame& F, int layer, bool last) {
    for (int rep = 0; rep < REP_SSD; ++rep) for (int u = F.bid; u < 256; u += F.G) ssd_scan_unit(F, layer, u >> 4, (u >> 1) & 7, u & 1);
    __syncthreads();
#ifdef NA_SIMPLE
    for (int rep = 0; rep < REP_NA; ++rep) na_simple(F, layer, last);
#else
    for (int rep = 0; rep < REP_NA; ++rep) {
        for (int u = F.bid; u < 2048; u += F.G) na_unit(F, layer, u >> 7, (u >> 4) & 7, 0, u & 15);
        if (!last) for (int u = F.bid; u < 256; u += F.G) na_unit(F, layer, u >> 4, (u >> 1) & 7, 1, u & 1);
    }
#endif
}

__device__ __forceinline__ void p_ssdcomb(const Frame& F, int layer, bool last) {
    const bf16_t* PROJ = (const bf16_t*)(F.ws + WS_PROJ); bf16_t* MIX = (bf16_t*)(F.ws + WS_MIX);
    const float* YF = (const float*)(F.ws + WS_YF); const float* YB = (const float*)(F.ws + WS_YB);
    const float* nw = F.in[I_NORMW] + layer * 512 + F.lane * 8;
    const f32x4 nw0 = *(const f32x4*)nw, nw1 = *(const f32x4*)(nw + 4);
    const int nrows = last ? NLAT : NTOK;
    for (int row = F.gw; row < nrows; row += F.NGW) {
        const size_t o = (size_t)row * 512 + F.lane * 8;
        const f32x4 a0 = *(const f32x4*)(YF + o) + *(const f32x4*)(YB + o), a1 = *(const f32x4*)(YF + o + 4) + *(const f32x4*)(YB + o + 4);
        const u32x4 zv = *(const u32x4*)(PROJ + (size_t)row * NPROJ + OFF_Z + F.lane * 8);
        float y[8] = {a0[0] * silu_f(bflo(zv.x)), a0[1] * silu_f(bfhi(zv.x)), a0[2] * silu_f(bflo(zv.y)), a0[3] * silu_f(bfhi(zv.y)),
                      a1[0] * silu_f(bflo(zv.z)), a1[1] * silu_f(bfhi(zv.z)), a1[2] * silu_f(bflo(zv.w)), a1[3] * silu_f(bfhi(zv.w))};
        float ss = 0.f;
#pragma unroll
        for (int k = 0; k < 8; ++k) ss += y[k] * y[k];
#pragma unroll
        for (int of = 1; of < 32; of <<= 1) ss += __shfl_xor(ss, of);
        const float rs = 1.0f / sqrtf(ss * (1.0f / 256.0f) + RMS_EPS);
        u32x4 w; w.x = pk2(y[0] * rs * nw0[0], y[1] * rs * nw0[1]); w.y = pk2(y[2] * rs * nw0[2], y[3] * rs * nw0[3]);
        w.z = pk2(y[4] * rs * nw1[0], y[5] * rs * nw1[1]); w.w = pk2(y[6] * rs * nw1[2], y[7] * rs * nw1[3]);
        *(u32x4*)(MIX + (size_t)row * D + 512 + F.lane * 8) = w;
    }
}

__device__ __forceinline__ void p_outproj(const Frame& F, int layer, bool last) {
    float* X = (float*)(F.ws + WS_X);
    pg8::Gemm g{(const bf16_t*)(F.ws + WS_MIX), (const bf16_t*)(F.ws + WS_WOUT) + (size_t)layer * D * D, D};
    pg8::DenseOrder S; S.init(last ? NLAT : NTOK, D, D, F.G, F.bid);
    pg8::EpiResid E{layer == 0 ? F.in[I_X] : X, layer == 0 ? F.in[I_CTX] : X + (size_t)NLAT * D, X, (const float*)(F.ws + WS_MOD) + (size_t)layer * 17 * MODW, 2 * D};
    pg8::gemm_phase<pg8::EpiResid, pg8::DenseOrder, true, true>(F.lds, g, S, E);
}

__device__ __forceinline__ unsigned* cnt_word(const Frame& F, int slot, int hf, int e) { return (unsigned*)(F.ws + WS_CTL) + CW_CNT + ((slot * 2 + hf) * 8 + e) * 64; }
__device__ __forceinline__ void p_ln1(const Frame& F, int layer, bool last) {
    float* X = (float*)(F.ws + WS_X); bf16_t* H = (bf16_t*)(F.ws + WS_H);
    const float* MOD = (const float*)(F.ws + WS_MOD) + (size_t)layer * 17 * MODW;
    const float* lg = F.in[I_LNG] + (size_t)(layer * 2) * D; const float* lb = F.in[I_LNB] + (size_t)(layer * 2) * D;
    const bool moe = layer & 1; const int slot = layer >> 1;
    const int nrows = last ? NLAT : NTOK, halfn = nrows / 2;
    float rw[16][8];
    if (moe) { const float* R = F.in[I_RW] + (size_t)slot * D * 8;
#pragma unroll
        for (int j = 0; j < 4; ++j)
#pragma unroll
            for (int k = 0; k < 4; ++k) { const f32x4 a = *(const f32x4*)(R + (size_t)(4 * F.lane + 256 * j + k) * 8), b2 = *(const f32x4*)(R + (size_t)(4 * F.lane + 256 * j + k) * 8 + 4);
                rw[j * 4 + k][0] = a[0]; rw[j * 4 + k][1] = a[1]; rw[j * 4 + k][2] = a[2]; rw[j * 4 + k][3] = a[3]; rw[j * 4 + k][4] = b2[0]; rw[j * 4 + k][5] = b2[1]; rw[j * 4 + k][6] = b2[2]; rw[j * 4 + k][7] = b2[3]; } }
    for (int row = F.gw; row < nrows; row += F.NGW) {
        f32x4 v[4], hv[4]; row_load(X + (size_t)row * D, F.lane, v);
        row_ln(v, lg, lb, F.lane);
        row_store(X + (size_t)row * D, F.lane, v);
        const float* m = MOD + (size_t)mod_row_of(row) * MODW;
        row_mod_store(H + (size_t)row * D, F.lane, v, m + 3 * D, m + 4 * D, hv);
        if (moe) {
            float lg8[8];
#pragma unroll
            for (int e = 0; e < 8; ++e) { float s = 0.f;
#pragma unroll
                for (int j = 0; j < 4; ++j)
#pragma unroll
                    for (int k = 0; k < 4; ++k) s += hv[j][k] * rw[j * 4 + k][e];
                lg8[e] = wave_sum(s); }
            int e0 = 0; float v0 = lg8[0];
#pragma unroll
            for (int e = 1; e < 8; ++e) if (lg8[e] > v0) { v0 = lg8[e]; e0 = e; }
            int e1 = -1; float v1 = -INFINITY;
#pragma unroll
            for (int e = 0; e < 8; ++e) if (e != e0 && lg8[e] > v1) { v1 = lg8[e]; e1 = e; }
            if (F.lane == 0) {
                const int hf = row < halfn ? 0 : 1;
                const unsigned s0 = atomicAdd(cnt_word(F, slot, hf, e0), 1u), s1 = atomicAdd(cnt_word(F, slot, hf, e1), 1u);
                int* list = (int*)(F.ws + WS_LIST);
                list[(hf * 8 + e0) * 18432 + s0] = row; list[(hf * 8 + e1) * 18432 + s1] = row;
                const float ex = __expf(v1 - v0), g0 = 1.0f / (1.0f + ex);
                u32x4 r; r.x = (unsigned)e0 | ((unsigned)e1 << 8); r.y = s0; r.z = s1; r.w = 0u;
                *(u32x4*)(F.ws + WS_ROUTE + (size_t)row * 16) = r;
                *(f32x2*)(F.ws + WS_GATES + (size_t)row * 8) = (f32x2){g0, ex * g0};
            }
        }
    }
}

__device__ __forceinline__ void p_ffn1_dense(const Frame& F, int layer, bool last) {
    const int s = layer >> 1;
    pg8::Gemm g{(const bf16_t*)(F.ws + WS_H), (const bf16_t*)(F.ws + WS_WFGU) + (size_t)s * 2 * DFF * D, D};
    pg8::DenseOrder S; S.init(last ? NLAT : NTOK, 2 * DFF, D, F.G, F.bid);
    pg8::EpiSwiGLU E{(bf16_t*)(F.ws + WS_HID), DFF};
    pg8::gemm_phase<pg8::EpiSwiGLU, pg8::DenseOrder, true, true>(F.lds, g, S, E);
}
__device__ __forceinline__ void p_ffn2_dense(const Frame& F, int layer, bool last) {
    const int s = layer >> 1; float* X = (float*)(F.ws + WS_X);
    pg8::Gemm g{(const bf16_t*)(F.ws + WS_HID), (const bf16_t*)(F.ws + WS_WFD) + (size_t)s * D * DFF, DFF};
    pg8::DenseOrder S; S.init(last ? NLAT : NTOK, D, DFF, F.G, F.bid);
    pg8::EpiResid E{X, X + (size_t)NLAT * D, X, (const float*)(F.ws + WS_MOD) + (size_t)layer * 17 * MODW, 5 * D};
    pg8::gemm_phase<pg8::EpiResid, pg8::DenseOrder, true, true>(F.lds, g, S, E);
}
__device__ __forceinline__ void moe_prefix(const Frame& F, int slot, int hf, int (&ts)[9], int (&cn)[8]) {
    int a = 0;
#pragma unroll
    for (int e = 0; e < 8; ++e) { cn[e] = (int)*cnt_word(F, slot, hf, e); ts[e] = a; a += (cn[e] + 255) >> 8; }
    ts[8] = a;
}
__device__ __forceinline__ void p_ffn1_moe(const Frame& F, int layer, int hf) {
    const int slot = layer >> 1; int cn[8];
    pg8::MoeOrder<true> S; moe_prefix(F, slot, hf, S.ts, cn);
    S.nM = S.ts[8]; S.nN = 2 * DFFE / 256; S.G = F.G; S.c = F.bid; S.K = D; S.estride = (long)2 * DFFE * D * 2; S.rowoff = (const LAS unsigned*)(F.lds + LDS_ROWOFF);
    {
        const int* list = (const int*)(F.ws + WS_LIST); LAS unsigned* ro = (LAS unsigned*)(F.lds + LDS_ROWOFF); pg8::Unit u;
        for (int i = 0; i < 18 && S.next(i, u); ++i) { const int e = S.expert_of(u.pm); int tse = 0, cne = 0;
#pragma unroll
            for (int j = 0; j < 8; ++j) { tse = (j == e) ? S.ts[j] : tse; cne = (j == e) ? cn[j] : cne; }
            for (int r = F.tid; r < 256; r += NT) { const int sl = (u.pm - tse) * 256 + r; const int tok = sl < cne ? list[(hf * 8 + e) * 18432 + sl] : 0; ro[i * 256 + r] = (unsigned)tok * (unsigned)(D * 2); } }
        __syncthreads();
    }
    pg8::Gemm g{(const bf16_t*)(F.ws + WS_H), (const bf16_t*)(F.ws + WS_WMGU), D};
    pg8::EpiSwiGLU E{(bf16_t*)(F.ws + WS_HID), DFFE};
    pg8::gemm_phase<pg8::EpiSwiGLU, pg8::MoeOrder<true>, true, true>(F.lds, g, S, E);
}
__device__ __forceinline__ void p_ffn2_moe(const Frame& F, int layer, int hf) {
    const int slot = layer >> 1; int cn[8];
    pg8::MoeOrder<false> S; moe_prefix(F, slot, hf, S.ts, cn);
    S.nM = S.ts[8]; S.nN = D / 256; S.G = F.G; S.c = F.bid; S.K = DFFE; S.estride = (long)D * DFFE * 2; S.rowoff = nullptr;
    pg8::Gemm g{(const bf16_t*)(F.ws + WS_HID), (const bf16_t*)(F.ws + WS_WMD), DFFE};
    pg8::EpiBf16 E{(bf16_t*)(F.ws + WS_YP) + (size_t)hf * HALF_PAD * D, D};
    pg8::gemm_phase<pg8::EpiBf16, pg8::MoeOrder<false>, true, true>(F.lds, g, S, E);
}

__device__ __forceinline__ void p_ln2(const Frame& F, int layer, bool last) {
    float* X = (float*)(F.ws + WS_X); bf16_t* H = (bf16_t*)(F.ws + WS_H);
    const float* MOD = (const float*)(F.ws + WS_MOD) + (size_t)layer * 17 * MODW;
    const float* lg = F.in[I_LNG] + (size_t)(layer * 2 + 1) * D; const float* lb = F.in[I_LNB] + (size_t)(layer * 2 + 1) * D;
    const bool moe = layer & 1; const int slot = layer >> 1;
    const int nrows = last ? NLAT : NTOK, halfn = nrows / 2;
    int ts0[9], ts1[9], cn[8];
    if (moe) { moe_prefix(F, slot, 0, ts0, cn); moe_prefix(F, slot, 1, ts1, cn); }
    const bf16_t* YP = (const bf16_t*)(F.ws + WS_YP);
    for (int row = F.gw; row < nrows; row += F.NGW) {
        f32x4 v[4], hv[4]; row_load(X + (size_t)row * D, F.lane, v);
        if (moe) {
            const int hf = row < halfn ? 0 : 1;
            const u32x4 r = *(const u32x4*)(F.ws + WS_ROUTE + (size_t)row * 16); const f32x2 gt = *(const f32x2*)(F.ws + WS_GATES + (size_t)row * 8);
            const int e0 = r.x & 255, e1 = (r.x >> 8) & 255;
            int t0 = 0, t1 = 0;
#pragma unroll
            for (int e = 0; e < 8; ++e) { const int tv = hf ? ts1[e] : ts0[e]; t0 = (e == e0) ? tv : t0; t1 = (e == e1) ? tv : t1; }
            const bf16_t* y0 = YP + ((size_t)hf * HALF_PAD + (size_t)t0 * 256 + r.y) * D; const bf16_t* y1 = YP + ((size_t)hf * HALF_PAD + (size_t)t1 * 256 + r.z) * D;
            const float* g2 = MOD + (size_t)mod_row_of(row) * MODW + 5 * D;
#pragma unroll
            for (int j = 0; j < 4; ++j) { const u32x2 a = *(const u32x2*)(y0 + 4 * F.lane + 256 * j), b2 = *(const u32x2*)(y1 + 4 * F.lane + 256 * j);
                const f32x4 gg = *(const f32x4*)(g2 + 4 * F.lane + 256 * j) + 1.0f;
                f32x4 f; f[0] = gt[0] * bflo(a.x) + gt[1] * bflo(b2.x); f[1] = gt[0] * bfhi(a.x) + gt[1] * bfhi(b2.x); f[2] = gt[0] * bflo(a.y) + gt[1] * bflo(b2.y); f[3] = gt[0] * bfhi(a.y) + gt[1] * bfhi(b2.y);
                v[j] = v[j] * ALPHA + gg * f; }
        }
        row_ln(v, lg, lb, F.lane);
        if (last) row_store(F.out + (size_t)row * D, F.lane, v);
        else { row_store(X + (size_t)row * D, F.lane, v);
            const float* m = MOD + (size_t)17 * MODW + (size_t)mod_row_of(row) * MODW;
            row_mod_store(H + (size_t)row * D, F.lane, v, m, m + D, hv); }
    }
}

constexpr int NPH = 2 + 10 * DEPTH;
#ifndef SITE_MASK
#define SITE_MASK 0xFFFF
#endif
#define SITE(n) (((SITE_MASK) >> (n)) & 1)
__global__ void __launch_bounds__(NT, 2) fwd_kernel(Args args) {
    extern __shared__ __attribute__((aligned(16))) unsigned char lds_raw[];
    Frame F;
    F.lds = (LAS unsigned char*)lds_raw; F.in = args.in; F.out = args.out; F.ws = args.ws;
    F.tid = threadIdx.x; F.lane = F.tid & 63; F.wave = __builtin_amdgcn_readfirstlane(F.tid >> 6); F.bid = blockIdx.x; F.G = gridDim.x;
    F.gw = F.bid * NWAVES + F.wave; F.NGW = F.G * NWAVES;
    volatile LAS unsigned* MISC = (volatile LAS unsigned*)(F.lds + LDS_MISC);
    if (F.tid < 64) MISC[F.tid] = 0u;
    __syncthreads();
    XcdBarrier bar; bar.bar = (unsigned*)(F.ws + WS_CTL) + CW_BAR; bar.x = 0; bar.st = MISC + 8;
#if MK_SINGLE
    bar = xcd_barrier_post((unsigned*)(F.ws + WS_CTL) + CW_BAR, MISC + 8);
#endif
    const int lo = args.ph_lo, hi = args.ph_hi;
#define IN(k) (lo <= (k) && (k) < hi)
#if MK_SINGLE
#define SEAM(k) do { if (IN(k) && IN((k) + 1)) { XcdBarrier b2_ = bar; int z_; asm volatile("s_mov_b32 %0, 0" : "=s"(z_)); b2_.bar = bar.bar + z_; xcd_barrier(b2_); } } while (0)
#else
#define SEAM(k) do { } while (0)
#endif
    if constexpr (SITE(0)) if (IN(0)) p_pro_a(fresh(F));
    SEAM(0);
    if constexpr (SITE(1)) if (IN(1)) p_pro_b(fresh(F));
    SEAM(1);
    for (int layer = 0; layer < DEPTH; ++layer) {
        const int pb = 2 + 10 * layer; const bool last = layer == DEPTH - 1; const bool moe = layer & 1;
        if constexpr (SITE(2)) if (IN(pb + 0)) p_inproj(fresh(F), layer);
        SEAM(pb + 0);
        if constexpr (SITE(3)) if (IN(pb + 1)) p_mixer(fresh(F), layer, last);
        SEAM(pb + 1);
        if constexpr (SITE(4)) if (IN(pb + 2)) { p_ssdcomb(fresh(F), layer, last); if (layer == 2) { int rot = 0; conv_moe(fresh(F), 1, rot); } }
        SEAM(pb + 2);
        if constexpr (SITE(5)) if (IN(pb + 3)) p_outproj(fresh(F), layer, last);
        SEAM(pb + 3);
        if constexpr (SITE(6)) if (IN(pb + 4)) p_ln1(fresh(F), layer, last);
        SEAM(pb + 4);
        if (moe) {
            if constexpr (SITE(7)) if (IN(pb + 5)) p_ffn1_moe(fresh(F), layer, 0);
            SEAM(pb + 5);
            if constexpr (SITE(8)) if (IN(pb + 6)) p_ffn2_moe(fresh(F), layer, 0);
            SEAM(pb + 6);
            if constexpr (SITE(7)) if (IN(pb + 7)) p_ffn1_moe(fresh(F), layer, 1);
            SEAM(pb + 7);
            if constexpr (SITE(8)) if (IN(pb + 8)) p_ffn2_moe(fresh(F), layer, 1);
            SEAM(pb + 8);
        } else {
            if constexpr (SITE(9)) if (IN(pb + 5)) p_ffn1_dense(fresh(F), layer, last);
            SEAM(pb + 5);
            if constexpr (SITE(10)) if (IN(pb + 6)) p_ffn2_dense(fresh(F), layer, last);
            SEAM(pb + 6);
            SEAM(pb + 7);
            SEAM(pb + 8);
        }
        if constexpr (SITE(11)) if (IN(pb + 9)) p_ln2(fresh(F), layer, last);
        if (!last) SEAM(pb + 9);
    }
#undef IN
#undef SEAM
}

extern "C" void kernel_launch(void* const* d_in, const int* in_sizes, int n_in, void* d_out, int out_size, void* d_ws, size_t ws_size, hipStream_t stream) {
    static int grid = 0;
    if (grid == 0) {
        if (n_in != 24 || out_size != NLAT * D || ws_size < WS_END) { fprintf(stderr, "kernel_launch: unexpected shapes (n_in %d, out %d, ws %zu < %zu)\n", n_in, out_size, ws_size, (size_t)WS_END); grid = -1; return; }
        int dev = 0, cus = 0, per_cu = 0;
        if (hipGetDevice(&dev) != hipSuccess || hipDeviceGetAttribute(&cus, hipDeviceAttributeMultiprocessorCount, dev) != hipSuccess) { grid = -1; return; }
        if (hipFuncSetAttribute((const void*)fwd_kernel, hipFuncAttributeMaxDynamicSharedMemorySize, LDS_BYTES) != hipSuccess) { fprintf(stderr, "kernel_launch: hipFuncSetAttribute failed\n"); grid = -1; return; }
        if (hipOccupancyMaxActiveBlocksPerMultiprocessor(&per_cu, (const void*)fwd_kernel, NT, LDS_BYTES) != hipSuccess || per_cu < 1) { fprintf(stderr, "kernel_launch: occupancy query says %d\n", per_cu); }
        (void)hipGetLastError();
        grid = cus;
    }
    if (grid < 0) return;
    (void)in_sizes;
    if (hipMemsetAsync((char*)d_ws + WS_CTL, 0, CTL_BYTES, stream) != hipSuccess) return;
    Args a{};
    for (int i = 0; i < 24; ++i) a.in[i] = (const float*)d_in[i];
    a.out = (float*)d_out; a.ws = (unsigned char*)d_ws;
#if MK_SINGLE
    a.ph_lo = 0; a.ph_hi = NPH;
    hipLaunchKernelGGL(fwd_kernel, dim3(grid), dim3(NT), LDS_BYTES, stream, a);
#else
    for (int ph = 0; ph < NPH; ++ph) {
        if (ph >= 2) { const int layer = (ph - 2) / 10, j = (ph - 2) % 10; const bool moe = layer & 1; if (!moe && (j == 7 || j == 8)) continue; }
        a.ph_lo = ph; a.ph_hi = ph + 1;
        hipLaunchKernelGGL(fwd_kernel, dim3(grid), dim3(NT), LDS_BYTES, stream, a);
    }
#endif
}
```

```cpp
#include <hip/hip_runtime.h>
#include <cstdio>
#include <cstdint>

#ifndef MK_SINGLE
#define MK_SINGLE 1
#endif

#ifndef REP_SSD
#define REP_SSD 1
#endif
#ifndef REP_NA
#define REP_NA 1
#endif
#ifndef REP_GEMM
#define REP_GEMM 1
#endif
#define GAS __attribute__((address_space(1)))
#define LAS __attribute__((address_space(3)))
typedef unsigned short bf16_t;
typedef short bf16x8 __attribute__((ext_vector_type(8)));
typedef float f32x4 __attribute__((ext_vector_type(4)));
typedef float f32x2 __attribute__((ext_vector_type(2)));
typedef unsigned u32x4 __attribute__((ext_vector_type(4)));
typedef unsigned u32x2 __attribute__((ext_vector_type(2)));

constexpr int D = 1024, BATCH = 16, SEQ = 2048, DEPTH = 4, GRID_W = 64, CTX = 256;
constexpr int NLAT = BATCH * SEQ;
constexpr int NCTX = BATCH * CTX;
constexpr int NTOK = NLAT + NCTX;
constexpr int NPROJ = 3072;
constexpr int OFF_K = 512, OFF_V = 1024, OFF_Z = 1536, OFF_XBC = 2048;
constexpr int D_IN_PROJ = 3088;
constexpr int DFF = 2816, DFFE = 3584, NEXP = 8;
constexpr float ALPHA = 1.6817928305074290f;
constexpr float LN_EPS = 1e-5f, RMS_EPS = 1e-5f;
constexpr int MODW = 6 * D;

constexpr size_t MiB = 1u << 20;
constexpr size_t WS_CTL = 0, CTL_BYTES = 1 * MiB;
constexpr size_t WS_MOD = 1 * MiB;
constexpr size_t WS_ROUTE = 3 * MiB;
constexpr size_t WS_GATES = 4 * MiB;
constexpr size_t WS_LIST = 5 * MiB;
constexpr size_t WS_WDT = 7 * MiB;
constexpr size_t WS_WIN = 8 * MiB;
constexpr size_t WS_WOUT = 32 * MiB;
constexpr size_t WS_WFGU = 40 * MiB;
constexpr size_t WS_WFD = 62 * MiB;
constexpr size_t WS_WMGU = 73 * MiB;
constexpr size_t WS_WMD = 185 * MiB;
constexpr size_t WS_X = 241 * MiB;
constexpr size_t WS_H = 385 * MiB;
constexpr size_t WS_R = 457 * MiB;
constexpr size_t WS_PROJ = WS_R;
constexpr size_t WS_DT = WS_R + 216 * MiB;
constexpr size_t WS_YF = WS_R + 219 * MiB;
constexpr size_t WS_YB = WS_R + 291 * MiB;
constexpr size_t WS_MIX = WS_R + 363 * MiB;
constexpr size_t WS_HID = WS_R;
constexpr size_t WS_YP = WS_R + 270 * MiB;
constexpr size_t WS_U = WS_R + 435 * MiB;
constexpr size_t WS_END = WS_R + 507 * MiB;
constexpr int HALF_PAD = 2 * 18432 + 2048;
static_assert(WS_HID + (size_t)HALF_PAD * 3584 * 2 <= WS_YP && WS_YP + (size_t)2 * HALF_PAD * 1024 * 2 <= WS_END, "MoE buffers");

constexpr int CW_TMO = 0;
constexpr int CW_BAR = 4096;
constexpr int CW_CNT = 16384;

constexpr int LDS_STAGE = 131072;
constexpr int LDS_ROWOFF = 131072;
constexpr int LDS_MISC = 131072 + 18432;
constexpr int LDS_BYTES = 155648;

__device__ __forceinline__ unsigned f2bf(float f) { unsigned u = __builtin_bit_cast(unsigned, f); return (u + 0x7fffu + ((u >> 16) & 1u)) >> 16; }
__device__ __forceinline__ unsigned pk2(float lo, float hi) { return f2bf(lo) | (f2bf(hi) << 16); }
__device__ __forceinline__ float bf2f(unsigned short b) { return __builtin_bit_cast(float, ((unsigned)b) << 16); }
__device__ __forceinline__ float bflo(unsigned w) { return __builtin_bit_cast(float, w << 16); }
__device__ __forceinline__ float bfhi(unsigned w) { return __builtin_bit_cast(float, w & 0xffff0000u); }
__device__ __forceinline__ float silu_f(float v) { return v / (1.0f + __expf(-v)); }
__device__ __forceinline__ float wave_sum(float v) {
#pragma unroll
    for (int o = 1; o < 64; o <<= 1) v += __shfl_xor(v, o);
    return v;
}

namespace pg8 {
constexpr int BM = 256, BK = 64, HALF = 128, HTB = HALF * BK * 2, STAGE_BYTES = 8 * HTB, NXCD = 8, WGM = 8;
__host__ __device__ __forceinline__ int lds_byte(int r, int c) { const int st = (r >> 4) * 2 + (c >> 5), rr = r & 15, cc = c & 31, ob = rr * 64 + cc * 2; return st * 1024 + (ob ^ (((ob >> 9) & 1) << 5)); }
__host__ __device__ __forceinline__ void stage_rc(int b, int& R, int& C) { const int st = b / 1024, sb = b % 1024, swz = sb ^ (((sb >> 9) & 1) << 5); R = (st >> 1) * 16 + swz / 64; C = (st & 1) * 32 + (swz % 64) / 2; }
__host__ __device__ __forceinline__ int perm32(int rho) { const int n = rho >> 4, i = rho & 15; return 8 * (i >> 2) + 4 * n + (i & 3); }

struct Unit { int pm, pn; long bofs; };
struct Gemm { const bf16_t* A; const bf16_t* Bt; int K; };

__device__ __forceinline__ unsigned cvt_pk_bf16(float lo, float hi) { unsigned r; asm volatile("v_cvt_pk_bf16_f32 %0, %1, %2" : "=v"(r) : "v"(lo), "v"(hi)); return r; }

__device__ __forceinline__ bool static_tile(int i, int G, int c, int nM, int nN, int& pm, int& pn) {
    const int nwg = nM * nN; const long L = (long)i * G + c; if (L >= nwg) return false;
    int wgid = (int)L; { const int q = nwg / NXCD, r = nwg % NXCD, xcd = wgid % NXCD, off = wgid / NXCD; wgid = (xcd < r ? xcd * (q + 1) : r * (q + 1) + (xcd - r) * q) + off; }
    const int nig = WGM * nN, gid = wgid / nig, fm = gid * WGM, gsz = (nM - fm) < WGM ? (nM - fm) : WGM;
    pm = fm + ((wgid % nig) % gsz); pn = (wgid % nig) / gsz; return true;
}
struct DenseOrder {
    int nM, nN, G, c, K;
    __device__ __forceinline__ void init(int M, int N, int K_, int G_, int c_) { nM = M / BM; nN = N / BM; G = G_; c = c_; K = K_; }
    __device__ __forceinline__ bool next(int i, Unit& u) const { if (!static_tile(i, G, c, nM, nN, u.pm, u.pn)) return false; u.bofs = (long)u.pn * BM * K * 2; return true; }
    static constexpr bool GATHER = false;
    __device__ __forceinline__ long a_base(const Unit& u) const { return (long)u.pm * BM * K * 2; }
    __device__ __forceinline__ void a_offs(int, const Unit&, int, unsigned (&)[2][2]) const {}
};
template <bool GATHER_> struct MoeOrder {
    int nM, nN, G, c, K; int ts[9]; long estride; const LAS unsigned* rowoff;
    __device__ __forceinline__ int expert_of(int pm) const { int e = 0;
#pragma unroll
        for (int j = 1; j < 8; ++j) e += (pm >= ts[j]) ? 1 : 0; return e; }
    __device__ __forceinline__ bool next(int i, Unit& u) const { if (!static_tile(i, G, c, nM, nN, u.pm, u.pn)) return false; u.bofs = (long)expert_of(u.pm) * estride + (long)u.pn * BM * K * 2; return true; }
    static constexpr bool GATHER = GATHER_;
    __device__ __forceinline__ long a_base(const Unit& u) const { return GATHER_ ? 0l : (long)u.pm * BM * K * 2; }
    __device__ __forceinline__ void a_offs(int ui, const Unit&, int tid, unsigned (&o)[2][2]) const {
        if (GATHER_) {
#pragma unroll
            for (int i = 0; i < 2; ++i) { int R, C; stage_rc(tid * 16 + i * 8192, R, C);
#pragma unroll
                for (int h = 0; h < 2; ++h) o[h][i] = rowoff[ui * 256 + h * HALF + R] + (unsigned)(C * 2); }
        }
    }
};

struct EpiBf16 {
    static constexpr bool PERM = true;
    bf16_t* O; int ldc;
    __device__ __forceinline__ void operator()(const f32x4 (&acc)[2][2][4][2], const Unit& u, int wr, int wc, int fr, int fq) const {
        const int row0 = u.pm * BM + wr * 64 + fr; const int col0 = u.pn * BM + wc * 32 + 8 * fq;
#pragma unroll
        for (int ai = 0; ai < 2; ++ai)
#pragma unroll
            for (int m = 0; m < 4; ++m) { bf16_t* rowp = O + (size_t)(row0 + ai * HALF + m * 16) * ldc + col0;
#pragma unroll
                for (int bj = 0; bj < 2; ++bj) { const f32x4 v0 = acc[ai][bj][m][0], v1 = acc[ai][bj][m][1];
                    u32x4 w; w.x = cvt_pk_bf16(v0[0], v0[1]); w.y = cvt_pk_bf16(v0[2], v0[3]); w.z = cvt_pk_bf16(v1[0], v1[1]); w.w = cvt_pk_bf16(v1[2], v1[3]);
                    *(u32x4*)(rowp + bj * HALF) = w; } }
    }
};
struct EpiSwiGLU {
    static constexpr bool PERM = true;
    bf16_t* O; int ldc;
    __device__ __forceinline__ void operator()(const f32x4 (&acc)[2][2][4][2], const Unit& u, int wr, int wc, int fr, int fq) const {
        const int row0 = u.pm * BM + wr * 64 + fr; const int col0 = u.pn * HALF + wc * 32 + 8 * fq;
#pragma unroll
        for (int ai = 0; ai < 2; ++ai)
#pragma unroll
            for (int m = 0; m < 4; ++m) { bf16_t* rowp = O + (size_t)(row0 + ai * HALF + m * 16) * ldc + col0;
                float h[8];
#pragma unroll
                for (int n = 0; n < 2; ++n)
#pragma unroll
                    for (int j = 0; j < 4; ++j) { const float g = acc[ai][0][m][n][j], up = acc[ai][1][m][n][j]; h[n * 4 + j] = g * __builtin_amdgcn_rcpf(1.0f + __expf(-g)) * up; }
                u32x4 w; w.x = cvt_pk_bf16(h[0], h[1]); w.y = cvt_pk_bf16(h[2], h[3]); w.z = cvt_pk_bf16(h[4], h[5]); w.w = cvt_pk_bf16(h[6], h[7]);
                *(u32x4*)rowp = w; }
    }
};
struct EpiResid {
    static constexpr bool PERM = false;
    const float* base_lat; const float* base_ctx; float* out; const float* mod; int gate_off;
    __device__ __forceinline__ void operator()(const f32x4 (&acc)[2][2][4][2], const Unit& u, int wr, int wc, int fr, int fq) const {
        const int rt = u.pm * BM; const bool isctx = rt >= NLAT; const int bi = isctx ? 16 : (rt >> 11);
        const float* base = isctx ? base_ctx + (size_t)(rt - NLAT) * D : base_lat + (size_t)rt * D;
        float* o = out + (size_t)rt * D; const float* gt = mod + bi * MODW + gate_off;
        const int r0 = wr * 64 + fr, col0 = u.pn * BM + wc * 32 + 4 * fq;
        f32x4 gv[2][2];
#pragma unroll
        for (int bj = 0; bj < 2; ++bj)
#pragma unroll
            for (int n = 0; n < 2; ++n) gv[bj][n] = *(const f32x4*)(gt + col0 + bj * HALF + n * 16) + 1.0f;
#pragma unroll
        for (int ai = 0; ai < 2; ++ai)
#pragma unroll
            for (int m = 0; m < 4; ++m) { const size_t off = (size_t)(r0 + ai * HALF + m * 16) * D + col0;
#pragma unroll
                for (int bj = 0; bj < 2; ++bj)
#pragma unroll
                    for (int n = 0; n < 2; ++n) { const f32x4 bs = *(const f32x4*)(base + off + bj * HALF + n * 16);
                        *(f32x4*)(o + off + bj * HALF + n * 16) = bs * ALPHA + gv[bj][n] * acc[ai][bj][m][n]; }
                if (m & 1) asm volatile("" ::: "memory"); }
    }
};

template <class Epi, class Sched, bool ALIGN_EPI, bool SP2>
__device__ __forceinline__ void gemm_phase(LAS unsigned char* lds, const Gemm g, const Sched& S, const Epi& E) {
    int tid_ = threadIdx.x; asm volatile("" : "+v"(tid_));
    const int tid = tid_, wid = __builtin_amdgcn_readfirstlane(tid >> 6), lane = tid & 63, wr = wid >> 2, wc = wid & 3, fr = lane & 15, fq = lane >> 4;
    const int K = g.K, nt = K / BK;
    constexpr bool GA = Sched::GATHER;
    unsigned voffA[2], voffB[2];
#pragma unroll
    for (int i = 0; i < 2; ++i) { int R, C; stage_rc(tid * 16 + i * 8192, R, C); const int Rb = Epi::PERM ? ((R & ~31) + perm32(R & 31)) : R;
        voffA[i] = (unsigned)(R * K + C) * 2u; voffB[i] = (unsigned)(Rb * K + C) * 2u; }
    const size_t kstep = (size_t)(BK * 2);
    const size_t hstep = (size_t)HALF * K * 2;
    const unsigned ldsw = (unsigned)wid * 1024u;
    const int aoff = lds_byte(wr * 64 + fr, fq * 8), boff = lds_byte(wc * 32 + fr, fq * 8);
#define PG8_SA(b, h) (((b) * 2 + (h)) * HTB)
#define PG8_SB(b, h) ((4 + (b) * 2 + (h)) * HTB)
#define PG8_STAGE(bufoff, gbase, voff) do { _Pragma("unroll") for (int _i = 0; _i < 2; ++_i) \
        __builtin_amdgcn_global_load_lds((const unsigned*)((const char*)(gbase) + (voff)[_i]), (LAS unsigned*)(lds + (bufoff) + ldsw + _i * 8192), 16, 0, 0); } while (0)
#define PG8_LDA(dst, b, h) do { _Pragma("unroll") for (int m = 0; m < 4; ++m) _Pragma("unroll") for (int k = 0; k < 2; ++k) dst[m][k] = *(const LAS bf16x8*)(lds + PG8_SA(b, h) + aoff + m * 2048 + k * 1024); } while (0)
#define PG8_LDB(dst, b, h) do { _Pragma("unroll") for (int n = 0; n < 2; ++n) _Pragma("unroll") for (int k = 0; k < 2; ++k) dst[n][k] = *(const LAS bf16x8*)(lds + PG8_SB(b, h) + boff + n * 2048 + k * 1024); } while (0)
#define PG8_MMA(ai, bj, At, Bt) do { __builtin_amdgcn_s_setprio(1); _Pragma("unroll") for (int m = 0; m < 4; ++m) _Pragma("unroll") for (int n = 0; n < 2; ++n) _Pragma("unroll") for (int k = 0; k < 2; ++k) \
        acc[ai][bj][m][n] = __builtin_amdgcn_mfma_f32_16x16x32_bf16(Bt[n][k], At[m][k], acc[ai][bj][m][n], 0, 0, 0); __builtin_amdgcn_s_setprio(0); } while (0)
#define PG8_WAIT_V(n) asm volatile("s_waitcnt vmcnt(" #n ")" ::: "memory")
#define PG8_WAIT_L(n) asm volatile("s_waitcnt lgkmcnt(" #n ")" ::: "memory")
#define PG8_BAR __builtin_amdgcn_s_barrier()
#define PG8_SCHED __builtin_amdgcn_sched_barrier(0)
    Unit cur, nxt; int ui = 0;
    if (!S.next(0, cur)) return;
    f32x4 acc[2][2][4][2];
#pragma unroll
    for (int a = 0; a < 2; ++a)
#pragma unroll
        for (int b = 0; b < 2; ++b)
#pragma unroll
            for (int m = 0; m < 4; ++m)
#pragma unroll
                for (int n = 0; n < 2; ++n) acc[a][b][m][n] = (f32x4){0.f, 0.f, 0.f, 0.f};
    bf16x8 At[4][2], B0[2][2], B1[2][2];
    const char* Ab = (const char*)g.A + S.a_base(cur);
    unsigned oc[2][2];
    S.a_offs(0, cur, tid, oc);
    const size_t hsA = GA ? (size_t)0 : hstep;
#define PG8_STAGE_A(bufoff, gbase, h) do { if constexpr (GA) PG8_STAGE(bufoff, gbase, oc[h]); else PG8_STAGE(bufoff, (gbase) + (h) * hsA, voffA); } while (0)
    const char* cB = (const char*)g.Bt + cur.bofs;
    if constexpr (SP2) {
        PG8_STAGE(PG8_SB(0, 0), cB, voffB); PG8_STAGE(PG8_SB(0, 1), cB + hstep, voffB); PG8_STAGE_A(PG8_SA(0, 0), Ab, 0); PG8_STAGE_A(PG8_SA(0, 1), Ab, 1);
        if (wr == 1) PG8_BAR;
        PG8_WAIT_V(2); PG8_BAR;
        PG8_STAGE(PG8_SB(1, 0), cB + kstep, voffB); PG8_STAGE_A(PG8_SA(1, 0), Ab + kstep, 0); PG8_STAGE(PG8_SB(1, 1), cB + hstep + kstep, voffB);
        PG8_WAIT_V(6); PG8_BAR;
    } else {
        PG8_STAGE(PG8_SB(0, 0), cB, voffB); PG8_STAGE_A(PG8_SA(0, 0), Ab, 0); PG8_STAGE(PG8_SB(0, 1), cB + hstep, voffB); PG8_STAGE_A(PG8_SA(0, 1), Ab, 1);
        if (wr == 1) PG8_BAR;
        PG8_WAIT_V(4); PG8_BAR;
        PG8_STAGE(PG8_SB(1, 0), cB + kstep, voffB); PG8_STAGE_A(PG8_SA(1, 0), Ab + kstep, 0); PG8_STAGE(PG8_SB(1, 1), cB + hstep + kstep, voffB);
        PG8_WAIT_V(6); PG8_BAR;
    }
    for (;;) {
        const bool has_next = S.next(ui + 1, nxt);
        const char* nB = has_next ? (const char*)g.Bt + nxt.bofs : cB;
        for (int t = 0; t < nt; t += 2) {
            const bool last = (t == nt - 2);
            const char* a1 = Ab + (size_t)(t + 1) * kstep;
            const char* b2 = last ? nB : cB + (size_t)(t + 2) * kstep; const char* b3 = b2 + kstep;
            if constexpr (SP2) {
            PG8_LDB(B0, 0, 0); PG8_LDB(B1, 0, 1); PG8_SCHED; PG8_LDA(At, 0, 0); PG8_STAGE_A(PG8_SA(1, 1), a1, 1);
            if (last && has_next) { S.a_offs(ui + 1, nxt, tid, oc); Ab = (const char*)g.A + S.a_base(nxt); }
            const char* a2 = last ? Ab : Ab + (size_t)(t + 2) * kstep; const char* a3 = a2 + kstep;
            PG8_WAIT_V(8); PG8_WAIT_L(0); PG8_BAR; PG8_MMA(0, 0, At, B0); PG8_MMA(0, 1, At, B1); PG8_BAR; PG8_SCHED;
            PG8_LDA(At, 0, 1); PG8_STAGE(PG8_SB(0, 0), b2, voffB); PG8_STAGE(PG8_SB(0, 1), b2 + hstep, voffB); PG8_STAGE_A(PG8_SA(0, 0), a2, 0);
            PG8_WAIT_V(8); PG8_WAIT_L(0); PG8_BAR; PG8_MMA(1, 0, At, B0); PG8_MMA(1, 1, At, B1); PG8_BAR; PG8_SCHED;
            PG8_LDB(B0, 1, 0); PG8_LDB(B1, 1, 1); PG8_SCHED; PG8_LDA(At, 1, 0); PG8_STAGE_A(PG8_SA(0, 1), a2, 1);
            PG8_WAIT_V(8); PG8_WAIT_L(0); PG8_BAR; PG8_MMA(0, 0, At, B0); PG8_MMA(0, 1, At, B1); PG8_BAR; PG8_SCHED;
            PG8_LDA(At, 1, 1); PG8_STAGE(PG8_SB(1, 0), b3, voffB); PG8_STAGE(PG8_SB(1, 1), b3 + hstep, voffB); PG8_STAGE_A(PG8_SA(1, 0), a3, 0);
            PG8_WAIT_V(8); PG8_WAIT_L(0); PG8_BAR; PG8_MMA(1, 0, At, B0); PG8_MMA(1, 1, At, B1); PG8_BAR; PG8_SCHED;
            } else {
            PG8_LDB(B0, 0, 0); PG8_SCHED; PG8_LDA(At, 0, 0); PG8_STAGE_A(PG8_SA(1, 1), a1, 1);
            if (last && has_next) { S.a_offs(ui + 1, nxt, tid, oc); Ab = (const char*)g.A + S.a_base(nxt); }
            const char* a2 = last ? Ab : Ab + (size_t)(t + 2) * kstep; const char* a3 = a2 + kstep;
            PG8_WAIT_L(8); PG8_BAR; PG8_WAIT_L(0); PG8_MMA(0, 0, At, B0); PG8_BAR; PG8_SCHED;
            PG8_LDB(B1, 0, 1); PG8_STAGE(PG8_SB(0, 0), b2, voffB);
            PG8_BAR; PG8_WAIT_L(0); PG8_MMA(0, 1, At, B1); PG8_BAR;
            PG8_LDA(At, 0, 1); PG8_STAGE_A(PG8_SA(0, 0), a2, 0);
            PG8_BAR; PG8_WAIT_L(0); PG8_MMA(1, 0, At, B0); PG8_BAR; PG8_SCHED;
            PG8_STAGE(PG8_SB(0, 1), b2 + hstep, voffB);
            PG8_WAIT_V(6); PG8_BAR; PG8_MMA(1, 1, At, B1); PG8_BAR;
            PG8_LDB(B0, 1, 0); PG8_SCHED; PG8_LDA(At, 1, 0); PG8_STAGE_A(PG8_SA(0, 1), a2, 1);
            PG8_WAIT_L(8); PG8_BAR; PG8_WAIT_L(0); PG8_MMA(0, 0, At, B0); PG8_BAR; PG8_SCHED;
            PG8_LDB(B1, 1, 1); PG8_STAGE(PG8_SB(1, 0), b3, voffB);
            PG8_BAR; PG8_WAIT_L(0); PG8_MMA(0, 1, At, B1); PG8_BAR;
            PG8_LDA(At, 1, 1); PG8_STAGE_A(PG8_SA(1, 0), a3, 0);
            PG8_BAR; PG8_WAIT_L(0); PG8_MMA(1, 0, At, B0); PG8_BAR; PG8_SCHED;
            PG8_STAGE(PG8_SB(1, 1), b3 + hstep, voffB);
            PG8_WAIT_V(6); PG8_BAR; PG8_MMA(1, 1, At, B1); PG8_BAR;
            }
        }
        if constexpr (ALIGN_EPI) { if (wr == 0) PG8_BAR; }
        E(acc, cur, wr, wc, fr, fq);
        if (!has_next) break;
#pragma unroll
        for (int a = 0; a < 2; ++a)
#pragma unroll
            for (int b = 0; b < 2; ++b)
#pragma unroll
                for (int m = 0; m < 4; ++m)
#pragma unroll
                    for (int n = 0; n < 2; ++n) acc[a][b][m][n] = (f32x4){0.f, 0.f, 0.f, 0.f};
        cur = nxt; cB = nB; ++ui;
        if constexpr (ALIGN_EPI) { if (wr == 1) PG8_BAR; }
    }
    PG8_WAIT_V(0);
    if constexpr (!ALIGN_EPI) { if (wr == 0) PG8_BAR; }
    PG8_BAR;
#undef PG8_SA
#undef PG8_SB
#undef PG8_STAGE
#undef PG8_STAGE_A
#undef PG8_LDA
#undef PG8_LDB
#undef PG8_MMA
#undef PG8_WAIT_V
#undef PG8_WAIT_L
#undef PG8_BAR
#undef PG8_SCHED
}
}

#define XB_TMO      128
#define XB_XCNT(j)  (256  + 64 * (j))
#define XB_XSUB(j)  (1280 + 64 * (j))
#define XB_XGEN(j)  (2304 + 64 * (j))
#define XB_TOP      3328
#define XB_TOPGEN   3392
#define XCD_BAR_WORDS 3456
#define XB_SPIN_CAP (1u << 18)
__device__ __forceinline__ unsigned xb_ld(unsigned* p)              { return __hip_atomic_load(p, __ATOMIC_RELAXED, __HIP_MEMORY_SCOPE_AGENT); }
__device__ __forceinline__ unsigned xb_add(unsigned* p, unsigned v) { return __hip_atomic_fetch_add(p, v, __ATOMIC_RELAXED, __HIP_MEMORY_SCOPE_AGENT); }
__device__ __forceinline__ unsigned xb_xcc_id() { return (unsigned)__builtin_amdgcn_s_getreg((3 << 11) | 20) & 0xFu; }
#define XB_SPIN(cond, bar) do { unsigned _sp = 0; while (cond) { __builtin_amdgcn_s_sleep(1); \
    if ((++_sp & 255u) == 0u) { if (xb_ld(&(bar)[XB_TMO])) break; if (_sp > XB_SPIN_CAP) { atomicAdd(&(bar)[XB_TMO], 1u); break; } } } } while (0)
struct XcdBarrier { unsigned* bar; unsigned x; volatile LAS unsigned* st; };
__device__ __forceinline__ XcdBarrier xcd_barrier_post(unsigned* bar, volatile LAS unsigned* st) {
    XcdBarrier b; b.bar = bar; b.x = xb_xcc_id(); b.st = st;
    if (threadIdx.x == 0) (void)xb_add(&bar[XB_XCNT(b.x)], 1u);
    return b;
}
__device__ __forceinline__ void xcd_barrier_complete(unsigned* bar, unsigned x, unsigned& nloc, unsigned& nx) {
    const unsigned G = gridDim.x * gridDim.y * gridDim.z;
    unsigned sum, cnt, mine, sp = 0u;
    for (;;) {
        sum = 0u; cnt = 0u; mine = 0u;
#pragma unroll
        for (unsigned j = 0; j < 16; ++j) { const unsigned c = xb_ld(&bar[XB_XCNT(j)]); sum += c; cnt += (c > 0u) ? 1u : 0u; mine = (j == x) ? c : mine; }
        if (sum == G) break;
        __builtin_amdgcn_s_sleep(1);
        if ((++sp & 255u) == 0u) { if (xb_ld(&bar[XB_TMO])) break; if (sp > XB_SPIN_CAP) { atomicAdd(&bar[XB_TMO], 1u); break; } }
    }
    nloc = mine > 0u ? mine : 1u; nx = cnt > 0u ? cnt : 1u;
}
__device__ __forceinline__ void xcd_barrier(const XcdBarrier& b) {
    asm volatile("s_waitcnt vmcnt(0)" ::: "memory");
    __syncthreads();
    if (threadIdx.x == 0) {
        unsigned* bar = b.bar;
        __builtin_amdgcn_s_waitcnt(0);
        unsigned nloc = b.st[0], nx = b.st[1];
        if (nloc == 0u) { xcd_barrier_complete(bar, b.x, nloc, nx); b.st[0] = nloc; b.st[1] = nx; }
        const unsigned old = xb_add(&bar[XB_XSUB(b.x)], 1u);
        const unsigned gen = old / nloc;
        if (old + 1u == (gen + 1u) * nloc) {
            __builtin_amdgcn_fence(__ATOMIC_RELEASE, "agent");
            asm volatile("s_waitcnt vmcnt(0)" ::: "memory");
            const unsigned og = xb_add(&bar[XB_TOP], 1u);
            const unsigned tg = og / nx;
            if (og + 1u == (tg + 1u) * nx) xb_add(&bar[XB_TOPGEN], 1u);
            else XB_SPIN(xb_ld(&bar[XB_TOPGEN]) == tg, bar);
            __builtin_amdgcn_fence(__ATOMIC_ACQUIRE, "agent");
            xb_add(&bar[XB_XGEN(b.x)], 1u);
            asm volatile("s_waitcnt vmcnt(0)" ::: "memory");
        } else {
            XB_SPIN(xb_ld(&bar[XB_XGEN(b.x)]) == gen, bar);
            __builtin_amdgcn_fence(__ATOMIC_ACQUIRE, "agent");
            asm volatile("s_waitcnt vmcnt(0)" ::: "memory");
        }
    }
    __syncthreads();
}

constexpr int NT = 512, NWAVES = 8;
struct Args { const float* in[24]; float* out; unsigned char* ws; int ph_lo, ph_hi; };
enum { I_X = 0, I_C, I_CTX, I_CCTX, I_WMOD, I_BMOD, I_WIN, I_WOUT, I_RPB, I_CONVW, I_CONVB, I_DTB, I_ALOG, I_DSKIP, I_NORMW, I_LNG, I_LNB, I_FG, I_FU, I_FD, I_RW, I_MG, I_MU, I_MD };
struct Frame {
    LAS unsigned char* lds;
    const float* const* in; float* out; unsigned char* ws;
    int tid, lane, wave, bid, G, gw, NGW;
};
#define LDS_WAIT() asm volatile("s_waitcnt lgkmcnt(0)" ::: "memory")
__device__ __forceinline__ Frame fresh(const Frame& F0) {
    Frame F = F0; int z; asm volatile("s_mov_b32 %0, 0" : "=s"(z)); F.ws = F0.ws + z; F.in = F0.in + z; F.out = F0.out + z;
    int t = F0.tid; asm volatile("" : "+v"(t)); F.tid = t; F.lane = t & 63; return F;
}

__device__ __forceinline__ void conv_item(const float* W, int ldn, int k0, int n0, bf16_t* dst, int K, int drow0, LAS float* scr, int lane) {
#pragma unroll 8
    for (int i = 0; i < 32; ++i) { const int kk = 2 * i + (lane >> 5); scr[kk * 33 + (lane & 31)] = W[(size_t)(k0 + kk) * ldn + n0 + (lane & 31)]; }
    LDS_WAIT(); asm volatile("" ::: "memory");
    const int c = lane & 7;
#pragma unroll
    for (int j = 0; j < 4; ++j) { const int n = (lane >> 3) + 8 * j; const LAS float* s = scr + (8 * c) * 33 + n;
        u32x4 o; o.x = pk2(s[0 * 33], s[1 * 33]); o.y = pk2(s[2 * 33], s[3 * 33]); o.z = pk2(s[4 * 33], s[5 * 33]); o.w = pk2(s[6 * 33], s[7 * 33]);
        *(u32x4*)(dst + (size_t)(drow0 + n) * K + k0 + 8 * c) = o; }
    LDS_WAIT(); asm volatile("" ::: "memory");
}
__device__ __forceinline__ void conv_seg(const Frame& F, const float* W, int K, int ldn, int ncols, bf16_t* dst, int mode, int& rot) {
    LAS float* scr = (LAS float*)(F.lds + F.wave * 16384);
    const int nblk = ncols / 32, nitems = (K / 64) * nblk;
    int start = F.gw - rot; if (start < 0) start += F.NGW;
    for (int it = start; it < nitems; it += F.NGW) {
        const int kb = it / nblk, nb = it % nblk, n0 = nb * 32;
        const int drow0 = (mode == 0) ? n0 : ((n0 >> 7) * 256 + (n0 & 127) + (mode == 2 ? 128 : 0));
        conv_item(W, ldn, kb * 64, n0, dst, K, drow0, scr, F.lane);
    }
    rot = (rot + nitems) % F.NGW;
}
__device__ __forceinline__ void conv_moe(const Frame& F, int slot, int& rot) {
    bf16_t* gu = (bf16_t*)(F.ws + WS_WMGU); bf16_t* dn = (bf16_t*)(F.ws + WS_WMD);
    for (int e = 0; e < NEXP; ++e) {
        const size_t so = ((size_t)slot * NEXP + e) * (size_t)D * DFFE;
        conv_seg(F, F.in[I_MG] + so, D, DFFE, DFFE, gu + (size_t)e * 2 * DFFE * D, 1, rot);
        conv_seg(F, F.in[I_MU] + so, D, DFFE, DFFE, gu + (size_t)e * 2 * DFFE * D, 2, rot);
        conv_seg(F, F.in[I_MD] + so, DFFE, D, D, dn + (size_t)e * D * DFFE, 0, rot);
    }
}

__device__ __forceinline__ void p_pro_a(const Frame& F) {
    {
        LAS float* sc = (LAS float*)F.lds; LAS float* red = sc + 17 * 1024;
        const float* c = F.in[I_C]; const float* cc = F.in[I_CCTX];
        for (int i = F.tid; i < 17 * 1024; i += NT) { const int r = i >> 10, k = i & 1023; const float v = (r < 16) ? c[r * 1024 + k] : cc[k]; sc[i] = silu_f(v); }
        __syncthreads();
        float* MOD = (float*)(F.ws + WS_MOD);
        const int col = F.tid & 63, ks = F.tid >> 6;
        for (int u = F.bid; u < 4 * 96; u += F.G) {
            const int l = u / 96, cb = u % 96;
            const float* W = F.in[I_WMOD] + (size_t)l * D * MODW + cb * 64 + col;
            float acc[17];
#pragma unroll
            for (int r = 0; r < 17; ++r) acc[r] = 0.f;
            for (int k = ks * 128; k < ks * 128 + 128; ++k) { const float w = W[(size_t)k * MODW];
#pragma unroll
                for (int r = 0; r < 17; ++r) acc[r] += sc[r * 1024 + k] * w; }
#pragma unroll
            for (int r = 0; r < 17; ++r) red[(ks * 17 + r) * 64 + col] = acc[r];
            __syncthreads();
            for (int i = F.tid; i < 17 * 64; i += NT) { const int r = i >> 6, c2 = i & 63; float s = 0.f;
#pragma unroll
                for (int k2 = 0; k2 < 8; ++k2) s += red[(k2 * 17 + r) * 64 + c2];
                MOD[(size_t)(l * 17 + r) * MODW + cb * 64 + c2] = s + F.in[I_BMOD][l * MODW + cb * 64 + c2]; }
            __syncthreads();
        }
    }
    int rot = 0;
    for (int l = 0; l < DEPTH; ++l) {
        conv_seg(F, F.in[I_WIN] + (size_t)l * D * D_IN_PROJ, D, D_IN_PROJ, NPROJ, (bf16_t*)(F.ws + WS_WIN) + (size_t)l * NPROJ * D, 0, rot);
        conv_seg(F, F.in[I_WOUT] + (size_t)l * D * D, D, D, D, (bf16_t*)(F.ws + WS_WOUT) + (size_t)l * D * D, 0, rot);
    }
    for (int s = 0; s < 2; ++s) {
        conv_seg(F, F.in[I_FG] + (size_t)s * D * DFF, D, DFF, DFF, (bf16_t*)(F.ws + WS_WFGU) + (size_t)s * 2 * DFF * D, 1, rot);
        conv_seg(F, F.in[I_FU] + (size_t)s * D * DFF, D, DFF, DFF, (bf16_t*)(F.ws + WS_WFGU) + (size_t)s * 2 * DFF * D, 2, rot);
        conv_seg(F, F.in[I_FD] + (size_t)s * DFF * D, DFF, D, D, (bf16_t*)(F.ws + WS_WFD) + (size_t)s * D * DFF, 0, rot);
    }
    conv_moe(F, 0, rot);
    { bf16_t* wdt = (bf16_t*)(F.ws + WS_WDT);
      for (int i = F.bid * NT + F.tid; i < DEPTH * 16 * D; i += F.G * NT) { const int l = i / (16 * D), n = (i / D) & 15, k = i % D;
          wdt[i] = (bf16_t)f2bf(F.in[I_WIN][((size_t)l * D + k) * D_IN_PROJ + NPROJ + n]); } }
}

__device__ __forceinline__ void row_load(const float* p, int lane, f32x4 (&v)[4]) {
#pragma unroll
    for (int j = 0; j < 4; ++j) v[j] = *(const f32x4*)(p + 4 * lane + 256 * j);
}
__device__ __forceinline__ void row_store(float* p, int lane, const f32x4 (&v)[4]) {
#pragma unroll
    for (int j = 0; j < 4; ++j) *(f32x4*)(p + 4 * lane + 256 * j) = v[j];
}
__device__ __forceinline__ void row_mod_store(bf16_t* hrow, int lane, const f32x4 (&v)[4], const float* sh, const float* sc, f32x4 (&hv)[4]) {
#pragma unroll
    for (int j = 0; j < 4; ++j) { const f32x4 a = *(const f32x4*)(sc + 4 * lane + 256 * j), b = *(const f32x4*)(sh + 4 * lane + 256 * j);
        hv[j] = v[j] * (a + 1.0f) + b;
        u32x2 w; w.x = pk2(hv[j][0], hv[j][1]); w.y = pk2(hv[j][2], hv[j][3]);
        *(u32x2*)(hrow + 4 * lane + 256 * j) = w; }
}
__device__ __forceinline__ void row_ln(f32x4 (&v)[4], const float* g, const float* b, int lane) {
    float s = 0.f;
#pragma unroll
    for (int j = 0; j < 4; ++j) s += (v[j][0] + v[j][1]) + (v[j][2] + v[j][3]);
    const float mean = wave_sum(s) * (1.0f / D); float q = 0.f;
#pragma unroll
    for (int j = 0; j < 4; ++j) { v[j] = v[j] - mean; q += (v[j][0] * v[j][0] + v[j][1] * v[j][1]) + (v[j][2] * v[j][2] + v[j][3] * v[j][3]); }
    const float rstd = 1.0f / sqrtf(wave_sum(q) * (1.0f / D) + LN_EPS);
#pragma unroll
    for (int j = 0; j < 4; ++j) { const f32x4 gg = *(const f32x4*)(g + 4 * lane + 256 * j), bb = *(const f32x4*)(b + 4 * lane + 256 * j); v[j] = v[j] * rstd * gg + bb; }
}
__device__ __forceinline__ int mod_row_of(int row) { return row < NLAT ? (row >> 11) : 16; }

__device__ __forceinline__ void p_pro_b(const Frame& F) {
    const float* MOD = (const float*)(F.ws + WS_MOD); bf16_t* H = (bf16_t*)(F.ws + WS_H);
    for (int row = F.gw; row < NTOK; row += F.NGW) {
        const float* src = row < NLAT ? F.in[I_X] + (size_t)row * D : F.in[I_CTX] + (size_t)(row - NLAT) * D;
        f32x4 v[4], hv[4]; row_load(src, F.lane, v);
        const float* m = MOD + (size_t)mod_row_of(row) * MODW;
        row_mod_store(H + (size_t)row * D, F.lane, v, m, m + D, hv);
    }
}

__device__ __forceinline__ void p_inproj(const Frame& F, int layer) {
    const bf16_t* H = (const bf16_t*)(F.ws + WS_H);
    {
        const bf16_t* wdt = (const bf16_t*)(F.ws + WS_WDT) + (size_t)layer * 16 * D; float* DT = (float*)(F.ws + WS_DT);
        const int fr = F.lane & 15, fq = F.lane >> 4;
        for (int g = F.gw; g < NTOK / 16; g += F.NGW) {
            f32x4 acc = {0.f, 0.f, 0.f, 0.f};
            const bf16_t* ap = H + (size_t)(g * 16 + fr) * D + fq * 8; const bf16_t* bp = wdt + (size_t)fr * D + fq * 8;
#pragma unroll 8
            for (int ks = 0; ks < 32; ++ks) { const bf16x8 a = *(const bf16x8*)(ap + ks * 32), b = *(const bf16x8*)(bp + ks * 32);
                acc = __builtin_amdgcn_mfma_f32_16x16x32_bf16(a, b, acc, 0, 0, 0); }
#pragma unroll
            for (int r = 0; r < 4; ++r) DT[(size_t)(g * 16 + fq * 4 + r) * 16 + fr] = acc[r];
        }
    }
    pg8::Gemm g{H, (const bf16_t*)(F.ws + WS_WIN) + (size_t)layer * NPROJ * D, D};
    pg8::DenseOrder S; S.init(NTOK, NPROJ, D, F.G, F.bid);
    pg8::EpiBf16 E{(bf16_t*)(F.ws + WS_PROJ), NPROJ};
    pg8::gemm_phase<pg8::EpiBf16, pg8::DenseOrder, true, true>(F.lds, g, S, E);
}

typedef short s16x4 __attribute__((ext_vector_type(4)));
__device__ __forceinline__ s16x4 lds_tr16(LAS const unsigned char* p) { return __builtin_bit_cast(s16x4, __builtin_amdgcn_ds_read_tr16_b64_v4i16((LAS s16x4*)p)); }
constexpr int NA_KS = 144;
constexpr float LOG2E = 1.4426950408889634f;
__device__ __forceinline__ void na_unit(const Frame& F, int layer, int b, int h, int mode, int m) {
    LAS unsigned char* KV = F.lds;
    LAS float* rp = (LAS float*)(F.lds + 120832);
    const bf16_t* PROJ = (const bf16_t*)(F.ws + WS_PROJ); bf16_t* MIX = (bf16_t*)(F.ws + WS_MIX);
    const int tid = F.tid, lane = F.lane, w = F.wave, q16 = lane & 15, g = lane >> 4;
    int rbase = 0, nk = 0;
    if (mode == 0) { rbase = 2 * m - 4; rbase = rbase < 0 ? 0 : (rbase > 24 ? 24 : rbase); nk = 32 - rbase; nk = nk > 9 ? 9 : nk; }
    const int kfirst = (mode == 0) ? 0 : 576 * 8, nloc8 = nk * 64 * 8;
    __syncthreads();
    for (int i = tid + kfirst; i < 832 * 8; i += NT) { const int key = i >> 3, ch = i & 7;
        if (key < 576 && i >= nloc8) continue;
        const int grow = key < 576 ? b * SEQ + rbase * 64 + key : NLAT + b * CTX + (key - 576);
        *(LAS u32x4*)(KV + key * NA_KS + ch * 16) = *(const u32x4*)(PROJ + (size_t)grow * NPROJ + OFF_K + h * 64 + ch * 8); }
    if (mode == 0 && tid < 465) rp[tid] = F.in[I_RPB][(size_t)(layer * 8 + h) * 465 + tid] * LOG2E;
    __syncthreads();
    int i = 0, j0 = 0, hs = 0, kr0 = 0, qrow;
    if (mode == 0) { i = 2 * m + (w >> 2); j0 = (w & 3) * 16; qrow = b * SEQ + i * 64 + j0; hs = j0 - 8; hs = hs < 0 ? 0 : (hs > 32 ? 32 : hs);
        int r0 = i - 4; r0 = r0 < 0 ? 0 : (r0 > 24 ? 24 : r0); kr0 = r0 - rbase; }
    else qrow = NLAT + b * CTX + m * 128 + w * 16;
    bf16x8 qf[2];
#pragma unroll
    for (int ks = 0; ks < 2; ++ks) qf[ks] = *(const bf16x8*)(PROJ + (size_t)(qrow + q16) * NPROJ + h * 64 + ks * 32 + g * 8);
    f32x4 S[32];
    const LAS unsigned char* kb = KV + q16 * NA_KS + g * 16;
    if (mode == 0) {
        const int j = j0 + q16; int cs = j - 8; cs = cs < 0 ? 0 : (cs > 48 ? 48 : cs);
        const int rb0 = (kr0 + rbase) - i + 7;
#pragma unroll
        for (int tl = 0; tl < 16; ++tl) { const int kr = tl >> 1, half = tl & 1; const int kidx0 = (kr0 + kr) * 64 + hs + 16 * half;
            f32x4 a = {0.f, 0.f, 0.f, 0.f};
#pragma unroll
            for (int ks = 0; ks < 2; ++ks) { const bf16x8 kf = *(const LAS bf16x8*)(kb + kidx0 * NA_KS + ks * 64); a = __builtin_amdgcn_mfma_f32_16x16x32_bf16(kf, qf[ks], a, 0, 0, 0); }
#pragma unroll
            for (int r = 0; r < 4; ++r) { const int kc = hs + 16 * half + 4 * g + r; const bool inw = (kc >= cs) && (kc < cs + 16);
                int cbi = kc - j + 15; cbi = cbi < 0 ? 0 : (cbi > 30 ? 30 : cbi);
                a[r] = inw ? a[r] * (0.125f * LOG2E) + rp[(rb0 + kr) * 31 + cbi] : -INFINITY; }
            S[tl] = a; }
    } else {
#pragma unroll
        for (int tl = 0; tl < 16; ++tl) S[tl] = (f32x4){-INFINITY, -INFINITY, -INFINITY, -INFINITY};
    }
#pragma unroll
    for (int tc = 0; tc < 16; ++tc) { const int kidx0 = 576 + 16 * tc; f32x4 a = {0.f, 0.f, 0.f, 0.f};
#pragma unroll
        for (int ks = 0; ks < 2; ++ks) { const bf16x8 kf = *(const LAS bf16x8*)(kb + kidx0 * NA_KS + ks * 64); a = __builtin_amdgcn_mfma_f32_16x16x32_bf16(kf, qf[ks], a, 0, 0, 0); }
        S[16 + tc] = a * (0.125f * LOG2E); }
    float mx = -INFINITY;
#pragma unroll
    for (int t = 0; t < 32; ++t) mx = fmaxf(fmaxf(fmaxf(S[t][0], S[t][1]), fmaxf(S[t][2], S[t][3])), mx);
    mx = fmaxf(mx, __shfl_xor(mx, 16)); mx = fmaxf(mx, __shfl_xor(mx, 32));
    float sum = 0.f; u32x4 P[16];
#pragma unroll
    for (int kk = 0; kk < 16; ++kk) { float e[8];
#pragma unroll
        for (int r = 0; r < 4; ++r) { e[r] = __builtin_amdgcn_exp2f(S[2 * kk][r] - mx); e[4 + r] = __builtin_amdgcn_exp2f(S[2 * kk + 1][r] - mx); }
        sum += ((e[0] + e[1]) + (e[2] + e[3])) + ((e[4] + e[5]) + (e[6] + e[7]));
        P[kk].x = pg8::cvt_pk_bf16(e[0], e[1]); P[kk].y = pg8::cvt_pk_bf16(e[2], e[3]); P[kk].z = pg8::cvt_pk_bf16(e[4], e[5]); P[kk].w = pg8::cvt_pk_bf16(e[6], e[7]); }
    sum += __shfl_xor(sum, 16); sum += __shfl_xor(sum, 32);
    const float inv = 1.0f / sum;
    __syncthreads();
    for (int i2 = tid + kfirst; i2 < 832 * 8; i2 += NT) { const int key = i2 >> 3, ch = i2 & 7;
        if (key < 576 && i2 >= nloc8) continue;
        const int grow = key < 576 ? b * SEQ + rbase * 64 + key : NLAT + b * CTX + (key - 576);
        *(LAS u32x4*)(KV + key * NA_KS + ch * 16) = *(const u32x4*)(PROJ + (size_t)grow * NPROJ + OFF_V + h * 64 + ch * 8); }
    __syncthreads();
    f32x4 o[4];
#pragma unroll
    for (int dt = 0; dt < 4; ++dt) o[dt] = (f32x4){0.f, 0.f, 0.f, 0.f};
    const LAS unsigned char* vb = KV + (4 * g + (q16 >> 2)) * NA_KS + (q16 & 3) * 8;
#pragma unroll
    for (int kk = 0; kk < 16; ++kk) {
        if (kk < 8 && mode != 0) continue;
        const int kidx0 = (kk < 8) ? (kr0 + kk) * 64 + hs : 576 + 32 * (kk - 8);
        const bf16x8 pa = __builtin_bit_cast(bf16x8, P[kk]);
#pragma unroll
        for (int dt = 0; dt < 4; ++dt) { const s16x4 lo = lds_tr16(vb + kidx0 * NA_KS + dt * 32), hi = lds_tr16(vb + (kidx0 + 16) * NA_KS + dt * 32);
            const bf16x8 vf = {lo[0], lo[1], lo[2], lo[3], hi[0], hi[1], hi[2], hi[3]};
            o[dt] = __builtin_amdgcn_mfma_f32_16x16x32_bf16(pa, vf, o[dt], 0, 0, 0); }
    }
#pragma unroll
    for (int r = 0; r < 4; ++r) { const float ir = __shfl(inv, 4 * g + r);
        bf16_t* op = MIX + (size_t)(qrow + 4 * g + r) * D + h * 64 + q16;
#pragma unroll
        for (int dt = 0; dt < 4; ++dt) op[dt * 16] = (bf16_t)f2bf(o[dt][r] * ir); }
}

__device__ __forceinline__ void ssd_prepass_unit(const Frame& F, int layer, int u) {
    const bf16_t* PROJ = (const bf16_t*)(F.ws + WS_PROJ); bf16_t* U = (bf16_t*)(F.ws + WS_U); float* DT = (float*)(F.ws + WS_DT);
    int rowbase, t0, L; bool lat;
    if (u < NLAT / 16) { rowbase = (u >> 7) * SEQ; t0 = (u & 127) * 16; L = SEQ; lat = true; }
    else { const int v = u - NLAT / 16; rowbase = NLAT + (v >> 4) * CTX; t0 = (v & 15) * 16; L = CTX; lat = false; }
    const int c0 = 2 * F.tid;
    const float* cwp = F.in[I_CONVW] + (size_t)layer * 5 * 1024 + c0;
    f32x2 wj[5];
#pragma unroll
    for (int j = 0; j < 5; ++j) wj[j] = *(const f32x2*)(cwp + j * 1024);
    const f32x2 bj = *(const f32x2*)(F.in[I_CONVB] + (size_t)layer * 1024 + c0);
    if (F.tid < 256) { const int r = F.tid >> 4, j = F.tid & 15; float* p = DT + (size_t)(rowbase + t0 + r) * 16 + j;
        const float x = *p + F.in[I_DTB][layer * 16 + j]; *p = x > 20.f ? x : log1pf(__expf(x)); }
    const int lc = 2 * F.lane, hf = lc >> 6, role = (lc >> 5) & 1, n = lc & 31;
    const float if0 = __builtin_amdgcn_exp2f(-(float)n * (13.287712379549449f / 32.0f)) * 0.15915494309189535f;
    const float if1 = __builtin_amdgcn_exp2f(-(float)(n + 1) * (13.287712379549449f / 32.0f)) * 0.15915494309189535f;
    const bool rope = lat && (F.wave >= 4);
    unsigned win[5];
#pragma unroll
    for (int j = 0; j < 4; ++j) { const int t = t0 - 2 + j; win[j] = (t >= 0 && t < L) ? *(const unsigned*)(PROJ + (size_t)(rowbase + t) * NPROJ + OFF_XBC + c0) : 0u; }
#pragma unroll 4
    for (int tt = 0; tt < 16; ++tt) {
        const int t = t0 + tt + 2; win[4] = (t < L) ? *(const unsigned*)(PROJ + (size_t)(rowbase + t) * NPROJ + OFF_XBC + c0) : 0u;
        float a0 = bj[0], a1 = bj[1];
#pragma unroll
        for (int j = 0; j < 5; ++j) { a0 += wj[j][0] * bflo(win[j]); a1 += wj[j][1] * bfhi(win[j]); }
        float u0 = silu_f(a0), u1 = silu_f(a1);
        if (rope) {
            const int tk = t0 + tt; const float pos = (float)(hf ? (tk & 63) : (tk >> 6));
            const float o0 = __shfl_xor(u0, 16), o1 = __shfl_xor(u1, 16);
            const float s0 = __builtin_amdgcn_sinf(pos * if0), c0f = __builtin_amdgcn_cosf(pos * if0), s1 = __builtin_amdgcn_sinf(pos * if1), c1f = __builtin_amdgcn_cosf(pos * if1);
            u0 = role ? (o0 * s0 + u0 * c0f) : (u0 * c0f - o0 * s0);
            u1 = role ? (o1 * s1 + u1 * c1f) : (u1 * c1f - o1 * s1);
        }
        *(unsigned*)(U + (size_t)(rowbase + t0 + tt) * 1024 + c0) = pk2(u0, u1);
#pragma unroll
        for (int j = 0; j < 4; ++j) win[j] = win[j + 1];
    }
}

constexpr int S_CQ = 0, S_BQ = 17408, S_BT = 34816, S_XT = 53248, S_MQ = 62464, S_HB = 71680, S_MISC = 106496;
__device__ __forceinline__ void ssd_mfma_unit(const Frame& F, int layer, int b, int h, int dir) {
    const int g = h >> 2, tid = F.tid, lane = F.lane, w = F.wave, q16 = lane & 15, gq = lane >> 4;
    const bf16_t* U = (const bf16_t*)(F.ws + WS_U); const float* DTS = (const float*)(F.ws + WS_DT);
    float* Y = (float*)(F.ws + (dir ? WS_YB : WS_YF));
    const float aneg = -__expf(F.in[I_ALOG][layer * 16 + dir * 8 + h]), dsk = F.in[I_DSKIP][layer * 8 + h];
    LAS unsigned char* L = F.lds;
    __syncthreads();
    for (int i = tid; i < 64 * 272 / 16; i += NT) *(LAS u32x4*)(L + S_HB + i * 16) = (u32x4){0u, 0u, 0u, 0u};
    f32x4 Hacc[4];
#pragma unroll
    for (int j = 0; j < 4; ++j) Hacc[j] = (f32x4){0.f, 0.f, 0.f, 0.f};
    u32x4 px, pb[2], pc[2];
    const int xl = tid >> 3, xc = tid & 7;
#define SSD_ROW(ci_, l_) ({ const int s_ = (ci_) < 4 ? 0 : 1, k_ = s_ ? (ci_) - 4 : (ci_), nc_ = s_ ? 32 : 4, c_ = dir ? nc_ - 1 - k_ : k_; \
        (s_ ? b * SEQ : NLAT + b * CTX) + c_ * 64 + (dir ? 63 - (l_) : (l_)); })
#define SSD_PREFETCH(ci_) do { px = *(const u32x4*)(U + (size_t)SSD_ROW(ci_, xl) * 1024 + h * 64 + xc * 8); \
        _Pragma("unroll") for (int k_ = 0; k_ < 2; ++k_) { const int it_ = tid + NT * k_, l_ = it_ >> 4, c16_ = it_ & 15; const size_t ro_ = (size_t)SSD_ROW(ci_, l_) * 1024; \
            pb[k_] = *(const u32x4*)(U + ro_ + 512 + g * 128 + c16_ * 8); pc[k_] = *(const u32x4*)(U + ro_ + 768 + g * 128 + c16_ * 8); } } while (0)
    SSD_PREFETCH(0);
    int par = 0;
    for (int ci = 0; ci < 36; ++ci) {
        LAS float* misc = (LAS float*)(L + S_MISC) + par * 272;
        if (w == 0) {
            const float dt = DTS[(size_t)SSD_ROW(ci, lane) * 16 + dir * 8 + h]; float cs = dt * aneg;
#pragma unroll
            for (int o = 1; o < 64; o <<= 1) { const float v = __shfl_up(cs, o); cs += (lane >= o) ? v : 0.f; }
            const float tot = __shfl(cs, 63);
            misc[lane] = dt; misc[64 + lane] = cs; misc[128 + lane] = __expf(cs); misc[192 + lane] = __expf(tot - cs) * dt; if (lane == 0) misc[256] = __expf(tot);
        }
        __syncthreads();
        {
            const unsigned xw[4] = {px.x, px.y, px.z, px.w};
#pragma unroll
            for (int e = 0; e < 4; ++e) { *(LAS unsigned short*)(L + S_XT + (xc * 8 + 2 * e) * 144 + xl * 2) = (unsigned short)(xw[e] & 0xffffu); *(LAS unsigned short*)(L + S_XT + (xc * 8 + 2 * e + 1) * 144 + xl * 2) = (unsigned short)(xw[e] >> 16); }
#pragma unroll
            for (int k = 0; k < 2; ++k) { const int it = tid + NT * k, l = it >> 4, c16 = it & 15; const float wl = misc[192 + l];
                *(LAS u32x4*)(L + S_BQ + l * 272 + c16 * 16) = pb[k]; *(LAS u32x4*)(L + S_CQ + l * 272 + c16 * 16) = pc[k];
                const unsigned bw[4] = {pb[k].x, pb[k].y, pb[k].z, pb[k].w};
#pragma unroll
                for (int e = 0; e < 4; ++e) { *(LAS unsigned short*)(L + S_BT + (c16 * 8 + 2 * e) * 144 + l * 2) = (unsigned short)f2bf(bflo(bw[e]) * wl); *(LAS unsigned short*)(L + S_BT + (c16 * 8 + 2 * e + 1) * 144 + l * 2) = (unsigned short)f2bf(bfhi(bw[e]) * wl); } }
        }
        if (ci + 1 < 36) SSD_PREFETCH(ci + 1);
        __syncthreads();
        const int lt = w >> 1, t2 = (w & 1) * 2;
        bf16x8 cfr[4];
#pragma unroll
        for (int ks = 0; ks < 4; ++ks) cfr[ks] = *(const LAS bf16x8*)(L + S_CQ + (16 * lt + q16) * 272 + ks * 64 + gq * 16);
        {
            const f32x4 csl = *(const LAS f32x4*)(misc + 64 + 16 * lt + 4 * gq);
#pragma unroll
            for (int k = 0; k < 2; ++k) { const int st = t2 + k; f32x4 a = {0.f, 0.f, 0.f, 0.f};
                if (st <= lt) {
#pragma unroll
                    for (int ks = 0; ks < 4; ++ks) { const bf16x8 bfr = *(const LAS bf16x8*)(L + S_BQ + (16 * st + q16) * 272 + ks * 64 + gq * 16); a = __builtin_amdgcn_mfma_f32_16x16x32_bf16(cfr[ks], bfr, a, 0, 0, 0); }
                    const int sidx = 16 * st + q16; const float css = misc[64 + sidx], dts = misc[sidx];
#pragma unroll
                    for (int r = 0; r < 4; ++r) { const int l = 16 * lt + 4 * gq + r; a[r] = (sidx <= l) ? a[r] * __expf(csl[r] - css) * dts : 0.f; }
                }
#pragma unroll
                for (int r = 0; r < 4; ++r) *(LAS unsigned short*)(L + S_MQ + (16 * lt + 4 * gq + r) * 144 + (16 * st + q16) * 2) = (unsigned short)f2bf(a[r]); }
        }
        __syncthreads();
        {
            const f32x4 ecs = *(const LAS f32x4*)(misc + 128 + 16 * lt + 4 * gq);
            const LAS unsigned char* HB = L + S_HB + par * 17408;
#pragma unroll
            for (int k = 0; k < 2; ++k) { const int pt = t2 + k; f32x4 a = {0.f, 0.f, 0.f, 0.f};
#pragma unroll
                for (int ks = 0; ks < 4; ++ks) { const bf16x8 hfr = *(const LAS bf16x8*)(HB + (16 * pt + q16) * 272 + ks * 64 + gq * 16); a = __builtin_amdgcn_mfma_f32_16x16x32_bf16(cfr[ks], hfr, a, 0, 0, 0); }
                a = a * ecs;
#pragma unroll
                for (int ks = 0; ks < 2; ++ks) if (ks <= (lt >> 1)) { const bf16x8 mfr = *(const LAS bf16x8*)(L + S_MQ + (16 * lt + q16) * 144 + ks * 64 + gq * 16), xfr = *(const LAS bf16x8*)(L + S_XT + (16 * pt + q16) * 144 + ks * 64 + gq * 16);
                    a = __builtin_amdgcn_mfma_f32_16x16x32_bf16(mfr, xfr, a, 0, 0, 0); }
                if (dir == 0) { const u32x2 xv = *(const LAS u32x2*)(L + S_XT + (16 * pt + q16) * 144 + (16 * lt + 4 * gq) * 2);
                    a[0] += dsk * bflo(xv.x); a[1] += dsk * bfhi(xv.x); a[2] += dsk * bflo(xv.y); a[3] += dsk * bfhi(xv.y); }
#pragma unroll
                for (int r = 0; r < 4; ++r) Y[(size_t)SSD_ROW(ci, 16 * lt + 4 * gq + r) * 512 + h * 64 + 16 * pt + q16] = a[r]; }
            const int pt2 = w & 3, nb = (w >> 2) * 4; const float et = misc[256];
            bf16x8 xf2[2];
#pragma unroll
            for (int ks = 0; ks < 2; ++ks) xf2[ks] = *(const LAS bf16x8*)(L + S_XT + (16 * pt2 + q16) * 144 + ks * 64 + gq * 16);
            LAS unsigned char* HN = L + S_HB + (par ^ 1) * 17408;
#pragma unroll
            for (int j = 0; j < 4; ++j) { const int nt = nb + j; Hacc[j] = Hacc[j] * et;
#pragma unroll
                for (int ks = 0; ks < 2; ++ks) { const bf16x8 bfr = *(const LAS bf16x8*)(L + S_BT + (16 * nt + q16) * 144 + ks * 64 + gq * 16); Hacc[j] = __builtin_amdgcn_mfma_f32_16x16x32_bf16(xf2[ks], bfr, Hacc[j], 0, 0, 0); }
#pragma unroll
                for (int r = 0; r < 4; ++r) *(LAS unsigned short*)(HN + (16 * pt2 + 4 * gq + r) * 272 + (16 * nt + q16) * 2) = (unsigned short)f2bf(Hacc[j][r]); }
        }
        par ^= 1;
    }
#undef SSD_ROW
#undef SSD_PREFETCH
}
__device__ __forceinline__ void p_mixa(const Frame& F, int layer, bool last) {
    for (int u = F.bid; u < NTOK / 16; u += F.G) ssd_prepass_unit(F, layer, u);
    for (int rep = 0; rep < REP_NA; ++rep) {
        for (int u = F.bid; u < 2048; u += F.G) na_unit(F, layer, u >> 7, (u >> 4) & 7, 0, u & 15);
        if (!last) for (int u = F.bid; u < 256; u += F.G) na_unit(F, layer, u >> 4, (u >> 1) & 7, 1, u & 1);
    }
}
__device__ __forceinline__ void p_mixb(const Frame& F, int layer) {
    for (int rep = 0; rep < REP_SSD; ++rep) for (int u = F.bid; u < 256; u += F.G) ssd_mfma_unit(F, layer, u >> 4, (u >> 1) & 7, u & 1);
}

__device__ __forceinline__ void p_ssdcomb(const Frame& F, int layer, bool last) {
    const bf16_t* PROJ = (const bf16_t*)(F.ws + WS_PROJ); bf16_t* MIX = (bf16_t*)(F.ws + WS_MIX);
    const float* YF = (const float*)(F.ws + WS_YF); const float* YB = (const float*)(F.ws + WS_YB);
    const float* nw = F.in[I_NORMW] + layer * 512 + F.lane * 8;
    const f32x4 nw0 = *(const f32x4*)nw, nw1 = *(const f32x4*)(nw + 4);
    const int nrows = last ? NLAT : NTOK;
    for (int row = F.gw; row < nrows; row += F.NGW) {
        const size_t o = (size_t)row * 512 + F.lane * 8;
        const f32x4 a0 = *(const f32x4*)(YF + o) + *(const f32x4*)(YB + o), a1 = *(const f32x4*)(YF + o + 4) + *(const f32x4*)(YB + o + 4);
        const u32x4 zv = *(const u32x4*)(PROJ + (size_t)row * NPROJ + OFF_Z + F.lane * 8);
        float y[8] = {a0[0] * silu_f(bflo(zv.x)), a0[1] * silu_f(bfhi(zv.x)), a0[2] * silu_f(bflo(zv.y)), a0[3] * silu_f(bfhi(zv.y)),
                      a1[0] * silu_f(bflo(zv.z)), a1[1] * silu_f(bfhi(zv.z)), a1[2] * silu_f(bflo(zv.w)), a1[3] * silu_f(bfhi(zv.w))};
        float ss = 0.f;
#pragma unroll
        for (int k = 0; k < 8; ++k) ss += y[k] * y[k];
#pragma unroll
        for (int of = 1; of < 32; of <<= 1) ss += __shfl_xor(ss, of);
        const float rs = 1.0f / sqrtf(ss * (1.0f / 256.0f) + RMS_EPS);
        u32x4 w; w.x = pk2(y[0] * rs * nw0[0], y[1] * rs * nw0[1]); w.y = pk2(y[2] * rs * nw0[2], y[3] * rs * nw0[3]);
        w.z = pk2(y[4] * rs * nw1[0], y[5] * rs * nw1[1]); w.w = pk2(y[6] * rs * nw1[2], y[7] * rs * nw1[3]);
        *(u32x4*)(MIX + (size_t)row * D + 512 + F.lane * 8) = w;
    }
}

__device__ __forceinline__ void p_outproj(const Frame& F, int layer, bool last) {
    float* X = (float*)(F.ws + WS_X);
    pg8::Gemm g{(const bf16_t*)(F.ws + WS_MIX), (const bf16_t*)(F.ws + WS_WOUT) + (size_t)layer * D * D, D};
    pg8::DenseOrder S; S.init(last ? NLAT : NTOK, D, D, F.G, F.bid);
    pg8::EpiResid E{layer == 0 ? F.in[I_X] : X, layer == 0 ? F.in[I_CTX] : X + (size_t)NLAT * D, X, (const float*)(F.ws + WS_MOD) + (size_t)layer * 17 * MODW, 2 * D};
    pg8::gemm_phase<pg8::EpiResid, pg8::DenseOrder, true, true>(F.lds, g, S, E);
}

__device__ __forceinline__ unsigned* cnt_word(const Frame& F, int slot, int hf, int e) { return (unsigned*)(F.ws + WS_CTL) + CW_CNT + ((slot * 2 + hf) * 8 + e) * 64; }
__device__ __forceinline__ void p_ln1(const Frame& F, int layer, bool last) {
    float* X = (float*)(F.ws + WS_X); bf16_t* H = (bf16_t*)(F.ws + WS_H);
    const float* MOD = (const float*)(F.ws + WS_MOD) + (size_t)layer * 17 * MODW;
    const float* lg = F.in[I_LNG] + (size_t)(layer * 2) * D; const float* lb = F.in[I_LNB] + (size_t)(layer * 2) * D;
    const bool moe = layer & 1; const int slot = layer >> 1;
    const int nrows = last ? NLAT : NTOK, halfn = nrows / 2;
    float rw[16][8];
    if (moe) { const float* R = F.in[I_RW] + (size_t)slot * D * 8;
#pragma unroll
        for (int j = 0; j < 4; ++j)
#pragma unroll
            for (int k = 0; k < 4; ++k) { const f32x4 a = *(const f32x4*)(R + (size_t)(4 * F.lane + 256 * j + k) * 8), b2 = *(const f32x4*)(R + (size_t)(4 * F.lane + 256 * j + k) * 8 + 4);
                rw[j * 4 + k][0] = a[0]; rw[j * 4 + k][1] = a[1]; rw[j * 4 + k][2] = a[2]; rw[j * 4 + k][3] = a[3]; rw[j * 4 + k][4] = b2[0]; rw[j * 4 + k][5] = b2[1]; rw[j * 4 + k][6] = b2[2]; rw[j * 4 + k][7] = b2[3]; } }
    for (int row = F.gw; row < nrows; row += F.NGW) {
        f32x4 v[4], hv[4]; row_load(X + (size_t)row * D, F.lane, v);
        row_ln(v, lg, lb, F.lane);
        row_store(X + (size_t)row * D, F.lane, v);
        const float* m = MOD + (size_t)mod_row_of(row) * MODW;
        row_mod_store(H + (size_t)row * D, F.lane, v, m + 3 * D, m + 4 * D, hv);
        if (moe) {
            float lg8[8];
#pragma unroll
            for (int e = 0; e < 8; ++e) { float s = 0.f;
#pragma unroll
                for (int j = 0; j < 4; ++j)
#pragma unroll
                    for (int k = 0; k < 4; ++k) s += hv[j][k] * rw[j * 4 + k][e];
                lg8[e] = wave_sum(s); }
            int e0 = 0; float v0 = lg8[0];
#pragma unroll
            for (int e = 1; e < 8; ++e) if (lg8[e] > v0) { v0 = lg8[e]; e0 = e; }
            int e1 = -1; float v1 = -INFINITY;
#pragma unroll
            for (int e = 0; e < 8; ++e) if (e != e0 && lg8[e] > v1) { v1 = lg8[e]; e1 = e; }
            if (F.lane == 0) {
                const int hf = row < halfn ? 0 : 1;
                const unsigned s0 = atomicAdd(cnt_word(F, slot, hf, e0), 1u), s1 = atomicAdd(cnt_word(F, slot, hf, e1), 1u);
                int* list = (int*)(F.ws + WS_LIST);
                list[(hf * 8 + e0) * 18432 + s0] = row; list[(hf * 8 + e1) * 18432 + s1] = row;
                const float ex = __expf(v1 - v0), g0 = 1.0f / (1.0f + ex);
                u32x4 r; r.x = (unsigned)e0 | ((unsigned)e1 << 8); r.y = s0; r.z = s1; r.w = 0u;
                *(u32x4*)(F.ws + WS_ROUTE + (size_t)row * 16) = r;
                *(f32x2*)(F.ws + WS_GATES + (size_t)row * 8) = (f32x2){g0, ex * g0};
            }
        }
    }
}

__device__ __forceinline__ void p_ffn1_dense(const Frame& F, int layer, bool last) {
    const int s = layer >> 1;
    pg8::Gemm g{(const bf16_t*)(F.ws + WS_H), (const bf16_t*)(F.ws + WS_WFGU) + (size_t)s * 2 * DFF * D, D};
    pg8::DenseOrder S; S.init(last ? NLAT : NTOK, 2 * DFF, D, F.G, F.bid);
    pg8::EpiSwiGLU E{(bf16_t*)(F.ws + WS_HID), DFF};
    pg8::gemm_phase<pg8::EpiSwiGLU, pg8::DenseOrder, true, true>(F.lds, g, S, E);
}
__device__ __forceinline__ void p_ffn2_dense(const Frame& F, int layer, bool last) {
    const int s = layer >> 1; float* X = (float*)(F.ws + WS_X);
    pg8::Gemm g{(const bf16_t*)(F.ws + WS_HID), (const bf16_t*)(F.ws + WS_WFD) + (size_t)s * D * DFF, DFF};
    pg8::DenseOrder S; S.init(last ? NLAT : NTOK, D, DFF, F.G, F.bid);
    pg8::EpiResid E{X, X + (size_t)NLAT * D, X, (const float*)(F.ws + WS_MOD) + (size_t)layer * 17 * MODW, 5 * D};
    pg8::gemm_phase<pg8::EpiResid, pg8::DenseOrder, true, true>(F.lds, g, S, E);
}
__device__ __forceinline__ void moe_prefix(const Frame& F, int slot, int hf, int (&ts)[9], int (&cn)[8]) {
    int a = 0;
#pragma unroll
    for (int e = 0; e < 8; ++e) { cn[e] = (int)*cnt_word(F, slot, hf, e); ts[e] = a; a += (cn[e] + 255) >> 8; }
    ts[8] = a;
}
__device__ __forceinline__ void p_ffn1_moe(const Frame& F, int layer, int hf) {
    const int slot = layer >> 1; int cn[8];
    pg8::MoeOrder<true> S; moe_prefix(F, slot, hf, S.ts, cn);
    S.nM = S.ts[8]; S.nN = 2 * DFFE / 256; S.G = F.G; S.c = F.bid; S.K = D; S.estride = (long)2 * DFFE * D * 2; S.rowoff = (const LAS unsigned*)(F.lds + LDS_ROWOFF);
    {
        const int* list = (const int*)(F.ws + WS_LIST); LAS unsigned* ro = (LAS unsigned*)(F.lds + LDS_ROWOFF); pg8::Unit u;
        for (int i = 0; i < 18 && S.next(i, u); ++i) { const int e = S.expert_of(u.pm); int tse = 0, cne = 0;
#pragma unroll
            for (int j = 0; j < 8; ++j) { tse = (j == e) ? S.ts[j] : tse; cne = (j == e) ? cn[j] : cne; }
            for (int r = F.tid; r < 256; r += NT) { const int sl = (u.pm - tse) * 256 + r; const int tok = sl < cne ? list[(hf * 8 + e) * 18432 + sl] : 0; ro[i * 256 + r] = (unsigned)tok * (unsigned)(D * 2); } }
        __syncthreads();
    }
    pg8::Gemm g{(const bf16_t*)(F.ws + WS_H), (const bf16_t*)(F.ws + WS_WMGU), D};
    pg8::EpiSwiGLU E{(bf16_t*)(F.ws + WS_HID), DFFE};
    pg8::gemm_phase<pg8::EpiSwiGLU, pg8::MoeOrder<true>, true, true>(F.lds, g, S, E);
}
__device__ __forceinline__ void p_ffn2_moe(const Frame& F, int layer, int hf) {
    const int slot = layer >> 1; int cn[8];
    pg8::MoeOrder<false> S; moe_prefix(F, slot, hf, S.ts, cn);
    S.nM = S.ts[8]; S.nN = D / 256; S.G = F.G; S.c = F.bid; S.K = DFFE; S.estride = (long)D * DFFE * 2; S.rowoff = nullptr;
    pg8::Gemm g{(const bf16_t*)(F.ws + WS_HID), (const bf16_t*)(F.ws + WS_WMD), DFFE};
    pg8::EpiBf16 E{(bf16_t*)(F.ws + WS_YP) + (size_t)hf * HALF_PAD * D, D};
    pg8::gemm_phase<pg8::EpiBf16, pg8::MoeOrder<false>, true, true>(F.lds, g, S, E);
}

__device__ __forceinline__ void p_ln2(const Frame& F, int layer, bool last) {
    float* X = (float*)(F.ws + WS_X); bf16_t* H = (bf16_t*)(F.ws + WS_H);
    const float* MOD = (const float*)(F.ws + WS_MOD) + (size_t)layer * 17 * MODW;
    const float* lg = F.in[I_LNG] + (size_t)(layer * 2 + 1) * D; const float* lb = F.in[I_LNB] + (size_t)(layer * 2 + 1) * D;
    const bool moe = layer & 1; const int slot = layer >> 1;
    const int nrows = last ? NLAT : NTOK, halfn = nrows / 2;
    int ts0[9], ts1[9], cn[8];
    if (moe) { moe_prefix(F, slot, 0, ts0, cn); moe_prefix(F, slot, 1, ts1, cn); }
    const bf16_t* YP = (const bf16_t*)(F.ws + WS_YP);
    for (int row = F.gw; row < nrows; row += F.NGW) {
        f32x4 v[4], hv[4]; row_load(X + (size_t)row * D, F.lane, v);
        if (moe) {
            const int hf = row < halfn ? 0 : 1;
            const u32x4 r = *(const u32x4*)(F.ws + WS_ROUTE + (size_t)row * 16); const f32x2 gt = *(const f32x2*)(F.ws + WS_GATES + (size_t)row * 8);
            const int e0 = r.x & 255, e1 = (r.x >> 8) & 255;
            int t0 = 0, t1 = 0;
#pragma unroll
            for (int e = 0; e < 8; ++e) { const int tv = hf ? ts1[e] : ts0[e]; t0 = (e == e0) ? tv : t0; t1 = (e == e1) ? tv : t1; }
            const bf16_t* y0 = YP + ((size_t)hf * HALF_PAD + (size_t)t0 * 256 + r.y) * D; const bf16_t* y1 = YP + ((size_t)hf * HALF_PAD + (size_t)t1 * 256 + r.z) * D;
            const float* g2 = MOD + (size_t)mod_row_of(row) * MODW + 5 * D;
#pragma unroll
            for (int j = 0; j < 4; ++j) { const u32x2 a = *(const u32x2*)(y0 + 4 * F.lane + 256 * j), b2 = *(const u32x2*)(y1 + 4 * F.lane + 256 * j);
                const f32x4 gg = *(const f32x4*)(g2 + 4 * F.lane + 256 * j) + 1.0f;
                f32x4 f; f[0] = gt[0] * bflo(a.x) + gt[1] * bflo(b2.x); f[1] = gt[0] * bfhi(a.x) + gt[1] * bfhi(b2.x); f[2] = gt[0] * bflo(a.y) + gt[1] * bflo(b2.y); f[3] = gt[0] * bfhi(a.y) + gt[1] * bfhi(b2.y);
                v[j] = v[j] * ALPHA + gg * f; }
        }
        row_ln(v, lg, lb, F.lane);
        if (last) row_store(F.out + (size_t)row * D, F.lane, v);
        else { row_store(X + (size_t)row * D, F.lane, v);
            const float* m = MOD + (size_t)17 * MODW + (size_t)mod_row_of(row) * MODW;
            row_mod_store(H + (size_t)row * D, F.lane, v, m, m + D, hv); }
    }
}

constexpr int NPL = 11;
constexpr int NPH = 2 + NPL * DEPTH;
#ifndef SITE_MASK
#define SITE_MASK 0xFFFFF
#endif
#define SITE(n) (((SITE_MASK) >> (n)) & 1)
__global__ void __launch_bounds__(NT, 2) fwd_kernel(Args args) {
    extern __shared__ __attribute__((aligned(16))) unsigned char lds_raw[];
    Frame F;
    F.lds = (LAS unsigned char*)lds_raw; F.in = args.in; F.out = args.out; F.ws = args.ws;
    F.tid = threadIdx.x; F.lane = F.tid & 63; F.wave = __builtin_amdgcn_readfirstlane(F.tid >> 6); F.bid = blockIdx.x; F.G = gridDim.x;
    F.gw = F.bid * NWAVES + F.wave; F.NGW = F.G * NWAVES;
    volatile LAS unsigned* MISC = (volatile LAS unsigned*)(F.lds + LDS_MISC);
    if (F.tid < 64) MISC[F.tid] = 0u;
    __syncthreads();
    XcdBarrier bar; bar.bar = (unsigned*)(F.ws + WS_CTL) + CW_BAR; bar.x = 0; bar.st = MISC + 8;
#if MK_SINGLE
    bar = xcd_barrier_post((unsigned*)(F.ws + WS_CTL) + CW_BAR, MISC + 8);
#endif
    const int lo = args.ph_lo, hi = args.ph_hi;
#define IN(k) (lo <= (k) && (k) < hi)
#if MK_SINGLE
#define SEAM(k) do { if (IN(k) && IN((k) + 1)) { XcdBarrier b2_ = bar; int z_; asm volatile("s_mov_b32 %0, 0" : "=s"(z_)); b2_.bar = bar.bar + z_; xcd_barrier(b2_); } } while (0)
#else
#define SEAM(k) do { } while (0)
#endif
    if constexpr (SITE(0)) if (IN(0)) p_pro_a(fresh(F));
    SEAM(0);
    if constexpr (SITE(1)) if (IN(1)) p_pro_b(fresh(F));
    SEAM(1);
    for (int layer = 0; layer < DEPTH; ++layer) {
        const int pb = 2 + NPL * layer; const bool last = layer == DEPTH - 1; const bool moe = layer & 1;
        if constexpr (SITE(2)) if (IN(pb + 0)) p_inproj(fresh(F), layer);
        SEAM(pb + 0);
        if constexpr (SITE(3)) if (IN(pb + 1)) p_mixa(fresh(F), layer, last);
        SEAM(pb + 1);
        if constexpr (SITE(12)) if (IN(pb + 2)) p_mixb(fresh(F), layer);
        SEAM(pb + 2);
        if constexpr (SITE(4)) if (IN(pb + 3)) { p_ssdcomb(fresh(F), layer, last); if (layer == 2) { int rot = 0; conv_moe(fresh(F), 1, rot); } }
        SEAM(pb + 3);
        if constexpr (SITE(5)) if (IN(pb + 4)) p_outproj(fresh(F), layer, last);
        SEAM(pb + 4);
        if constexpr (SITE(6)) if (IN(pb + 5)) p_ln1(fresh(F), layer, last);
        SEAM(pb + 5);
        if (moe) {
            if constexpr (SITE(7)) if (IN(pb + 6)) p_ffn1_moe(fresh(F), layer, 0);
            SEAM(pb + 6);
            if constexpr (SITE(8)) if (IN(pb + 7)) p_ffn2_moe(fresh(F), layer, 0);
            SEAM(pb + 7);
            if constexpr (SITE(7)) if (IN(pb + 8)) p_ffn1_moe(fresh(F), layer, 1);
            SEAM(pb + 8);
            if constexpr (SITE(8)) if (IN(pb + 9)) p_ffn2_moe(fresh(F), layer, 1);
            SEAM(pb + 9);
        } else {
            if constexpr (SITE(9)) if (IN(pb + 6)) p_ffn1_dense(fresh(F), layer, last);
            SEAM(pb + 6);
            if constexpr (SITE(10)) if (IN(pb + 7)) p_ffn2_dense(fresh(F), layer, last);
            SEAM(pb + 7);
            SEAM(pb + 8);
            SEAM(pb + 9);
        }
        if constexpr (SITE(11)) if (IN(pb + 10)) p_ln2(fresh(F), layer, last);
        if (!last) SEAM(pb + 10);
    }
#undef IN
#undef SEAM
}

extern "C" void kernel_launch(void* const* d_in, const int* in_sizes, int n_in, void* d_out, int out_size, void* d_ws, size_t ws_size, hipStream_t stream) {
    static int grid = 0;
    if (grid == 0) {
        if (n_in != 24 || out_size != NLAT * D || ws_size < WS_END) { fprintf(stderr, "kernel_launch: unexpected shapes (n_in %d, out %d, ws %zu < %zu)\n", n_in, out_size, ws_size, (size_t)WS_END); grid = -1; return; }
        int dev = 0, cus = 0, per_cu = 0;
        if (hipGetDevice(&dev) != hipSuccess || hipDeviceGetAttribute(&cus, hipDeviceAttributeMultiprocessorCount, dev) != hipSuccess) { grid = -1; return; }
        if (hipFuncSetAttribute((const void*)fwd_kernel, hipFuncAttributeMaxDynamicSharedMemorySize, LDS_BYTES) != hipSuccess) { fprintf(stderr, "kernel_launch: hipFuncSetAttribute failed\n"); grid = -1; return; }
        if (hipOccupancyMaxActiveBlocksPerMultiprocessor(&per_cu, (const void*)fwd_kernel, NT, LDS_BYTES) != hipSuccess || per_cu < 1) { fprintf(stderr, "kernel_launch: occupancy query says %d\n", per_cu); }
        (void)hipGetLastError();
        grid = cus;
    }
    if (grid < 0) return;
    (void)in_sizes;
    if (hipMemsetAsync((char*)d_ws + WS_CTL, 0, CTL_BYTES, stream) != hipSuccess) return;
    Args a{};
    for (int i = 0; i < 24; ++i) a.in[i] = (const float*)d_in[i];
    a.out = (float*)d_out; a.ws = (unsigned char*)d_ws;
#if MK_SINGLE
    a.ph_lo = 0; a.ph_hi = NPH;
    hipLaunchKernelGGL(fwd_kernel, dim3(grid), dim3(NT), LDS_BYTES, stream, a);
#else
    for (int ph = 0; ph < NPH; ++ph) {
        if (ph >= 2) { const int layer = (ph - 2) / NPL, j = (ph - 2) % NPL; const bool moe = layer & 1; if (!moe && (j == 8 || j == 9)) continue; }
        a.ph_lo = ph; a.ph_hi = ph + 1;
        hipLaunchKernelGGL(fwd_kernel, dim3(grid), dim3(NT), LDS_BYTES, stream, a);
    }
#endif
}
```

```cpp
#include <hip/hip_runtime.h>
#include <cstdio>
#include <cstdint>

#ifndef MK_SINGLE
#define MK_SINGLE 1
#endif

#ifndef FP8_DENSE
#define FP8_DENSE 0
#endif
#ifndef USE_FP8
#define USE_FP8 1
#endif
#ifndef FP8_SP2
#define FP8_SP2 true
#endif
#ifndef REP_SSD
#define REP_SSD 1
#endif
#ifndef REP_NA
#define REP_NA 1
#endif
#ifndef REP_GEMM
#define REP_GEMM 1
#endif
#define GAS __attribute__((address_space(1)))
#define LAS __attribute__((address_space(3)))
typedef unsigned short bf16_t;
typedef short bf16x8 __attribute__((ext_vector_type(8)));
typedef float f32x4 __attribute__((ext_vector_type(4)));
typedef float f32x2 __attribute__((ext_vector_type(2)));
typedef unsigned u32x4 __attribute__((ext_vector_type(4)));
typedef unsigned u32x2 __attribute__((ext_vector_type(2)));
typedef int i32x4 __attribute__((ext_vector_type(4)));
typedef int i32x8 __attribute__((ext_vector_type(8)));

constexpr int D = 1024, BATCH = 16, SEQ = 2048, DEPTH = 4, GRID_W = 64, CTX = 256;
constexpr int NLAT = BATCH * SEQ;
constexpr int NCTX = BATCH * CTX;
constexpr int NTOK = NLAT + NCTX;
constexpr int NPROJ = 3072;
constexpr int OFF_K = 512, OFF_V = 1024, OFF_Z = 1536, OFF_XBC = 2048;
constexpr int D_IN_PROJ = 3088;
constexpr int DFF = 2816, DFFE = 3584, NEXP = 8;
constexpr float ALPHA = 1.6817928305074290f;
constexpr float LN_EPS = 1e-5f, RMS_EPS = 1e-5f;
constexpr int MODW = 6 * D;

constexpr size_t MiB = 1u << 20;
constexpr size_t WS_CTL = 0, CTL_BYTES = 1 * MiB;
constexpr size_t WS_MOD = 1 * MiB;
constexpr size_t WS_ROUTE = 3 * MiB;
constexpr size_t WS_GATES = 4 * MiB;
constexpr size_t WS_LIST = 5 * MiB;
constexpr size_t WS_WDT = 7 * MiB;
constexpr size_t WS_WIN = 8 * MiB;
constexpr size_t WS_WOUT = 32 * MiB;
constexpr size_t WS_WFGU = 40 * MiB;
constexpr size_t WS_WFD = 62 * MiB;
constexpr size_t WS_WMGU = 73 * MiB;
constexpr size_t WS_WMD = 185 * MiB;
constexpr size_t WS_X = 241 * MiB;
constexpr size_t WS_H = 385 * MiB;
constexpr size_t WS_R = 457 * MiB;
constexpr size_t WS_PROJ = WS_R;
constexpr size_t WS_DT = WS_R + 216 * MiB;
constexpr size_t WS_YF = WS_R + 219 * MiB;
constexpr size_t WS_YB = WS_R + 291 * MiB;
constexpr size_t WS_MIX = WS_R + 363 * MiB;
constexpr size_t WS_HID = WS_R;
constexpr size_t WS_YP = WS_R + 270 * MiB;
constexpr size_t WS_U = WS_R + 435 * MiB;
constexpr size_t WS_END = WS_R + 507 * MiB;
constexpr int HALF_PAD = 2 * 18432 + 2048;
static_assert(WS_HID + (size_t)HALF_PAD * 3584 * 2 <= WS_YP && WS_YP + (size_t)2 * HALF_PAD * 1024 * 2 <= WS_END, "MoE buffers");

constexpr int CW_TMO = 0;
constexpr int CW_BAR = 4096;
constexpr int CW_CNT = 16384;

constexpr int LDS_STAGE = 131072;
constexpr int LDS_ROWOFF = 131072;
constexpr int LDS_MISC = 131072 + 18432;
constexpr int LDS_BYTES = 155648;

constexpr int S8_ACT = 3, S8_WGU = 8, S8_HID = 2, S8_WD = 9;
__device__ __forceinline__ unsigned f2bf(float f) { unsigned u = __builtin_bit_cast(unsigned, f); return (u + 0x7fffu + ((u >> 16) & 1u)) >> 16; }
typedef __bf16 bf16x2_t __attribute__((ext_vector_type(2)));
__device__ __forceinline__ unsigned pk2(float lo, float hi) { const f32x2 v = {lo, hi}; const bf16x2_t b = __builtin_convertvector(v, bf16x2_t); return __builtin_bit_cast(unsigned, b); }
__device__ __forceinline__ float bf2f(unsigned short b) { return __builtin_bit_cast(float, ((unsigned)b) << 16); }
__device__ __forceinline__ float bflo(unsigned w) { return __builtin_bit_cast(float, w << 16); }
__device__ __forceinline__ float bfhi(unsigned w) { return __builtin_bit_cast(float, w & 0xffff0000u); }
__device__ __forceinline__ float silu_f(float v) { return v / (1.0f + __expf(-v)); }
__device__ __forceinline__ float clamp8(float v) { return fminf(fmaxf(v, -448.0f), 448.0f); }
__device__ __forceinline__ unsigned pk8(float a, float b, float c, float d) {
    int w = 0; w = __builtin_amdgcn_cvt_pk_fp8_f32(clamp8(a), clamp8(b), w, false); w = __builtin_amdgcn_cvt_pk_fp8_f32(clamp8(c), clamp8(d), w, true); return (unsigned)w; }
__device__ __forceinline__ float wave_sum(float v) {
#pragma unroll
    for (int o = 1; o < 64; o <<= 1) v += __shfl_xor(v, o);
    return v;
}

namespace pg8 {
constexpr int BM = 256, BK = 64, HALF = 128, HTB = HALF * BK * 2, STAGE_BYTES = 8 * HTB, NXCD = 8, WGM = 8;
__host__ __device__ __forceinline__ int lds_byte(int r, int c) { const int st = (r >> 4) * 2 + (c >> 5), rr = r & 15, cc = c & 31, ob = rr * 64 + cc * 2; return st * 1024 + (ob ^ (((ob >> 9) & 1) << 5)); }
__host__ __device__ __forceinline__ void stage_rc(int b, int& R, int& C) { const int st = b / 1024, sb = b % 1024, swz = sb ^ (((sb >> 9) & 1) << 5); R = (st >> 1) * 16 + swz / 64; C = (st & 1) * 32 + (swz % 64) / 2; }
__host__ __device__ __forceinline__ int perm32(int rho) { const int n = rho >> 4, i = rho & 15; return 8 * (i >> 2) + 4 * n + (i & 3); }

struct Unit { int pm, pn; long bofs; };
struct Gemm { const bf16_t* A; const bf16_t* Bt; int K; };

__device__ __forceinline__ unsigned cvt_pk_bf16(float lo, float hi) { return pk2(lo, hi); }
__device__ __forceinline__ unsigned cvt_pk_bf16_pin(float lo, float hi) { unsigned r; asm volatile("v_cvt_pk_bf16_f32 %0, %1, %2" : "=v"(r) : "v"(lo), "v"(hi)); return r; }

__device__ __forceinline__ bool static_tile(int i, int G, int c, int nM, int nN, int& pm, int& pn, int rep = 1) {
    const int nwg = nM * nN;
#if REP_GEMM > 1
    { const int cnt = (nwg - c + G - 1) / G; if (cnt <= 0 || i >= rep * cnt) return false; i %= cnt; }
#endif
    const long L = (long)i * G + c; if (L >= nwg) return false;
    int wgid = (int)L; { const int q = nwg / NXCD, r = nwg % NXCD, xcd = wgid % NXCD, off = wgid / NXCD; wgid = (xcd < r ? xcd * (q + 1) : r * (q + 1) + (xcd - r) * q) + off; }
    const int nig = WGM * nN, gid = wgid / nig, fm = gid * WGM, gsz = (nM - fm) < WGM ? (nM - fm) : WGM;
    pm = fm + ((wgid % nig) % gsz); pn = (wgid % nig) / gsz; return true;
}
struct DenseOrder {
    int nM, nN, G, c, K, rep;
    __device__ __forceinline__ void init(int M, int N, int K_, int G_, int c_, int rep_ = 1) { nM = M / BM; nN = N / BM; G = G_; c = c_; K = K_; rep = rep_; }
    __device__ __forceinline__ bool next(int i, Unit& u) const { if (!static_tile(i, G, c, nM, nN, u.pm, u.pn, rep)) return false; u.bofs = (long)u.pn * BM * K * 2; return true; }
    static constexpr bool GATHER = false;
    __device__ __forceinline__ long a_base(const Unit& u) const { return (long)u.pm * BM * K * 2; }
    __device__ __forceinline__ void a_offs(int, const Unit&, int, unsigned (&)[2][2]) const {}
};
template <bool GATHER_> struct MoeOrder {
    int nM, nN, G, c, K; int ts[9]; long estride; const LAS unsigned* rowoff;
    __device__ __forceinline__ int expert_of(int pm) const { int e = 0;
#pragma unroll
        for (int j = 1; j < 8; ++j) e += (pm >= ts[j]) ? 1 : 0; return e; }
    __device__ __forceinline__ bool next(int i, Unit& u) const { if (!static_tile(i, G, c, nM, nN, u.pm, u.pn, REP_GEMM)) return false; u.bofs = (long)expert_of(u.pm) * estride + (long)u.pn * BM * K * 2; return true; }
    static constexpr bool GATHER = GATHER_;
    __device__ __forceinline__ long a_base(const Unit& u) const { return GATHER_ ? 0l : (long)u.pm * BM * K * 2; }
    __device__ __forceinline__ void a_offs(int ui, const Unit&, int tid, unsigned (&o)[2][2]) const {
        int uix = ui;
#if REP_GEMM > 1
        { const int cnt = (nM * nN - c + G - 1) / G; uix = ui % cnt; }
#endif
        if (GATHER_) {
#pragma unroll
            for (int i = 0; i < 2; ++i) { int R, C; stage_rc(tid * 16 + i * 8192, R, C);
#pragma unroll
                for (int h = 0; h < 2; ++h) o[h][i] = rowoff[uix * 256 + h * HALF + R] + (unsigned)(C * 2); }
        }
    }
};

struct EpiBf16 {
    static constexpr bool PERM = true;
    bf16_t* O; int ldc;
    __device__ __forceinline__ void operator()(const f32x4 (&acc)[2][2][4][2], const Unit& u, int wr, int wc, int fr, int fq) const {
        const int row0 = u.pm * BM + wr * 64 + fr; const int col0 = u.pn * BM + wc * 32 + 8 * fq;
#pragma unroll
        for (int ai = 0; ai < 2; ++ai)
#pragma unroll
            for (int m = 0; m < 4; ++m) { bf16_t* rowp = O + (size_t)(row0 + ai * HALF + m * 16) * ldc + col0;
#pragma unroll
                for (int bj = 0; bj < 2; ++bj) { const f32x4 v0 = acc[ai][bj][m][0], v1 = acc[ai][bj][m][1];
                    u32x4 w; w.x = cvt_pk_bf16(v0[0], v0[1]); w.y = cvt_pk_bf16(v0[2], v0[3]); w.z = cvt_pk_bf16(v1[0], v1[1]); w.w = cvt_pk_bf16(v1[2], v1[3]);
                    *(u32x4*)(rowp + bj * HALF) = w; } }
    }
};
struct EpiSwiGLU {
    static constexpr bool PERM = true;
    bf16_t* O; int ldc;
    __device__ __forceinline__ void operator()(const f32x4 (&acc)[2][2][4][2], const Unit& u, int wr, int wc, int fr, int fq) const {
        const int row0 = u.pm * BM + wr * 64 + fr; const int col0 = u.pn * HALF + wc * 32 + 8 * fq;
#pragma unroll
        for (int ai = 0; ai < 2; ++ai)
#pragma unroll
            for (int m = 0; m < 4; ++m) { bf16_t* rowp = O + (size_t)(row0 + ai * HALF + m * 16) * ldc + col0;
                float h[8];
#pragma unroll
                for (int n = 0; n < 2; ++n)
#pragma unroll
                    for (int j = 0; j < 4; ++j) { const float g = acc[ai][0][m][n][j], up = acc[ai][1][m][n][j]; h[n * 4 + j] = g * __builtin_amdgcn_rcpf(1.0f + __expf(-g)) * up; }
                u32x4 w; w.x = cvt_pk_bf16(h[0], h[1]); w.y = cvt_pk_bf16(h[2], h[3]); w.z = cvt_pk_bf16(h[4], h[5]); w.w = cvt_pk_bf16(h[6], h[7]);
                *(u32x4*)rowp = w; }
    }
};
struct EpiSwiGLU8 {
    static constexpr bool PERM = true;
    unsigned char* O; int ldc;
    __device__ __forceinline__ void operator()(const f32x4 (&acc)[2][2][4][2], const Unit& u, int wr, int wc, int fr, int fq) const {
        const int row0 = u.pm * BM + wr * 64 + fr; const int col0 = u.pn * HALF + wc * 32 + 8 * fq;
#pragma unroll
        for (int ai = 0; ai < 2; ++ai)
#pragma unroll
            for (int m = 0; m < 4; ++m) { unsigned char* rowp = O + (size_t)(row0 + ai * HALF + m * 16) * ldc + col0;
                float h[8];
#pragma unroll
                for (int n = 0; n < 2; ++n)
#pragma unroll
                    for (int j = 0; j < 4; ++j) { const float g = acc[ai][0][m][n][j], up = acc[ai][1][m][n][j]; h[n * 4 + j] = g * __builtin_amdgcn_rcpf(1.0f + __expf(-g)) * up * (float)(1 << S8_HID); }
                u32x2 w; w.x = pk8(h[0], h[1], h[2], h[3]); w.y = pk8(h[4], h[5], h[6], h[7]);
                *(u32x2*)rowp = w; }
    }
};
struct EpiResid {
    static constexpr bool PERM = false;
    const float* base_lat; const float* base_ctx; float* out; const float* mod; int gate_off;
    __device__ __forceinline__ void operator()(const f32x4 (&acc)[2][2][4][2], const Unit& u, int wr, int wc, int fr, int fq) const {
        const int rt = u.pm * BM; const bool isctx = rt >= NLAT; const int bi = isctx ? 16 : (rt >> 11);
        const float* base = isctx ? base_ctx + (size_t)(rt - NLAT) * D : base_lat + (size_t)rt * D;
        float* o = out + (size_t)rt * D; const float* gt = mod + bi * MODW + gate_off;
        const int r0 = wr * 64 + fr, col0 = u.pn * BM + wc * 32 + 4 * fq;
        f32x4 gv[2][2];
#pragma unroll
        for (int bj = 0; bj < 2; ++bj)
#pragma unroll
            for (int n = 0; n < 2; ++n) gv[bj][n] = *(const f32x4*)(gt + col0 + bj * HALF + n * 16) + 1.0f;
#pragma unroll
        for (int ai = 0; ai < 2; ++ai)
#pragma unroll
            for (int m = 0; m < 4; ++m) { const size_t off = (size_t)(r0 + ai * HALF + m * 16) * D + col0;
#pragma unroll
                for (int bj = 0; bj < 2; ++bj)
#pragma unroll
                    for (int n = 0; n < 2; ++n) { const f32x4 bs = *(const f32x4*)(base + off + bj * HALF + n * 16);
                        *(f32x4*)(o + off + bj * HALF + n * 16) = bs * ALPHA + gv[bj][n] * acc[ai][bj][m][n]; }
                if (m & 1) asm volatile("" ::: "memory"); }
    }
};

template <class Epi, class Sched, bool ALIGN_EPI, bool SP2, bool FP8 = false>
__device__ __forceinline__ void gemm_phase(LAS unsigned char* lds, const Gemm g, const Sched& S, const Epi& E, int sw = 0x7f7f7f7f, int sa = 0x7f7f7f7f) {
    int tid_ = threadIdx.x; asm volatile("" : "+v"(tid_));
    const int tid = tid_, wid = __builtin_amdgcn_readfirstlane(tid >> 6), lane = tid & 63, wr = wid >> 2, wc = wid & 3, fr = lane & 15, fq = lane >> 4;
    const int K = g.K, nt = K / BK;
    constexpr bool GA = Sched::GATHER;
    unsigned voffA[2], voffB[2];
#pragma unroll
    for (int i = 0; i < 2; ++i) { int R, C; stage_rc(tid * 16 + i * 8192, R, C); const int Rb = Epi::PERM ? ((R & ~31) + perm32(R & 31)) : R;
        voffA[i] = (unsigned)(R * K + C) * 2u; voffB[i] = (unsigned)(Rb * K + C) * 2u; }
    const size_t kstep = (size_t)(BK * 2);
    const size_t hstep = (size_t)HALF * K * 2;
    const unsigned ldsw = (unsigned)wid * 1024u;
    const int aoff = lds_byte(wr * 64 + fr, fq * 8), boff = lds_byte(wc * 32 + fr, fq * 8);
#define PG8_SA(b, h) (((b) * 2 + (h)) * HTB)
#define PG8_SB(b, h) ((4 + (b) * 2 + (h)) * HTB)
#define PG8_STAGE(bufoff, gbase, voff) do { _Pragma("unroll") for (int _i = 0; _i < 2; ++_i) \
        __builtin_amdgcn_global_load_lds((const unsigned*)((const char*)(gbase) + (voff)[_i]), (LAS unsigned*)(lds + (bufoff) + ldsw + _i * 8192), 16, 0, 0); } while (0)
#define PG8_LDA(dst, b, h) do { _Pragma("unroll") for (int m = 0; m < 4; ++m) _Pragma("unroll") for (int k = 0; k < 2; ++k) dst[m][k] = *(const LAS bf16x8*)(lds + PG8_SA(b, h) + aoff + m * 2048 + k * 1024); } while (0)
#define PG8_LDB(dst, b, h) do { _Pragma("unroll") for (int n = 0; n < 2; ++n) _Pragma("unroll") for (int k = 0; k < 2; ++k) dst[n][k] = *(const LAS bf16x8*)(lds + PG8_SB(b, h) + boff + n * 2048 + k * 1024); } while (0)
#define PG8_CAT(x) __builtin_shufflevector(__builtin_bit_cast(i32x4, (x)[0]), __builtin_bit_cast(i32x4, (x)[1]), 0, 1, 2, 3, 4, 5, 6, 7)
#define PG8_MMA(ai, bj, At, Bt) do { __builtin_amdgcn_s_setprio(1); _Pragma("unroll") for (int m = 0; m < 4; ++m) _Pragma("unroll") for (int n = 0; n < 2; ++n) { \
        if constexpr (FP8) { const i32x8 a8_ = PG8_CAT(Bt[n]), b8_ = PG8_CAT(At[m]); \
            asm volatile("v_mfma_scale_f32_16x16x128_f8f6f4 %0, %1, %2, %0, %3, %4 op_sel_hi:[0,0,0]" : "+v"(acc[ai][bj][m][n]) : "v"(a8_), "v"(b8_), "v"(sw), "v"(sa)); } \
        else { _Pragma("unroll") for (int k = 0; k < 2; ++k) acc[ai][bj][m][n] = __builtin_amdgcn_mfma_f32_16x16x32_bf16(Bt[n][k], At[m][k], acc[ai][bj][m][n], 0, 0, 0); } } \
        __builtin_amdgcn_s_setprio(0); } while (0)
#define PG8_WAIT_V(n) asm volatile("s_waitcnt vmcnt(" #n ")" ::: "memory")
#define PG8_WAIT_L(n) asm volatile("s_waitcnt lgkmcnt(" #n ")" ::: "memory")
#define PG8_BAR __builtin_amdgcn_s_barrier()
#define PG8_SCHED __builtin_amdgcn_sched_barrier(0)
    Unit cur, nxt; int ui = 0;
    if (!S.next(0, cur)) return;
    f32x4 acc[2][2][4][2];
#pragma unroll
    for (int a = 0; a < 2; ++a)
#pragma unroll
        for (int b = 0; b < 2; ++b)
#pragma unroll
            for (int m = 0; m < 4; ++m)
#pragma unroll
                for (int n = 0; n < 2; ++n) acc[a][b][m][n] = (f32x4){0.f, 0.f, 0.f, 0.f};
    bf16x8 At[4][2], B0[2][2], B1[2][2];
    const char* Ab = (const char*)g.A + S.a_base(cur);
    unsigned oc[2][2];
    S.a_offs(0, cur, tid, oc);
    const size_t hsA = GA ? (size_t)0 : hstep;
#define PG8_STAGE_A(bufoff, gbase, h) do { if constexpr (GA) PG8_STAGE(bufoff, gbase, oc[h]); else PG8_STAGE(bufoff, (gbase) + (h) * hsA, voffA); } while (0)
    const char* cB = (const char*)g.Bt + cur.bofs;
    if constexpr (SP2) {
        PG8_STAGE(PG8_SB(0, 0), cB, voffB); PG8_STAGE(PG8_SB(0, 1), cB + hstep, voffB); PG8_STAGE_A(PG8_SA(0, 0), Ab, 0); PG8_STAGE_A(PG8_SA(0, 1), Ab, 1);
        if (wr == 1) PG8_BAR;
        PG8_WAIT_V(2); PG8_BAR;
        PG8_STAGE(PG8_SB(1, 0), cB + kstep, voffB); PG8_STAGE_A(PG8_SA(1, 0), Ab + kstep, 0); PG8_STAGE(PG8_SB(1, 1), cB + hstep + kstep, voffB);
        PG8_WAIT_V(6); PG8_BAR;
    } else {
        PG8_STAGE(PG8_SB(0, 0), cB, voffB); PG8_STAGE_A(PG8_SA(0, 0), Ab, 0); PG8_STAGE(PG8_SB(0, 1), cB + hstep, voffB); PG8_STAGE_A(PG8_SA(0, 1), Ab, 1);
        if (wr == 1) PG8_BAR;
        PG8_WAIT_V(4); PG8_BAR;
        PG8_STAGE(PG8_SB(1, 0), cB + kstep, voffB); PG8_STAGE_A(PG8_SA(1, 0), Ab + kstep, 0); PG8_STAGE(PG8_SB(1, 1), cB + hstep + kstep, voffB);
        PG8_WAIT_V(6); PG8_BAR;
    }
    for (;;) {
        const bool has_next = S.next(ui + 1, nxt);
        const char* nB = has_next ? (const char*)g.Bt + nxt.bofs : cB;
        for (int t = 0; t < nt; t += 2) {
            const bool last = (t == nt - 2);
            const char* a1 = Ab + (size_t)(t + 1) * kstep;
            const char* b2 = last ? nB : cB + (size_t)(t + 2) * kstep; const char* b3 = b2 + kstep;
            if constexpr (SP2) {
            PG8_LDB(B0, 0, 0); PG8_LDB(B1, 0, 1); PG8_SCHED; PG8_LDA(At, 0, 0); PG8_STAGE_A(PG8_SA(1, 1), a1, 1);
            if (last && has_next) { S.a_offs(ui + 1, nxt, tid, oc); Ab = (const char*)g.A + S.a_base(nxt); }
            const char* a2 = last ? Ab : Ab + (size_t)(t + 2) * kstep; const char* a3 = a2 + kstep;
            PG8_WAIT_V(8); PG8_WAIT_L(0); PG8_BAR; PG8_MMA(0, 0, At, B0); PG8_MMA(0, 1, At, B1); PG8_BAR; PG8_SCHED;
            PG8_LDA(At, 0, 1); PG8_STAGE(PG8_SB(0, 0), b2, voffB); PG8_STAGE(PG8_SB(0, 1), b2 + hstep, voffB); PG8_STAGE_A(PG8_SA(0, 0), a2, 0);
            PG8_WAIT_V(8); PG8_WAIT_L(0); PG8_BAR; PG8_MMA(1, 0, At, B0); PG8_MMA(1, 1, At, B1); PG8_BAR; PG8_SCHED;
            PG8_LDB(B0, 1, 0); PG8_LDB(B1, 1, 1); PG8_SCHED; PG8_LDA(At, 1, 0); PG8_STAGE_A(PG8_SA(0, 1), a2, 1);
            PG8_WAIT_V(8); PG8_WAIT_L(0); PG8_BAR; PG8_MMA(0, 0, At, B0); PG8_MMA(0, 1, At, B1); PG8_BAR; PG8_SCHED;
            PG8_LDA(At, 1, 1); PG8_STAGE(PG8_SB(1, 0), b3, voffB); PG8_STAGE(PG8_SB(1, 1), b3 + hstep, voffB); PG8_STAGE_A(PG8_SA(1, 0), a3, 0);
            PG8_WAIT_V(8); PG8_WAIT_L(0); PG8_BAR; PG8_MMA(1, 0, At, B0); PG8_MMA(1, 1, At, B1); PG8_BAR; PG8_SCHED;
            } else {
            PG8_LDB(B0, 0, 0); PG8_SCHED; PG8_LDA(At, 0, 0); PG8_STAGE_A(PG8_SA(1, 1), a1, 1);
            if (last && has_next) { S.a_offs(ui + 1, nxt, tid, oc); Ab = (const char*)g.A + S.a_base(nxt); }
            const char* a2 = last ? Ab : Ab + (size_t)(t + 2) * kstep; const char* a3 = a2 + kstep;
            PG8_WAIT_L(8); PG8_BAR; PG8_WAIT_L(0); PG8_MMA(0, 0, At, B0); PG8_BAR; PG8_SCHED;
            PG8_LDB(B1, 0, 1); PG8_STAGE(PG8_SB(0, 0), b2, voffB);
            PG8_BAR; PG8_WAIT_L(0); PG8_MMA(0, 1, At, B1); PG8_BAR;
            PG8_LDA(At, 0, 1); PG8_STAGE_A(PG8_SA(0, 0), a2, 0);
            PG8_BAR; PG8_WAIT_L(0); PG8_MMA(1, 0, At, B0); PG8_BAR; PG8_SCHED;
            PG8_STAGE(PG8_SB(0, 1), b2 + hstep, voffB);
            PG8_WAIT_V(6); PG8_BAR; PG8_MMA(1, 1, At, B1); PG8_BAR;
            PG8_LDB(B0, 1, 0); PG8_SCHED; PG8_LDA(At, 1, 0); PG8_STAGE_A(PG8_SA(0, 1), a2, 1);
            PG8_WAIT_L(8); PG8_BAR; PG8_WAIT_L(0); PG8_MMA(0, 0, At, B0); PG8_BAR; PG8_SCHED;
            PG8_LDB(B1, 1, 1); PG8_STAGE(PG8_SB(1, 0), b3, voffB);
            PG8_BAR; PG8_WAIT_L(0); PG8_MMA(0, 1, At, B1); PG8_BAR;
            PG8_LDA(At, 1, 1); PG8_STAGE_A(PG8_SA(1, 0), a3, 0);
            PG8_BAR; PG8_WAIT_L(0); PG8_MMA(1, 0, At, B0); PG8_BAR; PG8_SCHED;
            PG8_STAGE(PG8_SB(1, 1), b3 + hstep, voffB);
            PG8_WAIT_V(6); PG8_BAR; PG8_MMA(1, 1, At, B1); PG8_BAR;
            }
        }
        if constexpr (ALIGN_EPI) { if (wr == 0) PG8_BAR; }
        if constexpr (FP8) asm volatile("s_nop 15\n\ts_nop 15\n\ts_nop 15" ::: "memory");
        E(acc, cur, wr, wc, fr, fq);
        if (!has_next) break;
#pragma unroll
        for (int a = 0; a < 2; ++a)
#pragma unroll
            for (int b = 0; b < 2; ++b)
#pragma unroll
                for (int m = 0; m < 4; ++m)
#pragma unroll
                    for (int n = 0; n < 2; ++n) acc[a][b][m][n] = (f32x4){0.f, 0.f, 0.f, 0.f};
        cur = nxt; cB = nB; ++ui;
        if constexpr (ALIGN_EPI) { if (wr == 1) PG8_BAR; }
    }
    PG8_WAIT_V(0);
    if constexpr (!ALIGN_EPI) { if (wr == 0) PG8_BAR; }
    PG8_BAR;
#undef PG8_SA
#undef PG8_SB
#undef PG8_STAGE
#undef PG8_STAGE_A
#undef PG8_LDA
#undef PG8_LDB
#undef PG8_MMA
#undef PG8_CAT
#undef PG8_WAIT_V
#undef PG8_WAIT_L
#undef PG8_BAR
#undef PG8_SCHED
}
}

#define XB_TMO      128
#define XB_XCNT(j)  (256  + 64 * (j))
#define XB_XSUB(j)  (1280 + 64 * (j))
#define XB_XGEN(j)  (2304 + 64 * (j))
#define XB_TOP      3328
#define XB_TOPGEN   3392
#define XCD_BAR_WORDS 3456
#define XB_SPIN_CAP (1u << 18)
__device__ __forceinline__ unsigned xb_ld(unsigned* p)              { return __hip_atomic_load(p, __ATOMIC_RELAXED, __HIP_MEMORY_SCOPE_AGENT); }
__device__ __forceinline__ unsigned xb_add(unsigned* p, unsigned v) { return __hip_atomic_fetch_add(p, v, __ATOMIC_RELAXED, __HIP_MEMORY_SCOPE_AGENT); }
__device__ __forceinline__ unsigned xb_xcc_id() { return (unsigned)__builtin_amdgcn_s_getreg((3 << 11) | 20) & 0xFu; }
#define XB_SPIN(cond, bar) do { unsigned _sp = 0; while (cond) { __builtin_amdgcn_s_sleep(1); \
    if ((++_sp & 255u) == 0u) { if (xb_ld(&(bar)[XB_TMO])) break; if (_sp > XB_SPIN_CAP) { atomicAdd(&(bar)[XB_TMO], 1u); break; } } } } while (0)
struct XcdBarrier { unsigned* bar; unsigned x; volatile LAS unsigned* st; };
__device__ __forceinline__ XcdBarrier xcd_barrier_post(unsigned* bar, volatile LAS unsigned* st) {
    XcdBarrier b; b.bar = bar; b.x = xb_xcc_id(); b.st = st;
    if (threadIdx.x == 0) (void)xb_add(&bar[XB_XCNT(b.x)], 1u);
    return b;
}
__device__ __forceinline__ void xcd_barrier_complete(unsigned* bar, unsigned x, unsigned& nloc, unsigned& nx) {
    const unsigned G = gridDim.x * gridDim.y * gridDim.z;
    unsigned sum, cnt, mine, sp = 0u;
    for (;;) {
        sum = 0u; cnt = 0u; mine = 0u;
#pragma unroll
        for (unsigned j = 0; j < 16; ++j) { const unsigned c = xb_ld(&bar[XB_XCNT(j)]); sum += c; cnt += (c > 0u) ? 1u : 0u; mine = (j == x) ? c : mine; }
        if (sum == G) break;
        __builtin_amdgcn_s_sleep(1);
        if ((++sp & 255u) == 0u) { if (xb_ld(&bar[XB_TMO])) break; if (sp > XB_SPIN_CAP) { atomicAdd(&bar[XB_TMO], 1u); break; } }
    }
    nloc = mine > 0u ? mine : 1u; nx = cnt > 0u ? cnt : 1u;
}
__device__ __forceinline__ void xcd_barrier(const XcdBarrier& b) {
    asm volatile("s_waitcnt vmcnt(0)" ::: "memory");
    __syncthreads();
    if (threadIdx.x == 0) {
        unsigned* bar = b.bar;
        __builtin_amdgcn_s_waitcnt(0);
        unsigned nloc = b.st[0], nx = b.st[1];
        if (nloc == 0u) { xcd_barrier_complete(bar, b.x, nloc, nx); b.st[0] = nloc; b.st[1] = nx; }
        const unsigned old = xb_add(&bar[XB_XSUB(b.x)], 1u);
        const unsigned gen = old / nloc;
        if (old + 1u == (gen + 1u) * nloc) {
            __builtin_amdgcn_fence(__ATOMIC_RELEASE, "agent");
            asm volatile("s_waitcnt vmcnt(0)" ::: "memory");
            const unsigned og = xb_add(&bar[XB_TOP], 1u);
            const unsigned tg = og / nx;
            if (og + 1u == (tg + 1u) * nx) xb_add(&bar[XB_TOPGEN], 1u);
            else XB_SPIN(xb_ld(&bar[XB_TOPGEN]) == tg, bar);
            __builtin_amdgcn_fence(__ATOMIC_ACQUIRE, "agent");
            xb_add(&bar[XB_XGEN(b.x)], 1u);
            asm volatile("s_waitcnt vmcnt(0)" ::: "memory");
        } else {
            XB_SPIN(xb_ld(&bar[XB_XGEN(b.x)]) == gen, bar);
            __builtin_amdgcn_fence(__ATOMIC_ACQUIRE, "agent");
            asm volatile("s_waitcnt vmcnt(0)" ::: "memory");
        }
    }
    __syncthreads();
}

constexpr int NT = 512, NWAVES = 8;
struct Args { const float* in[24]; float* out; unsigned char* ws; int ph_lo, ph_hi; };
enum { I_X = 0, I_C, I_CTX, I_CCTX, I_WMOD, I_BMOD, I_WIN, I_WOUT, I_RPB, I_CONVW, I_CONVB, I_DTB, I_ALOG, I_DSKIP, I_NORMW, I_LNG, I_LNB, I_FG, I_FU, I_FD, I_RW, I_MG, I_MU, I_MD };
struct Frame {
    LAS unsigned char* lds;
    const float* const* in; float* out; unsigned char* ws;
    int tid, lane, wave, bid, G, gw, NGW;
};
#define LDS_WAIT() asm volatile("s_waitcnt lgkmcnt(0)" ::: "memory")
__device__ __forceinline__ Frame fresh(const Frame& F0) {
    Frame F = F0; int z; asm volatile("s_mov_b32 %0, 0" : "=s"(z)); F.ws = F0.ws + z; F.in = F0.in + z; F.out = F0.out + z;
    int t = F0.tid; asm volatile("" : "+v"(t)); F.tid = t; F.lane = t & 63; return F;
}

__device__ __forceinline__ void conv_item(const float* W, int ldn, int k0, int n0, bf16_t* dst, int K, int drow0, LAS float* scr, int lane) {
#pragma unroll 8
    for (int i = 0; i < 32; ++i) { const int kk = 2 * i + (lane >> 5); scr[kk * 33 + (lane & 31)] = W[(size_t)(k0 + kk) * ldn + n0 + (lane & 31)]; }
    LDS_WAIT(); asm volatile("" ::: "memory");
    const int c = lane & 7;
#pragma unroll
    for (int j = 0; j < 4; ++j) { const int n = (lane >> 3) + 8 * j; const LAS float* s = scr + (8 * c) * 33 + n;
        u32x4 o; o.x = pk2(s[0 * 33], s[1 * 33]); o.y = pk2(s[2 * 33], s[3 * 33]); o.z = pk2(s[4 * 33], s[5 * 33]); o.w = pk2(s[6 * 33], s[7 * 33]);
        *(u32x4*)(dst + (size_t)(drow0 + n) * K + k0 + 8 * c) = o; }
    LDS_WAIT(); asm volatile("" ::: "memory");
}
__device__ __forceinline__ void conv_item8(const float* W, int ldn, int k0, int n0, unsigned char* dst, int K, int drow0, float scale, LAS float* scr, int lane) {
#pragma unroll 8
    for (int i = 0; i < 32; ++i) { const int kk = 2 * i + (lane >> 5); scr[kk * 33 + (lane & 31)] = W[(size_t)(k0 + kk) * ldn + n0 + (lane & 31)] * scale; }
    LDS_WAIT(); asm volatile("" ::: "memory");
    const int c = lane & 7;
#pragma unroll
    for (int j = 0; j < 4; ++j) { const int n = (lane >> 3) + 8 * j; const LAS float* sp = scr + (8 * c) * 33 + n;
        u32x2 o; o.x = pk8(sp[0 * 33], sp[1 * 33], sp[2 * 33], sp[3 * 33]); o.y = pk8(sp[4 * 33], sp[5 * 33], sp[6 * 33], sp[7 * 33]);
        *(u32x2*)(dst + (size_t)(drow0 + n) * K + k0 + 8 * c) = o; }
    LDS_WAIT(); asm volatile("" ::: "memory");
}
__device__ __forceinline__ void conv_seg(const Frame& F, const float* W, int K, int ldn, int ncols, bf16_t* dst, int mode, int& rot, int s8 = -1) {
    LAS float* scr = (LAS float*)(F.lds + F.wave * 16384);
    const int nblk = ncols / 32, nitems = (K / 64) * nblk;
    int start = F.gw - rot; if (start < 0) start += F.NGW;
    for (int it = start; it < nitems; it += F.NGW) {
        const int kb = it / nblk, nb = it % nblk, n0 = nb * 32;
        const int drow0 = (mode == 0) ? n0 : ((n0 >> 7) * 256 + (n0 & 127) + (mode == 2 ? 128 : 0));
        if (s8 >= 0) conv_item8(W, ldn, kb * 64, n0, (unsigned char*)dst, K, drow0, (float)(1 << s8), scr, F.lane);
        else conv_item(W, ldn, kb * 64, n0, dst, K, drow0, scr, F.lane);
    }
    rot = (rot + nitems) % F.NGW;
}
__device__ __forceinline__ void conv_moe(const Frame& F, int slot, int& rot) {
#if USE_FP8
    unsigned char* gu = F.ws + WS_WMGU + (size_t)slot * NEXP * 2 * DFFE * D; unsigned char* dn = F.ws + WS_WMD + (size_t)slot * NEXP * D * DFFE;
    for (int e = 0; e < NEXP; ++e) {
        const size_t so = ((size_t)slot * NEXP + e) * (size_t)D * DFFE;
        conv_seg(F, F.in[I_MG] + so, D, DFFE, DFFE, (bf16_t*)(gu + (size_t)e * 2 * DFFE * D), 1, rot, S8_WGU);
        conv_seg(F, F.in[I_MU] + so, D, DFFE, DFFE, (bf16_t*)(gu + (size_t)e * 2 * DFFE * D), 2, rot, S8_WGU);
        conv_seg(F, F.in[I_MD] + so, DFFE, D, D, (bf16_t*)(dn + (size_t)e * D * DFFE), 0, rot, S8_WD);
    }
#else
    bf16_t* gu = (bf16_t*)(F.ws + WS_WMGU); bf16_t* dn = (bf16_t*)(F.ws + WS_WMD);
    for (int e = 0; e < NEXP; ++e) {
        const size_t so = ((size_t)slot * NEXP + e) * (size_t)D * DFFE;
        conv_seg(F, F.in[I_MG] + so, D, DFFE, DFFE, gu + (size_t)e * 2 * DFFE * D, 1, rot);
        conv_seg(F, F.in[I_MU] + so, D, DFFE, DFFE, gu + (size_t)e * 2 * DFFE * D, 2, rot);
        conv_seg(F, F.in[I_MD] + so, DFFE, D, D, dn + (size_t)e * D * DFFE, 0, rot);
    }
#endif
}

__device__ __forceinline__ void p_pro_a(const Frame& F) {
    {
        LAS float* sc = (LAS float*)F.lds; LAS float* red = sc + 17 * 1024;
        const float* c = F.in[I_C]; const float* cc = F.in[I_CCTX];
        for (int i = F.tid; i < 17 * 1024; i += NT) { const int r = i >> 10, k = i & 1023; const float v = (r < 16) ? c[r * 1024 + k] : cc[k]; sc[i] = silu_f(v); }
        __syncthreads();
        float* MOD = (float*)(F.ws + WS_MOD);
        const int col = F.tid & 63, ks = F.tid >> 6;
        for (int u = F.bid; u < 4 * 96; u += F.G) {
            const int l = u / 96, cb = u % 96;
            const float* W = F.in[I_WMOD] + (size_t)l * D * MODW + cb * 64 + col;
            float acc[17];
#pragma unroll
            for (int r = 0; r < 17; ++r) acc[r] = 0.f;
            for (int k = ks * 128; k < ks * 128 + 128; ++k) { const float w = W[(size_t)k * MODW];
#pragma unroll
                for (int r = 0; r < 17; ++r) acc[r] += sc[r * 1024 + k] * w; }
#pragma unroll
            for (int r = 0; r < 17; ++r) red[(ks * 17 + r) * 64 + col] = acc[r];
            __syncthreads();
            for (int i = F.tid; i < 17 * 64; i += NT) { const int r = i >> 6, c2 = i & 63; float s = 0.f;
#pragma unroll
                for (int k2 = 0; k2 < 8; ++k2) s += red[(k2 * 17 + r) * 64 + c2];
                MOD[(size_t)(l * 17 + r) * MODW + cb * 64 + c2] = s + F.in[I_BMOD][l * MODW + cb * 64 + c2]; }
            __syncthreads();
        }
    }
    int rot = 0;
    for (int l = 0; l < DEPTH; ++l) {
        conv_seg(F, F.in[I_WIN] + (size_t)l * D * D_IN_PROJ, D, D_IN_PROJ, NPROJ, (bf16_t*)(F.ws + WS_WIN) + (size_t)l * NPROJ * D, 0, rot);
        conv_seg(F, F.in[I_WOUT] + (size_t)l * D * D, D, D, D, (bf16_t*)(F.ws + WS_WOUT) + (size_t)l * D * D, 0, rot);
    }
    for (int s = 0; s < 2; ++s) {
#if USE_FP8 && FP8_DENSE
        conv_seg(F, F.in[I_FG] + (size_t)s * D * DFF, D, DFF, DFF, (bf16_t*)(F.ws + WS_WFGU + (size_t)s * 2 * DFF * D), 1, rot, S8_WGU);
        conv_seg(F, F.in[I_FU] + (size_t)s * D * DFF, D, DFF, DFF, (bf16_t*)(F.ws + WS_WFGU + (size_t)s * 2 * DFF * D), 2, rot, S8_WGU);
        conv_seg(F, F.in[I_FD] + (size_t)s * DFF * D, DFF, D, D, (bf16_t*)(F.ws + WS_WFD + (size_t)s * D * DFF), 0, rot, S8_WD);
#else
        conv_seg(F, F.in[I_FG] + (size_t)s * D * DFF, D, DFF, DFF, (bf16_t*)(F.ws + WS_WFGU) + (size_t)s * 2 * DFF * D, 1, rot);
        conv_seg(F, F.in[I_FU] + (size_t)s * D * DFF, D, DFF, DFF, (bf16_t*)(F.ws + WS_WFGU) + (size_t)s * 2 * DFF * D, 2, rot);
        conv_seg(F, F.in[I_FD] + (size_t)s * DFF * D, DFF, D, D, (bf16_t*)(F.ws + WS_WFD) + (size_t)s * D * DFF, 0, rot);
#endif
    }
    conv_moe(F, 0, rot);
#if USE_FP8
    conv_moe(F, 1, rot);
#endif
    { bf16_t* wdt = (bf16_t*)(F.ws + WS_WDT);
      for (int i = F.bid * NT + F.tid; i < DEPTH * 16 * D; i += F.G * NT) { const int l = i / (16 * D), n = (i / D) & 15, k = i % D;
          wdt[i] = (bf16_t)f2bf(F.in[I_WIN][((size_t)l * D + k) * D_IN_PROJ + NPROJ + n]); } }
}

__device__ __forceinline__ void row_load(const float* p, int lane, f32x4 (&v)[4]) {
#pragma unroll
    for (int j = 0; j < 4; ++j) v[j] = *(const f32x4*)(p + 4 * lane + 256 * j);
}
__device__ __forceinline__ void row_store(float* p, int lane, const f32x4 (&v)[4]) {
#pragma unroll
    for (int j = 0; j < 4; ++j) *(f32x4*)(p + 4 * lane + 256 * j) = v[j];
}
__device__ __forceinline__ void row_mod_store8(unsigned char* hrow, int lane, const f32x4 (&v)[4], const float* sh, const float* sc, f32x4 (&hv)[4]) {
#pragma unroll
    for (int j = 0; j < 4; ++j) { const f32x4 a = *(const f32x4*)(sc + 4 * lane + 256 * j), b = *(const f32x4*)(sh + 4 * lane + 256 * j);
        hv[j] = v[j] * (a + 1.0f) + b; const f32x4 q = hv[j] * (float)(1 << S8_ACT);
        *(unsigned*)(hrow + 4 * lane + 256 * j) = pk8(q[0], q[1], q[2], q[3]); }
}
__device__ __forceinline__ void row_mod_store(bf16_t* hrow, int lane, const f32x4 (&v)[4], const float* sh, const float* sc, f32x4 (&hv)[4]) {
#pragma unroll
    for (int j = 0; j < 4; ++j) { const f32x4 a = *(const f32x4*)(sc + 4 * lane + 256 * j), b = *(const f32x4*)(sh + 4 * lane + 256 * j);
        hv[j] = v[j] * (a + 1.0f) + b;
        u32x2 w; w.x = pk2(hv[j][0], hv[j][1]); w.y = pk2(hv[j][2], hv[j][3]);
        *(u32x2*)(hrow + 4 * lane + 256 * j) = w; }
}
__device__ __forceinline__ void row_ln(f32x4 (&v)[4], const float* g, const float* b, int lane) {
    float s = 0.f;
#pragma unroll
    for (int j = 0; j < 4; ++j) s += (v[j][0] + v[j][1]) + (v[j][2] + v[j][3]);
    const float mean = wave_sum(s) * (1.0f / D); float q = 0.f;
#pragma unroll
    for (int j = 0; j < 4; ++j) { v[j] = v[j] - mean; q += (v[j][0] * v[j][0] + v[j][1] * v[j][1]) + (v[j][2] * v[j][2] + v[j][3] * v[j][3]); }
    const float rstd = 1.0f / sqrtf(wave_sum(q) * (1.0f / D) + LN_EPS);
#pragma unroll
    for (int j = 0; j < 4; ++j) { const f32x4 gg = *(const f32x4*)(g + 4 * lane + 256 * j), bb = *(const f32x4*)(b + 4 * lane + 256 * j); v[j] = v[j] * rstd * gg + bb; }
}
__device__ __forceinline__ int mod_row_of(int row) { return row < NLAT ? (row >> 11) : 16; }

__device__ __forceinline__ void p_pro_b(const Frame& F) {
    const float* MOD = (const float*)(F.ws + WS_MOD); bf16_t* H = (bf16_t*)(F.ws + WS_H);
    for (int row = F.gw; row < NTOK; row += F.NGW) {
        const float* src = row < NLAT ? F.in[I_X] + (size_t)row * D : F.in[I_CTX] + (size_t)(row - NLAT) * D;
        f32x4 v[4], hv[4]; row_load(src, F.lane, v);
        const float* m = MOD + (size_t)mod_row_of(row) * MODW;
        row_mod_store(H + (size_t)row * D, F.lane, v, m, m + D, hv);
    }
}

__device__ __forceinline__ void p_inproj(const Frame& F, int layer) {
    const bf16_t* H = (const bf16_t*)(F.ws + WS_H);
    {
        const bf16_t* wdt = (const bf16_t*)(F.ws + WS_WDT) + (size_t)layer * 16 * D; float* DT = (float*)(F.ws + WS_DT);
        const int fr = F.lane & 15, fq = F.lane >> 4;
        for (int g = F.gw; g < NTOK / 16; g += F.NGW) {
            f32x4 acc = {0.f, 0.f, 0.f, 0.f};
            const bf16_t* ap = H + (size_t)(g * 16 + fr) * D + fq * 8; const bf16_t* bp = wdt + (size_t)fr * D + fq * 8;
#pragma unroll 8
            for (int ks = 0; ks < 32; ++ks) { const bf16x8 a = *(const bf16x8*)(ap + ks * 32), b = *(const bf16x8*)(bp + ks * 32);
                acc = __builtin_amdgcn_mfma_f32_16x16x32_bf16(a, b, acc, 0, 0, 0); }
#pragma unroll
            for (int r = 0; r < 4; ++r) DT[(size_t)(g * 16 + fq * 4 + r) * 16 + fr] = acc[r];
        }
    }
    pg8::Gemm g{H, (const bf16_t*)(F.ws + WS_WIN) + (size_t)layer * NPROJ * D, D};
    pg8::DenseOrder S; S.init(NTOK, NPROJ, D, F.G, F.bid, REP_GEMM);
    pg8::EpiBf16 E{(bf16_t*)(F.ws + WS_PROJ), NPROJ};
    pg8::gemm_phase<pg8::EpiBf16, pg8::DenseOrder, true, true>(F.lds, g, S, E);
}

typedef short s16x4 __attribute__((ext_vector_type(4)));
__device__ __forceinline__ s16x4 lds_tr16(LAS const unsigned char* p) { return __builtin_bit_cast(s16x4, __builtin_amdgcn_ds_read_tr16_b64_v4i16((LAS s16x4*)p)); }
constexpr int NA_KS = 144;
constexpr float LOG2E = 1.4426950408889634f;
__device__ __forceinline__ void na_unit(const Frame& F, int layer, int b, int h, int mode, int m) {
    LAS unsigned char* KV = F.lds;
    LAS float* rp = (LAS float*)(F.lds + 120832);
    const bf16_t* PROJ = (const bf16_t*)(F.ws + WS_PROJ); bf16_t* MIX = (bf16_t*)(F.ws + WS_MIX);
    const int tid = F.tid, lane = F.lane, w = F.wave, q16 = lane & 15, g = lane >> 4;
    int rbase = 0, nk = 0;
    if (mode == 0) { rbase = 2 * m - 4; rbase = rbase < 0 ? 0 : (rbase > 24 ? 24 : rbase); nk = 32 - rbase; nk = nk > 9 ? 9 : nk; }
    const int kfirst = (mode == 0) ? 0 : 576 * 8, nloc8 = nk * 64 * 8;
    __syncthreads();
    for (int i = tid + kfirst; i < 832 * 8; i += NT) { const int key = i >> 3, ch = i & 7;
        if (key < 576 && i >= nloc8) continue;
        const int grow = key < 576 ? b * SEQ + rbase * 64 + key : NLAT + b * CTX + (key - 576);
        *(LAS u32x4*)(KV + key * NA_KS + ch * 16) = *(const u32x4*)(PROJ + (size_t)grow * NPROJ + OFF_K + h * 64 + ch * 8); }
    if (mode == 0 && tid < 465) rp[tid] = F.in[I_RPB][(size_t)(layer * 8 + h) * 465 + tid] * LOG2E;
    __syncthreads();
    int i = 0, j0 = 0, hs = 0, kr0 = 0, qrow;
    if (mode == 0) { i = 2 * m + (w >> 2); j0 = (w & 3) * 16; qrow = b * SEQ + i * 64 + j0; hs = j0 - 8; hs = hs < 0 ? 0 : (hs > 32 ? 32 : hs);
        int r0 = i - 4; r0 = r0 < 0 ? 0 : (r0 > 24 ? 24 : r0); kr0 = r0 - rbase; }
    else qrow = NLAT + b * CTX + m * 128 + w * 16;
    bf16x8 qf[2];
#pragma unroll
    for (int ks = 0; ks < 2; ++ks) qf[ks] = *(const bf16x8*)(PROJ + (size_t)(qrow + q16) * NPROJ + h * 64 + ks * 32 + g * 8);
    f32x4 S[32];
    const LAS unsigned char* kb = KV + q16 * NA_KS + g * 16;
    if (mode == 0) {
        const int j = j0 + q16; int cs = j - 8; cs = cs < 0 ? 0 : (cs > 48 ? 48 : cs);
        const int rb0 = (kr0 + rbase) - i + 7;
#pragma unroll
        for (int tl = 0; tl < 16; ++tl) { const int kr = tl >> 1, half = tl & 1; const int kidx0 = (kr0 + kr) * 64 + hs + 16 * half;
            f32x4 a = {0.f, 0.f, 0.f, 0.f};
#pragma unroll
            for (int ks = 0; ks < 2; ++ks) { const bf16x8 kf = *(const LAS bf16x8*)(kb + kidx0 * NA_KS + ks * 64); a = __builtin_amdgcn_mfma_f32_16x16x32_bf16(kf, qf[ks], a, 0, 0, 0); }
#pragma unroll
            for (int r = 0; r < 4; ++r) { const int kc = hs + 16 * half + 4 * g + r; const bool inw = (kc >= cs) && (kc < cs + 16);
                int cbi = kc - j + 15; cbi = cbi < 0 ? 0 : (cbi > 30 ? 30 : cbi);
                a[r] = inw ? a[r] * (0.125f * LOG2E) + rp[(rb0 + kr) * 31 + cbi] : -INFINITY; }
            S[tl] = a; if ((tl & 3) == 3) __builtin_amdgcn_sched_barrier(0); }
    } else {
#pragma unroll
        for (int tl = 0; tl < 16; ++tl) S[tl] = (f32x4){-INFINITY, -INFINITY, -INFINITY, -INFINITY};
    }
#pragma unroll
    for (int tc = 0; tc < 16; ++tc) { const int kidx0 = 576 + 16 * tc; f32x4 a = {0.f, 0.f, 0.f, 0.f};
#pragma unroll
        for (int ks = 0; ks < 2; ++ks) { const bf16x8 kf = *(const LAS bf16x8*)(kb + kidx0 * NA_KS + ks * 64); a = __builtin_amdgcn_mfma_f32_16x16x32_bf16(kf, qf[ks], a, 0, 0, 0); }
        S[16 + tc] = a * (0.125f * LOG2E); if ((tc & 3) == 3) __builtin_amdgcn_sched_barrier(0); }
    float mx = -INFINITY;
#pragma unroll
    for (int t = 0; t < 32; ++t) mx = fmaxf(fmaxf(fmaxf(S[t][0], S[t][1]), fmaxf(S[t][2], S[t][3])), mx);
    mx = fmaxf(mx, __shfl_xor(mx, 16)); mx = fmaxf(mx, __shfl_xor(mx, 32));
    float sum = 0.f; u32x4 P[16];
#pragma unroll
    for (int kk = 0; kk < 16; ++kk) { float e[8];
#pragma unroll
        for (int r = 0; r < 4; ++r) { e[r] = __builtin_amdgcn_exp2f(S[2 * kk][r] - mx); e[4 + r] = __builtin_amdgcn_exp2f(S[2 * kk + 1][r] - mx); }
        sum += ((e[0] + e[1]) + (e[2] + e[3])) + ((e[4] + e[5]) + (e[6] + e[7]));
        P[kk].x = pg8::cvt_pk_bf16_pin(e[0], e[1]); P[kk].y = pg8::cvt_pk_bf16_pin(e[2], e[3]); P[kk].z = pg8::cvt_pk_bf16_pin(e[4], e[5]); P[kk].w = pg8::cvt_pk_bf16_pin(e[6], e[7]); }
    sum += __shfl_xor(sum, 16); sum += __shfl_xor(sum, 32);
    const float inv = 1.0f / sum;
    __syncthreads();
    for (int i2 = tid + kfirst; i2 < 832 * 8; i2 += NT) { const int key = i2 >> 3, ch = i2 & 7;
        if (key < 576 && i2 >= nloc8) continue;
        const int grow = key < 576 ? b * SEQ + rbase * 64 + key : NLAT + b * CTX + (key - 576);
        *(LAS u32x4*)(KV + key * NA_KS + ch * 16) = *(const u32x4*)(PROJ + (size_t)grow * NPROJ + OFF_V + h * 64 + ch * 8); }
    __syncthreads();
    f32x4 o[4];
#pragma unroll
    for (int dt = 0; dt < 4; ++dt) o[dt] = (f32x4){0.f, 0.f, 0.f, 0.f};
    const LAS unsigned char* vb = KV + (4 * g + (q16 >> 2)) * NA_KS + (q16 & 3) * 8;
#pragma unroll
    for (int kk = 0; kk < 16; ++kk) {
        if (kk < 8 && mode != 0) continue;
        const int kidx0 = (kk < 8) ? (kr0 + kk) * 64 + hs : 576 + 32 * (kk - 8);
        const bf16x8 pa = __builtin_bit_cast(bf16x8, P[kk]);
#pragma unroll
        for (int dt = 0; dt < 4; ++dt) { const s16x4 lo = lds_tr16(vb + kidx0 * NA_KS + dt * 32), hi = lds_tr16(vb + (kidx0 + 16) * NA_KS + dt * 32);
            const bf16x8 vf = {lo[0], lo[1], lo[2], lo[3], hi[0], hi[1], hi[2], hi[3]};
            o[dt] = __builtin_amdgcn_mfma_f32_16x16x32_bf16(pa, vf, o[dt], 0, 0, 0); }
    }
#pragma unroll
    for (int r = 0; r < 4; ++r) { const float ir = __shfl(inv, 4 * g + r);
        bf16_t* op = MIX + (size_t)(qrow + 4 * g + r) * D + h * 64 + q16;
#pragma unroll
        for (int dt = 0; dt < 4; dt += 2) { const unsigned pw = pk2(o[dt][r] * ir, o[dt + 1][r] * ir); op[dt * 16] = (bf16_t)(pw & 0xffffu); op[dt * 16 + 16] = (bf16_t)(pw >> 16); } }
}

__device__ __forceinline__ void ssd_prepass_unit(const Frame& F, int layer, int u) {
    const bf16_t* PROJ = (const bf16_t*)(F.ws + WS_PROJ); bf16_t* U = (bf16_t*)(F.ws + WS_U); float* DT = (float*)(F.ws + WS_DT);
    int rowbase, t0, L; bool lat;
    if (u < NLAT / 16) { rowbase = (u >> 7) * SEQ; t0 = (u & 127) * 16; L = SEQ; lat = true; }
    else { const int v = u - NLAT / 16; rowbase = NLAT + (v >> 4) * CTX; t0 = (v & 15) * 16; L = CTX; lat = false; }
    const int c0 = 2 * F.tid;
    const float* cwp = F.in[I_CONVW] + (size_t)layer * 5 * 1024 + c0;
    f32x2 wj[5];
#pragma unroll
    for (int j = 0; j < 5; ++j) wj[j] = *(const f32x2*)(cwp + j * 1024);
    const f32x2 bj = *(const f32x2*)(F.in[I_CONVB] + (size_t)layer * 1024 + c0);
    if (F.tid < 256) { const int r = F.tid >> 4, j = F.tid & 15; float* p = DT + (size_t)(rowbase + t0 + r) * 16 + j;
        const float x = *p + F.in[I_DTB][layer * 16 + j]; *p = x > 20.f ? x : log1pf(__expf(x)); }
    const int lc = 2 * F.lane, hf = lc >> 6, role = (lc >> 5) & 1, n = lc & 31;
    const float if0 = __builtin_amdgcn_exp2f(-(float)n * (13.287712379549449f / 32.0f)) * 0.15915494309189535f;
    const float if1 = __builtin_amdgcn_exp2f(-(float)(n + 1) * (13.287712379549449f / 32.0f)) * 0.15915494309189535f;
    const bool rope = lat && (F.wave >= 4);
    unsigned win[5];
#pragma unroll
    for (int j = 0; j < 4; ++j) { const int t = t0 - 2 + j; win[j] = (t >= 0 && t < L) ? *(const unsigned*)(PROJ + (size_t)(rowbase + t) * NPROJ + OFF_XBC + c0) : 0u; }
#pragma unroll 4
    for (int tt = 0; tt < 16; ++tt) {
        const int t = t0 + tt + 2; win[4] = (t < L) ? *(const unsigned*)(PROJ + (size_t)(rowbase + t) * NPROJ + OFF_XBC + c0) : 0u;
        float a0 = bj[0], a1 = bj[1];
#pragma unroll
        for (int j = 0; j < 5; ++j) { a0 += wj[j][0] * bflo(win[j]); a1 += wj[j][1] * bfhi(win[j]); }
        float u0 = silu_f(a0), u1 = silu_f(a1);
        if (rope) {
            const int tk = t0 + tt; const float pos = (float)(hf ? (tk & 63) : (tk >> 6));
            const float o0 = __shfl_xor(u0, 16), o1 = __shfl_xor(u1, 16);
            const float s0 = __builtin_amdgcn_sinf(pos * if0), c0f = __builtin_amdgcn_cosf(pos * if0), s1 = __builtin_amdgcn_sinf(pos * if1), c1f = __builtin_amdgcn_cosf(pos * if1);
            u0 = role ? (o0 * s0 + u0 * c0f) : (u0 * c0f - o0 * s0);
            u1 = role ? (o1 * s1 + u1 * c1f) : (u1 * c1f - o1 * s1);
        }
        *(unsigned*)(U + (size_t)(rowbase + t0 + tt) * 1024 + c0) = pk2(u0, u1);
#pragma unroll
        for (int j = 0; j < 4; ++j) win[j] = win[j + 1];
    }
}

constexpr int S_CQ = 0, S_BQ = 17408, S_BT = 34816, S_XT = 53248, S_MQ = 62464, S_HB = 71680, S_MISC = 106496;
__device__ __forceinline__ void ssd_mfma_unit(const Frame& F, int layer, int b, int h, int dir) {
    const int g = h >> 2, tid = F.tid, lane = F.lane, w = F.wave, q16 = lane & 15, gq = lane >> 4;
    const bf16_t* U = (const bf16_t*)(F.ws + WS_U); const float* DTS = (const float*)(F.ws + WS_DT);
    float* Y = (float*)(F.ws + (dir ? WS_YB : WS_YF));
    const float aneg = -__expf(F.in[I_ALOG][layer * 16 + dir * 8 + h]), dsk = F.in[I_DSKIP][layer * 8 + h];
    LAS unsigned char* L = F.lds;
    __syncthreads();
    for (int i = tid; i < 64 * 272 / 16; i += NT) *(LAS u32x4*)(L + S_HB + i * 16) = (u32x4){0u, 0u, 0u, 0u};
    f32x4 Hacc[4];
#pragma unroll
    for (int j = 0; j < 4; ++j) Hacc[j] = (f32x4){0.f, 0.f, 0.f, 0.f};
    u32x4 px, pb[2], pc[2];
    const int xl = lane, xc = w;
    float pdt = 0.f;
#define SSD_ROW(ci_, l_) ({ const int s_ = (ci_) < 4 ? 0 : 1, k_ = s_ ? (ci_) - 4 : (ci_), nc_ = s_ ? 32 : 4, c_ = dir ? nc_ - 1 - k_ : k_; \
        (s_ ? b * SEQ : NLAT + b * CTX) + c_ * 64 + (dir ? 63 - (l_) : (l_)); })
#define SSD_PREFETCH(ci_) do { px = *(const u32x4*)(U + (size_t)SSD_ROW(ci_, xl) * 1024 + h * 64 + xc * 8); \
        if (w == 0) pdt = DTS[(size_t)SSD_ROW(ci_, lane) * 16 + dir * 8 + h]; \
        _Pragma("unroll") for (int k_ = 0; k_ < 2; ++k_) { const int l_ = lane, c16_ = w + 8 * k_; const size_t ro_ = (size_t)SSD_ROW(ci_, l_) * 1024; \
            pb[k_] = *(const u32x4*)(U + ro_ + 512 + g * 128 + c16_ * 8); pc[k_] = *(const u32x4*)(U + ro_ + 768 + g * 128 + c16_ * 8); } } while (0)
    SSD_PREFETCH(0);
    int par = 0;
    for (int ci = 0; ci < 36; ++ci) {
        LAS float* misc = (LAS float*)(L + S_MISC) + par * 272;
        if (w == 0) {
            const float dt = pdt; float cs = dt * aneg;
#pragma unroll
            for (int o = 1; o < 64; o <<= 1) { const float v = __shfl_up(cs, o); cs += (lane >= o) ? v : 0.f; }
            const float tot = __shfl(cs, 63);
            misc[lane] = dt; misc[64 + lane] = cs; misc[128 + lane] = __expf(cs); misc[192 + lane] = __expf(tot - cs) * dt; if (lane == 0) misc[256] = __expf(tot);
        }
        __syncthreads();
        {
            const unsigned xw[4] = {px.x, px.y, px.z, px.w};
#pragma unroll
            for (int e = 0; e < 4; ++e) { *(LAS unsigned short*)(L + S_XT + (xc * 8 + 2 * e) * 144 + xl * 2) = (unsigned short)(xw[e] & 0xffffu); *(LAS unsigned short*)(L + S_XT + (xc * 8 + 2 * e + 1) * 144 + xl * 2) = (unsigned short)(xw[e] >> 16); }
#pragma unroll
            for (int k = 0; k < 2; ++k) { const int l = lane, c16 = w + 8 * k; const float wl = misc[192 + l];
                *(LAS u32x4*)(L + S_BQ + l * 272 + c16 * 16) = pb[k]; *(LAS u32x4*)(L + S_CQ + l * 272 + c16 * 16) = pc[k];
                const unsigned bw[4] = {pb[k].x, pb[k].y, pb[k].z, pb[k].w};
#pragma unroll
                for (int e = 0; e < 4; ++e) { const unsigned pw = pk2(bflo(bw[e]) * wl, bfhi(bw[e]) * wl);
                    *(LAS unsigned short*)(L + S_BT + (c16 * 8 + 2 * e) * 144 + l * 2) = (unsigned short)(pw & 0xffffu); *(LAS unsigned short*)(L + S_BT + (c16 * 8 + 2 * e + 1) * 144 + l * 2) = (unsigned short)(pw >> 16); } }
        }
        if (ci + 1 < 36) SSD_PREFETCH(ci + 1);
        __syncthreads();
        const int lt = w >> 1, t2 = (w & 1) * 2;
        bf16x8 cfr[4];
#pragma unroll
        for (int ks = 0; ks < 4; ++ks) cfr[ks] = *(const LAS bf16x8*)(L + S_CQ + (16 * lt + q16) * 272 + ks * 64 + gq * 16);
        {
            const f32x4 csl = *(const LAS f32x4*)(misc + 64 + 16 * lt + 4 * gq);
#pragma unroll
            for (int k = 0; k < 2; ++k) { const int st = t2 + k; f32x4 a = {0.f, 0.f, 0.f, 0.f};
                if (st <= lt) {
#pragma unroll
                    for (int ks = 0; ks < 4; ++ks) { const bf16x8 bfr = *(const LAS bf16x8*)(L + S_BQ + (16 * st + q16) * 272 + ks * 64 + gq * 16); a = __builtin_amdgcn_mfma_f32_16x16x32_bf16(cfr[ks], bfr, a, 0, 0, 0); }
                    const int sidx = 16 * st + q16; const float css = misc[64 + sidx], dts = misc[sidx];
#pragma unroll
                    for (int r = 0; r < 4; ++r) { const int l = 16 * lt + 4 * gq + r; a[r] = (sidx <= l) ? a[r] * __expf(csl[r] - css) * dts : 0.f; }
                }
#pragma unroll
                for (int r = 0; r < 4; r += 2) { const unsigned pw = pk2(a[r], a[r + 1]);
                    *(LAS unsigned short*)(L + S_MQ + (16 * lt + 4 * gq + r) * 144 + (16 * st + q16) * 2) = (unsigned short)(pw & 0xffffu); *(LAS unsigned short*)(L + S_MQ + (16 * lt + 4 * gq + r + 1) * 144 + (16 * st + q16) * 2) = (unsigned short)(pw >> 16); } }
        }
        __syncthreads();
        {
            const f32x4 ecs = *(const LAS f32x4*)(misc + 128 + 16 * lt + 4 * gq);
            const LAS unsigned char* HB = L + S_HB + par * 17408;
#pragma unroll
            for (int k = 0; k < 2; ++k) { const int pt = t2 + k; f32x4 a = {0.f, 0.f, 0.f, 0.f};
#pragma unroll
                for (int ks = 0; ks < 4; ++ks) { const bf16x8 hfr = *(const LAS bf16x8*)(HB + (16 * pt + q16) * 272 + ks * 64 + gq * 16); a = __builtin_amdgcn_mfma_f32_16x16x32_bf16(cfr[ks], hfr, a, 0, 0, 0); }
                a = a * ecs;
#pragma unroll
                for (int ks = 0; ks < 2; ++ks) if (ks <= (lt >> 1)) { const bf16x8 mfr = *(const LAS bf16x8*)(L + S_MQ + (16 * lt + q16) * 144 + ks * 64 + gq * 16), xfr = *(const LAS bf16x8*)(L + S_XT + (16 * pt + q16) * 144 + ks * 64 + gq * 16);
                    a = __builtin_amdgcn_mfma_f32_16x16x32_bf16(mfr, xfr, a, 0, 0, 0); }
                if (dir == 0) { const u32x2 xv = *(const LAS u32x2*)(L + S_XT + (16 * pt + q16) * 144 + (16 * lt + 4 * gq) * 2);
                    a[0] += dsk * bflo(xv.x); a[1] += dsk * bfhi(xv.x); a[2] += dsk * bflo(xv.y); a[3] += dsk * bfhi(xv.y); }
                { const int row0 = SSD_ROW(ci, 16 * lt + 4 * gq); float* yp = Y + (size_t)row0 * 512 + h * 64 + 16 * pt + q16; const int rs = dir ? -512 : 512;
#pragma unroll
                  for (int r = 0; r < 4; ++r) yp[r * rs] = a[r]; } }
            const int pt2 = w & 3, nb = (w >> 2) * 4; const float et = misc[256];
            bf16x8 xf2[2];
#pragma unroll
            for (int ks = 0; ks < 2; ++ks) xf2[ks] = *(const LAS bf16x8*)(L + S_XT + (16 * pt2 + q16) * 144 + ks * 64 + gq * 16);
            LAS unsigned char* HN = L + S_HB + (par ^ 1) * 17408;
#pragma unroll
            for (int j = 0; j < 4; ++j) { const int nt = nb + j; Hacc[j] = Hacc[j] * et;
#pragma unroll
                for (int ks = 0; ks < 2; ++ks) { const bf16x8 bfr = *(const LAS bf16x8*)(L + S_BT + (16 * nt + q16) * 144 + ks * 64 + gq * 16); Hacc[j] = __builtin_amdgcn_mfma_f32_16x16x32_bf16(xf2[ks], bfr, Hacc[j], 0, 0, 0); }
#pragma unroll
                for (int r = 0; r < 4; r += 2) { const unsigned pw = pk2(Hacc[j][r], Hacc[j][r + 1]);
                    *(LAS unsigned short*)(HN + (16 * pt2 + 4 * gq + r) * 272 + (16 * nt + q16) * 2) = (unsigned short)(pw & 0xffffu); *(LAS unsigned short*)(HN + (16 * pt2 + 4 * gq + r + 1) * 272 + (16 * nt + q16) * 2) = (unsigned short)(pw >> 16); } }
        }
        par ^= 1;
    }
#undef SSD_ROW
#undef SSD_PREFETCH
}
__device__ __forceinline__ void p_mixa(const Frame& F, int layer, bool last) {
    for (int u = F.bid; u < NTOK / 16; u += F.G) ssd_prepass_unit(F, layer, u);
    for (int u0 = F.bid; u0 < 2048 * REP_NA; u0 += F.G) { const int u = u0 & 2047; na_unit(F, layer, u >> 7, (u >> 4) & 7, 0, u & 15); }
    if (!last) for (int u = F.bid; u < 256; u += F.G) na_unit(F, layer, u >> 4, (u >> 1) & 7, 1, u & 1);
}
__device__ __forceinline__ void p_mixb(const Frame& F, int layer) {
    for (int u0 = F.bid; u0 < 256 * REP_SSD; u0 += F.G) { const int u = u0 & 255; ssd_mfma_unit(F, layer, u >> 4, (u >> 1) & 7, u & 1); }
}

__device__ __forceinline__ void p_ssdcomb(const Frame& F, int layer, bool last) {
    const bf16_t* PROJ = (const bf16_t*)(F.ws + WS_PROJ); bf16_t* MIX = (bf16_t*)(F.ws + WS_MIX);
    const float* YF = (const float*)(F.ws + WS_YF); const float* YB = (const float*)(F.ws + WS_YB);
    const float* nw = F.in[I_NORMW] + layer * 512 + F.lane * 8;
    const f32x4 nw0 = *(const f32x4*)nw, nw1 = *(const f32x4*)(nw + 4);
    const int nrows = last ? NLAT : NTOK;
    for (int row = F.gw; row < nrows; row += F.NGW) {
        const size_t o = (size_t)row * 512 + F.lane * 8;
        const f32x4 a0 = *(const f32x4*)(YF + o) + *(const f32x4*)(YB + o), a1 = *(const f32x4*)(YF + o + 4) + *(const f32x4*)(YB + o + 4);
        const u32x4 zv = *(const u32x4*)(PROJ + (size_t)row * NPROJ + OFF_Z + F.lane * 8);
        float y[8] = {a0[0] * silu_f(bflo(zv.x)), a0[1] * silu_f(bfhi(zv.x)), a0[2] * silu_f(bflo(zv.y)), a0[3] * silu_f(bfhi(zv.y)),
                      a1[0] * silu_f(bflo(zv.z)), a1[1] * silu_f(bfhi(zv.z)), a1[2] * silu_f(bflo(zv.w)), a1[3] * silu_f(bfhi(zv.w))};
        float ss = 0.f;
#pragma unroll
        for (int k = 0; k < 8; ++k) ss += y[k] * y[k];
#pragma unroll
        for (int of = 1; of < 32; of <<= 1) ss += __shfl_xor(ss, of);
        const float rs = 1.0f / sqrtf(ss * (1.0f / 256.0f) + RMS_EPS);
        u32x4 w; w.x = pk2(y[0] * rs * nw0[0], y[1] * rs * nw0[1]); w.y = pk2(y[2] * rs * nw0[2], y[3] * rs * nw0[3]);
        w.z = pk2(y[4] * rs * nw1[0], y[5] * rs * nw1[1]); w.w = pk2(y[6] * rs * nw1[2], y[7] * rs * nw1[3]);
        *(u32x4*)(MIX + (size_t)row * D + 512 + F.lane * 8) = w;
    }
}

__device__ __forceinline__ void p_outproj(const Frame& F, int layer, bool last) {
    float* X = (float*)(F.ws + WS_X);
    pg8::Gemm g{(const bf16_t*)(F.ws + WS_MIX), (const bf16_t*)(F.ws + WS_WOUT) + (size_t)layer * D * D, D};
    pg8::DenseOrder S; S.init(last ? NLAT : NTOK, D, D, F.G, F.bid);
    pg8::EpiResid E{layer == 0 ? F.in[I_X] : X, layer == 0 ? F.in[I_CTX] : X + (size_t)NLAT * D, X, (const float*)(F.ws + WS_MOD) + (size_t)layer * 17 * MODW, 2 * D};
    pg8::gemm_phase<pg8::EpiResid, pg8::DenseOrder, true, true>(F.lds, g, S, E);
}

__device__ __forceinline__ unsigned* cnt_word(const Frame& F, int slot, int hf, int e) { return (unsigned*)(F.ws + WS_CTL) + CW_CNT + ((slot * 2 + hf) * 8 + e) * 64; }
__device__ __forceinline__ void p_ln1(const Frame& F, int layer, bool last) {
    float* X = (float*)(F.ws + WS_X); bf16_t* H = (bf16_t*)(F.ws + WS_H);
    const float* MOD = (const float*)(F.ws + WS_MOD) + (size_t)layer * 17 * MODW;
    const float* lg = F.in[I_LNG] + (size_t)(layer * 2) * D; const float* lb = F.in[I_LNB] + (size_t)(layer * 2) * D;
    const bool moe = layer & 1; const int slot = layer >> 1;
    const int nrows = last ? NLAT : NTOK, halfn = nrows / 2;
    float rw[16][8];
    if (moe) { const float* R = F.in[I_RW] + (size_t)slot * D * 8;
#pragma unroll
        for (int j = 0; j < 4; ++j)
#pragma unroll
            for (int k = 0; k < 4; ++k) { const f32x4 a = *(const f32x4*)(R + (size_t)(4 * F.lane + 256 * j + k) * 8), b2 = *(const f32x4*)(R + (size_t)(4 * F.lane + 256 * j + k) * 8 + 4);
                rw[j * 4 + k][0] = a[0]; rw[j * 4 + k][1] = a[1]; rw[j * 4 + k][2] = a[2]; rw[j * 4 + k][3] = a[3]; rw[j * 4 + k][4] = b2[0]; rw[j * 4 + k][5] = b2[1]; rw[j * 4 + k][6] = b2[2]; rw[j * 4 + k][7] = b2[3]; } }
    for (int row = F.gw; row < nrows; row += F.NGW) {
        f32x4 v[4], hv[4]; row_load(X + (size_t)row * D, F.lane, v);
        row_ln(v, lg, lb, F.lane);
        row_store(X + (size_t)row * D, F.lane, v);
        const float* m = MOD + (size_t)mod_row_of(row) * MODW;
        if (USE_FP8 && (moe || FP8_DENSE)) row_mod_store8((unsigned char*)H + (size_t)row * D, F.lane, v, m + 3 * D, m + 4 * D, hv);
        else row_mod_store(H + (size_t)row * D, F.lane, v, m + 3 * D, m + 4 * D, hv);
        if (moe) {
            float lg8[8];
#pragma unroll
            for (int e = 0; e < 8; ++e) { float s = 0.f;
#pragma unroll
                for (int j = 0; j < 4; ++j)
#pragma unroll
                    for (int k = 0; k < 4; ++k) s += hv[j][k] * rw[j * 4 + k][e];
                lg8[e] = wave_sum(s); }
            int e0 = 0; float v0 = lg8[0];
#pragma unroll
            for (int e = 1; e < 8; ++e) if (lg8[e] > v0) { v0 = lg8[e]; e0 = e; }
            int e1 = -1; float v1 = -INFINITY;
#pragma unroll
            for (int e = 0; e < 8; ++e) if (e != e0 && lg8[e] > v1) { v1 = lg8[e]; e1 = e; }
            if (F.lane == 0) {
                const int hf = row < halfn ? 0 : 1;
                const unsigned s0 = atomicAdd(cnt_word(F, slot, hf, e0), 1u), s1 = atomicAdd(cnt_word(F, slot, hf, e1), 1u);
                int* list = (int*)(F.ws + WS_LIST);
                list[(hf * 8 + e0) * 18432 + s0] = row; list[(hf * 8 + e1) * 18432 + s1] = row;
                const float ex = __expf(v1 - v0), g0 = 1.0f / (1.0f + ex);
                u32x4 r; r.x = (unsigned)e0 | ((unsigned)e1 << 8); r.y = s0; r.z = s1; r.w = 0u;
                *(u32x4*)(F.ws + WS_ROUTE + (size_t)row * 16) = r;
                *(f32x2*)(F.ws + WS_GATES + (size_t)row * 8) = (f32x2){g0, ex * g0};
            }
        }
    }
}

__device__ __forceinline__ void p_ffn1_dense(const Frame& F, int layer, bool last) {
    const int s = layer >> 1;
#if USE_FP8 && FP8_DENSE
    pg8::Gemm g{(const bf16_t*)(F.ws + WS_H), (const bf16_t*)(F.ws + WS_WFGU + (size_t)s * 2 * DFF * D), D / 2};
    pg8::DenseOrder S; S.init(last ? NLAT : NTOK, 2 * DFF, D / 2, F.G, F.bid, REP_GEMM);
    pg8::EpiSwiGLU8 E{F.ws + WS_HID, DFF};
    pg8::gemm_phase<pg8::EpiSwiGLU8, pg8::DenseOrder, true, FP8_SP2, true>(F.lds, g, S, E, (127 - S8_WGU) * 0x01010101, (127 - S8_ACT) * 0x01010101);
#else
    pg8::Gemm g{(const bf16_t*)(F.ws + WS_H), (const bf16_t*)(F.ws + WS_WFGU) + (size_t)s * 2 * DFF * D, D};
    pg8::DenseOrder S; S.init(last ? NLAT : NTOK, 2 * DFF, D, F.G, F.bid, REP_GEMM);
    pg8::EpiSwiGLU E{(bf16_t*)(F.ws + WS_HID), DFF};
    pg8::gemm_phase<pg8::EpiSwiGLU, pg8::DenseOrder, true, true>(F.lds, g, S, E);
#endif
}
__device__ __forceinline__ void p_ffn2_dense(const Frame& F, int layer, bool last) {
    const int s = layer >> 1; float* X = (float*)(F.ws + WS_X);
    pg8::EpiResid E{X, X + (size_t)NLAT * D, X, (const float*)(F.ws + WS_MOD) + (size_t)layer * 17 * MODW, 5 * D};
#if USE_FP8 && FP8_DENSE
    pg8::Gemm g{(const bf16_t*)(F.ws + WS_HID), (const bf16_t*)(F.ws + WS_WFD + (size_t)s * D * DFF), DFF / 2};
    pg8::DenseOrder S; S.init(last ? NLAT : NTOK, D, DFF / 2, F.G, F.bid);
    pg8::gemm_phase<pg8::EpiResid, pg8::DenseOrder, true, FP8_SP2, true>(F.lds, g, S, E, (127 - S8_WD) * 0x01010101, (127 - S8_HID) * 0x01010101);
#else
    pg8::Gemm g{(const bf16_t*)(F.ws + WS_HID), (const bf16_t*)(F.ws + WS_WFD) + (size_t)s * D * DFF, DFF};
    pg8::DenseOrder S; S.init(last ? NLAT : NTOK, D, DFF, F.G, F.bid);
    pg8::gemm_phase<pg8::EpiResid, pg8::DenseOrder, true, true>(F.lds, g, S, E);
#endif
}
__device__ __forceinline__ void moe_prefix(const Frame& F, int slot, int hf, int (&ts)[9], int (&cn)[8]) {
    int a = 0;
#pragma unroll
    for (int e = 0; e < 8; ++e) { cn[e] = (int)*cnt_word(F, slot, hf, e); ts[e] = a; a += (cn[e] + 255) >> 8; }
    ts[8] = a;
}
__device__ __forceinline__ void p_ffn1_moe(const Frame& F, int layer, int hf) {
    const int slot = layer >> 1; int cn[8];
    pg8::MoeOrder<true> S; moe_prefix(F, slot, hf, S.ts, cn);
    S.nM = S.ts[8]; S.nN = 2 * DFFE / 256; S.G = F.G; S.c = F.bid; S.K = USE_FP8 ? D / 2 : D; S.estride = (long)2 * DFFE * D * (USE_FP8 ? 1 : 2); S.rowoff = (const LAS unsigned*)(F.lds + LDS_ROWOFF);
    {
        const int* list = (const int*)(F.ws + WS_LIST); LAS unsigned* ro = (LAS unsigned*)(F.lds + LDS_ROWOFF); pg8::Unit u;
        for (int i = 0; i < 18 && S.next(i, u); ++i) { const int e = S.expert_of(u.pm); int tse = 0, cne = 0;
#pragma unroll
            for (int j = 0; j < 8; ++j) { tse = (j == e) ? S.ts[j] : tse; cne = (j == e) ? cn[j] : cne; }
            for (int r = F.tid; r < 256; r += NT) { const int sl = (u.pm - tse) * 256 + r; const int tok = sl < cne ? list[(hf * 8 + e) * 18432 + sl] : 0; ro[i * 256 + r] = (unsigned)tok * (unsigned)(USE_FP8 ? D : D * 2); } }
        __syncthreads();
    }
#if USE_FP8
    pg8::Gemm g{(const bf16_t*)(F.ws + WS_H), (const bf16_t*)(F.ws + WS_WMGU + (size_t)slot * NEXP * 2 * DFFE * D), D / 2};
    pg8::EpiSwiGLU8 E{F.ws + WS_HID, DFFE};
    pg8::gemm_phase<pg8::EpiSwiGLU8, pg8::MoeOrder<true>, true, FP8_SP2, true>(F.lds, g, S, E, (127 - S8_WGU) * 0x01010101, (127 - S8_ACT) * 0x01010101);
#else
    pg8::Gemm g{(const bf16_t*)(F.ws + WS_H), (const bf16_t*)(F.ws + WS_WMGU), D};
    pg8::EpiSwiGLU E{(bf16_t*)(F.ws + WS_HID), DFFE};
    pg8::gemm_phase<pg8::EpiSwiGLU, pg8::MoeOrder<true>, true, true>(F.lds, g, S, E);
#endif
}
__device__ __forceinline__ void p_ffn2_moe(const Frame& F, int layer, int hf) {
    const int slot = layer >> 1; int cn[8];
    pg8::MoeOrder<false> S; moe_prefix(F, slot, hf, S.ts, cn);
    S.nM = S.ts[8]; S.nN = D / 256; S.G = F.G; S.c = F.bid; S.K = USE_FP8 ? DFFE / 2 : DFFE; S.estride = (long)D * DFFE * (USE_FP8 ? 1 : 2); S.rowoff = nullptr;
    pg8::EpiBf16 E{(bf16_t*)(F.ws + WS_YP) + (size_t)hf * HALF_PAD * D, D};
#if USE_FP8
    pg8::Gemm g{(const bf16_t*)(F.ws + WS_HID), (const bf16_t*)(F.ws + WS_WMD + (size_t)slot * NEXP * D * DFFE), DFFE / 2};
    pg8::gemm_phase<pg8::EpiBf16, pg8::MoeOrder<false>, true, FP8_SP2, true>(F.lds, g, S, E, (127 - S8_WD) * 0x01010101, (127 - S8_HID) * 0x01010101);
#else
    pg8::Gemm g{(const bf16_t*)(F.ws + WS_HID), (const bf16_t*)(F.ws + WS_WMD), DFFE};
    pg8::gemm_phase<pg8::EpiBf16, pg8::MoeOrder<false>, true, true>(F.lds, g, S, E);
#endif
}

__device__ __forceinline__ void p_ln2(const Frame& F, int layer, bool last) {
    float* X = (float*)(F.ws + WS_X); bf16_t* H = (bf16_t*)(F.ws + WS_H);
    const float* MOD = (const float*)(F.ws + WS_MOD) + (size_t)layer * 17 * MODW;
    const float* lg = F.in[I_LNG] + (size_t)(layer * 2 + 1) * D; const float* lb = F.in[I_LNB] + (size_t)(layer * 2 + 1) * D;
    const bool moe = layer & 1; const int slot = layer >> 1;
    const int nrows = last ? NLAT : NTOK, halfn = nrows / 2;
    int ts0[9], ts1[9], cn[8];
    if (moe) { moe_prefix(F, slot, 0, ts0, cn); moe_prefix(F, slot, 1, ts1, cn); }
    const bf16_t* YP = (const bf16_t*)(F.ws + WS_YP);
    for (int row = F.gw; row < nrows; row += F.NGW) {
        f32x4 v[4], hv[4]; row_load(X + (size_t)row * D, F.lane, v);
        if (moe) {
            const int hf = row < halfn ? 0 : 1;
            const u32x4 r = *(const u32x4*)(F.ws + WS_ROUTE + (size_t)row * 16); const f32x2 gt = *(const f32x2*)(F.ws + WS_GATES + (size_t)row * 8);
            const int e0 = r.x & 255, e1 = (r.x >> 8) & 255;
            int t0 = 0, t1 = 0;
#pragma unroll
            for (int e = 0; e < 8; ++e) { const int tv = hf ? ts1[e] : ts0[e]; t0 = (e == e0) ? tv : t0; t1 = (e == e1) ? tv : t1; }
            const bf16_t* y0 = YP + ((size_t)hf * HALF_PAD + (size_t)t0 * 256 + r.y) * D; const bf16_t* y1 = YP + ((size_t)hf * HALF_PAD + (size_t)t1 * 256 + r.z) * D;
            const float* g2 = MOD + (size_t)mod_row_of(row) * MODW + 5 * D;
#pragma unroll
            for (int j = 0; j < 4; ++j) { const u32x2 a = *(const u32x2*)(y0 + 4 * F.lane + 256 * j), b2 = *(const u32x2*)(y1 + 4 * F.lane + 256 * j);
                const f32x4 gg = *(const f32x4*)(g2 + 4 * F.lane + 256 * j) + 1.0f;
                f32x4 f; f[0] = gt[0] * bflo(a.x) + gt[1] * bflo(b2.x); f[1] = gt[0] * bfhi(a.x) + gt[1] * bfhi(b2.x); f[2] = gt[0] * bflo(a.y) + gt[1] * bflo(b2.y); f[3] = gt[0] * bfhi(a.y) + gt[1] * bfhi(b2.y);
                v[j] = v[j] * ALPHA + gg * f; }
        }
        row_ln(v, lg, lb, F.lane);
        if (last) row_store(F.out + (size_t)row * D, F.lane, v);
        else { row_store(X + (size_t)row * D, F.lane, v);
            const float* m = MOD + (size_t)17 * MODW + (size_t)mod_row_of(row) * MODW;
            row_mod_store(H + (size_t)row * D, F.lane, v, m, m + D, hv); }
    }
}

constexpr int NPL = 11;
constexpr int NPH = 2 + NPL * DEPTH;
#ifndef SITE_MASK
#define SITE_MASK 0xFFFFF
#endif
#define SITE(n) (((SITE_MASK) >> (n)) & 1)
__global__ void __launch_bounds__(NT, 2) fwd_kernel(Args args) {
    extern __shared__ __attribute__((aligned(16))) unsigned char lds_raw[];
    Frame F;
    F.lds = (LAS unsigned char*)lds_raw; F.in = args.in; F.out = args.out; F.ws = args.ws;
    F.tid = threadIdx.x; F.lane = F.tid & 63; F.wave = __builtin_amdgcn_readfirstlane(F.tid >> 6); F.bid = blockIdx.x; F.G = gridDim.x;
    F.gw = F.bid * NWAVES + F.wave; F.NGW = F.G * NWAVES;
    volatile LAS unsigned* MISC = (volatile LAS unsigned*)(F.lds + LDS_MISC);
    if (F.tid < 64) MISC[F.tid] = 0u;
    __syncthreads();
    XcdBarrier bar; bar.bar = (unsigned*)(F.ws + WS_CTL) + CW_BAR; bar.x = 0; bar.st = MISC + 8;
#if MK_SINGLE
    bar = xcd_barrier_post((unsigned*)(F.ws + WS_CTL) + CW_BAR, MISC + 8);
#endif
    const int lo = args.ph_lo, hi = args.ph_hi;
#define IN(k) (lo <= (k) && (k) < hi)
#if MK_SINGLE
#define SEAM(k) do { if (IN(k) && IN((k) + 1)) { XcdBarrier b2_ = bar; int z_; asm volatile("s_mov_b32 %0, 0" : "=s"(z_)); b2_.bar = bar.bar + z_; xcd_barrier(b2_); } } while (0)
#else
#define SEAM(k) do { } while (0)
#endif
    if constexpr (SITE(0)) if (IN(0)) p_pro_a(fresh(F));
    SEAM(0);
    if constexpr (SITE(1)) if (IN(1)) p_pro_b(fresh(F));
    SEAM(1);
    for (int layer = 0; layer < DEPTH; ++layer) {
        const int pb = 2 + NPL * layer; const bool last = layer == DEPTH - 1; const bool moe = layer & 1;
        if constexpr (SITE(2)) if (IN(pb + 0)) p_inproj(fresh(F), layer);
        SEAM(pb + 0);
        if constexpr (SITE(3)) if (IN(pb + 1)) p_mixa(fresh(F), layer, last);
        SEAM(pb + 1);
        if constexpr (SITE(12)) if (IN(pb + 2)) p_mixb(fresh(F), layer);
        SEAM(pb + 2);
        if constexpr (SITE(4)) if (IN(pb + 3)) { p_ssdcomb(fresh(F), layer, last); if (!USE_FP8 && layer == 2) { int rot = 0; conv_moe(fresh(F), 1, rot); } }
        SEAM(pb + 3);
        if constexpr (SITE(5)) if (IN(pb + 4)) p_outproj(fresh(F), layer, last);
        SEAM(pb + 4);
        if constexpr (SITE(6)) if (IN(pb + 5)) p_ln1(fresh(F), layer, last);
        SEAM(pb + 5);
        if (moe) {
            if constexpr (SITE(7)) if (IN(pb + 6)) p_ffn1_moe(fresh(F), layer, 0);
            SEAM(pb + 6);
            if constexpr (SITE(8)) if (IN(pb + 7)) p_ffn2_moe(fresh(F), layer, 0);
            SEAM(pb + 7);
            if constexpr (SITE(7)) if (IN(pb + 8)) p_ffn1_moe(fresh(F), layer, 1);
            SEAM(pb + 8);
            if constexpr (SITE(8)) if (IN(pb + 9)) p_ffn2_moe(fresh(F), layer, 1);
            SEAM(pb + 9);
        } else {
            if constexpr (SITE(9)) if (IN(pb + 6)) p_ffn1_dense(fresh(F), layer, last);
            SEAM(pb + 6);
            if constexpr (SITE(10)) if (IN(pb + 7)) p_ffn2_dense(fresh(F), layer, last);
            SEAM(pb + 7);
            SEAM(pb + 8);
            SEAM(pb + 9);
        }
        if constexpr (SITE(11)) if (IN(pb + 10)) p_ln2(fresh(F), layer, last);
        if (!last) SEAM(pb + 10);
    }
#undef IN
#undef SEAM
}

extern "C" void kernel_launch(void* const* d_in, const int* in_sizes, int n_in, void* d_out, int out_size, void* d_ws, size_t ws_size, hipStream_t stream) {
    static int grid = 0;
    if (grid == 0) {
        if (n_in != 24 || out_size != NLAT * D || ws_size < WS_END) { fprintf(stderr, "kernel_launch: unexpected shapes (n_in %d, out %d, ws %zu < %zu)\n", n_in, out_size, ws_size, (size_t)WS_END); grid = -1; return; }
        int dev = 0, cus = 0, per_cu = 0;
        if (hipGetDevice(&dev) != hipSuccess || hipDeviceGetAttribute(&cus, hipDeviceAttributeMultiprocessorCount, dev) != hipSuccess) { grid = -1; return; }
        if (hipFuncSetAttribute((const void*)fwd_kernel, hipFuncAttributeMaxDynamicSharedMemorySize, LDS_BYTES) != hipSuccess) { fprintf(stderr, "kernel_launch: hipFuncSetAttribute failed\n"); grid = -1; return; }
        if (hipOccupancyMaxActiveBlocksPerMultiprocessor(&per_cu, (const void*)fwd_kernel, NT, LDS_BYTES) != hipSuccess || per_cu < 1) { fprintf(stderr, "kernel_launch: occupancy query says %d\n", per_cu); }
        (void)hipGetLastError();
        grid = cus;
    }
    if (grid < 0) return;
    (void)in_sizes;
    if (hipMemsetAsync((char*)d_ws + WS_CTL, 0, CTL_BYTES, stream) != hipSuccess) return;
    Args a{};
    for (int i = 0; i < 24; ++i) a.in[i] = (const float*)d_in[i];
    a.out = (float*)d_out; a.ws = (unsigned char*)d_ws;
#if MK_SINGLE
    a.ph_lo = 0; a.ph_hi = NPH;
    hipLaunchKernelGGL(fwd_kernel, dim3(grid), dim3(NT), LDS_BYTES, stream, a);
#else
    for (int ph = 0; ph < NPH; ++ph) {
        if (ph >= 2) { const int layer = (ph - 2) / NPL, j = (ph - 2) % NPL; const bool moe = layer & 1; if (!moe && (j == 8 || j == 9)) continue; }
        a.ph_lo = ph; a.ph_hi = ph + 1;
        hipLaunchKernelGGL(fwd_kernel, dim3(grid), dim3(NT), LDS_BYTES, stream, a);
    }
#endif
}
```

```cpp
#include <hip/hip_runtime.h>
#include <cstdio>
#include <cstdint>

#ifndef MK_SINGLE
#define MK_SINGLE 1
#endif

#ifndef FP8_INPROJ
#define FP8_INPROJ 0
#endif
#ifndef FP8_DENSE
#define FP8_DENSE 0
#endif
#ifndef USE_FP8
#define USE_FP8 1
#endif
#ifndef FP8_SP2
#define FP8_SP2 true
#endif
#ifndef REP_SSD
#define REP_SSD 1
#endif
#ifndef REP_NA
#define REP_NA 1
#endif
#ifndef REP_GEMM
#define REP_GEMM 1
#endif
#define GAS __attribute__((address_space(1)))
#define LAS __attribute__((address_space(3)))
typedef unsigned short bf16_t;
typedef short bf16x8 __attribute__((ext_vector_type(8)));
typedef float f32x4 __attribute__((ext_vector_type(4)));
typedef float f32x2 __attribute__((ext_vector_type(2)));
typedef unsigned u32x4 __attribute__((ext_vector_type(4)));
typedef unsigned u32x2 __attribute__((ext_vector_type(2)));
typedef int i32x4 __attribute__((ext_vector_type(4)));
typedef int i32x8 __attribute__((ext_vector_type(8)));

constexpr int D = 1024, BATCH = 16, SEQ = 2048, DEPTH = 4, GRID_W = 64, CTX = 256;
constexpr int NLAT = BATCH * SEQ;
constexpr int NCTX = BATCH * CTX;
constexpr int NTOK = NLAT + NCTX;
constexpr int NPROJ = 3072;
constexpr int OFF_K = 512, OFF_V = 1024, OFF_Z = 1536, OFF_XBC = 2048;
constexpr int D_IN_PROJ = 3088;
constexpr int DFF = 2816, DFFE = 3584, NEXP = 8;
constexpr float ALPHA = 1.6817928305074290f;
constexpr float LN_EPS = 1e-5f, RMS_EPS = 1e-5f;
constexpr int MODW = 6 * D;

constexpr size_t MiB = 1u << 20;
constexpr size_t WS_CTL = 0, CTL_BYTES = 1 * MiB;
constexpr size_t WS_MOD = 1 * MiB;
constexpr size_t WS_ROUTE = 3 * MiB;
constexpr size_t WS_GATES = 4 * MiB;
constexpr size_t WS_LIST = 5 * MiB;
constexpr size_t WS_WDT = 7 * MiB;
constexpr size_t WS_WIN = 8 * MiB;
constexpr size_t WS_WOUT = 32 * MiB;
constexpr size_t WS_WFGU = 40 * MiB;
constexpr size_t WS_WFD = 62 * MiB;
constexpr size_t WS_WMGU = 73 * MiB;
constexpr size_t WS_WMD = 185 * MiB;
constexpr size_t WS_X = 241 * MiB;
constexpr size_t WS_H = 385 * MiB;
constexpr size_t WS_R = 457 * MiB;
constexpr size_t WS_PROJ = WS_R;
constexpr size_t WS_DT = WS_R + 216 * MiB;
constexpr size_t WS_YF = WS_R + 219 * MiB;
constexpr size_t WS_YB = WS_R + 291 * MiB;
constexpr size_t WS_MIX = WS_R + 363 * MiB;
constexpr size_t WS_HID = WS_R;
constexpr size_t WS_YP = WS_R + 270 * MiB;
constexpr size_t WS_U = WS_R + 435 * MiB;
constexpr size_t WS_H8IN = WS_U;
constexpr size_t WS_END = WS_R + 507 * MiB;
constexpr int MOE_PAD = 2 * NTOK + 2048;
static_assert(USE_FP8 == 1, "the single-phase MoE needs the e4m3 hidden (the bf16 one does not fit the workspace)");
static_assert(WS_HID + (size_t)MOE_PAD * 3584 <= WS_YP && WS_YP + (size_t)MOE_PAD * 1024 * 2 <= WS_END, "MoE buffers");

constexpr int CW_TMO = 0;
constexpr int CW_BAR = 4096;
constexpr int CW_CNT = 16384;

constexpr int LDS_STAGE = 131072;
constexpr int LDS_ROWOFF = 131072;
constexpr int LDS_MISC = 131072 + 18432;
constexpr int LDS_BYTES = 155648;

constexpr int S8_ACT = 3, S8_WGU = 8, S8_HID = 2, S8_WD = 9;
__device__ __forceinline__ unsigned f2bf(float f) { unsigned u = __builtin_bit_cast(unsigned, f); return (u + 0x7fffu + ((u >> 16) & 1u)) >> 16; }
typedef __bf16 bf16x2_t __attribute__((ext_vector_type(2)));
__device__ __forceinline__ unsigned pk2(float lo, float hi) { const f32x2 v = {lo, hi}; const bf16x2_t b = __builtin_convertvector(v, bf16x2_t); return __builtin_bit_cast(unsigned, b); }
__device__ __forceinline__ float bf2f(unsigned short b) { return __builtin_bit_cast(float, ((unsigned)b) << 16); }
__device__ __forceinline__ float bflo(unsigned w) { return __builtin_bit_cast(float, w << 16); }
__device__ __forceinline__ float bfhi(unsigned w) { return __builtin_bit_cast(float, w & 0xffff0000u); }
__device__ __forceinline__ float silu_f(float v) { return v / (1.0f + __expf(-v)); }
__device__ __forceinline__ float clamp8(float v) { return fminf(fmaxf(v, -448.0f), 448.0f); }
__device__ __forceinline__ unsigned pk8(float a, float b, float c, float d) {
    int w = 0; w = __builtin_amdgcn_cvt_pk_fp8_f32(clamp8(a), clamp8(b), w, false); w = __builtin_amdgcn_cvt_pk_fp8_f32(clamp8(c), clamp8(d), w, true); return (unsigned)w; }
__device__ __forceinline__ float wave_sum(float v) {
#pragma unroll
    for (int o = 1; o < 64; o <<= 1) v += __shfl_xor(v, o);
    return v;
}

namespace pg8 {
constexpr int BM = 256, BK = 64, HALF = 128, HTB = HALF * BK * 2, STAGE_BYTES = 8 * HTB, NXCD = 8, WGM = 8;
__host__ __device__ __forceinline__ int lds_byte(int r, int c) { const int st = (r >> 4) * 2 + (c >> 5), rr = r & 15, cc = c & 31, ob = rr * 64 + cc * 2; return st * 1024 + (ob ^ (((ob >> 9) & 1) << 5)); }
__host__ __device__ __forceinline__ void stage_rc(int b, int& R, int& C) { const int st = b / 1024, sb = b % 1024, swz = sb ^ (((sb >> 9) & 1) << 5); R = (st >> 1) * 16 + swz / 64; C = (st & 1) * 32 + (swz % 64) / 2; }
__host__ __device__ __forceinline__ int perm32(int rho) { const int n = rho >> 4, i = rho & 15; return 8 * (i >> 2) + 4 * n + (i & 3); }

struct Unit { int pm, pn; long bofs; };
struct Gemm { const bf16_t* A; const bf16_t* Bt; int K; };

__device__ __forceinline__ unsigned cvt_pk_bf16(float lo, float hi) { return pk2(lo, hi); }
__device__ __forceinline__ unsigned cvt_pk_bf16_pin(float lo, float hi) { unsigned r; asm volatile("v_cvt_pk_bf16_f32 %0, %1, %2" : "=v"(r) : "v"(lo), "v"(hi)); return r; }

__device__ __forceinline__ bool static_tile(int i, int G, int c, int nM, int nN, int& pm, int& pn, int rep = 1) {
    const int nwg = nM * nN;
#if REP_GEMM > 1
    { const int cnt = (nwg - c + G - 1) / G; if (cnt <= 0 || i >= rep * cnt) return false; i %= cnt; }
#endif
    const long L = (long)i * G + c; if (L >= nwg) return false;
    int wgid = (int)L; { const int q = nwg / NXCD, r = nwg % NXCD, xcd = wgid % NXCD, off = wgid / NXCD; wgid = (xcd < r ? xcd * (q + 1) : r * (q + 1) + (xcd - r) * q) + off; }
    const int nig = WGM * nN, gid = wgid / nig, fm = gid * WGM, gsz = (nM - fm) < WGM ? (nM - fm) : WGM;
    pm = fm + ((wgid % nig) % gsz); pn = (wgid % nig) / gsz; return true;
}
struct DenseOrder {
    int nM, nN, G, c, K, rep;
    __device__ __forceinline__ void init(int M, int N, int K_, int G_, int c_, int rep_ = 1) { nM = M / BM; nN = N / BM; G = G_; c = c_; K = K_; rep = rep_; }
    __device__ __forceinline__ bool next(int i, Unit& u) const { if (!static_tile(i, G, c, nM, nN, u.pm, u.pn, rep)) return false; u.bofs = (long)u.pn * BM * K * 2; return true; }
    static constexpr bool GATHER = false;
    __device__ __forceinline__ long a_base(const Unit& u) const { return (long)u.pm * BM * K * 2; }
    __device__ __forceinline__ void a_offs(int, const Unit&, int, unsigned (&)[2][2]) const {}
};
template <bool GATHER_> struct MoeOrder {
    int nM, nN, G, c, K; int ts[9]; long estride; const LAS unsigned short* rowoff; unsigned rowbytes;
    __device__ __forceinline__ int expert_of(int pm) const { int e = 0;
#pragma unroll
        for (int j = 1; j < 8; ++j) e += (pm >= ts[j]) ? 1 : 0; return e; }
    __device__ __forceinline__ bool next(int i, Unit& u) const { if (!static_tile(i, G, c, nM, nN, u.pm, u.pn, REP_GEMM)) return false; u.bofs = (long)expert_of(u.pm) * estride + (long)u.pn * BM * K * 2; return true; }
    static constexpr bool GATHER = GATHER_;
    __device__ __forceinline__ long a_base(const Unit& u) const { return GATHER_ ? 0l : (long)u.pm * BM * K * 2; }
    __device__ __forceinline__ void a_offs(int ui, const Unit&, int tid, unsigned (&o)[2][2]) const {
        int uix = ui;
#if REP_GEMM > 1
        { const int cnt = (nM * nN - c + G - 1) / G; uix = ui % cnt; }
#endif
        if (GATHER_) {
#pragma unroll
            for (int i = 0; i < 2; ++i) { int R, C; stage_rc(tid * 16 + i * 8192, R, C);
#pragma unroll
                for (int h = 0; h < 2; ++h) o[h][i] = (unsigned)rowoff[uix * 256 + h * HALF + R] * rowbytes + (unsigned)(C * 2); }
        }
    }
};

struct EpiBf16 {
    static constexpr bool PERM = true;
    bf16_t* O; int ldc;
    __device__ __forceinline__ void operator()(const f32x4 (&acc)[2][2][4][2], const Unit& u, int wr, int wc, int fr, int fq) const {
        const int row0 = u.pm * BM + wr * 64 + fr; const int col0 = u.pn * BM + wc * 32 + 8 * fq;
#pragma unroll
        for (int ai = 0; ai < 2; ++ai)
#pragma unroll
            for (int m = 0; m < 4; ++m) { bf16_t* rowp = O + (size_t)(row0 + ai * HALF + m * 16) * ldc + col0;
#pragma unroll
                for (int bj = 0; bj < 2; ++bj) { const f32x4 v0 = acc[ai][bj][m][0], v1 = acc[ai][bj][m][1];
                    u32x4 w; w.x = cvt_pk_bf16(v0[0], v0[1]); w.y = cvt_pk_bf16(v0[2], v0[3]); w.z = cvt_pk_bf16(v1[0], v1[1]); w.w = cvt_pk_bf16(v1[2], v1[3]);
                    *(u32x4*)(rowp + bj * HALF) = w; } }
    }
};
struct EpiSwiGLU {
    static constexpr bool PERM = true;
    bf16_t* O; int ldc;
    __device__ __forceinline__ void operator()(const f32x4 (&acc)[2][2][4][2], const Unit& u, int wr, int wc, int fr, int fq) const {
        const int row0 = u.pm * BM + wr * 64 + fr; const int col0 = u.pn * HALF + wc * 32 + 8 * fq;
#pragma unroll
        for (int ai = 0; ai < 2; ++ai)
#pragma unroll
            for (int m = 0; m < 4; ++m) { bf16_t* rowp = O + (size_t)(row0 + ai * HALF + m * 16) * ldc + col0;
                float h[8];
#pragma unroll
                for (int n = 0; n < 2; ++n)
#pragma unroll
                    for (int j = 0; j < 4; ++j) { const float g = acc[ai][0][m][n][j], up = acc[ai][1][m][n][j]; h[n * 4 + j] = g * __builtin_amdgcn_rcpf(1.0f + __expf(-g)) * up; }
                u32x4 w; w.x = cvt_pk_bf16(h[0], h[1]); w.y = cvt_pk_bf16(h[2], h[3]); w.z = cvt_pk_bf16(h[4], h[5]); w.w = cvt_pk_bf16(h[6], h[7]);
                *(u32x4*)rowp = w; }
    }
};
struct EpiSwiGLU8 {
    static constexpr bool PERM = true;
    unsigned char* O; int ldc;
    __device__ __forceinline__ void operator()(const f32x4 (&acc)[2][2][4][2], const Unit& u, int wr, int wc, int fr, int fq) const {
        const int row0 = u.pm * BM + wr * 64 + fr; const int col0 = u.pn * HALF + wc * 32 + 8 * fq;
#pragma unroll
        for (int ai = 0; ai < 2; ++ai)
#pragma unroll
            for (int m = 0; m < 4; ++m) { unsigned char* rowp = O + (size_t)(row0 + ai * HALF + m * 16) * ldc + col0;
                float h[8];
#pragma unroll
                for (int n = 0; n < 2; ++n)
#pragma unroll
                    for (int j = 0; j < 4; ++j) { const float g = acc[ai][0][m][n][j], up = acc[ai][1][m][n][j]; h[n * 4 + j] = g * __builtin_amdgcn_rcpf(1.0f + __expf(-g)) * up * (float)(1 << S8_HID); }
                u32x2 w; w.x = pk8(h[0], h[1], h[2], h[3]); w.y = pk8(h[4], h[5], h[6], h[7]);
                *(u32x2*)rowp = w; }
    }
};
struct EpiResid {
    static constexpr bool PERM = false;
    const void* base_lat; const void* base_ctx; bf16_t* out; const float* mod; int gate_off; bool base_f32;
    __device__ __forceinline__ void operator()(const f32x4 (&acc)[2][2][4][2], const Unit& u, int wr, int wc, int fr, int fq) const {
        const int rt = u.pm * BM; const bool isctx = rt >= NLAT; const int bi = isctx ? 16 : (rt >> 11);
        const size_t brow = isctx ? (size_t)(rt - NLAT) : (size_t)rt;
        const float* bf = (const float*)(isctx ? base_ctx : base_lat) + brow * D; const bf16_t* bh = (const bf16_t*)(isctx ? base_ctx : base_lat) + brow * D;
        bf16_t* o = out + (size_t)rt * D; const float* gt = mod + bi * MODW + gate_off;
        const int r0 = wr * 64 + fr, col0 = u.pn * BM + wc * 32 + 4 * fq;
        f32x4 gv[2][2];
#pragma unroll
        for (int bj = 0; bj < 2; ++bj)
#pragma unroll
            for (int n = 0; n < 2; ++n) gv[bj][n] = *(const f32x4*)(gt + col0 + bj * HALF + n * 16) + 1.0f;
#pragma unroll
        for (int ai = 0; ai < 2; ++ai)
#pragma unroll
            for (int m = 0; m < 4; ++m) { const size_t off = (size_t)(r0 + ai * HALF + m * 16) * D + col0;
#pragma unroll
                for (int bj = 0; bj < 2; ++bj)
#pragma unroll
                    for (int n = 0; n < 2; ++n) { f32x4 bs;
                        if (base_f32) bs = *(const f32x4*)(bf + off + bj * HALF + n * 16);
                        else { const u32x2 w = *(const u32x2*)(bh + off + bj * HALF + n * 16); bs = (f32x4){bflo(w.x), bfhi(w.x), bflo(w.y), bfhi(w.y)}; }
                        const f32x4 r = bs * ALPHA + gv[bj][n] * acc[ai][bj][m][n];
                        u32x2 ow; ow.x = pk2(r[0], r[1]); ow.y = pk2(r[2], r[3]);
                        *(u32x2*)(o + off + bj * HALF + n * 16) = ow; }
                if (m & 1) asm volatile("" ::: "memory"); }
    }
};

template <class Epi, class Sched, bool ALIGN_EPI, bool SP2, bool FP8 = false>
__device__ __forceinline__ void gemm_phase(LAS unsigned char* lds, const Gemm g, const Sched& S, const Epi& E, int sw = 0x7f7f7f7f, int sa = 0x7f7f7f7f) {
    int tid_ = threadIdx.x; asm volatile("" : "+v"(tid_));
    const int tid = tid_, wid = __builtin_amdgcn_readfirstlane(tid >> 6), lane = tid & 63, wr = wid >> 2, wc = wid & 3, fr = lane & 15, fq = lane >> 4;
    const int K = g.K, nt = K / BK;
    constexpr bool GA = Sched::GATHER;
    unsigned voffA[2], voffB[2];
#pragma unroll
    for (int i = 0; i < 2; ++i) { int R, C; stage_rc(tid * 16 + i * 8192, R, C); const int Rb = Epi::PERM ? ((R & ~31) + perm32(R & 31)) : R;
        voffA[i] = (unsigned)(R * K + C) * 2u; voffB[i] = (unsigned)(Rb * K + C) * 2u; }
    const size_t kstep = (size_t)(BK * 2);
    const size_t hstep = (size_t)HALF * K * 2;
    const unsigned ldsw = (unsigned)wid * 1024u;
    const int aoff = lds_byte(wr * 64 + fr, fq * 8), boff = lds_byte(wc * 32 + fr, fq * 8);
#define PG8_SA(b, h) (((b) * 2 + (h)) * HTB)
#define PG8_SB(b, h) ((4 + (b) * 2 + (h)) * HTB)
#define PG8_STAGE(bufoff, gbase, voff) do { _Pragma("unroll") for (int _i = 0; _i < 2; ++_i) \
        __builtin_amdgcn_global_load_lds((const unsigned*)((const char*)(gbase) + (voff)[_i]), (LAS unsigned*)(lds + (bufoff) + ldsw + _i * 8192), 16, 0, 0); } while (0)
#define PG8_LDA(dst, b, h) do { _Pragma("unroll") for (int m = 0; m < 4; ++m) _Pragma("unroll") for (int k = 0; k < 2; ++k) dst[m][k] = *(const LAS bf16x8*)(lds + PG8_SA(b, h) + aoff + m * 2048 + k * 1024); } while (0)
#define PG8_LDB(dst, b, h) do { _Pragma("unroll") for (int n = 0; n < 2; ++n) _Pragma("unroll") for (int k = 0; k < 2; ++k) dst[n][k] = *(const LAS bf16x8*)(lds + PG8_SB(b, h) + boff + n * 2048 + k * 1024); } while (0)
#define PG8_CAT(x) __builtin_shufflevector(__builtin_bit_cast(i32x4, (x)[0]), __builtin_bit_cast(i32x4, (x)[1]), 0, 1, 2, 3, 4, 5, 6, 7)
#define PG8_MMA(ai, bj, At, Bt) do { __builtin_amdgcn_s_setprio(1); _Pragma("unroll") for (int m = 0; m < 4; ++m) _Pragma("unroll") for (int n = 0; n < 2; ++n) { \
        if constexpr (FP8) { const i32x8 a8_ = PG8_CAT(Bt[n]), b8_ = PG8_CAT(At[m]); \
            asm volatile("v_mfma_scale_f32_16x16x128_f8f6f4 %0, %1, %2, %0, %3, %4 op_sel_hi:[0,0,0]" : "+v"(acc[ai][bj][m][n]) : "v"(a8_), "v"(b8_), "v"(sw), "v"(sa)); } \
        else { _Pragma("unroll") for (int k = 0; k < 2; ++k) acc[ai][bj][m][n] = __builtin_amdgcn_mfma_f32_16x16x32_bf16(Bt[n][k], At[m][k], acc[ai][bj][m][n], 0, 0, 0); } } \
        __builtin_amdgcn_s_setprio(0); } while (0)
#define PG8_WAIT_V(n) asm volatile("s_waitcnt vmcnt(" #n ")" ::: "memory")
#define PG8_WAIT_L(n) asm volatile("s_waitcnt lgkmcnt(" #n ")" ::: "memory")
#define PG8_BAR __builtin_amdgcn_s_barrier()
#define PG8_SCHED __builtin_amdgcn_sched_barrier(0)
    Unit cur, nxt; int ui = 0;
    if (!S.next(0, cur)) return;
    f32x4 acc[2][2][4][2];
#pragma unroll
    for (int a = 0; a < 2; ++a)
#pragma unroll
        for (int b = 0; b < 2; ++b)
#pragma unroll
            for (int m = 0; m < 4; ++m)
#pragma unroll
                for (int n = 0; n < 2; ++n) acc[a][b][m][n] = (f32x4){0.f, 0.f, 0.f, 0.f};
    bf16x8 At[4][2], B0[2][2], B1[2][2];
    const char* Ab = (const char*)g.A + S.a_base(cur);
    unsigned oc[2][2];
    S.a_offs(0, cur, tid, oc);
    const size_t hsA = GA ? (size_t)0 : hstep;
#define PG8_STAGE_A(bufoff, gbase, h) do { if constexpr (GA) PG8_STAGE(bufoff, gbase, oc[h]); else PG8_STAGE(bufoff, (gbase) + (h) * hsA, voffA); } while (0)
    const char* cB = (const char*)g.Bt + cur.bofs;
    if constexpr (SP2) {
        PG8_STAGE(PG8_SB(0, 0), cB, voffB); PG8_STAGE(PG8_SB(0, 1), cB + hstep, voffB); PG8_STAGE_A(PG8_SA(0, 0), Ab, 0); PG8_STAGE_A(PG8_SA(0, 1), Ab, 1);
        if (wr == 1) PG8_BAR;
        PG8_WAIT_V(2); PG8_BAR;
        PG8_STAGE(PG8_SB(1, 0), cB + kstep, voffB); PG8_STAGE_A(PG8_SA(1, 0), Ab + kstep, 0); PG8_STAGE(PG8_SB(1, 1), cB + hstep + kstep, voffB);
        PG8_WAIT_V(6); PG8_BAR;
    } else {
        PG8_STAGE(PG8_SB(0, 0), cB, voffB); PG8_STAGE_A(PG8_SA(0, 0), Ab, 0); PG8_STAGE(PG8_SB(0, 1), cB + hstep, voffB); PG8_STAGE_A(PG8_SA(0, 1), Ab, 1);
        if (wr == 1) PG8_BAR;
        PG8_WAIT_V(4); PG8_BAR;
        PG8_STAGE(PG8_SB(1, 0), cB + kstep, voffB); PG8_STAGE_A(PG8_SA(1, 0), Ab + kstep, 0); PG8_STAGE(PG8_SB(1, 1), cB + hstep + kstep, voffB);
        PG8_WAIT_V(6); PG8_BAR;
    }
    for (;;) {
        const bool has_next = S.next(ui + 1, nxt);
        const char* nB = has_next ? (const char*)g.Bt + nxt.bofs : cB;
        for (int t = 0; t < nt; t += 2) {
            const bool last = (t == nt - 2);
            const char* a1 = Ab + (size_t)(t + 1) * kstep;
            const char* b2 = last ? nB : cB + (size_t)(t + 2) * kstep; const char* b3 = b2 + kstep;
            if constexpr (SP2) {
            PG8_LDB(B0, 0, 0); PG8_LDB(B1, 0, 1); PG8_SCHED; PG8_LDA(At, 0, 0); PG8_STAGE_A(PG8_SA(1, 1), a1, 1);
            if (last && has_next) { S.a_offs(ui + 1, nxt, tid, oc); Ab = (const char*)g.A + S.a_base(nxt); }
            const char* a2 = last ? Ab : Ab + (size_t)(t + 2) * kstep; const char* a3 = a2 + kstep;
            PG8_WAIT_V(8); PG8_WAIT_L(0); PG8_BAR; PG8_MMA(0, 0, At, B0); PG8_MMA(0, 1, At, B1); PG8_BAR; PG8_SCHED;
            PG8_LDA(At, 0, 1); PG8_STAGE(PG8_SB(0, 0), b2, voffB); PG8_STAGE(PG8_SB(0, 1), b2 + hstep, voffB); PG8_STAGE_A(PG8_SA(0, 0), a2, 0);
            PG8_WAIT_V(8); PG8_WAIT_L(0); PG8_BAR; PG8_MMA(1, 0, At, B0); PG8_MMA(1, 1, At, B1); PG8_BAR; PG8_SCHED;
            PG8_LDB(B0, 1, 0); PG8_LDB(B1, 1, 1); PG8_SCHED; PG8_LDA(At, 1, 0); PG8_STAGE_A(PG8_SA(0, 1), a2, 1);
            PG8_WAIT_V(8); PG8_WAIT_L(0); PG8_BAR; PG8_MMA(0, 0, At, B0); PG8_MMA(0, 1, At, B1); PG8_BAR; PG8_SCHED;
            PG8_LDA(At, 1, 1); PG8_STAGE(PG8_SB(1, 0), b3, voffB); PG8_STAGE(PG8_SB(1, 1), b3 + hstep, voffB); PG8_STAGE_A(PG8_SA(1, 0), a3, 0);
            PG8_WAIT_V(8); PG8_WAIT_L(0); PG8_BAR; PG8_MMA(1, 0, At, B0); PG8_MMA(1, 1, At, B1); PG8_BAR; PG8_SCHED;
            } else {
            PG8_LDB(B0, 0, 0); PG8_SCHED; PG8_LDA(At, 0, 0); PG8_STAGE_A(PG8_SA(1, 1), a1, 1);
            if (last && has_next) { S.a_offs(ui + 1, nxt, tid, oc); Ab = (const char*)g.A + S.a_base(nxt); }
            const char* a2 = last ? Ab : Ab + (size_t)(t + 2) * kstep; const char* a3 = a2 + kstep;
            PG8_WAIT_L(8); PG8_BAR; PG8_WAIT_L(0); PG8_MMA(0, 0, At, B0); PG8_BAR; PG8_SCHED;
            PG8_LDB(B1, 0, 1); PG8_STAGE(PG8_SB(0, 0), b2, voffB);
            PG8_BAR; PG8_WAIT_L(0); PG8_MMA(0, 1, At, B1); PG8_BAR;
            PG8_LDA(At, 0, 1); PG8_STAGE_A(PG8_SA(0, 0), a2, 0);
            PG8_BAR; PG8_WAIT_L(0); PG8_MMA(1, 0, At, B0); PG8_BAR; PG8_SCHED;
            PG8_STAGE(PG8_SB(0, 1), b2 + hstep, voffB);
            PG8_WAIT_V(6); PG8_BAR; PG8_MMA(1, 1, At, B1); PG8_BAR;
            PG8_LDB(B0, 1, 0); PG8_SCHED; PG8_LDA(At, 1, 0); PG8_STAGE_A(PG8_SA(0, 1), a2, 1);
            PG8_WAIT_L(8); PG8_BAR; PG8_WAIT_L(0); PG8_MMA(0, 0, At, B0); PG8_BAR; PG8_SCHED;
            PG8_LDB(B1, 1, 1); PG8_STAGE(PG8_SB(1, 0), b3, voffB);
            PG8_BAR; PG8_WAIT_L(0); PG8_MMA(0, 1, At, B1); PG8_BAR;
            PG8_LDA(At, 1, 1); PG8_STAGE_A(PG8_SA(1, 0), a3, 0);
            PG8_BAR; PG8_WAIT_L(0); PG8_MMA(1, 0, At, B0); PG8_BAR; PG8_SCHED;
            PG8_STAGE(PG8_SB(1, 1), b3 + hstep, voffB);
            PG8_WAIT_V(6); PG8_BAR; PG8_MMA(1, 1, At, B1); PG8_BAR;
            }
        }
        if constexpr (ALIGN_EPI) { if (wr == 0) PG8_BAR; }
        if constexpr (FP8) asm volatile("s_nop 15\n\ts_nop 15\n\ts_nop 15" ::: "memory");
        E(acc, cur, wr, wc, fr, fq);
        if (!has_next) break;
#pragma unroll
        for (int a = 0; a < 2; ++a)
#pragma unroll
            for (int b = 0; b < 2; ++b)
#pragma unroll
                for (int m = 0; m < 4; ++m)
#pragma unroll
                    for (int n = 0; n < 2; ++n) acc[a][b][m][n] = (f32x4){0.f, 0.f, 0.f, 0.f};
        cur = nxt; cB = nB; ++ui;
        if constexpr (ALIGN_EPI) { if (wr == 1) PG8_BAR; }
    }
    PG8_WAIT_V(0);
    if constexpr (!ALIGN_EPI) { if (wr == 0) PG8_BAR; }
    PG8_BAR;
#undef PG8_SA
#undef PG8_SB
#undef PG8_STAGE
#undef PG8_STAGE_A
#undef PG8_LDA
#undef PG8_LDB
#undef PG8_MMA
#undef PG8_CAT
#undef PG8_WAIT_V
#undef PG8_WAIT_L
#undef PG8_BAR
#undef PG8_SCHED
}
}

#define XB_TMO      128
#define XB_XCNT(j)  (256  + 64 * (j))
#define XB_XSUB(j)  (1280 + 64 * (j))
#define XB_XGEN(j)  (2304 + 64 * (j))
#define XB_TOP      3328
#define XB_TOPGEN   3392
#define XCD_BAR_WORDS 3456
#define XB_SPIN_CAP (1u << 18)
__device__ __forceinline__ unsigned xb_ld(unsigned* p)              { return __hip_atomic_load(p, __ATOMIC_RELAXED, __HIP_MEMORY_SCOPE_AGENT); }
__device__ __forceinline__ unsigned xb_add(unsigned* p, unsigned v) { return __hip_atomic_fetch_add(p, v, __ATOMIC_RELAXED, __HIP_MEMORY_SCOPE_AGENT); }
__device__ __forceinline__ unsigned xb_xcc_id() { return (unsigned)__builtin_amdgcn_s_getreg((3 << 11) | 20) & 0xFu; }
#define XB_SPIN(cond, bar) do { unsigned _sp = 0; while (cond) { __builtin_amdgcn_s_sleep(1); \
    if ((++_sp & 255u) == 0u) { if (xb_ld(&(bar)[XB_TMO])) break; if (_sp > XB_SPIN_CAP) { atomicAdd(&(bar)[XB_TMO], 1u); break; } } } } while (0)
struct XcdBarrier { unsigned* bar; unsigned x; volatile LAS unsigned* st; };
__device__ __forceinline__ XcdBarrier xcd_barrier_post(unsigned* bar, volatile LAS unsigned* st) {
    XcdBarrier b; b.bar = bar; b.x = xb_xcc_id(); b.st = st;
    if (threadIdx.x == 0) (void)xb_add(&bar[XB_XCNT(b.x)], 1u);
    return b;
}
__device__ __forceinline__ void xcd_barrier_complete(unsigned* bar, unsigned x, unsigned& nloc, unsigned& nx) {
    const unsigned G = gridDim.x * gridDim.y * gridDim.z;
    unsigned sum, cnt, mine, sp = 0u;
    for (;;) {
        sum = 0u; cnt = 0u; mine = 0u;
#pragma unroll
        for (unsigned j = 0; j < 16; ++j) { const unsigned c = xb_ld(&bar[XB_XCNT(j)]); sum += c; cnt += (c > 0u) ? 1u : 0u; mine = (j == x) ? c : mine; }
        if (sum == G) break;
        __builtin_amdgcn_s_sleep(1);
        if ((++sp & 255u) == 0u) { if (xb_ld(&bar[XB_TMO])) break; if (sp > XB_SPIN_CAP) { atomicAdd(&bar[XB_TMO], 1u); break; } }
    }
    nloc = mine > 0u ? mine : 1u; nx = cnt > 0u ? cnt : 1u;
}
__device__ __forceinline__ void xcd_barrier(const XcdBarrier& b) {
    asm volatile("s_waitcnt vmcnt(0)" ::: "memory");
    __syncthreads();
    if (threadIdx.x == 0) {
        unsigned* bar = b.bar;
        __builtin_amdgcn_s_waitcnt(0);
        unsigned nloc = b.st[0], nx = b.st[1];
        if (nloc == 0u) { xcd_barrier_complete(bar, b.x, nloc, nx); b.st[0] = nloc; b.st[1] = nx; }
        const unsigned old = xb_add(&bar[XB_XSUB(b.x)], 1u);
        const unsigned gen = old / nloc;
        if (old + 1u == (gen + 1u) * nloc) {
            __builtin_amdgcn_fence(__ATOMIC_RELEASE, "agent");
            asm volatile("s_waitcnt vmcnt(0)" ::: "memory");
            const unsigned og = xb_add(&bar[XB_TOP], 1u);
            const unsigned tg = og / nx;
            if (og + 1u == (tg + 1u) * nx) xb_add(&bar[XB_TOPGEN], 1u);
            else XB_SPIN(xb_ld(&bar[XB_TOPGEN]) == tg, bar);
            __builtin_amdgcn_fence(__ATOMIC_ACQUIRE, "agent");
            xb_add(&bar[XB_XGEN(b.x)], 1u);
            asm volatile("s_waitcnt vmcnt(0)" ::: "memory");
        } else {
            XB_SPIN(xb_ld(&bar[XB_XGEN(b.x)]) == gen, bar);
            __builtin_amdgcn_fence(__ATOMIC_ACQUIRE, "agent");
            asm volatile("s_waitcnt vmcnt(0)" ::: "memory");
        }
    }
    __syncthreads();
}

constexpr int NT = 512, NWAVES = 8;
struct Args { const float* in[24]; float* out; unsigned char* ws; int ph_lo, ph_hi; };
enum { I_X = 0, I_C, I_CTX, I_CCTX, I_WMOD, I_BMOD, I_WIN, I_WOUT, I_RPB, I_CONVW, I_CONVB, I_DTB, I_ALOG, I_DSKIP, I_NORMW, I_LNG, I_LNB, I_FG, I_FU, I_FD, I_RW, I_MG, I_MU, I_MD };
struct Frame {
    LAS unsigned char* lds;
    const float* const* in; float* out; unsigned char* ws;
    int tid, lane, wave, bid, G, gw, NGW;
};
#define LDS_WAIT() asm volatile("s_waitcnt lgkmcnt(0)" ::: "memory")
__device__ __forceinline__ Frame fresh(const Frame& F0) {
    Frame F = F0; int z; asm volatile("s_mov_b32 %0, 0" : "=s"(z)); F.ws = F0.ws + z; F.in = F0.in + z; F.out = F0.out + z;
    int t = F0.tid; asm volatile("" : "+v"(t)); F.tid = t; F.lane = t & 63; return F;
}

__device__ __forceinline__ void conv_item(const float* W, int ldn, int k0, int n0, bf16_t* dst, int K, int drow0, LAS float* scr, int lane) {
#pragma unroll 8
    for (int i = 0; i < 32; ++i) { const int kk = 2 * i + (lane >> 5); scr[kk * 33 + (lane & 31)] = W[(size_t)(k0 + kk) * ldn + n0 + (lane & 31)]; }
    LDS_WAIT(); asm volatile("" ::: "memory");
    const int c = lane & 7;
#pragma unroll
    for (int j = 0; j < 4; ++j) { const int n = (lane >> 3) + 8 * j; const LAS float* s = scr + (8 * c) * 33 + n;
        u32x4 o; o.x = pk2(s[0 * 33], s[1 * 33]); o.y = pk2(s[2 * 33], s[3 * 33]); o.z = pk2(s[4 * 33], s[5 * 33]); o.w = pk2(s[6 * 33], s[7 * 33]);
        *(u32x4*)(dst + (size_t)(drow0 + n) * K + k0 + 8 * c) = o; }
    LDS_WAIT(); asm volatile("" ::: "memory");
}
__device__ __forceinline__ void conv_item8(const float* W, int ldn, int k0, int n0, unsigned char* dst, int K, int drow0, float scale, LAS float* scr, int lane) {
#pragma unroll 8
    for (int i = 0; i < 32; ++i) { const int kk = 2 * i + (lane >> 5); scr[kk * 33 + (lane & 31)] = W[(size_t)(k0 + kk) * ldn + n0 + (lane & 31)] * scale; }
    LDS_WAIT(); asm volatile("" ::: "memory");
    const int c = lane & 7;
#pragma unroll
    for (int j = 0; j < 4; ++j) { const int n = (lane >> 3) + 8 * j; const LAS float* sp = scr + (8 * c) * 33 + n;
        u32x2 o; o.x = pk8(sp[0 * 33], sp[1 * 33], sp[2 * 33], sp[3 * 33]); o.y = pk8(sp[4 * 33], sp[5 * 33], sp[6 * 33], sp[7 * 33]);
        *(u32x2*)(dst + (size_t)(drow0 + n) * K + k0 + 8 * c) = o; }
    LDS_WAIT(); asm volatile("" ::: "memory");
}
__device__ __forceinline__ void conv_seg(const Frame& F, const float* W, int K, int ldn, int ncols, bf16_t* dst, int mode, int& rot, int s8 = -1) {
    LAS float* scr = (LAS float*)(F.lds + F.wave * 16384);
    const int nblk = ncols / 32, nitems = (K / 64) * nblk;
    int start = F.gw - rot; if (start < 0) start += F.NGW;
    for (int it = start; it < nitems; it += F.NGW) {
        const int kb = it / nblk, nb = it % nblk, n0 = nb * 32;
        const int drow0 = (mode == 0) ? n0 : ((n0 >> 7) * 256 + (n0 & 127) + (mode == 2 ? 128 : 0));
        if (s8 >= 0) conv_item8(W, ldn, kb * 64, n0, (unsigned char*)dst, K, drow0, (float)(1 << s8), scr, F.lane);
        else conv_item(W, ldn, kb * 64, n0, dst, K, drow0, scr, F.lane);
    }
    rot = (rot + nitems) % F.NGW;
}
__device__ __forceinline__ void conv_moe(const Frame& F, int slot, int& rot) {
#if USE_FP8
    unsigned char* gu = F.ws + WS_WMGU + (size_t)slot * NEXP * 2 * DFFE * D; unsigned char* dn = F.ws + WS_WMD + (size_t)slot * NEXP * D * DFFE;
    for (int e = 0; e < NEXP; ++e) {
        const size_t so = ((size_t)slot * NEXP + e) * (size_t)D * DFFE;
        conv_seg(F, F.in[I_MG] + so, D, DFFE, DFFE, (bf16_t*)(gu + (size_t)e * 2 * DFFE * D), 1, rot, S8_WGU);
        conv_seg(F, F.in[I_MU] + so, D, DFFE, DFFE, (bf16_t*)(gu + (size_t)e * 2 * DFFE * D), 2, rot, S8_WGU);
        conv_seg(F, F.in[I_MD] + so, DFFE, D, D, (bf16_t*)(dn + (size_t)e * D * DFFE), 0, rot, S8_WD);
    }
#else
    bf16_t* gu = (bf16_t*)(F.ws + WS_WMGU); bf16_t* dn = (bf16_t*)(F.ws + WS_WMD);
    for (int e = 0; e < NEXP; ++e) {
        const size_t so = ((size_t)slot * NEXP + e) * (size_t)D * DFFE;
        conv_seg(F, F.in[I_MG] + so, D, DFFE, DFFE, gu + (size_t)e * 2 * DFFE * D, 1, rot);
        conv_seg(F, F.in[I_MU] + so, D, DFFE, DFFE, gu + (size_t)e * 2 * DFFE * D, 2, rot);
        conv_seg(F, F.in[I_MD] + so, DFFE, D, D, dn + (size_t)e * D * DFFE, 0, rot);
    }
#endif
}

__device__ __forceinline__ void p_pro_a(const Frame& F) {
    {
        LAS float* sc = (LAS float*)F.lds; LAS float* red = sc + 17 * 1024;
        const float* c = F.in[I_C]; const float* cc = F.in[I_CCTX];
        for (int i = F.tid; i < 17 * 1024; i += NT) { const int r = i >> 10, k = i & 1023; const float v = (r < 16) ? c[r * 1024 + k] : cc[k]; sc[i] = silu_f(v); }
        __syncthreads();
        float* MOD = (float*)(F.ws + WS_MOD);
        const int col = F.tid & 63, ks = F.tid >> 6;
        for (int u = F.bid; u < 4 * 96; u += F.G) {
            const int l = u / 96, cb = u % 96;
            const float* W = F.in[I_WMOD] + (size_t)l * D * MODW + cb * 64 + col;
            float acc[17];
#pragma unroll
            for (int r = 0; r < 17; ++r) acc[r] = 0.f;
            for (int k = ks * 128; k < ks * 128 + 128; ++k) { const float w = W[(size_t)k * MODW];
#pragma unroll
                for (int r = 0; r < 17; ++r) acc[r] += sc[r * 1024 + k] * w; }
#pragma unroll
            for (int r = 0; r < 17; ++r) red[(ks * 17 + r) * 64 + col] = acc[r];
            __syncthreads();
            for (int i = F.tid; i < 17 * 64; i += NT) { const int r = i >> 6, c2 = i & 63; float s = 0.f;
#pragma unroll
                for (int k2 = 0; k2 < 8; ++k2) s += red[(k2 * 17 + r) * 64 + c2];
                MOD[(size_t)(l * 17 + r) * MODW + cb * 64 + c2] = s + F.in[I_BMOD][l * MODW + cb * 64 + c2]; }
            __syncthreads();
        }
    }
    int rot = 0;
    for (int l = 0; l < DEPTH; ++l) {
#if USE_FP8 && FP8_INPROJ
        conv_seg(F, F.in[I_WIN] + (size_t)l * D * D_IN_PROJ, D, D_IN_PROJ, NPROJ, (bf16_t*)(F.ws + WS_WIN + (size_t)l * NPROJ * D), 0, rot, S8_WGU);
#else
        conv_seg(F, F.in[I_WIN] + (size_t)l * D * D_IN_PROJ, D, D_IN_PROJ, NPROJ, (bf16_t*)(F.ws + WS_WIN) + (size_t)l * NPROJ * D, 0, rot);
#endif
        conv_seg(F, F.in[I_WOUT] + (size_t)l * D * D, D, D, D, (bf16_t*)(F.ws + WS_WOUT) + (size_t)l * D * D, 0, rot);
    }
    for (int s = 0; s < 2; ++s) {
#if USE_FP8 && FP8_DENSE
        conv_seg(F, F.in[I_FG] + (size_t)s * D * DFF, D, DFF, DFF, (bf16_t*)(F.ws + WS_WFGU + (size_t)s * 2 * DFF * D), 1, rot, S8_WGU);
        conv_seg(F, F.in[I_FU] + (size_t)s * D * DFF, D, DFF, DFF, (bf16_t*)(F.ws + WS_WFGU + (size_t)s * 2 * DFF * D), 2, rot, S8_WGU);
        conv_seg(F, F.in[I_FD] + (size_t)s * DFF * D, DFF, D, D, (bf16_t*)(F.ws + WS_WFD + (size_t)s * D * DFF), 0, rot, S8_WD);
#else
        conv_seg(F, F.in[I_FG] + (size_t)s * D * DFF, D, DFF, DFF, (bf16_t*)(F.ws + WS_WFGU) + (size_t)s * 2 * DFF * D, 1, rot);
        conv_seg(F, F.in[I_FU] + (size_t)s * D * DFF, D, DFF, DFF, (bf16_t*)(F.ws + WS_WFGU) + (size_t)s * 2 * DFF * D, 2, rot);
        conv_seg(F, F.in[I_FD] + (size_t)s * DFF * D, DFF, D, D, (bf16_t*)(F.ws + WS_WFD) + (size_t)s * D * DFF, 0, rot);
#endif
    }
    conv_moe(F, 0, rot);
#if USE_FP8
    conv_moe(F, 1, rot);
#endif
    { bf16_t* wdt = (bf16_t*)(F.ws + WS_WDT);
      for (int i = F.bid * NT + F.tid; i < DEPTH * 16 * D; i += F.G * NT) { const int l = i / (16 * D), n = (i / D) & 15, k = i % D;
          wdt[i] = (bf16_t)f2bf(F.in[I_WIN][((size_t)l * D + k) * D_IN_PROJ + NPROJ + n]); } }
}

__device__ __forceinline__ void row_load(const float* p, int lane, f32x4 (&v)[4]) {
#pragma unroll
    for (int j = 0; j < 4; ++j) v[j] = *(const f32x4*)(p + 4 * lane + 256 * j);
}
__device__ __forceinline__ void row_store(float* p, int lane, const f32x4 (&v)[4]) {
#pragma unroll
    for (int j = 0; j < 4; ++j) *(f32x4*)(p + 4 * lane + 256 * j) = v[j];
}
__device__ __forceinline__ void row_mod_store8(unsigned char* hrow, int lane, const f32x4 (&v)[4], const float* sh, const float* sc, f32x4 (&hv)[4]) {
#pragma unroll
    for (int j = 0; j < 4; ++j) { const f32x4 a = *(const f32x4*)(sc + 4 * lane + 256 * j), b = *(const f32x4*)(sh + 4 * lane + 256 * j);
        hv[j] = v[j] * (a + 1.0f) + b; const f32x4 q = hv[j] * (float)(1 << S8_ACT);
        *(unsigned*)(hrow + 4 * lane + 256 * j) = pk8(q[0], q[1], q[2], q[3]); }
}
__device__ __forceinline__ void row_store8(unsigned char* hrow, int lane, const f32x4 (&hv)[4]) {
#pragma unroll
    for (int j = 0; j < 4; ++j) { const f32x4 q = hv[j] * (float)(1 << S8_ACT); *(unsigned*)(hrow + 4 * lane + 256 * j) = pk8(q[0], q[1], q[2], q[3]); }
}
__device__ __forceinline__ void row_load_h(const bf16_t* p, int lane, f32x4 (&v)[4]) {
#pragma unroll
    for (int j = 0; j < 4; ++j) { const u32x2 w = *(const u32x2*)(p + 4 * lane + 256 * j); v[j] = (f32x4){bflo(w.x), bfhi(w.x), bflo(w.y), bfhi(w.y)}; }
}
__device__ __forceinline__ void row_store_h(bf16_t* p, int lane, const f32x4 (&v)[4]) {
#pragma unroll
    for (int j = 0; j < 4; ++j) { u32x2 w; w.x = pk2(v[j][0], v[j][1]); w.y = pk2(v[j][2], v[j][3]); *(u32x2*)(p + 4 * lane + 256 * j) = w; }
}
__device__ __forceinline__ void row_mod_store(bf16_t* hrow, int lane, const f32x4 (&v)[4], const float* sh, const float* sc, f32x4 (&hv)[4]) {
#pragma unroll
    for (int j = 0; j < 4; ++j) { const f32x4 a = *(const f32x4*)(sc + 4 * lane + 256 * j), b = *(const f32x4*)(sh + 4 * lane + 256 * j);
        hv[j] = v[j] * (a + 1.0f) + b;
        u32x2 w; w.x = pk2(hv[j][0], hv[j][1]); w.y = pk2(hv[j][2], hv[j][3]);
        *(u32x2*)(hrow + 4 * lane + 256 * j) = w; }
}
__device__ __forceinline__ void row_ln(f32x4 (&v)[4], const float* g, const float* b, int lane) {
    float s = 0.f;
#pragma unroll
    for (int j = 0; j < 4; ++j) s += (v[j][0] + v[j][1]) + (v[j][2] + v[j][3]);
    const float mean = wave_sum(s) * (1.0f / D); float q = 0.f;
#pragma unroll
    for (int j = 0; j < 4; ++j) { v[j] = v[j] - mean; q += (v[j][0] * v[j][0] + v[j][1] * v[j][1]) + (v[j][2] * v[j][2] + v[j][3] * v[j][3]); }
    const float rstd = 1.0f / sqrtf(wave_sum(q) * (1.0f / D) + LN_EPS);
#pragma unroll
    for (int j = 0; j < 4; ++j) { const f32x4 gg = *(const f32x4*)(g + 4 * lane + 256 * j), bb = *(const f32x4*)(b + 4 * lane + 256 * j); v[j] = v[j] * rstd * gg + bb; }
}
__device__ __forceinline__ int mod_row_of(int row) { return row < NLAT ? (row >> 11) : 16; }

__device__ __forceinline__ void p_pro_b(const Frame& F) {
    const float* MOD = (const float*)(F.ws + WS_MOD); bf16_t* H = (bf16_t*)(F.ws + WS_H);
    for (int row = F.gw; row < NTOK; row += F.NGW) {
        const float* src = row < NLAT ? F.in[I_X] + (size_t)row * D : F.in[I_CTX] + (size_t)(row - NLAT) * D;
        f32x4 v[4], hv[4]; row_load(src, F.lane, v);
        const float* m = MOD + (size_t)mod_row_of(row) * MODW;
        row_mod_store(H + (size_t)row * D, F.lane, v, m, m + D, hv);
        if (USE_FP8 && FP8_INPROJ) row_store8(F.ws + WS_H8IN + (size_t)row * D, F.lane, hv);
    }
}

__device__ __forceinline__ void p_inproj(const Frame& F, int layer) {
    const bf16_t* H = (const bf16_t*)(F.ws + WS_H);
    {
        const bf16_t* wdt = (const bf16_t*)(F.ws + WS_WDT) + (size_t)layer * 16 * D; float* DT = (float*)(F.ws + WS_DT);
        const int fr = F.lane & 15, fq = F.lane >> 4;
        for (int g = F.gw; g < NTOK / 16; g += F.NGW) {
            f32x4 acc = {0.f, 0.f, 0.f, 0.f};
            const bf16_t* ap = H + (size_t)(g * 16 + fr) * D + fq * 8; const bf16_t* bp = wdt + (size_t)fr * D + fq * 8;
#pragma unroll 8
            for (int ks = 0; ks < 32; ++ks) { const bf16x8 a = *(const bf16x8*)(ap + ks * 32), b = *(const bf16x8*)(bp + ks * 32);
                acc = __builtin_amdgcn_mfma_f32_16x16x32_bf16(a, b, acc, 0, 0, 0); }
#pragma unroll
            for (int r = 0; r < 4; ++r) DT[(size_t)(g * 16 + fq * 4 + r) * 16 + fr] = acc[r];
        }
    }
    pg8::EpiBf16 E{(bf16_t*)(F.ws + WS_PROJ), NPROJ};
#if USE_FP8 && FP8_INPROJ
    pg8::Gemm g{(const bf16_t*)(F.ws + WS_H8IN), (const bf16_t*)(F.ws + WS_WIN + (size_t)layer * NPROJ * D), D / 2};
    pg8::DenseOrder S; S.init(NTOK, NPROJ, D / 2, F.G, F.bid, REP_GEMM);
    pg8::gemm_phase<pg8::EpiBf16, pg8::DenseOrder, true, FP8_SP2, true>(F.lds, g, S, E, (127 - S8_WGU) * 0x01010101, (127 - S8_ACT) * 0x01010101);
#else
    pg8::Gemm g{H, (const bf16_t*)(F.ws + WS_WIN) + (size_t)layer * NPROJ * D, D};
    pg8::DenseOrder S; S.init(NTOK, NPROJ, D, F.G, F.bid, REP_GEMM);
    pg8::gemm_phase<pg8::EpiBf16, pg8::DenseOrder, true, true>(F.lds, g, S, E);
#endif
}

typedef short s16x4 __attribute__((ext_vector_type(4)));
__device__ __forceinline__ s16x4 lds_tr16(LAS const unsigned char* p) { return __builtin_bit_cast(s16x4, __builtin_amdgcn_ds_read_tr16_b64_v4i16((LAS s16x4*)p)); }
constexpr int NA_KS = 144;
constexpr float LOG2E = 1.4426950408889634f;
__device__ __forceinline__ void na_unit(const Frame& F, int layer, int b, int h, int mode, int m) {
    LAS unsigned char* KV = F.lds;
    LAS float* rp = (LAS float*)(F.lds + 120832);
    const bf16_t* PROJ = (const bf16_t*)(F.ws + WS_PROJ); bf16_t* MIX = (bf16_t*)(F.ws + WS_MIX);
    const int tid = F.tid, lane = F.lane, w = F.wave, q16 = lane & 15, g = lane >> 4;
    int rbase = 0, nk = 0;
    if (mode == 0) { rbase = 2 * m - 4; rbase = rbase < 0 ? 0 : (rbase > 24 ? 24 : rbase); nk = 32 - rbase; nk = nk > 9 ? 9 : nk; }
    const int kfirst = (mode == 0) ? 0 : 576 * 8, nloc8 = nk * 64 * 8;
    __syncthreads();
    for (int i = tid + kfirst; i < 832 * 8; i += NT) { const int key = i >> 3, ch = i & 7;
        if (key < 576 && i >= nloc8) continue;
        const int grow = key < 576 ? b * SEQ + rbase * 64 + key : NLAT + b * CTX + (key - 576);
        *(LAS u32x4*)(KV + key * NA_KS + ch * 16) = *(const u32x4*)(PROJ + (size_t)grow * NPROJ + OFF_K + h * 64 + ch * 8); }
    if (mode == 0 && tid < 465) rp[tid] = F.in[I_RPB][(size_t)(layer * 8 + h) * 465 + tid] * LOG2E;
    __syncthreads();
    int i = 0, j0 = 0, hs = 0, kr0 = 0, qrow;
    if (mode == 0) { i = 2 * m + (w >> 2); j0 = (w & 3) * 16; qrow = b * SEQ + i * 64 + j0; hs = j0 - 8; hs = hs < 0 ? 0 : (hs > 32 ? 32 : hs);
        int r0 = i - 4; r0 = r0 < 0 ? 0 : (r0 > 24 ? 24 : r0); kr0 = r0 - rbase; }
    else qrow = NLAT + b * CTX + m * 128 + w * 16;
    bf16x8 qf[2];
#pragma unroll
    for (int ks = 0; ks < 2; ++ks) qf[ks] = *(const bf16x8*)(PROJ + (size_t)(qrow + q16) * NPROJ + h * 64 + ks * 32 + g * 8);
    f32x4 S[32];
    const LAS unsigned char* kb = KV + q16 * NA_KS + g * 16;
    if (mode == 0) {
        const int j = j0 + q16; int cs = j - 8; cs = cs < 0 ? 0 : (cs > 48 ? 48 : cs);
        const int rb0 = (kr0 + rbase) - i + 7;
#pragma unroll
        for (int tl = 0; tl < 16; ++tl) { const int kr = tl >> 1, half = tl & 1; const int kidx0 = (kr0 + kr) * 64 + hs + 16 * half;
            f32x4 a = {0.f, 0.f, 0.f, 0.f};
#pragma unroll
            for (int ks = 0; ks < 2; ++ks) { const bf16x8 kf = *(const LAS bf16x8*)(kb + kidx0 * NA_KS + ks * 64); a = __builtin_amdgcn_mfma_f32_16x16x32_bf16(kf, qf[ks], a, 0, 0, 0); }
#pragma unroll
            for (int r = 0; r < 4; ++r) { const int kc = hs + 16 * half + 4 * g + r; const bool inw = (kc >= cs) && (kc < cs + 16);
                int cbi = kc - j + 15; cbi = cbi < 0 ? 0 : (cbi > 30 ? 30 : cbi);
                a[r] = inw ? a[r] * (0.125f * LOG2E) + rp[(rb0 + kr) * 31 + cbi] : -INFINITY; }
            S[tl] = a; if ((tl & 3) == 3) __builtin_amdgcn_sched_barrier(0); }
    } else {
#pragma unroll
        for (int tl = 0; tl < 16; ++tl) S[tl] = (f32x4){-INFINITY, -INFINITY, -INFINITY, -INFINITY};
    }
#pragma unroll
    for (int tc = 0; tc < 16; ++tc) { const int kidx0 = 576 + 16 * tc; f32x4 a = {0.f, 0.f, 0.f, 0.f};
#pragma unroll
        for (int ks = 0; ks < 2; ++ks) { const bf16x8 kf = *(const LAS bf16x8*)(kb + kidx0 * NA_KS + ks * 64); a = __builtin_amdgcn_mfma_f32_16x16x32_bf16(kf, qf[ks], a, 0, 0, 0); }
        S[16 + tc] = a * (0.125f * LOG2E); if ((tc & 3) == 3) __builtin_amdgcn_sched_barrier(0); }
    float mx = -INFINITY;
#pragma unroll
    for (int t = 0; t < 32; ++t) mx = fmaxf(fmaxf(fmaxf(S[t][0], S[t][1]), fmaxf(S[t][2], S[t][3])), mx);
    mx = fmaxf(mx, __shfl_xor(mx, 16)); mx = fmaxf(mx, __shfl_xor(mx, 32));
    float sum = 0.f; u32x4 P[16];
#pragma unroll
    for (int kk = 0; kk < 16; ++kk) { float e[8];
#pragma unroll
        for (int r = 0; r < 4; ++r) { e[r] = __builtin_amdgcn_exp2f(S[2 * kk][r] - mx); e[4 + r] = __builtin_amdgcn_exp2f(S[2 * kk + 1][r] - mx); }
        sum += ((e[0] + e[1]) + (e[2] + e[3])) + ((e[4] + e[5]) + (e[6] + e[7]));
        P[kk].x = pg8::cvt_pk_bf16_pin(e[0], e[1]); P[kk].y = pg8::cvt_pk_bf16_pin(e[2], e[3]); P[kk].z = pg8::cvt_pk_bf16_pin(e[4], e[5]); P[kk].w = pg8::cvt_pk_bf16_pin(e[6], e[7]); }
    sum += __shfl_xor(sum, 16); sum += __shfl_xor(sum, 32);
    const float inv = 1.0f / sum;
    __syncthreads();
    for (int i2 = tid + kfirst; i2 < 832 * 8; i2 += NT) { const int key = i2 >> 3, ch = i2 & 7;
        if (key < 576 && i2 >= nloc8) continue;
        const int grow = key < 576 ? b * SEQ + rbase * 64 + key : NLAT + b * CTX + (key - 576);
        *(LAS u32x4*)(KV + key * NA_KS + ch * 16) = *(const u32x4*)(PROJ + (size_t)grow * NPROJ + OFF_V + h * 64 + ch * 8); }
    __syncthreads();
    f32x4 o[4];
#pragma unroll
    for (int dt = 0; dt < 4; ++dt) o[dt] = (f32x4){0.f, 0.f, 0.f, 0.f};
    const LAS unsigned char* vb = KV + (4 * g + (q16 >> 2)) * NA_KS + (q16 & 3) * 8;
#pragma unroll
    for (int kk = 0; kk < 16; ++kk) {
        if (kk < 8 && mode != 0) continue;
        const int kidx0 = (kk < 8) ? (kr0 + kk) * 64 + hs : 576 + 32 * (kk - 8);
        const bf16x8 pa = __builtin_bit_cast(bf16x8, P[kk]);
#pragma unroll
        for (int dt = 0; dt < 4; ++dt) { const s16x4 lo = lds_tr16(vb + kidx0 * NA_KS + dt * 32), hi = lds_tr16(vb + (kidx0 + 16) * NA_KS + dt * 32);
            const bf16x8 vf = {lo[0], lo[1], lo[2], lo[3], hi[0], hi[1], hi[2], hi[3]};
            o[dt] = __builtin_amdgcn_mfma_f32_16x16x32_bf16(pa, vf, o[dt], 0, 0, 0); }
    }
#pragma unroll
    for (int r = 0; r < 4; ++r) { const float ir = __shfl(inv, 4 * g + r);
        bf16_t* op = MIX + (size_t)(qrow + 4 * g + r) * D + h * 64 + q16;
#pragma unroll
        for (int dt = 0; dt < 4; dt += 2) { const unsigned pw = pk2(o[dt][r] * ir, o[dt + 1][r] * ir); op[dt * 16] = (bf16_t)(pw & 0xffffu); op[dt * 16 + 16] = (bf16_t)(pw >> 16); } }
}

__device__ __forceinline__ void ssd_prepass_unit(const Frame& F, int layer, int u) {
    const bf16_t* PROJ = (const bf16_t*)(F.ws + WS_PROJ); bf16_t* U = (bf16_t*)(F.ws + WS_U); float* DT = (float*)(F.ws + WS_DT);
    int rowbase, t0, L; bool lat;
    if (u < NLAT / 16) { rowbase = (u >> 7) * SEQ; t0 = (u & 127) * 16; L = SEQ; lat = true; }
    else { const int v = u - NLAT / 16; rowbase = NLAT + (v >> 4) * CTX; t0 = (v & 15) * 16; L = CTX; lat = false; }
    const int c0 = 2 * F.tid;
    const float* cwp = F.in[I_CONVW] + (size_t)layer * 5 * 1024 + c0;
    f32x2 wj[5];
#pragma unroll
    for (int j = 0; j < 5; ++j) wj[j] = *(const f32x2*)(cwp + j * 1024);
    const f32x2 bj = *(const f32x2*)(F.in[I_CONVB] + (size_t)layer * 1024 + c0);
    if (F.tid < 256) { const int r = F.tid >> 4, j = F.tid & 15; float* p = DT + (size_t)(rowbase + t0 + r) * 16 + j;
        const float x = *p + F.in[I_DTB][layer * 16 + j]; *p = x > 20.f ? x : log1pf(__expf(x)); }
    const int lc = 2 * F.lane, hf = lc >> 6, role = (lc >> 5) & 1, n = lc & 31;
    const float if0 = __builtin_amdgcn_exp2f(-(float)n * (13.287712379549449f / 32.0f)) * 0.15915494309189535f;
    const float if1 = __builtin_amdgcn_exp2f(-(float)(n + 1) * (13.287712379549449f / 32.0f)) * 0.15915494309189535f;
    const bool rope = lat && (F.wave >= 4);
    unsigned win[5];
#pragma unroll
    for (int j = 0; j < 4; ++j) { const int t = t0 - 2 + j; win[j] = (t >= 0 && t < L) ? *(const unsigned*)(PROJ + (size_t)(rowbase + t) * NPROJ + OFF_XBC + c0) : 0u; }
#pragma unroll 4
    for (int tt = 0; tt < 16; ++tt) {
        const int t = t0 + tt + 2; win[4] = (t < L) ? *(const unsigned*)(PROJ + (size_t)(rowbase + t) * NPROJ + OFF_XBC + c0) : 0u;
        float a0 = bj[0], a1 = bj[1];
#pragma unroll
        for (int j = 0; j < 5; ++j) { a0 += wj[j][0] * bflo(win[j]); a1 += wj[j][1] * bfhi(win[j]); }
        float u0 = silu_f(a0), u1 = silu_f(a1);
        if (rope) {
            const int tk = t0 + tt; const float pos = (float)(hf ? (tk & 63) : (tk >> 6));
            const float o0 = __shfl_xor(u0, 16), o1 = __shfl_xor(u1, 16);
            const float s0 = __builtin_amdgcn_sinf(pos * if0), c0f = __builtin_amdgcn_cosf(pos * if0), s1 = __builtin_amdgcn_sinf(pos * if1), c1f = __builtin_amdgcn_cosf(pos * if1);
            u0 = role ? (o0 * s0 + u0 * c0f) : (u0 * c0f - o0 * s0);
            u1 = role ? (o1 * s1 + u1 * c1f) : (u1 * c1f - o1 * s1);
        }
        *(unsigned*)(U + (size_t)(rowbase + t0 + tt) * 1024 + c0) = pk2(u0, u1);
#pragma unroll
        for (int j = 0; j < 4; ++j) win[j] = win[j + 1];
    }
}

constexpr int S_CQ = 0, S_BQ = 17408, S_BT = 34816, S_XT = 53248, S_MQ = 62464, S_HB = 71680, S_MISC = 106496;
__device__ __forceinline__ void ssd_mfma_unit(const Frame& F, int layer, int b, int h, int dir) {
    const int g = h >> 2, tid = F.tid, lane = F.lane, w = F.wave, q16 = lane & 15, gq = lane >> 4;
    const bf16_t* U = (const bf16_t*)(F.ws + WS_U); const float* DTS = (const float*)(F.ws + WS_DT);
    float* Y = (float*)(F.ws + (dir ? WS_YB : WS_YF));
    const float aneg = -__expf(F.in[I_ALOG][layer * 16 + dir * 8 + h]), dsk = F.in[I_DSKIP][layer * 8 + h];
    LAS unsigned char* L = F.lds;
    __syncthreads();
    for (int i = tid; i < 64 * 272 / 16; i += NT) *(LAS u32x4*)(L + S_HB + i * 16) = (u32x4){0u, 0u, 0u, 0u};
    f32x4 Hacc[4];
#pragma unroll
    for (int j = 0; j < 4; ++j) Hacc[j] = (f32x4){0.f, 0.f, 0.f, 0.f};
    u32x4 px, pb[2], pc[2];
    const int xl = lane, xc = w;
    float pdt = 0.f;
#define SSD_ROW(ci_, l_) ({ const int s_ = (ci_) < 4 ? 0 : 1, k_ = s_ ? (ci_) - 4 : (ci_), nc_ = s_ ? 32 : 4, c_ = dir ? nc_ - 1 - k_ : k_; \
        (s_ ? b * SEQ : NLAT + b * CTX) + c_ * 64 + (dir ? 63 - (l_) : (l_)); })
#define SSD_PREFETCH(ci_) do { px = *(const u32x4*)(U + (size_t)SSD_ROW(ci_, xl) * 1024 + h * 64 + xc * 8); \
        if (w == 0) pdt = DTS[(size_t)SSD_ROW(ci_, lane) * 16 + dir * 8 + h]; \
        _Pragma("unroll") for (int k_ = 0; k_ < 2; ++k_) { const int l_ = lane, c16_ = w + 8 * k_; const size_t ro_ = (size_t)SSD_ROW(ci_, l_) * 1024; \
            pb[k_] = *(const u32x4*)(U + ro_ + 512 + g * 128 + c16_ * 8); pc[k_] = *(const u32x4*)(U + ro_ + 768 + g * 128 + c16_ * 8); } } while (0)
    SSD_PREFETCH(0);
    int par = 0;
    for (int ci = 0; ci < 36; ++ci) {
        LAS float* misc = (LAS float*)(L + S_MISC) + par * 272;
        if (w == 0) {
            const float dt = pdt; float cs = dt * aneg;
#pragma unroll
            for (int o = 1; o < 64; o <<= 1) { const float v = __shfl_up(cs, o); cs += (lane >= o) ? v : 0.f; }
            const float tot = __shfl(cs, 63);
            misc[lane] = dt; misc[64 + lane] = cs; misc[128 + lane] = __expf(cs); misc[192 + lane] = __expf(tot - cs) * dt; if (lane == 0) misc[256] = __expf(tot);
        }
        __syncthreads();
        {
            const unsigned xw[4] = {px.x, px.y, px.z, px.w};
#pragma unroll
            for (int e = 0; e < 4; ++e) { *(LAS unsigned short*)(L + S_XT + (xc * 8 + 2 * e) * 144 + xl * 2) = (unsigned short)(xw[e] & 0xffffu); *(LAS unsigned short*)(L + S_XT + (xc * 8 + 2 * e + 1) * 144 + xl * 2) = (unsigned short)(xw[e] >> 16); }
#pragma unroll
            for (int k = 0; k < 2; ++k) { const int l = lane, c16 = w + 8 * k; const float wl = misc[192 + l];
                *(LAS u32x4*)(L + S_BQ + l * 272 + c16 * 16) = pb[k]; *(LAS u32x4*)(L + S_CQ + l * 272 + c16 * 16) = pc[k];
                const unsigned bw[4] = {pb[k].x, pb[k].y, pb[k].z, pb[k].w};
#pragma unroll
                for (int e = 0; e < 4; ++e) { const unsigned pw = pk2(bflo(bw[e]) * wl, bfhi(bw[e]) * wl);
                    *(LAS unsigned short*)(L + S_BT + (c16 * 8 + 2 * e) * 144 + l * 2) = (unsigned short)(pw & 0xffffu); *(LAS unsigned short*)(L + S_BT + (c16 * 8 + 2 * e + 1) * 144 + l * 2) = (unsigned short)(pw >> 16); } }
        }
        if (ci + 1 < 36) SSD_PREFETCH(ci + 1);
        __syncthreads();
        const int lt = w >> 1, t2 = (w & 1) * 2;
        bf16x8 cfr[4];
#pragma unroll
        for (int ks = 0; ks < 4; ++ks) cfr[ks] = *(const LAS bf16x8*)(L + S_CQ + (16 * lt + q16) * 272 + ks * 64 + gq * 16);
        {
            const f32x4 csl = *(const LAS f32x4*)(misc + 64 + 16 * lt + 4 * gq);
#pragma unroll
            for (int k = 0; k < 2; ++k) { const int st = t2 + k; f32x4 a = {0.f, 0.f, 0.f, 0.f};
                if (st <= lt) {
#pragma unroll
                    for (int ks = 0; ks < 4; ++ks) { const bf16x8 bfr = *(const LAS bf16x8*)(L + S_BQ + (16 * st + q16) * 272 + ks * 64 + gq * 16); a = __builtin_amdgcn_mfma_f32_16x16x32_bf16(cfr[ks], bfr, a, 0, 0, 0); }
                    const int sidx = 16 * st + q16; const float css = misc[64 + sidx], dts = misc[sidx];
#pragma unroll
                    for (int r = 0; r < 4; ++r) { const int l = 16 * lt + 4 * gq + r; a[r] = (sidx <= l) ? a[r] * __expf(csl[r] - css) * dts : 0.f; }
                }
#pragma unroll
                for (int r = 0; r < 4; r += 2) { const unsigned pw = pk2(a[r], a[r + 1]);
                    *(LAS unsigned short*)(L + S_MQ + (16 * lt + 4 * gq + r) * 144 + (16 * st + q16) * 2) = (unsigned short)(pw & 0xffffu); *(LAS unsigned short*)(L + S_MQ + (16 * lt + 4 * gq + r + 1) * 144 + (16 * st + q16) * 2) = (unsigned short)(pw >> 16); } }
        }
        __syncthreads();
        {
            const f32x4 ecs = *(const LAS f32x4*)(misc + 128 + 16 * lt + 4 * gq);
            const LAS unsigned char* HB = L + S_HB + par * 17408;
#pragma unroll
            for (int k = 0; k < 2; ++k) { const int pt = t2 + k; f32x4 a = {0.f, 0.f, 0.f, 0.f};
#pragma unroll
                for (int ks = 0; ks < 4; ++ks) { const bf16x8 hfr = *(const LAS bf16x8*)(HB + (16 * pt + q16) * 272 + ks * 64 + gq * 16); a = __builtin_amdgcn_mfma_f32_16x16x32_bf16(cfr[ks], hfr, a, 0, 0, 0); }
                a = a * ecs;
#pragma unroll
                for (int ks = 0; ks < 2; ++ks) if (ks <= (lt >> 1)) { const bf16x8 mfr = *(const LAS bf16x8*)(L + S_MQ + (16 * lt + q16) * 144 + ks * 64 + gq * 16), xfr = *(const LAS bf16x8*)(L + S_XT + (16 * pt + q16) * 144 + ks * 64 + gq * 16);
                    a = __builtin_amdgcn_mfma_f32_16x16x32_bf16(mfr, xfr, a, 0, 0, 0); }
                if (dir == 0) { const u32x2 xv = *(const LAS u32x2*)(L + S_XT + (16 * pt + q16) * 144 + (16 * lt + 4 * gq) * 2);
                    a[0] += dsk * bflo(xv.x); a[1] += dsk * bfhi(xv.x); a[2] += dsk * bflo(xv.y); a[3] += dsk * bfhi(xv.y); }
                { const int row0 = SSD_ROW(ci, 16 * lt + 4 * gq); float* yp = Y + (size_t)row0 * 512 + h * 64 + 16 * pt + q16; const int rs = dir ? -512 : 512;
#pragma unroll
                  for (int r = 0; r < 4; ++r) yp[r * rs] = a[r]; } }
            const int pt2 = w & 3, nb = (w >> 2) * 4; const float et = misc[256];
            bf16x8 xf2[2];
#pragma unroll
            for (int ks = 0; ks < 2; ++ks) xf2[ks] = *(const LAS bf16x8*)(L + S_XT + (16 * pt2 + q16) * 144 + ks * 64 + gq * 16);
            LAS unsigned char* HN = L + S_HB + (par ^ 1) * 17408;
#pragma unroll
            for (int j = 0; j < 4; ++j) { const int nt = nb + j; Hacc[j] = Hacc[j] * et;
#pragma unroll
                for (int ks = 0; ks < 2; ++ks) { const bf16x8 bfr = *(const LAS bf16x8*)(L + S_BT + (16 * nt + q16) * 144 + ks * 64 + gq * 16); Hacc[j] = __builtin_amdgcn_mfma_f32_16x16x32_bf16(xf2[ks], bfr, Hacc[j], 0, 0, 0); }
#pragma unroll
                for (int r = 0; r < 4; r += 2) { const unsigned pw = pk2(Hacc[j][r], Hacc[j][r + 1]);
                    *(LAS unsigned short*)(HN + (16 * pt2 + 4 * gq + r) * 272 + (16 * nt + q16) * 2) = (unsigned short)(pw & 0xffffu); *(LAS unsigned short*)(HN + (16 * pt2 + 4 * gq + r + 1) * 272 + (16 * nt + q16) * 2) = (unsigned short)(pw >> 16); } }
        }
        par ^= 1;
    }
#undef SSD_ROW
#undef SSD_PREFETCH
}
__device__ __forceinline__ void p_mixa(const Frame& F, int layer, bool last) {
    for (int u = F.bid; u < NTOK / 16; u += F.G) ssd_prepass_unit(F, layer, u);
    for (int u0 = F.bid; u0 < 2048 * REP_NA; u0 += F.G) { const int u = u0 & 2047; na_unit(F, layer, u >> 7, (u >> 4) & 7, 0, u & 15); }
    if (!last) for (int u = F.bid; u < 256; u += F.G) na_unit(F, layer, u >> 4, (u >> 1) & 7, 1, u & 1);
}
__device__ __forceinline__ void p_mixb(const Frame& F, int layer) {
    for (int u0 = F.bid; u0 < 256 * REP_SSD; u0 += F.G) { const int u = u0 & 255; ssd_mfma_unit(F, layer, u >> 4, (u >> 1) & 7, u & 1); }
}

__device__ __forceinline__ void p_ssdcomb(const Frame& F, int layer, bool last) {
    const bf16_t* PROJ = (const bf16_t*)(F.ws + WS_PROJ); bf16_t* MIX = (bf16_t*)(F.ws + WS_MIX);
    const float* YF = (const float*)(F.ws + WS_YF); const float* YB = (const float*)(F.ws + WS_YB);
    const float* nw = F.in[I_NORMW] + layer * 512 + F.lane * 8;
    const f32x4 nw0 = *(const f32x4*)nw, nw1 = *(const f32x4*)(nw + 4);
    const int nrows = last ? NLAT : NTOK;
    f32x4 pf[4]; u32x4 pz = {0u, 0u, 0u, 0u};
#define SC_LOAD(r_) do { const size_t o_ = (size_t)(r_) * 512 + F.lane * 8; pf[0] = *(const f32x4*)(YF + o_); pf[1] = *(const f32x4*)(YB + o_); pf[2] = *(const f32x4*)(YF + o_ + 4); pf[3] = *(const f32x4*)(YB + o_ + 4); \
        pz = *(const u32x4*)(PROJ + (size_t)(r_) * NPROJ + OFF_Z + F.lane * 8); } while (0)
    if (F.gw < nrows) SC_LOAD(F.gw);
    for (int row = F.gw; row < nrows; row += F.NGW) {
        const f32x4 a0 = pf[0] + pf[1], a1 = pf[2] + pf[3]; const u32x4 zv = pz;
        if (row + F.NGW < nrows) SC_LOAD(row + F.NGW);
        float y[8] = {a0[0] * silu_f(bflo(zv.x)), a0[1] * silu_f(bfhi(zv.x)), a0[2] * silu_f(bflo(zv.y)), a0[3] * silu_f(bfhi(zv.y)),
                      a1[0] * silu_f(bflo(zv.z)), a1[1] * silu_f(bfhi(zv.z)), a1[2] * silu_f(bflo(zv.w)), a1[3] * silu_f(bfhi(zv.w))};
        float ss = 0.f;
#pragma unroll
        for (int k = 0; k < 8; ++k) ss += y[k] * y[k];
#pragma unroll
        for (int of = 1; of < 32; of <<= 1) ss += __shfl_xor(ss, of);
        const float rs = 1.0f / sqrtf(ss * (1.0f / 256.0f) + RMS_EPS);
        u32x4 w; w.x = pk2(y[0] * rs * nw0[0], y[1] * rs * nw0[1]); w.y = pk2(y[2] * rs * nw0[2], y[3] * rs * nw0[3]);
        w.z = pk2(y[4] * rs * nw1[0], y[5] * rs * nw1[1]); w.w = pk2(y[6] * rs * nw1[2], y[7] * rs * nw1[3]);
        *(u32x4*)(MIX + (size_t)row * D + 512 + F.lane * 8) = w;
    }
}

__device__ __forceinline__ void p_outproj(const Frame& F, int layer, bool last) {
    bf16_t* X = (bf16_t*)(F.ws + WS_X);
    pg8::Gemm g{(const bf16_t*)(F.ws + WS_MIX), (const bf16_t*)(F.ws + WS_WOUT) + (size_t)layer * D * D, D};
    pg8::DenseOrder S; S.init(last ? NLAT : NTOK, D, D, F.G, F.bid);
    pg8::EpiResid E{layer == 0 ? (const void*)F.in[I_X] : (const void*)X, layer == 0 ? (const void*)F.in[I_CTX] : (const void*)(X + (size_t)NLAT * D), X, (const float*)(F.ws + WS_MOD) + (size_t)layer * 17 * MODW, 2 * D, layer == 0};
    pg8::gemm_phase<pg8::EpiResid, pg8::DenseOrder, true, true>(F.lds, g, S, E);
}

__device__ __forceinline__ unsigned* cnt_word(const Frame& F, int slot, int hf, int e) { return (unsigned*)(F.ws + WS_CTL) + CW_CNT + ((slot * 2 + hf) * 8 + e) * 64; }
__device__ __forceinline__ void p_ln1(const Frame& F, int layer, bool last) {
    bf16_t* X = (bf16_t*)(F.ws + WS_X); bf16_t* H = (bf16_t*)(F.ws + WS_H);
    const float* MOD = (const float*)(F.ws + WS_MOD) + (size_t)layer * 17 * MODW;
    const float* lg = F.in[I_LNG] + (size_t)(layer * 2) * D; const float* lb = F.in[I_LNB] + (size_t)(layer * 2) * D;
    const bool moe = layer & 1; const int slot = layer >> 1;
    const int nrows = last ? NLAT : NTOK;
    float rw[16][8];
    if (moe) { const float* R = F.in[I_RW] + (size_t)slot * D * 8;
#pragma unroll
        for (int j = 0; j < 4; ++j)
#pragma unroll
            for (int k = 0; k < 4; ++k) { const f32x4 a = *(const f32x4*)(R + (size_t)(4 * F.lane + 256 * j + k) * 8), b2 = *(const f32x4*)(R + (size_t)(4 * F.lane + 256 * j + k) * 8 + 4);
                rw[j * 4 + k][0] = a[0]; rw[j * 4 + k][1] = a[1]; rw[j * 4 + k][2] = a[2]; rw[j * 4 + k][3] = a[3]; rw[j * 4 + k][4] = b2[0]; rw[j * 4 + k][5] = b2[1]; rw[j * 4 + k][6] = b2[2]; rw[j * 4 + k][7] = b2[3]; } }
    f32x4 vn[4];
    if (F.gw < nrows) row_load_h(X + (size_t)F.gw * D, F.lane, vn);
    for (int row = F.gw; row < nrows; row += F.NGW) {
        f32x4 v[4], hv[4];
#pragma unroll
        for (int j = 0; j < 4; ++j) v[j] = vn[j];
        if (row + F.NGW < nrows) row_load_h(X + (size_t)(row + F.NGW) * D, F.lane, vn);
        row_ln(v, lg, lb, F.lane);
        row_store_h(X + (size_t)row * D, F.lane, v);
        const float* m = MOD + (size_t)mod_row_of(row) * MODW;
        if (USE_FP8 && (moe || FP8_DENSE)) row_mod_store8((unsigned char*)H + (size_t)row * D, F.lane, v, m + 3 * D, m + 4 * D, hv);
        else row_mod_store(H + (size_t)row * D, F.lane, v, m + 3 * D, m + 4 * D, hv);
        if (moe) {
            float lg8[8];
#pragma unroll
            for (int e = 0; e < 8; ++e) { float s = 0.f;
#pragma unroll
                for (int j = 0; j < 4; ++j)
#pragma unroll
                    for (int k = 0; k < 4; ++k) s += hv[j][k] * rw[j * 4 + k][e];
                lg8[e] = wave_sum(s); }
            int e0 = 0; float v0 = lg8[0];
#pragma unroll
            for (int e = 1; e < 8; ++e) if (lg8[e] > v0) { v0 = lg8[e]; e0 = e; }
            int e1 = -1; float v1 = -INFINITY;
#pragma unroll
            for (int e = 0; e < 8; ++e) if (e != e0 && lg8[e] > v1) { v1 = lg8[e]; e1 = e; }
            if (F.lane == 0) {
                const unsigned s0 = atomicAdd(cnt_word(F, slot, 0, e0), 1u), s1 = atomicAdd(cnt_word(F, slot, 0, e1), 1u);
                int* list = (int*)(F.ws + WS_LIST);
                list[e0 * NTOK + s0] = row; list[e1 * NTOK + s1] = row;
                const float ex = __expf(v1 - v0), g0 = 1.0f / (1.0f + ex);
                u32x4 r; r.x = (unsigned)e0 | ((unsigned)e1 << 8); r.y = s0; r.z = s1; r.w = 0u;
                *(u32x4*)(F.ws + WS_ROUTE + (size_t)row * 16) = r;
                *(f32x2*)(F.ws + WS_GATES + (size_t)row * 8) = (f32x2){g0, ex * g0};
            }
        }
    }
}

__device__ __forceinline__ void p_ffn1_dense(const Frame& F, int layer, bool last) {
    const int s = layer >> 1;
#if USE_FP8 && FP8_DENSE
    pg8::Gemm g{(const bf16_t*)(F.ws + WS_H), (const bf16_t*)(F.ws + WS_WFGU + (size_t)s * 2 * DFF * D), D / 2};
    pg8::DenseOrder S; S.init(last ? NLAT : NTOK, 2 * DFF, D / 2, F.G, F.bid, REP_GEMM);
    pg8::EpiSwiGLU8 E{F.ws + WS_HID, DFF};
    pg8::gemm_phase<pg8::EpiSwiGLU8, pg8::DenseOrder, true, FP8_SP2, true>(F.lds, g, S, E, (127 - S8_WGU) * 0x01010101, (127 - S8_ACT) * 0x01010101);
#else
    pg8::Gemm g{(const bf16_t*)(F.ws + WS_H), (const bf16_t*)(F.ws + WS_WFGU) + (size_t)s * 2 * DFF * D, D};
    pg8::DenseOrder S; S.init(last ? NLAT : NTOK, 2 * DFF, D, F.G, F.bid, REP_GEMM);
    pg8::EpiSwiGLU E{(bf16_t*)(F.ws + WS_HID), DFF};
    pg8::gemm_phase<pg8::EpiSwiGLU, pg8::DenseOrder, true, true>(F.lds, g, S, E);
#endif
}
__device__ __forceinline__ void p_ffn2_dense(const Frame& F, int layer, bool last) {
    const int s = layer >> 1; bf16_t* X = (bf16_t*)(F.ws + WS_X);
    pg8::EpiResid E{(const void*)X, (const void*)(X + (size_t)NLAT * D), X, (const float*)(F.ws + WS_MOD) + (size_t)layer * 17 * MODW, 5 * D, false};
#if USE_FP8 && FP8_DENSE
    pg8::Gemm g{(const bf16_t*)(F.ws + WS_HID), (const bf16_t*)(F.ws + WS_WFD + (size_t)s * D * DFF), DFF / 2};
    pg8::DenseOrder S; S.init(last ? NLAT : NTOK, D, DFF / 2, F.G, F.bid);
    pg8::gemm_phase<pg8::EpiResid, pg8::DenseOrder, true, FP8_SP2, true>(F.lds, g, S, E, (127 - S8_WD) * 0x01010101, (127 - S8_HID) * 0x01010101);
#else
    pg8::Gemm g{(const bf16_t*)(F.ws + WS_HID), (const bf16_t*)(F.ws + WS_WFD) + (size_t)s * D * DFF, DFF};
    pg8::DenseOrder S; S.init(last ? NLAT : NTOK, D, DFF, F.G, F.bid);
    pg8::gemm_phase<pg8::EpiResid, pg8::DenseOrder, true, true>(F.lds, g, S, E);
#endif
}
__device__ __forceinline__ void moe_prefix(const Frame& F, int slot, int hf, int (&ts)[9], int (&cn)[8]) {
    int a = 0;
#pragma unroll
    for (int e = 0; e < 8; ++e) { cn[e] = (int)*cnt_word(F, slot, hf, e); ts[e] = a; a += (cn[e] + 255) >> 8; }
    ts[8] = a;
}
__device__ __forceinline__ void p_ffn1_moe(const Frame& F, int layer) {
    const int slot = layer >> 1; int cn[8];
    pg8::MoeOrder<true> S; moe_prefix(F, slot, 0, S.ts, cn);
    S.nM = S.ts[8]; S.nN = 2 * DFFE / 256; S.G = F.G; S.c = F.bid; S.K = D / 2; S.estride = (long)2 * DFFE * D; S.rowoff = (const LAS unsigned short*)(F.lds + LDS_ROWOFF); S.rowbytes = D;
    {
        const int* list = (const int*)(F.ws + WS_LIST); LAS unsigned short* ro = (LAS unsigned short*)(F.lds + LDS_ROWOFF); pg8::Unit u;
        for (int i = 0; i < 36 && S.next(i, u); ++i) { const int e = S.expert_of(u.pm); int tse = 0, cne = 0;
#pragma unroll
            for (int j = 0; j < 8; ++j) { tse = (j == e) ? S.ts[j] : tse; cne = (j == e) ? cn[j] : cne; }
            for (int r = F.tid; r < 256; r += NT) { const int sl = (u.pm - tse) * 256 + r; const int tok = sl < cne ? list[e * NTOK + sl] : 0; ro[i * 256 + r] = (unsigned short)tok; } }
        __syncthreads();
    }
    pg8::Gemm g{(const bf16_t*)(F.ws + WS_H), (const bf16_t*)(F.ws + WS_WMGU + (size_t)slot * NEXP * 2 * DFFE * D), D / 2};
    pg8::EpiSwiGLU8 E{F.ws + WS_HID, DFFE};
    pg8::gemm_phase<pg8::EpiSwiGLU8, pg8::MoeOrder<true>, true, FP8_SP2, true>(F.lds, g, S, E, (127 - S8_WGU) * 0x01010101, (127 - S8_ACT) * 0x01010101);
}
__device__ __forceinline__ void p_ffn2_moe(const Frame& F, int layer) {
    const int slot = layer >> 1; int cn[8];
    pg8::MoeOrder<false> S; moe_prefix(F, slot, 0, S.ts, cn);
    S.nM = S.ts[8]; S.nN = D / 256; S.G = F.G; S.c = F.bid; S.K = DFFE / 2; S.estride = (long)D * DFFE; S.rowoff = nullptr; S.rowbytes = 0;
    pg8::EpiBf16 E{(bf16_t*)(F.ws + WS_YP), D};
    pg8::Gemm g{(const bf16_t*)(F.ws + WS_HID), (const bf16_t*)(F.ws + WS_WMD + (size_t)slot * NEXP * D * DFFE), DFFE / 2};
    pg8::gemm_phase<pg8::EpiBf16, pg8::MoeOrder<false>, true, FP8_SP2, true>(F.lds, g, S, E, (127 - S8_WD) * 0x01010101, (127 - S8_HID) * 0x01010101);
}

__device__ __forceinline__ void p_ln2(const Frame& F, int layer, bool last) {
    bf16_t* X = (bf16_t*)(F.ws + WS_X); bf16_t* H = (bf16_t*)(F.ws + WS_H);
    const float* MOD = (const float*)(F.ws + WS_MOD) + (size_t)layer * 17 * MODW;
    const float* lg = F.in[I_LNG] + (size_t)(layer * 2 + 1) * D; const float* lb = F.in[I_LNB] + (size_t)(layer * 2 + 1) * D;
    const bool moe = layer & 1; const int slot = layer >> 1;
    const int nrows = last ? NLAT : NTOK;
    int ts0[9], cn[8];
    if (moe) moe_prefix(F, slot, 0, ts0, cn);
    const bf16_t* YP = (const bf16_t*)(F.ws + WS_YP);
    f32x4 vn[4]; u32x4 rn = {0u, 0u, 0u, 0u}; f32x2 gn = {0.f, 0.f};
    if (F.gw < nrows) { row_load_h(X + (size_t)F.gw * D, F.lane, vn); if (moe) { rn = *(const u32x4*)(F.ws + WS_ROUTE + (size_t)F.gw * 16); gn = *(const f32x2*)(F.ws + WS_GATES + (size_t)F.gw * 8); } }
    for (int row = F.gw; row < nrows; row += F.NGW) {
        f32x4 v[4], hv[4];
#pragma unroll
        for (int j = 0; j < 4; ++j) v[j] = vn[j];
        const u32x4 r = rn; const f32x2 gt = gn;
        if (row + F.NGW < nrows) { row_load_h(X + (size_t)(row + F.NGW) * D, F.lane, vn);
            if (moe) { rn = *(const u32x4*)(F.ws + WS_ROUTE + (size_t)(row + F.NGW) * 16); gn = *(const f32x2*)(F.ws + WS_GATES + (size_t)(row + F.NGW) * 8); } }
        if (moe) {
            const int e0 = r.x & 255, e1 = (r.x >> 8) & 255;
            int t0 = 0, t1 = 0;
#pragma unroll
            for (int e = 0; e < 8; ++e) { const int tv = ts0[e]; t0 = (e == e0) ? tv : t0; t1 = (e == e1) ? tv : t1; }
            const bf16_t* y0 = YP + ((size_t)t0 * 256 + r.y) * D; const bf16_t* y1 = YP + ((size_t)t1 * 256 + r.z) * D;
            const float* g2 = MOD + (size_t)mod_row_of(row) * MODW + 5 * D;
#pragma unroll
            for (int j = 0; j < 4; ++j) { const u32x2 a = *(const u32x2*)(y0 + 4 * F.lane + 256 * j), b2 = *(const u32x2*)(y1 + 4 * F.lane + 256 * j);
                const f32x4 gg = *(const f32x4*)(g2 + 4 * F.lane + 256 * j) + 1.0f;
                f32x4 f; f[0] = gt[0] * bflo(a.x) + gt[1] * bflo(b2.x); f[1] = gt[0] * bfhi(a.x) + gt[1] * bfhi(b2.x); f[2] = gt[0] * bflo(a.y) + gt[1] * bflo(b2.y); f[3] = gt[0] * bfhi(a.y) + gt[1] * bfhi(b2.y);
                v[j] = v[j] * ALPHA + gg * f; }
        }
        row_ln(v, lg, lb, F.lane);
        if (last) row_store(F.out + (size_t)row * D, F.lane, v);
        else { row_store_h(X + (size_t)row * D, F.lane, v);
            const float* m = MOD + (size_t)17 * MODW + (size_t)mod_row_of(row) * MODW;
            row_mod_store(H + (size_t)row * D, F.lane, v, m, m + D, hv);
            if (USE_FP8 && FP8_INPROJ) row_store8(F.ws + WS_H8IN + (size_t)row * D, F.lane, hv); }
    }
}

constexpr int NPL = 9;
constexpr int NPH = 2 + NPL * DEPTH;
#ifndef SITE_MASK
#define SITE_MASK 0xFFFFF
#endif
#define SITE(n) (((SITE_MASK) >> (n)) & 1)
__global__ void __launch_bounds__(NT, 2) fwd_kernel(Args args) {
    extern __shared__ __attribute__((aligned(16))) unsigned char lds_raw[];
    Frame F;
    F.lds = (LAS unsigned char*)lds_raw; F.in = args.in; F.out = args.out; F.ws = args.ws;
    F.tid = threadIdx.x; F.lane = F.tid & 63; F.wave = __builtin_amdgcn_readfirstlane(F.tid >> 6); F.bid = blockIdx.x; F.G = gridDim.x;
    F.gw = F.bid * NWAVES + F.wave; F.NGW = F.G * NWAVES;
    volatile LAS unsigned* MISC = (volatile LAS unsigned*)(F.lds + LDS_MISC);
    if (F.tid < 64) MISC[F.tid] = 0u;
    __syncthreads();
    XcdBarrier bar; bar.bar = (unsigned*)(F.ws + WS_CTL) + CW_BAR; bar.x = 0; bar.st = MISC + 8;
#if MK_SINGLE
    bar = xcd_barrier_post((unsigned*)(F.ws + WS_CTL) + CW_BAR, MISC + 8);
#endif
    const int lo = args.ph_lo, hi = args.ph_hi;
#define IN(k) (lo <= (k) && (k) < hi)
#if MK_SINGLE
#define SEAM(k) do { if (IN(k) && IN((k) + 1)) { XcdBarrier b2_ = bar; int z_; asm volatile("s_mov_b32 %0, 0" : "=s"(z_)); b2_.bar = bar.bar + z_; xcd_barrier(b2_); } } while (0)
#else
#define SEAM(k) do { } while (0)
#endif
    if constexpr (SITE(0)) if (IN(0)) p_pro_a(fresh(F));
    SEAM(0);
    if constexpr (SITE(1)) if (IN(1)) p_pro_b(fresh(F));
    SEAM(1);
    for (int layer = 0; layer < DEPTH; ++layer) {
        const int pb = 2 + NPL * layer; const bool last = layer == DEPTH - 1; const bool moe = layer & 1;
        if constexpr (SITE(2)) if (IN(pb + 0)) p_inproj(fresh(F), layer);
        SEAM(pb + 0);
        if constexpr (SITE(3)) if (IN(pb + 1)) p_mixa(fresh(F), layer, last);
        SEAM(pb + 1);
        if constexpr (SITE(12)) if (IN(pb + 2)) p_mixb(fresh(F), layer);
        SEAM(pb + 2);
        if constexpr (SITE(4)) if (IN(pb + 3)) { p_ssdcomb(fresh(F), layer, last); if (!USE_FP8 && layer == 2) { int rot = 0; conv_moe(fresh(F), 1, rot); } }
        SEAM(pb + 3);
        if constexpr (SITE(5)) if (IN(pb + 4)) p_outproj(fresh(F), layer, last);
        SEAM(pb + 4);
        if constexpr (SITE(6)) if (IN(pb + 5)) p_ln1(fresh(F), layer, last);
        SEAM(pb + 5);
        if (moe) {
            if constexpr (SITE(7)) if (IN(pb + 6)) p_ffn1_moe(fresh(F), layer);
            SEAM(pb + 6);
            if constexpr (SITE(8)) if (IN(pb + 7)) p_ffn2_moe(fresh(F), layer);
            SEAM(pb + 7);
        } else {
            if constexpr (SITE(9)) if (IN(pb + 6)) p_ffn1_dense(fresh(F), layer, last);
            SEAM(pb + 6);
            if constexpr (SITE(10)) if (IN(pb + 7)) p_ffn2_dense(fresh(F), layer, last);
            SEAM(pb + 7);
        }
        if constexpr (SITE(11)) if (IN(pb + 8)) p_ln2(fresh(F), layer, last);
        if (!last) SEAM(pb + 8);
    }
#undef IN
#undef SEAM
}

extern "C" void kernel_launch(void* const* d_in, const int* in_sizes, int n_in, void* d_out, int out_size, void* d_ws, size_t ws_size, hipStream_t stream) {
    static int grid = 0;
    if (grid == 0) {
        if (n_in != 24 || out_size != NLAT * D || ws_size < WS_END) { fprintf(stderr, "kernel_launch: unexpected shapes (n_in %d, out %d, ws %zu < %zu)\n", n_in, out_size, ws_size, (size_t)WS_END); grid = -1; return; }
        int dev = 0, cus = 0, per_cu = 0;
        if (hipGetDevice(&dev) != hipSuccess || hipDeviceGetAttribute(&cus, hipDeviceAttributeMultiprocessorCount, dev) != hipSuccess) { grid = -1; return; }
        if (hipFuncSetAttribute((const void*)fwd_kernel, hipFuncAttributeMaxDynamicSharedMemorySize, LDS_BYTES) != hipSuccess) { fprintf(stderr, "kernel_launch: hipFuncSetAttribute failed\n"); grid = -1; return; }
        if (hipOccupancyMaxActiveBlocksPerMultiprocessor(&per_cu, (const void*)fwd_kernel, NT, LDS_BYTES) != hipSuccess || per_cu < 1) { fprintf(stderr, "kernel_launch: occupancy query says %d\n", per_cu); }
        (void)hipGetLastError();
        grid = cus;
    }
    if (grid < 0) return;
    (void)in_sizes;
    if (hipMemsetAsync((char*)d_ws + WS_CTL, 0, CTL_BYTES, stream) != hipSuccess) return;
    Args a{};
    for (int i = 0; i < 24; ++i) a.in[i] = (const float*)d_in[i];
    a.out = (float*)d_out; a.ws = (unsigned char*)d_ws;
#if MK_SINGLE
    a.ph_lo = 0; a.ph_hi = NPH;
    hipLaunchKernelGGL(fwd_kernel, dim3(grid), dim3(NT), LDS_BYTES, stream, a);
#else
    for (int ph = 0; ph < NPH; ++ph) {

        a.ph_lo = ph; a.ph_hi = ph + 1;
        hipLaunchKernelGGL(fwd_kernel, dim3(grid), dim3(NT), LDS_BYTES, stream, a);
    }
#endif
}
```

```cpp
#include <hip/hip_runtime.h>
#include <cstdio>
#include <cstdint>

#ifndef MK_SINGLE
#define MK_SINGLE 1
#endif

#ifndef FP8_INPROJ
#define FP8_INPROJ 0
#endif
#ifndef FP8_DENSE
#define FP8_DENSE 0
#endif
#ifndef USE_FP8
#define USE_FP8 1
#endif
#ifndef FP8_SP2
#define FP8_SP2 true
#endif
#ifndef REP_SSD
#define REP_SSD 1
#endif
#ifndef REP_NA
#define REP_NA 1
#endif
#ifndef REP_GEMM
#define REP_GEMM 1
#endif
#define GAS __attribute__((address_space(1)))
#define LAS __attribute__((address_space(3)))
typedef unsigned short bf16_t;
typedef short bf16x8 __attribute__((ext_vector_type(8)));
typedef float f32x4 __attribute__((ext_vector_type(4)));
typedef float f32x2 __attribute__((ext_vector_type(2)));
typedef unsigned u32x4 __attribute__((ext_vector_type(4)));
typedef unsigned u32x2 __attribute__((ext_vector_type(2)));
typedef int i32x4 __attribute__((ext_vector_type(4)));
typedef int i32x8 __attribute__((ext_vector_type(8)));

constexpr int D = 1024, BATCH = 16, SEQ = 2048, DEPTH = 4, GRID_W = 64, CTX = 256;
constexpr int NLAT = BATCH * SEQ;
constexpr int NCTX = BATCH * CTX;
constexpr int NTOK = NLAT + NCTX;
constexpr int NPROJ = 3072;
constexpr int OFF_K = 512, OFF_V = 1024, OFF_Z = 1536, OFF_XBC = 2048;
constexpr int D_IN_PROJ = 3088;
constexpr int DFF = 2816, DFFE = 3584, NEXP = 8;
constexpr float ALPHA = 1.6817928305074290f;
constexpr float LN_EPS = 1e-5f, RMS_EPS = 1e-5f;
constexpr int MODW = 6 * D;

constexpr size_t MiB = 1u << 20;
constexpr size_t WS_CTL = 0, CTL_BYTES = 1 * MiB;
constexpr size_t WS_MOD = 1 * MiB;
constexpr size_t WS_ROUTE = 3 * MiB;
constexpr size_t WS_GATES = 4 * MiB;
constexpr size_t WS_LIST = 5 * MiB;
constexpr size_t WS_WDT = 7 * MiB;
constexpr size_t WS_WIN = 8 * MiB;
constexpr size_t WS_WOUT = 32 * MiB;
constexpr size_t WS_WFGU = 40 * MiB;
constexpr size_t WS_WFD = 62 * MiB;
constexpr size_t WS_WMGU = 73 * MiB;
constexpr size_t WS_WMD = 185 * MiB;
constexpr size_t WS_X = 241 * MiB;
constexpr size_t WS_H = 385 * MiB;
constexpr size_t WS_R = 457 * MiB;
constexpr size_t WS_PROJ = WS_R;
constexpr size_t WS_DT = WS_R + 216 * MiB;
constexpr size_t WS_YF = WS_R + 219 * MiB;
constexpr size_t WS_YB = WS_R + 291 * MiB;
constexpr size_t WS_MIX = WS_R + 363 * MiB;
constexpr size_t WS_HID = WS_R;
constexpr size_t WS_YP = WS_R + 270 * MiB;
constexpr size_t WS_U = WS_R + 435 * MiB;
constexpr size_t WS_H8IN = WS_U;
constexpr size_t WS_END = WS_R + 507 * MiB;
constexpr int MOE_PAD = 2 * NTOK + 2048;
static_assert(USE_FP8 == 1, "the single-phase MoE needs the e4m3 hidden (the bf16 one does not fit the workspace)");
static_assert(WS_HID + (size_t)MOE_PAD * 3584 <= WS_YP && WS_YP + (size_t)MOE_PAD * 1024 * 2 <= WS_END, "MoE buffers");

constexpr int CW_TMO = 0;
constexpr int CW_BAR = 4096;
constexpr int CW_CNT = 16384;

constexpr int LDS_STAGE = 131072;
constexpr int LDS_ROWOFF = 131072;
constexpr int LDS_MISC = 131072 + 18432;
constexpr int LDS_BYTES = 155648;

constexpr int S8_ACT = 3, S8_WGU = 8, S8_HID = 2, S8_WD = 9;
__device__ __forceinline__ unsigned f2bf(float f) { unsigned u = __builtin_bit_cast(unsigned, f); return (u + 0x7fffu + ((u >> 16) & 1u)) >> 16; }
typedef __bf16 bf16x2_t __attribute__((ext_vector_type(2)));
__device__ __forceinline__ unsigned pk2(float lo, float hi) { const f32x2 v = {lo, hi}; const bf16x2_t b = __builtin_convertvector(v, bf16x2_t); return __builtin_bit_cast(unsigned, b); }
__device__ __forceinline__ float bf2f(unsigned short b) { return __builtin_bit_cast(float, ((unsigned)b) << 16); }
__device__ __forceinline__ float bflo(unsigned w) { return __builtin_bit_cast(float, w << 16); }
__device__ __forceinline__ float bfhi(unsigned w) { return __builtin_bit_cast(float, w & 0xffff0000u); }
__device__ __forceinline__ float silu_f(float v) { return v / (1.0f + __expf(-v)); }
__device__ __forceinline__ float clamp8(float v) { return fminf(fmaxf(v, -448.0f), 448.0f); }
__device__ __forceinline__ unsigned pk8(float a, float b, float c, float d) {
    int w = 0; w = __builtin_amdgcn_cvt_pk_fp8_f32(clamp8(a), clamp8(b), w, false); w = __builtin_amdgcn_cvt_pk_fp8_f32(clamp8(c), clamp8(d), w, true); return (unsigned)w; }
__device__ __forceinline__ float wave_sum(float v) {
#pragma unroll
    for (int o = 1; o < 64; o <<= 1) v += __shfl_xor(v, o);
    return v;
}

namespace pg8 {
constexpr int BM = 256, BK = 64, HALF = 128, HTB = HALF * BK * 2, STAGE_BYTES = 8 * HTB, NXCD = 8, WGM = 8;
__host__ __device__ __forceinline__ int lds_byte(int r, int c) { const int st = (r >> 4) * 2 + (c >> 5), rr = r & 15, cc = c & 31, ob = rr * 64 + cc * 2; return st * 1024 + (ob ^ (((ob >> 9) & 1) << 5)); }
__host__ __device__ __forceinline__ void stage_rc(int b, int& R, int& C) { const int st = b / 1024, sb = b % 1024, swz = sb ^ (((sb >> 9) & 1) << 5); R = (st >> 1) * 16 + swz / 64; C = (st & 1) * 32 + (swz % 64) / 2; }
__host__ __device__ __forceinline__ int perm32(int rho) { const int n = rho >> 4, i = rho & 15; return 8 * (i >> 2) + 4 * n + (i & 3); }

struct Unit { int pm, pn; long bofs; };
struct Gemm { const bf16_t* A; const bf16_t* Bt; int K; };

__device__ __forceinline__ unsigned cvt_pk_bf16(float lo, float hi) { return pk2(lo, hi); }
__device__ __forceinline__ unsigned cvt_pk_bf16_pin(float lo, float hi) { unsigned r; asm volatile("v_cvt_pk_bf16_f32 %0, %1, %2" : "=v"(r) : "v"(lo), "v"(hi)); return r; }

__device__ __forceinline__ bool static_tile(int i, int G, int c, int nM, int nN, int& pm, int& pn, int rep = 1) {
    const int nwg = nM * nN;
#if REP_GEMM > 1
    { const int cnt = (nwg - c + G - 1) / G; if (cnt <= 0 || i >= rep * cnt) return false; i %= cnt; }
#endif
    const long L = (long)i * G + c; if (L >= nwg) return false;
    int wgid = (int)L; { const int q = nwg / NXCD, r = nwg % NXCD, xcd = wgid % NXCD, off = wgid / NXCD; wgid = (xcd < r ? xcd * (q + 1) : r * (q + 1) + (xcd - r) * q) + off; }
    const int nig = WGM * nN, gid = wgid / nig, fm = gid * WGM, gsz = (nM - fm) < WGM ? (nM - fm) : WGM;
    pm = fm + ((wgid % nig) % gsz); pn = (wgid % nig) / gsz; return true;
}
struct DenseOrder {
    int nM, nN, G, c, K, rep;
    __device__ __forceinline__ void init(int M, int N, int K_, int G_, int c_, int rep_ = 1) { nM = M / BM; nN = N / BM; G = G_; c = c_; K = K_; rep = rep_; }
    __device__ __forceinline__ bool next(int i, Unit& u) const { if (!static_tile(i, G, c, nM, nN, u.pm, u.pn, rep)) return false; u.bofs = (long)u.pn * BM * K * 2; return true; }
    static constexpr bool GATHER = false;
    __device__ __forceinline__ long a_base(const Unit& u) const { return (long)u.pm * BM * K * 2; }
    __device__ __forceinline__ void a_offs(int, const Unit&, int, unsigned (&)[2][2]) const {}
};
template <bool GATHER_> struct MoeOrder {
    int nM, nN, G, c, K; int ts[9]; long estride; const LAS unsigned short* rowoff; unsigned rowbytes;
    __device__ __forceinline__ int expert_of(int pm) const { int e = 0;
#pragma unroll
        for (int j = 1; j < 8; ++j) e += (pm >= ts[j]) ? 1 : 0; return e; }
    __device__ __forceinline__ bool next(int i, Unit& u) const { if (!static_tile(i, G, c, nM, nN, u.pm, u.pn, REP_GEMM)) return false; u.bofs = (long)expert_of(u.pm) * estride + (long)u.pn * BM * K * 2; return true; }
    static constexpr bool GATHER = GATHER_;
    __device__ __forceinline__ long a_base(const Unit& u) const { return GATHER_ ? 0l : (long)u.pm * BM * K * 2; }
    __device__ __forceinline__ void a_offs(int ui, const Unit&, int tid, unsigned (&o)[2][2]) const {
        int uix = ui;
#if REP_GEMM > 1
        { const int cnt = (nM * nN - c + G - 1) / G; uix = ui % cnt; }
#endif
        if (GATHER_) {
#pragma unroll
            for (int i = 0; i < 2; ++i) { int R, C; stage_rc(tid * 16 + i * 8192, R, C);
#pragma unroll
                for (int h = 0; h < 2; ++h) o[h][i] = (unsigned)rowoff[uix * 256 + h * HALF + R] * rowbytes + (unsigned)(C * 2); }
        }
    }
};

struct EpiBf16 {
    static constexpr bool PERM = true;
    bf16_t* O; int ldc;
    __device__ __forceinline__ void operator()(const f32x4 (&acc)[2][2][4][2], const Unit& u, int wr, int wc, int fr, int fq) const {
        const int row0 = u.pm * BM + wr * 64 + fr; const int col0 = u.pn * BM + wc * 32 + 8 * fq;
#pragma unroll
        for (int ai = 0; ai < 2; ++ai)
#pragma unroll
            for (int m = 0; m < 4; ++m) { bf16_t* rowp = O + (size_t)(row0 + ai * HALF + m * 16) * ldc + col0;
#pragma unroll
                for (int bj = 0; bj < 2; ++bj) { const f32x4 v0 = acc[ai][bj][m][0], v1 = acc[ai][bj][m][1];
                    u32x4 w; w.x = cvt_pk_bf16(v0[0], v0[1]); w.y = cvt_pk_bf16(v0[2], v0[3]); w.z = cvt_pk_bf16(v1[0], v1[1]); w.w = cvt_pk_bf16(v1[2], v1[3]);
                    *(u32x4*)(rowp + bj * HALF) = w; } }
    }
};
struct EpiSwiGLU {
    static constexpr bool PERM = true;
    bf16_t* O; int ldc;
    __device__ __forceinline__ void operator()(const f32x4 (&acc)[2][2][4][2], const Unit& u, int wr, int wc, int fr, int fq) const {
        const int row0 = u.pm * BM + wr * 64 + fr; const int col0 = u.pn * HALF + wc * 32 + 8 * fq;
#pragma unroll
        for (int ai = 0; ai < 2; ++ai)
#pragma unroll
            for (int m = 0; m < 4; ++m) { bf16_t* rowp = O + (size_t)(row0 + ai * HALF + m * 16) * ldc + col0;
                float h[8];
#pragma unroll
                for (int n = 0; n < 2; ++n)
#pragma unroll
                    for (int j = 0; j < 4; ++j) { const float g = acc[ai][0][m][n][j], up = acc[ai][1][m][n][j]; h[n * 4 + j] = g * __builtin_amdgcn_rcpf(1.0f + __expf(-g)) * up; }
                u32x4 w; w.x = cvt_pk_bf16(h[0], h[1]); w.y = cvt_pk_bf16(h[2], h[3]); w.z = cvt_pk_bf16(h[4], h[5]); w.w = cvt_pk_bf16(h[6], h[7]);
                *(u32x4*)rowp = w; }
    }
};
struct EpiSwiGLU8 {
    static constexpr bool PERM = true;
    unsigned char* O; int ldc;
    __device__ __forceinline__ void operator()(const f32x4 (&acc)[2][2][4][2], const Unit& u, int wr, int wc, int fr, int fq) const {
        const int row0 = u.pm * BM + wr * 64 + fr; const int col0 = u.pn * HALF + wc * 32 + 8 * fq;
#pragma unroll
        for (int ai = 0; ai < 2; ++ai)
#pragma unroll
            for (int m = 0; m < 4; ++m) { unsigned char* rowp = O + (size_t)(row0 + ai * HALF + m * 16) * ldc + col0;
                float h[8];
#pragma unroll
                for (int n = 0; n < 2; ++n)
#pragma unroll
                    for (int j = 0; j < 4; ++j) { const float g = acc[ai][0][m][n][j], up = acc[ai][1][m][n][j]; h[n * 4 + j] = g * __builtin_amdgcn_rcpf(1.0f + __expf(-g)) * up * (float)(1 << S8_HID); }
                u32x2 w; w.x = pk8(h[0], h[1], h[2], h[3]); w.y = pk8(h[4], h[5], h[6], h[7]);
                *(u32x2*)rowp = w; }
    }
};
struct EpiResid {
    static constexpr bool PERM = false;
    const void* base_lat; const void* base_ctx; bf16_t* out; const float* mod; int gate_off; bool base_f32;
    __device__ __forceinline__ void operator()(const f32x4 (&acc)[2][2][4][2], const Unit& u, int wr, int wc, int fr, int fq) const {
        const int rt = u.pm * BM; const bool isctx = rt >= NLAT; const int bi = isctx ? 16 : (rt >> 11);
        const size_t brow = isctx ? (size_t)(rt - NLAT) : (size_t)rt;
        const float* bf = (const float*)(isctx ? base_ctx : base_lat) + brow * D; const bf16_t* bh = (const bf16_t*)(isctx ? base_ctx : base_lat) + brow * D;
        bf16_t* o = out + (size_t)rt * D; const float* gt = mod + bi * MODW + gate_off;
        const int r0 = wr * 64 + fr, col0 = u.pn * BM + wc * 32 + 4 * fq;
        f32x4 gv[2][2];
#pragma unroll
        for (int bj = 0; bj < 2; ++bj)
#pragma unroll
            for (int n = 0; n < 2; ++n) gv[bj][n] = *(const f32x4*)(gt + col0 + bj * HALF + n * 16) + 1.0f;
#pragma unroll
        for (int ai = 0; ai < 2; ++ai)
#pragma unroll
            for (int m = 0; m < 4; ++m) { const size_t off = (size_t)(r0 + ai * HALF + m * 16) * D + col0;
#pragma unroll
                for (int bj = 0; bj < 2; ++bj)
#pragma unroll
                    for (int n = 0; n < 2; ++n) { f32x4 bs;
                        if (base_f32) bs = *(const f32x4*)(bf + off + bj * HALF + n * 16);
                        else { const u32x2 w = *(const u32x2*)(bh + off + bj * HALF + n * 16); bs = (f32x4){bflo(w.x), bfhi(w.x), bflo(w.y), bfhi(w.y)}; }
                        const f32x4 r = bs * ALPHA + gv[bj][n] * acc[ai][bj][m][n];
                        u32x2 ow; ow.x = pk2(r[0], r[1]); ow.y = pk2(r[2], r[3]);
                        *(u32x2*)(o + off + bj * HALF + n * 16) = ow; }
                if (m & 1) asm volatile("" ::: "memory"); }
    }
};

template <class Epi, class Sched, bool ALIGN_EPI, bool SP2, bool FP8 = false>
__device__ __forceinline__ void gemm_phase(LAS unsigned char* lds, const Gemm g, const Sched& S, const Epi& E, int tid_in, int sw = 0x7f7f7f7f, int sa = 0x7f7f7f7f) {
    int tid_ = tid_in; asm volatile("" : "+v"(tid_));
    const int tid = tid_, wid = __builtin_amdgcn_readfirstlane(tid >> 6), lane = tid & 63, wr = wid >> 2, wc = wid & 3, fr = lane & 15, fq = lane >> 4;
    const int K = g.K, nt = K / BK;
    constexpr bool GA = Sched::GATHER;
    unsigned voffA[2], voffB[2];
#pragma unroll
    for (int i = 0; i < 2; ++i) { int R, C; stage_rc(tid * 16 + i * 8192, R, C); const int Rb = Epi::PERM ? ((R & ~31) + perm32(R & 31)) : R;
        voffA[i] = (unsigned)(R * K + C) * 2u; voffB[i] = (unsigned)(Rb * K + C) * 2u; }
    const size_t kstep = (size_t)(BK * 2);
    const size_t hstep = (size_t)HALF * K * 2;
    const unsigned ldsw = (unsigned)wid * 1024u;
    const int aoff = lds_byte(wr * 64 + fr, fq * 8), boff = lds_byte(wc * 32 + fr, fq * 8);
#define PG8_SA(b, h) (((b) * 2 + (h)) * HTB)
#define PG8_SB(b, h) ((4 + (b) * 2 + (h)) * HTB)
#define PG8_STAGE(bufoff, gbase, voff) do { _Pragma("unroll") for (int _i = 0; _i < 2; ++_i) \
        __builtin_amdgcn_global_load_lds((const unsigned*)((const char*)(gbase) + (voff)[_i]), (LAS unsigned*)(lds + (bufoff) + ldsw + _i * 8192), 16, 0, 0); } while (0)
#define PG8_LDA(dst, b, h) do { _Pragma("unroll") for (int m = 0; m < 4; ++m) _Pragma("unroll") for (int k = 0; k < 2; ++k) dst[m][k] = *(const LAS bf16x8*)(lds + PG8_SA(b, h) + aoff + m * 2048 + k * 1024); } while (0)
#define PG8_LDB(dst, b, h) do { _Pragma("unroll") for (int n = 0; n < 2; ++n) _Pragma("unroll") for (int k = 0; k < 2; ++k) dst[n][k] = *(const LAS bf16x8*)(lds + PG8_SB(b, h) + boff + n * 2048 + k * 1024); } while (0)
#define PG8_CAT(x) __builtin_shufflevector(__builtin_bit_cast(i32x4, (x)[0]), __builtin_bit_cast(i32x4, (x)[1]), 0, 1, 2, 3, 4, 5, 6, 7)
#define PG8_MMA(ai, bj, At, Bt) do { __builtin_amdgcn_s_setprio(1); _Pragma("unroll") for (int m = 0; m < 4; ++m) _Pragma("unroll") for (int n = 0; n < 2; ++n) { \
        if constexpr (FP8) { const i32x8 a8_ = PG8_CAT(Bt[n]), b8_ = PG8_CAT(At[m]); \
            asm volatile("v_mfma_scale_f32_16x16x128_f8f6f4 %0, %1, %2, %0, %3, %4 op_sel_hi:[0,0,0]" : "+v"(acc[ai][bj][m][n]) : "v"(a8_), "v"(b8_), "v"(sw), "v"(sa)); } \
        else { _Pragma("unroll") for (int k = 0; k < 2; ++k) acc[ai][bj][m][n] = __builtin_amdgcn_mfma_f32_16x16x32_bf16(Bt[n][k], At[m][k], acc[ai][bj][m][n], 0, 0, 0); } } \
        __builtin_amdgcn_s_setprio(0); } while (0)
#define PG8_WAIT_V(n) asm volatile("s_waitcnt vmcnt(" #n ")" ::: "memory")
#define PG8_WAIT_L(n) asm volatile("s_waitcnt lgkmcnt(" #n ")" ::: "memory")
#define PG8_BAR __builtin_amdgcn_s_barrier()
#define PG8_SCHED __builtin_amdgcn_sched_barrier(0)
    Unit cur, nxt; int ui = 0;
    if (!S.next(0, cur)) return;
    f32x4 acc[2][2][4][2];
#pragma unroll
    for (int a = 0; a < 2; ++a)
#pragma unroll
        for (int b = 0; b < 2; ++b)
#pragma unroll
            for (int m = 0; m < 4; ++m)
#pragma unroll
                for (int n = 0; n < 2; ++n) acc[a][b][m][n] = (f32x4){0.f, 0.f, 0.f, 0.f};
    bf16x8 At[4][2], B0[2][2], B1[2][2];
    const char* Ab = (const char*)g.A + S.a_base(cur);
    unsigned oc[2][2];
    S.a_offs(0, cur, tid, oc);
    const size_t hsA = GA ? (size_t)0 : hstep;
#define PG8_STAGE_A(bufoff, gbase, h) do { if constexpr (GA) PG8_STAGE(bufoff, gbase, oc[h]); else PG8_STAGE(bufoff, (gbase) + (h) * hsA, voffA); } while (0)
    const char* cB = (const char*)g.Bt + cur.bofs;
    if constexpr (SP2) {
        PG8_STAGE(PG8_SB(0, 0), cB, voffB); PG8_STAGE(PG8_SB(0, 1), cB + hstep, voffB); PG8_STAGE_A(PG8_SA(0, 0), Ab, 0); PG8_STAGE_A(PG8_SA(0, 1), Ab, 1);
        if (wr == 1) PG8_BAR;
        PG8_WAIT_V(2); PG8_BAR;
        PG8_STAGE(PG8_SB(1, 0), cB + kstep, voffB); PG8_STAGE_A(PG8_SA(1, 0), Ab + kstep, 0); PG8_STAGE(PG8_SB(1, 1), cB + hstep + kstep, voffB);
        PG8_WAIT_V(6); PG8_BAR;
    } else {
        PG8_STAGE(PG8_SB(0, 0), cB, voffB); PG8_STAGE_A(PG8_SA(0, 0), Ab, 0); PG8_STAGE(PG8_SB(0, 1), cB + hstep, voffB); PG8_STAGE_A(PG8_SA(0, 1), Ab, 1);
        if (wr == 1) PG8_BAR;
        PG8_WAIT_V(4); PG8_BAR;
        PG8_STAGE(PG8_SB(1, 0), cB + kstep, voffB); PG8_STAGE_A(PG8_SA(1, 0), Ab + kstep, 0); PG8_STAGE(PG8_SB(1, 1), cB + hstep + kstep, voffB);
        PG8_WAIT_V(6); PG8_BAR;
    }
    for (;;) {
        const bool has_next = S.next(ui + 1, nxt);
        const char* nB = has_next ? (const char*)g.Bt + nxt.bofs : cB;
        for (int t = 0; t < nt; t += 2) {
            const bool last = (t == nt - 2);
            const char* a1 = Ab + (size_t)(t + 1) * kstep;
            const char* b2 = last ? nB : cB + (size_t)(t + 2) * kstep; const char* b3 = b2 + kstep;
            if constexpr (SP2) {
            PG8_LDB(B0, 0, 0); PG8_LDB(B1, 0, 1); PG8_SCHED; PG8_LDA(At, 0, 0); PG8_STAGE_A(PG8_SA(1, 1), a1, 1);
            if (last && has_next) { S.a_offs(ui + 1, nxt, tid, oc); Ab = (const char*)g.A + S.a_base(nxt); }
            const char* a2 = last ? Ab : Ab + (size_t)(t + 2) * kstep; const char* a3 = a2 + kstep;
            PG8_WAIT_V(8); PG8_WAIT_L(0); PG8_BAR; PG8_MMA(0, 0, At, B0); PG8_MMA(0, 1, At, B1); PG8_BAR; PG8_SCHED;
            PG8_LDA(At, 0, 1); PG8_STAGE(PG8_SB(0, 0), b2, voffB); PG8_STAGE(PG8_SB(0, 1), b2 + hstep, voffB); PG8_STAGE_A(PG8_SA(0, 0), a2, 0);
            PG8_WAIT_V(8); PG8_WAIT_L(0); PG8_BAR; PG8_MMA(1, 0, At, B0); PG8_MMA(1, 1, At, B1); PG8_BAR; PG8_SCHED;
            PG8_LDB(B0, 1, 0); PG8_LDB(B1, 1, 1); PG8_SCHED; PG8_LDA(At, 1, 0); PG8_STAGE_A(PG8_SA(0, 1), a2, 1);
            PG8_WAIT_V(8); PG8_WAIT_L(0); PG8_BAR; PG8_MMA(0, 0, At, B0); PG8_MMA(0, 1, At, B1); PG8_BAR; PG8_SCHED;
            PG8_LDA(At, 1, 1); PG8_STAGE(PG8_SB(1, 0), b3, voffB); PG8_STAGE(PG8_SB(1, 1), b3 + hstep, voffB); PG8_STAGE_A(PG8_SA(1, 0), a3, 0);
            PG8_WAIT_V(8); PG8_WAIT_L(0); PG8_BAR; PG8_MMA(1, 0, At, B0); PG8_MMA(1, 1, At, B1); PG8_BAR; PG8_SCHED;
            } else {
            PG8_LDB(B0, 0, 0); PG8_SCHED; PG8_LDA(At, 0, 0); PG8_STAGE_A(PG8_SA(1, 1), a1, 1);
            if (last && has_next) { S.a_offs(ui + 1, nxt, tid, oc); Ab = (const char*)g.A + S.a_base(nxt); }
            const char* a2 = last ? Ab : Ab + (size_t)(t + 2) * kstep; const char* a3 = a2 + kstep;
            PG8_WAIT_L(8); PG8_BAR; PG8_WAIT_L(0); PG8_MMA(0, 0, At, B0); PG8_BAR; PG8_SCHED;
            PG8_LDB(B1, 0, 1); PG8_STAGE(PG8_SB(0, 0), b2, voffB);
            PG8_BAR; PG8_WAIT_L(0); PG8_MMA(0, 1, At, B1); PG8_BAR;
            PG8_LDA(At, 0, 1); PG8_STAGE_A(PG8_SA(0, 0), a2, 0);
            PG8_BAR; PG8_WAIT_L(0); PG8_MMA(1, 0, At, B0); PG8_BAR; PG8_SCHED;
            PG8_STAGE(PG8_SB(0, 1), b2 + hstep, voffB);
            PG8_WAIT_V(6); PG8_BAR; PG8_MMA(1, 1, At, B1); PG8_BAR;
            PG8_LDB(B0, 1, 0); PG8_SCHED; PG8_LDA(At, 1, 0); PG8_STAGE_A(PG8_SA(0, 1), a2, 1);
            PG8_WAIT_L(8); PG8_BAR; PG8_WAIT_L(0); PG8_MMA(0, 0, At, B0); PG8_BAR; PG8_SCHED;
            PG8_LDB(B1, 1, 1); PG8_STAGE(PG8_SB(1, 0), b3, voffB);
            PG8_BAR; PG8_WAIT_L(0); PG8_MMA(0, 1, At, B1); PG8_BAR;
            PG8_LDA(At, 1, 1); PG8_STAGE_A(PG8_SA(1, 0), a3, 0);
            PG8_BAR; PG8_WAIT_L(0); PG8_MMA(1, 0, At, B0); PG8_BAR; PG8_SCHED;
            PG8_STAGE(PG8_SB(1, 1), b3 + hstep, voffB);
            PG8_WAIT_V(6); PG8_BAR; PG8_MMA(1, 1, At, B1); PG8_BAR;
            }
        }
        if constexpr (ALIGN_EPI) { if (wr == 0) PG8_BAR; }
        if constexpr (FP8) asm volatile("s_nop 15\n\ts_nop 15\n\ts_nop 15" ::: "memory");
        E(acc, cur, wr, wc, fr, fq);
        if (!has_next) break;
#pragma unroll
        for (int a = 0; a < 2; ++a)
#pragma unroll
            for (int b = 0; b < 2; ++b)
#pragma unroll
                for (int m = 0; m < 4; ++m)
#pragma unroll
                    for (int n = 0; n < 2; ++n) acc[a][b][m][n] = (f32x4){0.f, 0.f, 0.f, 0.f};
        cur = nxt; cB = nB; ++ui;
        if constexpr (ALIGN_EPI) { if (wr == 1) PG8_BAR; }
    }
    PG8_WAIT_V(0);
    if constexpr (!ALIGN_EPI) { if (wr == 0) PG8_BAR; }
    PG8_BAR;
#undef PG8_SA
#undef PG8_SB
#undef PG8_STAGE
#undef PG8_STAGE_A
#undef PG8_LDA
#undef PG8_LDB
#undef PG8_MMA
#undef PG8_CAT
#undef PG8_WAIT_V
#undef PG8_WAIT_L
#undef PG8_BAR
#undef PG8_SCHED
}
}

#define XB_TMO      128
#define XB_XCNT(j)  (256  + 64 * (j))
#define XB_XSUB(j)  (1280 + 64 * (j))
#define XB_XGEN(j)  (2304 + 64 * (j))
#define XB_TOP      3328
#define XB_TOPGEN   3392
#define XCD_BAR_WORDS 3456
#define XB_SPIN_CAP (1u << 18)
__device__ __forceinline__ unsigned xb_ld(unsigned* p)              { return __hip_atomic_load(p, __ATOMIC_RELAXED, __HIP_MEMORY_SCOPE_AGENT); }
__device__ __forceinline__ unsigned xb_add(unsigned* p, unsigned v) { return __hip_atomic_fetch_add(p, v, __ATOMIC_RELAXED, __HIP_MEMORY_SCOPE_AGENT); }
__device__ __forceinline__ unsigned xb_xcc_id() { return (unsigned)__builtin_amdgcn_s_getreg((3 << 11) | 20) & 0xFu; }
#define XB_SPIN(cond, bar) do { unsigned _sp = 0; while (cond) { __builtin_amdgcn_s_sleep(1); \
    if ((++_sp & 255u) == 0u) { if (xb_ld(&(bar)[XB_TMO])) break; if (_sp > XB_SPIN_CAP) { atomicAdd(&(bar)[XB_TMO], 1u); break; } } } } while (0)
struct XcdBarrier { unsigned* bar; unsigned x; volatile LAS unsigned* st; };
__device__ __forceinline__ XcdBarrier xcd_barrier_post(unsigned* bar, volatile LAS unsigned* st) {
    XcdBarrier b; b.bar = bar; b.x = xb_xcc_id(); b.st = st;
    if (threadIdx.x == 0) (void)xb_add(&bar[XB_XCNT(b.x)], 1u);
    return b;
}
__device__ __forceinline__ void xcd_barrier_complete(unsigned* bar, unsigned x, unsigned& nloc, unsigned& nx) {
    const unsigned G = gridDim.x * gridDim.y * gridDim.z;
    unsigned sum, cnt, mine, sp = 0u;
    for (;;) {
        sum = 0u; cnt = 0u; mine = 0u;
#pragma unroll
        for (unsigned j = 0; j < 16; ++j) { const unsigned c = xb_ld(&bar[XB_XCNT(j)]); sum += c; cnt += (c > 0u) ? 1u : 0u; }
        mine = xb_ld(&bar[XB_XCNT(x)]);
        if (sum == G) break;
        __builtin_amdgcn_s_sleep(1);
        if ((++sp & 255u) == 0u) { if (xb_ld(&bar[XB_TMO])) break; if (sp > XB_SPIN_CAP) { atomicAdd(&bar[XB_TMO], 1u); break; } }
    }
    nloc = mine > 0u ? mine : 1u; nx = cnt > 0u ? cnt : 1u;
}
__device__ __forceinline__ void xcd_barrier(const XcdBarrier& b, bool leader) {
    asm volatile("s_waitcnt vmcnt(0)" ::: "memory");
    __syncthreads();
    if (leader) {
        unsigned* bar = b.bar;
        __builtin_amdgcn_s_waitcnt(0);
        unsigned nloc = b.st[0], nx = b.st[1];
        if (nloc == 0u) { xcd_barrier_complete(bar, b.x, nloc, nx); b.st[0] = nloc; b.st[1] = nx; }
        const unsigned old = xb_add(&bar[XB_XSUB(b.x)], 1u);
        const unsigned gen = old / nloc;
        if (old + 1u == (gen + 1u) * nloc) {
            __builtin_amdgcn_fence(__ATOMIC_RELEASE, "agent");
            asm volatile("s_waitcnt vmcnt(0)" ::: "memory");
            const unsigned og = xb_add(&bar[XB_TOP], 1u);
            const unsigned tg = og / nx;
            if (og + 1u == (tg + 1u) * nx) xb_add(&bar[XB_TOPGEN], 1u);
            else XB_SPIN(xb_ld(&bar[XB_TOPGEN]) == tg, bar);
            __builtin_amdgcn_fence(__ATOMIC_ACQUIRE, "agent");
            xb_add(&bar[XB_XGEN(b.x)], 1u);
            asm volatile("s_waitcnt vmcnt(0)" ::: "memory");
        } else {
            XB_SPIN(xb_ld(&bar[XB_XGEN(b.x)]) == gen, bar);
            __builtin_amdgcn_fence(__ATOMIC_ACQUIRE, "agent");
            asm volatile("s_waitcnt vmcnt(0)" ::: "memory");
        }
    }
    __syncthreads();
}

constexpr int NT = 512, NWAVES = 8;
struct Args { const float* in[24]; float* out; unsigned char* ws; int ph_lo, ph_hi; };
enum { I_X = 0, I_C, I_CTX, I_CCTX, I_WMOD, I_BMOD, I_WIN, I_WOUT, I_RPB, I_CONVW, I_CONVB, I_DTB, I_ALOG, I_DSKIP, I_NORMW, I_LNG, I_LNB, I_FG, I_FU, I_FD, I_RW, I_MG, I_MU, I_MD };
struct Frame {
    LAS unsigned char* lds;
    const float* const* in; float* out; unsigned char* ws;
    int tid, lane, wave, bid, G, gw, NGW;
};
#define LDS_WAIT() asm volatile("s_waitcnt lgkmcnt(0)" ::: "memory")
__device__ __forceinline__ Frame fresh(const Frame& F0) {
    Frame F = F0; int z; asm volatile("s_mov_b32 %0, 0" : "=s"(z)); F.ws = F0.ws + z; F.in = F0.in + z; F.out = F0.out + z;
    int ln; asm volatile("v_mbcnt_lo_u32_b32 %0, -1, 0\n\tv_mbcnt_hi_u32_b32 %0, -1, %0" : "=v"(ln));     int t = F0.wave * 64 + ln;
    F.tid = t; F.lane = t & 63; return F;
}

__device__ __forceinline__ void conv_item(const float* W, int ldn, int k0, int n0, bf16_t* dst, int K, int drow0, LAS float* scr, int lane) {
#pragma unroll 8
    for (int i = 0; i < 32; ++i) { const int kk = 2 * i + (lane >> 5); scr[kk * 33 + (lane & 31)] = W[(size_t)(k0 + kk) * ldn + n0 + (lane & 31)]; }
    LDS_WAIT(); asm volatile("" ::: "memory");
    const int c = lane & 7;
#pragma unroll
    for (int j = 0; j < 4; ++j) { const int n = (lane >> 3) + 8 * j; const LAS float* s = scr + (8 * c) * 33 + n;
        u32x4 o; o.x = pk2(s[0 * 33], s[1 * 33]); o.y = pk2(s[2 * 33], s[3 * 33]); o.z = pk2(s[4 * 33], s[5 * 33]); o.w = pk2(s[6 * 33], s[7 * 33]);
        *(u32x4*)(dst + (size_t)(drow0 + n) * K + k0 + 8 * c) = o; }
    LDS_WAIT(); asm volatile("" ::: "memory");
}
__device__ __forceinline__ void conv_item8(const float* W, int ldn, int k0, int n0, unsigned char* dst, int K, int drow0, float scale, LAS float* scr, int lane) {
#pragma unroll 8
    for (int i = 0; i < 32; ++i) { const int kk = 2 * i + (lane >> 5); scr[kk * 33 + (lane & 31)] = W[(size_t)(k0 + kk) * ldn + n0 + (lane & 31)] * scale; }
    LDS_WAIT(); asm volatile("" ::: "memory");
    const int c = lane & 7;
#pragma unroll
    for (int j = 0; j < 4; ++j) { const int n = (lane >> 3) + 8 * j; const LAS float* sp = scr + (8 * c) * 33 + n;
        u32x2 o; o.x = pk8(sp[0 * 33], sp[1 * 33], sp[2 * 33], sp[3 * 33]); o.y = pk8(sp[4 * 33], sp[5 * 33], sp[6 * 33], sp[7 * 33]);
        *(u32x2*)(dst + (size_t)(drow0 + n) * K + k0 + 8 * c) = o; }
    LDS_WAIT(); asm volatile("" ::: "memory");
}
__device__ __forceinline__ void conv_seg(const Frame& F, const float* W, int K, int ldn, int ncols, bf16_t* dst, int mode, int& rot, int s8 = -1) {
    LAS float* scr = (LAS float*)(F.lds + F.wave * 16384);
    const int nblk = ncols / 32, nitems = (K / 64) * nblk;
    int start = F.gw - rot; if (start < 0) start += F.NGW;
    for (int it = start; it < nitems; it += F.NGW) {
        const int kb = it / nblk, nb = it % nblk, n0 = nb * 32;
        const int drow0 = (mode == 0) ? n0 : ((n0 >> 7) * 256 + (n0 & 127) + (mode == 2 ? 128 : 0));
        if (s8 >= 0) conv_item8(W, ldn, kb * 64, n0, (unsigned char*)dst, K, drow0, (float)(1 << s8), scr, F.lane);
        else conv_item(W, ldn, kb * 64, n0, dst, K, drow0, scr, F.lane);
    }
    rot = (rot + nitems) % F.NGW;
}
__device__ __forceinline__ void conv_moe(const Frame& F, int slot, int& rot) {
#if USE_FP8
    unsigned char* gu = F.ws + WS_WMGU + (size_t)slot * NEXP * 2 * DFFE * D; unsigned char* dn = F.ws + WS_WMD + (size_t)slot * NEXP * D * DFFE;
    for (int e = 0; e < NEXP; ++e) {
        const size_t so = ((size_t)slot * NEXP + e) * (size_t)D * DFFE;
        conv_seg(F, F.in[I_MG] + so, D, DFFE, DFFE, (bf16_t*)(gu + (size_t)e * 2 * DFFE * D), 1, rot, S8_WGU);
        conv_seg(F, F.in[I_MU] + so, D, DFFE, DFFE, (bf16_t*)(gu + (size_t)e * 2 * DFFE * D), 2, rot, S8_WGU);
        conv_seg(F, F.in[I_MD] + so, DFFE, D, D, (bf16_t*)(dn + (size_t)e * D * DFFE), 0, rot, S8_WD);
    }
#else
    bf16_t* gu = (bf16_t*)(F.ws + WS_WMGU); bf16_t* dn = (bf16_t*)(F.ws + WS_WMD);
    for (int e = 0; e < NEXP; ++e) {
        const size_t so = ((size_t)slot * NEXP + e) * (size_t)D * DFFE;
        conv_seg(F, F.in[I_MG] + so, D, DFFE, DFFE, gu + (size_t)e * 2 * DFFE * D, 1, rot);
        conv_seg(F, F.in[I_MU] + so, D, DFFE, DFFE, gu + (size_t)e * 2 * DFFE * D, 2, rot);
        conv_seg(F, F.in[I_MD] + so, DFFE, D, D, dn + (size_t)e * D * DFFE, 0, rot);
    }
#endif
}

__device__ __forceinline__ void p_pro_a(const Frame& F) {
    {
        LAS float* sc = (LAS float*)F.lds; LAS float* red = sc + 17 * 1024;
        const float* c = F.in[I_C]; const float* cc = F.in[I_CCTX];
        for (int i = F.tid; i < 17 * 1024; i += NT) { const int r = i >> 10, k = i & 1023; const float v = (r < 16) ? c[r * 1024 + k] : cc[k]; sc[i] = silu_f(v); }
        __syncthreads();
        float* MOD = (float*)(F.ws + WS_MOD);
        const int col = F.tid & 63, ks = F.tid >> 6;
        for (int u = F.bid; u < 4 * 96; u += F.G) {
            const int l = u / 96, cb = u % 96;
            const float* W = F.in[I_WMOD] + (size_t)l * D * MODW + cb * 64 + col;
            float acc[17];
#pragma unroll
            for (int r = 0; r < 17; ++r) acc[r] = 0.f;
            for (int k = ks * 128; k < ks * 128 + 128; ++k) { const float w = W[(size_t)k * MODW];
#pragma unroll
                for (int r = 0; r < 17; ++r) acc[r] += sc[r * 1024 + k] * w; }
#pragma unroll
            for (int r = 0; r < 17; ++r) red[(ks * 17 + r) * 64 + col] = acc[r];
            __syncthreads();
            for (int i = F.tid; i < 17 * 64; i += NT) { const int r = i >> 6, c2 = i & 63; float s = 0.f;
#pragma unroll
                for (int k2 = 0; k2 < 8; ++k2) s += red[(k2 * 17 + r) * 64 + c2];
                MOD[(size_t)(l * 17 + r) * MODW + cb * 64 + c2] = s + F.in[I_BMOD][l * MODW + cb * 64 + c2]; }
            __syncthreads();
        }
    }
    int rot = 0;
    for (int l = 0; l < DEPTH; ++l) {
#if USE_FP8 && FP8_INPROJ
        conv_seg(F, F.in[I_WIN] + (size_t)l * D * D_IN_PROJ, D, D_IN_PROJ, NPROJ, (bf16_t*)(F.ws + WS_WIN + (size_t)l * NPROJ * D), 0, rot, S8_WGU);
#else
        conv_seg(F, F.in[I_WIN] + (size_t)l * D * D_IN_PROJ, D, D_IN_PROJ, NPROJ, (bf16_t*)(F.ws + WS_WIN) + (size_t)l * NPROJ * D, 0, rot);
#endif
        conv_seg(F, F.in[I_WOUT] + (size_t)l * D * D, D, D, D, (bf16_t*)(F.ws + WS_WOUT) + (size_t)l * D * D, 0, rot);
    }
    for (int s = 0; s < 2; ++s) {
#if USE_FP8 && FP8_DENSE
        conv_seg(F, F.in[I_FG] + (size_t)s * D * DFF, D, DFF, DFF, (bf16_t*)(F.ws + WS_WFGU + (size_t)s * 2 * DFF * D), 1, rot, S8_WGU);
        conv_seg(F, F.in[I_FU] + (size_t)s * D * DFF, D, DFF, DFF, (bf16_t*)(F.ws + WS_WFGU + (size_t)s * 2 * DFF * D), 2, rot, S8_WGU);
        conv_seg(F, F.in[I_FD] + (size_t)s * DFF * D, DFF, D, D, (bf16_t*)(F.ws + WS_WFD + (size_t)s * D * DFF), 0, rot, S8_WD);
#else
        conv_seg(F, F.in[I_FG] + (size_t)s * D * DFF, D, DFF, DFF, (bf16_t*)(F.ws + WS_WFGU) + (size_t)s * 2 * DFF * D, 1, rot);
        conv_seg(F, F.in[I_FU] + (size_t)s * D * DFF, D, DFF, DFF, (bf16_t*)(F.ws + WS_WFGU) + (size_t)s * 2 * DFF * D, 2, rot);
        conv_seg(F, F.in[I_FD] + (size_t)s * DFF * D, DFF, D, D, (bf16_t*)(F.ws + WS_WFD) + (size_t)s * D * DFF, 0, rot);
#endif
    }
    conv_moe(F, 0, rot);
#if USE_FP8
    conv_moe(F, 1, rot);
#endif
    { bf16_t* wdt = (bf16_t*)(F.ws + WS_WDT);
      for (int i = F.bid * NT + F.tid; i < DEPTH * 16 * D; i += F.G * NT) { const int l = i / (16 * D), n = (i / D) & 15, k = i % D;
          wdt[i] = (bf16_t)f2bf(F.in[I_WIN][((size_t)l * D + k) * D_IN_PROJ + NPROJ + n]); } }
}

#define RIDX(q) (8 * lane + 512 * ((q) >> 1) + 4 * ((q) & 1))
__device__ __forceinline__ void row_load(const float* p, int lane, f32x4 (&v)[4]) {
#pragma unroll
    for (int q = 0; q < 4; ++q) v[q] = *(const f32x4*)(p + RIDX(q));
}
__device__ __forceinline__ void row_store(float* p, int lane, const f32x4 (&v)[4]) {
#pragma unroll
    for (int q = 0; q < 4; ++q) *(f32x4*)(p + RIDX(q)) = v[q];
}
__device__ __forceinline__ void row_mod_store8(unsigned char* hrow, int lane, const f32x4 (&v)[4], const float* sh, const float* sc, f32x4 (&hv)[4]) {
#pragma unroll
    for (int j = 0; j < 2; ++j) { u32x2 w;
#pragma unroll
        for (int h = 0; h < 2; ++h) { const int q = 2 * j + h; const f32x4 a = *(const f32x4*)(sc + RIDX(q)), b = *(const f32x4*)(sh + RIDX(q));
            hv[q] = v[q] * (a + 1.0f) + b; const f32x4 t = hv[q] * (float)(1 << S8_ACT); const unsigned pw = pk8(t[0], t[1], t[2], t[3]); if (h == 0) w.x = pw; else w.y = pw; }
        *(u32x2*)(hrow + 8 * lane + 512 * j) = w; }
}
__device__ __forceinline__ void row_load_h(const bf16_t* p, int lane, f32x4 (&v)[4]) {
#pragma unroll
    for (int j = 0; j < 2; ++j) { const u32x4 w = *(const u32x4*)(p + 8 * lane + 512 * j); v[2 * j] = (f32x4){bflo(w.x), bfhi(w.x), bflo(w.y), bfhi(w.y)}; v[2 * j + 1] = (f32x4){bflo(w.z), bfhi(w.z), bflo(w.w), bfhi(w.w)}; }
}
__device__ __forceinline__ void row_store_h(bf16_t* p, int lane, const f32x4 (&v)[4]) {
#pragma unroll
    for (int j = 0; j < 2; ++j) { u32x4 w; w.x = pk2(v[2 * j][0], v[2 * j][1]); w.y = pk2(v[2 * j][2], v[2 * j][3]); w.z = pk2(v[2 * j + 1][0], v[2 * j + 1][1]); w.w = pk2(v[2 * j + 1][2], v[2 * j + 1][3]);
        *(u32x4*)(p + 8 * lane + 512 * j) = w; }
}
__device__ __forceinline__ void row_mod_store(bf16_t* hrow, int lane, const f32x4 (&v)[4], const float* sh, const float* sc, f32x4 (&hv)[4]) {
#pragma unroll
    for (int q = 0; q < 4; ++q) { const f32x4 a = *(const f32x4*)(sc + RIDX(q)), b = *(const f32x4*)(sh + RIDX(q)); hv[q] = v[q] * (a + 1.0f) + b; }
    row_store_h(hrow, lane, hv);
}
__device__ __forceinline__ void row_ln(f32x4 (&v)[4], const float* g, const float* b, int lane) {
    float s = 0.f;
#pragma unroll
    for (int j = 0; j < 4; ++j) s += (v[j][0] + v[j][1]) + (v[j][2] + v[j][3]);
    const float mean = wave_sum(s) * (1.0f / D); float q2 = 0.f;
#pragma unroll
    for (int j = 0; j < 4; ++j) { v[j] = v[j] - mean; q2 += (v[j][0] * v[j][0] + v[j][1] * v[j][1]) + (v[j][2] * v[j][2] + v[j][3] * v[j][3]); }
    const float rstd = 1.0f / sqrtf(wave_sum(q2) * (1.0f / D) + LN_EPS);
#pragma unroll
    for (int q = 0; q < 4; ++q) { const f32x4 gg = *(const f32x4*)(g + RIDX(q)), bb = *(const f32x4*)(b + RIDX(q)); v[q] = v[q] * rstd * gg + bb; }
}
__device__ __forceinline__ int mod_row_of(int row) { return row < NLAT ? (row >> 11) : 16; }

__device__ __forceinline__ void p_pro_b(const Frame& F) {
    const float* MOD = (const float*)(F.ws + WS_MOD); bf16_t* H = (bf16_t*)(F.ws + WS_H);
    for (int row = F.gw; row < NTOK; row += F.NGW) {
        const float* src = row < NLAT ? F.in[I_X] + (size_t)row * D : F.in[I_CTX] + (size_t)(row - NLAT) * D;
        f32x4 v[4], hv[4]; row_load(src, F.lane, v);
        const float* m = MOD + (size_t)mod_row_of(row) * MODW;
        row_mod_store(H + (size_t)row * D, F.lane, v, m, m + D, hv);
    }
}

__device__ __forceinline__ void p_inproj(const Frame& F, int layer) {
    const bf16_t* H = (const bf16_t*)(F.ws + WS_H);
    {
        const bf16_t* wdt = (const bf16_t*)(F.ws + WS_WDT) + (size_t)layer * 16 * D; float* DT = (float*)(F.ws + WS_DT);
        const int fr = F.lane & 15, fq = F.lane >> 4; const float dtb = F.in[I_DTB][layer * 16 + fr];
        for (int g = F.gw; g < NTOK / 16; g += F.NGW) {
            f32x4 acc = {0.f, 0.f, 0.f, 0.f};
            const bf16_t* ap = H + (size_t)(g * 16 + fr) * D + fq * 8; const bf16_t* bp = wdt + (size_t)fr * D + fq * 8;
#pragma unroll 8
            for (int ks = 0; ks < 32; ++ks) { const bf16x8 a = *(const bf16x8*)(ap + ks * 32), b = *(const bf16x8*)(bp + ks * 32);
                acc = __builtin_amdgcn_mfma_f32_16x16x32_bf16(a, b, acc, 0, 0, 0); }
#pragma unroll
            for (int r = 0; r < 4; ++r) { const float x = acc[r] + dtb; DT[(size_t)(g * 16 + fq * 4 + r) * 16 + fr] = x > 20.f ? x : log1pf(__expf(x)); }
        }
    }
    pg8::EpiBf16 E{(bf16_t*)(F.ws + WS_PROJ), NPROJ};
#if USE_FP8 && FP8_INPROJ
    pg8::Gemm g{(const bf16_t*)(F.ws + WS_H8IN), (const bf16_t*)(F.ws + WS_WIN + (size_t)layer * NPROJ * D), D / 2};
    pg8::DenseOrder S; S.init(NTOK, NPROJ, D / 2, F.G, F.bid, REP_GEMM);
    pg8::gemm_phase<pg8::EpiBf16, pg8::DenseOrder, true, FP8_SP2, true>(F.lds, g, S, E, F.tid, (127 - S8_WGU) * 0x01010101, (127 - S8_ACT) * 0x01010101);
#else
    pg8::Gemm g{H, (const bf16_t*)(F.ws + WS_WIN) + (size_t)layer * NPROJ * D, D};
    pg8::DenseOrder S; S.init(NTOK, NPROJ, D, F.G, F.bid, REP_GEMM);
    pg8::gemm_phase<pg8::EpiBf16, pg8::DenseOrder, true, true>(F.lds, g, S, E, F.tid);
#endif
}

typedef short s16x4 __attribute__((ext_vector_type(4)));
__device__ __forceinline__ s16x4 lds_tr16(LAS const unsigned char* p) { return __builtin_bit_cast(s16x4, __builtin_amdgcn_ds_read_tr16_b64_v4i16((LAS s16x4*)p)); }
constexpr int NA_KS = 144;
constexpr float LOG2E = 1.4426950408889634f;
__device__ __forceinline__ void na_unit(const Frame& F, int layer, int b, int h, int mode, int m) {
    LAS unsigned char* KV = F.lds;
    LAS float* rp = (LAS float*)(F.lds + 120832);
    const bf16_t* PROJ = (const bf16_t*)(F.ws + WS_PROJ); bf16_t* MIX = (bf16_t*)(F.ws + WS_MIX);
    const int tid = F.tid, lane = F.lane, w = F.wave, q16 = lane & 15, g = lane >> 4;
    int rbase = 0, nk = 0;
    if (mode == 0) { rbase = 2 * m - 4; rbase = rbase < 0 ? 0 : (rbase > 24 ? 24 : rbase); nk = 32 - rbase; nk = nk > 9 ? 9 : nk; }
    const int kfirst = (mode == 0) ? 0 : 576 * 8, nloc8 = nk * 64 * 8;
#define NA_STAGE(OFFS) do { int stid_ = tid; asm volatile("" : "+v"(stid_));     \
        NA_STAGE_PART(OFFS, 0, 7); __builtin_amdgcn_sched_barrier(0); NA_STAGE_PART(OFFS, 7, 13); __builtin_amdgcn_sched_barrier(0); } while (0)
#define NA_STAGE_PART(OFFS, K0, K1) do { u32x4 st_[13]; \
        _Pragma("unroll") for (int k_ = K0; k_ < K1; ++k_) { const int i_ = stid_ + kfirst + k_ * NT, key_ = i_ >> 3, ch_ = i_ & 7; const bool ok_ = (i_ < 832 * 8) && !(key_ < 576 && i_ >= nloc8); \
            const int grow_ = key_ < 576 ? b * SEQ + rbase * 64 + key_ : NLAT + b * CTX + (key_ - 576); \
            st_[k_] = ok_ ? *(const u32x4*)(PROJ + (size_t)grow_ * NPROJ + (OFFS) + h * 64 + ch_ * 8) : (u32x4){0u, 0u, 0u, 0u}; } \
        _Pragma("unroll") for (int k_ = K0; k_ < K1; ++k_) { const int i_ = stid_ + kfirst + k_ * NT, key_ = i_ >> 3, ch_ = i_ & 7; const bool ok_ = (i_ < 832 * 8) && !(key_ < 576 && i_ >= nloc8); \
            if (ok_) *(LAS u32x4*)(KV + key_ * NA_KS + ch_ * 16) = st_[k_]; } } while (0)
    __syncthreads();
    NA_STAGE(OFF_K);
    if (mode == 0 && tid < 465) rp[tid] = F.in[I_RPB][(size_t)(layer * 8 + h) * 465 + tid] * LOG2E;
    __syncthreads();
    int i = 0, j0 = 0, hs = 0, kr0 = 0, qrow;
    if (mode == 0) { i = 2 * m + (w >> 2); j0 = (w & 3) * 16; qrow = b * SEQ + i * 64 + j0; hs = j0 - 8; hs = hs < 0 ? 0 : (hs > 32 ? 32 : hs);
        int r0 = i - 4; r0 = r0 < 0 ? 0 : (r0 > 24 ? 24 : r0); kr0 = r0 - rbase; }
    else qrow = NLAT + b * CTX + m * 128 + w * 16;
    bf16x8 qf[2];
#pragma unroll
    for (int ks = 0; ks < 2; ++ks) qf[ks] = *(const bf16x8*)(PROJ + (size_t)(qrow + q16) * NPROJ + h * 64 + ks * 32 + g * 8);
    f32x4 S[32];
    const LAS unsigned char* kb = KV + q16 * NA_KS + g * 16;
    if (mode == 0) {
        const int j = j0 + q16; int cs = j - 8; cs = cs < 0 ? 0 : (cs > 48 ? 48 : cs);
        const int rb0 = (kr0 + rbase) - i + 7;
#pragma unroll
        for (int tl = 0; tl < 16; ++tl) { const int kr = tl >> 1, half = tl & 1; const int kidx0 = (kr0 + kr) * 64 + hs + 16 * half;
            f32x4 a = {0.f, 0.f, 0.f, 0.f};
#pragma unroll
            for (int ks = 0; ks < 2; ++ks) { const bf16x8 kf = *(const LAS bf16x8*)(kb + kidx0 * NA_KS + ks * 64); a = __builtin_amdgcn_mfma_f32_16x16x32_bf16(kf, qf[ks], a, 0, 0, 0); }
#pragma unroll
            for (int r = 0; r < 4; ++r) { const int kc = hs + 16 * half + 4 * g + r; const bool inw = (kc >= cs) && (kc < cs + 16);
                int cbi = kc - j + 15; cbi = cbi < 0 ? 0 : (cbi > 30 ? 30 : cbi);
                a[r] = inw ? a[r] * (0.125f * LOG2E) + rp[(rb0 + kr) * 31 + cbi] : -INFINITY; }
            S[tl] = a; if ((tl & 1) == 1) __builtin_amdgcn_sched_barrier(0); }
    } else {
#pragma unroll
        for (int tl = 0; tl < 16; ++tl) S[tl] = (f32x4){-INFINITY, -INFINITY, -INFINITY, -INFINITY};
    }
#pragma unroll
    for (int tc = 0; tc < 16; ++tc) { const int kidx0 = 576 + 16 * tc; f32x4 a = {0.f, 0.f, 0.f, 0.f};
#pragma unroll
        for (int ks = 0; ks < 2; ++ks) { const bf16x8 kf = *(const LAS bf16x8*)(kb + kidx0 * NA_KS + ks * 64); a = __builtin_amdgcn_mfma_f32_16x16x32_bf16(kf, qf[ks], a, 0, 0, 0); }
        S[16 + tc] = a * (0.125f * LOG2E); if ((tc & 1) == 1) __builtin_amdgcn_sched_barrier(0); }
    float mx = -INFINITY;
#pragma unroll
    for (int t = 0; t < 32; ++t) mx = fmaxf(fmaxf(fmaxf(S[t][0], S[t][1]), fmaxf(S[t][2], S[t][3])), mx);
    mx = fmaxf(mx, __shfl_xor(mx, 16)); mx = fmaxf(mx, __shfl_xor(mx, 32));
    float sum = 0.f; u32x4 P[16];
#pragma unroll
    for (int kk = 0; kk < 16; ++kk) { float e[8];
#pragma unroll
        for (int r = 0; r < 4; ++r) { e[r] = __builtin_amdgcn_exp2f(S[2 * kk][r] - mx); e[4 + r] = __builtin_amdgcn_exp2f(S[2 * kk + 1][r] - mx); }
        sum += ((e[0] + e[1]) + (e[2] + e[3])) + ((e[4] + e[5]) + (e[6] + e[7]));
        P[kk].x = pg8::cvt_pk_bf16_pin(e[0], e[1]); P[kk].y = pg8::cvt_pk_bf16_pin(e[2], e[3]); P[kk].z = pg8::cvt_pk_bf16_pin(e[4], e[5]); P[kk].w = pg8::cvt_pk_bf16_pin(e[6], e[7]); }
    sum += __shfl_xor(sum, 16); sum += __shfl_xor(sum, 32);
    const float inv = 1.0f / sum;
    __syncthreads();
    NA_STAGE(OFF_V);
    __syncthreads();
    f32x4 o[4];
#pragma unroll
    for (int dt = 0; dt < 4; ++dt) o[dt] = (f32x4){0.f, 0.f, 0.f, 0.f};
    const LAS unsigned char* vb = KV + (4 * g + (q16 >> 2)) * NA_KS + (q16 & 3) * 8;
#pragma unroll
    for (int kk = 0; kk < 16; ++kk) {
        if (kk < 8 && mode != 0) continue;
        const int kidx0 = (kk < 8) ? (kr0 + kk) * 64 + hs : 576 + 32 * (kk - 8);
        const bf16x8 pa = __builtin_bit_cast(bf16x8, P[kk]);
#pragma unroll
        for (int dt = 0; dt < 4; ++dt) { const s16x4 lo = lds_tr16(vb + kidx0 * NA_KS + dt * 32), hi = lds_tr16(vb + (kidx0 + 16) * NA_KS + dt * 32);
            const bf16x8 vf = {lo[0], lo[1], lo[2], lo[3], hi[0], hi[1], hi[2], hi[3]};
            o[dt] = __builtin_amdgcn_mfma_f32_16x16x32_bf16(pa, vf, o[dt], 0, 0, 0); }
    }
#undef NA_STAGE
#undef NA_STAGE_PART
#pragma unroll
    for (int r = 0; r < 4; ++r) { const float ir = __shfl(inv, 4 * g + r);
        bf16_t* op = MIX + (size_t)(qrow + 4 * g + r) * D + h * 64 + q16;
#pragma unroll
        for (int dt = 0; dt < 4; dt += 2) { const unsigned pw = pk2(o[dt][r] * ir, o[dt + 1][r] * ir); op[dt * 16] = (bf16_t)(pw & 0xffffu); op[dt * 16 + 16] = (bf16_t)(pw >> 16); } }
}

__device__ __forceinline__ void ssd_prepass_unit(const Frame& F, int layer, int u) {
    const bf16_t* PROJ = (const bf16_t*)(F.ws + WS_PROJ); bf16_t* U = (bf16_t*)(F.ws + WS_U);
    int rowbase, t0, L; bool lat;
    if (u < NLAT / 16) { rowbase = (u >> 7) * SEQ; t0 = (u & 127) * 16; L = SEQ; lat = true; }
    else { const int v = u - NLAT / 16; rowbase = NLAT + (v >> 4) * CTX; t0 = (v & 15) * 16; L = CTX; lat = false; }
    const int c0 = 2 * F.tid;
    const float* cwp = F.in[I_CONVW] + (size_t)layer * 5 * 1024 + c0;
    f32x2 wj[5];
#pragma unroll
    for (int j = 0; j < 5; ++j) wj[j] = *(const f32x2*)(cwp + j * 1024);
    const f32x2 bj = *(const f32x2*)(F.in[I_CONVB] + (size_t)layer * 1024 + c0);
    const int lc = 2 * F.lane, hf = lc >> 6, role = (lc >> 5) & 1, n = lc & 31;
    const float if0 = __builtin_amdgcn_exp2f(-(float)n * (13.287712379549449f / 32.0f)) * 0.15915494309189535f;
    const float if1 = __builtin_amdgcn_exp2f(-(float)(n + 1) * (13.287712379549449f / 32.0f)) * 0.15915494309189535f;
    const bool rope = lat && (F.wave >= 4);
    unsigned win[5];
#pragma unroll
    for (int j = 0; j < 4; ++j) { const int t = t0 - 2 + j; win[j] = (t >= 0 && t < L) ? *(const unsigned*)(PROJ + (size_t)(rowbase + t) * NPROJ + OFF_XBC + c0) : 0u; }
#pragma unroll 4
    for (int tt = 0; tt < 16; ++tt) {
        const int t = t0 + tt + 2; win[4] = (t < L) ? *(const unsigned*)(PROJ + (size_t)(rowbase + t) * NPROJ + OFF_XBC + c0) : 0u;
        float a0 = bj[0], a1 = bj[1];
#pragma unroll
        for (int j = 0; j < 5; ++j) { a0 += wj[j][0] * bflo(win[j]); a1 += wj[j][1] * bfhi(win[j]); }
        float u0 = silu_f(a0), u1 = silu_f(a1);
        if (rope) {
            const int tk = t0 + tt; const float pos = (float)(hf ? (tk & 63) : (tk >> 6));
            const float o0 = __shfl_xor(u0, 16), o1 = __shfl_xor(u1, 16);
            const float s0 = __builtin_amdgcn_sinf(pos * if0), c0f = __builtin_amdgcn_cosf(pos * if0), s1 = __builtin_amdgcn_sinf(pos * if1), c1f = __builtin_amdgcn_cosf(pos * if1);
            u0 = role ? (o0 * s0 + u0 * c0f) : (u0 * c0f - o0 * s0);
            u1 = role ? (o1 * s1 + u1 * c1f) : (u1 * c1f - o1 * s1);
        }
        *(unsigned*)(U + (size_t)(rowbase + t0 + tt) * 1024 + c0) = pk2(u0, u1);
#pragma unroll
        for (int j = 0; j < 4; ++j) win[j] = win[j + 1];
    }
}

constexpr int S_CQ = 0, S_BQ = 17408, S_BT = 34816, S_XT = 53248, S_MQ = 62464, S_HB = 71680, S_MISC = 106496;
__device__ __forceinline__ void ssd_mfma_unit(const Frame& F, int layer, int b, int h, int dir) {
    const int g = h >> 2, tid = F.tid, lane = F.lane, w = F.wave, q16 = lane & 15, gq = lane >> 4;
    const bf16_t* U = (const bf16_t*)(F.ws + WS_U); const float* DTS = (const float*)(F.ws + WS_DT);
    bf16_t* Y = (bf16_t*)(F.ws + (dir ? WS_YB : WS_YF));
    const float aneg = -__expf(F.in[I_ALOG][layer * 16 + dir * 8 + h]), dsk = F.in[I_DSKIP][layer * 8 + h];
    LAS unsigned char* L = F.lds;
    __syncthreads();
    for (int i = tid; i < 64 * 272 / 16; i += NT) *(LAS u32x4*)(L + S_HB + i * 16) = (u32x4){0u, 0u, 0u, 0u};
    f32x4 Hacc[4];
#pragma unroll
    for (int j = 0; j < 4; ++j) Hacc[j] = (f32x4){0.f, 0.f, 0.f, 0.f};
    u32x4 px, pb[2], pc[2];
    const int xl = lane, xc = w;
    float pdt = 0.f;
#define SSD_ROW(ci_, l_) ({ const int s_ = (ci_) < 4 ? 0 : 1, k_ = s_ ? (ci_) - 4 : (ci_), nc_ = s_ ? 32 : 4, c_ = dir ? nc_ - 1 - k_ : k_; \
        (s_ ? b * SEQ : NLAT + b * CTX) + c_ * 64 + (dir ? 63 - (l_) : (l_)); })
#define SSD_PREFETCH(ci_) do { px = *(const u32x4*)(U + (size_t)SSD_ROW(ci_, xl) * 1024 + h * 64 + xc * 8); \
        if (w == 0) pdt = DTS[(size_t)SSD_ROW(ci_, lane) * 16 + dir * 8 + h]; \
        _Pragma("unroll") for (int k_ = 0; k_ < 2; ++k_) { const int l_ = lane, c16_ = w + 8 * k_; const size_t ro_ = (size_t)SSD_ROW(ci_, l_) * 1024; \
            pb[k_] = *(const u32x4*)(U + ro_ + 512 + g * 128 + c16_ * 8); pc[k_] = *(const u32x4*)(U + ro_ + 768 + g * 128 + c16_ * 8); } } while (0)
    SSD_PREFETCH(0);
    int par = 0;
    for (int ci = 0; ci < 36; ++ci) {
        LAS float* misc = (LAS float*)(L + S_MISC) + par * 272;
        if (w == 0) {
            const float dt = pdt; float cs = dt * aneg;
#pragma unroll
            for (int o = 1; o < 64; o <<= 1) { const float v = __shfl_up(cs, o); cs += (lane >= o) ? v : 0.f; }
            const float tot = __shfl(cs, 63);
            misc[lane] = dt; misc[64 + lane] = cs; misc[128 + lane] = __expf(cs); misc[192 + lane] = __expf(tot - cs) * dt; if (lane == 0) misc[256] = __expf(tot);
        }
        __syncthreads();
        {
            const unsigned xw[4] = {px.x, px.y, px.z, px.w};
#pragma unroll
            for (int e = 0; e < 4; ++e) { *(LAS unsigned short*)(L + S_XT + (xc * 8 + 2 * e) * 144 + xl * 2) = (unsigned short)(xw[e] & 0xffffu); *(LAS unsigned short*)(L + S_XT + (xc * 8 + 2 * e + 1) * 144 + xl * 2) = (unsigned short)(xw[e] >> 16); }
#pragma unroll
            for (int k = 0; k < 2; ++k) { const int l = lane, c16 = w + 8 * k; const float wl = misc[192 + l];
                *(LAS u32x4*)(L + S_BQ + l * 272 + c16 * 16) = pb[k]; *(LAS u32x4*)(L + S_CQ + l * 272 + c16 * 16) = pc[k];
                const unsigned bw[4] = {pb[k].x, pb[k].y, pb[k].z, pb[k].w};
#pragma unroll
                for (int e = 0; e < 4; ++e) { const unsigned pw = pk2(bflo(bw[e]) * wl, bfhi(bw[e]) * wl);
                    *(LAS unsigned short*)(L + S_BT + (c16 * 8 + 2 * e) * 144 + l * 2) = (unsigned short)(pw & 0xffffu); *(LAS unsigned short*)(L + S_BT + (c16 * 8 + 2 * e + 1) * 144 + l * 2) = (unsigned short)(pw >> 16); } }
        }
        if (ci + 1 < 36) SSD_PREFETCH(ci + 1);
        __syncthreads();
        const int lt = w >> 1, t2 = (w & 1) * 2;
        bf16x8 cfr[4];
#pragma unroll
        for (int ks = 0; ks < 4; ++ks) cfr[ks] = *(const LAS bf16x8*)(L + S_CQ + (16 * lt + q16) * 272 + ks * 64 + gq * 16);
        {
            const f32x4 csl = *(const LAS f32x4*)(misc + 64 + 16 * lt + 4 * gq);
#pragma unroll
            for (int k = 0; k < 2; ++k) { const int st = t2 + k; f32x4 a = {0.f, 0.f, 0.f, 0.f};
                if (st <= lt) {
#pragma unroll
                    for (int ks = 0; ks < 4; ++ks) { const bf16x8 bfr = *(const LAS bf16x8*)(L + S_BQ + (16 * st + q16) * 272 + ks * 64 + gq * 16); a = __builtin_amdgcn_mfma_f32_16x16x32_bf16(cfr[ks], bfr, a, 0, 0, 0); }
                    const int sidx = 16 * st + q16; const float css = misc[64 + sidx], dts = misc[sidx];
#pragma unroll
                    for (int r = 0; r < 4; ++r) { const int l = 16 * lt + 4 * gq + r; a[r] = (sidx <= l) ? a[r] * __expf(csl[r] - css) * dts : 0.f; }
                }
#pragma unroll
                for (int r = 0; r < 4; r += 2) { const unsigned pw = pk2(a[r], a[r + 1]);
                    *(LAS unsigned short*)(L + S_MQ + (16 * lt + 4 * gq + r) * 144 + (16 * st + q16) * 2) = (unsigned short)(pw & 0xffffu); *(LAS unsigned short*)(L + S_MQ + (16 * lt + 4 * gq + r + 1) * 144 + (16 * st + q16) * 2) = (unsigned short)(pw >> 16); } }
        }
        __syncthreads();
        {
            const f32x4 ecs = *(const LAS f32x4*)(misc + 128 + 16 * lt + 4 * gq);
            const LAS unsigned char* HB = L + S_HB + par * 17408;
#pragma unroll
            for (int k = 0; k < 2; ++k) { const int pt = t2 + k; f32x4 a = {0.f, 0.f, 0.f, 0.f};
#pragma unroll
                for (int ks = 0; ks < 4; ++ks) { const bf16x8 hfr = *(const LAS bf16x8*)(HB + (16 * pt + q16) * 272 + ks * 64 + gq * 16); a = __builtin_amdgcn_mfma_f32_16x16x32_bf16(cfr[ks], hfr, a, 0, 0, 0); }
                a = a * ecs;
#pragma unroll
                for (int ks = 0; ks < 2; ++ks) if (ks <= (lt >> 1)) { const bf16x8 mfr = *(const LAS bf16x8*)(L + S_MQ + (16 * lt + q16) * 144 + ks * 64 + gq * 16), xfr = *(const LAS bf16x8*)(L + S_XT + (16 * pt + q16) * 144 + ks * 64 + gq * 16);
                    a = __builtin_amdgcn_mfma_f32_16x16x32_bf16(mfr, xfr, a, 0, 0, 0); }
                if (dir == 0) { const u32x2 xv = *(const LAS u32x2*)(L + S_XT + (16 * pt + q16) * 144 + (16 * lt + 4 * gq) * 2);
                    a[0] += dsk * bflo(xv.x); a[1] += dsk * bfhi(xv.x); a[2] += dsk * bflo(xv.y); a[3] += dsk * bfhi(xv.y); }
                { const int row0 = SSD_ROW(ci, 16 * lt + 4 * gq); bf16_t* yp = Y + (size_t)row0 * 512 + h * 64 + 16 * pt + q16; const int rs = dir ? -512 : 512;
                  const unsigned w01 = pk2(a[0], a[1]), w23 = pk2(a[2], a[3]);
                  yp[0] = (bf16_t)(w01 & 0xffffu); yp[rs] = (bf16_t)(w01 >> 16); yp[2 * rs] = (bf16_t)(w23 & 0xffffu); yp[3 * rs] = (bf16_t)(w23 >> 16); } }
            const int pt2 = w & 3, nb = (w >> 2) * 4; const float et = misc[256];
            bf16x8 xf2[2];
#pragma unroll
            for (int ks = 0; ks < 2; ++ks) xf2[ks] = *(const LAS bf16x8*)(L + S_XT + (16 * pt2 + q16) * 144 + ks * 64 + gq * 16);
            LAS unsigned char* HN = L + S_HB + (par ^ 1) * 17408;
#pragma unroll
            for (int j = 0; j < 4; ++j) { const int nt = nb + j; Hacc[j] = Hacc[j] * et;
#pragma unroll
                for (int ks = 0; ks < 2; ++ks) { const bf16x8 bfr = *(const LAS bf16x8*)(L + S_BT + (16 * nt + q16) * 144 + ks * 64 + gq * 16); Hacc[j] = __builtin_amdgcn_mfma_f32_16x16x32_bf16(xf2[ks], bfr, Hacc[j], 0, 0, 0); }
#pragma unroll
                for (int r = 0; r < 4; r += 2) { const unsigned pw = pk2(Hacc[j][r], Hacc[j][r + 1]);
                    *(LAS unsigned short*)(HN + (16 * pt2 + 4 * gq + r) * 272 + (16 * nt + q16) * 2) = (unsigned short)(pw & 0xffffu); *(LAS unsigned short*)(HN + (16 * pt2 + 4 * gq + r + 1) * 272 + (16 * nt + q16) * 2) = (unsigned short)(pw >> 16); } }
        }
        par ^= 1;
    }
#undef SSD_ROW
#undef SSD_PREFETCH
}
__device__ __forceinline__ void p_mixa(const Frame& F, int layer, bool last) {
    for (int u = F.bid; u < NTOK / 16; u += F.G) ssd_prepass_unit(F, layer, u);
    for (int u0 = F.bid; u0 < 2048 * REP_NA; u0 += F.G) { const int u = u0 & 2047; na_unit(F, layer, u >> 7, (u >> 4) & 7, 0, u & 15); }
    if (!last) for (int u = F.bid; u < 256; u += F.G) na_unit(F, layer, u >> 4, (u >> 1) & 7, 1, u & 1);
}
__device__ __forceinline__ void p_mixb(const Frame& F, int layer) {
    for (int u0 = F.bid; u0 < 256 * REP_SSD; u0 += F.G) { const int u = u0 & 255; ssd_mfma_unit(F, layer, u >> 4, (u >> 1) & 7, u & 1); }
}

__device__ __forceinline__ void p_ssdcomb(const Frame& F, int layer, bool last) {
    const bf16_t* PROJ = (const bf16_t*)(F.ws + WS_PROJ); bf16_t* MIX = (bf16_t*)(F.ws + WS_MIX);
    const bf16_t* YF = (const bf16_t*)(F.ws + WS_YF); const bf16_t* YB = (const bf16_t*)(F.ws + WS_YB);
    const float* nw = F.in[I_NORMW] + layer * 512 + F.lane * 8;
    const f32x4 nw0 = *(const f32x4*)nw, nw1 = *(const f32x4*)(nw + 4);
    const int nrows = last ? NLAT : NTOK;
    u32x4 pyf = {0u, 0u, 0u, 0u}, pyb = pyf, pz = pyf;
#define SC_LOAD(r_) do { const size_t o_ = (size_t)(r_) * 512 + F.lane * 8; pyf = *(const u32x4*)(YF + o_); pyb = *(const u32x4*)(YB + o_); \
        pz = *(const u32x4*)(PROJ + (size_t)(r_) * NPROJ + OFF_Z + F.lane * 8); } while (0)
    if (F.gw < nrows) SC_LOAD(F.gw);
    for (int row = F.gw; row < nrows; row += F.NGW) {
        const f32x4 a0 = {bflo(pyf.x) + bflo(pyb.x), bfhi(pyf.x) + bfhi(pyb.x), bflo(pyf.y) + bflo(pyb.y), bfhi(pyf.y) + bfhi(pyb.y)}, a1 = {bflo(pyf.z) + bflo(pyb.z), bfhi(pyf.z) + bfhi(pyb.z), bflo(pyf.w) + bflo(pyb.w), bfhi(pyf.w) + bfhi(pyb.w)}; const u32x4 zv = pz;
        if (row + F.NGW < nrows) SC_LOAD(row + F.NGW);
        float y[8] = {a0[0] * silu_f(bflo(zv.x)), a0[1] * silu_f(bfhi(zv.x)), a0[2] * silu_f(bflo(zv.y)), a0[3] * silu_f(bfhi(zv.y)),
                      a1[0] * silu_f(bflo(zv.z)), a1[1] * silu_f(bfhi(zv.z)), a1[2] * silu_f(bflo(zv.w)), a1[3] * silu_f(bfhi(zv.w))};
        float ss = 0.f;
#pragma unroll
        for (int k = 0; k < 8; ++k) ss += y[k] * y[k];
#pragma unroll
        for (int of = 1; of < 32; of <<= 1) ss += __shfl_xor(ss, of);
        const float rs = 1.0f / sqrtf(ss * (1.0f / 256.0f) + RMS_EPS);
        u32x4 w; w.x = pk2(y[0] * rs * nw0[0], y[1] * rs * nw0[1]); w.y = pk2(y[2] * rs * nw0[2], y[3] * rs * nw0[3]);
        w.z = pk2(y[4] * rs * nw1[0], y[5] * rs * nw1[1]); w.w = pk2(y[6] * rs * nw1[2], y[7] * rs * nw1[3]);
        *(u32x4*)(MIX + (size_t)row * D + 512 + F.lane * 8) = w;
    }
}

__device__ __forceinline__ void p_outproj(const Frame& F, int layer, bool last) {
    bf16_t* X = (bf16_t*)(F.ws + WS_X);
    pg8::Gemm g{(const bf16_t*)(F.ws + WS_MIX), (const bf16_t*)(F.ws + WS_WOUT) + (size_t)layer * D * D, D};
    pg8::DenseOrder S; S.init(last ? NLAT : NTOK, D, D, F.G, F.bid);
    pg8::EpiResid E{layer == 0 ? (const void*)F.in[I_X] : (const void*)X, layer == 0 ? (const void*)F.in[I_CTX] : (const void*)(X + (size_t)NLAT * D), X, (const float*)(F.ws + WS_MOD) + (size_t)layer * 17 * MODW, 2 * D, layer == 0};
    pg8::gemm_phase<pg8::EpiResid, pg8::DenseOrder, true, true>(F.lds, g, S, E, F.tid);
}

__device__ __forceinline__ unsigned* cnt_word(const Frame& F, int slot, int hf, int e) { return (unsigned*)(F.ws + WS_CTL) + CW_CNT + ((slot * 2 + hf) * 8 + e) * 64; }
__device__ __forceinline__ void p_ln1(const Frame& F, int layer, bool last) {
    bf16_t* X = (bf16_t*)(F.ws + WS_X); bf16_t* H = (bf16_t*)(F.ws + WS_H);
    const float* MOD = (const float*)(F.ws + WS_MOD) + (size_t)layer * 17 * MODW;
    const float* lg = F.in[I_LNG] + (size_t)(layer * 2) * D; const float* lb = F.in[I_LNB] + (size_t)(layer * 2) * D;
    const bool moe = layer & 1; const int slot = layer >> 1;
    const int nrows = last ? NLAT : NTOK;
    float rw[16][8];
    if (moe) { const float* R = F.in[I_RW] + (size_t)slot * D * 8;
#pragma unroll
        for (int j = 0; j < 4; ++j)
#pragma unroll
            for (int k = 0; k < 4; ++k) { const int lane = F.lane; const f32x4 a = *(const f32x4*)(R + (size_t)(RIDX(j) + k) * 8), b2 = *(const f32x4*)(R + (size_t)(RIDX(j) + k) * 8 + 4);
                rw[j * 4 + k][0] = a[0]; rw[j * 4 + k][1] = a[1]; rw[j * 4 + k][2] = a[2]; rw[j * 4 + k][3] = a[3]; rw[j * 4 + k][4] = b2[0]; rw[j * 4 + k][5] = b2[1]; rw[j * 4 + k][6] = b2[2]; rw[j * 4 + k][7] = b2[3]; } }
    f32x4 vn[4];
    if (F.gw < nrows) row_load_h(X + (size_t)F.gw * D, F.lane, vn);
    for (int row = F.gw; row < nrows; row += F.NGW) {
        f32x4 v[4], hv[4];
#pragma unroll
        for (int j = 0; j < 4; ++j) v[j] = vn[j];
        if (row + F.NGW < nrows) row_load_h(X + (size_t)(row + F.NGW) * D, F.lane, vn);
        row_ln(v, lg, lb, F.lane);
        row_store_h(X + (size_t)row * D, F.lane, v);
        const float* m = MOD + (size_t)mod_row_of(row) * MODW;
        if (USE_FP8 && (moe || FP8_DENSE)) row_mod_store8((unsigned char*)H + (size_t)row * D, F.lane, v, m + 3 * D, m + 4 * D, hv);
        else row_mod_store(H + (size_t)row * D, F.lane, v, m + 3 * D, m + 4 * D, hv);
        if (moe) {
            float lg8[8];
#pragma unroll
            for (int e = 0; e < 8; ++e) { float s = 0.f;
#pragma unroll
                for (int j = 0; j < 4; ++j)
#pragma unroll
                    for (int k = 0; k < 4; ++k) s += hv[j][k] * rw[j * 4 + k][e];
                lg8[e] = wave_sum(s); }
            int e0 = 0; float v0 = lg8[0];
#pragma unroll
            for (int e = 1; e < 8; ++e) if (lg8[e] > v0) { v0 = lg8[e]; e0 = e; }
            int e1 = -1; float v1 = -INFINITY;
#pragma unroll
            for (int e = 0; e < 8; ++e) if (e != e0 && lg8[e] > v1) { v1 = lg8[e]; e1 = e; }
            if (F.lane == 0) {
                const unsigned s0 = atomicAdd(cnt_word(F, slot, 0, e0), 1u), s1 = atomicAdd(cnt_word(F, slot, 0, e1), 1u);
                int* list = (int*)(F.ws + WS_LIST);
                list[e0 * NTOK + s0] = row; list[e1 * NTOK + s1] = row;
                const float ex = __expf(v1 - v0), g0 = 1.0f / (1.0f + ex);
                u32x4 r; r.x = (unsigned)e0 | ((unsigned)e1 << 8); r.y = s0; r.z = s1; r.w = 0u;
                *(u32x4*)(F.ws + WS_ROUTE + (size_t)row * 16) = r;
                *(f32x2*)(F.ws + WS_GATES + (size_t)row * 8) = (f32x2){g0, ex * g0};
            }
        }
    }
}

__device__ __forceinline__ void p_ffn1_dense(const Frame& F, int layer, bool last) {
    const int s = layer >> 1;
#if USE_FP8 && FP8_DENSE
    pg8::Gemm g{(const bf16_t*)(F.ws + WS_H), (const bf16_t*)(F.ws + WS_WFGU + (size_t)s * 2 * DFF * D), D / 2};
    pg8::DenseOrder S; S.init(last ? NLAT : NTOK, 2 * DFF, D / 2, F.G, F.bid, REP_GEMM);
    pg8::EpiSwiGLU8 E{F.ws + WS_HID, DFF};
    pg8::gemm_phase<pg8::EpiSwiGLU8, pg8::DenseOrder, true, FP8_SP2, true>(F.lds, g, S, E, F.tid, (127 - S8_WGU) * 0x01010101, (127 - S8_ACT) * 0x01010101);
#else
    pg8::Gemm g{(const bf16_t*)(F.ws + WS_H), (const bf16_t*)(F.ws + WS_WFGU) + (size_t)s * 2 * DFF * D, D};
    pg8::DenseOrder S; S.init(last ? NLAT : NTOK, 2 * DFF, D, F.G, F.bid, REP_GEMM);
    pg8::EpiSwiGLU E{(bf16_t*)(F.ws + WS_HID), DFF};
    pg8::gemm_phase<pg8::EpiSwiGLU, pg8::DenseOrder, true, true>(F.lds, g, S, E, F.tid);
#endif
}
__device__ __forceinline__ void p_ffn2_dense(const Frame& F, int layer, bool last) {
    const int s = layer >> 1; bf16_t* X = (bf16_t*)(F.ws + WS_X);
    pg8::EpiResid E{(const void*)X, (const void*)(X + (size_t)NLAT * D), X, (const float*)(F.ws + WS_MOD) + (size_t)layer * 17 * MODW, 5 * D, false};
#if USE_FP8 && FP8_DENSE
    pg8::Gemm g{(const bf16_t*)(F.ws + WS_HID), (const bf16_t*)(F.ws + WS_WFD + (size_t)s * D * DFF), DFF / 2};
    pg8::DenseOrder S; S.init(last ? NLAT : NTOK, D, DFF / 2, F.G, F.bid);
    pg8::gemm_phase<pg8::EpiResid, pg8::DenseOrder, true, FP8_SP2, true>(F.lds, g, S, E, F.tid, (127 - S8_WD) * 0x01010101, (127 - S8_HID) * 0x01010101);
#else
    pg8::Gemm g{(const bf16_t*)(F.ws + WS_HID), (const bf16_t*)(F.ws + WS_WFD) + (size_t)s * D * DFF, DFF};
    pg8::DenseOrder S; S.init(last ? NLAT : NTOK, D, DFF, F.G, F.bid);
    pg8::gemm_phase<pg8::EpiResid, pg8::DenseOrder, true, true>(F.lds, g, S, E, F.tid);
#endif
}
__device__ __forceinline__ void moe_prefix(const Frame& F, int slot, int hf, int (&ts)[9], int (&cn)[8]) {
    int a = 0;
#pragma unroll
    for (int e = 0; e < 8; ++e) { cn[e] = (int)*cnt_word(F, slot, hf, e); ts[e] = a; a += (cn[e] + 255) >> 8; }
    ts[8] = a;
}
__device__ __forceinline__ void p_ffn1_moe(const Frame& F, int layer) {
    const int slot = layer >> 1; int cn[8];
    pg8::MoeOrder<true> S; moe_prefix(F, slot, 0, S.ts, cn);
    S.nM = S.ts[8]; S.nN = 2 * DFFE / 256; S.G = F.G; S.c = F.bid; S.K = D / 2; S.estride = (long)2 * DFFE * D; S.rowoff = (const LAS unsigned short*)(F.lds + LDS_ROWOFF); S.rowbytes = D;
    {
        const int* list = (const int*)(F.ws + WS_LIST); LAS unsigned short* ro = (LAS unsigned short*)(F.lds + LDS_ROWOFF); pg8::Unit u;
        for (int i = 0; i < 36 && S.next(i, u); ++i) { const int e = S.expert_of(u.pm); int tse = 0, cne = 0;
#pragma unroll
            for (int j = 0; j < 8; ++j) { tse = (j == e) ? S.ts[j] : tse; cne = (j == e) ? cn[j] : cne; }
            for (int r = F.tid; r < 256; r += NT) { const int sl = (u.pm - tse) * 256 + r; const int tok = sl < cne ? list[e * NTOK + sl] : 0; ro[i * 256 + r] = (unsigned short)tok; } }
        __syncthreads();
    }
    pg8::Gemm g{(const bf16_t*)(F.ws + WS_H), (const bf16_t*)(F.ws + WS_WMGU + (size_t)slot * NEXP * 2 * DFFE * D), D / 2};
    pg8::EpiSwiGLU8 E{F.ws + WS_HID, DFFE};
    pg8::gemm_phase<pg8::EpiSwiGLU8, pg8::MoeOrder<true>, true, FP8_SP2, true>(F.lds, g, S, E, F.tid, (127 - S8_WGU) * 0x01010101, (127 - S8_ACT) * 0x01010101);
}
__device__ __forceinline__ void p_ffn2_moe(const Frame& F, int layer) {
    const int slot = layer >> 1; int cn[8];
    pg8::MoeOrder<false> S; moe_prefix(F, slot, 0, S.ts, cn);
    S.nM = S.ts[8]; S.nN = D / 256; S.G = F.G; S.c = F.bid; S.K = DFFE / 2; S.estride = (long)D * DFFE; S.rowoff = nullptr; S.rowbytes = 0;
    pg8::EpiBf16 E{(bf16_t*)(F.ws + WS_YP), D};
    pg8::Gemm g{(const bf16_t*)(F.ws + WS_HID), (const bf16_t*)(F.ws + WS_WMD + (size_t)slot * NEXP * D * DFFE), DFFE / 2};
    pg8::gemm_phase<pg8::EpiBf16, pg8::MoeOrder<false>, true, FP8_SP2, true>(F.lds, g, S, E, F.tid, (127 - S8_WD) * 0x01010101, (127 - S8_HID) * 0x01010101);
}

__device__ __forceinline__ void p_ln2(const Frame& F, int layer, bool last) {
    bf16_t* X = (bf16_t*)(F.ws + WS_X); bf16_t* H = (bf16_t*)(F.ws + WS_H);
    const float* MOD = (const float*)(F.ws + WS_MOD) + (size_t)layer * 17 * MODW;
    const float* lg = F.in[I_LNG] + (size_t)(layer * 2 + 1) * D; const float* lb = F.in[I_LNB] + (size_t)(layer * 2 + 1) * D;
    const bool moe = layer & 1; const int slot = layer >> 1;
    const int nrows = last ? NLAT : NTOK;
    int ts0[9], cn[8];
    if (moe) moe_prefix(F, slot, 0, ts0, cn);
    const bf16_t* YP = (const bf16_t*)(F.ws + WS_YP);
    f32x4 vn[4]; u32x4 rn = {0u, 0u, 0u, 0u}; f32x2 gn = {0.f, 0.f};
    if (F.gw < nrows) { row_load_h(X + (size_t)F.gw * D, F.lane, vn); if (moe) { rn = *(const u32x4*)(F.ws + WS_ROUTE + (size_t)F.gw * 16); gn = *(const f32x2*)(F.ws + WS_GATES + (size_t)F.gw * 8); } }
    for (int row = F.gw; row < nrows; row += F.NGW) {
        f32x4 v[4], hv[4];
#pragma unroll
        for (int j = 0; j < 4; ++j) v[j] = vn[j];
        const u32x4 r = rn; const f32x2 gt = gn;
        if (row + F.NGW < nrows) { row_load_h(X + (size_t)(row + F.NGW) * D, F.lane, vn);
            if (moe) { rn = *(const u32x4*)(F.ws + WS_ROUTE + (size_t)(row + F.NGW) * 16); gn = *(const f32x2*)(F.ws + WS_GATES + (size_t)(row + F.NGW) * 8); } }
        if (moe) {
            const int e0 = r.x & 255, e1 = (r.x >> 8) & 255;
            int t0 = 0, t1 = 0;
#pragma unroll
            for (int e = 0; e < 8; ++e) { const int tv = ts0[e]; t0 = (e == e0) ? tv : t0; t1 = (e == e1) ? tv : t1; }
            const bf16_t* y0 = YP + ((size_t)t0 * 256 + r.y) * D; const bf16_t* y1 = YP + ((size_t)t1 * 256 + r.z) * D;
            const float* g2 = MOD + (size_t)mod_row_of(row) * MODW + 5 * D;
#pragma unroll
            for (int j = 0; j < 2; ++j) { const int lane = F.lane; const u32x4 a = *(const u32x4*)(y0 + 8 * lane + 512 * j), b2 = *(const u32x4*)(y1 + 8 * lane + 512 * j);
                const f32x4 g0 = *(const f32x4*)(g2 + RIDX(2 * j)) + 1.0f, g1 = *(const f32x4*)(g2 + RIDX(2 * j + 1)) + 1.0f;
                f32x4 f0, f1; f0[0] = gt[0] * bflo(a.x) + gt[1] * bflo(b2.x); f0[1] = gt[0] * bfhi(a.x) + gt[1] * bfhi(b2.x); f0[2] = gt[0] * bflo(a.y) + gt[1] * bflo(b2.y); f0[3] = gt[0] * bfhi(a.y) + gt[1] * bfhi(b2.y);
                f1[0] = gt[0] * bflo(a.z) + gt[1] * bflo(b2.z); f1[1] = gt[0] * bfhi(a.z) + gt[1] * bfhi(b2.z); f1[2] = gt[0] * bflo(a.w) + gt[1] * bflo(b2.w); f1[3] = gt[0] * bfhi(a.w) + gt[1] * bfhi(b2.w);
                v[2 * j] = v[2 * j] * ALPHA + g0 * f0; v[2 * j + 1] = v[2 * j + 1] * ALPHA + g1 * f1; }
        }
        row_ln(v, lg, lb, F.lane);
        if (last) row_store(F.out + (size_t)row * D, F.lane, v);
        else { row_store_h(X + (size_t)row * D, F.lane, v);
            const float* m = MOD + (size_t)17 * MODW + (size_t)mod_row_of(row) * MODW;
            row_mod_store(H + (size_t)row * D, F.lane, v, m, m + D, hv);
            }
    }
}

constexpr int NPL = 9;
constexpr int NPH = 2 + NPL * DEPTH;
#ifndef SITE_MASK
#define SITE_MASK 0xFFFFF
#endif
#define SITE(n) (((SITE_MASK) >> (n)) & 1)
__global__ void __launch_bounds__(NT, 2) fwd_kernel(Args args) {
    extern __shared__ __attribute__((aligned(16))) unsigned char lds_raw[];
    Frame F;
    F.lds = (LAS unsigned char*)lds_raw; F.in = args.in; F.out = args.out; F.ws = args.ws;
    F.tid = threadIdx.x; F.lane = F.tid & 63; F.wave = __builtin_amdgcn_readfirstlane(F.tid >> 6); F.bid = blockIdx.x; F.G = gridDim.x;
    F.gw = F.bid * NWAVES + F.wave; F.NGW = F.G * NWAVES;
    volatile LAS unsigned* MISC = (volatile LAS unsigned*)(F.lds + LDS_MISC);
    if (F.tid < 64) MISC[F.tid] = 0u;
    __syncthreads();
    XcdBarrier bar; bar.bar = (unsigned*)(F.ws + WS_CTL) + CW_BAR; bar.x = 0; bar.st = MISC + 8;
#if MK_SINGLE
    bar = xcd_barrier_post((unsigned*)(F.ws + WS_CTL) + CW_BAR, MISC + 8);
#endif
    const int lo = args.ph_lo, hi = args.ph_hi;
#define IN(k) (lo <= (k) && (k) < hi)
#if MK_SINGLE
#define SEAM(k) do { if (IN(k) && IN((k) + 1)) { XcdBarrier b2_ = bar; int z_; asm volatile("s_mov_b32 %0, 0" : "=s"(z_)); b2_.bar = bar.bar + z_; int ln_; asm volatile("v_mbcnt_lo_u32_b32 %0, -1, 0\n\tv_mbcnt_hi_u32_b32 %0, -1, %0" : "=v"(ln_)); xcd_barrier(b2_, F.wave == 0 && ln_ == 0); } } while (0)
#else
#define SEAM(k) do { } while (0)
#endif
    if constexpr (SITE(0)) if (IN(0)) p_pro_a(fresh(F));
    SEAM(0);
    if constexpr (SITE(1)) if (IN(1)) p_pro_b(fresh(F));
    SEAM(1);
    for (int layer = 0; layer < DEPTH; ++layer) {
        const int pb = 2 + NPL * layer; const bool last = layer == DEPTH - 1; const bool moe = layer & 1;
        if constexpr (SITE(2)) if (IN(pb + 0)) p_inproj(fresh(F), layer);
        SEAM(pb + 0);
        if constexpr (SITE(3)) if (IN(pb + 1)) p_mixa(fresh(F), layer, last);
        SEAM(pb + 1);
        if constexpr (SITE(12)) if (IN(pb + 2)) p_mixb(fresh(F), layer);
        SEAM(pb + 2);
        if constexpr (SITE(4)) if (IN(pb + 3)) { p_ssdcomb(fresh(F), layer, last); if (!USE_FP8 && layer == 2) { int rot = 0; conv_moe(fresh(F), 1, rot); } }
        SEAM(pb + 3);
        if constexpr (SITE(5)) if (IN(pb + 4)) p_outproj(fresh(F), layer, last);
        SEAM(pb + 4);
        if constexpr (SITE(6)) if (IN(pb + 5)) p_ln1(fresh(F), layer, last);
        SEAM(pb + 5);
        if (moe) {
            if constexpr (SITE(7)) if (IN(pb + 6)) p_ffn1_moe(fresh(F), layer);
            SEAM(pb + 6);
            if constexpr (SITE(8)) if (IN(pb + 7)) p_ffn2_moe(fresh(F), layer);
            SEAM(pb + 7);
        } else {
            if constexpr (SITE(9)) if (IN(pb + 6)) p_ffn1_dense(fresh(F), layer, last);
            SEAM(pb + 6);
            if constexpr (SITE(10)) if (IN(pb + 7)) p_ffn2_dense(fresh(F), layer, last);
            SEAM(pb + 7);
        }
        if constexpr (SITE(11)) if (IN(pb + 8)) p_ln2(fresh(F), layer, last);
        if (!last) SEAM(pb + 8);
    }
#undef IN
#undef SEAM
}

extern "C" void kernel_launch(void* const* d_in, const int* in_sizes, int n_in, void* d_out, int out_size, void* d_ws, size_t ws_size, hipStream_t stream) {
    static int grid = 0;
    if (grid == 0) {
        if (n_in != 24 || out_size != NLAT * D || ws_size < WS_END) { fprintf(stderr, "kernel_launch: unexpected shapes (n_in %d, out %d, ws %zu < %zu)\n", n_in, out_size, ws_size, (size_t)WS_END); grid = -1; return; }
        int dev = 0, cus = 0, per_cu = 0;
        if (hipGetDevice(&dev) != hipSuccess || hipDeviceGetAttribute(&cus, hipDeviceAttributeMultiprocessorCount, dev) != hipSuccess) { grid = -1; return; }
        if (hipFuncSetAttribute((const void*)fwd_kernel, hipFuncAttributeMaxDynamicSharedMemorySize, LDS_BYTES) != hipSuccess) { fprintf(stderr, "kernel_launch: hipFuncSetAttribute failed\n"); grid = -1; return; }
        if (hipOccupancyMaxActiveBlocksPerMultiprocessor(&per_cu, (const void*)fwd_kernel, NT, LDS_BYTES) != hipSuccess || per_cu < 1) { fprintf(stderr, "kernel_launch: occupancy query says %d\n", per_cu); }
        (void)hipGetLastError();
        grid = cus;
    }
    if (grid < 0) return;
    (void)in_sizes;
    if (hipMemsetAsync((char*)d_ws + WS_CTL, 0, CTL_BYTES, stream) != hipSuccess) return;
    Args a{};
    for (int i = 0; i < 24; ++i) a.in[i] = (const float*)d_in[i];
    a.out = (float*)d_out; a.ws = (unsigned char*)d_ws;
#if MK_SINGLE
    a.ph_lo = 0; a.ph_hi = NPH;
    hipLaunchKernelGGL(fwd_kernel, dim3(grid), dim3(NT), LDS_BYTES, stream, a);
#else
    for (int ph = 0; ph < NPH; ++ph) {

        a.ph_lo = ph; a.ph_hi = ph + 1;
        hipLaunchKernelGGL(fwd_kernel, dim3(grid), dim3(NT), LDS_BYTES, stream, a);
    }
#endif
}
```

```cpp
#include <hip/hip_runtime.h>
#include <cstdio>
#include <cstdint>

#ifndef MK_SINGLE
#define MK_SINGLE 1
#endif

#ifndef FP8_INPROJ
#define FP8_INPROJ 0
#endif
#ifndef FP8_DENSE
#define FP8_DENSE 0
#endif
#ifndef USE_FP8
#define USE_FP8 1
#endif
#ifndef FP8_SP2
#define FP8_SP2 true
#endif
#ifndef REP_SSD
#define REP_SSD 1
#endif
#ifndef REP_NA
#define REP_NA 1
#endif
#ifndef REP_GEMM
#define REP_GEMM 1
#endif
#define GAS __attribute__((address_space(1)))
#define LAS __attribute__((address_space(3)))
typedef unsigned short bf16_t;
typedef short bf16x8 __attribute__((ext_vector_type(8)));
typedef float f32x4 __attribute__((ext_vector_type(4)));
typedef float f32x2 __attribute__((ext_vector_type(2)));
typedef unsigned u32x4 __attribute__((ext_vector_type(4)));
typedef unsigned u32x2 __attribute__((ext_vector_type(2)));
typedef int i32x4 __attribute__((ext_vector_type(4)));
typedef int i32x8 __attribute__((ext_vector_type(8)));

constexpr int D = 1024, BATCH = 16, SEQ = 2048, DEPTH = 4, GRID_W = 64, CTX = 256;
constexpr int NLAT = BATCH * SEQ;
constexpr int NCTX = BATCH * CTX;
constexpr int NTOK = NLAT + NCTX;
constexpr int NPROJ = 3072;
constexpr int OFF_K = 512, OFF_V = 1024, OFF_Z = 1536, OFF_XBC = 2048;
constexpr int D_IN_PROJ = 3088;
constexpr int DFF = 2816, DFFE = 3584, NEXP = 8;
constexpr float ALPHA = 1.6817928305074290f;
constexpr float LN_EPS = 1e-5f, RMS_EPS = 1e-5f;
constexpr int MODW = 6 * D;

constexpr size_t MiB = 1u << 20;
constexpr size_t WS_CTL = 0, CTL_BYTES = 1 * MiB;
constexpr size_t WS_MOD = 1 * MiB;
constexpr size_t WS_ROUTE = 3 * MiB;
constexpr size_t WS_GATES = 4 * MiB;
constexpr size_t WS_LIST = 5 * MiB;
constexpr size_t WS_WDT = 7 * MiB;
constexpr size_t WS_WIN = 8 * MiB;
constexpr size_t WS_WOUT = 32 * MiB;
constexpr size_t WS_WFGU = 40 * MiB;
constexpr size_t WS_WFD = 62 * MiB;
constexpr size_t WS_WMGU = 73 * MiB;
constexpr size_t WS_WMD = 185 * MiB;
constexpr size_t WS_X = 241 * MiB;
constexpr size_t WS_H = 385 * MiB;
constexpr size_t WS_R = 457 * MiB;
constexpr size_t WS_PROJ = WS_R;
constexpr size_t WS_DT = WS_R + 216 * MiB;
constexpr size_t WS_YF = WS_R + 219 * MiB;
constexpr size_t WS_YB = WS_R + 291 * MiB;
constexpr size_t WS_MIX = WS_R + 363 * MiB;
constexpr size_t WS_HID = WS_R;
constexpr size_t WS_YP = WS_R + 270 * MiB;
constexpr size_t WS_U = WS_R + 435 * MiB;
constexpr size_t WS_H8IN = WS_U;
constexpr size_t WS_END = WS_R + 507 * MiB;
constexpr int MOE_PAD = 2 * NTOK + 2048;
static_assert(USE_FP8 == 1, "the single-phase MoE needs the e4m3 hidden (the bf16 one does not fit the workspace)");
static_assert(WS_HID + (size_t)MOE_PAD * 3584 <= WS_YP && WS_YP + (size_t)MOE_PAD * 1024 * 2 <= WS_END, "MoE buffers");

constexpr int CW_TMO = 0;
constexpr int CW_BAR = 4096;
constexpr int CW_CNT = 16384;

constexpr int LDS_STAGE = 131072;
constexpr int LDS_ROWOFF = 131072;
constexpr int LDS_MISC = 131072 + 18432;
constexpr int LDS_BYTES = 155648;

constexpr int S8_ACT = 3, S8_WGU = 8, S8_HID = 2, S8_WD = 9;
__device__ __forceinline__ unsigned f2bf(float f) { unsigned u = __builtin_bit_cast(unsigned, f); return (u + 0x7fffu + ((u >> 16) & 1u)) >> 16; }
typedef __bf16 bf16x2_t __attribute__((ext_vector_type(2)));
__device__ __forceinline__ unsigned pk2(float lo, float hi) { const f32x2 v = {lo, hi}; const bf16x2_t b = __builtin_convertvector(v, bf16x2_t); return __builtin_bit_cast(unsigned, b); }
__device__ __forceinline__ float bf2f(unsigned short b) { return __builtin_bit_cast(float, ((unsigned)b) << 16); }
__device__ __forceinline__ float bflo(unsigned w) { return __builtin_bit_cast(float, w << 16); }
__device__ __forceinline__ float bfhi(unsigned w) { return __builtin_bit_cast(float, w & 0xffff0000u); }
__device__ __forceinline__ float silu_f(float v) { return v / (1.0f + __expf(-v)); }
__device__ __forceinline__ float clamp8(float v) { return fminf(fmaxf(v, -448.0f), 448.0f); }
__device__ __forceinline__ unsigned pk8(float a, float b, float c, float d) {
    int w = 0; w = __builtin_amdgcn_cvt_pk_fp8_f32(clamp8(a), clamp8(b), w, false); w = __builtin_amdgcn_cvt_pk_fp8_f32(clamp8(c), clamp8(d), w, true); return (unsigned)w; }
__device__ __forceinline__ float wave_sum(float v) {
#pragma unroll
    for (int o = 1; o < 64; o <<= 1) v += __shfl_xor(v, o);
    return v;
}

namespace pg8 {
constexpr int BM = 256, BK = 64, HALF = 128, HTB = HALF * BK * 2, STAGE_BYTES = 8 * HTB, NXCD = 8, WGM = 8;
__host__ __device__ __forceinline__ int lds_byte(int r, int c) { const int st = (r >> 4) * 2 + (c >> 5), rr = r & 15, cc = c & 31, ob = rr * 64 + cc * 2; return st * 1024 + (ob ^ (((ob >> 9) & 1) << 5)); }
__host__ __device__ __forceinline__ void stage_rc(int b, int& R, int& C) { const int st = b / 1024, sb = b % 1024, swz = sb ^ (((sb >> 9) & 1) << 5); R = (st >> 1) * 16 + swz / 64; C = (st & 1) * 32 + (swz % 64) / 2; }
__host__ __device__ __forceinline__ int perm32(int rho) { const int n = rho >> 4, i = rho & 15; return 8 * (i >> 2) + 4 * n + (i & 3); }

struct Unit { int pm, pn; long bofs; };
struct Gemm { const bf16_t* A; const bf16_t* Bt; int K; };

__device__ __forceinline__ unsigned cvt_pk_bf16(float lo, float hi) { return pk2(lo, hi); }
__device__ __forceinline__ unsigned cvt_pk_bf16_pin(float lo, float hi) { unsigned r; asm volatile("v_cvt_pk_bf16_f32 %0, %1, %2" : "=v"(r) : "v"(lo), "v"(hi)); return r; }

__device__ __forceinline__ bool static_tile(int i, int G, int c, int nM, int nN, int& pm, int& pn, int rep = 1) {
    const int nwg = nM * nN;
#if REP_GEMM > 1
    { const int cnt = (nwg - c + G - 1) / G; if (cnt <= 0 || i >= rep * cnt) return false; i %= cnt; }
#endif
    const long L = (long)i * G + c; if (L >= nwg) return false;
    int wgid = (int)L; { const int q = nwg / NXCD, r = nwg % NXCD, xcd = wgid % NXCD, off = wgid / NXCD; wgid = (xcd < r ? xcd * (q + 1) : r * (q + 1) + (xcd - r) * q) + off; }
    const int nig = WGM * nN, gid = wgid / nig, fm = gid * WGM, gsz = (nM - fm) < WGM ? (nM - fm) : WGM;
    pm = fm + ((wgid % nig) % gsz); pn = (wgid % nig) / gsz; return true;
}
struct DenseOrder {
    int nM, nN, G, c, K, rep;
    __device__ __forceinline__ void init(int M, int N, int K_, int G_, int c_, int rep_ = 1) { nM = M / BM; nN = N / BM; G = G_; c = c_; K = K_; rep = rep_; }
    __device__ __forceinline__ bool next(int i, Unit& u) const { if (!static_tile(i, G, c, nM, nN, u.pm, u.pn, rep)) return false; u.bofs = (long)u.pn * BM * K * 2; return true; }
    static constexpr bool GATHER = false;
    __device__ __forceinline__ long a_base(const Unit& u) const { return (long)u.pm * BM * K * 2; }
    __device__ __forceinline__ void a_offs(int, const Unit&, int, unsigned (&)[2][2]) const {}
};
template <bool GATHER_> struct MoeOrder {
    int nM, nN, G, c, K; int ts[9]; long estride; const LAS unsigned short* rowoff; unsigned rowbytes;
    __device__ __forceinline__ int expert_of(int pm) const { int e = 0;
#pragma unroll
        for (int j = 1; j < 8; ++j) e += (pm >= ts[j]) ? 1 : 0; return e; }
    __device__ __forceinline__ bool next(int i, Unit& u) const { if (!static_tile(i, G, c, nM, nN, u.pm, u.pn, REP_GEMM)) return false; u.bofs = (long)expert_of(u.pm) * estride + (long)u.pn * BM * K * 2; return true; }
    static constexpr bool GATHER = GATHER_;
    __device__ __forceinline__ long a_base(const Unit& u) const { return GATHER_ ? 0l : (long)u.pm * BM * K * 2; }
    __device__ __forceinline__ void a_offs(int ui, const Unit&, int tid, unsigned (&o)[2][2]) const {
        int uix = ui;
#if REP_GEMM > 1
        { const int cnt = (nM * nN - c + G - 1) / G; uix = ui % cnt; }
#endif
        if (GATHER_) {
#pragma unroll
            for (int i = 0; i < 2; ++i) { int R, C; stage_rc(tid * 16 + i * 8192, R, C);
#pragma unroll
                for (int h = 0; h < 2; ++h) o[h][i] = (unsigned)rowoff[uix * 256 + h * HALF + R] * rowbytes + (unsigned)(C * 2); }
        }
    }
};

struct EpiBf16 {
    static constexpr bool PERM = true;
    bf16_t* O; int ldc;
    __device__ __forceinline__ void operator()(const f32x4 (&acc)[2][2][4][2], const Unit& u, int wr, int wc, int fr, int fq) const {
        const int row0 = u.pm * BM + wr * 64 + fr; const int col0 = u.pn * BM + wc * 32 + 8 * fq;
#pragma unroll
        for (int ai = 0; ai < 2; ++ai)
#pragma unroll
            for (int m = 0; m < 4; ++m) { bf16_t* rowp = O + (size_t)(row0 + ai * HALF + m * 16) * ldc + col0;
#pragma unroll
                for (int bj = 0; bj < 2; ++bj) { const f32x4 v0 = acc[ai][bj][m][0], v1 = acc[ai][bj][m][1];
                    u32x4 w; w.x = cvt_pk_bf16(v0[0], v0[1]); w.y = cvt_pk_bf16(v0[2], v0[3]); w.z = cvt_pk_bf16(v1[0], v1[1]); w.w = cvt_pk_bf16(v1[2], v1[3]);
                    *(u32x4*)(rowp + bj * HALF) = w; } }
    }
};
struct EpiSwiGLU {
    static constexpr bool PERM = true;
    bf16_t* O; int ldc;
    __device__ __forceinline__ void operator()(const f32x4 (&acc)[2][2][4][2], const Unit& u, int wr, int wc, int fr, int fq) const {
        const int row0 = u.pm * BM + wr * 64 + fr; const int col0 = u.pn * HALF + wc * 32 + 8 * fq;
#pragma unroll
        for (int ai = 0; ai < 2; ++ai)
#pragma unroll
            for (int m = 0; m < 4; ++m) { bf16_t* rowp = O + (size_t)(row0 + ai * HALF + m * 16) * ldc + col0;
                float h[8];
#pragma unroll
                for (int n = 0; n < 2; ++n)
#pragma unroll
                    for (int j = 0; j < 4; ++j) { const float g = acc[ai][0][m][n][j], up = acc[ai][1][m][n][j]; h[n * 4 + j] = g * __builtin_amdgcn_rcpf(1.0f + __expf(-g)) * up; }
                u32x4 w; w.x = cvt_pk_bf16(h[0], h[1]); w.y = cvt_pk_bf16(h[2], h[3]); w.z = cvt_pk_bf16(h[4], h[5]); w.w = cvt_pk_bf16(h[6], h[7]);
                *(u32x4*)rowp = w; }
    }
};
struct EpiSwiGLU8 {
    static constexpr bool PERM = true;
    unsigned char* O; int ldc;
    __device__ __forceinline__ void operator()(const f32x4 (&acc)[2][2][4][2], const Unit& u, int wr, int wc, int fr, int fq) const {
        const int row0 = u.pm * BM + wr * 64 + fr; const int col0 = u.pn * HALF + wc * 32 + 8 * fq;
#pragma unroll
        for (int ai = 0; ai < 2; ++ai)
#pragma unroll
            for (int m = 0; m < 4; ++m) { unsigned char* rowp = O + (size_t)(row0 + ai * HALF + m * 16) * ldc + col0;
                float h[8];
#pragma unroll
                for (int n = 0; n < 2; ++n)
#pragma unroll
                    for (int j = 0; j < 4; ++j) { const float g = acc[ai][0][m][n][j], up = acc[ai][1][m][n][j]; h[n * 4 + j] = g * __builtin_amdgcn_rcpf(1.0f + __expf(-g)) * up * (float)(1 << S8_HID); }
                u32x2 w; w.x = pk8(h[0], h[1], h[2], h[3]); w.y = pk8(h[4], h[5], h[6], h[7]);
                *(u32x2*)rowp = w; }
    }
};
struct EpiResid {
    static constexpr bool PERM = false;
    const void* base_lat; const void* base_ctx; bf16_t* out; const float* mod; int gate_off; bool base_f32;
    __device__ __forceinline__ void operator()(const f32x4 (&acc)[2][2][4][2], const Unit& u, int wr, int wc, int fr, int fq) const {
        const int rt = u.pm * BM; const bool isctx = rt >= NLAT; const int bi = isctx ? 16 : (rt >> 11);
        const size_t brow = isctx ? (size_t)(rt - NLAT) : (size_t)rt;
        const float* bf = (const float*)(isctx ? base_ctx : base_lat) + brow * D; const bf16_t* bh = (const bf16_t*)(isctx ? base_ctx : base_lat) + brow * D;
        bf16_t* o = out + (size_t)rt * D; const float* gt = mod + bi * MODW + gate_off;
        const int r0 = wr * 64 + fr, col0 = u.pn * BM + wc * 32 + 4 * fq;
        f32x4 gv[2][2];
#pragma unroll
        for (int bj = 0; bj < 2; ++bj)
#pragma unroll
            for (int n = 0; n < 2; ++n) gv[bj][n] = *(const f32x4*)(gt + col0 + bj * HALF + n * 16) + 1.0f;
#pragma unroll
        for (int ai = 0; ai < 2; ++ai)
#pragma unroll
            for (int m = 0; m < 4; ++m) { const size_t off = (size_t)(r0 + ai * HALF + m * 16) * D + col0;
#pragma unroll
                for (int bj = 0; bj < 2; ++bj)
#pragma unroll
                    for (int n = 0; n < 2; ++n) { f32x4 bs;
                        if (base_f32) bs = *(const f32x4*)(bf + off + bj * HALF + n * 16);
                        else { const u32x2 w = *(const u32x2*)(bh + off + bj * HALF + n * 16); bs = (f32x4){bflo(w.x), bfhi(w.x), bflo(w.y), bfhi(w.y)}; }
                        const f32x4 r = bs * ALPHA + gv[bj][n] * acc[ai][bj][m][n];
                        u32x2 ow; ow.x = pk2(r[0], r[1]); ow.y = pk2(r[2], r[3]);
                        *(u32x2*)(o + off + bj * HALF + n * 16) = ow; }
                if (m & 1) asm volatile("" ::: "memory"); }
    }
};

template <class Epi, class Sched, bool ALIGN_EPI, bool SP2, bool FP8 = false>
__device__ __forceinline__ void gemm_phase(LAS unsigned char* lds, const Gemm g, const Sched& S, const Epi& E, int tid_in, int sw = 0x7f7f7f7f, int sa = 0x7f7f7f7f) {
    int tid_ = tid_in; asm volatile("" : "+v"(tid_));
    const int tid = tid_, wid = __builtin_amdgcn_readfirstlane(tid >> 6), lane = tid & 63, wr = wid >> 2, wc = wid & 3, fr = lane & 15, fq = lane >> 4;
    const int K = g.K, nt = K / BK;
    constexpr bool GA = Sched::GATHER;
    unsigned voffA[2], voffB[2];
#pragma unroll
    for (int i = 0; i < 2; ++i) { int R, C; stage_rc(tid * 16 + i * 8192, R, C); const int Rb = Epi::PERM ? ((R & ~31) + perm32(R & 31)) : R;
        voffA[i] = (unsigned)(R * K + C) * 2u; voffB[i] = (unsigned)(Rb * K + C) * 2u; }
    const size_t kstep = (size_t)(BK * 2);
    const size_t hstep = (size_t)HALF * K * 2;
    const unsigned ldsw = (unsigned)wid * 1024u;
    const int aoff = lds_byte(wr * 64 + fr, fq * 8), boff = lds_byte(wc * 32 + fr, fq * 8);
#define PG8_SA(b, h) (((b) * 2 + (h)) * HTB)
#define PG8_SB(b, h) ((4 + (b) * 2 + (h)) * HTB)
#define PG8_STAGE(bufoff, gbase, voff) do { _Pragma("unroll") for (int _i = 0; _i < 2; ++_i) \
        __builtin_amdgcn_global_load_lds((const unsigned*)((const char*)(gbase) + (voff)[_i]), (LAS unsigned*)(lds + (bufoff) + ldsw + _i * 8192), 16, 0, 0); } while (0)
#define PG8_LDA(dst, b, h) do { _Pragma("unroll") for (int m = 0; m < 4; ++m) _Pragma("unroll") for (int k = 0; k < 2; ++k) dst[m][k] = *(const LAS bf16x8*)(lds + PG8_SA(b, h) + aoff + m * 2048 + k * 1024); } while (0)
#define PG8_LDB(dst, b, h) do { _Pragma("unroll") for (int n = 0; n < 2; ++n) _Pragma("unroll") for (int k = 0; k < 2; ++k) dst[n][k] = *(const LAS bf16x8*)(lds + PG8_SB(b, h) + boff + n * 2048 + k * 1024); } while (0)
#define PG8_CAT(x) __builtin_shufflevector(__builtin_bit_cast(i32x4, (x)[0]), __builtin_bit_cast(i32x4, (x)[1]), 0, 1, 2, 3, 4, 5, 6, 7)
#define PG8_MMA(ai, bj, At, Bt) do { __builtin_amdgcn_s_setprio(1); _Pragma("unroll") for (int m = 0; m < 4; ++m) _Pragma("unroll") for (int n = 0; n < 2; ++n) { \
        if constexpr (FP8) { const i32x8 a8_ = PG8_CAT(Bt[n]), b8_ = PG8_CAT(At[m]); \
            asm volatile("v_mfma_scale_f32_16x16x128_f8f6f4 %0, %1, %2, %0, %3, %4 op_sel_hi:[0,0,0]" : "+v"(acc[ai][bj][m][n]) : "v"(a8_), "v"(b8_), "v"(sw), "v"(sa)); } \
        else { _Pragma("unroll") for (int k = 0; k < 2; ++k) acc[ai][bj][m][n] = __builtin_amdgcn_mfma_f32_16x16x32_bf16(Bt[n][k], At[m][k], acc[ai][bj][m][n], 0, 0, 0); } } \
        __builtin_amdgcn_s_setprio(0); } while (0)
#define PG8_WAIT_V(n) asm volatile("s_waitcnt vmcnt(" #n ")" ::: "memory")
#define PG8_WAIT_L(n) asm volatile("s_waitcnt lgkmcnt(" #n ")" ::: "memory")
#define PG8_BAR __builtin_amdgcn_s_barrier()
#define PG8_SCHED __builtin_amdgcn_sched_barrier(0)
    Unit cur, nxt; int ui = 0;
    if (!S.next(0, cur)) return;
    f32x4 acc[2][2][4][2];
#pragma unroll
    for (int a = 0; a < 2; ++a)
#pragma unroll
        for (int b = 0; b < 2; ++b)
#pragma unroll
            for (int m = 0; m < 4; ++m)
#pragma unroll
                for (int n = 0; n < 2; ++n) acc[a][b][m][n] = (f32x4){0.f, 0.f, 0.f, 0.f};
    bf16x8 At[4][2], B0[2][2], B1[2][2];
    const char* Ab = (const char*)g.A + S.a_base(cur);
    unsigned oc[2][2];
    S.a_offs(0, cur, tid, oc);
    const size_t hsA = GA ? (size_t)0 : hstep;
#define PG8_STAGE_A(bufoff, gbase, h) do { if constexpr (GA) PG8_STAGE(bufoff, gbase, oc[h]); else PG8_STAGE(bufoff, (gbase) + (h) * hsA, voffA); } while (0)
    const char* cB = (const char*)g.Bt + cur.bofs;
    if constexpr (SP2) {
        PG8_STAGE(PG8_SB(0, 0), cB, voffB); PG8_STAGE(PG8_SB(0, 1), cB + hstep, voffB); PG8_STAGE_A(PG8_SA(0, 0), Ab, 0); PG8_STAGE_A(PG8_SA(0, 1), Ab, 1);
        if (wr == 1) PG8_BAR;
        PG8_WAIT_V(2); PG8_BAR;
        PG8_STAGE(PG8_SB(1, 0), cB + kstep, voffB); PG8_STAGE_A(PG8_SA(1, 0), Ab + kstep, 0); PG8_STAGE(PG8_SB(1, 1), cB + hstep + kstep, voffB);
        PG8_WAIT_V(6); PG8_BAR;
    } else {
        PG8_STAGE(PG8_SB(0, 0), cB, voffB); PG8_STAGE_A(PG8_SA(0, 0), Ab, 0); PG8_STAGE(PG8_SB(0, 1), cB + hstep, voffB); PG8_STAGE_A(PG8_SA(0, 1), Ab, 1);
        if (wr == 1) PG8_BAR;
        PG8_WAIT_V(4); PG8_BAR;
        PG8_STAGE(PG8_SB(1, 0), cB + kstep, voffB); PG8_STAGE_A(PG8_SA(1, 0), Ab + kstep, 0); PG8_STAGE(PG8_SB(1, 1), cB + hstep + kstep, voffB);
        PG8_WAIT_V(6); PG8_BAR;
    }
    for (;;) {
        const bool has_next = S.next(ui + 1, nxt);
        const char* nB = has_next ? (const char*)g.Bt + nxt.bofs : cB;
        for (int t = 0; t < nt; t += 2) {
            const bool last = (t == nt - 2);
            const char* a1 = Ab + (size_t)(t + 1) * kstep;
            const char* b2 = last ? nB : cB + (size_t)(t + 2) * kstep; const char* b3 = b2 + kstep;
            if constexpr (SP2) {
            PG8_LDB(B0, 0, 0); PG8_LDB(B1, 0, 1); PG8_SCHED; PG8_LDA(At, 0, 0); PG8_STAGE_A(PG8_SA(1, 1), a1, 1);
            if (last && has_next) { S.a_offs(ui + 1, nxt, tid, oc); Ab = (const char*)g.A + S.a_base(nxt); }
            const char* a2 = last ? Ab : Ab + (size_t)(t + 2) * kstep; const char* a3 = a2 + kstep;
            PG8_WAIT_V(8); PG8_WAIT_L(0); PG8_BAR; PG8_MMA(0, 0, At, B0); PG8_MMA(0, 1, At, B1); PG8_BAR; PG8_SCHED;
            PG8_LDA(At, 0, 1); PG8_STAGE(PG8_SB(0, 0), b2, voffB); PG8_STAGE(PG8_SB(0, 1), b2 + hstep, voffB); PG8_STAGE_A(PG8_SA(0, 0), a2, 0);
            PG8_WAIT_V(8); PG8_WAIT_L(0); PG8_BAR; PG8_MMA(1, 0, At, B0); PG8_MMA(1, 1, At, B1); PG8_BAR; PG8_SCHED;
            PG8_LDB(B0, 1, 0); PG8_LDB(B1, 1, 1); PG8_SCHED; PG8_LDA(At, 1, 0); PG8_STAGE_A(PG8_SA(0, 1), a2, 1);
            PG8_WAIT_V(8); PG8_WAIT_L(0); PG8_BAR; PG8_MMA(0, 0, At, B0); PG8_MMA(0, 1, At, B1); PG8_BAR; PG8_SCHED;
            PG8_LDA(At, 1, 1); PG8_STAGE(PG8_SB(1, 0), b3, voffB); PG8_STAGE(PG8_SB(1, 1), b3 + hstep, voffB); PG8_STAGE_A(PG8_SA(1, 0), a3, 0);
            PG8_WAIT_V(8); PG8_WAIT_L(0); PG8_BAR; PG8_MMA(1, 0, At, B0); PG8_MMA(1, 1, At, B1); PG8_BAR; PG8_SCHED;
            } else {
            PG8_LDB(B0, 0, 0); PG8_SCHED; PG8_LDA(At, 0, 0); PG8_STAGE_A(PG8_SA(1, 1), a1, 1);
            if (last && has_next) { S.a_offs(ui + 1, nxt, tid, oc); Ab = (const char*)g.A + S.a_base(nxt); }
            const char* a2 = last ? Ab : Ab + (size_t)(t + 2) * kstep; const char* a3 = a2 + kstep;
            PG8_WAIT_L(8); PG8_BAR; PG8_WAIT_L(0); PG8_MMA(0, 0, At, B0); PG8_BAR; PG8_SCHED;
            PG8_LDB(B1, 0, 1); PG8_STAGE(PG8_SB(0, 0), b2, voffB);
            PG8_BAR; PG8_WAIT_L(0); PG8_MMA(0, 1, At, B1); PG8_BAR;
            PG8_LDA(At, 0, 1); PG8_STAGE_A(PG8_SA(0, 0), a2, 0);
            PG8_BAR; PG8_WAIT_L(0); PG8_MMA(1, 0, At, B0); PG8_BAR; PG8_SCHED;
            PG8_STAGE(PG8_SB(0, 1), b2 + hstep, voffB);
            PG8_WAIT_V(6); PG8_BAR; PG8_MMA(1, 1, At, B1); PG8_BAR;
            PG8_LDB(B0, 1, 0); PG8_SCHED; PG8_LDA(At, 1, 0); PG8_STAGE_A(PG8_SA(0, 1), a2, 1);
            PG8_WAIT_L(8); PG8_BAR; PG8_WAIT_L(0); PG8_MMA(0, 0, At, B0); PG8_BAR; PG8_SCHED;
            PG8_LDB(B1, 1, 1); PG8_STAGE(PG8_SB(1, 0), b3, voffB);
            PG8_BAR; PG8_WAIT_L(0); PG8_MMA(0, 1, At, B1); PG8_BAR;
            PG8_LDA(At, 1, 1); PG8_STAGE_A(PG8_SA(1, 0), a3, 0);
            PG8_BAR; PG8_WAIT_L(0); PG8_MMA(1, 0, At, B0); PG8_BAR; PG8_SCHED;
            PG8_STAGE(PG8_SB(1, 1), b3 + hstep, voffB);
            PG8_WAIT_V(6); PG8_BAR; PG8_MMA(1, 1, At, B1); PG8_BAR;
            }
        }
        if constexpr (ALIGN_EPI) { if (wr == 0) PG8_BAR; }
        if constexpr (FP8) asm volatile("s_nop 15\n\ts_nop 15\n\ts_nop 15" ::: "memory");
        E(acc, cur, wr, wc, fr, fq);
        if (!has_next) break;
#pragma unroll
        for (int a = 0; a < 2; ++a)
#pragma unroll
            for (int b = 0; b < 2; ++b)
#pragma unroll
                for (int m = 0; m < 4; ++m)
#pragma unroll
                    for (int n = 0; n < 2; ++n) acc[a][b][m][n] = (f32x4){0.f, 0.f, 0.f, 0.f};
        cur = nxt; cB = nB; ++ui;
        if constexpr (ALIGN_EPI) { if (wr == 1) PG8_BAR; }
    }
    PG8_WAIT_V(0);
    if constexpr (!ALIGN_EPI) { if (wr == 0) PG8_BAR; }
    PG8_BAR;
#undef PG8_SA
#undef PG8_SB
#undef PG8_STAGE
#undef PG8_STAGE_A
#undef PG8_LDA
#undef PG8_LDB
#undef PG8_MMA
#undef PG8_CAT
#undef PG8_WAIT_V
#undef PG8_WAIT_L
#undef PG8_BAR
#undef PG8_SCHED
}
}

#define XB_TMO      128
#define XB_XCNT(j)  (256  + 64 * (j))
#define XB_XSUB(j)  (1280 + 64 * (j))
#define XB_XGEN(j)  (2304 + 64 * (j))
#define XB_TOP      3328
#define XB_TOPGEN   3392
#define XCD_BAR_WORDS 3456
#define XB_SPIN_CAP (1u << 18)
__device__ __forceinline__ unsigned xb_ld(unsigned* p)              { return __hip_atomic_load(p, __ATOMIC_RELAXED, __HIP_MEMORY_SCOPE_AGENT); }
__device__ __forceinline__ unsigned xb_add(unsigned* p, unsigned v) { return __hip_atomic_fetch_add(p, v, __ATOMIC_RELAXED, __HIP_MEMORY_SCOPE_AGENT); }
__device__ __forceinline__ unsigned xb_xcc_id() { return (unsigned)__builtin_amdgcn_s_getreg((3 << 11) | 20) & 0xFu; }
#define XB_SPIN(cond, bar) do { unsigned _sp = 0; while (cond) { __builtin_amdgcn_s_sleep(1); \
    if ((++_sp & 255u) == 0u) { if (xb_ld(&(bar)[XB_TMO])) break; if (_sp > XB_SPIN_CAP) { atomicAdd(&(bar)[XB_TMO], 1u); break; } } } } while (0)
struct XcdBarrier { unsigned* bar; unsigned x; volatile LAS unsigned* st; };
__device__ __forceinline__ XcdBarrier xcd_barrier_post(unsigned* bar, volatile LAS unsigned* st) {
    XcdBarrier b; b.bar = bar; b.x = xb_xcc_id(); b.st = st;
    if (threadIdx.x == 0) (void)xb_add(&bar[XB_XCNT(b.x)], 1u);
    return b;
}
__device__ __forceinline__ void xcd_barrier_complete(unsigned* bar, unsigned x, unsigned& nloc, unsigned& nx) {
    const unsigned G = gridDim.x * gridDim.y * gridDim.z;
    unsigned sum, cnt, mine, sp = 0u;
    for (;;) {
        sum = 0u; cnt = 0u; mine = 0u;
#pragma unroll
        for (unsigned j = 0; j < 16; ++j) { const unsigned c = xb_ld(&bar[XB_XCNT(j)]); sum += c; cnt += (c > 0u) ? 1u : 0u; }
        mine = xb_ld(&bar[XB_XCNT(x)]);
        if (sum == G) break;
        __builtin_amdgcn_s_sleep(1);
        if ((++sp & 255u) == 0u) { if (xb_ld(&bar[XB_TMO])) break; if (sp > XB_SPIN_CAP) { atomicAdd(&bar[XB_TMO], 1u); break; } }
    }
    nloc = mine > 0u ? mine : 1u; nx = cnt > 0u ? cnt : 1u;
}
__device__ __forceinline__ void xcd_barrier(const XcdBarrier& b, bool leader) {
    asm volatile("s_waitcnt vmcnt(0)" ::: "memory");
    __syncthreads();
    if (leader) {
        unsigned* bar = b.bar;
        __builtin_amdgcn_s_waitcnt(0);
        unsigned nloc = b.st[0], nx = b.st[1];
        if (nloc == 0u) { xcd_barrier_complete(bar, b.x, nloc, nx); b.st[0] = nloc; b.st[1] = nx; }
        const unsigned old = xb_add(&bar[XB_XSUB(b.x)], 1u);
        const unsigned gen = old / nloc;
        if (old + 1u == (gen + 1u) * nloc) {
            __builtin_amdgcn_fence(__ATOMIC_RELEASE, "agent");
            asm volatile("s_waitcnt vmcnt(0)" ::: "memory");
            const unsigned og = xb_add(&bar[XB_TOP], 1u);
            const unsigned tg = og / nx;
            if (og + 1u == (tg + 1u) * nx) xb_add(&bar[XB_TOPGEN], 1u);
            else XB_SPIN(xb_ld(&bar[XB_TOPGEN]) == tg, bar);
            __builtin_amdgcn_fence(__ATOMIC_ACQUIRE, "agent");
            xb_add(&bar[XB_XGEN(b.x)], 1u);
            asm volatile("s_waitcnt vmcnt(0)" ::: "memory");
        } else {
            XB_SPIN(xb_ld(&bar[XB_XGEN(b.x)]) == gen, bar);
            __builtin_amdgcn_fence(__ATOMIC_ACQUIRE, "agent");
            asm volatile("s_waitcnt vmcnt(0)" ::: "memory");
        }
    }
    __syncthreads();
}

constexpr int NT = 512, NWAVES = 8;
struct Args { const float* in[24]; float* out; unsigned char* ws; int ph_lo, ph_hi; };
enum { I_X = 0, I_C, I_CTX, I_CCTX, I_WMOD, I_BMOD, I_WIN, I_WOUT, I_RPB, I_CONVW, I_CONVB, I_DTB, I_ALOG, I_DSKIP, I_NORMW, I_LNG, I_LNB, I_FG, I_FU, I_FD, I_RW, I_MG, I_MU, I_MD };
struct Frame {
    LAS unsigned char* lds;
    const float* const* in; float* out; unsigned char* ws;
    int tid, lane, wave, bid, G, gw, NGW;
};
#define LDS_WAIT() asm volatile("s_waitcnt lgkmcnt(0)" ::: "memory")
__device__ __forceinline__ Frame fresh(const Frame& F0) {
    Frame F = F0; int z; asm volatile("s_mov_b32 %0, 0" : "=s"(z)); F.ws = F0.ws + z; F.in = F0.in + z; F.out = F0.out + z;
    int ln; asm volatile("v_mbcnt_lo_u32_b32 %0, -1, 0\n\tv_mbcnt_hi_u32_b32 %0, -1, %0" : "=v"(ln));     int t = F0.wave * 64 + ln;
    F.tid = t; F.lane = t & 63; return F;
}

__device__ __forceinline__ void conv_item(const float* W, int ldn, int k0, int n0, bf16_t* dst, int K, int drow0, LAS float* scr, int lane) {
    f32x4 ld[8];
#pragma unroll
    for (int i = 0; i < 8; ++i) ld[i] = *(const f32x4*)(W + (size_t)(k0 + 8 * i + (lane >> 3)) * ldn + n0 + 4 * (lane & 7));
#pragma unroll
    for (int i = 0; i < 8; ++i) { LAS float* d = scr + (8 * i + (lane >> 3)) * 33 + 4 * (lane & 7); d[0] = ld[i][0]; d[1] = ld[i][1]; d[2] = ld[i][2]; d[3] = ld[i][3]; }
    LDS_WAIT(); asm volatile("" ::: "memory");
    const int c = lane & 7;
#pragma unroll
    for (int j = 0; j < 4; ++j) { const int n = (lane >> 3) + 8 * j; const LAS float* s = scr + (8 * c) * 33 + n;
        u32x4 o; o.x = pk2(s[0 * 33], s[1 * 33]); o.y = pk2(s[2 * 33], s[3 * 33]); o.z = pk2(s[4 * 33], s[5 * 33]); o.w = pk2(s[6 * 33], s[7 * 33]);
        *(u32x4*)(dst + (size_t)(drow0 + n) * K + k0 + 8 * c) = o; }
    LDS_WAIT(); asm volatile("" ::: "memory");
}
__device__ __forceinline__ void conv_item8(const float* W, int ldn, int k0, int n0, unsigned char* dst, int K, int drow0, float scale, LAS float* scr, int lane) {
    f32x4 ld[8];
#pragma unroll
    for (int i = 0; i < 8; ++i) ld[i] = *(const f32x4*)(W + (size_t)(k0 + 8 * i + (lane >> 3)) * ldn + n0 + 4 * (lane & 7));
#pragma unroll
    for (int i = 0; i < 8; ++i) { LAS float* d = scr + (8 * i + (lane >> 3)) * 33 + 4 * (lane & 7); d[0] = ld[i][0] * scale; d[1] = ld[i][1] * scale; d[2] = ld[i][2] * scale; d[3] = ld[i][3] * scale; }
    LDS_WAIT(); asm volatile("" ::: "memory");
    const int c = lane & 7;
#pragma unroll
    for (int j = 0; j < 4; ++j) { const int n = (lane >> 3) + 8 * j; const LAS float* sp = scr + (8 * c) * 33 + n;
        u32x2 o; o.x = pk8(sp[0 * 33], sp[1 * 33], sp[2 * 33], sp[3 * 33]); o.y = pk8(sp[4 * 33], sp[5 * 33], sp[6 * 33], sp[7 * 33]);
        *(u32x2*)(dst + (size_t)(drow0 + n) * K + k0 + 8 * c) = o; }
    LDS_WAIT(); asm volatile("" ::: "memory");
}
__device__ __forceinline__ void conv_seg(const Frame& F, const float* W, int K, int ldn, int ncols, bf16_t* dst, int mode, int& rot, int s8 = -1) {
    LAS float* scr = (LAS float*)(F.lds + F.wave * 16384);
    const int nblk = ncols / 32, nitems = (K / 64) * nblk;
    int start = F.gw - rot; if (start < 0) start += F.NGW;
    for (int it = start; it < nitems; it += F.NGW) {
        const int kb = it / nblk, nb = it % nblk, n0 = nb * 32;
        const int drow0 = (mode == 0) ? n0 : ((n0 >> 7) * 256 + (n0 & 127) + (mode == 2 ? 128 : 0));
        if (s8 >= 0) conv_item8(W, ldn, kb * 64, n0, (unsigned char*)dst, K, drow0, (float)(1 << s8), scr, F.lane);
        else conv_item(W, ldn, kb * 64, n0, dst, K, drow0, scr, F.lane);
    }
    rot = (rot + nitems) % F.NGW;
}
__device__ __forceinline__ void conv_moe(const Frame& F, int slot, int& rot) {
#if USE_FP8
    unsigned char* gu = F.ws + WS_WMGU + (size_t)slot * NEXP * 2 * DFFE * D; unsigned char* dn = F.ws + WS_WMD + (size_t)slot * NEXP * D * DFFE;
    for (int e = 0; e < NEXP; ++e) {
        const size_t so = ((size_t)slot * NEXP + e) * (size_t)D * DFFE;
        conv_seg(F, F.in[I_MG] + so, D, DFFE, DFFE, (bf16_t*)(gu + (size_t)e * 2 * DFFE * D), 1, rot, S8_WGU);
        conv_seg(F, F.in[I_MU] + so, D, DFFE, DFFE, (bf16_t*)(gu + (size_t)e * 2 * DFFE * D), 2, rot, S8_WGU);
        conv_seg(F, F.in[I_MD] + so, DFFE, D, D, (bf16_t*)(dn + (size_t)e * D * DFFE), 0, rot, S8_WD);
    }
#else
    bf16_t* gu = (bf16_t*)(F.ws + WS_WMGU); bf16_t* dn = (bf16_t*)(F.ws + WS_WMD);
    for (int e = 0; e < NEXP; ++e) {
        const size_t so = ((size_t)slot * NEXP + e) * (size_t)D * DFFE;
        conv_seg(F, F.in[I_MG] + so, D, DFFE, DFFE, gu + (size_t)e * 2 * DFFE * D, 1, rot);
        conv_seg(F, F.in[I_MU] + so, D, DFFE, DFFE, gu + (size_t)e * 2 * DFFE * D, 2, rot);
        conv_seg(F, F.in[I_MD] + so, DFFE, D, D, dn + (size_t)e * D * DFFE, 0, rot);
    }
#endif
}

__device__ __forceinline__ void p_pro_a(const Frame& F) {
    {
        LAS float* sc = (LAS float*)F.lds; LAS float* red = sc + 17 * 1024;
        const float* c = F.in[I_C]; const float* cc = F.in[I_CCTX];
        for (int i = F.tid; i < 17 * 1024; i += NT) { const int r = i >> 10, k = i & 1023; const float v = (r < 16) ? c[r * 1024 + k] : cc[k]; sc[i] = silu_f(v); }
        __syncthreads();
        float* MOD = (float*)(F.ws + WS_MOD);
        const int col = F.tid & 31, ks = F.tid >> 5;
        for (int u = F.bid; u < 4 * 192; u += F.G) {
            const int l = u / 192, cb = u % 192;
            const float* W = F.in[I_WMOD] + (size_t)l * D * MODW + cb * 32 + col;
            float acc[17];
#pragma unroll
            for (int r = 0; r < 17; ++r) acc[r] = 0.f;
#pragma unroll 1
            for (int kb = 0; kb < 4; ++kb) { float w[16];
#pragma unroll
                for (int i = 0; i < 16; ++i) w[i] = W[(size_t)(ks * 64 + kb * 16 + i) * MODW];
#pragma unroll
                for (int i = 0; i < 16; ++i) { const int k = ks * 64 + kb * 16 + i;
#pragma unroll
                    for (int r = 0; r < 17; ++r) acc[r] += sc[r * 1024 + k] * w[i]; } }
#pragma unroll
            for (int r = 0; r < 17; ++r) red[(ks * 17 + r) * 32 + col] = acc[r];
            __syncthreads();
            for (int i = F.tid; i < 17 * 32; i += NT) { const int r = i >> 5, c2 = i & 31; float sm = 0.f;
#pragma unroll
                for (int k2 = 0; k2 < 16; ++k2) sm += red[(k2 * 17 + r) * 32 + c2];
                MOD[(size_t)(l * 17 + r) * MODW + cb * 32 + c2] = sm + F.in[I_BMOD][l * MODW + cb * 32 + c2]; }
            __syncthreads();
        }
    }
    int rot = 0;
    for (int l = 0; l < DEPTH; ++l) {
#if USE_FP8 && FP8_INPROJ
        conv_seg(F, F.in[I_WIN] + (size_t)l * D * D_IN_PROJ, D, D_IN_PROJ, NPROJ, (bf16_t*)(F.ws + WS_WIN + (size_t)l * NPROJ * D), 0, rot, S8_WGU);
#else
        conv_seg(F, F.in[I_WIN] + (size_t)l * D * D_IN_PROJ, D, D_IN_PROJ, NPROJ, (bf16_t*)(F.ws + WS_WIN) + (size_t)l * NPROJ * D, 0, rot);
#endif
        conv_seg(F, F.in[I_WOUT] + (size_t)l * D * D, D, D, D, (bf16_t*)(F.ws + WS_WOUT) + (size_t)l * D * D, 0, rot);
    }
    for (int s = 0; s < 2; ++s) {
#if USE_FP8 && FP8_DENSE
        conv_seg(F, F.in[I_FG] + (size_t)s * D * DFF, D, DFF, DFF, (bf16_t*)(F.ws + WS_WFGU + (size_t)s * 2 * DFF * D), 1, rot, S8_WGU);
        conv_seg(F, F.in[I_FU] + (size_t)s * D * DFF, D, DFF, DFF, (bf16_t*)(F.ws + WS_WFGU + (size_t)s * 2 * DFF * D), 2, rot, S8_WGU);
        conv_seg(F, F.in[I_FD] + (size_t)s * DFF * D, DFF, D, D, (bf16_t*)(F.ws + WS_WFD + (size_t)s * D * DFF), 0, rot, S8_WD);
#else
        conv_seg(F, F.in[I_FG] + (size_t)s * D * DFF, D, DFF, DFF, (bf16_t*)(F.ws + WS_WFGU) + (size_t)s * 2 * DFF * D, 1, rot);
        conv_seg(F, F.in[I_FU] + (size_t)s * D * DFF, D, DFF, DFF, (bf16_t*)(F.ws + WS_WFGU) + (size_t)s * 2 * DFF * D, 2, rot);
        conv_seg(F, F.in[I_FD] + (size_t)s * DFF * D, DFF, D, D, (bf16_t*)(F.ws + WS_WFD) + (size_t)s * D * DFF, 0, rot);
#endif
    }
    conv_moe(F, 0, rot);
#if USE_FP8
    conv_moe(F, 1, rot);
#endif
    { bf16_t* wdt = (bf16_t*)(F.ws + WS_WDT);
      for (int i = F.bid * NT + F.tid; i < DEPTH * 16 * D; i += F.G * NT) { const int l = i / (16 * D), n = (i / D) & 15, k = i % D;
          wdt[i] = (bf16_t)f2bf(F.in[I_WIN][((size_t)l * D + k) * D_IN_PROJ + NPROJ + n]); } }
}

#define RIDX(q) (8 * lane + 512 * ((q) >> 1) + 4 * ((q) & 1))
__device__ __forceinline__ void row_load(const float* p, int lane, f32x4 (&v)[4]) {
#pragma unroll
    for (int q = 0; q < 4; ++q) v[q] = *(const f32x4*)(p + RIDX(q));
}
__device__ __forceinline__ void row_store(float* p, int lane, const f32x4 (&v)[4]) {
#pragma unroll
    for (int q = 0; q < 4; ++q) *(f32x4*)(p + RIDX(q)) = v[q];
}
__device__ __forceinline__ void row_mod_store8(unsigned char* hrow, int lane, const f32x4 (&v)[4], const float* sh, const float* sc, f32x4 (&hv)[4]) {
#pragma unroll
    for (int j = 0; j < 2; ++j) { u32x2 w;
#pragma unroll
        for (int h = 0; h < 2; ++h) { const int q = 2 * j + h; const f32x4 a = *(const f32x4*)(sc + RIDX(q)), b = *(const f32x4*)(sh + RIDX(q));
            hv[q] = v[q] * (a + 1.0f) + b; const f32x4 t = hv[q] * (float)(1 << S8_ACT); const unsigned pw = pk8(t[0], t[1], t[2], t[3]); if (h == 0) w.x = pw; else w.y = pw; }
        *(u32x2*)(hrow + 8 * lane + 512 * j) = w; }
}
__device__ __forceinline__ void row_load_h(const bf16_t* p, int lane, f32x4 (&v)[4]) {
#pragma unroll
    for (int j = 0; j < 2; ++j) { const u32x4 w = *(const u32x4*)(p + 8 * lane + 512 * j); v[2 * j] = (f32x4){bflo(w.x), bfhi(w.x), bflo(w.y), bfhi(w.y)}; v[2 * j + 1] = (f32x4){bflo(w.z), bfhi(w.z), bflo(w.w), bfhi(w.w)}; }
}
__device__ __forceinline__ void row_store_h(bf16_t* p, int lane, const f32x4 (&v)[4]) {
#pragma unroll
    for (int j = 0; j < 2; ++j) { u32x4 w; w.x = pk2(v[2 * j][0], v[2 * j][1]); w.y = pk2(v[2 * j][2], v[2 * j][3]); w.z = pk2(v[2 * j + 1][0], v[2 * j + 1][1]); w.w = pk2(v[2 * j + 1][2], v[2 * j + 1][3]);
        *(u32x4*)(p + 8 * lane + 512 * j) = w; }
}
__device__ __forceinline__ void row_mod_store(bf16_t* hrow, int lane, const f32x4 (&v)[4], const float* sh, const float* sc, f32x4 (&hv)[4]) {
#pragma unroll
    for (int q = 0; q < 4; ++q) { const f32x4 a = *(const f32x4*)(sc + RIDX(q)), b = *(const f32x4*)(sh + RIDX(q)); hv[q] = v[q] * (a + 1.0f) + b; }
    row_store_h(hrow, lane, hv);
}
__device__ __forceinline__ void row_ln(f32x4 (&v)[4], const float* g, const float* b, int lane) {
    float s = 0.f;
#pragma unroll
    for (int j = 0; j < 4; ++j) s += (v[j][0] + v[j][1]) + (v[j][2] + v[j][3]);
    const float mean = wave_sum(s) * (1.0f / D); float q2 = 0.f;
#pragma unroll
    for (int j = 0; j < 4; ++j) { v[j] = v[j] - mean; q2 += (v[j][0] * v[j][0] + v[j][1] * v[j][1]) + (v[j][2] * v[j][2] + v[j][3] * v[j][3]); }
    const float rstd = 1.0f / sqrtf(wave_sum(q2) * (1.0f / D) + LN_EPS);
#pragma unroll
    for (int q = 0; q < 4; ++q) { const f32x4 gg = *(const f32x4*)(g + RIDX(q)), bb = *(const f32x4*)(b + RIDX(q)); v[q] = v[q] * rstd * gg + bb; }
}
__device__ __forceinline__ int mod_row_of(int row) { return row < NLAT ? (row >> 11) : 16; }

__device__ __forceinline__ void p_pro_b(const Frame& F) {
    const float* MOD = (const float*)(F.ws + WS_MOD); bf16_t* H = (bf16_t*)(F.ws + WS_H);
    for (int row = F.gw; row < NTOK; row += F.NGW) {
        const float* src = row < NLAT ? F.in[I_X] + (size_t)row * D : F.in[I_CTX] + (size_t)(row - NLAT) * D;
        f32x4 v[4], hv[4]; row_load(src, F.lane, v);
        const float* m = MOD + (size_t)mod_row_of(row) * MODW;
        row_mod_store(H + (size_t)row * D, F.lane, v, m, m + D, hv);
    }
}

__device__ __forceinline__ void p_inproj(const Frame& F, int layer) {
    const bf16_t* H = (const bf16_t*)(F.ws + WS_H);
    {
        const bf16_t* wdt = (const bf16_t*)(F.ws + WS_WDT) + (size_t)layer * 16 * D; float* DT = (float*)(F.ws + WS_DT);
        const int fr = F.lane & 15, fq = F.lane >> 4; const float dtb = F.in[I_DTB][layer * 16 + fr];
        for (int g = F.gw; g < NTOK / 16; g += F.NGW) {
            f32x4 acc = {0.f, 0.f, 0.f, 0.f};
            const bf16_t* ap = H + (size_t)(g * 16 + fr) * D + fq * 8; const bf16_t* bp = wdt + (size_t)fr * D + fq * 8;
#pragma unroll 8
            for (int ks = 0; ks < 32; ++ks) { const bf16x8 a = *(const bf16x8*)(ap + ks * 32), b = *(const bf16x8*)(bp + ks * 32);
                acc = __builtin_amdgcn_mfma_f32_16x16x32_bf16(a, b, acc, 0, 0, 0); }
#pragma unroll
            for (int r = 0; r < 4; ++r) { const float x = acc[r] + dtb; DT[(size_t)(g * 16 + fq * 4 + r) * 16 + fr] = x > 20.f ? x : log1pf(__expf(x)); }
        }
    }
    pg8::EpiBf16 E{(bf16_t*)(F.ws + WS_PROJ), NPROJ};
#if USE_FP8 && FP8_INPROJ
    pg8::Gemm g{(const bf16_t*)(F.ws + WS_H8IN), (const bf16_t*)(F.ws + WS_WIN + (size_t)layer * NPROJ * D), D / 2};
    pg8::DenseOrder S; S.init(NTOK, NPROJ, D / 2, F.G, F.bid, REP_GEMM);
    pg8::gemm_phase<pg8::EpiBf16, pg8::DenseOrder, true, FP8_SP2, true>(F.lds, g, S, E, F.tid, (127 - S8_WGU) * 0x01010101, (127 - S8_ACT) * 0x01010101);
#else
    pg8::Gemm g{H, (const bf16_t*)(F.ws + WS_WIN) + (size_t)layer * NPROJ * D, D};
    pg8::DenseOrder S; S.init(NTOK, NPROJ, D, F.G, F.bid, REP_GEMM);
    pg8::gemm_phase<pg8::EpiBf16, pg8::DenseOrder, true, true>(F.lds, g, S, E, F.tid);
#endif
}

typedef short s16x4 __attribute__((ext_vector_type(4)));
__device__ __forceinline__ s16x4 lds_tr16(LAS const unsigned char* p) { return __builtin_bit_cast(s16x4, __builtin_amdgcn_ds_read_tr16_b64_v4i16((LAS s16x4*)p)); }
constexpr int NA_KS = 144;
constexpr float LOG2E = 1.4426950408889634f;
__device__ __forceinline__ void na_unit(const Frame& F, int layer, int b, int h, int mode, int m) {
    LAS unsigned char* KV = F.lds;
    LAS float* rp = (LAS float*)(F.lds + 120832);
    const bf16_t* PROJ = (const bf16_t*)(F.ws + WS_PROJ); bf16_t* MIX = (bf16_t*)(F.ws + WS_MIX);
    const int tid = F.tid, lane = F.lane, w = F.wave, q16 = lane & 15, g = lane >> 4;
    int rbase = 0, nk = 0;
    if (mode == 0) { rbase = 2 * m - 4; rbase = rbase < 0 ? 0 : (rbase > 24 ? 24 : rbase); nk = 32 - rbase; nk = nk > 9 ? 9 : nk; }
    const int kfirst = (mode == 0) ? 0 : 576 * 8, nloc8 = nk * 64 * 8;
#define NA_STAGE(OFFS) do { int stid_ = tid; asm volatile("" : "+v"(stid_));     \
        NA_STAGE_PART(OFFS, 0, 7); __builtin_amdgcn_sched_barrier(0); NA_STAGE_PART(OFFS, 7, 13); __builtin_amdgcn_sched_barrier(0); } while (0)
#define NA_STAGE_PART(OFFS, K0, K1) do { u32x4 st_[13]; \
        _Pragma("unroll") for (int k_ = K0; k_ < K1; ++k_) { const int i_ = stid_ + kfirst + k_ * NT, key_ = i_ >> 3, ch_ = i_ & 7; const bool ok_ = (i_ < 832 * 8) && !(key_ < 576 && i_ >= nloc8); \
            const int grow_ = key_ < 576 ? b * SEQ + rbase * 64 + key_ : NLAT + b * CTX + (key_ - 576); \
            st_[k_] = ok_ ? *(const u32x4*)(PROJ + (size_t)grow_ * NPROJ + (OFFS) + h * 64 + ch_ * 8) : (u32x4){0u, 0u, 0u, 0u}; } \
        _Pragma("unroll") for (int k_ = K0; k_ < K1; ++k_) { const int i_ = stid_ + kfirst + k_ * NT, key_ = i_ >> 3, ch_ = i_ & 7; const bool ok_ = (i_ < 832 * 8) && !(key_ < 576 && i_ >= nloc8); \
            if (ok_) *(LAS u32x4*)(KV + key_ * NA_KS + ch_ * 16) = st_[k_]; } } while (0)
    __syncthreads();
    NA_STAGE(OFF_K);
    if (mode == 0 && tid < 465) rp[tid] = F.in[I_RPB][(size_t)(layer * 8 + h) * 465 + tid] * LOG2E;
    __syncthreads();
    int i = 0, j0 = 0, hs = 0, kr0 = 0, qrow;
    if (mode == 0) { i = 2 * m + (w >> 2); j0 = (w & 3) * 16; qrow = b * SEQ + i * 64 + j0; hs = j0 - 8; hs = hs < 0 ? 0 : (hs > 32 ? 32 : hs);
        int r0 = i - 4; r0 = r0 < 0 ? 0 : (r0 > 24 ? 24 : r0); kr0 = r0 - rbase; }
    else qrow = NLAT + b * CTX + m * 128 + w * 16;
    bf16x8 qf[2];
#pragma unroll
    for (int ks = 0; ks < 2; ++ks) qf[ks] = *(const bf16x8*)(PROJ + (size_t)(qrow + q16) * NPROJ + h * 64 + ks * 32 + g * 8);
    f32x4 S[32];
    const LAS unsigned char* kb = KV + q16 * NA_KS + g * 16;
    if (mode == 0) {
        const int j = j0 + q16; int cs = j - 8; cs = cs < 0 ? 0 : (cs > 48 ? 48 : cs);
        const int rb0 = (kr0 + rbase) - i + 7;
#pragma unroll
        for (int tl = 0; tl < 16; ++tl) { const int kr = tl >> 1, half = tl & 1; const int kidx0 = (kr0 + kr) * 64 + hs + 16 * half;
            f32x4 a = {0.f, 0.f, 0.f, 0.f};
#pragma unroll
            for (int ks = 0; ks < 2; ++ks) { const bf16x8 kf = *(const LAS bf16x8*)(kb + kidx0 * NA_KS + ks * 64); a = __builtin_amdgcn_mfma_f32_16x16x32_bf16(kf, qf[ks], a, 0, 0, 0); }
#pragma unroll
            for (int r = 0; r < 4; ++r) { const int kc = hs + 16 * half + 4 * g + r; const bool inw = (kc >= cs) && (kc < cs + 16);
                int cbi = kc - j + 15; cbi = cbi < 0 ? 0 : (cbi > 30 ? 30 : cbi);
                a[r] = inw ? a[r] * (0.125f * LOG2E) + rp[(rb0 + kr) * 31 + cbi] : -INFINITY; }
            S[tl] = a; if ((tl & 1) == 1) __builtin_amdgcn_sched_barrier(0); }
    } else {
#pragma unroll
        for (int tl = 0; tl < 16; ++tl) S[tl] = (f32x4){-INFINITY, -INFINITY, -INFINITY, -INFINITY};
    }
#pragma unroll
    for (int tc = 0; tc < 16; ++tc) { const int kidx0 = 576 + 16 * tc; f32x4 a = {0.f, 0.f, 0.f, 0.f};
#pragma unroll
        for (int ks = 0; ks < 2; ++ks) { const bf16x8 kf = *(const LAS bf16x8*)(kb + kidx0 * NA_KS + ks * 64); a = __builtin_amdgcn_mfma_f32_16x16x32_bf16(kf, qf[ks], a, 0, 0, 0); }
        S[16 + tc] = a * (0.125f * LOG2E); if ((tc & 1) == 1) __builtin_amdgcn_sched_barrier(0); }
    float mx = -INFINITY;
#pragma unroll
    for (int t = 0; t < 32; ++t) mx = fmaxf(fmaxf(fmaxf(S[t][0], S[t][1]), fmaxf(S[t][2], S[t][3])), mx);
    mx = fmaxf(mx, __shfl_xor(mx, 16)); mx = fmaxf(mx, __shfl_xor(mx, 32));
    float sum = 0.f; u32x4 P[16];
#pragma unroll
    for (int kk = 0; kk < 16; ++kk) { float e[8];
#pragma unroll
        for (int r = 0; r < 4; ++r) { e[r] = __builtin_amdgcn_exp2f(S[2 * kk][r] - mx); e[4 + r] = __builtin_amdgcn_exp2f(S[2 * kk + 1][r] - mx); }
        sum += ((e[0] + e[1]) + (e[2] + e[3])) + ((e[4] + e[5]) + (e[6] + e[7]));
        P[kk].x = pg8::cvt_pk_bf16_pin(e[0], e[1]); P[kk].y = pg8::cvt_pk_bf16_pin(e[2], e[3]); P[kk].z = pg8::cvt_pk_bf16_pin(e[4], e[5]); P[kk].w = pg8::cvt_pk_bf16_pin(e[6], e[7]); }
    sum += __shfl_xor(sum, 16); sum += __shfl_xor(sum, 32);
    const float inv = 1.0f / sum;
    __syncthreads();
    NA_STAGE(OFF_V);
    __syncthreads();
    f32x4 o[4];
#pragma unroll
    for (int dt = 0; dt < 4; ++dt) o[dt] = (f32x4){0.f, 0.f, 0.f, 0.f};
    const LAS unsigned char* vb = KV + (4 * g + (q16 >> 2)) * NA_KS + (q16 & 3) * 8;
#pragma unroll
    for (int kk = 0; kk < 16; ++kk) {
        if (kk < 8 && mode != 0) continue;
        const int kidx0 = (kk < 8) ? (kr0 + kk) * 64 + hs : 576 + 32 * (kk - 8);
        const bf16x8 pa = __builtin_bit_cast(bf16x8, P[kk]);
#pragma unroll
        for (int dt = 0; dt < 4; ++dt) { const s16x4 lo = lds_tr16(vb + kidx0 * NA_KS + dt * 32), hi = lds_tr16(vb + (kidx0 + 16) * NA_KS + dt * 32);
            const bf16x8 vf = {lo[0], lo[1], lo[2], lo[3], hi[0], hi[1], hi[2], hi[3]};
            o[dt] = __builtin_amdgcn_mfma_f32_16x16x32_bf16(pa, vf, o[dt], 0, 0, 0); }
    }
#undef NA_STAGE
#undef NA_STAGE_PART
#pragma unroll
    for (int r = 0; r < 4; ++r) { const float ir = __shfl(inv, 4 * g + r);
        bf16_t* op = MIX + (size_t)(qrow + 4 * g + r) * D + h * 64 + q16;
#pragma unroll
        for (int dt = 0; dt < 4; dt += 2) { const unsigned pw = pk2(o[dt][r] * ir, o[dt + 1][r] * ir); op[dt * 16] = (bf16_t)(pw & 0xffffu); op[dt * 16 + 16] = (bf16_t)(pw >> 16); } }
}

struct PrepassW { f32x4 w[5][2]; f32x4 b[2]; float ifq[8]; };
__device__ __forceinline__ void ssd_prepass_unit(const Frame& F, int u, const PrepassW& W) {
    const bf16_t* PROJ = (const bf16_t*)(F.ws + WS_PROJ); bf16_t* U = (bf16_t*)(F.ws + WS_U);
    int rowbase, t0, L; bool lat;
    if (u < NLAT / 16) { rowbase = (u >> 7) * SEQ; t0 = (u & 127) * 16; L = SEQ; lat = true; }
    else { const int v = u - NLAT / 16; rowbase = NLAT + (v >> 4) * CTX; t0 = (v & 15) * 16; L = CTX; lat = false; }
    const int cg = F.tid & 127, tq = F.tid >> 7, c0 = 8 * cg, tb = t0 + 4 * tq;
    u32x4 win[8];
#pragma unroll
    for (int j = 0; j < 8; ++j) { const int t = tb - 2 + j; win[j] = (t >= 0 && t < L) ? *(const u32x4*)(PROJ + (size_t)(rowbase + t) * NPROJ + OFF_XBC + c0) : (u32x4){0u, 0u, 0u, 0u}; }
    const int lc = c0 & 127, hf = lc >> 6, role = (lc >> 5) & 1; const bool rope = lat && (c0 >= 512);
#pragma unroll
    for (int tt = 0; tt < 4; ++tt) {
        f32x4 a0 = W.b[0], a1 = W.b[1];
#pragma unroll
        for (int j = 0; j < 5; ++j) { const u32x4 r = win[tt + j];
            a0 += W.w[j][0] * (f32x4){bflo(r.x), bfhi(r.x), bflo(r.y), bfhi(r.y)}; a1 += W.w[j][1] * (f32x4){bflo(r.z), bfhi(r.z), bflo(r.w), bfhi(r.w)}; }
        float uu[8];
#pragma unroll
        for (int k = 0; k < 4; ++k) { uu[k] = silu_f(a0[k]); uu[4 + k] = silu_f(a1[k]); }
        if (rope) {
            const int tk = tb + tt; const float pos = (float)(hf ? (tk & 63) : (tk >> 6));
#pragma unroll
            for (int k = 0; k < 8; ++k) { const float o = __shfl_xor(uu[k], 4); const float sn = __builtin_amdgcn_sinf(pos * W.ifq[k]), cs = __builtin_amdgcn_cosf(pos * W.ifq[k]);
                uu[k] = role ? (o * sn + uu[k] * cs) : (uu[k] * cs - o * sn); }
        }
        u32x4 o; o.x = pk2(uu[0], uu[1]); o.y = pk2(uu[2], uu[3]); o.z = pk2(uu[4], uu[5]); o.w = pk2(uu[6], uu[7]);
        *(u32x4*)(U + (size_t)(rowbase + tb + tt) * 1024 + c0) = o;
    }
}
__device__ __forceinline__ void ssd_prepass_weights(const Frame& F, int layer, PrepassW& W) {
    const int c0 = 8 * (F.tid & 127);
    const float* cwp = F.in[I_CONVW] + (size_t)layer * 5 * 1024 + c0;
#pragma unroll
    for (int j = 0; j < 5; ++j) { W.w[j][0] = *(const f32x4*)(cwp + j * 1024); W.w[j][1] = *(const f32x4*)(cwp + j * 1024 + 4); }
    W.b[0] = *(const f32x4*)(F.in[I_CONVB] + (size_t)layer * 1024 + c0); W.b[1] = *(const f32x4*)(F.in[I_CONVB] + (size_t)layer * 1024 + c0 + 4);
    const int n0 = c0 & 31;
#pragma unroll
    for (int k = 0; k < 8; ++k) W.ifq[k] = __builtin_amdgcn_exp2f(-(float)(n0 + k) * (13.287712379549449f / 32.0f)) * 0.15915494309189535f;
}

constexpr int S_CQ = 0, S_BQ = 17408, S_BT = 34816, S_XT = 53248, S_MQ = 62464, S_HB = 71680, S_MISC = 106496;
__device__ __forceinline__ void ssd_mfma_unit(const Frame& F, int layer, int b, int h, int dir) {
    const int g = h >> 2, tid = F.tid, lane = F.lane, w = F.wave, q16 = lane & 15, gq = lane >> 4;
    const bf16_t* U = (const bf16_t*)(F.ws + WS_U); const float* DTS = (const float*)(F.ws + WS_DT);
    bf16_t* Y = (bf16_t*)(F.ws + (dir ? WS_YB : WS_YF));
    const float aneg = -__expf(F.in[I_ALOG][layer * 16 + dir * 8 + h]), dsk = F.in[I_DSKIP][layer * 8 + h];
    LAS unsigned char* L = F.lds;
    __syncthreads();
    for (int i = tid; i < 64 * 272 / 16; i += NT) *(LAS u32x4*)(L + S_HB + i * 16) = (u32x4){0u, 0u, 0u, 0u};
    f32x4 Hacc[4];
#pragma unroll
    for (int j = 0; j < 4; ++j) Hacc[j] = (f32x4){0.f, 0.f, 0.f, 0.f};
    u32x4 px, pb[2], pc[2];
    const int xl = lane, xc = w;
    float pdt = 0.f;
#define SSD_ROW(ci_, l_) ({ const int s_ = (ci_) < 4 ? 0 : 1, k_ = s_ ? (ci_) - 4 : (ci_), nc_ = s_ ? 32 : 4, c_ = dir ? nc_ - 1 - k_ : k_; \
        (s_ ? b * SEQ : NLAT + b * CTX) + c_ * 64 + (dir ? 63 - (l_) : (l_)); })
#define SSD_PREFETCH(ci_) do { px = *(const u32x4*)(U + (size_t)SSD_ROW(ci_, xl) * 1024 + h * 64 + xc * 8); \
        if (w == 0) pdt = DTS[(size_t)SSD_ROW(ci_, lane) * 16 + dir * 8 + h]; \
        _Pragma("unroll") for (int k_ = 0; k_ < 2; ++k_) { const int l_ = lane, c16_ = w + 8 * k_; const size_t ro_ = (size_t)SSD_ROW(ci_, l_) * 1024; \
            pb[k_] = *(const u32x4*)(U + ro_ + 512 + g * 128 + c16_ * 8); pc[k_] = *(const u32x4*)(U + ro_ + 768 + g * 128 + c16_ * 8); } } while (0)
    SSD_PREFETCH(0);
    int par = 0;
    for (int ci = 0; ci < 36; ++ci) {
        LAS float* misc = (LAS float*)(L + S_MISC) + par * 272;
        if (w == 0) {
            const float dt = pdt; float cs = dt * aneg;
#pragma unroll
            for (int o = 1; o < 64; o <<= 1) { const float v = __shfl_up(cs, o); cs += (lane >= o) ? v : 0.f; }
            const float tot = __shfl(cs, 63);
            misc[lane] = dt; misc[64 + lane] = cs; misc[128 + lane] = __expf(cs); misc[192 + lane] = __expf(tot - cs) * dt; if (lane == 0) misc[256] = __expf(tot);
        }
        __syncthreads();
        {
            const unsigned xw[4] = {px.x, px.y, px.z, px.w};
#pragma unroll
            for (int e = 0; e < 4; ++e) { *(LAS unsigned short*)(L + S_XT + (xc * 8 + 2 * e) * 144 + xl * 2) = (unsigned short)(xw[e] & 0xffffu); *(LAS unsigned short*)(L + S_XT + (xc * 8 + 2 * e + 1) * 144 + xl * 2) = (unsigned short)(xw[e] >> 16); }
#pragma unroll
            for (int k = 0; k < 2; ++k) { const int l = lane, c16 = w + 8 * k; const float wl = misc[192 + l];
                *(LAS u32x4*)(L + S_BQ + l * 272 + c16 * 16) = pb[k]; *(LAS u32x4*)(L + S_CQ + l * 272 + c16 * 16) = pc[k];
                const unsigned bw[4] = {pb[k].x, pb[k].y, pb[k].z, pb[k].w};
#pragma unroll
                for (int e = 0; e < 4; ++e) { const unsigned pw = pk2(bflo(bw[e]) * wl, bfhi(bw[e]) * wl);
                    *(LAS unsigned short*)(L + S_BT + (c16 * 8 + 2 * e) * 144 + l * 2) = (unsigned short)(pw & 0xffffu); *(LAS unsigned short*)(L + S_BT + (c16 * 8 + 2 * e + 1) * 144 + l * 2) = (unsigned short)(pw >> 16); } }
        }
        if (ci + 1 < 36) SSD_PREFETCH(ci + 1);
        __syncthreads();
        const int lt = w >> 1, t2 = (w & 1) * 2;
        bf16x8 cfr[4];
#pragma unroll
        for (int ks = 0; ks < 4; ++ks) cfr[ks] = *(const LAS bf16x8*)(L + S_CQ + (16 * lt + q16) * 272 + ks * 64 + gq * 16);
        {
            const f32x4 csl = *(const LAS f32x4*)(misc + 64 + 16 * lt + 4 * gq);
#pragma unroll
            for (int k = 0; k < 2; ++k) { const int st = t2 + k; f32x4 a = {0.f, 0.f, 0.f, 0.f};
                if (st <= lt) {
#pragma unroll
                    for (int ks = 0; ks < 4; ++ks) { const bf16x8 bfr = *(const LAS bf16x8*)(L + S_BQ + (16 * st + q16) * 272 + ks * 64 + gq * 16); a = __builtin_amdgcn_mfma_f32_16x16x32_bf16(cfr[ks], bfr, a, 0, 0, 0); }
                    const int sidx = 16 * st + q16; const float css = misc[64 + sidx], dts = misc[sidx];
#pragma unroll
                    for (int r = 0; r < 4; ++r) { const int l = 16 * lt + 4 * gq + r; a[r] = (sidx <= l) ? a[r] * __expf(csl[r] - css) * dts : 0.f; }
                }
#pragma unroll
                for (int r = 0; r < 4; r += 2) { const unsigned pw = pk2(a[r], a[r + 1]);
                    *(LAS unsigned short*)(L + S_MQ + (16 * lt + 4 * gq + r) * 144 + (16 * st + q16) * 2) = (unsigned short)(pw & 0xffffu); *(LAS unsigned short*)(L + S_MQ + (16 * lt + 4 * gq + r + 1) * 144 + (16 * st + q16) * 2) = (unsigned short)(pw >> 16); } }
        }
        __syncthreads();
        {
            const f32x4 ecs = *(const LAS f32x4*)(misc + 128 + 16 * lt + 4 * gq);
            const LAS unsigned char* HB = L + S_HB + par * 17408;
#pragma unroll
            for (int k = 0; k < 2; ++k) { const int pt = t2 + k; f32x4 a = {0.f, 0.f, 0.f, 0.f};
#pragma unroll
                for (int ks = 0; ks < 4; ++ks) { const bf16x8 hfr = *(const LAS bf16x8*)(HB + (16 * pt + q16) * 272 + ks * 64 + gq * 16); a = __builtin_amdgcn_mfma_f32_16x16x32_bf16(cfr[ks], hfr, a, 0, 0, 0); }
                a = a * ecs;
#pragma unroll
                for (int ks = 0; ks < 2; ++ks) if (ks <= (lt >> 1)) { const bf16x8 mfr = *(const LAS bf16x8*)(L + S_MQ + (16 * lt + q16) * 144 + ks * 64 + gq * 16), xfr = *(const LAS bf16x8*)(L + S_XT + (16 * pt + q16) * 144 + ks * 64 + gq * 16);
                    a = __builtin_amdgcn_mfma_f32_16x16x32_bf16(mfr, xfr, a, 0, 0, 0); }
                if (dir == 0) { const u32x2 xv = *(const LAS u32x2*)(L + S_XT + (16 * pt + q16) * 144 + (16 * lt + 4 * gq) * 2);
                    a[0] += dsk * bflo(xv.x); a[1] += dsk * bfhi(xv.x); a[2] += dsk * bflo(xv.y); a[3] += dsk * bfhi(xv.y); }
                { const int row0 = SSD_ROW(ci, 16 * lt + 4 * gq); bf16_t* yp = Y + (size_t)row0 * 512 + h * 64 + 16 * pt + q16; const int rs = dir ? -512 : 512;
                  const unsigned w01 = pk2(a[0], a[1]), w23 = pk2(a[2], a[3]);
                  yp[0] = (bf16_t)(w01 & 0xffffu); yp[rs] = (bf16_t)(w01 >> 16); yp[2 * rs] = (bf16_t)(w23 & 0xffffu); yp[3 * rs] = (bf16_t)(w23 >> 16); } }
            const int pt2 = w & 3, nb = (w >> 2) * 4; const float et = misc[256];
            bf16x8 xf2[2];
#pragma unroll
            for (int ks = 0; ks < 2; ++ks) xf2[ks] = *(const LAS bf16x8*)(L + S_XT + (16 * pt2 + q16) * 144 + ks * 64 + gq * 16);
            LAS unsigned char* HN = L + S_HB + (par ^ 1) * 17408;
#pragma unroll
            for (int j = 0; j < 4; ++j) { const int nt = nb + j; Hacc[j] = Hacc[j] * et;
#pragma unroll
                for (int ks = 0; ks < 2; ++ks) { const bf16x8 bfr = *(const LAS bf16x8*)(L + S_BT + (16 * nt + q16) * 144 + ks * 64 + gq * 16); Hacc[j] = __builtin_amdgcn_mfma_f32_16x16x32_bf16(xf2[ks], bfr, Hacc[j], 0, 0, 0); }
#pragma unroll
                for (int r = 0; r < 4; r += 2) { const unsigned pw = pk2(Hacc[j][r], Hacc[j][r + 1]);
                    *(LAS unsigned short*)(HN + (16 * pt2 + 4 * gq + r) * 272 + (16 * nt + q16) * 2) = (unsigned short)(pw & 0xffffu); *(LAS unsigned short*)(HN + (16 * pt2 + 4 * gq + r + 1) * 272 + (16 * nt + q16) * 2) = (unsigned short)(pw >> 16); } }
        }
        par ^= 1;
    }
#undef SSD_ROW
#undef SSD_PREFETCH
}
__device__ __forceinline__ void p_mixa(const Frame& F, int layer, bool last) {
    { PrepassW W; ssd_prepass_weights(F, layer, W);
      for (int u = F.bid; u < NTOK / 16; u += F.G) ssd_prepass_unit(F, u, W); }
    for (int u0 = F.bid; u0 < 2048 * REP_NA; u0 += F.G) { const int u = u0 & 2047; na_unit(F, layer, u >> 7, (u >> 4) & 7, 0, u & 15); }
    if (!last) for (int u = F.bid; u < 256; u += F.G) na_unit(F, layer, u >> 4, (u >> 1) & 7, 1, u & 1);
}
__device__ __forceinline__ void p_mixb(const Frame& F, int layer) {
    for (int u0 = F.bid; u0 < 256 * REP_SSD; u0 += F.G) { const int u = u0 & 255; ssd_mfma_unit(F, layer, u >> 4, (u >> 1) & 7, u & 1); }
}

__device__ __forceinline__ void p_ssdcomb(const Frame& F, int layer, bool last) {
    const bf16_t* PROJ = (const bf16_t*)(F.ws + WS_PROJ); bf16_t* MIX = (bf16_t*)(F.ws + WS_MIX);
    const bf16_t* YF = (const bf16_t*)(F.ws + WS_YF); const bf16_t* YB = (const bf16_t*)(F.ws + WS_YB);
    const float* nw = F.in[I_NORMW] + layer * 512 + F.lane * 8;
    const f32x4 nw0 = *(const f32x4*)nw, nw1 = *(const f32x4*)(nw + 4);
    const int nrows = last ? NLAT : NTOK;
    u32x4 pyf = {0u, 0u, 0u, 0u}, pyb = pyf, pz = pyf;
#define SC_LOAD(r_) do { const size_t o_ = (size_t)(r_) * 512 + F.lane * 8; pyf = *(const u32x4*)(YF + o_); pyb = *(const u32x4*)(YB + o_); \
        pz = *(const u32x4*)(PROJ + (size_t)(r_) * NPROJ + OFF_Z + F.lane * 8); } while (0)
    if (F.gw < nrows) SC_LOAD(F.gw);
    for (int row = F.gw; row < nrows; row += F.NGW) {
        const f32x4 a0 = {bflo(pyf.x) + bflo(pyb.x), bfhi(pyf.x) + bfhi(pyb.x), bflo(pyf.y) + bflo(pyb.y), bfhi(pyf.y) + bfhi(pyb.y)}, a1 = {bflo(pyf.z) + bflo(pyb.z), bfhi(pyf.z) + bfhi(pyb.z), bflo(pyf.w) + bflo(pyb.w), bfhi(pyf.w) + bfhi(pyb.w)}; const u32x4 zv = pz;
        if (row + F.NGW < nrows) SC_LOAD(row + F.NGW);
        float y[8] = {a0[0] * silu_f(bflo(zv.x)), a0[1] * silu_f(bfhi(zv.x)), a0[2] * silu_f(bflo(zv.y)), a0[3] * silu_f(bfhi(zv.y)),
                      a1[0] * silu_f(bflo(zv.z)), a1[1] * silu_f(bfhi(zv.z)), a1[2] * silu_f(bflo(zv.w)), a1[3] * silu_f(bfhi(zv.w))};
        float ss = 0.f;
#pragma unroll
        for (int k = 0; k < 8; ++k) ss += y[k] * y[k];
#pragma unroll
        for (int of = 1; of < 32; of <<= 1) ss += __shfl_xor(ss, of);
        const float rs = 1.0f / sqrtf(ss * (1.0f / 256.0f) + RMS_EPS);
        u32x4 w; w.x = pk2(y[0] * rs * nw0[0], y[1] * rs * nw0[1]); w.y = pk2(y[2] * rs * nw0[2], y[3] * rs * nw0[3]);
        w.z = pk2(y[4] * rs * nw1[0], y[5] * rs * nw1[1]); w.w = pk2(y[6] * rs * nw1[2], y[7] * rs * nw1[3]);
        *(u32x4*)(MIX + (size_t)row * D + 512 + F.lane * 8) = w;
    }
}

__device__ __forceinline__ void p_outproj(const Frame& F, int layer, bool last) {
    bf16_t* X = (bf16_t*)(F.ws + WS_X);
    pg8::Gemm g{(const bf16_t*)(F.ws + WS_MIX), (const bf16_t*)(F.ws + WS_WOUT) + (size_t)layer * D * D, D};
    pg8::DenseOrder S; S.init(last ? NLAT : NTOK, D, D, F.G, F.bid);
    pg8::EpiResid E{layer == 0 ? (const void*)F.in[I_X] : (const void*)X, layer == 0 ? (const void*)F.in[I_CTX] : (const void*)(X + (size_t)NLAT * D), X, (const float*)(F.ws + WS_MOD) + (size_t)layer * 17 * MODW, 2 * D, layer == 0};
    pg8::gemm_phase<pg8::EpiResid, pg8::DenseOrder, true, true>(F.lds, g, S, E, F.tid);
}

__device__ __forceinline__ unsigned* cnt_word(const Frame& F, int slot, int hf, int e) { return (unsigned*)(F.ws + WS_CTL) + CW_CNT + ((slot * 2 + hf) * 8 + e) * 64; }
__device__ __forceinline__ void p_ln1(const Frame& F, int layer, bool last) {
    bf16_t* X = (bf16_t*)(F.ws + WS_X); bf16_t* H = (bf16_t*)(F.ws + WS_H);
    const float* MOD = (const float*)(F.ws + WS_MOD) + (size_t)layer * 17 * MODW;
    const float* lg = F.in[I_LNG] + (size_t)(layer * 2) * D; const float* lb = F.in[I_LNB] + (size_t)(layer * 2) * D;
    const bool moe = layer & 1; const int slot = layer >> 1;
    const int nrows = last ? NLAT : NTOK;
    float rw[16][8];
    if (moe) { const float* R = F.in[I_RW] + (size_t)slot * D * 8;
#pragma unroll
        for (int j = 0; j < 4; ++j)
#pragma unroll
            for (int k = 0; k < 4; ++k) { const int lane = F.lane; const f32x4 a = *(const f32x4*)(R + (size_t)(RIDX(j) + k) * 8), b2 = *(const f32x4*)(R + (size_t)(RIDX(j) + k) * 8 + 4);
                rw[j * 4 + k][0] = a[0]; rw[j * 4 + k][1] = a[1]; rw[j * 4 + k][2] = a[2]; rw[j * 4 + k][3] = a[3]; rw[j * 4 + k][4] = b2[0]; rw[j * 4 + k][5] = b2[1]; rw[j * 4 + k][6] = b2[2]; rw[j * 4 + k][7] = b2[3]; } }
    int nrec = 0;
    if (moe) { __syncthreads(); if (F.tid < 32) ((LAS unsigned*)F.lds)[F.tid] = 0u; __syncthreads(); }
    f32x4 vn[4];
    if (F.gw < nrows) row_load_h(X + (size_t)F.gw * D, F.lane, vn);
    for (int row = F.gw; row < nrows; row += F.NGW) {
        f32x4 v[4], hv[4];
#pragma unroll
        for (int j = 0; j < 4; ++j) v[j] = vn[j];
        if (row + F.NGW < nrows) row_load_h(X + (size_t)(row + F.NGW) * D, F.lane, vn);
        row_ln(v, lg, lb, F.lane);
        row_store_h(X + (size_t)row * D, F.lane, v);
        const float* m = MOD + (size_t)mod_row_of(row) * MODW;
        if (USE_FP8 && (moe || FP8_DENSE)) row_mod_store8((unsigned char*)H + (size_t)row * D, F.lane, v, m + 3 * D, m + 4 * D, hv);
        else row_mod_store(H + (size_t)row * D, F.lane, v, m + 3 * D, m + 4 * D, hv);
        if (moe) {
            float lg8[8];
#pragma unroll
            for (int e = 0; e < 8; ++e) { float s = 0.f;
#pragma unroll
                for (int j = 0; j < 4; ++j)
#pragma unroll
                    for (int k = 0; k < 4; ++k) s += hv[j][k] * rw[j * 4 + k][e];
                lg8[e] = wave_sum(s); }
            int e0 = 0; float v0 = lg8[0];
#pragma unroll
            for (int e = 1; e < 8; ++e) if (lg8[e] > v0) { v0 = lg8[e]; e0 = e; }
            int e1 = -1; float v1 = -INFINITY;
#pragma unroll
            for (int e = 0; e < 8; ++e) if (e != e0 && lg8[e] > v1) { v1 = lg8[e]; e1 = e; }
            if (F.lane == 0) {
                const unsigned s0 = __hip_atomic_fetch_add((LAS unsigned*)F.lds + e0, 1u, __ATOMIC_RELAXED, __HIP_MEMORY_SCOPE_WORKGROUP), s1 = __hip_atomic_fetch_add((LAS unsigned*)F.lds + e1, 1u, __ATOMIC_RELAXED, __HIP_MEMORY_SCOPE_WORKGROUP);
                const float ex = __expf(v1 - v0), g0 = 1.0f / (1.0f + ex);
                ((LAS u32x4*)(F.lds + 256))[F.wave * 32 + nrec] = (u32x4){(unsigned)e0 | ((unsigned)e1 << 8), s0, s1, (unsigned)row};
                *(f32x2*)(F.ws + WS_GATES + (size_t)row * 8) = (f32x2){g0, ex * g0};
            }
            ++nrec;
        }
    }
    if (moe) {
        __syncthreads();
        if (F.tid < 8) ((LAS unsigned*)F.lds)[16 + F.tid] = atomicAdd(cnt_word(F, slot, 0, F.tid), ((LAS unsigned*)F.lds)[F.tid]);
        __syncthreads();
        int* list = (int*)(F.ws + WS_LIST);
        if (F.lane < nrec) { const u32x4 rc = ((LAS u32x4*)(F.lds + 256))[F.wave * 32 + F.lane]; const int e0 = rc.x & 255, e1 = (rc.x >> 8) & 255; const int row = (int)rc.w;
            const unsigned s0 = ((LAS unsigned*)F.lds)[16 + e0] + rc.y, s1 = ((LAS unsigned*)F.lds)[16 + e1] + rc.z;
            list[e0 * NTOK + s0] = row; list[e1 * NTOK + s1] = row;
            *(u32x4*)(F.ws + WS_ROUTE + (size_t)row * 16) = (u32x4){rc.x, s0, s1, 0u}; }
    }
}

__device__ __forceinline__ void p_ffn1_dense(const Frame& F, int layer, bool last) {
    const int s = layer >> 1;
#if USE_FP8 && FP8_DENSE
    pg8::Gemm g{(const bf16_t*)(F.ws + WS_H), (const bf16_t*)(F.ws + WS_WFGU + (size_t)s * 2 * DFF * D), D / 2};
    pg8::DenseOrder S; S.init(last ? NLAT : NTOK, 2 * DFF, D / 2, F.G, F.bid, REP_GEMM);
    pg8::EpiSwiGLU8 E{F.ws + WS_HID, DFF};
    pg8::gemm_phase<pg8::EpiSwiGLU8, pg8::DenseOrder, true, FP8_SP2, true>(F.lds, g, S, E, F.tid, (127 - S8_WGU) * 0x01010101, (127 - S8_ACT) * 0x01010101);
#else
    pg8::Gemm g{(const bf16_t*)(F.ws + WS_H), (const bf16_t*)(F.ws + WS_WFGU) + (size_t)s * 2 * DFF * D, D};
    pg8::DenseOrder S; S.init(last ? NLAT : NTOK, 2 * DFF, D, F.G, F.bid, REP_GEMM);
    pg8::EpiSwiGLU E{(bf16_t*)(F.ws + WS_HID), DFF};
    pg8::gemm_phase<pg8::EpiSwiGLU, pg8::DenseOrder, true, true>(F.lds, g, S, E, F.tid);
#endif
}
__device__ __forceinline__ void p_ffn2_dense(const Frame& F, int layer, bool last) {
    const int s = layer >> 1; bf16_t* X = (bf16_t*)(F.ws + WS_X);
    pg8::EpiResid E{(const void*)X, (const void*)(X + (size_t)NLAT * D), X, (const float*)(F.ws + WS_MOD) + (size_t)layer * 17 * MODW, 5 * D, false};
#if USE_FP8 && FP8_DENSE
    pg8::Gemm g{(const bf16_t*)(F.ws + WS_HID), (const bf16_t*)(F.ws + WS_WFD + (size_t)s * D * DFF), DFF / 2};
    pg8::DenseOrder S; S.init(last ? NLAT : NTOK, D, DFF / 2, F.G, F.bid);
    pg8::gemm_phase<pg8::EpiResid, pg8::DenseOrder, true, FP8_SP2, true>(F.lds, g, S, E, F.tid, (127 - S8_WD) * 0x01010101, (127 - S8_HID) * 0x01010101);
#else
    pg8::Gemm g{(const bf16_t*)(F.ws + WS_HID), (const bf16_t*)(F.ws + WS_WFD) + (size_t)s * D * DFF, DFF};
    pg8::DenseOrder S; S.init(last ? NLAT : NTOK, D, DFF, F.G, F.bid);
    pg8::gemm_phase<pg8::EpiResid, pg8::DenseOrder, true, true>(F.lds, g, S, E, F.tid);
#endif
}
__device__ __forceinline__ void moe_prefix(const Frame& F, int slot, int hf, int (&ts)[9], int (&cn)[8]) {
    int a = 0;
#pragma unroll
    for (int e = 0; e < 8; ++e) { cn[e] = (int)*cnt_word(F, slot, hf, e); ts[e] = a; a += (cn[e] + 255) >> 8; }
    ts[8] = a;
}
__device__ __forceinline__ void p_ffn1_moe(const Frame& F, int layer) {
    const int slot = layer >> 1; int cn[8];
    pg8::MoeOrder<true> S; moe_prefix(F, slot, 0, S.ts, cn);
    S.nM = S.ts[8]; S.nN = 2 * DFFE / 256; S.G = F.G; S.c = F.bid; S.K = D / 2; S.estride = (long)2 * DFFE * D; S.rowoff = (const LAS unsigned short*)(F.lds + LDS_ROWOFF); S.rowbytes = D;
    {
        const int* list = (const int*)(F.ws + WS_LIST); LAS unsigned short* ro = (LAS unsigned short*)(F.lds + LDS_ROWOFF); pg8::Unit u;
        for (int i = F.wave; i < 36 && S.next(i, u); i += NWAVES) { const int e = S.expert_of(u.pm); int tse = 0, cne = 0;
#pragma unroll
            for (int j = 0; j < 8; ++j) { tse = (j == e) ? S.ts[j] : tse; cne = (j == e) ? cn[j] : cne; }
            int tk[4];
#pragma unroll
            for (int q = 0; q < 4; ++q) { const int sl = (u.pm - tse) * 256 + F.lane + 64 * q; tk[q] = sl < cne ? list[e * NTOK + sl] : 0; }
#pragma unroll
            for (int q = 0; q < 4; ++q) ro[i * 256 + F.lane + 64 * q] = (unsigned short)tk[q]; }
        __syncthreads();
    }
    pg8::Gemm g{(const bf16_t*)(F.ws + WS_H), (const bf16_t*)(F.ws + WS_WMGU + (size_t)slot * NEXP * 2 * DFFE * D), D / 2};
    pg8::EpiSwiGLU8 E{F.ws + WS_HID, DFFE};
    pg8::gemm_phase<pg8::EpiSwiGLU8, pg8::MoeOrder<true>, true, FP8_SP2, true>(F.lds, g, S, E, F.tid, (127 - S8_WGU) * 0x01010101, (127 - S8_ACT) * 0x01010101);
}
__device__ __forceinline__ void p_ffn2_moe(const Frame& F, int layer) {
    const int slot = layer >> 1; int cn[8];
    pg8::MoeOrder<false> S; moe_prefix(F, slot, 0, S.ts, cn);
    S.nM = S.ts[8]; S.nN = D / 256; S.G = F.G; S.c = F.bid; S.K = DFFE / 2; S.estride = (long)D * DFFE; S.rowoff = nullptr; S.rowbytes = 0;
    pg8::EpiBf16 E{(bf16_t*)(F.ws + WS_YP), D};
    pg8::Gemm g{(const bf16_t*)(F.ws + WS_HID), (const bf16_t*)(F.ws + WS_WMD + (size_t)slot * NEXP * D * DFFE), DFFE / 2};
    pg8::gemm_phase<pg8::EpiBf16, pg8::MoeOrder<false>, true, FP8_SP2, true>(F.lds, g, S, E, F.tid, (127 - S8_WD) * 0x01010101, (127 - S8_HID) * 0x01010101);
}

__device__ __forceinline__ void p_ln2(const Frame& F, int layer, bool last) {
    bf16_t* X = (bf16_t*)(F.ws + WS_X); bf16_t* H = (bf16_t*)(F.ws + WS_H);
    const float* MOD = (const float*)(F.ws + WS_MOD) + (size_t)layer * 17 * MODW;
    const float* lg = F.in[I_LNG] + (size_t)(layer * 2 + 1) * D; const float* lb = F.in[I_LNB] + (size_t)(layer * 2 + 1) * D;
    const bool moe = layer & 1; const int slot = layer >> 1;
    const int nrows = last ? NLAT : NTOK;
    int ts0[9], cn[8];
    if (moe) moe_prefix(F, slot, 0, ts0, cn);
    const bf16_t* YP = (const bf16_t*)(F.ws + WS_YP);
    f32x4 vn[4]; u32x4 rn = {0u, 0u, 0u, 0u}; f32x2 gn = {0.f, 0.f};
    if (F.gw < nrows) { row_load_h(X + (size_t)F.gw * D, F.lane, vn); if (moe) { rn = *(const u32x4*)(F.ws + WS_ROUTE + (size_t)F.gw * 16); gn = *(const f32x2*)(F.ws + WS_GATES + (size_t)F.gw * 8); } }
    for (int row = F.gw; row < nrows; row += F.NGW) {
        f32x4 v[4], hv[4];
#pragma unroll
        for (int j = 0; j < 4; ++j) v[j] = vn[j];
        const u32x4 r = rn; const f32x2 gt = gn;
        if (row + F.NGW < nrows) { row_load_h(X + (size_t)(row + F.NGW) * D, F.lane, vn);
            if (moe) { rn = *(const u32x4*)(F.ws + WS_ROUTE + (size_t)(row + F.NGW) * 16); gn = *(const f32x2*)(F.ws + WS_GATES + (size_t)(row + F.NGW) * 8); } }
        if (moe) {
            const int e0 = r.x & 255, e1 = (r.x >> 8) & 255;
            int t0 = 0, t1 = 0;
#pragma unroll
            for (int e = 0; e < 8; ++e) { const int tv = ts0[e]; t0 = (e == e0) ? tv : t0; t1 = (e == e1) ? tv : t1; }
            const bf16_t* y0 = YP + ((size_t)t0 * 256 + r.y) * D; const bf16_t* y1 = YP + ((size_t)t1 * 256 + r.z) * D;
            const float* g2 = MOD + (size_t)mod_row_of(row) * MODW + 5 * D;
#pragma unroll
            for (int j = 0; j < 2; ++j) { const int lane = F.lane; const u32x4 a = *(const u32x4*)(y0 + 8 * lane + 512 * j), b2 = *(const u32x4*)(y1 + 8 * lane + 512 * j);
                const f32x4 g0 = *(const f32x4*)(g2 + RIDX(2 * j)) + 1.0f, g1 = *(const f32x4*)(g2 + RIDX(2 * j + 1)) + 1.0f;
                f32x4 f0, f1; f0[0] = gt[0] * bflo(a.x) + gt[1] * bflo(b2.x); f0[1] = gt[0] * bfhi(a.x) + gt[1] * bfhi(b2.x); f0[2] = gt[0] * bflo(a.y) + gt[1] * bflo(b2.y); f0[3] = gt[0] * bfhi(a.y) + gt[1] * bfhi(b2.y);
                f1[0] = gt[0] * bflo(a.z) + gt[1] * bflo(b2.z); f1[1] = gt[0] * bfhi(a.z) + gt[1] * bfhi(b2.z); f1[2] = gt[0] * bflo(a.w) + gt[1] * bflo(b2.w); f1[3] = gt[0] * bfhi(a.w) + gt[1] * bfhi(b2.w);
                v[2 * j] = v[2 * j] * ALPHA + g0 * f0; v[2 * j + 1] = v[2 * j + 1] * ALPHA + g1 * f1; }
        }
        row_ln(v, lg, lb, F.lane);
        if (last) row_store(F.out + (size_t)row * D, F.lane, v);
        else { row_store_h(X + (size_t)row * D, F.lane, v);
            const float* m = MOD + (size_t)17 * MODW + (size_t)mod_row_of(row) * MODW;
            row_mod_store(H + (size_t)row * D, F.lane, v, m, m + D, hv);
            }
    }
}

constexpr int NPL = 9;
constexpr int NPH = 2 + NPL * DEPTH;
#ifndef SITE_MASK
#define SITE_MASK 0xFFFFF
#endif
#define SITE(n) (((SITE_MASK) >> (n)) & 1)
__global__ void __launch_bounds__(NT, 2) fwd_kernel(Args args) {
    extern __shared__ __attribute__((aligned(16))) unsigned char lds_raw[];
    Frame F;
    F.lds = (LAS unsigned char*)lds_raw; F.in = args.in; F.out = args.out; F.ws = args.ws;
    F.tid = threadIdx.x; F.lane = F.tid & 63; F.wave = __builtin_amdgcn_readfirstlane(F.tid >> 6); F.bid = blockIdx.x; F.G = gridDim.x;
    F.gw = F.bid * NWAVES + F.wave; F.NGW = F.G * NWAVES;
    volatile LAS unsigned* MISC = (volatile LAS unsigned*)(F.lds + LDS_MISC);
    if (F.tid < 64) MISC[F.tid] = 0u;
    __syncthreads();
    XcdBarrier bar; bar.bar = (unsigned*)(F.ws + WS_CTL) + CW_BAR; bar.x = 0; bar.st = MISC + 8;
#if MK_SINGLE
    bar = xcd_barrier_post((unsigned*)(F.ws + WS_CTL) + CW_BAR, MISC + 8);
#endif
    const int lo = args.ph_lo, hi = args.ph_hi;
#define IN(k) (lo <= (k) && (k) < hi)
#if MK_SINGLE
#define SEAM(k) do { if (IN(k) && IN((k) + 1)) { XcdBarrier b2_ = bar; int z_; asm volatile("s_mov_b32 %0, 0" : "=s"(z_)); b2_.bar = bar.bar + z_; int ln_; asm volatile("v_mbcnt_lo_u32_b32 %0, -1, 0\n\tv_mbcnt_hi_u32_b32 %0, -1, %0" : "=v"(ln_)); xcd_barrier(b2_, F.wave == 0 && ln_ == 0); } } while (0)
#else
#define SEAM(k) do { } while (0)
#endif
    if constexpr (SITE(0)) if (IN(0)) p_pro_a(fresh(F));
    SEAM(0);
    if constexpr (SITE(1)) if (IN(1)) p_pro_b(fresh(F));
    SEAM(1);
    for (int layer = 0; layer < DEPTH; ++layer) {
        const int pb = 2 + NPL * layer; const bool last = layer == DEPTH - 1; const bool moe = layer & 1;
        if constexpr (SITE(2)) if (IN(pb + 0)) p_inproj(fresh(F), layer);
        SEAM(pb + 0);
        if constexpr (SITE(3)) if (IN(pb + 1)) p_mixa(fresh(F), layer, last);
        SEAM(pb + 1);
        if constexpr (SITE(12)) if (IN(pb + 2)) p_mixb(fresh(F), layer);
        SEAM(pb + 2);
        if constexpr (SITE(4)) if (IN(pb + 3)) { p_ssdcomb(fresh(F), layer, last); if (!USE_FP8 && layer == 2) { int rot = 0; conv_moe(fresh(F), 1, rot); } }
        SEAM(pb + 3);
        if constexpr (SITE(5)) if (IN(pb + 4)) p_outproj(fresh(F), layer, last);
        SEAM(pb + 4);
        if constexpr (SITE(6)) if (IN(pb + 5)) p_ln1(fresh(F), layer, last);
        SEAM(pb + 5);
        if (moe) {
            if constexpr (SITE(7)) if (IN(pb + 6)) p_ffn1_moe(fresh(F), layer);
            SEAM(pb + 6);
            if constexpr (SITE(8)) if (IN(pb + 7)) p_ffn2_moe(fresh(F), layer);
            SEAM(pb + 7);
        } else {
            if constexpr (SITE(9)) if (IN(pb + 6)) p_ffn1_dense(fresh(F), layer, last);
            SEAM(pb + 6);
            if constexpr (SITE(10)) if (IN(pb + 7)) p_ffn2_dense(fresh(F), layer, last);
            SEAM(pb + 7);
        }
        if constexpr (SITE(11)) if (IN(pb + 8)) p_ln2(fresh(F), layer, last);
        if (!last) SEAM(pb + 8);
    }
#undef IN
#undef SEAM
}

extern "C" void kernel_launch(void* const* d_in, const int* in_sizes, int n_in, void* d_out, int out_size, void* d_ws, size_t ws_size, hipStream_t stream) {
    static int grid = 0;
    if (grid == 0) {
        if (n_in != 24 || out_size != NLAT * D || ws_size < WS_END) { fprintf(stderr, "kernel_launch: unexpected shapes (n_in %d, out %d, ws %zu < %zu)\n", n_in, out_size, ws_size, (size_t)WS_END); grid = -1; return; }
        int dev = 0, cus = 0, per_cu = 0;
        if (hipGetDevice(&dev) != hipSuccess || hipDeviceGetAttribute(&cus, hipDeviceAttributeMultiprocessorCount, dev) != hipSuccess) { grid = -1; return; }
        if (hipFuncSetAttribute((const void*)fwd_kernel, hipFuncAttributeMaxDynamicSharedMemorySize, LDS_BYTES) != hipSuccess) { fprintf(stderr, "kernel_launch: hipFuncSetAttribute failed\n"); grid = -1; return; }
        if (hipOccupancyMaxActiveBlocksPerMultiprocessor(&per_cu, (const void*)fwd_kernel, NT, LDS_BYTES) != hipSuccess || per_cu < 1) { fprintf(stderr, "kernel_launch: occupancy query says %d\n", per_cu); }
        (void)hipGetLastError();
        grid = cus;
    }
    if (grid < 0) return;
    (void)in_sizes;
    if (hipMemsetAsync((char*)d_ws + WS_CTL, 0, CTL_BYTES, stream) != hipSuccess) return;
    Args a{};
    for (int i = 0; i < 24; ++i) a.in[i] = (const float*)d_in[i];
    a.out = (float*)d_out; a.ws = (unsigned char*)d_ws;
#if MK_SINGLE
    a.ph_lo = 0; a.ph_hi = NPH;
    hipLaunchKernelGGL(fwd_kernel, dim3(grid), dim3(NT), LDS_BYTES, stream, a);
#else
    for (int ph = 0; ph < NPH; ++ph) {

        a.ph_lo = ph; a.ph_hi = ph + 1;
        hipLaunchKernelGGL(fwd_kernel, dim3(grid), dim3(NT), LDS_BYTES, stream, a);
    }
#endif
}
```

```cpp
#include <hip/hip_runtime.h>
#include <cstdio>
#include <cstdint>

#ifndef MK_SINGLE
#define MK_SINGLE 1
#endif

#ifndef FP8_INPROJ
#define FP8_INPROJ 0
#endif
#ifndef FP8_DENSE
#define FP8_DENSE 0
#endif
#ifndef USE_FP8
#define USE_FP8 1
#endif
#ifndef FP8_SP2
#define FP8_SP2 true
#endif
#ifndef REP_SSD
#define REP_SSD 1
#endif
#ifndef REP_NA
#define REP_NA 1
#endif
#ifndef REP_GEMM
#define REP_GEMM 1
#endif
#define GAS __attribute__((address_space(1)))
#define LAS __attribute__((address_space(3)))
typedef unsigned short bf16_t;
typedef short bf16x8 __attribute__((ext_vector_type(8)));
typedef float f32x4 __attribute__((ext_vector_type(4)));
typedef float f32x2 __attribute__((ext_vector_type(2)));
typedef unsigned u32x4 __attribute__((ext_vector_type(4)));
typedef unsigned u32x2 __attribute__((ext_vector_type(2)));
typedef int i32x4 __attribute__((ext_vector_type(4)));
typedef int i32x8 __attribute__((ext_vector_type(8)));

constexpr int D = 1024, BATCH = 16, SEQ = 2048, DEPTH = 4, GRID_W = 64, CTX = 256;
constexpr int NLAT = BATCH * SEQ;
constexpr int NCTX = BATCH * CTX;
constexpr int NTOK = NLAT + NCTX;
constexpr int NPROJ = 3072;
constexpr int OFF_K = 512, OFF_V = 1024, OFF_Z = 1536, OFF_XBC = 2048;
constexpr int D_IN_PROJ = 3088;
constexpr int DFF = 2816, DFFE = 3584, NEXP = 8;
constexpr float ALPHA = 1.6817928305074290f;
constexpr float LN_EPS = 1e-5f, RMS_EPS = 1e-5f;
constexpr int MODW = 6 * D;

constexpr size_t MiB = 1u << 20;
constexpr size_t WS_CTL = 0, CTL_BYTES = 1 * MiB;
constexpr size_t WS_MOD = 1 * MiB;
constexpr size_t WS_ROUTE = 3 * MiB;
constexpr size_t WS_GATES = 4 * MiB;
constexpr size_t WS_LIST = 5 * MiB;
constexpr size_t WS_WDT = 7 * MiB;
constexpr size_t WS_WIN = 8 * MiB;
constexpr size_t WS_WOUT = 32 * MiB;
constexpr size_t WS_WFGU = 40 * MiB;
constexpr size_t WS_WFD = 62 * MiB;
constexpr size_t WS_WMGU = 73 * MiB;
constexpr size_t WS_WMD = 185 * MiB;
constexpr size_t WS_X = 241 * MiB;
constexpr size_t WS_H = 385 * MiB;
constexpr size_t WS_R = 457 * MiB;
constexpr size_t WS_PROJ = WS_R;
constexpr size_t WS_DT = WS_R + 216 * MiB;
constexpr size_t WS_YF = WS_R + 219 * MiB;
constexpr size_t WS_YB = WS_R + 291 * MiB;
constexpr size_t WS_MIX = WS_R + 363 * MiB;
constexpr size_t WS_HID = WS_R;
constexpr size_t WS_YP = WS_R + 270 * MiB;
constexpr size_t WS_U = WS_R + 435 * MiB;
constexpr size_t WS_H8IN = WS_U;
constexpr size_t WS_END = WS_R + 507 * MiB;
constexpr int MOE_PAD = 2 * NTOK + 2048;
static_assert(USE_FP8 == 1, "the single-phase MoE needs the e4m3 hidden (the bf16 one does not fit the workspace)");
static_assert(WS_HID + (size_t)MOE_PAD * 3584 <= WS_YP && WS_YP + (size_t)MOE_PAD * 1024 * 2 <= WS_END, "MoE buffers");

constexpr int CW_TMO = 0;
constexpr int CW_BAR = 4096;
constexpr int CW_CNT = 16384;

constexpr int LDS_STAGE = 131072;
constexpr int LDS_ROWOFF = 131072;
constexpr int LDS_MISC = 131072 + 18432;
constexpr int LDS_BYTES = 155648;

constexpr int S8_ACT = 3, S8_WGU = 8, S8_HID = 2, S8_WD = 9;
__device__ __forceinline__ unsigned f2bf(float f) { unsigned u = __builtin_bit_cast(unsigned, f); return (u + 0x7fffu + ((u >> 16) & 1u)) >> 16; }
typedef __bf16 bf16x2_t __attribute__((ext_vector_type(2)));
__device__ __forceinline__ unsigned pk2(float lo, float hi) { const f32x2 v = {lo, hi}; const bf16x2_t b = __builtin_convertvector(v, bf16x2_t); return __builtin_bit_cast(unsigned, b); }
__device__ __forceinline__ float bf2f(unsigned short b) { return __builtin_bit_cast(float, ((unsigned)b) << 16); }
__device__ __forceinline__ float bflo(unsigned w) { return __builtin_bit_cast(float, w << 16); }
__device__ __forceinline__ float bfhi(unsigned w) { return __builtin_bit_cast(float, w & 0xffff0000u); }
__device__ __forceinline__ float silu_f(float v) { return v / (1.0f + __expf(-v)); }
__device__ __forceinline__ float clamp8(float v) { return fminf(fmaxf(v, -448.0f), 448.0f); }
__device__ __forceinline__ unsigned pk8(float a, float b, float c, float d) {
    int w = 0; w = __builtin_amdgcn_cvt_pk_fp8_f32(clamp8(a), clamp8(b), w, false); w = __builtin_amdgcn_cvt_pk_fp8_f32(clamp8(c), clamp8(d), w, true); return (unsigned)w; }
__device__ __forceinline__ float wave_sum(float v) {
#pragma unroll
    for (int o = 1; o < 64; o <<= 1) v += __shfl_xor(v, o);
    return v;
}

namespace pg8 {
constexpr int BM = 256, BK = 64, HALF = 128, HTB = HALF * BK * 2, STAGE_BYTES = 8 * HTB, NXCD = 8, WGM = 8;
__host__ __device__ __forceinline__ int lds_byte(int r, int c) { const int st = (r >> 4) * 2 + (c >> 5), rr = r & 15, cc = c & 31, ob = rr * 64 + cc * 2; return st * 1024 + (ob ^ (((ob >> 9) & 1) << 5)); }
__host__ __device__ __forceinline__ void stage_rc(int b, int& R, int& C) { const int st = b / 1024, sb = b % 1024, swz = sb ^ (((sb >> 9) & 1) << 5); R = (st >> 1) * 16 + swz / 64; C = (st & 1) * 32 + (swz % 64) / 2; }
__host__ __device__ __forceinline__ int perm32(int rho) { const int n = rho >> 4, i = rho & 15; return 8 * (i >> 2) + 4 * n + (i & 3); }

struct Unit { int pm, pn; long bofs; };
struct Gemm { const bf16_t* A; const bf16_t* Bt; int K; };

__device__ __forceinline__ unsigned cvt_pk_bf16(float lo, float hi) { return pk2(lo, hi); }
__device__ __forceinline__ unsigned cvt_pk_bf16_pin(float lo, float hi) { unsigned r; asm volatile("v_cvt_pk_bf16_f32 %0, %1, %2" : "=v"(r) : "v"(lo), "v"(hi)); return r; }

__device__ __forceinline__ bool static_tile(int i, int G, int c, int nM, int nN, int& pm, int& pn, int rep = 1) {
    const int nwg = nM * nN;
#if REP_GEMM > 1
    { const int cnt = (nwg - c + G - 1) / G; if (cnt <= 0 || i >= rep * cnt) return false; i %= cnt; }
#endif
    const long L = (long)i * G + c; if (L >= nwg) return false;
    int wgid = (int)L; { const int q = nwg / NXCD, r = nwg % NXCD, xcd = wgid % NXCD, off = wgid / NXCD; wgid = (xcd < r ? xcd * (q + 1) : r * (q + 1) + (xcd - r) * q) + off; }
    const int nig = WGM * nN, gid = wgid / nig, fm = gid * WGM, gsz = (nM - fm) < WGM ? (nM - fm) : WGM;
    pm = fm + ((wgid % nig) % gsz); pn = (wgid % nig) / gsz; return true;
}
struct DenseOrder {
    int nM, nN, G, c, K, rep;
    __device__ __forceinline__ void init(int M, int N, int K_, int G_, int c_, int rep_ = 1) { nM = M / BM; nN = N / BM; G = G_; c = c_; K = K_; rep = rep_; }
    __device__ __forceinline__ bool next(int i, Unit& u) const { if (!static_tile(i, G, c, nM, nN, u.pm, u.pn, rep)) return false; u.bofs = (long)u.pn * BM * K * 2; return true; }
    static constexpr bool GATHER = false;
    __device__ __forceinline__ long a_base(const Unit& u) const { return (long)u.pm * BM * K * 2; }
    __device__ __forceinline__ void a_offs(int, const Unit&, int, unsigned (&)[2][2]) const {}
};
template <bool GATHER_> struct MoeOrder {
    int nM, nN, G, c, K; int ts[9]; long estride; const LAS unsigned short* rowoff; unsigned rowbytes;
    __device__ __forceinline__ int expert_of(int pm) const { int e = 0;
#pragma unroll
        for (int j = 1; j < 8; ++j) e += (pm >= ts[j]) ? 1 : 0; return e; }
    __device__ __forceinline__ bool next(int i, Unit& u) const { if (!static_tile(i, G, c, nM, nN, u.pm, u.pn, REP_GEMM)) return false; u.bofs = (long)expert_of(u.pm) * estride + (long)u.pn * BM * K * 2; return true; }
    static constexpr bool GATHER = GATHER_;
    __device__ __forceinline__ long a_base(const Unit& u) const { return GATHER_ ? 0l : (long)u.pm * BM * K * 2; }
    __device__ __forceinline__ void a_offs(int ui, const Unit&, int tid, unsigned (&o)[2][2]) const {
        int uix = ui;
#if REP_GEMM > 1
        { const int cnt = (nM * nN - c + G - 1) / G; uix = ui % cnt; }
#endif
        if (GATHER_) {
#pragma unroll
            for (int i = 0; i < 2; ++i) { int R, C; stage_rc(tid * 16 + i * 8192, R, C);
#pragma unroll
                for (int h = 0; h < 2; ++h) o[h][i] = (unsigned)rowoff[uix * 256 + h * HALF + R] * rowbytes + (unsigned)(C * 2); }
        }
    }
};

struct EpiBf16 {
    static constexpr bool PERM = true;
    bf16_t* O; int ldc;
    __device__ __forceinline__ void operator()(const f32x4 (&acc)[2][2][4][2], const Unit& u, int wr, int wc, int fr, int fq) const {
        const int row0 = u.pm * BM + wr * 64 + fr; const int col0 = u.pn * BM + wc * 32 + 8 * fq;
#pragma unroll
        for (int ai = 0; ai < 2; ++ai)
#pragma unroll
            for (int m = 0; m < 4; ++m) { bf16_t* rowp = O + (size_t)(row0 + ai * HALF + m * 16) * ldc + col0;
#pragma unroll
                for (int bj = 0; bj < 2; ++bj) { const f32x4 v0 = acc[ai][bj][m][0], v1 = acc[ai][bj][m][1];
                    u32x4 w; w.x = cvt_pk_bf16(v0[0], v0[1]); w.y = cvt_pk_bf16(v0[2], v0[3]); w.z = cvt_pk_bf16(v1[0], v1[1]); w.w = cvt_pk_bf16(v1[2], v1[3]);
                    *(u32x4*)(rowp + bj * HALF) = w; } }
    }
};
struct EpiSwiGLU {
    static constexpr bool PERM = true;
    bf16_t* O; int ldc;
    __device__ __forceinline__ void operator()(const f32x4 (&acc)[2][2][4][2], const Unit& u, int wr, int wc, int fr, int fq) const {
        const int row0 = u.pm * BM + wr * 64 + fr; const int col0 = u.pn * HALF + wc * 32 + 8 * fq;
#pragma unroll
        for (int ai = 0; ai < 2; ++ai)
#pragma unroll
            for (int m = 0; m < 4; ++m) { bf16_t* rowp = O + (size_t)(row0 + ai * HALF + m * 16) * ldc + col0;
                float h[8];
#pragma unroll
                for (int n = 0; n < 2; ++n)
#pragma unroll
                    for (int j = 0; j < 4; ++j) { const float g = acc[ai][0][m][n][j], up = acc[ai][1][m][n][j]; h[n * 4 + j] = g * __builtin_amdgcn_rcpf(1.0f + __expf(-g)) * up; }
                u32x4 w; w.x = cvt_pk_bf16(h[0], h[1]); w.y = cvt_pk_bf16(h[2], h[3]); w.z = cvt_pk_bf16(h[4], h[5]); w.w = cvt_pk_bf16(h[6], h[7]);
                *(u32x4*)rowp = w; }
    }
};
struct EpiSwiGLU8 {
    static constexpr bool PERM = true;
    unsigned char* O; int ldc;
    __device__ __forceinline__ void operator()(const f32x4 (&acc)[2][2][4][2], const Unit& u, int wr, int wc, int fr, int fq) const {
        const int row0 = u.pm * BM + wr * 64 + fr; const int col0 = u.pn * HALF + wc * 32 + 8 * fq;
#pragma unroll
        for (int ai = 0; ai < 2; ++ai)
#pragma unroll
            for (int m = 0; m < 4; ++m) { unsigned char* rowp = O + (size_t)(row0 + ai * HALF + m * 16) * ldc + col0;
                float h[8];
#pragma unroll
                for (int n = 0; n < 2; ++n)
#pragma unroll
                    for (int j = 0; j < 4; ++j) { const float g = acc[ai][0][m][n][j], up = acc[ai][1][m][n][j]; h[n * 4 + j] = g * __builtin_amdgcn_rcpf(1.0f + __expf(-g)) * up * (float)(1 << S8_HID); }
                u32x2 w; w.x = pk8(h[0], h[1], h[2], h[3]); w.y = pk8(h[4], h[5], h[6], h[7]);
                *(u32x2*)rowp = w; }
    }
};
struct EpiResid {
    static constexpr bool PERM = false;
    const void* base_lat; const void* base_ctx; bf16_t* out; const float* mod; int gate_off; bool base_f32;
    __device__ __forceinline__ void operator()(const f32x4 (&acc)[2][2][4][2], const Unit& u, int wr, int wc, int fr, int fq) const {
        const int rt = u.pm * BM; const bool isctx = rt >= NLAT; const int bi = isctx ? 16 : (rt >> 11);
        const size_t brow = isctx ? (size_t)(rt - NLAT) : (size_t)rt;
        const float* bf = (const float*)(isctx ? base_ctx : base_lat) + brow * D; const bf16_t* bh = (const bf16_t*)(isctx ? base_ctx : base_lat) + brow * D;
        bf16_t* o = out + (size_t)rt * D; const float* gt = mod + bi * MODW + gate_off;
        const int r0 = wr * 64 + fr, col0 = u.pn * BM + wc * 32 + 4 * fq;
        f32x4 gv[2][2];
#pragma unroll
        for (int bj = 0; bj < 2; ++bj)
#pragma unroll
            for (int n = 0; n < 2; ++n) gv[bj][n] = *(const f32x4*)(gt + col0 + bj * HALF + n * 16) + 1.0f;
#pragma unroll
        for (int ai = 0; ai < 2; ++ai)
#pragma unroll
            for (int m = 0; m < 4; ++m) { const size_t off = (size_t)(r0 + ai * HALF + m * 16) * D + col0;
#pragma unroll
                for (int bj = 0; bj < 2; ++bj)
#pragma unroll
                    for (int n = 0; n < 2; ++n) { f32x4 bs;
                        if (base_f32) bs = *(const f32x4*)(bf + off + bj * HALF + n * 16);
                        else { const u32x2 w = *(const u32x2*)(bh + off + bj * HALF + n * 16); bs = (f32x4){bflo(w.x), bfhi(w.x), bflo(w.y), bfhi(w.y)}; }
                        const f32x4 r = bs * ALPHA + gv[bj][n] * acc[ai][bj][m][n];
                        u32x2 ow; ow.x = pk2(r[0], r[1]); ow.y = pk2(r[2], r[3]);
                        *(u32x2*)(o + off + bj * HALF + n * 16) = ow; }
                if (m & 1) asm volatile("" ::: "memory"); }
    }
};

template <class Epi, class Sched, bool ALIGN_EPI, bool SP2, bool FP8 = false>
__device__ __forceinline__ void gemm_phase(LAS unsigned char* lds, const Gemm g, const Sched& S, const Epi& E, int tid_in, int sw = 0x7f7f7f7f, int sa = 0x7f7f7f7f) {
    int tid_ = tid_in; asm volatile("" : "+v"(tid_));
    const int tid = tid_, wid = __builtin_amdgcn_readfirstlane(tid >> 6), lane = tid & 63, wr = wid >> 2, wc = wid & 3, fr = lane & 15, fq = lane >> 4;
    const int K = g.K, nt = K / BK;
    constexpr bool GA = Sched::GATHER;
    unsigned voffA[2], voffB[2];
#pragma unroll
    for (int i = 0; i < 2; ++i) { int R, C; stage_rc(tid * 16 + i * 8192, R, C); const int Rb = Epi::PERM ? ((R & ~31) + perm32(R & 31)) : R;
        voffA[i] = (unsigned)(R * K + C) * 2u; voffB[i] = (unsigned)(Rb * K + C) * 2u; }
    const size_t kstep = (size_t)(BK * 2);
    const size_t hstep = (size_t)HALF * K * 2;
    const unsigned ldsw = (unsigned)wid * 1024u;
    const int aoff = lds_byte(wr * 64 + fr, fq * 8), boff = lds_byte(wc * 32 + fr, fq * 8);
#define PG8_SA(b, h) (((b) * 2 + (h)) * HTB)
#define PG8_SB(b, h) ((4 + (b) * 2 + (h)) * HTB)
#define PG8_STAGE(bufoff, gbase, voff) do { _Pragma("unroll") for (int _i = 0; _i < 2; ++_i) \
        __builtin_amdgcn_global_load_lds((const unsigned*)((const char*)(gbase) + (voff)[_i]), (LAS unsigned*)(lds + (bufoff) + ldsw + _i * 8192), 16, 0, 0); } while (0)
#define PG8_LDA(dst, b, h) do { _Pragma("unroll") for (int m = 0; m < 4; ++m) _Pragma("unroll") for (int k = 0; k < 2; ++k) dst[m][k] = *(const LAS bf16x8*)(lds + PG8_SA(b, h) + aoff + m * 2048 + k * 1024); } while (0)
#define PG8_LDB(dst, b, h) do { _Pragma("unroll") for (int n = 0; n < 2; ++n) _Pragma("unroll") for (int k = 0; k < 2; ++k) dst[n][k] = *(const LAS bf16x8*)(lds + PG8_SB(b, h) + boff + n * 2048 + k * 1024); } while (0)
#define PG8_CAT(x) __builtin_shufflevector(__builtin_bit_cast(i32x4, (x)[0]), __builtin_bit_cast(i32x4, (x)[1]), 0, 1, 2, 3, 4, 5, 6, 7)
#define PG8_MMA(ai, bj, At, Bt) do { __builtin_amdgcn_s_setprio(1); _Pragma("unroll") for (int m = 0; m < 4; ++m) _Pragma("unroll") for (int n = 0; n < 2; ++n) { \
        if constexpr (FP8) { const i32x8 a8_ = PG8_CAT(Bt[n]), b8_ = PG8_CAT(At[m]); \
            asm volatile("v_mfma_scale_f32_16x16x128_f8f6f4 %0, %1, %2, %0, %3, %4 op_sel_hi:[0,0,0]" : "+v"(acc[ai][bj][m][n]) : "v"(a8_), "v"(b8_), "v"(sw), "v"(sa)); } \
        else { _Pragma("unroll") for (int k = 0; k < 2; ++k) acc[ai][bj][m][n] = __builtin_amdgcn_mfma_f32_16x16x32_bf16(Bt[n][k], At[m][k], acc[ai][bj][m][n], 0, 0, 0); } } \
        __builtin_amdgcn_s_setprio(0); } while (0)
#define PG8_WAIT_V(n) asm volatile("s_waitcnt vmcnt(" #n ")" ::: "memory")
#define PG8_WAIT_L(n) asm volatile("s_waitcnt lgkmcnt(" #n ")" ::: "memory")
#define PG8_BAR __builtin_amdgcn_s_barrier()
#define PG8_SCHED __builtin_amdgcn_sched_barrier(0)
    Unit cur, nxt; int ui = 0;
    if (!S.next(0, cur)) return;
    f32x4 acc[2][2][4][2];
#pragma unroll
    for (int a = 0; a < 2; ++a)
#pragma unroll
        for (int b = 0; b < 2; ++b)
#pragma unroll
            for (int m = 0; m < 4; ++m)
#pragma unroll
                for (int n = 0; n < 2; ++n) acc[a][b][m][n] = (f32x4){0.f, 0.f, 0.f, 0.f};
    bf16x8 At[4][2], B0[2][2], B1[2][2];
    const char* Ab = (const char*)g.A + S.a_base(cur);
    unsigned oc[2][2];
    S.a_offs(0, cur, tid, oc);
    const size_t hsA = GA ? (size_t)0 : hstep;
#define PG8_STAGE_A(bufoff, gbase, h) do { if constexpr (GA) PG8_STAGE(bufoff, gbase, oc[h]); else PG8_STAGE(bufoff, (gbase) + (h) * hsA, voffA); } while (0)
    const char* cB = (const char*)g.Bt + cur.bofs;
    if constexpr (SP2) {
        PG8_STAGE(PG8_SB(0, 0), cB, voffB); PG8_STAGE(PG8_SB(0, 1), cB + hstep, voffB); PG8_STAGE_A(PG8_SA(0, 0), Ab, 0); PG8_STAGE_A(PG8_SA(0, 1), Ab, 1);
        if (wr == 1) PG8_BAR;
        PG8_WAIT_V(2); PG8_BAR;
        PG8_STAGE(PG8_SB(1, 0), cB + kstep, voffB); PG8_STAGE_A(PG8_SA(1, 0), Ab + kstep, 0); PG8_STAGE(PG8_SB(1, 1), cB + hstep + kstep, voffB);
        PG8_WAIT_V(6); PG8_BAR;
    } else {
        PG8_STAGE(PG8_SB(0, 0), cB, voffB); PG8_STAGE_A(PG8_SA(0, 0), Ab, 0); PG8_STAGE(PG8_SB(0, 1), cB + hstep, voffB); PG8_STAGE_A(PG8_SA(0, 1), Ab, 1);
        if (wr == 1) PG8_BAR;
        PG8_WAIT_V(4); PG8_BAR;
        PG8_STAGE(PG8_SB(1, 0), cB + kstep, voffB); PG8_STAGE_A(PG8_SA(1, 0), Ab + kstep, 0); PG8_STAGE(PG8_SB(1, 1), cB + hstep + kstep, voffB);
        PG8_WAIT_V(6); PG8_BAR;
    }
    for (;;) {
        const bool has_next = S.next(ui + 1, nxt);
        const char* nB = has_next ? (const char*)g.Bt + nxt.bofs : cB;
        for (int t = 0; t < nt; t += 2) {
            const bool last = (t == nt - 2);
            const char* a1 = Ab + (size_t)(t + 1) * kstep;
            const char* b2 = last ? nB : cB + (size_t)(t + 2) * kstep; const char* b3 = b2 + kstep;
            if constexpr (SP2) {
            PG8_LDB(B0, 0, 0); PG8_LDB(B1, 0, 1); PG8_SCHED; PG8_LDA(At, 0, 0); PG8_STAGE_A(PG8_SA(1, 1), a1, 1);
            if (last && has_next) { S.a_offs(ui + 1, nxt, tid, oc); Ab = (const char*)g.A + S.a_base(nxt); }
            const char* a2 = last ? Ab : Ab + (size_t)(t + 2) * kstep; const char* a3 = a2 + kstep;
            PG8_WAIT_V(8); PG8_WAIT_L(0); PG8_BAR; PG8_MMA(0, 0, At, B0); PG8_MMA(0, 1, At, B1); PG8_BAR; PG8_SCHED;
            PG8_LDA(At, 0, 1); PG8_STAGE(PG8_SB(0, 0), b2, voffB); PG8_STAGE(PG8_SB(0, 1), b2 + hstep, voffB); PG8_STAGE_A(PG8_SA(0, 0), a2, 0);
            PG8_WAIT_V(8); PG8_WAIT_L(0); PG8_BAR; PG8_MMA(1, 0, At, B0); PG8_MMA(1, 1, At, B1); PG8_BAR; PG8_SCHED;
            PG8_LDB(B0, 1, 0); PG8_LDB(B1, 1, 1); PG8_SCHED; PG8_LDA(At, 1, 0); PG8_STAGE_A(PG8_SA(0, 1), a2, 1);
            PG8_WAIT_V(8); PG8_WAIT_L(0); PG8_BAR; PG8_MMA(0, 0, At, B0); PG8_MMA(0, 1, At, B1); PG8_BAR; PG8_SCHED;
            PG8_LDA(At, 1, 1); PG8_STAGE(PG8_SB(1, 0), b3, voffB); PG8_STAGE(PG8_SB(1, 1), b3 + hstep, voffB); PG8_STAGE_A(PG8_SA(1, 0), a3, 0);
            PG8_WAIT_V(8); PG8_WAIT_L(0); PG8_BAR; PG8_MMA(1, 0, At, B0); PG8_MMA(1, 1, At, B1); PG8_BAR; PG8_SCHED;
            } else {
            PG8_LDB(B0, 0, 0); PG8_SCHED; PG8_LDA(At, 0, 0); PG8_STAGE_A(PG8_SA(1, 1), a1, 1);
            if (last && has_next) { S.a_offs(ui + 1, nxt, tid, oc); Ab = (const char*)g.A + S.a_base(nxt); }
            const char* a2 = last ? Ab : Ab + (size_t)(t + 2) * kstep; const char* a3 = a2 + kstep;
            PG8_WAIT_L(8); PG8_BAR; PG8_WAIT_L(0); PG8_MMA(0, 0, At, B0); PG8_BAR; PG8_SCHED;
            PG8_LDB(B1, 0, 1); PG8_STAGE(PG8_SB(0, 0), b2, voffB);
            PG8_BAR; PG8_WAIT_L(0); PG8_MMA(0, 1, At, B1); PG8_BAR;
            PG8_LDA(At, 0, 1); PG8_STAGE_A(PG8_SA(0, 0), a2, 0);
            PG8_BAR; PG8_WAIT_L(0); PG8_MMA(1, 0, At, B0); PG8_BAR; PG8_SCHED;
            PG8_STAGE(PG8_SB(0, 1), b2 + hstep, voffB);
            PG8_WAIT_V(6); PG8_BAR; PG8_MMA(1, 1, At, B1); PG8_BAR;
            PG8_LDB(B0, 1, 0); PG8_SCHED; PG8_LDA(At, 1, 0); PG8_STAGE_A(PG8_SA(0, 1), a2, 1);
            PG8_WAIT_L(8); PG8_BAR; PG8_WAIT_L(0); PG8_MMA(0, 0, At, B0); PG8_BAR; PG8_SCHED;
            PG8_LDB(B1, 1, 1); PG8_STAGE(PG8_SB(1, 0), b3, voffB);
            PG8_BAR; PG8_WAIT_L(0); PG8_MMA(0, 1, At, B1); PG8_BAR;
            PG8_LDA(At, 1, 1); PG8_STAGE_A(PG8_SA(1, 0), a3, 0);
            PG8_BAR; PG8_WAIT_L(0); PG8_MMA(1, 0, At, B0); PG8_BAR; PG8_SCHED;
            PG8_STAGE(PG8_SB(1, 1), b3 + hstep, voffB);
            PG8_WAIT_V(6); PG8_BAR; PG8_MMA(1, 1, At, B1); PG8_BAR;
            }
        }
        if constexpr (ALIGN_EPI) { if (wr == 0) PG8_BAR; }
        if constexpr (FP8) asm volatile("s_nop 15\n\ts_nop 15\n\ts_nop 15" ::: "memory");
        E(acc, cur, wr, wc, fr, fq);
        if (!has_next) break;
#pragma unroll
        for (int a = 0; a < 2; ++a)
#pragma unroll
            for (int b = 0; b < 2; ++b)
#pragma unroll
                for (int m = 0; m < 4; ++m)
#pragma unroll
                    for (int n = 0; n < 2; ++n) acc[a][b][m][n] = (f32x4){0.f, 0.f, 0.f, 0.f};
        cur = nxt; cB = nB; ++ui;
        if constexpr (ALIGN_EPI) { if (wr == 1) PG8_BAR; }
    }
    PG8_WAIT_V(0);
    if constexpr (!ALIGN_EPI) { if (wr == 0) PG8_BAR; }
    PG8_BAR;
#undef PG8_SA
#undef PG8_SB
#undef PG8_STAGE
#undef PG8_STAGE_A
#undef PG8_LDA
#undef PG8_LDB
#undef PG8_MMA
#undef PG8_CAT
#undef PG8_WAIT_V
#undef PG8_WAIT_L
#undef PG8_BAR
#undef PG8_SCHED
}
}

#define XB_TMO      128
#define XB_XCNT(j)  (256  + 64 * (j))
#define XB_XSUB(j)  (1280 + 64 * (j))
#define XB_XGEN(j)  (2304 + 64 * (j))
#define XB_TOP      3328
#define XB_TOPGEN   3392
#define XCD_BAR_WORDS 3456
#define XB_SPIN_CAP (1u << 18)
__device__ __forceinline__ unsigned xb_ld(unsigned* p)              { return __hip_atomic_load(p, __ATOMIC_RELAXED, __HIP_MEMORY_SCOPE_AGENT); }
__device__ __forceinline__ unsigned xb_add(unsigned* p, unsigned v) { return __hip_atomic_fetch_add(p, v, __ATOMIC_RELAXED, __HIP_MEMORY_SCOPE_AGENT); }
__device__ __forceinline__ unsigned xb_xcc_id() { return (unsigned)__builtin_amdgcn_s_getreg((3 << 11) | 20) & 0xFu; }
#define XB_SPIN(cond, bar) do { unsigned _sp = 0; while (cond) { __builtin_amdgcn_s_sleep(1); \
    if ((++_sp & 255u) == 0u) { if (xb_ld(&(bar)[XB_TMO])) break; if (_sp > XB_SPIN_CAP) { atomicAdd(&(bar)[XB_TMO], 1u); break; } } } } while (0)
struct XcdBarrier { unsigned* bar; unsigned x; volatile LAS unsigned* st; };
__device__ __forceinline__ XcdBarrier xcd_barrier_post(unsigned* bar, volatile LAS unsigned* st) {
    XcdBarrier b; b.bar = bar; b.x = xb_xcc_id(); b.st = st;
    if (threadIdx.x == 0) (void)xb_add(&bar[XB_XCNT(b.x)], 1u);
    return b;
}
__device__ __forceinline__ void xcd_barrier_complete(unsigned* bar, unsigned x, unsigned& nloc, unsigned& nx) {
    const unsigned G = gridDim.x * gridDim.y * gridDim.z;
    unsigned sum, cnt, mine, sp = 0u;
    for (;;) {
        sum = 0u; cnt = 0u; mine = 0u;
#pragma unroll
        for (unsigned j = 0; j < 16; ++j) { const unsigned c = xb_ld(&bar[XB_XCNT(j)]); sum += c; cnt += (c > 0u) ? 1u : 0u; }
        mine = xb_ld(&bar[XB_XCNT(x)]);
        if (sum == G) break;
        __builtin_amdgcn_s_sleep(1);
        if ((++sp & 255u) == 0u) { if (xb_ld(&bar[XB_TMO])) break; if (sp > XB_SPIN_CAP) { atomicAdd(&bar[XB_TMO], 1u); break; } }
    }
    nloc = mine > 0u ? mine : 1u; nx = cnt > 0u ? cnt : 1u;
}
__device__ __forceinline__ void xcd_barrier(const XcdBarrier& b, bool leader) {
    asm volatile("s_waitcnt vmcnt(0)" ::: "memory");
    __syncthreads();
    if (leader) {
        unsigned* bar = b.bar;
        __builtin_amdgcn_s_waitcnt(0);
        unsigned nloc = b.st[0], nx = b.st[1];
        if (nloc == 0u) { xcd_barrier_complete(bar, b.x, nloc, nx); b.st[0] = nloc; b.st[1] = nx; }
        const unsigned old = xb_add(&bar[XB_XSUB(b.x)], 1u);
        const unsigned gen = old / nloc;
        if (old + 1u == (gen + 1u) * nloc) {
            __builtin_amdgcn_fence(__ATOMIC_RELEASE, "agent");
            asm volatile("s_waitcnt vmcnt(0)" ::: "memory");
            const unsigned og = xb_add(&bar[XB_TOP], 1u);
            const unsigned tg = og / nx;
            if (og + 1u == (tg + 1u) * nx) xb_add(&bar[XB_TOPGEN], 1u);
            else XB_SPIN(xb_ld(&bar[XB_TOPGEN]) == tg, bar);
            __builtin_amdgcn_fence(__ATOMIC_ACQUIRE, "agent");
            xb_add(&bar[XB_XGEN(b.x)], 1u);
            asm volatile("s_waitcnt vmcnt(0)" ::: "memory");
        } else {
            XB_SPIN(xb_ld(&bar[XB_XGEN(b.x)]) == gen, bar);
            __builtin_amdgcn_fence(__ATOMIC_ACQUIRE, "agent");
            asm volatile("s_waitcnt vmcnt(0)" ::: "memory");
        }
    }
    __syncthreads();
}

constexpr int NT = 512, NWAVES = 8;
struct Args { const float* in[24]; float* out; unsigned char* ws; int ph_lo, ph_hi; };
enum { I_X = 0, I_C, I_CTX, I_CCTX, I_WMOD, I_BMOD, I_WIN, I_WOUT, I_RPB, I_CONVW, I_CONVB, I_DTB, I_ALOG, I_DSKIP, I_NORMW, I_LNG, I_LNB, I_FG, I_FU, I_FD, I_RW, I_MG, I_MU, I_MD };
struct Frame {
    LAS unsigned char* lds;
    const float* const* in; float* out; unsigned char* ws;
    int tid, lane, wave, bid, G, gw, NGW;
};
#define LDS_WAIT() asm volatile("s_waitcnt lgkmcnt(0)" ::: "memory")
__device__ __forceinline__ Frame fresh(const Frame& F0) {
    Frame F = F0; int z; asm volatile("s_mov_b32 %0, 0" : "=s"(z)); F.ws = F0.ws + z; F.in = F0.in + z; F.out = F0.out + z;
    int ln; asm volatile("v_mbcnt_lo_u32_b32 %0, -1, 0\n\tv_mbcnt_hi_u32_b32 %0, -1, %0" : "=v"(ln));     int t = F0.wave * 64 + ln;
    F.tid = t; F.lane = t & 63; return F;
}

__device__ __forceinline__ void conv_item(const float* W, int ldn, int k0, int n0, bf16_t* dst, int K, int drow0, LAS float* scr, int lane) {
    f32x4 ld[8];
#pragma unroll
    for (int i = 0; i < 8; ++i) ld[i] = *(const f32x4*)(W + (size_t)(k0 + 8 * i + (lane >> 3)) * ldn + n0 + 4 * (lane & 7));
#pragma unroll
    for (int i = 0; i < 8; ++i) { LAS float* d = scr + (8 * i + (lane >> 3)) * 33 + 4 * (lane & 7); d[0] = ld[i][0]; d[1] = ld[i][1]; d[2] = ld[i][2]; d[3] = ld[i][3]; }
    LDS_WAIT(); asm volatile("" ::: "memory");
    const int c = lane & 7;
#pragma unroll
    for (int j = 0; j < 4; ++j) { const int n = (lane >> 3) + 8 * j; const LAS float* s = scr + (8 * c) * 33 + n;
        u32x4 o; o.x = pk2(s[0 * 33], s[1 * 33]); o.y = pk2(s[2 * 33], s[3 * 33]); o.z = pk2(s[4 * 33], s[5 * 33]); o.w = pk2(s[6 * 33], s[7 * 33]);
        *(u32x4*)(dst + (size_t)(drow0 + n) * K + k0 + 8 * c) = o; }
    LDS_WAIT(); asm volatile("" ::: "memory");
}
__device__ __forceinline__ void conv_item8(const float* W, int ldn, int k0, int n0, unsigned char* dst, int K, int drow0, float scale, LAS float* scr, int lane) {
    f32x4 ld[8];
#pragma unroll
    for (int i = 0; i < 8; ++i) ld[i] = *(const f32x4*)(W + (size_t)(k0 + 8 * i + (lane >> 3)) * ldn + n0 + 4 * (lane & 7));
#pragma unroll
    for (int i = 0; i < 8; ++i) { LAS float* d = scr + (8 * i + (lane >> 3)) * 33 + 4 * (lane & 7); d[0] = ld[i][0] * scale; d[1] = ld[i][1] * scale; d[2] = ld[i][2] * scale; d[3] = ld[i][3] * scale; }
    LDS_WAIT(); asm volatile("" ::: "memory");
    const int c = lane & 7;
#pragma unroll
    for (int j = 0; j < 4; ++j) { const int n = (lane >> 3) + 8 * j; const LAS float* sp = scr + (8 * c) * 33 + n;
        u32x2 o; o.x = pk8(sp[0 * 33], sp[1 * 33], sp[2 * 33], sp[3 * 33]); o.y = pk8(sp[4 * 33], sp[5 * 33], sp[6 * 33], sp[7 * 33]);
        *(u32x2*)(dst + (size_t)(drow0 + n) * K + k0 + 8 * c) = o; }
    LDS_WAIT(); asm volatile("" ::: "memory");
}
__device__ __forceinline__ void conv_seg(const Frame& F, const float* W, int K, int ldn, int ncols, bf16_t* dst, int mode, int& rot, int s8 = -1) {
    LAS float* scr = (LAS float*)(F.lds + F.wave * 16384);
    const int nblk = ncols / 32, nitems = (K / 64) * nblk;
    int start = F.gw - rot; if (start < 0) start += F.NGW;
    for (int it = start; it < nitems; it += F.NGW) {
        const int kb = it / nblk, nb = it % nblk, n0 = nb * 32;
        const int drow0 = (mode == 0) ? n0 : ((n0 >> 7) * 256 + (n0 & 127) + (mode == 2 ? 128 : 0));
        if (s8 >= 0) conv_item8(W, ldn, kb * 64, n0, (unsigned char*)dst, K, drow0, (float)(1 << s8), scr, F.lane);
        else conv_item(W, ldn, kb * 64, n0, dst, K, drow0, scr, F.lane);
    }
    rot = (rot + nitems) % F.NGW;
}
__device__ __forceinline__ void conv_moe(const Frame& F, int slot, int& rot) {
#if USE_FP8
    unsigned char* gu = F.ws + WS_WMGU + (size_t)slot * NEXP * 2 * DFFE * D; unsigned char* dn = F.ws + WS_WMD + (size_t)slot * NEXP * D * DFFE;
    for (int e = 0; e < NEXP; ++e) {
        const size_t so = ((size_t)slot * NEXP + e) * (size_t)D * DFFE;
        conv_seg(F, F.in[I_MG] + so, D, DFFE, DFFE, (bf16_t*)(gu + (size_t)e * 2 * DFFE * D), 1, rot, S8_WGU);
        conv_seg(F, F.in[I_MU] + so, D, DFFE, DFFE, (bf16_t*)(gu + (size_t)e * 2 * DFFE * D), 2, rot, S8_WGU);
        conv_seg(F, F.in[I_MD] + so, DFFE, D, D, (bf16_t*)(dn + (size_t)e * D * DFFE), 0, rot, S8_WD);
    }
#else
    bf16_t* gu = (bf16_t*)(F.ws + WS_WMGU); bf16_t* dn = (bf16_t*)(F.ws + WS_WMD);
    for (int e = 0; e < NEXP; ++e) {
        const size_t so = ((size_t)slot * NEXP + e) * (size_t)D * DFFE;
        conv_seg(F, F.in[I_MG] + so, D, DFFE, DFFE, gu + (size_t)e * 2 * DFFE * D, 1, rot);
        conv_seg(F, F.in[I_MU] + so, D, DFFE, DFFE, gu + (size_t)e * 2 * DFFE * D, 2, rot);
        conv_seg(F, F.in[I_MD] + so, DFFE, D, D, dn + (size_t)e * D * DFFE, 0, rot);
    }
#endif
}

constexpr int MOE_ITEMS_MAT = 1792, MOE_ITEMS_EXP = 3 * MOE_ITEMS_MAT, MOE_ITEMS_SLOT = 8 * MOE_ITEMS_EXP, MOE_ITEMS = 2 * MOE_ITEMS_SLOT;
__device__ __forceinline__ void conv_moe_item(const Frame& F, int gidx) {
    LAS float* scr = (LAS float*)(F.lds + F.wave * 16384);
    const int slot = gidx / MOE_ITEMS_SLOT, r = gidx % MOE_ITEMS_SLOT, e = r / MOE_ITEMS_EXP, r2 = r % MOE_ITEMS_EXP, mat = r2 / MOE_ITEMS_MAT, it = r2 % MOE_ITEMS_MAT;
    const size_t so = ((size_t)slot * NEXP + e) * (size_t)D * DFFE;
    if (mat < 2) { const int kb = it / 112, nb = it % 112, n0 = nb * 32; const int drow0 = (n0 >> 7) * 256 + (n0 & 127) + (mat == 1 ? 128 : 0);
        conv_item8((mat ? F.in[I_MU] : F.in[I_MG]) + so, DFFE, kb * 64, n0, F.ws + WS_WMGU + ((size_t)slot * NEXP + e) * 2 * DFFE * D, D, drow0, (float)(1 << S8_WGU), scr, F.lane); }
    else { const int kb = it / 32, nb = it % 32, n0 = nb * 32;
        conv_item8(F.in[I_MD] + so, D, kb * 64, n0, F.ws + WS_WMD + ((size_t)slot * NEXP + e) * D * DFFE, DFFE, n0, (float)(1 << S8_WD), scr, F.lane); }
}
__device__ __forceinline__ void deferred_conv(const Frame& F, int nwg, int base, int quota) {
    if (F.G != 256) return;
    const int maxu = (nwg + F.G - 1) / F.G, c0 = nwg - (maxu - 1) * F.G;
    if (c0 >= F.G || F.bid < c0) return;
    const int first = base + ((F.bid - c0) * NWAVES + F.wave) * quota;
    for (int j = 0; j < quota; ++j) { const int gidx = first + j; if (gidx < MOE_ITEMS) conv_moe_item(F, gidx); }
}
constexpr int DW_Q = 12, DW_Q2 = 16;
constexpr int DW_L0_IN = 0, DW_L0_OUT = DW_L0_IN + 64 * 8 * DW_Q, DW_L0_F1 = DW_L0_OUT + 192 * 8 * DW_Q, DW_L0_F2 = DW_L0_F1 + 160 * 8 * DW_Q, DW_L1_IN = DW_L0_F2 + 192 * 8 * DW_Q2, DW_L1_OUT = DW_L1_IN + 64 * 8 * DW_Q, DW_END = DW_L1_OUT + 192 * 8 * DW_Q;
static_assert(DW_L1_IN >= MOE_ITEMS_SLOT && DW_END >= MOE_ITEMS, "deferred conversion: layer-1 experts must be done before layer 1's FFN, all before layer 3's");
__device__ __forceinline__ void p_pro_a(const Frame& F) {
    {
        LAS float* sc = (LAS float*)F.lds; LAS float* red = sc + 17 * 1024;
        const float* c = F.in[I_C]; const float* cc = F.in[I_CCTX];
        for (int i = F.tid; i < 17 * 1024; i += NT) { const int r = i >> 10, k = i & 1023; const float v = (r < 16) ? c[r * 1024 + k] : cc[k]; sc[i] = silu_f(v); }
        __syncthreads();
        float* MOD = (float*)(F.ws + WS_MOD);
        const int col = F.tid & 31, ks = F.tid >> 5;
        for (int u = F.bid; u < 4 * 192; u += F.G) {
            const int l = u / 192, cb = u % 192;
            const float* W = F.in[I_WMOD] + (size_t)l * D * MODW + cb * 32 + col;
            float acc[17];
#pragma unroll
            for (int r = 0; r < 17; ++r) acc[r] = 0.f;
#pragma unroll 1
            for (int kb = 0; kb < 4; ++kb) { float w[16];
#pragma unroll
                for (int i = 0; i < 16; ++i) w[i] = W[(size_t)(ks * 64 + kb * 16 + i) * MODW];
#pragma unroll
                for (int i = 0; i < 16; ++i) { const int k = ks * 64 + kb * 16 + i;
#pragma unroll
                    for (int r = 0; r < 17; ++r) acc[r] += sc[r * 1024 + k] * w[i]; } }
#pragma unroll
            for (int r = 0; r < 17; ++r) red[(ks * 17 + r) * 32 + col] = acc[r];
            __syncthreads();
            for (int i = F.tid; i < 17 * 32; i += NT) { const int r = i >> 5, c2 = i & 31; float sm = 0.f;
#pragma unroll
                for (int k2 = 0; k2 < 16; ++k2) sm += red[(k2 * 17 + r) * 32 + c2];
                MOD[(size_t)(l * 17 + r) * MODW + cb * 32 + c2] = sm + F.in[I_BMOD][l * MODW + cb * 32 + c2]; }
            __syncthreads();
        }
    }
    int rot = 0;
    for (int l = 0; l < DEPTH; ++l) {
#if USE_FP8 && FP8_INPROJ
        conv_seg(F, F.in[I_WIN] + (size_t)l * D * D_IN_PROJ, D, D_IN_PROJ, NPROJ, (bf16_t*)(F.ws + WS_WIN + (size_t)l * NPROJ * D), 0, rot, S8_WGU);
#else
        conv_seg(F, F.in[I_WIN] + (size_t)l * D * D_IN_PROJ, D, D_IN_PROJ, NPROJ, (bf16_t*)(F.ws + WS_WIN) + (size_t)l * NPROJ * D, 0, rot);
#endif
        conv_seg(F, F.in[I_WOUT] + (size_t)l * D * D, D, D, D, (bf16_t*)(F.ws + WS_WOUT) + (size_t)l * D * D, 0, rot);
    }
    for (int s = 0; s < 2; ++s) {
#if USE_FP8 && FP8_DENSE
        conv_seg(F, F.in[I_FG] + (size_t)s * D * DFF, D, DFF, DFF, (bf16_t*)(F.ws + WS_WFGU + (size_t)s * 2 * DFF * D), 1, rot, S8_WGU);
        conv_seg(F, F.in[I_FU] + (size_t)s * D * DFF, D, DFF, DFF, (bf16_t*)(F.ws + WS_WFGU + (size_t)s * 2 * DFF * D), 2, rot, S8_WGU);
        conv_seg(F, F.in[I_FD] + (size_t)s * DFF * D, DFF, D, D, (bf16_t*)(F.ws + WS_WFD + (size_t)s * D * DFF), 0, rot, S8_WD);
#else
        conv_seg(F, F.in[I_FG] + (size_t)s * D * DFF, D, DFF, DFF, (bf16_t*)(F.ws + WS_WFGU) + (size_t)s * 2 * DFF * D, 1, rot);
        conv_seg(F, F.in[I_FU] + (size_t)s * D * DFF, D, DFF, DFF, (bf16_t*)(F.ws + WS_WFGU) + (size_t)s * 2 * DFF * D, 2, rot);
        conv_seg(F, F.in[I_FD] + (size_t)s * DFF * D, DFF, D, D, (bf16_t*)(F.ws + WS_WFD) + (size_t)s * D * DFF, 0, rot);
#endif
    }
    if (F.G != 256) { conv_moe(F, 0, rot); conv_moe(F, 1, rot); }
    { bf16_t* wdt = (bf16_t*)(F.ws + WS_WDT);
      for (int i = F.bid * NT + F.tid; i < DEPTH * 16 * D; i += F.G * NT) { const int l = i / (16 * D), n = (i / D) & 15, k = i % D;
          wdt[i] = (bf16_t)f2bf(F.in[I_WIN][((size_t)l * D + k) * D_IN_PROJ + NPROJ + n]); } }
}

#define RIDX(q) (8 * lane + 512 * ((q) >> 1) + 4 * ((q) & 1))
__device__ __forceinline__ void row_load(const float* p, int lane, f32x4 (&v)[4]) {
#pragma unroll
    for (int q = 0; q < 4; ++q) v[q] = *(const f32x4*)(p + RIDX(q));
}
__device__ __forceinline__ void row_store(float* p, int lane, const f32x4 (&v)[4]) {
#pragma unroll
    for (int q = 0; q < 4; ++q) *(f32x4*)(p + RIDX(q)) = v[q];
}
__device__ __forceinline__ void row_mod_store8(unsigned char* hrow, int lane, const f32x4 (&v)[4], const float* sh, const float* sc, f32x4 (&hv)[4]) {
#pragma unroll
    for (int j = 0; j < 2; ++j) { u32x2 w;
#pragma unroll
        for (int h = 0; h < 2; ++h) { const int q = 2 * j + h; const f32x4 a = *(const f32x4*)(sc + RIDX(q)), b = *(const f32x4*)(sh + RIDX(q));
            hv[q] = v[q] * (a + 1.0f) + b; const f32x4 t = hv[q] * (float)(1 << S8_ACT); const unsigned pw = pk8(t[0], t[1], t[2], t[3]); if (h == 0) w.x = pw; else w.y = pw; }
        *(u32x2*)(hrow + 8 * lane + 512 * j) = w; }
}
__device__ __forceinline__ void row_load_h(const bf16_t* p, int lane, f32x4 (&v)[4]) {
#pragma unroll
    for (int j = 0; j < 2; ++j) { const u32x4 w = *(const u32x4*)(p + 8 * lane + 512 * j); v[2 * j] = (f32x4){bflo(w.x), bfhi(w.x), bflo(w.y), bfhi(w.y)}; v[2 * j + 1] = (f32x4){bflo(w.z), bfhi(w.z), bflo(w.w), bfhi(w.w)}; }
}
__device__ __forceinline__ void row_store_h(bf16_t* p, int lane, const f32x4 (&v)[4]) {
#pragma unroll
    for (int j = 0; j < 2; ++j) { u32x4 w; w.x = pk2(v[2 * j][0], v[2 * j][1]); w.y = pk2(v[2 * j][2], v[2 * j][3]); w.z = pk2(v[2 * j + 1][0], v[2 * j + 1][1]); w.w = pk2(v[2 * j + 1][2], v[2 * j + 1][3]);
        *(u32x4*)(p + 8 * lane + 512 * j) = w; }
}
__device__ __forceinline__ void row_mod_store(bf16_t* hrow, int lane, const f32x4 (&v)[4], const float* sh, const float* sc, f32x4 (&hv)[4]) {
#pragma unroll
    for (int q = 0; q < 4; ++q) { const f32x4 a = *(const f32x4*)(sc + RIDX(q)), b = *(const f32x4*)(sh + RIDX(q)); hv[q] = v[q] * (a + 1.0f) + b; }
    row_store_h(hrow, lane, hv);
}
__device__ __forceinline__ void row_ln(f32x4 (&v)[4], const float* g, const float* b, int lane) {
    float s = 0.f;
#pragma unroll
    for (int j = 0; j < 4; ++j) s += (v[j][0] + v[j][1]) + (v[j][2] + v[j][3]);
    const float mean = wave_sum(s) * (1.0f / D); float q2 = 0.f;
#pragma unroll
    for (int j = 0; j < 4; ++j) { v[j] = v[j] - mean; q2 += (v[j][0] * v[j][0] + v[j][1] * v[j][1]) + (v[j][2] * v[j][2] + v[j][3] * v[j][3]); }
    const float rstd = 1.0f / sqrtf(wave_sum(q2) * (1.0f / D) + LN_EPS);
#pragma unroll
    for (int q = 0; q < 4; ++q) { const f32x4 gg = *(const f32x4*)(g + RIDX(q)), bb = *(const f32x4*)(b + RIDX(q)); v[q] = v[q] * rstd * gg + bb; }
}
__device__ __forceinline__ int mod_row_of(int row) { return row < NLAT ? (row >> 11) : 16; }

__device__ __forceinline__ void p_pro_b(const Frame& F) {
    const float* MOD = (const float*)(F.ws + WS_MOD); bf16_t* H = (bf16_t*)(F.ws + WS_H);
    for (int row = F.gw; row < NTOK; row += F.NGW) {
        const float* src = row < NLAT ? F.in[I_X] + (size_t)row * D : F.in[I_CTX] + (size_t)(row - NLAT) * D;
        f32x4 v[4], hv[4]; row_load(src, F.lane, v);
        const float* m = MOD + (size_t)mod_row_of(row) * MODW;
        row_mod_store(H + (size_t)row * D, F.lane, v, m, m + D, hv);
    }
}

__device__ __forceinline__ void p_inproj(const Frame& F, int layer) {
    const bf16_t* H = (const bf16_t*)(F.ws + WS_H);
    {
        const bf16_t* wdt = (const bf16_t*)(F.ws + WS_WDT) + (size_t)layer * 16 * D; float* DT = (float*)(F.ws + WS_DT);
        const int fr = F.lane & 15, fq = F.lane >> 4; const float dtb = F.in[I_DTB][layer * 16 + fr];
        for (int g = F.gw; g < NTOK / 16; g += F.NGW) {
            f32x4 acc = {0.f, 0.f, 0.f, 0.f};
            const bf16_t* ap = H + (size_t)(g * 16 + fr) * D + fq * 8; const bf16_t* bp = wdt + (size_t)fr * D + fq * 8;
#pragma unroll 8
            for (int ks = 0; ks < 32; ++ks) { const bf16x8 a = *(const bf16x8*)(ap + ks * 32), b = *(const bf16x8*)(bp + ks * 32);
                acc = __builtin_amdgcn_mfma_f32_16x16x32_bf16(a, b, acc, 0, 0, 0); }
#pragma unroll
            for (int r = 0; r < 4; ++r) { const float x = acc[r] + dtb; DT[(size_t)(g * 16 + fq * 4 + r) * 16 + fr] = x > 20.f ? x : log1pf(__expf(x)); }
        }
    }
    pg8::EpiBf16 E{(bf16_t*)(F.ws + WS_PROJ), NPROJ};
#if USE_FP8 && FP8_INPROJ
    pg8::Gemm g{(const bf16_t*)(F.ws + WS_H8IN), (const bf16_t*)(F.ws + WS_WIN + (size_t)layer * NPROJ * D), D / 2};
    pg8::DenseOrder S; S.init(NTOK, NPROJ, D / 2, F.G, F.bid, REP_GEMM);
    pg8::gemm_phase<pg8::EpiBf16, pg8::DenseOrder, true, FP8_SP2, true>(F.lds, g, S, E, F.tid, (127 - S8_WGU) * 0x01010101, (127 - S8_ACT) * 0x01010101);
#else
    pg8::Gemm g{H, (const bf16_t*)(F.ws + WS_WIN) + (size_t)layer * NPROJ * D, D};
    pg8::DenseOrder S; S.init(NTOK, NPROJ, D, F.G, F.bid, REP_GEMM);
    pg8::gemm_phase<pg8::EpiBf16, pg8::DenseOrder, true, true>(F.lds, g, S, E, F.tid);
#endif
    if (layer == 0) deferred_conv(F, (NTOK / 256) * (NPROJ / 256), DW_L0_IN, DW_Q); else if (layer == 1) deferred_conv(F, (NTOK / 256) * (NPROJ / 256), DW_L1_IN, DW_Q);
}

typedef short s16x4 __attribute__((ext_vector_type(4)));
__device__ __forceinline__ s16x4 lds_tr16(LAS const unsigned char* p) { return __builtin_bit_cast(s16x4, __builtin_amdgcn_ds_read_tr16_b64_v4i16((LAS s16x4*)p)); }
constexpr int NA_KS = 144;
constexpr float LOG2E = 1.4426950408889634f;
__device__ __forceinline__ void na_unit(const Frame& F, int layer, int b, int h, int mode, int m) {
    LAS unsigned char* KV = F.lds;
    LAS float* rp = (LAS float*)(F.lds + 120832);
    const bf16_t* PROJ = (const bf16_t*)(F.ws + WS_PROJ); bf16_t* MIX = (bf16_t*)(F.ws + WS_MIX);
    const int tid = F.tid, lane = F.lane, w = F.wave, q16 = lane & 15, g = lane >> 4;
    int rbase = 0, nk = 0;
    if (mode == 0) { rbase = 2 * m - 4; rbase = rbase < 0 ? 0 : (rbase > 24 ? 24 : rbase); nk = 32 - rbase; nk = nk > 9 ? 9 : nk; }
    const int kfirst = (mode == 0) ? 0 : 576 * 8, nloc8 = nk * 64 * 8;
#define NA_STAGE(OFFS) do { int stid_ = tid; asm volatile("" : "+v"(stid_));     \
        NA_STAGE_PART(OFFS, 0, 7); __builtin_amdgcn_sched_barrier(0); NA_STAGE_PART(OFFS, 7, 13); __builtin_amdgcn_sched_barrier(0); } while (0)
#define NA_STAGE_PART(OFFS, K0, K1) do { u32x4 st_[13]; \
        _Pragma("unroll") for (int k_ = K0; k_ < K1; ++k_) { const int i_ = stid_ + kfirst + k_ * NT, key_ = i_ >> 3, ch_ = i_ & 7; const bool ok_ = (i_ < 832 * 8) && !(key_ < 576 && i_ >= nloc8); \
            const int grow_ = key_ < 576 ? b * SEQ + rbase * 64 + key_ : NLAT + b * CTX + (key_ - 576); \
            st_[k_] = ok_ ? *(const u32x4*)(PROJ + (size_t)grow_ * NPROJ + (OFFS) + h * 64 + ch_ * 8) : (u32x4){0u, 0u, 0u, 0u}; } \
        _Pragma("unroll") for (int k_ = K0; k_ < K1; ++k_) { const int i_ = stid_ + kfirst + k_ * NT, key_ = i_ >> 3, ch_ = i_ & 7; const bool ok_ = (i_ < 832 * 8) && !(key_ < 576 && i_ >= nloc8); \
            if (ok_) *(LAS u32x4*)(KV + key_ * NA_KS + ch_ * 16) = st_[k_]; } } while (0)
    __syncthreads();
    NA_STAGE(OFF_K);
    if (mode == 0 && tid < 465) rp[tid] = F.in[I_RPB][(size_t)(layer * 8 + h) * 465 + tid] * LOG2E;
    __syncthreads();
    int i = 0, j0 = 0, hs = 0, kr0 = 0, qrow;
    if (mode == 0) { i = 2 * m + (w >> 2); j0 = (w & 3) * 16; qrow = b * SEQ + i * 64 + j0; hs = j0 - 8; hs = hs < 0 ? 0 : (hs > 32 ? 32 : hs);
        int r0 = i - 4; r0 = r0 < 0 ? 0 : (r0 > 24 ? 24 : r0); kr0 = r0 - rbase; }
    else qrow = NLAT + b * CTX + m * 128 + w * 16;
    bf16x8 qf[2];
#pragma unroll
    for (int ks = 0; ks < 2; ++ks) qf[ks] = *(const bf16x8*)(PROJ + (size_t)(qrow + q16) * NPROJ + h * 64 + ks * 32 + g * 8);
    f32x4 S[32];
    const LAS unsigned char* kb = KV + q16 * NA_KS + g * 16;
    if (mode == 0) {
        const int j = j0 + q16; int cs = j - 8; cs = cs < 0 ? 0 : (cs > 48 ? 48 : cs);
        const int rb0 = (kr0 + rbase) - i + 7;
#pragma unroll
        for (int tl = 0; tl < 16; ++tl) { const int kr = tl >> 1, half = tl & 1; const int kidx0 = (kr0 + kr) * 64 + hs + 16 * half;
            f32x4 a = {0.f, 0.f, 0.f, 0.f};
#pragma unroll
            for (int ks = 0; ks < 2; ++ks) { const bf16x8 kf = *(const LAS bf16x8*)(kb + kidx0 * NA_KS + ks * 64); a = __builtin_amdgcn_mfma_f32_16x16x32_bf16(kf, qf[ks], a, 0, 0, 0); }
#pragma unroll
            for (int r = 0; r < 4; ++r) { const int kc = hs + 16 * half + 4 * g + r; const bool inw = (kc >= cs) && (kc < cs + 16);
                int cbi = kc - j + 15; cbi = cbi < 0 ? 0 : (cbi > 30 ? 30 : cbi);
                a[r] = inw ? a[r] * (0.125f * LOG2E) + rp[(rb0 + kr) * 31 + cbi] : -INFINITY; }
            S[tl] = a; if ((tl & 1) == 1) __builtin_amdgcn_sched_barrier(0); }
    } else {
#pragma unroll
        for (int tl = 0; tl < 16; ++tl) S[tl] = (f32x4){-INFINITY, -INFINITY, -INFINITY, -INFINITY};
    }
#pragma unroll
    for (int tc = 0; tc < 16; ++tc) { const int kidx0 = 576 + 16 * tc; f32x4 a = {0.f, 0.f, 0.f, 0.f};
#pragma unroll
        for (int ks = 0; ks < 2; ++ks) { const bf16x8 kf = *(const LAS bf16x8*)(kb + kidx0 * NA_KS + ks * 64); a = __builtin_amdgcn_mfma_f32_16x16x32_bf16(kf, qf[ks], a, 0, 0, 0); }
        S[16 + tc] = a * (0.125f * LOG2E); if ((tc & 1) == 1) __builtin_amdgcn_sched_barrier(0); }
    float mx = -INFINITY;
#pragma unroll
    for (int t = 0; t < 32; ++t) mx = fmaxf(fmaxf(fmaxf(S[t][0], S[t][1]), fmaxf(S[t][2], S[t][3])), mx);
    mx = fmaxf(mx, __shfl_xor(mx, 16)); mx = fmaxf(mx, __shfl_xor(mx, 32));
    float sum = 0.f; u32x4 P[16];
#pragma unroll
    for (int kk = 0; kk < 16; ++kk) { float e[8];
#pragma unroll
        for (int r = 0; r < 4; ++r) { e[r] = __builtin_amdgcn_exp2f(S[2 * kk][r] - mx); e[4 + r] = __builtin_amdgcn_exp2f(S[2 * kk + 1][r] - mx); }
        sum += ((e[0] + e[1]) + (e[2] + e[3])) + ((e[4] + e[5]) + (e[6] + e[7]));
        P[kk].x = pg8::cvt_pk_bf16_pin(e[0], e[1]); P[kk].y = pg8::cvt_pk_bf16_pin(e[2], e[3]); P[kk].z = pg8::cvt_pk_bf16_pin(e[4], e[5]); P[kk].w = pg8::cvt_pk_bf16_pin(e[6], e[7]); }
    sum += __shfl_xor(sum, 16); sum += __shfl_xor(sum, 32);
    const float inv = 1.0f / sum;
    __syncthreads();
    NA_STAGE(OFF_V);
    __syncthreads();
    f32x4 o[4];
#pragma unroll
    for (int dt = 0; dt < 4; ++dt) o[dt] = (f32x4){0.f, 0.f, 0.f, 0.f};
    const LAS unsigned char* vb = KV + (4 * g + (q16 >> 2)) * NA_KS + (q16 & 3) * 8;
#pragma unroll
    for (int kk = 0; kk < 16; ++kk) {
        if (kk < 8 && mode != 0) continue;
        const int kidx0 = (kk < 8) ? (kr0 + kk) * 64 + hs : 576 + 32 * (kk - 8);
        const bf16x8 pa = __builtin_bit_cast(bf16x8, P[kk]);
#pragma unroll
        for (int dt = 0; dt < 4; ++dt) { const s16x4 lo = lds_tr16(vb + kidx0 * NA_KS + dt * 32), hi = lds_tr16(vb + (kidx0 + 16) * NA_KS + dt * 32);
            const bf16x8 vf = {lo[0], lo[1], lo[2], lo[3], hi[0], hi[1], hi[2], hi[3]};
            o[dt] = __builtin_amdgcn_mfma_f32_16x16x32_bf16(pa, vf, o[dt], 0, 0, 0); }
    }
#undef NA_STAGE
#undef NA_STAGE_PART
#pragma unroll
    for (int r = 0; r < 4; ++r) { const float ir = __shfl(inv, 4 * g + r);
        bf16_t* op = MIX + (size_t)(qrow + 4 * g + r) * D + h * 64 + q16;
#pragma unroll
        for (int dt = 0; dt < 4; dt += 2) { const unsigned pw = pk2(o[dt][r] * ir, o[dt + 1][r] * ir); op[dt * 16] = (bf16_t)(pw & 0xffffu); op[dt * 16 + 16] = (bf16_t)(pw >> 16); } }
}

struct PrepassW { f32x4 w[5][2]; f32x4 b[2]; float ifq[8]; };
__device__ __forceinline__ void ssd_prepass_unit(const Frame& F, int u, const PrepassW& W) {
    const bf16_t* PROJ = (const bf16_t*)(F.ws + WS_PROJ); bf16_t* U = (bf16_t*)(F.ws + WS_U);
    int rowbase, t0, L; bool lat;
    if (u < NLAT / 16) { rowbase = (u >> 7) * SEQ; t0 = (u & 127) * 16; L = SEQ; lat = true; }
    else { const int v = u - NLAT / 16; rowbase = NLAT + (v >> 4) * CTX; t0 = (v & 15) * 16; L = CTX; lat = false; }
    const int cg = F.tid & 127, tq = F.tid >> 7, c0 = 8 * cg, tb = t0 + 4 * tq;
    u32x4 win[8];
#pragma unroll
    for (int j = 0; j < 8; ++j) { const int t = tb - 2 + j; win[j] = (t >= 0 && t < L) ? *(const u32x4*)(PROJ + (size_t)(rowbase + t) * NPROJ + OFF_XBC + c0) : (u32x4){0u, 0u, 0u, 0u}; }
    const int lc = c0 & 127, hf = lc >> 6, role = (lc >> 5) & 1; const bool rope = lat && (c0 >= 512);
#pragma unroll
    for (int tt = 0; tt < 4; ++tt) {
        f32x4 a0 = W.b[0], a1 = W.b[1];
#pragma unroll
        for (int j = 0; j < 5; ++j) { const u32x4 r = win[tt + j];
            a0 += W.w[j][0] * (f32x4){bflo(r.x), bfhi(r.x), bflo(r.y), bfhi(r.y)}; a1 += W.w[j][1] * (f32x4){bflo(r.z), bfhi(r.z), bflo(r.w), bfhi(r.w)}; }
        float uu[8];
#pragma unroll
        for (int k = 0; k < 4; ++k) { uu[k] = silu_f(a0[k]); uu[4 + k] = silu_f(a1[k]); }
        if (rope) {
            const int tk = tb + tt; const float pos = (float)(hf ? (tk & 63) : (tk >> 6));
#pragma unroll
            for (int k = 0; k < 8; ++k) { const float o = __shfl_xor(uu[k], 4); const float sn = __builtin_amdgcn_sinf(pos * W.ifq[k]), cs = __builtin_amdgcn_cosf(pos * W.ifq[k]);
                uu[k] = role ? (o * sn + uu[k] * cs) : (uu[k] * cs - o * sn); }
        }
        u32x4 o; o.x = pk2(uu[0], uu[1]); o.y = pk2(uu[2], uu[3]); o.z = pk2(uu[4], uu[5]); o.w = pk2(uu[6], uu[7]);
        *(u32x4*)(U + (size_t)(rowbase + tb + tt) * 1024 + c0) = o;
    }
}
__device__ __forceinline__ void ssd_prepass_weights(const Frame& F, int layer, PrepassW& W) {
    const int c0 = 8 * (F.tid & 127);
    const float* cwp = F.in[I_CONVW] + (size_t)layer * 5 * 1024 + c0;
#pragma unroll
    for (int j = 0; j < 5; ++j) { W.w[j][0] = *(const f32x4*)(cwp + j * 1024); W.w[j][1] = *(const f32x4*)(cwp + j * 1024 + 4); }
    W.b[0] = *(const f32x4*)(F.in[I_CONVB] + (size_t)layer * 1024 + c0); W.b[1] = *(const f32x4*)(F.in[I_CONVB] + (size_t)layer * 1024 + c0 + 4);
    const int n0 = c0 & 31;
#pragma unroll
    for (int k = 0; k < 8; ++k) W.ifq[k] = __builtin_amdgcn_exp2f(-(float)(n0 + k) * (13.287712379549449f / 32.0f)) * 0.15915494309189535f;
}

constexpr int S_CQ = 0, S_BQ = 17408, S_BT = 34816, S_XT = 53248, S_MQ = 62464, S_HB = 71680, S_MISC = 106496;
__device__ __forceinline__ void ssd_mfma_unit(const Frame& F, int layer, int b, int h, int dir) {
    const int g = h >> 2, tid = F.tid, lane = F.lane, w = F.wave, q16 = lane & 15, gq = lane >> 4;
    const bf16_t* U = (const bf16_t*)(F.ws + WS_U); const float* DTS = (const float*)(F.ws + WS_DT);
    bf16_t* Y = (bf16_t*)(F.ws + (dir ? WS_YB : WS_YF));
    const float aneg = -__expf(F.in[I_ALOG][layer * 16 + dir * 8 + h]), dsk = F.in[I_DSKIP][layer * 8 + h];
    LAS unsigned char* L = F.lds;
    __syncthreads();
    for (int i = tid; i < 64 * 272 / 16; i += NT) *(LAS u32x4*)(L + S_HB + i * 16) = (u32x4){0u, 0u, 0u, 0u};
    f32x4 Hacc[4];
#pragma unroll
    for (int j = 0; j < 4; ++j) Hacc[j] = (f32x4){0.f, 0.f, 0.f, 0.f};
    u32x4 px, pb[2], pc[2];
    const int xl = lane, xc = w;
    float pdt = 0.f;
#define SSD_ROW(ci_, l_) ({ const int s_ = (ci_) < 4 ? 0 : 1, k_ = s_ ? (ci_) - 4 : (ci_), nc_ = s_ ? 32 : 4, c_ = dir ? nc_ - 1 - k_ : k_; \
        (s_ ? b * SEQ : NLAT + b * CTX) + c_ * 64 + (dir ? 63 - (l_) : (l_)); })
#define SSD_PREFETCH(ci_) do { px = *(const u32x4*)(U + (size_t)SSD_ROW(ci_, xl) * 1024 + h * 64 + xc * 8); \
        if (w == 0) pdt = DTS[(size_t)SSD_ROW(ci_, lane) * 16 + dir * 8 + h]; \
        _Pragma("unroll") for (int k_ = 0; k_ < 2; ++k_) { const int l_ = lane, c16_ = w + 8 * k_; const size_t ro_ = (size_t)SSD_ROW(ci_, l_) * 1024; \
            pb[k_] = *(const u32x4*)(U + ro_ + 512 + g * 128 + c16_ * 8); pc[k_] = *(const u32x4*)(U + ro_ + 768 + g * 128 + c16_ * 8); } } while (0)
    SSD_PREFETCH(0);
    int par = 0;
    for (int ci = 0; ci < 36; ++ci) {
        LAS float* misc = (LAS float*)(L + S_MISC) + par * 272;
        if (w == 0) {
            const float dt = pdt; float cs = dt * aneg;
#pragma unroll
            for (int o = 1; o < 64; o <<= 1) { const float v = __shfl_up(cs, o); cs += (lane >= o) ? v : 0.f; }
            const float tot = __shfl(cs, 63);
            misc[lane] = dt; misc[64 + lane] = cs; misc[128 + lane] = __expf(cs); misc[192 + lane] = __expf(tot - cs) * dt; if (lane == 0) misc[256] = __expf(tot);
        }
        __syncthreads();
        {
            const unsigned xw[4] = {px.x, px.y, px.z, px.w};
#pragma unroll
            for (int e = 0; e < 4; ++e) { *(LAS unsigned short*)(L + S_XT + (xc * 8 + 2 * e) * 144 + xl * 2) = (unsigned short)(xw[e] & 0xffffu); *(LAS unsigned short*)(L + S_XT + (xc * 8 + 2 * e + 1) * 144 + xl * 2) = (unsigned short)(xw[e] >> 16); }
#pragma unroll
            for (int k = 0; k < 2; ++k) { const int l = lane, c16 = w + 8 * k; const float wl = misc[192 + l];
                *(LAS u32x4*)(L + S_BQ + l * 272 + c16 * 16) = pb[k]; *(LAS u32x4*)(L + S_CQ + l * 272 + c16 * 16) = pc[k];
                const unsigned bw[4] = {pb[k].x, pb[k].y, pb[k].z, pb[k].w};
#pragma unroll
                for (int e = 0; e < 4; ++e) { const unsigned pw = pk2(bflo(bw[e]) * wl, bfhi(bw[e]) * wl);
                    *(LAS unsigned short*)(L + S_BT + (c16 * 8 + 2 * e) * 144 + l * 2) = (unsigned short)(pw & 0xffffu); *(LAS unsigned short*)(L + S_BT + (c16 * 8 + 2 * e + 1) * 144 + l * 2) = (unsigned short)(pw >> 16); } }
        }
        if (ci + 1 < 36) SSD_PREFETCH(ci + 1);
        __syncthreads();
        const int lt = w >> 1, t2 = (w & 1) * 2;
        bf16x8 cfr[4];
#pragma unroll
        for (int ks = 0; ks < 4; ++ks) cfr[ks] = *(const LAS bf16x8*)(L + S_CQ + (16 * lt + q16) * 272 + ks * 64 + gq * 16);
        {
            const f32x4 csl = *(const LAS f32x4*)(misc + 64 + 16 * lt + 4 * gq);
#pragma unroll
            for (int k = 0; k < 2; ++k) { const int st = t2 + k; f32x4 a = {0.f, 0.f, 0.f, 0.f};
                if (st <= lt) {
#pragma unroll
                    for (int ks = 0; ks < 4; ++ks) { const bf16x8 bfr = *(const LAS bf16x8*)(L + S_BQ + (16 * st + q16) * 272 + ks * 64 + gq * 16); a = __builtin_amdgcn_mfma_f32_16x16x32_bf16(cfr[ks], bfr, a, 0, 0, 0); }
                    const int sidx = 16 * st + q16; const float css = misc[64 + sidx], dts = misc[sidx];
#pragma unroll
                    for (int r = 0; r < 4; ++r) { const int l = 16 * lt + 4 * gq + r; a[r] = (sidx <= l) ? a[r] * __expf(csl[r] - css) * dts : 0.f; }
                }
#pragma unroll
                for (int r = 0; r < 4; r += 2) { const unsigned pw = pk2(a[r], a[r + 1]);
                    *(LAS unsigned short*)(L + S_MQ + (16 * lt + 4 * gq + r) * 144 + (16 * st + q16) * 2) = (unsigned short)(pw & 0xffffu); *(LAS unsigned short*)(L + S_MQ + (16 * lt + 4 * gq + r + 1) * 144 + (16 * st + q16) * 2) = (unsigned short)(pw >> 16); } }
        }
        __syncthreads();
        {
            const f32x4 ecs = *(const LAS f32x4*)(misc + 128 + 16 * lt + 4 * gq);
            const LAS unsigned char* HB = L + S_HB + par * 17408;
#pragma unroll
            for (int k = 0; k < 2; ++k) { const int pt = t2 + k; f32x4 a = {0.f, 0.f, 0.f, 0.f};
#pragma unroll
                for (int ks = 0; ks < 4; ++ks) { const bf16x8 hfr = *(const LAS bf16x8*)(HB + (16 * pt + q16) * 272 + ks * 64 + gq * 16); a = __builtin_amdgcn_mfma_f32_16x16x32_bf16(cfr[ks], hfr, a, 0, 0, 0); }
                a = a * ecs;
#pragma unroll
                for (int ks = 0; ks < 2; ++ks) if (ks <= (lt >> 1)) { const bf16x8 mfr = *(const LAS bf16x8*)(L + S_MQ + (16 * lt + q16) * 144 + ks * 64 + gq * 16), xfr = *(const LAS bf16x8*)(L + S_XT + (16 * pt + q16) * 144 + ks * 64 + gq * 16);
                    a = __builtin_amdgcn_mfma_f32_16x16x32_bf16(mfr, xfr, a, 0, 0, 0); }
                if (dir == 0) { const u32x2 xv = *(const LAS u32x2*)(L + S_XT + (16 * pt + q16) * 144 + (16 * lt + 4 * gq) * 2);
                    a[0] += dsk * bflo(xv.x); a[1] += dsk * bfhi(xv.x); a[2] += dsk * bflo(xv.y); a[3] += dsk * bfhi(xv.y); }
                { const int row0 = SSD_ROW(ci, 16 * lt + 4 * gq); bf16_t* yp = Y + (size_t)row0 * 512 + h * 64 + 16 * pt + q16; const int rs = dir ? -512 : 512;
                  const unsigned w01 = pk2(a[0], a[1]), w23 = pk2(a[2], a[3]);
                  yp[0] = (bf16_t)(w01 & 0xffffu); yp[rs] = (bf16_t)(w01 >> 16); yp[2 * rs] = (bf16_t)(w23 & 0xffffu); yp[3 * rs] = (bf16_t)(w23 >> 16); } }
            const int pt2 = w & 3, nb = (w >> 2) * 4; const float et = misc[256];
            bf16x8 xf2[2];
#pragma unroll
            for (int ks = 0; ks < 2; ++ks) xf2[ks] = *(const LAS bf16x8*)(L + S_XT + (16 * pt2 + q16) * 144 + ks * 64 + gq * 16);
            LAS unsigned char* HN = L + S_HB + (par ^ 1) * 17408;
#pragma unroll
            for (int j = 0; j < 4; ++j) { const int nt = nb + j; Hacc[j] = Hacc[j] * et;
#pragma unroll
                for (int ks = 0; ks < 2; ++ks) { const bf16x8 bfr = *(const LAS bf16x8*)(L + S_BT + (16 * nt + q16) * 144 + ks * 64 + gq * 16); Hacc[j] = __builtin_amdgcn_mfma_f32_16x16x32_bf16(xf2[ks], bfr, Hacc[j], 0, 0, 0); }
#pragma unroll
                for (int r = 0; r < 4; r += 2) { const unsigned pw = pk2(Hacc[j][r], Hacc[j][r + 1]);
                    *(LAS unsigned short*)(HN + (16 * pt2 + 4 * gq + r) * 272 + (16 * nt + q16) * 2) = (unsigned short)(pw & 0xffffu); *(LAS unsigned short*)(HN + (16 * pt2 + 4 * gq + r + 1) * 272 + (16 * nt + q16) * 2) = (unsigned short)(pw >> 16); } }
        }
        par ^= 1;
    }
#undef SSD_ROW
#undef SSD_PREFETCH
}

__device__ __forceinline__ void na_run(const Frame& F, int layer) {
    LAS unsigned char* KV = F.lds; LAS float* rp = (LAS float*)(F.lds + 120832);
    const bf16_t* PROJ = (const bf16_t*)(F.ws + WS_PROJ); bf16_t* MIX = (bf16_t*)(F.ws + WS_MIX);
    const int tid = F.tid, lane = F.lane, w = F.wave, q16 = lane & 15, g = lane >> 4;
    u32x4 pre[13];
#define NA_VPRE 13
#define NA_RB(m_) ({ int rb_ = 2 * (m_) - 4; rb_ = rb_ < 0 ? 0 : (rb_ > 24 ? 24 : rb_); __builtin_amdgcn_readfirstlane(rb_); })
#define NA_NL(rb_) ({ int nk_ = 32 - (rb_); nk_ = nk_ > 9 ? 9 : nk_; __builtin_amdgcn_readfirstlane(nk_ * 64 * 8); })
#define NA_LOAD(OFFS, b_, h_, rb_, nl_, K0, K1) do { int stid_ = tid; asm volatile("" : "+v"(stid_)); \
        _Pragma("unroll") for (int k_ = K0; k_ < K1; ++k_) { const int i_ = stid_ + k_ * NT, key_ = i_ >> 3, ch_ = i_ & 7; const bool ok_ = !(key_ < 576 && i_ >= (nl_)); \
            const int grow_ = key_ < 576 ? (b_) * SEQ + (rb_) * 64 + key_ : NLAT + (b_) * CTX + (key_ - 576); \
            pre[k_] = ok_ ? *(const u32x4*)(PROJ + (size_t)grow_ * NPROJ + (OFFS) + (h_) * 64 + ch_ * 8) : (u32x4){0u, 0u, 0u, 0u}; } } while (0)
#define NA_WRITE(nl_, K0, K1) do { int stid_ = tid; asm volatile("" : "+v"(stid_)); \
        _Pragma("unroll") for (int k_ = K0; k_ < K1; ++k_) { const int i_ = stid_ + k_ * NT, key_ = i_ >> 3, ch_ = i_ & 7; const bool ok_ = !(key_ < 576 && i_ >= (nl_)); \
            if (ok_) *(LAS u32x4*)(KV + key_ * NA_KS + ch_ * 16) = pre[k_]; } } while (0)
    int u = __builtin_amdgcn_readfirstlane(F.bid);
    if (u < 2048) { const int b = u >> 7, h = (u >> 4) & 7, m = u & 15, rb = NA_RB(m); NA_LOAD(OFF_K, b, h, rb, NA_NL(rb), 0, 13); }
    for (; u < 2048; u += F.G) {
        const int b = u >> 7, h = (u >> 4) & 7, m = u & 15, rbase = NA_RB(m), nloc8 = NA_NL(rbase);
        __syncthreads();
        NA_WRITE(nloc8, 0, 13);
        if (tid < 465) rp[tid] = F.in[I_RPB][(size_t)(layer * 8 + h) * 465 + tid] * LOG2E;
        NA_LOAD(OFF_V, b, h, rbase, nloc8, 0, NA_VPRE);
        __syncthreads();
        const int i = 2 * m + (w >> 2), j0 = (w & 3) * 16, qrow = b * SEQ + i * 64 + j0; int hs = j0 - 8; hs = hs < 0 ? 0 : (hs > 32 ? 32 : hs);
        int r0 = i - 4; r0 = r0 < 0 ? 0 : (r0 > 24 ? 24 : r0); const int kr0 = r0 - rbase;
        bf16x8 qf[2];
#pragma unroll
        for (int ks = 0; ks < 2; ++ks) qf[ks] = *(const bf16x8*)(PROJ + (size_t)(qrow + q16) * NPROJ + h * 64 + ks * 32 + g * 8);
        f32x4 S[32];
        const LAS unsigned char* kb = KV + q16 * NA_KS + g * 16;
        { const int j = j0 + q16; int cs = j - 8; cs = cs < 0 ? 0 : (cs > 48 ? 48 : cs);
          const int rb0 = (kr0 + rbase) - i + 7;
#pragma unroll
          for (int tl = 0; tl < 16; ++tl) { const int kr = tl >> 1, half = tl & 1; const int kidx0 = (kr0 + kr) * 64 + hs + 16 * half;
              f32x4 a = {0.f, 0.f, 0.f, 0.f};
#pragma unroll
              for (int ks = 0; ks < 2; ++ks) { const bf16x8 kf = *(const LAS bf16x8*)(kb + kidx0 * NA_KS + ks * 64); a = __builtin_amdgcn_mfma_f32_16x16x32_bf16(kf, qf[ks], a, 0, 0, 0); }
#pragma unroll
              for (int r = 0; r < 4; ++r) { const int kc = hs + 16 * half + 4 * g + r; const bool inw = (kc >= cs) && (kc < cs + 16);
                  int cbi = kc - j + 15; cbi = cbi < 0 ? 0 : (cbi > 30 ? 30 : cbi);
                  a[r] = inw ? a[r] * (0.125f * LOG2E) + rp[(rb0 + kr) * 31 + cbi] : -INFINITY; }
              S[tl] = a; if ((tl & 1) == 1) __builtin_amdgcn_sched_barrier(0); } }
#pragma unroll
        for (int tc = 0; tc < 16; ++tc) { const int kidx0 = 576 + 16 * tc; f32x4 a = {0.f, 0.f, 0.f, 0.f};
#pragma unroll
            for (int ks = 0; ks < 2; ++ks) { const bf16x8 kf = *(const LAS bf16x8*)(kb + kidx0 * NA_KS + ks * 64); a = __builtin_amdgcn_mfma_f32_16x16x32_bf16(kf, qf[ks], a, 0, 0, 0); }
            S[16 + tc] = a * (0.125f * LOG2E); if ((tc & 1) == 1) __builtin_amdgcn_sched_barrier(0); }
        float mx = -INFINITY;
#pragma unroll
        for (int t = 0; t < 32; ++t) mx = fmaxf(fmaxf(fmaxf(S[t][0], S[t][1]), fmaxf(S[t][2], S[t][3])), mx);
        mx = fmaxf(mx, __shfl_xor(mx, 16)); mx = fmaxf(mx, __shfl_xor(mx, 32));
        float sum = 0.f; u32x4 P[16];
#pragma unroll
        for (int kk = 0; kk < 16; ++kk) { float e[8];
#pragma unroll
            for (int r = 0; r < 4; ++r) { e[r] = __builtin_amdgcn_exp2f(S[2 * kk][r] - mx); e[4 + r] = __builtin_amdgcn_exp2f(S[2 * kk + 1][r] - mx); }
            sum += ((e[0] + e[1]) + (e[2] + e[3])) + ((e[4] + e[5]) + (e[6] + e[7]));
            P[kk].x = pg8::cvt_pk_bf16_pin(e[0], e[1]); P[kk].y = pg8::cvt_pk_bf16_pin(e[2], e[3]); P[kk].z = pg8::cvt_pk_bf16_pin(e[4], e[5]); P[kk].w = pg8::cvt_pk_bf16_pin(e[6], e[7]); }
        sum += __shfl_xor(sum, 16); sum += __shfl_xor(sum, 32);
        const float inv = 1.0f / sum;
        __syncthreads();
        NA_WRITE(nloc8, 0, NA_VPRE); NA_LOAD(OFF_V, b, h, rbase, nloc8, NA_VPRE, 13); NA_WRITE(nloc8, NA_VPRE, 13);
        { const int un = u + F.G; if (un < 2048) { const int bn = un >> 7, hn = (un >> 4) & 7, mn = un & 15, rbn = NA_RB(mn); NA_LOAD(OFF_K, bn, hn, rbn, NA_NL(rbn), 0, 13); } }
        __syncthreads();
        f32x4 o[4];
#pragma unroll
        for (int dt = 0; dt < 4; ++dt) o[dt] = (f32x4){0.f, 0.f, 0.f, 0.f};
        const LAS unsigned char* vb = KV + (4 * g + (q16 >> 2)) * NA_KS + (q16 & 3) * 8;
#pragma unroll
        for (int kk = 0; kk < 16; ++kk) {
            const int kidx0 = (kk < 8) ? (kr0 + kk) * 64 + hs : 576 + 32 * (kk - 8);
            const bf16x8 pa = __builtin_bit_cast(bf16x8, P[kk]);
#pragma unroll
            for (int dt = 0; dt < 4; ++dt) { const s16x4 lo = lds_tr16(vb + kidx0 * NA_KS + dt * 32), hi = lds_tr16(vb + (kidx0 + 16) * NA_KS + dt * 32);
                const bf16x8 vf = {lo[0], lo[1], lo[2], lo[3], hi[0], hi[1], hi[2], hi[3]};
                o[dt] = __builtin_amdgcn_mfma_f32_16x16x32_bf16(pa, vf, o[dt], 0, 0, 0); }
            if ((kk & 1) == 1) __builtin_amdgcn_sched_barrier(0);
        }
#pragma unroll
        for (int r = 0; r < 4; ++r) { const float ir = __shfl(inv, 4 * g + r);
            bf16_t* op = MIX + (size_t)(qrow + 4 * g + r) * D + h * 64 + q16;
#pragma unroll
            for (int dt = 0; dt < 4; dt += 2) { const unsigned pw = pk2(o[dt][r] * ir, o[dt + 1][r] * ir); op[dt * 16] = (bf16_t)(pw & 0xffffu); op[dt * 16 + 16] = (bf16_t)(pw >> 16); } }
    }
#undef NA_RB
#undef NA_NL
#undef NA_LOAD
#undef NA_WRITE
}
__device__ __forceinline__ void p_mixa(const Frame& F, int layer, bool last) {
    { PrepassW W; ssd_prepass_weights(F, layer, W);
      for (int u = F.bid; u < NTOK / 16; u += F.G) ssd_prepass_unit(F, u, W); }
    na_run(F, layer);
    if (!last) for (int u = F.bid; u < 256; u += F.G) na_unit(F, layer, u >> 4, (u >> 1) & 7, 1, u & 1);
}
__device__ __forceinline__ void p_mixb(const Frame& F, int layer) {
    for (int u0 = F.bid; u0 < 256 * REP_SSD; u0 += F.G) { const int u = u0 & 255; ssd_mfma_unit(F, layer, u >> 4, (u >> 1) & 7, u & 1); }
}

__device__ __forceinline__ void p_ssdcomb(const Frame& F, int layer, bool last) {
    const bf16_t* PROJ = (const bf16_t*)(F.ws + WS_PROJ); bf16_t* MIX = (bf16_t*)(F.ws + WS_MIX);
    const bf16_t* YF = (const bf16_t*)(F.ws + WS_YF); const bf16_t* YB = (const bf16_t*)(F.ws + WS_YB);
    const float* nw = F.in[I_NORMW] + layer * 512 + F.lane * 8;
    const f32x4 nw0 = *(const f32x4*)nw, nw1 = *(const f32x4*)(nw + 4);
    const int nrows = last ? NLAT : NTOK;
    u32x4 pyf = {0u, 0u, 0u, 0u}, pyb = pyf, pz = pyf;
#define SC_LOAD(r_) do { const size_t o_ = (size_t)(r_) * 512 + F.lane * 8; pyf = *(const u32x4*)(YF + o_); pyb = *(const u32x4*)(YB + o_); \
        pz = *(const u32x4*)(PROJ + (size_t)(r_) * NPROJ + OFF_Z + F.lane * 8); } while (0)
    if (F.gw < nrows) SC_LOAD(F.gw);
    for (int row = F.gw; row < nrows; row += F.NGW) {
        const f32x4 a0 = {bflo(pyf.x) + bflo(pyb.x), bfhi(pyf.x) + bfhi(pyb.x), bflo(pyf.y) + bflo(pyb.y), bfhi(pyf.y) + bfhi(pyb.y)}, a1 = {bflo(pyf.z) + bflo(pyb.z), bfhi(pyf.z) + bfhi(pyb.z), bflo(pyf.w) + bflo(pyb.w), bfhi(pyf.w) + bfhi(pyb.w)}; const u32x4 zv = pz;
        if (row + F.NGW < nrows) SC_LOAD(row + F.NGW);
        float y[8] = {a0[0] * silu_f(bflo(zv.x)), a0[1] * silu_f(bfhi(zv.x)), a0[2] * silu_f(bflo(zv.y)), a0[3] * silu_f(bfhi(zv.y)),
                      a1[0] * silu_f(bflo(zv.z)), a1[1] * silu_f(bfhi(zv.z)), a1[2] * silu_f(bflo(zv.w)), a1[3] * silu_f(bfhi(zv.w))};
        float ss = 0.f;
#pragma unroll
        for (int k = 0; k < 8; ++k) ss += y[k] * y[k];
#pragma unroll
        for (int of = 1; of < 32; of <<= 1) ss += __shfl_xor(ss, of);
        const float rs = 1.0f / sqrtf(ss * (1.0f / 256.0f) + RMS_EPS);
        u32x4 w; w.x = pk2(y[0] * rs * nw0[0], y[1] * rs * nw0[1]); w.y = pk2(y[2] * rs * nw0[2], y[3] * rs * nw0[3]);
        w.z = pk2(y[4] * rs * nw1[0], y[5] * rs * nw1[1]); w.w = pk2(y[6] * rs * nw1[2], y[7] * rs * nw1[3]);
        *(u32x4*)(MIX + (size_t)row * D + 512 + F.lane * 8) = w;
    }
}

__device__ __forceinline__ void p_outproj(const Frame& F, int layer, bool last) {
    bf16_t* X = (bf16_t*)(F.ws + WS_X);
    pg8::Gemm g{(const bf16_t*)(F.ws + WS_MIX), (const bf16_t*)(F.ws + WS_WOUT) + (size_t)layer * D * D, D};
    pg8::DenseOrder S; S.init(last ? NLAT : NTOK, D, D, F.G, F.bid);
    pg8::EpiResid E{layer == 0 ? (const void*)F.in[I_X] : (const void*)X, layer == 0 ? (const void*)F.in[I_CTX] : (const void*)(X + (size_t)NLAT * D), X, (const float*)(F.ws + WS_MOD) + (size_t)layer * 17 * MODW, 2 * D, layer == 0};
    pg8::gemm_phase<pg8::EpiResid, pg8::DenseOrder, true, true>(F.lds, g, S, E, F.tid);
    if (layer == 0) deferred_conv(F, (NTOK / 256) * (D / 256), DW_L0_OUT, DW_Q); else if (layer == 1) deferred_conv(F, (NTOK / 256) * (D / 256), DW_L1_OUT, DW_Q);
}

__device__ __forceinline__ unsigned* cnt_word(const Frame& F, int slot, int hf, int e) { return (unsigned*)(F.ws + WS_CTL) + CW_CNT + ((slot * 2 + hf) * 8 + e) * 64; }
__device__ __forceinline__ void p_ln1(const Frame& F, int layer, bool last) {
    bf16_t* X = (bf16_t*)(F.ws + WS_X); bf16_t* H = (bf16_t*)(F.ws + WS_H);
    const float* MOD = (const float*)(F.ws + WS_MOD) + (size_t)layer * 17 * MODW;
    const float* lg = F.in[I_LNG] + (size_t)(layer * 2) * D; const float* lb = F.in[I_LNB] + (size_t)(layer * 2) * D;
    const bool moe = layer & 1; const int slot = layer >> 1;
    const int nrows = last ? NLAT : NTOK;
    float rw[16][8];
    if (moe) { const float* R = F.in[I_RW] + (size_t)slot * D * 8;
#pragma unroll
        for (int j = 0; j < 4; ++j)
#pragma unroll
            for (int k = 0; k < 4; ++k) { const int lane = F.lane; const f32x4 a = *(const f32x4*)(R + (size_t)(RIDX(j) + k) * 8), b2 = *(const f32x4*)(R + (size_t)(RIDX(j) + k) * 8 + 4);
                rw[j * 4 + k][0] = a[0]; rw[j * 4 + k][1] = a[1]; rw[j * 4 + k][2] = a[2]; rw[j * 4 + k][3] = a[3]; rw[j * 4 + k][4] = b2[0]; rw[j * 4 + k][5] = b2[1]; rw[j * 4 + k][6] = b2[2]; rw[j * 4 + k][7] = b2[3]; } }
    int nrec = 0;
    if (moe) { __syncthreads(); if (F.tid < 32) ((LAS unsigned*)F.lds)[F.tid] = 0u; __syncthreads(); }
    f32x4 vn[4];
    if (F.gw < nrows) row_load_h(X + (size_t)F.gw * D, F.lane, vn);
    for (int row = F.gw; row < nrows; row += F.NGW) {
        f32x4 v[4], hv[4];
#pragma unroll
        for (int j = 0; j < 4; ++j) v[j] = vn[j];
        if (row + F.NGW < nrows) row_load_h(X + (size_t)(row + F.NGW) * D, F.lane, vn);
        row_ln(v, lg, lb, F.lane);
        row_store_h(X + (size_t)row * D, F.lane, v);
        const float* m = MOD + (size_t)mod_row_of(row) * MODW;
        if (USE_FP8 && (moe || FP8_DENSE)) row_mod_store8((unsigned char*)H + (size_t)row * D, F.lane, v, m + 3 * D, m + 4 * D, hv);
        else row_mod_store(H + (size_t)row * D, F.lane, v, m + 3 * D, m + 4 * D, hv);
        if (moe) {
            float lg8[8];
#pragma unroll
            for (int e = 0; e < 8; ++e) { float s = 0.f;
#pragma unroll
                for (int j = 0; j < 4; ++j)
#pragma unroll
                    for (int k = 0; k < 4; ++k) s += hv[j][k] * rw[j * 4 + k][e];
                lg8[e] = wave_sum(s); }
            int e0 = 0; float v0 = lg8[0];
#pragma unroll
            for (int e = 1; e < 8; ++e) if (lg8[e] > v0) { v0 = lg8[e]; e0 = e; }
            int e1 = -1; float v1 = -INFINITY;
#pragma unroll
            for (int e = 0; e < 8; ++e) if (e != e0 && lg8[e] > v1) { v1 = lg8[e]; e1 = e; }
            if (F.lane == 0) {
                const unsigned s0 = __hip_atomic_fetch_add((LAS unsigned*)F.lds + e0, 1u, __ATOMIC_RELAXED, __HIP_MEMORY_SCOPE_WORKGROUP), s1 = __hip_atomic_fetch_add((LAS unsigned*)F.lds + e1, 1u, __ATOMIC_RELAXED, __HIP_MEMORY_SCOPE_WORKGROUP);
                const float ex = __expf(v1 - v0), g0 = 1.0f / (1.0f + ex);
                ((LAS u32x4*)(F.lds + 256))[F.wave * 32 + nrec] = (u32x4){(unsigned)e0 | ((unsigned)e1 << 8), s0, s1, (unsigned)row};
                *(f32x2*)(F.ws + WS_GATES + (size_t)row * 8) = (f32x2){g0, ex * g0};
            }
            ++nrec;
        }
    }
    if (moe) {
        __syncthreads();
        if (F.tid < 8) ((LAS unsigned*)F.lds)[16 + F.tid] = atomicAdd(cnt_word(F, slot, 0, F.tid), ((LAS unsigned*)F.lds)[F.tid]);
        __syncthreads();
        int* list = (int*)(F.ws + WS_LIST);
        if (F.lane < nrec) { const u32x4 rc = ((LAS u32x4*)(F.lds + 256))[F.wave * 32 + F.lane]; const int e0 = rc.x & 255, e1 = (rc.x >> 8) & 255; const int row = (int)rc.w;
            const unsigned s0 = ((LAS unsigned*)F.lds)[16 + e0] + rc.y, s1 = ((LAS unsigned*)F.lds)[16 + e1] + rc.z;
            list[e0 * NTOK + s0] = row; list[e1 * NTOK + s1] = row;
            *(u32x4*)(F.ws + WS_ROUTE + (size_t)row * 16) = (u32x4){rc.x, s0, s1, 0u}; }
    }
}

__device__ __forceinline__ void p_ffn1_dense(const Frame& F, int layer, bool last) {
    const int s = layer >> 1;
#if USE_FP8 && FP8_DENSE
    pg8::Gemm g{(const bf16_t*)(F.ws + WS_H), (const bf16_t*)(F.ws + WS_WFGU + (size_t)s * 2 * DFF * D), D / 2};
    pg8::DenseOrder S; S.init(last ? NLAT : NTOK, 2 * DFF, D / 2, F.G, F.bid, REP_GEMM);
    pg8::EpiSwiGLU8 E{F.ws + WS_HID, DFF};
    pg8::gemm_phase<pg8::EpiSwiGLU8, pg8::DenseOrder, true, FP8_SP2, true>(F.lds, g, S, E, F.tid, (127 - S8_WGU) * 0x01010101, (127 - S8_ACT) * 0x01010101);
#else
    pg8::Gemm g{(const bf16_t*)(F.ws + WS_H), (const bf16_t*)(F.ws + WS_WFGU) + (size_t)s * 2 * DFF * D, D};
    pg8::DenseOrder S; S.init(last ? NLAT : NTOK, 2 * DFF, D, F.G, F.bid, REP_GEMM);
    pg8::EpiSwiGLU E{(bf16_t*)(F.ws + WS_HID), DFF};
    pg8::gemm_phase<pg8::EpiSwiGLU, pg8::DenseOrder, true, true>(F.lds, g, S, E, F.tid);
#endif
    if (layer == 0) deferred_conv(F, (NTOK / 256) * (2 * DFF / 256), DW_L0_F1, DW_Q);
}
__device__ __forceinline__ void p_ffn2_dense(const Frame& F, int layer, bool last) {
    const int s = layer >> 1; bf16_t* X = (bf16_t*)(F.ws + WS_X);
    pg8::EpiResid E{(const void*)X, (const void*)(X + (size_t)NLAT * D), X, (const float*)(F.ws + WS_MOD) + (size_t)layer * 17 * MODW, 5 * D, false};
#if USE_FP8 && FP8_DENSE
    pg8::Gemm g{(const bf16_t*)(F.ws + WS_HID), (const bf16_t*)(F.ws + WS_WFD + (size_t)s * D * DFF), DFF / 2};
    pg8::DenseOrder S; S.init(last ? NLAT : NTOK, D, DFF / 2, F.G, F.bid);
    pg8::gemm_phase<pg8::EpiResid, pg8::DenseOrder, true, FP8_SP2, true>(F.lds, g, S, E, F.tid, (127 - S8_WD) * 0x01010101, (127 - S8_HID) * 0x01010101);
#else
    pg8::Gemm g{(const bf16_t*)(F.ws + WS_HID), (const bf16_t*)(F.ws + WS_WFD) + (size_t)s * D * DFF, DFF};
    pg8::DenseOrder S; S.init(last ? NLAT : NTOK, D, DFF, F.G, F.bid);
    pg8::gemm_phase<pg8::EpiResid, pg8::DenseOrder, true, true>(F.lds, g, S, E, F.tid);
#endif
    if (layer == 0) deferred_conv(F, (NTOK / 256) * (D / 256), DW_L0_F2, DW_Q2);
}
__device__ __forceinline__ void moe_prefix(const Frame& F, int slot, int hf, int (&ts)[9], int (&cn)[8]) {
    int a = 0;
#pragma unroll
    for (int e = 0; e < 8; ++e) { cn[e] = (int)*cnt_word(F, slot, hf, e); ts[e] = a; a += (cn[e] + 255) >> 8; }
    ts[8] = a;
}
__device__ __forceinline__ void p_ffn1_moe(const Frame& F, int layer) {
    const int slot = layer >> 1; int cn[8];
    pg8::MoeOrder<true> S; moe_prefix(F, slot, 0, S.ts, cn);
    S.nM = S.ts[8]; S.nN = 2 * DFFE / 256; S.G = F.G; S.c = F.bid; S.K = D / 2; S.estride = (long)2 * DFFE * D; S.rowoff = (const LAS unsigned short*)(F.lds + LDS_ROWOFF); S.rowbytes = D;
    {
        const int* list = (const int*)(F.ws + WS_LIST); LAS unsigned short* ro = (LAS unsigned short*)(F.lds + LDS_ROWOFF); pg8::Unit u;
        for (int i = F.wave; i < 36 && S.next(i, u); i += NWAVES) { const int e = S.expert_of(u.pm); int tse = 0, cne = 0;
#pragma unroll
            for (int j = 0; j < 8; ++j) { tse = (j == e) ? S.ts[j] : tse; cne = (j == e) ? cn[j] : cne; }
            int tk[4];
#pragma unroll
            for (int q = 0; q < 4; ++q) { const int sl = (u.pm - tse) * 256 + F.lane + 64 * q; tk[q] = sl < cne ? list[e * NTOK + sl] : 0; }
#pragma unroll
            for (int q = 0; q < 4; ++q) ro[i * 256 + F.lane + 64 * q] = (unsigned short)tk[q]; }
        __syncthreads();
    }
    pg8::Gemm g{(const bf16_t*)(F.ws + WS_H), (const bf16_t*)(F.ws + WS_WMGU + (size_t)slot * NEXP * 2 * DFFE * D), D / 2};
    pg8::EpiSwiGLU8 E{F.ws + WS_HID, DFFE};
    pg8::gemm_phase<pg8::EpiSwiGLU8, pg8::MoeOrder<true>, true, FP8_SP2, true>(F.lds, g, S, E, F.tid, (127 - S8_WGU) * 0x01010101, (127 - S8_ACT) * 0x01010101);
}
__device__ __forceinline__ void p_ffn2_moe(const Frame& F, int layer) {
    const int slot = layer >> 1; int cn[8];
    pg8::MoeOrder<false> S; moe_prefix(F, slot, 0, S.ts, cn);
    S.nM = S.ts[8]; S.nN = D / 256; S.G = F.G; S.c = F.bid; S.K = DFFE / 2; S.estride = (long)D * DFFE; S.rowoff = nullptr; S.rowbytes = 0;
    pg8::EpiBf16 E{(bf16_t*)(F.ws + WS_YP), D};
    pg8::Gemm g{(const bf16_t*)(F.ws + WS_HID), (const bf16_t*)(F.ws + WS_WMD + (size_t)slot * NEXP * D * DFFE), DFFE / 2};
    pg8::gemm_phase<pg8::EpiBf16, pg8::MoeOrder<false>, true, FP8_SP2, true>(F.lds, g, S, E, F.tid, (127 - S8_WD) * 0x01010101, (127 - S8_HID) * 0x01010101);
}

__device__ __forceinline__ void p_ln2(const Frame& F, int layer, bool last) {
    bf16_t* X = (bf16_t*)(F.ws + WS_X); bf16_t* H = (bf16_t*)(F.ws + WS_H);
    const float* MOD = (const float*)(F.ws + WS_MOD) + (size_t)layer * 17 * MODW;
    const float* lg = F.in[I_LNG] + (size_t)(layer * 2 + 1) * D; const float* lb = F.in[I_LNB] + (size_t)(layer * 2 + 1) * D;
    const bool moe = layer & 1; const int slot = layer >> 1;
    const int nrows = last ? NLAT : NTOK;
    int ts0[9], cn[8];
    if (moe) moe_prefix(F, slot, 0, ts0, cn);
    const bf16_t* YP = (const bf16_t*)(F.ws + WS_YP);
    f32x4 vn[4]; u32x4 rn = {0u, 0u, 0u, 0u}; f32x2 gn = {0.f, 0.f};
    if (F.gw < nrows) { row_load_h(X + (size_t)F.gw * D, F.lane, vn); if (moe) { rn = *(const u32x4*)(F.ws + WS_ROUTE + (size_t)F.gw * 16); gn = *(const f32x2*)(F.ws + WS_GATES + (size_t)F.gw * 8); } }
    for (int row = F.gw; row < nrows; row += F.NGW) {
        f32x4 v[4], hv[4];
#pragma unroll
        for (int j = 0; j < 4; ++j) v[j] = vn[j];
        const u32x4 r = rn; const f32x2 gt = gn;
        if (row + F.NGW < nrows) { row_load_h(X + (size_t)(row + F.NGW) * D, F.lane, vn);
            if (moe) { rn = *(const u32x4*)(F.ws + WS_ROUTE + (size_t)(row + F.NGW) * 16); gn = *(const f32x2*)(F.ws + WS_GATES + (size_t)(row + F.NGW) * 8); } }
        if (moe) {
            const int e0 = r.x & 255, e1 = (r.x >> 8) & 255;
            int t0 = 0, t1 = 0;
#pragma unroll
            for (int e = 0; e < 8; ++e) { const int tv = ts0[e]; t0 = (e == e0) ? tv : t0; t1 = (e == e1) ? tv : t1; }
            const bf16_t* y0 = YP + ((size_t)t0 * 256 + r.y) * D; const bf16_t* y1 = YP + ((size_t)t1 * 256 + r.z) * D;
            const float* g2 = MOD + (size_t)mod_row_of(row) * MODW + 5 * D;
#pragma unroll
            for (int j = 0; j < 2; ++j) { const int lane = F.lane; const u32x4 a = *(const u32x4*)(y0 + 8 * lane + 512 * j), b2 = *(const u32x4*)(y1 + 8 * lane + 512 * j);
                const f32x4 g0 = *(const f32x4*)(g2 + RIDX(2 * j)) + 1.0f, g1 = *(const f32x4*)(g2 + RIDX(2 * j + 1)) + 1.0f;
                f32x4 f0, f1; f0[0] = gt[0] * bflo(a.x) + gt[1] * bflo(b2.x); f0[1] = gt[0] * bfhi(a.x) + gt[1] * bfhi(b2.x); f0[2] = gt[0] * bflo(a.y) + gt[1] * bflo(b2.y); f0[3] = gt[0] * bfhi(a.y) + gt[1] * bfhi(b2.y);
                f1[0] = gt[0] * bflo(a.z) + gt[1] * bflo(b2.z); f1[1] = gt[0] * bfhi(a.z) + gt[1] * bfhi(b2.z); f1[2] = gt[0] * bflo(a.w) + gt[1] * bflo(b2.w); f1[3] = gt[0] * bfhi(a.w) + gt[1] * bfhi(b2.w);
                v[2 * j] = v[2 * j] * ALPHA + g0 * f0; v[2 * j + 1] = v[2 * j + 1] * ALPHA + g1 * f1; }
        }
        row_ln(v, lg, lb, F.lane);
        if (last) row_store(F.out + (size_t)row * D, F.lane, v);
        else { row_store_h(X + (size_t)row * D, F.lane, v);
            const float* m = MOD + (size_t)17 * MODW + (size_t)mod_row_of(row) * MODW;
            row_mod_store(H + (size_t)row * D, F.lane, v, m, m + D, hv);
            }
    }
}

constexpr int NPL = 9;
constexpr int NPH = 2 + NPL * DEPTH;
#ifndef SITE_MASK
#define SITE_MASK 0xFFFFF
#endif
#define SITE(n) (((SITE_MASK) >> (n)) & 1)
__global__ void __launch_bounds__(NT, 2) fwd_kernel(Args args) {
    extern __shared__ __attribute__((aligned(16))) unsigned char lds_raw[];
    Frame F;
    F.lds = (LAS unsigned char*)lds_raw; F.in = args.in; F.out = args.out; F.ws = args.ws;
    F.tid = threadIdx.x; F.lane = F.tid & 63; F.wave = __builtin_amdgcn_readfirstlane(F.tid >> 6); F.bid = blockIdx.x; F.G = gridDim.x;
    F.gw = F.bid * NWAVES + F.wave; F.NGW = F.G * NWAVES;
    volatile LAS unsigned* MISC = (volatile LAS unsigned*)(F.lds + LDS_MISC);
    if (F.tid < 64) MISC[F.tid] = 0u;
    __syncthreads();
    XcdBarrier bar; bar.bar = (unsigned*)(F.ws + WS_CTL) + CW_BAR; bar.x = 0; bar.st = MISC + 8;
#if MK_SINGLE
    bar = xcd_barrier_post((unsigned*)(F.ws + WS_CTL) + CW_BAR, MISC + 8);
#endif
    const int lo = args.ph_lo, hi = args.ph_hi;
#define IN(k) (lo <= (k) && (k) < hi)
#if MK_SINGLE
#define SEAM(k) do { if (IN(k) && IN((k) + 1)) { XcdBarrier b2_ = bar; int z_; asm volatile("s_mov_b32 %0, 0" : "=s"(z_)); b2_.bar = bar.bar + z_; int ln_; asm volatile("v_mbcnt_lo_u32_b32 %0, -1, 0\n\tv_mbcnt_hi_u32_b32 %0, -1, %0" : "=v"(ln_)); xcd_barrier(b2_, F.wave == 0 && ln_ == 0); } } while (0)
#else
#define SEAM(k) do { } while (0)
#endif
    if constexpr (SITE(0)) if (IN(0)) p_pro_a(fresh(F));
    SEAM(0);
    if constexpr (SITE(1)) if (IN(1)) p_pro_b(fresh(F));
    SEAM(1);
    for (int layer = 0; layer < DEPTH; ++layer) {
        const int pb = 2 + NPL * layer; const bool last = layer == DEPTH - 1; const bool moe = layer & 1;
        if constexpr (SITE(2)) if (IN(pb + 0)) p_inproj(fresh(F), layer);
        SEAM(pb + 0);
        if constexpr (SITE(3)) if (IN(pb + 1)) p_mixa(fresh(F), layer, last);
        SEAM(pb + 1);
        if constexpr (SITE(12)) if (IN(pb + 2)) p_mixb(fresh(F), layer);
        SEAM(pb + 2);
        if constexpr (SITE(4)) if (IN(pb + 3)) { p_ssdcomb(fresh(F), layer, last); if (!USE_FP8 && layer == 2) { int rot = 0; conv_moe(fresh(F), 1, rot); } }
        SEAM(pb + 3);
        if constexpr (SITE(5)) if (IN(pb + 4)) p_outproj(fresh(F), layer, last);
        SEAM(pb + 4);
        if constexpr (SITE(6)) if (IN(pb + 5)) p_ln1(fresh(F), layer, last);
        SEAM(pb + 5);
        if (moe) {
            if constexpr (SITE(7)) if (IN(pb + 6)) p_ffn1_moe(fresh(F), layer);
            SEAM(pb + 6);
            if constexpr (SITE(8)) if (IN(pb + 7)) p_ffn2_moe(fresh(F), layer);
            SEAM(pb + 7);
        } else {
            if constexpr (SITE(9)) if (IN(pb + 6)) p_ffn1_dense(fresh(F), layer, last);
            SEAM(pb + 6);
            if constexpr (SITE(10)) if (IN(pb + 7)) p_ffn2_dense(fresh(F), layer, last);
            SEAM(pb + 7);
        }
        if constexpr (SITE(11)) if (IN(pb + 8)) p_ln2(fresh(F), layer, last);
        if (!last) SEAM(pb + 8);
    }
#undef IN
#undef SEAM
}

extern "C" void kernel_launch(void* const* d_in, const int* in_sizes, int n_in, void* d_out, int out_size, void* d_ws, size_t ws_size, hipStream_t stream) {
    static int grid = 0;
    if (grid == 0) {
        if (n_in != 24 || out_size != NLAT * D || ws_size < WS_END) { fprintf(stderr, "kernel_launch: unexpected shapes (n_in %d, out %d, ws %zu < %zu)\n", n_in, out_size, ws_size, (size_t)WS_END); grid = -1; return; }
        int dev = 0, cus = 0, per_cu = 0;
        if (hipGetDevice(&dev) != hipSuccess || hipDeviceGetAttribute(&cus, hipDeviceAttributeMultiprocessorCount, dev) != hipSuccess) { grid = -1; return; }
        if (hipFuncSetAttribute((const void*)fwd_kernel, hipFuncAttributeMaxDynamicSharedMemorySize, LDS_BYTES) != hipSuccess) { fprintf(stderr, "kernel_launch: hipFuncSetAttribute failed\n"); grid = -1; return; }
        if (hipOccupancyMaxActiveBlocksPerMultiprocessor(&per_cu, (const void*)fwd_kernel, NT, LDS_BYTES) != hipSuccess || per_cu < 1) { fprintf(stderr, "kernel_launch: occupancy query says %d\n", per_cu); }
        (void)hipGetLastError();
        grid = cus;
    }
    if (grid < 0) return;
    (void)in_sizes;
    if (hipMemsetAsync((char*)d_ws + WS_CTL, 0, CTL_BYTES, stream) != hipSuccess) return;
    Args a{};
    for (int i = 0; i < 24; ++i) a.in[i] = (const float*)d_in[i];
    a.out = (float*)d_out; a.ws = (unsigned char*)d_ws;
#if MK_SINGLE
    a.ph_lo = 0; a.ph_hi = NPH;
    hipLaunchKernelGGL(fwd_kernel, dim3(grid), dim3(NT), LDS_BYTES, stream, a);
#else
    for (int ph = 0; ph < NPH; ++ph) {

        a.ph_lo = ph; a.ph_hi = ph + 1;
        hipLaunchKernelGGL(fwd_kernel, dim3(grid), dim3(NT), LDS_BYTES, stream, a);
    }
#endif
}
```

```cpp
#include <hip/hip_runtime.h>
#include <cstdio>
#include <cstdint>

#ifndef MK_SINGLE
#define MK_SINGLE 1
#endif

#ifndef FP8_INPROJ
#define FP8_INPROJ 0
#endif
#ifndef FP8_DENSE1
#define FP8_DENSE1 0
#endif
#ifndef FP8_DENSE2
#define FP8_DENSE2 1
#endif
#ifndef USE_FP8
#define USE_FP8 1
#endif
#ifndef FP8_SP2
#define FP8_SP2 true
#endif
#ifndef REP_SSD
#define REP_SSD 1
#endif
#ifndef REP_NA
#define REP_NA 1
#endif
#ifndef REP_GEMM
#define REP_GEMM 1
#endif
#define GAS __attribute__((address_space(1)))
#define LAS __attribute__((address_space(3)))
typedef unsigned short bf16_t;
typedef short bf16x8 __attribute__((ext_vector_type(8)));
typedef float f32x4 __attribute__((ext_vector_type(4)));
typedef float f32x2 __attribute__((ext_vector_type(2)));
typedef unsigned u32x4 __attribute__((ext_vector_type(4)));
typedef unsigned u32x2 __attribute__((ext_vector_type(2)));
typedef int i32x4 __attribute__((ext_vector_type(4)));
typedef int i32x8 __attribute__((ext_vector_type(8)));

constexpr int D = 1024, BATCH = 16, SEQ = 2048, DEPTH = 4, GRID_W = 64, CTX = 256;
constexpr int NLAT = BATCH * SEQ;
constexpr int NCTX = BATCH * CTX;
constexpr int NTOK = NLAT + NCTX;
constexpr int NPROJ = 3072;
constexpr int OFF_K = 512, OFF_V = 1024, OFF_Z = 1536, OFF_XBC = 2048;
constexpr int D_IN_PROJ = 3088;
constexpr int DFF = 2816, DFFE = 3584, NEXP = 8;
constexpr float ALPHA = 1.6817928305074290f;
constexpr float LN_EPS = 1e-5f, RMS_EPS = 1e-5f;
constexpr int MODW = 6 * D;

constexpr size_t MiB = 1u << 20;
constexpr size_t WS_CTL = 0, CTL_BYTES = 1 * MiB;
constexpr size_t WS_MOD = 1 * MiB;
constexpr size_t WS_ROUTE = 3 * MiB;
constexpr size_t WS_GATES = 4 * MiB;
constexpr size_t WS_LIST = 5 * MiB;
constexpr size_t WS_WDT = 7 * MiB;
constexpr size_t WS_WIN = 8 * MiB;
constexpr size_t WS_WOUT = 32 * MiB;
constexpr size_t WS_WFGU = 40 * MiB;
constexpr size_t WS_WFD = 62 * MiB;
constexpr size_t WS_WMGU = 73 * MiB;
constexpr size_t WS_WMD = 185 * MiB;
constexpr size_t WS_X = 241 * MiB;
constexpr size_t WS_H = 385 * MiB;
constexpr size_t WS_R = 457 * MiB;
constexpr size_t WS_PROJ = WS_R;
constexpr size_t WS_DT = WS_R + 216 * MiB;
constexpr size_t WS_YF = WS_R + 219 * MiB;
constexpr size_t WS_YB = WS_R + 291 * MiB;
constexpr size_t WS_MIX = WS_R + 363 * MiB;
constexpr size_t WS_HID = WS_R;
constexpr size_t WS_YP = WS_R + 270 * MiB;
constexpr size_t WS_U = WS_R + 435 * MiB;
constexpr size_t WS_H8IN = WS_U;
constexpr size_t WS_END = WS_R + 507 * MiB;
constexpr int MOE_PAD = 2 * NTOK + 2048;
static_assert(USE_FP8 == 1, "the single-phase MoE needs the e4m3 hidden (the bf16 one does not fit the workspace)");
static_assert(WS_HID + (size_t)MOE_PAD * 3584 <= WS_YP && WS_YP + (size_t)MOE_PAD * 1024 * 2 <= WS_END, "MoE buffers");

constexpr int CW_TMO = 0;
constexpr int CW_BAR = 4096;
constexpr int CW_CNT = 16384;

constexpr int LDS_STAGE = 131072;
constexpr int LDS_ROWOFF = 131072;
constexpr int LDS_MISC = 131072 + 18432;
constexpr int LDS_BYTES = 155648;

constexpr int S8_ACT = 3, S8_WGU = 8, S8_HID = 2, S8_WD = 9;
__device__ __forceinline__ unsigned f2bf(float f) { unsigned u = __builtin_bit_cast(unsigned, f); return (u + 0x7fffu + ((u >> 16) & 1u)) >> 16; }
typedef __bf16 bf16x2_t __attribute__((ext_vector_type(2)));
__device__ __forceinline__ unsigned pk2(float lo, float hi) { const f32x2 v = {lo, hi}; const bf16x2_t b = __builtin_convertvector(v, bf16x2_t); return __builtin_bit_cast(unsigned, b); }
__device__ __forceinline__ float bf2f(unsigned short b) { return __builtin_bit_cast(float, ((unsigned)b) << 16); }
__device__ __forceinline__ float bflo(unsigned w) { return __builtin_bit_cast(float, w << 16); }
__device__ __forceinline__ float bfhi(unsigned w) { return __builtin_bit_cast(float, w & 0xffff0000u); }
__device__ __forceinline__ float silu_f(float v) { return v / (1.0f + __expf(-v)); }
__device__ __forceinline__ float clamp8(float v) { return fminf(fmaxf(v, -448.0f), 448.0f); }
__device__ __forceinline__ unsigned pk8(float a, float b, float c, float d) {
    int w = 0; w = __builtin_amdgcn_cvt_pk_fp8_f32(clamp8(a), clamp8(b), w, false); w = __builtin_amdgcn_cvt_pk_fp8_f32(clamp8(c), clamp8(d), w, true); return (unsigned)w; }
__device__ __forceinline__ float wave_sum(float v) {
#pragma unroll
    for (int o = 1; o < 64; o <<= 1) v += __shfl_xor(v, o);
    return v;
}

namespace pg8 {
constexpr int BM = 256, BK = 64, HALF = 128, HTB = HALF * BK * 2, STAGE_BYTES = 8 * HTB, NXCD = 8, WGM = 8;
__host__ __device__ __forceinline__ int lds_byte(int r, int c) { const int st = (r >> 4) * 2 + (c >> 5), rr = r & 15, cc = c & 31, ob = rr * 64 + cc * 2; return st * 1024 + (ob ^ (((ob >> 9) & 1) << 5)); }
__host__ __device__ __forceinline__ void stage_rc(int b, int& R, int& C) { const int st = b / 1024, sb = b % 1024, swz = sb ^ (((sb >> 9) & 1) << 5); R = (st >> 1) * 16 + swz / 64; C = (st & 1) * 32 + (swz % 64) / 2; }
__host__ __device__ __forceinline__ int perm32(int rho) { const int n = rho >> 4, i = rho & 15; return 8 * (i >> 2) + 4 * n + (i & 3); }

struct Unit { int pm, pn; long bofs; };
struct Gemm { const bf16_t* A; const bf16_t* Bt; int K; };

__device__ __forceinline__ unsigned cvt_pk_bf16(float lo, float hi) { return pk2(lo, hi); }
__device__ __forceinline__ unsigned cvt_pk_bf16_pin(float lo, float hi) { unsigned r; asm volatile("v_cvt_pk_bf16_f32 %0, %1, %2" : "=v"(r) : "v"(lo), "v"(hi)); return r; }

__device__ __forceinline__ bool static_tile(int i, int G, int c, int nM, int nN, int& pm, int& pn, int rep = 1) {
    const int nwg = nM * nN;
#if REP_GEMM > 1
    { const int cnt = (nwg - c + G - 1) / G; if (cnt <= 0 || i >= rep * cnt) return false; i %= cnt; }
#endif
    const long L = (long)i * G + c; if (L >= nwg) return false;
    int wgid = (int)L; { const int q = nwg / NXCD, r = nwg % NXCD, xcd = wgid % NXCD, off = wgid / NXCD; wgid = (xcd < r ? xcd * (q + 1) : r * (q + 1) + (xcd - r) * q) + off; }
    const int nig = WGM * nN, gid = wgid / nig, fm = gid * WGM, gsz = (nM - fm) < WGM ? (nM - fm) : WGM;
    pm = fm + ((wgid % nig) % gsz); pn = (wgid % nig) / gsz; return true;
}
struct DenseOrder {
    int nM, nN, G, c, K, rep;
    __device__ __forceinline__ void init(int M, int N, int K_, int G_, int c_, int rep_ = 1) { nM = M / BM; nN = N / BM; G = G_; c = c_; K = K_; rep = rep_; }
    __device__ __forceinline__ bool next(int i, Unit& u) const { if (!static_tile(i, G, c, nM, nN, u.pm, u.pn, rep)) return false; u.bofs = (long)u.pn * BM * K * 2; return true; }
    static constexpr bool GATHER = false;
    __device__ __forceinline__ long a_base(const Unit& u) const { return (long)u.pm * BM * K * 2; }
    __device__ __forceinline__ void a_offs(int, const Unit&, int, unsigned (&)[2][2]) const {}
};
template <bool GATHER_> struct MoeOrder {
    int nM, nN, G, c, K; int ts[9]; long estride; const LAS unsigned short* rowoff; unsigned rowbytes;
    __device__ __forceinline__ int expert_of(int pm) const { int e = 0;
#pragma unroll
        for (int j = 1; j < 8; ++j) e += (pm >= ts[j]) ? 1 : 0; return e; }
    __device__ __forceinline__ bool next(int i, Unit& u) const { if (!static_tile(i, G, c, nM, nN, u.pm, u.pn, REP_GEMM)) return false; u.bofs = (long)expert_of(u.pm) * estride + (long)u.pn * BM * K * 2; return true; }
    static constexpr bool GATHER = GATHER_;
    __device__ __forceinline__ long a_base(const Unit& u) const { return GATHER_ ? 0l : (long)u.pm * BM * K * 2; }
    __device__ __forceinline__ void a_offs(int ui, const Unit&, int tid, unsigned (&o)[2][2]) const {
        int uix = ui;
#if REP_GEMM > 1
        { const int cnt = (nM * nN - c + G - 1) / G; uix = ui % cnt; }
#endif
        if (GATHER_) {
#pragma unroll
            for (int i = 0; i < 2; ++i) { int R, C; stage_rc(tid * 16 + i * 8192, R, C);
#pragma unroll
                for (int h = 0; h < 2; ++h) o[h][i] = (unsigned)rowoff[uix * 256 + h * HALF + R] * rowbytes + (unsigned)(C * 2); }
        }
    }
};

struct EpiBf16 {
    static constexpr bool PERM = true;
    bf16_t* O; int ldc;
    __device__ __forceinline__ void operator()(const f32x4 (&acc)[2][2][4][2], const Unit& u, int wr, int wc, int fr, int fq) const {
        const int row0 = u.pm * BM + wr * 64 + fr; const int col0 = u.pn * BM + wc * 32 + 8 * fq;
#pragma unroll
        for (int ai = 0; ai < 2; ++ai)
#pragma unroll
            for (int m = 0; m < 4; ++m) { bf16_t* rowp = O + (size_t)(row0 + ai * HALF + m * 16) * ldc + col0;
#pragma unroll
                for (int bj = 0; bj < 2; ++bj) { const f32x4 v0 = acc[ai][bj][m][0], v1 = acc[ai][bj][m][1];
                    u32x4 w; w.x = cvt_pk_bf16(v0[0], v0[1]); w.y = cvt_pk_bf16(v0[2], v0[3]); w.z = cvt_pk_bf16(v1[0], v1[1]); w.w = cvt_pk_bf16(v1[2], v1[3]);
                    *(u32x4*)(rowp + bj * HALF) = w; } }
    }
};
struct EpiSwiGLU {
    static constexpr bool PERM = true;
    bf16_t* O; int ldc;
    __device__ __forceinline__ void operator()(const f32x4 (&acc)[2][2][4][2], const Unit& u, int wr, int wc, int fr, int fq) const {
        const int row0 = u.pm * BM + wr * 64 + fr; const int col0 = u.pn * HALF + wc * 32 + 8 * fq;
#pragma unroll
        for (int ai = 0; ai < 2; ++ai)
#pragma unroll
            for (int m = 0; m < 4; ++m) { bf16_t* rowp = O + (size_t)(row0 + ai * HALF + m * 16) * ldc + col0;
                float h[8];
#pragma unroll
                for (int n = 0; n < 2; ++n)
#pragma unroll
                    for (int j = 0; j < 4; ++j) { const float g = acc[ai][0][m][n][j], up = acc[ai][1][m][n][j]; h[n * 4 + j] = g * __builtin_amdgcn_rcpf(1.0f + __expf(-g)) * up; }
                u32x4 w; w.x = cvt_pk_bf16(h[0], h[1]); w.y = cvt_pk_bf16(h[2], h[3]); w.z = cvt_pk_bf16(h[4], h[5]); w.w = cvt_pk_bf16(h[6], h[7]);
                *(u32x4*)rowp = w; }
    }
};
struct EpiSwiGLU8 {
    static constexpr bool PERM = true;
    unsigned char* O; int ldc;
    __device__ __forceinline__ void operator()(const f32x4 (&acc)[2][2][4][2], const Unit& u, int wr, int wc, int fr, int fq) const {
        const int row0 = u.pm * BM + wr * 64 + fr; const int col0 = u.pn * HALF + wc * 32 + 8 * fq;
#pragma unroll
        for (int ai = 0; ai < 2; ++ai)
#pragma unroll
            for (int m = 0; m < 4; ++m) { unsigned char* rowp = O + (size_t)(row0 + ai * HALF + m * 16) * ldc + col0;
                float h[8];
#pragma unroll
                for (int n = 0; n < 2; ++n)
#pragma unroll
                    for (int j = 0; j < 4; ++j) { const float g = acc[ai][0][m][n][j], up = acc[ai][1][m][n][j]; h[n * 4 + j] = g * __builtin_amdgcn_rcpf(1.0f + __expf(-g)) * up * (float)(1 << S8_HID); }
                u32x2 w; w.x = pk8(h[0], h[1], h[2], h[3]); w.y = pk8(h[4], h[5], h[6], h[7]);
                *(u32x2*)rowp = w; }
    }
};
struct EpiResid {
    static constexpr bool PERM = false;
    const void* base_lat; const void* base_ctx; bf16_t* out; const float* mod; int gate_off; bool base_f32;
    __device__ __forceinline__ void operator()(const f32x4 (&acc)[2][2][4][2], const Unit& u, int wr, int wc, int fr, int fq) const {
        const int rt = u.pm * BM; const bool isctx = rt >= NLAT; const int bi = isctx ? 16 : (rt >> 11);
        const size_t brow = isctx ? (size_t)(rt - NLAT) : (size_t)rt;
        const float* bf = (const float*)(isctx ? base_ctx : base_lat) + brow * D; const bf16_t* bh = (const bf16_t*)(isctx ? base_ctx : base_lat) + brow * D;
        bf16_t* o = out + (size_t)rt * D; const float* gt = mod + bi * MODW + gate_off;
        const int r0 = wr * 64 + fr, col0 = u.pn * BM + wc * 32 + 4 * fq;
        f32x4 gv[2][2];
#pragma unroll
        for (int bj = 0; bj < 2; ++bj)
#pragma unroll
            for (int n = 0; n < 2; ++n) gv[bj][n] = *(const f32x4*)(gt + col0 + bj * HALF + n * 16) + 1.0f;
#pragma unroll
        for (int ai = 0; ai < 2; ++ai)
#pragma unroll
            for (int m = 0; m < 4; ++m) { const size_t off = (size_t)(r0 + ai * HALF + m * 16) * D + col0;
#pragma unroll
                for (int bj = 0; bj < 2; ++bj)
#pragma unroll
                    for (int n = 0; n < 2; ++n) { f32x4 bs;
                        if (base_f32) bs = *(const f32x4*)(bf + off + bj * HALF + n * 16);
                        else { const u32x2 w = *(const u32x2*)(bh + off + bj * HALF + n * 16); bs = (f32x4){bflo(w.x), bfhi(w.x), bflo(w.y), bfhi(w.y)}; }
                        const f32x4 r = bs * ALPHA + gv[bj][n] * acc[ai][bj][m][n];
                        u32x2 ow; ow.x = pk2(r[0], r[1]); ow.y = pk2(r[2], r[3]);
                        *(u32x2*)(o + off + bj * HALF + n * 16) = ow; }
                if (m & 1) asm volatile("" ::: "memory"); }
    }
};

template <class Epi, class Sched, bool ALIGN_EPI, bool SP2, bool FP8 = false>
__device__ __forceinline__ void gemm_phase(LAS unsigned char* lds, const Gemm g, const Sched& S, const Epi& E, int tid_in, int sw = 0x7f7f7f7f, int sa = 0x7f7f7f7f) {
    int tid_ = tid_in; asm volatile("" : "+v"(tid_));
    const int tid = tid_, wid = __builtin_amdgcn_readfirstlane(tid >> 6), lane = tid & 63, wr = wid >> 2, wc = wid & 3, fr = lane & 15, fq = lane >> 4;
    const int K = g.K, nt = K / BK;
    constexpr bool GA = Sched::GATHER;
    unsigned voffA[2], voffB[2];
#pragma unroll
    for (int i = 0; i < 2; ++i) { int R, C; stage_rc(tid * 16 + i * 8192, R, C); const int Rb = Epi::PERM ? ((R & ~31) + perm32(R & 31)) : R;
        voffA[i] = (unsigned)(R * K + C) * 2u; voffB[i] = (unsigned)(Rb * K + C) * 2u; }
    const size_t kstep = (size_t)(BK * 2);
    const size_t hstep = (size_t)HALF * K * 2;
    const unsigned ldsw = (unsigned)wid * 1024u;
    const int aoff = lds_byte(wr * 64 + fr, fq * 8), boff = lds_byte(wc * 32 + fr, fq * 8);
#define PG8_SA(b, h) (((b) * 2 + (h)) * HTB)
#define PG8_SB(b, h) ((4 + (b) * 2 + (h)) * HTB)
#define PG8_STAGE(bufoff, gbase, voff) do { _Pragma("unroll") for (int _i = 0; _i < 2; ++_i) \
        __builtin_amdgcn_global_load_lds((const unsigned*)((const char*)(gbase) + (voff)[_i]), (LAS unsigned*)(lds + (bufoff) + ldsw + _i * 8192), 16, 0, 0); } while (0)
#define PG8_LDA(dst, b, h) do { _Pragma("unroll") for (int m = 0; m < 4; ++m) _Pragma("unroll") for (int k = 0; k < 2; ++k) dst[m][k] = *(const LAS bf16x8*)(lds + PG8_SA(b, h) + aoff + m * 2048 + k * 1024); } while (0)
#define PG8_LDB(dst, b, h) do { _Pragma("unroll") for (int n = 0; n < 2; ++n) _Pragma("unroll") for (int k = 0; k < 2; ++k) dst[n][k] = *(const LAS bf16x8*)(lds + PG8_SB(b, h) + boff + n * 2048 + k * 1024); } while (0)
#define PG8_CAT(x) __builtin_shufflevector(__builtin_bit_cast(i32x4, (x)[0]), __builtin_bit_cast(i32x4, (x)[1]), 0, 1, 2, 3, 4, 5, 6, 7)
#define PG8_MMA(ai, bj, At, Bt) do { __builtin_amdgcn_s_setprio(1); _Pragma("unroll") for (int m = 0; m < 4; ++m) _Pragma("unroll") for (int n = 0; n < 2; ++n) { \
        if constexpr (FP8) { const i32x8 a8_ = PG8_CAT(Bt[n]), b8_ = PG8_CAT(At[m]); \
            asm volatile("v_mfma_scale_f32_16x16x128_f8f6f4 %0, %1, %2, %0, %3, %4 op_sel_hi:[0,0,0]" : "+v"(acc[ai][bj][m][n]) : "v"(a8_), "v"(b8_), "v"(sw), "v"(sa)); } \
        else { _Pragma("unroll") for (int k = 0; k < 2; ++k) acc[ai][bj][m][n] = __builtin_amdgcn_mfma_f32_16x16x32_bf16(Bt[n][k], At[m][k], acc[ai][bj][m][n], 0, 0, 0); } } \
        __builtin_amdgcn_s_setprio(0); } while (0)
#define PG8_WAIT_V(n) asm volatile("s_waitcnt vmcnt(" #n ")" ::: "memory")
#define PG8_WAIT_L(n) asm volatile("s_waitcnt lgkmcnt(" #n ")" ::: "memory")
#define PG8_BAR __builtin_amdgcn_s_barrier()
#define PG8_SCHED __builtin_amdgcn_sched_barrier(0)
    Unit cur, nxt; int ui = 0;
    if (!S.next(0, cur)) return;
    f32x4 acc[2][2][4][2];
#pragma unroll
    for (int a = 0; a < 2; ++a)
#pragma unroll
        for (int b = 0; b < 2; ++b)
#pragma unroll
            for (int m = 0; m < 4; ++m)
#pragma unroll
                for (int n = 0; n < 2; ++n) acc[a][b][m][n] = (f32x4){0.f, 0.f, 0.f, 0.f};
    bf16x8 At[4][2], B0[2][2], B1[2][2];
    const char* Ab = (const char*)g.A + S.a_base(cur);
    unsigned oc[2][2];
    S.a_offs(0, cur, tid, oc);
    const size_t hsA = GA ? (size_t)0 : hstep;
#define PG8_STAGE_A(bufoff, gbase, h) do { if constexpr (GA) PG8_STAGE(bufoff, gbase, oc[h]); else PG8_STAGE(bufoff, (gbase) + (h) * hsA, voffA); } while (0)
    const char* cB = (const char*)g.Bt + cur.bofs;
    if constexpr (SP2) {
        PG8_STAGE(PG8_SB(0, 0), cB, voffB); PG8_STAGE(PG8_SB(0, 1), cB + hstep, voffB); PG8_STAGE_A(PG8_SA(0, 0), Ab, 0); PG8_STAGE_A(PG8_SA(0, 1), Ab, 1);
        if (wr == 1) PG8_BAR;
        PG8_WAIT_V(2); PG8_BAR;
        PG8_STAGE(PG8_SB(1, 0), cB + kstep, voffB); PG8_STAGE_A(PG8_SA(1, 0), Ab + kstep, 0); PG8_STAGE(PG8_SB(1, 1), cB + hstep + kstep, voffB);
        PG8_WAIT_V(6); PG8_BAR;
    } else {
        PG8_STAGE(PG8_SB(0, 0), cB, voffB); PG8_STAGE_A(PG8_SA(0, 0), Ab, 0); PG8_STAGE(PG8_SB(0, 1), cB + hstep, voffB); PG8_STAGE_A(PG8_SA(0, 1), Ab, 1);
        if (wr == 1) PG8_BAR;
        PG8_WAIT_V(4); PG8_BAR;
        PG8_STAGE(PG8_SB(1, 0), cB + kstep, voffB); PG8_STAGE_A(PG8_SA(1, 0), Ab + kstep, 0); PG8_STAGE(PG8_SB(1, 1), cB + hstep + kstep, voffB);
        PG8_WAIT_V(6); PG8_BAR;
    }
    for (;;) {
        const bool has_next = S.next(ui + 1, nxt);
        const char* nB = has_next ? (const char*)g.Bt + nxt.bofs : cB;
        for (int t = 0; t < nt; t += 2) {
            const bool last = (t == nt - 2);
            const char* a1 = Ab + (size_t)(t + 1) * kstep;
            const char* b2 = last ? nB : cB + (size_t)(t + 2) * kstep; const char* b3 = b2 + kstep;
            if constexpr (SP2) {
            PG8_LDB(B0, 0, 0); PG8_LDB(B1, 0, 1); PG8_SCHED; PG8_LDA(At, 0, 0); PG8_STAGE_A(PG8_SA(1, 1), a1, 1);
            if (last && has_next) { S.a_offs(ui + 1, nxt, tid, oc); Ab = (const char*)g.A + S.a_base(nxt); }
            const char* a2 = last ? Ab : Ab + (size_t)(t + 2) * kstep; const char* a3 = a2 + kstep;
            PG8_WAIT_V(8); PG8_WAIT_L(0); PG8_BAR; PG8_MMA(0, 0, At, B0); PG8_MMA(0, 1, At, B1); PG8_BAR; PG8_SCHED;
            PG8_LDA(At, 0, 1); PG8_STAGE(PG8_SB(0, 0), b2, voffB); PG8_STAGE(PG8_SB(0, 1), b2 + hstep, voffB); PG8_STAGE_A(PG8_SA(0, 0), a2, 0);
            PG8_WAIT_V(8); PG8_WAIT_L(0); PG8_BAR; PG8_MMA(1, 0, At, B0); PG8_MMA(1, 1, At, B1); PG8_BAR; PG8_SCHED;
            PG8_LDB(B0, 1, 0); PG8_LDB(B1, 1, 1); PG8_SCHED; PG8_LDA(At, 1, 0); PG8_STAGE_A(PG8_SA(0, 1), a2, 1);
            PG8_WAIT_V(8); PG8_WAIT_L(0); PG8_BAR; PG8_MMA(0, 0, At, B0); PG8_MMA(0, 1, At, B1); PG8_BAR; PG8_SCHED;
            PG8_LDA(At, 1, 1); PG8_STAGE(PG8_SB(1, 0), b3, voffB); PG8_STAGE(PG8_SB(1, 1), b3 + hstep, voffB); PG8_STAGE_A(PG8_SA(1, 0), a3, 0);
            PG8_WAIT_V(8); PG8_WAIT_L(0); PG8_BAR; PG8_MMA(1, 0, At, B0); PG8_MMA(1, 1, At, B1); PG8_BAR; PG8_SCHED;
            } else {
            PG8_LDB(B0, 0, 0); PG8_SCHED; PG8_LDA(At, 0, 0); PG8_STAGE_A(PG8_SA(1, 1), a1, 1);
            if (last && has_next) { S.a_offs(ui + 1, nxt, tid, oc); Ab = (const char*)g.A + S.a_base(nxt); }
            const char* a2 = last ? Ab : Ab + (size_t)(t + 2) * kstep; const char* a3 = a2 + kstep;
            PG8_WAIT_L(8); PG8_BAR; PG8_WAIT_L(0); PG8_MMA(0, 0, At, B0); PG8_BAR; PG8_SCHED;
            PG8_LDB(B1, 0, 1); PG8_STAGE(PG8_SB(0, 0), b2, voffB);
            PG8_BAR; PG8_WAIT_L(0); PG8_MMA(0, 1, At, B1); PG8_BAR;
            PG8_LDA(At, 0, 1); PG8_STAGE_A(PG8_SA(0, 0), a2, 0);
            PG8_BAR; PG8_WAIT_L(0); PG8_MMA(1, 0, At, B0); PG8_BAR; PG8_SCHED;
            PG8_STAGE(PG8_SB(0, 1), b2 + hstep, voffB);
            PG8_WAIT_V(6); PG8_BAR; PG8_MMA(1, 1, At, B1); PG8_BAR;
            PG8_LDB(B0, 1, 0); PG8_SCHED; PG8_LDA(At, 1, 0); PG8_STAGE_A(PG8_SA(0, 1), a2, 1);
            PG8_WAIT_L(8); PG8_BAR; PG8_WAIT_L(0); PG8_MMA(0, 0, At, B0); PG8_BAR; PG8_SCHED;
            PG8_LDB(B1, 1, 1); PG8_STAGE(PG8_SB(1, 0), b3, voffB);
            PG8_BAR; PG8_WAIT_L(0); PG8_MMA(0, 1, At, B1); PG8_BAR;
            PG8_LDA(At, 1, 1); PG8_STAGE_A(PG8_SA(1, 0), a3, 0);
            PG8_BAR; PG8_WAIT_L(0); PG8_MMA(1, 0, At, B0); PG8_BAR; PG8_SCHED;
            PG8_STAGE(PG8_SB(1, 1), b3 + hstep, voffB);
            PG8_WAIT_V(6); PG8_BAR; PG8_MMA(1, 1, At, B1); PG8_BAR;
            }
        }
        if constexpr (ALIGN_EPI) { if (wr == 0) PG8_BAR; }
        if constexpr (FP8) asm volatile("s_nop 15\n\ts_nop 15\n\ts_nop 15" ::: "memory");
        E(acc, cur, wr, wc, fr, fq);
        if (!has_next) break;
#pragma unroll
        for (int a = 0; a < 2; ++a)
#pragma unroll
            for (int b = 0; b < 2; ++b)
#pragma unroll
                for (int m = 0; m < 4; ++m)
#pragma unroll
                    for (int n = 0; n < 2; ++n) acc[a][b][m][n] = (f32x4){0.f, 0.f, 0.f, 0.f};
        cur = nxt; cB = nB; ++ui;
        if constexpr (ALIGN_EPI) { if (wr == 1) PG8_BAR; }
    }
    PG8_WAIT_V(0);
    if constexpr (!ALIGN_EPI) { if (wr == 0) PG8_BAR; }
    PG8_BAR;
#undef PG8_SA
#undef PG8_SB
#undef PG8_STAGE
#undef PG8_STAGE_A
#undef PG8_LDA
#undef PG8_LDB
#undef PG8_MMA
#undef PG8_CAT
#undef PG8_WAIT_V
#undef PG8_WAIT_L
#undef PG8_BAR
#undef PG8_SCHED
}
}

#define XB_TMO      128
#define XB_XCNT(j)  (256  + 64 * (j))
#define XB_XSUB(j)  (1280 + 64 * (j))
#define XB_XGEN(j)  (2304 + 64 * (j))
#define XB_TOP      3328
#define XB_TOPGEN   3392
#define XCD_BAR_WORDS 3456
#define XB_SPIN_CAP (1u << 18)
__device__ __forceinline__ unsigned xb_ld(unsigned* p)              { return __hip_atomic_load(p, __ATOMIC_RELAXED, __HIP_MEMORY_SCOPE_AGENT); }
__device__ __forceinline__ unsigned xb_add(unsigned* p, unsigned v) { return __hip_atomic_fetch_add(p, v, __ATOMIC_RELAXED, __HIP_MEMORY_SCOPE_AGENT); }
__device__ __forceinline__ unsigned xb_xcc_id() { return (unsigned)__builtin_amdgcn_s_getreg((3 << 11) | 20) & 0xFu; }
#define XB_SPIN(cond, bar) do { unsigned _sp = 0; while (cond) { __builtin_amdgcn_s_sleep(1); \
    if ((++_sp & 255u) == 0u) { if (xb_ld(&(bar)[XB_TMO])) break; if (_sp > XB_SPIN_CAP) { atomicAdd(&(bar)[XB_TMO], 1u); break; } } } } while (0)
struct XcdBarrier { unsigned* bar; unsigned x; volatile LAS unsigned* st; };
__device__ __forceinline__ XcdBarrier xcd_barrier_post(unsigned* bar, volatile LAS unsigned* st) {
    XcdBarrier b; b.bar = bar; b.x = xb_xcc_id(); b.st = st;
    if (threadIdx.x == 0) (void)xb_add(&bar[XB_XCNT(b.x)], 1u);
    return b;
}
__device__ __forceinline__ void xcd_barrier_complete(unsigned* bar, unsigned x, unsigned& nloc, unsigned& nx) {
    const unsigned G = gridDim.x * gridDim.y * gridDim.z;
    unsigned sum, cnt, mine, sp = 0u;
    for (;;) {
        sum = 0u; cnt = 0u; mine = 0u;
#pragma unroll
        for (unsigned j = 0; j < 16; ++j) { const unsigned c = xb_ld(&bar[XB_XCNT(j)]); sum += c; cnt += (c > 0u) ? 1u : 0u; }
        mine = xb_ld(&bar[XB_XCNT(x)]);
        if (sum == G) break;
        __builtin_amdgcn_s_sleep(1);
        if ((++sp & 255u) == 0u) { if (xb_ld(&bar[XB_TMO])) break; if (sp > XB_SPIN_CAP) { atomicAdd(&bar[XB_TMO], 1u); break; } }
    }
    nloc = mine > 0u ? mine : 1u; nx = cnt > 0u ? cnt : 1u;
}
__device__ __forceinline__ void xcd_barrier(const XcdBarrier& b, bool leader) {
    asm volatile("s_waitcnt vmcnt(0)" ::: "memory");
    __syncthreads();
    if (leader) {
        unsigned* bar = b.bar;
        __builtin_amdgcn_s_waitcnt(0);
        unsigned nloc = b.st[0], nx = b.st[1];
        if (nloc == 0u) { xcd_barrier_complete(bar, b.x, nloc, nx); b.st[0] = nloc; b.st[1] = nx; }
        const unsigned old = xb_add(&bar[XB_XSUB(b.x)], 1u);
        const unsigned gen = old / nloc;
        if (old + 1u == (gen + 1u) * nloc) {
            __builtin_amdgcn_fence(__ATOMIC_RELEASE, "agent");
            asm volatile("s_waitcnt vmcnt(0)" ::: "memory");
            const unsigned og = xb_add(&bar[XB_TOP], 1u);
            const unsigned tg = og / nx;
            if (og + 1u == (tg + 1u) * nx) xb_add(&bar[XB_TOPGEN], 1u);
            else XB_SPIN(xb_ld(&bar[XB_TOPGEN]) == tg, bar);
            __builtin_amdgcn_fence(__ATOMIC_ACQUIRE, "agent");
            xb_add(&bar[XB_XGEN(b.x)], 1u);
            asm volatile("s_waitcnt vmcnt(0)" ::: "memory");
        } else {
            XB_SPIN(xb_ld(&bar[XB_XGEN(b.x)]) == gen, bar);
            __builtin_amdgcn_fence(__ATOMIC_ACQUIRE, "agent");
            asm volatile("s_waitcnt vmcnt(0)" ::: "memory");
        }
    }
    __syncthreads();
}

constexpr int NT = 512, NWAVES = 8;
struct Args { const float* in[24]; float* out; unsigned char* ws; int ph_lo, ph_hi; };
enum { I_X = 0, I_C, I_CTX, I_CCTX, I_WMOD, I_BMOD, I_WIN, I_WOUT, I_RPB, I_CONVW, I_CONVB, I_DTB, I_ALOG, I_DSKIP, I_NORMW, I_LNG, I_LNB, I_FG, I_FU, I_FD, I_RW, I_MG, I_MU, I_MD };
struct Frame {
    LAS unsigned char* lds;
    const float* const* in; float* out; unsigned char* ws;
    int tid, lane, wave, bid, G, gw, NGW;
};
#define LDS_WAIT() asm volatile("s_waitcnt lgkmcnt(0)" ::: "memory")
__device__ __forceinline__ Frame fresh(const Frame& F0) {
    Frame F = F0; int z; asm volatile("s_mov_b32 %0, 0" : "=s"(z)); F.ws = F0.ws + z; F.in = F0.in + z; F.out = F0.out + z;
    int ln; asm volatile("v_mbcnt_lo_u32_b32 %0, -1, 0\n\tv_mbcnt_hi_u32_b32 %0, -1, %0" : "=v"(ln));     int t = F0.wave * 64 + ln;
    F.tid = t; F.lane = t & 63; return F;
}

__device__ __forceinline__ void conv_item(const float* W, int ldn, int k0, int n0, bf16_t* dst, int K, int drow0, LAS float* scr, int lane) {
    f32x4 ld[8];
#pragma unroll
    for (int i = 0; i < 8; ++i) ld[i] = *(const f32x4*)(W + (size_t)(k0 + 8 * i + (lane >> 3)) * ldn + n0 + 4 * (lane & 7));
#pragma unroll
    for (int i = 0; i < 8; ++i) { LAS float* d = scr + (8 * i + (lane >> 3)) * 33 + 4 * (lane & 7); d[0] = ld[i][0]; d[1] = ld[i][1]; d[2] = ld[i][2]; d[3] = ld[i][3]; }
    LDS_WAIT(); asm volatile("" ::: "memory");
    const int c = lane & 7;
#pragma unroll
    for (int j = 0; j < 4; ++j) { const int n = (lane >> 3) + 8 * j; const LAS float* s = scr + (8 * c) * 33 + n;
        u32x4 o; o.x = pk2(s[0 * 33], s[1 * 33]); o.y = pk2(s[2 * 33], s[3 * 33]); o.z = pk2(s[4 * 33], s[5 * 33]); o.w = pk2(s[6 * 33], s[7 * 33]);
        *(u32x4*)(dst + (size_t)(drow0 + n) * K + k0 + 8 * c) = o; }
    LDS_WAIT(); asm volatile("" ::: "memory");
}
__device__ __forceinline__ void conv_item8(const float* W, int ldn, int k0, int n0, unsigned char* dst, int K, int drow0, float scale, LAS float* scr, int lane) {
    f32x4 ld[8];
#pragma unroll
    for (int i = 0; i < 8; ++i) ld[i] = *(const f32x4*)(W + (size_t)(k0 + 8 * i + (lane >> 3)) * ldn + n0 + 4 * (lane & 7));
#pragma unroll
    for (int i = 0; i < 8; ++i) { LAS float* d = scr + (8 * i + (lane >> 3)) * 33 + 4 * (lane & 7); d[0] = ld[i][0] * scale; d[1] = ld[i][1] * scale; d[2] = ld[i][2] * scale; d[3] = ld[i][3] * scale; }
    LDS_WAIT(); asm volatile("" ::: "memory");
    const int c = lane & 7;
#pragma unroll
    for (int j = 0; j < 4; ++j) { const int n = (lane >> 3) + 8 * j; const LAS float* sp = scr + (8 * c) * 33 + n;
        u32x2 o; o.x = pk8(sp[0 * 33], sp[1 * 33], sp[2 * 33], sp[3 * 33]); o.y = pk8(sp[4 * 33], sp[5 * 33], sp[6 * 33], sp[7 * 33]);
        *(u32x2*)(dst + (size_t)(drow0 + n) * K + k0 + 8 * c) = o; }
    LDS_WAIT(); asm volatile("" ::: "memory");
}
__device__ __forceinline__ void conv_seg(const Frame& F, const float* W, int K, int ldn, int ncols, bf16_t* dst, int mode, int& rot, int s8 = -1) {
    LAS float* scr = (LAS float*)(F.lds + F.wave * 16384);
    const int nblk = ncols / 32, nitems = (K / 64) * nblk;
    int start = F.gw - rot; if (start < 0) start += F.NGW;
    for (int it = start; it < nitems; it += F.NGW) {
        const int kb = it / nblk, nb = it % nblk, n0 = nb * 32;
        const int drow0 = (mode == 0) ? n0 : ((n0 >> 7) * 256 + (n0 & 127) + (mode == 2 ? 128 : 0));
        if (s8 >= 0) conv_item8(W, ldn, kb * 64, n0, (unsigned char*)dst, K, drow0, (float)(1 << s8), scr, F.lane);
        else conv_item(W, ldn, kb * 64, n0, dst, K, drow0, scr, F.lane);
    }
    rot = (rot + nitems) % F.NGW;
}
__device__ __forceinline__ void conv_moe(const Frame& F, int slot, int& rot) {
#if USE_FP8
    unsigned char* gu = F.ws + WS_WMGU + (size_t)slot * NEXP * 2 * DFFE * D; unsigned char* dn = F.ws + WS_WMD + (size_t)slot * NEXP * D * DFFE;
    for (int e = 0; e < NEXP; ++e) {
        const size_t so = ((size_t)slot * NEXP + e) * (size_t)D * DFFE;
        conv_seg(F, F.in[I_MG] + so, D, DFFE, DFFE, (bf16_t*)(gu + (size_t)e * 2 * DFFE * D), 1, rot, S8_WGU);
        conv_seg(F, F.in[I_MU] + so, D, DFFE, DFFE, (bf16_t*)(gu + (size_t)e * 2 * DFFE * D), 2, rot, S8_WGU);
        conv_seg(F, F.in[I_MD] + so, DFFE, D, D, (bf16_t*)(dn + (size_t)e * D * DFFE), 0, rot, S8_WD);
    }
#else
    bf16_t* gu = (bf16_t*)(F.ws + WS_WMGU); bf16_t* dn = (bf16_t*)(F.ws + WS_WMD);
    for (int e = 0; e < NEXP; ++e) {
        const size_t so = ((size_t)slot * NEXP + e) * (size_t)D * DFFE;
        conv_seg(F, F.in[I_MG] + so, D, DFFE, DFFE, gu + (size_t)e * 2 * DFFE * D, 1, rot);
        conv_seg(F, F.in[I_MU] + so, D, DFFE, DFFE, gu + (size_t)e * 2 * DFFE * D, 2, rot);
        conv_seg(F, F.in[I_MD] + so, DFFE, D, D, dn + (size_t)e * D * DFFE, 0, rot);
    }
#endif
}

constexpr int MOE_ITEMS_MAT = 1792, MOE_ITEMS_EXP = 3 * MOE_ITEMS_MAT, MOE_ITEMS_SLOT = 8 * MOE_ITEMS_EXP, MOE_ITEMS = 2 * MOE_ITEMS_SLOT;
__device__ __forceinline__ void conv_moe_item(const Frame& F, int gidx) {
    LAS float* scr = (LAS float*)(F.lds + F.wave * 16384);
    const int slot = gidx / MOE_ITEMS_SLOT, r = gidx % MOE_ITEMS_SLOT, e = r / MOE_ITEMS_EXP, r2 = r % MOE_ITEMS_EXP, mat = r2 / MOE_ITEMS_MAT, it = r2 % MOE_ITEMS_MAT;
    const size_t so = ((size_t)slot * NEXP + e) * (size_t)D * DFFE;
    if (mat < 2) { const int kb = it / 112, nb = it % 112, n0 = nb * 32; const int drow0 = (n0 >> 7) * 256 + (n0 & 127) + (mat == 1 ? 128 : 0);
        conv_item8((mat ? F.in[I_MU] : F.in[I_MG]) + so, DFFE, kb * 64, n0, F.ws + WS_WMGU + ((size_t)slot * NEXP + e) * 2 * DFFE * D, D, drow0, (float)(1 << S8_WGU), scr, F.lane); }
    else { const int kb = it / 32, nb = it % 32, n0 = nb * 32;
        conv_item8(F.in[I_MD] + so, D, kb * 64, n0, F.ws + WS_WMD + ((size_t)slot * NEXP + e) * D * DFFE, DFFE, n0, (float)(1 << S8_WD), scr, F.lane); }
}
__device__ __forceinline__ void deferred_conv(const Frame& F, int nwg, int base, int quota) {
    if (F.G != 256) return;
    const int maxu = (nwg + F.G - 1) / F.G, c0 = nwg - (maxu - 1) * F.G;
    if (c0 >= F.G || F.bid < c0) return;
    const int first = base + ((F.bid - c0) * NWAVES + F.wave) * quota;
    for (int j = 0; j < quota; ++j) { const int gidx = first + j; if (gidx < MOE_ITEMS) conv_moe_item(F, gidx); }
}
constexpr int DW_Q = 12, DW_Q2 = 10;
constexpr int DW_L0_IN = 0, DW_L0_OUT = DW_L0_IN + 64 * 8 * DW_Q, DW_L0_F1 = DW_L0_OUT + 192 * 8 * DW_Q, DW_L0_F2 = DW_L0_F1 + 160 * 8 * DW_Q, DW_L1_IN = DW_L0_F2 + 192 * 8 * DW_Q2, DW_L1_OUT = DW_L1_IN + 64 * 8 * DW_Q, DW_L2_IN = DW_L1_OUT + 192 * 8 * DW_Q, DW_END = DW_L2_IN + 64 * 8 * DW_Q;
static_assert(DW_L1_IN >= MOE_ITEMS_SLOT && DW_END >= MOE_ITEMS, "deferred conversion: layer-1 experts must be done before layer 1's FFN, all before layer 3's");
__device__ __forceinline__ void p_pro_a(const Frame& F) {
    {
        LAS float* sc = (LAS float*)F.lds; LAS float* red = sc + 17 * 1024;
        const float* c = F.in[I_C]; const float* cc = F.in[I_CCTX];
        for (int i = F.tid; i < 17 * 1024; i += NT) { const int r = i >> 10, k = i & 1023; const float v = (r < 16) ? c[r * 1024 + k] : cc[k]; sc[i] = silu_f(v); }
        __syncthreads();
        float* MOD = (float*)(F.ws + WS_MOD);
        const int col = F.tid & 31, ks = F.tid >> 5;
        for (int u = F.bid; u < 4 * 192; u += F.G) {
            const int l = u / 192, cb = u % 192;
            const float* W = F.in[I_WMOD] + (size_t)l * D * MODW + cb * 32 + col;
            float acc[17];
#pragma unroll
            for (int r = 0; r < 17; ++r) acc[r] = 0.f;
#pragma unroll 1
            for (int kb = 0; kb < 4; ++kb) { float w[16];
#pragma unroll
                for (int i = 0; i < 16; ++i) w[i] = W[(size_t)(ks * 64 + kb * 16 + i) * MODW];
#pragma unroll
                for (int i = 0; i < 16; ++i) { const int k = ks * 64 + kb * 16 + i;
#pragma unroll
                    for (int r = 0; r < 17; ++r) acc[r] += sc[r * 1024 + k] * w[i]; } }
#pragma unroll
            for (int r = 0; r < 17; ++r) red[(ks * 17 + r) * 32 + col] = acc[r];
            __syncthreads();
            for (int i = F.tid; i < 17 * 32; i += NT) { const int r = i >> 5, c2 = i & 31; float sm = 0.f;
#pragma unroll
                for (int k2 = 0; k2 < 16; ++k2) sm += red[(k2 * 17 + r) * 32 + c2];
                MOD[(size_t)(l * 17 + r) * MODW + cb * 32 + c2] = sm + F.in[I_BMOD][l * MODW + cb * 32 + c2]; }
            __syncthreads();
        }
    }
    int rot = 0;
    for (int l = 0; l < DEPTH; ++l) {
#if USE_FP8 && FP8_INPROJ
        conv_seg(F, F.in[I_WIN] + (size_t)l * D * D_IN_PROJ, D, D_IN_PROJ, NPROJ, (bf16_t*)(F.ws + WS_WIN + (size_t)l * NPROJ * D), 0, rot, S8_WGU);
#else
        conv_seg(F, F.in[I_WIN] + (size_t)l * D * D_IN_PROJ, D, D_IN_PROJ, NPROJ, (bf16_t*)(F.ws + WS_WIN) + (size_t)l * NPROJ * D, 0, rot);
#endif
        conv_seg(F, F.in[I_WOUT] + (size_t)l * D * D, D, D, D, (bf16_t*)(F.ws + WS_WOUT) + (size_t)l * D * D, 0, rot);
    }
    for (int s = 0; s < 2; ++s) {
#if USE_FP8 && FP8_DENSE1
        conv_seg(F, F.in[I_FG] + (size_t)s * D * DFF, D, DFF, DFF, (bf16_t*)(F.ws + WS_WFGU + (size_t)s * 2 * DFF * D), 1, rot, S8_WGU);
        conv_seg(F, F.in[I_FU] + (size_t)s * D * DFF, D, DFF, DFF, (bf16_t*)(F.ws + WS_WFGU + (size_t)s * 2 * DFF * D), 2, rot, S8_WGU);
#else
        conv_seg(F, F.in[I_FG] + (size_t)s * D * DFF, D, DFF, DFF, (bf16_t*)(F.ws + WS_WFGU) + (size_t)s * 2 * DFF * D, 1, rot);
        conv_seg(F, F.in[I_FU] + (size_t)s * D * DFF, D, DFF, DFF, (bf16_t*)(F.ws + WS_WFGU) + (size_t)s * 2 * DFF * D, 2, rot);
#endif
#if USE_FP8 && FP8_DENSE2
        conv_seg(F, F.in[I_FD] + (size_t)s * DFF * D, DFF, D, D, (bf16_t*)(F.ws + WS_WFD + (size_t)s * D * DFF), 0, rot, S8_WD);
#else
        conv_seg(F, F.in[I_FD] + (size_t)s * DFF * D, DFF, D, D, (bf16_t*)(F.ws + WS_WFD) + (size_t)s * D * DFF, 0, rot);
#endif
    }
    if (F.G != 256) { conv_moe(F, 0, rot); conv_moe(F, 1, rot); }
    { bf16_t* wdt = (bf16_t*)(F.ws + WS_WDT);
      for (int i = F.bid * NT + F.tid; i < DEPTH * 16 * D; i += F.G * NT) { const int l = i / (16 * D), n = (i / D) & 15, k = i % D;
          wdt[i] = (bf16_t)f2bf(F.in[I_WIN][((size_t)l * D + k) * D_IN_PROJ + NPROJ + n]); } }
}

#define RIDX(q) (8 * lane + 512 * ((q) >> 1) + 4 * ((q) & 1))
__device__ __forceinline__ void row_load(const float* p, int lane, f32x4 (&v)[4]) {
#pragma unroll
    for (int q = 0; q < 4; ++q) v[q] = *(const f32x4*)(p + RIDX(q));
}
__device__ __forceinline__ void row_store(float* p, int lane, const f32x4 (&v)[4]) {
#pragma unroll
    for (int q = 0; q < 4; ++q) *(f32x4*)(p + RIDX(q)) = v[q];
}
__device__ __forceinline__ void row_mod_store8(unsigned char* hrow, int lane, const f32x4 (&v)[4], const float* sh, const float* sc, f32x4 (&hv)[4]) {
#pragma unroll
    for (int j = 0; j < 2; ++j) { u32x2 w;
#pragma unroll
        for (int h = 0; h < 2; ++h) { const int q = 2 * j + h; const f32x4 a = *(const f32x4*)(sc + RIDX(q)), b = *(const f32x4*)(sh + RIDX(q));
            hv[q] = v[q] * (a + 1.0f) + b; const f32x4 t = hv[q] * (float)(1 << S8_ACT); const unsigned pw = pk8(t[0], t[1], t[2], t[3]); if (h == 0) w.x = pw; else w.y = pw; }
        *(u32x2*)(hrow + 8 * lane + 512 * j) = w; }
}
__device__ __forceinline__ void row_load_h(const bf16_t* p, int lane, f32x4 (&v)[4]) {
#pragma unroll
    for (int j = 0; j < 2; ++j) { const u32x4 w = *(const u32x4*)(p + 8 * lane + 512 * j); v[2 * j] = (f32x4){bflo(w.x), bfhi(w.x), bflo(w.y), bfhi(w.y)}; v[2 * j + 1] = (f32x4){bflo(w.z), bfhi(w.z), bflo(w.w), bfhi(w.w)}; }
}
__device__ __forceinline__ void row_store_h(bf16_t* p, int lane, const f32x4 (&v)[4]) {
#pragma unroll
    for (int j = 0; j < 2; ++j) { u32x4 w; w.x = pk2(v[2 * j][0], v[2 * j][1]); w.y = pk2(v[2 * j][2], v[2 * j][3]); w.z = pk2(v[2 * j + 1][0], v[2 * j + 1][1]); w.w = pk2(v[2 * j + 1][2], v[2 * j + 1][3]);
        *(u32x4*)(p + 8 * lane + 512 * j) = w; }
}
__device__ __forceinline__ void row_mod_store(bf16_t* hrow, int lane, const f32x4 (&v)[4], const float* sh, const float* sc, f32x4 (&hv)[4]) {
#pragma unroll
    for (int q = 0; q < 4; ++q) { const f32x4 a = *(const f32x4*)(sc + RIDX(q)), b = *(const f32x4*)(sh + RIDX(q)); hv[q] = v[q] * (a + 1.0f) + b; }
    row_store_h(hrow, lane, hv);
}
__device__ __forceinline__ void row_ln(f32x4 (&v)[4], const float* g, const float* b, int lane) {
    float s = 0.f;
#pragma unroll
    for (int j = 0; j < 4; ++j) s += (v[j][0] + v[j][1]) + (v[j][2] + v[j][3]);
    const float mean = wave_sum(s) * (1.0f / D); float q2 = 0.f;
#pragma unroll
    for (int j = 0; j < 4; ++j) { v[j] = v[j] - mean; q2 += (v[j][0] * v[j][0] + v[j][1] * v[j][1]) + (v[j][2] * v[j][2] + v[j][3] * v[j][3]); }
    const float rstd = 1.0f / sqrtf(wave_sum(q2) * (1.0f / D) + LN_EPS);
#pragma unroll
    for (int q = 0; q < 4; ++q) { const f32x4 gg = *(const f32x4*)(g + RIDX(q)), bb = *(const f32x4*)(b + RIDX(q)); v[q] = v[q] * rstd * gg + bb; }
}
__device__ __forceinline__ int mod_row_of(int row) { return row < NLAT ? (row >> 11) : 16; }

__device__ __forceinline__ void p_pro_b(const Frame& F) {
    const float* MOD = (const float*)(F.ws + WS_MOD); bf16_t* H = (bf16_t*)(F.ws + WS_H);
    for (int row = F.gw; row < NTOK; row += F.NGW) {
        const float* src = row < NLAT ? F.in[I_X] + (size_t)row * D : F.in[I_CTX] + (size_t)(row - NLAT) * D;
        f32x4 v[4], hv[4]; row_load(src, F.lane, v);
        const float* m = MOD + (size_t)mod_row_of(row) * MODW;
        row_mod_store(H + (size_t)row * D, F.lane, v, m, m + D, hv);
    }
}

__device__ __forceinline__ void p_inproj(const Frame& F, int layer) {
    const bf16_t* H = (const bf16_t*)(F.ws + WS_H);
    {
        const bf16_t* wdt = (const bf16_t*)(F.ws + WS_WDT) + (size_t)layer * 16 * D; float* DT = (float*)(F.ws + WS_DT);
        const int fr = F.lane & 15, fq = F.lane >> 4; const float dtb = F.in[I_DTB][layer * 16 + fr];
        for (int g = F.gw; g < NTOK / 16; g += F.NGW) {
            f32x4 acc = {0.f, 0.f, 0.f, 0.f};
            const bf16_t* ap = H + (size_t)(g * 16 + fr) * D + fq * 8; const bf16_t* bp = wdt + (size_t)fr * D + fq * 8;
#pragma unroll 8
            for (int ks = 0; ks < 32; ++ks) { const bf16x8 a = *(const bf16x8*)(ap + ks * 32), b = *(const bf16x8*)(bp + ks * 32);
                acc = __builtin_amdgcn_mfma_f32_16x16x32_bf16(a, b, acc, 0, 0, 0); }
#pragma unroll
            for (int r = 0; r < 4; ++r) { const float x = acc[r] + dtb; DT[(size_t)(g * 16 + fq * 4 + r) * 16 + fr] = x > 20.f ? x : log1pf(__expf(x)); }
        }
    }
    pg8::EpiBf16 E{(bf16_t*)(F.ws + WS_PROJ), NPROJ};
#if USE_FP8 && FP8_INPROJ
    pg8::Gemm g{(const bf16_t*)(F.ws + WS_H8IN), (const bf16_t*)(F.ws + WS_WIN + (size_t)layer * NPROJ * D), D / 2};
    pg8::DenseOrder S; S.init(NTOK, NPROJ, D / 2, F.G, F.bid, REP_GEMM);
    pg8::gemm_phase<pg8::EpiBf16, pg8::DenseOrder, true, FP8_SP2, true>(F.lds, g, S, E, F.tid, (127 - S8_WGU) * 0x01010101, (127 - S8_ACT) * 0x01010101);
#else
    pg8::Gemm g{H, (const bf16_t*)(F.ws + WS_WIN) + (size_t)layer * NPROJ * D, D};
    pg8::DenseOrder S; S.init(NTOK, NPROJ, D, F.G, F.bid, REP_GEMM);
    pg8::gemm_phase<pg8::EpiBf16, pg8::DenseOrder, true, true>(F.lds, g, S, E, F.tid);
#endif
    if (layer == 0) deferred_conv(F, (NTOK / 256) * (NPROJ / 256), DW_L0_IN, DW_Q); else if (layer < 3) deferred_conv(F, (NTOK / 256) * (NPROJ / 256), layer == 1 ? DW_L1_IN : DW_L2_IN, DW_Q);
}

typedef short s16x4 __attribute__((ext_vector_type(4)));
__device__ __forceinline__ s16x4 lds_tr16(LAS const unsigned char* p) { return __builtin_bit_cast(s16x4, __builtin_amdgcn_ds_read_tr16_b64_v4i16((LAS s16x4*)p)); }
constexpr int NA_KS = 144;
constexpr float LOG2E = 1.4426950408889634f;
__device__ __forceinline__ void na_unit(const Frame& F, int layer, int b, int h, int mode, int m) {
    LAS unsigned char* KV = F.lds;
    LAS float* rp = (LAS float*)(F.lds + 120832);
    const bf16_t* PROJ = (const bf16_t*)(F.ws + WS_PROJ); bf16_t* MIX = (bf16_t*)(F.ws + WS_MIX);
    const int tid = F.tid, lane = F.lane, w = F.wave, q16 = lane & 15, g = lane >> 4;
    int rbase = 0, nk = 0;
    if (mode == 0) { rbase = 2 * m - 4; rbase = rbase < 0 ? 0 : (rbase > 24 ? 24 : rbase); nk = 32 - rbase; nk = nk > 9 ? 9 : nk; }
    const int kfirst = (mode == 0) ? 0 : 576 * 8, nloc8 = nk * 64 * 8;
#define NA_STAGE(OFFS) do { int stid_ = tid; asm volatile("" : "+v"(stid_));     \
        NA_STAGE_PART(OFFS, 0, 7); __builtin_amdgcn_sched_barrier(0); NA_STAGE_PART(OFFS, 7, 13); __builtin_amdgcn_sched_barrier(0); } while (0)
#define NA_STAGE_PART(OFFS, K0, K1) do { u32x4 st_[13]; \
        _Pragma("unroll") for (int k_ = K0; k_ < K1; ++k_) { const int i_ = stid_ + kfirst + k_ * NT, key_ = i_ >> 3, ch_ = i_ & 7; const bool ok_ = (i_ < 832 * 8) && !(key_ < 576 && i_ >= nloc8); \
            const int grow_ = key_ < 576 ? b * SEQ + rbase * 64 + key_ : NLAT + b * CTX + (key_ - 576); \
            st_[k_] = ok_ ? *(const u32x4*)(PROJ + (size_t)grow_ * NPROJ + (OFFS) + h * 64 + ch_ * 8) : (u32x4){0u, 0u, 0u, 0u}; } \
        _Pragma("unroll") for (int k_ = K0; k_ < K1; ++k_) { const int i_ = stid_ + kfirst + k_ * NT, key_ = i_ >> 3, ch_ = i_ & 7; const bool ok_ = (i_ < 832 * 8) && !(key_ < 576 && i_ >= nloc8); \
            if (ok_) *(LAS u32x4*)(KV + key_ * NA_KS + ch_ * 16) = st_[k_]; } } while (0)
    __syncthreads();
    NA_STAGE(OFF_K);
    if (mode == 0 && tid < 465) rp[tid] = F.in[I_RPB][(size_t)(layer * 8 + h) * 465 + tid] * LOG2E;
    __syncthreads();
    int i = 0, j0 = 0, hs = 0, kr0 = 0, qrow;
    if (mode == 0) { i = 2 * m + (w >> 2); j0 = (w & 3) * 16; qrow = b * SEQ + i * 64 + j0; hs = j0 - 8; hs = hs < 0 ? 0 : (hs > 32 ? 32 : hs);
        int r0 = i - 4; r0 = r0 < 0 ? 0 : (r0 > 24 ? 24 : r0); kr0 = r0 - rbase; }
    else qrow = NLAT + b * CTX + m * 128 + w * 16;
    bf16x8 qf[2];
#pragma unroll
    for (int ks = 0; ks < 2; ++ks) qf[ks] = *(const bf16x8*)(PROJ + (size_t)(qrow + q16) * NPROJ + h * 64 + ks * 32 + g * 8);
    f32x4 S[32];
    const LAS unsigned char* kb = KV + q16 * NA_KS + g * 16;
    if (mode == 0) {
        const int j = j0 + q16; int cs = j - 8; cs = cs < 0 ? 0 : (cs > 48 ? 48 : cs);
        const int rb0 = (kr0 + rbase) - i + 7;
#pragma unroll
        for (int tl = 0; tl < 16; ++tl) { const int kr = tl >> 1, half = tl & 1; const int kidx0 = (kr0 + kr) * 64 + hs + 16 * half;
            f32x4 a = {0.f, 0.f, 0.f, 0.f};
#pragma unroll
            for (int ks = 0; ks < 2; ++ks) { const bf16x8 kf = *(const LAS bf16x8*)(kb + kidx0 * NA_KS + ks * 64); a = __builtin_amdgcn_mfma_f32_16x16x32_bf16(kf, qf[ks], a, 0, 0, 0); }
#pragma unroll
            for (int r = 0; r < 4; ++r) { const int kc = hs + 16 * half + 4 * g + r; const bool inw = (kc >= cs) && (kc < cs + 16);
                int cbi = kc - j + 15; cbi = cbi < 0 ? 0 : (cbi > 30 ? 30 : cbi);
                a[r] = inw ? a[r] * (0.125f * LOG2E) + rp[(rb0 + kr) * 31 + cbi] : -INFINITY; }
            S[tl] = a; if ((tl & 1) == 1) __builtin_amdgcn_sched_barrier(0); }
    } else {
#pragma unroll
        for (int tl = 0; tl < 16; ++tl) S[tl] = (f32x4){-INFINITY, -INFINITY, -INFINITY, -INFINITY};
    }
#pragma unroll
    for (int tc = 0; tc < 16; ++tc) { const int kidx0 = 576 + 16 * tc; f32x4 a = {0.f, 0.f, 0.f, 0.f};
#pragma unroll
        for (int ks = 0; ks < 2; ++ks) { const bf16x8 kf = *(const LAS bf16x8*)(kb + kidx0 * NA_KS + ks * 64); a = __builtin_amdgcn_mfma_f32_16x16x32_bf16(kf, qf[ks], a, 0, 0, 0); }
        S[16 + tc] = a * (0.125f * LOG2E); if ((tc & 1) == 1) __builtin_amdgcn_sched_barrier(0); }
    float mx = -INFINITY;
#pragma unroll
    for (int t = 0; t < 32; ++t) mx = fmaxf(fmaxf(fmaxf(S[t][0], S[t][1]), fmaxf(S[t][2], S[t][3])), mx);
    mx = fmaxf(mx, __shfl_xor(mx, 16)); mx = fmaxf(mx, __shfl_xor(mx, 32));
    float sum = 0.f; u32x4 P[16];
#pragma unroll
    for (int kk = 0; kk < 16; ++kk) { float e[8];
#pragma unroll
        for (int r = 0; r < 4; ++r) { e[r] = __builtin_amdgcn_exp2f(S[2 * kk][r] - mx); e[4 + r] = __builtin_amdgcn_exp2f(S[2 * kk + 1][r] - mx); }
        sum += ((e[0] + e[1]) + (e[2] + e[3])) + ((e[4] + e[5]) + (e[6] + e[7]));
        P[kk].x = pg8::cvt_pk_bf16_pin(e[0], e[1]); P[kk].y = pg8::cvt_pk_bf16_pin(e[2], e[3]); P[kk].z = pg8::cvt_pk_bf16_pin(e[4], e[5]); P[kk].w = pg8::cvt_pk_bf16_pin(e[6], e[7]); }
    sum += __shfl_xor(sum, 16); sum += __shfl_xor(sum, 32);
    const float inv = 1.0f / sum;
    __syncthreads();
    NA_STAGE(OFF_V);
    __syncthreads();
    f32x4 o[4];
#pragma unroll
    for (int dt = 0; dt < 4; ++dt) o[dt] = (f32x4){0.f, 0.f, 0.f, 0.f};
    const LAS unsigned char* vb = KV + (4 * g + (q16 >> 2)) * NA_KS + (q16 & 3) * 8;
#pragma unroll
    for (int kk = 0; kk < 16; ++kk) {
        if (kk < 8 && mode != 0) continue;
        const int kidx0 = (kk < 8) ? (kr0 + kk) * 64 + hs : 576 + 32 * (kk - 8);
        const bf16x8 pa = __builtin_bit_cast(bf16x8, P[kk]);
#pragma unroll
        for (int dt = 0; dt < 4; ++dt) { const s16x4 lo = lds_tr16(vb + kidx0 * NA_KS + dt * 32), hi = lds_tr16(vb + (kidx0 + 16) * NA_KS + dt * 32);
            const bf16x8 vf = {lo[0], lo[1], lo[2], lo[3], hi[0], hi[1], hi[2], hi[3]};
            o[dt] = __builtin_amdgcn_mfma_f32_16x16x32_bf16(pa, vf, o[dt], 0, 0, 0); }
    }
#undef NA_STAGE
#undef NA_STAGE_PART
#pragma unroll
    for (int r = 0; r < 4; ++r) { const float ir = __shfl(inv, 4 * g + r);
        bf16_t* op = MIX + (size_t)(qrow + 4 * g + r) * D + h * 64 + q16;
#pragma unroll
        for (int dt = 0; dt < 4; dt += 2) { const unsigned pw = pk2(o[dt][r] * ir, o[dt + 1][r] * ir); op[dt * 16] = (bf16_t)(pw & 0xffffu); op[dt * 16 + 16] = (bf16_t)(pw >> 16); } }
}

struct PrepassW { f32x4 w[5][2]; f32x4 b[2]; float ifq[8]; };
__device__ __forceinline__ void ssd_prepass_unit(const Frame& F, int u, const PrepassW& W) {
    const bf16_t* PROJ = (const bf16_t*)(F.ws + WS_PROJ); bf16_t* U = (bf16_t*)(F.ws + WS_U);
    int rowbase, t0, L; bool lat;
    if (u < NLAT / 16) { rowbase = (u >> 7) * SEQ; t0 = (u & 127) * 16; L = SEQ; lat = true; }
    else { const int v = u - NLAT / 16; rowbase = NLAT + (v >> 4) * CTX; t0 = (v & 15) * 16; L = CTX; lat = false; }
    const int cg = F.tid & 127, tq = F.tid >> 7, c0 = 8 * cg, tb = t0 + 4 * tq;
    u32x4 win[8];
#pragma unroll
    for (int j = 0; j < 8; ++j) { const int t = tb - 2 + j; win[j] = (t >= 0 && t < L) ? *(const u32x4*)(PROJ + (size_t)(rowbase + t) * NPROJ + OFF_XBC + c0) : (u32x4){0u, 0u, 0u, 0u}; }
    const int lc = c0 & 127, hf = lc >> 6, role = (lc >> 5) & 1; const bool rope = lat && (c0 >= 512);
#pragma unroll
    for (int tt = 0; tt < 4; ++tt) {
        f32x4 a0 = W.b[0], a1 = W.b[1];
#pragma unroll
        for (int j = 0; j < 5; ++j) { const u32x4 r = win[tt + j];
            a0 += W.w[j][0] * (f32x4){bflo(r.x), bfhi(r.x), bflo(r.y), bfhi(r.y)}; a1 += W.w[j][1] * (f32x4){bflo(r.z), bfhi(r.z), bflo(r.w), bfhi(r.w)}; }
        float uu[8];
#pragma unroll
        for (int k = 0; k < 4; ++k) { uu[k] = silu_f(a0[k]); uu[4 + k] = silu_f(a1[k]); }
        if (rope) {
            const int tk = tb + tt; const float pos = (float)(hf ? (tk & 63) : (tk >> 6));
#pragma unroll
            for (int k = 0; k < 8; ++k) { const float o = __shfl_xor(uu[k], 4); const float sn = __builtin_amdgcn_sinf(pos * W.ifq[k]), cs = __builtin_amdgcn_cosf(pos * W.ifq[k]);
                uu[k] = role ? (o * sn + uu[k] * cs) : (uu[k] * cs - o * sn); }
        }
        u32x4 o; o.x = pk2(uu[0], uu[1]); o.y = pk2(uu[2], uu[3]); o.z = pk2(uu[4], uu[5]); o.w = pk2(uu[6], uu[7]);
        *(u32x4*)(U + (size_t)(rowbase + tb + tt) * 1024 + c0) = o;
    }
}
__device__ __forceinline__ void ssd_prepass_weights(const Frame& F, int layer, PrepassW& W) {
    const int c0 = 8 * (F.tid & 127);
    const float* cwp = F.in[I_CONVW] + (size_t)layer * 5 * 1024 + c0;
#pragma unroll
    for (int j = 0; j < 5; ++j) { W.w[j][0] = *(const f32x4*)(cwp + j * 1024); W.w[j][1] = *(const f32x4*)(cwp + j * 1024 + 4); }
    W.b[0] = *(const f32x4*)(F.in[I_CONVB] + (size_t)layer * 1024 + c0); W.b[1] = *(const f32x4*)(F.in[I_CONVB] + (size_t)layer * 1024 + c0 + 4);
    const int n0 = c0 & 31;
#pragma unroll
    for (int k = 0; k < 8; ++k) W.ifq[k] = __builtin_amdgcn_exp2f(-(float)(n0 + k) * (13.287712379549449f / 32.0f)) * 0.15915494309189535f;
}

constexpr int S_CQ = 0, S_BQ = 17408, S_BT = 34816, S_XT = 53248, S_MQ = 62464, S_HB = 71680, S_MISC = 106496;
__device__ __forceinline__ void ssd_mfma_unit(const Frame& F, int layer, int b, int h, int dir) {
    const int g = h >> 2, tid = F.tid, lane = F.lane, w = F.wave, q16 = lane & 15, gq = lane >> 4;
    const bf16_t* U = (const bf16_t*)(F.ws + WS_U); const float* DTS = (const float*)(F.ws + WS_DT);
    bf16_t* Y = (bf16_t*)(F.ws + (dir ? WS_YB : WS_YF));
    const float aneg = -__expf(F.in[I_ALOG][layer * 16 + dir * 8 + h]), dsk = F.in[I_DSKIP][layer * 8 + h];
    LAS unsigned char* L = F.lds;
    __syncthreads();
    for (int i = tid; i < 64 * 272 / 16; i += NT) *(LAS u32x4*)(L + S_HB + i * 16) = (u32x4){0u, 0u, 0u, 0u};
    f32x4 Hacc[4];
#pragma unroll
    for (int j = 0; j < 4; ++j) Hacc[j] = (f32x4){0.f, 0.f, 0.f, 0.f};
    u32x4 px, pb[2], pc[2];
    const int xl = lane, xc = w;
    float pdt = 0.f;
#define SSD_ROW(ci_, l_) ({ const int s_ = (ci_) < 4 ? 0 : 1, k_ = s_ ? (ci_) - 4 : (ci_), nc_ = s_ ? 32 : 4, c_ = dir ? nc_ - 1 - k_ : k_; \
        (s_ ? b * SEQ : NLAT + b * CTX) + c_ * 64 + (dir ? 63 - (l_) : (l_)); })
#define SSD_PREFETCH(ci_) do { px = *(const u32x4*)(U + (size_t)SSD_ROW(ci_, xl) * 1024 + h * 64 + xc * 8); \
        if (w == 0) pdt = DTS[(size_t)SSD_ROW(ci_, lane) * 16 + dir * 8 + h]; \
        _Pragma("unroll") for (int k_ = 0; k_ < 2; ++k_) { const int l_ = lane, c16_ = w + 8 * k_; const size_t ro_ = (size_t)SSD_ROW(ci_, l_) * 1024; \
            pb[k_] = *(const u32x4*)(U + ro_ + 512 + g * 128 + c16_ * 8); pc[k_] = *(const u32x4*)(U + ro_ + 768 + g * 128 + c16_ * 8); } } while (0)
    SSD_PREFETCH(0);
    int par = 0;
    for (int ci = 0; ci < 36; ++ci) {
        LAS float* misc = (LAS float*)(L + S_MISC) + par * 272;
        if (w == 0) {
            const float dt = pdt; float cs = dt * aneg;
#pragma unroll
            for (int o = 1; o < 64; o <<= 1) { const float v = __shfl_up(cs, o); cs += (lane >= o) ? v : 0.f; }
            const float tot = __shfl(cs, 63);
            misc[lane] = dt; misc[64 + lane] = cs; misc[128 + lane] = __expf(cs); misc[192 + lane] = __expf(tot - cs) * dt; if (lane == 0) misc[256] = __expf(tot);
        }
        __syncthreads();
        {
            const unsigned xw[4] = {px.x, px.y, px.z, px.w};
#pragma unroll
            for (int e = 0; e < 4; ++e) { *(LAS unsigned short*)(L + S_XT + (xc * 8 + 2 * e) * 144 + xl * 2) = (unsigned short)(xw[e] & 0xffffu); *(LAS unsigned short*)(L + S_XT + (xc * 8 + 2 * e + 1) * 144 + xl * 2) = (unsigned short)(xw[e] >> 16); }
#pragma unroll
            for (int k = 0; k < 2; ++k) { const int l = lane, c16 = w + 8 * k; const float wl = misc[192 + l];
                *(LAS u32x4*)(L + S_BQ + l * 272 + c16 * 16) = pb[k]; *(LAS u32x4*)(L + S_CQ + l * 272 + c16 * 16) = pc[k];
                const unsigned bw[4] = {pb[k].x, pb[k].y, pb[k].z, pb[k].w};
#pragma unroll
                for (int e = 0; e < 4; ++e) { const unsigned pw = pk2(bflo(bw[e]) * wl, bfhi(bw[e]) * wl);
                    *(LAS unsigned short*)(L + S_BT + (c16 * 8 + 2 * e) * 144 + l * 2) = (unsigned short)(pw & 0xffffu); *(LAS unsigned short*)(L + S_BT + (c16 * 8 + 2 * e + 1) * 144 + l * 2) = (unsigned short)(pw >> 16); } }
        }
        if (ci + 1 < 36) SSD_PREFETCH(ci + 1);
        __syncthreads();
        const int lt = w >> 1, t2 = (w & 1) * 2;
        bf16x8 cfr[4];
#pragma unroll
        for (int ks = 0; ks < 4; ++ks) cfr[ks] = *(const LAS bf16x8*)(L + S_CQ + (16 * lt + q16) * 272 + ks * 64 + gq * 16);
        {
            const f32x4 csl = *(const LAS f32x4*)(misc + 64 + 16 * lt + 4 * gq);
#pragma unroll
            for (int k = 0; k < 2; ++k) { const int st = t2 + k; f32x4 a = {0.f, 0.f, 0.f, 0.f};
                if (st <= lt) {
#pragma unroll
                    for (int ks = 0; ks < 4; ++ks) { const bf16x8 bfr = *(const LAS bf16x8*)(L + S_BQ + (16 * st + q16) * 272 + ks * 64 + gq * 16); a = __builtin_amdgcn_mfma_f32_16x16x32_bf16(cfr[ks], bfr, a, 0, 0, 0); }
                    const int sidx = 16 * st + q16; const float css = misc[64 + sidx], dts = misc[sidx];
#pragma unroll
                    for (int r = 0; r < 4; ++r) { const int l = 16 * lt + 4 * gq + r; a[r] = (sidx <= l) ? a[r] * __expf(csl[r] - css) * dts : 0.f; }
                }
#pragma unroll
                for (int r = 0; r < 4; r += 2) { const unsigned pw = pk2(a[r], a[r + 1]);
                    *(LAS unsigned short*)(L + S_MQ + (16 * lt + 4 * gq + r) * 144 + (16 * st + q16) * 2) = (unsigned short)(pw & 0xffffu); *(LAS unsigned short*)(L + S_MQ + (16 * lt + 4 * gq + r + 1) * 144 + (16 * st + q16) * 2) = (unsigned short)(pw >> 16); } }
        }
        __syncthreads();
        {
            const f32x4 ecs = *(const LAS f32x4*)(misc + 128 + 16 * lt + 4 * gq);
            const LAS unsigned char* HB = L + S_HB + par * 17408;
#pragma unroll
            for (int k = 0; k < 2; ++k) { const int pt = t2 + k; f32x4 a = {0.f, 0.f, 0.f, 0.f};
#pragma unroll
                for (int ks = 0; ks < 4; ++ks) { const bf16x8 hfr = *(const LAS bf16x8*)(HB + (16 * pt + q16) * 272 + ks * 64 + gq * 16); a = __builtin_amdgcn_mfma_f32_16x16x32_bf16(cfr[ks], hfr, a, 0, 0, 0); }
                a = a * ecs;
#pragma unroll
                for (int ks = 0; ks < 2; ++ks) if (ks <= (lt >> 1)) { const bf16x8 mfr = *(const LAS bf16x8*)(L + S_MQ + (16 * lt + q16) * 144 + ks * 64 + gq * 16), xfr = *(const LAS bf16x8*)(L + S_XT + (16 * pt + q16) * 144 + ks * 64 + gq * 16);
                    a = __builtin_amdgcn_mfma_f32_16x16x32_bf16(mfr, xfr, a, 0, 0, 0); }
                if (dir == 0) { const u32x2 xv = *(const LAS u32x2*)(L + S_XT + (16 * pt + q16) * 144 + (16 * lt + 4 * gq) * 2);
                    a[0] += dsk * bflo(xv.x); a[1] += dsk * bfhi(xv.x); a[2] += dsk * bflo(xv.y); a[3] += dsk * bfhi(xv.y); }
                { const int row0 = SSD_ROW(ci, 16 * lt + 4 * gq); bf16_t* yp = Y + (size_t)row0 * 512 + h * 64 + 16 * pt + q16; const int rs = dir ? -512 : 512;
                  const unsigned w01 = pk2(a[0], a[1]), w23 = pk2(a[2], a[3]);
                  yp[0] = (bf16_t)(w01 & 0xffffu); yp[rs] = (bf16_t)(w01 >> 16); yp[2 * rs] = (bf16_t)(w23 & 0xffffu); yp[3 * rs] = (bf16_t)(w23 >> 16); } }
            const int pt2 = w & 3, nb = (w >> 2) * 4; const float et = misc[256];
            bf16x8 xf2[2];
#pragma unroll
            for (int ks = 0; ks < 2; ++ks) xf2[ks] = *(const LAS bf16x8*)(L + S_XT + (16 * pt2 + q16) * 144 + ks * 64 + gq * 16);
            LAS unsigned char* HN = L + S_HB + (par ^ 1) * 17408;
#pragma unroll
            for (int j = 0; j < 4; ++j) { const int nt = nb + j; Hacc[j] = Hacc[j] * et;
#pragma unroll
                for (int ks = 0; ks < 2; ++ks) { const bf16x8 bfr = *(const LAS bf16x8*)(L + S_BT + (16 * nt + q16) * 144 + ks * 64 + gq * 16); Hacc[j] = __builtin_amdgcn_mfma_f32_16x16x32_bf16(xf2[ks], bfr, Hacc[j], 0, 0, 0); }
#pragma unroll
                for (int r = 0; r < 4; r += 2) { const unsigned pw = pk2(Hacc[j][r], Hacc[j][r + 1]);
                    *(LAS unsigned short*)(HN + (16 * pt2 + 4 * gq + r) * 272 + (16 * nt + q16) * 2) = (unsigned short)(pw & 0xffffu); *(LAS unsigned short*)(HN + (16 * pt2 + 4 * gq + r + 1) * 272 + (16 * nt + q16) * 2) = (unsigned short)(pw >> 16); } }
        }
        par ^= 1;
    }
#undef SSD_ROW
#undef SSD_PREFETCH
}

__device__ __forceinline__ void na_run(const Frame& F, int layer) {
    LAS unsigned char* KV = F.lds; LAS float* rp = (LAS float*)(F.lds + 120832);
    const bf16_t* PROJ = (const bf16_t*)(F.ws + WS_PROJ); bf16_t* MIX = (bf16_t*)(F.ws + WS_MIX);
    const int tid = F.tid, lane = F.lane, w = F.wave, q16 = lane & 15, g = lane >> 4;
    u32x4 pre[13];
#define NA_VPRE 13
#define NA_RB(m_) ({ int rb_ = 2 * (m_) - 4; rb_ = rb_ < 0 ? 0 : (rb_ > 24 ? 24 : rb_); __builtin_amdgcn_readfirstlane(rb_); })
#define NA_NL(rb_) ({ int nk_ = 32 - (rb_); nk_ = nk_ > 9 ? 9 : nk_; __builtin_amdgcn_readfirstlane(nk_ * 64 * 8); })
#define NA_LOAD(OFFS, b_, h_, rb_, nl_, K0, K1) do { int stid_ = tid; asm volatile("" : "+v"(stid_)); \
        _Pragma("unroll") for (int k_ = K0; k_ < K1; ++k_) { const int i_ = stid_ + k_ * NT, key_ = i_ >> 3, ch_ = i_ & 7; const bool ok_ = !(key_ < 576 && i_ >= (nl_)); \
            const int grow_ = key_ < 576 ? (b_) * SEQ + (rb_) * 64 + key_ : NLAT + (b_) * CTX + (key_ - 576); \
            pre[k_] = ok_ ? *(const u32x4*)(PROJ + (size_t)grow_ * NPROJ + (OFFS) + (h_) * 64 + ch_ * 8) : (u32x4){0u, 0u, 0u, 0u}; } } while (0)
#define NA_WRITE(nl_, K0, K1) do { int stid_ = tid; asm volatile("" : "+v"(stid_)); \
        _Pragma("unroll") for (int k_ = K0; k_ < K1; ++k_) { const int i_ = stid_ + k_ * NT, key_ = i_ >> 3, ch_ = i_ & 7; const bool ok_ = !(key_ < 576 && i_ >= (nl_)); \
            if (ok_) *(LAS u32x4*)(KV + key_ * NA_KS + ch_ * 16) = pre[k_]; } } while (0)
    int u = __builtin_amdgcn_readfirstlane(F.bid);
    if (u < 2048) { const int b = u >> 7, h = (u >> 4) & 7, m = u & 15, rb = NA_RB(m); NA_LOAD(OFF_K, b, h, rb, NA_NL(rb), 0, 13); }
    for (; u < 2048; u += F.G) {
        const int b = u >> 7, h = (u >> 4) & 7, m = u & 15, rbase = NA_RB(m), nloc8 = NA_NL(rbase);
        __syncthreads();
        NA_WRITE(nloc8, 0, 13);
        if (tid < 465) rp[tid] = F.in[I_RPB][(size_t)(layer * 8 + h) * 465 + tid] * LOG2E;
        NA_LOAD(OFF_V, b, h, rbase, nloc8, 0, NA_VPRE);
        __syncthreads();
        const int i = 2 * m + (w >> 2), j0 = (w & 3) * 16, qrow = b * SEQ + i * 64 + j0; int hs = j0 - 8; hs = hs < 0 ? 0 : (hs > 32 ? 32 : hs);
        int r0 = i - 4; r0 = r0 < 0 ? 0 : (r0 > 24 ? 24 : r0); const int kr0 = r0 - rbase;
        bf16x8 qf[2];
#pragma unroll
        for (int ks = 0; ks < 2; ++ks) qf[ks] = *(const bf16x8*)(PROJ + (size_t)(qrow + q16) * NPROJ + h * 64 + ks * 32 + g * 8);
        f32x4 S[32];
        const LAS unsigned char* kb = KV + q16 * NA_KS + g * 16;
        { const int j = j0 + q16; int cs = j - 8; cs = cs < 0 ? 0 : (cs > 48 ? 48 : cs);
          const int rb0 = (kr0 + rbase) - i + 7;
#pragma unroll
          for (int tl = 0; tl < 16; ++tl) { const int kr = tl >> 1, half = tl & 1; const int kidx0 = (kr0 + kr) * 64 + hs + 16 * half;
              f32x4 a = {0.f, 0.f, 0.f, 0.f};
#pragma unroll
              for (int ks = 0; ks < 2; ++ks) { const bf16x8 kf = *(const LAS bf16x8*)(kb + kidx0 * NA_KS + ks * 64); a = __builtin_amdgcn_mfma_f32_16x16x32_bf16(kf, qf[ks], a, 0, 0, 0); }
#pragma unroll
              for (int r = 0; r < 4; ++r) { const int kc = hs + 16 * half + 4 * g + r; const bool inw = (kc >= cs) && (kc < cs + 16);
                  int cbi = kc - j + 15; cbi = cbi < 0 ? 0 : (cbi > 30 ? 30 : cbi);
                  a[r] = inw ? a[r] * (0.125f * LOG2E) + rp[(rb0 + kr) * 31 + cbi] : -INFINITY; }
              S[tl] = a; if ((tl & 1) == 1) __builtin_amdgcn_sched_barrier(0); } }
#pragma unroll
        for (int tc = 0; tc < 16; ++tc) { const int kidx0 = 576 + 16 * tc; f32x4 a = {0.f, 0.f, 0.f, 0.f};
#pragma unroll
            for (int ks = 0; ks < 2; ++ks) { const bf16x8 kf = *(const LAS bf16x8*)(kb + kidx0 * NA_KS + ks * 64); a = __builtin_amdgcn_mfma_f32_16x16x32_bf16(kf, qf[ks], a, 0, 0, 0); }
            S[16 + tc] = a * (0.125f * LOG2E); if ((tc & 1) == 1) __builtin_amdgcn_sched_barrier(0); }
        float mx = -INFINITY;
#pragma unroll
        for (int t = 0; t < 32; ++t) mx = fmaxf(fmaxf(fmaxf(S[t][0], S[t][1]), fmaxf(S[t][2], S[t][3])), mx);
        mx = fmaxf(mx, __shfl_xor(mx, 16)); mx = fmaxf(mx, __shfl_xor(mx, 32));
        float sum = 0.f; u32x4 P[16];
#pragma unroll
        for (int kk = 0; kk < 16; ++kk) { float e[8];
#pragma unroll
            for (int r = 0; r < 4; ++r) { e[r] = __builtin_amdgcn_exp2f(S[2 * kk][r] - mx); e[4 + r] = __builtin_amdgcn_exp2f(S[2 * kk + 1][r] - mx); }
            sum += ((e[0] + e[1]) + (e[2] + e[3])) + ((e[4] + e[5]) + (e[6] + e[7]));
            P[kk].x = pg8::cvt_pk_bf16_pin(e[0], e[1]); P[kk].y = pg8::cvt_pk_bf16_pin(e[2], e[3]); P[kk].z = pg8::cvt_pk_bf16_pin(e[4], e[5]); P[kk].w = pg8::cvt_pk_bf16_pin(e[6], e[7]); }
        sum += __shfl_xor(sum, 16); sum += __shfl_xor(sum, 32);
        const float inv = 1.0f / sum;
        __syncthreads();
        NA_WRITE(nloc8, 0, NA_VPRE); NA_LOAD(OFF_V, b, h, rbase, nloc8, NA_VPRE, 13); NA_WRITE(nloc8, NA_VPRE, 13);
        { const int un = u + F.G; if (un < 2048) { const int bn = un >> 7, hn = (un >> 4) & 7, mn = un & 15, rbn = NA_RB(mn); NA_LOAD(OFF_K, bn, hn, rbn, NA_NL(rbn), 0, 13); } }
        __syncthreads();
        f32x4 o[4];
#pragma unroll
        for (int dt = 0; dt < 4; ++dt) o[dt] = (f32x4){0.f, 0.f, 0.f, 0.f};
        const LAS unsigned char* vb = KV + (4 * g + (q16 >> 2)) * NA_KS + (q16 & 3) * 8;
#pragma unroll
        for (int kk = 0; kk < 16; ++kk) {
            const int kidx0 = (kk < 8) ? (kr0 + kk) * 64 + hs : 576 + 32 * (kk - 8);
            const bf16x8 pa = __builtin_bit_cast(bf16x8, P[kk]);
#pragma unroll
            for (int dt = 0; dt < 4; ++dt) { const s16x4 lo = lds_tr16(vb + kidx0 * NA_KS + dt * 32), hi = lds_tr16(vb + (kidx0 + 16) * NA_KS + dt * 32);
                const bf16x8 vf = {lo[0], lo[1], lo[2], lo[3], hi[0], hi[1], hi[2], hi[3]};
                o[dt] = __builtin_amdgcn_mfma_f32_16x16x32_bf16(pa, vf, o[dt], 0, 0, 0); }
            if ((kk & 1) == 1) __builtin_amdgcn_sched_barrier(0);
        }
#pragma unroll
        for (int r = 0; r < 4; ++r) { const float ir = __shfl(inv, 4 * g + r);
            bf16_t* op = MIX + (size_t)(qrow + 4 * g + r) * D + h * 64 + q16;
#pragma unroll
            for (int dt = 0; dt < 4; dt += 2) { const unsigned pw = pk2(o[dt][r] * ir, o[dt + 1][r] * ir); op[dt * 16] = (bf16_t)(pw & 0xffffu); op[dt * 16 + 16] = (bf16_t)(pw >> 16); } }
    }
#undef NA_RB
#undef NA_NL
#undef NA_LOAD
#undef NA_WRITE
}
__device__ __forceinline__ void p_mixa(const Frame& F, int layer, bool last) {
    { PrepassW W; ssd_prepass_weights(F, layer, W);
      for (int u = F.bid; u < NTOK / 16; u += F.G) ssd_prepass_unit(F, u, W); }
    na_run(F, layer);
    if (!last) for (int u = F.bid; u < 256; u += F.G) na_unit(F, layer, u >> 4, (u >> 1) & 7, 1, u & 1);
}
__device__ __forceinline__ void p_mixb(const Frame& F, int layer) {
    for (int u0 = F.bid; u0 < 256 * REP_SSD; u0 += F.G) { const int u = u0 & 255; ssd_mfma_unit(F, layer, u >> 4, (u >> 1) & 7, u & 1); }
}

__device__ __forceinline__ void p_ssdcomb(const Frame& F, int layer, bool last) {
    const bf16_t* PROJ = (const bf16_t*)(F.ws + WS_PROJ); bf16_t* MIX = (bf16_t*)(F.ws + WS_MIX);
    const bf16_t* YF = (const bf16_t*)(F.ws + WS_YF); const bf16_t* YB = (const bf16_t*)(F.ws + WS_YB);
    const float* nw = F.in[I_NORMW] + layer * 512 + F.lane * 8;
    const f32x4 nw0 = *(const f32x4*)nw, nw1 = *(const f32x4*)(nw + 4);
    const int nrows = last ? NLAT : NTOK;
    u32x4 pyf = {0u, 0u, 0u, 0u}, pyb = pyf, pz = pyf;
#define SC_LOAD(r_) do { const size_t o_ = (size_t)(r_) * 512 + F.lane * 8; pyf = *(const u32x4*)(YF + o_); pyb = *(const u32x4*)(YB + o_); \
        pz = *(const u32x4*)(PROJ + (size_t)(r_) * NPROJ + OFF_Z + F.lane * 8); } while (0)
    if (F.gw < nrows) SC_LOAD(F.gw);
    for (int row = F.gw; row < nrows; row += F.NGW) {
        const f32x4 a0 = {bflo(pyf.x) + bflo(pyb.x), bfhi(pyf.x) + bfhi(pyb.x), bflo(pyf.y) + bflo(pyb.y), bfhi(pyf.y) + bfhi(pyb.y)}, a1 = {bflo(pyf.z) + bflo(pyb.z), bfhi(pyf.z) + bfhi(pyb.z), bflo(pyf.w) + bflo(pyb.w), bfhi(pyf.w) + bfhi(pyb.w)}; const u32x4 zv = pz;
        if (row + F.NGW < nrows) SC_LOAD(row + F.NGW);
        float y[8] = {a0[0] * silu_f(bflo(zv.x)), a0[1] * silu_f(bfhi(zv.x)), a0[2] * silu_f(bflo(zv.y)), a0[3] * silu_f(bfhi(zv.y)),
                      a1[0] * silu_f(bflo(zv.z)), a1[1] * silu_f(bfhi(zv.z)), a1[2] * silu_f(bflo(zv.w)), a1[3] * silu_f(bfhi(zv.w))};
        float ss = 0.f;
#pragma unroll
        for (int k = 0; k < 8; ++k) ss += y[k] * y[k];
#pragma unroll
        for (int of = 1; of < 32; of <<= 1) ss += __shfl_xor(ss, of);
        const float rs = 1.0f / sqrtf(ss * (1.0f / 256.0f) + RMS_EPS);
        u32x4 w; w.x = pk2(y[0] * rs * nw0[0], y[1] * rs * nw0[1]); w.y = pk2(y[2] * rs * nw0[2], y[3] * rs * nw0[3]);
        w.z = pk2(y[4] * rs * nw1[0], y[5] * rs * nw1[1]); w.w = pk2(y[6] * rs * nw1[2], y[7] * rs * nw1[3]);
        *(u32x4*)(MIX + (size_t)row * D + 512 + F.lane * 8) = w;
    }
}

__device__ __forceinline__ void p_outproj(const Frame& F, int layer, bool last) {
    bf16_t* X = (bf16_t*)(F.ws + WS_X);
    pg8::Gemm g{(const bf16_t*)(F.ws + WS_MIX), (const bf16_t*)(F.ws + WS_WOUT) + (size_t)layer * D * D, D};
    pg8::DenseOrder S; S.init(last ? NLAT : NTOK, D, D, F.G, F.bid);
    pg8::EpiResid E{layer == 0 ? (const void*)F.in[I_X] : (const void*)X, layer == 0 ? (const void*)F.in[I_CTX] : (const void*)(X + (size_t)NLAT * D), X, (const float*)(F.ws + WS_MOD) + (size_t)layer * 17 * MODW, 2 * D, layer == 0};
    pg8::gemm_phase<pg8::EpiResid, pg8::DenseOrder, true, true>(F.lds, g, S, E, F.tid);
    if (layer == 0) deferred_conv(F, (NTOK / 256) * (D / 256), DW_L0_OUT, DW_Q); else if (layer == 1) deferred_conv(F, (NTOK / 256) * (D / 256), DW_L1_OUT, DW_Q);
}

__device__ __forceinline__ unsigned* cnt_word(const Frame& F, int slot, int hf, int e) { return (unsigned*)(F.ws + WS_CTL) + CW_CNT + ((slot * 2 + hf) * 8 + e) * 64; }
__device__ __forceinline__ void p_ln1(const Frame& F, int layer, bool last) {
    bf16_t* X = (bf16_t*)(F.ws + WS_X); bf16_t* H = (bf16_t*)(F.ws + WS_H);
    const float* MOD = (const float*)(F.ws + WS_MOD) + (size_t)layer * 17 * MODW;
    const float* lg = F.in[I_LNG] + (size_t)(layer * 2) * D; const float* lb = F.in[I_LNB] + (size_t)(layer * 2) * D;
    const bool moe = layer & 1; const int slot = layer >> 1;
    const int nrows = last ? NLAT : NTOK;
    float rw[16][8];
    if (moe) { const float* R = F.in[I_RW] + (size_t)slot * D * 8;
#pragma unroll
        for (int j = 0; j < 4; ++j)
#pragma unroll
            for (int k = 0; k < 4; ++k) { const int lane = F.lane; const f32x4 a = *(const f32x4*)(R + (size_t)(RIDX(j) + k) * 8), b2 = *(const f32x4*)(R + (size_t)(RIDX(j) + k) * 8 + 4);
                rw[j * 4 + k][0] = a[0]; rw[j * 4 + k][1] = a[1]; rw[j * 4 + k][2] = a[2]; rw[j * 4 + k][3] = a[3]; rw[j * 4 + k][4] = b2[0]; rw[j * 4 + k][5] = b2[1]; rw[j * 4 + k][6] = b2[2]; rw[j * 4 + k][7] = b2[3]; } }
    int nrec = 0;
    if (moe) { __syncthreads(); if (F.tid < 32) ((LAS unsigned*)F.lds)[F.tid] = 0u; __syncthreads(); }
    f32x4 vn[4];
    if (F.gw < nrows) row_load_h(X + (size_t)F.gw * D, F.lane, vn);
    for (int row = F.gw; row < nrows; row += F.NGW) {
        f32x4 v[4], hv[4];
#pragma unroll
        for (int j = 0; j < 4; ++j) v[j] = vn[j];
        if (row + F.NGW < nrows) row_load_h(X + (size_t)(row + F.NGW) * D, F.lane, vn);
        row_ln(v, lg, lb, F.lane);
        row_store_h(X + (size_t)row * D, F.lane, v);
        const float* m = MOD + (size_t)mod_row_of(row) * MODW;
        if (USE_FP8 && (moe || FP8_DENSE1)) row_mod_store8((unsigned char*)H + (size_t)row * D, F.lane, v, m + 3 * D, m + 4 * D, hv);
        else row_mod_store(H + (size_t)row * D, F.lane, v, m + 3 * D, m + 4 * D, hv);
        if (moe) {
            float lg8[8];
#pragma unroll
            for (int e = 0; e < 8; ++e) { float s = 0.f;
#pragma unroll
                for (int j = 0; j < 4; ++j)
#pragma unroll
                    for (int k = 0; k < 4; ++k) s += hv[j][k] * rw[j * 4 + k][e];
                lg8[e] = wave_sum(s); }
            int e0 = 0; float v0 = lg8[0];
#pragma unroll
            for (int e = 1; e < 8; ++e) if (lg8[e] > v0) { v0 = lg8[e]; e0 = e; }
            int e1 = -1; float v1 = -INFINITY;
#pragma unroll
            for (int e = 0; e < 8; ++e) if (e != e0 && lg8[e] > v1) { v1 = lg8[e]; e1 = e; }
            if (F.lane == 0) {
                const unsigned s0 = __hip_atomic_fetch_add((LAS unsigned*)F.lds + e0, 1u, __ATOMIC_RELAXED, __HIP_MEMORY_SCOPE_WORKGROUP), s1 = __hip_atomic_fetch_add((LAS unsigned*)F.lds + e1, 1u, __ATOMIC_RELAXED, __HIP_MEMORY_SCOPE_WORKGROUP);
                const float ex = __expf(v1 - v0), g0 = 1.0f / (1.0f + ex);
                ((LAS u32x4*)(F.lds + 256))[F.wave * 32 + nrec] = (u32x4){(unsigned)e0 | ((unsigned)e1 << 8), s0, s1, (unsigned)row};
                *(f32x2*)(F.ws + WS_GATES + (size_t)row * 8) = (f32x2){g0, ex * g0};
            }
            ++nrec;
        }
    }
    if (moe) {
        __syncthreads();
        if (F.tid < 8) ((LAS unsigned*)F.lds)[16 + F.tid] = atomicAdd(cnt_word(F, slot, 0, F.tid), ((LAS unsigned*)F.lds)[F.tid]);
        __syncthreads();
        int* list = (int*)(F.ws + WS_LIST);
        if (F.lane < nrec) { const u32x4 rc = ((LAS u32x4*)(F.lds + 256))[F.wave * 32 + F.lane]; const int e0 = rc.x & 255, e1 = (rc.x >> 8) & 255; const int row = (int)rc.w;
            const unsigned s0 = ((LAS unsigned*)F.lds)[16 + e0] + rc.y, s1 = ((LAS unsigned*)F.lds)[16 + e1] + rc.z;
            list[e0 * NTOK + s0] = row; list[e1 * NTOK + s1] = row;
            *(u32x4*)(F.ws + WS_ROUTE + (size_t)row * 16) = (u32x4){rc.x, s0, s1, 0u}; }
    }
}

__device__ __forceinline__ void p_ffn1_dense(const Frame& F, int layer, bool last) {
    const int s = layer >> 1;
#if USE_FP8 && FP8_DENSE2
    typedef pg8::EpiSwiGLU8 EpiH; EpiH E{F.ws + WS_HID, DFF};
#else
    typedef pg8::EpiSwiGLU EpiH; EpiH E{(bf16_t*)(F.ws + WS_HID), DFF};
#endif
#if USE_FP8 && FP8_DENSE1
    pg8::Gemm g{(const bf16_t*)(F.ws + WS_H), (const bf16_t*)(F.ws + WS_WFGU + (size_t)s * 2 * DFF * D), D / 2};
    pg8::DenseOrder S; S.init(last ? NLAT : NTOK, 2 * DFF, D / 2, F.G, F.bid, REP_GEMM);
    pg8::gemm_phase<EpiH, pg8::DenseOrder, true, FP8_SP2, true>(F.lds, g, S, E, F.tid, (127 - S8_WGU) * 0x01010101, (127 - S8_ACT) * 0x01010101);
#else
    pg8::Gemm g{(const bf16_t*)(F.ws + WS_H), (const bf16_t*)(F.ws + WS_WFGU) + (size_t)s * 2 * DFF * D, D};
    pg8::DenseOrder S; S.init(last ? NLAT : NTOK, 2 * DFF, D, F.G, F.bid, REP_GEMM);
    pg8::gemm_phase<EpiH, pg8::DenseOrder, true, true>(F.lds, g, S, E, F.tid);
#endif
    if (layer == 0) deferred_conv(F, (NTOK / 256) * (2 * DFF / 256), DW_L0_F1, DW_Q);
}
__device__ __forceinline__ void p_ffn2_dense(const Frame& F, int layer, bool last) {
    const int s = layer >> 1; bf16_t* X = (bf16_t*)(F.ws + WS_X);
    pg8::EpiResid E{(const void*)X, (const void*)(X + (size_t)NLAT * D), X, (const float*)(F.ws + WS_MOD) + (size_t)layer * 17 * MODW, 5 * D, false};
#if USE_FP8 && FP8_DENSE2
    pg8::Gemm g{(const bf16_t*)(F.ws + WS_HID), (const bf16_t*)(F.ws + WS_WFD + (size_t)s * D * DFF), DFF / 2};
    pg8::DenseOrder S; S.init(last ? NLAT : NTOK, D, DFF / 2, F.G, F.bid);
    pg8::gemm_phase<pg8::EpiResid, pg8::DenseOrder, true, FP8_SP2, true>(F.lds, g, S, E, F.tid, (127 - S8_WD) * 0x01010101, (127 - S8_HID) * 0x01010101);
#else
    pg8::Gemm g{(const bf16_t*)(F.ws + WS_HID), (const bf16_t*)(F.ws + WS_WFD) + (size_t)s * D * DFF, DFF};
    pg8::DenseOrder S; S.init(last ? NLAT : NTOK, D, DFF, F.G, F.bid);
    pg8::gemm_phase<pg8::EpiResid, pg8::DenseOrder, true, true>(F.lds, g, S, E, F.tid);
#endif
    if (layer == 0) deferred_conv(F, (NTOK / 256) * (D / 256), DW_L0_F2, DW_Q2);
}
__device__ __forceinline__ void moe_prefix(const Frame& F, int slot, int hf, int (&ts)[9], int (&cn)[8]) {
    int a = 0;
#pragma unroll
    for (int e = 0; e < 8; ++e) { cn[e] = (int)*cnt_word(F, slot, hf, e); ts[e] = a; a += (cn[e] + 255) >> 8; }
    ts[8] = a;
}
__device__ __forceinline__ void p_ffn1_moe(const Frame& F, int layer) {
    const int slot = layer >> 1; int cn[8];
    pg8::MoeOrder<true> S; moe_prefix(F, slot, 0, S.ts, cn);
    S.nM = S.ts[8]; S.nN = 2 * DFFE / 256; S.G = F.G; S.c = F.bid; S.K = D / 2; S.estride = (long)2 * DFFE * D; S.rowoff = (const LAS unsigned short*)(F.lds + LDS_ROWOFF); S.rowbytes = D;
    {
        const int* list = (const int*)(F.ws + WS_LIST); LAS unsigned short* ro = (LAS unsigned short*)(F.lds + LDS_ROWOFF); pg8::Unit u;
        for (int i = F.wave; i < 36 && S.next(i, u); i += NWAVES) { const int e = S.expert_of(u.pm); int tse = 0, cne = 0;
#pragma unroll
            for (int j = 0; j < 8; ++j) { tse = (j == e) ? S.ts[j] : tse; cne = (j == e) ? cn[j] : cne; }
            int tk[4];
#pragma unroll
            for (int q = 0; q < 4; ++q) { const int sl = (u.pm - tse) * 256 + F.lane + 64 * q; tk[q] = sl < cne ? list[e * NTOK + sl] : 0; }
#pragma unroll
            for (int q = 0; q < 4; ++q) ro[i * 256 + F.lane + 64 * q] = (unsigned short)tk[q]; }
        __syncthreads();
    }
    pg8::Gemm g{(const bf16_t*)(F.ws + WS_H), (const bf16_t*)(F.ws + WS_WMGU + (size_t)slot * NEXP * 2 * DFFE * D), D / 2};
    pg8::EpiSwiGLU8 E{F.ws + WS_HID, DFFE};
    pg8::gemm_phase<pg8::EpiSwiGLU8, pg8::MoeOrder<true>, true, FP8_SP2, true>(F.lds, g, S, E, F.tid, (127 - S8_WGU) * 0x01010101, (127 - S8_ACT) * 0x01010101);
}
__device__ __forceinline__ void p_ffn2_moe(const Frame& F, int layer) {
    const int slot = layer >> 1; int cn[8];
    pg8::MoeOrder<false> S; moe_prefix(F, slot, 0, S.ts, cn);
    S.nM = S.ts[8]; S.nN = D / 256; S.G = F.G; S.c = F.bid; S.K = DFFE / 2; S.estride = (long)D * DFFE; S.rowoff = nullptr; S.rowbytes = 0;
    pg8::EpiBf16 E{(bf16_t*)(F.ws + WS_YP), D};
    pg8::Gemm g{(const bf16_t*)(F.ws + WS_HID), (const bf16_t*)(F.ws + WS_WMD + (size_t)slot * NEXP * D * DFFE), DFFE / 2};
    pg8::gemm_phase<pg8::EpiBf16, pg8::MoeOrder<false>, true, FP8_SP2, true>(F.lds, g, S, E, F.tid, (127 - S8_WD) * 0x01010101, (127 - S8_HID) * 0x01010101);
}

__device__ __forceinline__ void p_ln2(const Frame& F, int layer, bool last) {
    bf16_t* X = (bf16_t*)(F.ws + WS_X); bf16_t* H = (bf16_t*)(F.ws + WS_H);
    const float* MOD = (const float*)(F.ws + WS_MOD) + (size_t)layer * 17 * MODW;
    const float* lg = F.in[I_LNG] + (size_t)(layer * 2 + 1) * D; const float* lb = F.in[I_LNB] + (size_t)(layer * 2 + 1) * D;
    const bool moe = layer & 1; const int slot = layer >> 1;
    const int nrows = last ? NLAT : NTOK;
    int ts0[9], cn[8];
    if (moe) moe_prefix(F, slot, 0, ts0, cn);
    const bf16_t* YP = (const bf16_t*)(F.ws + WS_YP);
    f32x4 vn[4]; u32x4 rn = {0u, 0u, 0u, 0u}; f32x2 gn = {0.f, 0.f};
    if (F.gw < nrows) { row_load_h(X + (size_t)F.gw * D, F.lane, vn); if (moe) { rn = *(const u32x4*)(F.ws + WS_ROUTE + (size_t)F.gw * 16); gn = *(const f32x2*)(F.ws + WS_GATES + (size_t)F.gw * 8); } }
    for (int row = F.gw; row < nrows; row += F.NGW) {
        f32x4 v[4], hv[4];
#pragma unroll
        for (int j = 0; j < 4; ++j) v[j] = vn[j];
        const u32x4 r = rn; const f32x2 gt = gn;
        if (row + F.NGW < nrows) { row_load_h(X + (size_t)(row + F.NGW) * D, F.lane, vn);
            if (moe) { rn = *(const u32x4*)(F.ws + WS_ROUTE + (size_t)(row + F.NGW) * 16); gn = *(const f32x2*)(F.ws + WS_GATES + (size_t)(row + F.NGW) * 8); } }
        if (moe) {
            const int e0 = r.x & 255, e1 = (r.x >> 8) & 255;
            int t0 = 0, t1 = 0;
#pragma unroll
            for (int e = 0; e < 8; ++e) { const int tv = ts0[e]; t0 = (e == e0) ? tv : t0; t1 = (e == e1) ? tv : t1; }
            const bf16_t* y0 = YP + ((size_t)t0 * 256 + r.y) * D; const bf16_t* y1 = YP + ((size_t)t1 * 256 + r.z) * D;
            const float* g2 = MOD + (size_t)mod_row_of(row) * MODW + 5 * D;
#pragma unroll
            for (int j = 0; j < 2; ++j) { const int lane = F.lane; const u32x4 a = *(const u32x4*)(y0 + 8 * lane + 512 * j), b2 = *(const u32x4*)(y1 + 8 * lane + 512 * j);
                const f32x4 g0 = *(const f32x4*)(g2 + RIDX(2 * j)) + 1.0f, g1 = *(const f32x4*)(g2 + RIDX(2 * j + 1)) + 1.0f;
                f32x4 f0, f1; f0[0] = gt[0] * bflo(a.x) + gt[1] * bflo(b2.x); f0[1] = gt[0] * bfhi(a.x) + gt[1] * bfhi(b2.x); f0[2] = gt[0] * bflo(a.y) + gt[1] * bflo(b2.y); f0[3] = gt[0] * bfhi(a.y) + gt[1] * bfhi(b2.y);
                f1[0] = gt[0] * bflo(a.z) + gt[1] * bflo(b2.z); f1[1] = gt[0] * bfhi(a.z) + gt[1] * bfhi(b2.z); f1[2] = gt[0] * bflo(a.w) + gt[1] * bflo(b2.w); f1[3] = gt[0] * bfhi(a.w) + gt[1] * bfhi(b2.w);
                v[2 * j] = v[2 * j] * ALPHA + g0 * f0; v[2 * j + 1] = v[2 * j + 1] * ALPHA + g1 * f1; }
        }
        row_ln(v, lg, lb, F.lane);
        if (last) row_store(F.out + (size_t)row * D, F.lane, v);
        else { row_store_h(X + (size_t)row * D, F.lane, v);
            const float* m = MOD + (size_t)17 * MODW + (size_t)mod_row_of(row) * MODW;
            row_mod_store(H + (size_t)row * D, F.lane, v, m, m + D, hv);
            }
    }
}

constexpr int NPL = 9;
constexpr int NPH = 2 + NPL * DEPTH;
#ifndef SITE_MASK
#define SITE_MASK 0xFFFFF
#endif
#define SITE(n) (((SITE_MASK) >> (n)) & 1)
__global__ void __launch_bounds__(NT, 2) fwd_kernel(Args args) {
    extern __shared__ __attribute__((aligned(16))) unsigned char lds_raw[];
    Frame F;
    F.lds = (LAS unsigned char*)lds_raw; F.in = args.in; F.out = args.out; F.ws = args.ws;
    F.tid = threadIdx.x; F.lane = F.tid & 63; F.wave = __builtin_amdgcn_readfirstlane(F.tid >> 6); F.bid = blockIdx.x; F.G = gridDim.x;
    F.gw = F.bid * NWAVES + F.wave; F.NGW = F.G * NWAVES;
    volatile LAS unsigned* MISC = (volatile LAS unsigned*)(F.lds + LDS_MISC);
    if (F.tid < 64) MISC[F.tid] = 0u;
    __syncthreads();
    XcdBarrier bar; bar.bar = (unsigned*)(F.ws + WS_CTL) + CW_BAR; bar.x = 0; bar.st = MISC + 8;
#if MK_SINGLE
    bar = xcd_barrier_post((unsigned*)(F.ws + WS_CTL) + CW_BAR, MISC + 8);
#endif
    const int lo = args.ph_lo, hi = args.ph_hi;
#define IN(k) (lo <= (k) && (k) < hi)
#if MK_SINGLE
#define SEAM(k) do { if (IN(k) && IN((k) + 1)) { XcdBarrier b2_ = bar; int z_; asm volatile("s_mov_b32 %0, 0" : "=s"(z_)); b2_.bar = bar.bar + z_; int ln_; asm volatile("v_mbcnt_lo_u32_b32 %0, -1, 0\n\tv_mbcnt_hi_u32_b32 %0, -1, %0" : "=v"(ln_)); xcd_barrier(b2_, F.wave == 0 && ln_ == 0); } } while (0)
#else
#define SEAM(k) do { } while (0)
#endif
    if constexpr (SITE(0)) if (IN(0)) p_pro_a(fresh(F));
    SEAM(0);
    if constexpr (SITE(1)) if (IN(1)) p_pro_b(fresh(F));
    SEAM(1);
    for (int layer = 0; layer < DEPTH; ++layer) {
        const int pb = 2 + NPL * layer; const bool last = layer == DEPTH - 1; const bool moe = layer & 1;
        if constexpr (SITE(2)) if (IN(pb + 0)) p_inproj(fresh(F), layer);
        SEAM(pb + 0);
        if constexpr (SITE(3)) if (IN(pb + 1)) p_mixa(fresh(F), layer, last);
        SEAM(pb + 1);
        if constexpr (SITE(12)) if (IN(pb + 2)) p_mixb(fresh(F), layer);
        SEAM(pb + 2);
        if constexpr (SITE(4)) if (IN(pb + 3)) { p_ssdcomb(fresh(F), layer, last); if (!USE_FP8 && layer == 2) { int rot = 0; conv_moe(fresh(F), 1, rot); } }
        SEAM(pb + 3);
        if constexpr (SITE(5)) if (IN(pb + 4)) p_outproj(fresh(F), layer, last);
        SEAM(pb + 4);
        if constexpr (SITE(6)) if (IN(pb + 5)) p_ln1(fresh(F), layer, last);
        SEAM(pb + 5);
        if (moe) {
            if constexpr (SITE(7)) if (IN(pb + 6)) p_ffn1_moe(fresh(F), layer);
            SEAM(pb + 6);
            if constexpr (SITE(8)) if (IN(pb + 7)) p_ffn2_moe(fresh(F), layer);
            SEAM(pb + 7);
        } else {
            if constexpr (SITE(9)) if (IN(pb + 6)) p_ffn1_dense(fresh(F), layer, last);
            SEAM(pb + 6);
            if constexpr (SITE(10)) if (IN(pb + 7)) p_ffn2_dense(fresh(F), layer, last);
            SEAM(pb + 7);
        }
        if constexpr (SITE(11)) if (IN(pb + 8)) p_ln2(fresh(F), layer, last);
        if (!last) SEAM(pb + 8);
    }
#undef IN
#undef SEAM
}

extern "C" void kernel_launch(void* const* d_in, const int* in_sizes, int n_in, void* d_out, int out_size, void* d_ws, size_t ws_size, hipStream_t stream) {
    static int grid = 0;
    if (grid == 0) {
        if (n_in != 24 || out_size != NLAT * D || ws_size < WS_END) { fprintf(stderr, "kernel_launch: unexpected shapes (n_in %d, out %d, ws %zu < %zu)\n", n_in, out_size, ws_size, (size_t)WS_END); grid = -1; return; }
        int dev = 0, cus = 0, per_cu = 0;
        if (hipGetDevice(&dev) != hipSuccess || hipDeviceGetAttribute(&cus, hipDeviceAttributeMultiprocessorCount, dev) != hipSuccess) { grid = -1; return; }
        if (hipFuncSetAttribute((const void*)fwd_kernel, hipFuncAttributeMaxDynamicSharedMemorySize, LDS_BYTES) != hipSuccess) { fprintf(stderr, "kernel_launch: hipFuncSetAttribute failed\n"); grid = -1; return; }
        if (hipOccupancyMaxActiveBlocksPerMultiprocessor(&per_cu, (const void*)fwd_kernel, NT, LDS_BYTES) != hipSuccess || per_cu < 1) { fprintf(stderr, "kernel_launch: occupancy query says %d\n", per_cu); }
        (void)hipGetLastError();
        grid = cus;
    }
    if (grid < 0) return;
    (void)in_sizes;
    if (hipMemsetAsync((char*)d_ws + WS_CTL, 0, CTL_BYTES, stream) != hipSuccess) return;
    Args a{};
    for (int i = 0; i < 24; ++i) a.in[i] = (const float*)d_in[i];
    a.out = (float*)d_out; a.ws = (unsigned char*)d_ws;
#if MK_SINGLE
    a.ph_lo = 0; a.ph_hi = NPH;
    hipLaunchKernelGGL(fwd_kernel, dim3(grid), dim3(NT), LDS_BYTES, stream, a);
#else
    for (int ph = 0; ph < NPH; ++ph) {

        a.ph_lo = ph; a.ph_hi = ph + 1;
        hipLaunchKernelGGL(fwd_kernel, dim3(grid), dim3(NT), LDS_BYTES, stream, a);
    }
#endif
}
```

```cpp
#include <hip/hip_runtime.h>
#include <cstdio>
#include <cstdint>

#ifndef MK_SINGLE
#define MK_SINGLE 1
#endif

#ifndef FP8_INPROJ
#define FP8_INPROJ 0
#endif
#ifndef FP8_DENSE1
#define FP8_DENSE1 0
#endif
#ifndef FP8_DENSE2
#define FP8_DENSE2 1
#endif
#ifndef USE_FP8
#define USE_FP8 1
#endif
#ifndef FP8_SP2
#define FP8_SP2 true
#endif
#ifndef REP_SSD
#define REP_SSD 1
#endif
#ifndef REP_NA
#define REP_NA 1
#endif
#ifndef REP_GEMM
#define REP_GEMM 1
#endif
#define GAS __attribute__((address_space(1)))
#define LAS __attribute__((address_space(3)))
typedef unsigned short bf16_t;
typedef short bf16x8 __attribute__((ext_vector_type(8)));
typedef float f32x4 __attribute__((ext_vector_type(4)));
typedef float f32x2 __attribute__((ext_vector_type(2)));
typedef unsigned u32x4 __attribute__((ext_vector_type(4)));
typedef unsigned u32x2 __attribute__((ext_vector_type(2)));
typedef int i32x4 __attribute__((ext_vector_type(4)));
typedef int i32x8 __attribute__((ext_vector_type(8)));

constexpr int D = 1024, BATCH = 16, SEQ = 2048, DEPTH = 4, GRID_W = 64, CTX = 256;
constexpr int NLAT = BATCH * SEQ;
constexpr int NCTX = BATCH * CTX;
constexpr int NTOK = NLAT + NCTX;
constexpr int NPROJ = 3072;
constexpr int OFF_K = 512, OFF_V = 1024, OFF_Z = 1536, OFF_XBC = 2048;
constexpr int D_IN_PROJ = 3088;
constexpr int DFF = 2816, DFFE = 3584, NEXP = 8;
constexpr float ALPHA = 1.6817928305074290f;
constexpr float LN_EPS = 1e-5f, RMS_EPS = 1e-5f;
constexpr int MODW = 6 * D;

constexpr size_t MiB = 1u << 20;
constexpr size_t WS_CTL = 0, CTL_BYTES = 1 * MiB;
constexpr size_t WS_MOD = 1 * MiB;
constexpr size_t WS_ROUTE = 3 * MiB;
constexpr size_t WS_GATES = 4 * MiB;
constexpr size_t WS_LIST = 5 * MiB;
constexpr size_t WS_WDT = 7 * MiB;
constexpr size_t WS_WIN = 8 * MiB;
constexpr size_t WS_WOUT = 32 * MiB;
constexpr size_t WS_WFGU = 40 * MiB;
constexpr size_t WS_WFD = 62 * MiB;
constexpr size_t WS_WMGU = 73 * MiB;
constexpr size_t WS_WMD = 185 * MiB;
constexpr size_t WS_X = 241 * MiB;
constexpr size_t WS_H = 385 * MiB;
constexpr size_t WS_R = 457 * MiB;
constexpr size_t WS_PROJ = WS_R;
constexpr size_t WS_DT = WS_R + 216 * MiB;
constexpr size_t WS_YF = WS_R + 219 * MiB;
constexpr size_t WS_YB = WS_R + 291 * MiB;
constexpr size_t WS_MIX = WS_R + 363 * MiB;
constexpr size_t WS_HID = WS_R;
constexpr size_t WS_YP = WS_R + 270 * MiB;
constexpr size_t WS_DELTA1 = WS_R;
constexpr size_t WS_DELTA2 = WS_R + 270 * MiB;
constexpr size_t WS_U = WS_R + 435 * MiB;
constexpr size_t WS_H8IN = WS_U;
constexpr size_t WS_END = WS_R + 507 * MiB;
constexpr int MOE_PAD = 2 * NTOK + 2048;
static_assert(USE_FP8 == 1, "the single-phase MoE needs the e4m3 hidden (the bf16 one does not fit the workspace)");
static_assert(WS_HID + (size_t)MOE_PAD * 3584 <= WS_YP && WS_YP + (size_t)MOE_PAD * 1024 * 2 <= WS_END, "MoE buffers");

constexpr int CW_TMO = 0;
constexpr int CW_BAR = 4096;
constexpr int CW_CNT = 16384;

constexpr int LDS_STAGE = 131072;
constexpr int LDS_ROWOFF = 131072;
constexpr int LDS_MISC = 131072 + 18432;
constexpr int LDS_BYTES = 155648;

constexpr int S8_ACT = 3, S8_WGU = 8, S8_HID = 2, S8_WD = 9;
__device__ __forceinline__ unsigned f2bf(float f) { unsigned u = __builtin_bit_cast(unsigned, f); return (u + 0x7fffu + ((u >> 16) & 1u)) >> 16; }
typedef __bf16 bf16x2_t __attribute__((ext_vector_type(2)));
__device__ __forceinline__ unsigned pk2(float lo, float hi) { const f32x2 v = {lo, hi}; const bf16x2_t b = __builtin_convertvector(v, bf16x2_t); return __builtin_bit_cast(unsigned, b); }
__device__ __forceinline__ float bf2f(unsigned short b) { return __builtin_bit_cast(float, ((unsigned)b) << 16); }
__device__ __forceinline__ float bflo(unsigned w) { return __builtin_bit_cast(float, w << 16); }
__device__ __forceinline__ float bfhi(unsigned w) { return __builtin_bit_cast(float, w & 0xffff0000u); }
__device__ __forceinline__ float silu_f(float v) { return v / (1.0f + __expf(-v)); }
__device__ __forceinline__ float clamp8(float v) { return fminf(fmaxf(v, -448.0f), 448.0f); }
__device__ __forceinline__ unsigned pk8(float a, float b, float c, float d) {
    int w = 0; w = __builtin_amdgcn_cvt_pk_fp8_f32(clamp8(a), clamp8(b), w, false); w = __builtin_amdgcn_cvt_pk_fp8_f32(clamp8(c), clamp8(d), w, true); return (unsigned)w; }
__device__ __forceinline__ float wave_sum(float v) {
#pragma unroll
    for (int o = 1; o < 64; o <<= 1) v += __shfl_xor(v, o);
    return v;
}

namespace pg8 {
constexpr int BM = 256, BK = 64, HALF = 128, HTB = HALF * BK * 2, STAGE_BYTES = 8 * HTB, NXCD = 8, WGM = 8;
__host__ __device__ __forceinline__ int lds_byte(int r, int c) { const int st = (r >> 4) * 2 + (c >> 5), rr = r & 15, cc = c & 31, ob = rr * 64 + cc * 2; return st * 1024 + (ob ^ (((ob >> 9) & 1) << 5)); }
__host__ __device__ __forceinline__ void stage_rc(int b, int& R, int& C) { const int st = b / 1024, sb = b % 1024, swz = sb ^ (((sb >> 9) & 1) << 5); R = (st >> 1) * 16 + swz / 64; C = (st & 1) * 32 + (swz % 64) / 2; }
__host__ __device__ __forceinline__ int perm32(int rho) { const int n = rho >> 4, i = rho & 15; return 8 * (i >> 2) + 4 * n + (i & 3); }

struct Unit { int pm, pn; long bofs; };
struct Gemm { const bf16_t* A; const bf16_t* Bt; int K; };

__device__ __forceinline__ unsigned cvt_pk_bf16(float lo, float hi) { return pk2(lo, hi); }
__device__ __forceinline__ unsigned cvt_pk_bf16_pin(float lo, float hi) { unsigned r; asm volatile("v_cvt_pk_bf16_f32 %0, %1, %2" : "=v"(r) : "v"(lo), "v"(hi)); return r; }

__device__ __forceinline__ bool static_tile(int i, int G, int c, int nM, int nN, int& pm, int& pn, int rep = 1) {
    const int nwg = nM * nN;
#if REP_GEMM > 1
    { const int cnt = (nwg - c + G - 1) / G; if (cnt <= 0 || i >= rep * cnt) return false; i %= cnt; }
#endif
    const long L = (long)i * G + c; if (L >= nwg) return false;
    int wgid = (int)L; { const int q = nwg / NXCD, r = nwg % NXCD, xcd = wgid % NXCD, off = wgid / NXCD; wgid = (xcd < r ? xcd * (q + 1) : r * (q + 1) + (xcd - r) * q) + off; }
    const int nig = WGM * nN, gid = wgid / nig, fm = gid * WGM, gsz = (nM - fm) < WGM ? (nM - fm) : WGM;
    pm = fm + ((wgid % nig) % gsz); pn = (wgid % nig) / gsz; return true;
}
struct DenseOrder {
    int nM, nN, G, c, K, rep;
    __device__ __forceinline__ void init(int M, int N, int K_, int G_, int c_, int rep_ = 1) { nM = M / BM; nN = N / BM; G = G_; c = c_; K = K_; rep = rep_; }
    __device__ __forceinline__ bool next(int i, Unit& u) const { if (!static_tile(i, G, c, nM, nN, u.pm, u.pn, rep)) return false; u.bofs = (long)u.pn * BM * K * 2; return true; }
    static constexpr bool GATHER = false;
    __device__ __forceinline__ long a_base(const Unit& u) const { return (long)u.pm * BM * K * 2; }
    __device__ __forceinline__ void a_offs(int, const Unit&, int, unsigned (&)[2][2]) const {}
};
template <bool GATHER_> struct MoeOrder {
    int nM, nN, G, c, K; int ts[9]; long estride; const LAS unsigned short* rowoff; unsigned rowbytes;
    __device__ __forceinline__ int expert_of(int pm) const { int e = 0;
#pragma unroll
        for (int j = 1; j < 8; ++j) e += (pm >= ts[j]) ? 1 : 0; return e; }
    __device__ __forceinline__ bool next(int i, Unit& u) const { if (!static_tile(i, G, c, nM, nN, u.pm, u.pn, REP_GEMM)) return false; u.bofs = (long)expert_of(u.pm) * estride + (long)u.pn * BM * K * 2; return true; }
    static constexpr bool GATHER = GATHER_;
    __device__ __forceinline__ long a_base(const Unit& u) const { return GATHER_ ? 0l : (long)u.pm * BM * K * 2; }
    __device__ __forceinline__ void a_offs(int ui, const Unit&, int tid, unsigned (&o)[2][2]) const {
        int uix = ui;
#if REP_GEMM > 1
        { const int cnt = (nM * nN - c + G - 1) / G; uix = ui % cnt; }
#endif
        if (GATHER_) {
#pragma unroll
            for (int i = 0; i < 2; ++i) { int R, C; stage_rc(tid * 16 + i * 8192, R, C);
#pragma unroll
                for (int h = 0; h < 2; ++h) o[h][i] = (unsigned)rowoff[uix * 256 + h * HALF + R] * rowbytes + (unsigned)(C * 2); }
        }
    }
};

struct EpiBf16 {
    static constexpr bool PERM = true;
    bf16_t* O; int ldc;
    __device__ __forceinline__ void operator()(const f32x4 (&acc)[2][2][4][2], const Unit& u, int wr, int wc, int fr, int fq) const {
        const int row0 = u.pm * BM + wr * 64 + fr; const int col0 = u.pn * BM + wc * 32 + 8 * fq;
#pragma unroll
        for (int ai = 0; ai < 2; ++ai)
#pragma unroll
            for (int m = 0; m < 4; ++m) { bf16_t* rowp = O + (size_t)(row0 + ai * HALF + m * 16) * ldc + col0;
#pragma unroll
                for (int bj = 0; bj < 2; ++bj) { const f32x4 v0 = acc[ai][bj][m][0], v1 = acc[ai][bj][m][1];
                    u32x4 w; w.x = cvt_pk_bf16(v0[0], v0[1]); w.y = cvt_pk_bf16(v0[2], v0[3]); w.z = cvt_pk_bf16(v1[0], v1[1]); w.w = cvt_pk_bf16(v1[2], v1[3]);
                    *(u32x4*)(rowp + bj * HALF) = w; } }
    }
};
struct EpiSwiGLU {
    static constexpr bool PERM = true;
    bf16_t* O; int ldc;
    __device__ __forceinline__ void operator()(const f32x4 (&acc)[2][2][4][2], const Unit& u, int wr, int wc, int fr, int fq) const {
        const int row0 = u.pm * BM + wr * 64 + fr; const int col0 = u.pn * HALF + wc * 32 + 8 * fq;
#pragma unroll
        for (int ai = 0; ai < 2; ++ai)
#pragma unroll
            for (int m = 0; m < 4; ++m) { bf16_t* rowp = O + (size_t)(row0 + ai * HALF + m * 16) * ldc + col0;
                float h[8];
#pragma unroll
                for (int n = 0; n < 2; ++n)
#pragma unroll
                    for (int j = 0; j < 4; ++j) { const float g = acc[ai][0][m][n][j], up = acc[ai][1][m][n][j]; h[n * 4 + j] = g * __builtin_amdgcn_rcpf(1.0f + __expf(-g)) * up; }
                u32x4 w; w.x = cvt_pk_bf16(h[0], h[1]); w.y = cvt_pk_bf16(h[2], h[3]); w.z = cvt_pk_bf16(h[4], h[5]); w.w = cvt_pk_bf16(h[6], h[7]);
                *(u32x4*)rowp = w; }
    }
};
struct EpiSwiGLU8 {
    static constexpr bool PERM = true;
    unsigned char* O; int ldc;
    __device__ __forceinline__ void operator()(const f32x4 (&acc)[2][2][4][2], const Unit& u, int wr, int wc, int fr, int fq) const {
        const int row0 = u.pm * BM + wr * 64 + fr; const int col0 = u.pn * HALF + wc * 32 + 8 * fq;
#pragma unroll
        for (int ai = 0; ai < 2; ++ai)
#pragma unroll
            for (int m = 0; m < 4; ++m) { unsigned char* rowp = O + (size_t)(row0 + ai * HALF + m * 16) * ldc + col0;
                float h[8];
#pragma unroll
                for (int n = 0; n < 2; ++n)
#pragma unroll
                    for (int j = 0; j < 4; ++j) { const float g = acc[ai][0][m][n][j], up = acc[ai][1][m][n][j]; h[n * 4 + j] = g * __builtin_amdgcn_rcpf(1.0f + __expf(-g)) * up * (float)(1 << S8_HID); }
                u32x2 w; w.x = pk8(h[0], h[1], h[2], h[3]); w.y = pk8(h[4], h[5], h[6], h[7]);
                *(u32x2*)rowp = w; }
    }
};
struct EpiGate {
    static constexpr bool PERM = true;
    bf16_t* O; const float* mod; int gate_off;
    __device__ __forceinline__ void operator()(const f32x4 (&acc)[2][2][4][2], const Unit& u, int wr, int wc, int fr, int fq) const {
        const int rt = u.pm * BM; const int bi = rt >= NLAT ? 16 : (rt >> 11);
        const int col0 = u.pn * BM + wc * 32 + 8 * fq; const float* gt = mod + bi * MODW + gate_off + col0;
        f32x4 gv[2][2];
#pragma unroll
        for (int bj = 0; bj < 2; ++bj)
#pragma unroll
            for (int n = 0; n < 2; ++n) gv[bj][n] = *(const f32x4*)(gt + bj * HALF + 4 * n) + 1.0f;
        const int row0 = rt + wr * 64 + fr;
#pragma unroll
        for (int ai = 0; ai < 2; ++ai)
#pragma unroll
            for (int m = 0; m < 4; ++m) { bf16_t* rowp = O + (size_t)(row0 + ai * HALF + m * 16) * D + col0;
#pragma unroll
                for (int bj = 0; bj < 2; ++bj) { const f32x4 v0 = acc[ai][bj][m][0] * gv[bj][0], v1 = acc[ai][bj][m][1] * gv[bj][1];
                    u32x4 w; w.x = cvt_pk_bf16(v0[0], v0[1]); w.y = cvt_pk_bf16(v0[2], v0[3]); w.z = cvt_pk_bf16(v1[0], v1[1]); w.w = cvt_pk_bf16(v1[2], v1[3]);
                    *(u32x4*)(rowp + bj * HALF) = w; } }
    }
};

template <class Epi, class Sched, bool ALIGN_EPI, bool SP2, bool FP8 = false>
__device__ __forceinline__ void gemm_phase(LAS unsigned char* lds, const Gemm g, const Sched& S, const Epi& E, int tid_in, int sw = 0x7f7f7f7f, int sa = 0x7f7f7f7f) {
    int tid_ = tid_in; asm volatile("" : "+v"(tid_));
    const int tid = tid_, wid = __builtin_amdgcn_readfirstlane(tid >> 6), lane = tid & 63, wr = wid >> 2, wc = wid & 3, fr = lane & 15, fq = lane >> 4;
    const int K = g.K, nt = K / BK;
    constexpr bool GA = Sched::GATHER;
    unsigned voffA[2], voffB[2];
#pragma unroll
    for (int i = 0; i < 2; ++i) { int R, C; stage_rc(tid * 16 + i * 8192, R, C); const int Rb = Epi::PERM ? ((R & ~31) + perm32(R & 31)) : R;
        voffA[i] = (unsigned)(R * K + C) * 2u; voffB[i] = (unsigned)(Rb * K + C) * 2u; }
    const size_t kstep = (size_t)(BK * 2);
    const size_t hstep = (size_t)HALF * K * 2;
    const unsigned ldsw = (unsigned)wid * 1024u;
    const int aoff = lds_byte(wr * 64 + fr, fq * 8), boff = lds_byte(wc * 32 + fr, fq * 8);
#define PG8_SA(b, h) (((b) * 2 + (h)) * HTB)
#define PG8_SB(b, h) ((4 + (b) * 2 + (h)) * HTB)
#define PG8_STAGE(bufoff, gbase, voff) do { _Pragma("unroll") for (int _i = 0; _i < 2; ++_i) \
        __builtin_amdgcn_global_load_lds((const unsigned*)((const char*)(gbase) + (voff)[_i]), (LAS unsigned*)(lds + (bufoff) + ldsw + _i * 8192), 16, 0, 0); } while (0)
#define PG8_LDA(dst, b, h) do { _Pragma("unroll") for (int m = 0; m < 4; ++m) _Pragma("unroll") for (int k = 0; k < 2; ++k) dst[m][k] = *(const LAS bf16x8*)(lds + PG8_SA(b, h) + aoff + m * 2048 + k * 1024); } while (0)
#define PG8_LDB(dst, b, h) do { _Pragma("unroll") for (int n = 0; n < 2; ++n) _Pragma("unroll") for (int k = 0; k < 2; ++k) dst[n][k] = *(const LAS bf16x8*)(lds + PG8_SB(b, h) + boff + n * 2048 + k * 1024); } while (0)
#define PG8_CAT(x) __builtin_shufflevector(__builtin_bit_cast(i32x4, (x)[0]), __builtin_bit_cast(i32x4, (x)[1]), 0, 1, 2, 3, 4, 5, 6, 7)
#define PG8_MMA(ai, bj, At, Bt) do { __builtin_amdgcn_s_setprio(1); _Pragma("unroll") for (int m = 0; m < 4; ++m) _Pragma("unroll") for (int n = 0; n < 2; ++n) { \
        if constexpr (FP8) { const i32x8 a8_ = PG8_CAT(Bt[n]), b8_ = PG8_CAT(At[m]); \
            asm volatile("v_mfma_scale_f32_16x16x128_f8f6f4 %0, %1, %2, %0, %3, %4 op_sel_hi:[0,0,0]" : "+v"(acc[ai][bj][m][n]) : "v"(a8_), "v"(b8_), "v"(sw), "v"(sa)); } \
        else { _Pragma("unroll") for (int k = 0; k < 2; ++k) acc[ai][bj][m][n] = __builtin_amdgcn_mfma_f32_16x16x32_bf16(Bt[n][k], At[m][k], acc[ai][bj][m][n], 0, 0, 0); } } \
        __builtin_amdgcn_s_setprio(0); } while (0)
#define PG8_WAIT_V(n) asm volatile("s_waitcnt vmcnt(" #n ")" ::: "memory")
#define PG8_WAIT_L(n) asm volatile("s_waitcnt lgkmcnt(" #n ")" ::: "memory")
#define PG8_BAR __builtin_amdgcn_s_barrier()
#define PG8_SCHED __builtin_amdgcn_sched_barrier(0)
    Unit cur, nxt; int ui = 0;
    if (!S.next(0, cur)) return;
    f32x4 acc[2][2][4][2];
#pragma unroll
    for (int a = 0; a < 2; ++a)
#pragma unroll
        for (int b = 0; b < 2; ++b)
#pragma unroll
            for (int m = 0; m < 4; ++m)
#pragma unroll
                for (int n = 0; n < 2; ++n) acc[a][b][m][n] = (f32x4){0.f, 0.f, 0.f, 0.f};
    bf16x8 At[4][2], B0[2][2], B1[2][2];
    const char* Ab = (const char*)g.A + S.a_base(cur);
    unsigned oc[2][2];
    S.a_offs(0, cur, tid, oc);
    const size_t hsA = GA ? (size_t)0 : hstep;
#define PG8_STAGE_A(bufoff, gbase, h) do { if constexpr (GA) PG8_STAGE(bufoff, gbase, oc[h]); else PG8_STAGE(bufoff, (gbase) + (h) * hsA, voffA); } while (0)
    const char* cB = (const char*)g.Bt + cur.bofs;
    if constexpr (SP2) {
        PG8_STAGE(PG8_SB(0, 0), cB, voffB); PG8_STAGE(PG8_SB(0, 1), cB + hstep, voffB); PG8_STAGE_A(PG8_SA(0, 0), Ab, 0); PG8_STAGE_A(PG8_SA(0, 1), Ab, 1);
        if (wr == 1) PG8_BAR;
        PG8_WAIT_V(2); PG8_BAR;
        PG8_STAGE(PG8_SB(1, 0), cB + kstep, voffB); PG8_STAGE_A(PG8_SA(1, 0), Ab + kstep, 0); PG8_STAGE(PG8_SB(1, 1), cB + hstep + kstep, voffB);
        PG8_WAIT_V(6); PG8_BAR;
    } else {
        PG8_STAGE(PG8_SB(0, 0), cB, voffB); PG8_STAGE_A(PG8_SA(0, 0), Ab, 0); PG8_STAGE(PG8_SB(0, 1), cB + hstep, voffB); PG8_STAGE_A(PG8_SA(0, 1), Ab, 1);
        if (wr == 1) PG8_BAR;
        PG8_WAIT_V(4); PG8_BAR;
        PG8_STAGE(PG8_SB(1, 0), cB + kstep, voffB); PG8_STAGE_A(PG8_SA(1, 0), Ab + kstep, 0); PG8_STAGE(PG8_SB(1, 1), cB + hstep + kstep, voffB);
        PG8_WAIT_V(6); PG8_BAR;
    }
    for (;;) {
        const bool has_next = S.next(ui + 1, nxt);
        const char* nB = has_next ? (const char*)g.Bt + nxt.bofs : cB;
        for (int t = 0; t < nt; t += 2) {
            const bool last = (t == nt - 2);
            const char* a1 = Ab + (size_t)(t + 1) * kstep;
            const char* b2 = last ? nB : cB + (size_t)(t + 2) * kstep; const char* b3 = b2 + kstep;
            if constexpr (SP2) {
            PG8_LDB(B0, 0, 0); PG8_LDB(B1, 0, 1); PG8_SCHED; PG8_LDA(At, 0, 0); PG8_STAGE_A(PG8_SA(1, 1), a1, 1);
            if (last && has_next) { S.a_offs(ui + 1, nxt, tid, oc); Ab = (const char*)g.A + S.a_base(nxt); }
            const char* a2 = last ? Ab : Ab + (size_t)(t + 2) * kstep; const char* a3 = a2 + kstep;
            PG8_WAIT_V(8); PG8_WAIT_L(0); PG8_BAR; PG8_MMA(0, 0, At, B0); PG8_MMA(0, 1, At, B1); PG8_BAR; PG8_SCHED;
            PG8_LDA(At, 0, 1); PG8_STAGE(PG8_SB(0, 0), b2, voffB); PG8_STAGE(PG8_SB(0, 1), b2 + hstep, voffB); PG8_STAGE_A(PG8_SA(0, 0), a2, 0);
            PG8_WAIT_V(8); PG8_WAIT_L(0); PG8_BAR; PG8_MMA(1, 0, At, B0); PG8_MMA(1, 1, At, B1); PG8_BAR; PG8_SCHED;
            PG8_LDB(B0, 1, 0); PG8_LDB(B1, 1, 1); PG8_SCHED; PG8_LDA(At, 1, 0); PG8_STAGE_A(PG8_SA(0, 1), a2, 1);
            PG8_WAIT_V(8); PG8_WAIT_L(0); PG8_BAR; PG8_MMA(0, 0, At, B0); PG8_MMA(0, 1, At, B1); PG8_BAR; PG8_SCHED;
            PG8_LDA(At, 1, 1); PG8_STAGE(PG8_SB(1, 0), b3, voffB); PG8_STAGE(PG8_SB(1, 1), b3 + hstep, voffB); PG8_STAGE_A(PG8_SA(1, 0), a3, 0);
            PG8_WAIT_V(8); PG8_WAIT_L(0); PG8_BAR; PG8_MMA(1, 0, At, B0); PG8_MMA(1, 1, At, B1); PG8_BAR; PG8_SCHED;
            } else {
            PG8_LDB(B0, 0, 0); PG8_SCHED; PG8_LDA(At, 0, 0); PG8_STAGE_A(PG8_SA(1, 1), a1, 1);
            if (last && has_next) { S.a_offs(ui + 1, nxt, tid, oc); Ab = (const char*)g.A + S.a_base(nxt); }
            const char* a2 = last ? Ab : Ab + (size_t)(t + 2) * kstep; const char* a3 = a2 + kstep;
            PG8_WAIT_L(8); PG8_BAR; PG8_WAIT_L(0); PG8_MMA(0, 0, At, B0); PG8_BAR; PG8_SCHED;
            PG8_LDB(B1, 0, 1); PG8_STAGE(PG8_SB(0, 0), b2, voffB);
            PG8_BAR; PG8_WAIT_L(0); PG8_MMA(0, 1, At, B1); PG8_BAR;
            PG8_LDA(At, 0, 1); PG8_STAGE_A(PG8_SA(0, 0), a2, 0);
            PG8_BAR; PG8_WAIT_L(0); PG8_MMA(1, 0, At, B0); PG8_BAR; PG8_SCHED;
            PG8_STAGE(PG8_SB(0, 1), b2 + hstep, voffB);
            PG8_WAIT_V(6); PG8_BAR; PG8_MMA(1, 1, At, B1); PG8_BAR;
            PG8_LDB(B0, 1, 0); PG8_SCHED; PG8_LDA(At, 1, 0); PG8_STAGE_A(PG8_SA(0, 1), a2, 1);
            PG8_WAIT_L(8); PG8_BAR; PG8_WAIT_L(0); PG8_MMA(0, 0, At, B0); PG8_BAR; PG8_SCHED;
            PG8_LDB(B1, 1, 1); PG8_STAGE(PG8_SB(1, 0), b3, voffB);
            PG8_BAR; PG8_WAIT_L(0); PG8_MMA(0, 1, At, B1); PG8_BAR;
            PG8_LDA(At, 1, 1); PG8_STAGE_A(PG8_SA(1, 0), a3, 0);
            PG8_BAR; PG8_WAIT_L(0); PG8_MMA(1, 0, At, B0); PG8_BAR; PG8_SCHED;
            PG8_STAGE(PG8_SB(1, 1), b3 + hstep, voffB);
            PG8_WAIT_V(6); PG8_BAR; PG8_MMA(1, 1, At, B1); PG8_BAR;
            }
        }
        if constexpr (ALIGN_EPI) { if (wr == 0) PG8_BAR; }
        if constexpr (FP8) asm volatile("s_nop 15\n\ts_nop 15\n\ts_nop 15" ::: "memory");
        E(acc, cur, wr, wc, fr, fq);
        if (!has_next) break;
#pragma unroll
        for (int a = 0; a < 2; ++a)
#pragma unroll
            for (int b = 0; b < 2; ++b)
#pragma unroll
                for (int m = 0; m < 4; ++m)
#pragma unroll
                    for (int n = 0; n < 2; ++n) acc[a][b][m][n] = (f32x4){0.f, 0.f, 0.f, 0.f};
        cur = nxt; cB = nB; ++ui;
        if constexpr (ALIGN_EPI) { if (wr == 1) PG8_BAR; }
    }
    PG8_WAIT_V(0);
    if constexpr (!ALIGN_EPI) { if (wr == 0) PG8_BAR; }
    PG8_BAR;
#undef PG8_SA
#undef PG8_SB
#undef PG8_STAGE
#undef PG8_STAGE_A
#undef PG8_LDA
#undef PG8_LDB
#undef PG8_MMA
#undef PG8_CAT
#undef PG8_WAIT_V
#undef PG8_WAIT_L
#undef PG8_BAR
#undef PG8_SCHED
}
}

#define XB_TMO      128
#define XB_XCNT(j)  (256  + 64 * (j))
#define XB_XSUB(j)  (1280 + 64 * (j))
#define XB_XGEN(j)  (2304 + 64 * (j))
#define XB_TOP      3328
#define XB_TOPGEN   3392
#define XCD_BAR_WORDS 3456
#define XB_SPIN_CAP (1u << 18)
__device__ __forceinline__ unsigned xb_ld(unsigned* p)              { return __hip_atomic_load(p, __ATOMIC_RELAXED, __HIP_MEMORY_SCOPE_AGENT); }
__device__ __forceinline__ unsigned xb_add(unsigned* p, unsigned v) { return __hip_atomic_fetch_add(p, v, __ATOMIC_RELAXED, __HIP_MEMORY_SCOPE_AGENT); }
__device__ __forceinline__ unsigned xb_xcc_id() { return (unsigned)__builtin_amdgcn_s_getreg((3 << 11) | 20) & 0xFu; }
#define XB_SPIN(cond, bar) do { unsigned _sp = 0; while (cond) { __builtin_amdgcn_s_sleep(1); \
    if ((++_sp & 255u) == 0u) { if (xb_ld(&(bar)[XB_TMO])) break; if (_sp > XB_SPIN_CAP) { atomicAdd(&(bar)[XB_TMO], 1u); break; } } } } while (0)
struct XcdBarrier { unsigned* bar; unsigned x; volatile LAS unsigned* st; };
__device__ __forceinline__ XcdBarrier xcd_barrier_post(unsigned* bar, volatile LAS unsigned* st) {
    XcdBarrier b; b.bar = bar; b.x = xb_xcc_id(); b.st = st;
    if (threadIdx.x == 0) (void)xb_add(&bar[XB_XCNT(b.x)], 1u);
    return b;
}
__device__ __forceinline__ void xcd_barrier_complete(unsigned* bar, unsigned x, unsigned& nloc, unsigned& nx) {
    const unsigned G = gridDim.x * gridDim.y * gridDim.z;
    unsigned sum, cnt, mine, sp = 0u;
    for (;;) {
        sum = 0u; cnt = 0u; mine = 0u;
#pragma unroll
        for (unsigned j = 0; j < 16; ++j) { const unsigned c = xb_ld(&bar[XB_XCNT(j)]); sum += c; cnt += (c > 0u) ? 1u : 0u; }
        mine = xb_ld(&bar[XB_XCNT(x)]);
        if (sum == G) break;
        __builtin_amdgcn_s_sleep(1);
        if ((++sp & 255u) == 0u) { if (xb_ld(&bar[XB_TMO])) break; if (sp > XB_SPIN_CAP) { atomicAdd(&bar[XB_TMO], 1u); break; } }
    }
    nloc = mine > 0u ? mine : 1u; nx = cnt > 0u ? cnt : 1u;
}
__device__ __forceinline__ void xcd_barrier(const XcdBarrier& b, bool leader) {
    asm volatile("s_waitcnt vmcnt(0)" ::: "memory");
    __syncthreads();
    if (leader) {
        unsigned* bar = b.bar;
        __builtin_amdgcn_s_waitcnt(0);
        unsigned nloc = b.st[0], nx = b.st[1];
        if (nloc == 0u) { xcd_barrier_complete(bar, b.x, nloc, nx); b.st[0] = nloc; b.st[1] = nx; }
        const unsigned old = xb_add(&bar[XB_XSUB(b.x)], 1u);
        const unsigned gen = old / nloc;
        if (old + 1u == (gen + 1u) * nloc) {
            __builtin_amdgcn_fence(__ATOMIC_RELEASE, "agent");
            asm volatile("s_waitcnt vmcnt(0)" ::: "memory");
            const unsigned og = xb_add(&bar[XB_TOP], 1u);
            const unsigned tg = og / nx;
            if (og + 1u == (tg + 1u) * nx) xb_add(&bar[XB_TOPGEN], 1u);
            else XB_SPIN(xb_ld(&bar[XB_TOPGEN]) == tg, bar);
            __builtin_amdgcn_fence(__ATOMIC_ACQUIRE, "agent");
            xb_add(&bar[XB_XGEN(b.x)], 1u);
            asm volatile("s_waitcnt vmcnt(0)" ::: "memory");
        } else {
            XB_SPIN(xb_ld(&bar[XB_XGEN(b.x)]) == gen, bar);
            __builtin_amdgcn_fence(__ATOMIC_ACQUIRE, "agent");
            asm volatile("s_waitcnt vmcnt(0)" ::: "memory");
        }
    }
    __syncthreads();
}

constexpr int NT = 512, NWAVES = 8;
struct Args { const float* in[24]; float* out; unsigned char* ws; int ph_lo, ph_hi; };
enum { I_X = 0, I_C, I_CTX, I_CCTX, I_WMOD, I_BMOD, I_WIN, I_WOUT, I_RPB, I_CONVW, I_CONVB, I_DTB, I_ALOG, I_DSKIP, I_NORMW, I_LNG, I_LNB, I_FG, I_FU, I_FD, I_RW, I_MG, I_MU, I_MD };
struct Frame {
    LAS unsigned char* lds;
    const float* const* in; float* out; unsigned char* ws;
    int tid, lane, wave, bid, G, gw, NGW;
};
#define LDS_WAIT() asm volatile("s_waitcnt lgkmcnt(0)" ::: "memory")
__device__ __forceinline__ Frame fresh(const Frame& F0) {
    Frame F = F0; int z; asm volatile("s_mov_b32 %0, 0" : "=s"(z)); F.ws = F0.ws + z; F.in = F0.in + z; F.out = F0.out + z;
    int ln; asm volatile("v_mbcnt_lo_u32_b32 %0, -1, 0\n\tv_mbcnt_hi_u32_b32 %0, -1, %0" : "=v"(ln));     int t = F0.wave * 64 + ln;
    F.tid = t; F.lane = t & 63; return F;
}

__device__ __forceinline__ void conv_item(const float* W, int ldn, int k0, int n0, bf16_t* dst, int K, int drow0, LAS float* scr, int lane) {
    f32x4 ld[8];
#pragma unroll
    for (int i = 0; i < 8; ++i) ld[i] = *(const f32x4*)(W + (size_t)(k0 + 8 * i + (lane >> 3)) * ldn + n0 + 4 * (lane & 7));
#pragma unroll
    for (int i = 0; i < 8; ++i) { LAS float* d = scr + (8 * i + (lane >> 3)) * 33 + 4 * (lane & 7); d[0] = ld[i][0]; d[1] = ld[i][1]; d[2] = ld[i][2]; d[3] = ld[i][3]; }
    LDS_WAIT(); asm volatile("" ::: "memory");
    const int c = lane & 7;
#pragma unroll
    for (int j = 0; j < 4; ++j) { const int n = (lane >> 3) + 8 * j; const LAS float* s = scr + (8 * c) * 33 + n;
        u32x4 o; o.x = pk2(s[0 * 33], s[1 * 33]); o.y = pk2(s[2 * 33], s[3 * 33]); o.z = pk2(s[4 * 33], s[5 * 33]); o.w = pk2(s[6 * 33], s[7 * 33]);
        *(u32x4*)(dst + (size_t)(drow0 + n) * K + k0 + 8 * c) = o; }
    LDS_WAIT(); asm volatile("" ::: "memory");
}
__device__ __forceinline__ void conv_item8(const float* W, int ldn, int k0, int n0, unsigned char* dst, int K, int drow0, float scale, LAS float* scr, int lane) {
    f32x4 ld[8];
#pragma unroll
    for (int i = 0; i < 8; ++i) ld[i] = *(const f32x4*)(W + (size_t)(k0 + 8 * i + (lane >> 3)) * ldn + n0 + 4 * (lane & 7));
#pragma unroll
    for (int i = 0; i < 8; ++i) { LAS float* d = scr + (8 * i + (lane >> 3)) * 33 + 4 * (lane & 7); d[0] = ld[i][0] * scale; d[1] = ld[i][1] * scale; d[2] = ld[i][2] * scale; d[3] = ld[i][3] * scale; }
    LDS_WAIT(); asm volatile("" ::: "memory");
    const int c = lane & 7;
#pragma unroll
    for (int j = 0; j < 4; ++j) { const int n = (lane >> 3) + 8 * j; const LAS float* sp = scr + (8 * c) * 33 + n;
        u32x2 o; o.x = pk8(sp[0 * 33], sp[1 * 33], sp[2 * 33], sp[3 * 33]); o.y = pk8(sp[4 * 33], sp[5 * 33], sp[6 * 33], sp[7 * 33]);
        *(u32x2*)(dst + (size_t)(drow0 + n) * K + k0 + 8 * c) = o; }
    LDS_WAIT(); asm volatile("" ::: "memory");
}
__device__ __forceinline__ void conv_seg(const Frame& F, const float* W, int K, int ldn, int ncols, bf16_t* dst, int mode, int& rot, int s8 = -1) {
    LAS float* scr = (LAS float*)(F.lds + F.wave * 16384);
    const int nblk = ncols / 32, nitems = (K / 64) * nblk;
    int start = F.gw - rot; if (start < 0) start += F.NGW;
    for (int it = start; it < nitems; it += F.NGW) {
        const int kb = it / nblk, nb = it % nblk, n0 = nb * 32;
        const int drow0 = (mode == 0) ? n0 : ((n0 >> 7) * 256 + (n0 & 127) + (mode == 2 ? 128 : 0));
        if (s8 >= 0) conv_item8(W, ldn, kb * 64, n0, (unsigned char*)dst, K, drow0, (float)(1 << s8), scr, F.lane);
        else conv_item(W, ldn, kb * 64, n0, dst, K, drow0, scr, F.lane);
    }
    rot = (rot + nitems) % F.NGW;
}
__device__ __forceinline__ void conv_moe(const Frame& F, int slot, int& rot) {
#if USE_FP8
    unsigned char* gu = F.ws + WS_WMGU + (size_t)slot * NEXP * 2 * DFFE * D; unsigned char* dn = F.ws + WS_WMD + (size_t)slot * NEXP * D * DFFE;
    for (int e = 0; e < NEXP; ++e) {
        const size_t so = ((size_t)slot * NEXP + e) * (size_t)D * DFFE;
        conv_seg(F, F.in[I_MG] + so, D, DFFE, DFFE, (bf16_t*)(gu + (size_t)e * 2 * DFFE * D), 1, rot, S8_WGU);
        conv_seg(F, F.in[I_MU] + so, D, DFFE, DFFE, (bf16_t*)(gu + (size_t)e * 2 * DFFE * D), 2, rot, S8_WGU);
        conv_seg(F, F.in[I_MD] + so, DFFE, D, D, (bf16_t*)(dn + (size_t)e * D * DFFE), 0, rot, S8_WD);
    }
#else
    bf16_t* gu = (bf16_t*)(F.ws + WS_WMGU); bf16_t* dn = (bf16_t*)(F.ws + WS_WMD);
    for (int e = 0; e < NEXP; ++e) {
        const size_t so = ((size_t)slot * NEXP + e) * (size_t)D * DFFE;
        conv_seg(F, F.in[I_MG] + so, D, DFFE, DFFE, gu + (size_t)e * 2 * DFFE * D, 1, rot);
        conv_seg(F, F.in[I_MU] + so, D, DFFE, DFFE, gu + (size_t)e * 2 * DFFE * D, 2, rot);
        conv_seg(F, F.in[I_MD] + so, DFFE, D, D, dn + (size_t)e * D * DFFE, 0, rot);
    }
#endif
}

constexpr int MOE_ITEMS_MAT = 1792, MOE_ITEMS_EXP = 3 * MOE_ITEMS_MAT, MOE_ITEMS_SLOT = 8 * MOE_ITEMS_EXP, MOE_ITEMS = 2 * MOE_ITEMS_SLOT;
__device__ __forceinline__ void conv_moe_item(const Frame& F, int gidx) {
    LAS float* scr = (LAS float*)(F.lds + F.wave * 16384);
    const int slot = gidx / MOE_ITEMS_SLOT, r = gidx % MOE_ITEMS_SLOT, e = r / MOE_ITEMS_EXP, r2 = r % MOE_ITEMS_EXP, mat = r2 / MOE_ITEMS_MAT, it = r2 % MOE_ITEMS_MAT;
    const size_t so = ((size_t)slot * NEXP + e) * (size_t)D * DFFE;
    if (mat < 2) { const int kb = it / 112, nb = it % 112, n0 = nb * 32; const int drow0 = (n0 >> 7) * 256 + (n0 & 127) + (mat == 1 ? 128 : 0);
        conv_item8((mat ? F.in[I_MU] : F.in[I_MG]) + so, DFFE, kb * 64, n0, F.ws + WS_WMGU + ((size_t)slot * NEXP + e) * 2 * DFFE * D, D, drow0, (float)(1 << S8_WGU), scr, F.lane); }
    else { const int kb = it / 32, nb = it % 32, n0 = nb * 32;
        conv_item8(F.in[I_MD] + so, D, kb * 64, n0, F.ws + WS_WMD + ((size_t)slot * NEXP + e) * D * DFFE, DFFE, n0, (float)(1 << S8_WD), scr, F.lane); }
}
__device__ __forceinline__ void deferred_conv(const Frame& F, int nwg, int base, int quota) {
    if (F.G != 256) return;
    const int maxu = (nwg + F.G - 1) / F.G, c0 = nwg - (maxu - 1) * F.G;
    if (c0 >= F.G || F.bid < c0) return;
    const int first = base + ((F.bid - c0) * NWAVES + F.wave) * quota;
    for (int j = 0; j < quota; ++j) { const int gidx = first + j; if (gidx < MOE_ITEMS) conv_moe_item(F, gidx); }
}
constexpr int DW_Q = 12, DW_Q2 = 10;
constexpr int DW_L0_IN = 0, DW_L0_OUT = DW_L0_IN + 64 * 8 * DW_Q, DW_L0_F1 = DW_L0_OUT + 192 * 8 * DW_Q, DW_L0_F2 = DW_L0_F1 + 160 * 8 * DW_Q, DW_L1_IN = DW_L0_F2 + 192 * 8 * DW_Q2, DW_L1_OUT = DW_L1_IN + 64 * 8 * DW_Q, DW_L2_IN = DW_L1_OUT + 192 * 8 * DW_Q, DW_END = DW_L2_IN + 64 * 8 * DW_Q;
static_assert(DW_L1_IN >= MOE_ITEMS_SLOT && DW_END >= MOE_ITEMS, "deferred conversion: layer-1 experts must be done before layer 1's FFN, all before layer 3's");
__device__ __forceinline__ void p_pro_a(const Frame& F) {
    {
        LAS float* sc = (LAS float*)F.lds; LAS float* red = sc + 17 * 1024;
        const float* c = F.in[I_C]; const float* cc = F.in[I_CCTX];
        for (int i = F.tid; i < 17 * 1024; i += NT) { const int r = i >> 10, k = i & 1023; const float v = (r < 16) ? c[r * 1024 + k] : cc[k]; sc[i] = silu_f(v); }
        __syncthreads();
        float* MOD = (float*)(F.ws + WS_MOD);
        const int col = F.tid & 31, ks = F.tid >> 5;
        for (int u = F.bid; u < 4 * 192; u += F.G) {
            const int l = u / 192, cb = u % 192;
            const float* W = F.in[I_WMOD] + (size_t)l * D * MODW + cb * 32 + col;
            float acc[17];
#pragma unroll
            for (int r = 0; r < 17; ++r) acc[r] = 0.f;
#pragma unroll 1
            for (int kb = 0; kb < 4; ++kb) { float w[16];
#pragma unroll
                for (int i = 0; i < 16; ++i) w[i] = W[(size_t)(ks * 64 + kb * 16 + i) * MODW];
#pragma unroll
                for (int i = 0; i < 16; ++i) { const int k = ks * 64 + kb * 16 + i;
#pragma unroll
                    for (int r = 0; r < 17; ++r) acc[r] += sc[r * 1024 + k] * w[i]; } }
#pragma unroll
            for (int r = 0; r < 17; ++r) red[(ks * 17 + r) * 32 + col] = acc[r];
            __syncthreads();
            for (int i = F.tid; i < 17 * 32; i += NT) { const int r = i >> 5, c2 = i & 31; float sm = 0.f;
#pragma unroll
                for (int k2 = 0; k2 < 16; ++k2) sm += red[(k2 * 17 + r) * 32 + c2];
                MOD[(size_t)(l * 17 + r) * MODW + cb * 32 + c2] = sm + F.in[I_BMOD][l * MODW + cb * 32 + c2]; }
            __syncthreads();
        }
    }
    int rot = 0;
    for (int l = 0; l < DEPTH; ++l) {
#if USE_FP8 && FP8_INPROJ
        conv_seg(F, F.in[I_WIN] + (size_t)l * D * D_IN_PROJ, D, D_IN_PROJ, NPROJ, (bf16_t*)(F.ws + WS_WIN + (size_t)l * NPROJ * D), 0, rot, S8_WGU);
#else
        conv_seg(F, F.in[I_WIN] + (size_t)l * D * D_IN_PROJ, D, D_IN_PROJ, NPROJ, (bf16_t*)(F.ws + WS_WIN) + (size_t)l * NPROJ * D, 0, rot);
#endif
        conv_seg(F, F.in[I_WOUT] + (size_t)l * D * D, D, D, D, (bf16_t*)(F.ws + WS_WOUT) + (size_t)l * D * D, 0, rot);
    }
    for (int s = 0; s < 2; ++s) {
#if USE_FP8 && FP8_DENSE1
        conv_seg(F, F.in[I_FG] + (size_t)s * D * DFF, D, DFF, DFF, (bf16_t*)(F.ws + WS_WFGU + (size_t)s * 2 * DFF * D), 1, rot, S8_WGU);
        conv_seg(F, F.in[I_FU] + (size_t)s * D * DFF, D, DFF, DFF, (bf16_t*)(F.ws + WS_WFGU + (size_t)s * 2 * DFF * D), 2, rot, S8_WGU);
#else
        conv_seg(F, F.in[I_FG] + (size_t)s * D * DFF, D, DFF, DFF, (bf16_t*)(F.ws + WS_WFGU) + (size_t)s * 2 * DFF * D, 1, rot);
        conv_seg(F, F.in[I_FU] + (size_t)s * D * DFF, D, DFF, DFF, (bf16_t*)(F.ws + WS_WFGU) + (size_t)s * 2 * DFF * D, 2, rot);
#endif
#if USE_FP8 && FP8_DENSE2
        conv_seg(F, F.in[I_FD] + (size_t)s * DFF * D, DFF, D, D, (bf16_t*)(F.ws + WS_WFD + (size_t)s * D * DFF), 0, rot, S8_WD);
#else
        conv_seg(F, F.in[I_FD] + (size_t)s * DFF * D, DFF, D, D, (bf16_t*)(F.ws + WS_WFD) + (size_t)s * D * DFF, 0, rot);
#endif
    }
    if (F.G != 256) { conv_moe(F, 0, rot); conv_moe(F, 1, rot); }
    { bf16_t* wdt = (bf16_t*)(F.ws + WS_WDT);
      for (int i = F.bid * NT + F.tid; i < DEPTH * 16 * D; i += F.G * NT) { const int l = i / (16 * D), n = (i / D) & 15, k = i % D;
          wdt[i] = (bf16_t)f2bf(F.in[I_WIN][((size_t)l * D + k) * D_IN_PROJ + NPROJ + n]); } }
}

#define RIDX(q) (8 * lane + 512 * ((q) >> 1) + 4 * ((q) & 1))
__device__ __forceinline__ void row_load(const float* p, int lane, f32x4 (&v)[4]) {
#pragma unroll
    for (int q = 0; q < 4; ++q) v[q] = *(const f32x4*)(p + RIDX(q));
}
__device__ __forceinline__ void row_store(float* p, int lane, const f32x4 (&v)[4]) {
#pragma unroll
    for (int q = 0; q < 4; ++q) *(f32x4*)(p + RIDX(q)) = v[q];
}
__device__ __forceinline__ void row_mod_store8(unsigned char* hrow, int lane, const f32x4 (&v)[4], const float* sh, const float* sc, f32x4 (&hv)[4]) {
#pragma unroll
    for (int j = 0; j < 2; ++j) { u32x2 w;
#pragma unroll
        for (int h = 0; h < 2; ++h) { const int q = 2 * j + h; const f32x4 a = *(const f32x4*)(sc + RIDX(q)), b = *(const f32x4*)(sh + RIDX(q));
            hv[q] = v[q] * (a + 1.0f) + b; const f32x4 t = hv[q] * (float)(1 << S8_ACT); const unsigned pw = pk8(t[0], t[1], t[2], t[3]); if (h == 0) w.x = pw; else w.y = pw; }
        *(u32x2*)(hrow + 8 * lane + 512 * j) = w; }
}
__device__ __forceinline__ void row_load_h(const bf16_t* p, int lane, f32x4 (&v)[4]) {
#pragma unroll
    for (int j = 0; j < 2; ++j) { const u32x4 w = *(const u32x4*)(p + 8 * lane + 512 * j); v[2 * j] = (f32x4){bflo(w.x), bfhi(w.x), bflo(w.y), bfhi(w.y)}; v[2 * j + 1] = (f32x4){bflo(w.z), bfhi(w.z), bflo(w.w), bfhi(w.w)}; }
}
__device__ __forceinline__ void row_store_h(bf16_t* p, int lane, const f32x4 (&v)[4]) {
#pragma unroll
    for (int j = 0; j < 2; ++j) { u32x4 w; w.x = pk2(v[2 * j][0], v[2 * j][1]); w.y = pk2(v[2 * j][2], v[2 * j][3]); w.z = pk2(v[2 * j + 1][0], v[2 * j + 1][1]); w.w = pk2(v[2 * j + 1][2], v[2 * j + 1][3]);
        *(u32x4*)(p + 8 * lane + 512 * j) = w; }
}
__device__ __forceinline__ void row_mod_store(bf16_t* hrow, int lane, const f32x4 (&v)[4], const float* sh, const float* sc, f32x4 (&hv)[4]) {
#pragma unroll
    for (int q = 0; q < 4; ++q) { const f32x4 a = *(const f32x4*)(sc + RIDX(q)), b = *(const f32x4*)(sh + RIDX(q)); hv[q] = v[q] * (a + 1.0f) + b; }
    row_store_h(hrow, lane, hv);
}
__device__ __forceinline__ void row_ln(f32x4 (&v)[4], const float* g, const float* b, int lane) {
    float s = 0.f;
#pragma unroll
    for (int j = 0; j < 4; ++j) s += (v[j][0] + v[j][1]) + (v[j][2] + v[j][3]);
    const float mean = wave_sum(s) * (1.0f / D); float q2 = 0.f;
#pragma unroll
    for (int j = 0; j < 4; ++j) { v[j] = v[j] - mean; q2 += (v[j][0] * v[j][0] + v[j][1] * v[j][1]) + (v[j][2] * v[j][2] + v[j][3] * v[j][3]); }
    const float rstd = 1.0f / sqrtf(wave_sum(q2) * (1.0f / D) + LN_EPS);
#pragma unroll
    for (int q = 0; q < 4; ++q) { const f32x4 gg = *(const f32x4*)(g + RIDX(q)), bb = *(const f32x4*)(b + RIDX(q)); v[q] = v[q] * rstd * gg + bb; }
}
__device__ __forceinline__ int mod_row_of(int row) { return row < NLAT ? (row >> 11) : 16; }
struct RowRaw { u32x4 x[2], d[2]; };
template <bool WITH_D> __device__ __forceinline__ void row_issue(const bf16_t* X, const bf16_t* Dl, int row, int lane, RowRaw& r) {
#pragma unroll
    for (int j = 0; j < 2; ++j) { r.x[j] = *(const u32x4*)(X + (size_t)row * D + 8 * lane + 512 * j); if (WITH_D) r.d[j] = *(const u32x4*)(Dl + (size_t)row * D + 8 * lane + 512 * j); }
}
__device__ __forceinline__ void unpack8(const u32x4 w, f32x4& lo, f32x4& hi) { lo = (f32x4){bflo(w.x), bfhi(w.x), bflo(w.y), bfhi(w.y)}; hi = (f32x4){bflo(w.z), bfhi(w.z), bflo(w.w), bfhi(w.w)}; }
__device__ __forceinline__ void row_combine(const RowRaw& r, f32x4 (&v)[4]) {
#pragma unroll
    for (int j = 0; j < 2; ++j) { f32x4 x0, x1, d0, d1; unpack8(r.x[j], x0, x1); unpack8(r.d[j], d0, d1); v[2 * j] = x0 * ALPHA + d0; v[2 * j + 1] = x1 * ALPHA + d1; }
}

__device__ __forceinline__ void p_pro_b(const Frame& F) {
    const float* MOD = (const float*)(F.ws + WS_MOD); bf16_t* H = (bf16_t*)(F.ws + WS_H); bf16_t* X = (bf16_t*)(F.ws + WS_X);
    for (int row = F.gw; row < NTOK; row += F.NGW) {
        const float* src = row < NLAT ? F.in[I_X] + (size_t)row * D : F.in[I_CTX] + (size_t)(row - NLAT) * D;
        f32x4 v[4], hv[4]; row_load(src, F.lane, v);
        row_store_h(X + (size_t)row * D, F.lane, v);
        const float* m = MOD + (size_t)mod_row_of(row) * MODW;
        row_mod_store(H + (size_t)row * D, F.lane, v, m, m + D, hv);
    }
}

__device__ __forceinline__ void p_inproj(const Frame& F, int layer) {
    const bf16_t* H = (const bf16_t*)(F.ws + WS_H);
    {
        const bf16_t* wdt = (const bf16_t*)(F.ws + WS_WDT) + (size_t)layer * 16 * D; float* DT = (float*)(F.ws + WS_DT);
        const int fr = F.lane & 15, fq = F.lane >> 4; const float dtb = F.in[I_DTB][layer * 16 + fr];
        for (int g = F.gw; g < NTOK / 16; g += F.NGW) {
            f32x4 acc = {0.f, 0.f, 0.f, 0.f};
            const bf16_t* ap = H + (size_t)(g * 16 + fr) * D + fq * 8; const bf16_t* bp = wdt + (size_t)fr * D + fq * 8;
#pragma unroll 8
            for (int ks = 0; ks < 32; ++ks) { const bf16x8 a = *(const bf16x8*)(ap + ks * 32), b = *(const bf16x8*)(bp + ks * 32);
                acc = __builtin_amdgcn_mfma_f32_16x16x32_bf16(a, b, acc, 0, 0, 0); }
#pragma unroll
            for (int r = 0; r < 4; ++r) { const float x = acc[r] + dtb; DT[(size_t)(g * 16 + fq * 4 + r) * 16 + fr] = x > 20.f ? x : log1pf(__expf(x)); }
        }
    }
    pg8::EpiBf16 E{(bf16_t*)(F.ws + WS_PROJ), NPROJ};
#if USE_FP8 && FP8_INPROJ
    pg8::Gemm g{(const bf16_t*)(F.ws + WS_H8IN), (const bf16_t*)(F.ws + WS_WIN + (size_t)layer * NPROJ * D), D / 2};
    pg8::DenseOrder S; S.init(NTOK, NPROJ, D / 2, F.G, F.bid, REP_GEMM);
    pg8::gemm_phase<pg8::EpiBf16, pg8::DenseOrder, true, FP8_SP2, true>(F.lds, g, S, E, F.tid, (127 - S8_WGU) * 0x01010101, (127 - S8_ACT) * 0x01010101);
#else
    pg8::Gemm g{H, (const bf16_t*)(F.ws + WS_WIN) + (size_t)layer * NPROJ * D, D};
    pg8::DenseOrder S; S.init(NTOK, NPROJ, D, F.G, F.bid, REP_GEMM);
    pg8::gemm_phase<pg8::EpiBf16, pg8::DenseOrder, true, true>(F.lds, g, S, E, F.tid);
#endif
    if (layer == 0) deferred_conv(F, (NTOK / 256) * (NPROJ / 256), DW_L0_IN, DW_Q); else if (layer < 3) deferred_conv(F, (NTOK / 256) * (NPROJ / 256), layer == 1 ? DW_L1_IN : DW_L2_IN, DW_Q);
}

typedef short s16x4 __attribute__((ext_vector_type(4)));
__device__ __forceinline__ s16x4 lds_tr16(LAS const unsigned char* p) { return __builtin_bit_cast(s16x4, __builtin_amdgcn_ds_read_tr16_b64_v4i16((LAS s16x4*)p)); }
constexpr int NA_KS = 144;
constexpr float LOG2E = 1.4426950408889634f;
__device__ __forceinline__ void na_unit(const Frame& F, int layer, int b, int h, int mode, int m) {
    LAS unsigned char* KV = F.lds;
    LAS float* rp = (LAS float*)(F.lds + 120832);
    const bf16_t* PROJ = (const bf16_t*)(F.ws + WS_PROJ); bf16_t* MIX = (bf16_t*)(F.ws + WS_MIX);
    const int tid = F.tid, lane = F.lane, w = F.wave, q16 = lane & 15, g = lane >> 4;
    int rbase = 0, nk = 0;
    if (mode == 0) { rbase = 2 * m - 4; rbase = rbase < 0 ? 0 : (rbase > 24 ? 24 : rbase); nk = 32 - rbase; nk = nk > 9 ? 9 : nk; }
    const int kfirst = (mode == 0) ? 0 : 576 * 8, nloc8 = nk * 64 * 8;
#define NA_STAGE(OFFS) do { int stid_ = tid; asm volatile("" : "+v"(stid_));     \
        NA_STAGE_PART(OFFS, 0, 7); __builtin_amdgcn_sched_barrier(0); NA_STAGE_PART(OFFS, 7, 13); __builtin_amdgcn_sched_barrier(0); } while (0)
#define NA_STAGE_PART(OFFS, K0, K1) do { u32x4 st_[13]; \
        _Pragma("unroll") for (int k_ = K0; k_ < K1; ++k_) { const int i_ = stid_ + kfirst + k_ * NT, key_ = i_ >> 3, ch_ = i_ & 7; const bool ok_ = (i_ < 832 * 8) && !(key_ < 576 && i_ >= nloc8); \
            const int grow_ = key_ < 576 ? b * SEQ + rbase * 64 + key_ : NLAT + b * CTX + (key_ - 576); \
            st_[k_] = ok_ ? *(const u32x4*)(PROJ + (size_t)grow_ * NPROJ + (OFFS) + h * 64 + ch_ * 8) : (u32x4){0u, 0u, 0u, 0u}; } \
        _Pragma("unroll") for (int k_ = K0; k_ < K1; ++k_) { const int i_ = stid_ + kfirst + k_ * NT, key_ = i_ >> 3, ch_ = i_ & 7; const bool ok_ = (i_ < 832 * 8) && !(key_ < 576 && i_ >= nloc8); \
            if (ok_) *(LAS u32x4*)(KV + key_ * NA_KS + ch_ * 16) = st_[k_]; } } while (0)
    __syncthreads();
    NA_STAGE(OFF_K);
    if (mode == 0 && tid < 465) rp[tid] = F.in[I_RPB][(size_t)(layer * 8 + h) * 465 + tid] * LOG2E;
    __syncthreads();
    int i = 0, j0 = 0, hs = 0, kr0 = 0, qrow;
    if (mode == 0) { i = 2 * m + (w >> 2); j0 = (w & 3) * 16; qrow = b * SEQ + i * 64 + j0; hs = j0 - 8; hs = hs < 0 ? 0 : (hs > 32 ? 32 : hs);
        int r0 = i - 4; r0 = r0 < 0 ? 0 : (r0 > 24 ? 24 : r0); kr0 = r0 - rbase; }
    else qrow = NLAT + b * CTX + m * 128 + w * 16;
    bf16x8 qf[2];
#pragma unroll
    for (int ks = 0; ks < 2; ++ks) qf[ks] = *(const bf16x8*)(PROJ + (size_t)(qrow + q16) * NPROJ + h * 64 + ks * 32 + g * 8);
    f32x4 S[32];
    const LAS unsigned char* kb = KV + q16 * NA_KS + g * 16;
    if (mode == 0) {
        const int j = j0 + q16; int cs = j - 8; cs = cs < 0 ? 0 : (cs > 48 ? 48 : cs);
        const int rb0 = (kr0 + rbase) - i + 7;
#pragma unroll
        for (int tl = 0; tl < 16; ++tl) { const int kr = tl >> 1, half = tl & 1; const int kidx0 = (kr0 + kr) * 64 + hs + 16 * half;
            f32x4 a = {0.f, 0.f, 0.f, 0.f};
#pragma unroll
            for (int ks = 0; ks < 2; ++ks) { const bf16x8 kf = *(const LAS bf16x8*)(kb + kidx0 * NA_KS + ks * 64); a = __builtin_amdgcn_mfma_f32_16x16x32_bf16(kf, qf[ks], a, 0, 0, 0); }
#pragma unroll
            for (int r = 0; r < 4; ++r) { const int kc = hs + 16 * half + 4 * g + r; const bool inw = (kc >= cs) && (kc < cs + 16);
                int cbi = kc - j + 15; cbi = cbi < 0 ? 0 : (cbi > 30 ? 30 : cbi);
                a[r] = inw ? a[r] * (0.125f * LOG2E) + rp[(rb0 + kr) * 31 + cbi] : -INFINITY; }
            S[tl] = a; if ((tl & 1) == 1) __builtin_amdgcn_sched_barrier(0); }
    } else {
#pragma unroll
        for (int tl = 0; tl < 16; ++tl) S[tl] = (f32x4){-INFINITY, -INFINITY, -INFINITY, -INFINITY};
    }
#pragma unroll
    for (int tc = 0; tc < 16; ++tc) { const int kidx0 = 576 + 16 * tc; f32x4 a = {0.f, 0.f, 0.f, 0.f};
#pragma unroll
        for (int ks = 0; ks < 2; ++ks) { const bf16x8 kf = *(const LAS bf16x8*)(kb + kidx0 * NA_KS + ks * 64); a = __builtin_amdgcn_mfma_f32_16x16x32_bf16(kf, qf[ks], a, 0, 0, 0); }
        S[16 + tc] = a * (0.125f * LOG2E); if ((tc & 1) == 1) __builtin_amdgcn_sched_barrier(0); }
    float mx = -INFINITY;
#pragma unroll
    for (int t = 0; t < 32; ++t) mx = fmaxf(fmaxf(fmaxf(S[t][0], S[t][1]), fmaxf(S[t][2], S[t][3])), mx);
    mx = fmaxf(mx, __shfl_xor(mx, 16)); mx = fmaxf(mx, __shfl_xor(mx, 32));
    float sum = 0.f; u32x4 P[16];
#pragma unroll
    for (int kk = 0; kk < 16; ++kk) { float e[8];
#pragma unroll
        for (int r = 0; r < 4; ++r) { e[r] = __builtin_amdgcn_exp2f(S[2 * kk][r] - mx); e[4 + r] = __builtin_amdgcn_exp2f(S[2 * kk + 1][r] - mx); }
        sum += ((e[0] + e[1]) + (e[2] + e[3])) + ((e[4] + e[5]) + (e[6] + e[7]));
        P[kk].x = pg8::cvt_pk_bf16_pin(e[0], e[1]); P[kk].y = pg8::cvt_pk_bf16_pin(e[2], e[3]); P[kk].z = pg8::cvt_pk_bf16_pin(e[4], e[5]); P[kk].w = pg8::cvt_pk_bf16_pin(e[6], e[7]); }
    sum += __shfl_xor(sum, 16); sum += __shfl_xor(sum, 32);
    const float inv = 1.0f / sum;
    __syncthreads();
    NA_STAGE(OFF_V);
    __syncthreads();
    f32x4 o[4];
#pragma unroll
    for (int dt = 0; dt < 4; ++dt) o[dt] = (f32x4){0.f, 0.f, 0.f, 0.f};
    const LAS unsigned char* vb = KV + (4 * g + (q16 >> 2)) * NA_KS + (q16 & 3) * 8;
#pragma unroll
    for (int kk = 0; kk < 16; ++kk) {
        if (kk < 8 && mode != 0) continue;
        const int kidx0 = (kk < 8) ? (kr0 + kk) * 64 + hs : 576 + 32 * (kk - 8);
        const bf16x8 pa = __builtin_bit_cast(bf16x8, P[kk]);
#pragma unroll
        for (int dt = 0; dt < 4; ++dt) { const s16x4 lo = lds_tr16(vb + kidx0 * NA_KS + dt * 32), hi = lds_tr16(vb + (kidx0 + 16) * NA_KS + dt * 32);
            const bf16x8 vf = {lo[0], lo[1], lo[2], lo[3], hi[0], hi[1], hi[2], hi[3]};
            o[dt] = __builtin_amdgcn_mfma_f32_16x16x32_bf16(pa, vf, o[dt], 0, 0, 0); }
    }
#undef NA_STAGE
#undef NA_STAGE_PART
#pragma unroll
    for (int r = 0; r < 4; ++r) { const float ir = __shfl(inv, 4 * g + r);
        bf16_t* op = MIX + (size_t)(qrow + 4 * g + r) * D + h * 64 + q16;
#pragma unroll
        for (int dt = 0; dt < 4; dt += 2) { const unsigned pw = pk2(o[dt][r] * ir, o[dt + 1][r] * ir); op[dt * 16] = (bf16_t)(pw & 0xffffu); op[dt * 16 + 16] = (bf16_t)(pw >> 16); } }
}

struct PrepassW { f32x4 w[5][2]; f32x4 b[2]; float ifq[8]; };
__device__ __forceinline__ void ssd_prepass_unit(const Frame& F, int u, const PrepassW& W) {
    const bf16_t* PROJ = (const bf16_t*)(F.ws + WS_PROJ); bf16_t* U = (bf16_t*)(F.ws + WS_U);
    int rowbase, t0, L; bool lat;
    if (u < NLAT / 16) { rowbase = (u >> 7) * SEQ; t0 = (u & 127) * 16; L = SEQ; lat = true; }
    else { const int v = u - NLAT / 16; rowbase = NLAT + (v >> 4) * CTX; t0 = (v & 15) * 16; L = CTX; lat = false; }
    const int cg = F.tid & 127, tq = F.tid >> 7, c0 = 8 * cg, tb = t0 + 4 * tq;
    u32x4 win[8];
#pragma unroll
    for (int j = 0; j < 8; ++j) { const int t = tb - 2 + j; win[j] = (t >= 0 && t < L) ? *(const u32x4*)(PROJ + (size_t)(rowbase + t) * NPROJ + OFF_XBC + c0) : (u32x4){0u, 0u, 0u, 0u}; }
    const int lc = c0 & 127, hf = lc >> 6, role = (lc >> 5) & 1; const bool rope = lat && (c0 >= 512);
#pragma unroll
    for (int tt = 0; tt < 4; ++tt) {
        f32x4 a0 = W.b[0], a1 = W.b[1];
#pragma unroll
        for (int j = 0; j < 5; ++j) { const u32x4 r = win[tt + j];
            a0 += W.w[j][0] * (f32x4){bflo(r.x), bfhi(r.x), bflo(r.y), bfhi(r.y)}; a1 += W.w[j][1] * (f32x4){bflo(r.z), bfhi(r.z), bflo(r.w), bfhi(r.w)}; }
        float uu[8];
#pragma unroll
        for (int k = 0; k < 4; ++k) { uu[k] = silu_f(a0[k]); uu[4 + k] = silu_f(a1[k]); }
        if (rope) {
            const int tk = tb + tt; const float pos = (float)(hf ? (tk & 63) : (tk >> 6));
#pragma unroll
            for (int k = 0; k < 8; ++k) { const float o = __shfl_xor(uu[k], 4); const float sn = __builtin_amdgcn_sinf(pos * W.ifq[k]), cs = __builtin_amdgcn_cosf(pos * W.ifq[k]);
                uu[k] = role ? (o * sn + uu[k] * cs) : (uu[k] * cs - o * sn); }
        }
        u32x4 o; o.x = pk2(uu[0], uu[1]); o.y = pk2(uu[2], uu[3]); o.z = pk2(uu[4], uu[5]); o.w = pk2(uu[6], uu[7]);
        *(u32x4*)(U + (size_t)(rowbase + tb + tt) * 1024 + c0) = o;
    }
}
__device__ __forceinline__ void ssd_prepass_weights(const Frame& F, int layer, PrepassW& W) {
    const int c0 = 8 * (F.tid & 127);
    const float* cwp = F.in[I_CONVW] + (size_t)layer * 5 * 1024 + c0;
#pragma unroll
    for (int j = 0; j < 5; ++j) { W.w[j][0] = *(const f32x4*)(cwp + j * 1024); W.w[j][1] = *(const f32x4*)(cwp + j * 1024 + 4); }
    W.b[0] = *(const f32x4*)(F.in[I_CONVB] + (size_t)layer * 1024 + c0); W.b[1] = *(const f32x4*)(F.in[I_CONVB] + (size_t)layer * 1024 + c0 + 4);
    const int n0 = c0 & 31;
#pragma unroll
    for (int k = 0; k < 8; ++k) W.ifq[k] = __builtin_amdgcn_exp2f(-(float)(n0 + k) * (13.287712379549449f / 32.0f)) * 0.15915494309189535f;
}

constexpr int S_CQ = 0, S_BQ = 17408, S_BT = 34816, S_XT = 53248, S_MQ = 62464, S_HB = 71680, S_MISC = 106496;
__device__ __forceinline__ void ssd_mfma_unit(const Frame& F, int layer, int b, int h, int dir) {
    const int g = h >> 2, tid = F.tid, lane = F.lane, w = F.wave, q16 = lane & 15, gq = lane >> 4;
    const bf16_t* U = (const bf16_t*)(F.ws + WS_U); const float* DTS = (const float*)(F.ws + WS_DT);
    bf16_t* Y = (bf16_t*)(F.ws + (dir ? WS_YB : WS_YF));
    const float aneg = -__expf(F.in[I_ALOG][layer * 16 + dir * 8 + h]), dsk = F.in[I_DSKIP][layer * 8 + h];
    LAS unsigned char* L = F.lds;
    __syncthreads();
    for (int i = tid; i < 64 * 272 / 16; i += NT) *(LAS u32x4*)(L + S_HB + i * 16) = (u32x4){0u, 0u, 0u, 0u};
    f32x4 Hacc[4];
#pragma unroll
    for (int j = 0; j < 4; ++j) Hacc[j] = (f32x4){0.f, 0.f, 0.f, 0.f};
    u32x4 px, pb[2], pc[2];
    const int xl = lane, xc = w;
    float pdt = 0.f;
#define SSD_ROW(ci_, l_) ({ const int s_ = (ci_) < 4 ? 0 : 1, k_ = s_ ? (ci_) - 4 : (ci_), nc_ = s_ ? 32 : 4, c_ = dir ? nc_ - 1 - k_ : k_; \
        (s_ ? b * SEQ : NLAT + b * CTX) + c_ * 64 + (dir ? 63 - (l_) : (l_)); })
#define SSD_PREFETCH(ci_) do { px = *(const u32x4*)(U + (size_t)SSD_ROW(ci_, xl) * 1024 + h * 64 + xc * 8); \
        if (w == 0) pdt = DTS[(size_t)SSD_ROW(ci_, lane) * 16 + dir * 8 + h]; \
        _Pragma("unroll") for (int k_ = 0; k_ < 2; ++k_) { const int l_ = lane, c16_ = w + 8 * k_; const size_t ro_ = (size_t)SSD_ROW(ci_, l_) * 1024; \
            pb[k_] = *(const u32x4*)(U + ro_ + 512 + g * 128 + c16_ * 8); pc[k_] = *(const u32x4*)(U + ro_ + 768 + g * 128 + c16_ * 8); } } while (0)
    SSD_PREFETCH(0);
    int par = 0;
    for (int ci = 0; ci < 36; ++ci) {
        LAS float* misc = (LAS float*)(L + S_MISC) + par * 272;
        if (w == 0) {
            const float dt = pdt; float cs = dt * aneg;
#pragma unroll
            for (int o = 1; o < 64; o <<= 1) { const float v = __shfl_up(cs, o); cs += (lane >= o) ? v : 0.f; }
            const float tot = __shfl(cs, 63);
            misc[lane] = dt; misc[64 + lane] = cs; misc[128 + lane] = __expf(cs); misc[192 + lane] = __expf(tot - cs) * dt; if (lane == 0) misc[256] = __expf(tot);
        }
        __syncthreads();
        {
            const unsigned xw[4] = {px.x, px.y, px.z, px.w};
#pragma unroll
            for (int e = 0; e < 4; ++e) { *(LAS unsigned short*)(L + S_XT + (xc * 8 + 2 * e) * 144 + xl * 2) = (unsigned short)(xw[e] & 0xffffu); *(LAS unsigned short*)(L + S_XT + (xc * 8 + 2 * e + 1) * 144 + xl * 2) = (unsigned short)(xw[e] >> 16); }
#pragma unroll
            for (int k = 0; k < 2; ++k) { const int l = lane, c16 = w + 8 * k; const float wl = misc[192 + l];
                *(LAS u32x4*)(L + S_BQ + l * 272 + c16 * 16) = pb[k]; *(LAS u32x4*)(L + S_CQ + l * 272 + c16 * 16) = pc[k];
                const unsigned bw[4] = {pb[k].x, pb[k].y, pb[k].z, pb[k].w};
#pragma unroll
                for (int e = 0; e < 4; ++e) { const unsigned pw = pk2(bflo(bw[e]) * wl, bfhi(bw[e]) * wl);
                    *(LAS unsigned short*)(L + S_BT + (c16 * 8 + 2 * e) * 144 + l * 2) = (unsigned short)(pw & 0xffffu); *(LAS unsigned short*)(L + S_BT + (c16 * 8 + 2 * e + 1) * 144 + l * 2) = (unsigned short)(pw >> 16); } }
        }
        if (ci + 1 < 36) SSD_PREFETCH(ci + 1);
        __syncthreads();
        const int lt = w >> 1, t2 = (w & 1) * 2;
        bf16x8 cfr[4];
#pragma unroll
        for (int ks = 0; ks < 4; ++ks) cfr[ks] = *(const LAS bf16x8*)(L + S_CQ + (16 * lt + q16) * 272 + ks * 64 + gq * 16);
        {
            const f32x4 csl = *(const LAS f32x4*)(misc + 64 + 16 * lt + 4 * gq);
#pragma unroll
            for (int k = 0; k < 2; ++k) { const int st = t2 + k; f32x4 a = {0.f, 0.f, 0.f, 0.f};
                if (st <= lt) {
#pragma unroll
                    for (int ks = 0; ks < 4; ++ks) { const bf16x8 bfr = *(const LAS bf16x8*)(L + S_BQ + (16 * st + q16) * 272 + ks * 64 + gq * 16); a = __builtin_amdgcn_mfma_f32_16x16x32_bf16(cfr[ks], bfr, a, 0, 0, 0); }
                    const int sidx = 16 * st + q16; const float css = misc[64 + sidx], dts = misc[sidx];
#pragma unroll
                    for (int r = 0; r < 4; ++r) { const int l = 16 * lt + 4 * gq + r; a[r] = (sidx <= l) ? a[r] * __expf(csl[r] - css) * dts : 0.f; }
                }
#pragma unroll
                for (int r = 0; r < 4; r += 2) { const unsigned pw = pk2(a[r], a[r + 1]);
                    *(LAS unsigned short*)(L + S_MQ + (16 * lt + 4 * gq + r) * 144 + (16 * st + q16) * 2) = (unsigned short)(pw & 0xffffu); *(LAS unsigned short*)(L + S_MQ + (16 * lt + 4 * gq + r + 1) * 144 + (16 * st + q16) * 2) = (unsigned short)(pw >> 16); } }
        }
        __syncthreads();
        {
            const f32x4 ecs = *(const LAS f32x4*)(misc + 128 + 16 * lt + 4 * gq);
            const LAS unsigned char* HB = L + S_HB + par * 17408;
#pragma unroll
            for (int k = 0; k < 2; ++k) { const int pt = t2 + k; f32x4 a = {0.f, 0.f, 0.f, 0.f};
#pragma unroll
                for (int ks = 0; ks < 4; ++ks) { const bf16x8 hfr = *(const LAS bf16x8*)(HB + (16 * pt + q16) * 272 + ks * 64 + gq * 16); a = __builtin_amdgcn_mfma_f32_16x16x32_bf16(cfr[ks], hfr, a, 0, 0, 0); }
                a = a * ecs;
#pragma unroll
                for (int ks = 0; ks < 2; ++ks) if (ks <= (lt >> 1)) { const bf16x8 mfr = *(const LAS bf16x8*)(L + S_MQ + (16 * lt + q16) * 144 + ks * 64 + gq * 16), xfr = *(const LAS bf16x8*)(L + S_XT + (16 * pt + q16) * 144 + ks * 64 + gq * 16);
                    a = __builtin_amdgcn_mfma_f32_16x16x32_bf16(mfr, xfr, a, 0, 0, 0); }
                if (dir == 0) { const u32x2 xv = *(const LAS u32x2*)(L + S_XT + (16 * pt + q16) * 144 + (16 * lt + 4 * gq) * 2);
                    a[0] += dsk * bflo(xv.x); a[1] += dsk * bfhi(xv.x); a[2] += dsk * bflo(xv.y); a[3] += dsk * bfhi(xv.y); }
                { const int row0 = SSD_ROW(ci, 16 * lt + 4 * gq); bf16_t* yp = Y + (size_t)row0 * 512 + h * 64 + 16 * pt + q16; const int rs = dir ? -512 : 512;
                  const unsigned w01 = pk2(a[0], a[1]), w23 = pk2(a[2], a[3]);
                  yp[0] = (bf16_t)(w01 & 0xffffu); yp[rs] = (bf16_t)(w01 >> 16); yp[2 * rs] = (bf16_t)(w23 & 0xffffu); yp[3 * rs] = (bf16_t)(w23 >> 16); } }
            const int pt2 = w & 3, nb = (w >> 2) * 4; const float et = misc[256];
            bf16x8 xf2[2];
#pragma unroll
            for (int ks = 0; ks < 2; ++ks) xf2[ks] = *(const LAS bf16x8*)(L + S_XT + (16 * pt2 + q16) * 144 + ks * 64 + gq * 16);
            LAS unsigned char* HN = L + S_HB + (par ^ 1) * 17408;
#pragma unroll
            for (int j = 0; j < 4; ++j) { const int nt = nb + j; Hacc[j] = Hacc[j] * et;
#pragma unroll
                for (int ks = 0; ks < 2; ++ks) { const bf16x8 bfr = *(const LAS bf16x8*)(L + S_BT + (16 * nt + q16) * 144 + ks * 64 + gq * 16); Hacc[j] = __builtin_amdgcn_mfma_f32_16x16x32_bf16(xf2[ks], bfr, Hacc[j], 0, 0, 0); }
#pragma unroll
                for (int r = 0; r < 4; r += 2) { const unsigned pw = pk2(Hacc[j][r], Hacc[j][r + 1]);
                    *(LAS unsigned short*)(HN + (16 * pt2 + 4 * gq + r) * 272 + (16 * nt + q16) * 2) = (unsigned short)(pw & 0xffffu); *(LAS unsigned short*)(HN + (16 * pt2 + 4 * gq + r + 1) * 272 + (16 * nt + q16) * 2) = (unsigned short)(pw >> 16); } }
        }
        par ^= 1;
    }
#undef SSD_ROW
#undef SSD_PREFETCH
}

__device__ __forceinline__ void na_run(const Frame& F, int layer) {
    LAS unsigned char* KV = F.lds; LAS float* rp = (LAS float*)(F.lds + 120832);
    const bf16_t* PROJ = (const bf16_t*)(F.ws + WS_PROJ); bf16_t* MIX = (bf16_t*)(F.ws + WS_MIX);
    const int tid = F.tid, lane = F.lane, w = F.wave, q16 = lane & 15, g = lane >> 4;
    u32x4 pre[13];
#define NA_VPRE 13
#define NA_RB(m_) ({ int rb_ = 2 * (m_) - 4; rb_ = rb_ < 0 ? 0 : (rb_ > 24 ? 24 : rb_); __builtin_amdgcn_readfirstlane(rb_); })
#define NA_NL(rb_) ({ int nk_ = 32 - (rb_); nk_ = nk_ > 9 ? 9 : nk_; __builtin_amdgcn_readfirstlane(nk_ * 64 * 8); })
#define NA_LOAD(OFFS, b_, h_, rb_, nl_, K0, K1) do { int stid_ = tid; asm volatile("" : "+v"(stid_)); \
        _Pragma("unroll") for (int k_ = K0; k_ < K1; ++k_) { const int i_ = stid_ + k_ * NT, key_ = i_ >> 3, ch_ = i_ & 7; const bool ok_ = !(key_ < 576 && i_ >= (nl_)); \
            const int grow_ = key_ < 576 ? (b_) * SEQ + (rb_) * 64 + key_ : NLAT + (b_) * CTX + (key_ - 576); \
            pre[k_] = ok_ ? *(const u32x4*)(PROJ + (size_t)grow_ * NPROJ + (OFFS) + (h_) * 64 + ch_ * 8) : (u32x4){0u, 0u, 0u, 0u}; } } while (0)
#define NA_WRITE(nl_, K0, K1) do { int stid_ = tid; asm volatile("" : "+v"(stid_)); \
        _Pragma("unroll") for (int k_ = K0; k_ < K1; ++k_) { const int i_ = stid_ + k_ * NT, key_ = i_ >> 3, ch_ = i_ & 7; const bool ok_ = !(key_ < 576 && i_ >= (nl_)); \
            if (ok_) *(LAS u32x4*)(KV + key_ * NA_KS + ch_ * 16) = pre[k_]; } } while (0)
    int u = __builtin_amdgcn_readfirstlane(F.bid);
    if (u < 2048) { const int b = u >> 7, h = (u >> 4) & 7, m = u & 15, rb = NA_RB(m); NA_LOAD(OFF_K, b, h, rb, NA_NL(rb), 0, 13); }
    for (; u < 2048; u += F.G) {
        const int b = u >> 7, h = (u >> 4) & 7, m = u & 15, rbase = NA_RB(m), nloc8 = NA_NL(rbase);
        __syncthreads();
        NA_WRITE(nloc8, 0, 13);
        if (tid < 465) rp[tid] = F.in[I_RPB][(size_t)(layer * 8 + h) * 465 + tid] * LOG2E;
        NA_LOAD(OFF_V, b, h, rbase, nloc8, 0, NA_VPRE);
        __syncthreads();
        const int i = 2 * m + (w >> 2), j0 = (w & 3) * 16, qrow = b * SEQ + i * 64 + j0; int hs = j0 - 8; hs = hs < 0 ? 0 : (hs > 32 ? 32 : hs);
        int r0 = i - 4; r0 = r0 < 0 ? 0 : (r0 > 24 ? 24 : r0); const int kr0 = r0 - rbase;
        bf16x8 qf[2];
#pragma unroll
        for (int ks = 0; ks < 2; ++ks) qf[ks] = *(const bf16x8*)(PROJ + (size_t)(qrow + q16) * NPROJ + h * 64 + ks * 32 + g * 8);
        f32x4 S[32];
        const LAS unsigned char* kb = KV + q16 * NA_KS + g * 16;
        { const int j = j0 + q16; int cs = j - 8; cs = cs < 0 ? 0 : (cs > 48 ? 48 : cs);
          const int rb0 = (kr0 + rbase) - i + 7;
#pragma unroll
          for (int tl = 0; tl < 16; ++tl) { const int kr = tl >> 1, half = tl & 1; const int kidx0 = (kr0 + kr) * 64 + hs + 16 * half;
              f32x4 a = {0.f, 0.f, 0.f, 0.f};
#pragma unroll
              for (int ks = 0; ks < 2; ++ks) { const bf16x8 kf = *(const LAS bf16x8*)(kb + kidx0 * NA_KS + ks * 64); a = __builtin_amdgcn_mfma_f32_16x16x32_bf16(kf, qf[ks], a, 0, 0, 0); }
#pragma unroll
              for (int r = 0; r < 4; ++r) { const int kc = hs + 16 * half + 4 * g + r; const bool inw = (kc >= cs) && (kc < cs + 16);
                  int cbi = kc - j + 15; cbi = cbi < 0 ? 0 : (cbi > 30 ? 30 : cbi);
                  a[r] = inw ? a[r] * (0.125f * LOG2E) + rp[(rb0 + kr) * 31 + cbi] : -INFINITY; }
              S[tl] = a; if ((tl & 1) == 1) __builtin_amdgcn_sched_barrier(0); } }
#pragma unroll
        for (int tc = 0; tc < 16; ++tc) { const int kidx0 = 576 + 16 * tc; f32x4 a = {0.f, 0.f, 0.f, 0.f};
#pragma unroll
            for (int ks = 0; ks < 2; ++ks) { const bf16x8 kf = *(const LAS bf16x8*)(kb + kidx0 * NA_KS + ks * 64); a = __builtin_amdgcn_mfma_f32_16x16x32_bf16(kf, qf[ks], a, 0, 0, 0); }
            S[16 + tc] = a * (0.125f * LOG2E); if ((tc & 1) == 1) __builtin_amdgcn_sched_barrier(0); }
        float mx = -INFINITY;
#pragma unroll
        for (int t = 0; t < 32; ++t) mx = fmaxf(fmaxf(fmaxf(S[t][0], S[t][1]), fmaxf(S[t][2], S[t][3])), mx);
        mx = fmaxf(mx, __shfl_xor(mx, 16)); mx = fmaxf(mx, __shfl_xor(mx, 32));
        float sum = 0.f; u32x4 P[16];
#pragma unroll
        for (int kk = 0; kk < 16; ++kk) { float e[8];
#pragma unroll
            for (int r = 0; r < 4; ++r) { e[r] = __builtin_amdgcn_exp2f(S[2 * kk][r] - mx); e[4 + r] = __builtin_amdgcn_exp2f(S[2 * kk + 1][r] - mx); }
            sum += ((e[0] + e[1]) + (e[2] + e[3])) + ((e[4] + e[5]) + (e[6] + e[7]));
            P[kk].x = pg8::cvt_pk_bf16_pin(e[0], e[1]); P[kk].y = pg8::cvt_pk_bf16_pin(e[2], e[3]); P[kk].z = pg8::cvt_pk_bf16_pin(e[4], e[5]); P[kk].w = pg8::cvt_pk_bf16_pin(e[6], e[7]); }
        sum += __shfl_xor(sum, 16); sum += __shfl_xor(sum, 32);
        const float inv = 1.0f / sum;
        __syncthreads();
        NA_WRITE(nloc8, 0, NA_VPRE); NA_LOAD(OFF_V, b, h, rbase, nloc8, NA_VPRE, 13); NA_WRITE(nloc8, NA_VPRE, 13);
        { const int un = u + F.G; if (un < 2048) { const int bn = un >> 7, hn = (un >> 4) & 7, mn = un & 15, rbn = NA_RB(mn); NA_LOAD(OFF_K, bn, hn, rbn, NA_NL(rbn), 0, 13); } }
        __syncthreads();
        f32x4 o[4];
#pragma unroll
        for (int dt = 0; dt < 4; ++dt) o[dt] = (f32x4){0.f, 0.f, 0.f, 0.f};
        const LAS unsigned char* vb = KV + (4 * g + (q16 >> 2)) * NA_KS + (q16 & 3) * 8;
#pragma unroll
        for (int kk = 0; kk < 16; ++kk) {
            const int kidx0 = (kk < 8) ? (kr0 + kk) * 64 + hs : 576 + 32 * (kk - 8);
            const bf16x8 pa = __builtin_bit_cast(bf16x8, P[kk]);
#pragma unroll
            for (int dt = 0; dt < 4; ++dt) { const s16x4 lo = lds_tr16(vb + kidx0 * NA_KS + dt * 32), hi = lds_tr16(vb + (kidx0 + 16) * NA_KS + dt * 32);
                const bf16x8 vf = {lo[0], lo[1], lo[2], lo[3], hi[0], hi[1], hi[2], hi[3]};
                o[dt] = __builtin_amdgcn_mfma_f32_16x16x32_bf16(pa, vf, o[dt], 0, 0, 0); }
            if ((kk & 1) == 1) __builtin_amdgcn_sched_barrier(0);
        }
#pragma unroll
        for (int r = 0; r < 4; ++r) { const float ir = __shfl(inv, 4 * g + r);
            bf16_t* op = MIX + (size_t)(qrow + 4 * g + r) * D + h * 64 + q16;
#pragma unroll
            for (int dt = 0; dt < 4; dt += 2) { const unsigned pw = pk2(o[dt][r] * ir, o[dt + 1][r] * ir); op[dt * 16] = (bf16_t)(pw & 0xffffu); op[dt * 16 + 16] = (bf16_t)(pw >> 16); } }
    }
#undef NA_RB
#undef NA_NL
#undef NA_LOAD
#undef NA_WRITE
}
__device__ __forceinline__ void p_mixa(const Frame& F, int layer, bool last) {
    { PrepassW W; ssd_prepass_weights(F, layer, W);
      for (int u = F.bid; u < NTOK / 16; u += F.G) ssd_prepass_unit(F, u, W); }
    na_run(F, layer);
    if (!last) for (int u = F.bid; u < 256; u += F.G) na_unit(F, layer, u >> 4, (u >> 1) & 7, 1, u & 1);
}
__device__ __forceinline__ void p_mixb(const Frame& F, int layer) {
    for (int u0 = F.bid; u0 < 256 * REP_SSD; u0 += F.G) { const int u = u0 & 255; ssd_mfma_unit(F, layer, u >> 4, (u >> 1) & 7, u & 1); }
}

__device__ __forceinline__ void p_ssdcomb(const Frame& F, int layer, bool last) {
    const bf16_t* PROJ = (const bf16_t*)(F.ws + WS_PROJ); bf16_t* MIX = (bf16_t*)(F.ws + WS_MIX);
    const bf16_t* YF = (const bf16_t*)(F.ws + WS_YF); const bf16_t* YB = (const bf16_t*)(F.ws + WS_YB);
    const float* nw = F.in[I_NORMW] + layer * 512 + F.lane * 8;
    const f32x4 nw0 = *(const f32x4*)nw, nw1 = *(const f32x4*)(nw + 4);
    const int nrows = last ? NLAT : NTOK;
    u32x4 pyf = {0u, 0u, 0u, 0u}, pyb = pyf, pz = pyf;
#define SC_LOAD(r_) do { const size_t o_ = (size_t)(r_) * 512 + F.lane * 8; pyf = *(const u32x4*)(YF + o_); pyb = *(const u32x4*)(YB + o_); \
        pz = *(const u32x4*)(PROJ + (size_t)(r_) * NPROJ + OFF_Z + F.lane * 8); } while (0)
    if (F.gw < nrows) SC_LOAD(F.gw);
    for (int row = F.gw; row < nrows; row += F.NGW) {
        const f32x4 a0 = {bflo(pyf.x) + bflo(pyb.x), bfhi(pyf.x) + bfhi(pyb.x), bflo(pyf.y) + bflo(pyb.y), bfhi(pyf.y) + bfhi(pyb.y)}, a1 = {bflo(pyf.z) + bflo(pyb.z), bfhi(pyf.z) + bfhi(pyb.z), bflo(pyf.w) + bflo(pyb.w), bfhi(pyf.w) + bfhi(pyb.w)}; const u32x4 zv = pz;
        if (row + F.NGW < nrows) SC_LOAD(row + F.NGW);
        float y[8] = {a0[0] * silu_f(bflo(zv.x)), a0[1] * silu_f(bfhi(zv.x)), a0[2] * silu_f(bflo(zv.y)), a0[3] * silu_f(bfhi(zv.y)),
                      a1[0] * silu_f(bflo(zv.z)), a1[1] * silu_f(bfhi(zv.z)), a1[2] * silu_f(bflo(zv.w)), a1[3] * silu_f(bfhi(zv.w))};
        float ss = 0.f;
#pragma unroll
        for (int k = 0; k < 8; ++k) ss += y[k] * y[k];
#pragma unroll
        for (int of = 1; of < 32; of <<= 1) ss += __shfl_xor(ss, of);
        const float rs = 1.0f / sqrtf(ss * (1.0f / 256.0f) + RMS_EPS);
        u32x4 w; w.x = pk2(y[0] * rs * nw0[0], y[1] * rs * nw0[1]); w.y = pk2(y[2] * rs * nw0[2], y[3] * rs * nw0[3]);
        w.z = pk2(y[4] * rs * nw1[0], y[5] * rs * nw1[1]); w.w = pk2(y[6] * rs * nw1[2], y[7] * rs * nw1[3]);
        *(u32x4*)(MIX + (size_t)row * D + 512 + F.lane * 8) = w;
    }
}

__device__ __forceinline__ void p_outproj(const Frame& F, int layer, bool last) {
    pg8::Gemm g{(const bf16_t*)(F.ws + WS_MIX), (const bf16_t*)(F.ws + WS_WOUT) + (size_t)layer * D * D, D};
    pg8::DenseOrder S; S.init(last ? NLAT : NTOK, D, D, F.G, F.bid);
    pg8::EpiGate E{(bf16_t*)(F.ws + WS_DELTA1), (const float*)(F.ws + WS_MOD) + (size_t)layer * 17 * MODW, 2 * D};
    pg8::gemm_phase<pg8::EpiGate, pg8::DenseOrder, true, true>(F.lds, g, S, E, F.tid);
    if (layer == 0) deferred_conv(F, (NTOK / 256) * (D / 256), DW_L0_OUT, DW_Q); else if (layer == 1) deferred_conv(F, (NTOK / 256) * (D / 256), DW_L1_OUT, DW_Q);
}

__device__ __forceinline__ unsigned* cnt_word(const Frame& F, int slot, int hf, int e) { return (unsigned*)(F.ws + WS_CTL) + CW_CNT + ((slot * 2 + hf) * 8 + e) * 64; }
__device__ __forceinline__ void p_ln1(const Frame& F, int layer, bool last) {
    bf16_t* X = (bf16_t*)(F.ws + WS_X); bf16_t* H = (bf16_t*)(F.ws + WS_H);
    const float* MOD = (const float*)(F.ws + WS_MOD) + (size_t)layer * 17 * MODW;
    const float* lg = F.in[I_LNG] + (size_t)(layer * 2) * D; const float* lb = F.in[I_LNB] + (size_t)(layer * 2) * D;
    const bool moe = layer & 1; const int slot = layer >> 1;
    const int nrows = last ? NLAT : NTOK;
    float rw[16][8];
    if (moe) { const float* R = F.in[I_RW] + (size_t)slot * D * 8;
#pragma unroll
        for (int j = 0; j < 4; ++j)
#pragma unroll
            for (int k = 0; k < 4; ++k) { const int lane = F.lane; const f32x4 a = *(const f32x4*)(R + (size_t)(RIDX(j) + k) * 8), b2 = *(const f32x4*)(R + (size_t)(RIDX(j) + k) * 8 + 4);
                rw[j * 4 + k][0] = a[0]; rw[j * 4 + k][1] = a[1]; rw[j * 4 + k][2] = a[2]; rw[j * 4 + k][3] = a[3]; rw[j * 4 + k][4] = b2[0]; rw[j * 4 + k][5] = b2[1]; rw[j * 4 + k][6] = b2[2]; rw[j * 4 + k][7] = b2[3]; } }
    int nrec = 0;
    if (moe) { __syncthreads(); if (F.tid < 32) ((LAS unsigned*)F.lds)[F.tid] = 0u; __syncthreads(); }
    const bf16_t* DL = (const bf16_t*)(F.ws + WS_DELTA1);
    RowRaw r0 = {}, r1 = {};
    if (F.gw < nrows) row_issue<true>(X, DL, F.gw, F.lane, r0);
    if (F.gw + F.NGW < nrows) row_issue<true>(X, DL, F.gw + F.NGW, F.lane, r1);
    for (int row = F.gw; row < nrows; row += F.NGW) {
        f32x4 v[4], hv[4];
        row_combine(r0, v); r0 = r1;
        if (row + 2 * F.NGW < nrows) row_issue<true>(X, DL, row + 2 * F.NGW, F.lane, r1);
        row_ln(v, lg, lb, F.lane);
        row_store_h(X + (size_t)row * D, F.lane, v);
        const float* m = MOD + (size_t)mod_row_of(row) * MODW;
        if (USE_FP8 && (moe || FP8_DENSE1)) row_mod_store8((unsigned char*)H + (size_t)row * D, F.lane, v, m + 3 * D, m + 4 * D, hv);
        else row_mod_store(H + (size_t)row * D, F.lane, v, m + 3 * D, m + 4 * D, hv);
        if (moe) {
            float lg8[8];
#pragma unroll
            for (int e = 0; e < 8; ++e) { float s = 0.f;
#pragma unroll
                for (int j = 0; j < 4; ++j)
#pragma unroll
                    for (int k = 0; k < 4; ++k) s += hv[j][k] * rw[j * 4 + k][e];
                lg8[e] = wave_sum(s); }
            int e0 = 0; float v0 = lg8[0];
#pragma unroll
            for (int e = 1; e < 8; ++e) if (lg8[e] > v0) { v0 = lg8[e]; e0 = e; }
            int e1 = -1; float v1 = -INFINITY;
#pragma unroll
            for (int e = 0; e < 8; ++e) if (e != e0 && lg8[e] > v1) { v1 = lg8[e]; e1 = e; }
            if (F.lane == 0) {
                const unsigned s0 = __hip_atomic_fetch_add((LAS unsigned*)F.lds + e0, 1u, __ATOMIC_RELAXED, __HIP_MEMORY_SCOPE_WORKGROUP), s1 = __hip_atomic_fetch_add((LAS unsigned*)F.lds + e1, 1u, __ATOMIC_RELAXED, __HIP_MEMORY_SCOPE_WORKGROUP);
                const float ex = __expf(v1 - v0), g0 = 1.0f / (1.0f + ex);
                ((LAS u32x4*)(F.lds + 256))[F.wave * 32 + nrec] = (u32x4){(unsigned)e0 | ((unsigned)e1 << 8), s0, s1, (unsigned)row};
                *(f32x2*)(F.ws + WS_GATES + (size_t)row * 8) = (f32x2){g0, ex * g0};
            }
            ++nrec;
        }
    }
    if (moe) {
        __syncthreads();
        if (F.tid < 8) ((LAS unsigned*)F.lds)[16 + F.tid] = atomicAdd(cnt_word(F, slot, 0, F.tid), ((LAS unsigned*)F.lds)[F.tid]);
        __syncthreads();
        int* list = (int*)(F.ws + WS_LIST);
        if (F.lane < nrec) { const u32x4 rc = ((LAS u32x4*)(F.lds + 256))[F.wave * 32 + F.lane]; const int e0 = rc.x & 255, e1 = (rc.x >> 8) & 255; const int row = (int)rc.w;
            const unsigned s0 = ((LAS unsigned*)F.lds)[16 + e0] + rc.y, s1 = ((LAS unsigned*)F.lds)[16 + e1] + rc.z;
            list[e0 * NTOK + s0] = row; list[e1 * NTOK + s1] = row;
            *(u32x4*)(F.ws + WS_ROUTE + (size_t)row * 16) = (u32x4){rc.x, s0, s1, 0u}; }
    }
}

__device__ __forceinline__ void p_ffn1_dense(const Frame& F, int layer, bool last) {
    const int s = layer >> 1;
#if USE_FP8 && FP8_DENSE2
    typedef pg8::EpiSwiGLU8 EpiH; EpiH E{F.ws + WS_HID, DFF};
#else
    typedef pg8::EpiSwiGLU EpiH; EpiH E{(bf16_t*)(F.ws + WS_HID), DFF};
#endif
#if USE_FP8 && FP8_DENSE1
    pg8::Gemm g{(const bf16_t*)(F.ws + WS_H), (const bf16_t*)(F.ws + WS_WFGU + (size_t)s * 2 * DFF * D), D / 2};
    pg8::DenseOrder S; S.init(last ? NLAT : NTOK, 2 * DFF, D / 2, F.G, F.bid, REP_GEMM);
    pg8::gemm_phase<EpiH, pg8::DenseOrder, true, FP8_SP2, true>(F.lds, g, S, E, F.tid, (127 - S8_WGU) * 0x01010101, (127 - S8_ACT) * 0x01010101);
#else
    pg8::Gemm g{(const bf16_t*)(F.ws + WS_H), (const bf16_t*)(F.ws + WS_WFGU) + (size_t)s * 2 * DFF * D, D};
    pg8::DenseOrder S; S.init(last ? NLAT : NTOK, 2 * DFF, D, F.G, F.bid, REP_GEMM);
    pg8::gemm_phase<EpiH, pg8::DenseOrder, true, true>(F.lds, g, S, E, F.tid);
#endif
    if (layer == 0) deferred_conv(F, (NTOK / 256) * (2 * DFF / 256), DW_L0_F1, DW_Q);
}
__device__ __forceinline__ void p_ffn2_dense(const Frame& F, int layer, bool last) {
    const int s = layer >> 1;
    pg8::EpiGate E{(bf16_t*)(F.ws + WS_DELTA2), (const float*)(F.ws + WS_MOD) + (size_t)layer * 17 * MODW, 5 * D};
#if USE_FP8 && FP8_DENSE2
    pg8::Gemm g{(const bf16_t*)(F.ws + WS_HID), (const bf16_t*)(F.ws + WS_WFD + (size_t)s * D * DFF), DFF / 2};
    pg8::DenseOrder S; S.init(last ? NLAT : NTOK, D, DFF / 2, F.G, F.bid);
    pg8::gemm_phase<pg8::EpiGate, pg8::DenseOrder, true, FP8_SP2, true>(F.lds, g, S, E, F.tid, (127 - S8_WD) * 0x01010101, (127 - S8_HID) * 0x01010101);
#else
    pg8::Gemm g{(const bf16_t*)(F.ws + WS_HID), (const bf16_t*)(F.ws + WS_WFD) + (size_t)s * D * DFF, DFF};
    pg8::DenseOrder S; S.init(last ? NLAT : NTOK, D, DFF, F.G, F.bid);
    pg8::gemm_phase<pg8::EpiGate, pg8::DenseOrder, true, true>(F.lds, g, S, E, F.tid);
#endif
    if (layer == 0) deferred_conv(F, (NTOK / 256) * (D / 256), DW_L0_F2, DW_Q2);
}
__device__ __forceinline__ void moe_prefix(const Frame& F, int slot, int hf, int (&ts)[9], int (&cn)[8]) {
    int a = 0;
#pragma unroll
    for (int e = 0; e < 8; ++e) { cn[e] = (int)*cnt_word(F, slot, hf, e); ts[e] = a; a += (cn[e] + 255) >> 8; }
    ts[8] = a;
}
__device__ __forceinline__ void p_ffn1_moe(const Frame& F, int layer) {
    const int slot = layer >> 1; int cn[8];
    pg8::MoeOrder<true> S; moe_prefix(F, slot, 0, S.ts, cn);
    S.nM = S.ts[8]; S.nN = 2 * DFFE / 256; S.G = F.G; S.c = F.bid; S.K = D / 2; S.estride = (long)2 * DFFE * D; S.rowoff = (const LAS unsigned short*)(F.lds + LDS_ROWOFF); S.rowbytes = D;
    {
        const int* list = (const int*)(F.ws + WS_LIST); LAS unsigned short* ro = (LAS unsigned short*)(F.lds + LDS_ROWOFF); pg8::Unit u;
        for (int i = F.wave; i < 36 && S.next(i, u); i += NWAVES) { const int e = S.expert_of(u.pm); int tse = 0, cne = 0;
#pragma unroll
            for (int j = 0; j < 8; ++j) { tse = (j == e) ? S.ts[j] : tse; cne = (j == e) ? cn[j] : cne; }
            int tk[4];
#pragma unroll
            for (int q = 0; q < 4; ++q) { const int sl = (u.pm - tse) * 256 + F.lane + 64 * q; tk[q] = sl < cne ? list[e * NTOK + sl] : 0; }
#pragma unroll
            for (int q = 0; q < 4; ++q) ro[i * 256 + F.lane + 64 * q] = (unsigned short)tk[q]; }
        __syncthreads();
    }
    pg8::Gemm g{(const bf16_t*)(F.ws + WS_H), (const bf16_t*)(F.ws + WS_WMGU + (size_t)slot * NEXP * 2 * DFFE * D), D / 2};
    pg8::EpiSwiGLU8 E{F.ws + WS_HID, DFFE};
    pg8::gemm_phase<pg8::EpiSwiGLU8, pg8::MoeOrder<true>, true, FP8_SP2, true>(F.lds, g, S, E, F.tid, (127 - S8_WGU) * 0x01010101, (127 - S8_ACT) * 0x01010101);
}
__device__ __forceinline__ void p_ffn2_moe(const Frame& F, int layer) {
    const int slot = layer >> 1; int cn[8];
    pg8::MoeOrder<false> S; moe_prefix(F, slot, 0, S.ts, cn);
    S.nM = S.ts[8]; S.nN = D / 256; S.G = F.G; S.c = F.bid; S.K = DFFE / 2; S.estride = (long)D * DFFE; S.rowoff = nullptr; S.rowbytes = 0;
    pg8::EpiBf16 E{(bf16_t*)(F.ws + WS_YP), D};
    pg8::Gemm g{(const bf16_t*)(F.ws + WS_HID), (const bf16_t*)(F.ws + WS_WMD + (size_t)slot * NEXP * D * DFFE), DFFE / 2};
    pg8::gemm_phase<pg8::EpiBf16, pg8::MoeOrder<false>, true, FP8_SP2, true>(F.lds, g, S, E, F.tid, (127 - S8_WD) * 0x01010101, (127 - S8_HID) * 0x01010101);
}

template <bool MOE> __device__ __forceinline__ void ln2_body(const Frame& F, int layer, bool last) {
    bf16_t* X = (bf16_t*)(F.ws + WS_X); bf16_t* H = (bf16_t*)(F.ws + WS_H);
    const float* MOD = (const float*)(F.ws + WS_MOD) + (size_t)layer * 17 * MODW;
    const float* lg = F.in[I_LNG] + (size_t)(layer * 2 + 1) * D; const float* lb = F.in[I_LNB] + (size_t)(layer * 2 + 1) * D;
    const int slot = layer >> 1;
    const int nrows = last ? NLAT : NTOK;
    int ts0[9], cn[8];
    if (MOE) moe_prefix(F, slot, 0, ts0, cn);
    const bf16_t* YP = (const bf16_t*)(F.ws + WS_YP); const bf16_t* DL = (const bf16_t*)(F.ws + WS_DELTA2);
    RowRaw r0 = {}, r1 = {}; u32x4 rt0 = {0u, 0u, 0u, 0u}, rt1 = {0u, 0u, 0u, 0u}; f32x2 g0 = {0.f, 0.f}, g1 = {0.f, 0.f}; u32x4 ya[2] = {}, yb[2] = {};
#define LN2_ISSUE(row_, r_, rt_, g_) do { row_issue<!MOE>(X, DL, (row_), F.lane, r_); \
        if (MOE) { rt_ = *(const u32x4*)(F.ws + WS_ROUTE + (size_t)(row_) * 16); g_ = *(const f32x2*)(F.ws + WS_GATES + (size_t)(row_) * 8); } } while (0)
#define LN2_ISSUE_Y(rt_) do { const int e0_ = (rt_).x & 255, e1_ = ((rt_).x >> 8) & 255; int t0_ = 0, t1_ = 0; \
        _Pragma("unroll") for (int e = 0; e < 8; ++e) { const int tv = ts0[e]; t0_ = (e == e0_) ? tv : t0_; t1_ = (e == e1_) ? tv : t1_; } \
        const bf16_t* y0_ = YP + ((size_t)t0_ * 256 + (rt_).y) * D; const bf16_t* y1_ = YP + ((size_t)t1_ * 256 + (rt_).z) * D; \
        _Pragma("unroll") for (int j = 0; j < 2; ++j) { ya[j] = *(const u32x4*)(y0_ + 8 * F.lane + 512 * j); yb[j] = *(const u32x4*)(y1_ + 8 * F.lane + 512 * j); } } while (0)
    if (F.gw < nrows) LN2_ISSUE(F.gw, r0, rt0, g0);
    if (F.gw + F.NGW < nrows) LN2_ISSUE(F.gw + F.NGW, r1, rt1, g1);
    if (MOE) { if (F.gw < nrows) LN2_ISSUE_Y(rt0); }
    for (int row = F.gw; row < nrows; row += F.NGW) {
        f32x4 v[4], hv[4];
        if (MOE) {
            const float* g2 = MOD + (size_t)mod_row_of(row) * MODW + 5 * D;
#pragma unroll
            for (int j = 0; j < 2; ++j) { const int lane = F.lane; f32x4 x0, x1, a0, a1, b0, b1; unpack8(r0.x[j], x0, x1); unpack8(ya[j], a0, a1); unpack8(yb[j], b0, b1);
                const f32x4 q0 = *(const f32x4*)(g2 + RIDX(2 * j)) + 1.0f, q1 = *(const f32x4*)(g2 + RIDX(2 * j + 1)) + 1.0f;
                v[2 * j] = x0 * ALPHA + q0 * (a0 * g0[0] + b0 * g0[1]); v[2 * j + 1] = x1 * ALPHA + q1 * (a1 * g0[0] + b1 * g0[1]); }
        } else row_combine(r0, v);
        r0 = r1; rt0 = rt1; g0 = g1;
        if (MOE) { if (row + F.NGW < nrows) LN2_ISSUE_Y(rt0); }
        if (row + 2 * F.NGW < nrows) LN2_ISSUE(row + 2 * F.NGW, r1, rt1, g1);
        row_ln(v, lg, lb, F.lane);
        if (last) row_store(F.out + (size_t)row * D, F.lane, v);
        else { row_store_h(X + (size_t)row * D, F.lane, v);
            const float* m = MOD + (size_t)17 * MODW + (size_t)mod_row_of(row) * MODW;
            row_mod_store(H + (size_t)row * D, F.lane, v, m, m + D, hv);
            }
    }
#undef LN2_ISSUE
#undef LN2_ISSUE_Y
}
__device__ __forceinline__ void p_ln2(const Frame& F, int layer, bool last) { if (layer & 1) ln2_body<true>(F, layer, last); else ln2_body<false>(F, layer, last); }

constexpr int NPL = 9;
constexpr int NPH = 2 + NPL * DEPTH;
#ifndef SITE_MASK
#define SITE_MASK 0xFFFFF
#endif
#ifndef TPROBE
#define TPROBE (-1)
#endif
#ifndef TPROBE_MULT
#define TPROBE_MULT 4
#endif
#define SITE(n) (((SITE_MASK) >> (n)) & 1)
__global__ void __launch_bounds__(NT, 2) fwd_kernel(Args args) {
    extern __shared__ __attribute__((aligned(16))) unsigned char lds_raw[];
    Frame F;
    F.lds = (LAS unsigned char*)lds_raw; F.in = args.in; F.out = args.out; F.ws = args.ws;
    F.tid = threadIdx.x; F.lane = F.tid & 63; F.wave = __builtin_amdgcn_readfirstlane(F.tid >> 6); F.bid = blockIdx.x; F.G = gridDim.x;
    F.gw = F.bid * NWAVES + F.wave; F.NGW = F.G * NWAVES;
    volatile LAS unsigned* MISC = (volatile LAS unsigned*)(F.lds + LDS_MISC);
    if (F.tid < 64) MISC[F.tid] = 0u;
    __syncthreads();
    XcdBarrier bar; bar.bar = (unsigned*)(F.ws + WS_CTL) + CW_BAR; bar.x = 0; bar.st = MISC + 8;
#if MK_SINGLE
    bar = xcd_barrier_post((unsigned*)(F.ws + WS_CTL) + CW_BAR, MISC + 8);
#endif
    const int lo = args.ph_lo, hi = args.ph_hi;
#define IN(k) (lo <= (k) && (k) < hi)
#if TPROBE >= 0
    unsigned long long tp_prev = __builtin_amdgcn_s_memrealtime(), tp_acc = 0ull;
#define TP(type) do { const unsigned long long t_ = __builtin_amdgcn_s_memrealtime(); if ((type) == TPROBE) tp_acc += t_ - tp_prev; tp_prev = t_; } while (0)
#else
#define TP(type) do { } while (0)
#endif
#if MK_SINGLE
#define SEAM(k) do { if (IN(k) && IN((k) + 1)) { XcdBarrier b2_ = bar; int z_; asm volatile("s_mov_b32 %0, 0" : "=s"(z_)); b2_.bar = bar.bar + z_; int ln_; asm volatile("v_mbcnt_lo_u32_b32 %0, -1, 0\n\tv_mbcnt_hi_u32_b32 %0, -1, %0" : "=v"(ln_)); xcd_barrier(b2_, F.wave == 0 && ln_ == 0); } } while (0)
#else
#define SEAM(k) do { } while (0)
#endif
    if constexpr (SITE(0)) if (IN(0)) p_pro_a(fresh(F));
    SEAM(0); TP(0);
    if constexpr (SITE(1)) if (IN(1)) p_pro_b(fresh(F));
    SEAM(1); TP(1);
    for (int layer = 0; layer < DEPTH; ++layer) {
        const int pb = 2 + NPL * layer; const bool last = layer == DEPTH - 1; const bool moe = layer & 1;
        if constexpr (SITE(2)) if (IN(pb + 0)) p_inproj(fresh(F), layer);
        SEAM(pb + 0); TP(2);
        if constexpr (SITE(3)) if (IN(pb + 1)) p_mixa(fresh(F), layer, last);
        SEAM(pb + 1); TP(3);
        if constexpr (SITE(12)) if (IN(pb + 2)) p_mixb(fresh(F), layer);
        SEAM(pb + 2); TP(4);
        if constexpr (SITE(4)) if (IN(pb + 3)) { p_ssdcomb(fresh(F), layer, last); if (!USE_FP8 && layer == 2) { int rot = 0; conv_moe(fresh(F), 1, rot); } }
        SEAM(pb + 3); TP(5);
        if constexpr (SITE(5)) if (IN(pb + 4)) p_outproj(fresh(F), layer, last);
        SEAM(pb + 4); TP(6);
        if constexpr (SITE(6)) if (IN(pb + 5)) p_ln1(fresh(F), layer, last);
        SEAM(pb + 5); TP(7);
        if (moe) {
            if constexpr (SITE(7)) if (IN(pb + 6)) p_ffn1_moe(fresh(F), layer);
            SEAM(pb + 6); TP(8);
            if constexpr (SITE(8)) if (IN(pb + 7)) p_ffn2_moe(fresh(F), layer);
            SEAM(pb + 7); TP(9);
        } else {
            if constexpr (SITE(9)) if (IN(pb + 6)) p_ffn1_dense(fresh(F), layer, last);
            SEAM(pb + 6); TP(10);
            if constexpr (SITE(10)) if (IN(pb + 7)) p_ffn2_dense(fresh(F), layer, last);
            SEAM(pb + 7); TP(11);
        }
        if constexpr (SITE(11)) if (IN(pb + 8)) p_ln2(fresh(F), layer, last);
        if (!last) SEAM(pb + 8);
        TP(12);
    }
#if TPROBE >= 0
    { const unsigned long long t_end = __builtin_amdgcn_s_memrealtime(); while (__builtin_amdgcn_s_memrealtime() - t_end < (unsigned long long)TPROBE_MULT * tp_acc) __builtin_amdgcn_s_sleep(8); }
#endif
#undef IN
#undef SEAM
}

extern "C" void kernel_launch(void* const* d_in, const int* in_sizes, int n_in, void* d_out, int out_size, void* d_ws, size_t ws_size, hipStream_t stream) {
    static int grid = 0;
    if (grid == 0) {
        if (n_in != 24 || out_size != NLAT * D || ws_size < WS_END) { fprintf(stderr, "kernel_launch: unexpected shapes (n_in %d, out %d, ws %zu < %zu)\n", n_in, out_size, ws_size, (size_t)WS_END); grid = -1; return; }
        int dev = 0, cus = 0, per_cu = 0;
        if (hipGetDevice(&dev) != hipSuccess || hipDeviceGetAttribute(&cus, hipDeviceAttributeMultiprocessorCount, dev) != hipSuccess) { grid = -1; return; }
        if (hipFuncSetAttribute((const void*)fwd_kernel, hipFuncAttributeMaxDynamicSharedMemorySize, LDS_BYTES) != hipSuccess) { fprintf(stderr, "kernel_launch: hipFuncSetAttribute failed\n"); grid = -1; return; }
        if (hipOccupancyMaxActiveBlocksPerMultiprocessor(&per_cu, (const void*)fwd_kernel, NT, LDS_BYTES) != hipSuccess || per_cu < 1) { fprintf(stderr, "kernel_launch: occupancy query says %d\n", per_cu); }
        (void)hipGetLastError();
        grid = cus;
    }
    if (grid < 0) return;
    (void)in_sizes;
    if (hipMemsetAsync((char*)d_ws + WS_CTL, 0, CTL_BYTES, stream) != hipSuccess) return;
    Args a{};
    for (int i = 0; i < 24; ++i) a.in[i] = (const float*)d_in[i];
    a.out = (float*)d_out; a.ws = (unsigned char*)d_ws;
#if MK_SINGLE
    a.ph_lo = 0; a.ph_hi = NPH;
    hipLaunchKernelGGL(fwd_kernel, dim3(grid), dim3(NT), LDS_BYTES, stream, a);
#else
    for (int ph = 0; ph < NPH; ++ph) {

        a.ph_lo = ph; a.ph_hi = ph + 1;
        hipLaunchKernelGGL(fwd_kernel, dim3(grid), dim3(NT), LDS_BYTES, stream, a);
    }
#endif
}
```

```cpp
#include <hip/hip_runtime.h>
#include <cstdio>
#include <cstdint>

#ifndef MK_SINGLE
#define MK_SINGLE 1
#endif

#ifndef FP8_INPROJ
#define FP8_INPROJ 0
#endif
#ifndef FP8_DENSE1
#define FP8_DENSE1 0
#endif
#ifndef FP8_DENSE2
#define FP8_DENSE2 1
#endif
#ifndef USE_FP8
#define USE_FP8 1
#endif
#ifndef FP8_SP2
#define FP8_SP2 true
#endif
#ifndef REP_SSD
#define REP_SSD 1
#endif
#ifndef REP_NA
#define REP_NA 1
#endif
#ifndef REP_GEMM
#define REP_GEMM 1
#endif
#define GAS __attribute__((address_space(1)))
#define LAS __attribute__((address_space(3)))
typedef unsigned short bf16_t;
typedef short bf16x8 __attribute__((ext_vector_type(8)));
typedef float f32x4 __attribute__((ext_vector_type(4)));
typedef float f32x2 __attribute__((ext_vector_type(2)));
typedef unsigned u32x4 __attribute__((ext_vector_type(4)));
typedef unsigned u32x2 __attribute__((ext_vector_type(2)));
typedef int i32x4 __attribute__((ext_vector_type(4)));
typedef int i32x8 __attribute__((ext_vector_type(8)));

constexpr int D = 1024, BATCH = 16, SEQ = 2048, DEPTH = 4, GRID_W = 64, CTX = 256;
constexpr int NLAT = BATCH * SEQ;
constexpr int NCTX = BATCH * CTX;
constexpr int NTOK = NLAT + NCTX;
constexpr int NPROJ = 3072;
constexpr int OFF_K = 512, OFF_V = 1024, OFF_Z = 1536, OFF_XBC = 2048;
constexpr int D_IN_PROJ = 3088;
constexpr int DFF = 2816, DFFE = 3584, NEXP = 8;
constexpr float ALPHA = 1.6817928305074290f;
constexpr float LN_EPS = 1e-5f, RMS_EPS = 1e-5f;
constexpr int MODW = 6 * D;

constexpr size_t MiB = 1u << 20;
constexpr size_t WS_CTL = 0, CTL_BYTES = 1 * MiB;
constexpr size_t WS_MOD = 1 * MiB;
constexpr size_t WS_ROUTE = 3 * MiB;
constexpr size_t WS_GATES = 4 * MiB;
constexpr size_t WS_LIST = 5 * MiB;
constexpr size_t WS_WDT = 7 * MiB;
constexpr size_t WS_WIN = 8 * MiB;
constexpr size_t WS_WOUT = 32 * MiB;
constexpr size_t WS_WFGU = 40 * MiB;
constexpr size_t WS_WFD = 62 * MiB;
constexpr size_t WS_WMGU = 73 * MiB;
constexpr size_t WS_WMD = 185 * MiB;
constexpr size_t WS_X = 241 * MiB;
constexpr size_t WS_H = 385 * MiB;
constexpr size_t WS_R = 457 * MiB;
constexpr size_t WS_PROJ = WS_R;
constexpr size_t WS_DT = WS_R + 216 * MiB;
constexpr size_t WS_YF = WS_R + 219 * MiB;
constexpr size_t WS_YB = WS_R + 291 * MiB;
constexpr size_t WS_MIX = WS_R + 363 * MiB;
constexpr size_t WS_HID = WS_R;
constexpr size_t WS_YP = WS_R + 270 * MiB;
constexpr size_t WS_DELTA1 = WS_R;
constexpr size_t WS_DELTA2 = WS_R + 270 * MiB;
constexpr size_t WS_U = WS_R + 435 * MiB;
constexpr size_t WS_H8IN = WS_U;
constexpr size_t WS_END = WS_R + 507 * MiB;
constexpr int MOE_PAD = 2 * NTOK + 2048;
static_assert(USE_FP8 == 1, "the single-phase MoE needs the e4m3 hidden (the bf16 one does not fit the workspace)");
static_assert(WS_HID + (size_t)MOE_PAD * 3584 <= WS_YP && WS_YP + (size_t)MOE_PAD * 1024 * 2 <= WS_END, "MoE buffers");

constexpr int CW_TMO = 0;
constexpr int CW_BAR = 4096;
constexpr int CW_CNT = 16384;

constexpr int LDS_STAGE = 131072;
constexpr int LDS_ROWOFF = 131072;
constexpr int LDS_MISC = 131072 + 18432;
constexpr int LDS_BYTES = 155648;

constexpr int S8_ACT = 3, S8_WGU = 8, S8_HID = 2, S8_WD = 9;
#ifndef TPROBE
#define TPROBE (-1)
#endif
#if TPROBE >= 100
#define TPS_BEGIN unsigned long long tps_t_ = __builtin_amdgcn_s_memrealtime()
#define TPS(k) do { const unsigned long long t_ = __builtin_amdgcn_s_memrealtime(); if (TPROBE == 100 + (k) && F.tid == 0) ((volatile LAS unsigned*)(F.lds + LDS_MISC))[40] += (unsigned)(t_ - tps_t_); tps_t_ = t_; } while (0)
#else
#define TPS_BEGIN do { } while (0)
#define TPS(k) do { } while (0)
#endif
__device__ __forceinline__ unsigned f2bf(float f) { unsigned u = __builtin_bit_cast(unsigned, f); return (u + 0x7fffu + ((u >> 16) & 1u)) >> 16; }
typedef __bf16 bf16x2_t __attribute__((ext_vector_type(2)));
__device__ __forceinline__ unsigned pk2(float lo, float hi) { const f32x2 v = {lo, hi}; const bf16x2_t b = __builtin_convertvector(v, bf16x2_t); return __builtin_bit_cast(unsigned, b); }
__device__ __forceinline__ float bf2f(unsigned short b) { return __builtin_bit_cast(float, ((unsigned)b) << 16); }
__device__ __forceinline__ float bflo(unsigned w) { return __builtin_bit_cast(float, w << 16); }
__device__ __forceinline__ float bfhi(unsigned w) { return __builtin_bit_cast(float, w & 0xffff0000u); }
__device__ __forceinline__ float silu_f(float v) { return v / (1.0f + __expf(-v)); }
__device__ __forceinline__ float clamp8(float v) { return fminf(fmaxf(v, -448.0f), 448.0f); }
__device__ __forceinline__ unsigned pk8(float a, float b, float c, float d) {
    int w = 0; w = __builtin_amdgcn_cvt_pk_fp8_f32(clamp8(a), clamp8(b), w, false); w = __builtin_amdgcn_cvt_pk_fp8_f32(clamp8(c), clamp8(d), w, true); return (unsigned)w; }
template <int CTRL, int ROWMASK = 0xF, bool BC = false>
__device__ __forceinline__ float dpp_f(float v) { return __builtin_bit_cast(float, __builtin_amdgcn_update_dpp(0, __builtin_bit_cast(int, v), CTRL, ROWMASK, 0xF, BC)); }
__device__ __forceinline__ float row16_sum(float v) {
    v += dpp_f<0xB1>(v); v += dpp_f<0x4E>(v); v += dpp_f<0x141>(v); v += dpp_f<0x140>(v);
    return v;
}
__device__ __forceinline__ float wave_sum(float v) {
    v = row16_sum(v);
    v += dpp_f<0x142, 0xA>(v); v += dpp_f<0x143, 0xC>(v);
    return __builtin_bit_cast(float, __builtin_amdgcn_readlane(__builtin_bit_cast(int, v), 63));
}
__device__ __forceinline__ float wave_scan(float v) {
    v += dpp_f<0x111, 0xF, true>(v); v += dpp_f<0x112, 0xF, true>(v); v += dpp_f<0x114, 0xF, true>(v); v += dpp_f<0x118, 0xF, true>(v);
    v += dpp_f<0x142, 0xA>(v); v += dpp_f<0x143, 0xC>(v);
    return v;
}

namespace pg8 {
constexpr int BM = 256, BK = 64, HALF = 128, HTB = HALF * BK * 2, STAGE_BYTES = 8 * HTB, NXCD = 8, WGM = 8;
__host__ __device__ __forceinline__ int lds_byte(int r, int c) { const int st = (r >> 4) * 2 + (c >> 5), rr = r & 15, cc = c & 31, ob = rr * 64 + cc * 2; return st * 1024 + (ob ^ (((ob >> 9) & 1) << 5)); }
__host__ __device__ __forceinline__ void stage_rc(int b, int& R, int& C) { const int st = b / 1024, sb = b % 1024, swz = sb ^ (((sb >> 9) & 1) << 5); R = (st >> 1) * 16 + swz / 64; C = (st & 1) * 32 + (swz % 64) / 2; }
__host__ __device__ __forceinline__ int perm32(int rho) { const int n = rho >> 4, i = rho & 15; return 8 * (i >> 2) + 4 * n + (i & 3); }

struct Unit { int pm, pn; long bofs; };
struct Gemm { const bf16_t* A; const bf16_t* Bt; int K; };

__device__ __forceinline__ unsigned cvt_pk_bf16(float lo, float hi) { return pk2(lo, hi); }
__device__ __forceinline__ unsigned cvt_pk_bf16_pin(float lo, float hi) { unsigned r; asm volatile("v_cvt_pk_bf16_f32 %0, %1, %2" : "=v"(r) : "v"(lo), "v"(hi)); return r; }

__device__ __forceinline__ bool static_tile(int i, int G, int c, int nM, int nN, int& pm, int& pn, int rep = 1) {
    const int nwg = nM * nN;
#if REP_GEMM > 1
    { const int cnt = (nwg - c + G - 1) / G; if (cnt <= 0 || i >= rep * cnt) return false; i %= cnt; }
#endif
    const long L = (long)i * G + c; if (L >= nwg) return false;
    int wgid = (int)L; { const int q = nwg / NXCD, r = nwg % NXCD, xcd = wgid % NXCD, off = wgid / NXCD; wgid = (xcd < r ? xcd * (q + 1) : r * (q + 1) + (xcd - r) * q) + off; }
    const int nig = WGM * nN, gid = wgid / nig, fm = gid * WGM, gsz = (nM - fm) < WGM ? (nM - fm) : WGM;
    pm = fm + ((wgid % nig) % gsz); pn = (wgid % nig) / gsz; return true;
}
struct DenseOrder {
    int nM, nN, G, c, K, rep;
    __device__ __forceinline__ void init(int M, int N, int K_, int G_, int c_, int rep_ = 1) { nM = M / BM; nN = N / BM; G = G_; c = c_; K = K_; rep = rep_; }
    __device__ __forceinline__ bool next(int i, Unit& u) const { if (!static_tile(i, G, c, nM, nN, u.pm, u.pn, rep)) return false; u.bofs = (long)u.pn * BM * K * 2; return true; }
    static constexpr bool GATHER = false;
    __device__ __forceinline__ long a_base(const Unit& u) const { return (long)u.pm * BM * K * 2; }
    __device__ __forceinline__ void a_offs(int, const Unit&, int, unsigned (&)[2][2]) const {}
};
template <bool GATHER_> struct MoeOrder {
    int nM, nN, G, c, K; int ts[9]; long estride; const LAS unsigned short* rowoff; unsigned rowbytes;
    __device__ __forceinline__ int expert_of(int pm) const { int e = 0;
#pragma unroll
        for (int j = 1; j < 8; ++j) e += (pm >= ts[j]) ? 1 : 0; return e; }
    __device__ __forceinline__ bool next(int i, Unit& u) const { if (!static_tile(i, G, c, nM, nN, u.pm, u.pn, REP_GEMM)) return false; u.bofs = (long)expert_of(u.pm) * estride + (long)u.pn * BM * K * 2; return true; }
    static constexpr bool GATHER = GATHER_;
    __device__ __forceinline__ long a_base(const Unit& u) const { return GATHER_ ? 0l : (long)u.pm * BM * K * 2; }
    __device__ __forceinline__ void a_offs(int ui, const Unit&, int tid, unsigned (&o)[2][2]) const {
        int uix = ui;
#if REP_GEMM > 1
        { const int cnt = (nM * nN - c + G - 1) / G; uix = ui % cnt; }
#endif
        if (GATHER_) {
#pragma unroll
            for (int i = 0; i < 2; ++i) { int R, C; stage_rc(tid * 16 + i * 8192, R, C);
#pragma unroll
                for (int h = 0; h < 2; ++h) o[h][i] = (unsigned)rowoff[uix * 256 + h * HALF + R] * rowbytes + (unsigned)(C * 2); }
        }
    }
};

struct EpiBf16 {
    static constexpr bool PERM = true;
    bf16_t* O; int ldc;
    __device__ __forceinline__ void operator()(const f32x4 (&acc)[2][2][4][2], const Unit& u, int wr, int wc, int fr, int fq) const {
        const int row0 = u.pm * BM + wr * 64 + fr; const int col0 = u.pn * BM + wc * 32 + 8 * fq;
#pragma unroll
        for (int ai = 0; ai < 2; ++ai)
#pragma unroll
            for (int m = 0; m < 4; ++m) { bf16_t* rowp = O + (size_t)(row0 + ai * HALF + m * 16) * ldc + col0;
#pragma unroll
                for (int bj = 0; bj < 2; ++bj) { const f32x4 v0 = acc[ai][bj][m][0], v1 = acc[ai][bj][m][1];
                    u32x4 w; w.x = cvt_pk_bf16(v0[0], v0[1]); w.y = cvt_pk_bf16(v0[2], v0[3]); w.z = cvt_pk_bf16(v1[0], v1[1]); w.w = cvt_pk_bf16(v1[2], v1[3]);
                    *(u32x4*)(rowp + bj * HALF) = w; } }
    }
};
struct EpiSwiGLU {
    static constexpr bool PERM = true;
    bf16_t* O; int ldc;
    __device__ __forceinline__ void operator()(const f32x4 (&acc)[2][2][4][2], const Unit& u, int wr, int wc, int fr, int fq) const {
        const int row0 = u.pm * BM + wr * 64 + fr; const int col0 = u.pn * HALF + wc * 32 + 8 * fq;
#pragma unroll
        for (int ai = 0; ai < 2; ++ai)
#pragma unroll
            for (int m = 0; m < 4; ++m) { bf16_t* rowp = O + (size_t)(row0 + ai * HALF + m * 16) * ldc + col0;
                float h[8];
#pragma unroll
                for (int n = 0; n < 2; ++n)
#pragma unroll
                    for (int j = 0; j < 4; ++j) { const float g = acc[ai][0][m][n][j], up = acc[ai][1][m][n][j]; h[n * 4 + j] = g * __builtin_amdgcn_rcpf(1.0f + __expf(-g)) * up; }
                u32x4 w; w.x = cvt_pk_bf16(h[0], h[1]); w.y = cvt_pk_bf16(h[2], h[3]); w.z = cvt_pk_bf16(h[4], h[5]); w.w = cvt_pk_bf16(h[6], h[7]);
                *(u32x4*)rowp = w; }
    }
};
struct EpiSwiGLU8 {
    static constexpr bool PERM = true;
    unsigned char* O; int ldc;
    __device__ __forceinline__ void operator()(const f32x4 (&acc)[2][2][4][2], const Unit& u, int wr, int wc, int fr, int fq) const {
        const int row0 = u.pm * BM + wr * 64 + fr; const int col0 = u.pn * HALF + wc * 32 + 8 * fq;
#pragma unroll
        for (int ai = 0; ai < 2; ++ai)
#pragma unroll
            for (int m = 0; m < 4; ++m) { unsigned char* rowp = O + (size_t)(row0 + ai * HALF + m * 16) * ldc + col0;
                float h[8];
#pragma unroll
                for (int n = 0; n < 2; ++n)
#pragma unroll
                    for (int j = 0; j < 4; ++j) { const float g = acc[ai][0][m][n][j], up = acc[ai][1][m][n][j]; h[n * 4 + j] = g * __builtin_amdgcn_rcpf(1.0f + __expf(-g)) * up * (float)(1 << S8_HID); }
                u32x2 w; w.x = pk8(h[0], h[1], h[2], h[3]); w.y = pk8(h[4], h[5], h[6], h[7]);
                *(u32x2*)rowp = w; }
    }
};
struct EpiGate {
    static constexpr bool PERM = true;
    bf16_t* O; const float* mod; int gate_off;
    __device__ __forceinline__ void operator()(const f32x4 (&acc)[2][2][4][2], const Unit& u, int wr, int wc, int fr, int fq) const {
        const int rt = u.pm * BM; const int bi = rt >= NLAT ? 16 : (rt >> 11);
        const int col0 = u.pn * BM + wc * 32 + 8 * fq; const float* gt = mod + bi * MODW + gate_off + col0;
        f32x4 gv[2][2];
#pragma unroll
        for (int bj = 0; bj < 2; ++bj)
#pragma unroll
            for (int n = 0; n < 2; ++n) gv[bj][n] = *(const f32x4*)(gt + bj * HALF + 4 * n) + 1.0f;
        const int row0 = rt + wr * 64 + fr;
#pragma unroll
        for (int ai = 0; ai < 2; ++ai)
#pragma unroll
            for (int m = 0; m < 4; ++m) { bf16_t* rowp = O + (size_t)(row0 + ai * HALF + m * 16) * D + col0;
#pragma unroll
                for (int bj = 0; bj < 2; ++bj) { const f32x4 v0 = acc[ai][bj][m][0] * gv[bj][0], v1 = acc[ai][bj][m][1] * gv[bj][1];
                    u32x4 w; w.x = cvt_pk_bf16(v0[0], v0[1]); w.y = cvt_pk_bf16(v0[2], v0[3]); w.z = cvt_pk_bf16(v1[0], v1[1]); w.w = cvt_pk_bf16(v1[2], v1[3]);
                    *(u32x4*)(rowp + bj * HALF) = w; } }
    }
};

template <class Epi, class Sched, bool ALIGN_EPI, bool SP2, bool FP8 = false>
__device__ __forceinline__ void gemm_phase(LAS unsigned char* lds, const Gemm g, const Sched& S, const Epi& E, int tid_in, int sw = 0x7f7f7f7f, int sa = 0x7f7f7f7f) {
    int tid_ = tid_in; asm volatile("" : "+v"(tid_));
    const int tid = tid_, wid = __builtin_amdgcn_readfirstlane(tid >> 6), lane = tid & 63, wr = wid >> 2, wc = wid & 3, fr = lane & 15, fq = lane >> 4;
    const int K = g.K, nt = K / BK;
    constexpr bool GA = Sched::GATHER;
    unsigned voffA[2], voffB[2];
#pragma unroll
    for (int i = 0; i < 2; ++i) { int R, C; stage_rc(tid * 16 + i * 8192, R, C); const int Rb = Epi::PERM ? ((R & ~31) + perm32(R & 31)) : R;
        voffA[i] = (unsigned)(R * K + C) * 2u; voffB[i] = (unsigned)(Rb * K + C) * 2u; }
    const size_t kstep = (size_t)(BK * 2);
    const size_t hstep = (size_t)HALF * K * 2;
    const unsigned ldsw = (unsigned)wid * 1024u;
    const int aoff = lds_byte(wr * 64 + fr, fq * 8), boff = lds_byte(wc * 32 + fr, fq * 8);
#define PG8_SA(b, h) (((b) * 2 + (h)) * HTB)
#define PG8_SB(b, h) ((4 + (b) * 2 + (h)) * HTB)
#define PG8_STAGE(bufoff, gbase, voff) do { _Pragma("unroll") for (int _i = 0; _i < 2; ++_i) \
        __builtin_amdgcn_global_load_lds((const unsigned*)((const char*)(gbase) + (voff)[_i]), (LAS unsigned*)(lds + (bufoff) + ldsw + _i * 8192), 16, 0, 0); } while (0)
#define PG8_LDA(dst, b, h) do { _Pragma("unroll") for (int m = 0; m < 4; ++m) _Pragma("unroll") for (int k = 0; k < 2; ++k) dst[m][k] = *(const LAS bf16x8*)(lds + PG8_SA(b, h) + aoff + m * 2048 + k * 1024); } while (0)
#define PG8_LDB(dst, b, h) do { _Pragma("unroll") for (int n = 0; n < 2; ++n) _Pragma("unroll") for (int k = 0; k < 2; ++k) dst[n][k] = *(const LAS bf16x8*)(lds + PG8_SB(b, h) + boff + n * 2048 + k * 1024); } while (0)
#define PG8_CAT(x) __builtin_shufflevector(__builtin_bit_cast(i32x4, (x)[0]), __builtin_bit_cast(i32x4, (x)[1]), 0, 1, 2, 3, 4, 5, 6, 7)
#define PG8_MMA(ai, bj, At, Bt) do { __builtin_amdgcn_s_setprio(1); _Pragma("unroll") for (int m = 0; m < 4; ++m) _Pragma("unroll") for (int n = 0; n < 2; ++n) { \
        if constexpr (FP8) { const i32x8 a8_ = PG8_CAT(Bt[n]), b8_ = PG8_CAT(At[m]); \
            asm volatile("v_mfma_scale_f32_16x16x128_f8f6f4 %0, %1, %2, %0, %3, %4 op_sel_hi:[0,0,0]" : "+v"(acc[ai][bj][m][n]) : "v"(a8_), "v"(b8_), "v"(sw), "v"(sa)); } \
        else { _Pragma("unroll") for (int k = 0; k < 2; ++k) acc[ai][bj][m][n] = __builtin_amdgcn_mfma_f32_16x16x32_bf16(Bt[n][k], At[m][k], acc[ai][bj][m][n], 0, 0, 0); } } \
        __builtin_amdgcn_s_setprio(0); } while (0)
#define PG8_WAIT_V(n) asm volatile("s_waitcnt vmcnt(" #n ")" ::: "memory")
#define PG8_WAIT_L(n) asm volatile("s_waitcnt lgkmcnt(" #n ")" ::: "memory")
#define PG8_BAR __builtin_amdgcn_s_barrier()
#define PG8_SCHED __builtin_amdgcn_sched_barrier(0)
    Unit cur, nxt; int ui = 0;
    if (!S.next(0, cur)) return;
    f32x4 acc[2][2][4][2];
#pragma unroll
    for (int a = 0; a < 2; ++a)
#pragma unroll
        for (int b = 0; b < 2; ++b)
#pragma unroll
            for (int m = 0; m < 4; ++m)
#pragma unroll
                for (int n = 0; n < 2; ++n) acc[a][b][m][n] = (f32x4){0.f, 0.f, 0.f, 0.f};
    bf16x8 At[4][2], B0[2][2], B1[2][2];
    const char* Ab = (const char*)g.A + S.a_base(cur);
    unsigned oc[2][2];
    S.a_offs(0, cur, tid, oc);
    const size_t hsA = GA ? (size_t)0 : hstep;
#define PG8_STAGE_A(bufoff, gbase, h) do { if constexpr (GA) PG8_STAGE(bufoff, gbase, oc[h]); else PG8_STAGE(bufoff, (gbase) + (h) * hsA, voffA); } while (0)
    const char* cB = (const char*)g.Bt + cur.bofs;
    if constexpr (SP2) {
        PG8_STAGE(PG8_SB(0, 0), cB, voffB); PG8_STAGE(PG8_SB(0, 1), cB + hstep, voffB); PG8_STAGE_A(PG8_SA(0, 0), Ab, 0); PG8_STAGE_A(PG8_SA(0, 1), Ab, 1);
        if (wr == 1) PG8_BAR;
        PG8_WAIT_V(2); PG8_BAR;
        PG8_STAGE(PG8_SB(1, 0), cB + kstep, voffB); PG8_STAGE_A(PG8_SA(1, 0), Ab + kstep, 0); PG8_STAGE(PG8_SB(1, 1), cB + hstep + kstep, voffB);
        PG8_WAIT_V(6); PG8_BAR;
    } else {
        PG8_STAGE(PG8_SB(0, 0), cB, voffB); PG8_STAGE_A(PG8_SA(0, 0), Ab, 0); PG8_STAGE(PG8_SB(0, 1), cB + hstep, voffB); PG8_STAGE_A(PG8_SA(0, 1), Ab, 1);
        if (wr == 1) PG8_BAR;
        PG8_WAIT_V(4); PG8_BAR;
        PG8_STAGE(PG8_SB(1, 0), cB + kstep, voffB); PG8_STAGE_A(PG8_SA(1, 0), Ab + kstep, 0); PG8_STAGE(PG8_SB(1, 1), cB + hstep + kstep, voffB);
        PG8_WAIT_V(6); PG8_BAR;
    }
    for (;;) {
        const bool has_next = S.next(ui + 1, nxt);
        const char* nB = has_next ? (const char*)g.Bt + nxt.bofs : cB;
        for (int t = 0; t < nt; t += 2) {
            const bool last = (t == nt - 2);
            const char* a1 = Ab + (size_t)(t + 1) * kstep;
            const char* b2 = last ? nB : cB + (size_t)(t + 2) * kstep; const char* b3 = b2 + kstep;
            if constexpr (SP2) {
            PG8_LDB(B0, 0, 0); PG8_LDB(B1, 0, 1); PG8_SCHED; PG8_LDA(At, 0, 0); PG8_STAGE_A(PG8_SA(1, 1), a1, 1);
            if (last && has_next) { S.a_offs(ui + 1, nxt, tid, oc); Ab = (const char*)g.A + S.a_base(nxt); }
            const char* a2 = last ? Ab : Ab + (size_t)(t + 2) * kstep; const char* a3 = a2 + kstep;
            PG8_WAIT_V(8); PG8_WAIT_L(0); PG8_BAR; PG8_MMA(0, 0, At, B0); PG8_MMA(0, 1, At, B1); PG8_BAR; PG8_SCHED;
            PG8_LDA(At, 0, 1); PG8_STAGE(PG8_SB(0, 0), b2, voffB); PG8_STAGE(PG8_SB(0, 1), b2 + hstep, voffB); PG8_STAGE_A(PG8_SA(0, 0), a2, 0);
            PG8_WAIT_V(8); PG8_WAIT_L(0); PG8_BAR; PG8_MMA(1, 0, At, B0); PG8_MMA(1, 1, At, B1); PG8_BAR; PG8_SCHED;
            PG8_LDB(B0, 1, 0); PG8_LDB(B1, 1, 1); PG8_SCHED; PG8_LDA(At, 1, 0); PG8_STAGE_A(PG8_SA(0, 1), a2, 1);
            PG8_WAIT_V(8); PG8_WAIT_L(0); PG8_BAR; PG8_MMA(0, 0, At, B0); PG8_MMA(0, 1, At, B1); PG8_BAR; PG8_SCHED;
            PG8_LDA(At, 1, 1); PG8_STAGE(PG8_SB(1, 0), b3, voffB); PG8_STAGE(PG8_SB(1, 1), b3 + hstep, voffB); PG8_STAGE_A(PG8_SA(1, 0), a3, 0);
            PG8_WAIT_V(8); PG8_WAIT_L(0); PG8_BAR; PG8_MMA(1, 0, At, B0); PG8_MMA(1, 1, At, B1); PG8_BAR; PG8_SCHED;
            } else {
            PG8_LDB(B0, 0, 0); PG8_SCHED; PG8_LDA(At, 0, 0); PG8_STAGE_A(PG8_SA(1, 1), a1, 1);
            if (last && has_next) { S.a_offs(ui + 1, nxt, tid, oc); Ab = (const char*)g.A + S.a_base(nxt); }
            const char* a2 = last ? Ab : Ab + (size_t)(t + 2) * kstep; const char* a3 = a2 + kstep;
            PG8_WAIT_L(8); PG8_BAR; PG8_WAIT_L(0); PG8_MMA(0, 0, At, B0); PG8_BAR; PG8_SCHED;
            PG8_LDB(B1, 0, 1); PG8_STAGE(PG8_SB(0, 0), b2, voffB);
            PG8_BAR; PG8_WAIT_L(0); PG8_MMA(0, 1, At, B1); PG8_BAR;
            PG8_LDA(At, 0, 1); PG8_STAGE_A(PG8_SA(0, 0), a2, 0);
            PG8_BAR; PG8_WAIT_L(0); PG8_MMA(1, 0, At, B0); PG8_BAR; PG8_SCHED;
            PG8_STAGE(PG8_SB(0, 1), b2 + hstep, voffB);
            PG8_WAIT_V(6); PG8_BAR; PG8_MMA(1, 1, At, B1); PG8_BAR;
            PG8_LDB(B0, 1, 0); PG8_SCHED; PG8_LDA(At, 1, 0); PG8_STAGE_A(PG8_SA(0, 1), a2, 1);
            PG8_WAIT_L(8); PG8_BAR; PG8_WAIT_L(0); PG8_MMA(0, 0, At, B0); PG8_BAR; PG8_SCHED;
            PG8_LDB(B1, 1, 1); PG8_STAGE(PG8_SB(1, 0), b3, voffB);
            PG8_BAR; PG8_WAIT_L(0); PG8_MMA(0, 1, At, B1); PG8_BAR;
            PG8_LDA(At, 1, 1); PG8_STAGE_A(PG8_SA(1, 0), a3, 0);
            PG8_BAR; PG8_WAIT_L(0); PG8_MMA(1, 0, At, B0); PG8_BAR; PG8_SCHED;
            PG8_STAGE(PG8_SB(1, 1), b3 + hstep, voffB);
            PG8_WAIT_V(6); PG8_BAR; PG8_MMA(1, 1, At, B1); PG8_BAR;
            }
        }
        if constexpr (ALIGN_EPI) { if (wr == 0) PG8_BAR; }
        if constexpr (FP8) asm volatile("s_nop 15\n\ts_nop 15\n\ts_nop 15" ::: "memory");
        E(acc, cur, wr, wc, fr, fq);
        if (!has_next) break;
#pragma unroll
        for (int a = 0; a < 2; ++a)
#pragma unroll
            for (int b = 0; b < 2; ++b)
#pragma unroll
                for (int m = 0; m < 4; ++m)
#pragma unroll
                    for (int n = 0; n < 2; ++n) acc[a][b][m][n] = (f32x4){0.f, 0.f, 0.f, 0.f};
        cur = nxt; cB = nB; ++ui;
        if constexpr (ALIGN_EPI) { if (wr == 1) PG8_BAR; }
    }
    PG8_WAIT_V(0);
    if constexpr (!ALIGN_EPI) { if (wr == 0) PG8_BAR; }
    PG8_BAR;
#undef PG8_SA
#undef PG8_SB
#undef PG8_STAGE
#undef PG8_STAGE_A
#undef PG8_LDA
#undef PG8_LDB
#undef PG8_MMA
#undef PG8_CAT
#undef PG8_WAIT_V
#undef PG8_WAIT_L
#undef PG8_BAR
#undef PG8_SCHED
}
}

#define XB_TMO      128
#define XB_XCNT(j)  (256  + 64 * (j))
#define XB_XSUB(j)  (1280 + 64 * (j))
#define XB_XGEN(j)  (2304 + 64 * (j))
#define XB_TOP      3328
#define XB_TOPGEN   3392
#define XCD_BAR_WORDS 3456
#define XB_SPIN_CAP (1u << 18)
__device__ __forceinline__ unsigned xb_ld(unsigned* p)              { return __hip_atomic_load(p, __ATOMIC_RELAXED, __HIP_MEMORY_SCOPE_AGENT); }
__device__ __forceinline__ unsigned xb_add(unsigned* p, unsigned v) { return __hip_atomic_fetch_add(p, v, __ATOMIC_RELAXED, __HIP_MEMORY_SCOPE_AGENT); }
__device__ __forceinline__ unsigned xb_xcc_id() { return (unsigned)__builtin_amdgcn_s_getreg((3 << 11) | 20) & 0xFu; }
#define XB_SPIN(cond, bar) do { unsigned _sp = 0; while (cond) { __builtin_amdgcn_s_sleep(1); \
    if ((++_sp & 255u) == 0u) { if (xb_ld(&(bar)[XB_TMO])) break; if (_sp > XB_SPIN_CAP) { atomicAdd(&(bar)[XB_TMO], 1u); break; } } } } while (0)
struct XcdBarrier { unsigned* bar; unsigned x; volatile LAS unsigned* st; };
__device__ __forceinline__ XcdBarrier xcd_barrier_post(unsigned* bar, volatile LAS unsigned* st) {
    XcdBarrier b; b.bar = bar; b.x = xb_xcc_id(); b.st = st;
    if (threadIdx.x == 0) (void)xb_add(&bar[XB_XCNT(b.x)], 1u);
    return b;
}
__device__ __forceinline__ void xcd_barrier_complete(unsigned* bar, unsigned x, unsigned& nloc, unsigned& nx) {
    const unsigned G = gridDim.x * gridDim.y * gridDim.z;
    unsigned sum, cnt, mine, sp = 0u;
    for (;;) {
        sum = 0u; cnt = 0u; mine = 0u;
#pragma unroll
        for (unsigned j = 0; j < 16; ++j) { const unsigned c = xb_ld(&bar[XB_XCNT(j)]); sum += c; cnt += (c > 0u) ? 1u : 0u; }
        mine = xb_ld(&bar[XB_XCNT(x)]);
        if (sum == G) break;
        __builtin_amdgcn_s_sleep(1);
        if ((++sp & 255u) == 0u) { if (xb_ld(&bar[XB_TMO])) break; if (sp > XB_SPIN_CAP) { atomicAdd(&bar[XB_TMO], 1u); break; } }
    }
    nloc = mine > 0u ? mine : 1u; nx = cnt > 0u ? cnt : 1u;
}
__device__ __forceinline__ void xcd_barrier(const XcdBarrier& b, bool leader) {
    asm volatile("s_waitcnt vmcnt(0)" ::: "memory");
    __syncthreads();
    if (leader) {
        unsigned* bar = b.bar;
        __builtin_amdgcn_s_waitcnt(0);
        unsigned nloc = b.st[0], nx = b.st[1];
        if (nloc == 0u) { xcd_barrier_complete(bar, b.x, nloc, nx); b.st[0] = nloc; b.st[1] = nx; }
        const unsigned old = xb_add(&bar[XB_XSUB(b.x)], 1u);
        const unsigned gen = old / nloc;
        if (old + 1u == (gen + 1u) * nloc) {
            __builtin_amdgcn_fence(__ATOMIC_RELEASE, "agent");
            asm volatile("s_waitcnt vmcnt(0)" ::: "memory");
            const unsigned og = xb_add(&bar[XB_TOP], 1u);
            const unsigned tg = og / nx;
            if (og + 1u == (tg + 1u) * nx) xb_add(&bar[XB_TOPGEN], 1u);
            else XB_SPIN(xb_ld(&bar[XB_TOPGEN]) == tg, bar);
            __builtin_amdgcn_fence(__ATOMIC_ACQUIRE, "agent");
            xb_add(&bar[XB_XGEN(b.x)], 1u);
            asm volatile("s_waitcnt vmcnt(0)" ::: "memory");
        } else {
            XB_SPIN(xb_ld(&bar[XB_XGEN(b.x)]) == gen, bar);
            __builtin_amdgcn_fence(__ATOMIC_ACQUIRE, "agent");
            asm volatile("s_waitcnt vmcnt(0)" ::: "memory");
        }
    }
    __syncthreads();
}

constexpr int NT = 512, NWAVES = 8;
struct Args { const float* in[24]; float* out; unsigned char* ws; int ph_lo, ph_hi; };
enum { I_X = 0, I_C, I_CTX, I_CCTX, I_WMOD, I_BMOD, I_WIN, I_WOUT, I_RPB, I_CONVW, I_CONVB, I_DTB, I_ALOG, I_DSKIP, I_NORMW, I_LNG, I_LNB, I_FG, I_FU, I_FD, I_RW, I_MG, I_MU, I_MD };
struct Frame {
    LAS unsigned char* lds;
    const float* const* in; float* out; unsigned char* ws;
    int tid, lane, wave, bid, G, gw, NGW;
};
#define LDS_WAIT() asm volatile("s_waitcnt lgkmcnt(0)" ::: "memory")
__device__ __forceinline__ Frame fresh(const Frame& F0) {
    Frame F = F0; int z; asm volatile("s_mov_b32 %0, 0" : "=s"(z)); F.ws = F0.ws + z; F.in = F0.in + z; F.out = F0.out + z;
    int ln; asm volatile("v_mbcnt_lo_u32_b32 %0, -1, 0\n\tv_mbcnt_hi_u32_b32 %0, -1, %0" : "=v"(ln));     int t = F0.wave * 64 + ln;
    F.tid = t; F.lane = t & 63; return F;
}

__device__ __forceinline__ void conv_item(const float* W, int ldn, int k0, int n0, bf16_t* dst, int K, int drow0, LAS float* scr, int lane) {
    f32x4 ld[8];
#pragma unroll
    for (int i = 0; i < 8; ++i) ld[i] = *(const f32x4*)(W + (size_t)(k0 + 8 * i + (lane >> 3)) * ldn + n0 + 4 * (lane & 7));
#pragma unroll
    for (int i = 0; i < 8; ++i) { LAS float* d = scr + (8 * i + (lane >> 3)) * 33 + 4 * (lane & 7); d[0] = ld[i][0]; d[1] = ld[i][1]; d[2] = ld[i][2]; d[3] = ld[i][3]; }
    LDS_WAIT(); asm volatile("" ::: "memory");
    const int c = lane & 7;
#pragma unroll
    for (int j = 0; j < 4; ++j) { const int n = (lane >> 3) + 8 * j; const LAS float* s = scr + (8 * c) * 33 + n;
        u32x4 o; o.x = pk2(s[0 * 33], s[1 * 33]); o.y = pk2(s[2 * 33], s[3 * 33]); o.z = pk2(s[4 * 33], s[5 * 33]); o.w = pk2(s[6 * 33], s[7 * 33]);
        *(u32x4*)(dst + (size_t)(drow0 + n) * K + k0 + 8 * c) = o; }
    LDS_WAIT(); asm volatile("" ::: "memory");
}
__device__ __forceinline__ void conv_item8(const float* W, int ldn, int k0, int n0, unsigned char* dst, int K, int drow0, float scale, LAS float* scr, int lane) {
    f32x4 ld[8];
#pragma unroll
    for (int i = 0; i < 8; ++i) ld[i] = *(const f32x4*)(W + (size_t)(k0 + 8 * i + (lane >> 3)) * ldn + n0 + 4 * (lane & 7));
#pragma unroll
    for (int i = 0; i < 8; ++i) { LAS float* d = scr + (8 * i + (lane >> 3)) * 33 + 4 * (lane & 7); d[0] = ld[i][0] * scale; d[1] = ld[i][1] * scale; d[2] = ld[i][2] * scale; d[3] = ld[i][3] * scale; }
    LDS_WAIT(); asm volatile("" ::: "memory");
    const int c = lane & 7;
#pragma unroll
    for (int j = 0; j < 4; ++j) { const int n = (lane >> 3) + 8 * j; const LAS float* sp = scr + (8 * c) * 33 + n;
        u32x2 o; o.x = pk8(sp[0 * 33], sp[1 * 33], sp[2 * 33], sp[3 * 33]); o.y = pk8(sp[4 * 33], sp[5 * 33], sp[6 * 33], sp[7 * 33]);
        *(u32x2*)(dst + (size_t)(drow0 + n) * K + k0 + 8 * c) = o; }
    LDS_WAIT(); asm volatile("" ::: "memory");
}
__device__ __forceinline__ void conv_seg(const Frame& F, const float* W, int K, int ldn, int ncols, bf16_t* dst, int mode, int& rot, int s8 = -1) {
    LAS float* scr = (LAS float*)(F.lds + F.wave * 16384);
    const int nblk = ncols / 32, nitems = (K / 64) * nblk;
    int start = F.gw - rot; if (start < 0) start += F.NGW;
    for (int it = start; it < nitems; it += F.NGW) {
        const int kb = it / nblk, nb = it % nblk, n0 = nb * 32;
        const int drow0 = (mode == 0) ? n0 : ((n0 >> 7) * 256 + (n0 & 127) + (mode == 2 ? 128 : 0));
        if (s8 >= 0) conv_item8(W, ldn, kb * 64, n0, (unsigned char*)dst, K, drow0, (float)(1 << s8), scr, F.lane);
        else conv_item(W, ldn, kb * 64, n0, dst, K, drow0, scr, F.lane);
    }
    rot = (rot + nitems) % F.NGW;
}
__device__ __forceinline__ void conv_moe(const Frame& F, int slot, int& rot) {
#if USE_FP8
    unsigned char* gu = F.ws + WS_WMGU + (size_t)slot * NEXP * 2 * DFFE * D; unsigned char* dn = F.ws + WS_WMD + (size_t)slot * NEXP * D * DFFE;
    for (int e = 0; e < NEXP; ++e) {
        const size_t so = ((size_t)slot * NEXP + e) * (size_t)D * DFFE;
        conv_seg(F, F.in[I_MG] + so, D, DFFE, DFFE, (bf16_t*)(gu + (size_t)e * 2 * DFFE * D), 1, rot, S8_WGU);
        conv_seg(F, F.in[I_MU] + so, D, DFFE, DFFE, (bf16_t*)(gu + (size_t)e * 2 * DFFE * D), 2, rot, S8_WGU);
        conv_seg(F, F.in[I_MD] + so, DFFE, D, D, (bf16_t*)(dn + (size_t)e * D * DFFE), 0, rot, S8_WD);
    }
#else
    bf16_t* gu = (bf16_t*)(F.ws + WS_WMGU); bf16_t* dn = (bf16_t*)(F.ws + WS_WMD);
    for (int e = 0; e < NEXP; ++e) {
        const size_t so = ((size_t)slot * NEXP + e) * (size_t)D * DFFE;
        conv_seg(F, F.in[I_MG] + so, D, DFFE, DFFE, gu + (size_t)e * 2 * DFFE * D, 1, rot);
        conv_seg(F, F.in[I_MU] + so, D, DFFE, DFFE, gu + (size_t)e * 2 * DFFE * D, 2, rot);
        conv_seg(F, F.in[I_MD] + so, DFFE, D, D, dn + (size_t)e * D * DFFE, 0, rot);
    }
#endif
}

constexpr int MOE_ITEMS_MAT = 1792, MOE_ITEMS_EXP = 3 * MOE_ITEMS_MAT, MOE_ITEMS_SLOT = 8 * MOE_ITEMS_EXP, MOE_ITEMS = 2 * MOE_ITEMS_SLOT;
__device__ __forceinline__ void conv_moe_item(const Frame& F, int gidx) {
    LAS float* scr = (LAS float*)(F.lds + F.wave * 16384);
    const int slot = gidx / MOE_ITEMS_SLOT, r = gidx % MOE_ITEMS_SLOT, e = r / MOE_ITEMS_EXP, r2 = r % MOE_ITEMS_EXP, mat = r2 / MOE_ITEMS_MAT, it = r2 % MOE_ITEMS_MAT;
    const size_t so = ((size_t)slot * NEXP + e) * (size_t)D * DFFE;
    if (mat < 2) { const int kb = it / 112, nb = it % 112, n0 = nb * 32; const int drow0 = (n0 >> 7) * 256 + (n0 & 127) + (mat == 1 ? 128 : 0);
        conv_item8((mat ? F.in[I_MU] : F.in[I_MG]) + so, DFFE, kb * 64, n0, F.ws + WS_WMGU + ((size_t)slot * NEXP + e) * 2 * DFFE * D, D, drow0, (float)(1 << S8_WGU), scr, F.lane); }
    else { const int kb = it / 32, nb = it % 32, n0 = nb * 32;
        conv_item8(F.in[I_MD] + so, D, kb * 64, n0, F.ws + WS_WMD + ((size_t)slot * NEXP + e) * D * DFFE, DFFE, n0, (float)(1 << S8_WD), scr, F.lane); }
}
__device__ __forceinline__ void deferred_conv(const Frame& F, int nwg, int base, int quota) {
    if (F.G != 256) return;
    const int maxu = (nwg + F.G - 1) / F.G, c0 = nwg - (maxu - 1) * F.G;
    if (c0 >= F.G || F.bid < c0) return;
    const int first = base + ((F.bid - c0) * NWAVES + F.wave) * quota;
    for (int j = 0; j < quota; ++j) { const int gidx = first + j; if (gidx < MOE_ITEMS) conv_moe_item(F, gidx); }
}
constexpr int DW_Q = 12, DW_Q2 = 10;
constexpr int DW_L0_IN = 0, DW_L0_OUT = DW_L0_IN + 64 * 8 * DW_Q, DW_L0_F1 = DW_L0_OUT + 192 * 8 * DW_Q, DW_L0_F2 = DW_L0_F1 + 160 * 8 * DW_Q, DW_L1_IN = DW_L0_F2 + 192 * 8 * DW_Q2, DW_L1_OUT = DW_L1_IN + 64 * 8 * DW_Q, DW_L2_IN = DW_L1_OUT + 192 * 8 * DW_Q, DW_END = DW_L2_IN + 64 * 8 * DW_Q;
static_assert(DW_L1_IN >= MOE_ITEMS_SLOT && DW_END >= MOE_ITEMS, "deferred conversion: layer-1 experts must be done before layer 1's FFN, all before layer 3's");
__device__ __forceinline__ void p_pro_a(const Frame& F) {
    {
        LAS float* sc = (LAS float*)F.lds; LAS float* red = sc + 17 * 1024;
        const float* c = F.in[I_C]; const float* cc = F.in[I_CCTX];
        for (int i = F.tid; i < 17 * 1024; i += NT) { const int r = i >> 10, k = i & 1023; const float v = (r < 16) ? c[r * 1024 + k] : cc[k]; sc[i] = silu_f(v); }
        __syncthreads();
        float* MOD = (float*)(F.ws + WS_MOD);
        const int col = F.tid & 31, ks = F.tid >> 5;
        for (int u = F.bid; u < 4 * 192; u += F.G) {
            const int l = u / 192, cb = u % 192;
            const float* W = F.in[I_WMOD] + (size_t)l * D * MODW + cb * 32 + col;
            float acc[17];
#pragma unroll
            for (int r = 0; r < 17; ++r) acc[r] = 0.f;
#pragma unroll 1
            for (int kb = 0; kb < 4; ++kb) { float w[16];
#pragma unroll
                for (int i = 0; i < 16; ++i) w[i] = W[(size_t)(ks * 64 + kb * 16 + i) * MODW];
#pragma unroll
                for (int i = 0; i < 16; ++i) { const int k = ks * 64 + kb * 16 + i;
#pragma unroll
                    for (int r = 0; r < 17; ++r) acc[r] += sc[r * 1024 + k] * w[i]; } }
#pragma unroll
            for (int r = 0; r < 17; ++r) red[(ks * 17 + r) * 32 + col] = acc[r];
            __syncthreads();
            for (int i = F.tid; i < 17 * 32; i += NT) { const int r = i >> 5, c2 = i & 31; float sm = 0.f;
#pragma unroll
                for (int k2 = 0; k2 < 16; ++k2) sm += red[(k2 * 17 + r) * 32 + c2];
                MOD[(size_t)(l * 17 + r) * MODW + cb * 32 + c2] = sm + F.in[I_BMOD][l * MODW + cb * 32 + c2]; }
            __syncthreads();
        }
    }
    int rot = 0;
    for (int l = 0; l < DEPTH; ++l) {
#if USE_FP8 && FP8_INPROJ
        conv_seg(F, F.in[I_WIN] + (size_t)l * D * D_IN_PROJ, D, D_IN_PROJ, NPROJ, (bf16_t*)(F.ws + WS_WIN + (size_t)l * NPROJ * D), 0, rot, S8_WGU);
#else
        conv_seg(F, F.in[I_WIN] + (size_t)l * D * D_IN_PROJ, D, D_IN_PROJ, NPROJ, (bf16_t*)(F.ws + WS_WIN) + (size_t)l * NPROJ * D, 0, rot);
#endif
        conv_seg(F, F.in[I_WOUT] + (size_t)l * D * D, D, D, D, (bf16_t*)(F.ws + WS_WOUT) + (size_t)l * D * D, 0, rot);
    }
    for (int s = 0; s < 2; ++s) {
#if USE_FP8 && FP8_DENSE1
        conv_seg(F, F.in[I_FG] + (size_t)s * D * DFF, D, DFF, DFF, (bf16_t*)(F.ws + WS_WFGU + (size_t)s * 2 * DFF * D), 1, rot, S8_WGU);
        conv_seg(F, F.in[I_FU] + (size_t)s * D * DFF, D, DFF, DFF, (bf16_t*)(F.ws + WS_WFGU + (size_t)s * 2 * DFF * D), 2, rot, S8_WGU);
#else
        conv_seg(F, F.in[I_FG] + (size_t)s * D * DFF, D, DFF, DFF, (bf16_t*)(F.ws + WS_WFGU) + (size_t)s * 2 * DFF * D, 1, rot);
        conv_seg(F, F.in[I_FU] + (size_t)s * D * DFF, D, DFF, DFF, (bf16_t*)(F.ws + WS_WFGU) + (size_t)s * 2 * DFF * D, 2, rot);
#endif
#if USE_FP8 && FP8_DENSE2
        conv_seg(F, F.in[I_FD] + (size_t)s * DFF * D, DFF, D, D, (bf16_t*)(F.ws + WS_WFD + (size_t)s * D * DFF), 0, rot, S8_WD);
#else
        conv_seg(F, F.in[I_FD] + (size_t)s * DFF * D, DFF, D, D, (bf16_t*)(F.ws + WS_WFD) + (size_t)s * D * DFF, 0, rot);
#endif
    }
    if (F.G != 256) { conv_moe(F, 0, rot); conv_moe(F, 1, rot); }
    { bf16_t* wdt = (bf16_t*)(F.ws + WS_WDT);
      for (int i = F.bid * NT + F.tid; i < DEPTH * 16 * D; i += F.G * NT) { const int l = i / (16 * D), n = (i / D) & 15, k = i % D;
          wdt[i] = (bf16_t)f2bf(F.in[I_WIN][((size_t)l * D + k) * D_IN_PROJ + NPROJ + n]); } }
}

#define RIDX(q) (8 * lane + 512 * ((q) >> 1) + 4 * ((q) & 1))
__device__ __forceinline__ void row_load(const float* p, int lane, f32x4 (&v)[4]) {
#pragma unroll
    for (int q = 0; q < 4; ++q) v[q] = *(const f32x4*)(p + RIDX(q));
}
__device__ __forceinline__ void row_store(float* p, int lane, const f32x4 (&v)[4]) {
#pragma unroll
    for (int q = 0; q < 4; ++q) *(f32x4*)(p + RIDX(q)) = v[q];
}
__device__ __forceinline__ void row_mod_store8(unsigned char* hrow, int lane, const f32x4 (&v)[4], const float* sh, const float* sc, f32x4 (&hv)[4]) {
#pragma unroll
    for (int j = 0; j < 2; ++j) { u32x2 w;
#pragma unroll
        for (int h = 0; h < 2; ++h) { const int q = 2 * j + h; const f32x4 a = *(const f32x4*)(sc + RIDX(q)), b = *(const f32x4*)(sh + RIDX(q));
            hv[q] = v[q] * (a + 1.0f) + b; const f32x4 t = hv[q] * (float)(1 << S8_ACT); const unsigned pw = pk8(t[0], t[1], t[2], t[3]); if (h == 0) w.x = pw; else w.y = pw; }
        *(u32x2*)(hrow + 8 * lane + 512 * j) = w; }
}
__device__ __forceinline__ void row_load_h(const bf16_t* p, int lane, f32x4 (&v)[4]) {
#pragma unroll
    for (int j = 0; j < 2; ++j) { const u32x4 w = *(const u32x4*)(p + 8 * lane + 512 * j); v[2 * j] = (f32x4){bflo(w.x), bfhi(w.x), bflo(w.y), bfhi(w.y)}; v[2 * j + 1] = (f32x4){bflo(w.z), bfhi(w.z), bflo(w.w), bfhi(w.w)}; }
}
__device__ __forceinline__ void row_store_h(bf16_t* p, int lane, const f32x4 (&v)[4]) {
#pragma unroll
    for (int j = 0; j < 2; ++j) { u32x4 w; w.x = pk2(v[2 * j][0], v[2 * j][1]); w.y = pk2(v[2 * j][2], v[2 * j][3]); w.z = pk2(v[2 * j + 1][0], v[2 * j + 1][1]); w.w = pk2(v[2 * j + 1][2], v[2 * j + 1][3]);
        *(u32x4*)(p + 8 * lane + 512 * j) = w; }
}
__device__ __forceinline__ void row_mod_store(bf16_t* hrow, int lane, const f32x4 (&v)[4], const float* sh, const float* sc, f32x4 (&hv)[4]) {
#pragma unroll
    for (int q = 0; q < 4; ++q) { const f32x4 a = *(const f32x4*)(sc + RIDX(q)), b = *(const f32x4*)(sh + RIDX(q)); hv[q] = v[q] * (a + 1.0f) + b; }
    row_store_h(hrow, lane, hv);
}
__device__ __forceinline__ void row_ln(f32x4 (&v)[4], const float* g, const float* b, int lane) {
    float s = 0.f;
#pragma unroll
    for (int j = 0; j < 4; ++j) s += (v[j][0] + v[j][1]) + (v[j][2] + v[j][3]);
    const float mean = wave_sum(s) * (1.0f / D); float q2 = 0.f;
#pragma unroll
    for (int j = 0; j < 4; ++j) { v[j] = v[j] - mean; q2 += (v[j][0] * v[j][0] + v[j][1] * v[j][1]) + (v[j][2] * v[j][2] + v[j][3] * v[j][3]); }
    const float rstd = 1.0f / sqrtf(wave_sum(q2) * (1.0f / D) + LN_EPS);
#pragma unroll
    for (int q = 0; q < 4; ++q) { const f32x4 gg = *(const f32x4*)(g + RIDX(q)), bb = *(const f32x4*)(b + RIDX(q)); v[q] = v[q] * rstd * gg + bb; }
}
__device__ __forceinline__ int mod_row_of(int row) { return row < NLAT ? (row >> 11) : 16; }
struct RowRaw { u32x4 x[2], d[2]; };
template <bool WITH_D> __device__ __forceinline__ void row_issue(const bf16_t* X, const bf16_t* Dl, int row, int lane, RowRaw& r) {
#pragma unroll
    for (int j = 0; j < 2; ++j) { r.x[j] = *(const u32x4*)(X + (size_t)row * D + 8 * lane + 512 * j); if (WITH_D) r.d[j] = *(const u32x4*)(Dl + (size_t)row * D + 8 * lane + 512 * j); }
}
__device__ __forceinline__ void unpack8(const u32x4 w, f32x4& lo, f32x4& hi) { lo = (f32x4){bflo(w.x), bfhi(w.x), bflo(w.y), bfhi(w.y)}; hi = (f32x4){bflo(w.z), bfhi(w.z), bflo(w.w), bfhi(w.w)}; }
__device__ __forceinline__ void row_combine(const RowRaw& r, f32x4 (&v)[4]) {
#pragma unroll
    for (int j = 0; j < 2; ++j) { f32x4 x0, x1, d0, d1; unpack8(r.x[j], x0, x1); unpack8(r.d[j], d0, d1); v[2 * j] = x0 * ALPHA + d0; v[2 * j + 1] = x1 * ALPHA + d1; }
}

__device__ __forceinline__ void p_pro_b(const Frame& F) {
    const float* MOD = (const float*)(F.ws + WS_MOD); bf16_t* H = (bf16_t*)(F.ws + WS_H); bf16_t* X = (bf16_t*)(F.ws + WS_X);
    for (int row = F.gw; row < NTOK; row += F.NGW) {
        const float* src = row < NLAT ? F.in[I_X] + (size_t)row * D : F.in[I_CTX] + (size_t)(row - NLAT) * D;
        f32x4 v[4], hv[4]; row_load(src, F.lane, v);
        row_store_h(X + (size_t)row * D, F.lane, v);
        const float* m = MOD + (size_t)mod_row_of(row) * MODW;
        row_mod_store(H + (size_t)row * D, F.lane, v, m, m + D, hv);
    }
}

__device__ __forceinline__ void p_inproj(const Frame& F, int layer) {
    const bf16_t* H = (const bf16_t*)(F.ws + WS_H);
    {
        const bf16_t* wdt = (const bf16_t*)(F.ws + WS_WDT) + (size_t)layer * 16 * D; float* DT = (float*)(F.ws + WS_DT);
        const int fr = F.lane & 15, fq = F.lane >> 4; const float dtb = F.in[I_DTB][layer * 16 + fr];
        for (int g = F.gw; g < NTOK / 16; g += F.NGW) {
            f32x4 acc = {0.f, 0.f, 0.f, 0.f};
            const bf16_t* ap = H + (size_t)(g * 16 + fr) * D + fq * 8; const bf16_t* bp = wdt + (size_t)fr * D + fq * 8;
#pragma unroll 8
            for (int ks = 0; ks < 32; ++ks) { const bf16x8 a = *(const bf16x8*)(ap + ks * 32), b = *(const bf16x8*)(bp + ks * 32);
                acc = __builtin_amdgcn_mfma_f32_16x16x32_bf16(a, b, acc, 0, 0, 0); }
#pragma unroll
            for (int r = 0; r < 4; ++r) { const float x = acc[r] + dtb; DT[(size_t)(g * 16 + fq * 4 + r) * 16 + fr] = x > 20.f ? x : log1pf(__expf(x)); }
        }
    }
    pg8::EpiBf16 E{(bf16_t*)(F.ws + WS_PROJ), NPROJ};
#if USE_FP8 && FP8_INPROJ
    pg8::Gemm g{(const bf16_t*)(F.ws + WS_H8IN), (const bf16_t*)(F.ws + WS_WIN + (size_t)layer * NPROJ * D), D / 2};
    pg8::DenseOrder S; S.init(NTOK, NPROJ, D / 2, F.G, F.bid, REP_GEMM);
    pg8::gemm_phase<pg8::EpiBf16, pg8::DenseOrder, true, FP8_SP2, true>(F.lds, g, S, E, F.tid, (127 - S8_WGU) * 0x01010101, (127 - S8_ACT) * 0x01010101);
#else
    pg8::Gemm g{H, (const bf16_t*)(F.ws + WS_WIN) + (size_t)layer * NPROJ * D, D};
    pg8::DenseOrder S; S.init(NTOK, NPROJ, D, F.G, F.bid, REP_GEMM);
    pg8::gemm_phase<pg8::EpiBf16, pg8::DenseOrder, true, true>(F.lds, g, S, E, F.tid);
#endif
    if (layer == 0) deferred_conv(F, (NTOK / 256) * (NPROJ / 256), DW_L0_IN, DW_Q); else if (layer < 3) deferred_conv(F, (NTOK / 256) * (NPROJ / 256), layer == 1 ? DW_L1_IN : DW_L2_IN, DW_Q);
}

typedef short s16x4 __attribute__((ext_vector_type(4)));
__device__ __forceinline__ s16x4 lds_tr16(LAS const unsigned char* p) { return __builtin_bit_cast(s16x4, __builtin_amdgcn_ds_read_tr16_b64_v4i16((LAS s16x4*)p)); }
constexpr int NA_KS = 144;
constexpr float LOG2E = 1.4426950408889634f;
__device__ __forceinline__ void na_unit(const Frame& F, int layer, int b, int h, int mode, int m) {
    LAS unsigned char* KV = F.lds;
    LAS float* rp = (LAS float*)(F.lds + 120832);
    const bf16_t* PROJ = (const bf16_t*)(F.ws + WS_PROJ); bf16_t* MIX = (bf16_t*)(F.ws + WS_MIX);
    const int tid = F.tid, lane = F.lane, w = F.wave, q16 = lane & 15, g = lane >> 4;
    int rbase = 0, nk = 0;
    if (mode == 0) { rbase = 2 * m - 4; rbase = rbase < 0 ? 0 : (rbase > 24 ? 24 : rbase); nk = 32 - rbase; nk = nk > 9 ? 9 : nk; }
    const int kfirst = (mode == 0) ? 0 : 576 * 8, nloc8 = nk * 64 * 8;
#define NA_STAGE(OFFS) do { int stid_ = tid; asm volatile("" : "+v"(stid_));     \
        NA_STAGE_PART(OFFS, 0, 7); __builtin_amdgcn_sched_barrier(0); NA_STAGE_PART(OFFS, 7, 13); __builtin_amdgcn_sched_barrier(0); } while (0)
#define NA_STAGE_PART(OFFS, K0, K1) do { u32x4 st_[13]; \
        _Pragma("unroll") for (int k_ = K0; k_ < K1; ++k_) { const int i_ = stid_ + kfirst + k_ * NT, key_ = i_ >> 3, ch_ = i_ & 7; const bool ok_ = (i_ < 832 * 8) && !(key_ < 576 && i_ >= nloc8); \
            const int grow_ = key_ < 576 ? b * SEQ + rbase * 64 + key_ : NLAT + b * CTX + (key_ - 576); \
            st_[k_] = ok_ ? *(const u32x4*)(PROJ + (size_t)grow_ * NPROJ + (OFFS) + h * 64 + ch_ * 8) : (u32x4){0u, 0u, 0u, 0u}; } \
        _Pragma("unroll") for (int k_ = K0; k_ < K1; ++k_) { const int i_ = stid_ + kfirst + k_ * NT, key_ = i_ >> 3, ch_ = i_ & 7; const bool ok_ = (i_ < 832 * 8) && !(key_ < 576 && i_ >= nloc8); \
            if (ok_) *(LAS u32x4*)(KV + key_ * NA_KS + ch_ * 16) = st_[k_]; } } while (0)
    __syncthreads();
    NA_STAGE(OFF_K);
    if (mode == 0 && tid < 465) rp[tid] = F.in[I_RPB][(size_t)(layer * 8 + h) * 465 + tid] * LOG2E;
    __syncthreads();
    int i = 0, j0 = 0, hs = 0, kr0 = 0, qrow;
    if (mode == 0) { i = 2 * m + (w >> 2); j0 = (w & 3) * 16; qrow = b * SEQ + i * 64 + j0; hs = j0 - 8; hs = hs < 0 ? 0 : (hs > 32 ? 32 : hs);
        int r0 = i - 4; r0 = r0 < 0 ? 0 : (r0 > 24 ? 24 : r0); kr0 = r0 - rbase; }
    else qrow = NLAT + b * CTX + m * 128 + w * 16;
    bf16x8 qf[2];
#pragma unroll
    for (int ks = 0; ks < 2; ++ks) qf[ks] = *(const bf16x8*)(PROJ + (size_t)(qrow + q16) * NPROJ + h * 64 + ks * 32 + g * 8);
    f32x4 S[32];
    const LAS unsigned char* kb = KV + q16 * NA_KS + g * 16;
    if (mode == 0) {
        const int j = j0 + q16; int cs = j - 8; cs = cs < 0 ? 0 : (cs > 48 ? 48 : cs);
        const int rb0 = (kr0 + rbase) - i + 7;
#pragma unroll
        for (int tl = 0; tl < 16; ++tl) { const int kr = tl >> 1, half = tl & 1; const int kidx0 = (kr0 + kr) * 64 + hs + 16 * half;
            f32x4 a = {0.f, 0.f, 0.f, 0.f};
#pragma unroll
            for (int ks = 0; ks < 2; ++ks) { const bf16x8 kf = *(const LAS bf16x8*)(kb + kidx0 * NA_KS + ks * 64); a = __builtin_amdgcn_mfma_f32_16x16x32_bf16(kf, qf[ks], a, 0, 0, 0); }
#pragma unroll
            for (int r = 0; r < 4; ++r) { const int kc = hs + 16 * half + 4 * g + r; const bool inw = (kc >= cs) && (kc < cs + 16);
                int cbi = kc - j + 15; cbi = cbi < 0 ? 0 : (cbi > 30 ? 30 : cbi);
                a[r] = inw ? a[r] * (0.125f * LOG2E) + rp[(rb0 + kr) * 31 + cbi] : -INFINITY; }
            S[tl] = a; if ((tl & 1) == 1) __builtin_amdgcn_sched_barrier(0); }
    } else {
#pragma unroll
        for (int tl = 0; tl < 16; ++tl) S[tl] = (f32x4){-INFINITY, -INFINITY, -INFINITY, -INFINITY};
    }
#pragma unroll
    for (int tc = 0; tc < 16; ++tc) { const int kidx0 = 576 + 16 * tc; f32x4 a = {0.f, 0.f, 0.f, 0.f};
#pragma unroll
        for (int ks = 0; ks < 2; ++ks) { const bf16x8 kf = *(const LAS bf16x8*)(kb + kidx0 * NA_KS + ks * 64); a = __builtin_amdgcn_mfma_f32_16x16x32_bf16(kf, qf[ks], a, 0, 0, 0); }
        S[16 + tc] = a * (0.125f * LOG2E); if ((tc & 1) == 1) __builtin_amdgcn_sched_barrier(0); }
    float mx = -INFINITY;
#pragma unroll
    for (int t = 0; t < 32; ++t) mx = fmaxf(fmaxf(fmaxf(S[t][0], S[t][1]), fmaxf(S[t][2], S[t][3])), mx);
    mx = fmaxf(mx, __shfl_xor(mx, 16)); mx = fmaxf(mx, __shfl_xor(mx, 32));
    float sum = 0.f; u32x4 P[16];
#pragma unroll
    for (int kk = 0; kk < 16; ++kk) { float e[8];
#pragma unroll
        for (int r = 0; r < 4; ++r) { e[r] = __builtin_amdgcn_exp2f(S[2 * kk][r] - mx); e[4 + r] = __builtin_amdgcn_exp2f(S[2 * kk + 1][r] - mx); }
        sum += ((e[0] + e[1]) + (e[2] + e[3])) + ((e[4] + e[5]) + (e[6] + e[7]));
        P[kk].x = pg8::cvt_pk_bf16_pin(e[0], e[1]); P[kk].y = pg8::cvt_pk_bf16_pin(e[2], e[3]); P[kk].z = pg8::cvt_pk_bf16_pin(e[4], e[5]); P[kk].w = pg8::cvt_pk_bf16_pin(e[6], e[7]); }
    sum += __shfl_xor(sum, 16); sum += __shfl_xor(sum, 32);
    const float inv = 1.0f / sum;
    __syncthreads();
    NA_STAGE(OFF_V);
    __syncthreads();
    f32x4 o[4];
#pragma unroll
    for (int dt = 0; dt < 4; ++dt) o[dt] = (f32x4){0.f, 0.f, 0.f, 0.f};
    const LAS unsigned char* vb = KV + (4 * g + (q16 >> 2)) * NA_KS + (q16 & 3) * 8;
#pragma unroll
    for (int kk = 0; kk < 16; ++kk) {
        if (kk < 8 && mode != 0) continue;
        const int kidx0 = (kk < 8) ? (kr0 + kk) * 64 + hs : 576 + 32 * (kk - 8);
        const bf16x8 pa = __builtin_bit_cast(bf16x8, P[kk]);
#pragma unroll
        for (int dt = 0; dt < 4; ++dt) { const s16x4 lo = lds_tr16(vb + kidx0 * NA_KS + dt * 32), hi = lds_tr16(vb + (kidx0 + 16) * NA_KS + dt * 32);
            const bf16x8 vf = {lo[0], lo[1], lo[2], lo[3], hi[0], hi[1], hi[2], hi[3]};
            o[dt] = __builtin_amdgcn_mfma_f32_16x16x32_bf16(pa, vf, o[dt], 0, 0, 0); }
    }
#undef NA_STAGE
#undef NA_STAGE_PART
#pragma unroll
    for (int r = 0; r < 4; ++r) { const float ir = __shfl(inv, 4 * g + r);
        bf16_t* op = MIX + (size_t)(qrow + 4 * g + r) * D + h * 64 + q16;
#pragma unroll
        for (int dt = 0; dt < 4; dt += 2) { const unsigned pw = pk2(o[dt][r] * ir, o[dt + 1][r] * ir); op[dt * 16] = (bf16_t)(pw & 0xffffu); op[dt * 16 + 16] = (bf16_t)(pw >> 16); } }
}

struct PrepassW { f32x4 w[5][2]; f32x4 b[2]; float ifq[8]; };
__device__ __forceinline__ void ssd_prepass_unit(const Frame& F, int u, const PrepassW& W) {
    const bf16_t* PROJ = (const bf16_t*)(F.ws + WS_PROJ); bf16_t* U = (bf16_t*)(F.ws + WS_U);
    int rowbase, t0, L; bool lat;
    if (u < NLAT / 16) { rowbase = (u >> 7) * SEQ; t0 = (u & 127) * 16; L = SEQ; lat = true; }
    else { const int v = u - NLAT / 16; rowbase = NLAT + (v >> 4) * CTX; t0 = (v & 15) * 16; L = CTX; lat = false; }
    const int cg = F.tid & 127, tq = F.tid >> 7, c0 = 8 * cg, tb = t0 + 4 * tq;
    u32x4 win[8];
#pragma unroll
    for (int j = 0; j < 8; ++j) { const int t = tb - 2 + j; win[j] = (t >= 0 && t < L) ? *(const u32x4*)(PROJ + (size_t)(rowbase + t) * NPROJ + OFF_XBC + c0) : (u32x4){0u, 0u, 0u, 0u}; }
    const int lc = c0 & 127, hf = lc >> 6, role = (lc >> 5) & 1; const bool rope = lat && (c0 >= 512);
#pragma unroll
    for (int tt = 0; tt < 4; ++tt) {
        f32x4 a0 = W.b[0], a1 = W.b[1];
#pragma unroll
        for (int j = 0; j < 5; ++j) { const u32x4 r = win[tt + j];
            a0 += W.w[j][0] * (f32x4){bflo(r.x), bfhi(r.x), bflo(r.y), bfhi(r.y)}; a1 += W.w[j][1] * (f32x4){bflo(r.z), bfhi(r.z), bflo(r.w), bfhi(r.w)}; }
        float uu[8];
#pragma unroll
        for (int k = 0; k < 4; ++k) { uu[k] = silu_f(a0[k]); uu[4 + k] = silu_f(a1[k]); }
        if (rope) {
            const int tk = tb + tt; const float pos = (float)(hf ? (tk & 63) : (tk >> 6));
#pragma unroll
            for (int k = 0; k < 8; ++k) { const float o = __shfl_xor(uu[k], 4); const float sn = __builtin_amdgcn_sinf(pos * W.ifq[k]), cs = __builtin_amdgcn_cosf(pos * W.ifq[k]);
                uu[k] = role ? (o * sn + uu[k] * cs) : (uu[k] * cs - o * sn); }
        }
        u32x4 o; o.x = pk2(uu[0], uu[1]); o.y = pk2(uu[2], uu[3]); o.z = pk2(uu[4], uu[5]); o.w = pk2(uu[6], uu[7]);
        *(u32x4*)(U + (size_t)(rowbase + tb + tt) * 1024 + c0) = o;
    }
}
__device__ __forceinline__ void ssd_prepass_weights(const Frame& F, int layer, PrepassW& W) {
    const int c0 = 8 * (F.tid & 127);
    const float* cwp = F.in[I_CONVW] + (size_t)layer * 5 * 1024 + c0;
#pragma unroll
    for (int j = 0; j < 5; ++j) { W.w[j][0] = *(const f32x4*)(cwp + j * 1024); W.w[j][1] = *(const f32x4*)(cwp + j * 1024 + 4); }
    W.b[0] = *(const f32x4*)(F.in[I_CONVB] + (size_t)layer * 1024 + c0); W.b[1] = *(const f32x4*)(F.in[I_CONVB] + (size_t)layer * 1024 + c0 + 4);
    const int n0 = c0 & 31;
#pragma unroll
    for (int k = 0; k < 8; ++k) W.ifq[k] = __builtin_amdgcn_exp2f(-(float)(n0 + k) * (13.287712379549449f / 32.0f)) * 0.15915494309189535f;
}

constexpr int S_CQ = 0, S_BQ = 17408, S_XN = 34816, S_XW = 44032, S_OPS = 53248, S_HB = 2 * S_OPS, S_MISC = S_HB + 2 * 17408, S_END = S_MISC + 3 * 1088;
static_assert(S_END <= LDS_ROWOFF + 18432, "SSD LDS image must stay below the control words");
__device__ __forceinline__ void ssd_chunk_compute(const LAS unsigned char* O, const LAS float* misc, const LAS unsigned char* HB, LAS unsigned char* HN, f32x4 (&Hacc)[4],
                                                  bf16_t* yp, int w, int q16, int gq, bool skip, float dsk) {
    const int lt = w >> 1, t2 = (w & 1) * 2;
    bf16x8 cfr[4];
#pragma unroll
    for (int ks = 0; ks < 4; ++ks) cfr[ks] = *(const LAS bf16x8*)(O + S_CQ + (16 * lt + q16) * 272 + ks * 64 + gq * 16);
    u32x4 pm[2];
    {
        const float csl = misc[64 + 16 * lt + q16];
#pragma unroll
        for (int pr = 0; pr < 2; ++pr) {
            f32x4 v[2];
#pragma unroll
            for (int hh = 0; hh < 2; ++hh) { const int st = 2 * pr + hh; f32x4 a = {0.f, 0.f, 0.f, 0.f};
                if (st <= lt) {
#pragma unroll
                    for (int ks = 0; ks < 4; ++ks) { const bf16x8 bfr = *(const LAS bf16x8*)(O + S_BQ + (16 * st + q16) * 272 + ks * 64 + gq * 16); a = __builtin_amdgcn_mfma_f32_16x16x32_bf16(bfr, cfr[ks], a, 0, 0, 0); }
                    const f32x4 css = *(const LAS f32x4*)(misc + 64 + 16 * st + 4 * gq), dts = *(const LAS f32x4*)(misc + 16 * st + 4 * gq);
#pragma unroll
                    for (int r = 0; r < 4; ++r) { const int sidx = 16 * st + 4 * gq + r; a[r] = (sidx <= 16 * lt + q16) ? a[r] * __expf(csl - css[r]) * dts[r] : 0.f; }
                }
                v[hh] = a; }
            pm[pr].x = pk2(v[0][0], v[0][1]); pm[pr].y = pk2(v[0][2], v[0][3]); pm[pr].z = pk2(v[1][0], v[1][1]); pm[pr].w = pk2(v[1][2], v[1][3]);
        }
    }
    {
        const float ecs = misc[128 + 16 * lt + q16];
        const LAS unsigned char* xtr = O + S_XN + (4 * gq + (q16 >> 2)) * 144 + (q16 & 3) * 8;
#pragma unroll
        for (int k = 0; k < 2; ++k) { const int pt = t2 + k; f32x4 a = {0.f, 0.f, 0.f, 0.f};
#pragma unroll
            for (int ks = 0; ks < 4; ++ks) { const bf16x8 hfr = *(const LAS bf16x8*)(HB + (16 * pt + q16) * 272 + ks * 64 + gq * 16); a = __builtin_amdgcn_mfma_f32_16x16x32_bf16(hfr, cfr[ks], a, 0, 0, 0); }
            a = a * ecs;
#pragma unroll
            for (int pr = 0; pr < 2; ++pr) if (2 * pr <= lt) { const s16x4 lo = lds_tr16(xtr + (32 * pr) * 144 + pt * 32), hi = lds_tr16(xtr + (32 * pr + 16) * 144 + pt * 32);
                const bf16x8 xf = {lo[0], lo[1], lo[2], lo[3], hi[0], hi[1], hi[2], hi[3]};
                a = __builtin_amdgcn_mfma_f32_16x16x32_bf16(xf, __builtin_bit_cast(bf16x8, pm[pr]), a, 0, 0, 0); }
            if (skip) { const u32x2 xv = *(const LAS u32x2*)(O + S_XN + (16 * lt + q16) * 144 + (16 * pt + 4 * gq) * 2);
                a[0] += dsk * bflo(xv.x); a[1] += dsk * bfhi(xv.x); a[2] += dsk * bflo(xv.y); a[3] += dsk * bfhi(xv.y); }
            { u32x2 ow; ow.x = pk2(a[0], a[1]); ow.y = pk2(a[2], a[3]); *(u32x2*)(yp + 16 * pt + 4 * gq) = ow; } }
    }
    {
        const int pt2 = w & 3, nb = (w >> 2) * 4; const float et = misc[256];
        const LAS unsigned char* xwtr = O + S_XW + (4 * gq + (q16 >> 2)) * 144 + (q16 & 3) * 8 + pt2 * 32;
        const LAS unsigned char* btr = O + S_BQ + (4 * gq + (q16 >> 2)) * 272 + (q16 & 3) * 8;
        bf16x8 xf2[2];
#pragma unroll
        for (int kk = 0; kk < 2; ++kk) { const s16x4 lo = lds_tr16(xwtr + (32 * kk) * 144), hi = lds_tr16(xwtr + (32 * kk + 16) * 144); xf2[kk] = (bf16x8){lo[0], lo[1], lo[2], lo[3], hi[0], hi[1], hi[2], hi[3]}; }
#pragma unroll
        for (int j = 0; j < 4; ++j) { const int nt = nb + j; Hacc[j] = Hacc[j] * et;
#pragma unroll
            for (int kk = 0; kk < 2; ++kk) { const s16x4 lo = lds_tr16(btr + (32 * kk) * 272 + nt * 32), hi = lds_tr16(btr + (32 * kk + 16) * 272 + nt * 32);
                const bf16x8 bT = {lo[0], lo[1], lo[2], lo[3], hi[0], hi[1], hi[2], hi[3]};
                Hacc[j] = __builtin_amdgcn_mfma_f32_16x16x32_bf16(bT, xf2[kk], Hacc[j], 0, 0, 0); }
            u32x2 hw; hw.x = pk2(Hacc[j][0], Hacc[j][1]); hw.y = pk2(Hacc[j][2], Hacc[j][3]);
            *(LAS u32x2*)(HN + (16 * pt2 + q16) * 272 + (16 * nt + 4 * gq) * 2) = hw; }
    }
}
struct SsdPre { u32x4 x, b[2], c[2]; float dt; };
__device__ __forceinline__ void ssd_mfma_unit(const Frame& F, int layer, int b, int h, int dir) {
    const int g = h >> 2, tid = F.tid, lane = F.lane, w = F.wave, q16 = lane & 15, gq = lane >> 4;
    const bf16_t* U = (const bf16_t*)(F.ws + WS_U); const float* DTS = (const float*)(F.ws + WS_DT);
    bf16_t* Y = (bf16_t*)(F.ws + (dir ? WS_YB : WS_YF));
    const float aneg = -__expf(F.in[I_ALOG][layer * 16 + dir * 8 + h]), dsk = F.in[I_DSKIP][layer * 8 + h];
    LAS unsigned char* L = F.lds;
    __syncthreads();
    for (int i = tid; i < 64 * 272 / 16; i += NT) *(LAS u32x4*)(L + S_HB + i * 16) = (u32x4){0u, 0u, 0u, 0u};
    f32x4 Hacc[4];
#pragma unroll
    for (int j = 0; j < 4; ++j) Hacc[j] = (f32x4){0.f, 0.f, 0.f, 0.f};
    SsdPre P0, P1;
    P0.dt = 0.f; P1.dt = 0.f;
    const int xt = tid >> 3, xp = tid & 7;
    const int bt = tid >> 4, bp = tid & 15;
#define SSD_ROW(ci_, l_) ({ const int s_ = (ci_) < 4 ? 0 : 1, k_ = s_ ? (ci_) - 4 : (ci_), nc_ = s_ ? 32 : 4, c_ = dir ? nc_ - 1 - k_ : k_; \
        (s_ ? b * SEQ : NLAT + b * CTX) + c_ * 64 + (dir ? 63 - (l_) : (l_)); })
#define SSD_PREFETCH(ci_, P_) do { P_.x = *(const u32x4*)(U + (size_t)SSD_ROW(ci_, xt) * 1024 + h * 64 + xp * 8); \
        if (w == 0) P_.dt = DTS[(size_t)SSD_ROW(ci_, lane) * 16 + dir * 8 + h]; \
        _Pragma("unroll") for (int j2_ = 0; j2_ < 2; ++j2_) { const int tok_ = bt + 32 * j2_; const size_t ro_ = (size_t)SSD_ROW(ci_, tok_) * 1024; \
            P_.b[j2_] = *(const u32x4*)(U + ro_ + 512 + g * 128 + bp * 8); P_.c[j2_] = *(const u32x4*)(U + ro_ + 768 + g * 128 + bp * 8); } } while (0)
#define SSD_MISC(slot_, P_) do { LAS float* m_ = (LAS float*)(L + S_MISC) + (slot_) * 272; const float dt_ = P_.dt; const float cs_ = wave_scan(dt_ * aneg); \
        const float tot_ = __builtin_bit_cast(float, __builtin_amdgcn_readlane(__builtin_bit_cast(int, cs_), 63)); \
        m_[lane] = dt_; m_[64 + lane] = cs_; m_[128 + lane] = __expf(cs_); m_[192 + lane] = __expf(tot_ - cs_) * dt_; if (lane == 0) m_[256] = __expf(tot_); } while (0)
#define SSD_STAGE(set_, slot_, P_) do { LAS unsigned char* O_ = L + (set_) * S_OPS; const float wl = ((const LAS float*)(L + S_MISC))[(slot_) * 272 + 192 + xt]; \
        *(LAS u32x4*)(O_ + S_XN + xt * 144 + xp * 16) = P_.x; \
        u32x4 xw; xw.x = pk2(bflo(P_.x.x) * wl, bfhi(P_.x.x) * wl); xw.y = pk2(bflo(P_.x.y) * wl, bfhi(P_.x.y) * wl); xw.z = pk2(bflo(P_.x.z) * wl, bfhi(P_.x.z) * wl); xw.w = pk2(bflo(P_.x.w) * wl, bfhi(P_.x.w) * wl); \
        *(LAS u32x4*)(O_ + S_XW + xt * 144 + xp * 16) = xw; \
        _Pragma("unroll") for (int k = 0; k < 2; ++k) { *(LAS u32x4*)(O_ + S_BQ + (bt + 32 * k) * 272 + bp * 16) = P_.b[k]; *(LAS u32x4*)(O_ + S_CQ + (bt + 32 * k) * 272 + bp * 16) = P_.c[k]; } } while (0)
#define SSD_ITER(ci_, PN_, PC_) do { const int ci = (ci_); const int ms1 = ms == 2 ? 0 : ms + 1, ms2 = ms1 == 2 ? 0 : ms1 + 1; \
        if (ci + 1 < 36) SSD_STAGE(cur ^ 1, ms1, PN_); \
        if (ci + 3 < 36) SSD_PREFETCH(ci + 3, PN_); \
        TPS(0); \
        { const int row0 = SSD_ROW(ci, 16 * (w >> 1) + q16); \
          ssd_chunk_compute(L + cur * S_OPS, (const LAS float*)(L + S_MISC) + ms * 272, L + S_HB + cur * 17408, L + S_HB + (cur ^ 1) * 17408, Hacc, Y + (size_t)row0 * 512 + h * 64, w, q16, gq, dir == 0, dsk); } \
        TPS(2); \
        if (w == 0 && ci + 2 < 36) SSD_MISC(ms2, PC_); \
        __syncthreads(); \
        TPS(3); \
        cur ^= 1; ms = ms1; } while (0)
    SSD_PREFETCH(0, P0);
    if (w == 0) SSD_MISC(0, P0);
    __syncthreads();
    SSD_STAGE(0, 0, P0);
    SSD_PREFETCH(1, P1);
    SSD_PREFETCH(2, P0);
    if (w == 0) SSD_MISC(1, P1);
    __syncthreads();
    TPS_BEGIN;
    int cur = 0, ms = 0;
    for (int c2 = 0; c2 < 36; c2 += 2) { SSD_ITER(c2, P1, P0); SSD_ITER(c2 + 1, P0, P1); }
#undef SSD_ROW
#undef SSD_PREFETCH
#undef SSD_MISC
#undef SSD_STAGE
#undef SSD_ITER
}

__device__ __forceinline__ void na_run(const Frame& F, int layer) {
    LAS unsigned char* KV = F.lds; LAS float* rp = (LAS float*)(F.lds + 120832);
    const bf16_t* PROJ = (const bf16_t*)(F.ws + WS_PROJ); bf16_t* MIX = (bf16_t*)(F.ws + WS_MIX);
    const int tid = F.tid, lane = F.lane, w = F.wave, q16 = lane & 15, g = lane >> 4;
    u32x4 pre[13];
#define NA_VPRE 13
#define NA_RB(m_) ({ int rb_ = 2 * (m_) - 4; rb_ = rb_ < 0 ? 0 : (rb_ > 24 ? 24 : rb_); __builtin_amdgcn_readfirstlane(rb_); })
#define NA_NL(rb_) ({ int nk_ = 32 - (rb_); nk_ = nk_ > 9 ? 9 : nk_; __builtin_amdgcn_readfirstlane(nk_ * 64 * 8); })
#define NA_LOAD(OFFS, b_, h_, rb_, nl_, K0, K1) do { int stid_ = tid; asm volatile("" : "+v"(stid_)); \
        _Pragma("unroll") for (int k_ = K0; k_ < K1; ++k_) { const int i_ = stid_ + k_ * NT, key_ = i_ >> 3, ch_ = i_ & 7; const bool ok_ = !(key_ < 576 && i_ >= (nl_)); \
            const int grow_ = key_ < 576 ? (b_) * SEQ + (rb_) * 64 + key_ : NLAT + (b_) * CTX + (key_ - 576); \
            pre[k_] = ok_ ? *(const u32x4*)(PROJ + (size_t)grow_ * NPROJ + (OFFS) + (h_) * 64 + ch_ * 8) : (u32x4){0u, 0u, 0u, 0u}; } } while (0)
#define NA_WRITE(nl_, K0, K1) do { int stid_ = tid; asm volatile("" : "+v"(stid_)); \
        _Pragma("unroll") for (int k_ = K0; k_ < K1; ++k_) { const int i_ = stid_ + k_ * NT, key_ = i_ >> 3, ch_ = i_ & 7; const bool ok_ = !(key_ < 576 && i_ >= (nl_)); \
            if (ok_) *(LAS u32x4*)(KV + key_ * NA_KS + ch_ * 16) = pre[k_]; } } while (0)
    int u = __builtin_amdgcn_readfirstlane(F.bid);
    if (u < 2048) { const int b = u >> 7, h = (u >> 4) & 7, m = u & 15, rb = NA_RB(m); NA_LOAD(OFF_K, b, h, rb, NA_NL(rb), 0, 13); }
    for (; u < 2048; u += F.G) {
        const int b = u >> 7, h = (u >> 4) & 7, m = u & 15, rbase = NA_RB(m), nloc8 = NA_NL(rbase);
        __syncthreads();
        NA_WRITE(nloc8, 0, 13);
        if (tid < 465) rp[tid] = F.in[I_RPB][(size_t)(layer * 8 + h) * 465 + tid] * LOG2E;
        NA_LOAD(OFF_V, b, h, rbase, nloc8, 0, NA_VPRE);
        __syncthreads();
        const int i = 2 * m + (w >> 2), j0 = (w & 3) * 16, qrow = b * SEQ + i * 64 + j0; int hs = j0 - 8; hs = hs < 0 ? 0 : (hs > 32 ? 32 : hs);
        int r0 = i - 4; r0 = r0 < 0 ? 0 : (r0 > 24 ? 24 : r0); const int kr0 = r0 - rbase;
        bf16x8 qf[2];
#pragma unroll
        for (int ks = 0; ks < 2; ++ks) qf[ks] = *(const bf16x8*)(PROJ + (size_t)(qrow + q16) * NPROJ + h * 64 + ks * 32 + g * 8);
        f32x4 S[32];
        const LAS unsigned char* kb = KV + q16 * NA_KS + g * 16;
        { const int j = j0 + q16; int cs = j - 8; cs = cs < 0 ? 0 : (cs > 48 ? 48 : cs);
          const int rb0 = (kr0 + rbase) - i + 7;
#pragma unroll
          for (int tl = 0; tl < 16; ++tl) { const int kr = tl >> 1, half = tl & 1; const int kidx0 = (kr0 + kr) * 64 + hs + 16 * half;
              f32x4 a = {0.f, 0.f, 0.f, 0.f};
#pragma unroll
              for (int ks = 0; ks < 2; ++ks) { const bf16x8 kf = *(const LAS bf16x8*)(kb + kidx0 * NA_KS + ks * 64); a = __builtin_amdgcn_mfma_f32_16x16x32_bf16(kf, qf[ks], a, 0, 0, 0); }
#pragma unroll
              for (int r = 0; r < 4; ++r) { const int kc = hs + 16 * half + 4 * g + r; const bool inw = (kc >= cs) && (kc < cs + 16);
                  int cbi = kc - j + 15; cbi = cbi < 0 ? 0 : (cbi > 30 ? 30 : cbi);
                  a[r] = inw ? a[r] * (0.125f * LOG2E) + rp[(rb0 + kr) * 31 + cbi] : -INFINITY; }
              S[tl] = a; if ((tl & 1) == 1) __builtin_amdgcn_sched_barrier(0); } }
#pragma unroll
        for (int tc = 0; tc < 16; ++tc) { const int kidx0 = 576 + 16 * tc; f32x4 a = {0.f, 0.f, 0.f, 0.f};
#pragma unroll
            for (int ks = 0; ks < 2; ++ks) { const bf16x8 kf = *(const LAS bf16x8*)(kb + kidx0 * NA_KS + ks * 64); a = __builtin_amdgcn_mfma_f32_16x16x32_bf16(kf, qf[ks], a, 0, 0, 0); }
            S[16 + tc] = a * (0.125f * LOG2E); if ((tc & 1) == 1) __builtin_amdgcn_sched_barrier(0); }
        float mx = -INFINITY;
#pragma unroll
        for (int t = 0; t < 32; ++t) mx = fmaxf(fmaxf(fmaxf(S[t][0], S[t][1]), fmaxf(S[t][2], S[t][3])), mx);
        mx = fmaxf(mx, __shfl_xor(mx, 16)); mx = fmaxf(mx, __shfl_xor(mx, 32));
        float sum = 0.f; u32x4 P[16];
#pragma unroll
        for (int kk = 0; kk < 16; ++kk) { float e[8];
#pragma unroll
            for (int r = 0; r < 4; ++r) { e[r] = __builtin_amdgcn_exp2f(S[2 * kk][r] - mx); e[4 + r] = __builtin_amdgcn_exp2f(S[2 * kk + 1][r] - mx); }
            sum += ((e[0] + e[1]) + (e[2] + e[3])) + ((e[4] + e[5]) + (e[6] + e[7]));
            P[kk].x = pg8::cvt_pk_bf16_pin(e[0], e[1]); P[kk].y = pg8::cvt_pk_bf16_pin(e[2], e[3]); P[kk].z = pg8::cvt_pk_bf16_pin(e[4], e[5]); P[kk].w = pg8::cvt_pk_bf16_pin(e[6], e[7]); }
        sum += __shfl_xor(sum, 16); sum += __shfl_xor(sum, 32);
        const float inv = 1.0f / sum;
        __syncthreads();
        NA_WRITE(nloc8, 0, NA_VPRE); NA_LOAD(OFF_V, b, h, rbase, nloc8, NA_VPRE, 13); NA_WRITE(nloc8, NA_VPRE, 13);
        { const int un = u + F.G; if (un < 2048) { const int bn = un >> 7, hn = (un >> 4) & 7, mn = un & 15, rbn = NA_RB(mn); NA_LOAD(OFF_K, bn, hn, rbn, NA_NL(rbn), 0, 13); } }
        __syncthreads();
        f32x4 o[4];
#pragma unroll
        for (int dt = 0; dt < 4; ++dt) o[dt] = (f32x4){0.f, 0.f, 0.f, 0.f};
        const LAS unsigned char* vb = KV + (4 * g + (q16 >> 2)) * NA_KS + (q16 & 3) * 8;
#pragma unroll
        for (int kk = 0; kk < 16; ++kk) {
            const int kidx0 = (kk < 8) ? (kr0 + kk) * 64 + hs : 576 + 32 * (kk - 8);
            const bf16x8 pa = __builtin_bit_cast(bf16x8, P[kk]);
#pragma unroll
            for (int dt = 0; dt < 4; ++dt) { const s16x4 lo = lds_tr16(vb + kidx0 * NA_KS + dt * 32), hi = lds_tr16(vb + (kidx0 + 16) * NA_KS + dt * 32);
                const bf16x8 vf = {lo[0], lo[1], lo[2], lo[3], hi[0], hi[1], hi[2], hi[3]};
                o[dt] = __builtin_amdgcn_mfma_f32_16x16x32_bf16(pa, vf, o[dt], 0, 0, 0); }
            if ((kk & 1) == 1) __builtin_amdgcn_sched_barrier(0);
        }
#pragma unroll
        for (int r = 0; r < 4; ++r) { const float ir = __shfl(inv, 4 * g + r);
            bf16_t* op = MIX + (size_t)(qrow + 4 * g + r) * D + h * 64 + q16;
#pragma unroll
            for (int dt = 0; dt < 4; dt += 2) { const unsigned pw = pk2(o[dt][r] * ir, o[dt + 1][r] * ir); op[dt * 16] = (bf16_t)(pw & 0xffffu); op[dt * 16 + 16] = (bf16_t)(pw >> 16); } }
    }
#undef NA_RB
#undef NA_NL
#undef NA_LOAD
#undef NA_WRITE
}
__device__ __forceinline__ void p_mixa(const Frame& F, int layer, bool last) {
    { PrepassW W; ssd_prepass_weights(F, layer, W);
      for (int u = F.bid; u < NTOK / 16; u += F.G) ssd_prepass_unit(F, u, W); }
    na_run(F, layer);
    if (!last) for (int u = F.bid; u < 256; u += F.G) na_unit(F, layer, u >> 4, (u >> 1) & 7, 1, u & 1);
}
__device__ __forceinline__ void p_mixb(const Frame& F, int layer) {
    for (int u0 = F.bid; u0 < 256 * REP_SSD; u0 += F.G) { const int u = u0 & 255; ssd_mfma_unit(F, layer, u >> 4, (u >> 1) & 7, u & 1); }
}

__device__ __forceinline__ void p_ssdcomb(const Frame& F, int layer, bool last) {
    const bf16_t* PROJ = (const bf16_t*)(F.ws + WS_PROJ); bf16_t* MIX = (bf16_t*)(F.ws + WS_MIX);
    const bf16_t* YF = (const bf16_t*)(F.ws + WS_YF); const bf16_t* YB = (const bf16_t*)(F.ws + WS_YB);
    const float* nw = F.in[I_NORMW] + layer * 512 + F.lane * 8;
    const f32x4 nw0 = *(const f32x4*)nw, nw1 = *(const f32x4*)(nw + 4);
    const int nrows = last ? NLAT : NTOK;
    u32x4 pyf = {0u, 0u, 0u, 0u}, pyb = pyf, pz = pyf;
#define SC_LOAD(r_) do { const size_t o_ = (size_t)(r_) * 512 + F.lane * 8; pyf = *(const u32x4*)(YF + o_); pyb = *(const u32x4*)(YB + o_); \
        pz = *(const u32x4*)(PROJ + (size_t)(r_) * NPROJ + OFF_Z + F.lane * 8); } while (0)
    if (F.gw < nrows) SC_LOAD(F.gw);
    for (int row = F.gw; row < nrows; row += F.NGW) {
        const f32x4 a0 = {bflo(pyf.x) + bflo(pyb.x), bfhi(pyf.x) + bfhi(pyb.x), bflo(pyf.y) + bflo(pyb.y), bfhi(pyf.y) + bfhi(pyb.y)}, a1 = {bflo(pyf.z) + bflo(pyb.z), bfhi(pyf.z) + bfhi(pyb.z), bflo(pyf.w) + bflo(pyb.w), bfhi(pyf.w) + bfhi(pyb.w)}; const u32x4 zv = pz;
        if (row + F.NGW < nrows) SC_LOAD(row + F.NGW);
        float y[8] = {a0[0] * silu_f(bflo(zv.x)), a0[1] * silu_f(bfhi(zv.x)), a0[2] * silu_f(bflo(zv.y)), a0[3] * silu_f(bfhi(zv.y)),
                      a1[0] * silu_f(bflo(zv.z)), a1[1] * silu_f(bfhi(zv.z)), a1[2] * silu_f(bflo(zv.w)), a1[3] * silu_f(bfhi(zv.w))};
        float ss = 0.f;
#pragma unroll
        for (int k = 0; k < 8; ++k) ss += y[k] * y[k];
#pragma unroll
        for (int of = 1; of < 32; of <<= 1) ss += __shfl_xor(ss, of);
        const float rs = 1.0f / sqrtf(ss * (1.0f / 256.0f) + RMS_EPS);
        u32x4 w; w.x = pk2(y[0] * rs * nw0[0], y[1] * rs * nw0[1]); w.y = pk2(y[2] * rs * nw0[2], y[3] * rs * nw0[3]);
        w.z = pk2(y[4] * rs * nw1[0], y[5] * rs * nw1[1]); w.w = pk2(y[6] * rs * nw1[2], y[7] * rs * nw1[3]);
        *(u32x4*)(MIX + (size_t)row * D + 512 + F.lane * 8) = w;
    }
}

__device__ __forceinline__ void p_outproj(const Frame& F, int layer, bool last) {
    pg8::Gemm g{(const bf16_t*)(F.ws + WS_MIX), (const bf16_t*)(F.ws + WS_WOUT) + (size_t)layer * D * D, D};
    pg8::DenseOrder S; S.init(last ? NLAT : NTOK, D, D, F.G, F.bid);
    pg8::EpiGate E{(bf16_t*)(F.ws + WS_DELTA1), (const float*)(F.ws + WS_MOD) + (size_t)layer * 17 * MODW, 2 * D};
    pg8::gemm_phase<pg8::EpiGate, pg8::DenseOrder, true, true>(F.lds, g, S, E, F.tid);
    if (layer == 0) deferred_conv(F, (NTOK / 256) * (D / 256), DW_L0_OUT, DW_Q); else if (layer == 1) deferred_conv(F, (NTOK / 256) * (D / 256), DW_L1_OUT, DW_Q);
}

__device__ __forceinline__ unsigned* cnt_word(const Frame& F, int slot, int hf, int e) { return (unsigned*)(F.ws + WS_CTL) + CW_CNT + ((slot * 2 + hf) * 8 + e) * 64; }
__device__ __forceinline__ void p_ln1(const Frame& F, int layer, bool last) {
    bf16_t* X = (bf16_t*)(F.ws + WS_X); bf16_t* H = (bf16_t*)(F.ws + WS_H);
    const float* MOD = (const float*)(F.ws + WS_MOD) + (size_t)layer * 17 * MODW;
    const float* lg = F.in[I_LNG] + (size_t)(layer * 2) * D; const float* lb = F.in[I_LNB] + (size_t)(layer * 2) * D;
    const bool moe = layer & 1; const int slot = layer >> 1;
    const int nrows = last ? NLAT : NTOK;
    float rw[16][8];
    if (moe) { const float* R = F.in[I_RW] + (size_t)slot * D * 8;
#pragma unroll
        for (int j = 0; j < 4; ++j)
#pragma unroll
            for (int k = 0; k < 4; ++k) { const int lane = F.lane; const f32x4 a = *(const f32x4*)(R + (size_t)(RIDX(j) + k) * 8), b2 = *(const f32x4*)(R + (size_t)(RIDX(j) + k) * 8 + 4);
                rw[j * 4 + k][0] = a[0]; rw[j * 4 + k][1] = a[1]; rw[j * 4 + k][2] = a[2]; rw[j * 4 + k][3] = a[3]; rw[j * 4 + k][4] = b2[0]; rw[j * 4 + k][5] = b2[1]; rw[j * 4 + k][6] = b2[2]; rw[j * 4 + k][7] = b2[3]; } }
    int nrec = 0;
    if (moe) { __syncthreads(); if (F.tid < 32) ((LAS unsigned*)F.lds)[F.tid] = 0u; __syncthreads(); }
    const bf16_t* DL = (const bf16_t*)(F.ws + WS_DELTA1);
    RowRaw r0 = {}, r1 = {};
    if (F.gw < nrows) row_issue<true>(X, DL, F.gw, F.lane, r0);
    if (F.gw + F.NGW < nrows) row_issue<true>(X, DL, F.gw + F.NGW, F.lane, r1);
    for (int row = F.gw; row < nrows; row += F.NGW) {
        f32x4 v[4], hv[4];
        row_combine(r0, v); r0 = r1;
        if (row + 2 * F.NGW < nrows) row_issue<true>(X, DL, row + 2 * F.NGW, F.lane, r1);
        row_ln(v, lg, lb, F.lane);
        row_store_h(X + (size_t)row * D, F.lane, v);
        const float* m = MOD + (size_t)mod_row_of(row) * MODW;
        if (USE_FP8 && (moe || FP8_DENSE1)) row_mod_store8((unsigned char*)H + (size_t)row * D, F.lane, v, m + 3 * D, m + 4 * D, hv);
        else row_mod_store(H + (size_t)row * D, F.lane, v, m + 3 * D, m + 4 * D, hv);
        if (moe) {
            float lg8[8];
#pragma unroll
            for (int e = 0; e < 8; ++e) { float s = 0.f;
#pragma unroll
                for (int j = 0; j < 4; ++j)
#pragma unroll
                    for (int k = 0; k < 4; ++k) s += hv[j][k] * rw[j * 4 + k][e];
                lg8[e] = wave_sum(s); }
            int e0 = 0; float v0 = lg8[0];
#pragma unroll
            for (int e = 1; e < 8; ++e) if (lg8[e] > v0) { v0 = lg8[e]; e0 = e; }
            int e1 = -1; float v1 = -INFINITY;
#pragma unroll
            for (int e = 0; e < 8; ++e) if (e != e0 && lg8[e] > v1) { v1 = lg8[e]; e1 = e; }
            if (F.lane == 0) {
                const unsigned s0 = __hip_atomic_fetch_add((LAS unsigned*)F.lds + e0, 1u, __ATOMIC_RELAXED, __HIP_MEMORY_SCOPE_WORKGROUP), s1 = __hip_atomic_fetch_add((LAS unsigned*)F.lds + e1, 1u, __ATOMIC_RELAXED, __HIP_MEMORY_SCOPE_WORKGROUP);
                const float ex = __expf(v1 - v0), g0 = 1.0f / (1.0f + ex);
                ((LAS u32x4*)(F.lds + 256))[F.wave * 32 + nrec] = (u32x4){(unsigned)e0 | ((unsigned)e1 << 8), s0, s1, (unsigned)row};
                *(f32x2*)(F.ws + WS_GATES + (size_t)row * 8) = (f32x2){g0, ex * g0};
            }
            ++nrec;
        }
    }
    if (moe) {
        __syncthreads();
        if (F.tid < 8) ((LAS unsigned*)F.lds)[16 + F.tid] = atomicAdd(cnt_word(F, slot, 0, F.tid), ((LAS unsigned*)F.lds)[F.tid]);
        __syncthreads();
        int* list = (int*)(F.ws + WS_LIST);
        if (F.lane < nrec) { const u32x4 rc = ((LAS u32x4*)(F.lds + 256))[F.wave * 32 + F.lane]; const int e0 = rc.x & 255, e1 = (rc.x >> 8) & 255; const int row = (int)rc.w;
            const unsigned s0 = ((LAS unsigned*)F.lds)[16 + e0] + rc.y, s1 = ((LAS unsigned*)F.lds)[16 + e1] + rc.z;
            list[e0 * NTOK + s0] = row; list[e1 * NTOK + s1] = row;
            *(u32x4*)(F.ws + WS_ROUTE + (size_t)row * 16) = (u32x4){rc.x, s0, s1, 0u}; }
    }
}

__device__ __forceinline__ void p_ffn1_dense(const Frame& F, int layer, bool last) {
    const int s = layer >> 1;
#if USE_FP8 && FP8_DENSE2
    typedef pg8::EpiSwiGLU8 EpiH; EpiH E{F.ws + WS_HID, DFF};
#else
    typedef pg8::EpiSwiGLU EpiH; EpiH E{(bf16_t*)(F.ws + WS_HID), DFF};
#endif
#if USE_FP8 && FP8_DENSE1
    pg8::Gemm g{(const bf16_t*)(F.ws + WS_H), (const bf16_t*)(F.ws + WS_WFGU + (size_t)s * 2 * DFF * D), D / 2};
    pg8::DenseOrder S; S.init(last ? NLAT : NTOK, 2 * DFF, D / 2, F.G, F.bid, REP_GEMM);
    pg8::gemm_phase<EpiH, pg8::DenseOrder, true, FP8_SP2, true>(F.lds, g, S, E, F.tid, (127 - S8_WGU) * 0x01010101, (127 - S8_ACT) * 0x01010101);
#else
    pg8::Gemm g{(const bf16_t*)(F.ws + WS_H), (const bf16_t*)(F.ws + WS_WFGU) + (size_t)s * 2 * DFF * D, D};
    pg8::DenseOrder S; S.init(last ? NLAT : NTOK, 2 * DFF, D, F.G, F.bid, REP_GEMM);
    pg8::gemm_phase<EpiH, pg8::DenseOrder, true, true>(F.lds, g, S, E, F.tid);
#endif
    if (layer == 0) deferred_conv(F, (NTOK / 256) * (2 * DFF / 256), DW_L0_F1, DW_Q);
}
__device__ __forceinline__ void p_ffn2_dense(const Frame& F, int layer, bool last) {
    const int s = layer >> 1;
    pg8::EpiGate E{(bf16_t*)(F.ws + WS_DELTA2), (const float*)(F.ws + WS_MOD) + (size_t)layer * 17 * MODW, 5 * D};
#if USE_FP8 && FP8_DENSE2
    pg8::Gemm g{(const bf16_t*)(F.ws + WS_HID), (const bf16_t*)(F.ws + WS_WFD + (size_t)s * D * DFF), DFF / 2};
    pg8::DenseOrder S; S.init(last ? NLAT : NTOK, D, DFF / 2, F.G, F.bid);
    pg8::gemm_phase<pg8::EpiGate, pg8::DenseOrder, true, FP8_SP2, true>(F.lds, g, S, E, F.tid, (127 - S8_WD) * 0x01010101, (127 - S8_HID) * 0x01010101);
#else
    pg8::Gemm g{(const bf16_t*)(F.ws + WS_HID), (const bf16_t*)(F.ws + WS_WFD) + (size_t)s * D * DFF, DFF};
    pg8::DenseOrder S; S.init(last ? NLAT : NTOK, D, DFF, F.G, F.bid);
    pg8::gemm_phase<pg8::EpiGate, pg8::DenseOrder, true, true>(F.lds, g, S, E, F.tid);
#endif
    if (layer == 0) deferred_conv(F, (NTOK / 256) * (D / 256), DW_L0_F2, DW_Q2);
}
__device__ __forceinline__ void moe_prefix(const Frame& F, int slot, int hf, int (&ts)[9], int (&cn)[8]) {
    int a = 0;
#pragma unroll
    for (int e = 0; e < 8; ++e) { cn[e] = (int)*cnt_word(F, slot, hf, e); ts[e] = a; a += (cn[e] + 255) >> 8; }
    ts[8] = a;
}
__device__ __forceinline__ void p_ffn1_moe(const Frame& F, int layer) {
    const int slot = layer >> 1; int cn[8];
    pg8::MoeOrder<true> S; moe_prefix(F, slot, 0, S.ts, cn);
    S.nM = S.ts[8]; S.nN = 2 * DFFE / 256; S.G = F.G; S.c = F.bid; S.K = D / 2; S.estride = (long)2 * DFFE * D; S.rowoff = (const LAS unsigned short*)(F.lds + LDS_ROWOFF); S.rowbytes = D;
    {
        const int* list = (const int*)(F.ws + WS_LIST); LAS unsigned short* ro = (LAS unsigned short*)(F.lds + LDS_ROWOFF); pg8::Unit u;
        for (int i = F.wave; i < 36 && S.next(i, u); i += NWAVES) { const int e = S.expert_of(u.pm); int tse = 0, cne = 0;
#pragma unroll
            for (int j = 0; j < 8; ++j) { tse = (j == e) ? S.ts[j] : tse; cne = (j == e) ? cn[j] : cne; }
            int tk[4];
#pragma unroll
            for (int q = 0; q < 4; ++q) { const int sl = (u.pm - tse) * 256 + F.lane + 64 * q; tk[q] = sl < cne ? list[e * NTOK + sl] : 0; }
#pragma unroll
            for (int q = 0; q < 4; ++q) ro[i * 256 + F.lane + 64 * q] = (unsigned short)tk[q]; }
        __syncthreads();
    }
    pg8::Gemm g{(const bf16_t*)(F.ws + WS_H), (const bf16_t*)(F.ws + WS_WMGU + (size_t)slot * NEXP * 2 * DFFE * D), D / 2};
    pg8::EpiSwiGLU8 E{F.ws + WS_HID, DFFE};
    pg8::gemm_phase<pg8::EpiSwiGLU8, pg8::MoeOrder<true>, true, FP8_SP2, true>(F.lds, g, S, E, F.tid, (127 - S8_WGU) * 0x01010101, (127 - S8_ACT) * 0x01010101);
}
__device__ __forceinline__ void p_ffn2_moe(const Frame& F, int layer) {
    const int slot = layer >> 1; int cn[8];
    pg8::MoeOrder<false> S; moe_prefix(F, slot, 0, S.ts, cn);
    S.nM = S.ts[8]; S.nN = D / 256; S.G = F.G; S.c = F.bid; S.K = DFFE / 2; S.estride = (long)D * DFFE; S.rowoff = nullptr; S.rowbytes = 0;
    pg8::EpiBf16 E{(bf16_t*)(F.ws + WS_YP), D};
    pg8::Gemm g{(const bf16_t*)(F.ws + WS_HID), (const bf16_t*)(F.ws + WS_WMD + (size_t)slot * NEXP * D * DFFE), DFFE / 2};
    pg8::gemm_phase<pg8::EpiBf16, pg8::MoeOrder<false>, true, FP8_SP2, true>(F.lds, g, S, E, F.tid, (127 - S8_WD) * 0x01010101, (127 - S8_HID) * 0x01010101);
}

template <bool MOE> __device__ __forceinline__ void ln2_body(const Frame& F, int layer, bool last) {
    bf16_t* X = (bf16_t*)(F.ws + WS_X); bf16_t* H = (bf16_t*)(F.ws + WS_H);
    const float* MOD = (const float*)(F.ws + WS_MOD) + (size_t)layer * 17 * MODW;
    const float* lg = F.in[I_LNG] + (size_t)(layer * 2 + 1) * D; const float* lb = F.in[I_LNB] + (size_t)(layer * 2 + 1) * D;
    const int slot = layer >> 1;
    const int nrows = last ? NLAT : NTOK;
    int ts0[9], cn[8];
    if (MOE) moe_prefix(F, slot, 0, ts0, cn);
    const bf16_t* YP = (const bf16_t*)(F.ws + WS_YP); const bf16_t* DL = (const bf16_t*)(F.ws + WS_DELTA2);
    RowRaw r0 = {}, r1 = {}; u32x4 rt0 = {0u, 0u, 0u, 0u}, rt1 = {0u, 0u, 0u, 0u}; f32x2 g0 = {0.f, 0.f}, g1 = {0.f, 0.f}; u32x4 ya[2] = {}, yb[2] = {};
#define LN2_ISSUE(row_, r_, rt_, g_) do { row_issue<!MOE>(X, DL, (row_), F.lane, r_); \
        if (MOE) { rt_ = *(const u32x4*)(F.ws + WS_ROUTE + (size_t)(row_) * 16); g_ = *(const f32x2*)(F.ws + WS_GATES + (size_t)(row_) * 8); } } while (0)
#define LN2_ISSUE_Y(rt_) do { const int e0_ = (rt_).x & 255, e1_ = ((rt_).x >> 8) & 255; int t0_ = 0, t1_ = 0; \
        _Pragma("unroll") for (int e = 0; e < 8; ++e) { const int tv = ts0[e]; t0_ = (e == e0_) ? tv : t0_; t1_ = (e == e1_) ? tv : t1_; } \
        const bf16_t* y0_ = YP + ((size_t)t0_ * 256 + (rt_).y) * D; const bf16_t* y1_ = YP + ((size_t)t1_ * 256 + (rt_).z) * D; \
        _Pragma("unroll") for (int j = 0; j < 2; ++j) { ya[j] = *(const u32x4*)(y0_ + 8 * F.lane + 512 * j); yb[j] = *(const u32x4*)(y1_ + 8 * F.lane + 512 * j); } } while (0)
    if (F.gw < nrows) LN2_ISSUE(F.gw, r0, rt0, g0);
    if (F.gw + F.NGW < nrows) LN2_ISSUE(F.gw + F.NGW, r1, rt1, g1);
    if (MOE) { if (F.gw < nrows) LN2_ISSUE_Y(rt0); }
    for (int row = F.gw; row < nrows; row += F.NGW) {
        f32x4 v[4], hv[4];
        if (MOE) {
            const float* g2 = MOD + (size_t)mod_row_of(row) * MODW + 5 * D;
#pragma unroll
            for (int j = 0; j < 2; ++j) { const int lane = F.lane; f32x4 x0, x1, a0, a1, b0, b1; unpack8(r0.x[j], x0, x1); unpack8(ya[j], a0, a1); unpack8(yb[j], b0, b1);
                const f32x4 q0 = *(const f32x4*)(g2 + RIDX(2 * j)) + 1.0f, q1 = *(const f32x4*)(g2 + RIDX(2 * j + 1)) + 1.0f;
                v[2 * j] = x0 * ALPHA + q0 * (a0 * g0[0] + b0 * g0[1]); v[2 * j + 1] = x1 * ALPHA + q1 * (a1 * g0[0] + b1 * g0[1]); }
        } else row_combine(r0, v);
        r0 = r1; rt0 = rt1; g0 = g1;
        if (MOE) { if (row + F.NGW < nrows) LN2_ISSUE_Y(rt0); }
        if (row + 2 * F.NGW < nrows) LN2_ISSUE(row + 2 * F.NGW, r1, rt1, g1);
        row_ln(v, lg, lb, F.lane);
        if (last) row_store(F.out + (size_t)row * D, F.lane, v);
        else { row_store_h(X + (size_t)row * D, F.lane, v);
            const float* m = MOD + (size_t)17 * MODW + (size_t)mod_row_of(row) * MODW;
            row_mod_store(H + (size_t)row * D, F.lane, v, m, m + D, hv);
            }
    }
#undef LN2_ISSUE
#undef LN2_ISSUE_Y
}
__device__ __forceinline__ void p_ln2(const Frame& F, int layer, bool last) { if (layer & 1) ln2_body<true>(F, layer, last); else ln2_body<false>(F, layer, last); }

constexpr int NPL = 9;
constexpr int NPH = 2 + NPL * DEPTH;
#ifndef SITE_MASK
#define SITE_MASK 0xFFFFF
#endif
#ifndef TPROBE_MULT
#define TPROBE_MULT 4
#endif
#define SITE(n) (((SITE_MASK) >> (n)) & 1)
__global__ void __launch_bounds__(NT, 2) fwd_kernel(Args args) {
    extern __shared__ __attribute__((aligned(16))) unsigned char lds_raw[];
    Frame F;
    F.lds = (LAS unsigned char*)lds_raw; F.in = args.in; F.out = args.out; F.ws = args.ws;
    F.tid = threadIdx.x; F.lane = F.tid & 63; F.wave = __builtin_amdgcn_readfirstlane(F.tid >> 6); F.bid = blockIdx.x; F.G = gridDim.x;
    F.gw = F.bid * NWAVES + F.wave; F.NGW = F.G * NWAVES;
    volatile LAS unsigned* MISC = (volatile LAS unsigned*)(F.lds + LDS_MISC);
    if (F.tid < 64) MISC[F.tid] = 0u;
    __syncthreads();
    XcdBarrier bar; bar.bar = (unsigned*)(F.ws + WS_CTL) + CW_BAR; bar.x = 0; bar.st = MISC + 8;
#if MK_SINGLE
    bar = xcd_barrier_post((unsigned*)(F.ws + WS_CTL) + CW_BAR, MISC + 8);
#endif
    const int lo = args.ph_lo, hi = args.ph_hi;
#define IN(k) (lo <= (k) && (k) < hi)
#if TPROBE >= 0
    unsigned long long tp_prev = __builtin_amdgcn_s_memrealtime(), tp_acc = 0ull;
#define TP(type) do { const unsigned long long t_ = __builtin_amdgcn_s_memrealtime(); if ((type) == TPROBE) tp_acc += t_ - tp_prev; tp_prev = t_; } while (0)
#else
#define TP(type) do { } while (0)
#endif
#if MK_SINGLE
#define SEAM(k) do { if (IN(k) && IN((k) + 1)) { XcdBarrier b2_ = bar; int z_; asm volatile("s_mov_b32 %0, 0" : "=s"(z_)); b2_.bar = bar.bar + z_; int ln_; asm volatile("v_mbcnt_lo_u32_b32 %0, -1, 0\n\tv_mbcnt_hi_u32_b32 %0, -1, %0" : "=v"(ln_)); xcd_barrier(b2_, F.wave == 0 && ln_ == 0); } } while (0)
#else
#define SEAM(k) do { } while (0)
#endif
    if constexpr (SITE(0)) if (IN(0)) p_pro_a(fresh(F));
    SEAM(0); TP(0);
    if constexpr (SITE(1)) if (IN(1)) p_pro_b(fresh(F));
    SEAM(1); TP(1);
    for (int layer = 0; layer < DEPTH; ++layer) {
        const int pb = 2 + NPL * layer; const bool last = layer == DEPTH - 1; const bool moe = layer & 1;
        if constexpr (SITE(2)) if (IN(pb + 0)) p_inproj(fresh(F), layer);
        SEAM(pb + 0); TP(2);
        if constexpr (SITE(3)) if (IN(pb + 1)) p_mixa(fresh(F), layer, last);
        SEAM(pb + 1); TP(3);
        if constexpr (SITE(12)) if (IN(pb + 2)) p_mixb(fresh(F), layer);
        SEAM(pb + 2); TP(4);
        if constexpr (SITE(4)) if (IN(pb + 3)) { p_ssdcomb(fresh(F), layer, last); if (!USE_FP8 && layer == 2) { int rot = 0; conv_moe(fresh(F), 1, rot); } }
        SEAM(pb + 3); TP(5);
        if constexpr (SITE(5)) if (IN(pb + 4)) p_outproj(fresh(F), layer, last);
        SEAM(pb + 4); TP(6);
        if constexpr (SITE(6)) if (IN(pb + 5)) p_ln1(fresh(F), layer, last);
        SEAM(pb + 5); TP(7);
        if (moe) {
            if constexpr (SITE(7)) if (IN(pb + 6)) p_ffn1_moe(fresh(F), layer);
            SEAM(pb + 6); TP(8);
            if constexpr (SITE(8)) if (IN(pb + 7)) p_ffn2_moe(fresh(F), layer);
            SEAM(pb + 7); TP(9);
        } else {
            if constexpr (SITE(9)) if (IN(pb + 6)) p_ffn1_dense(fresh(F), layer, last);
            SEAM(pb + 6); TP(10);
            if constexpr (SITE(10)) if (IN(pb + 7)) p_ffn2_dense(fresh(F), layer, last);
            SEAM(pb + 7); TP(11);
        }
        if constexpr (SITE(11)) if (IN(pb + 8)) p_ln2(fresh(F), layer, last);
        if (!last) SEAM(pb + 8);
        TP(12);
    }
#if TPROBE >= 100
    __syncthreads(); tp_acc = ((volatile LAS unsigned*)(F.lds + LDS_MISC))[40];
#endif
#if TPROBE >= 0
    { const unsigned long long t_end = __builtin_amdgcn_s_memrealtime(); while (__builtin_amdgcn_s_memrealtime() - t_end < (unsigned long long)TPROBE_MULT * tp_acc) __builtin_amdgcn_s_sleep(8); }
#endif
#undef IN
#undef SEAM
}

extern "C" void kernel_launch(void* const* d_in, const int* in_sizes, int n_in, void* d_out, int out_size, void* d_ws, size_t ws_size, hipStream_t stream) {
    static int grid = 0;
    if (grid == 0) {
        if (n_in != 24 || out_size != NLAT * D || ws_size < WS_END) { fprintf(stderr, "kernel_launch: unexpected shapes (n_in %d, out %d, ws %zu < %zu)\n", n_in, out_size, ws_size, (size_t)WS_END); grid = -1; return; }
        int dev = 0, cus = 0, per_cu = 0;
        if (hipGetDevice(&dev) != hipSuccess || hipDeviceGetAttribute(&cus, hipDeviceAttributeMultiprocessorCount, dev) != hipSuccess) { grid = -1; return; }
        if (hipFuncSetAttribute((const void*)fwd_kernel, hipFuncAttributeMaxDynamicSharedMemorySize, LDS_BYTES) != hipSuccess) { fprintf(stderr, "kernel_launch: hipFuncSetAttribute failed\n"); grid = -1; return; }
        if (hipOccupancyMaxActiveBlocksPerMultiprocessor(&per_cu, (const void*)fwd_kernel, NT, LDS_BYTES) != hipSuccess || per_cu < 1) { fprintf(stderr, "kernel_launch: occupancy query says %d\n", per_cu); }
        (void)hipGetLastError();
        grid = cus;
    }
    if (grid < 0) return;
    (void)in_sizes;
    if (hipMemsetAsync((char*)d_ws + WS_CTL, 0, CTL_BYTES, stream) != hipSuccess) return;
    Args a{};
    for (int i = 0; i < 24; ++i) a.in[i] = (const float*)d_in[i];
    a.out = (float*)d_out; a.ws = (unsigned char*)d_ws;
#if MK_SINGLE
    a.ph_lo = 0; a.ph_hi = NPH;
    hipLaunchKernelGGL(fwd_kernel, dim3(grid), dim3(NT), LDS_BYTES, stream, a);
#else
    for (int ph = 0; ph < NPH; ++ph) {

        a.ph_lo = ph; a.ph_hi = ph + 1;
        hipLaunchKernelGGL(fwd_kernel, dim3(grid), dim3(NT), LDS_BYTES, stream, a);
    }
#endif
}
```

```cpp
#include <hip/hip_runtime.h>
#include <cstdio>
#include <cstdint>

#ifndef MK_SINGLE
#define MK_SINGLE 1
#endif

#ifndef FP8_INPROJ
#define FP8_INPROJ 0
#endif
#ifndef FP8_DENSE1
#define FP8_DENSE1 0
#endif
#ifndef FP8_DENSE2
#define FP8_DENSE2 1
#endif
#ifndef USE_FP8
#define USE_FP8 1
#endif
#ifndef FP8_SP2
#define FP8_SP2 true
#endif
#ifndef REP_SSD
#define REP_SSD 1
#endif
#ifndef REP_NA
#define REP_NA 1
#endif
#ifndef REP_GEMM
#define REP_GEMM 1
#endif
#define GAS __attribute__((address_space(1)))
#define LAS __attribute__((address_space(3)))
typedef unsigned short bf16_t;
typedef short bf16x8 __attribute__((ext_vector_type(8)));
typedef float f32x4 __attribute__((ext_vector_type(4)));
typedef float f32x2 __attribute__((ext_vector_type(2)));
typedef unsigned u32x4 __attribute__((ext_vector_type(4)));
typedef unsigned u32x2 __attribute__((ext_vector_type(2)));
typedef int i32x4 __attribute__((ext_vector_type(4)));
typedef int i32x8 __attribute__((ext_vector_type(8)));

constexpr int D = 1024, BATCH = 16, SEQ = 2048, DEPTH = 4, GRID_W = 64, CTX = 256;
constexpr int NLAT = BATCH * SEQ;
constexpr int NCTX = BATCH * CTX;
constexpr int NTOK = NLAT + NCTX;
constexpr int NPROJ = 3072;
constexpr int OFF_K = 512, OFF_V = 1024, OFF_Z = 1536, OFF_XBC = 2048;
constexpr int D_IN_PROJ = 3088;
constexpr int DFF = 2816, DFFE = 3584, NEXP = 8;
constexpr float ALPHA = 1.6817928305074290f;
constexpr float LN_EPS = 1e-5f, RMS_EPS = 1e-5f;
constexpr int MODW = 6 * D;

constexpr size_t MiB = 1u << 20;
constexpr size_t WS_CTL = 0, CTL_BYTES = 1 * MiB;
constexpr size_t WS_MOD = 1 * MiB;
constexpr size_t WS_ROUTE = 3 * MiB;
constexpr size_t WS_GATES = 4 * MiB;
constexpr size_t WS_LIST = 5 * MiB;
constexpr size_t WS_WDT = 7 * MiB;
constexpr size_t WS_WIN = 8 * MiB;
constexpr size_t WS_WOUT = 32 * MiB;
constexpr size_t WS_WFGU = 40 * MiB;
constexpr size_t WS_WFD = 62 * MiB;
constexpr size_t WS_WMGU = 73 * MiB;
constexpr size_t WS_WMD = 185 * MiB;
constexpr size_t WS_X = 241 * MiB;
constexpr size_t WS_H = 385 * MiB;
constexpr size_t WS_R = 457 * MiB;
constexpr size_t WS_PROJ = WS_R;
constexpr size_t WS_DT = WS_R + 216 * MiB;
constexpr size_t WS_YF = WS_R + 219 * MiB;
constexpr size_t WS_YB = WS_R + 291 * MiB;
constexpr size_t WS_MIX = WS_R + 363 * MiB;
constexpr size_t WS_HID = WS_R;
constexpr size_t WS_YP = WS_R + 270 * MiB;
constexpr size_t WS_DELTA1 = WS_R;
constexpr size_t WS_DELTA2 = WS_R + 270 * MiB;
constexpr size_t WS_U = WS_R + 435 * MiB;
constexpr size_t WS_H8IN = WS_U;
constexpr size_t WS_END = WS_R + 507 * MiB;
constexpr int MOE_PAD = 2 * NTOK + 2048;
static_assert(USE_FP8 == 1, "the single-phase MoE needs the e4m3 hidden (the bf16 one does not fit the workspace)");
static_assert(WS_HID + (size_t)MOE_PAD * 3584 <= WS_YP && WS_YP + (size_t)MOE_PAD * 1024 * 2 <= WS_END, "MoE buffers");

constexpr int CW_TMO = 0;
constexpr int CW_BAR = 4096;
constexpr int CW_CNT = 16384;

constexpr int LDS_STAGE = 131072;
constexpr int LDS_ROWOFF = 131072;
constexpr int LDS_MISC = 131072 + 18432;
constexpr int LDS_BYTES = 155648;

constexpr int S8_ACT = 3, S8_WGU = 8, S8_HID = 2, S8_WD = 9;
#ifndef TPROBE
#define TPROBE (-1)
#endif
#if TPROBE >= 100
#define TPS_BEGIN unsigned long long tps_t_ = __builtin_amdgcn_s_memrealtime()
#define TPS(k) do { const unsigned long long t_ = __builtin_amdgcn_s_memrealtime(); if (TPROBE == 100 + (k) && F.tid == 0) ((volatile LAS unsigned*)(F.lds + LDS_MISC))[40] += (unsigned)(t_ - tps_t_); tps_t_ = t_; } while (0)
#else
#define TPS_BEGIN do { } while (0)
#define TPS(k) do { } while (0)
#endif
__device__ __forceinline__ unsigned f2bf(float f) { unsigned u = __builtin_bit_cast(unsigned, f); return (u + 0x7fffu + ((u >> 16) & 1u)) >> 16; }
typedef __bf16 bf16x2_t __attribute__((ext_vector_type(2)));
__device__ __forceinline__ unsigned pk2(float lo, float hi) { const f32x2 v = {lo, hi}; const bf16x2_t b = __builtin_convertvector(v, bf16x2_t); return __builtin_bit_cast(unsigned, b); }
__device__ __forceinline__ float bf2f(unsigned short b) { return __builtin_bit_cast(float, ((unsigned)b) << 16); }
__device__ __forceinline__ float bflo(unsigned w) { return __builtin_bit_cast(float, w << 16); }
__device__ __forceinline__ float bfhi(unsigned w) { return __builtin_bit_cast(float, w & 0xffff0000u); }
__device__ __forceinline__ float silu_f(float v) { return v / (1.0f + __expf(-v)); }
__device__ __forceinline__ float clamp8(float v) { return fminf(fmaxf(v, -448.0f), 448.0f); }
__device__ __forceinline__ unsigned pk8(float a, float b, float c, float d) {
    int w = 0; w = __builtin_amdgcn_cvt_pk_fp8_f32(clamp8(a), clamp8(b), w, false); w = __builtin_amdgcn_cvt_pk_fp8_f32(clamp8(c), clamp8(d), w, true); return (unsigned)w; }
template <int CTRL, int ROWMASK = 0xF, bool BC = false>
__device__ __forceinline__ float dpp_f(float v) { return __builtin_bit_cast(float, __builtin_amdgcn_update_dpp(0, __builtin_bit_cast(int, v), CTRL, ROWMASK, 0xF, BC)); }
__device__ __forceinline__ float row16_sum(float v) {
    v += dpp_f<0xB1>(v); v += dpp_f<0x4E>(v); v += dpp_f<0x141>(v); v += dpp_f<0x140>(v);
    return v;
}
__device__ __forceinline__ float wave_sum(float v) {
    v = row16_sum(v);
    v += dpp_f<0x142, 0xA>(v); v += dpp_f<0x143, 0xC>(v);
    return __builtin_bit_cast(float, __builtin_amdgcn_readlane(__builtin_bit_cast(int, v), 63));
}
__device__ __forceinline__ float xrow_max(float v) {
    unsigned u = __builtin_bit_cast(unsigned, v); auto r = __builtin_amdgcn_permlane16_swap(u, u, false, false);
    v = fmaxf(__builtin_bit_cast(float, r[0]), __builtin_bit_cast(float, r[1]));
    u = __builtin_bit_cast(unsigned, v); auto r2 = __builtin_amdgcn_permlane32_swap(u, u, false, false);
    return fmaxf(__builtin_bit_cast(float, r2[0]), __builtin_bit_cast(float, r2[1]));
}
__device__ __forceinline__ float xrow_sum(float v) {
    unsigned u = __builtin_bit_cast(unsigned, v); auto r = __builtin_amdgcn_permlane16_swap(u, u, false, false);
    v = __builtin_bit_cast(float, r[0]) + __builtin_bit_cast(float, r[1]);
    u = __builtin_bit_cast(unsigned, v); auto r2 = __builtin_amdgcn_permlane32_swap(u, u, false, false);
    return __builtin_bit_cast(float, r2[0]) + __builtin_bit_cast(float, r2[1]);
}
__device__ __forceinline__ float wave_scan(float v) {
    v += dpp_f<0x111, 0xF, true>(v); v += dpp_f<0x112, 0xF, true>(v); v += dpp_f<0x114, 0xF, true>(v); v += dpp_f<0x118, 0xF, true>(v);
    v += dpp_f<0x142, 0xA>(v); v += dpp_f<0x143, 0xC>(v);
    return v;
}

namespace pg8 {
constexpr int BM = 256, BK = 64, HALF = 128, HTB = HALF * BK * 2, STAGE_BYTES = 8 * HTB, NXCD = 8, WGM = 8;
__host__ __device__ __forceinline__ int lds_byte(int r, int c) { const int st = (r >> 4) * 2 + (c >> 5), rr = r & 15, cc = c & 31, ob = rr * 64 + cc * 2; return st * 1024 + (ob ^ (((ob >> 9) & 1) << 5)); }
__host__ __device__ __forceinline__ void stage_rc(int b, int& R, int& C) { const int st = b / 1024, sb = b % 1024, swz = sb ^ (((sb >> 9) & 1) << 5); R = (st >> 1) * 16 + swz / 64; C = (st & 1) * 32 + (swz % 64) / 2; }
__host__ __device__ __forceinline__ int perm32(int rho) { const int n = rho >> 4, i = rho & 15; return 8 * (i >> 2) + 4 * n + (i & 3); }

struct Unit { int pm, pn; long bofs; };
struct Gemm { const bf16_t* A; const bf16_t* Bt; int K; };

__device__ __forceinline__ unsigned cvt_pk_bf16(float lo, float hi) { return pk2(lo, hi); }
__device__ __forceinline__ unsigned cvt_pk_bf16_pin(float lo, float hi) { unsigned r; asm volatile("v_cvt_pk_bf16_f32 %0, %1, %2" : "=v"(r) : "v"(lo), "v"(hi)); return r; }

__device__ __forceinline__ bool static_tile(int i, int G, int c, int nM, int nN, int& pm, int& pn, int rep = 1) {
    const int nwg = nM * nN;
#if REP_GEMM > 1
    { const int cnt = (nwg - c + G - 1) / G; if (cnt <= 0 || i >= rep * cnt) return false; i %= cnt; }
#endif
    const long L = (long)i * G + c; if (L >= nwg) return false;
    int wgid = (int)L; { const int q = nwg / NXCD, r = nwg % NXCD, xcd = wgid % NXCD, off = wgid / NXCD; wgid = (xcd < r ? xcd * (q + 1) : r * (q + 1) + (xcd - r) * q) + off; }
    const int nig = WGM * nN, gid = wgid / nig, fm = gid * WGM, gsz = (nM - fm) < WGM ? (nM - fm) : WGM;
    pm = fm + ((wgid % nig) % gsz); pn = (wgid % nig) / gsz; return true;
}
struct DenseOrder {
    int nM, nN, G, c, K, rep;
    __device__ __forceinline__ void init(int M, int N, int K_, int G_, int c_, int rep_ = 1) { nM = M / BM; nN = N / BM; G = G_; c = c_; K = K_; rep = rep_; }
    __device__ __forceinline__ bool next(int i, Unit& u) const { if (!static_tile(i, G, c, nM, nN, u.pm, u.pn, rep)) return false; u.bofs = (long)u.pn * BM * K * 2; return true; }
    static constexpr bool GATHER = false;
    __device__ __forceinline__ long a_base(const Unit& u) const { return (long)u.pm * BM * K * 2; }
    __device__ __forceinline__ void a_offs(int, const Unit&, int, unsigned (&)[2][2]) const {}
};
template <bool GATHER_> struct MoeOrder {
    int nM, nN, G, c, K; int ts[9]; long estride; const LAS unsigned short* rowoff; unsigned rowbytes;
    __device__ __forceinline__ int expert_of(int pm) const { int e = 0;
#pragma unroll
        for (int j = 1; j < 8; ++j) e += (pm >= ts[j]) ? 1 : 0; return e; }
    __device__ __forceinline__ bool next(int i, Unit& u) const { if (!static_tile(i, G, c, nM, nN, u.pm, u.pn, REP_GEMM)) return false; u.bofs = (long)expert_of(u.pm) * estride + (long)u.pn * BM * K * 2; return true; }
    static constexpr bool GATHER = GATHER_;
    __device__ __forceinline__ long a_base(const Unit& u) const { return GATHER_ ? 0l : (long)u.pm * BM * K * 2; }
    __device__ __forceinline__ void a_offs(int ui, const Unit&, int tid, unsigned (&o)[2][2]) const {
        int uix = ui;
#if REP_GEMM > 1
        { const int cnt = (nM * nN - c + G - 1) / G; uix = ui % cnt; }
#endif
        if (GATHER_) {
#pragma unroll
            for (int i = 0; i < 2; ++i) { int R, C; stage_rc(tid * 16 + i * 8192, R, C);
#pragma unroll
                for (int h = 0; h < 2; ++h) o[h][i] = (unsigned)rowoff[uix * 256 + h * HALF + R] * rowbytes + (unsigned)(C * 2); }
        }
    }
};

struct EpiBf16 {
    static constexpr bool PERM = true;
    bf16_t* O; int ldc;
    __device__ __forceinline__ void operator()(const f32x4 (&acc)[2][2][4][2], const Unit& u, int wr, int wc, int fr, int fq) const {
        const int row0 = u.pm * BM + wr * 64 + fr; const int col0 = u.pn * BM + wc * 32 + 8 * fq;
#pragma unroll
        for (int ai = 0; ai < 2; ++ai)
#pragma unroll
            for (int m = 0; m < 4; ++m) { bf16_t* rowp = O + (size_t)(row0 + ai * HALF + m * 16) * ldc + col0;
#pragma unroll
                for (int bj = 0; bj < 2; ++bj) { const f32x4 v0 = acc[ai][bj][m][0], v1 = acc[ai][bj][m][1];
                    u32x4 w; w.x = cvt_pk_bf16(v0[0], v0[1]); w.y = cvt_pk_bf16(v0[2], v0[3]); w.z = cvt_pk_bf16(v1[0], v1[1]); w.w = cvt_pk_bf16(v1[2], v1[3]);
                    *(u32x4*)(rowp + bj * HALF) = w; } }
    }
};
struct EpiSwiGLU {
    static constexpr bool PERM = true;
    bf16_t* O; int ldc;
    __device__ __forceinline__ void operator()(const f32x4 (&acc)[2][2][4][2], const Unit& u, int wr, int wc, int fr, int fq) const {
        const int row0 = u.pm * BM + wr * 64 + fr; const int col0 = u.pn * HALF + wc * 32 + 8 * fq;
#pragma unroll
        for (int ai = 0; ai < 2; ++ai)
#pragma unroll
            for (int m = 0; m < 4; ++m) { bf16_t* rowp = O + (size_t)(row0 + ai * HALF + m * 16) * ldc + col0;
                float h[8];
#pragma unroll
                for (int n = 0; n < 2; ++n)
#pragma unroll
                    for (int j = 0; j < 4; ++j) { const float g = acc[ai][0][m][n][j], up = acc[ai][1][m][n][j]; h[n * 4 + j] = g * __builtin_amdgcn_rcpf(1.0f + __expf(-g)) * up; }
                u32x4 w; w.x = cvt_pk_bf16(h[0], h[1]); w.y = cvt_pk_bf16(h[2], h[3]); w.z = cvt_pk_bf16(h[4], h[5]); w.w = cvt_pk_bf16(h[6], h[7]);
                *(u32x4*)rowp = w; }
    }
};
struct EpiSwiGLU8 {
    static constexpr bool PERM = true;
    unsigned char* O; int ldc;
    __device__ __forceinline__ void operator()(const f32x4 (&acc)[2][2][4][2], const Unit& u, int wr, int wc, int fr, int fq) const {
        const int row0 = u.pm * BM + wr * 64 + fr; const int col0 = u.pn * HALF + wc * 32 + 8 * fq;
#pragma unroll
        for (int ai = 0; ai < 2; ++ai)
#pragma unroll
            for (int m = 0; m < 4; ++m) { unsigned char* rowp = O + (size_t)(row0 + ai * HALF + m * 16) * ldc + col0;
                float h[8];
#pragma unroll
                for (int n = 0; n < 2; ++n)
#pragma unroll
                    for (int j = 0; j < 4; ++j) { const float g = acc[ai][0][m][n][j], up = acc[ai][1][m][n][j]; h[n * 4 + j] = g * __builtin_amdgcn_rcpf(1.0f + __expf(-g)) * up * (float)(1 << S8_HID); }
                u32x2 w; w.x = pk8(h[0], h[1], h[2], h[3]); w.y = pk8(h[4], h[5], h[6], h[7]);
                *(u32x2*)rowp = w; }
    }
};
struct EpiGate {
    static constexpr bool PERM = true;
    bf16_t* O; const float* mod; int gate_off;
    __device__ __forceinline__ void operator()(const f32x4 (&acc)[2][2][4][2], const Unit& u, int wr, int wc, int fr, int fq) const {
        const int rt = u.pm * BM; const int bi = rt >= NLAT ? 16 : (rt >> 11);
        const int col0 = u.pn * BM + wc * 32 + 8 * fq; const float* gt = mod + bi * MODW + gate_off + col0;
        f32x4 gv[2][2];
#pragma unroll
        for (int bj = 0; bj < 2; ++bj)
#pragma unroll
            for (int n = 0; n < 2; ++n) gv[bj][n] = *(const f32x4*)(gt + bj * HALF + 4 * n) + 1.0f;
        const int row0 = rt + wr * 64 + fr;
#pragma unroll
        for (int ai = 0; ai < 2; ++ai)
#pragma unroll
            for (int m = 0; m < 4; ++m) { bf16_t* rowp = O + (size_t)(row0 + ai * HALF + m * 16) * D + col0;
#pragma unroll
                for (int bj = 0; bj < 2; ++bj) { const f32x4 v0 = acc[ai][bj][m][0] * gv[bj][0], v1 = acc[ai][bj][m][1] * gv[bj][1];
                    u32x4 w; w.x = cvt_pk_bf16(v0[0], v0[1]); w.y = cvt_pk_bf16(v0[2], v0[3]); w.z = cvt_pk_bf16(v1[0], v1[1]); w.w = cvt_pk_bf16(v1[2], v1[3]);
                    *(u32x4*)(rowp + bj * HALF) = w; } }
    }
};

template <class Epi, class Sched, bool ALIGN_EPI, bool SP2, bool FP8 = false>
__device__ __forceinline__ void gemm_phase(LAS unsigned char* lds, const Gemm g, const Sched& S, const Epi& E, int tid_in, int sw = 0x7f7f7f7f, int sa = 0x7f7f7f7f) {
    int tid_ = tid_in; asm volatile("" : "+v"(tid_));
    const int tid = tid_, wid = __builtin_amdgcn_readfirstlane(tid >> 6), lane = tid & 63, wr = wid >> 2, wc = wid & 3, fr = lane & 15, fq = lane >> 4;
    const int K = g.K, nt = K / BK;
    constexpr bool GA = Sched::GATHER;
    unsigned voffA[2], voffB[2];
#pragma unroll
    for (int i = 0; i < 2; ++i) { int R, C; stage_rc(tid * 16 + i * 8192, R, C); const int Rb = Epi::PERM ? ((R & ~31) + perm32(R & 31)) : R;
        voffA[i] = (unsigned)(R * K + C) * 2u; voffB[i] = (unsigned)(Rb * K + C) * 2u; }
    const size_t kstep = (size_t)(BK * 2);
    const size_t hstep = (size_t)HALF * K * 2;
    const unsigned ldsw = (unsigned)wid * 1024u;
    const int aoff = lds_byte(wr * 64 + fr, fq * 8), boff = lds_byte(wc * 32 + fr, fq * 8);
#define PG8_SA(b, h) (((b) * 2 + (h)) * HTB)
#define PG8_SB(b, h) ((4 + (b) * 2 + (h)) * HTB)
#define PG8_STAGE(bufoff, gbase, voff) do { _Pragma("unroll") for (int _i = 0; _i < 2; ++_i) \
        __builtin_amdgcn_global_load_lds((const unsigned*)((const char*)(gbase) + (voff)[_i]), (LAS unsigned*)(lds + (bufoff) + ldsw + _i * 8192), 16, 0, 0); } while (0)
#define PG8_LDA(dst, b, h) do { _Pragma("unroll") for (int m = 0; m < 4; ++m) _Pragma("unroll") for (int k = 0; k < 2; ++k) dst[m][k] = *(const LAS bf16x8*)(lds + PG8_SA(b, h) + aoff + m * 2048 + k * 1024); } while (0)
#define PG8_LDB(dst, b, h) do { _Pragma("unroll") for (int n = 0; n < 2; ++n) _Pragma("unroll") for (int k = 0; k < 2; ++k) dst[n][k] = *(const LAS bf16x8*)(lds + PG8_SB(b, h) + boff + n * 2048 + k * 1024); } while (0)
#define PG8_CAT(x) __builtin_shufflevector(__builtin_bit_cast(i32x4, (x)[0]), __builtin_bit_cast(i32x4, (x)[1]), 0, 1, 2, 3, 4, 5, 6, 7)
#define PG8_MMA(ai, bj, At, Bt) do { __builtin_amdgcn_s_setprio(1); _Pragma("unroll") for (int m = 0; m < 4; ++m) _Pragma("unroll") for (int n = 0; n < 2; ++n) { \
        if constexpr (FP8) { const i32x8 a8_ = PG8_CAT(Bt[n]), b8_ = PG8_CAT(At[m]); \
            asm volatile("v_mfma_scale_f32_16x16x128_f8f6f4 %0, %1, %2, %0, %3, %4 op_sel_hi:[0,0,0]" : "+v"(acc[ai][bj][m][n]) : "v"(a8_), "v"(b8_), "v"(sw), "v"(sa)); } \
        else { _Pragma("unroll") for (int k = 0; k < 2; ++k) acc[ai][bj][m][n] = __builtin_amdgcn_mfma_f32_16x16x32_bf16(Bt[n][k], At[m][k], acc[ai][bj][m][n], 0, 0, 0); } } \
        __builtin_amdgcn_s_setprio(0); } while (0)
#define PG8_WAIT_V(n) asm volatile("s_waitcnt vmcnt(" #n ")" ::: "memory")
#define PG8_WAIT_L(n) asm volatile("s_waitcnt lgkmcnt(" #n ")" ::: "memory")
#define PG8_BAR __builtin_amdgcn_s_barrier()
#define PG8_SCHED __builtin_amdgcn_sched_barrier(0)
    Unit cur, nxt; int ui = 0;
    if (!S.next(0, cur)) return;
    f32x4 acc[2][2][4][2];
#pragma unroll
    for (int a = 0; a < 2; ++a)
#pragma unroll
        for (int b = 0; b < 2; ++b)
#pragma unroll
            for (int m = 0; m < 4; ++m)
#pragma unroll
                for (int n = 0; n < 2; ++n) acc[a][b][m][n] = (f32x4){0.f, 0.f, 0.f, 0.f};
    bf16x8 At[4][2], B0[2][2], B1[2][2];
    const char* Ab = (const char*)g.A + S.a_base(cur);
    unsigned oc[2][2];
    S.a_offs(0, cur, tid, oc);
    const size_t hsA = GA ? (size_t)0 : hstep;
#define PG8_STAGE_A(bufoff, gbase, h) do { if constexpr (GA) PG8_STAGE(bufoff, gbase, oc[h]); else PG8_STAGE(bufoff, (gbase) + (h) * hsA, voffA); } while (0)
    const char* cB = (const char*)g.Bt + cur.bofs;
    if constexpr (SP2) {
        PG8_STAGE(PG8_SB(0, 0), cB, voffB); PG8_STAGE(PG8_SB(0, 1), cB + hstep, voffB); PG8_STAGE_A(PG8_SA(0, 0), Ab, 0); PG8_STAGE_A(PG8_SA(0, 1), Ab, 1);
        if (wr == 1) PG8_BAR;
        PG8_WAIT_V(2); PG8_BAR;
        PG8_STAGE(PG8_SB(1, 0), cB + kstep, voffB); PG8_STAGE_A(PG8_SA(1, 0), Ab + kstep, 0); PG8_STAGE(PG8_SB(1, 1), cB + hstep + kstep, voffB);
        PG8_WAIT_V(6); PG8_BAR;
    } else {
        PG8_STAGE(PG8_SB(0, 0), cB, voffB); PG8_STAGE_A(PG8_SA(0, 0), Ab, 0); PG8_STAGE(PG8_SB(0, 1), cB + hstep, voffB); PG8_STAGE_A(PG8_SA(0, 1), Ab, 1);
        if (wr == 1) PG8_BAR;
        PG8_WAIT_V(4); PG8_BAR;
        PG8_STAGE(PG8_SB(1, 0), cB + kstep, voffB); PG8_STAGE_A(PG8_SA(1, 0), Ab + kstep, 0); PG8_STAGE(PG8_SB(1, 1), cB + hstep + kstep, voffB);
        PG8_WAIT_V(6); PG8_BAR;
    }
    for (;;) {
        const bool has_next = S.next(ui + 1, nxt);
        const char* nB = has_next ? (const char*)g.Bt + nxt.bofs : cB;
        for (int t = 0; t < nt; t += 2) {
            const bool last = (t == nt - 2);
            const char* a1 = Ab + (size_t)(t + 1) * kstep;
            const char* b2 = last ? nB : cB + (size_t)(t + 2) * kstep; const char* b3 = b2 + kstep;
            if constexpr (SP2) {
            PG8_LDB(B0, 0, 0); PG8_LDB(B1, 0, 1); PG8_SCHED; PG8_LDA(At, 0, 0); PG8_STAGE_A(PG8_SA(1, 1), a1, 1);
            if (last && has_next) { S.a_offs(ui + 1, nxt, tid, oc); Ab = (const char*)g.A + S.a_base(nxt); }
            const char* a2 = last ? Ab : Ab + (size_t)(t + 2) * kstep; const char* a3 = a2 + kstep;
            PG8_WAIT_V(8); PG8_WAIT_L(0); PG8_BAR; PG8_MMA(0, 0, At, B0); PG8_MMA(0, 1, At, B1); PG8_BAR; PG8_SCHED;
            PG8_LDA(At, 0, 1); PG8_STAGE(PG8_SB(0, 0), b2, voffB); PG8_STAGE(PG8_SB(0, 1), b2 + hstep, voffB); PG8_STAGE_A(PG8_SA(0, 0), a2, 0);
            PG8_WAIT_V(8); PG8_WAIT_L(0); PG8_BAR; PG8_MMA(1, 0, At, B0); PG8_MMA(1, 1, At, B1); PG8_BAR; PG8_SCHED;
            PG8_LDB(B0, 1, 0); PG8_LDB(B1, 1, 1); PG8_SCHED; PG8_LDA(At, 1, 0); PG8_STAGE_A(PG8_SA(0, 1), a2, 1);
            PG8_WAIT_V(8); PG8_WAIT_L(0); PG8_BAR; PG8_MMA(0, 0, At, B0); PG8_MMA(0, 1, At, B1); PG8_BAR; PG8_SCHED;
            PG8_LDA(At, 1, 1); PG8_STAGE(PG8_SB(1, 0), b3, voffB); PG8_STAGE(PG8_SB(1, 1), b3 + hstep, voffB); PG8_STAGE_A(PG8_SA(1, 0), a3, 0);
            PG8_WAIT_V(8); PG8_WAIT_L(0); PG8_BAR; PG8_MMA(1, 0, At, B0); PG8_MMA(1, 1, At, B1); PG8_BAR; PG8_SCHED;
            } else {
            PG8_LDB(B0, 0, 0); PG8_SCHED; PG8_LDA(At, 0, 0); PG8_STAGE_A(PG8_SA(1, 1), a1, 1);
            if (last && has_next) { S.a_offs(ui + 1, nxt, tid, oc); Ab = (const char*)g.A + S.a_base(nxt); }
            const char* a2 = last ? Ab : Ab + (size_t)(t + 2) * kstep; const char* a3 = a2 + kstep;
            PG8_WAIT_L(8); PG8_BAR; PG8_WAIT_L(0); PG8_MMA(0, 0, At, B0); PG8_BAR; PG8_SCHED;
            PG8_LDB(B1, 0, 1); PG8_STAGE(PG8_SB(0, 0), b2, voffB);
            PG8_BAR; PG8_WAIT_L(0); PG8_MMA(0, 1, At, B1); PG8_BAR;
            PG8_LDA(At, 0, 1); PG8_STAGE_A(PG8_SA(0, 0), a2, 0);
            PG8_BAR; PG8_WAIT_L(0); PG8_MMA(1, 0, At, B0); PG8_BAR; PG8_SCHED;
            PG8_STAGE(PG8_SB(0, 1), b2 + hstep, voffB);
            PG8_WAIT_V(6); PG8_BAR; PG8_MMA(1, 1, At, B1); PG8_BAR;
            PG8_LDB(B0, 1, 0); PG8_SCHED; PG8_LDA(At, 1, 0); PG8_STAGE_A(PG8_SA(0, 1), a2, 1);
            PG8_WAIT_L(8); PG8_BAR; PG8_WAIT_L(0); PG8_MMA(0, 0, At, B0); PG8_BAR; PG8_SCHED;
            PG8_LDB(B1, 1, 1); PG8_STAGE(PG8_SB(1, 0), b3, voffB);
            PG8_BAR; PG8_WAIT_L(0); PG8_MMA(0, 1, At, B1); PG8_BAR;
            PG8_LDA(At, 1, 1); PG8_STAGE_A(PG8_SA(1, 0), a3, 0);
            PG8_BAR; PG8_WAIT_L(0); PG8_MMA(1, 0, At, B0); PG8_BAR; PG8_SCHED;
            PG8_STAGE(PG8_SB(1, 1), b3 + hstep, voffB);
            PG8_WAIT_V(6); PG8_BAR; PG8_MMA(1, 1, At, B1); PG8_BAR;
            }
        }
        if constexpr (ALIGN_EPI) { if (wr == 0) PG8_BAR; }
        if constexpr (FP8) asm volatile("s_nop 15\n\ts_nop 15\n\ts_nop 15" ::: "memory");
        E(acc, cur, wr, wc, fr, fq);
        if (!has_next) break;
#pragma unroll
        for (int a = 0; a < 2; ++a)
#pragma unroll
            for (int b = 0; b < 2; ++b)
#pragma unroll
                for (int m = 0; m < 4; ++m)
#pragma unroll
                    for (int n = 0; n < 2; ++n) acc[a][b][m][n] = (f32x4){0.f, 0.f, 0.f, 0.f};
        cur = nxt; cB = nB; ++ui;
        if constexpr (ALIGN_EPI) { if (wr == 1) PG8_BAR; }
    }
    PG8_WAIT_V(0);
    if constexpr (!ALIGN_EPI) { if (wr == 0) PG8_BAR; }
    PG8_BAR;
#undef PG8_SA
#undef PG8_SB
#undef PG8_STAGE
#undef PG8_STAGE_A
#undef PG8_LDA
#undef PG8_LDB
#undef PG8_MMA
#undef PG8_CAT
#undef PG8_WAIT_V
#undef PG8_WAIT_L
#undef PG8_BAR
#undef PG8_SCHED
}
}

#define XB_TMO      128
#define XB_XCNT(j)  (256  + 64 * (j))
#define XB_XSUB(j)  (1280 + 64 * (j))
#define XB_XGEN(j)  (2304 + 64 * (j))
#define XB_TOP      3328
#define XB_TOPGEN   3392
#define XCD_BAR_WORDS 3456
#define XB_SPIN_CAP (1u << 18)
__device__ __forceinline__ unsigned xb_ld(unsigned* p)              { return __hip_atomic_load(p, __ATOMIC_RELAXED, __HIP_MEMORY_SCOPE_AGENT); }
__device__ __forceinline__ unsigned xb_add(unsigned* p, unsigned v) { return __hip_atomic_fetch_add(p, v, __ATOMIC_RELAXED, __HIP_MEMORY_SCOPE_AGENT); }
__device__ __forceinline__ unsigned xb_xcc_id() { return (unsigned)__builtin_amdgcn_s_getreg((3 << 11) | 20) & 0xFu; }
#define XB_SPIN(cond, bar) do { unsigned _sp = 0; while (cond) { __builtin_amdgcn_s_sleep(1); \
    if ((++_sp & 255u) == 0u) { if (xb_ld(&(bar)[XB_TMO])) break; if (_sp > XB_SPIN_CAP) { atomicAdd(&(bar)[XB_TMO], 1u); break; } } } } while (0)
struct XcdBarrier { unsigned* bar; unsigned x; volatile LAS unsigned* st; };
__device__ __forceinline__ XcdBarrier xcd_barrier_post(unsigned* bar, volatile LAS unsigned* st) {
    XcdBarrier b; b.bar = bar; b.x = xb_xcc_id(); b.st = st;
    if (threadIdx.x == 0) (void)xb_add(&bar[XB_XCNT(b.x)], 1u);
    return b;
}
__device__ __forceinline__ void xcd_barrier_complete(unsigned* bar, unsigned x, unsigned& nloc, unsigned& nx) {
    const unsigned G = gridDim.x * gridDim.y * gridDim.z;
    unsigned sum, cnt, mine, sp = 0u;
    for (;;) {
        sum = 0u; cnt = 0u; mine = 0u;
#pragma unroll
        for (unsigned j = 0; j < 16; ++j) { const unsigned c = xb_ld(&bar[XB_XCNT(j)]); sum += c; cnt += (c > 0u) ? 1u : 0u; }
        mine = xb_ld(&bar[XB_XCNT(x)]);
        if (sum == G) break;
        __builtin_amdgcn_s_sleep(1);
        if ((++sp & 255u) == 0u) { if (xb_ld(&bar[XB_TMO])) break; if (sp > XB_SPIN_CAP) { atomicAdd(&bar[XB_TMO], 1u); break; } }
    }
    nloc = mine > 0u ? mine : 1u; nx = cnt > 0u ? cnt : 1u;
}
__device__ __forceinline__ void xcd_barrier(const XcdBarrier& b, bool leader) {
    asm volatile("s_waitcnt vmcnt(0)" ::: "memory");
    __syncthreads();
    if (leader) {
        unsigned* bar = b.bar;
        __builtin_amdgcn_s_waitcnt(0);
        unsigned nloc = b.st[0], nx = b.st[1];
        if (nloc == 0u) { xcd_barrier_complete(bar, b.x, nloc, nx); b.st[0] = nloc; b.st[1] = nx; }
        const unsigned old = xb_add(&bar[XB_XSUB(b.x)], 1u);
        const unsigned gen = old / nloc;
        if (old + 1u == (gen + 1u) * nloc) {
            __builtin_amdgcn_fence(__ATOMIC_RELEASE, "agent");
            asm volatile("s_waitcnt vmcnt(0)" ::: "memory");
            const unsigned og = xb_add(&bar[XB_TOP], 1u);
            const unsigned tg = og / nx;
            if (og + 1u == (tg + 1u) * nx) xb_add(&bar[XB_TOPGEN], 1u);
            else XB_SPIN(xb_ld(&bar[XB_TOPGEN]) == tg, bar);
            __builtin_amdgcn_fence(__ATOMIC_ACQUIRE, "agent");
            xb_add(&bar[XB_XGEN(b.x)], 1u);
            asm volatile("s_waitcnt vmcnt(0)" ::: "memory");
        } else {
            XB_SPIN(xb_ld(&bar[XB_XGEN(b.x)]) == gen, bar);
            __builtin_amdgcn_fence(__ATOMIC_ACQUIRE, "agent");
            asm volatile("s_waitcnt vmcnt(0)" ::: "memory");
        }
    }
    __syncthreads();
}

constexpr int NT = 512, NWAVES = 8;
struct Args { const float* in[24]; float* out; unsigned char* ws; int ph_lo, ph_hi; };
enum { I_X = 0, I_C, I_CTX, I_CCTX, I_WMOD, I_BMOD, I_WIN, I_WOUT, I_RPB, I_CONVW, I_CONVB, I_DTB, I_ALOG, I_DSKIP, I_NORMW, I_LNG, I_LNB, I_FG, I_FU, I_FD, I_RW, I_MG, I_MU, I_MD };
struct Frame {
    LAS unsigned char* lds;
    const float* const* in; float* out; unsigned char* ws;
    int tid, lane, wave, bid, G, gw, NGW;
};
#define LDS_WAIT() asm volatile("s_waitcnt lgkmcnt(0)" ::: "memory")
__device__ __forceinline__ Frame fresh(const Frame& F0) {
    Frame F = F0; int z; asm volatile("s_mov_b32 %0, 0" : "=s"(z)); F.ws = F0.ws + z; F.in = F0.in + z; F.out = F0.out + z;
    int ln; asm volatile("v_mbcnt_lo_u32_b32 %0, -1, 0\n\tv_mbcnt_hi_u32_b32 %0, -1, %0" : "=v"(ln));     int t = F0.wave * 64 + ln;
    F.tid = t; F.lane = t & 63; return F;
}

__device__ __forceinline__ void conv_item(const float* W, int ldn, int k0, int n0, bf16_t* dst, int K, int drow0, LAS float* scr, int lane) {
    f32x4 ld[8];
#pragma unroll
    for (int i = 0; i < 8; ++i) ld[i] = *(const f32x4*)(W + (size_t)(k0 + 8 * i + (lane >> 3)) * ldn + n0 + 4 * (lane & 7));
#pragma unroll
    for (int i = 0; i < 8; ++i) { LAS float* d = scr + (8 * i + (lane >> 3)) * 33 + 4 * (lane & 7); d[0] = ld[i][0]; d[1] = ld[i][1]; d[2] = ld[i][2]; d[3] = ld[i][3]; }
    LDS_WAIT(); asm volatile("" ::: "memory");
    const int c = lane & 7;
#pragma unroll
    for (int j = 0; j < 4; ++j) { const int n = (lane >> 3) + 8 * j; const LAS float* s = scr + (8 * c) * 33 + n;
        u32x4 o; o.x = pk2(s[0 * 33], s[1 * 33]); o.y = pk2(s[2 * 33], s[3 * 33]); o.z = pk2(s[4 * 33], s[5 * 33]); o.w = pk2(s[6 * 33], s[7 * 33]);
        *(u32x4*)(dst + (size_t)(drow0 + n) * K + k0 + 8 * c) = o; }
    LDS_WAIT(); asm volatile("" ::: "memory");
}
__device__ __forceinline__ void conv_item8(const float* W, int ldn, int k0, int n0, unsigned char* dst, int K, int drow0, float scale, LAS float* scr, int lane) {
    f32x4 ld[8];
#pragma unroll
    for (int i = 0; i < 8; ++i) ld[i] = *(const f32x4*)(W + (size_t)(k0 + 8 * i + (lane >> 3)) * ldn + n0 + 4 * (lane & 7));
#pragma unroll
    for (int i = 0; i < 8; ++i) { LAS float* d = scr + (8 * i + (lane >> 3)) * 33 + 4 * (lane & 7); d[0] = ld[i][0] * scale; d[1] = ld[i][1] * scale; d[2] = ld[i][2] * scale; d[3] = ld[i][3] * scale; }
    LDS_WAIT(); asm volatile("" ::: "memory");
    const int c = lane & 7;
#pragma unroll
    for (int j = 0; j < 4; ++j) { const int n = (lane >> 3) + 8 * j; const LAS float* sp = scr + (8 * c) * 33 + n;
        u32x2 o; o.x = pk8(sp[0 * 33], sp[1 * 33], sp[2 * 33], sp[3 * 33]); o.y = pk8(sp[4 * 33], sp[5 * 33], sp[6 * 33], sp[7 * 33]);
        *(u32x2*)(dst + (size_t)(drow0 + n) * K + k0 + 8 * c) = o; }
    LDS_WAIT(); asm volatile("" ::: "memory");
}
__device__ __forceinline__ void conv_seg(const Frame& F, const float* W, int K, int ldn, int ncols, bf16_t* dst, int mode, int& rot, int s8 = -1) {
    LAS float* scr = (LAS float*)(F.lds + F.wave * 16384);
    const int nblk = ncols / 32, nitems = (K / 64) * nblk;
    int start = F.gw - rot; if (start < 0) start += F.NGW;
    for (int it = start; it < nitems; it += F.NGW) {
        const int kb = it / nblk, nb = it % nblk, n0 = nb * 32;
        const int drow0 = (mode == 0) ? n0 : ((n0 >> 7) * 256 + (n0 & 127) + (mode == 2 ? 128 : 0));
        if (s8 >= 0) conv_item8(W, ldn, kb * 64, n0, (unsigned char*)dst, K, drow0, (float)(1 << s8), scr, F.lane);
        else conv_item(W, ldn, kb * 64, n0, dst, K, drow0, scr, F.lane);
    }
    rot = (rot + nitems) % F.NGW;
}
__device__ __forceinline__ void conv_moe(const Frame& F, int slot, int& rot) {
#if USE_FP8
    unsigned char* gu = F.ws + WS_WMGU + (size_t)slot * NEXP * 2 * DFFE * D; unsigned char* dn = F.ws + WS_WMD + (size_t)slot * NEXP * D * DFFE;
    for (int e = 0; e < NEXP; ++e) {
        const size_t so = ((size_t)slot * NEXP + e) * (size_t)D * DFFE;
        conv_seg(F, F.in[I_MG] + so, D, DFFE, DFFE, (bf16_t*)(gu + (size_t)e * 2 * DFFE * D), 1, rot, S8_WGU);
        conv_seg(F, F.in[I_MU] + so, D, DFFE, DFFE, (bf16_t*)(gu + (size_t)e * 2 * DFFE * D), 2, rot, S8_WGU);
        conv_seg(F, F.in[I_MD] + so, DFFE, D, D, (bf16_t*)(dn + (size_t)e * D * DFFE), 0, rot, S8_WD);
    }
#else
    bf16_t* gu = (bf16_t*)(F.ws + WS_WMGU); bf16_t* dn = (bf16_t*)(F.ws + WS_WMD);
    for (int e = 0; e < NEXP; ++e) {
        const size_t so = ((size_t)slot * NEXP + e) * (size_t)D * DFFE;
        conv_seg(F, F.in[I_MG] + so, D, DFFE, DFFE, gu + (size_t)e * 2 * DFFE * D, 1, rot);
        conv_seg(F, F.in[I_MU] + so, D, DFFE, DFFE, gu + (size_t)e * 2 * DFFE * D, 2, rot);
        conv_seg(F, F.in[I_MD] + so, DFFE, D, D, dn + (size_t)e * D * DFFE, 0, rot);
    }
#endif
}

constexpr int MOE_ITEMS_MAT = 1792, MOE_ITEMS_EXP = 3 * MOE_ITEMS_MAT, MOE_ITEMS_SLOT = 8 * MOE_ITEMS_EXP, MOE_ITEMS = 2 * MOE_ITEMS_SLOT;
__device__ __forceinline__ void conv_moe_item(const Frame& F, int gidx) {
    LAS float* scr = (LAS float*)(F.lds + F.wave * 16384);
    const int slot = gidx / MOE_ITEMS_SLOT, r = gidx % MOE_ITEMS_SLOT, e = r / MOE_ITEMS_EXP, r2 = r % MOE_ITEMS_EXP, mat = r2 / MOE_ITEMS_MAT, it = r2 % MOE_ITEMS_MAT;
    const size_t so = ((size_t)slot * NEXP + e) * (size_t)D * DFFE;
    if (mat < 2) { const int kb = it / 112, nb = it % 112, n0 = nb * 32; const int drow0 = (n0 >> 7) * 256 + (n0 & 127) + (mat == 1 ? 128 : 0);
        conv_item8((mat ? F.in[I_MU] : F.in[I_MG]) + so, DFFE, kb * 64, n0, F.ws + WS_WMGU + ((size_t)slot * NEXP + e) * 2 * DFFE * D, D, drow0, (float)(1 << S8_WGU), scr, F.lane); }
    else { const int kb = it / 32, nb = it % 32, n0 = nb * 32;
        conv_item8(F.in[I_MD] + so, D, kb * 64, n0, F.ws + WS_WMD + ((size_t)slot * NEXP + e) * D * DFFE, DFFE, n0, (float)(1 << S8_WD), scr, F.lane); }
}
__device__ __forceinline__ void deferred_conv(const Frame& F, int nwg, int base, int quota) {
    if (F.G != 256) return;
    const int maxu = (nwg + F.G - 1) / F.G, c0 = nwg - (maxu - 1) * F.G;
    if (c0 >= F.G || F.bid < c0) return;
    const int first = base + ((F.bid - c0) * NWAVES + F.wave) * quota;
    for (int j = 0; j < quota; ++j) { const int gidx = first + j; if (gidx < MOE_ITEMS) conv_moe_item(F, gidx); }
}
constexpr int DW_Q = 12, DW_Q2 = 10;
constexpr int DW_L0_IN = 0, DW_L0_OUT = DW_L0_IN + 64 * 8 * DW_Q, DW_L0_F1 = DW_L0_OUT + 192 * 8 * DW_Q, DW_L0_F2 = DW_L0_F1 + 160 * 8 * DW_Q, DW_L1_IN = DW_L0_F2 + 192 * 8 * DW_Q2, DW_L1_OUT = DW_L1_IN + 64 * 8 * DW_Q, DW_L2_IN = DW_L1_OUT + 192 * 8 * DW_Q, DW_END = DW_L2_IN + 64 * 8 * DW_Q;
static_assert(DW_L1_IN >= MOE_ITEMS_SLOT && DW_END >= MOE_ITEMS, "deferred conversion: layer-1 experts must be done before layer 1's FFN, all before layer 3's");
__device__ __forceinline__ void p_pro_a(const Frame& F) {
    {
        LAS float* sc = (LAS float*)F.lds; LAS float* red = sc + 17 * 1024;
        const float* c = F.in[I_C]; const float* cc = F.in[I_CCTX];
        for (int i = F.tid; i < 17 * 1024; i += NT) { const int r = i >> 10, k = i & 1023; const float v = (r < 16) ? c[r * 1024 + k] : cc[k]; sc[i] = silu_f(v); }
        __syncthreads();
        float* MOD = (float*)(F.ws + WS_MOD);
        const int col = F.tid & 31, ks = F.tid >> 5;
        for (int u = F.bid; u < 4 * 192; u += F.G) {
            const int l = u / 192, cb = u % 192;
            const float* W = F.in[I_WMOD] + (size_t)l * D * MODW + cb * 32 + col;
            float acc[17];
#pragma unroll
            for (int r = 0; r < 17; ++r) acc[r] = 0.f;
#pragma unroll 1
            for (int kb = 0; kb < 4; ++kb) { float w[16];
#pragma unroll
                for (int i = 0; i < 16; ++i) w[i] = W[(size_t)(ks * 64 + kb * 16 + i) * MODW];
#pragma unroll
                for (int i = 0; i < 16; ++i) { const int k = ks * 64 + kb * 16 + i;
#pragma unroll
                    for (int r = 0; r < 17; ++r) acc[r] += sc[r * 1024 + k] * w[i]; } }
#pragma unroll
            for (int r = 0; r < 17; ++r) red[(ks * 17 + r) * 32 + col] = acc[r];
            __syncthreads();
            for (int i = F.tid; i < 17 * 32; i += NT) { const int r = i >> 5, c2 = i & 31; float sm = 0.f;
#pragma unroll
                for (int k2 = 0; k2 < 16; ++k2) sm += red[(k2 * 17 + r) * 32 + c2];
                MOD[(size_t)(l * 17 + r) * MODW + cb * 32 + c2] = sm + F.in[I_BMOD][l * MODW + cb * 32 + c2]; }
            __syncthreads();
        }
    }
    int rot = 0;
    for (int l = 0; l < DEPTH; ++l) {
#if USE_FP8 && FP8_INPROJ
        conv_seg(F, F.in[I_WIN] + (size_t)l * D * D_IN_PROJ, D, D_IN_PROJ, NPROJ, (bf16_t*)(F.ws + WS_WIN + (size_t)l * NPROJ * D), 0, rot, S8_WGU);
#else
        conv_seg(F, F.in[I_WIN] + (size_t)l * D * D_IN_PROJ, D, D_IN_PROJ, NPROJ, (bf16_t*)(F.ws + WS_WIN) + (size_t)l * NPROJ * D, 0, rot);
#endif
        conv_seg(F, F.in[I_WOUT] + (size_t)l * D * D, D, D, D, (bf16_t*)(F.ws + WS_WOUT) + (size_t)l * D * D, 0, rot);
    }
    for (int s = 0; s < 2; ++s) {
#if USE_FP8 && FP8_DENSE1
        conv_seg(F, F.in[I_FG] + (size_t)s * D * DFF, D, DFF, DFF, (bf16_t*)(F.ws + WS_WFGU + (size_t)s * 2 * DFF * D), 1, rot, S8_WGU);
        conv_seg(F, F.in[I_FU] + (size_t)s * D * DFF, D, DFF, DFF, (bf16_t*)(F.ws + WS_WFGU + (size_t)s * 2 * DFF * D), 2, rot, S8_WGU);
#else
        conv_seg(F, F.in[I_FG] + (size_t)s * D * DFF, D, DFF, DFF, (bf16_t*)(F.ws + WS_WFGU) + (size_t)s * 2 * DFF * D, 1, rot);
        conv_seg(F, F.in[I_FU] + (size_t)s * D * DFF, D, DFF, DFF, (bf16_t*)(F.ws + WS_WFGU) + (size_t)s * 2 * DFF * D, 2, rot);
#endif
#if USE_FP8 && FP8_DENSE2
        conv_seg(F, F.in[I_FD] + (size_t)s * DFF * D, DFF, D, D, (bf16_t*)(F.ws + WS_WFD + (size_t)s * D * DFF), 0, rot, S8_WD);
#else
        conv_seg(F, F.in[I_FD] + (size_t)s * DFF * D, DFF, D, D, (bf16_t*)(F.ws + WS_WFD) + (size_t)s * D * DFF, 0, rot);
#endif
    }
    if (F.G != 256) { conv_moe(F, 0, rot); conv_moe(F, 1, rot); }
    { bf16_t* wdt = (bf16_t*)(F.ws + WS_WDT);
      for (int i = F.bid * NT + F.tid; i < DEPTH * 16 * D; i += F.G * NT) { const int l = i / (16 * D), n = (i / D) & 15, k = i % D;
          wdt[i] = (bf16_t)f2bf(F.in[I_WIN][((size_t)l * D + k) * D_IN_PROJ + NPROJ + n]); } }
}

#define RIDX(q) (8 * lane + 512 * ((q) >> 1) + 4 * ((q) & 1))
__device__ __forceinline__ void row_load(const float* p, int lane, f32x4 (&v)[4]) {
#pragma unroll
    for (int q = 0; q < 4; ++q) v[q] = *(const f32x4*)(p + RIDX(q));
}
__device__ __forceinline__ void row_store(float* p, int lane, const f32x4 (&v)[4]) {
#pragma unroll
    for (int q = 0; q < 4; ++q) *(f32x4*)(p + RIDX(q)) = v[q];
}
__device__ __forceinline__ void row_mod_store8(unsigned char* hrow, int lane, const f32x4 (&v)[4], const float* sh, const float* sc, f32x4 (&hv)[4]) {
#pragma unroll
    for (int j = 0; j < 2; ++j) { u32x2 w;
#pragma unroll
        for (int h = 0; h < 2; ++h) { const int q = 2 * j + h; const f32x4 a = *(const f32x4*)(sc + RIDX(q)), b = *(const f32x4*)(sh + RIDX(q));
            hv[q] = v[q] * (a + 1.0f) + b; const f32x4 t = hv[q] * (float)(1 << S8_ACT); const unsigned pw = pk8(t[0], t[1], t[2], t[3]); if (h == 0) w.x = pw; else w.y = pw; }
        *(u32x2*)(hrow + 8 * lane + 512 * j) = w; }
}
__device__ __forceinline__ void row_load_h(const bf16_t* p, int lane, f32x4 (&v)[4]) {
#pragma unroll
    for (int j = 0; j < 2; ++j) { const u32x4 w = *(const u32x4*)(p + 8 * lane + 512 * j); v[2 * j] = (f32x4){bflo(w.x), bfhi(w.x), bflo(w.y), bfhi(w.y)}; v[2 * j + 1] = (f32x4){bflo(w.z), bfhi(w.z), bflo(w.w), bfhi(w.w)}; }
}
__device__ __forceinline__ void row_store_h(bf16_t* p, int lane, const f32x4 (&v)[4]) {
#pragma unroll
    for (int j = 0; j < 2; ++j) { u32x4 w; w.x = pk2(v[2 * j][0], v[2 * j][1]); w.y = pk2(v[2 * j][2], v[2 * j][3]); w.z = pk2(v[2 * j + 1][0], v[2 * j + 1][1]); w.w = pk2(v[2 * j + 1][2], v[2 * j + 1][3]);
        *(u32x4*)(p + 8 * lane + 512 * j) = w; }
}
__device__ __forceinline__ void row_mod_store(bf16_t* hrow, int lane, const f32x4 (&v)[4], const float* sh, const float* sc, f32x4 (&hv)[4]) {
#pragma unroll
    for (int q = 0; q < 4; ++q) { const f32x4 a = *(const f32x4*)(sc + RIDX(q)), b = *(const f32x4*)(sh + RIDX(q)); hv[q] = v[q] * (a + 1.0f) + b; }
    row_store_h(hrow, lane, hv);
}
__device__ __forceinline__ void row_ln(f32x4 (&v)[4], const float* g, const float* b, int lane) {
    float s = 0.f;
#pragma unroll
    for (int j = 0; j < 4; ++j) s += (v[j][0] + v[j][1]) + (v[j][2] + v[j][3]);
    const float mean = wave_sum(s) * (1.0f / D); float q2 = 0.f;
#pragma unroll
    for (int j = 0; j < 4; ++j) { v[j] = v[j] - mean; q2 += (v[j][0] * v[j][0] + v[j][1] * v[j][1]) + (v[j][2] * v[j][2] + v[j][3] * v[j][3]); }
    const float rstd = 1.0f / sqrtf(wave_sum(q2) * (1.0f / D) + LN_EPS);
#pragma unroll
    for (int q = 0; q < 4; ++q) { const f32x4 gg = *(const f32x4*)(g + RIDX(q)), bb = *(const f32x4*)(b + RIDX(q)); v[q] = v[q] * rstd * gg + bb; }
}
__device__ __forceinline__ int mod_row_of(int row) { return row < NLAT ? (row >> 11) : 16; }
struct RowRaw { u32x4 x[2], d[2]; };
template <bool WITH_D> __device__ __forceinline__ void row_issue(const bf16_t* X, const bf16_t* Dl, int row, int lane, RowRaw& r) {
#pragma unroll
    for (int j = 0; j < 2; ++j) { r.x[j] = *(const u32x4*)(X + (size_t)row * D + 8 * lane + 512 * j); if (WITH_D) r.d[j] = *(const u32x4*)(Dl + (size_t)row * D + 8 * lane + 512 * j); }
}
__device__ __forceinline__ void unpack8(const u32x4 w, f32x4& lo, f32x4& hi) { lo = (f32x4){bflo(w.x), bfhi(w.x), bflo(w.y), bfhi(w.y)}; hi = (f32x4){bflo(w.z), bfhi(w.z), bflo(w.w), bfhi(w.w)}; }
__device__ __forceinline__ void row_combine(const RowRaw& r, f32x4 (&v)[4]) {
#pragma unroll
    for (int j = 0; j < 2; ++j) { f32x4 x0, x1, d0, d1; unpack8(r.x[j], x0, x1); unpack8(r.d[j], d0, d1); v[2 * j] = x0 * ALPHA + d0; v[2 * j + 1] = x1 * ALPHA + d1; }
}

__device__ __forceinline__ void p_pro_b(const Frame& F) {
    const float* MOD = (const float*)(F.ws + WS_MOD); bf16_t* H = (bf16_t*)(F.ws + WS_H); bf16_t* X = (bf16_t*)(F.ws + WS_X);
    for (int row = F.gw; row < NTOK; row += F.NGW) {
        const float* src = row < NLAT ? F.in[I_X] + (size_t)row * D : F.in[I_CTX] + (size_t)(row - NLAT) * D;
        f32x4 v[4], hv[4]; row_load(src, F.lane, v);
        row_store_h(X + (size_t)row * D, F.lane, v);
        const float* m = MOD + (size_t)mod_row_of(row) * MODW;
        row_mod_store(H + (size_t)row * D, F.lane, v, m, m + D, hv);
    }
}

__device__ __forceinline__ void p_inproj(const Frame& F, int layer) {
    const bf16_t* H = (const bf16_t*)(F.ws + WS_H);
    {
        const bf16_t* wdt = (const bf16_t*)(F.ws + WS_WDT) + (size_t)layer * 16 * D; float* DT = (float*)(F.ws + WS_DT);
        const int fr = F.lane & 15, fq = F.lane >> 4; const float dtb = F.in[I_DTB][layer * 16 + fr];
        for (int g = F.gw; g < NTOK / 16; g += F.NGW) {
            f32x4 acc = {0.f, 0.f, 0.f, 0.f};
            const bf16_t* ap = H + (size_t)(g * 16 + fr) * D + fq * 8; const bf16_t* bp = wdt + (size_t)fr * D + fq * 8;
#pragma unroll 8
            for (int ks = 0; ks < 32; ++ks) { const bf16x8 a = *(const bf16x8*)(ap + ks * 32), b = *(const bf16x8*)(bp + ks * 32);
                acc = __builtin_amdgcn_mfma_f32_16x16x32_bf16(a, b, acc, 0, 0, 0); }
#pragma unroll
            for (int r = 0; r < 4; ++r) { const float x = acc[r] + dtb; DT[(size_t)(g * 16 + fq * 4 + r) * 16 + fr] = x > 20.f ? x : log1pf(__expf(x)); }
        }
    }
    pg8::EpiBf16 E{(bf16_t*)(F.ws + WS_PROJ), NPROJ};
#if USE_FP8 && FP8_INPROJ
    pg8::Gemm g{(const bf16_t*)(F.ws + WS_H8IN), (const bf16_t*)(F.ws + WS_WIN + (size_t)layer * NPROJ * D), D / 2};
    pg8::DenseOrder S; S.init(NTOK, NPROJ, D / 2, F.G, F.bid, REP_GEMM);
    pg8::gemm_phase<pg8::EpiBf16, pg8::DenseOrder, true, FP8_SP2, true>(F.lds, g, S, E, F.tid, (127 - S8_WGU) * 0x01010101, (127 - S8_ACT) * 0x01010101);
#else
    pg8::Gemm g{H, (const bf16_t*)(F.ws + WS_WIN) + (size_t)layer * NPROJ * D, D};
    pg8::DenseOrder S; S.init(NTOK, NPROJ, D, F.G, F.bid, REP_GEMM);
    pg8::gemm_phase<pg8::EpiBf16, pg8::DenseOrder, true, true>(F.lds, g, S, E, F.tid);
#endif
    if (layer == 0) deferred_conv(F, (NTOK / 256) * (NPROJ / 256), DW_L0_IN, DW_Q); else if (layer < 3) deferred_conv(F, (NTOK / 256) * (NPROJ / 256), layer == 1 ? DW_L1_IN : DW_L2_IN, DW_Q);
}

typedef short s16x4 __attribute__((ext_vector_type(4)));
__device__ __forceinline__ s16x4 lds_tr16(LAS const unsigned char* p) { return __builtin_bit_cast(s16x4, __builtin_amdgcn_ds_read_tr16_b64_v4i16((LAS s16x4*)p)); }
constexpr int NA_KS = 144;
constexpr float LOG2E = 1.4426950408889634f;
__device__ __forceinline__ void na_unit(const Frame& F, int layer, int b, int h, int mode, int m) {
    LAS unsigned char* KV = F.lds;
    LAS float* rp = (LAS float*)(F.lds + 120832);
    const bf16_t* PROJ = (const bf16_t*)(F.ws + WS_PROJ); bf16_t* MIX = (bf16_t*)(F.ws + WS_MIX);
    const int tid = F.tid, lane = F.lane, w = F.wave, q16 = lane & 15, g = lane >> 4;
    int rbase = 0, nk = 0;
    if (mode == 0) { rbase = 2 * m - 4; rbase = rbase < 0 ? 0 : (rbase > 24 ? 24 : rbase); nk = 32 - rbase; nk = nk > 9 ? 9 : nk; }
    const int kfirst = (mode == 0) ? 0 : 576 * 8, nloc8 = nk * 64 * 8;
#define NA_STAGE(OFFS) do { int stid_ = tid; asm volatile("" : "+v"(stid_));     \
        NA_STAGE_PART(OFFS, 0, 7); __builtin_amdgcn_sched_barrier(0); NA_STAGE_PART(OFFS, 7, 13); __builtin_amdgcn_sched_barrier(0); } while (0)
#define NA_STAGE_PART(OFFS, K0, K1) do { u32x4 st_[13]; \
        _Pragma("unroll") for (int k_ = K0; k_ < K1; ++k_) { const int i_ = stid_ + kfirst + k_ * NT, key_ = i_ >> 3, ch_ = i_ & 7; const bool ok_ = (i_ < 832 * 8) && !(key_ < 576 && i_ >= nloc8); \
            const int grow_ = key_ < 576 ? b * SEQ + rbase * 64 + key_ : NLAT + b * CTX + (key_ - 576); \
            st_[k_] = ok_ ? *(const u32x4*)(PROJ + (size_t)grow_ * NPROJ + (OFFS) + h * 64 + ch_ * 8) : (u32x4){0u, 0u, 0u, 0u}; } \
        _Pragma("unroll") for (int k_ = K0; k_ < K1; ++k_) { const int i_ = stid_ + kfirst + k_ * NT, key_ = i_ >> 3, ch_ = i_ & 7; const bool ok_ = (i_ < 832 * 8) && !(key_ < 576 && i_ >= nloc8); \
            if (ok_) *(LAS u32x4*)(KV + key_ * NA_KS + ch_ * 16) = st_[k_]; } } while (0)
    __syncthreads();
    NA_STAGE(OFF_K);
    if (mode == 0 && tid < 465) rp[tid] = F.in[I_RPB][(size_t)(layer * 8 + h) * 465 + tid] * LOG2E;
    __syncthreads();
    int i = 0, j0 = 0, hs = 0, kr0 = 0, qrow;
    if (mode == 0) { i = 2 * m + (w >> 2); j0 = (w & 3) * 16; qrow = b * SEQ + i * 64 + j0; hs = j0 - 8; hs = hs < 0 ? 0 : (hs > 32 ? 32 : hs);
        int r0 = i - 4; r0 = r0 < 0 ? 0 : (r0 > 24 ? 24 : r0); kr0 = r0 - rbase; }
    else qrow = NLAT + b * CTX + m * 128 + w * 16;
    bf16x8 qf[2];
#pragma unroll
    for (int ks = 0; ks < 2; ++ks) qf[ks] = *(const bf16x8*)(PROJ + (size_t)(qrow + q16) * NPROJ + h * 64 + ks * 32 + g * 8);
    f32x4 S[32];
    const LAS unsigned char* kb = KV + q16 * NA_KS + g * 16;
    if (mode == 0) {
        const int j = j0 + q16; int cs = j - 8; cs = cs < 0 ? 0 : (cs > 48 ? 48 : cs);
        const int rb0 = (kr0 + rbase) - i + 7;
#pragma unroll
        for (int tl = 0; tl < 16; ++tl) { const int kr = tl >> 1, half = tl & 1; const int kidx0 = (kr0 + kr) * 64 + hs + 16 * half;
            f32x4 a = {0.f, 0.f, 0.f, 0.f};
#pragma unroll
            for (int ks = 0; ks < 2; ++ks) { const bf16x8 kf = *(const LAS bf16x8*)(kb + kidx0 * NA_KS + ks * 64); a = __builtin_amdgcn_mfma_f32_16x16x32_bf16(kf, qf[ks], a, 0, 0, 0); }
#pragma unroll
            for (int r = 0; r < 4; ++r) { const int kc = hs + 16 * half + 4 * g + r; const bool inw = (kc >= cs) && (kc < cs + 16);
                int cbi = kc - j + 15; cbi = cbi < 0 ? 0 : (cbi > 30 ? 30 : cbi);
                a[r] = inw ? a[r] * (0.125f * LOG2E) + rp[(rb0 + kr) * 31 + cbi] : -INFINITY; }
            S[tl] = a; if ((tl & 1) == 1) __builtin_amdgcn_sched_barrier(0); }
    } else {
#pragma unroll
        for (int tl = 0; tl < 16; ++tl) S[tl] = (f32x4){-INFINITY, -INFINITY, -INFINITY, -INFINITY};
    }
#pragma unroll
    for (int tc = 0; tc < 16; ++tc) { const int kidx0 = 576 + 16 * tc; f32x4 a = {0.f, 0.f, 0.f, 0.f};
#pragma unroll
        for (int ks = 0; ks < 2; ++ks) { const bf16x8 kf = *(const LAS bf16x8*)(kb + kidx0 * NA_KS + ks * 64); a = __builtin_amdgcn_mfma_f32_16x16x32_bf16(kf, qf[ks], a, 0, 0, 0); }
        S[16 + tc] = a * (0.125f * LOG2E); if ((tc & 1) == 1) __builtin_amdgcn_sched_barrier(0); }
    float mx = -INFINITY;
#pragma unroll
    for (int t = 0; t < 32; ++t) mx = fmaxf(fmaxf(fmaxf(S[t][0], S[t][1]), fmaxf(S[t][2], S[t][3])), mx);
    mx = fmaxf(mx, __shfl_xor(mx, 16)); mx = fmaxf(mx, __shfl_xor(mx, 32));
    float sum = 0.f; u32x4 P[16];
#pragma unroll
    for (int kk = 0; kk < 16; ++kk) { float e[8];
#pragma unroll
        for (int r = 0; r < 4; ++r) { e[r] = __builtin_amdgcn_exp2f(S[2 * kk][r] - mx); e[4 + r] = __builtin_amdgcn_exp2f(S[2 * kk + 1][r] - mx); }
        sum += ((e[0] + e[1]) + (e[2] + e[3])) + ((e[4] + e[5]) + (e[6] + e[7]));
        P[kk].x = pg8::cvt_pk_bf16_pin(e[0], e[1]); P[kk].y = pg8::cvt_pk_bf16_pin(e[2], e[3]); P[kk].z = pg8::cvt_pk_bf16_pin(e[4], e[5]); P[kk].w = pg8::cvt_pk_bf16_pin(e[6], e[7]); }
    sum += __shfl_xor(sum, 16); sum += __shfl_xor(sum, 32);
    const float inv = 1.0f / sum;
    __syncthreads();
    NA_STAGE(OFF_V);
    __syncthreads();
    f32x4 o[4];
#pragma unroll
    for (int dt = 0; dt < 4; ++dt) o[dt] = (f32x4){0.f, 0.f, 0.f, 0.f};
    const LAS unsigned char* vb = KV + (4 * g + (q16 >> 2)) * NA_KS + (q16 & 3) * 8;
#pragma unroll
    for (int kk = 0; kk < 16; ++kk) {
        if (kk < 8 && mode != 0) continue;
        const int kidx0 = (kk < 8) ? (kr0 + kk) * 64 + hs : 576 + 32 * (kk - 8);
        const bf16x8 pa = __builtin_bit_cast(bf16x8, P[kk]);
#pragma unroll
        for (int dt = 0; dt < 4; ++dt) { const s16x4 lo = lds_tr16(vb + kidx0 * NA_KS + dt * 32), hi = lds_tr16(vb + (kidx0 + 16) * NA_KS + dt * 32);
            const bf16x8 vf = {lo[0], lo[1], lo[2], lo[3], hi[0], hi[1], hi[2], hi[3]};
            o[dt] = __builtin_amdgcn_mfma_f32_16x16x32_bf16(pa, vf, o[dt], 0, 0, 0); }
    }
#undef NA_STAGE
#undef NA_STAGE_PART
#pragma unroll
    for (int r = 0; r < 4; ++r) { const float ir = __shfl(inv, 4 * g + r);
        bf16_t* op = MIX + (size_t)(qrow + 4 * g + r) * D + h * 64 + q16;
#pragma unroll
        for (int dt = 0; dt < 4; dt += 2) { const unsigned pw = pk2(o[dt][r] * ir, o[dt + 1][r] * ir); op[dt * 16] = (bf16_t)(pw & 0xffffu); op[dt * 16 + 16] = (bf16_t)(pw >> 16); } }
}

struct PrepassW { f32x4 w[5][2]; f32x4 b[2]; float ifq[8]; };
__device__ __forceinline__ void ssd_prepass_unit(const Frame& F, int u, const PrepassW& W) {
    const bf16_t* PROJ = (const bf16_t*)(F.ws + WS_PROJ); bf16_t* U = (bf16_t*)(F.ws + WS_U);
    int rowbase, t0, L; bool lat;
    if (u < NLAT / 16) { rowbase = (u >> 7) * SEQ; t0 = (u & 127) * 16; L = SEQ; lat = true; }
    else { const int v = u - NLAT / 16; rowbase = NLAT + (v >> 4) * CTX; t0 = (v & 15) * 16; L = CTX; lat = false; }
    const int cg = F.tid & 127, tq = F.tid >> 7, c0 = 8 * cg, tb = t0 + 4 * tq;
    u32x4 win[8];
#pragma unroll
    for (int j = 0; j < 8; ++j) { const int t = tb - 2 + j; win[j] = (t >= 0 && t < L) ? *(const u32x4*)(PROJ + (size_t)(rowbase + t) * NPROJ + OFF_XBC + c0) : (u32x4){0u, 0u, 0u, 0u}; }
    const int lc = c0 & 127, hf = lc >> 6, role = (lc >> 5) & 1; const bool rope = lat && (c0 >= 512);
#pragma unroll
    for (int tt = 0; tt < 4; ++tt) {
        f32x4 a0 = W.b[0], a1 = W.b[1];
#pragma unroll
        for (int j = 0; j < 5; ++j) { const u32x4 r = win[tt + j];
            a0 += W.w[j][0] * (f32x4){bflo(r.x), bfhi(r.x), bflo(r.y), bfhi(r.y)}; a1 += W.w[j][1] * (f32x4){bflo(r.z), bfhi(r.z), bflo(r.w), bfhi(r.w)}; }
        float uu[8];
#pragma unroll
        for (int k = 0; k < 4; ++k) { uu[k] = silu_f(a0[k]); uu[4 + k] = silu_f(a1[k]); }
        if (rope) {
            const int tk = tb + tt; const float pos = (float)(hf ? (tk & 63) : (tk >> 6));
#pragma unroll
            for (int k = 0; k < 8; ++k) { const float o = __shfl_xor(uu[k], 4); const float sn = __builtin_amdgcn_sinf(pos * W.ifq[k]), cs = __builtin_amdgcn_cosf(pos * W.ifq[k]);
                uu[k] = role ? (o * sn + uu[k] * cs) : (uu[k] * cs - o * sn); }
        }
        u32x4 o; o.x = pk2(uu[0], uu[1]); o.y = pk2(uu[2], uu[3]); o.z = pk2(uu[4], uu[5]); o.w = pk2(uu[6], uu[7]);
        *(u32x4*)(U + (size_t)(rowbase + tb + tt) * 1024 + c0) = o;
    }
}
__device__ __forceinline__ void ssd_prepass_weights(const Frame& F, int layer, PrepassW& W) {
    const int c0 = 8 * (F.tid & 127);
    const float* cwp = F.in[I_CONVW] + (size_t)layer * 5 * 1024 + c0;
#pragma unroll
    for (int j = 0; j < 5; ++j) { W.w[j][0] = *(const f32x4*)(cwp + j * 1024); W.w[j][1] = *(const f32x4*)(cwp + j * 1024 + 4); }
    W.b[0] = *(const f32x4*)(F.in[I_CONVB] + (size_t)layer * 1024 + c0); W.b[1] = *(const f32x4*)(F.in[I_CONVB] + (size_t)layer * 1024 + c0 + 4);
    const int n0 = c0 & 31;
#pragma unroll
    for (int k = 0; k < 8; ++k) W.ifq[k] = __builtin_amdgcn_exp2f(-(float)(n0 + k) * (13.287712379549449f / 32.0f)) * 0.15915494309189535f;
}

constexpr int S_CQ = 0, S_BQ = 17408, S_XN = 34816, S_XW = 44032, S_OPS = 53248, S_HB = 2 * S_OPS, S_MISC = S_HB + 2 * 17408, S_END = S_MISC + 3 * 1088;
static_assert(S_END <= LDS_ROWOFF + 18432, "SSD LDS image must stay below the control words");
__device__ __forceinline__ void ssd_chunk_compute(const LAS unsigned char* O, const LAS float* misc, const LAS unsigned char* HB, LAS unsigned char* HN, f32x4 (&Hacc)[4],
                                                  bf16_t* yp, int w, int q16, int gq, bool skip, float dsk) {
    const int lt = w >> 1, t2 = (w & 1) * 2;
    bf16x8 cfr[4];
#pragma unroll
    for (int ks = 0; ks < 4; ++ks) cfr[ks] = *(const LAS bf16x8*)(O + S_CQ + (16 * lt + q16) * 272 + ks * 64 + gq * 16);
    u32x4 pm[2];
    {
        const float csl = misc[64 + 16 * lt + q16];
#pragma unroll
        for (int pr = 0; pr < 2; ++pr) {
            f32x4 v[2];
#pragma unroll
            for (int hh = 0; hh < 2; ++hh) { const int st = 2 * pr + hh; f32x4 a = {0.f, 0.f, 0.f, 0.f};
                if (st <= lt) {
#pragma unroll
                    for (int ks = 0; ks < 4; ++ks) { const bf16x8 bfr = *(const LAS bf16x8*)(O + S_BQ + (16 * st + q16) * 272 + ks * 64 + gq * 16); a = __builtin_amdgcn_mfma_f32_16x16x32_bf16(bfr, cfr[ks], a, 0, 0, 0); }
                    const f32x4 css = *(const LAS f32x4*)(misc + 64 + 16 * st + 4 * gq), dts = *(const LAS f32x4*)(misc + 16 * st + 4 * gq);
#pragma unroll
                    for (int r = 0; r < 4; ++r) { const int sidx = 16 * st + 4 * gq + r; a[r] = (sidx <= 16 * lt + q16) ? a[r] * __expf(csl - css[r]) * dts[r] : 0.f; }
                }
                v[hh] = a; }
            pm[pr].x = pk2(v[0][0], v[0][1]); pm[pr].y = pk2(v[0][2], v[0][3]); pm[pr].z = pk2(v[1][0], v[1][1]); pm[pr].w = pk2(v[1][2], v[1][3]);
        }
    }
    {
        const float ecs = misc[128 + 16 * lt + q16];
        const LAS unsigned char* xtr = O + S_XN + (4 * gq + (q16 >> 2)) * 144 + (q16 & 3) * 8;
#pragma unroll
        for (int k = 0; k < 2; ++k) { const int pt = t2 + k; f32x4 a = {0.f, 0.f, 0.f, 0.f};
#pragma unroll
            for (int ks = 0; ks < 4; ++ks) { const bf16x8 hfr = *(const LAS bf16x8*)(HB + (16 * pt + q16) * 272 + ks * 64 + gq * 16); a = __builtin_amdgcn_mfma_f32_16x16x32_bf16(hfr, cfr[ks], a, 0, 0, 0); }
            a = a * ecs;
#pragma unroll
            for (int pr = 0; pr < 2; ++pr) if (2 * pr <= lt) { const s16x4 lo = lds_tr16(xtr + (32 * pr) * 144 + pt * 32), hi = lds_tr16(xtr + (32 * pr + 16) * 144 + pt * 32);
                const bf16x8 xf = {lo[0], lo[1], lo[2], lo[3], hi[0], hi[1], hi[2], hi[3]};
                a = __builtin_amdgcn_mfma_f32_16x16x32_bf16(xf, __builtin_bit_cast(bf16x8, pm[pr]), a, 0, 0, 0); }
            if (skip) { const u32x2 xv = *(const LAS u32x2*)(O + S_XN + (16 * lt + q16) * 144 + (16 * pt + 4 * gq) * 2);
                a[0] += dsk * bflo(xv.x); a[1] += dsk * bfhi(xv.x); a[2] += dsk * bflo(xv.y); a[3] += dsk * bfhi(xv.y); }
            { u32x2 ow; ow.x = pk2(a[0], a[1]); ow.y = pk2(a[2], a[3]); *(u32x2*)(yp + 16 * pt + 4 * gq) = ow; } }
    }
    {
        const int pt2 = w & 3, nb = (w >> 2) * 4; const float et = misc[256];
        const LAS unsigned char* xwtr = O + S_XW + (4 * gq + (q16 >> 2)) * 144 + (q16 & 3) * 8 + pt2 * 32;
        const LAS unsigned char* btr = O + S_BQ + (4 * gq + (q16 >> 2)) * 272 + (q16 & 3) * 8;
        bf16x8 xf2[2];
#pragma unroll
        for (int kk = 0; kk < 2; ++kk) { const s16x4 lo = lds_tr16(xwtr + (32 * kk) * 144), hi = lds_tr16(xwtr + (32 * kk + 16) * 144); xf2[kk] = (bf16x8){lo[0], lo[1], lo[2], lo[3], hi[0], hi[1], hi[2], hi[3]}; }
#pragma unroll
        for (int j = 0; j < 4; ++j) { const int nt = nb + j; Hacc[j] = Hacc[j] * et;
#pragma unroll
            for (int kk = 0; kk < 2; ++kk) { const s16x4 lo = lds_tr16(btr + (32 * kk) * 272 + nt * 32), hi = lds_tr16(btr + (32 * kk + 16) * 272 + nt * 32);
                const bf16x8 bT = {lo[0], lo[1], lo[2], lo[3], hi[0], hi[1], hi[2], hi[3]};
                Hacc[j] = __builtin_amdgcn_mfma_f32_16x16x32_bf16(bT, xf2[kk], Hacc[j], 0, 0, 0); }
            u32x2 hw; hw.x = pk2(Hacc[j][0], Hacc[j][1]); hw.y = pk2(Hacc[j][2], Hacc[j][3]);
            *(LAS u32x2*)(HN + (16 * pt2 + q16) * 272 + (16 * nt + 4 * gq) * 2) = hw; }
    }
}
struct SsdPre { u32x4 x, b[2], c[2]; float dt; };
__device__ __forceinline__ void ssd_mfma_unit(const Frame& F, int layer, int b, int h, int dir) {
    const int g = h >> 2, tid = F.tid, lane = F.lane, w = F.wave, q16 = lane & 15, gq = lane >> 4;
    const bf16_t* U = (const bf16_t*)(F.ws + WS_U); const float* DTS = (const float*)(F.ws + WS_DT);
    bf16_t* Y = (bf16_t*)(F.ws + (dir ? WS_YB : WS_YF));
    const float aneg = -__expf(F.in[I_ALOG][layer * 16 + dir * 8 + h]), dsk = F.in[I_DSKIP][layer * 8 + h];
    LAS unsigned char* L = F.lds;
    __syncthreads();
    for (int i = tid; i < 64 * 272 / 16; i += NT) *(LAS u32x4*)(L + S_HB + i * 16) = (u32x4){0u, 0u, 0u, 0u};
    f32x4 Hacc[4];
#pragma unroll
    for (int j = 0; j < 4; ++j) Hacc[j] = (f32x4){0.f, 0.f, 0.f, 0.f};
    SsdPre P0, P1;
    P0.dt = 0.f; P1.dt = 0.f;
    const int xt = tid >> 3, xp = tid & 7;
    const int bt = tid >> 4, bp = tid & 15;
#define SSD_ROW(ci_, l_) ({ const int s_ = (ci_) < 4 ? 0 : 1, k_ = s_ ? (ci_) - 4 : (ci_), nc_ = s_ ? 32 : 4, c_ = dir ? nc_ - 1 - k_ : k_; \
        (s_ ? b * SEQ : NLAT + b * CTX) + c_ * 64 + (dir ? 63 - (l_) : (l_)); })
#define SSD_PREFETCH(ci_, P_) do { P_.x = *(const u32x4*)(U + (size_t)SSD_ROW(ci_, xt) * 1024 + h * 64 + xp * 8); \
        if (w == 0) P_.dt = DTS[(size_t)SSD_ROW(ci_, lane) * 16 + dir * 8 + h]; \
        _Pragma("unroll") for (int j2_ = 0; j2_ < 2; ++j2_) { const int tok_ = bt + 32 * j2_; const size_t ro_ = (size_t)SSD_ROW(ci_, tok_) * 1024; \
            P_.b[j2_] = *(const u32x4*)(U + ro_ + 512 + g * 128 + bp * 8); P_.c[j2_] = *(const u32x4*)(U + ro_ + 768 + g * 128 + bp * 8); } } while (0)
#define SSD_MISC(slot_, P_) do { LAS float* m_ = (LAS float*)(L + S_MISC) + (slot_) * 272; const float dt_ = P_.dt; const float cs_ = wave_scan(dt_ * aneg); \
        const float tot_ = __builtin_bit_cast(float, __builtin_amdgcn_readlane(__builtin_bit_cast(int, cs_), 63)); \
        m_[lane] = dt_; m_[64 + lane] = cs_; m_[128 + lane] = __expf(cs_); m_[192 + lane] = __expf(tot_ - cs_) * dt_; if (lane == 0) m_[256] = __expf(tot_); } while (0)
#define SSD_STAGE(set_, slot_, P_) do { LAS unsigned char* O_ = L + (set_) * S_OPS; const float wl = ((const LAS float*)(L + S_MISC))[(slot_) * 272 + 192 + xt]; \
        *(LAS u32x4*)(O_ + S_XN + xt * 144 + xp * 16) = P_.x; \
        u32x4 xw; xw.x = pk2(bflo(P_.x.x) * wl, bfhi(P_.x.x) * wl); xw.y = pk2(bflo(P_.x.y) * wl, bfhi(P_.x.y) * wl); xw.z = pk2(bflo(P_.x.z) * wl, bfhi(P_.x.z) * wl); xw.w = pk2(bflo(P_.x.w) * wl, bfhi(P_.x.w) * wl); \
        *(LAS u32x4*)(O_ + S_XW + xt * 144 + xp * 16) = xw; \
        _Pragma("unroll") for (int k = 0; k < 2; ++k) { *(LAS u32x4*)(O_ + S_BQ + (bt + 32 * k) * 272 + bp * 16) = P_.b[k]; *(LAS u32x4*)(O_ + S_CQ + (bt + 32 * k) * 272 + bp * 16) = P_.c[k]; } } while (0)
#define SSD_ITER(ci_, PN_, PC_) do { const int ci = (ci_); const int ms1 = ms == 2 ? 0 : ms + 1, ms2 = ms1 == 2 ? 0 : ms1 + 1; \
        if (ci + 1 < 36) SSD_STAGE(cur ^ 1, ms1, PN_); \
        if (ci + 3 < 36) SSD_PREFETCH(ci + 3, PN_); \
        TPS(0); \
        { const int row0 = SSD_ROW(ci, 16 * (w >> 1) + q16); \
          ssd_chunk_compute(L + cur * S_OPS, (const LAS float*)(L + S_MISC) + ms * 272, L + S_HB + cur * 17408, L + S_HB + (cur ^ 1) * 17408, Hacc, Y + (size_t)row0 * 512 + h * 64, w, q16, gq, dir == 0, dsk); } \
        TPS(2); \
        if (w == 0 && ci + 2 < 36) SSD_MISC(ms2, PC_); \
        __syncthreads(); \
        TPS(3); \
        cur ^= 1; ms = ms1; } while (0)
    SSD_PREFETCH(0, P0);
    if (w == 0) SSD_MISC(0, P0);
    __syncthreads();
    SSD_STAGE(0, 0, P0);
    SSD_PREFETCH(1, P1);
    SSD_PREFETCH(2, P0);
    if (w == 0) SSD_MISC(1, P1);
    __syncthreads();
    TPS_BEGIN;
    int cur = 0, ms = 0;
    for (int c2 = 0; c2 < 36; c2 += 2) { SSD_ITER(c2, P1, P0); SSD_ITER(c2 + 1, P0, P1); }
#undef SSD_ROW
#undef SSD_PREFETCH
#undef SSD_MISC
#undef SSD_STAGE
#undef SSD_ITER
}

__device__ __forceinline__ void na_run(const Frame& F, int layer) {
    LAS unsigned char* KV = F.lds; LAS float* rp = (LAS float*)(F.lds + 120832);
    const bf16_t* PROJ = (const bf16_t*)(F.ws + WS_PROJ); bf16_t* MIX = (bf16_t*)(F.ws + WS_MIX);
    const int tid = F.tid, lane = F.lane, w = F.wave, q16 = lane & 15, g = lane >> 4;
    u32x4 pre[13];
#define NA_VPRE 13
#define NA_RB(m_) ({ int rb_ = 2 * (m_) - 4; rb_ = rb_ < 0 ? 0 : (rb_ > 24 ? 24 : rb_); __builtin_amdgcn_readfirstlane(rb_); })
#define NA_NL(rb_) ({ int nk_ = 32 - (rb_); nk_ = nk_ > 9 ? 9 : nk_; __builtin_amdgcn_readfirstlane(nk_ * 64 * 8); })
#define NA_LOAD(OFFS, b_, h_, rb_, nl_, K0, K1) do { int stid_ = tid; asm volatile("" : "+v"(stid_)); \
        _Pragma("unroll") for (int k_ = K0; k_ < K1; ++k_) { const int i_ = stid_ + k_ * NT, key_ = i_ >> 3, ch_ = i_ & 7; const bool ok_ = !(key_ < 576 && i_ >= (nl_)); \
            const int grow_ = key_ < 576 ? (b_) * SEQ + (rb_) * 64 + key_ : NLAT + (b_) * CTX + (key_ - 576); \
            pre[k_] = ok_ ? *(const u32x4*)(PROJ + (size_t)grow_ * NPROJ + (OFFS) + (h_) * 64 + ch_ * 8) : (u32x4){0u, 0u, 0u, 0u}; } } while (0)
#define NA_WRITE(nl_, K0, K1) do { int stid_ = tid; asm volatile("" : "+v"(stid_)); \
        _Pragma("unroll") for (int k_ = K0; k_ < K1; ++k_) { const int i_ = stid_ + k_ * NT, key_ = i_ >> 3, ch_ = i_ & 7; const bool ok_ = !(key_ < 576 && i_ >= (nl_)); \
            if (ok_) *(LAS u32x4*)(KV + key_ * NA_KS + ch_ * 16) = pre[k_]; } } while (0)
    int u = __builtin_amdgcn_readfirstlane(F.bid); int hprev = -1;
    if (u < 2048) { const int b = u >> 7, h = (u >> 4) & 7, m = u & 15, rb = NA_RB(m); NA_LOAD(OFF_K, b, h, rb, NA_NL(rb), 0, 13); }
    TPS_BEGIN;
    for (; u < 2048; u += F.G) {
        const int b = u >> 7, h = (u >> 4) & 7, m = u & 15, rbase = NA_RB(m), nloc8 = NA_NL(rbase);
        TPS(14);
        __syncthreads();
        TPS(10);
        NA_WRITE(nloc8, 0, 13);
        if (h != hprev) { if (tid < 465) rp[tid] = F.in[I_RPB][(size_t)(layer * 8 + h) * 465 + tid] * LOG2E; hprev = h; }
        NA_LOAD(OFF_V, b, h, rbase, nloc8, 0, NA_VPRE);
        __syncthreads();
        TPS(11);
        const int i = 2 * m + (w >> 2), j0 = (w & 3) * 16, qrow = b * SEQ + i * 64 + j0; int hs = j0 - 8; hs = hs < 0 ? 0 : (hs > 32 ? 32 : hs);
        int r0 = i - 4; r0 = r0 < 0 ? 0 : (r0 > 24 ? 24 : r0); const int kr0 = r0 - rbase;
        bf16x8 qf[2];
#pragma unroll
        for (int ks = 0; ks < 2; ++ks) qf[ks] = *(const bf16x8*)(PROJ + (size_t)(qrow + q16) * NPROJ + h * 64 + ks * 32 + g * 8);
        f32x4 S[32];
        const LAS unsigned char* kb = KV + q16 * NA_KS + g * 16;
        { const int j = j0 + q16; int cs = j - 8; cs = cs < 0 ? 0 : (cs > 48 ? 48 : cs);
          const int rb0 = (kr0 + rbase) - i + 7;
#pragma unroll
          for (int tl = 0; tl < 16; ++tl) { const int kr = tl >> 1, half = tl & 1; const int kidx0 = (kr0 + kr) * 64 + hs + 16 * half;
              f32x4 a = {0.f, 0.f, 0.f, 0.f};
#pragma unroll
              for (int ks = 0; ks < 2; ++ks) { const bf16x8 kf = *(const LAS bf16x8*)(kb + kidx0 * NA_KS + ks * 64); a = __builtin_amdgcn_mfma_f32_16x16x32_bf16(kf, qf[ks], a, 0, 0, 0); }
#pragma unroll
              for (int r = 0; r < 4; ++r) { const int kc = hs + 16 * half + 4 * g + r; const bool inw = (kc >= cs) && (kc < cs + 16);
                  int cbi = kc - j + 15; cbi = cbi < 0 ? 0 : (cbi > 30 ? 30 : cbi);
                  const float bias = rp[(rb0 + kr) * 31 + cbi];
                  const float t = a[r] * (0.125f * LOG2E) + bias; a[r] = inw ? t : -INFINITY; }
              S[tl] = a; if ((tl & 1) == 1) __builtin_amdgcn_sched_barrier(0); } }
#pragma unroll
        for (int tc = 0; tc < 16; ++tc) { const int kidx0 = 576 + 16 * tc; f32x4 a = {0.f, 0.f, 0.f, 0.f};
#pragma unroll
            for (int ks = 0; ks < 2; ++ks) { const bf16x8 kf = *(const LAS bf16x8*)(kb + kidx0 * NA_KS + ks * 64); a = __builtin_amdgcn_mfma_f32_16x16x32_bf16(kf, qf[ks], a, 0, 0, 0); }
            S[16 + tc] = a * (0.125f * LOG2E); if ((tc & 1) == 1) __builtin_amdgcn_sched_barrier(0); }
        float mx = -INFINITY;
#pragma unroll
        for (int t = 0; t < 32; ++t) mx = fmaxf(fmaxf(fmaxf(S[t][0], S[t][1]), fmaxf(S[t][2], S[t][3])), mx);
        mx = fmaxf(mx, __shfl_xor(mx, 16)); mx = fmaxf(mx, __shfl_xor(mx, 32));
        float sum = 0.f; u32x4 P[16];
#pragma unroll
        for (int kk = 0; kk < 16; ++kk) { float e[8];
#pragma unroll
            for (int r = 0; r < 4; ++r) { e[r] = __builtin_amdgcn_exp2f(S[2 * kk][r] - mx); e[4 + r] = __builtin_amdgcn_exp2f(S[2 * kk + 1][r] - mx); }
            sum += ((e[0] + e[1]) + (e[2] + e[3])) + ((e[4] + e[5]) + (e[6] + e[7]));
            P[kk].x = pg8::cvt_pk_bf16_pin(e[0], e[1]); P[kk].y = pg8::cvt_pk_bf16_pin(e[2], e[3]); P[kk].z = pg8::cvt_pk_bf16_pin(e[4], e[5]); P[kk].w = pg8::cvt_pk_bf16_pin(e[6], e[7]); }
        sum += __shfl_xor(sum, 16); sum += __shfl_xor(sum, 32);
        const float inv = 1.0f / sum;
        TPS(12);
        __syncthreads();
        NA_WRITE(nloc8, 0, NA_VPRE); NA_LOAD(OFF_V, b, h, rbase, nloc8, NA_VPRE, 13); NA_WRITE(nloc8, NA_VPRE, 13);
        { const int un = u + F.G; if (un < 2048) { const int bn = un >> 7, hn = (un >> 4) & 7, mn = un & 15, rbn = NA_RB(mn); NA_LOAD(OFF_K, bn, hn, rbn, NA_NL(rbn), 0, 13); } }
        __syncthreads();
        TPS(13);
        f32x4 o[4];
#pragma unroll
        for (int dt = 0; dt < 4; ++dt) o[dt] = (f32x4){0.f, 0.f, 0.f, 0.f};
        const LAS unsigned char* vb = KV + (4 * g + (q16 >> 2)) * NA_KS + (q16 & 3) * 8;
#pragma unroll
        for (int kk = 0; kk < 16; ++kk) {
            const int kidx0 = (kk < 8) ? (kr0 + kk) * 64 + hs : 576 + 32 * (kk - 8);
            const bf16x8 pa = __builtin_bit_cast(bf16x8, P[kk]);
#pragma unroll
            for (int dt = 0; dt < 4; ++dt) { const s16x4 lo = lds_tr16(vb + kidx0 * NA_KS + dt * 32), hi = lds_tr16(vb + (kidx0 + 16) * NA_KS + dt * 32);
                const bf16x8 vf = {lo[0], lo[1], lo[2], lo[3], hi[0], hi[1], hi[2], hi[3]};
                o[dt] = __builtin_amdgcn_mfma_f32_16x16x32_bf16(vf, pa, o[dt], 0, 0, 0); }
            if ((kk & 1) == 1) __builtin_amdgcn_sched_barrier(0);
        }
        { bf16_t* op = MIX + (size_t)(qrow + q16) * D + h * 64 + 4 * g;
#pragma unroll
          for (int dt = 0; dt < 4; ++dt) { u32x2 ow; ow.x = pk2(o[dt][0] * inv, o[dt][1] * inv); ow.y = pk2(o[dt][2] * inv, o[dt][3] * inv); *(u32x2*)(op + dt * 16) = ow; } }
    }
#undef NA_RB
#undef NA_NL
#undef NA_LOAD
#undef NA_WRITE
}
__device__ __forceinline__ void p_mixa(const Frame& F, int layer, bool last) {
    TPS_BEGIN;
    { PrepassW W; ssd_prepass_weights(F, layer, W);
      for (int u = F.bid; u < NTOK / 16; u += F.G) ssd_prepass_unit(F, u, W); }
    TPS(4);
    na_run(F, layer);
    TPS(5);
    if (!last) for (int u = F.bid; u < 256; u += F.G) na_unit(F, layer, u >> 4, (u >> 1) & 7, 1, u & 1);
    TPS(6);
}
__device__ __forceinline__ void p_mixb(const Frame& F, int layer) {
    for (int u0 = F.bid; u0 < 256 * REP_SSD; u0 += F.G) { const int u = u0 & 255; ssd_mfma_unit(F, layer, u >> 4, (u >> 1) & 7, u & 1); }
}

__device__ __forceinline__ void p_ssdcomb(const Frame& F, int layer, bool last) {
    const bf16_t* PROJ = (const bf16_t*)(F.ws + WS_PROJ); bf16_t* MIX = (bf16_t*)(F.ws + WS_MIX);
    const bf16_t* YF = (const bf16_t*)(F.ws + WS_YF); const bf16_t* YB = (const bf16_t*)(F.ws + WS_YB);
    const float* nw = F.in[I_NORMW] + layer * 512 + F.lane * 8;
    const f32x4 nw0 = *(const f32x4*)nw, nw1 = *(const f32x4*)(nw + 4);
    const int nrows = last ? NLAT : NTOK;
    u32x4 pyf = {0u, 0u, 0u, 0u}, pyb = pyf, pz = pyf;
#define SC_LOAD(r_) do { const size_t o_ = (size_t)(r_) * 512 + F.lane * 8; pyf = *(const u32x4*)(YF + o_); pyb = *(const u32x4*)(YB + o_); \
        pz = *(const u32x4*)(PROJ + (size_t)(r_) * NPROJ + OFF_Z + F.lane * 8); } while (0)
    if (F.gw < nrows) SC_LOAD(F.gw);
    for (int row = F.gw; row < nrows; row += F.NGW) {
        const f32x4 a0 = {bflo(pyf.x) + bflo(pyb.x), bfhi(pyf.x) + bfhi(pyb.x), bflo(pyf.y) + bflo(pyb.y), bfhi(pyf.y) + bfhi(pyb.y)}, a1 = {bflo(pyf.z) + bflo(pyb.z), bfhi(pyf.z) + bfhi(pyb.z), bflo(pyf.w) + bflo(pyb.w), bfhi(pyf.w) + bfhi(pyb.w)}; const u32x4 zv = pz;
        if (row + F.NGW < nrows) SC_LOAD(row + F.NGW);
        float y[8] = {a0[0] * silu_f(bflo(zv.x)), a0[1] * silu_f(bfhi(zv.x)), a0[2] * silu_f(bflo(zv.y)), a0[3] * silu_f(bfhi(zv.y)),
                      a1[0] * silu_f(bflo(zv.z)), a1[1] * silu_f(bfhi(zv.z)), a1[2] * silu_f(bflo(zv.w)), a1[3] * silu_f(bfhi(zv.w))};
        float ss = 0.f;
#pragma unroll
        for (int k = 0; k < 8; ++k) ss += y[k] * y[k];
#pragma unroll
        for (int of = 1; of < 32; of <<= 1) ss += __shfl_xor(ss, of);
        const float rs = 1.0f / sqrtf(ss * (1.0f / 256.0f) + RMS_EPS);
        u32x4 w; w.x = pk2(y[0] * rs * nw0[0], y[1] * rs * nw0[1]); w.y = pk2(y[2] * rs * nw0[2], y[3] * rs * nw0[3]);
        w.z = pk2(y[4] * rs * nw1[0], y[5] * rs * nw1[1]); w.w = pk2(y[6] * rs * nw1[2], y[7] * rs * nw1[3]);
        *(u32x4*)(MIX + (size_t)row * D + 512 + F.lane * 8) = w;
    }
}

__device__ __forceinline__ void p_outproj(const Frame& F, int layer, bool last) {
    pg8::Gemm g{(const bf16_t*)(F.ws + WS_MIX), (const bf16_t*)(F.ws + WS_WOUT) + (size_t)layer * D * D, D};
    pg8::DenseOrder S; S.init(last ? NLAT : NTOK, D, D, F.G, F.bid);
    pg8::EpiGate E{(bf16_t*)(F.ws + WS_DELTA1), (const float*)(F.ws + WS_MOD) + (size_t)layer * 17 * MODW, 2 * D};
    pg8::gemm_phase<pg8::EpiGate, pg8::DenseOrder, true, true>(F.lds, g, S, E, F.tid);
    if (layer == 0) deferred_conv(F, (NTOK / 256) * (D / 256), DW_L0_OUT, DW_Q); else if (layer == 1) deferred_conv(F, (NTOK / 256) * (D / 256), DW_L1_OUT, DW_Q);
}

__device__ __forceinline__ unsigned* cnt_word(const Frame& F, int slot, int hf, int e) { return (unsigned*)(F.ws + WS_CTL) + CW_CNT + ((slot * 2 + hf) * 8 + e) * 64; }
__device__ __forceinline__ void p_ln1(const Frame& F, int layer, bool last) {
    bf16_t* X = (bf16_t*)(F.ws + WS_X); bf16_t* H = (bf16_t*)(F.ws + WS_H);
    const float* MOD = (const float*)(F.ws + WS_MOD) + (size_t)layer * 17 * MODW;
    const float* lg = F.in[I_LNG] + (size_t)(layer * 2) * D; const float* lb = F.in[I_LNB] + (size_t)(layer * 2) * D;
    const bool moe = layer & 1; const int slot = layer >> 1;
    const int nrows = last ? NLAT : NTOK;
    float rw[16][8];
    if (moe) { const float* R = F.in[I_RW] + (size_t)slot * D * 8;
#pragma unroll
        for (int j = 0; j < 4; ++j)
#pragma unroll
            for (int k = 0; k < 4; ++k) { const int lane = F.lane; const f32x4 a = *(const f32x4*)(R + (size_t)(RIDX(j) + k) * 8), b2 = *(const f32x4*)(R + (size_t)(RIDX(j) + k) * 8 + 4);
                rw[j * 4 + k][0] = a[0]; rw[j * 4 + k][1] = a[1]; rw[j * 4 + k][2] = a[2]; rw[j * 4 + k][3] = a[3]; rw[j * 4 + k][4] = b2[0]; rw[j * 4 + k][5] = b2[1]; rw[j * 4 + k][6] = b2[2]; rw[j * 4 + k][7] = b2[3]; } }
    int nrec = 0;
    if (moe) { __syncthreads(); if (F.tid < 32) ((LAS unsigned*)F.lds)[F.tid] = 0u; __syncthreads(); }
    const bf16_t* DL = (const bf16_t*)(F.ws + WS_DELTA1);
    RowRaw r0 = {}, r1 = {};
    if (F.gw < nrows) row_issue<true>(X, DL, F.gw, F.lane, r0);
    if (F.gw + F.NGW < nrows) row_issue<true>(X, DL, F.gw + F.NGW, F.lane, r1);
    for (int row = F.gw; row < nrows; row += F.NGW) {
        f32x4 v[4], hv[4];
        row_combine(r0, v); r0 = r1;
        if (row + 2 * F.NGW < nrows) row_issue<true>(X, DL, row + 2 * F.NGW, F.lane, r1);
        row_ln(v, lg, lb, F.lane);
        row_store_h(X + (size_t)row * D, F.lane, v);
        const float* m = MOD + (size_t)mod_row_of(row) * MODW;
        if (USE_FP8 && (moe || FP8_DENSE1)) row_mod_store8((unsigned char*)H + (size_t)row * D, F.lane, v, m + 3 * D, m + 4 * D, hv);
        else row_mod_store(H + (size_t)row * D, F.lane, v, m + 3 * D, m + 4 * D, hv);
        if (moe) {
            float lg8[8];
#pragma unroll
            for (int e = 0; e < 8; ++e) { float s = 0.f;
#pragma unroll
                for (int j = 0; j < 4; ++j)
#pragma unroll
                    for (int k = 0; k < 4; ++k) s += hv[j][k] * rw[j * 4 + k][e];
                lg8[e] = wave_sum(s); }
            int e0 = 0; float v0 = lg8[0];
#pragma unroll
            for (int e = 1; e < 8; ++e) if (lg8[e] > v0) { v0 = lg8[e]; e0 = e; }
            int e1 = -1; float v1 = -INFINITY;
#pragma unroll
            for (int e = 0; e < 8; ++e) if (e != e0 && lg8[e] > v1) { v1 = lg8[e]; e1 = e; }
            if (F.lane == 0) {
                const unsigned s0 = __hip_atomic_fetch_add((LAS unsigned*)F.lds + e0, 1u, __ATOMIC_RELAXED, __HIP_MEMORY_SCOPE_WORKGROUP), s1 = __hip_atomic_fetch_add((LAS unsigned*)F.lds + e1, 1u, __ATOMIC_RELAXED, __HIP_MEMORY_SCOPE_WORKGROUP);
                const float ex = __expf(v1 - v0), g0 = 1.0f / (1.0f + ex);
                ((LAS u32x4*)(F.lds + 256))[F.wave * 32 + nrec] = (u32x4){(unsigned)e0 | ((unsigned)e1 << 8), s0, s1, (unsigned)row};
                *(f32x2*)(F.ws + WS_GATES + (size_t)row * 8) = (f32x2){g0, ex * g0};
            }
            ++nrec;
        }
    }
    if (moe) {
        __syncthreads();
        if (F.tid < 8) ((LAS unsigned*)F.lds)[16 + F.tid] = atomicAdd(cnt_word(F, slot, 0, F.tid), ((LAS unsigned*)F.lds)[F.tid]);
        __syncthreads();
        int* list = (int*)(F.ws + WS_LIST);
        if (F.lane < nrec) { const u32x4 rc = ((LAS u32x4*)(F.lds + 256))[F.wave * 32 + F.lane]; const int e0 = rc.x & 255, e1 = (rc.x >> 8) & 255; const int row = (int)rc.w;
            const unsigned s0 = ((LAS unsigned*)F.lds)[16 + e0] + rc.y, s1 = ((LAS unsigned*)F.lds)[16 + e1] + rc.z;
            list[e0 * NTOK + s0] = row; list[e1 * NTOK + s1] = row;
            *(u32x4*)(F.ws + WS_ROUTE + (size_t)row * 16) = (u32x4){rc.x, s0, s1, 0u}; }
    }
}

__device__ __forceinline__ void p_ffn1_dense(const Frame& F, int layer, bool last) {
    const int s = layer >> 1;
#if USE_FP8 && FP8_DENSE2
    typedef pg8::EpiSwiGLU8 EpiH; EpiH E{F.ws + WS_HID, DFF};
#else
    typedef pg8::EpiSwiGLU EpiH; EpiH E{(bf16_t*)(F.ws + WS_HID), DFF};
#endif
#if USE_FP8 && FP8_DENSE1
    pg8::Gemm g{(const bf16_t*)(F.ws + WS_H), (const bf16_t*)(F.ws + WS_WFGU + (size_t)s * 2 * DFF * D), D / 2};
    pg8::DenseOrder S; S.init(last ? NLAT : NTOK, 2 * DFF, D / 2, F.G, F.bid, REP_GEMM);
    pg8::gemm_phase<EpiH, pg8::DenseOrder, true, FP8_SP2, true>(F.lds, g, S, E, F.tid, (127 - S8_WGU) * 0x01010101, (127 - S8_ACT) * 0x01010101);
#else
    pg8::Gemm g{(const bf16_t*)(F.ws + WS_H), (const bf16_t*)(F.ws + WS_WFGU) + (size_t)s * 2 * DFF * D, D};
    pg8::DenseOrder S; S.init(last ? NLAT : NTOK, 2 * DFF, D, F.G, F.bid, REP_GEMM);
    pg8::gemm_phase<EpiH, pg8::DenseOrder, true, true>(F.lds, g, S, E, F.tid);
#endif
    if (layer == 0) deferred_conv(F, (NTOK / 256) * (2 * DFF / 256), DW_L0_F1, DW_Q);
}
__device__ __forceinline__ void p_ffn2_dense(const Frame& F, int layer, bool last) {
    const int s = layer >> 1;
    pg8::EpiGate E{(bf16_t*)(F.ws + WS_DELTA2), (const float*)(F.ws + WS_MOD) + (size_t)layer * 17 * MODW, 5 * D};
#if USE_FP8 && FP8_DENSE2
    pg8::Gemm g{(const bf16_t*)(F.ws + WS_HID), (const bf16_t*)(F.ws + WS_WFD + (size_t)s * D * DFF), DFF / 2};
    pg8::DenseOrder S; S.init(last ? NLAT : NTOK, D, DFF / 2, F.G, F.bid);
    pg8::gemm_phase<pg8::EpiGate, pg8::DenseOrder, true, FP8_SP2, true>(F.lds, g, S, E, F.tid, (127 - S8_WD) * 0x01010101, (127 - S8_HID) * 0x01010101);
#else
    pg8::Gemm g{(const bf16_t*)(F.ws + WS_HID), (const bf16_t*)(F.ws + WS_WFD) + (size_t)s * D * DFF, DFF};
    pg8::DenseOrder S; S.init(last ? NLAT : NTOK, D, DFF, F.G, F.bid);
    pg8::gemm_phase<pg8::EpiGate, pg8::DenseOrder, true, true>(F.lds, g, S, E, F.tid);
#endif
    if (layer == 0) deferred_conv(F, (NTOK / 256) * (D / 256), DW_L0_F2, DW_Q2);
}
__device__ __forceinline__ void moe_prefix(const Frame& F, int slot, int hf, int (&ts)[9], int (&cn)[8]) {
    int a = 0;
#pragma unroll
    for (int e = 0; e < 8; ++e) { cn[e] = (int)*cnt_word(F, slot, hf, e); ts[e] = a; a += (cn[e] + 255) >> 8; }
    ts[8] = a;
}
__device__ __forceinline__ void p_ffn1_moe(const Frame& F, int layer) {
    const int slot = layer >> 1; int cn[8];
    pg8::MoeOrder<true> S; moe_prefix(F, slot, 0, S.ts, cn);
    S.nM = S.ts[8]; S.nN = 2 * DFFE / 256; S.G = F.G; S.c = F.bid; S.K = D / 2; S.estride = (long)2 * DFFE * D; S.rowoff = (const LAS unsigned short*)(F.lds + LDS_ROWOFF); S.rowbytes = D;
    {
        const int* list = (const int*)(F.ws + WS_LIST); LAS unsigned short* ro = (LAS unsigned short*)(F.lds + LDS_ROWOFF); pg8::Unit u;
        for (int i = F.wave; i < 36 && S.next(i, u); i += NWAVES) { const int e = S.expert_of(u.pm); int tse = 0, cne = 0;
#pragma unroll
            for (int j = 0; j < 8; ++j) { tse = (j == e) ? S.ts[j] : tse; cne = (j == e) ? cn[j] : cne; }
            int tk[4];
#pragma unroll
            for (int q = 0; q < 4; ++q) { const int sl = (u.pm - tse) * 256 + F.lane + 64 * q; tk[q] = sl < cne ? list[e * NTOK + sl] : 0; }
#pragma unroll
            for (int q = 0; q < 4; ++q) ro[i * 256 + F.lane + 64 * q] = (unsigned short)tk[q]; }
        __syncthreads();
    }
    pg8::Gemm g{(const bf16_t*)(F.ws + WS_H), (const bf16_t*)(F.ws + WS_WMGU + (size_t)slot * NEXP * 2 * DFFE * D), D / 2};
    pg8::EpiSwiGLU8 E{F.ws + WS_HID, DFFE};
    pg8::gemm_phase<pg8::EpiSwiGLU8, pg8::MoeOrder<true>, true, FP8_SP2, true>(F.lds, g, S, E, F.tid, (127 - S8_WGU) * 0x01010101, (127 - S8_ACT) * 0x01010101);
}
__device__ __forceinline__ void p_ffn2_moe(const Frame& F, int layer) {
    const int slot = layer >> 1; int cn[8];
    pg8::MoeOrder<false> S; moe_prefix(F, slot, 0, S.ts, cn);
    S.nM = S.ts[8]; S.nN = D / 256; S.G = F.G; S.c = F.bid; S.K = DFFE / 2; S.estride = (long)D * DFFE; S.rowoff = nullptr; S.rowbytes = 0;
    pg8::EpiBf16 E{(bf16_t*)(F.ws + WS_YP), D};
    pg8::Gemm g{(const bf16_t*)(F.ws + WS_HID), (const bf16_t*)(F.ws + WS_WMD + (size_t)slot * NEXP * D * DFFE), DFFE / 2};
    pg8::gemm_phase<pg8::EpiBf16, pg8::MoeOrder<false>, true, FP8_SP2, true>(F.lds, g, S, E, F.tid, (127 - S8_WD) * 0x01010101, (127 - S8_HID) * 0x01010101);
}

template <bool MOE> __device__ __forceinline__ void ln2_body(const Frame& F, int layer, bool last) {
    bf16_t* X = (bf16_t*)(F.ws + WS_X); bf16_t* H = (bf16_t*)(F.ws + WS_H);
    const float* MOD = (const float*)(F.ws + WS_MOD) + (size_t)layer * 17 * MODW;
    const float* lg = F.in[I_LNG] + (size_t)(layer * 2 + 1) * D; const float* lb = F.in[I_LNB] + (size_t)(layer * 2 + 1) * D;
    const int slot = layer >> 1;
    const int nrows = last ? NLAT : NTOK;
    int ts0[9], cn[8];
    if (MOE) moe_prefix(F, slot, 0, ts0, cn);
    const bf16_t* YP = (const bf16_t*)(F.ws + WS_YP); const bf16_t* DL = (const bf16_t*)(F.ws + WS_DELTA2);
    RowRaw r0 = {}, r1 = {}; u32x4 rt0 = {0u, 0u, 0u, 0u}, rt1 = {0u, 0u, 0u, 0u}; f32x2 g0 = {0.f, 0.f}, g1 = {0.f, 0.f}; u32x4 ya[2] = {}, yb[2] = {};
#define LN2_ISSUE(row_, r_, rt_, g_) do { row_issue<!MOE>(X, DL, (row_), F.lane, r_); \
        if (MOE) { rt_ = *(const u32x4*)(F.ws + WS_ROUTE + (size_t)(row_) * 16); g_ = *(const f32x2*)(F.ws + WS_GATES + (size_t)(row_) * 8); } } while (0)
#define LN2_ISSUE_Y(rt_) do { const int e0_ = (rt_).x & 255, e1_ = ((rt_).x >> 8) & 255; int t0_ = 0, t1_ = 0; \
        _Pragma("unroll") for (int e = 0; e < 8; ++e) { const int tv = ts0[e]; t0_ = (e == e0_) ? tv : t0_; t1_ = (e == e1_) ? tv : t1_; } \
        const bf16_t* y0_ = YP + ((size_t)t0_ * 256 + (rt_).y) * D; const bf16_t* y1_ = YP + ((size_t)t1_ * 256 + (rt_).z) * D; \
        _Pragma("unroll") for (int j = 0; j < 2; ++j) { ya[j] = *(const u32x4*)(y0_ + 8 * F.lane + 512 * j); yb[j] = *(const u32x4*)(y1_ + 8 * F.lane + 512 * j); } } while (0)
    if (F.gw < nrows) LN2_ISSUE(F.gw, r0, rt0, g0);
    if (F.gw + F.NGW < nrows) LN2_ISSUE(F.gw + F.NGW, r1, rt1, g1);
    if (MOE) { if (F.gw < nrows) LN2_ISSUE_Y(rt0); }
    for (int row = F.gw; row < nrows; row += F.NGW) {
        f32x4 v[4], hv[4];
        if (MOE) {
            const float* g2 = MOD + (size_t)mod_row_of(row) * MODW + 5 * D;
#pragma unroll
            for (int j = 0; j < 2; ++j) { const int lane = F.lane; f32x4 x0, x1, a0, a1, b0, b1; unpack8(r0.x[j], x0, x1); unpack8(ya[j], a0, a1); unpack8(yb[j], b0, b1);
                const f32x4 q0 = *(const f32x4*)(g2 + RIDX(2 * j)) + 1.0f, q1 = *(const f32x4*)(g2 + RIDX(2 * j + 1)) + 1.0f;
                v[2 * j] = x0 * ALPHA + q0 * (a0 * g0[0] + b0 * g0[1]); v[2 * j + 1] = x1 * ALPHA + q1 * (a1 * g0[0] + b1 * g0[1]); }
        } else row_combine(r0, v);
        r0 = r1; rt0 = rt1; g0 = g1;
        if (MOE) { if (row + F.NGW < nrows) LN2_ISSUE_Y(rt0); }
        if (row + 2 * F.NGW < nrows) LN2_ISSUE(row + 2 * F.NGW, r1, rt1, g1);
        row_ln(v, lg, lb, F.lane);
        if (last) row_store(F.out + (size_t)row * D, F.lane, v);
        else { row_store_h(X + (size_t)row * D, F.lane, v);
            const float* m = MOD + (size_t)17 * MODW + (size_t)mod_row_of(row) * MODW;
            row_mod_store(H + (size_t)row * D, F.lane, v, m, m + D, hv);
            }
    }
#undef LN2_ISSUE
#undef LN2_ISSUE_Y
}
__device__ __forceinline__ void p_ln2(const Frame& F, int layer, bool last) { if (layer & 1) ln2_body<true>(F, layer, last); else ln2_body<false>(F, layer, last); }

constexpr int NPL = 9;
constexpr int NPH = 2 + NPL * DEPTH;
#ifndef SITE_MASK
#define SITE_MASK 0xFFFFF
#endif
#ifndef TPROBE_MULT
#define TPROBE_MULT 4
#endif
#define SITE(n) (((SITE_MASK) >> (n)) & 1)
__global__ void __launch_bounds__(NT, 2) fwd_kernel(Args args) {
    extern __shared__ __attribute__((aligned(16))) unsigned char lds_raw[];
    Frame F;
    F.lds = (LAS unsigned char*)lds_raw; F.in = args.in; F.out = args.out; F.ws = args.ws;
    F.tid = threadIdx.x; F.lane = F.tid & 63; F.wave = __builtin_amdgcn_readfirstlane(F.tid >> 6); F.bid = blockIdx.x; F.G = gridDim.x;
    F.gw = F.bid * NWAVES + F.wave; F.NGW = F.G * NWAVES;
    volatile LAS unsigned* MISC = (volatile LAS unsigned*)(F.lds + LDS_MISC);
    if (F.tid < 64) MISC[F.tid] = 0u;
    __syncthreads();
    XcdBarrier bar; bar.bar = (unsigned*)(F.ws + WS_CTL) + CW_BAR; bar.x = 0; bar.st = MISC + 8;
#if MK_SINGLE
    bar = xcd_barrier_post((unsigned*)(F.ws + WS_CTL) + CW_BAR, MISC + 8);
#endif
    const int lo = args.ph_lo, hi = args.ph_hi;
#define IN(k) (lo <= (k) && (k) < hi)
#if TPROBE >= 0
    unsigned long long tp_prev = __builtin_amdgcn_s_memrealtime(), tp_acc = 0ull;
#define TP(type) do { const unsigned long long t_ = __builtin_amdgcn_s_memrealtime(); if ((type) == TPROBE) tp_acc += t_ - tp_prev; tp_prev = t_; } while (0)
#else
#define TP(type) do { } while (0)
#endif
#if MK_SINGLE
#define SEAM(k) do { if (IN(k) && IN((k) + 1)) { XcdBarrier b2_ = bar; int z_; asm volatile("s_mov_b32 %0, 0" : "=s"(z_)); b2_.bar = bar.bar + z_; int ln_; asm volatile("v_mbcnt_lo_u32_b32 %0, -1, 0\n\tv_mbcnt_hi_u32_b32 %0, -1, %0" : "=v"(ln_)); xcd_barrier(b2_, F.wave == 0 && ln_ == 0); } } while (0)
#else
#define SEAM(k) do { } while (0)
#endif
    if constexpr (SITE(0)) if (IN(0)) p_pro_a(fresh(F));
    SEAM(0); TP(0);
    if constexpr (SITE(1)) if (IN(1)) p_pro_b(fresh(F));
    SEAM(1); TP(1);
    for (int layer = 0; layer < DEPTH; ++layer) {
        const int pb = 2 + NPL * layer; const bool last = layer == DEPTH - 1; const bool moe = layer & 1;
        if constexpr (SITE(2)) if (IN(pb + 0)) p_inproj(fresh(F), layer);
        SEAM(pb + 0); TP(2);
        if constexpr (SITE(3)) if (IN(pb + 1)) p_mixa(fresh(F), layer, last);
        SEAM(pb + 1); TP(3);
        if constexpr (SITE(12)) if (IN(pb + 2)) p_mixb(fresh(F), layer);
        SEAM(pb + 2); TP(4);
        if constexpr (SITE(4)) if (IN(pb + 3)) { p_ssdcomb(fresh(F), layer, last); if (!USE_FP8 && layer == 2) { int rot = 0; conv_moe(fresh(F), 1, rot); } }
        SEAM(pb + 3); TP(5);
        if constexpr (SITE(5)) if (IN(pb + 4)) p_outproj(fresh(F), layer, last);
        SEAM(pb + 4); TP(6);
        if constexpr (SITE(6)) if (IN(pb + 5)) p_ln1(fresh(F), layer, last);
        SEAM(pb + 5); TP(7);
        if (moe) {
            if constexpr (SITE(7)) if (IN(pb + 6)) p_ffn1_moe(fresh(F), layer);
            SEAM(pb + 6); TP(8);
            if constexpr (SITE(8)) if (IN(pb + 7)) p_ffn2_moe(fresh(F), layer);
            SEAM(pb + 7); TP(9);
        } else {
            if constexpr (SITE(9)) if (IN(pb + 6)) p_ffn1_dense(fresh(F), layer, last);
            SEAM(pb + 6); TP(10);
            if constexpr (SITE(10)) if (IN(pb + 7)) p_ffn2_dense(fresh(F), layer, last);
            SEAM(pb + 7); TP(11);
        }
        if constexpr (SITE(11)) if (IN(pb + 8)) p_ln2(fresh(F), layer, last);
        if (!last) SEAM(pb + 8);
        TP(12);
    }
#if TPROBE >= 100
    __syncthreads(); tp_acc = ((volatile LAS unsigned*)(F.lds + LDS_MISC))[40];
#endif
#if TPROBE >= 0
    { const unsigned long long t_end = __builtin_amdgcn_s_memrealtime(); while (__builtin_amdgcn_s_memrealtime() - t_end < (unsigned long long)TPROBE_MULT * tp_acc) __builtin_amdgcn_s_sleep(8); }
#endif
#undef IN
#undef SEAM
}

extern "C" void kernel_launch(void* const* d_in, const int* in_sizes, int n_in, void* d_out, int out_size, void* d_ws, size_t ws_size, hipStream_t stream) {
    static int grid = 0;
    if (grid == 0) {
        if (n_in != 24 || out_size != NLAT * D || ws_size < WS_END) { fprintf(stderr, "kernel_launch: unexpected shapes (n_in %d, out %d, ws %zu < %zu)\n", n_in, out_size, ws_size, (size_t)WS_END); grid = -1; return; }
        int dev = 0, cus = 0, per_cu = 0;
        if (hipGetDevice(&dev) != hipSuccess || hipDeviceGetAttribute(&cus, hipDeviceAttributeMultiprocessorCount, dev) != hipSuccess) { grid = -1; return; }
        if (hipFuncSetAttribute((const void*)fwd_kernel, hipFuncAttributeMaxDynamicSharedMemorySize, LDS_BYTES) != hipSuccess) { fprintf(stderr, "kernel_launch: hipFuncSetAttribute failed\n"); grid = -1; return; }
        if (hipOccupancyMaxActiveBlocksPerMultiprocessor(&per_cu, (const void*)fwd_kernel, NT, LDS_BYTES) != hipSuccess || per_cu < 1) { fprintf(stderr, "kernel_launch: occupancy query says %d\n", per_cu); }
        (void)hipGetLastError();
        grid = cus;
    }
    if (grid < 0) return;
    (void)in_sizes;
    if (hipMemsetAsync((char*)d_ws + WS_CTL, 0, CTL_BYTES, stream) != hipSuccess) return;
    Args a{};
    for (int i = 0; i < 24; ++i) a.in[i] = (const float*)d_in[i];
    a.out = (float*)d_out; a.ws = (unsigned char*)d_ws;
#if MK_SINGLE
    a.ph_lo = 0; a.ph_hi = NPH;
    hipLaunchKernelGGL(fwd_kernel, dim3(grid), dim3(NT), LDS_BYTES, stream, a);
#else
    for (int ph = 0; ph < NPH; ++ph) {

        a.ph_lo = ph; a.ph_hi = ph + 1;
        hipLaunchKernelGGL(fwd_kernel, dim3(grid), dim3(NT), LDS_BYTES, stream, a);
    }
#endif
}
```

```cpp
#include <hip/hip_runtime.h>
#include <cstdio>
#include <cstdint>

#ifndef MK_SINGLE
#define MK_SINGLE 1
#endif

#ifndef FP8_INPROJ
#define FP8_INPROJ 0
#endif
#ifndef FP8_DENSE1
#define FP8_DENSE1 0
#endif
#ifndef FP8_DENSE2
#define FP8_DENSE2 1
#endif
#ifndef USE_FP8
#define USE_FP8 1
#endif
#ifndef FP8_SP2
#define FP8_SP2 true
#endif
#ifndef REP_SSD
#define REP_SSD 1
#endif
#ifndef REP_NA
#define REP_NA 1
#endif
#ifndef REP_GEMM
#define REP_GEMM 1
#endif
#define GAS __attribute__((address_space(1)))
#define LAS __attribute__((address_space(3)))
typedef unsigned short bf16_t;
typedef short bf16x8 __attribute__((ext_vector_type(8)));
typedef float f32x4 __attribute__((ext_vector_type(4)));
typedef float f32x2 __attribute__((ext_vector_type(2)));
typedef unsigned u32x4 __attribute__((ext_vector_type(4)));
typedef unsigned u32x2 __attribute__((ext_vector_type(2)));
typedef int i32x4 __attribute__((ext_vector_type(4)));
typedef int i32x8 __attribute__((ext_vector_type(8)));

constexpr int D = 1024, BATCH = 16, SEQ = 2048, DEPTH = 4, GRID_W = 64, CTX = 256;
constexpr int NLAT = BATCH * SEQ;
constexpr int NCTX = BATCH * CTX;
constexpr int NTOK = NLAT + NCTX;
constexpr int NPROJ = 3072;
constexpr int OFF_K = 512, OFF_V = 1024, OFF_Z = 1536, OFF_XBC = 2048;
constexpr int D_IN_PROJ = 3088;
constexpr int DFF = 2816, DFFE = 3584, NEXP = 8;
constexpr float ALPHA = 1.6817928305074290f;
constexpr float LN_EPS = 1e-5f, RMS_EPS = 1e-5f;
constexpr int MODW = 6 * D;

constexpr size_t MiB = 1u << 20;
constexpr size_t WS_CTL = 0, CTL_BYTES = 1 * MiB;
constexpr size_t WS_MOD = 1 * MiB;
constexpr size_t WS_ROUTE = 3 * MiB;
constexpr size_t WS_GATES = 4 * MiB;
constexpr size_t WS_LIST = 5 * MiB;
constexpr size_t WS_WDT = 7 * MiB;
constexpr size_t WS_WIN = 8 * MiB;
constexpr size_t WS_WOUT = 32 * MiB;
constexpr size_t WS_WFGU = 40 * MiB;
constexpr size_t WS_WFD = 62 * MiB;
constexpr size_t WS_WMGU = 73 * MiB;
constexpr size_t WS_WMD = 185 * MiB;
constexpr size_t WS_X = 241 * MiB;
constexpr size_t WS_H = 385 * MiB;
constexpr size_t WS_R = 457 * MiB;
constexpr size_t WS_PROJ = WS_R;
constexpr size_t WS_DT = WS_R + 216 * MiB;
constexpr size_t WS_YF = WS_R + 219 * MiB;
constexpr size_t WS_YB = WS_R + 291 * MiB;
constexpr size_t WS_MIX = WS_R + 363 * MiB;
constexpr size_t WS_HID = WS_R;
constexpr size_t WS_YP = WS_R + 270 * MiB;
constexpr size_t WS_DELTA1 = WS_R;
constexpr size_t WS_DELTA2 = WS_R + 270 * MiB;
constexpr size_t WS_U = WS_R + 435 * MiB;
constexpr size_t WS_H8IN = WS_U;
constexpr size_t WS_END = WS_R + 507 * MiB;
constexpr int MOE_PAD = 2 * NTOK + 2048;
static_assert(USE_FP8 == 1, "the single-phase MoE needs the e4m3 hidden (the bf16 one does not fit the workspace)");
static_assert(WS_HID + (size_t)MOE_PAD * 3584 <= WS_YP && WS_YP + (size_t)MOE_PAD * 1024 * 2 <= WS_END, "MoE buffers");

constexpr int CW_TMO = 0;
constexpr int CW_BAR = 4096;
constexpr int CW_CNT = 16384;

constexpr int LDS_STAGE = 131072;
constexpr int LDS_ROWOFF = 131072;
constexpr int LDS_MISC = 131072 + 18432;
constexpr int LDS_BYTES = 155648;

constexpr int S8_ACT = 3, S8_WGU = 8, S8_HID = 2, S8_WD = 9;
#ifndef TPROBE
#define TPROBE (-1)
#endif
#if TPROBE >= 100
#define TPS_BEGIN unsigned long long tps_t_ = __builtin_amdgcn_s_memrealtime()
#define TPS(k) do { const unsigned long long t_ = __builtin_amdgcn_s_memrealtime(); if (TPROBE == 100 + (k) && F.tid == 0) ((volatile LAS unsigned*)(F.lds + LDS_MISC))[40] += (unsigned)(t_ - tps_t_); tps_t_ = t_; } while (0)
#else
#define TPS_BEGIN do { } while (0)
#define TPS(k) do { } while (0)
#endif
#define GATE_PRESCALE (-1.4426950408889634f)
__device__ __forceinline__ unsigned f2bf(float f) { unsigned u = __builtin_bit_cast(unsigned, f); return (u + 0x7fffu + ((u >> 16) & 1u)) >> 16; }
typedef __bf16 bf16x2_t __attribute__((ext_vector_type(2)));
__device__ __forceinline__ unsigned pk2(float lo, float hi) { const f32x2 v = {lo, hi}; const bf16x2_t b = __builtin_convertvector(v, bf16x2_t); return __builtin_bit_cast(unsigned, b); }
__device__ __forceinline__ float bf2f(unsigned short b) { return __builtin_bit_cast(float, ((unsigned)b) << 16); }
__device__ __forceinline__ float bflo(unsigned w) { return __builtin_bit_cast(float, w << 16); }
__device__ __forceinline__ float bfhi(unsigned w) { return __builtin_bit_cast(float, w & 0xffff0000u); }
__device__ __forceinline__ float silu_f(float v) { return v / (1.0f + __expf(-v)); }
__device__ __forceinline__ float clamp8(float v) { return fminf(fmaxf(v, -448.0f), 448.0f); }
__device__ __forceinline__ unsigned pk8(float a, float b, float c, float d) {
    int w = 0; w = __builtin_amdgcn_cvt_pk_fp8_f32(clamp8(a), clamp8(b), w, false); w = __builtin_amdgcn_cvt_pk_fp8_f32(clamp8(c), clamp8(d), w, true); return (unsigned)w; }
template <int CTRL, int ROWMASK = 0xF, bool BC = false>
__device__ __forceinline__ float dpp_f(float v) { return __builtin_bit_cast(float, __builtin_amdgcn_update_dpp(0, __builtin_bit_cast(int, v), CTRL, ROWMASK, 0xF, BC)); }
__device__ __forceinline__ float row16_sum(float v) {
    v += dpp_f<0xB1>(v); v += dpp_f<0x4E>(v); v += dpp_f<0x141>(v); v += dpp_f<0x140>(v);
    return v;
}
__device__ __forceinline__ float wave_sum(float v) {
    v = row16_sum(v);
    v += dpp_f<0x142, 0xA>(v); v += dpp_f<0x143, 0xC>(v);
    return __builtin_bit_cast(float, __builtin_amdgcn_readlane(__builtin_bit_cast(int, v), 63));
}
__device__ __forceinline__ float xrow_max(float v) {
    unsigned u = __builtin_bit_cast(unsigned, v); auto r = __builtin_amdgcn_permlane16_swap(u, u, false, false);
    v = fmaxf(__builtin_bit_cast(float, r[0]), __builtin_bit_cast(float, r[1]));
    u = __builtin_bit_cast(unsigned, v); auto r2 = __builtin_amdgcn_permlane32_swap(u, u, false, false);
    return fmaxf(__builtin_bit_cast(float, r2[0]), __builtin_bit_cast(float, r2[1]));
}
__device__ __forceinline__ float xrow_sum(float v) {
    unsigned u = __builtin_bit_cast(unsigned, v); auto r = __builtin_amdgcn_permlane16_swap(u, u, false, false);
    v = __builtin_bit_cast(float, r[0]) + __builtin_bit_cast(float, r[1]);
    u = __builtin_bit_cast(unsigned, v); auto r2 = __builtin_amdgcn_permlane32_swap(u, u, false, false);
    return __builtin_bit_cast(float, r2[0]) + __builtin_bit_cast(float, r2[1]);
}
__device__ __forceinline__ float wave_scan(float v) {
    v += dpp_f<0x111, 0xF, true>(v); v += dpp_f<0x112, 0xF, true>(v); v += dpp_f<0x114, 0xF, true>(v); v += dpp_f<0x118, 0xF, true>(v);
    v += dpp_f<0x142, 0xA>(v); v += dpp_f<0x143, 0xC>(v);
    return v;
}

namespace pg8 {
constexpr int BM = 256, BK = 64, HALF = 128, HTB = HALF * BK * 2, STAGE_BYTES = 8 * HTB, NXCD = 8, WGM = 8;
__host__ __device__ __forceinline__ int lds_byte(int r, int c) { const int st = (r >> 4) * 2 + (c >> 5), rr = r & 15, cc = c & 31, ob = rr * 64 + cc * 2; return st * 1024 + (ob ^ (((ob >> 9) & 1) << 5)); }
__host__ __device__ __forceinline__ void stage_rc(int b, int& R, int& C) { const int st = b / 1024, sb = b % 1024, swz = sb ^ (((sb >> 9) & 1) << 5); R = (st >> 1) * 16 + swz / 64; C = (st & 1) * 32 + (swz % 64) / 2; }
__host__ __device__ __forceinline__ int perm32(int rho) { const int n = rho >> 4, i = rho & 15; return 8 * (i >> 2) + 4 * n + (i & 3); }

struct Unit { int pm, pn; long bofs; };
struct Gemm { const bf16_t* A; const bf16_t* Bt; int K; };

__device__ __forceinline__ unsigned cvt_pk_bf16(float lo, float hi) { return pk2(lo, hi); }
__device__ __forceinline__ unsigned cvt_pk_bf16_pin(float lo, float hi) { unsigned r; asm volatile("v_cvt_pk_bf16_f32 %0, %1, %2" : "=v"(r) : "v"(lo), "v"(hi)); return r; }

__device__ __forceinline__ bool static_tile(int i, int G, int c, int nM, int nN, int& pm, int& pn, int rep = 1) {
    const int nwg = nM * nN;
#if REP_GEMM > 1
    { const int cnt = (nwg - c + G - 1) / G; if (cnt <= 0 || i >= rep * cnt) return false; i %= cnt; }
#endif
    const long L = (long)i * G + c; if (L >= nwg) return false;
    int wgid = (int)L; { const int q = nwg / NXCD, r = nwg % NXCD, xcd = wgid % NXCD, off = wgid / NXCD; wgid = (xcd < r ? xcd * (q + 1) : r * (q + 1) + (xcd - r) * q) + off; }
    const int nig = WGM * nN, gid = wgid / nig, fm = gid * WGM, gsz = (nM - fm) < WGM ? (nM - fm) : WGM;
    pm = fm + ((wgid % nig) % gsz); pn = (wgid % nig) / gsz; return true;
}
struct DenseOrder {
    int nM, nN, G, c, K, rep;
    __device__ __forceinline__ void init(int M, int N, int K_, int G_, int c_, int rep_ = 1) { nM = M / BM; nN = N / BM; G = G_; c = c_; K = K_; rep = rep_; }
    __device__ __forceinline__ bool next(int i, Unit& u) const { if (!static_tile(i, G, c, nM, nN, u.pm, u.pn, rep)) return false; u.bofs = (long)u.pn * BM * K * 2; return true; }
    static constexpr bool GATHER = false;
    __device__ __forceinline__ long a_base(const Unit& u) const { return (long)u.pm * BM * K * 2; }
    __device__ __forceinline__ void a_offs(int, const Unit&, int, unsigned (&)[2][2]) const {}
};
template <bool GATHER_> struct MoeOrder {
    int nM, nN, G, c, K; int ts[9]; long estride; const LAS unsigned short* rowoff; unsigned rowbytes;
    __device__ __forceinline__ int expert_of(int pm) const { int e = 0;
#pragma unroll
        for (int j = 1; j < 8; ++j) e += (pm >= ts[j]) ? 1 : 0; return e; }
    __device__ __forceinline__ bool next(int i, Unit& u) const { if (!static_tile(i, G, c, nM, nN, u.pm, u.pn, REP_GEMM)) return false; u.bofs = (long)expert_of(u.pm) * estride + (long)u.pn * BM * K * 2; return true; }
    static constexpr bool GATHER = GATHER_;
    __device__ __forceinline__ long a_base(const Unit& u) const { return GATHER_ ? 0l : (long)u.pm * BM * K * 2; }
    __device__ __forceinline__ void a_offs(int ui, const Unit&, int tid, unsigned (&o)[2][2]) const {
        int uix = ui;
#if REP_GEMM > 1
        { const int cnt = (nM * nN - c + G - 1) / G; uix = ui % cnt; }
#endif
        if (GATHER_) {
#pragma unroll
            for (int i = 0; i < 2; ++i) { int R, C; stage_rc(tid * 16 + i * 8192, R, C);
#pragma unroll
                for (int h = 0; h < 2; ++h) o[h][i] = (unsigned)rowoff[uix * 256 + h * HALF + R] * rowbytes + (unsigned)(C * 2); }
        }
    }
};

struct EpiBf16 {
    static constexpr bool PERM = true;
    bf16_t* O; int ldc;
    __device__ __forceinline__ void operator()(const f32x4 (&acc)[2][2][4][2], const Unit& u, int wr, int wc, int fr, int fq) const {
        const int row0 = u.pm * BM + wr * 64 + fr; const int col0 = u.pn * BM + wc * 32 + 8 * fq;
#pragma unroll
        for (int ai = 0; ai < 2; ++ai)
#pragma unroll
            for (int m = 0; m < 4; ++m) { bf16_t* rowp = O + (size_t)(row0 + ai * HALF + m * 16) * ldc + col0;
#pragma unroll
                for (int bj = 0; bj < 2; ++bj) { const f32x4 v0 = acc[ai][bj][m][0], v1 = acc[ai][bj][m][1];
                    u32x4 w; w.x = cvt_pk_bf16(v0[0], v0[1]); w.y = cvt_pk_bf16(v0[2], v0[3]); w.z = cvt_pk_bf16(v1[0], v1[1]); w.w = cvt_pk_bf16(v1[2], v1[3]);
                    *(u32x4*)(rowp + bj * HALF) = w; } }
    }
};
struct EpiSwiGLU {
    static constexpr bool PERM = true;
    bf16_t* O; int ldc;
    __device__ __forceinline__ void operator()(const f32x4 (&acc)[2][2][4][2], const Unit& u, int wr, int wc, int fr, int fq) const {
        const int row0 = u.pm * BM + wr * 64 + fr; const int col0 = u.pn * HALF + wc * 32 + 8 * fq;
#pragma unroll
        for (int ai = 0; ai < 2; ++ai)
#pragma unroll
            for (int m = 0; m < 4; ++m) { bf16_t* rowp = O + (size_t)(row0 + ai * HALF + m * 16) * ldc + col0;
                float h[8];
#pragma unroll
                for (int n = 0; n < 2; ++n)
#pragma unroll
                    for (int j = 0; j < 4; ++j) { const float gp = acc[ai][0][m][n][j], up = acc[ai][1][m][n][j];
                        h[n * 4 + j] = (gp * up) * __builtin_amdgcn_rcpf(__builtin_fmaf(__builtin_amdgcn_exp2f(gp), GATE_PRESCALE, GATE_PRESCALE)); }
                u32x4 w; w.x = cvt_pk_bf16(h[0], h[1]); w.y = cvt_pk_bf16(h[2], h[3]); w.z = cvt_pk_bf16(h[4], h[5]); w.w = cvt_pk_bf16(h[6], h[7]);
                *(u32x4*)rowp = w; }
    }
};
struct EpiSwiGLU8 {
    static constexpr bool PERM = true;
    unsigned char* O; int ldc;
    __device__ __forceinline__ void operator()(const f32x4 (&acc)[2][2][4][2], const Unit& u, int wr, int wc, int fr, int fq) const {
        const int row0 = u.pm * BM + wr * 64 + fr; const int col0 = u.pn * HALF + wc * 32 + 8 * fq;
#pragma unroll
        for (int ai = 0; ai < 2; ++ai)
#pragma unroll
            for (int m = 0; m < 4; ++m) { unsigned char* rowp = O + (size_t)(row0 + ai * HALF + m * 16) * ldc + col0;
                float h[8];
#pragma unroll
                for (int n = 0; n < 2; ++n)
#pragma unroll
                    for (int j = 0; j < 4; ++j) { const float gp = acc[ai][0][m][n][j], up = acc[ai][1][m][n][j];
                        constexpr float C8 = GATE_PRESCALE / (float)(1 << S8_HID); h[n * 4 + j] = (gp * up) * __builtin_amdgcn_rcpf((__builtin_amdgcn_exp2f(gp) + 1.0f) * C8); }
                u32x2 w; w.x = pk8(h[0], h[1], h[2], h[3]); w.y = pk8(h[4], h[5], h[6], h[7]);
                *(u32x2*)rowp = w; }
    }
};
struct EpiGate {
    static constexpr bool PERM = true;
    bf16_t* O; const float* mod; int gate_off;
    __device__ __forceinline__ void operator()(const f32x4 (&acc)[2][2][4][2], const Unit& u, int wr, int wc, int fr, int fq) const {
        const int rt = u.pm * BM; const int bi = rt >= NLAT ? 16 : (rt >> 11);
        const int col0 = u.pn * BM + wc * 32 + 8 * fq; const float* gt = mod + bi * MODW + gate_off + col0;
        f32x4 gv[2][2];
#pragma unroll
        for (int bj = 0; bj < 2; ++bj)
#pragma unroll
            for (int n = 0; n < 2; ++n) gv[bj][n] = *(const f32x4*)(gt + bj * HALF + 4 * n) + 1.0f;
        const int row0 = rt + wr * 64 + fr;
#pragma unroll
        for (int ai = 0; ai < 2; ++ai)
#pragma unroll
            for (int m = 0; m < 4; ++m) { bf16_t* rowp = O + (size_t)(row0 + ai * HALF + m * 16) * D + col0;
#pragma unroll
                for (int bj = 0; bj < 2; ++bj) { const f32x4 v0 = acc[ai][bj][m][0] * gv[bj][0], v1 = acc[ai][bj][m][1] * gv[bj][1];
                    u32x4 w; w.x = cvt_pk_bf16(v0[0], v0[1]); w.y = cvt_pk_bf16(v0[2], v0[3]); w.z = cvt_pk_bf16(v1[0], v1[1]); w.w = cvt_pk_bf16(v1[2], v1[3]);
                    *(u32x4*)(rowp + bj * HALF) = w; } }
    }
};

template <class Epi, class Sched, bool ALIGN_EPI, bool SP2, bool FP8 = false>
__device__ __forceinline__ void gemm_phase(LAS unsigned char* lds, const Gemm g, const Sched& S, const Epi& E, int tid_in, int sw = 0x7f7f7f7f, int sa = 0x7f7f7f7f) {
    int tid_ = tid_in; asm volatile("" : "+v"(tid_));
    const int tid = tid_, wid = __builtin_amdgcn_readfirstlane(tid >> 6), lane = tid & 63, wr = wid >> 2, wc = wid & 3, fr = lane & 15, fq = lane >> 4;
    const int K = g.K, nt = K / BK;
    constexpr bool GA = Sched::GATHER;
    unsigned voffA[2], voffB[2];
#pragma unroll
    for (int i = 0; i < 2; ++i) { int R, C; stage_rc(tid * 16 + i * 8192, R, C); const int Rb = Epi::PERM ? ((R & ~31) + perm32(R & 31)) : R;
        voffA[i] = (unsigned)(R * K + C) * 2u; voffB[i] = (unsigned)(Rb * K + C) * 2u; }
    const size_t kstep = (size_t)(BK * 2);
    const size_t hstep = (size_t)HALF * K * 2;
    const unsigned ldsw = (unsigned)wid * 1024u;
    const int aoff = lds_byte(wr * 64 + fr, fq * 8), boff = lds_byte(wc * 32 + fr, fq * 8);
#define PG8_SA(b, h) (((b) * 2 + (h)) * HTB)
#define PG8_SB(b, h) ((4 + (b) * 2 + (h)) * HTB)
#define PG8_STAGE(bufoff, gbase, voff) do { _Pragma("unroll") for (int _i = 0; _i < 2; ++_i) \
        __builtin_amdgcn_global_load_lds((const unsigned*)((const char*)(gbase) + (voff)[_i]), (LAS unsigned*)(lds + (bufoff) + ldsw + _i * 8192), 16, 0, 0); } while (0)
#define PG8_LDA(dst, b, h) do { _Pragma("unroll") for (int m = 0; m < 4; ++m) _Pragma("unroll") for (int k = 0; k < 2; ++k) dst[m][k] = *(const LAS bf16x8*)(lds + PG8_SA(b, h) + aoff + m * 2048 + k * 1024); } while (0)
#define PG8_LDB(dst, b, h) do { _Pragma("unroll") for (int n = 0; n < 2; ++n) _Pragma("unroll") for (int k = 0; k < 2; ++k) dst[n][k] = *(const LAS bf16x8*)(lds + PG8_SB(b, h) + boff + n * 2048 + k * 1024); } while (0)
#define PG8_CAT(x) __builtin_shufflevector(__builtin_bit_cast(i32x4, (x)[0]), __builtin_bit_cast(i32x4, (x)[1]), 0, 1, 2, 3, 4, 5, 6, 7)
#define PG8_MMA(ai, bj, At, Bt) do { __builtin_amdgcn_s_setprio(1); _Pragma("unroll") for (int m = 0; m < 4; ++m) _Pragma("unroll") for (int n = 0; n < 2; ++n) { \
        if constexpr (FP8) { const i32x8 a8_ = PG8_CAT(Bt[n]), b8_ = PG8_CAT(At[m]); \
            asm volatile("v_mfma_scale_f32_16x16x128_f8f6f4 %0, %1, %2, %0, %3, %4 op_sel_hi:[0,0,0]" : "+v"(acc[ai][bj][m][n]) : "v"(a8_), "v"(b8_), "v"(sw), "v"(sa)); } \
        else { _Pragma("unroll") for (int k = 0; k < 2; ++k) acc[ai][bj][m][n] = __builtin_amdgcn_mfma_f32_16x16x32_bf16(Bt[n][k], At[m][k], acc[ai][bj][m][n], 0, 0, 0); } } \
        __builtin_amdgcn_s_setprio(0); } while (0)
#define PG8_WAIT_V(n) asm volatile("s_waitcnt vmcnt(" #n ")" ::: "memory")
#define PG8_WAIT_L(n) asm volatile("s_waitcnt lgkmcnt(" #n ")" ::: "memory")
#define PG8_BAR __builtin_amdgcn_s_barrier()
#define PG8_SCHED __builtin_amdgcn_sched_barrier(0)
    Unit cur, nxt; int ui = 0;
    if (!S.next(0, cur)) return;
    f32x4 acc[2][2][4][2];
#pragma unroll
    for (int a = 0; a < 2; ++a)
#pragma unroll
        for (int b = 0; b < 2; ++b)
#pragma unroll
            for (int m = 0; m < 4; ++m)
#pragma unroll
                for (int n = 0; n < 2; ++n) acc[a][b][m][n] = (f32x4){0.f, 0.f, 0.f, 0.f};
    bf16x8 At[4][2], B0[2][2], B1[2][2];
    const char* Ab = (const char*)g.A + S.a_base(cur);
    unsigned oc[2][2];
    S.a_offs(0, cur, tid, oc);
    const size_t hsA = GA ? (size_t)0 : hstep;
#define PG8_STAGE_A(bufoff, gbase, h) do { if constexpr (GA) PG8_STAGE(bufoff, gbase, oc[h]); else PG8_STAGE(bufoff, (gbase) + (h) * hsA, voffA); } while (0)
    const char* cB = (const char*)g.Bt + cur.bofs;
    if constexpr (SP2) {
        PG8_STAGE(PG8_SB(0, 0), cB, voffB); PG8_STAGE(PG8_SB(0, 1), cB + hstep, voffB); PG8_STAGE_A(PG8_SA(0, 0), Ab, 0); PG8_STAGE_A(PG8_SA(0, 1), Ab, 1);
        if (wr == 1) PG8_BAR;
        PG8_WAIT_V(2); PG8_BAR;
        PG8_STAGE(PG8_SB(1, 0), cB + kstep, voffB); PG8_STAGE_A(PG8_SA(1, 0), Ab + kstep, 0); PG8_STAGE(PG8_SB(1, 1), cB + hstep + kstep, voffB);
        PG8_WAIT_V(6); PG8_BAR;
    } else {
        PG8_STAGE(PG8_SB(0, 0), cB, voffB); PG8_STAGE_A(PG8_SA(0, 0), Ab, 0); PG8_STAGE(PG8_SB(0, 1), cB + hstep, voffB); PG8_STAGE_A(PG8_SA(0, 1), Ab, 1);
        if (wr == 1) PG8_BAR;
        PG8_WAIT_V(4); PG8_BAR;
        PG8_STAGE(PG8_SB(1, 0), cB + kstep, voffB); PG8_STAGE_A(PG8_SA(1, 0), Ab + kstep, 0); PG8_STAGE(PG8_SB(1, 1), cB + hstep + kstep, voffB);
        PG8_WAIT_V(6); PG8_BAR;
    }
    for (;;) {
        const bool has_next = S.next(ui + 1, nxt);
        const char* nB = has_next ? (const char*)g.Bt + nxt.bofs : cB;
        for (int t = 0; t < nt; t += 2) {
            const bool last = (t == nt - 2);
            const char* a1 = Ab + (size_t)(t + 1) * kstep;
            const char* b2 = last ? nB : cB + (size_t)(t + 2) * kstep; const char* b3 = b2 + kstep;
            if constexpr (SP2) {
            PG8_LDB(B0, 0, 0); PG8_LDB(B1, 0, 1); PG8_SCHED; PG8_LDA(At, 0, 0); PG8_STAGE_A(PG8_SA(1, 1), a1, 1);
            if (last && has_next) { S.a_offs(ui + 1, nxt, tid, oc); Ab = (const char*)g.A + S.a_base(nxt); }
            const char* a2 = last ? Ab : Ab + (size_t)(t + 2) * kstep; const char* a3 = a2 + kstep;
            PG8_WAIT_V(8); PG8_WAIT_L(0); PG8_BAR; PG8_MMA(0, 0, At, B0); PG8_MMA(0, 1, At, B1); PG8_BAR; PG8_SCHED;
            PG8_LDA(At, 0, 1); PG8_STAGE(PG8_SB(0, 0), b2, voffB); PG8_STAGE(PG8_SB(0, 1), b2 + hstep, voffB); PG8_STAGE_A(PG8_SA(0, 0), a2, 0);
            PG8_WAIT_V(8); PG8_WAIT_L(0); PG8_BAR; PG8_MMA(1, 0, At, B0); PG8_MMA(1, 1, At, B1); PG8_BAR; PG8_SCHED;
            PG8_LDB(B0, 1, 0); PG8_LDB(B1, 1, 1); PG8_SCHED; PG8_LDA(At, 1, 0); PG8_STAGE_A(PG8_SA(0, 1), a2, 1);
            PG8_WAIT_V(8); PG8_WAIT_L(0); PG8_BAR; PG8_MMA(0, 0, At, B0); PG8_MMA(0, 1, At, B1); PG8_BAR; PG8_SCHED;
            PG8_LDA(At, 1, 1); PG8_STAGE(PG8_SB(1, 0), b3, voffB); PG8_STAGE(PG8_SB(1, 1), b3 + hstep, voffB); PG8_STAGE_A(PG8_SA(1, 0), a3, 0);
            PG8_WAIT_V(8); PG8_WAIT_L(0); PG8_BAR; PG8_MMA(1, 0, At, B0); PG8_MMA(1, 1, At, B1); PG8_BAR; PG8_SCHED;
            } else {
            PG8_LDB(B0, 0, 0); PG8_SCHED; PG8_LDA(At, 0, 0); PG8_STAGE_A(PG8_SA(1, 1), a1, 1);
            if (last && has_next) { S.a_offs(ui + 1, nxt, tid, oc); Ab = (const char*)g.A + S.a_base(nxt); }
            const char* a2 = last ? Ab : Ab + (size_t)(t + 2) * kstep; const char* a3 = a2 + kstep;
            PG8_WAIT_L(8); PG8_BAR; PG8_WAIT_L(0); PG8_MMA(0, 0, At, B0); PG8_BAR; PG8_SCHED;
            PG8_LDB(B1, 0, 1); PG8_STAGE(PG8_SB(0, 0), b2, voffB);
            PG8_BAR; PG8_WAIT_L(0); PG8_MMA(0, 1, At, B1); PG8_BAR;
            PG8_LDA(At, 0, 1); PG8_STAGE_A(PG8_SA(0, 0), a2, 0);
            PG8_BAR; PG8_WAIT_L(0); PG8_MMA(1, 0, At, B0); PG8_BAR; PG8_SCHED;
            PG8_STAGE(PG8_SB(0, 1), b2 + hstep, voffB);
            PG8_WAIT_V(6); PG8_BAR; PG8_MMA(1, 1, At, B1); PG8_BAR;
            PG8_LDB(B0, 1, 0); PG8_SCHED; PG8_LDA(At, 1, 0); PG8_STAGE_A(PG8_SA(0, 1), a2, 1);
            PG8_WAIT_L(8); PG8_BAR; PG8_WAIT_L(0); PG8_MMA(0, 0, At, B0); PG8_BAR; PG8_SCHED;
            PG8_LDB(B1, 1, 1); PG8_STAGE(PG8_SB(1, 0), b3, voffB);
            PG8_BAR; PG8_WAIT_L(0); PG8_MMA(0, 1, At, B1); PG8_BAR;
            PG8_LDA(At, 1, 1); PG8_STAGE_A(PG8_SA(1, 0), a3, 0);
            PG8_BAR; PG8_WAIT_L(0); PG8_MMA(1, 0, At, B0); PG8_BAR; PG8_SCHED;
            PG8_STAGE(PG8_SB(1, 1), b3 + hstep, voffB);
            PG8_WAIT_V(6); PG8_BAR; PG8_MMA(1, 1, At, B1); PG8_BAR;
            }
        }
        if constexpr (ALIGN_EPI) { if (wr == 0) PG8_BAR; }
        if constexpr (FP8) asm volatile("s_nop 15\n\ts_nop 15\n\ts_nop 15" ::: "memory");
        E(acc, cur, wr, wc, fr, fq);
        if (!has_next) break;
#pragma unroll
        for (int a = 0; a < 2; ++a)
#pragma unroll
            for (int b = 0; b < 2; ++b)
#pragma unroll
                for (int m = 0; m < 4; ++m)
#pragma unroll
                    for (int n = 0; n < 2; ++n) acc[a][b][m][n] = (f32x4){0.f, 0.f, 0.f, 0.f};
        cur = nxt; cB = nB; ++ui;
        if constexpr (ALIGN_EPI) { if (wr == 1) PG8_BAR; }
    }
    PG8_WAIT_V(0);
    if constexpr (!ALIGN_EPI) { if (wr == 0) PG8_BAR; }
    PG8_BAR;
#undef PG8_SA
#undef PG8_SB
#undef PG8_STAGE
#undef PG8_STAGE_A
#undef PG8_LDA
#undef PG8_LDB
#undef PG8_MMA
#undef PG8_CAT
#undef PG8_WAIT_V
#undef PG8_WAIT_L
#undef PG8_BAR
#undef PG8_SCHED
}
}

#define XB_TMO      128
#define XB_XCNT(j)  (256  + 64 * (j))
#define XB_XSUB(j)  (1280 + 64 * (j))
#define XB_XGEN(j)  (2304 + 64 * (j))
#define XB_TOP      3328
#define XB_TOPGEN   3392
#define XCD_BAR_WORDS 3456
#define XB_SPIN_CAP (1u << 18)
__device__ __forceinline__ unsigned xb_ld(unsigned* p)              { return __hip_atomic_load(p, __ATOMIC_RELAXED, __HIP_MEMORY_SCOPE_AGENT); }
__device__ __forceinline__ unsigned xb_add(unsigned* p, unsigned v) { return __hip_atomic_fetch_add(p, v, __ATOMIC_RELAXED, __HIP_MEMORY_SCOPE_AGENT); }
__device__ __forceinline__ unsigned xb_xcc_id() { return (unsigned)__builtin_amdgcn_s_getreg((3 << 11) | 20) & 0xFu; }
#define XB_SPIN(cond, bar) do { unsigned _sp = 0; while (cond) { __builtin_amdgcn_s_sleep(1); \
    if ((++_sp & 255u) == 0u) { if (xb_ld(&(bar)[XB_TMO])) break; if (_sp > XB_SPIN_CAP) { atomicAdd(&(bar)[XB_TMO], 1u); break; } } } } while (0)
struct XcdBarrier { unsigned* bar; unsigned x; volatile LAS unsigned* st; };
__device__ __forceinline__ XcdBarrier xcd_barrier_post(unsigned* bar, volatile LAS unsigned* st) {
    XcdBarrier b; b.bar = bar; b.x = xb_xcc_id(); b.st = st;
    if (threadIdx.x == 0) (void)xb_add(&bar[XB_XCNT(b.x)], 1u);
    return b;
}
__device__ __forceinline__ void xcd_barrier_complete(unsigned* bar, unsigned x, unsigned& nloc, unsigned& nx) {
    const unsigned G = gridDim.x * gridDim.y * gridDim.z;
    unsigned sum, cnt, mine, sp = 0u;
    for (;;) {
        sum = 0u; cnt = 0u; mine = 0u;
#pragma unroll
        for (unsigned j = 0; j < 16; ++j) { const unsigned c = xb_ld(&bar[XB_XCNT(j)]); sum += c; cnt += (c > 0u) ? 1u : 0u; }
        mine = xb_ld(&bar[XB_XCNT(x)]);
        if (sum == G) break;
        __builtin_amdgcn_s_sleep(1);
        if ((++sp & 255u) == 0u) { if (xb_ld(&bar[XB_TMO])) break; if (sp > XB_SPIN_CAP) { atomicAdd(&bar[XB_TMO], 1u); break; } }
    }
    nloc = mine > 0u ? mine : 1u; nx = cnt > 0u ? cnt : 1u;
}
__device__ __forceinline__ void xcd_barrier(const XcdBarrier& b, bool leader) {
    asm volatile("s_waitcnt vmcnt(0)" ::: "memory");
    __syncthreads();
    if (leader) {
        unsigned* bar = b.bar;
        __builtin_amdgcn_s_waitcnt(0);
        unsigned nloc = b.st[0], nx = b.st[1];
        if (nloc == 0u) { xcd_barrier_complete(bar, b.x, nloc, nx); b.st[0] = nloc; b.st[1] = nx; }
        const unsigned old = xb_add(&bar[XB_XSUB(b.x)], 1u);
        const unsigned gen = old / nloc;
        if (old + 1u == (gen + 1u) * nloc) {
            __builtin_amdgcn_fence(__ATOMIC_RELEASE, "agent");
            asm volatile("s_waitcnt vmcnt(0)" ::: "memory");
            const unsigned og = xb_add(&bar[XB_TOP], 1u);
            const unsigned tg = og / nx;
            if (og + 1u == (tg + 1u) * nx) xb_add(&bar[XB_TOPGEN], 1u);
            else XB_SPIN(xb_ld(&bar[XB_TOPGEN]) == tg, bar);
            __builtin_amdgcn_fence(__ATOMIC_ACQUIRE, "agent");
            xb_add(&bar[XB_XGEN(b.x)], 1u);
            asm volatile("s_waitcnt vmcnt(0)" ::: "memory");
        } else {
            XB_SPIN(xb_ld(&bar[XB_XGEN(b.x)]) == gen, bar);
            __builtin_amdgcn_fence(__ATOMIC_ACQUIRE, "agent");
            asm volatile("s_waitcnt vmcnt(0)" ::: "memory");
        }
    }
    __syncthreads();
}

constexpr int NT = 512, NWAVES = 8;
struct Args { const float* in[24]; float* out; unsigned char* ws; int ph_lo, ph_hi; };
enum { I_X = 0, I_C, I_CTX, I_CCTX, I_WMOD, I_BMOD, I_WIN, I_WOUT, I_RPB, I_CONVW, I_CONVB, I_DTB, I_ALOG, I_DSKIP, I_NORMW, I_LNG, I_LNB, I_FG, I_FU, I_FD, I_RW, I_MG, I_MU, I_MD };
struct Frame {
    LAS unsigned char* lds;
    const float* const* in; float* out; unsigned char* ws;
    int tid, lane, wave, bid, G, gw, NGW;
};
#define LDS_WAIT() asm volatile("s_waitcnt lgkmcnt(0)" ::: "memory")
__device__ __forceinline__ Frame fresh(const Frame& F0) {
    Frame F = F0; int z; asm volatile("s_mov_b32 %0, 0" : "=s"(z)); F.ws = F0.ws + z; F.in = F0.in + z; F.out = F0.out + z;
    int ln; asm volatile("v_mbcnt_lo_u32_b32 %0, -1, 0\n\tv_mbcnt_hi_u32_b32 %0, -1, %0" : "=v"(ln));     int t = F0.wave * 64 + ln;
    F.tid = t; F.lane = t & 63; return F;
}

__device__ __forceinline__ void conv_item(const float* W, int ldn, int k0, int n0, bf16_t* dst, int K, int drow0, float scale, LAS float* scr, int lane) {
    f32x4 ld[8];
#pragma unroll
    for (int i = 0; i < 8; ++i) ld[i] = *(const f32x4*)(W + (size_t)(k0 + 8 * i + (lane >> 3)) * ldn + n0 + 4 * (lane & 7));
#pragma unroll
    for (int i = 0; i < 8; ++i) { LAS float* d = scr + (8 * i + (lane >> 3)) * 33 + 4 * (lane & 7); d[0] = ld[i][0] * scale; d[1] = ld[i][1] * scale; d[2] = ld[i][2] * scale; d[3] = ld[i][3] * scale; }
    LDS_WAIT(); asm volatile("" ::: "memory");
    const int c = lane & 7;
#pragma unroll
    for (int j = 0; j < 4; ++j) { const int n = (lane >> 3) + 8 * j; const LAS float* s = scr + (8 * c) * 33 + n;
        u32x4 o; o.x = pk2(s[0 * 33], s[1 * 33]); o.y = pk2(s[2 * 33], s[3 * 33]); o.z = pk2(s[4 * 33], s[5 * 33]); o.w = pk2(s[6 * 33], s[7 * 33]);
        *(u32x4*)(dst + (size_t)(drow0 + n) * K + k0 + 8 * c) = o; }
    LDS_WAIT(); asm volatile("" ::: "memory");
}
__device__ __forceinline__ void conv_item8(const float* W, int ldn, int k0, int n0, unsigned char* dst, int K, int drow0, float scale, LAS float* scr, int lane) {
    f32x4 ld[8];
#pragma unroll
    for (int i = 0; i < 8; ++i) ld[i] = *(const f32x4*)(W + (size_t)(k0 + 8 * i + (lane >> 3)) * ldn + n0 + 4 * (lane & 7));
#pragma unroll
    for (int i = 0; i < 8; ++i) { LAS float* d = scr + (8 * i + (lane >> 3)) * 33 + 4 * (lane & 7); d[0] = ld[i][0] * scale; d[1] = ld[i][1] * scale; d[2] = ld[i][2] * scale; d[3] = ld[i][3] * scale; }
    LDS_WAIT(); asm volatile("" ::: "memory");
    const int c = lane & 7;
#pragma unroll
    for (int j = 0; j < 4; ++j) { const int n = (lane >> 3) + 8 * j; const LAS float* sp = scr + (8 * c) * 33 + n;
        u32x2 o; o.x = pk8(sp[0 * 33], sp[1 * 33], sp[2 * 33], sp[3 * 33]); o.y = pk8(sp[4 * 33], sp[5 * 33], sp[6 * 33], sp[7 * 33]);
        *(u32x2*)(dst + (size_t)(drow0 + n) * K + k0 + 8 * c) = o; }
    LDS_WAIT(); asm volatile("" ::: "memory");
}
__device__ __forceinline__ void conv_seg(const Frame& F, const float* W, int K, int ldn, int ncols, bf16_t* dst, int mode, int& rot, int s8 = -1) {
    LAS float* scr = (LAS float*)(F.lds + F.wave * 16384);
    const int nblk = ncols / 32, nitems = (K / 64) * nblk;
    int start = F.gw - rot; if (start < 0) start += F.NGW;
    for (int it = start; it < nitems; it += F.NGW) {
        const int kb = it / nblk, nb = it % nblk, n0 = nb * 32;
        const int drow0 = (mode == 0) ? n0 : ((n0 >> 7) * 256 + (n0 & 127) + (mode == 2 ? 128 : 0));
        const float gs = (mode == 1) ? GATE_PRESCALE : 1.0f;
        if (s8 >= 0) conv_item8(W, ldn, kb * 64, n0, (unsigned char*)dst, K, drow0, (float)(1 << s8) * gs, scr, F.lane);
        else conv_item(W, ldn, kb * 64, n0, dst, K, drow0, gs, scr, F.lane);
    }
    rot = (rot + nitems) % F.NGW;
}
__device__ __forceinline__ void conv_moe(const Frame& F, int slot, int& rot) {
#if USE_FP8
    unsigned char* gu = F.ws + WS_WMGU + (size_t)slot * NEXP * 2 * DFFE * D; unsigned char* dn = F.ws + WS_WMD + (size_t)slot * NEXP * D * DFFE;
    for (int e = 0; e < NEXP; ++e) {
        const size_t so = ((size_t)slot * NEXP + e) * (size_t)D * DFFE;
        conv_seg(F, F.in[I_MG] + so, D, DFFE, DFFE, (bf16_t*)(gu + (size_t)e * 2 * DFFE * D), 1, rot, S8_WGU);
        conv_seg(F, F.in[I_MU] + so, D, DFFE, DFFE, (bf16_t*)(gu + (size_t)e * 2 * DFFE * D), 2, rot, S8_WGU);
        conv_seg(F, F.in[I_MD] + so, DFFE, D, D, (bf16_t*)(dn + (size_t)e * D * DFFE), 0, rot, S8_WD);
    }
#else
    bf16_t* gu = (bf16_t*)(F.ws + WS_WMGU); bf16_t* dn = (bf16_t*)(F.ws + WS_WMD);
    for (int e = 0; e < NEXP; ++e) {
        const size_t so = ((size_t)slot * NEXP + e) * (size_t)D * DFFE;
        conv_seg(F, F.in[I_MG] + so, D, DFFE, DFFE, gu + (size_t)e * 2 * DFFE * D, 1, rot);
        conv_seg(F, F.in[I_MU] + so, D, DFFE, DFFE, gu + (size_t)e * 2 * DFFE * D, 2, rot);
        conv_seg(F, F.in[I_MD] + so, DFFE, D, D, dn + (size_t)e * D * DFFE, 0, rot);
    }
#endif
}

constexpr int MOE_ITEMS_MAT = 1792, MOE_ITEMS_EXP = 3 * MOE_ITEMS_MAT, MOE_ITEMS_SLOT = 8 * MOE_ITEMS_EXP, MOE_ITEMS = 2 * MOE_ITEMS_SLOT;
__device__ __forceinline__ void conv_moe_item(const Frame& F, int gidx) {
    LAS float* scr = (LAS float*)(F.lds + F.wave * 16384);
    const int slot = gidx / MOE_ITEMS_SLOT, r = gidx % MOE_ITEMS_SLOT, e = r / MOE_ITEMS_EXP, r2 = r % MOE_ITEMS_EXP, mat = r2 / MOE_ITEMS_MAT, it = r2 % MOE_ITEMS_MAT;
    const size_t so = ((size_t)slot * NEXP + e) * (size_t)D * DFFE;
    if (mat < 2) { const int kb = it / 112, nb = it % 112, n0 = nb * 32; const int drow0 = (n0 >> 7) * 256 + (n0 & 127) + (mat == 1 ? 128 : 0);
        conv_item8((mat ? F.in[I_MU] : F.in[I_MG]) + so, DFFE, kb * 64, n0, F.ws + WS_WMGU + ((size_t)slot * NEXP + e) * 2 * DFFE * D, D, drow0, (float)(1 << S8_WGU) * (mat ? 1.0f : GATE_PRESCALE), scr, F.lane); }
    else { const int kb = it / 32, nb = it % 32, n0 = nb * 32;
        conv_item8(F.in[I_MD] + so, D, kb * 64, n0, F.ws + WS_WMD + ((size_t)slot * NEXP + e) * D * DFFE, DFFE, n0, (float)(1 << S8_WD), scr, F.lane); }
}
__device__ __forceinline__ void deferred_conv(const Frame& F, int nwg, int base, int quota) {
    if (F.G != 256) return;
    const int maxu = (nwg + F.G - 1) / F.G, c0 = nwg - (maxu - 1) * F.G;
    if (c0 >= F.G || F.bid < c0) return;
    const int first = base + ((F.bid - c0) * NWAVES + F.wave) * quota;
    for (int j = 0; j < quota; ++j) { const int gidx = first + j; if (gidx < MOE_ITEMS) conv_moe_item(F, gidx); }
}
constexpr int DW_Q = 12, DW_Q2 = 10;
constexpr int DW_L0_IN = 0, DW_L0_OUT = DW_L0_IN + 64 * 8 * DW_Q, DW_L0_F1 = DW_L0_OUT + 192 * 8 * DW_Q, DW_L0_F2 = DW_L0_F1 + 160 * 8 * DW_Q, DW_L1_IN = DW_L0_F2 + 192 * 8 * DW_Q2, DW_L1_OUT = DW_L1_IN + 64 * 8 * DW_Q, DW_L2_IN = DW_L1_OUT + 192 * 8 * DW_Q, DW_END = DW_L2_IN + 64 * 8 * DW_Q;
static_assert(DW_L1_IN >= MOE_ITEMS_SLOT && DW_END >= MOE_ITEMS, "deferred conversion: layer-1 experts must be done before layer 1's FFN, all before layer 3's");
__device__ __forceinline__ void p_pro_a(const Frame& F) {
    {
        LAS float* sc = (LAS float*)F.lds; LAS float* red = sc + 17 * 1024;
        const float* c = F.in[I_C]; const float* cc = F.in[I_CCTX];
        for (int i = F.tid; i < 17 * 1024; i += NT) { const int r = i >> 10, k = i & 1023; const float v = (r < 16) ? c[r * 1024 + k] : cc[k]; sc[i] = silu_f(v); }
        __syncthreads();
        float* MOD = (float*)(F.ws + WS_MOD);
        const int col = F.tid & 31, ks = F.tid >> 5;
        for (int u = F.bid; u < 4 * 192; u += F.G) {
            const int l = u / 192, cb = u % 192;
            const float* W = F.in[I_WMOD] + (size_t)l * D * MODW + cb * 32 + col;
            float acc[17];
#pragma unroll
            for (int r = 0; r < 17; ++r) acc[r] = 0.f;
#pragma unroll 1
            for (int kb = 0; kb < 4; ++kb) { float w[16];
#pragma unroll
                for (int i = 0; i < 16; ++i) w[i] = W[(size_t)(ks * 64 + kb * 16 + i) * MODW];
#pragma unroll
                for (int i = 0; i < 16; ++i) { const int k = ks * 64 + kb * 16 + i;
#pragma unroll
                    for (int r = 0; r < 17; ++r) acc[r] += sc[r * 1024 + k] * w[i]; } }
#pragma unroll
            for (int r = 0; r < 17; ++r) red[(ks * 17 + r) * 32 + col] = acc[r];
            __syncthreads();
            for (int i = F.tid; i < 17 * 32; i += NT) { const int r = i >> 5, c2 = i & 31; float sm = 0.f;
#pragma unroll
                for (int k2 = 0; k2 < 16; ++k2) sm += red[(k2 * 17 + r) * 32 + c2];
                MOD[(size_t)(l * 17 + r) * MODW + cb * 32 + c2] = sm + F.in[I_BMOD][l * MODW + cb * 32 + c2]; }
            __syncthreads();
        }
    }
    int rot = 0;
    for (int l = 0; l < DEPTH; ++l) {
#if USE_FP8 && FP8_INPROJ
        conv_seg(F, F.in[I_WIN] + (size_t)l * D * D_IN_PROJ, D, D_IN_PROJ, NPROJ, (bf16_t*)(F.ws + WS_WIN + (size_t)l * NPROJ * D), 0, rot, S8_WGU);
#else
        conv_seg(F, F.in[I_WIN] + (size_t)l * D * D_IN_PROJ, D, D_IN_PROJ, NPROJ, (bf16_t*)(F.ws + WS_WIN) + (size_t)l * NPROJ * D, 0, rot);
#endif
        conv_seg(F, F.in[I_WOUT] + (size_t)l * D * D, D, D, D, (bf16_t*)(F.ws + WS_WOUT) + (size_t)l * D * D, 0, rot);
    }
    for (int s = 0; s < 2; ++s) {
#if USE_FP8 && FP8_DENSE1
        conv_seg(F, F.in[I_FG] + (size_t)s * D * DFF, D, DFF, DFF, (bf16_t*)(F.ws + WS_WFGU + (size_t)s * 2 * DFF * D), 1, rot, S8_WGU);
        conv_seg(F, F.in[I_FU] + (size_t)s * D * DFF, D, DFF, DFF, (bf16_t*)(F.ws + WS_WFGU + (size_t)s * 2 * DFF * D), 2, rot, S8_WGU);
#else
        conv_seg(F, F.in[I_FG] + (size_t)s * D * DFF, D, DFF, DFF, (bf16_t*)(F.ws + WS_WFGU) + (size_t)s * 2 * DFF * D, 1, rot);
        conv_seg(F, F.in[I_FU] + (size_t)s * D * DFF, D, DFF, DFF, (bf16_t*)(F.ws + WS_WFGU) + (size_t)s * 2 * DFF * D, 2, rot);
#endif
#if USE_FP8 && FP8_DENSE2
        conv_seg(F, F.in[I_FD] + (size_t)s * DFF * D, DFF, D, D, (bf16_t*)(F.ws + WS_WFD + (size_t)s * D * DFF), 0, rot, S8_WD);
#else
        conv_seg(F, F.in[I_FD] + (size_t)s * DFF * D, DFF, D, D, (bf16_t*)(F.ws + WS_WFD) + (size_t)s * D * DFF, 0, rot);
#endif
    }
    if (F.G != 256) { conv_moe(F, 0, rot); conv_moe(F, 1, rot); }
    { bf16_t* wdt = (bf16_t*)(F.ws + WS_WDT);
      for (int i = F.bid * NT + F.tid; i < DEPTH * 16 * D; i += F.G * NT) { const int l = i / (16 * D), n = (i / D) & 15, k = i % D;
          wdt[i] = (bf16_t)f2bf(F.in[I_WIN][((size_t)l * D + k) * D_IN_PROJ + NPROJ + n]); } }
}

#define RIDX(q) (8 * lane + 512 * ((q) >> 1) + 4 * ((q) & 1))
__device__ __forceinline__ void row_load(const float* p, int lane, f32x4 (&v)[4]) {
#pragma unroll
    for (int q = 0; q < 4; ++q) v[q] = *(const f32x4*)(p + RIDX(q));
}
__device__ __forceinline__ void row_store(float* p, int lane, const f32x4 (&v)[4]) {
#pragma unroll
    for (int q = 0; q < 4; ++q) *(f32x4*)(p + RIDX(q)) = v[q];
}
__device__ __forceinline__ void row_mod_store8(unsigned char* hrow, int lane, const f32x4 (&v)[4], const float* sh, const float* sc, f32x4 (&hv)[4]) {
#pragma unroll
    for (int j = 0; j < 2; ++j) { u32x2 w;
#pragma unroll
        for (int h = 0; h < 2; ++h) { const int q = 2 * j + h; const f32x4 a = *(const f32x4*)(sc + RIDX(q)), b = *(const f32x4*)(sh + RIDX(q));
            hv[q] = v[q] * (a + 1.0f) + b; const f32x4 t = hv[q] * (float)(1 << S8_ACT); const unsigned pw = pk8(t[0], t[1], t[2], t[3]); if (h == 0) w.x = pw; else w.y = pw; }
        *(u32x2*)(hrow + 8 * lane + 512 * j) = w; }
}
__device__ __forceinline__ void row_load_h(const bf16_t* p, int lane, f32x4 (&v)[4]) {
#pragma unroll
    for (int j = 0; j < 2; ++j) { const u32x4 w = *(const u32x4*)(p + 8 * lane + 512 * j); v[2 * j] = (f32x4){bflo(w.x), bfhi(w.x), bflo(w.y), bfhi(w.y)}; v[2 * j + 1] = (f32x4){bflo(w.z), bfhi(w.z), bflo(w.w), bfhi(w.w)}; }
}
__device__ __forceinline__ void row_store_h(bf16_t* p, int lane, const f32x4 (&v)[4]) {
#pragma unroll
    for (int j = 0; j < 2; ++j) { u32x4 w; w.x = pk2(v[2 * j][0], v[2 * j][1]); w.y = pk2(v[2 * j][2], v[2 * j][3]); w.z = pk2(v[2 * j + 1][0], v[2 * j + 1][1]); w.w = pk2(v[2 * j + 1][2], v[2 * j + 1][3]);
        *(u32x4*)(p + 8 * lane + 512 * j) = w; }
}
__device__ __forceinline__ void row_mod_store(bf16_t* hrow, int lane, const f32x4 (&v)[4], const float* sh, const float* sc, f32x4 (&hv)[4]) {
#pragma unroll
    for (int q = 0; q < 4; ++q) { const f32x4 a = *(const f32x4*)(sc + RIDX(q)), b = *(const f32x4*)(sh + RIDX(q)); hv[q] = v[q] * (a + 1.0f) + b; }
    row_store_h(hrow, lane, hv);
}
__device__ __forceinline__ void row_ln(f32x4 (&v)[4], const float* g, const float* b, int lane) {
    float s = 0.f;
#pragma unroll
    for (int j = 0; j < 4; ++j) s += (v[j][0] + v[j][1]) + (v[j][2] + v[j][3]);
    const float mean = wave_sum(s) * (1.0f / D); float q2 = 0.f;
#pragma unroll
    for (int j = 0; j < 4; ++j) { v[j] = v[j] - mean; q2 += (v[j][0] * v[j][0] + v[j][1] * v[j][1]) + (v[j][2] * v[j][2] + v[j][3] * v[j][3]); }
    const float rstd = 1.0f / sqrtf(wave_sum(q2) * (1.0f / D) + LN_EPS);
#pragma unroll
    for (int q = 0; q < 4; ++q) { const f32x4 gg = *(const f32x4*)(g + RIDX(q)), bb = *(const f32x4*)(b + RIDX(q)); v[q] = v[q] * rstd * gg + bb; }
}
__device__ __forceinline__ int mod_row_of(int row) { return row < NLAT ? (row >> 11) : 16; }
struct RowRaw { u32x4 x[2], d[2]; };
template <bool WITH_D> __device__ __forceinline__ void row_issue(const bf16_t* X, const bf16_t* Dl, int row, int lane, RowRaw& r) {
#pragma unroll
    for (int j = 0; j < 2; ++j) { r.x[j] = *(const u32x4*)(X + (size_t)row * D + 8 * lane + 512 * j); if (WITH_D) r.d[j] = *(const u32x4*)(Dl + (size_t)row * D + 8 * lane + 512 * j); }
}
__device__ __forceinline__ void unpack8(const u32x4 w, f32x4& lo, f32x4& hi) { lo = (f32x4){bflo(w.x), bfhi(w.x), bflo(w.y), bfhi(w.y)}; hi = (f32x4){bflo(w.z), bfhi(w.z), bflo(w.w), bfhi(w.w)}; }
__device__ __forceinline__ void row_combine(const RowRaw& r, f32x4 (&v)[4]) {
#pragma unroll
    for (int j = 0; j < 2; ++j) { f32x4 x0, x1, d0, d1; unpack8(r.x[j], x0, x1); unpack8(r.d[j], d0, d1); v[2 * j] = x0 * ALPHA + d0; v[2 * j + 1] = x1 * ALPHA + d1; }
}

__device__ __forceinline__ void p_pro_b(const Frame& F) {
    const float* MOD = (const float*)(F.ws + WS_MOD); bf16_t* H = (bf16_t*)(F.ws + WS_H); bf16_t* X = (bf16_t*)(F.ws + WS_X);
    for (int row = F.gw; row < NTOK; row += F.NGW) {
        const float* src = row < NLAT ? F.in[I_X] + (size_t)row * D : F.in[I_CTX] + (size_t)(row - NLAT) * D;
        f32x4 v[4], hv[4]; row_load(src, F.lane, v);
        row_store_h(X + (size_t)row * D, F.lane, v);
        const float* m = MOD + (size_t)mod_row_of(row) * MODW;
        row_mod_store(H + (size_t)row * D, F.lane, v, m, m + D, hv);
    }
}

__device__ __forceinline__ void p_inproj(const Frame& F, int layer) {
    const bf16_t* H = (const bf16_t*)(F.ws + WS_H);
    {
        const bf16_t* wdt = (const bf16_t*)(F.ws + WS_WDT) + (size_t)layer * 16 * D; float* DT = (float*)(F.ws + WS_DT);
        const int fr = F.lane & 15, fq = F.lane >> 4; const float dtb = F.in[I_DTB][layer * 16 + fr];
        for (int g = F.gw; g < NTOK / 16; g += F.NGW) {
            f32x4 acc = {0.f, 0.f, 0.f, 0.f};
            const bf16_t* ap = H + (size_t)(g * 16 + fr) * D + fq * 8; const bf16_t* bp = wdt + (size_t)fr * D + fq * 8;
#pragma unroll 8
            for (int ks = 0; ks < 32; ++ks) { const bf16x8 a = *(const bf16x8*)(ap + ks * 32), b = *(const bf16x8*)(bp + ks * 32);
                acc = __builtin_amdgcn_mfma_f32_16x16x32_bf16(a, b, acc, 0, 0, 0); }
#pragma unroll
            for (int r = 0; r < 4; ++r) { const float x = acc[r] + dtb; DT[(size_t)(g * 16 + fq * 4 + r) * 16 + fr] = fmaxf(x, 0.f) + __logf(1.0f + __expf(-fabsf(x))); }
        }
    }
    pg8::EpiBf16 E{(bf16_t*)(F.ws + WS_PROJ), NPROJ};
#if USE_FP8 && FP8_INPROJ
    pg8::Gemm g{(const bf16_t*)(F.ws + WS_H8IN), (const bf16_t*)(F.ws + WS_WIN + (size_t)layer * NPROJ * D), D / 2};
    pg8::DenseOrder S; S.init(NTOK, NPROJ, D / 2, F.G, F.bid, REP_GEMM);
    pg8::gemm_phase<pg8::EpiBf16, pg8::DenseOrder, true, FP8_SP2, true>(F.lds, g, S, E, F.tid, (127 - S8_WGU) * 0x01010101, (127 - S8_ACT) * 0x01010101);
#else
    pg8::Gemm g{H, (const bf16_t*)(F.ws + WS_WIN) + (size_t)layer * NPROJ * D, D};
    pg8::DenseOrder S; S.init(NTOK, NPROJ, D, F.G, F.bid, REP_GEMM);
    pg8::gemm_phase<pg8::EpiBf16, pg8::DenseOrder, true, true>(F.lds, g, S, E, F.tid);
#endif
    if (layer == 0) deferred_conv(F, (NTOK / 256) * (NPROJ / 256), DW_L0_IN, DW_Q); else if (layer < 3) deferred_conv(F, (NTOK / 256) * (NPROJ / 256), layer == 1 ? DW_L1_IN : DW_L2_IN, DW_Q);
}

typedef short s16x4 __attribute__((ext_vector_type(4)));
__device__ __forceinline__ s16x4 lds_tr16(LAS const unsigned char* p) { return __builtin_bit_cast(s16x4, __builtin_amdgcn_ds_read_tr16_b64_v4i16((LAS s16x4*)p)); }
constexpr int NA_KS = 144;
constexpr float LOG2E = 1.4426950408889634f;
__device__ __forceinline__ void na_unit(const Frame& F, int layer, int b, int h, int mode, int m) {
    LAS unsigned char* KV = F.lds;
    LAS float* rp = (LAS float*)(F.lds + 120832);
    const bf16_t* PROJ = (const bf16_t*)(F.ws + WS_PROJ); bf16_t* MIX = (bf16_t*)(F.ws + WS_MIX);
    const int tid = F.tid, lane = F.lane, w = F.wave, q16 = lane & 15, g = lane >> 4;
    int rbase = 0, nk = 0;
    if (mode == 0) { rbase = 2 * m - 4; rbase = rbase < 0 ? 0 : (rbase > 24 ? 24 : rbase); nk = 32 - rbase; nk = nk > 9 ? 9 : nk; }
    const int kfirst = (mode == 0) ? 0 : 576 * 8, nloc8 = nk * 64 * 8;
#define NA_STAGE(OFFS) do { int stid_ = tid; asm volatile("" : "+v"(stid_));     \
        NA_STAGE_PART(OFFS, 0, 7); __builtin_amdgcn_sched_barrier(0); NA_STAGE_PART(OFFS, 7, 13); __builtin_amdgcn_sched_barrier(0); } while (0)
#define NA_STAGE_PART(OFFS, K0, K1) do { u32x4 st_[13]; \
        _Pragma("unroll") for (int k_ = K0; k_ < K1; ++k_) { const int i_ = stid_ + kfirst + k_ * NT, key_ = i_ >> 3, ch_ = i_ & 7; const bool ok_ = (i_ < 832 * 8) && !(key_ < 576 && i_ >= nloc8); \
            const int grow_ = key_ < 576 ? b * SEQ + rbase * 64 + key_ : NLAT + b * CTX + (key_ - 576); \
            st_[k_] = ok_ ? *(const u32x4*)(PROJ + (size_t)grow_ * NPROJ + (OFFS) + h * 64 + ch_ * 8) : (u32x4){0u, 0u, 0u, 0u}; } \
        _Pragma("unroll") for (int k_ = K0; k_ < K1; ++k_) { const int i_ = stid_ + kfirst + k_ * NT, key_ = i_ >> 3, ch_ = i_ & 7; const bool ok_ = (i_ < 832 * 8) && !(key_ < 576 && i_ >= nloc8); \
            if (ok_) *(LAS u32x4*)(KV + key_ * NA_KS + ch_ * 16) = st_[k_]; } } while (0)
    __syncthreads();
    NA_STAGE(OFF_K);
    if (mode == 0 && tid < 465) rp[tid] = F.in[I_RPB][(size_t)(layer * 8 + h) * 465 + tid] * LOG2E;
    __syncthreads();
    int i = 0, j0 = 0, hs = 0, kr0 = 0, qrow;
    if (mode == 0) { i = 2 * m + (w >> 2); j0 = (w & 3) * 16; qrow = b * SEQ + i * 64 + j0; hs = j0 - 8; hs = hs < 0 ? 0 : (hs > 32 ? 32 : hs);
        int r0 = i - 4; r0 = r0 < 0 ? 0 : (r0 > 24 ? 24 : r0); kr0 = r0 - rbase; }
    else qrow = NLAT + b * CTX + m * 128 + w * 16;
    bf16x8 qf[2];
#pragma unroll
    for (int ks = 0; ks < 2; ++ks) qf[ks] = *(const bf16x8*)(PROJ + (size_t)(qrow + q16) * NPROJ + h * 64 + ks * 32 + g * 8);
    f32x4 S[32];
    const LAS unsigned char* kb = KV + q16 * NA_KS + g * 16;
    if (mode == 0) {
        const int j = j0 + q16; int cs = j - 8; cs = cs < 0 ? 0 : (cs > 48 ? 48 : cs);
        const int rb0 = (kr0 + rbase) - i + 7;
#pragma unroll
        for (int tl = 0; tl < 16; ++tl) { const int kr = tl >> 1, half = tl & 1; const int kidx0 = (kr0 + kr) * 64 + hs + 16 * half;
            f32x4 a = {0.f, 0.f, 0.f, 0.f};
#pragma unroll
            for (int ks = 0; ks < 2; ++ks) { const bf16x8 kf = *(const LAS bf16x8*)(kb + kidx0 * NA_KS + ks * 64); a = __builtin_amdgcn_mfma_f32_16x16x32_bf16(kf, qf[ks], a, 0, 0, 0); }
#pragma unroll
            for (int r = 0; r < 4; ++r) { const int kc = hs + 16 * half + 4 * g + r; const bool inw = (kc >= cs) && (kc < cs + 16);
                int cbi = kc - j + 15; cbi = cbi < 0 ? 0 : (cbi > 30 ? 30 : cbi);
                a[r] = inw ? a[r] * (0.125f * LOG2E) + rp[(rb0 + kr) * 31 + cbi] : -INFINITY; }
            S[tl] = a; if ((tl & 1) == 1) __builtin_amdgcn_sched_barrier(0); }
    } else {
#pragma unroll
        for (int tl = 0; tl < 16; ++tl) S[tl] = (f32x4){-INFINITY, -INFINITY, -INFINITY, -INFINITY};
    }
#pragma unroll
    for (int tc = 0; tc < 16; ++tc) { const int kidx0 = 576 + 16 * tc; f32x4 a = {0.f, 0.f, 0.f, 0.f};
#pragma unroll
        for (int ks = 0; ks < 2; ++ks) { const bf16x8 kf = *(const LAS bf16x8*)(kb + kidx0 * NA_KS + ks * 64); a = __builtin_amdgcn_mfma_f32_16x16x32_bf16(kf, qf[ks], a, 0, 0, 0); }
        S[16 + tc] = a * (0.125f * LOG2E); if ((tc & 1) == 1) __builtin_amdgcn_sched_barrier(0); }
    float mx = -INFINITY;
#pragma unroll
    for (int t = 0; t < 32; ++t) mx = fmaxf(fmaxf(fmaxf(S[t][0], S[t][1]), fmaxf(S[t][2], S[t][3])), mx);
    mx = fmaxf(mx, __shfl_xor(mx, 16)); mx = fmaxf(mx, __shfl_xor(mx, 32));
    float sum = 0.f; u32x4 P[16];
#pragma unroll
    for (int kk = 0; kk < 16; ++kk) { float e[8];
#pragma unroll
        for (int r = 0; r < 4; ++r) { e[r] = __builtin_amdgcn_exp2f(S[2 * kk][r] - mx); e[4 + r] = __builtin_amdgcn_exp2f(S[2 * kk + 1][r] - mx); }
        sum += ((e[0] + e[1]) + (e[2] + e[3])) + ((e[4] + e[5]) + (e[6] + e[7]));
        P[kk].x = pg8::cvt_pk_bf16_pin(e[0], e[1]); P[kk].y = pg8::cvt_pk_bf16_pin(e[2], e[3]); P[kk].z = pg8::cvt_pk_bf16_pin(e[4], e[5]); P[kk].w = pg8::cvt_pk_bf16_pin(e[6], e[7]); }
    sum += __shfl_xor(sum, 16); sum += __shfl_xor(sum, 32);
    const float inv = 1.0f / sum;
    __syncthreads();
    NA_STAGE(OFF_V);
    __syncthreads();
    f32x4 o[4];
#pragma unroll
    for (int dt = 0; dt < 4; ++dt) o[dt] = (f32x4){0.f, 0.f, 0.f, 0.f};
    const LAS unsigned char* vb = KV + (4 * g + (q16 >> 2)) * NA_KS + (q16 & 3) * 8;
#pragma unroll
    for (int kk = 0; kk < 16; ++kk) {
        if (kk < 8 && mode != 0) continue;
        const int kidx0 = (kk < 8) ? (kr0 + kk) * 64 + hs : 576 + 32 * (kk - 8);
        const bf16x8 pa = __builtin_bit_cast(bf16x8, P[kk]);
#pragma unroll
        for (int dt = 0; dt < 4; ++dt) { const s16x4 lo = lds_tr16(vb + kidx0 * NA_KS + dt * 32), hi = lds_tr16(vb + (kidx0 + 16) * NA_KS + dt * 32);
            const bf16x8 vf = {lo[0], lo[1], lo[2], lo[3], hi[0], hi[1], hi[2], hi[3]};
            o[dt] = __builtin_amdgcn_mfma_f32_16x16x32_bf16(pa, vf, o[dt], 0, 0, 0); }
    }
#undef NA_STAGE
#undef NA_STAGE_PART
#pragma unroll
    for (int r = 0; r < 4; ++r) { const float ir = __shfl(inv, 4 * g + r);
        bf16_t* op = MIX + (size_t)(qrow + 4 * g + r) * D + h * 64 + q16;
#pragma unroll
        for (int dt = 0; dt < 4; dt += 2) { const unsigned pw = pk2(o[dt][r] * ir, o[dt + 1][r] * ir); op[dt * 16] = (bf16_t)(pw & 0xffffu); op[dt * 16 + 16] = (bf16_t)(pw >> 16); } }
}

struct PrepassW { f32x4 w[5][2]; f32x4 b[2]; float ifq[8]; };
__device__ __forceinline__ void ssd_prepass_unit(const Frame& F, int u, const PrepassW& W) {
    const bf16_t* PROJ = (const bf16_t*)(F.ws + WS_PROJ); bf16_t* U = (bf16_t*)(F.ws + WS_U);
    int rowbase, t0, L; bool lat;
    if (u < NLAT / 16) { rowbase = (u >> 7) * SEQ; t0 = (u & 127) * 16; L = SEQ; lat = true; }
    else { const int v = u - NLAT / 16; rowbase = NLAT + (v >> 4) * CTX; t0 = (v & 15) * 16; L = CTX; lat = false; }
    const int cg = F.tid & 127, tq = F.tid >> 7, c0 = 8 * cg, tb = t0 + 4 * tq;
    u32x4 win[8];
#pragma unroll
    for (int j = 0; j < 8; ++j) { const int t = tb - 2 + j; win[j] = (t >= 0 && t < L) ? *(const u32x4*)(PROJ + (size_t)(rowbase + t) * NPROJ + OFF_XBC + c0) : (u32x4){0u, 0u, 0u, 0u}; }
    const int lc = c0 & 127, hf = lc >> 6, role = (lc >> 5) & 1; const bool rope = lat && (c0 >= 512);
#pragma unroll
    for (int tt = 0; tt < 4; ++tt) {
        f32x4 a0 = W.b[0], a1 = W.b[1];
#pragma unroll
        for (int j = 0; j < 5; ++j) { const u32x4 r = win[tt + j];
            a0 += W.w[j][0] * (f32x4){bflo(r.x), bfhi(r.x), bflo(r.y), bfhi(r.y)}; a1 += W.w[j][1] * (f32x4){bflo(r.z), bfhi(r.z), bflo(r.w), bfhi(r.w)}; }
        float uu[8];
#pragma unroll
        for (int k = 0; k < 4; ++k) { uu[k] = silu_f(a0[k]); uu[4 + k] = silu_f(a1[k]); }
        if (rope) {
            const int tk = tb + tt; const float pos = (float)(hf ? (tk & 63) : (tk >> 6));
#pragma unroll
            for (int k = 0; k < 8; ++k) { const float o = __shfl_xor(uu[k], 4); const float sn = __builtin_amdgcn_sinf(pos * W.ifq[k]), cs = __builtin_amdgcn_cosf(pos * W.ifq[k]);
                uu[k] = role ? (o * sn + uu[k] * cs) : (uu[k] * cs - o * sn); }
        }
        u32x4 o; o.x = pk2(uu[0], uu[1]); o.y = pk2(uu[2], uu[3]); o.z = pk2(uu[4], uu[5]); o.w = pk2(uu[6], uu[7]);
        *(u32x4*)(U + (size_t)(rowbase + tb + tt) * 1024 + c0) = o;
    }
}
__device__ __forceinline__ void ssd_prepass_weights(const Frame& F, int layer, PrepassW& W) {
    const int c0 = 8 * (F.tid & 127);
    const float* cwp = F.in[I_CONVW] + (size_t)layer * 5 * 1024 + c0;
#pragma unroll
    for (int j = 0; j < 5; ++j) { W.w[j][0] = *(const f32x4*)(cwp + j * 1024); W.w[j][1] = *(const f32x4*)(cwp + j * 1024 + 4); }
    W.b[0] = *(const f32x4*)(F.in[I_CONVB] + (size_t)layer * 1024 + c0); W.b[1] = *(const f32x4*)(F.in[I_CONVB] + (size_t)layer * 1024 + c0 + 4);
    const int n0 = c0 & 31;
#pragma unroll
    for (int k = 0; k < 8; ++k) W.ifq[k] = __builtin_amdgcn_exp2f(-(float)(n0 + k) * (13.287712379549449f / 32.0f)) * 0.15915494309189535f;
}

constexpr int S_CQ = 0, S_BQ = 17408, S_XN = 34816, S_XW = 44032, S_OPS = 53248, S_HB = 2 * S_OPS, S_MISC = S_HB + 2 * 17408, S_END = S_MISC + 3 * 1088;
static_assert(S_END <= LDS_ROWOFF + 18432, "SSD LDS image must stay below the control words");
__device__ __forceinline__ void ssd_chunk_compute(const LAS unsigned char* O, const LAS float* misc, const LAS unsigned char* HB, LAS unsigned char* HN, f32x4 (&Hacc)[4],
                                                  bf16_t* yp, int w, int q16, int gq, bool skip, float dsk) {
    const int lt = w >> 1, t2 = (w & 1) * 2;
    bf16x8 cfr[4];
#pragma unroll
    for (int ks = 0; ks < 4; ++ks) cfr[ks] = *(const LAS bf16x8*)(O + S_CQ + (16 * lt + q16) * 272 + ks * 64 + gq * 16);
    u32x4 pm[2];
    {
        const float csl = misc[64 + 16 * lt + q16];
#pragma unroll
        for (int pr = 0; pr < 2; ++pr) {
            f32x4 v[2];
#pragma unroll
            for (int hh = 0; hh < 2; ++hh) { const int st = 2 * pr + hh; f32x4 a = {0.f, 0.f, 0.f, 0.f};
                if (st <= lt) {
#pragma unroll
                    for (int ks = 0; ks < 4; ++ks) { const bf16x8 bfr = *(const LAS bf16x8*)(O + S_BQ + (16 * st + q16) * 272 + ks * 64 + gq * 16); a = __builtin_amdgcn_mfma_f32_16x16x32_bf16(bfr, cfr[ks], a, 0, 0, 0); }
                    const f32x4 css = *(const LAS f32x4*)(misc + 64 + 16 * st + 4 * gq), dts = *(const LAS f32x4*)(misc + 16 * st + 4 * gq);
#pragma unroll
                    for (int r = 0; r < 4; ++r) { const int sidx = 16 * st + 4 * gq + r; a[r] = (sidx <= 16 * lt + q16) ? a[r] * __expf(csl - css[r]) * dts[r] : 0.f; }
                }
                v[hh] = a; }
            pm[pr].x = pk2(v[0][0], v[0][1]); pm[pr].y = pk2(v[0][2], v[0][3]); pm[pr].z = pk2(v[1][0], v[1][1]); pm[pr].w = pk2(v[1][2], v[1][3]);
        }
    }
    {
        const float ecs = misc[128 + 16 * lt + q16];
        const LAS unsigned char* xtr = O + S_XN + (4 * gq + (q16 >> 2)) * 144 + (q16 & 3) * 8;
#pragma unroll
        for (int k = 0; k < 2; ++k) { const int pt = t2 + k; f32x4 a = {0.f, 0.f, 0.f, 0.f};
#pragma unroll
            for (int ks = 0; ks < 4; ++ks) { const bf16x8 hfr = *(const LAS bf16x8*)(HB + (16 * pt + q16) * 272 + ks * 64 + gq * 16); a = __builtin_amdgcn_mfma_f32_16x16x32_bf16(hfr, cfr[ks], a, 0, 0, 0); }
            a = a * ecs;
#pragma unroll
            for (int pr = 0; pr < 2; ++pr) if (2 * pr <= lt) { const s16x4 lo = lds_tr16(xtr + (32 * pr) * 144 + pt * 32), hi = lds_tr16(xtr + (32 * pr + 16) * 144 + pt * 32);
                const bf16x8 xf = {lo[0], lo[1], lo[2], lo[3], hi[0], hi[1], hi[2], hi[3]};
                a = __builtin_amdgcn_mfma_f32_16x16x32_bf16(xf, __builtin_bit_cast(bf16x8, pm[pr]), a, 0, 0, 0); }
            if (skip) { const u32x2 xv = *(const LAS u32x2*)(O + S_XN + (16 * lt + q16) * 144 + (16 * pt + 4 * gq) * 2);
                a[0] += dsk * bflo(xv.x); a[1] += dsk * bfhi(xv.x); a[2] += dsk * bflo(xv.y); a[3] += dsk * bfhi(xv.y); }
            { u32x2 ow; ow.x = pk2(a[0], a[1]); ow.y = pk2(a[2], a[3]); *(u32x2*)(yp + 16 * pt + 4 * gq) = ow; } }
    }
    {
        const int pt2 = w & 3, nb = (w >> 2) * 4; const float et = misc[256];
        const LAS unsigned char* xwtr = O + S_XW + (4 * gq + (q16 >> 2)) * 144 + (q16 & 3) * 8 + pt2 * 32;
        const LAS unsigned char* btr = O + S_BQ + (4 * gq + (q16 >> 2)) * 272 + (q16 & 3) * 8;
        bf16x8 xf2[2];
#pragma unroll
        for (int kk = 0; kk < 2; ++kk) { const s16x4 lo = lds_tr16(xwtr + (32 * kk) * 144), hi = lds_tr16(xwtr + (32 * kk + 16) * 144); xf2[kk] = (bf16x8){lo[0], lo[1], lo[2], lo[3], hi[0], hi[1], hi[2], hi[3]}; }
#pragma unroll
        for (int j = 0; j < 4; ++j) { const int nt = nb + j; Hacc[j] = Hacc[j] * et;
#pragma unroll
            for (int kk = 0; kk < 2; ++kk) { const s16x4 lo = lds_tr16(btr + (32 * kk) * 272 + nt * 32), hi = lds_tr16(btr + (32 * kk + 16) * 272 + nt * 32);
                const bf16x8 bT = {lo[0], lo[1], lo[2], lo[3], hi[0], hi[1], hi[2], hi[3]};
                Hacc[j] = __builtin_amdgcn_mfma_f32_16x16x32_bf16(bT, xf2[kk], Hacc[j], 0, 0, 0); }
            u32x2 hw; hw.x = pk2(Hacc[j][0], Hacc[j][1]); hw.y = pk2(Hacc[j][2], Hacc[j][3]);
            *(LAS u32x2*)(HN + (16 * pt2 + q16) * 272 + (16 * nt + 4 * gq) * 2) = hw; }
    }
}
struct SsdPre { u32x4 x, b[2], c[2]; float dt; };
__device__ __forceinline__ void ssd_mfma_unit(const Frame& F, int layer, int b, int h, int dir) {
    const int g = h >> 2, tid = F.tid, lane = F.lane, w = F.wave, q16 = lane & 15, gq = lane >> 4;
    const bf16_t* U = (const bf16_t*)(F.ws + WS_U); const float* DTS = (const float*)(F.ws + WS_DT);
    bf16_t* Y = (bf16_t*)(F.ws + (dir ? WS_YB : WS_YF));
    const float aneg = -__expf(F.in[I_ALOG][layer * 16 + dir * 8 + h]), dsk = F.in[I_DSKIP][layer * 8 + h];
    LAS unsigned char* L = F.lds;
    __syncthreads();
    for (int i = tid; i < 64 * 272 / 16; i += NT) *(LAS u32x4*)(L + S_HB + i * 16) = (u32x4){0u, 0u, 0u, 0u};
    f32x4 Hacc[4];
#pragma unroll
    for (int j = 0; j < 4; ++j) Hacc[j] = (f32x4){0.f, 0.f, 0.f, 0.f};
    SsdPre P0, P1;
    P0.dt = 0.f; P1.dt = 0.f;
    const int xt = tid >> 3, xp = tid & 7;
    const int bt = tid >> 4, bp = tid & 15;
#define SSD_ROW(ci_, l_) ({ const int s_ = (ci_) < 4 ? 0 : 1, k_ = s_ ? (ci_) - 4 : (ci_), nc_ = s_ ? 32 : 4, c_ = dir ? nc_ - 1 - k_ : k_; \
        (s_ ? b * SEQ : NLAT + b * CTX) + c_ * 64 + (dir ? 63 - (l_) : (l_)); })
#define SSD_PREFETCH(ci_, P_) do { P_.x = *(const u32x4*)(U + (size_t)SSD_ROW(ci_, xt) * 1024 + h * 64 + xp * 8); \
        if (w == 0) P_.dt = DTS[(size_t)SSD_ROW(ci_, lane) * 16 + dir * 8 + h]; \
        _Pragma("unroll") for (int j2_ = 0; j2_ < 2; ++j2_) { const int tok_ = bt + 32 * j2_; const size_t ro_ = (size_t)SSD_ROW(ci_, tok_) * 1024; \
            P_.b[j2_] = *(const u32x4*)(U + ro_ + 512 + g * 128 + bp * 8); P_.c[j2_] = *(const u32x4*)(U + ro_ + 768 + g * 128 + bp * 8); } } while (0)
#define SSD_MISC(slot_, P_) do { LAS float* m_ = (LAS float*)(L + S_MISC) + (slot_) * 272; const float dt_ = P_.dt; const float cs_ = wave_scan(dt_ * aneg); \
        const float tot_ = __builtin_bit_cast(float, __builtin_amdgcn_readlane(__builtin_bit_cast(int, cs_), 63)); \
        m_[lane] = dt_; m_[64 + lane] = cs_; m_[128 + lane] = __expf(cs_); m_[192 + lane] = __expf(tot_ - cs_) * dt_; if (lane == 0) m_[256] = __expf(tot_); } while (0)
#define SSD_STAGE(set_, slot_, P_) do { LAS unsigned char* O_ = L + (set_) * S_OPS; const float wl = ((const LAS float*)(L + S_MISC))[(slot_) * 272 + 192 + xt]; \
        *(LAS u32x4*)(O_ + S_XN + xt * 144 + xp * 16) = P_.x; \
        u32x4 xw; xw.x = pk2(bflo(P_.x.x) * wl, bfhi(P_.x.x) * wl); xw.y = pk2(bflo(P_.x.y) * wl, bfhi(P_.x.y) * wl); xw.z = pk2(bflo(P_.x.z) * wl, bfhi(P_.x.z) * wl); xw.w = pk2(bflo(P_.x.w) * wl, bfhi(P_.x.w) * wl); \
        *(LAS u32x4*)(O_ + S_XW + xt * 144 + xp * 16) = xw; \
        _Pragma("unroll") for (int k = 0; k < 2; ++k) { *(LAS u32x4*)(O_ + S_BQ + (bt + 32 * k) * 272 + bp * 16) = P_.b[k]; *(LAS u32x4*)(O_ + S_CQ + (bt + 32 * k) * 272 + bp * 16) = P_.c[k]; } } while (0)
#define SSD_ITER(ci_, PN_, PC_) do { const int ci = (ci_); const int ms1 = ms == 2 ? 0 : ms + 1, ms2 = ms1 == 2 ? 0 : ms1 + 1; \
        if (ci + 1 < 36) SSD_STAGE(cur ^ 1, ms1, PN_); \
        if (ci + 3 < 36) SSD_PREFETCH(ci + 3, PN_); \
        TPS(0); \
        { const int row0 = SSD_ROW(ci, 16 * (w >> 1) + q16); \
          ssd_chunk_compute(L + cur * S_OPS, (const LAS float*)(L + S_MISC) + ms * 272, L + S_HB + cur * 17408, L + S_HB + (cur ^ 1) * 17408, Hacc, Y + (size_t)row0 * 512 + h * 64, w, q16, gq, dir == 0, dsk); } \
        TPS(2); \
        if (w == 0 && ci + 2 < 36) SSD_MISC(ms2, PC_); \
        __syncthreads(); \
        TPS(3); \
        cur ^= 1; ms = ms1; } while (0)
    SSD_PREFETCH(0, P0);
    if (w == 0) SSD_MISC(0, P0);
    __syncthreads();
    SSD_STAGE(0, 0, P0);
    SSD_PREFETCH(1, P1);
    SSD_PREFETCH(2, P0);
    if (w == 0) SSD_MISC(1, P1);
    __syncthreads();
    TPS_BEGIN;
    int cur = 0, ms = 0;
    for (int c2 = 0; c2 < 36; c2 += 2) { SSD_ITER(c2, P1, P0); SSD_ITER(c2 + 1, P0, P1); }
#undef SSD_ROW
#undef SSD_PREFETCH
#undef SSD_MISC
#undef SSD_STAGE
#undef SSD_ITER
}

__device__ __forceinline__ void na_run(const Frame& F, int layer) {
    LAS unsigned char* KV = F.lds; LAS float* rp = (LAS float*)(F.lds + 120832);
    const bf16_t* PROJ = (const bf16_t*)(F.ws + WS_PROJ); bf16_t* MIX = (bf16_t*)(F.ws + WS_MIX);
    const int tid = F.tid, lane = F.lane, w = F.wave, q16 = lane & 15, g = lane >> 4;
    u32x4 pre[13];
#define NA_VPRE 13
#define NA_RB(m_) ({ int rb_ = 2 * (m_) - 4; rb_ = rb_ < 0 ? 0 : (rb_ > 24 ? 24 : rb_); __builtin_amdgcn_readfirstlane(rb_); })
#define NA_NL(rb_) ({ int nk_ = 32 - (rb_); nk_ = nk_ > 9 ? 9 : nk_; __builtin_amdgcn_readfirstlane(nk_ * 64 * 8); })
#define NA_LOAD(OFFS, b_, h_, rb_, nl_, K0, K1) do { int stid_ = tid; asm volatile("" : "+v"(stid_)); \
        _Pragma("unroll") for (int k_ = K0; k_ < K1; ++k_) { const int i_ = stid_ + k_ * NT, key_ = i_ >> 3, ch_ = i_ & 7; const bool ok_ = !(key_ < 576 && i_ >= (nl_)); \
            const int grow_ = key_ < 576 ? (b_) * SEQ + (rb_) * 64 + key_ : NLAT + (b_) * CTX + (key_ - 576); \
            pre[k_] = ok_ ? *(const u32x4*)(PROJ + (size_t)grow_ * NPROJ + (OFFS) + (h_) * 64 + ch_ * 8) : (u32x4){0u, 0u, 0u, 0u}; } } while (0)
#define NA_WRITE(nl_, K0, K1) do { int stid_ = tid; asm volatile("" : "+v"(stid_)); \
        _Pragma("unroll") for (int k_ = K0; k_ < K1; ++k_) { const int i_ = stid_ + k_ * NT, key_ = i_ >> 3, ch_ = i_ & 7; const bool ok_ = !(key_ < 576 && i_ >= (nl_)); \
            if (ok_) *(LAS u32x4*)(KV + key_ * NA_KS + ch_ * 16) = pre[k_]; } } while (0)
    int u = __builtin_amdgcn_readfirstlane(F.bid); int hprev = -1;
    if (u < 2048) { const int b = u >> 7, h = (u >> 4) & 7, m = u & 15, rb = NA_RB(m); NA_LOAD(OFF_K, b, h, rb, NA_NL(rb), 0, 13); }
    TPS_BEGIN;
    for (; u < 2048; u += F.G) {
        const int b = u >> 7, h = (u >> 4) & 7, m = u & 15, rbase = NA_RB(m), nloc8 = NA_NL(rbase);
        TPS(14);
        __syncthreads();
        TPS(10);
        NA_WRITE(nloc8, 0, 13);
        if (h != hprev) { if (tid < 465) rp[tid] = F.in[I_RPB][(size_t)(layer * 8 + h) * 465 + tid] * LOG2E; hprev = h; }
        NA_LOAD(OFF_V, b, h, rbase, nloc8, 0, NA_VPRE);
        __syncthreads();
        TPS(11);
        const int i = 2 * m + (w >> 2), j0 = (w & 3) * 16, qrow = b * SEQ + i * 64 + j0; int hs = j0 - 8; hs = hs < 0 ? 0 : (hs > 32 ? 32 : hs);
        int r0 = i - 4; r0 = r0 < 0 ? 0 : (r0 > 24 ? 24 : r0); const int kr0 = r0 - rbase;
        bf16x8 qf[2];
#pragma unroll
        for (int ks = 0; ks < 2; ++ks) qf[ks] = *(const bf16x8*)(PROJ + (size_t)(qrow + q16) * NPROJ + h * 64 + ks * 32 + g * 8);
        f32x4 S[32];
        const LAS unsigned char* kb = KV + q16 * NA_KS + g * 16;
        { const int j = j0 + q16; int cs = j - 8; cs = cs < 0 ? 0 : (cs > 48 ? 48 : cs);
          const int rb0 = (kr0 + rbase) - i + 7;
#pragma unroll
          for (int tl = 0; tl < 16; ++tl) { const int kr = tl >> 1, half = tl & 1; const int kidx0 = (kr0 + kr) * 64 + hs + 16 * half;
              f32x4 a = {0.f, 0.f, 0.f, 0.f};
#pragma unroll
              for (int ks = 0; ks < 2; ++ks) { const bf16x8 kf = *(const LAS bf16x8*)(kb + kidx0 * NA_KS + ks * 64); a = __builtin_amdgcn_mfma_f32_16x16x32_bf16(kf, qf[ks], a, 0, 0, 0); }
#pragma unroll
              for (int r = 0; r < 4; ++r) { const int kc = hs + 16 * half + 4 * g + r; const bool inw = (kc >= cs) && (kc < cs + 16);
                  int cbi = kc - j + 15; cbi = cbi < 0 ? 0 : (cbi > 30 ? 30 : cbi);
                  const float bias = rp[(rb0 + kr) * 31 + cbi];
                  const float t = a[r] * (0.125f * LOG2E) + bias; a[r] = inw ? t : -INFINITY; }
              S[tl] = a; if ((tl & 1) == 1) __builtin_amdgcn_sched_barrier(0); } }
#pragma unroll
        for (int tc = 0; tc < 16; ++tc) { const int kidx0 = 576 + 16 * tc; f32x4 a = {0.f, 0.f, 0.f, 0.f};
#pragma unroll
            for (int ks = 0; ks < 2; ++ks) { const bf16x8 kf = *(const LAS bf16x8*)(kb + kidx0 * NA_KS + ks * 64); a = __builtin_amdgcn_mfma_f32_16x16x32_bf16(kf, qf[ks], a, 0, 0, 0); }
            S[16 + tc] = a * (0.125f * LOG2E); if ((tc & 1) == 1) __builtin_amdgcn_sched_barrier(0); }
        float mx = -INFINITY;
#pragma unroll
        for (int t = 0; t < 32; ++t) mx = fmaxf(fmaxf(fmaxf(S[t][0], S[t][1]), fmaxf(S[t][2], S[t][3])), mx);
        mx = fmaxf(mx, __shfl_xor(mx, 16)); mx = fmaxf(mx, __shfl_xor(mx, 32));
        float sum = 0.f; u32x4 P[16];
#pragma unroll
        for (int kk = 0; kk < 16; ++kk) { float e[8];
#pragma unroll
            for (int r = 0; r < 4; ++r) { e[r] = __builtin_amdgcn_exp2f(S[2 * kk][r] - mx); e[4 + r] = __builtin_amdgcn_exp2f(S[2 * kk + 1][r] - mx); }
            sum += ((e[0] + e[1]) + (e[2] + e[3])) + ((e[4] + e[5]) + (e[6] + e[7]));
            P[kk].x = pg8::cvt_pk_bf16_pin(e[0], e[1]); P[kk].y = pg8::cvt_pk_bf16_pin(e[2], e[3]); P[kk].z = pg8::cvt_pk_bf16_pin(e[4], e[5]); P[kk].w = pg8::cvt_pk_bf16_pin(e[6], e[7]); }
        sum += __shfl_xor(sum, 16); sum += __shfl_xor(sum, 32);
        const float inv = 1.0f / sum;
        TPS(12);
        __syncthreads();
        NA_WRITE(nloc8, 0, NA_VPRE); NA_LOAD(OFF_V, b, h, rbase, nloc8, NA_VPRE, 13); NA_WRITE(nloc8, NA_VPRE, 13);
        { const int un = u + F.G; if (un < 2048) { const int bn = un >> 7, hn = (un >> 4) & 7, mn = un & 15, rbn = NA_RB(mn); NA_LOAD(OFF_K, bn, hn, rbn, NA_NL(rbn), 0, 13); } }
        __syncthreads();
        TPS(13);
        f32x4 o[4];
#pragma unroll
        for (int dt = 0; dt < 4; ++dt) o[dt] = (f32x4){0.f, 0.f, 0.f, 0.f};
        const LAS unsigned char* vb = KV + (4 * g + (q16 >> 2)) * NA_KS + (q16 & 3) * 8;
#pragma unroll
        for (int kk = 0; kk < 16; ++kk) {
            const int kidx0 = (kk < 8) ? (kr0 + kk) * 64 + hs : 576 + 32 * (kk - 8);
            const bf16x8 pa = __builtin_bit_cast(bf16x8, P[kk]);
#pragma unroll
            for (int dt = 0; dt < 4; ++dt) { const s16x4 lo = lds_tr16(vb + kidx0 * NA_KS + dt * 32), hi = lds_tr16(vb + (kidx0 + 16) * NA_KS + dt * 32);
                const bf16x8 vf = {lo[0], lo[1], lo[2], lo[3], hi[0], hi[1], hi[2], hi[3]};
                o[dt] = __builtin_amdgcn_mfma_f32_16x16x32_bf16(vf, pa, o[dt], 0, 0, 0); }
            if ((kk & 1) == 1) __builtin_amdgcn_sched_barrier(0);
        }
        { bf16_t* op = MIX + (size_t)(qrow + q16) * D + h * 64 + 4 * g;
#pragma unroll
          for (int dt = 0; dt < 4; ++dt) { u32x2 ow; ow.x = pk2(o[dt][0] * inv, o[dt][1] * inv); ow.y = pk2(o[dt][2] * inv, o[dt][3] * inv); *(u32x2*)(op + dt * 16) = ow; } }
    }
#undef NA_RB
#undef NA_NL
#undef NA_LOAD
#undef NA_WRITE
}
__device__ __forceinline__ void p_mixa(const Frame& F, int layer, bool last) {
    TPS_BEGIN;
    { PrepassW W; ssd_prepass_weights(F, layer, W);
      for (int u = F.bid; u < NTOK / 16; u += F.G) ssd_prepass_unit(F, u, W); }
    TPS(4);
    na_run(F, layer);
    TPS(5);
    if (!last) for (int u = F.bid; u < 256; u += F.G) na_unit(F, layer, u >> 4, (u >> 1) & 7, 1, u & 1);
    TPS(6);
}
__device__ __forceinline__ void p_mixb(const Frame& F, int layer) {
    for (int u0 = F.bid; u0 < 256 * REP_SSD; u0 += F.G) { const int u = u0 & 255; ssd_mfma_unit(F, layer, u >> 4, (u >> 1) & 7, u & 1); }
}

__device__ __forceinline__ void p_ssdcomb(const Frame& F, int layer, bool last) {
    const bf16_t* PROJ = (const bf16_t*)(F.ws + WS_PROJ); bf16_t* MIX = (bf16_t*)(F.ws + WS_MIX);
    const bf16_t* YF = (const bf16_t*)(F.ws + WS_YF); const bf16_t* YB = (const bf16_t*)(F.ws + WS_YB);
    const float* nw = F.in[I_NORMW] + layer * 512 + F.lane * 8;
    const f32x4 nw0 = *(const f32x4*)nw, nw1 = *(const f32x4*)(nw + 4);
    const int nrows = last ? NLAT : NTOK;
    u32x4 pyf = {0u, 0u, 0u, 0u}, pyb = pyf, pz = pyf;
#define SC_LOAD(r_) do { const size_t o_ = (size_t)(r_) * 512 + F.lane * 8; pyf = *(const u32x4*)(YF + o_); pyb = *(const u32x4*)(YB + o_); \
        pz = *(const u32x4*)(PROJ + (size_t)(r_) * NPROJ + OFF_Z + F.lane * 8); } while (0)
    if (F.gw < nrows) SC_LOAD(F.gw);
    for (int row = F.gw; row < nrows; row += F.NGW) {
        const f32x4 a0 = {bflo(pyf.x) + bflo(pyb.x), bfhi(pyf.x) + bfhi(pyb.x), bflo(pyf.y) + bflo(pyb.y), bfhi(pyf.y) + bfhi(pyb.y)}, a1 = {bflo(pyf.z) + bflo(pyb.z), bfhi(pyf.z) + bfhi(pyb.z), bflo(pyf.w) + bflo(pyb.w), bfhi(pyf.w) + bfhi(pyb.w)}; const u32x4 zv = pz;
        if (row + F.NGW < nrows) SC_LOAD(row + F.NGW);
        float y[8] = {a0[0] * silu_f(bflo(zv.x)), a0[1] * silu_f(bfhi(zv.x)), a0[2] * silu_f(bflo(zv.y)), a0[3] * silu_f(bfhi(zv.y)),
                      a1[0] * silu_f(bflo(zv.z)), a1[1] * silu_f(bfhi(zv.z)), a1[2] * silu_f(bflo(zv.w)), a1[3] * silu_f(bfhi(zv.w))};
        float ss = 0.f;
#pragma unroll
        for (int k = 0; k < 8; ++k) ss += y[k] * y[k];
#pragma unroll
        for (int of = 1; of < 32; of <<= 1) ss += __shfl_xor(ss, of);
        const float rs = 1.0f / sqrtf(ss * (1.0f / 256.0f) + RMS_EPS);
        u32x4 w; w.x = pk2(y[0] * rs * nw0[0], y[1] * rs * nw0[1]); w.y = pk2(y[2] * rs * nw0[2], y[3] * rs * nw0[3]);
        w.z = pk2(y[4] * rs * nw1[0], y[5] * rs * nw1[1]); w.w = pk2(y[6] * rs * nw1[2], y[7] * rs * nw1[3]);
        *(u32x4*)(MIX + (size_t)row * D + 512 + F.lane * 8) = w;
    }
}

__device__ __forceinline__ void p_outproj(const Frame& F, int layer, bool last) {
    pg8::Gemm g{(const bf16_t*)(F.ws + WS_MIX), (const bf16_t*)(F.ws + WS_WOUT) + (size_t)layer * D * D, D};
    pg8::DenseOrder S; S.init(last ? NLAT : NTOK, D, D, F.G, F.bid);
    pg8::EpiGate E{(bf16_t*)(F.ws + WS_DELTA1), (const float*)(F.ws + WS_MOD) + (size_t)layer * 17 * MODW, 2 * D};
    pg8::gemm_phase<pg8::EpiGate, pg8::DenseOrder, true, true>(F.lds, g, S, E, F.tid);
    if (layer == 0) deferred_conv(F, (NTOK / 256) * (D / 256), DW_L0_OUT, DW_Q); else if (layer == 1) deferred_conv(F, (NTOK / 256) * (D / 256), DW_L1_OUT, DW_Q);
}

__device__ __forceinline__ unsigned* cnt_word(const Frame& F, int slot, int hf, int e) { return (unsigned*)(F.ws + WS_CTL) + CW_CNT + ((slot * 2 + hf) * 8 + e) * 64; }
__device__ __forceinline__ void p_ln1(const Frame& F, int layer, bool last) {
    bf16_t* X = (bf16_t*)(F.ws + WS_X); bf16_t* H = (bf16_t*)(F.ws + WS_H);
    const float* MOD = (const float*)(F.ws + WS_MOD) + (size_t)layer * 17 * MODW;
    const float* lg = F.in[I_LNG] + (size_t)(layer * 2) * D; const float* lb = F.in[I_LNB] + (size_t)(layer * 2) * D;
    const bool moe = layer & 1; const int slot = layer >> 1;
    const int nrows = last ? NLAT : NTOK;
    float rw[16][8];
    if (moe) { const float* R = F.in[I_RW] + (size_t)slot * D * 8;
#pragma unroll
        for (int j = 0; j < 4; ++j)
#pragma unroll
            for (int k = 0; k < 4; ++k) { const int lane = F.lane; const f32x4 a = *(const f32x4*)(R + (size_t)(RIDX(j) + k) * 8), b2 = *(const f32x4*)(R + (size_t)(RIDX(j) + k) * 8 + 4);
                rw[j * 4 + k][0] = a[0]; rw[j * 4 + k][1] = a[1]; rw[j * 4 + k][2] = a[2]; rw[j * 4 + k][3] = a[3]; rw[j * 4 + k][4] = b2[0]; rw[j * 4 + k][5] = b2[1]; rw[j * 4 + k][6] = b2[2]; rw[j * 4 + k][7] = b2[3]; } }
    int nrec = 0;
    if (moe) { __syncthreads(); if (F.tid < 32) ((LAS unsigned*)F.lds)[F.tid] = 0u; __syncthreads(); }
    const bf16_t* DL = (const bf16_t*)(F.ws + WS_DELTA1);
    RowRaw r0 = {}, r1 = {};
    if (F.gw < nrows) row_issue<true>(X, DL, F.gw, F.lane, r0);
    if (F.gw + F.NGW < nrows) row_issue<true>(X, DL, F.gw + F.NGW, F.lane, r1);
    for (int row = F.gw; row < nrows; row += F.NGW) {
        f32x4 v[4], hv[4];
        row_combine(r0, v); r0 = r1;
        if (row + 2 * F.NGW < nrows) row_issue<true>(X, DL, row + 2 * F.NGW, F.lane, r1);
        row_ln(v, lg, lb, F.lane);
        row_store_h(X + (size_t)row * D, F.lane, v);
        const float* m = MOD + (size_t)mod_row_of(row) * MODW;
        if (USE_FP8 && (moe || FP8_DENSE1)) row_mod_store8((unsigned char*)H + (size_t)row * D, F.lane, v, m + 3 * D, m + 4 * D, hv);
        else row_mod_store(H + (size_t)row * D, F.lane, v, m + 3 * D, m + 4 * D, hv);
        if (moe) {
            float lg8[8];
#pragma unroll
            for (int e = 0; e < 8; ++e) { float s = 0.f;
#pragma unroll
                for (int j = 0; j < 4; ++j)
#pragma unroll
                    for (int k = 0; k < 4; ++k) s += hv[j][k] * rw[j * 4 + k][e];
                lg8[e] = wave_sum(s); }
            int e0 = 0; float v0 = lg8[0];
#pragma unroll
            for (int e = 1; e < 8; ++e) if (lg8[e] > v0) { v0 = lg8[e]; e0 = e; }
            int e1 = -1; float v1 = -INFINITY;
#pragma unroll
            for (int e = 0; e < 8; ++e) if (e != e0 && lg8[e] > v1) { v1 = lg8[e]; e1 = e; }
            if (F.lane == 0) {
                const unsigned s0 = __hip_atomic_fetch_add((LAS unsigned*)F.lds + e0, 1u, __ATOMIC_RELAXED, __HIP_MEMORY_SCOPE_WORKGROUP), s1 = __hip_atomic_fetch_add((LAS unsigned*)F.lds + e1, 1u, __ATOMIC_RELAXED, __HIP_MEMORY_SCOPE_WORKGROUP);
                const float ex = __expf(v1 - v0), g0 = 1.0f / (1.0f + ex);
                ((LAS u32x4*)(F.lds + 256))[F.wave * 32 + nrec] = (u32x4){(unsigned)e0 | ((unsigned)e1 << 8), s0, s1, (unsigned)row};
                *(f32x2*)(F.ws + WS_GATES + (size_t)row * 8) = (f32x2){g0, ex * g0};
            }
            ++nrec;
        }
    }
    if (moe) {
        __syncthreads();
        if (F.tid < 8) ((LAS unsigned*)F.lds)[16 + F.tid] = atomicAdd(cnt_word(F, slot, 0, F.tid), ((LAS unsigned*)F.lds)[F.tid]);
        __syncthreads();
        int* list = (int*)(F.ws + WS_LIST);
        if (F.lane < nrec) { const u32x4 rc = ((LAS u32x4*)(F.lds + 256))[F.wave * 32 + F.lane]; const int e0 = rc.x & 255, e1 = (rc.x >> 8) & 255; const int row = (int)rc.w;
            const unsigned s0 = ((LAS unsigned*)F.lds)[16 + e0] + rc.y, s1 = ((LAS unsigned*)F.lds)[16 + e1] + rc.z;
            list[e0 * NTOK + s0] = row; list[e1 * NTOK + s1] = row;
            *(u32x4*)(F.ws + WS_ROUTE + (size_t)row * 16) = (u32x4){rc.x, s0, s1, 0u}; }
    }
}

__device__ __forceinline__ void p_ffn1_dense(const Frame& F, int layer, bool last) {
    const int s = layer >> 1;
#if USE_FP8 && FP8_DENSE2
    typedef pg8::EpiSwiGLU8 EpiH; EpiH E{F.ws + WS_HID, DFF};
#else
    typedef pg8::EpiSwiGLU EpiH; EpiH E{(bf16_t*)(F.ws + WS_HID), DFF};
#endif
#if USE_FP8 && FP8_DENSE1
    pg8::Gemm g{(const bf16_t*)(F.ws + WS_H), (const bf16_t*)(F.ws + WS_WFGU + (size_t)s * 2 * DFF * D), D / 2};
    pg8::DenseOrder S; S.init(last ? NLAT : NTOK, 2 * DFF, D / 2, F.G, F.bid, REP_GEMM);
    pg8::gemm_phase<EpiH, pg8::DenseOrder, true, FP8_SP2, true>(F.lds, g, S, E, F.tid, (127 - S8_WGU) * 0x01010101, (127 - S8_ACT) * 0x01010101);
#else
    pg8::Gemm g{(const bf16_t*)(F.ws + WS_H), (const bf16_t*)(F.ws + WS_WFGU) + (size_t)s * 2 * DFF * D, D};
    pg8::DenseOrder S; S.init(last ? NLAT : NTOK, 2 * DFF, D, F.G, F.bid, REP_GEMM);
    pg8::gemm_phase<EpiH, pg8::DenseOrder, true, true>(F.lds, g, S, E, F.tid);
#endif
    if (layer == 0) deferred_conv(F, (NTOK / 256) * (2 * DFF / 256), DW_L0_F1, DW_Q);
}
__device__ __forceinline__ void p_ffn2_dense(const Frame& F, int layer, bool last) {
    const int s = layer >> 1;
    pg8::EpiGate E{(bf16_t*)(F.ws + WS_DELTA2), (const float*)(F.ws + WS_MOD) + (size_t)layer * 17 * MODW, 5 * D};
#if USE_FP8 && FP8_DENSE2
    pg8::Gemm g{(const bf16_t*)(F.ws + WS_HID), (const bf16_t*)(F.ws + WS_WFD + (size_t)s * D * DFF), DFF / 2};
    pg8::DenseOrder S; S.init(last ? NLAT : NTOK, D, DFF / 2, F.G, F.bid);
    pg8::gemm_phase<pg8::EpiGate, pg8::DenseOrder, true, FP8_SP2, true>(F.lds, g, S, E, F.tid, (127 - S8_WD) * 0x01010101, (127 - S8_HID) * 0x01010101);
#else
    pg8::Gemm g{(const bf16_t*)(F.ws + WS_HID), (const bf16_t*)(F.ws + WS_WFD) + (size_t)s * D * DFF, DFF};
    pg8::DenseOrder S; S.init(last ? NLAT : NTOK, D, DFF, F.G, F.bid);
    pg8::gemm_phase<pg8::EpiGate, pg8::DenseOrder, true, true>(F.lds, g, S, E, F.tid);
#endif
    if (layer == 0) deferred_conv(F, (NTOK / 256) * (D / 256), DW_L0_F2, DW_Q2);
}
__device__ __forceinline__ void moe_prefix(const Frame& F, int slot, int hf, int (&ts)[9], int (&cn)[8]) {
    int a = 0;
#pragma unroll
    for (int e = 0; e < 8; ++e) { cn[e] = (int)*cnt_word(F, slot, hf, e); ts[e] = a; a += (cn[e] + 255) >> 8; }
    ts[8] = a;
}
__device__ __forceinline__ void p_ffn1_moe(const Frame& F, int layer) {
    const int slot = layer >> 1; int cn[8];
    pg8::MoeOrder<true> S; moe_prefix(F, slot, 0, S.ts, cn);
    S.nM = S.ts[8]; S.nN = 2 * DFFE / 256; S.G = F.G; S.c = F.bid; S.K = D / 2; S.estride = (long)2 * DFFE * D; S.rowoff = (const LAS unsigned short*)(F.lds + LDS_ROWOFF); S.rowbytes = D;
    {
        const int* list = (const int*)(F.ws + WS_LIST); LAS unsigned short* ro = (LAS unsigned short*)(F.lds + LDS_ROWOFF); pg8::Unit u;
        for (int i = F.wave; i < 36 && S.next(i, u); i += NWAVES) { const int e = S.expert_of(u.pm); int tse = 0, cne = 0;
#pragma unroll
            for (int j = 0; j < 8; ++j) { tse = (j == e) ? S.ts[j] : tse; cne = (j == e) ? cn[j] : cne; }
            int tk[4];
#pragma unroll
            for (int q = 0; q < 4; ++q) { const int sl = (u.pm - tse) * 256 + F.lane + 64 * q; tk[q] = sl < cne ? list[e * NTOK + sl] : 0; }
#pragma unroll
            for (int q = 0; q < 4; ++q) ro[i * 256 + F.lane + 64 * q] = (unsigned short)tk[q]; }
        __syncthreads();
    }
    pg8::Gemm g{(const bf16_t*)(F.ws + WS_H), (const bf16_t*)(F.ws + WS_WMGU + (size_t)slot * NEXP * 2 * DFFE * D), D / 2};
    pg8::EpiSwiGLU8 E{F.ws + WS_HID, DFFE};
    pg8::gemm_phase<pg8::EpiSwiGLU8, pg8::MoeOrder<true>, true, FP8_SP2, true>(F.lds, g, S, E, F.tid, (127 - S8_WGU) * 0x01010101, (127 - S8_ACT) * 0x01010101);
}
__device__ __forceinline__ void p_ffn2_moe(const Frame& F, int layer) {
    const int slot = layer >> 1; int cn[8];
    pg8::MoeOrder<false> S; moe_prefix(F, slot, 0, S.ts, cn);
    S.nM = S.ts[8]; S.nN = D / 256; S.G = F.G; S.c = F.bid; S.K = DFFE / 2; S.estride = (long)D * DFFE; S.rowoff = nullptr; S.rowbytes = 0;
    pg8::EpiBf16 E{(bf16_t*)(F.ws + WS_YP), D};
    pg8::Gemm g{(const bf16_t*)(F.ws + WS_HID), (const bf16_t*)(F.ws + WS_WMD + (size_t)slot * NEXP * D * DFFE), DFFE / 2};
    pg8::gemm_phase<pg8::EpiBf16, pg8::MoeOrder<false>, true, FP8_SP2, true>(F.lds, g, S, E, F.tid, (127 - S8_WD) * 0x01010101, (127 - S8_HID) * 0x01010101);
}

template <bool MOE> __device__ __forceinline__ void ln2_body(const Frame& F, int layer, bool last) {
    bf16_t* X = (bf16_t*)(F.ws + WS_X); bf16_t* H = (bf16_t*)(F.ws + WS_H);
    const float* MOD = (const float*)(F.ws + WS_MOD) + (size_t)layer * 17 * MODW;
    const float* lg = F.in[I_LNG] + (size_t)(layer * 2 + 1) * D; const float* lb = F.in[I_LNB] + (size_t)(layer * 2 + 1) * D;
    const int slot = layer >> 1;
    const int nrows = last ? NLAT : NTOK;
    int ts0[9], cn[8];
    if (MOE) moe_prefix(F, slot, 0, ts0, cn);
    const bf16_t* YP = (const bf16_t*)(F.ws + WS_YP); const bf16_t* DL = (const bf16_t*)(F.ws + WS_DELTA2);
    RowRaw r0 = {}, r1 = {}; u32x4 rt0 = {0u, 0u, 0u, 0u}, rt1 = {0u, 0u, 0u, 0u}; f32x2 g0 = {0.f, 0.f}, g1 = {0.f, 0.f}; u32x4 ya[2] = {}, yb[2] = {};
#define LN2_ISSUE(row_, r_, rt_, g_) do { row_issue<!MOE>(X, DL, (row_), F.lane, r_); \
        if (MOE) { rt_ = *(const u32x4*)(F.ws + WS_ROUTE + (size_t)(row_) * 16); g_ = *(const f32x2*)(F.ws + WS_GATES + (size_t)(row_) * 8); } } while (0)
#define LN2_ISSUE_Y(rt_) do { const int e0_ = (rt_).x & 255, e1_ = ((rt_).x >> 8) & 255; int t0_ = 0, t1_ = 0; \
        _Pragma("unroll") for (int e = 0; e < 8; ++e) { const int tv = ts0[e]; t0_ = (e == e0_) ? tv : t0_; t1_ = (e == e1_) ? tv : t1_; } \
        const bf16_t* y0_ = YP + ((size_t)t0_ * 256 + (rt_).y) * D; const bf16_t* y1_ = YP + ((size_t)t1_ * 256 + (rt_).z) * D; \
        _Pragma("unroll") for (int j = 0; j < 2; ++j) { ya[j] = *(const u32x4*)(y0_ + 8 * F.lane + 512 * j); yb[j] = *(const u32x4*)(y1_ + 8 * F.lane + 512 * j); } } while (0)
    if (F.gw < nrows) LN2_ISSUE(F.gw, r0, rt0, g0);
    if (F.gw + F.NGW < nrows) LN2_ISSUE(F.gw + F.NGW, r1, rt1, g1);
    if (MOE) { if (F.gw < nrows) LN2_ISSUE_Y(rt0); }
    for (int row = F.gw; row < nrows; row += F.NGW) {
        f32x4 v[4], hv[4];
        if (MOE) {
            const float* g2 = MOD + (size_t)mod_row_of(row) * MODW + 5 * D;
#pragma unroll
            for (int j = 0; j < 2; ++j) { const int lane = F.lane; f32x4 x0, x1, a0, a1, b0, b1; unpack8(r0.x[j], x0, x1); unpack8(ya[j], a0, a1); unpack8(yb[j], b0, b1);
                const f32x4 q0 = *(const f32x4*)(g2 + RIDX(2 * j)) + 1.0f, q1 = *(const f32x4*)(g2 + RIDX(2 * j + 1)) + 1.0f;
                v[2 * j] = x0 * ALPHA + q0 * (a0 * g0[0] + b0 * g0[1]); v[2 * j + 1] = x1 * ALPHA + q1 * (a1 * g0[0] + b1 * g0[1]); }
        } else row_combine(r0, v);
        r0 = r1; rt0 = rt1; g0 = g1;
        if (MOE) { if (row + F.NGW < nrows) LN2_ISSUE_Y(rt0); }
        if (row + 2 * F.NGW < nrows) LN2_ISSUE(row + 2 * F.NGW, r1, rt1, g1);
        row_ln(v, lg, lb, F.lane);
        if (last) row_store(F.out + (size_t)row * D, F.lane, v);
        else { row_store_h(X + (size_t)row * D, F.lane, v);
            const float* m = MOD + (size_t)17 * MODW + (size_t)mod_row_of(row) * MODW;
            row_mod_store(H + (size_t)row * D, F.lane, v, m, m + D, hv);
            }
    }
#undef LN2_ISSUE
#undef LN2_ISSUE_Y
}
__device__ __forceinline__ void p_ln2(const Frame& F, int layer, bool last) { if (layer & 1) ln2_body<true>(F, layer, last); else ln2_body<false>(F, layer, last); }

constexpr int NPL = 9;
constexpr int NPH = 2 + NPL * DEPTH;
#ifndef SITE_MASK
#define SITE_MASK 0xFFFFF
#endif
#ifndef TPROBE_MULT
#define TPROBE_MULT 4
#endif
#define SITE(n) (((SITE_MASK) >> (n)) & 1)
__global__ void __launch_bounds__(NT, 2) fwd_kernel(Args args) {
    extern __shared__ __attribute__((aligned(16))) unsigned char lds_raw[];
    Frame F;
    F.lds = (LAS unsigned char*)lds_raw; F.in = args.in; F.out = args.out; F.ws = args.ws;
    F.tid = threadIdx.x; F.lane = F.tid & 63; F.wave = __builtin_amdgcn_readfirstlane(F.tid >> 6); F.bid = blockIdx.x; F.G = gridDim.x;
    F.gw = F.bid * NWAVES + F.wave; F.NGW = F.G * NWAVES;
    volatile LAS unsigned* MISC = (volatile LAS unsigned*)(F.lds + LDS_MISC);
    if (F.tid < 64) MISC[F.tid] = 0u;
    __syncthreads();
    XcdBarrier bar; bar.bar = (unsigned*)(F.ws + WS_CTL) + CW_BAR; bar.x = 0; bar.st = MISC + 8;
#if MK_SINGLE
    bar = xcd_barrier_post((unsigned*)(F.ws + WS_CTL) + CW_BAR, MISC + 8);
#endif
    const int lo = args.ph_lo, hi = args.ph_hi;
#define IN(k) (lo <= (k) && (k) < hi)
#if TPROBE >= 0
    unsigned long long tp_prev = __builtin_amdgcn_s_memrealtime(), tp_acc = 0ull;
#define TP(type) do { const unsigned long long t_ = __builtin_amdgcn_s_memrealtime(); if ((type) == TPROBE) tp_acc += t_ - tp_prev; tp_prev = t_; } while (0)
#else
#define TP(type) do { } while (0)
#endif
#if MK_SINGLE
#define SEAM(k) do { if (IN(k) && IN((k) + 1)) { XcdBarrier b2_ = bar; int z_; asm volatile("s_mov_b32 %0, 0" : "=s"(z_)); b2_.bar = bar.bar + z_; int ln_; asm volatile("v_mbcnt_lo_u32_b32 %0, -1, 0\n\tv_mbcnt_hi_u32_b32 %0, -1, %0" : "=v"(ln_)); xcd_barrier(b2_, F.wave == 0 && ln_ == 0); } } while (0)
#else
#define SEAM(k) do { } while (0)
#endif
    if constexpr (SITE(0)) if (IN(0)) p_pro_a(fresh(F));
    SEAM(0); TP(0);
    if constexpr (SITE(1)) if (IN(1)) p_pro_b(fresh(F));
    SEAM(1); TP(1);
    for (int layer = 0; layer < DEPTH; ++layer) {
        const int pb = 2 + NPL * layer; const bool last = layer == DEPTH - 1; const bool moe = layer & 1;
        if constexpr (SITE(2)) if (IN(pb + 0)) p_inproj(fresh(F), layer);
        SEAM(pb + 0); TP(2);
        if constexpr (SITE(3)) if (IN(pb + 1)) p_mixa(fresh(F), layer, last);
        SEAM(pb + 1); TP(3);
        if constexpr (SITE(12)) if (IN(pb + 2)) p_mixb(fresh(F), layer);
        SEAM(pb + 2); TP(4);
        if constexpr (SITE(4)) if (IN(pb + 3)) { p_ssdcomb(fresh(F), layer, last); if (!USE_FP8 && layer == 2) { int rot = 0; conv_moe(fresh(F), 1, rot); } }
        SEAM(pb + 3); TP(5);
        if constexpr (SITE(5)) if (IN(pb + 4)) p_outproj(fresh(F), layer, last);
        SEAM(pb + 4); TP(6);
        if constexpr (SITE(6)) if (IN(pb + 5)) p_ln1(fresh(F), layer, last);
        SEAM(pb + 5); TP(7);
        if (moe) {
            if constexpr (SITE(7)) if (IN(pb + 6)) p_ffn1_moe(fresh(F), layer);
            SEAM(pb + 6); TP(8);
            if constexpr (SITE(8)) if (IN(pb + 7)) p_ffn2_moe(fresh(F), layer);
            SEAM(pb + 7); TP(9);
        } else {
            if constexpr (SITE(9)) if (IN(pb + 6)) p_ffn1_dense(fresh(F), layer, last);
            SEAM(pb + 6); TP(10);
            if constexpr (SITE(10)) if (IN(pb + 7)) p_ffn2_dense(fresh(F), layer, last);
            SEAM(pb + 7); TP(11);
        }
        if constexpr (SITE(11)) if (IN(pb + 8)) p_ln2(fresh(F), layer, last);
        if (!last) SEAM(pb + 8);
        TP(12);
    }
#if TPROBE >= 100
    __syncthreads(); tp_acc = ((volatile LAS unsigned*)(F.lds + LDS_MISC))[40];
#endif
#if TPROBE >= 0
    { const unsigned long long t_end = __builtin_amdgcn_s_memrealtime(); while (__builtin_amdgcn_s_memrealtime() - t_end < (unsigned long long)TPROBE_MULT * tp_acc) __builtin_amdgcn_s_sleep(8); }
#endif
#undef IN
#undef SEAM
}

extern "C" void kernel_launch(void* const* d_in, const int* in_sizes, int n_in, void* d_out, int out_size, void* d_ws, size_t ws_size, hipStream_t stream) {
    static int grid = 0;
    if (grid == 0) {
        if (n_in != 24 || out_size != NLAT * D || ws_size < WS_END) { fprintf(stderr, "kernel_launch: unexpected shapes (n_in %d, out %d, ws %zu < %zu)\n", n_in, out_size, ws_size, (size_t)WS_END); grid = -1; return; }
        int dev = 0, cus = 0, per_cu = 0;
        if (hipGetDevice(&dev) != hipSuccess || hipDeviceGetAttribute(&cus, hipDeviceAttributeMultiprocessorCount, dev) != hipSuccess) { grid = -1; return; }
        if (hipFuncSetAttribute((const void*)fwd_kernel, hipFuncAttributeMaxDynamicSharedMemorySize, LDS_BYTES) != hipSuccess) { fprintf(stderr, "kernel_launch: hipFuncSetAttribute failed\n"); grid = -1; return; }
        if (hipOccupancyMaxActiveBlocksPerMultiprocessor(&per_cu, (const void*)fwd_kernel, NT, LDS_BYTES) != hipSuccess || per_cu < 1) { fprintf(stderr, "kernel_launch: occupancy query says %d\n", per_cu); }
        (void)hipGetLastError();
        grid = cus;
    }
    if (grid < 0) return;
    (void)in_sizes;
    if (hipMemsetAsync((char*)d_ws + WS_CTL, 0, CTL_BYTES, stream) != hipSuccess) return;
    Args a{};
    for (int i = 0; i < 24; ++i) a.in[i] = (const float*)d_in[i];
    a.out = (float*)d_out; a.ws = (unsigned char*)d_ws;
#if MK_SINGLE
    a.ph_lo = 0; a.ph_hi = NPH;
    hipLaunchKernelGGL(fwd_kernel, dim3(grid), dim3(NT), LDS_BYTES, stream, a);
#else
    for (int ph = 0; ph < NPH; ++ph) {

        a.ph_lo = ph; a.ph_hi = ph + 1;
        hipLaunchKernelGGL(fwd_kernel, dim3(grid), dim3(NT), LDS_BYTES, stream, a);
    }
#endif
}
```

```cpp
#include <hip/hip_runtime.h>
#include <cstdio>
#include <cstdint>

#ifndef MK_SINGLE
#define MK_SINGLE 1
#endif

#ifndef FP8_INPROJ
#define FP8_INPROJ 0
#endif
#ifndef FP8_DENSE1
#define FP8_DENSE1 0
#endif
#ifndef FP8_DENSE2
#define FP8_DENSE2 1
#endif
#ifndef USE_FP8
#define USE_FP8 1
#endif
#ifndef FP8_SP2
#define FP8_SP2 true
#endif
#ifndef REP_SSD
#define REP_SSD 1
#endif
#ifndef REP_NA
#define REP_NA 1
#endif
#ifndef REP_GEMM
#define REP_GEMM 1
#endif
#define GAS __attribute__((address_space(1)))
#define LAS __attribute__((address_space(3)))
typedef unsigned short bf16_t;
typedef short bf16x8 __attribute__((ext_vector_type(8)));
typedef float f32x4 __attribute__((ext_vector_type(4)));
typedef float f32x2 __attribute__((ext_vector_type(2)));
typedef unsigned u32x4 __attribute__((ext_vector_type(4)));
typedef unsigned u32x2 __attribute__((ext_vector_type(2)));
typedef int i32x4 __attribute__((ext_vector_type(4)));
typedef int i32x8 __attribute__((ext_vector_type(8)));

constexpr int D = 1024, BATCH = 16, SEQ = 2048, DEPTH = 4, GRID_W = 64, CTX = 256;
constexpr int NLAT = BATCH * SEQ;
constexpr int NCTX = BATCH * CTX;
constexpr int NTOK = NLAT + NCTX;
constexpr int NPROJ = 3072;
constexpr int OFF_K = 512, OFF_V = 1024, OFF_Z = 1536, OFF_XBC = 2048;
constexpr int D_IN_PROJ = 3088;
constexpr int DFF = 2816, DFFE = 3584, NEXP = 8;
constexpr float ALPHA = 1.6817928305074290f;
constexpr float LN_EPS = 1e-5f, RMS_EPS = 1e-5f;
constexpr int MODW = 6 * D;

constexpr size_t MiB = 1u << 20;
constexpr size_t WS_CTL = 0, CTL_BYTES = 1 * MiB;
constexpr size_t WS_MOD = 1 * MiB;
constexpr size_t WS_ROUTE = 3 * MiB;
constexpr size_t WS_GATES = 4 * MiB;
constexpr size_t WS_LIST = 5 * MiB;
constexpr size_t WS_WDT = 7 * MiB;
constexpr size_t WS_WIN = 8 * MiB;
constexpr size_t WS_WOUT = 32 * MiB;
constexpr size_t WS_WFGU = 40 * MiB;
constexpr size_t WS_WFD = 62 * MiB;
constexpr size_t WS_WMGU = 73 * MiB;
constexpr size_t WS_WMD = 185 * MiB;
constexpr size_t WS_X = 241 * MiB;
constexpr size_t WS_H = 385 * MiB;
constexpr size_t WS_R = 457 * MiB;
constexpr size_t WS_PROJ = WS_R;
constexpr size_t WS_DT = WS_R + 216 * MiB;
constexpr size_t WS_YF = WS_R + 219 * MiB;
constexpr size_t WS_YB = WS_R + 291 * MiB;
constexpr size_t WS_MIX = WS_R + 363 * MiB;
constexpr size_t WS_HID = WS_R;
constexpr size_t WS_YP = WS_R + 270 * MiB;
constexpr size_t WS_DELTA1 = WS_R;
constexpr size_t WS_DELTA2 = WS_R + 270 * MiB;
constexpr size_t WS_U = WS_R + 435 * MiB;
constexpr size_t WS_H8IN = WS_U;
constexpr size_t WS_END = WS_R + 507 * MiB;
constexpr int MOE_PAD = 2 * NTOK + 2048;
static_assert(USE_FP8 == 1, "the single-phase MoE needs the e4m3 hidden (the bf16 one does not fit the workspace)");
static_assert(WS_HID + (size_t)MOE_PAD * 3584 <= WS_YP && WS_YP + (size_t)MOE_PAD * 1024 * 2 <= WS_END, "MoE buffers");

constexpr int CW_TMO = 0;
constexpr int CW_BAR = 4096;
constexpr int CW_CNT = 16384;

constexpr int LDS_STAGE = 131072;
constexpr int LDS_ROWOFF = 131072;
constexpr int LDS_MISC = 131072 + 18432;
constexpr int LDS_BYTES = 155648;

constexpr int S8_ACT = 3, S8_WGU = 8, S8_HID = 2, S8_WD = 9;
#ifndef TPROBE
#define TPROBE (-1)
#endif
#if TPROBE >= 100
#define TPS_BEGIN unsigned long long tps_t_ = __builtin_amdgcn_s_memrealtime()
#define TPS(k) do { const unsigned long long t_ = __builtin_amdgcn_s_memrealtime(); if (TPROBE == 100 + (k) && F.tid == 0) ((volatile LAS unsigned*)(F.lds + LDS_MISC))[40] += (unsigned)(t_ - tps_t_); tps_t_ = t_; } while (0)
#else
#define TPS_BEGIN do { } while (0)
#define TPS(k) do { } while (0)
#endif
#define GATE_PRESCALE (-1.4426950408889634f)
__device__ __forceinline__ unsigned f2bf(float f) { unsigned u = __builtin_bit_cast(unsigned, f); return (u + 0x7fffu + ((u >> 16) & 1u)) >> 16; }
typedef __bf16 bf16x2_t __attribute__((ext_vector_type(2)));
__device__ __forceinline__ unsigned pk2(float lo, float hi) { const f32x2 v = {lo, hi}; const bf16x2_t b = __builtin_convertvector(v, bf16x2_t); return __builtin_bit_cast(unsigned, b); }
__device__ __forceinline__ float bf2f(unsigned short b) { return __builtin_bit_cast(float, ((unsigned)b) << 16); }
__device__ __forceinline__ float bflo(unsigned w) { return __builtin_bit_cast(float, w << 16); }
__device__ __forceinline__ float bfhi(unsigned w) { return __builtin_bit_cast(float, w & 0xffff0000u); }
__device__ __forceinline__ float silu_f(float v) { return v / (1.0f + __expf(-v)); }
__device__ __forceinline__ float clamp8(float v) { return fminf(fmaxf(v, -448.0f), 448.0f); }
__device__ __forceinline__ unsigned pk8(float a, float b, float c, float d) {
    int w = 0; w = __builtin_amdgcn_cvt_pk_fp8_f32(clamp8(a), clamp8(b), w, false); w = __builtin_amdgcn_cvt_pk_fp8_f32(clamp8(c), clamp8(d), w, true); return (unsigned)w; }
template <int CTRL, int ROWMASK = 0xF, bool BC = false>
__device__ __forceinline__ float dpp_f(float v) { return __builtin_bit_cast(float, __builtin_amdgcn_update_dpp(0, __builtin_bit_cast(int, v), CTRL, ROWMASK, 0xF, BC)); }
__device__ __forceinline__ float row16_sum(float v) {
    v += dpp_f<0xB1>(v); v += dpp_f<0x4E>(v); v += dpp_f<0x141>(v); v += dpp_f<0x140>(v);
    return v;
}
__device__ __forceinline__ float wave_sum(float v) {
    v = row16_sum(v);
    v += dpp_f<0x142, 0xA>(v); v += dpp_f<0x143, 0xC>(v);
    return __builtin_bit_cast(float, __builtin_amdgcn_readlane(__builtin_bit_cast(int, v), 63));
}
__device__ __forceinline__ float xrow_max(float v) {
    unsigned u = __builtin_bit_cast(unsigned, v); auto r = __builtin_amdgcn_permlane16_swap(u, u, false, false);
    v = fmaxf(__builtin_bit_cast(float, r[0]), __builtin_bit_cast(float, r[1]));
    u = __builtin_bit_cast(unsigned, v); auto r2 = __builtin_amdgcn_permlane32_swap(u, u, false, false);
    return fmaxf(__builtin_bit_cast(float, r2[0]), __builtin_bit_cast(float, r2[1]));
}
__device__ __forceinline__ float xrow_sum(float v) {
    unsigned u = __builtin_bit_cast(unsigned, v); auto r = __builtin_amdgcn_permlane16_swap(u, u, false, false);
    v = __builtin_bit_cast(float, r[0]) + __builtin_bit_cast(float, r[1]);
    u = __builtin_bit_cast(unsigned, v); auto r2 = __builtin_amdgcn_permlane32_swap(u, u, false, false);
    return __builtin_bit_cast(float, r2[0]) + __builtin_bit_cast(float, r2[1]);
}
__device__ __forceinline__ float wave_scan(float v) {
    v += dpp_f<0x111, 0xF, true>(v); v += dpp_f<0x112, 0xF, true>(v); v += dpp_f<0x114, 0xF, true>(v); v += dpp_f<0x118, 0xF, true>(v);
    v += dpp_f<0x142, 0xA>(v); v += dpp_f<0x143, 0xC>(v);
    return v;
}

namespace pg8 {
constexpr int BM = 256, BK = 64, HALF = 128, HTB = HALF * BK * 2, STAGE_BYTES = 8 * HTB, NXCD = 8, WGM = 8;
__host__ __device__ __forceinline__ int lds_byte(int r, int c) { const int st = (r >> 4) * 2 + (c >> 5), rr = r & 15, cc = c & 31, ob = rr * 64 + cc * 2; return st * 1024 + (ob ^ (((ob >> 9) & 1) << 5)); }
__host__ __device__ __forceinline__ void stage_rc(int b, int& R, int& C) { const int st = b / 1024, sb = b % 1024, swz = sb ^ (((sb >> 9) & 1) << 5); R = (st >> 1) * 16 + swz / 64; C = (st & 1) * 32 + (swz % 64) / 2; }
__host__ __device__ __forceinline__ int perm32(int rho) { const int n = rho >> 4, i = rho & 15; return 8 * (i >> 2) + 4 * n + (i & 3); }

struct Unit { int pm, pn; long bofs; };
struct Gemm { const bf16_t* A; const bf16_t* Bt; int K; };

__device__ __forceinline__ unsigned cvt_pk_bf16(float lo, float hi) { return pk2(lo, hi); }
__device__ __forceinline__ unsigned cvt_pk_bf16_pin(float lo, float hi) { unsigned r; asm volatile("v_cvt_pk_bf16_f32 %0, %1, %2" : "=v"(r) : "v"(lo), "v"(hi)); return r; }

__device__ __forceinline__ bool static_tile(int i, int G, int c, int nM, int nN, int& pm, int& pn, int rep = 1) {
    const int nwg = nM * nN;
#if REP_GEMM > 1
    { const int cnt = (nwg - c + G - 1) / G; if (cnt <= 0 || i >= rep * cnt) return false; i %= cnt; }
#endif
    const long L = (long)i * G + c; if (L >= nwg) return false;
    int wgid = (int)L; { const int q = nwg / NXCD, r = nwg % NXCD, xcd = wgid % NXCD, off = wgid / NXCD; wgid = (xcd < r ? xcd * (q + 1) : r * (q + 1) + (xcd - r) * q) + off; }
    const int nig = WGM * nN, gid = wgid / nig, fm = gid * WGM, gsz = (nM - fm) < WGM ? (nM - fm) : WGM;
    pm = fm + ((wgid % nig) % gsz); pn = (wgid % nig) / gsz; return true;
}
struct DenseOrder {
    int nM, nN, G, c, K, rep;
    __device__ __forceinline__ void init(int M, int N, int K_, int G_, int c_, int rep_ = 1) { nM = M / BM; nN = N / BM; G = G_; c = c_; K = K_; rep = rep_; }
    __device__ __forceinline__ bool next(int i, Unit& u) const { if (!static_tile(i, G, c, nM, nN, u.pm, u.pn, rep)) return false; u.bofs = (long)u.pn * BM * K * 2; return true; }
    static constexpr bool GATHER = false;
    __device__ __forceinline__ long a_base(const Unit& u) const { return (long)u.pm * BM * K * 2; }
    __device__ __forceinline__ void a_offs(int, const Unit&, int, unsigned (&)[2][2]) const {}
};
template <bool GATHER_> struct MoeOrder {
    int nM, nN, G, c, K; int ts[9]; long estride; const LAS unsigned short* rowoff; unsigned rowbytes;
    __device__ __forceinline__ int expert_of(int pm) const { int e = 0;
#pragma unroll
        for (int j = 1; j < 8; ++j) e += (pm >= ts[j]) ? 1 : 0; return e; }
    __device__ __forceinline__ bool next(int i, Unit& u) const { if (!static_tile(i, G, c, nM, nN, u.pm, u.pn, REP_GEMM)) return false; u.bofs = (long)expert_of(u.pm) * estride + (long)u.pn * BM * K * 2; return true; }
    static constexpr bool GATHER = GATHER_;
    __device__ __forceinline__ long a_base(const Unit& u) const { return GATHER_ ? 0l : (long)u.pm * BM * K * 2; }
    __device__ __forceinline__ void a_offs(int ui, const Unit&, int tid, unsigned (&o)[2][2]) const {
        int uix = ui;
#if REP_GEMM > 1
        { const int cnt = (nM * nN - c + G - 1) / G; uix = ui % cnt; }
#endif
        if (GATHER_) {
#pragma unroll
            for (int i = 0; i < 2; ++i) { int R, C; stage_rc(tid * 16 + i * 8192, R, C);
#pragma unroll
                for (int h = 0; h < 2; ++h) o[h][i] = (unsigned)rowoff[uix * 256 + h * HALF + R] * rowbytes + (unsigned)(C * 2); }
        }
    }
};

struct EpiBf16 {
    static constexpr bool PERM = true;
    bf16_t* O; int ldc;
    __device__ __forceinline__ void operator()(const f32x4 (&acc)[2][2][4][2], const Unit& u, int wr, int wc, int fr, int fq) const {
        const int row0 = u.pm * BM + wr * 64 + fr; const int col0 = u.pn * BM + wc * 32 + 8 * fq;
#pragma unroll
        for (int ai = 0; ai < 2; ++ai)
#pragma unroll
            for (int m = 0; m < 4; ++m) { bf16_t* rowp = O + (size_t)(row0 + ai * HALF + m * 16) * ldc + col0;
#pragma unroll
                for (int bj = 0; bj < 2; ++bj) { const f32x4 v0 = acc[ai][bj][m][0], v1 = acc[ai][bj][m][1];
                    u32x4 w; w.x = cvt_pk_bf16(v0[0], v0[1]); w.y = cvt_pk_bf16(v0[2], v0[3]); w.z = cvt_pk_bf16(v1[0], v1[1]); w.w = cvt_pk_bf16(v1[2], v1[3]);
                    *(u32x4*)(rowp + bj * HALF) = w; } }
    }
};
struct EpiSwiGLU {
    static constexpr bool PERM = true;
    bf16_t* O; int ldc;
    __device__ __forceinline__ void operator()(const f32x4 (&acc)[2][2][4][2], const Unit& u, int wr, int wc, int fr, int fq) const {
        const int row0 = u.pm * BM + wr * 64 + fr; const int col0 = u.pn * HALF + wc * 32 + 8 * fq;
#pragma unroll
        for (int ai = 0; ai < 2; ++ai)
#pragma unroll
            for (int m = 0; m < 4; ++m) { bf16_t* rowp = O + (size_t)(row0 + ai * HALF + m * 16) * ldc + col0;
                float h[8];
#pragma unroll
                for (int n = 0; n < 2; ++n)
#pragma unroll
                    for (int j = 0; j < 4; ++j) { const float gp = acc[ai][0][m][n][j], up = acc[ai][1][m][n][j];
                        h[n * 4 + j] = (gp * up) * __builtin_amdgcn_rcpf(__builtin_fmaf(__builtin_amdgcn_exp2f(gp), GATE_PRESCALE, GATE_PRESCALE)); }
                u32x4 w; w.x = cvt_pk_bf16(h[0], h[1]); w.y = cvt_pk_bf16(h[2], h[3]); w.z = cvt_pk_bf16(h[4], h[5]); w.w = cvt_pk_bf16(h[6], h[7]);
                *(u32x4*)rowp = w; }
    }
};
struct EpiSwiGLU8 {
    static constexpr bool PERM = true;
    unsigned char* O; int ldc;
    __device__ __forceinline__ void operator()(const f32x4 (&acc)[2][2][4][2], const Unit& u, int wr, int wc, int fr, int fq) const {
        const int row0 = u.pm * BM + wr * 64 + fr; const int col0 = u.pn * HALF + wc * 32 + 8 * fq;
#pragma unroll
        for (int ai = 0; ai < 2; ++ai)
#pragma unroll
            for (int m = 0; m < 4; ++m) { unsigned char* rowp = O + (size_t)(row0 + ai * HALF + m * 16) * ldc + col0;
                float h[8];
#pragma unroll
                for (int n = 0; n < 2; ++n)
#pragma unroll
                    for (int j = 0; j < 4; ++j) { const float gp = acc[ai][0][m][n][j], up = acc[ai][1][m][n][j];
                        constexpr float C8 = GATE_PRESCALE / (float)(1 << S8_HID); h[n * 4 + j] = (gp * up) * __builtin_amdgcn_rcpf((__builtin_amdgcn_exp2f(gp) + 1.0f) * C8); }
                u32x2 w; w.x = pk8(h[0], h[1], h[2], h[3]); w.y = pk8(h[4], h[5], h[6], h[7]);
                *(u32x2*)rowp = w; }
    }
};
struct EpiGate {
    static constexpr bool PERM = true;
    bf16_t* O; const float* mod; int gate_off;
    __device__ __forceinline__ void operator()(const f32x4 (&acc)[2][2][4][2], const Unit& u, int wr, int wc, int fr, int fq) const {
        const int rt = u.pm * BM; const int bi = rt >= NLAT ? 16 : (rt >> 11);
        const int col0 = u.pn * BM + wc * 32 + 8 * fq; const float* gt = mod + bi * MODW + gate_off + col0;
        f32x4 gv[2][2];
#pragma unroll
        for (int bj = 0; bj < 2; ++bj)
#pragma unroll
            for (int n = 0; n < 2; ++n) gv[bj][n] = *(const f32x4*)(gt + bj * HALF + 4 * n) + 1.0f;
        const int row0 = rt + wr * 64 + fr;
#pragma unroll
        for (int ai = 0; ai < 2; ++ai)
#pragma unroll
            for (int m = 0; m < 4; ++m) { bf16_t* rowp = O + (size_t)(row0 + ai * HALF + m * 16) * D + col0;
#pragma unroll
                for (int bj = 0; bj < 2; ++bj) { const f32x4 v0 = acc[ai][bj][m][0] * gv[bj][0], v1 = acc[ai][bj][m][1] * gv[bj][1];
                    u32x4 w; w.x = cvt_pk_bf16(v0[0], v0[1]); w.y = cvt_pk_bf16(v0[2], v0[3]); w.z = cvt_pk_bf16(v1[0], v1[1]); w.w = cvt_pk_bf16(v1[2], v1[3]);
                    *(u32x4*)(rowp + bj * HALF) = w; } }
    }
};

template <class Epi, class Sched, bool ALIGN_EPI, bool SP2, bool FP8 = false>
__device__ __forceinline__ void gemm_phase(LAS unsigned char* lds, const Gemm g, const Sched& S, const Epi& E, int tid_in, int sw = 0x7f7f7f7f, int sa = 0x7f7f7f7f) {
    int tid_ = tid_in; asm volatile("" : "+v"(tid_));
    const int tid = tid_, wid = __builtin_amdgcn_readfirstlane(tid >> 6), lane = tid & 63, wr = wid >> 2, wc = wid & 3, fr = lane & 15, fq = lane >> 4;
    const int K = g.K, nt = K / BK;
    constexpr bool GA = Sched::GATHER;
    unsigned voffA[2], voffB[2];
#pragma unroll
    for (int i = 0; i < 2; ++i) { int R, C; stage_rc(tid * 16 + i * 8192, R, C); const int Rb = Epi::PERM ? ((R & ~31) + perm32(R & 31)) : R;
        voffA[i] = (unsigned)(R * K + C) * 2u; voffB[i] = (unsigned)(Rb * K + C) * 2u; }
    const size_t kstep = (size_t)(BK * 2);
    const size_t hstep = (size_t)HALF * K * 2;
    const unsigned ldsw = (unsigned)wid * 1024u;
    const int aoff = lds_byte(wr * 64 + fr, fq * 8), boff = lds_byte(wc * 32 + fr, fq * 8);
#define PG8_SA(b, h) (((b) * 2 + (h)) * HTB)
#define PG8_SB(b, h) ((4 + (b) * 2 + (h)) * HTB)
#define PG8_STAGE(bufoff, gbase, voff) do { _Pragma("unroll") for (int _i = 0; _i < 2; ++_i) \
        __builtin_amdgcn_global_load_lds((const unsigned*)((const char*)(gbase) + (voff)[_i]), (LAS unsigned*)(lds + (bufoff) + ldsw + _i * 8192), 16, 0, 0); } while (0)
#define PG8_LDA(dst, b, h) do { _Pragma("unroll") for (int m = 0; m < 4; ++m) _Pragma("unroll") for (int k = 0; k < 2; ++k) dst[m][k] = *(const LAS bf16x8*)(lds + PG8_SA(b, h) + aoff + m * 2048 + k * 1024); } while (0)
#define PG8_LDB(dst, b, h) do { _Pragma("unroll") for (int n = 0; n < 2; ++n) _Pragma("unroll") for (int k = 0; k < 2; ++k) dst[n][k] = *(const LAS bf16x8*)(lds + PG8_SB(b, h) + boff + n * 2048 + k * 1024); } while (0)
#define PG8_CAT(x) __builtin_shufflevector(__builtin_bit_cast(i32x4, (x)[0]), __builtin_bit_cast(i32x4, (x)[1]), 0, 1, 2, 3, 4, 5, 6, 7)
#define PG8_MMA(ai, bj, At, Bt) do { __builtin_amdgcn_s_setprio(1); _Pragma("unroll") for (int m = 0; m < 4; ++m) _Pragma("unroll") for (int n = 0; n < 2; ++n) { \
        if constexpr (FP8) { const i32x8 a8_ = PG8_CAT(Bt[n]), b8_ = PG8_CAT(At[m]); \
            asm volatile("v_mfma_scale_f32_16x16x128_f8f6f4 %0, %1, %2, %0, %3, %4 op_sel_hi:[0,0,0]" : "+v"(acc[ai][bj][m][n]) : "v"(a8_), "v"(b8_), "v"(sw), "v"(sa)); } \
        else { _Pragma("unroll") for (int k = 0; k < 2; ++k) acc[ai][bj][m][n] = __builtin_amdgcn_mfma_f32_16x16x32_bf16(Bt[n][k], At[m][k], acc[ai][bj][m][n], 0, 0, 0); } } \
        __builtin_amdgcn_s_setprio(0); } while (0)
#define PG8_WAIT_V(n) asm volatile("s_waitcnt vmcnt(" #n ")" ::: "memory")
#define PG8_WAIT_L(n) asm volatile("s_waitcnt lgkmcnt(" #n ")" ::: "memory")
#define PG8_BAR __builtin_amdgcn_s_barrier()
#define PG8_SCHED __builtin_amdgcn_sched_barrier(0)
    Unit cur, nxt; int ui = 0;
    if (!S.next(0, cur)) return;
    f32x4 acc[2][2][4][2];
#pragma unroll
    for (int a = 0; a < 2; ++a)
#pragma unroll
        for (int b = 0; b < 2; ++b)
#pragma unroll
            for (int m = 0; m < 4; ++m)
#pragma unroll
                for (int n = 0; n < 2; ++n) acc[a][b][m][n] = (f32x4){0.f, 0.f, 0.f, 0.f};
    bf16x8 At[4][2], B0[2][2], B1[2][2];
    const char* Ab = (const char*)g.A + S.a_base(cur);
    unsigned oc[2][2];
    S.a_offs(0, cur, tid, oc);
    const size_t hsA = GA ? (size_t)0 : hstep;
#define PG8_STAGE_A(bufoff, gbase, h) do { if constexpr (GA) PG8_STAGE(bufoff, gbase, oc[h]); else PG8_STAGE(bufoff, (gbase) + (h) * hsA, voffA); } while (0)
    const char* cB = (const char*)g.Bt + cur.bofs;
    if constexpr (SP2) {
        PG8_STAGE(PG8_SB(0, 0), cB, voffB); PG8_STAGE(PG8_SB(0, 1), cB + hstep, voffB); PG8_STAGE_A(PG8_SA(0, 0), Ab, 0); PG8_STAGE_A(PG8_SA(0, 1), Ab, 1);
        if (wr == 1) PG8_BAR;
        PG8_WAIT_V(2); PG8_BAR;
        PG8_STAGE(PG8_SB(1, 0), cB + kstep, voffB); PG8_STAGE_A(PG8_SA(1, 0), Ab + kstep, 0); PG8_STAGE(PG8_SB(1, 1), cB + hstep + kstep, voffB);
        PG8_WAIT_V(6); PG8_BAR;
    } else {
        PG8_STAGE(PG8_SB(0, 0), cB, voffB); PG8_STAGE_A(PG8_SA(0, 0), Ab, 0); PG8_STAGE(PG8_SB(0, 1), cB + hstep, voffB); PG8_STAGE_A(PG8_SA(0, 1), Ab, 1);
        if (wr == 1) PG8_BAR;
        PG8_WAIT_V(4); PG8_BAR;
        PG8_STAGE(PG8_SB(1, 0), cB + kstep, voffB); PG8_STAGE_A(PG8_SA(1, 0), Ab + kstep, 0); PG8_STAGE(PG8_SB(1, 1), cB + hstep + kstep, voffB);
        PG8_WAIT_V(6); PG8_BAR;
    }
    for (;;) {
        const bool has_next = S.next(ui + 1, nxt);
        const char* nB = has_next ? (const char*)g.Bt + nxt.bofs : cB;
        for (int t = 0; t < nt; t += 2) {
            const bool last = (t == nt - 2);
            const char* a1 = Ab + (size_t)(t + 1) * kstep;
            const char* b2 = last ? nB : cB + (size_t)(t + 2) * kstep; const char* b3 = b2 + kstep;
            if constexpr (SP2) {
            PG8_LDB(B0, 0, 0); PG8_LDB(B1, 0, 1); PG8_SCHED; PG8_LDA(At, 0, 0); PG8_STAGE_A(PG8_SA(1, 1), a1, 1);
            if (last && has_next) { S.a_offs(ui + 1, nxt, tid, oc); Ab = (const char*)g.A + S.a_base(nxt); }
            const char* a2 = last ? Ab : Ab + (size_t)(t + 2) * kstep; const char* a3 = a2 + kstep;
            PG8_WAIT_V(8); PG8_WAIT_L(0); PG8_BAR; PG8_MMA(0, 0, At, B0); PG8_MMA(0, 1, At, B1); PG8_BAR; PG8_SCHED;
            PG8_LDA(At, 0, 1); PG8_STAGE(PG8_SB(0, 0), b2, voffB); PG8_STAGE(PG8_SB(0, 1), b2 + hstep, voffB); PG8_STAGE_A(PG8_SA(0, 0), a2, 0);
            PG8_WAIT_V(8); PG8_WAIT_L(0); PG8_BAR; PG8_MMA(1, 0, At, B0); PG8_MMA(1, 1, At, B1); PG8_BAR; PG8_SCHED;
            PG8_LDB(B0, 1, 0); PG8_LDB(B1, 1, 1); PG8_SCHED; PG8_LDA(At, 1, 0); PG8_STAGE_A(PG8_SA(0, 1), a2, 1);
            PG8_WAIT_V(8); PG8_WAIT_L(0); PG8_BAR; PG8_MMA(0, 0, At, B0); PG8_MMA(0, 1, At, B1); PG8_BAR; PG8_SCHED;
            PG8_LDA(At, 1, 1); PG8_STAGE(PG8_SB(1, 0), b3, voffB); PG8_STAGE(PG8_SB(1, 1), b3 + hstep, voffB); PG8_STAGE_A(PG8_SA(1, 0), a3, 0);
            PG8_WAIT_V(8); PG8_WAIT_L(0); PG8_BAR; PG8_MMA(1, 0, At, B0); PG8_MMA(1, 1, At, B1); PG8_BAR; PG8_SCHED;
            } else {
            PG8_LDB(B0, 0, 0); PG8_SCHED; PG8_LDA(At, 0, 0); PG8_STAGE_A(PG8_SA(1, 1), a1, 1);
            if (last && has_next) { S.a_offs(ui + 1, nxt, tid, oc); Ab = (const char*)g.A + S.a_base(nxt); }
            const char* a2 = last ? Ab : Ab + (size_t)(t + 2) * kstep; const char* a3 = a2 + kstep;
            PG8_WAIT_L(8); PG8_BAR; PG8_WAIT_L(0); PG8_MMA(0, 0, At, B0); PG8_BAR; PG8_SCHED;
            PG8_LDB(B1, 0, 1); PG8_STAGE(PG8_SB(0, 0), b2, voffB);
            PG8_BAR; PG8_WAIT_L(0); PG8_MMA(0, 1, At, B1); PG8_BAR;
            PG8_LDA(At, 0, 1); PG8_STAGE_A(PG8_SA(0, 0), a2, 0);
            PG8_BAR; PG8_WAIT_L(0); PG8_MMA(1, 0, At, B0); PG8_BAR; PG8_SCHED;
            PG8_STAGE(PG8_SB(0, 1), b2 + hstep, voffB);
            PG8_WAIT_V(6); PG8_BAR; PG8_MMA(1, 1, At, B1); PG8_BAR;
            PG8_LDB(B0, 1, 0); PG8_SCHED; PG8_LDA(At, 1, 0); PG8_STAGE_A(PG8_SA(0, 1), a2, 1);
            PG8_WAIT_L(8); PG8_BAR; PG8_WAIT_L(0); PG8_MMA(0, 0, At, B0); PG8_BAR; PG8_SCHED;
            PG8_LDB(B1, 1, 1); PG8_STAGE(PG8_SB(1, 0), b3, voffB);
            PG8_BAR; PG8_WAIT_L(0); PG8_MMA(0, 1, At, B1); PG8_BAR;
            PG8_LDA(At, 1, 1); PG8_STAGE_A(PG8_SA(1, 0), a3, 0);
            PG8_BAR; PG8_WAIT_L(0); PG8_MMA(1, 0, At, B0); PG8_BAR; PG8_SCHED;
            PG8_STAGE(PG8_SB(1, 1), b3 + hstep, voffB);
            PG8_WAIT_V(6); PG8_BAR; PG8_MMA(1, 1, At, B1); PG8_BAR;
            }
        }
        if constexpr (ALIGN_EPI) { if (wr == 0) PG8_BAR; }
        if constexpr (FP8) asm volatile("s_nop 15\n\ts_nop 15\n\ts_nop 15" ::: "memory");
        E(acc, cur, wr, wc, fr, fq);
        if (!has_next) break;
#pragma unroll
        for (int a = 0; a < 2; ++a)
#pragma unroll
            for (int b = 0; b < 2; ++b)
#pragma unroll
                for (int m = 0; m < 4; ++m)
#pragma unroll
                    for (int n = 0; n < 2; ++n) acc[a][b][m][n] = (f32x4){0.f, 0.f, 0.f, 0.f};
        cur = nxt; cB = nB; ++ui;
        if constexpr (ALIGN_EPI) { if (wr == 1) PG8_BAR; }
    }
    PG8_WAIT_V(0);
    if constexpr (!ALIGN_EPI) { if (wr == 0) PG8_BAR; }
    PG8_BAR;
#undef PG8_SA
#undef PG8_SB
#undef PG8_STAGE
#undef PG8_STAGE_A
#undef PG8_LDA
#undef PG8_LDB
#undef PG8_MMA
#undef PG8_CAT
#undef PG8_WAIT_V
#undef PG8_WAIT_L
#undef PG8_BAR
#undef PG8_SCHED
}
}

#define XB_TMO      128
#define XB_XCNT(j)  (256  + 64 * (j))
#define XB_XSUB(j)  (1280 + 64 * (j))
#define XB_XGEN(j)  (2304 + 64 * (j))
#define XB_TOP      3328
#define XB_TOPGEN   3392
#define XCD_BAR_WORDS 3456
#define XB_SPIN_CAP (1u << 18)
__device__ __forceinline__ unsigned xb_ld(unsigned* p)              { return __hip_atomic_load(p, __ATOMIC_RELAXED, __HIP_MEMORY_SCOPE_AGENT); }
__device__ __forceinline__ unsigned xb_add(unsigned* p, unsigned v) { return __hip_atomic_fetch_add(p, v, __ATOMIC_RELAXED, __HIP_MEMORY_SCOPE_AGENT); }
__device__ __forceinline__ unsigned xb_xcc_id() { return (unsigned)__builtin_amdgcn_s_getreg((3 << 11) | 20) & 0xFu; }
#define XB_SPIN(cond, bar) do { unsigned _sp = 0; while (cond) { __builtin_amdgcn_s_sleep(1); \
    if ((++_sp & 255u) == 0u) { if (xb_ld(&(bar)[XB_TMO])) break; if (_sp > XB_SPIN_CAP) { atomicAdd(&(bar)[XB_TMO], 1u); break; } } } } while (0)
struct XcdBarrier { unsigned* bar; unsigned x; volatile LAS unsigned* st; };
__device__ __forceinline__ XcdBarrier xcd_barrier_post(unsigned* bar, volatile LAS unsigned* st) {
    XcdBarrier b; b.bar = bar; b.x = xb_xcc_id(); b.st = st;
    if (threadIdx.x == 0) (void)xb_add(&bar[XB_XCNT(b.x)], 1u);
    return b;
}
__device__ __forceinline__ void xcd_barrier_complete(unsigned* bar, unsigned x, unsigned& nloc, unsigned& nx) {
    const unsigned G = gridDim.x * gridDim.y * gridDim.z;
    unsigned sum, cnt, mine, sp = 0u;
    for (;;) {
        sum = 0u; cnt = 0u; mine = 0u;
#pragma unroll
        for (unsigned j = 0; j < 16; ++j) { const unsigned c = xb_ld(&bar[XB_XCNT(j)]); sum += c; cnt += (c > 0u) ? 1u : 0u; }
        mine = xb_ld(&bar[XB_XCNT(x)]);
        if (sum == G) break;
        __builtin_amdgcn_s_sleep(1);
        if ((++sp & 255u) == 0u) { if (xb_ld(&bar[XB_TMO])) break; if (sp > XB_SPIN_CAP) { atomicAdd(&bar[XB_TMO], 1u); break; } }
    }
    nloc = mine > 0u ? mine : 1u; nx = cnt > 0u ? cnt : 1u;
}
__device__ __forceinline__ void xcd_barrier(const XcdBarrier& b, bool leader) {
    asm volatile("s_waitcnt vmcnt(0)" ::: "memory");
    __syncthreads();
    if (leader) {
        unsigned* bar = b.bar;
        __builtin_amdgcn_s_waitcnt(0);
        unsigned nloc = b.st[0], nx = b.st[1];
        if (nloc == 0u) { xcd_barrier_complete(bar, b.x, nloc, nx); b.st[0] = nloc; b.st[1] = nx; }
        const unsigned old = xb_add(&bar[XB_XSUB(b.x)], 1u);
        const unsigned gen = old / nloc;
        if (old + 1u == (gen + 1u) * nloc) {
            __builtin_amdgcn_fence(__ATOMIC_RELEASE, "agent");
            asm volatile("s_waitcnt vmcnt(0)" ::: "memory");
            const unsigned og = xb_add(&bar[XB_TOP], 1u);
            const unsigned tg = og / nx;
            if (og + 1u == (tg + 1u) * nx) xb_add(&bar[XB_TOPGEN], 1u);
            else XB_SPIN(xb_ld(&bar[XB_TOPGEN]) == tg, bar);
            __builtin_amdgcn_fence(__ATOMIC_ACQUIRE, "agent");
            xb_add(&bar[XB_XGEN(b.x)], 1u);
            asm volatile("s_waitcnt vmcnt(0)" ::: "memory");
        } else {
            XB_SPIN(xb_ld(&bar[XB_XGEN(b.x)]) == gen, bar);
            __builtin_amdgcn_fence(__ATOMIC_ACQUIRE, "agent");
            asm volatile("s_waitcnt vmcnt(0)" ::: "memory");
        }
    }
    __syncthreads();
}

constexpr int NT = 512, NWAVES = 8;
struct Args { const float* in[24]; float* out; unsigned char* ws; int ph_lo, ph_hi; };
enum { I_X = 0, I_C, I_CTX, I_CCTX, I_WMOD, I_BMOD, I_WIN, I_WOUT, I_RPB, I_CONVW, I_CONVB, I_DTB, I_ALOG, I_DSKIP, I_NORMW, I_LNG, I_LNB, I_FG, I_FU, I_FD, I_RW, I_MG, I_MU, I_MD };
struct Frame {
    LAS unsigned char* lds;
    const float* const* in; float* out; unsigned char* ws;
    int tid, lane, wave, bid, G, gw, NGW;
};
#define LDS_WAIT() asm volatile("s_waitcnt lgkmcnt(0)" ::: "memory")
__device__ __forceinline__ Frame fresh(const Frame& F0) {
    Frame F = F0; int z; asm volatile("s_mov_b32 %0, 0" : "=s"(z)); F.ws = F0.ws + z; F.in = F0.in + z; F.out = F0.out + z;
    int ln; asm volatile("v_mbcnt_lo_u32_b32 %0, -1, 0\n\tv_mbcnt_hi_u32_b32 %0, -1, %0" : "=v"(ln));     int t = F0.wave * 64 + ln;
    F.tid = t; F.lane = t & 63; return F;
}

__device__ __forceinline__ void conv_item(const float* W, int ldn, int k0, int n0, bf16_t* dst, int K, int drow0, float scale, LAS float* scr, int lane) {
    f32x4 ld[8];
#pragma unroll
    for (int i = 0; i < 8; ++i) ld[i] = *(const f32x4*)(W + (size_t)(k0 + 8 * i + (lane >> 3)) * ldn + n0 + 4 * (lane & 7));
#pragma unroll
    for (int i = 0; i < 8; ++i) { LAS float* d = scr + (8 * i + (lane >> 3)) * 33 + 4 * (lane & 7); d[0] = ld[i][0] * scale; d[1] = ld[i][1] * scale; d[2] = ld[i][2] * scale; d[3] = ld[i][3] * scale; }
    LDS_WAIT(); asm volatile("" ::: "memory");
    const int c = lane & 7;
#pragma unroll
    for (int j = 0; j < 4; ++j) { const int n = (lane >> 3) + 8 * j; const LAS float* s = scr + (8 * c) * 33 + n;
        u32x4 o; o.x = pk2(s[0 * 33], s[1 * 33]); o.y = pk2(s[2 * 33], s[3 * 33]); o.z = pk2(s[4 * 33], s[5 * 33]); o.w = pk2(s[6 * 33], s[7 * 33]);
        *(u32x4*)(dst + (size_t)(drow0 + n) * K + k0 + 8 * c) = o; }
    LDS_WAIT(); asm volatile("" ::: "memory");
}
__device__ __forceinline__ void conv_item8(const float* W, int ldn, int k0, int n0, unsigned char* dst, int K, int drow0, float scale, LAS float* scr, int lane) {
    f32x4 ld[8];
#pragma unroll
    for (int i = 0; i < 8; ++i) ld[i] = *(const f32x4*)(W + (size_t)(k0 + 8 * i + (lane >> 3)) * ldn + n0 + 4 * (lane & 7));
#pragma unroll
    for (int i = 0; i < 8; ++i) { LAS float* d = scr + (8 * i + (lane >> 3)) * 33 + 4 * (lane & 7); d[0] = ld[i][0] * scale; d[1] = ld[i][1] * scale; d[2] = ld[i][2] * scale; d[3] = ld[i][3] * scale; }
    LDS_WAIT(); asm volatile("" ::: "memory");
    const int c = lane & 7;
#pragma unroll
    for (int j = 0; j < 4; ++j) { const int n = (lane >> 3) + 8 * j; const LAS float* sp = scr + (8 * c) * 33 + n;
        u32x2 o; o.x = pk8(sp[0 * 33], sp[1 * 33], sp[2 * 33], sp[3 * 33]); o.y = pk8(sp[4 * 33], sp[5 * 33], sp[6 * 33], sp[7 * 33]);
        *(u32x2*)(dst + (size_t)(drow0 + n) * K + k0 + 8 * c) = o; }
    LDS_WAIT(); asm volatile("" ::: "memory");
}
__device__ __forceinline__ void conv_seg(const Frame& F, const float* W, int K, int ldn, int ncols, bf16_t* dst, int mode, int& rot, int s8 = -1) {
    LAS float* scr = (LAS float*)(F.lds + F.wave * 16384);
    const int nblk = ncols / 32, nitems = (K / 64) * nblk;
    int start = F.gw - rot; if (start < 0) start += F.NGW;
    for (int it = start; it < nitems; it += F.NGW) {
        const int kb = it / nblk, nb = it % nblk, n0 = nb * 32;
        const int drow0 = (mode == 0) ? n0 : ((n0 >> 7) * 256 + (n0 & 127) + (mode == 2 ? 128 : 0));
        const float gs = (mode == 1) ? GATE_PRESCALE : 1.0f;
        if (s8 >= 0) conv_item8(W, ldn, kb * 64, n0, (unsigned char*)dst, K, drow0, (float)(1 << s8) * gs, scr, F.lane);
        else conv_item(W, ldn, kb * 64, n0, dst, K, drow0, gs, scr, F.lane);
    }
    rot = (rot + nitems) % F.NGW;
}
__device__ __forceinline__ void conv_moe(const Frame& F, int slot, int& rot) {
#if USE_FP8
    unsigned char* gu = F.ws + WS_WMGU + (size_t)slot * NEXP * 2 * DFFE * D; unsigned char* dn = F.ws + WS_WMD + (size_t)slot * NEXP * D * DFFE;
    for (int e = 0; e < NEXP; ++e) {
        const size_t so = ((size_t)slot * NEXP + e) * (size_t)D * DFFE;
        conv_seg(F, F.in[I_MG] + so, D, DFFE, DFFE, (bf16_t*)(gu + (size_t)e * 2 * DFFE * D), 1, rot, S8_WGU);
        conv_seg(F, F.in[I_MU] + so, D, DFFE, DFFE, (bf16_t*)(gu + (size_t)e * 2 * DFFE * D), 2, rot, S8_WGU);
        conv_seg(F, F.in[I_MD] + so, DFFE, D, D, (bf16_t*)(dn + (size_t)e * D * DFFE), 0, rot, S8_WD);
    }
#else
    bf16_t* gu = (bf16_t*)(F.ws + WS_WMGU); bf16_t* dn = (bf16_t*)(F.ws + WS_WMD);
    for (int e = 0; e < NEXP; ++e) {
        const size_t so = ((size_t)slot * NEXP + e) * (size_t)D * DFFE;
        conv_seg(F, F.in[I_MG] + so, D, DFFE, DFFE, gu + (size_t)e * 2 * DFFE * D, 1, rot);
        conv_seg(F, F.in[I_MU] + so, D, DFFE, DFFE, gu + (size_t)e * 2 * DFFE * D, 2, rot);
        conv_seg(F, F.in[I_MD] + so, DFFE, D, D, dn + (size_t)e * D * DFFE, 0, rot);
    }
#endif
}

constexpr int MOE_ITEMS_MAT = 1792, MOE_ITEMS_EXP = 3 * MOE_ITEMS_MAT, MOE_ITEMS_SLOT = 8 * MOE_ITEMS_EXP, MOE_ITEMS = 2 * MOE_ITEMS_SLOT;
__device__ __forceinline__ void conv_moe_item(const Frame& F, int gidx) {
    LAS float* scr = (LAS float*)(F.lds + F.wave * 16384);
    const int slot = gidx / MOE_ITEMS_SLOT, r = gidx % MOE_ITEMS_SLOT, e = r / MOE_ITEMS_EXP, r2 = r % MOE_ITEMS_EXP, mat = r2 / MOE_ITEMS_MAT, it = r2 % MOE_ITEMS_MAT;
    const size_t so = ((size_t)slot * NEXP + e) * (size_t)D * DFFE;
    if (mat < 2) { const int kb = it / 112, nb = it % 112, n0 = nb * 32; const int drow0 = (n0 >> 7) * 256 + (n0 & 127) + (mat == 1 ? 128 : 0);
        conv_item8((mat ? F.in[I_MU] : F.in[I_MG]) + so, DFFE, kb * 64, n0, F.ws + WS_WMGU + ((size_t)slot * NEXP + e) * 2 * DFFE * D, D, drow0, (float)(1 << S8_WGU) * (mat ? 1.0f : GATE_PRESCALE), scr, F.lane); }
    else { const int kb = it / 32, nb = it % 32, n0 = nb * 32;
        conv_item8(F.in[I_MD] + so, D, kb * 64, n0, F.ws + WS_WMD + ((size_t)slot * NEXP + e) * D * DFFE, DFFE, n0, (float)(1 << S8_WD), scr, F.lane); }
}
__device__ __forceinline__ void deferred_conv(const Frame& F, int nwg, int base, int quota) {
    if (F.G != 256) return;
    const int maxu = (nwg + F.G - 1) / F.G, c0 = nwg - (maxu - 1) * F.G;
    if (c0 >= F.G || F.bid < c0) return;
    const int first = base + ((F.bid - c0) * NWAVES + F.wave) * quota;
    for (int j = 0; j < quota; ++j) { const int gidx = first + j; if (gidx < MOE_ITEMS) conv_moe_item(F, gidx); }
}
constexpr int DW_Q = 12, DW_Q2 = 10;
constexpr int DW_L0_IN = 0, DW_L0_OUT = DW_L0_IN + 64 * 8 * DW_Q, DW_L0_F1 = DW_L0_OUT + 192 * 8 * DW_Q, DW_L0_F2 = DW_L0_F1 + 160 * 8 * DW_Q, DW_L1_IN = DW_L0_F2 + 192 * 8 * DW_Q2, DW_L1_OUT = DW_L1_IN + 64 * 8 * DW_Q, DW_L2_IN = DW_L1_OUT + 192 * 8 * DW_Q, DW_END = DW_L2_IN + 64 * 8 * DW_Q;
static_assert(DW_L1_IN >= MOE_ITEMS_SLOT && DW_END >= MOE_ITEMS, "deferred conversion: layer-1 experts must be done before layer 1's FFN, all before layer 3's");
__device__ __forceinline__ void p_pro_a(const Frame& F) {
    {
        LAS float* sc = (LAS float*)F.lds; LAS float* red = sc + 17 * 1024;
        const float* c = F.in[I_C]; const float* cc = F.in[I_CCTX];
        for (int i = F.tid; i < 17 * 1024; i += NT) { const int r = i >> 10, k = i & 1023; const float v = (r < 16) ? c[r * 1024 + k] : cc[k]; sc[i] = silu_f(v); }
        __syncthreads();
        float* MOD = (float*)(F.ws + WS_MOD);
        const int col = F.tid & 31, ks = F.tid >> 5;
        for (int u = F.bid; u < 4 * 192; u += F.G) {
            const int l = u / 192, cb = u % 192;
            const float* W = F.in[I_WMOD] + (size_t)l * D * MODW + cb * 32 + col;
            float acc[17];
#pragma unroll
            for (int r = 0; r < 17; ++r) acc[r] = 0.f;
#pragma unroll 1
            for (int kb = 0; kb < 4; ++kb) { float w[16];
#pragma unroll
                for (int i = 0; i < 16; ++i) w[i] = W[(size_t)(ks * 64 + kb * 16 + i) * MODW];
#pragma unroll
                for (int i = 0; i < 16; ++i) { const int k = ks * 64 + kb * 16 + i;
#pragma unroll
                    for (int r = 0; r < 17; ++r) acc[r] += sc[r * 1024 + k] * w[i]; } }
#pragma unroll
            for (int r = 0; r < 17; ++r) red[(ks * 17 + r) * 32 + col] = acc[r];
            __syncthreads();
            for (int i = F.tid; i < 17 * 32; i += NT) { const int r = i >> 5, c2 = i & 31; float sm = 0.f;
#pragma unroll
                for (int k2 = 0; k2 < 16; ++k2) sm += red[(k2 * 17 + r) * 32 + c2];
                MOD[(size_t)(l * 17 + r) * MODW + cb * 32 + c2] = sm + F.in[I_BMOD][l * MODW + cb * 32 + c2]; }
            __syncthreads();
        }
    }
    int rot = 0;
    for (int l = 0; l < DEPTH; ++l) {
#if USE_FP8 && FP8_INPROJ
        conv_seg(F, F.in[I_WIN] + (size_t)l * D * D_IN_PROJ, D, D_IN_PROJ, NPROJ, (bf16_t*)(F.ws + WS_WIN + (size_t)l * NPROJ * D), 0, rot, S8_WGU);
#else
        conv_seg(F, F.in[I_WIN] + (size_t)l * D * D_IN_PROJ, D, D_IN_PROJ, NPROJ, (bf16_t*)(F.ws + WS_WIN) + (size_t)l * NPROJ * D, 0, rot);
#endif
        conv_seg(F, F.in[I_WOUT] + (size_t)l * D * D, D, D, D, (bf16_t*)(F.ws + WS_WOUT) + (size_t)l * D * D, 0, rot);
    }
    for (int s = 0; s < 2; ++s) {
#if USE_FP8 && FP8_DENSE1
        conv_seg(F, F.in[I_FG] + (size_t)s * D * DFF, D, DFF, DFF, (bf16_t*)(F.ws + WS_WFGU + (size_t)s * 2 * DFF * D), 1, rot, S8_WGU);
        conv_seg(F, F.in[I_FU] + (size_t)s * D * DFF, D, DFF, DFF, (bf16_t*)(F.ws + WS_WFGU + (size_t)s * 2 * DFF * D), 2, rot, S8_WGU);
#else
        conv_seg(F, F.in[I_FG] + (size_t)s * D * DFF, D, DFF, DFF, (bf16_t*)(F.ws + WS_WFGU) + (size_t)s * 2 * DFF * D, 1, rot);
        conv_seg(F, F.in[I_FU] + (size_t)s * D * DFF, D, DFF, DFF, (bf16_t*)(F.ws + WS_WFGU) + (size_t)s * 2 * DFF * D, 2, rot);
#endif
#if USE_FP8 && FP8_DENSE2
        conv_seg(F, F.in[I_FD] + (size_t)s * DFF * D, DFF, D, D, (bf16_t*)(F.ws + WS_WFD + (size_t)s * D * DFF), 0, rot, S8_WD);
#else
        conv_seg(F, F.in[I_FD] + (size_t)s * DFF * D, DFF, D, D, (bf16_t*)(F.ws + WS_WFD) + (size_t)s * D * DFF, 0, rot);
#endif
    }
    if (F.G != 256) { conv_moe(F, 0, rot); conv_moe(F, 1, rot); }
    { bf16_t* wdt = (bf16_t*)(F.ws + WS_WDT);
      for (int i = F.bid * NT + F.tid; i < DEPTH * 16 * D; i += F.G * NT) { const int l = i / (16 * D), n = (i / D) & 15, k = i % D;
          wdt[i] = (bf16_t)f2bf(F.in[I_WIN][((size_t)l * D + k) * D_IN_PROJ + NPROJ + n]); } }
}

#define RIDX(q) (8 * lane + 512 * ((q) >> 1) + 4 * ((q) & 1))
__device__ __forceinline__ void row_load(const float* p, int lane, f32x4 (&v)[4]) {
#pragma unroll
    for (int q = 0; q < 4; ++q) v[q] = *(const f32x4*)(p + RIDX(q));
}
__device__ __forceinline__ void row_store(float* p, int lane, const f32x4 (&v)[4]) {
#pragma unroll
    for (int q = 0; q < 4; ++q) *(f32x4*)(p + RIDX(q)) = v[q];
}
__device__ __forceinline__ void row_mod_store8(unsigned char* hrow, int lane, const f32x4 (&v)[4], const float* sh, const float* sc, f32x4 (&hv)[4]) {
#pragma unroll
    for (int j = 0; j < 2; ++j) { u32x2 w;
#pragma unroll
        for (int h = 0; h < 2; ++h) { const int q = 2 * j + h; const f32x4 a = *(const f32x4*)(sc + RIDX(q)), b = *(const f32x4*)(sh + RIDX(q));
            hv[q] = v[q] * (a + 1.0f) + b; const f32x4 t = hv[q] * (float)(1 << S8_ACT); const unsigned pw = pk8(t[0], t[1], t[2], t[3]); if (h == 0) w.x = pw; else w.y = pw; }
        *(u32x2*)(hrow + 8 * lane + 512 * j) = w; }
}
__device__ __forceinline__ void row_load_h(const bf16_t* p, int lane, f32x4 (&v)[4]) {
#pragma unroll
    for (int j = 0; j < 2; ++j) { const u32x4 w = *(const u32x4*)(p + 8 * lane + 512 * j); v[2 * j] = (f32x4){bflo(w.x), bfhi(w.x), bflo(w.y), bfhi(w.y)}; v[2 * j + 1] = (f32x4){bflo(w.z), bfhi(w.z), bflo(w.w), bfhi(w.w)}; }
}
__device__ __forceinline__ void row_store_h(bf16_t* p, int lane, const f32x4 (&v)[4]) {
#pragma unroll
    for (int j = 0; j < 2; ++j) { u32x4 w; w.x = pk2(v[2 * j][0], v[2 * j][1]); w.y = pk2(v[2 * j][2], v[2 * j][3]); w.z = pk2(v[2 * j + 1][0], v[2 * j + 1][1]); w.w = pk2(v[2 * j + 1][2], v[2 * j + 1][3]);
        *(u32x4*)(p + 8 * lane + 512 * j) = w; }
}
__device__ __forceinline__ void row_mod_store(bf16_t* hrow, int lane, const f32x4 (&v)[4], const float* sh, const float* sc, f32x4 (&hv)[4]) {
#pragma unroll
    for (int q = 0; q < 4; ++q) { const f32x4 a = *(const f32x4*)(sc + RIDX(q)), b = *(const f32x4*)(sh + RIDX(q)); hv[q] = v[q] * (a + 1.0f) + b; }
    row_store_h(hrow, lane, hv);
}
__device__ __forceinline__ void row_ln(f32x4 (&v)[4], const float* g, const float* b, int lane) {
    float s = 0.f;
#pragma unroll
    for (int j = 0; j < 4; ++j) s += (v[j][0] + v[j][1]) + (v[j][2] + v[j][3]);
    const float mean = wave_sum(s) * (1.0f / D); float q2 = 0.f;
#pragma unroll
    for (int j = 0; j < 4; ++j) { v[j] = v[j] - mean; q2 += (v[j][0] * v[j][0] + v[j][1] * v[j][1]) + (v[j][2] * v[j][2] + v[j][3] * v[j][3]); }
    const float rstd = 1.0f / sqrtf(wave_sum(q2) * (1.0f / D) + LN_EPS);
#pragma unroll
    for (int q = 0; q < 4; ++q) { const f32x4 gg = *(const f32x4*)(g + RIDX(q)), bb = *(const f32x4*)(b + RIDX(q)); v[q] = v[q] * rstd * gg + bb; }
}
__device__ __forceinline__ int mod_row_of(int row) { return row < NLAT ? (row >> 11) : 16; }
__device__ __forceinline__ void col_load(const float* p, int lane, f32x4 (&c)[4], float add = 0.f) {
#pragma unroll
    for (int q = 0; q < 4; ++q) c[q] = *(const f32x4*)(p + RIDX(q)) + add;
}
__device__ __forceinline__ void row_ln_r(f32x4 (&v)[4], const f32x4 (&G)[4], const f32x4 (&B)[4]) {
    float s = 0.f;
#pragma unroll
    for (int j = 0; j < 4; ++j) s += (v[j][0] + v[j][1]) + (v[j][2] + v[j][3]);
    const float mean = wave_sum(s) * (1.0f / D); float q2 = 0.f;
#pragma unroll
    for (int j = 0; j < 4; ++j) { v[j] = v[j] - mean; q2 += (v[j][0] * v[j][0] + v[j][1] * v[j][1]) + (v[j][2] * v[j][2] + v[j][3] * v[j][3]); }
    const float rstd = 1.0f / sqrtf(wave_sum(q2) * (1.0f / D) + LN_EPS);
#pragma unroll
    for (int q = 0; q < 4; ++q) v[q] = v[q] * rstd * G[q] + B[q];
}
struct RowRaw { u32x4 x[2], d[2]; };
template <bool WITH_D> __device__ __forceinline__ void row_issue(const bf16_t* X, const bf16_t* Dl, int row, int lane, RowRaw& r) {
#pragma unroll
    for (int j = 0; j < 2; ++j) { r.x[j] = *(const u32x4*)(X + (size_t)row * D + 8 * lane + 512 * j); if (WITH_D) r.d[j] = *(const u32x4*)(Dl + (size_t)row * D + 8 * lane + 512 * j); }
}
__device__ __forceinline__ void unpack8(const u32x4 w, f32x4& lo, f32x4& hi) { lo = (f32x4){bflo(w.x), bfhi(w.x), bflo(w.y), bfhi(w.y)}; hi = (f32x4){bflo(w.z), bfhi(w.z), bflo(w.w), bfhi(w.w)}; }
__device__ __forceinline__ void row_combine(const RowRaw& r, f32x4 (&v)[4]) {
#pragma unroll
    for (int j = 0; j < 2; ++j) { f32x4 x0, x1, d0, d1; unpack8(r.x[j], x0, x1); unpack8(r.d[j], d0, d1); v[2 * j] = x0 * ALPHA + d0; v[2 * j + 1] = x1 * ALPHA + d1; }
}

__device__ __forceinline__ void p_pro_b(const Frame& F) {
    const float* MOD = (const float*)(F.ws + WS_MOD); bf16_t* H = (bf16_t*)(F.ws + WS_H); bf16_t* X = (bf16_t*)(F.ws + WS_X);
    for (int row = F.gw; row < NTOK; row += F.NGW) {
        const float* src = row < NLAT ? F.in[I_X] + (size_t)row * D : F.in[I_CTX] + (size_t)(row - NLAT) * D;
        f32x4 v[4], hv[4]; row_load(src, F.lane, v);
        row_store_h(X + (size_t)row * D, F.lane, v);
        const float* m = MOD + (size_t)mod_row_of(row) * MODW;
        row_mod_store(H + (size_t)row * D, F.lane, v, m, m + D, hv);
    }
}

__device__ __forceinline__ void p_inproj(const Frame& F, int layer) {
    const bf16_t* H = (const bf16_t*)(F.ws + WS_H);
    {
        const bf16_t* wdt = (const bf16_t*)(F.ws + WS_WDT) + (size_t)layer * 16 * D; float* DT = (float*)(F.ws + WS_DT);
        const int fr = F.lane & 15, fq = F.lane >> 4; const float dtb = F.in[I_DTB][layer * 16 + fr];
        for (int g = F.gw; g < NTOK / 16; g += F.NGW) {
            f32x4 acc = {0.f, 0.f, 0.f, 0.f};
            const bf16_t* ap = H + (size_t)(g * 16 + fr) * D + fq * 8; const bf16_t* bp = wdt + (size_t)fr * D + fq * 8;
#pragma unroll 8
            for (int ks = 0; ks < 32; ++ks) { const bf16x8 a = *(const bf16x8*)(ap + ks * 32), b = *(const bf16x8*)(bp + ks * 32);
                acc = __builtin_amdgcn_mfma_f32_16x16x32_bf16(a, b, acc, 0, 0, 0); }
#pragma unroll
            for (int r = 0; r < 4; ++r) { const float x = acc[r] + dtb; DT[(size_t)(g * 16 + fq * 4 + r) * 16 + fr] = fmaxf(x, 0.f) + __logf(1.0f + __expf(-fabsf(x))); }
        }
    }
    pg8::EpiBf16 E{(bf16_t*)(F.ws + WS_PROJ), NPROJ};
#if USE_FP8 && FP8_INPROJ
    pg8::Gemm g{(const bf16_t*)(F.ws + WS_H8IN), (const bf16_t*)(F.ws + WS_WIN + (size_t)layer * NPROJ * D), D / 2};
    pg8::DenseOrder S; S.init(NTOK, NPROJ, D / 2, F.G, F.bid, REP_GEMM);
    pg8::gemm_phase<pg8::EpiBf16, pg8::DenseOrder, true, FP8_SP2, true>(F.lds, g, S, E, F.tid, (127 - S8_WGU) * 0x01010101, (127 - S8_ACT) * 0x01010101);
#else
    pg8::Gemm g{H, (const bf16_t*)(F.ws + WS_WIN) + (size_t)layer * NPROJ * D, D};
    pg8::DenseOrder S; S.init(NTOK, NPROJ, D, F.G, F.bid, REP_GEMM);
    pg8::gemm_phase<pg8::EpiBf16, pg8::DenseOrder, true, true>(F.lds, g, S, E, F.tid);
#endif
    if (layer == 0) deferred_conv(F, (NTOK / 256) * (NPROJ / 256), DW_L0_IN, DW_Q); else if (layer < 3) deferred_conv(F, (NTOK / 256) * (NPROJ / 256), layer == 1 ? DW_L1_IN : DW_L2_IN, DW_Q);
}

typedef short s16x4 __attribute__((ext_vector_type(4)));
__device__ __forceinline__ s16x4 lds_tr16(LAS const unsigned char* p) { return __builtin_bit_cast(s16x4, __builtin_amdgcn_ds_read_tr16_b64_v4i16((LAS s16x4*)p)); }
constexpr int NA_KS = 144;
constexpr float LOG2E = 1.4426950408889634f;
__device__ __forceinline__ void na_unit(const Frame& F, int layer, int b, int h, int mode, int m) {
    LAS unsigned char* KV = F.lds;
    LAS float* rp = (LAS float*)(F.lds + 120832);
    const bf16_t* PROJ = (const bf16_t*)(F.ws + WS_PROJ); bf16_t* MIX = (bf16_t*)(F.ws + WS_MIX);
    const int tid = F.tid, lane = F.lane, w = F.wave, q16 = lane & 15, g = lane >> 4;
    int rbase = 0, nk = 0;
    if (mode == 0) { rbase = 2 * m - 4; rbase = rbase < 0 ? 0 : (rbase > 24 ? 24 : rbase); nk = 32 - rbase; nk = nk > 9 ? 9 : nk; }
    const int kfirst = (mode == 0) ? 0 : 576 * 8, nloc8 = nk * 64 * 8;
#define NA_STAGE(OFFS) do { int stid_ = tid; asm volatile("" : "+v"(stid_));     \
        NA_STAGE_PART(OFFS, 0, 7); __builtin_amdgcn_sched_barrier(0); NA_STAGE_PART(OFFS, 7, 13); __builtin_amdgcn_sched_barrier(0); } while (0)
#define NA_STAGE_PART(OFFS, K0, K1) do { u32x4 st_[13]; \
        _Pragma("unroll") for (int k_ = K0; k_ < K1; ++k_) { const int i_ = stid_ + kfirst + k_ * NT, key_ = i_ >> 3, ch_ = i_ & 7; const bool ok_ = (i_ < 832 * 8) && !(key_ < 576 && i_ >= nloc8); \
            const int grow_ = key_ < 576 ? b * SEQ + rbase * 64 + key_ : NLAT + b * CTX + (key_ - 576); \
            st_[k_] = ok_ ? *(const u32x4*)(PROJ + (size_t)grow_ * NPROJ + (OFFS) + h * 64 + ch_ * 8) : (u32x4){0u, 0u, 0u, 0u}; } \
        _Pragma("unroll") for (int k_ = K0; k_ < K1; ++k_) { const int i_ = stid_ + kfirst + k_ * NT, key_ = i_ >> 3, ch_ = i_ & 7; const bool ok_ = (i_ < 832 * 8) && !(key_ < 576 && i_ >= nloc8); \
            if (ok_) *(LAS u32x4*)(KV + key_ * NA_KS + ch_ * 16) = st_[k_]; } } while (0)
    __syncthreads();
    NA_STAGE(OFF_K);
    if (mode == 0 && tid < 465) rp[tid] = F.in[I_RPB][(size_t)(layer * 8 + h) * 465 + tid] * LOG2E;
    __syncthreads();
    int i = 0, j0 = 0, hs = 0, kr0 = 0, qrow;
    if (mode == 0) { i = 2 * m + (w >> 2); j0 = (w & 3) * 16; qrow = b * SEQ + i * 64 + j0; hs = j0 - 8; hs = hs < 0 ? 0 : (hs > 32 ? 32 : hs);
        int r0 = i - 4; r0 = r0 < 0 ? 0 : (r0 > 24 ? 24 : r0); kr0 = r0 - rbase; }
    else qrow = NLAT + b * CTX + m * 128 + w * 16;
    bf16x8 qf[2];
#pragma unroll
    for (int ks = 0; ks < 2; ++ks) qf[ks] = *(const bf16x8*)(PROJ + (size_t)(qrow + q16) * NPROJ + h * 64 + ks * 32 + g * 8);
    f32x4 S[32];
    const LAS unsigned char* kb = KV + q16 * NA_KS + g * 16;
    if (mode == 0) {
        const int j = j0 + q16; int cs = j - 8; cs = cs < 0 ? 0 : (cs > 48 ? 48 : cs);
        const int rb0 = (kr0 + rbase) - i + 7;
#pragma unroll
        for (int tl = 0; tl < 16; ++tl) { const int kr = tl >> 1, half = tl & 1; const int kidx0 = (kr0 + kr) * 64 + hs + 16 * half;
            f32x4 a = {0.f, 0.f, 0.f, 0.f};
#pragma unroll
            for (int ks = 0; ks < 2; ++ks) { const bf16x8 kf = *(const LAS bf16x8*)(kb + kidx0 * NA_KS + ks * 64); a = __builtin_amdgcn_mfma_f32_16x16x32_bf16(kf, qf[ks], a, 0, 0, 0); }
#pragma unroll
            for (int r = 0; r < 4; ++r) { const int kc = hs + 16 * half + 4 * g + r; const bool inw = (kc >= cs) && (kc < cs + 16);
                int cbi = kc - j + 15; cbi = cbi < 0 ? 0 : (cbi > 30 ? 30 : cbi);
                a[r] = inw ? a[r] * (0.125f * LOG2E) + rp[(rb0 + kr) * 31 + cbi] : -INFINITY; }
            S[tl] = a; if ((tl & 1) == 1) __builtin_amdgcn_sched_barrier(0); }
    } else {
#pragma unroll
        for (int tl = 0; tl < 16; ++tl) S[tl] = (f32x4){-INFINITY, -INFINITY, -INFINITY, -INFINITY};
    }
#pragma unroll
    for (int tc = 0; tc < 16; ++tc) { const int kidx0 = 576 + 16 * tc; f32x4 a = {0.f, 0.f, 0.f, 0.f};
#pragma unroll
        for (int ks = 0; ks < 2; ++ks) { const bf16x8 kf = *(const LAS bf16x8*)(kb + kidx0 * NA_KS + ks * 64); a = __builtin_amdgcn_mfma_f32_16x16x32_bf16(kf, qf[ks], a, 0, 0, 0); }
        S[16 + tc] = a * (0.125f * LOG2E); if ((tc & 1) == 1) __builtin_amdgcn_sched_barrier(0); }
    float mx = -INFINITY;
#pragma unroll
    for (int t = 0; t < 32; ++t) mx = fmaxf(fmaxf(fmaxf(S[t][0], S[t][1]), fmaxf(S[t][2], S[t][3])), mx);
    mx = fmaxf(mx, __shfl_xor(mx, 16)); mx = fmaxf(mx, __shfl_xor(mx, 32));
    float sum = 0.f; u32x4 P[16];
#pragma unroll
    for (int kk = 0; kk < 16; ++kk) { float e[8];
#pragma unroll
        for (int r = 0; r < 4; ++r) { e[r] = __builtin_amdgcn_exp2f(S[2 * kk][r] - mx); e[4 + r] = __builtin_amdgcn_exp2f(S[2 * kk + 1][r] - mx); }
        sum += ((e[0] + e[1]) + (e[2] + e[3])) + ((e[4] + e[5]) + (e[6] + e[7]));
        P[kk].x = pg8::cvt_pk_bf16_pin(e[0], e[1]); P[kk].y = pg8::cvt_pk_bf16_pin(e[2], e[3]); P[kk].z = pg8::cvt_pk_bf16_pin(e[4], e[5]); P[kk].w = pg8::cvt_pk_bf16_pin(e[6], e[7]); }
    sum += __shfl_xor(sum, 16); sum += __shfl_xor(sum, 32);
    const float inv = 1.0f / sum;
    __syncthreads();
    NA_STAGE(OFF_V);
    __syncthreads();
    f32x4 o[4];
#pragma unroll
    for (int dt = 0; dt < 4; ++dt) o[dt] = (f32x4){0.f, 0.f, 0.f, 0.f};
    const LAS unsigned char* vb = KV + (4 * g + (q16 >> 2)) * NA_KS + (q16 & 3) * 8;
#pragma unroll
    for (int kk = 0; kk < 16; ++kk) {
        if (kk < 8 && mode != 0) continue;
        const int kidx0 = (kk < 8) ? (kr0 + kk) * 64 + hs : 576 + 32 * (kk - 8);
        const bf16x8 pa = __builtin_bit_cast(bf16x8, P[kk]);
#pragma unroll
        for (int dt = 0; dt < 4; ++dt) { const s16x4 lo = lds_tr16(vb + kidx0 * NA_KS + dt * 32), hi = lds_tr16(vb + (kidx0 + 16) * NA_KS + dt * 32);
            const bf16x8 vf = {lo[0], lo[1], lo[2], lo[3], hi[0], hi[1], hi[2], hi[3]};
            o[dt] = __builtin_amdgcn_mfma_f32_16x16x32_bf16(pa, vf, o[dt], 0, 0, 0); }
    }
#undef NA_STAGE
#undef NA_STAGE_PART
#pragma unroll
    for (int r = 0; r < 4; ++r) { const float ir = __shfl(inv, 4 * g + r);
        bf16_t* op = MIX + (size_t)(qrow + 4 * g + r) * D + h * 64 + q16;
#pragma unroll
        for (int dt = 0; dt < 4; dt += 2) { const unsigned pw = pk2(o[dt][r] * ir, o[dt + 1][r] * ir); op[dt * 16] = (bf16_t)(pw & 0xffffu); op[dt * 16 + 16] = (bf16_t)(pw >> 16); } }
}

struct PrepassW { f32x4 w[5][2]; f32x4 b[2]; float ifq[8]; };
__device__ __forceinline__ void ssd_prepass_unit(const Frame& F, int u, const PrepassW& W) {
    const bf16_t* PROJ = (const bf16_t*)(F.ws + WS_PROJ); bf16_t* U = (bf16_t*)(F.ws + WS_U);
    int rowbase, t0, L; bool lat;
    if (u < NLAT / 16) { rowbase = (u >> 7) * SEQ; t0 = (u & 127) * 16; L = SEQ; lat = true; }
    else { const int v = u - NLAT / 16; rowbase = NLAT + (v >> 4) * CTX; t0 = (v & 15) * 16; L = CTX; lat = false; }
    const int cg = F.tid & 127, tq = F.tid >> 7, c0 = 8 * cg, tb = t0 + 4 * tq;
    u32x4 win[8];
#pragma unroll
    for (int j = 0; j < 8; ++j) { const int t = tb - 2 + j; win[j] = (t >= 0 && t < L) ? *(const u32x4*)(PROJ + (size_t)(rowbase + t) * NPROJ + OFF_XBC + c0) : (u32x4){0u, 0u, 0u, 0u}; }
    const int lc = c0 & 127, hf = lc >> 6, role = (lc >> 5) & 1; const bool rope = lat && (c0 >= 512);
#pragma unroll
    for (int tt = 0; tt < 4; ++tt) {
        f32x4 a0 = W.b[0], a1 = W.b[1];
#pragma unroll
        for (int j = 0; j < 5; ++j) { const u32x4 r = win[tt + j];
            a0 += W.w[j][0] * (f32x4){bflo(r.x), bfhi(r.x), bflo(r.y), bfhi(r.y)}; a1 += W.w[j][1] * (f32x4){bflo(r.z), bfhi(r.z), bflo(r.w), bfhi(r.w)}; }
        float uu[8];
#pragma unroll
        for (int k = 0; k < 4; ++k) { uu[k] = silu_f(a0[k]); uu[4 + k] = silu_f(a1[k]); }
        if (rope) {
            const int tk = tb + tt; const float pos = (float)(hf ? (tk & 63) : (tk >> 6));
#pragma unroll
            for (int k = 0; k < 8; ++k) { const float o = __shfl_xor(uu[k], 4); const float sn = __builtin_amdgcn_sinf(pos * W.ifq[k]), cs = __builtin_amdgcn_cosf(pos * W.ifq[k]);
                uu[k] = role ? (o * sn + uu[k] * cs) : (uu[k] * cs - o * sn); }
        }
        u32x4 o; o.x = pk2(uu[0], uu[1]); o.y = pk2(uu[2], uu[3]); o.z = pk2(uu[4], uu[5]); o.w = pk2(uu[6], uu[7]);
        *(u32x4*)(U + (size_t)(rowbase + tb + tt) * 1024 + c0) = o;
    }
}
__device__ __forceinline__ void ssd_prepass_weights(const Frame& F, int layer, PrepassW& W) {
    const int c0 = 8 * (F.tid & 127);
    const float* cwp = F.in[I_CONVW] + (size_t)layer * 5 * 1024 + c0;
#pragma unroll
    for (int j = 0; j < 5; ++j) { W.w[j][0] = *(const f32x4*)(cwp + j * 1024); W.w[j][1] = *(const f32x4*)(cwp + j * 1024 + 4); }
    W.b[0] = *(const f32x4*)(F.in[I_CONVB] + (size_t)layer * 1024 + c0); W.b[1] = *(const f32x4*)(F.in[I_CONVB] + (size_t)layer * 1024 + c0 + 4);
    const int n0 = c0 & 31;
#pragma unroll
    for (int k = 0; k < 8; ++k) W.ifq[k] = __builtin_amdgcn_exp2f(-(float)(n0 + k) * (13.287712379549449f / 32.0f)) * 0.15915494309189535f;
}

constexpr int S_CQ = 0, S_BQ = 17408, S_XN = 34816, S_XW = 44032, S_OPS = 53248, S_HB = 2 * S_OPS, S_MISC = S_HB + 2 * 17408, S_END = S_MISC + 3 * 1088;
static_assert(S_END <= LDS_ROWOFF + 18432, "SSD LDS image must stay below the control words");
__device__ __forceinline__ void ssd_chunk_compute(const LAS unsigned char* O, const LAS float* misc, const LAS unsigned char* HB, LAS unsigned char* HN, f32x4 (&Hacc)[4],
                                                  bf16_t* yp, int w, int q16, int gq, bool skip, float dsk) {
    const int lt = w >> 1, t2 = (w & 1) * 2;
    bf16x8 cfr[4];
#pragma unroll
    for (int ks = 0; ks < 4; ++ks) cfr[ks] = *(const LAS bf16x8*)(O + S_CQ + (16 * lt + q16) * 272 + ks * 64 + gq * 16);
    u32x4 pm[2];
    {
        const float csl = misc[64 + 16 * lt + q16];
#pragma unroll
        for (int pr = 0; pr < 2; ++pr) {
            f32x4 v[2];
#pragma unroll
            for (int hh = 0; hh < 2; ++hh) { const int st = 2 * pr + hh; f32x4 a = {0.f, 0.f, 0.f, 0.f};
                if (st <= lt) {
#pragma unroll
                    for (int ks = 0; ks < 4; ++ks) { const bf16x8 bfr = *(const LAS bf16x8*)(O + S_BQ + (16 * st + q16) * 272 + ks * 64 + gq * 16); a = __builtin_amdgcn_mfma_f32_16x16x32_bf16(bfr, cfr[ks], a, 0, 0, 0); }
                    const f32x4 css = *(const LAS f32x4*)(misc + 64 + 16 * st + 4 * gq), dts = *(const LAS f32x4*)(misc + 16 * st + 4 * gq);
#pragma unroll
                    for (int r = 0; r < 4; ++r) { const int sidx = 16 * st + 4 * gq + r; a[r] = (sidx <= 16 * lt + q16) ? a[r] * __expf(csl - css[r]) * dts[r] : 0.f; }
                }
                v[hh] = a; }
            pm[pr].x = pk2(v[0][0], v[0][1]); pm[pr].y = pk2(v[0][2], v[0][3]); pm[pr].z = pk2(v[1][0], v[1][1]); pm[pr].w = pk2(v[1][2], v[1][3]);
        }
    }
    {
        const float ecs = misc[128 + 16 * lt + q16];
        const LAS unsigned char* xtr = O + S_XN + (4 * gq + (q16 >> 2)) * 144 + (q16 & 3) * 8;
#pragma unroll
        for (int k = 0; k < 2; ++k) { const int pt = t2 + k; f32x4 a = {0.f, 0.f, 0.f, 0.f};
#pragma unroll
            for (int ks = 0; ks < 4; ++ks) { const bf16x8 hfr = *(const LAS bf16x8*)(HB + (16 * pt + q16) * 272 + ks * 64 + gq * 16); a = __builtin_amdgcn_mfma_f32_16x16x32_bf16(hfr, cfr[ks], a, 0, 0, 0); }
            a = a * ecs;
#pragma unroll
            for (int pr = 0; pr < 2; ++pr) if (2 * pr <= lt) { const s16x4 lo = lds_tr16(xtr + (32 * pr) * 144 + pt * 32), hi = lds_tr16(xtr + (32 * pr + 16) * 144 + pt * 32);
                const bf16x8 xf = {lo[0], lo[1], lo[2], lo[3], hi[0], hi[1], hi[2], hi[3]};
                a = __builtin_amdgcn_mfma_f32_16x16x32_bf16(xf, __builtin_bit_cast(bf16x8, pm[pr]), a, 0, 0, 0); }
            if (skip) { const u32x2 xv = *(const LAS u32x2*)(O + S_XN + (16 * lt + q16) * 144 + (16 * pt + 4 * gq) * 2);
                a[0] += dsk * bflo(xv.x); a[1] += dsk * bfhi(xv.x); a[2] += dsk * bflo(xv.y); a[3] += dsk * bfhi(xv.y); }
            { u32x2 ow; ow.x = pk2(a[0], a[1]); ow.y = pk2(a[2], a[3]); *(u32x2*)(yp + 16 * pt + 4 * gq) = ow; } }
    }
    {
        const int pt2 = w & 3, nb = (w >> 2) * 4; const float et = misc[256];
        const LAS unsigned char* xwtr = O + S_XW + (4 * gq + (q16 >> 2)) * 144 + (q16 & 3) * 8 + pt2 * 32;
        const LAS unsigned char* btr = O + S_BQ + (4 * gq + (q16 >> 2)) * 272 + (q16 & 3) * 8;
        bf16x8 xf2[2];
#pragma unroll
        for (int kk = 0; kk < 2; ++kk) { const s16x4 lo = lds_tr16(xwtr + (32 * kk) * 144), hi = lds_tr16(xwtr + (32 * kk + 16) * 144); xf2[kk] = (bf16x8){lo[0], lo[1], lo[2], lo[3], hi[0], hi[1], hi[2], hi[3]}; }
#pragma unroll
        for (int j = 0; j < 4; ++j) { const int nt = nb + j; Hacc[j] = Hacc[j] * et;
#pragma unroll
            for (int kk = 0; kk < 2; ++kk) { const s16x4 lo = lds_tr16(btr + (32 * kk) * 272 + nt * 32), hi = lds_tr16(btr + (32 * kk + 16) * 272 + nt * 32);
                const bf16x8 bT = {lo[0], lo[1], lo[2], lo[3], hi[0], hi[1], hi[2], hi[3]};
                Hacc[j] = __builtin_amdgcn_mfma_f32_16x16x32_bf16(bT, xf2[kk], Hacc[j], 0, 0, 0); }
            u32x2 hw; hw.x = pk2(Hacc[j][0], Hacc[j][1]); hw.y = pk2(Hacc[j][2], Hacc[j][3]);
            *(LAS u32x2*)(HN + (16 * pt2 + q16) * 272 + (16 * nt + 4 * gq) * 2) = hw; }
    }
}
struct SsdPre { u32x4 x, b[2], c[2]; float dt; };
__device__ __forceinline__ void ssd_mfma_unit(const Frame& F, int layer, int b, int h, int dir) {
    const int g = h >> 2, tid = F.tid, lane = F.lane, w = F.wave, q16 = lane & 15, gq = lane >> 4;
    const bf16_t* U = (const bf16_t*)(F.ws + WS_U); const float* DTS = (const float*)(F.ws + WS_DT);
    bf16_t* Y = (bf16_t*)(F.ws + (dir ? WS_YB : WS_YF));
    const float aneg = -__expf(F.in[I_ALOG][layer * 16 + dir * 8 + h]), dsk = F.in[I_DSKIP][layer * 8 + h];
    LAS unsigned char* L = F.lds;
    __syncthreads();
    for (int i = tid; i < 64 * 272 / 16; i += NT) *(LAS u32x4*)(L + S_HB + i * 16) = (u32x4){0u, 0u, 0u, 0u};
    f32x4 Hacc[4];
#pragma unroll
    for (int j = 0; j < 4; ++j) Hacc[j] = (f32x4){0.f, 0.f, 0.f, 0.f};
    SsdPre P0, P1;
    P0.dt = 0.f; P1.dt = 0.f;
    const int xt = tid >> 3, xp = tid & 7;
    const int bt = tid >> 4, bp = tid & 15;
#define SSD_ROW(ci_, l_) ({ const int s_ = (ci_) < 4 ? 0 : 1, k_ = s_ ? (ci_) - 4 : (ci_), nc_ = s_ ? 32 : 4, c_ = dir ? nc_ - 1 - k_ : k_; \
        (s_ ? b * SEQ : NLAT + b * CTX) + c_ * 64 + (dir ? 63 - (l_) : (l_)); })
#define SSD_PREFETCH(ci_, P_) do { P_.x = *(const u32x4*)(U + (size_t)SSD_ROW(ci_, xt) * 1024 + h * 64 + xp * 8); \
        if (w == 0) P_.dt = DTS[(size_t)SSD_ROW(ci_, lane) * 16 + dir * 8 + h]; \
        _Pragma("unroll") for (int j2_ = 0; j2_ < 2; ++j2_) { const int tok_ = bt + 32 * j2_; const size_t ro_ = (size_t)SSD_ROW(ci_, tok_) * 1024; \
            P_.b[j2_] = *(const u32x4*)(U + ro_ + 512 + g * 128 + bp * 8); P_.c[j2_] = *(const u32x4*)(U + ro_ + 768 + g * 128 + bp * 8); } } while (0)
#define SSD_MISC(slot_, P_) do { LAS float* m_ = (LAS float*)(L + S_MISC) + (slot_) * 272; const float dt_ = P_.dt; const float cs_ = wave_scan(dt_ * aneg); \
        const float tot_ = __builtin_bit_cast(float, __builtin_amdgcn_readlane(__builtin_bit_cast(int, cs_), 63)); \
        m_[lane] = dt_; m_[64 + lane] = cs_; m_[128 + lane] = __expf(cs_); m_[192 + lane] = __expf(tot_ - cs_) * dt_; if (lane == 0) m_[256] = __expf(tot_); } while (0)
#define SSD_STAGE(set_, slot_, P_) do { LAS unsigned char* O_ = L + (set_) * S_OPS; const float wl = ((const LAS float*)(L + S_MISC))[(slot_) * 272 + 192 + xt]; \
        *(LAS u32x4*)(O_ + S_XN + xt * 144 + xp * 16) = P_.x; \
        u32x4 xw; xw.x = pk2(bflo(P_.x.x) * wl, bfhi(P_.x.x) * wl); xw.y = pk2(bflo(P_.x.y) * wl, bfhi(P_.x.y) * wl); xw.z = pk2(bflo(P_.x.z) * wl, bfhi(P_.x.z) * wl); xw.w = pk2(bflo(P_.x.w) * wl, bfhi(P_.x.w) * wl); \
        *(LAS u32x4*)(O_ + S_XW + xt * 144 + xp * 16) = xw; \
        _Pragma("unroll") for (int k = 0; k < 2; ++k) { *(LAS u32x4*)(O_ + S_BQ + (bt + 32 * k) * 272 + bp * 16) = P_.b[k]; *(LAS u32x4*)(O_ + S_CQ + (bt + 32 * k) * 272 + bp * 16) = P_.c[k]; } } while (0)
#define SSD_ITER(ci_, PN_, PC_) do { const int ci = (ci_); const int ms1 = ms == 2 ? 0 : ms + 1, ms2 = ms1 == 2 ? 0 : ms1 + 1; \
        if (ci + 1 < 36) SSD_STAGE(cur ^ 1, ms1, PN_); \
        if (ci + 3 < 36) SSD_PREFETCH(ci + 3, PN_); \
        TPS(0); \
        { const int row0 = SSD_ROW(ci, 16 * (w >> 1) + q16); \
          ssd_chunk_compute(L + cur * S_OPS, (const LAS float*)(L + S_MISC) + ms * 272, L + S_HB + cur * 17408, L + S_HB + (cur ^ 1) * 17408, Hacc, Y + (size_t)row0 * 512 + h * 64, w, q16, gq, dir == 0, dsk); } \
        TPS(2); \
        if (w == 0 && ci + 2 < 36) SSD_MISC(ms2, PC_); \
        __syncthreads(); \
        TPS(3); \
        cur ^= 1; ms = ms1; } while (0)
    SSD_PREFETCH(0, P0);
    if (w == 0) SSD_MISC(0, P0);
    __syncthreads();
    SSD_STAGE(0, 0, P0);
    SSD_PREFETCH(1, P1);
    SSD_PREFETCH(2, P0);
    if (w == 0) SSD_MISC(1, P1);
    __syncthreads();
    TPS_BEGIN;
    int cur = 0, ms = 0;
    for (int c2 = 0; c2 < 36; c2 += 2) { SSD_ITER(c2, P1, P0); SSD_ITER(c2 + 1, P0, P1); }
#undef SSD_ROW
#undef SSD_PREFETCH
#undef SSD_MISC
#undef SSD_STAGE
#undef SSD_ITER
}

__device__ __forceinline__ void na_run(const Frame& F, int layer) {
    LAS unsigned char* KV = F.lds; LAS float* rp = (LAS float*)(F.lds + 120832);
    const bf16_t* PROJ = (const bf16_t*)(F.ws + WS_PROJ); bf16_t* MIX = (bf16_t*)(F.ws + WS_MIX);
    const int tid = F.tid, lane = F.lane, w = F.wave, q16 = lane & 15, g = lane >> 4;
    u32x4 pre[13];
#define NA_VPRE 13
#define NA_RB(m_) ({ int rb_ = 2 * (m_) - 4; rb_ = rb_ < 0 ? 0 : (rb_ > 24 ? 24 : rb_); __builtin_amdgcn_readfirstlane(rb_); })
#define NA_NL(rb_) ({ int nk_ = 32 - (rb_); nk_ = nk_ > 9 ? 9 : nk_; __builtin_amdgcn_readfirstlane(nk_ * 64 * 8); })
#define NA_LOAD(OFFS, b_, h_, rb_, nl_, K0, K1) do { int stid_ = tid; asm volatile("" : "+v"(stid_)); \
        _Pragma("unroll") for (int k_ = K0; k_ < K1; ++k_) { const int i_ = stid_ + k_ * NT, key_ = i_ >> 3, ch_ = i_ & 7; const bool ok_ = !(key_ < 576 && i_ >= (nl_)); \
            const int grow_ = key_ < 576 ? (b_) * SEQ + (rb_) * 64 + key_ : NLAT + (b_) * CTX + (key_ - 576); \
            pre[k_] = ok_ ? *(const u32x4*)(PROJ + (size_t)grow_ * NPROJ + (OFFS) + (h_) * 64 + ch_ * 8) : (u32x4){0u, 0u, 0u, 0u}; } } while (0)
#define NA_WRITE(nl_, K0, K1) do { int stid_ = tid; asm volatile("" : "+v"(stid_)); \
        _Pragma("unroll") for (int k_ = K0; k_ < K1; ++k_) { const int i_ = stid_ + k_ * NT, key_ = i_ >> 3, ch_ = i_ & 7; const bool ok_ = !(key_ < 576 && i_ >= (nl_)); \
            if (ok_) *(LAS u32x4*)(KV + key_ * NA_KS + ch_ * 16) = pre[k_]; } } while (0)
    int u = __builtin_amdgcn_readfirstlane(F.bid); int hprev = -1;
    if (u < 2048) { const int b = u >> 7, h = (u >> 4) & 7, m = u & 15, rb = NA_RB(m); NA_LOAD(OFF_K, b, h, rb, NA_NL(rb), 0, 13); }
    TPS_BEGIN;
    for (; u < 2048; u += F.G) {
        const int b = u >> 7, h = (u >> 4) & 7, m = u & 15, rbase = NA_RB(m), nloc8 = NA_NL(rbase);
        TPS(14);
        __syncthreads();
        TPS(10);
        NA_WRITE(nloc8, 0, 13);
        if (h != hprev) { if (tid < 465) rp[tid] = F.in[I_RPB][(size_t)(layer * 8 + h) * 465 + tid] * LOG2E; hprev = h; }
        NA_LOAD(OFF_V, b, h, rbase, nloc8, 0, NA_VPRE);
        __syncthreads();
        TPS(11);
        const int i = 2 * m + (w >> 2), j0 = (w & 3) * 16, qrow = b * SEQ + i * 64 + j0; int hs = j0 - 8; hs = hs < 0 ? 0 : (hs > 32 ? 32 : hs);
        int r0 = i - 4; r0 = r0 < 0 ? 0 : (r0 > 24 ? 24 : r0); const int kr0 = r0 - rbase;
        bf16x8 qf[2];
#pragma unroll
        for (int ks = 0; ks < 2; ++ks) qf[ks] = *(const bf16x8*)(PROJ + (size_t)(qrow + q16) * NPROJ + h * 64 + ks * 32 + g * 8);
        f32x4 S[32];
        const LAS unsigned char* kb = KV + q16 * NA_KS + g * 16;
        { const int j = j0 + q16; int cs = j - 8; cs = cs < 0 ? 0 : (cs > 48 ? 48 : cs);
          const int rb0 = (kr0 + rbase) - i + 7;
#pragma unroll
          for (int tl = 0; tl < 16; ++tl) { const int kr = tl >> 1, half = tl & 1; const int kidx0 = (kr0 + kr) * 64 + hs + 16 * half;
              f32x4 a = {0.f, 0.f, 0.f, 0.f};
#pragma unroll
              for (int ks = 0; ks < 2; ++ks) { const bf16x8 kf = *(const LAS bf16x8*)(kb + kidx0 * NA_KS + ks * 64); a = __builtin_amdgcn_mfma_f32_16x16x32_bf16(kf, qf[ks], a, 0, 0, 0); }
#pragma unroll
              for (int r = 0; r < 4; ++r) { const int kc = hs + 16 * half + 4 * g + r; const bool inw = (kc >= cs) && (kc < cs + 16);
                  int cbi = kc - j + 15; cbi = cbi < 0 ? 0 : (cbi > 30 ? 30 : cbi);
                  const float bias = rp[(rb0 + kr) * 31 + cbi];
                  const float t = a[r] * (0.125f * LOG2E) + bias; a[r] = inw ? t : -INFINITY; }
              S[tl] = a; if ((tl & 1) == 1) __builtin_amdgcn_sched_barrier(0); } }
#pragma unroll
        for (int tc = 0; tc < 16; ++tc) { const int kidx0 = 576 + 16 * tc; f32x4 a = {0.f, 0.f, 0.f, 0.f};
#pragma unroll
            for (int ks = 0; ks < 2; ++ks) { const bf16x8 kf = *(const LAS bf16x8*)(kb + kidx0 * NA_KS + ks * 64); a = __builtin_amdgcn_mfma_f32_16x16x32_bf16(kf, qf[ks], a, 0, 0, 0); }
            S[16 + tc] = a * (0.125f * LOG2E); if ((tc & 1) == 1) __builtin_amdgcn_sched_barrier(0); }
        float mx = -INFINITY;
#pragma unroll
        for (int t = 0; t < 32; ++t) mx = fmaxf(fmaxf(fmaxf(S[t][0], S[t][1]), fmaxf(S[t][2], S[t][3])), mx);
        mx = fmaxf(mx, __shfl_xor(mx, 16)); mx = fmaxf(mx, __shfl_xor(mx, 32));
        float sum = 0.f; u32x4 P[16];
#pragma unroll
        for (int kk = 0; kk < 16; ++kk) { float e[8];
#pragma unroll
            for (int r = 0; r < 4; ++r) { e[r] = __builtin_amdgcn_exp2f(S[2 * kk][r] - mx); e[4 + r] = __builtin_amdgcn_exp2f(S[2 * kk + 1][r] - mx); }
            sum += ((e[0] + e[1]) + (e[2] + e[3])) + ((e[4] + e[5]) + (e[6] + e[7]));
            P[kk].x = pg8::cvt_pk_bf16_pin(e[0], e[1]); P[kk].y = pg8::cvt_pk_bf16_pin(e[2], e[3]); P[kk].z = pg8::cvt_pk_bf16_pin(e[4], e[5]); P[kk].w = pg8::cvt_pk_bf16_pin(e[6], e[7]); }
        sum += __shfl_xor(sum, 16); sum += __shfl_xor(sum, 32);
        const float inv = 1.0f / sum;
        TPS(12);
        __syncthreads();
        NA_WRITE(nloc8, 0, NA_VPRE); NA_LOAD(OFF_V, b, h, rbase, nloc8, NA_VPRE, 13); NA_WRITE(nloc8, NA_VPRE, 13);
        { const int un = u + F.G; if (un < 2048) { const int bn = un >> 7, hn = (un >> 4) & 7, mn = un & 15, rbn = NA_RB(mn); NA_LOAD(OFF_K, bn, hn, rbn, NA_NL(rbn), 0, 13); } }
        __syncthreads();
        TPS(13);
        f32x4 o[4];
#pragma unroll
        for (int dt = 0; dt < 4; ++dt) o[dt] = (f32x4){0.f, 0.f, 0.f, 0.f};
        const LAS unsigned char* vb = KV + (4 * g + (q16 >> 2)) * NA_KS + (q16 & 3) * 8;
#pragma unroll
        for (int kk = 0; kk < 16; ++kk) {
            const int kidx0 = (kk < 8) ? (kr0 + kk) * 64 + hs : 576 + 32 * (kk - 8);
            const bf16x8 pa = __builtin_bit_cast(bf16x8, P[kk]);
#pragma unroll
            for (int dt = 0; dt < 4; ++dt) { const s16x4 lo = lds_tr16(vb + kidx0 * NA_KS + dt * 32), hi = lds_tr16(vb + (kidx0 + 16) * NA_KS + dt * 32);
                const bf16x8 vf = {lo[0], lo[1], lo[2], lo[3], hi[0], hi[1], hi[2], hi[3]};
                o[dt] = __builtin_amdgcn_mfma_f32_16x16x32_bf16(vf, pa, o[dt], 0, 0, 0); }
            if ((kk & 1) == 1) __builtin_amdgcn_sched_barrier(0);
        }
        { bf16_t* op = MIX + (size_t)(qrow + q16) * D + h * 64 + 4 * g;
#pragma unroll
          for (int dt = 0; dt < 4; ++dt) { u32x2 ow; ow.x = pk2(o[dt][0] * inv, o[dt][1] * inv); ow.y = pk2(o[dt][2] * inv, o[dt][3] * inv); *(u32x2*)(op + dt * 16) = ow; } }
    }
#undef NA_RB
#undef NA_NL
#undef NA_LOAD
#undef NA_WRITE
}
__device__ __forceinline__ void p_mixa(const Frame& F, int layer, bool last) {
    TPS_BEGIN;
    { PrepassW W; ssd_prepass_weights(F, layer, W);
      for (int u = F.bid; u < NTOK / 16; u += F.G) ssd_prepass_unit(F, u, W); }
    TPS(4);
    na_run(F, layer);
    TPS(5);
    if (!last) for (int u = F.bid; u < 256; u += F.G) na_unit(F, layer, u >> 4, (u >> 1) & 7, 1, u & 1);
    TPS(6);
}
__device__ __forceinline__ void p_mixb(const Frame& F, int layer) {
    for (int u0 = F.bid; u0 < 256 * REP_SSD; u0 += F.G) { const int u = u0 & 255; ssd_mfma_unit(F, layer, u >> 4, (u >> 1) & 7, u & 1); }
}

__device__ __forceinline__ void p_ssdcomb(const Frame& F, int layer, bool last) {
    const bf16_t* PROJ = (const bf16_t*)(F.ws + WS_PROJ); bf16_t* MIX = (bf16_t*)(F.ws + WS_MIX);
    const bf16_t* YF = (const bf16_t*)(F.ws + WS_YF); const bf16_t* YB = (const bf16_t*)(F.ws + WS_YB);
    const float* nw = F.in[I_NORMW] + layer * 512 + F.lane * 8;
    const f32x4 nw0 = *(const f32x4*)nw, nw1 = *(const f32x4*)(nw + 4);
    const int nrows = last ? NLAT : NTOK;
    u32x4 pyf = {0u, 0u, 0u, 0u}, pyb = pyf, pz = pyf;
#define SC_LOAD(r_) do { const size_t o_ = (size_t)(r_) * 512 + F.lane * 8; pyf = *(const u32x4*)(YF + o_); pyb = *(const u32x4*)(YB + o_); \
        pz = *(const u32x4*)(PROJ + (size_t)(r_) * NPROJ + OFF_Z + F.lane * 8); } while (0)
    if (F.gw < nrows) SC_LOAD(F.gw);
    for (int row = F.gw; row < nrows; row += F.NGW) {
        const f32x4 a0 = {bflo(pyf.x) + bflo(pyb.x), bfhi(pyf.x) + bfhi(pyb.x), bflo(pyf.y) + bflo(pyb.y), bfhi(pyf.y) + bfhi(pyb.y)}, a1 = {bflo(pyf.z) + bflo(pyb.z), bfhi(pyf.z) + bfhi(pyb.z), bflo(pyf.w) + bflo(pyb.w), bfhi(pyf.w) + bfhi(pyb.w)}; const u32x4 zv = pz;
        if (row + F.NGW < nrows) SC_LOAD(row + F.NGW);
        float y[8] = {a0[0] * silu_f(bflo(zv.x)), a0[1] * silu_f(bfhi(zv.x)), a0[2] * silu_f(bflo(zv.y)), a0[3] * silu_f(bfhi(zv.y)),
                      a1[0] * silu_f(bflo(zv.z)), a1[1] * silu_f(bfhi(zv.z)), a1[2] * silu_f(bflo(zv.w)), a1[3] * silu_f(bfhi(zv.w))};
        float ss = 0.f;
#pragma unroll
        for (int k = 0; k < 8; ++k) ss += y[k] * y[k];
#pragma unroll
        for (int of = 1; of < 32; of <<= 1) ss += __shfl_xor(ss, of);
        const float rs = 1.0f / sqrtf(ss * (1.0f / 256.0f) + RMS_EPS);
        u32x4 w; w.x = pk2(y[0] * rs * nw0[0], y[1] * rs * nw0[1]); w.y = pk2(y[2] * rs * nw0[2], y[3] * rs * nw0[3]);
        w.z = pk2(y[4] * rs * nw1[0], y[5] * rs * nw1[1]); w.w = pk2(y[6] * rs * nw1[2], y[7] * rs * nw1[3]);
        *(u32x4*)(MIX + (size_t)row * D + 512 + F.lane * 8) = w;
    }
}

__device__ __forceinline__ void p_outproj(const Frame& F, int layer, bool last) {
    pg8::Gemm g{(const bf16_t*)(F.ws + WS_MIX), (const bf16_t*)(F.ws + WS_WOUT) + (size_t)layer * D * D, D};
    pg8::DenseOrder S; S.init(last ? NLAT : NTOK, D, D, F.G, F.bid);
    pg8::EpiGate E{(bf16_t*)(F.ws + WS_DELTA1), (const float*)(F.ws + WS_MOD) + (size_t)layer * 17 * MODW, 2 * D};
    pg8::gemm_phase<pg8::EpiGate, pg8::DenseOrder, true, true>(F.lds, g, S, E, F.tid);
    if (layer == 0) deferred_conv(F, (NTOK / 256) * (D / 256), DW_L0_OUT, DW_Q); else if (layer == 1) deferred_conv(F, (NTOK / 256) * (D / 256), DW_L1_OUT, DW_Q);
}

__device__ __forceinline__ unsigned* cnt_word(const Frame& F, int slot, int hf, int e) { return (unsigned*)(F.ws + WS_CTL) + CW_CNT + ((slot * 2 + hf) * 8 + e) * 64; }
template <bool MOE> __device__ __forceinline__ void ln1_body(const Frame& F, int layer, bool last) {
    constexpr bool moe = MOE;
    bf16_t* X = (bf16_t*)(F.ws + WS_X); bf16_t* H = (bf16_t*)(F.ws + WS_H);
    const float* MOD = (const float*)(F.ws + WS_MOD) + (size_t)layer * 17 * MODW;
    const float* lg = F.in[I_LNG] + (size_t)(layer * 2) * D; const float* lb = F.in[I_LNB] + (size_t)(layer * 2) * D;
    const int slot = layer >> 1;
    const int nrows = last ? NLAT : NTOK;
    float rw[16][8];
    if (moe) { const float* R = F.in[I_RW] + (size_t)slot * D * 8;
#pragma unroll
        for (int j = 0; j < 4; ++j)
#pragma unroll
            for (int k = 0; k < 4; ++k) { const int lane = F.lane; const f32x4 a = *(const f32x4*)(R + (size_t)(RIDX(j) + k) * 8), b2 = *(const f32x4*)(R + (size_t)(RIDX(j) + k) * 8 + 4);
                rw[j * 4 + k][0] = a[0]; rw[j * 4 + k][1] = a[1]; rw[j * 4 + k][2] = a[2]; rw[j * 4 + k][3] = a[3]; rw[j * 4 + k][4] = b2[0]; rw[j * 4 + k][5] = b2[1]; rw[j * 4 + k][6] = b2[2]; rw[j * 4 + k][7] = b2[3]; } }
    int nrec = 0;
    if (moe) { __syncthreads(); if (F.tid < 32) ((LAS unsigned*)F.lds)[F.tid] = 0u; __syncthreads(); }
    const bf16_t* DL = (const bf16_t*)(F.ws + WS_DELTA1);
    const int rpw = (nrows + F.NGW - 1) / F.NGW, rbeg = F.gw * rpw, rend = (rbeg + rpw < nrows) ? rbeg + rpw : nrows;
    f32x4 G[4], B[4], SC[4], SH[4]; int mcur = -1;
    if (!moe) { col_load(lg, F.lane, G); col_load(lb, F.lane, B); }
    RowRaw r0 = {}, r1 = {};
    if (rbeg < rend) row_issue<true>(X, DL, rbeg, F.lane, r0);
    if (rbeg + 1 < rend) row_issue<true>(X, DL, rbeg + 1, F.lane, r1);
    for (int row = rbeg; row < rend; ++row) {
        f32x4 v[4], hv[4];
        row_combine(r0, v); r0 = r1;
        if (row + 2 < rend) row_issue<true>(X, DL, row + 2, F.lane, r1);
        const float* m = MOD + (size_t)mod_row_of(row) * MODW;
        if (moe) {
            row_ln(v, lg, lb, F.lane);
            row_store_h(X + (size_t)row * D, F.lane, v);
            row_mod_store8((unsigned char*)H + (size_t)row * D, F.lane, v, m + 3 * D, m + 4 * D, hv);
        } else {
            row_ln_r(v, G, B);
            row_store_h(X + (size_t)row * D, F.lane, v);
            const int mr = mod_row_of(row);
            if (mr != mcur) { col_load(m + 4 * D, F.lane, SC, 1.0f); col_load(m + 3 * D, F.lane, SH); mcur = mr; }
#pragma unroll
            for (int q = 0; q < 4; ++q) hv[q] = v[q] * SC[q] + SH[q];
            if (USE_FP8 && FP8_DENSE1) { f32x4 dmy[4]; row_mod_store8((unsigned char*)H + (size_t)row * D, F.lane, v, m + 3 * D, m + 4 * D, dmy); }
            else row_store_h(H + (size_t)row * D, F.lane, hv);
        }
        if (moe) {
            float lg8[8];
#pragma unroll
            for (int e = 0; e < 8; ++e) { float s = 0.f;
#pragma unroll
                for (int j = 0; j < 4; ++j)
#pragma unroll
                    for (int k = 0; k < 4; ++k) s += hv[j][k] * rw[j * 4 + k][e];
                lg8[e] = wave_sum(s); }
            int e0 = 0; float v0 = lg8[0];
#pragma unroll
            for (int e = 1; e < 8; ++e) if (lg8[e] > v0) { v0 = lg8[e]; e0 = e; }
            int e1 = -1; float v1 = -INFINITY;
#pragma unroll
            for (int e = 0; e < 8; ++e) if (e != e0 && lg8[e] > v1) { v1 = lg8[e]; e1 = e; }
            if (F.lane == 0) {
                const unsigned s0 = __hip_atomic_fetch_add((LAS unsigned*)F.lds + e0, 1u, __ATOMIC_RELAXED, __HIP_MEMORY_SCOPE_WORKGROUP), s1 = __hip_atomic_fetch_add((LAS unsigned*)F.lds + e1, 1u, __ATOMIC_RELAXED, __HIP_MEMORY_SCOPE_WORKGROUP);
                const float ex = __expf(v1 - v0), g0 = 1.0f / (1.0f + ex);
                ((LAS u32x4*)(F.lds + 256))[F.wave * 32 + nrec] = (u32x4){(unsigned)e0 | ((unsigned)e1 << 8), s0, s1, (unsigned)row};
                *(f32x2*)(F.ws + WS_GATES + (size_t)row * 8) = (f32x2){g0, ex * g0};
            }
            ++nrec;
        }
    }
    if (moe) {
        __syncthreads();
        if (F.tid < 8) ((LAS unsigned*)F.lds)[16 + F.tid] = atomicAdd(cnt_word(F, slot, 0, F.tid), ((LAS unsigned*)F.lds)[F.tid]);
        __syncthreads();
        int* list = (int*)(F.ws + WS_LIST);
        if (F.lane < nrec) { const u32x4 rc = ((LAS u32x4*)(F.lds + 256))[F.wave * 32 + F.lane]; const int e0 = rc.x & 255, e1 = (rc.x >> 8) & 255; const int row = (int)rc.w;
            const unsigned s0 = ((LAS unsigned*)F.lds)[16 + e0] + rc.y, s1 = ((LAS unsigned*)F.lds)[16 + e1] + rc.z;
            list[e0 * NTOK + s0] = row; list[e1 * NTOK + s1] = row;
            *(u32x4*)(F.ws + WS_ROUTE + (size_t)row * 16) = (u32x4){rc.x, s0, s1, 0u}; }
    }
}

__device__ __forceinline__ void p_ln1(const Frame& F, int layer, bool last) { if (layer & 1) ln1_body<true>(F, layer, last); else ln1_body<false>(F, layer, last); }

__device__ __forceinline__ void p_ffn1_dense(const Frame& F, int layer, bool last) {
    const int s = layer >> 1;
#if USE_FP8 && FP8_DENSE2
    typedef pg8::EpiSwiGLU8 EpiH; EpiH E{F.ws + WS_HID, DFF};
#else
    typedef pg8::EpiSwiGLU EpiH; EpiH E{(bf16_t*)(F.ws + WS_HID), DFF};
#endif
#if USE_FP8 && FP8_DENSE1
    pg8::Gemm g{(const bf16_t*)(F.ws + WS_H), (const bf16_t*)(F.ws + WS_WFGU + (size_t)s * 2 * DFF * D), D / 2};
    pg8::DenseOrder S; S.init(last ? NLAT : NTOK, 2 * DFF, D / 2, F.G, F.bid, REP_GEMM);
    pg8::gemm_phase<EpiH, pg8::DenseOrder, true, FP8_SP2, true>(F.lds, g, S, E, F.tid, (127 - S8_WGU) * 0x01010101, (127 - S8_ACT) * 0x01010101);
#else
    pg8::Gemm g{(const bf16_t*)(F.ws + WS_H), (const bf16_t*)(F.ws + WS_WFGU) + (size_t)s * 2 * DFF * D, D};
    pg8::DenseOrder S; S.init(last ? NLAT : NTOK, 2 * DFF, D, F.G, F.bid, REP_GEMM);
    pg8::gemm_phase<EpiH, pg8::DenseOrder, true, true>(F.lds, g, S, E, F.tid);
#endif
    if (layer == 0) deferred_conv(F, (NTOK / 256) * (2 * DFF / 256), DW_L0_F1, DW_Q);
}
__device__ __forceinline__ void p_ffn2_dense(const Frame& F, int layer, bool last) {
    const int s = layer >> 1;
    pg8::EpiGate E{(bf16_t*)(F.ws + WS_DELTA2), (const float*)(F.ws + WS_MOD) + (size_t)layer * 17 * MODW, 5 * D};
#if USE_FP8 && FP8_DENSE2
    pg8::Gemm g{(const bf16_t*)(F.ws + WS_HID), (const bf16_t*)(F.ws + WS_WFD + (size_t)s * D * DFF), DFF / 2};
    pg8::DenseOrder S; S.init(last ? NLAT : NTOK, D, DFF / 2, F.G, F.bid);
    pg8::gemm_phase<pg8::EpiGate, pg8::DenseOrder, true, FP8_SP2, true>(F.lds, g, S, E, F.tid, (127 - S8_WD) * 0x01010101, (127 - S8_HID) * 0x01010101);
#else
    pg8::Gemm g{(const bf16_t*)(F.ws + WS_HID), (const bf16_t*)(F.ws + WS_WFD) + (size_t)s * D * DFF, DFF};
    pg8::DenseOrder S; S.init(last ? NLAT : NTOK, D, DFF, F.G, F.bid);
    pg8::gemm_phase<pg8::EpiGate, pg8::DenseOrder, true, true>(F.lds, g, S, E, F.tid);
#endif
    if (layer == 0) deferred_conv(F, (NTOK / 256) * (D / 256), DW_L0_F2, DW_Q2);
}
__device__ __forceinline__ void moe_prefix(const Frame& F, int slot, int hf, int (&ts)[9], int (&cn)[8]) {
    int a = 0;
#pragma unroll
    for (int e = 0; e < 8; ++e) { cn[e] = (int)*cnt_word(F, slot, hf, e); ts[e] = a; a += (cn[e] + 255) >> 8; }
    ts[8] = a;
}
__device__ __forceinline__ void p_ffn1_moe(const Frame& F, int layer) {
    const int slot = layer >> 1; int cn[8];
    pg8::MoeOrder<true> S; moe_prefix(F, slot, 0, S.ts, cn);
    S.nM = S.ts[8]; S.nN = 2 * DFFE / 256; S.G = F.G; S.c = F.bid; S.K = D / 2; S.estride = (long)2 * DFFE * D; S.rowoff = (const LAS unsigned short*)(F.lds + LDS_ROWOFF); S.rowbytes = D;
    {
        const int* list = (const int*)(F.ws + WS_LIST); LAS unsigned short* ro = (LAS unsigned short*)(F.lds + LDS_ROWOFF); pg8::Unit u;
        for (int i = F.wave; i < 36 && S.next(i, u); i += NWAVES) { const int e = S.expert_of(u.pm); int tse = 0, cne = 0;
#pragma unroll
            for (int j = 0; j < 8; ++j) { tse = (j == e) ? S.ts[j] : tse; cne = (j == e) ? cn[j] : cne; }
            int tk[4];
#pragma unroll
            for (int q = 0; q < 4; ++q) { const int sl = (u.pm - tse) * 256 + F.lane + 64 * q; tk[q] = sl < cne ? list[e * NTOK + sl] : 0; }
#pragma unroll
            for (int q = 0; q < 4; ++q) ro[i * 256 + F.lane + 64 * q] = (unsigned short)tk[q]; }
        __syncthreads();
    }
    pg8::Gemm g{(const bf16_t*)(F.ws + WS_H), (const bf16_t*)(F.ws + WS_WMGU + (size_t)slot * NEXP * 2 * DFFE * D), D / 2};
    pg8::EpiSwiGLU8 E{F.ws + WS_HID, DFFE};
    pg8::gemm_phase<pg8::EpiSwiGLU8, pg8::MoeOrder<true>, true, FP8_SP2, true>(F.lds, g, S, E, F.tid, (127 - S8_WGU) * 0x01010101, (127 - S8_ACT) * 0x01010101);
}
__device__ __forceinline__ void p_ffn2_moe(const Frame& F, int layer) {
    const int slot = layer >> 1; int cn[8];
    pg8::MoeOrder<false> S; moe_prefix(F, slot, 0, S.ts, cn);
    S.nM = S.ts[8]; S.nN = D / 256; S.G = F.G; S.c = F.bid; S.K = DFFE / 2; S.estride = (long)D * DFFE; S.rowoff = nullptr; S.rowbytes = 0;
    pg8::EpiBf16 E{(bf16_t*)(F.ws + WS_YP), D};
    pg8::Gemm g{(const bf16_t*)(F.ws + WS_HID), (const bf16_t*)(F.ws + WS_WMD + (size_t)slot * NEXP * D * DFFE), DFFE / 2};
    pg8::gemm_phase<pg8::EpiBf16, pg8::MoeOrder<false>, true, FP8_SP2, true>(F.lds, g, S, E, F.tid, (127 - S8_WD) * 0x01010101, (127 - S8_HID) * 0x01010101);
}

template <bool MOE> __device__ __forceinline__ void ln2_body(const Frame& F, int layer, bool last) {
    bf16_t* X = (bf16_t*)(F.ws + WS_X); bf16_t* H = (bf16_t*)(F.ws + WS_H);
    const float* MOD = (const float*)(F.ws + WS_MOD) + (size_t)layer * 17 * MODW;
    const float* lg = F.in[I_LNG] + (size_t)(layer * 2 + 1) * D; const float* lb = F.in[I_LNB] + (size_t)(layer * 2 + 1) * D;
    const int slot = layer >> 1;
    const int nrows = last ? NLAT : NTOK;
    int ts0[9], cn[8];
    if (MOE) moe_prefix(F, slot, 0, ts0, cn);
    const bf16_t* YP = (const bf16_t*)(F.ws + WS_YP); const bf16_t* DL = (const bf16_t*)(F.ws + WS_DELTA2);
    const int rpw = (nrows + F.NGW - 1) / F.NGW, rbeg = F.gw * rpw, rend = (rbeg + rpw < nrows) ? rbeg + rpw : nrows;
    f32x4 G[4], B[4], SC[4], SH[4], Q[4]; int mcur = -1;
    col_load(lg, F.lane, G); col_load(lb, F.lane, B);
    RowRaw r0 = {}, r1 = {}; u32x4 rt0 = {0u, 0u, 0u, 0u}, rt1 = {0u, 0u, 0u, 0u}; f32x2 g0 = {0.f, 0.f}, g1 = {0.f, 0.f}; u32x4 ya[2] = {}, yb[2] = {};
#define LN2_ISSUE(row_, r_, rt_, g_) do { row_issue<!MOE>(X, DL, (row_), F.lane, r_); \
        if (MOE) { rt_ = *(const u32x4*)(F.ws + WS_ROUTE + (size_t)(row_) * 16); g_ = *(const f32x2*)(F.ws + WS_GATES + (size_t)(row_) * 8); } } while (0)
#define LN2_ISSUE_Y(rt_) do { const int e0_ = (rt_).x & 255, e1_ = ((rt_).x >> 8) & 255; int t0_ = 0, t1_ = 0; \
        _Pragma("unroll") for (int e = 0; e < 8; ++e) { const int tv = ts0[e]; t0_ = (e == e0_) ? tv : t0_; t1_ = (e == e1_) ? tv : t1_; } \
        const bf16_t* y0_ = YP + ((size_t)t0_ * 256 + (rt_).y) * D; const bf16_t* y1_ = YP + ((size_t)t1_ * 256 + (rt_).z) * D; \
        _Pragma("unroll") for (int j = 0; j < 2; ++j) { ya[j] = *(const u32x4*)(y0_ + 8 * F.lane + 512 * j); yb[j] = *(const u32x4*)(y1_ + 8 * F.lane + 512 * j); } } while (0)
    if (rbeg < rend) LN2_ISSUE(rbeg, r0, rt0, g0);
    if (rbeg + 1 < rend) LN2_ISSUE(rbeg + 1, r1, rt1, g1);
    if (MOE) { if (rbeg < rend) LN2_ISSUE_Y(rt0); }
    for (int row = rbeg; row < rend; ++row) {
        f32x4 v[4], hv[4];
        const int mr = mod_row_of(row);
        if (mr != mcur) { const float* m = MOD + (size_t)mr * MODW; if (MOE) col_load(m + 5 * D, F.lane, Q, 1.0f);
            if (!last) { const float* mn = m + (size_t)17 * MODW; col_load(mn + D, F.lane, SC, 1.0f); col_load(mn, F.lane, SH); }
            mcur = mr; }
        if (MOE) {
#pragma unroll
            for (int j = 0; j < 2; ++j) { f32x4 x0, x1, a0, a1, b0, b1; unpack8(r0.x[j], x0, x1); unpack8(ya[j], a0, a1); unpack8(yb[j], b0, b1);
                v[2 * j] = x0 * ALPHA + Q[2 * j] * (a0 * g0[0] + b0 * g0[1]); v[2 * j + 1] = x1 * ALPHA + Q[2 * j + 1] * (a1 * g0[0] + b1 * g0[1]); }
        } else row_combine(r0, v);
        r0 = r1; rt0 = rt1; g0 = g1;
        if (MOE) { if (row + 1 < rend) LN2_ISSUE_Y(rt0); }
        if (row + 2 < rend) LN2_ISSUE(row + 2, r1, rt1, g1);
        row_ln_r(v, G, B);
        if (last) row_store(F.out + (size_t)row * D, F.lane, v);
        else { row_store_h(X + (size_t)row * D, F.lane, v);
#pragma unroll
            for (int q = 0; q < 4; ++q) hv[q] = v[q] * SC[q] + SH[q];
            row_store_h(H + (size_t)row * D, F.lane, hv); }
    }
#undef LN2_ISSUE
#undef LN2_ISSUE_Y
}
__device__ __forceinline__ void p_ln2(const Frame& F, int layer, bool last) { if (layer & 1) ln2_body<true>(F, layer, last); else ln2_body<false>(F, layer, last); }

constexpr int NPL = 9;
constexpr int NPH = 2 + NPL * DEPTH;
#ifndef SITE_MASK
#define SITE_MASK 0xFFFFF
#endif
#ifndef TPROBE_MULT
#define TPROBE_MULT 4
#endif
#define SITE(n) (((SITE_MASK) >> (n)) & 1)
__global__ void __launch_bounds__(NT, 2) fwd_kernel(Args args) {
    extern __shared__ __attribute__((aligned(16))) unsigned char lds_raw[];
    Frame F;
    F.lds = (LAS unsigned char*)lds_raw; F.in = args.in; F.out = args.out; F.ws = args.ws;
    F.tid = threadIdx.x; F.lane = F.tid & 63; F.wave = __builtin_amdgcn_readfirstlane(F.tid >> 6); F.bid = blockIdx.x; F.G = gridDim.x;
    F.gw = F.bid * NWAVES + F.wave; F.NGW = F.G * NWAVES;
    volatile LAS unsigned* MISC = (volatile LAS unsigned*)(F.lds + LDS_MISC);
    if (F.tid < 64) MISC[F.tid] = 0u;
    __syncthreads();
    XcdBarrier bar; bar.bar = (unsigned*)(F.ws + WS_CTL) + CW_BAR; bar.x = 0; bar.st = MISC + 8;
#if MK_SINGLE
    bar = xcd_barrier_post((unsigned*)(F.ws + WS_CTL) + CW_BAR, MISC + 8);
#endif
    const int lo = args.ph_lo, hi = args.ph_hi;
#define IN(k) (lo <= (k) && (k) < hi)
#if TPROBE >= 0
    unsigned long long tp_prev = __builtin_amdgcn_s_memrealtime(), tp_acc = 0ull;
#define TP(type) do { const unsigned long long t_ = __builtin_amdgcn_s_memrealtime(); if ((type) == TPROBE) tp_acc += t_ - tp_prev; tp_prev = t_; } while (0)
#else
#define TP(type) do { } while (0)
#endif
#if MK_SINGLE
#define SEAM(k) do { if (IN(k) && IN((k) + 1)) { XcdBarrier b2_ = bar; int z_; asm volatile("s_mov_b32 %0, 0" : "=s"(z_)); b2_.bar = bar.bar + z_; int ln_; asm volatile("v_mbcnt_lo_u32_b32 %0, -1, 0\n\tv_mbcnt_hi_u32_b32 %0, -1, %0" : "=v"(ln_)); xcd_barrier(b2_, F.wave == 0 && ln_ == 0); } } while (0)
#else
#define SEAM(k) do { } while (0)
#endif
    if constexpr (SITE(0)) if (IN(0)) p_pro_a(fresh(F));
    SEAM(0); TP(0);
    if constexpr (SITE(1)) if (IN(1)) p_pro_b(fresh(F));
    SEAM(1); TP(1);
    for (int layer = 0; layer < DEPTH; ++layer) {
        const int pb = 2 + NPL * layer; const bool last = layer == DEPTH - 1; const bool moe = layer & 1;
        if constexpr (SITE(2)) if (IN(pb + 0)) p_inproj(fresh(F), layer);
        SEAM(pb + 0); TP(2);
        if constexpr (SITE(3)) if (IN(pb + 1)) p_mixa(fresh(F), layer, last);
        SEAM(pb + 1); TP(3);
        if constexpr (SITE(12)) if (IN(pb + 2)) p_mixb(fresh(F), layer);
        SEAM(pb + 2); TP(4);
        if constexpr (SITE(4)) if (IN(pb + 3)) { p_ssdcomb(fresh(F), layer, last); if (!USE_FP8 && layer == 2) { int rot = 0; conv_moe(fresh(F), 1, rot); } }
        SEAM(pb + 3); TP(5);
        if constexpr (SITE(5)) if (IN(pb + 4)) p_outproj(fresh(F), layer, last);
        SEAM(pb + 4); TP(6);
        if constexpr (SITE(6)) if (IN(pb + 5)) p_ln1(fresh(F), layer, last);
        SEAM(pb + 5); TP(7);
        if (moe) {
            if constexpr (SITE(7)) if (IN(pb + 6)) p_ffn1_moe(fresh(F), layer);
            SEAM(pb + 6); TP(8);
            if constexpr (SITE(8)) if (IN(pb + 7)) p_ffn2_moe(fresh(F), layer);
            SEAM(pb + 7); TP(9);
        } else {
            if constexpr (SITE(9)) if (IN(pb + 6)) p_ffn1_dense(fresh(F), layer, last);
            SEAM(pb + 6); TP(10);
            if constexpr (SITE(10)) if (IN(pb + 7)) p_ffn2_dense(fresh(F), layer, last);
            SEAM(pb + 7); TP(11);
        }
        if constexpr (SITE(11)) if (IN(pb + 8)) p_ln2(fresh(F), layer, last);
        if (!last) SEAM(pb + 8);
        TP(12);
    }
#if TPROBE >= 100
    __syncthreads(); tp_acc = ((volatile LAS unsigned*)(F.lds + LDS_MISC))[40];
#endif
#if TPROBE >= 0
    { const unsigned long long t_end = __builtin_amdgcn_s_memrealtime(); while (__builtin_amdgcn_s_memrealtime() - t_end < (unsigned long long)TPROBE_MULT * tp_acc) __builtin_amdgcn_s_sleep(8); }
#endif
#undef IN
#undef SEAM
}

extern "C" void kernel_launch(void* const* d_in, const int* in_sizes, int n_in, void* d_out, int out_size, void* d_ws, size_t ws_size, hipStream_t stream) {
    static int grid = 0;
    if (grid == 0) {
        if (n_in != 24 || out_size != NLAT * D || ws_size < WS_END) { fprintf(stderr, "kernel_launch: unexpected shapes (n_in %d, out %d, ws %zu < %zu)\n", n_in, out_size, ws_size, (size_t)WS_END); grid = -1; return; }
        int dev = 0, cus = 0, per_cu = 0;
        if (hipGetDevice(&dev) != hipSuccess || hipDeviceGetAttribute(&cus, hipDeviceAttributeMultiprocessorCount, dev) != hipSuccess) { grid = -1; return; }
        if (hipFuncSetAttribute((const void*)fwd_kernel, hipFuncAttributeMaxDynamicSharedMemorySize, LDS_BYTES) != hipSuccess) { fprintf(stderr, "kernel_launch: hipFuncSetAttribute failed\n"); grid = -1; return; }
        if (hipOccupancyMaxActiveBlocksPerMultiprocessor(&per_cu, (const void*)fwd_kernel, NT, LDS_BYTES) != hipSuccess || per_cu < 1) { fprintf(stderr, "kernel_launch: occupancy query says %d\n", per_cu); }
        (void)hipGetLastError();
        grid = cus;
    }
    if (grid < 0) return;
    (void)in_sizes;
    if (hipMemsetAsync((char*)d_ws + WS_CTL, 0, CTL_BYTES, stream) != hipSuccess) return;
    Args a{};
    for (int i = 0; i < 24; ++i) a.in[i] = (const float*)d_in[i];
    a.out = (float*)d_out; a.ws = (unsigned char*)d_ws;
#if MK_SINGLE
    a.ph_lo = 0; a.ph_hi = NPH;
    hipLaunchKernelGGL(fwd_kernel, dim3(grid), dim3(NT), LDS_BYTES, stream, a);
#else
    for (int ph = 0; ph < NPH; ++ph) {

        a.ph_lo = ph; a.ph_hi = ph + 1;
        hipLaunchKernelGGL(fwd_kernel, dim3(grid), dim3(NT), LDS_BYTES, stream, a);
    }
#endif
}
```

```cpp
#include <hip/hip_runtime.h>
#include <cstdio>
#include <cstdint>

#ifndef MK_SINGLE
#define MK_SINGLE 1
#endif

#ifndef FP8_INPROJ
#define FP8_INPROJ 0
#endif
#ifndef FP8_DENSE1_MASK
#define FP8_DENSE1_MASK 2
#endif
#ifndef FP8_DENSE2
#define FP8_DENSE2 1
#endif
#ifndef USE_FP8
#define USE_FP8 1
#endif
#ifndef FP8_SP2
#define FP8_SP2 true
#endif
#ifndef REP_SSD
#define REP_SSD 1
#endif
#ifndef REP_NA
#define REP_NA 1
#endif
#ifndef REP_GEMM
#define REP_GEMM 1
#endif
#define GAS __attribute__((address_space(1)))
#define LAS __attribute__((address_space(3)))
typedef unsigned short bf16_t;
typedef short bf16x8 __attribute__((ext_vector_type(8)));
typedef float f32x4 __attribute__((ext_vector_type(4)));
typedef float f32x2 __attribute__((ext_vector_type(2)));
typedef unsigned u32x4 __attribute__((ext_vector_type(4)));
typedef unsigned u32x2 __attribute__((ext_vector_type(2)));
typedef int i32x4 __attribute__((ext_vector_type(4)));
typedef int i32x8 __attribute__((ext_vector_type(8)));

constexpr int D = 1024, BATCH = 16, SEQ = 2048, DEPTH = 4, GRID_W = 64, CTX = 256;
constexpr int NLAT = BATCH * SEQ;
constexpr int NCTX = BATCH * CTX;
constexpr int NTOK = NLAT + NCTX;
constexpr int NPROJ = 3072;
constexpr int OFF_K = 512, OFF_V = 1024, OFF_Z = 1536, OFF_XBC = 2048;
constexpr int D_IN_PROJ = 3088;
constexpr int DFF = 2816, DFFE = 3584, NEXP = 8;
constexpr float ALPHA = 1.6817928305074290f;
constexpr float LN_EPS = 1e-5f, RMS_EPS = 1e-5f;
constexpr int MODW = 6 * D;

constexpr size_t MiB = 1u << 20;
constexpr size_t WS_CTL = 0, CTL_BYTES = 1 * MiB;
constexpr size_t WS_MOD = 1 * MiB;
constexpr size_t WS_ROUTE = 3 * MiB;
constexpr size_t WS_GATES = 4 * MiB;
constexpr size_t WS_LIST = 5 * MiB;
constexpr size_t WS_WDT = 7 * MiB;
constexpr size_t WS_WIN = 8 * MiB;
constexpr size_t WS_WOUT = 32 * MiB;
constexpr size_t WS_WFGU = 40 * MiB;
constexpr size_t WS_WFD = 62 * MiB;
constexpr size_t WS_WMGU = 73 * MiB;
constexpr size_t WS_WMD = 185 * MiB;
constexpr size_t WS_X = 241 * MiB;
constexpr size_t WS_H = 385 * MiB;
constexpr size_t WS_R = 457 * MiB;
constexpr size_t WS_PROJ = WS_R;
constexpr size_t WS_DT = WS_R + 216 * MiB;
constexpr size_t WS_YF = WS_R + 219 * MiB;
constexpr size_t WS_YB = WS_R + 291 * MiB;
constexpr size_t WS_MIX = WS_R + 363 * MiB;
constexpr size_t WS_HID = WS_R;
constexpr size_t WS_YP = WS_R + 270 * MiB;
constexpr size_t WS_DELTA1 = WS_R;
constexpr size_t WS_DELTA2 = WS_R + 270 * MiB;
constexpr size_t WS_U = WS_R + 435 * MiB;
constexpr size_t WS_H8IN = WS_U;
constexpr size_t WS_END = WS_R + 507 * MiB;
constexpr int MOE_PAD = 2 * NTOK + 2048;
static_assert(USE_FP8 == 1, "the single-phase MoE needs the e4m3 hidden (the bf16 one does not fit the workspace)");
static_assert(WS_HID + (size_t)MOE_PAD * 3584 <= WS_YP && WS_YP + (size_t)MOE_PAD * 1024 * 2 <= WS_END, "MoE buffers");

constexpr int CW_TMO = 0;
constexpr int CW_BAR = 4096;
constexpr int CW_CNT = 16384;

constexpr int LDS_STAGE = 131072;
constexpr int LDS_ROWOFF = 131072;
constexpr int LDS_MISC = 131072 + 18432;
constexpr int LDS_BYTES = 155648;

constexpr int S8_ACT = 3, S8_WGU = 8, S8_HID = 2, S8_WD = 9;
#ifndef TPROBE
#define TPROBE (-1)
#endif
#if TPROBE >= 100
#define TPS_BEGIN unsigned long long tps_t_ = __builtin_amdgcn_s_memrealtime()
#define TPS(k) do { const unsigned long long t_ = __builtin_amdgcn_s_memrealtime(); if (TPROBE == 100 + (k) && F.tid == 0) ((volatile LAS unsigned*)(F.lds + LDS_MISC))[40] += (unsigned)(t_ - tps_t_); tps_t_ = t_; } while (0)
#else
#define TPS_BEGIN do { } while (0)
#define TPS(k) do { } while (0)
#endif
#define GATE_PRESCALE (-1.4426950408889634f)
__device__ __forceinline__ unsigned f2bf(float f) { unsigned u = __builtin_bit_cast(unsigned, f); return (u + 0x7fffu + ((u >> 16) & 1u)) >> 16; }
typedef __bf16 bf16x2_t __attribute__((ext_vector_type(2)));
__device__ __forceinline__ unsigned pk2(float lo, float hi) { const f32x2 v = {lo, hi}; const bf16x2_t b = __builtin_convertvector(v, bf16x2_t); return __builtin_bit_cast(unsigned, b); }
__device__ __forceinline__ float bf2f(unsigned short b) { return __builtin_bit_cast(float, ((unsigned)b) << 16); }
__device__ __forceinline__ float bflo(unsigned w) { return __builtin_bit_cast(float, w << 16); }
__device__ __forceinline__ float bfhi(unsigned w) { return __builtin_bit_cast(float, w & 0xffff0000u); }
__device__ __forceinline__ float silu_f(float v) { return v / (1.0f + __expf(-v)); }
__device__ __forceinline__ float clamp8(float v) { return fminf(fmaxf(v, -448.0f), 448.0f); }
__device__ __forceinline__ unsigned pk8(float a, float b, float c, float d) {
    int w = 0; w = __builtin_amdgcn_cvt_pk_fp8_f32(clamp8(a), clamp8(b), w, false); w = __builtin_amdgcn_cvt_pk_fp8_f32(clamp8(c), clamp8(d), w, true); return (unsigned)w; }
template <int CTRL, int ROWMASK = 0xF, bool BC = false>
__device__ __forceinline__ float dpp_f(float v) { return __builtin_bit_cast(float, __builtin_amdgcn_update_dpp(0, __builtin_bit_cast(int, v), CTRL, ROWMASK, 0xF, BC)); }
__device__ __forceinline__ float row16_sum(float v) {
    v += dpp_f<0xB1>(v); v += dpp_f<0x4E>(v); v += dpp_f<0x141>(v); v += dpp_f<0x140>(v);
    return v;
}
__device__ __forceinline__ float wave_sum(float v) {
    v = row16_sum(v);
    v += dpp_f<0x142, 0xA>(v); v += dpp_f<0x143, 0xC>(v);
    return __builtin_bit_cast(float, __builtin_amdgcn_readlane(__builtin_bit_cast(int, v), 63));
}
__device__ __forceinline__ float xrow_max(float v) {
    unsigned u = __builtin_bit_cast(unsigned, v); auto r = __builtin_amdgcn_permlane16_swap(u, u, false, false);
    v = fmaxf(__builtin_bit_cast(float, r[0]), __builtin_bit_cast(float, r[1]));
    u = __builtin_bit_cast(unsigned, v); auto r2 = __builtin_amdgcn_permlane32_swap(u, u, false, false);
    return fmaxf(__builtin_bit_cast(float, r2[0]), __builtin_bit_cast(float, r2[1]));
}
__device__ __forceinline__ float xrow_sum(float v) {
    unsigned u = __builtin_bit_cast(unsigned, v); auto r = __builtin_amdgcn_permlane16_swap(u, u, false, false);
    v = __builtin_bit_cast(float, r[0]) + __builtin_bit_cast(float, r[1]);
    u = __builtin_bit_cast(unsigned, v); auto r2 = __builtin_amdgcn_permlane32_swap(u, u, false, false);
    return __builtin_bit_cast(float, r2[0]) + __builtin_bit_cast(float, r2[1]);
}
__device__ __forceinline__ float wave_scan(float v) {
    v += dpp_f<0x111, 0xF, true>(v); v += dpp_f<0x112, 0xF, true>(v); v += dpp_f<0x114, 0xF, true>(v); v += dpp_f<0x118, 0xF, true>(v);
    v += dpp_f<0x142, 0xA>(v); v += dpp_f<0x143, 0xC>(v);
    return v;
}

namespace pg8 {
constexpr int BM = 256, BK = 64, HALF = 128, HTB = HALF * BK * 2, STAGE_BYTES = 8 * HTB, NXCD = 8, WGM = 8;
__host__ __device__ __forceinline__ int lds_byte(int r, int c) { const int st = (r >> 4) * 2 + (c >> 5), rr = r & 15, cc = c & 31, ob = rr * 64 + cc * 2; return st * 1024 + (ob ^ (((ob >> 9) & 1) << 5)); }
__host__ __device__ __forceinline__ void stage_rc(int b, int& R, int& C) { const int st = b / 1024, sb = b % 1024, swz = sb ^ (((sb >> 9) & 1) << 5); R = (st >> 1) * 16 + swz / 64; C = (st & 1) * 32 + (swz % 64) / 2; }
__host__ __device__ __forceinline__ int perm32(int rho) { const int n = rho >> 4, i = rho & 15; return 8 * (i >> 2) + 4 * n + (i & 3); }

struct Unit { int pm, pn; long bofs; };
struct Gemm { const bf16_t* A; const bf16_t* Bt; int K; };

__device__ __forceinline__ unsigned cvt_pk_bf16(float lo, float hi) { return pk2(lo, hi); }
__device__ __forceinline__ unsigned cvt_pk_bf16_pin(float lo, float hi) { unsigned r; asm volatile("v_cvt_pk_bf16_f32 %0, %1, %2" : "=v"(r) : "v"(lo), "v"(hi)); return r; }

__device__ __forceinline__ bool static_tile(int i, int G, int c, int nM, int nN, int& pm, int& pn, int rep = 1) {
    const int nwg = nM * nN;
#if REP_GEMM > 1
    { const int cnt = (nwg - c + G - 1) / G; if (cnt <= 0 || i >= rep * cnt) return false; i %= cnt; }
#endif
    const long L = (long)i * G + c; if (L >= nwg) return false;
    int wgid = (int)L; { const int q = nwg / NXCD, r = nwg % NXCD, xcd = wgid % NXCD, off = wgid / NXCD; wgid = (xcd < r ? xcd * (q + 1) : r * (q + 1) + (xcd - r) * q) + off; }
    const int nig = WGM * nN, gid = wgid / nig, fm = gid * WGM, gsz = (nM - fm) < WGM ? (nM - fm) : WGM;
    pm = fm + ((wgid % nig) % gsz); pn = (wgid % nig) / gsz; return true;
}
struct DenseOrder {
    int nM, nN, G, c, K, rep;
    __device__ __forceinline__ void init(int M, int N, int K_, int G_, int c_, int rep_ = 1) { nM = M / BM; nN = N / BM; G = G_; c = c_; K = K_; rep = rep_; }
    __device__ __forceinline__ bool next(int i, Unit& u) const { if (!static_tile(i, G, c, nM, nN, u.pm, u.pn, rep)) return false; u.bofs = (long)u.pn * BM * K * 2; return true; }
    static constexpr bool GATHER = false;
    __device__ __forceinline__ long a_base(const Unit& u) const { return (long)u.pm * BM * K * 2; }
    __device__ __forceinline__ void a_offs(int, const Unit&, int, unsigned (&)[2][2]) const {}
};
template <bool GATHER_> struct MoeOrder {
    int nM, nN, G, c, K; int ts[9]; long estride; const LAS unsigned short* rowoff; unsigned rowbytes;
    __device__ __forceinline__ int expert_of(int pm) const { int e = 0;
#pragma unroll
        for (int j = 1; j < 8; ++j) e += (pm >= ts[j]) ? 1 : 0; return e; }
    __device__ __forceinline__ bool next(int i, Unit& u) const { if (!static_tile(i, G, c, nM, nN, u.pm, u.pn, REP_GEMM)) return false; u.bofs = (long)expert_of(u.pm) * estride + (long)u.pn * BM * K * 2; return true; }
    static constexpr bool GATHER = GATHER_;
    __device__ __forceinline__ long a_base(const Unit& u) const { return GATHER_ ? 0l : (long)u.pm * BM * K * 2; }
    __device__ __forceinline__ void a_offs(int ui, const Unit&, int tid, unsigned (&o)[2][2]) const {
        int uix = ui;
#if REP_GEMM > 1
        { const int cnt = (nM * nN - c + G - 1) / G; uix = ui % cnt; }
#endif
        if (GATHER_) {
#pragma unroll
            for (int i = 0; i < 2; ++i) { int R, C; stage_rc(tid * 16 + i * 8192, R, C);
#pragma unroll
                for (int h = 0; h < 2; ++h) o[h][i] = (unsigned)rowoff[uix * 256 + h * HALF + R] * rowbytes + (unsigned)(C * 2); }
        }
    }
};

struct EpiBf16 {
    static constexpr bool PERM = true;
    bf16_t* O; int ldc;
    __device__ __forceinline__ void operator()(const f32x4 (&acc)[2][2][4][2], const Unit& u, int wr, int wc, int fr, int fq) const {
        const int row0 = u.pm * BM + wr * 64 + fr; const int col0 = u.pn * BM + wc * 32 + 8 * fq;
#pragma unroll
        for (int ai = 0; ai < 2; ++ai)
#pragma unroll
            for (int m = 0; m < 4; ++m) { bf16_t* rowp = O + (size_t)(row0 + ai * HALF + m * 16) * ldc + col0;
#pragma unroll
                for (int bj = 0; bj < 2; ++bj) { const f32x4 v0 = acc[ai][bj][m][0], v1 = acc[ai][bj][m][1];
                    u32x4 w; w.x = cvt_pk_bf16(v0[0], v0[1]); w.y = cvt_pk_bf16(v0[2], v0[3]); w.z = cvt_pk_bf16(v1[0], v1[1]); w.w = cvt_pk_bf16(v1[2], v1[3]);
                    *(u32x4*)(rowp + bj * HALF) = w; } }
    }
};
struct EpiSwiGLU {
    static constexpr bool PERM = true;
    bf16_t* O; int ldc;
    __device__ __forceinline__ void operator()(const f32x4 (&acc)[2][2][4][2], const Unit& u, int wr, int wc, int fr, int fq) const {
        const int row0 = u.pm * BM + wr * 64 + fr; const int col0 = u.pn * HALF + wc * 32 + 8 * fq;
#pragma unroll
        for (int ai = 0; ai < 2; ++ai)
#pragma unroll
            for (int m = 0; m < 4; ++m) { bf16_t* rowp = O + (size_t)(row0 + ai * HALF + m * 16) * ldc + col0;
                float h[8];
#pragma unroll
                for (int n = 0; n < 2; ++n)
#pragma unroll
                    for (int j = 0; j < 4; ++j) { const float gp = acc[ai][0][m][n][j], up = acc[ai][1][m][n][j];
                        h[n * 4 + j] = (gp * up) * __builtin_amdgcn_rcpf(__builtin_fmaf(__builtin_amdgcn_exp2f(gp), GATE_PRESCALE, GATE_PRESCALE)); }
                u32x4 w; w.x = cvt_pk_bf16(h[0], h[1]); w.y = cvt_pk_bf16(h[2], h[3]); w.z = cvt_pk_bf16(h[4], h[5]); w.w = cvt_pk_bf16(h[6], h[7]);
                *(u32x4*)rowp = w; }
    }
};
struct EpiSwiGLU8 {
    static constexpr bool PERM = true;
    unsigned char* O; int ldc;
    __device__ __forceinline__ void operator()(const f32x4 (&acc)[2][2][4][2], const Unit& u, int wr, int wc, int fr, int fq) const {
        const int row0 = u.pm * BM + wr * 64 + fr; const int col0 = u.pn * HALF + wc * 32 + 8 * fq;
#pragma unroll
        for (int ai = 0; ai < 2; ++ai)
#pragma unroll
            for (int m = 0; m < 4; ++m) { unsigned char* rowp = O + (size_t)(row0 + ai * HALF + m * 16) * ldc + col0;
                float h[8];
#pragma unroll
                for (int n = 0; n < 2; ++n)
#pragma unroll
                    for (int j = 0; j < 4; ++j) { const float gp = acc[ai][0][m][n][j], up = acc[ai][1][m][n][j];
                        constexpr float C8 = GATE_PRESCALE / (float)(1 << S8_HID); h[n * 4 + j] = (gp * up) * __builtin_amdgcn_rcpf((__builtin_amdgcn_exp2f(gp) + 1.0f) * C8); }
                u32x2 w; w.x = pk8(h[0], h[1], h[2], h[3]); w.y = pk8(h[4], h[5], h[6], h[7]);
                *(u32x2*)rowp = w; }
    }
};
struct EpiGate {
    static constexpr bool PERM = true;
    bf16_t* O; const float* mod; int gate_off;
    __device__ __forceinline__ void operator()(const f32x4 (&acc)[2][2][4][2], const Unit& u, int wr, int wc, int fr, int fq) const {
        const int rt = u.pm * BM; const int bi = rt >= NLAT ? 16 : (rt >> 11);
        const int col0 = u.pn * BM + wc * 32 + 8 * fq; const float* gt = mod + bi * MODW + gate_off + col0;
        f32x4 gv[2][2];
#pragma unroll
        for (int bj = 0; bj < 2; ++bj)
#pragma unroll
            for (int n = 0; n < 2; ++n) gv[bj][n] = *(const f32x4*)(gt + bj * HALF + 4 * n) + 1.0f;
        const int row0 = rt + wr * 64 + fr;
#pragma unroll
        for (int ai = 0; ai < 2; ++ai)
#pragma unroll
            for (int m = 0; m < 4; ++m) { bf16_t* rowp = O + (size_t)(row0 + ai * HALF + m * 16) * D + col0;
#pragma unroll
                for (int bj = 0; bj < 2; ++bj) { const f32x4 v0 = acc[ai][bj][m][0] * gv[bj][0], v1 = acc[ai][bj][m][1] * gv[bj][1];
                    u32x4 w; w.x = cvt_pk_bf16(v0[0], v0[1]); w.y = cvt_pk_bf16(v0[2], v0[3]); w.z = cvt_pk_bf16(v1[0], v1[1]); w.w = cvt_pk_bf16(v1[2], v1[3]);
                    *(u32x4*)(rowp + bj * HALF) = w; } }
    }
};

template <class Epi, class Sched, bool ALIGN_EPI, bool SP2, bool FP8 = false>
__device__ __forceinline__ void gemm_phase(LAS unsigned char* lds, const Gemm g, const Sched& S, const Epi& E, int tid_in, int sw = 0x7f7f7f7f, int sa = 0x7f7f7f7f) {
    int tid_ = tid_in; asm volatile("" : "+v"(tid_));
    const int tid = tid_, wid = __builtin_amdgcn_readfirstlane(tid >> 6), lane = tid & 63, wr = wid >> 2, wc = wid & 3, fr = lane & 15, fq = lane >> 4;
    const int K = g.K, nt = K / BK;
    constexpr bool GA = Sched::GATHER;
    unsigned voffA[2], voffB[2];
#pragma unroll
    for (int i = 0; i < 2; ++i) { int R, C; stage_rc(tid * 16 + i * 8192, R, C); const int Rb = Epi::PERM ? ((R & ~31) + perm32(R & 31)) : R;
        voffA[i] = (unsigned)(R * K + C) * 2u; voffB[i] = (unsigned)(Rb * K + C) * 2u; }
    const size_t kstep = (size_t)(BK * 2);
    const size_t hstep = (size_t)HALF * K * 2;
    const unsigned ldsw = (unsigned)wid * 1024u;
    const int aoff = lds_byte(wr * 64 + fr, fq * 8), boff = lds_byte(wc * 32 + fr, fq * 8);
#define PG8_SA(b, h) (((b) * 2 + (h)) * HTB)
#define PG8_SB(b, h) ((4 + (b) * 2 + (h)) * HTB)
#define PG8_STAGE(bufoff, gbase, voff) do { _Pragma("unroll") for (int _i = 0; _i < 2; ++_i) \
        __builtin_amdgcn_global_load_lds((const unsigned*)((const char*)(gbase) + (voff)[_i]), (LAS unsigned*)(lds + (bufoff) + ldsw + _i * 8192), 16, 0, 0); } while (0)
#define PG8_LDA(dst, b, h) do { _Pragma("unroll") for (int m = 0; m < 4; ++m) _Pragma("unroll") for (int k = 0; k < 2; ++k) dst[m][k] = *(const LAS bf16x8*)(lds + PG8_SA(b, h) + aoff + m * 2048 + k * 1024); } while (0)
#define PG8_LDB(dst, b, h) do { _Pragma("unroll") for (int n = 0; n < 2; ++n) _Pragma("unroll") for (int k = 0; k < 2; ++k) dst[n][k] = *(const LAS bf16x8*)(lds + PG8_SB(b, h) + boff + n * 2048 + k * 1024); } while (0)
#define PG8_CAT(x) __builtin_shufflevector(__builtin_bit_cast(i32x4, (x)[0]), __builtin_bit_cast(i32x4, (x)[1]), 0, 1, 2, 3, 4, 5, 6, 7)
#define PG8_MMA(ai, bj, At, Bt) do { __builtin_amdgcn_s_setprio(1); _Pragma("unroll") for (int m = 0; m < 4; ++m) _Pragma("unroll") for (int n = 0; n < 2; ++n) { \
        if constexpr (FP8) { const i32x8 a8_ = PG8_CAT(Bt[n]), b8_ = PG8_CAT(At[m]); \
            asm volatile("v_mfma_scale_f32_16x16x128_f8f6f4 %0, %1, %2, %0, %3, %4 op_sel_hi:[0,0,0]" : "+v"(acc[ai][bj][m][n]) : "v"(a8_), "v"(b8_), "v"(sw), "v"(sa)); } \
        else { _Pragma("unroll") for (int k = 0; k < 2; ++k) acc[ai][bj][m][n] = __builtin_amdgcn_mfma_f32_16x16x32_bf16(Bt[n][k], At[m][k], acc[ai][bj][m][n], 0, 0, 0); } } \
        __builtin_amdgcn_s_setprio(0); } while (0)
#define PG8_WAIT_V(n) asm volatile("s_waitcnt vmcnt(" #n ")" ::: "memory")
#define PG8_WAIT_L(n) asm volatile("s_waitcnt lgkmcnt(" #n ")" ::: "memory")
#define PG8_BAR __builtin_amdgcn_s_barrier()
#define PG8_SCHED __builtin_amdgcn_sched_barrier(0)
    Unit cur, nxt; int ui = 0;
    if (!S.next(0, cur)) return;
    f32x4 acc[2][2][4][2];
#pragma unroll
    for (int a = 0; a < 2; ++a)
#pragma unroll
        for (int b = 0; b < 2; ++b)
#pragma unroll
            for (int m = 0; m < 4; ++m)
#pragma unroll
                for (int n = 0; n < 2; ++n) acc[a][b][m][n] = (f32x4){0.f, 0.f, 0.f, 0.f};
    bf16x8 At[4][2], B0[2][2], B1[2][2];
    const char* Ab = (const char*)g.A + S.a_base(cur);
    unsigned oc[2][2];
    S.a_offs(0, cur, tid, oc);
    const size_t hsA = GA ? (size_t)0 : hstep;
#define PG8_STAGE_A(bufoff, gbase, h) do { if constexpr (GA) PG8_STAGE(bufoff, gbase, oc[h]); else PG8_STAGE(bufoff, (gbase) + (h) * hsA, voffA); } while (0)
    const char* cB = (const char*)g.Bt + cur.bofs;
    if constexpr (SP2) {
        PG8_STAGE(PG8_SB(0, 0), cB, voffB); PG8_STAGE(PG8_SB(0, 1), cB + hstep, voffB); PG8_STAGE_A(PG8_SA(0, 0), Ab, 0); PG8_STAGE_A(PG8_SA(0, 1), Ab, 1);
        if (wr == 1) PG8_BAR;
        PG8_WAIT_V(2); PG8_BAR;
        PG8_STAGE(PG8_SB(1, 0), cB + kstep, voffB); PG8_STAGE_A(PG8_SA(1, 0), Ab + kstep, 0); PG8_STAGE(PG8_SB(1, 1), cB + hstep + kstep, voffB);
        PG8_WAIT_V(6); PG8_BAR;
    } else {
        PG8_STAGE(PG8_SB(0, 0), cB, voffB); PG8_STAGE_A(PG8_SA(0, 0), Ab, 0); PG8_STAGE(PG8_SB(0, 1), cB + hstep, voffB); PG8_STAGE_A(PG8_SA(0, 1), Ab, 1);
        if (wr == 1) PG8_BAR;
        PG8_WAIT_V(4); PG8_BAR;
        PG8_STAGE(PG8_SB(1, 0), cB + kstep, voffB); PG8_STAGE_A(PG8_SA(1, 0), Ab + kstep, 0); PG8_STAGE(PG8_SB(1, 1), cB + hstep + kstep, voffB);
        PG8_WAIT_V(6); PG8_BAR;
    }
    for (;;) {
        const bool has_next = S.next(ui + 1, nxt);
        const char* nB = has_next ? (const char*)g.Bt + nxt.bofs : cB;
        for (int t = 0; t < nt; t += 2) {
            const bool last = (t == nt - 2);
            const char* a1 = Ab + (size_t)(t + 1) * kstep;
            const char* b2 = last ? nB : cB + (size_t)(t + 2) * kstep; const char* b3 = b2 + kstep;
            if constexpr (SP2) {
            PG8_LDB(B0, 0, 0); PG8_LDB(B1, 0, 1); PG8_SCHED; PG8_LDA(At, 0, 0); PG8_STAGE_A(PG8_SA(1, 1), a1, 1);
            if (last && has_next) { S.a_offs(ui + 1, nxt, tid, oc); Ab = (const char*)g.A + S.a_base(nxt); }
            const char* a2 = last ? Ab : Ab + (size_t)(t + 2) * kstep; const char* a3 = a2 + kstep;
            PG8_WAIT_V(8); PG8_WAIT_L(0); PG8_BAR; PG8_MMA(0, 0, At, B0); PG8_MMA(0, 1, At, B1); PG8_BAR; PG8_SCHED;
            PG8_LDA(At, 0, 1); PG8_STAGE(PG8_SB(0, 0), b2, voffB); PG8_STAGE(PG8_SB(0, 1), b2 + hstep, voffB); PG8_STAGE_A(PG8_SA(0, 0), a2, 0);
            PG8_WAIT_V(8); PG8_WAIT_L(0); PG8_BAR; PG8_MMA(1, 0, At, B0); PG8_MMA(1, 1, At, B1); PG8_BAR; PG8_SCHED;
            PG8_LDB(B0, 1, 0); PG8_LDB(B1, 1, 1); PG8_SCHED; PG8_LDA(At, 1, 0); PG8_STAGE_A(PG8_SA(0, 1), a2, 1);
            PG8_WAIT_V(8); PG8_WAIT_L(0); PG8_BAR; PG8_MMA(0, 0, At, B0); PG8_MMA(0, 1, At, B1); PG8_BAR; PG8_SCHED;
            PG8_LDA(At, 1, 1); PG8_STAGE(PG8_SB(1, 0), b3, voffB); PG8_STAGE(PG8_SB(1, 1), b3 + hstep, voffB); PG8_STAGE_A(PG8_SA(1, 0), a3, 0);
            PG8_WAIT_V(8); PG8_WAIT_L(0); PG8_BAR; PG8_MMA(1, 0, At, B0); PG8_MMA(1, 1, At, B1); PG8_BAR; PG8_SCHED;
            } else {
            PG8_LDB(B0, 0, 0); PG8_SCHED; PG8_LDA(At, 0, 0); PG8_STAGE_A(PG8_SA(1, 1), a1, 1);
            if (last && has_next) { S.a_offs(ui + 1, nxt, tid, oc); Ab = (const char*)g.A + S.a_base(nxt); }
            const char* a2 = last ? Ab : Ab + (size_t)(t + 2) * kstep; const char* a3 = a2 + kstep;
            PG8_WAIT_L(8); PG8_BAR; PG8_WAIT_L(0); PG8_MMA(0, 0, At, B0); PG8_BAR; PG8_SCHED;
            PG8_LDB(B1, 0, 1); PG8_STAGE(PG8_SB(0, 0), b2, voffB);
            PG8_BAR; PG8_WAIT_L(0); PG8_MMA(0, 1, At, B1); PG8_BAR;
            PG8_LDA(At, 0, 1); PG8_STAGE_A(PG8_SA(0, 0), a2, 0);
            PG8_BAR; PG8_WAIT_L(0); PG8_MMA(1, 0, At, B0); PG8_BAR; PG8_SCHED;
            PG8_STAGE(PG8_SB(0, 1), b2 + hstep, voffB);
            PG8_WAIT_V(6); PG8_BAR; PG8_MMA(1, 1, At, B1); PG8_BAR;
            PG8_LDB(B0, 1, 0); PG8_SCHED; PG8_LDA(At, 1, 0); PG8_STAGE_A(PG8_SA(0, 1), a2, 1);
            PG8_WAIT_L(8); PG8_BAR; PG8_WAIT_L(0); PG8_MMA(0, 0, At, B0); PG8_BAR; PG8_SCHED;
            PG8_LDB(B1, 1, 1); PG8_STAGE(PG8_SB(1, 0), b3, voffB);
            PG8_BAR; PG8_WAIT_L(0); PG8_MMA(0, 1, At, B1); PG8_BAR;
            PG8_LDA(At, 1, 1); PG8_STAGE_A(PG8_SA(1, 0), a3, 0);
            PG8_BAR; PG8_WAIT_L(0); PG8_MMA(1, 0, At, B0); PG8_BAR; PG8_SCHED;
            PG8_STAGE(PG8_SB(1, 1), b3 + hstep, voffB);
            PG8_WAIT_V(6); PG8_BAR; PG8_MMA(1, 1, At, B1); PG8_BAR;
            }
        }
        if constexpr (ALIGN_EPI) { if (wr == 0) PG8_BAR; }
        if constexpr (FP8) asm volatile("s_nop 15\n\ts_nop 15\n\ts_nop 15" ::: "memory");
        E(acc, cur, wr, wc, fr, fq);
        if (!has_next) break;
#pragma unroll
        for (int a = 0; a < 2; ++a)
#pragma unroll
            for (int b = 0; b < 2; ++b)
#pragma unroll
                for (int m = 0; m < 4; ++m)
#pragma unroll
                    for (int n = 0; n < 2; ++n) acc[a][b][m][n] = (f32x4){0.f, 0.f, 0.f, 0.f};
        cur = nxt; cB = nB; ++ui;
        if constexpr (ALIGN_EPI) { if (wr == 1) PG8_BAR; }
    }
    PG8_WAIT_V(0);
    if constexpr (!ALIGN_EPI) { if (wr == 0) PG8_BAR; }
    PG8_BAR;
#undef PG8_SA
#undef PG8_SB
#undef PG8_STAGE
#undef PG8_STAGE_A
#undef PG8_LDA
#undef PG8_LDB
#undef PG8_MMA
#undef PG8_CAT
#undef PG8_WAIT_V
#undef PG8_WAIT_L
#undef PG8_BAR
#undef PG8_SCHED
}
}

#define XB_TMO      128
#define XB_XCNT(j)  (256  + 64 * (j))
#define XB_XSUB(j)  (1280 + 64 * (j))
#define XB_XGEN(j)  (2304 + 64 * (j))
#define XB_TOP      3328
#define XB_TOPGEN   3392
#define XCD_BAR_WORDS 3456
#define XB_SPIN_CAP (1u << 18)
__device__ __forceinline__ unsigned xb_ld(unsigned* p)              { return __hip_atomic_load(p, __ATOMIC_RELAXED, __HIP_MEMORY_SCOPE_AGENT); }
__device__ __forceinline__ unsigned xb_add(unsigned* p, unsigned v) { return __hip_atomic_fetch_add(p, v, __ATOMIC_RELAXED, __HIP_MEMORY_SCOPE_AGENT); }
__device__ __forceinline__ unsigned xb_xcc_id() { return (unsigned)__builtin_amdgcn_s_getreg((3 << 11) | 20) & 0xFu; }
#define XB_SPIN(cond, bar) do { unsigned _sp = 0; while (cond) { __builtin_amdgcn_s_sleep(1); \
    if ((++_sp & 255u) == 0u) { if (xb_ld(&(bar)[XB_TMO])) break; if (_sp > XB_SPIN_CAP) { atomicAdd(&(bar)[XB_TMO], 1u); break; } } } } while (0)
struct XcdBarrier { unsigned* bar; unsigned x; volatile LAS unsigned* st; };
__device__ __forceinline__ XcdBarrier xcd_barrier_post(unsigned* bar, volatile LAS unsigned* st) {
    XcdBarrier b; b.bar = bar; b.x = xb_xcc_id(); b.st = st;
    if (threadIdx.x == 0) (void)xb_add(&bar[XB_XCNT(b.x)], 1u);
    return b;
}
__device__ __forceinline__ void xcd_barrier_complete(unsigned* bar, unsigned x, unsigned& nloc, unsigned& nx) {
    const unsigned G = gridDim.x * gridDim.y * gridDim.z;
    unsigned sum, cnt, mine, sp = 0u;
    for (;;) {
        sum = 0u; cnt = 0u; mine = 0u;
#pragma unroll
        for (unsigned j = 0; j < 16; ++j) { const unsigned c = xb_ld(&bar[XB_XCNT(j)]); sum += c; cnt += (c > 0u) ? 1u : 0u; }
        mine = xb_ld(&bar[XB_XCNT(x)]);
        if (sum == G) break;
        __builtin_amdgcn_s_sleep(1);
        if ((++sp & 255u) == 0u) { if (xb_ld(&bar[XB_TMO])) break; if (sp > XB_SPIN_CAP) { atomicAdd(&bar[XB_TMO], 1u); break; } }
    }
    nloc = mine > 0u ? mine : 1u; nx = cnt > 0u ? cnt : 1u;
}
__device__ __forceinline__ void xcd_barrier(const XcdBarrier& b, bool leader) {
    asm volatile("s_waitcnt vmcnt(0)" ::: "memory");
    __syncthreads();
    if (leader) {
        unsigned* bar = b.bar;
        __builtin_amdgcn_s_waitcnt(0);
        unsigned nloc = b.st[0], nx = b.st[1];
        if (nloc == 0u) { xcd_barrier_complete(bar, b.x, nloc, nx); b.st[0] = nloc; b.st[1] = nx; }
        const unsigned old = xb_add(&bar[XB_XSUB(b.x)], 1u);
        const unsigned gen = old / nloc;
        if (old + 1u == (gen + 1u) * nloc) {
            __builtin_amdgcn_fence(__ATOMIC_RELEASE, "agent");
            asm volatile("s_waitcnt vmcnt(0)" ::: "memory");
            const unsigned og = xb_add(&bar[XB_TOP], 1u);
            const unsigned tg = og / nx;
            if (og + 1u == (tg + 1u) * nx) xb_add(&bar[XB_TOPGEN], 1u);
            else XB_SPIN(xb_ld(&bar[XB_TOPGEN]) == tg, bar);
            __builtin_amdgcn_fence(__ATOMIC_ACQUIRE, "agent");
            xb_add(&bar[XB_XGEN(b.x)], 1u);
            asm volatile("s_waitcnt vmcnt(0)" ::: "memory");
        } else {
            XB_SPIN(xb_ld(&bar[XB_XGEN(b.x)]) == gen, bar);
            __builtin_amdgcn_fence(__ATOMIC_ACQUIRE, "agent");
            asm volatile("s_waitcnt vmcnt(0)" ::: "memory");
        }
    }
    __syncthreads();
}

constexpr int NT = 512, NWAVES = 8;
struct Args { const float* in[24]; float* out; unsigned char* ws; int ph_lo, ph_hi; };
enum { I_X = 0, I_C, I_CTX, I_CCTX, I_WMOD, I_BMOD, I_WIN, I_WOUT, I_RPB, I_CONVW, I_CONVB, I_DTB, I_ALOG, I_DSKIP, I_NORMW, I_LNG, I_LNB, I_FG, I_FU, I_FD, I_RW, I_MG, I_MU, I_MD };
struct Frame {
    LAS unsigned char* lds;
    const float* const* in; float* out; unsigned char* ws;
    int tid, lane, wave, bid, G, gw, NGW;
};
#define LDS_WAIT() asm volatile("s_waitcnt lgkmcnt(0)" ::: "memory")
__device__ __forceinline__ Frame fresh(const Frame& F0) {
    Frame F = F0; int z; asm volatile("s_mov_b32 %0, 0" : "=s"(z)); F.ws = F0.ws + z; F.in = F0.in + z; F.out = F0.out + z;
    int ln; asm volatile("v_mbcnt_lo_u32_b32 %0, -1, 0\n\tv_mbcnt_hi_u32_b32 %0, -1, %0" : "=v"(ln));     int t = F0.wave * 64 + ln;
    F.tid = t; F.lane = t & 63; return F;
}

__device__ __forceinline__ void conv_item(const float* W, int ldn, int k0, int n0, bf16_t* dst, int K, int drow0, float scale, LAS float* scr, int lane) {
    f32x4 ld[8];
#pragma unroll
    for (int i = 0; i < 8; ++i) ld[i] = *(const f32x4*)(W + (size_t)(k0 + 8 * i + (lane >> 3)) * ldn + n0 + 4 * (lane & 7));
#pragma unroll
    for (int i = 0; i < 8; ++i) { LAS float* d = scr + (8 * i + (lane >> 3)) * 33 + 4 * (lane & 7); d[0] = ld[i][0] * scale; d[1] = ld[i][1] * scale; d[2] = ld[i][2] * scale; d[3] = ld[i][3] * scale; }
    LDS_WAIT(); asm volatile("" ::: "memory");
    const int c = lane & 7;
#pragma unroll
    for (int j = 0; j < 4; ++j) { const int n = (lane >> 3) + 8 * j; const LAS float* s = scr + (8 * c) * 33 + n;
        u32x4 o; o.x = pk2(s[0 * 33], s[1 * 33]); o.y = pk2(s[2 * 33], s[3 * 33]); o.z = pk2(s[4 * 33], s[5 * 33]); o.w = pk2(s[6 * 33], s[7 * 33]);
        *(u32x4*)(dst + (size_t)(drow0 + n) * K + k0 + 8 * c) = o; }
    LDS_WAIT(); asm volatile("" ::: "memory");
}
__device__ __forceinline__ void conv_item8(const float* W, int ldn, int k0, int n0, unsigned char* dst, int K, int drow0, float scale, LAS float* scr, int lane) {
    f32x4 ld[8];
#pragma unroll
    for (int i = 0; i < 8; ++i) ld[i] = *(const f32x4*)(W + (size_t)(k0 + 8 * i + (lane >> 3)) * ldn + n0 + 4 * (lane & 7));
#pragma unroll
    for (int i = 0; i < 8; ++i) { LAS float* d = scr + (8 * i + (lane >> 3)) * 33 + 4 * (lane & 7); d[0] = ld[i][0] * scale; d[1] = ld[i][1] * scale; d[2] = ld[i][2] * scale; d[3] = ld[i][3] * scale; }
    LDS_WAIT(); asm volatile("" ::: "memory");
    const int c = lane & 7;
#pragma unroll
    for (int j = 0; j < 4; ++j) { const int n = (lane >> 3) + 8 * j; const LAS float* sp = scr + (8 * c) * 33 + n;
        u32x2 o; o.x = pk8(sp[0 * 33], sp[1 * 33], sp[2 * 33], sp[3 * 33]); o.y = pk8(sp[4 * 33], sp[5 * 33], sp[6 * 33], sp[7 * 33]);
        *(u32x2*)(dst + (size_t)(drow0 + n) * K + k0 + 8 * c) = o; }
    LDS_WAIT(); asm volatile("" ::: "memory");
}
__device__ __forceinline__ void conv_seg(const Frame& F, const float* W, int K, int ldn, int ncols, bf16_t* dst, int mode, int& rot, int s8 = -1) {
    LAS float* scr = (LAS float*)(F.lds + F.wave * 16384);
    const int nblk = ncols / 32, nitems = (K / 64) * nblk;
    int start = F.gw - rot; if (start < 0) start += F.NGW;
    for (int it = start; it < nitems; it += F.NGW) {
        const int kb = it / nblk, nb = it % nblk, n0 = nb * 32;
        const int drow0 = (mode == 0) ? n0 : ((n0 >> 7) * 256 + (n0 & 127) + (mode == 2 ? 128 : 0));
        const float gs = (mode == 1) ? GATE_PRESCALE : 1.0f;
        if (s8 >= 0) conv_item8(W, ldn, kb * 64, n0, (unsigned char*)dst, K, drow0, (float)(1 << s8) * gs, scr, F.lane);
        else conv_item(W, ldn, kb * 64, n0, dst, K, drow0, gs, scr, F.lane);
    }
    rot = (rot + nitems) % F.NGW;
}
__device__ __forceinline__ void conv_moe(const Frame& F, int slot, int& rot) {
#if USE_FP8
    unsigned char* gu = F.ws + WS_WMGU + (size_t)slot * NEXP * 2 * DFFE * D; unsigned char* dn = F.ws + WS_WMD + (size_t)slot * NEXP * D * DFFE;
    for (int e = 0; e < NEXP; ++e) {
        const size_t so = ((size_t)slot * NEXP + e) * (size_t)D * DFFE;
        conv_seg(F, F.in[I_MG] + so, D, DFFE, DFFE, (bf16_t*)(gu + (size_t)e * 2 * DFFE * D), 1, rot, S8_WGU);
        conv_seg(F, F.in[I_MU] + so, D, DFFE, DFFE, (bf16_t*)(gu + (size_t)e * 2 * DFFE * D), 2, rot, S8_WGU);
        conv_seg(F, F.in[I_MD] + so, DFFE, D, D, (bf16_t*)(dn + (size_t)e * D * DFFE), 0, rot, S8_WD);
    }
#else
    bf16_t* gu = (bf16_t*)(F.ws + WS_WMGU); bf16_t* dn = (bf16_t*)(F.ws + WS_WMD);
    for (int e = 0; e < NEXP; ++e) {
        const size_t so = ((size_t)slot * NEXP + e) * (size_t)D * DFFE;
        conv_seg(F, F.in[I_MG] + so, D, DFFE, DFFE, gu + (size_t)e * 2 * DFFE * D, 1, rot);
        conv_seg(F, F.in[I_MU] + so, D, DFFE, DFFE, gu + (size_t)e * 2 * DFFE * D, 2, rot);
        conv_seg(F, F.in[I_MD] + so, DFFE, D, D, dn + (size_t)e * D * DFFE, 0, rot);
    }
#endif
}

constexpr int MOE_ITEMS_MAT = 1792, MOE_ITEMS_EXP = 3 * MOE_ITEMS_MAT, MOE_ITEMS_SLOT = 8 * MOE_ITEMS_EXP, MOE_ITEMS = 2 * MOE_ITEMS_SLOT;
__device__ __forceinline__ void conv_moe_item(const Frame& F, int gidx) {
    LAS float* scr = (LAS float*)(F.lds + F.wave * 16384);
    const int slot = gidx / MOE_ITEMS_SLOT, r = gidx % MOE_ITEMS_SLOT, e = r / MOE_ITEMS_EXP, r2 = r % MOE_ITEMS_EXP, mat = r2 / MOE_ITEMS_MAT, it = r2 % MOE_ITEMS_MAT;
    const size_t so = ((size_t)slot * NEXP + e) * (size_t)D * DFFE;
    if (mat < 2) { const int kb = it / 112, nb = it % 112, n0 = nb * 32; const int drow0 = (n0 >> 7) * 256 + (n0 & 127) + (mat == 1 ? 128 : 0);
        conv_item8((mat ? F.in[I_MU] : F.in[I_MG]) + so, DFFE, kb * 64, n0, F.ws + WS_WMGU + ((size_t)slot * NEXP + e) * 2 * DFFE * D, D, drow0, (float)(1 << S8_WGU) * (mat ? 1.0f : GATE_PRESCALE), scr, F.lane); }
    else { const int kb = it / 32, nb = it % 32, n0 = nb * 32;
        conv_item8(F.in[I_MD] + so, D, kb * 64, n0, F.ws + WS_WMD + ((size_t)slot * NEXP + e) * D * DFFE, DFFE, n0, (float)(1 << S8_WD), scr, F.lane); }
}
__device__ __forceinline__ void deferred_conv(const Frame& F, int nwg, int base, int quota) {
    if (F.G != 256) return;
    const int maxu = (nwg + F.G - 1) / F.G, c0 = nwg - (maxu - 1) * F.G;
    if (c0 >= F.G || F.bid < c0) return;
    const int first = base + ((F.bid - c0) * NWAVES + F.wave) * quota;
    for (int j = 0; j < quota; ++j) { const int gidx = first + j; if (gidx < MOE_ITEMS) conv_moe_item(F, gidx); }
}
constexpr int DW_Q = 12, DW_Q2 = 10;
constexpr int DW_L0_IN = 0, DW_L0_OUT = DW_L0_IN + 64 * 8 * DW_Q, DW_L0_F1 = DW_L0_OUT + 192 * 8 * DW_Q, DW_L0_F2 = DW_L0_F1 + 160 * 8 * DW_Q, DW_L1_IN = DW_L0_F2 + 192 * 8 * DW_Q2, DW_L1_OUT = DW_L1_IN + 64 * 8 * DW_Q, DW_L2_IN = DW_L1_OUT + 192 * 8 * DW_Q, DW_END = DW_L2_IN + 64 * 8 * DW_Q;
static_assert(DW_L1_IN >= MOE_ITEMS_SLOT && DW_END >= MOE_ITEMS, "deferred conversion: layer-1 experts must be done before layer 1's FFN, all before layer 3's");
__device__ __forceinline__ void p_pro_a(const Frame& F) {
    {
        LAS float* sc = (LAS float*)F.lds; LAS float* red = sc + 17 * 1024;
        const float* c = F.in[I_C]; const float* cc = F.in[I_CCTX];
        for (int i = F.tid; i < 17 * 1024; i += NT) { const int r = i >> 10, k = i & 1023; const float v = (r < 16) ? c[r * 1024 + k] : cc[k]; sc[i] = silu_f(v); }
        __syncthreads();
        float* MOD = (float*)(F.ws + WS_MOD);
        const int col = F.tid & 31, ks = F.tid >> 5;
        for (int u = F.bid; u < 4 * 192; u += F.G) {
            const int l = u / 192, cb = u % 192;
            const float* W = F.in[I_WMOD] + (size_t)l * D * MODW + cb * 32 + col;
            float acc[17];
#pragma unroll
            for (int r = 0; r < 17; ++r) acc[r] = 0.f;
#pragma unroll 1
            for (int kb = 0; kb < 4; ++kb) { float w[16];
#pragma unroll
                for (int i = 0; i < 16; ++i) w[i] = W[(size_t)(ks * 64 + kb * 16 + i) * MODW];
#pragma unroll
                for (int i = 0; i < 16; ++i) { const int k = ks * 64 + kb * 16 + i;
#pragma unroll
                    for (int r = 0; r < 17; ++r) acc[r] += sc[r * 1024 + k] * w[i]; } }
#pragma unroll
            for (int r = 0; r < 17; ++r) red[(ks * 17 + r) * 32 + col] = acc[r];
            __syncthreads();
            for (int i = F.tid; i < 17 * 32; i += NT) { const int r = i >> 5, c2 = i & 31; float sm = 0.f;
#pragma unroll
                for (int k2 = 0; k2 < 16; ++k2) sm += red[(k2 * 17 + r) * 32 + c2];
                MOD[(size_t)(l * 17 + r) * MODW + cb * 32 + c2] = sm + F.in[I_BMOD][l * MODW + cb * 32 + c2]; }
            __syncthreads();
        }
    }
    int rot = 0;
    for (int l = 0; l < DEPTH; ++l) {
#if USE_FP8 && FP8_INPROJ
        conv_seg(F, F.in[I_WIN] + (size_t)l * D * D_IN_PROJ, D, D_IN_PROJ, NPROJ, (bf16_t*)(F.ws + WS_WIN + (size_t)l * NPROJ * D), 0, rot, S8_WGU);
#else
        conv_seg(F, F.in[I_WIN] + (size_t)l * D * D_IN_PROJ, D, D_IN_PROJ, NPROJ, (bf16_t*)(F.ws + WS_WIN) + (size_t)l * NPROJ * D, 0, rot);
#endif
        conv_seg(F, F.in[I_WOUT] + (size_t)l * D * D, D, D, D, (bf16_t*)(F.ws + WS_WOUT) + (size_t)l * D * D, 0, rot);
    }
    for (int s = 0; s < 2; ++s) {
        if ((FP8_DENSE1_MASK >> s) & 1) {
            conv_seg(F, F.in[I_FG] + (size_t)s * D * DFF, D, DFF, DFF, (bf16_t*)(F.ws + WS_WFGU + (size_t)s * 2 * DFF * D * 2), 1, rot, S8_WGU);
            conv_seg(F, F.in[I_FU] + (size_t)s * D * DFF, D, DFF, DFF, (bf16_t*)(F.ws + WS_WFGU + (size_t)s * 2 * DFF * D * 2), 2, rot, S8_WGU);
        } else {
            conv_seg(F, F.in[I_FG] + (size_t)s * D * DFF, D, DFF, DFF, (bf16_t*)(F.ws + WS_WFGU) + (size_t)s * 2 * DFF * D, 1, rot);
            conv_seg(F, F.in[I_FU] + (size_t)s * D * DFF, D, DFF, DFF, (bf16_t*)(F.ws + WS_WFGU) + (size_t)s * 2 * DFF * D, 2, rot);
        }
#if USE_FP8 && FP8_DENSE2
        conv_seg(F, F.in[I_FD] + (size_t)s * DFF * D, DFF, D, D, (bf16_t*)(F.ws + WS_WFD + (size_t)s * D * DFF), 0, rot, S8_WD);
#else
        conv_seg(F, F.in[I_FD] + (size_t)s * DFF * D, DFF, D, D, (bf16_t*)(F.ws + WS_WFD) + (size_t)s * D * DFF, 0, rot);
#endif
    }
    if (F.G != 256) { conv_moe(F, 0, rot); conv_moe(F, 1, rot); }
    { bf16_t* wdt = (bf16_t*)(F.ws + WS_WDT);
      for (int i = F.bid * NT + F.tid; i < DEPTH * 16 * D; i += F.G * NT) { const int l = i / (16 * D), n = (i / D) & 15, k = i % D;
          wdt[i] = (bf16_t)f2bf(F.in[I_WIN][((size_t)l * D + k) * D_IN_PROJ + NPROJ + n]); } }
}

#define RIDX(q) (8 * lane + 512 * ((q) >> 1) + 4 * ((q) & 1))
__device__ __forceinline__ void row_load(const float* p, int lane, f32x4 (&v)[4]) {
#pragma unroll
    for (int q = 0; q < 4; ++q) v[q] = *(const f32x4*)(p + RIDX(q));
}
__device__ __forceinline__ void row_store(float* p, int lane, const f32x4 (&v)[4]) {
#pragma unroll
    for (int q = 0; q < 4; ++q) *(f32x4*)(p + RIDX(q)) = v[q];
}
__device__ __forceinline__ void row_mod_store8(unsigned char* hrow, int lane, const f32x4 (&v)[4], const float* sh, const float* sc, f32x4 (&hv)[4]) {
#pragma unroll
    for (int j = 0; j < 2; ++j) { u32x2 w;
#pragma unroll
        for (int h = 0; h < 2; ++h) { const int q = 2 * j + h; const f32x4 a = *(const f32x4*)(sc + RIDX(q)), b = *(const f32x4*)(sh + RIDX(q));
            hv[q] = v[q] * (a + 1.0f) + b; const f32x4 t = hv[q] * (float)(1 << S8_ACT); const unsigned pw = pk8(t[0], t[1], t[2], t[3]); if (h == 0) w.x = pw; else w.y = pw; }
        *(u32x2*)(hrow + 8 * lane + 512 * j) = w; }
}
__device__ __forceinline__ void row_load_h(const bf16_t* p, int lane, f32x4 (&v)[4]) {
#pragma unroll
    for (int j = 0; j < 2; ++j) { const u32x4 w = *(const u32x4*)(p + 8 * lane + 512 * j); v[2 * j] = (f32x4){bflo(w.x), bfhi(w.x), bflo(w.y), bfhi(w.y)}; v[2 * j + 1] = (f32x4){bflo(w.z), bfhi(w.z), bflo(w.w), bfhi(w.w)}; }
}
__device__ __forceinline__ void row_store_h(bf16_t* p, int lane, const f32x4 (&v)[4]) {
#pragma unroll
    for (int j = 0; j < 2; ++j) { u32x4 w; w.x = pk2(v[2 * j][0], v[2 * j][1]); w.y = pk2(v[2 * j][2], v[2 * j][3]); w.z = pk2(v[2 * j + 1][0], v[2 * j + 1][1]); w.w = pk2(v[2 * j + 1][2], v[2 * j + 1][3]);
        *(u32x4*)(p + 8 * lane + 512 * j) = w; }
}
__device__ __forceinline__ void row_mod_store(bf16_t* hrow, int lane, const f32x4 (&v)[4], const float* sh, const float* sc, f32x4 (&hv)[4]) {
#pragma unroll
    for (int q = 0; q < 4; ++q) { const f32x4 a = *(const f32x4*)(sc + RIDX(q)), b = *(const f32x4*)(sh + RIDX(q)); hv[q] = v[q] * (a + 1.0f) + b; }
    row_store_h(hrow, lane, hv);
}
__device__ __forceinline__ void row_ln(f32x4 (&v)[4], const float* g, const float* b, int lane) {
    float s = 0.f;
#pragma unroll
    for (int j = 0; j < 4; ++j) s += (v[j][0] + v[j][1]) + (v[j][2] + v[j][3]);
    const float mean = wave_sum(s) * (1.0f / D); float q2 = 0.f;
#pragma unroll
    for (int j = 0; j < 4; ++j) { v[j] = v[j] - mean; q2 += (v[j][0] * v[j][0] + v[j][1] * v[j][1]) + (v[j][2] * v[j][2] + v[j][3] * v[j][3]); }
    const float rstd = 1.0f / sqrtf(wave_sum(q2) * (1.0f / D) + LN_EPS);
#pragma unroll
    for (int q = 0; q < 4; ++q) { const f32x4 gg = *(const f32x4*)(g + RIDX(q)), bb = *(const f32x4*)(b + RIDX(q)); v[q] = v[q] * rstd * gg + bb; }
}
__device__ __forceinline__ int mod_row_of(int row) { return row < NLAT ? (row >> 11) : 16; }
__device__ __forceinline__ void col_load(const float* p, int lane, f32x4 (&c)[4], float add = 0.f) {
#pragma unroll
    for (int q = 0; q < 4; ++q) c[q] = *(const f32x4*)(p + RIDX(q)) + add;
}
__device__ __forceinline__ void row_ln_r(f32x4 (&v)[4], const f32x4 (&G)[4], const f32x4 (&B)[4]) {
    float s = 0.f;
#pragma unroll
    for (int j = 0; j < 4; ++j) s += (v[j][0] + v[j][1]) + (v[j][2] + v[j][3]);
    const float mean = wave_sum(s) * (1.0f / D); float q2 = 0.f;
#pragma unroll
    for (int j = 0; j < 4; ++j) { v[j] = v[j] - mean; q2 += (v[j][0] * v[j][0] + v[j][1] * v[j][1]) + (v[j][2] * v[j][2] + v[j][3] * v[j][3]); }
    const float rstd = 1.0f / sqrtf(wave_sum(q2) * (1.0f / D) + LN_EPS);
#pragma unroll
    for (int q = 0; q < 4; ++q) v[q] = v[q] * rstd * G[q] + B[q];
}
struct RowRaw { u32x4 x[2], d[2]; };
template <bool WITH_D> __device__ __forceinline__ void row_issue(const bf16_t* X, const bf16_t* Dl, int row, int lane, RowRaw& r) {
#pragma unroll
    for (int j = 0; j < 2; ++j) { r.x[j] = *(const u32x4*)(X + (size_t)row * D + 8 * lane + 512 * j); if (WITH_D) r.d[j] = *(const u32x4*)(Dl + (size_t)row * D + 8 * lane + 512 * j); }
}
__device__ __forceinline__ void unpack8(const u32x4 w, f32x4& lo, f32x4& hi) { lo = (f32x4){bflo(w.x), bfhi(w.x), bflo(w.y), bfhi(w.y)}; hi = (f32x4){bflo(w.z), bfhi(w.z), bflo(w.w), bfhi(w.w)}; }
__device__ __forceinline__ void row_combine(const RowRaw& r, f32x4 (&v)[4]) {
#pragma unroll
    for (int j = 0; j < 2; ++j) { f32x4 x0, x1, d0, d1; unpack8(r.x[j], x0, x1); unpack8(r.d[j], d0, d1); v[2 * j] = x0 * ALPHA + d0; v[2 * j + 1] = x1 * ALPHA + d1; }
}

__device__ __forceinline__ void p_pro_b(const Frame& F) {
    const float* MOD = (const float*)(F.ws + WS_MOD); bf16_t* H = (bf16_t*)(F.ws + WS_H); bf16_t* X = (bf16_t*)(F.ws + WS_X);
    const int rpw = (NTOK + F.NGW - 1) / F.NGW, rbeg = F.gw * rpw, rend = (rbeg + rpw < NTOK) ? rbeg + rpw : NTOK;
    f32x4 SC[4], SH[4]; int mcur = -1;
#define PB_SRC(row_) ((row_) < NLAT ? F.in[I_X] + (size_t)(row_) * D : F.in[I_CTX] + (size_t)((row_) - NLAT) * D)
    f32x4 vn[4];
    if (rbeg < rend) row_load(PB_SRC(rbeg), F.lane, vn);
    for (int row = rbeg; row < rend; ++row) {
        f32x4 v[4], hv[4];
#pragma unroll
        for (int q = 0; q < 4; ++q) v[q] = vn[q];
        if (row + 1 < rend) row_load(PB_SRC(row + 1), F.lane, vn);
        row_store_h(X + (size_t)row * D, F.lane, v);
        const int mr = mod_row_of(row);
        if (mr != mcur) { const float* m = MOD + (size_t)mr * MODW; col_load(m + D, F.lane, SC, 1.0f); col_load(m, F.lane, SH); mcur = mr; }
#pragma unroll
        for (int q = 0; q < 4; ++q) hv[q] = v[q] * SC[q] + SH[q];
        row_store_h(H + (size_t)row * D, F.lane, hv);
    }
#undef PB_SRC
}

__device__ __forceinline__ void p_inproj(const Frame& F, int layer) {
    const bf16_t* H = (const bf16_t*)(F.ws + WS_H);
    {
        const bf16_t* wdt = (const bf16_t*)(F.ws + WS_WDT) + (size_t)layer * 16 * D; float* DT = (float*)(F.ws + WS_DT);
        const int fr = F.lane & 15, fq = F.lane >> 4; const float dtb = F.in[I_DTB][layer * 16 + fr];
        for (int g = F.gw; g < NTOK / 16; g += F.NGW) {
            f32x4 acc = {0.f, 0.f, 0.f, 0.f};
            const bf16_t* ap = H + (size_t)(g * 16 + fr) * D + fq * 8; const bf16_t* bp = wdt + (size_t)fr * D + fq * 8;
#pragma unroll 8
            for (int ks = 0; ks < 32; ++ks) { const bf16x8 a = *(const bf16x8*)(ap + ks * 32), b = *(const bf16x8*)(bp + ks * 32);
                acc = __builtin_amdgcn_mfma_f32_16x16x32_bf16(a, b, acc, 0, 0, 0); }
#pragma unroll
            for (int r = 0; r < 4; ++r) { const float x = acc[r] + dtb; DT[(size_t)(g * 16 + fq * 4 + r) * 16 + fr] = fmaxf(x, 0.f) + __logf(1.0f + __expf(-fabsf(x))); }
        }
    }
    pg8::EpiBf16 E{(bf16_t*)(F.ws + WS_PROJ), NPROJ};
#if USE_FP8 && FP8_INPROJ
    pg8::Gemm g{(const bf16_t*)(F.ws + WS_H8IN), (const bf16_t*)(F.ws + WS_WIN + (size_t)layer * NPROJ * D), D / 2};
    pg8::DenseOrder S; S.init(NTOK, NPROJ, D / 2, F.G, F.bid, REP_GEMM);
    pg8::gemm_phase<pg8::EpiBf16, pg8::DenseOrder, true, FP8_SP2, true>(F.lds, g, S, E, F.tid, (127 - S8_WGU) * 0x01010101, (127 - S8_ACT) * 0x01010101);
#else
    pg8::Gemm g{H, (const bf16_t*)(F.ws + WS_WIN) + (size_t)layer * NPROJ * D, D};
    pg8::DenseOrder S; S.init(NTOK, NPROJ, D, F.G, F.bid, REP_GEMM);
    pg8::gemm_phase<pg8::EpiBf16, pg8::DenseOrder, true, true>(F.lds, g, S, E, F.tid);
#endif
    if (layer == 0) deferred_conv(F, (NTOK / 256) * (NPROJ / 256), DW_L0_IN, DW_Q); else if (layer < 3) deferred_conv(F, (NTOK / 256) * (NPROJ / 256), layer == 1 ? DW_L1_IN : DW_L2_IN, DW_Q);
}

typedef short s16x4 __attribute__((ext_vector_type(4)));
__device__ __forceinline__ s16x4 lds_tr16(LAS const unsigned char* p) { return __builtin_bit_cast(s16x4, __builtin_amdgcn_ds_read_tr16_b64_v4i16((LAS s16x4*)p)); }
constexpr int NA_KS = 144;
constexpr float LOG2E = 1.4426950408889634f;
__device__ __forceinline__ void na_unit(const Frame& F, int layer, int b, int h, int mode, int m) {
    LAS unsigned char* KV = F.lds;
    LAS float* rp = (LAS float*)(F.lds + 120832);
    const bf16_t* PROJ = (const bf16_t*)(F.ws + WS_PROJ); bf16_t* MIX = (bf16_t*)(F.ws + WS_MIX);
    const int tid = F.tid, lane = F.lane, w = F.wave, q16 = lane & 15, g = lane >> 4;
    int rbase = 0, nk = 0;
    if (mode == 0) { rbase = 2 * m - 4; rbase = rbase < 0 ? 0 : (rbase > 24 ? 24 : rbase); nk = 32 - rbase; nk = nk > 9 ? 9 : nk; }
    const int kfirst = (mode == 0) ? 0 : 576 * 8, nloc8 = nk * 64 * 8;
#define NA_STAGE(OFFS) do { int stid_ = tid; asm volatile("" : "+v"(stid_));     \
        NA_STAGE_PART(OFFS, 0, 7); __builtin_amdgcn_sched_barrier(0); NA_STAGE_PART(OFFS, 7, 13); __builtin_amdgcn_sched_barrier(0); } while (0)
#define NA_STAGE_PART(OFFS, K0, K1) do { u32x4 st_[13]; \
        _Pragma("unroll") for (int k_ = K0; k_ < K1; ++k_) { const int i_ = stid_ + kfirst + k_ * NT, key_ = i_ >> 3, ch_ = i_ & 7; const bool ok_ = (i_ < 832 * 8) && !(key_ < 576 && i_ >= nloc8); \
            const int grow_ = key_ < 576 ? b * SEQ + rbase * 64 + key_ : NLAT + b * CTX + (key_ - 576); \
            st_[k_] = ok_ ? *(const u32x4*)(PROJ + (size_t)grow_ * NPROJ + (OFFS) + h * 64 + ch_ * 8) : (u32x4){0u, 0u, 0u, 0u}; } \
        _Pragma("unroll") for (int k_ = K0; k_ < K1; ++k_) { const int i_ = stid_ + kfirst + k_ * NT, key_ = i_ >> 3, ch_ = i_ & 7; const bool ok_ = (i_ < 832 * 8) && !(key_ < 576 && i_ >= nloc8); \
            if (ok_) *(LAS u32x4*)(KV + key_ * NA_KS + ch_ * 16) = st_[k_]; } } while (0)
    __syncthreads();
    NA_STAGE(OFF_K);
    if (mode == 0 && tid < 465) rp[tid] = F.in[I_RPB][(size_t)(layer * 8 + h) * 465 + tid] * LOG2E;
    __syncthreads();
    int i = 0, j0 = 0, hs = 0, kr0 = 0, qrow;
    if (mode == 0) { i = 2 * m + (w >> 2); j0 = (w & 3) * 16; qrow = b * SEQ + i * 64 + j0; hs = j0 - 8; hs = hs < 0 ? 0 : (hs > 32 ? 32 : hs);
        int r0 = i - 4; r0 = r0 < 0 ? 0 : (r0 > 24 ? 24 : r0); kr0 = r0 - rbase; }
    else qrow = NLAT + b * CTX + m * 128 + w * 16;
    bf16x8 qf[2];
#pragma unroll
    for (int ks = 0; ks < 2; ++ks) qf[ks] = *(const bf16x8*)(PROJ + (size_t)(qrow + q16) * NPROJ + h * 64 + ks * 32 + g * 8);
    f32x4 S[32];
    const LAS unsigned char* kb = KV + q16 * NA_KS + g * 16;
    if (mode == 0) {
        const int j = j0 + q16; int cs = j - 8; cs = cs < 0 ? 0 : (cs > 48 ? 48 : cs);
        const int rb0 = (kr0 + rbase) - i + 7;
#pragma unroll
        for (int tl = 0; tl < 16; ++tl) { const int kr = tl >> 1, half = tl & 1; const int kidx0 = (kr0 + kr) * 64 + hs + 16 * half;
            f32x4 a = {0.f, 0.f, 0.f, 0.f};
#pragma unroll
            for (int ks = 0; ks < 2; ++ks) { const bf16x8 kf = *(const LAS bf16x8*)(kb + kidx0 * NA_KS + ks * 64); a = __builtin_amdgcn_mfma_f32_16x16x32_bf16(kf, qf[ks], a, 0, 0, 0); }
#pragma unroll
            for (int r = 0; r < 4; ++r) { const int kc = hs + 16 * half + 4 * g + r; const bool inw = (kc >= cs) && (kc < cs + 16);
                int cbi = kc - j + 15; cbi = cbi < 0 ? 0 : (cbi > 30 ? 30 : cbi);
                a[r] = inw ? a[r] * (0.125f * LOG2E) + rp[(rb0 + kr) * 31 + cbi] : -INFINITY; }
            S[tl] = a; if ((tl & 1) == 1) __builtin_amdgcn_sched_barrier(0); }
    } else {
#pragma unroll
        for (int tl = 0; tl < 16; ++tl) S[tl] = (f32x4){-INFINITY, -INFINITY, -INFINITY, -INFINITY};
    }
#pragma unroll
    for (int tc = 0; tc < 16; ++tc) { const int kidx0 = 576 + 16 * tc; f32x4 a = {0.f, 0.f, 0.f, 0.f};
#pragma unroll
        for (int ks = 0; ks < 2; ++ks) { const bf16x8 kf = *(const LAS bf16x8*)(kb + kidx0 * NA_KS + ks * 64); a = __builtin_amdgcn_mfma_f32_16x16x32_bf16(kf, qf[ks], a, 0, 0, 0); }
        S[16 + tc] = a * (0.125f * LOG2E); if ((tc & 1) == 1) __builtin_amdgcn_sched_barrier(0); }
    float mx = -INFINITY;
#pragma unroll
    for (int t = 0; t < 32; ++t) mx = fmaxf(fmaxf(fmaxf(S[t][0], S[t][1]), fmaxf(S[t][2], S[t][3])), mx);
    mx = fmaxf(mx, __shfl_xor(mx, 16)); mx = fmaxf(mx, __shfl_xor(mx, 32));
    float sum = 0.f; u32x4 P[16];
#pragma unroll
    for (int kk = 0; kk < 16; ++kk) { float e[8];
#pragma unroll
        for (int r = 0; r < 4; ++r) { e[r] = __builtin_amdgcn_exp2f(S[2 * kk][r] - mx); e[4 + r] = __builtin_amdgcn_exp2f(S[2 * kk + 1][r] - mx); }
        sum += ((e[0] + e[1]) + (e[2] + e[3])) + ((e[4] + e[5]) + (e[6] + e[7]));
        P[kk].x = pg8::cvt_pk_bf16_pin(e[0], e[1]); P[kk].y = pg8::cvt_pk_bf16_pin(e[2], e[3]); P[kk].z = pg8::cvt_pk_bf16_pin(e[4], e[5]); P[kk].w = pg8::cvt_pk_bf16_pin(e[6], e[7]); }
    sum += __shfl_xor(sum, 16); sum += __shfl_xor(sum, 32);
    const float inv = 1.0f / sum;
    __syncthreads();
    NA_STAGE(OFF_V);
    __syncthreads();
    f32x4 o[4];
#pragma unroll
    for (int dt = 0; dt < 4; ++dt) o[dt] = (f32x4){0.f, 0.f, 0.f, 0.f};
    const LAS unsigned char* vb = KV + (4 * g + (q16 >> 2)) * NA_KS + (q16 & 3) * 8;
#pragma unroll
    for (int kk = 0; kk < 16; ++kk) {
        if (kk < 8 && mode != 0) continue;
        const int kidx0 = (kk < 8) ? (kr0 + kk) * 64 + hs : 576 + 32 * (kk - 8);
        const bf16x8 pa = __builtin_bit_cast(bf16x8, P[kk]);
#pragma unroll
        for (int dt = 0; dt < 4; ++dt) { const s16x4 lo = lds_tr16(vb + kidx0 * NA_KS + dt * 32), hi = lds_tr16(vb + (kidx0 + 16) * NA_KS + dt * 32);
            const bf16x8 vf = {lo[0], lo[1], lo[2], lo[3], hi[0], hi[1], hi[2], hi[3]};
            o[dt] = __builtin_amdgcn_mfma_f32_16x16x32_bf16(pa, vf, o[dt], 0, 0, 0); }
    }
#undef NA_STAGE
#undef NA_STAGE_PART
#pragma unroll
    for (int r = 0; r < 4; ++r) { const float ir = __shfl(inv, 4 * g + r);
        bf16_t* op = MIX + (size_t)(qrow + 4 * g + r) * D + h * 64 + q16;
#pragma unroll
        for (int dt = 0; dt < 4; dt += 2) { const unsigned pw = pk2(o[dt][r] * ir, o[dt + 1][r] * ir); op[dt * 16] = (bf16_t)(pw & 0xffffu); op[dt * 16 + 16] = (bf16_t)(pw >> 16); } }
}

struct PrepassW { f32x4 w[5][2]; f32x4 b[2]; float ifq[8]; };
__device__ __forceinline__ void ssd_prepass_unit(const Frame& F, int u, const PrepassW& W) {
    const bf16_t* PROJ = (const bf16_t*)(F.ws + WS_PROJ); bf16_t* U = (bf16_t*)(F.ws + WS_U);
    int rowbase, t0, L; bool lat;
    if (u < NLAT / 16) { rowbase = (u >> 7) * SEQ; t0 = (u & 127) * 16; L = SEQ; lat = true; }
    else { const int v = u - NLAT / 16; rowbase = NLAT + (v >> 4) * CTX; t0 = (v & 15) * 16; L = CTX; lat = false; }
    const int cg = F.tid & 127, tq = F.tid >> 7, c0 = 8 * cg, tb = t0 + 4 * tq;
    u32x4 win[8];
#pragma unroll
    for (int j = 0; j < 8; ++j) { const int t = tb - 2 + j; win[j] = (t >= 0 && t < L) ? *(const u32x4*)(PROJ + (size_t)(rowbase + t) * NPROJ + OFF_XBC + c0) : (u32x4){0u, 0u, 0u, 0u}; }
    const int lc = c0 & 127, hf = lc >> 6, role = (lc >> 5) & 1; const bool rope = lat && (c0 >= 512);
#pragma unroll
    for (int tt = 0; tt < 4; ++tt) {
        f32x4 a0 = W.b[0], a1 = W.b[1];
#pragma unroll
        for (int j = 0; j < 5; ++j) { const u32x4 r = win[tt + j];
            a0 += W.w[j][0] * (f32x4){bflo(r.x), bfhi(r.x), bflo(r.y), bfhi(r.y)}; a1 += W.w[j][1] * (f32x4){bflo(r.z), bfhi(r.z), bflo(r.w), bfhi(r.w)}; }
        float uu[8];
#pragma unroll
        for (int k = 0; k < 4; ++k) { uu[k] = silu_f(a0[k]); uu[4 + k] = silu_f(a1[k]); }
        if (rope) {
            const int tk = tb + tt; const float pos = (float)(hf ? (tk & 63) : (tk >> 6));
#pragma unroll
            for (int k = 0; k < 8; ++k) { const float o = __shfl_xor(uu[k], 4); const float sn = __builtin_amdgcn_sinf(pos * W.ifq[k]), cs = __builtin_amdgcn_cosf(pos * W.ifq[k]);
                uu[k] = role ? (o * sn + uu[k] * cs) : (uu[k] * cs - o * sn); }
        }
        u32x4 o; o.x = pk2(uu[0], uu[1]); o.y = pk2(uu[2], uu[3]); o.z = pk2(uu[4], uu[5]); o.w = pk2(uu[6], uu[7]);
        *(u32x4*)(U + (size_t)(rowbase + tb + tt) * 1024 + c0) = o;
    }
}
__device__ __forceinline__ void ssd_prepass_weights(const Frame& F, int layer, PrepassW& W) {
    const int c0 = 8 * (F.tid & 127);
    const float* cwp = F.in[I_CONVW] + (size_t)layer * 5 * 1024 + c0;
#pragma unroll
    for (int j = 0; j < 5; ++j) { W.w[j][0] = *(const f32x4*)(cwp + j * 1024); W.w[j][1] = *(const f32x4*)(cwp + j * 1024 + 4); }
    W.b[0] = *(const f32x4*)(F.in[I_CONVB] + (size_t)layer * 1024 + c0); W.b[1] = *(const f32x4*)(F.in[I_CONVB] + (size_t)layer * 1024 + c0 + 4);
    const int n0 = c0 & 31;
#pragma unroll
    for (int k = 0; k < 8; ++k) W.ifq[k] = __builtin_amdgcn_exp2f(-(float)(n0 + k) * (13.287712379549449f / 32.0f)) * 0.15915494309189535f;
}

constexpr int S_CQ = 0, S_BQ = 17408, S_XN = 34816, S_XW = 44032, S_OPS = 53248, S_HB = 2 * S_OPS, S_MISC = S_HB + 2 * 17408, S_END = S_MISC + 3 * 1088;
static_assert(S_END <= LDS_ROWOFF + 18432, "SSD LDS image must stay below the control words");
__device__ __forceinline__ void ssd_chunk_compute(const LAS unsigned char* O, const LAS float* misc, const LAS unsigned char* HB, LAS unsigned char* HN, f32x4 (&Hacc)[4],
                                                  bf16_t* yp, int w, int q16, int gq, bool skip, float dsk) {
    const int lt = w >> 1, t2 = (w & 1) * 2;
    bf16x8 cfr[4];
#pragma unroll
    for (int ks = 0; ks < 4; ++ks) cfr[ks] = *(const LAS bf16x8*)(O + S_CQ + (16 * lt + q16) * 272 + ks * 64 + gq * 16);
    u32x4 pm[2];
    {
        const float csl = misc[64 + 16 * lt + q16];
#pragma unroll
        for (int pr = 0; pr < 2; ++pr) {
            f32x4 v[2];
#pragma unroll
            for (int hh = 0; hh < 2; ++hh) { const int st = 2 * pr + hh; f32x4 a = {0.f, 0.f, 0.f, 0.f};
#pragma unroll
                for (int ks = 0; ks < 4; ++ks) { const bf16x8 bfr = *(const LAS bf16x8*)(O + S_BQ + (16 * st + q16) * 272 + ks * 64 + gq * 16); a = __builtin_amdgcn_mfma_f32_16x16x32_bf16(bfr, cfr[ks], a, 0, 0, 0); }
                const f32x4 css = *(const LAS f32x4*)(misc + 64 + 16 * st + 4 * gq), dts = *(const LAS f32x4*)(misc + 16 * st + 4 * gq);
#pragma unroll
                for (int r = 0; r < 4; ++r) { const int sidx = 16 * st + 4 * gq + r; const float e = __expf(fminf(csl - css[r], 0.f)); a[r] = (sidx <= 16 * lt + q16) ? a[r] * e * dts[r] : 0.f; }
                v[hh] = a; }
            pm[pr].x = pk2(v[0][0], v[0][1]); pm[pr].y = pk2(v[0][2], v[0][3]); pm[pr].z = pk2(v[1][0], v[1][1]); pm[pr].w = pk2(v[1][2], v[1][3]);
        }
    }
    {
        const float ecs = misc[128 + 16 * lt + q16];
        const LAS unsigned char* xtr = O + S_XN + (4 * gq + (q16 >> 2)) * 144 + (q16 & 3) * 8;
#pragma unroll
        for (int k = 0; k < 2; ++k) { const int pt = t2 + k; f32x4 a = {0.f, 0.f, 0.f, 0.f};
#pragma unroll
            for (int ks = 0; ks < 4; ++ks) { const bf16x8 hfr = *(const LAS bf16x8*)(HB + (16 * pt + q16) * 272 + ks * 64 + gq * 16); a = __builtin_amdgcn_mfma_f32_16x16x32_bf16(hfr, cfr[ks], a, 0, 0, 0); }
            a = a * ecs;
#pragma unroll
            for (int pr = 0; pr < 2; ++pr) { const s16x4 lo = lds_tr16(xtr + (32 * pr) * 144 + pt * 32), hi = lds_tr16(xtr + (32 * pr + 16) * 144 + pt * 32);
                const bf16x8 xf = {lo[0], lo[1], lo[2], lo[3], hi[0], hi[1], hi[2], hi[3]};
                a = __builtin_amdgcn_mfma_f32_16x16x32_bf16(xf, __builtin_bit_cast(bf16x8, pm[pr]), a, 0, 0, 0); }
            { const u32x2 xv = *(const LAS u32x2*)(O + S_XN + (16 * lt + q16) * 144 + (16 * pt + 4 * gq) * 2); const float ds = skip ? dsk : 0.f;
                a[0] += ds * bflo(xv.x); a[1] += ds * bfhi(xv.x); a[2] += ds * bflo(xv.y); a[3] += ds * bfhi(xv.y); }
            { u32x2 ow; ow.x = pk2(a[0], a[1]); ow.y = pk2(a[2], a[3]); *(u32x2*)(yp + 16 * pt + 4 * gq) = ow; } }
    }
    {
        const int pt2 = w & 3, nb = (w >> 2) * 4; const float et = misc[256];
        const LAS unsigned char* xwtr = O + S_XW + (4 * gq + (q16 >> 2)) * 144 + (q16 & 3) * 8 + pt2 * 32;
        const LAS unsigned char* btr = O + S_BQ + (4 * gq + (q16 >> 2)) * 272 + (q16 & 3) * 8;
        bf16x8 xf2[2];
#pragma unroll
        for (int kk = 0; kk < 2; ++kk) { const s16x4 lo = lds_tr16(xwtr + (32 * kk) * 144), hi = lds_tr16(xwtr + (32 * kk + 16) * 144); xf2[kk] = (bf16x8){lo[0], lo[1], lo[2], lo[3], hi[0], hi[1], hi[2], hi[3]}; }
#pragma unroll
        for (int j = 0; j < 4; ++j) { const int nt = nb + j; Hacc[j] = Hacc[j] * et;
#pragma unroll
            for (int kk = 0; kk < 2; ++kk) { const s16x4 lo = lds_tr16(btr + (32 * kk) * 272 + nt * 32), hi = lds_tr16(btr + (32 * kk + 16) * 272 + nt * 32);
                const bf16x8 bT = {lo[0], lo[1], lo[2], lo[3], hi[0], hi[1], hi[2], hi[3]};
                Hacc[j] = __builtin_amdgcn_mfma_f32_16x16x32_bf16(bT, xf2[kk], Hacc[j], 0, 0, 0); }
            u32x2 hw; hw.x = pk2(Hacc[j][0], Hacc[j][1]); hw.y = pk2(Hacc[j][2], Hacc[j][3]);
            *(LAS u32x2*)(HN + (16 * pt2 + q16) * 272 + (16 * nt + 4 * gq) * 2) = hw; }
    }
}
struct SsdPre { u32x4 x, b[2], c[2]; float dt; };
__device__ __forceinline__ void ssd_mfma_unit(const Frame& F, int layer, int b, int h, int dir) {
    const int g = h >> 2, tid = F.tid, lane = F.lane, w = F.wave, q16 = lane & 15, gq = lane >> 4;
    const bf16_t* U = (const bf16_t*)(F.ws + WS_U); const float* DTS = (const float*)(F.ws + WS_DT);
    bf16_t* Y = (bf16_t*)(F.ws + (dir ? WS_YB : WS_YF));
    const float aneg = -__expf(F.in[I_ALOG][layer * 16 + dir * 8 + h]), dsk = F.in[I_DSKIP][layer * 8 + h];
    LAS unsigned char* L = F.lds;
    __syncthreads();
    { unsigned z_; asm volatile("v_mov_b32 %0, 0" : "=v"(z_));
      for (int i = tid; i < 64 * 272 / 16; i += NT) *(LAS u32x4*)(L + S_HB + i * 16) = (u32x4){z_, z_, z_, z_}; }
    f32x4 Hacc[4];
#pragma unroll
    for (int j = 0; j < 4; ++j) Hacc[j] = (f32x4){0.f, 0.f, 0.f, 0.f};
    SsdPre P0, P1;
    P0.dt = 0.f; P1.dt = 0.f;
    const int xt = tid >> 3, xp = tid & 7;
    const int bt = tid >> 4, bp = tid & 15;
#define SSD_ROW(ci_, l_) ({ const int s_ = (ci_) < 4 ? 0 : 1, k_ = s_ ? (ci_) - 4 : (ci_), nc_ = s_ ? 32 : 4, c_ = dir ? nc_ - 1 - k_ : k_; \
        (s_ ? b * SEQ : NLAT + b * CTX) + c_ * 64 + (dir ? 63 - (l_) : (l_)); })
#define SSD_PREFETCH(ci_, P_) do { P_.x = *(const u32x4*)(U + (size_t)SSD_ROW(ci_, xt) * 1024 + h * 64 + xp * 8); \
        if (w == 0) P_.dt = DTS[(size_t)SSD_ROW(ci_, lane) * 16 + dir * 8 + h]; \
        _Pragma("unroll") for (int j2_ = 0; j2_ < 2; ++j2_) { const int tok_ = bt + 32 * j2_; const size_t ro_ = (size_t)SSD_ROW(ci_, tok_) * 1024; \
            P_.b[j2_] = *(const u32x4*)(U + ro_ + 512 + g * 128 + bp * 8); P_.c[j2_] = *(const u32x4*)(U + ro_ + 768 + g * 128 + bp * 8); } } while (0)
#define SSD_MISC(slot_, P_) do { LAS float* m_ = (LAS float*)(L + S_MISC) + (slot_) * 272; const float dt_ = P_.dt; const float cs_ = wave_scan(dt_ * aneg); \
        const float tot_ = __builtin_bit_cast(float, __builtin_amdgcn_readlane(__builtin_bit_cast(int, cs_), 63)); \
        m_[lane] = dt_; m_[64 + lane] = cs_; m_[128 + lane] = __expf(cs_); m_[192 + lane] = __expf(tot_ - cs_) * dt_; if (lane == 0) m_[256] = __expf(tot_); } while (0)
#define SSD_STAGE(set_, slot_, P_) do { LAS unsigned char* O_ = L + (set_) * S_OPS; const float wl = ((const LAS float*)(L + S_MISC))[(slot_) * 272 + 192 + xt]; \
        *(LAS u32x4*)(O_ + S_XN + xt * 144 + xp * 16) = P_.x; \
        u32x4 xw; xw.x = pk2(bflo(P_.x.x) * wl, bfhi(P_.x.x) * wl); xw.y = pk2(bflo(P_.x.y) * wl, bfhi(P_.x.y) * wl); xw.z = pk2(bflo(P_.x.z) * wl, bfhi(P_.x.z) * wl); xw.w = pk2(bflo(P_.x.w) * wl, bfhi(P_.x.w) * wl); \
        *(LAS u32x4*)(O_ + S_XW + xt * 144 + xp * 16) = xw; \
        _Pragma("unroll") for (int k = 0; k < 2; ++k) { *(LAS u32x4*)(O_ + S_BQ + (bt + 32 * k) * 272 + bp * 16) = P_.b[k]; *(LAS u32x4*)(O_ + S_CQ + (bt + 32 * k) * 272 + bp * 16) = P_.c[k]; } } while (0)
#define SSD_ITER(ci_, PN_, PC_) do { const int ci = (ci_); const int ms1 = ms == 2 ? 0 : ms + 1, ms2 = ms1 == 2 ? 0 : ms1 + 1; \
        if (ci + 1 < 36) SSD_STAGE(cur ^ 1, ms1, PN_); \
        if (ci + 3 < 36) SSD_PREFETCH(ci + 3, PN_); \
        TPS(0); \
        { const int row0 = SSD_ROW(ci, 16 * (w >> 1) + q16); \
          ssd_chunk_compute(L + cur * S_OPS, (const LAS float*)(L + S_MISC) + ms * 272, L + S_HB + cur * 17408, L + S_HB + (cur ^ 1) * 17408, Hacc, Y + (size_t)row0 * 512 + h * 64, w, q16, gq, dir == 0, dsk); } \
        TPS(2); \
        if (w == 0 && ci + 2 < 36) SSD_MISC(ms2, PC_); \
        __syncthreads(); \
        TPS(3); \
        cur ^= 1; ms = ms1; } while (0)
    SSD_PREFETCH(0, P0);
    if (w == 0) SSD_MISC(0, P0);
    __syncthreads();
    SSD_STAGE(0, 0, P0);
    SSD_PREFETCH(1, P1);
    SSD_PREFETCH(2, P0);
    if (w == 0) SSD_MISC(1, P1);
    __syncthreads();
    TPS_BEGIN;
    int cur = 0, ms = 0;
    for (int c2 = 0; c2 < 36; c2 += 2) { SSD_ITER(c2, P1, P0); SSD_ITER(c2 + 1, P0, P1); }
#undef SSD_ROW
#undef SSD_PREFETCH
#undef SSD_MISC
#undef SSD_STAGE
#undef SSD_ITER
}

__device__ __forceinline__ void na_run(const Frame& F, int layer) {
    LAS unsigned char* KV = F.lds; LAS float* rp = (LAS float*)(F.lds + 120832);
    const bf16_t* PROJ = (const bf16_t*)(F.ws + WS_PROJ); bf16_t* MIX = (bf16_t*)(F.ws + WS_MIX);
    const int tid = F.tid, lane = F.lane, w = F.wave, q16 = lane & 15, g = lane >> 4;
    u32x4 pre[13];
#define NA_VPRE 13
#define NA_RB(m_) ({ int rb_ = 2 * (m_) - 4; rb_ = rb_ < 0 ? 0 : (rb_ > 24 ? 24 : rb_); __builtin_amdgcn_readfirstlane(rb_); })
#define NA_NL(rb_) ({ int nk_ = 32 - (rb_); nk_ = nk_ > 9 ? 9 : nk_; __builtin_amdgcn_readfirstlane(nk_ * 64 * 8); })
#define NA_LOAD(OFFS, b_, h_, rb_, nl_, K0, K1) do { int stid_ = tid; asm volatile("" : "+v"(stid_)); \
        _Pragma("unroll") for (int k_ = K0; k_ < K1; ++k_) { const int i_ = stid_ + k_ * NT, key_ = i_ >> 3, ch_ = i_ & 7; const bool ok_ = !(key_ < 576 && i_ >= (nl_)); \
            const int grow_ = key_ < 576 ? (b_) * SEQ + (rb_) * 64 + key_ : NLAT + (b_) * CTX + (key_ - 576); \
            pre[k_] = ok_ ? *(const u32x4*)(PROJ + (size_t)grow_ * NPROJ + (OFFS) + (h_) * 64 + ch_ * 8) : (u32x4){0u, 0u, 0u, 0u}; } } while (0)
#define NA_WRITE(nl_, K0, K1) do { int stid_ = tid; asm volatile("" : "+v"(stid_)); \
        _Pragma("unroll") for (int k_ = K0; k_ < K1; ++k_) { const int i_ = stid_ + k_ * NT, key_ = i_ >> 3, ch_ = i_ & 7; const bool ok_ = !(key_ < 576 && i_ >= (nl_)); \
            if (ok_) *(LAS u32x4*)(KV + key_ * NA_KS + ch_ * 16) = pre[k_]; } } while (0)
    int u = __builtin_amdgcn_readfirstlane(F.bid); int hprev = -1;
    if (u < 2048) { const int b = u >> 7, h = (u >> 4) & 7, m = u & 15, rb = NA_RB(m); NA_LOAD(OFF_K, b, h, rb, NA_NL(rb), 0, 13); }
    TPS_BEGIN;
    for (; u < 2048; u += F.G) {
        const int b = u >> 7, h = (u >> 4) & 7, m = u & 15, rbase = NA_RB(m), nloc8 = NA_NL(rbase);
        TPS(14);
        __syncthreads();
        TPS(10);
        NA_WRITE(nloc8, 0, 13);
        if (h != hprev) { if (tid < 465) rp[tid] = F.in[I_RPB][(size_t)(layer * 8 + h) * 465 + tid] * LOG2E; hprev = h; }
        NA_LOAD(OFF_V, b, h, rbase, nloc8, 0, NA_VPRE);
        __syncthreads();
        TPS(11);
        const int i = 2 * m + (w >> 2), j0 = (w & 3) * 16, qrow = b * SEQ + i * 64 + j0; int hs = j0 - 8; hs = hs < 0 ? 0 : (hs > 32 ? 32 : hs);
        int r0 = i - 4; r0 = r0 < 0 ? 0 : (r0 > 24 ? 24 : r0); const int kr0 = r0 - rbase;
        bf16x8 qf[2];
#pragma unroll
        for (int ks = 0; ks < 2; ++ks) qf[ks] = *(const bf16x8*)(PROJ + (size_t)(qrow + q16) * NPROJ + h * 64 + ks * 32 + g * 8);
        f32x4 S[32];
        const LAS unsigned char* kb = KV + q16 * NA_KS + g * 16;
        { const int j = j0 + q16; int cs = j - 8; cs = cs < 0 ? 0 : (cs > 48 ? 48 : cs);
          const int rb0 = (kr0 + rbase) - i + 7;
#pragma unroll
          for (int tl = 0; tl < 16; ++tl) { const int kr = tl >> 1, half = tl & 1; const int kidx0 = (kr0 + kr) * 64 + hs + 16 * half;
              f32x4 a = {0.f, 0.f, 0.f, 0.f};
#pragma unroll
              for (int ks = 0; ks < 2; ++ks) { const bf16x8 kf = *(const LAS bf16x8*)(kb + kidx0 * NA_KS + ks * 64); a = __builtin_amdgcn_mfma_f32_16x16x32_bf16(kf, qf[ks], a, 0, 0, 0); }
#pragma unroll
              for (int r = 0; r < 4; ++r) { const int kc = hs + 16 * half + 4 * g + r; const bool inw = (kc >= cs) && (kc < cs + 16);
                  int cbi = kc - j + 15; cbi = cbi < 0 ? 0 : (cbi > 30 ? 30 : cbi);
                  const float bias = rp[(rb0 + kr) * 31 + cbi];
                  const float t = a[r] * (0.125f * LOG2E) + bias; a[r] = inw ? t : -INFINITY; }
              S[tl] = a; if ((tl & 1) == 1) __builtin_amdgcn_sched_barrier(0); } }
#pragma unroll
        for (int tc = 0; tc < 16; ++tc) { const int kidx0 = 576 + 16 * tc; f32x4 a = {0.f, 0.f, 0.f, 0.f};
#pragma unroll
            for (int ks = 0; ks < 2; ++ks) { const bf16x8 kf = *(const LAS bf16x8*)(kb + kidx0 * NA_KS + ks * 64); a = __builtin_amdgcn_mfma_f32_16x16x32_bf16(kf, qf[ks], a, 0, 0, 0); }
            S[16 + tc] = a * (0.125f * LOG2E); if ((tc & 1) == 1) __builtin_amdgcn_sched_barrier(0); }
        float mx = -INFINITY;
#pragma unroll
        for (int t = 0; t < 32; ++t) mx = fmaxf(fmaxf(fmaxf(S[t][0], S[t][1]), fmaxf(S[t][2], S[t][3])), mx);
        mx = fmaxf(mx, __shfl_xor(mx, 16)); mx = fmaxf(mx, __shfl_xor(mx, 32));
        float sum = 0.f; u32x4 P[16];
#pragma unroll
        for (int kk = 0; kk < 16; ++kk) { float e[8];
#pragma unroll
            for (int r = 0; r < 4; ++r) { e[r] = __builtin_amdgcn_exp2f(S[2 * kk][r] - mx); e[4 + r] = __builtin_amdgcn_exp2f(S[2 * kk + 1][r] - mx); }
            sum += ((e[0] + e[1]) + (e[2] + e[3])) + ((e[4] + e[5]) + (e[6] + e[7]));
            P[kk].x = pg8::cvt_pk_bf16_pin(e[0], e[1]); P[kk].y = pg8::cvt_pk_bf16_pin(e[2], e[3]); P[kk].z = pg8::cvt_pk_bf16_pin(e[4], e[5]); P[kk].w = pg8::cvt_pk_bf16_pin(e[6], e[7]); }
        sum += __shfl_xor(sum, 16); sum += __shfl_xor(sum, 32);
        const float inv = 1.0f / sum;
        TPS(12);
        __syncthreads();
        NA_WRITE(nloc8, 0, NA_VPRE); NA_LOAD(OFF_V, b, h, rbase, nloc8, NA_VPRE, 13); NA_WRITE(nloc8, NA_VPRE, 13);
        { const int un = u + F.G; if (un < 2048) { const int bn = un >> 7, hn = (un >> 4) & 7, mn = un & 15, rbn = NA_RB(mn); NA_LOAD(OFF_K, bn, hn, rbn, NA_NL(rbn), 0, 13); } }
        __syncthreads();
        TPS(13);
        f32x4 o[4];
#pragma unroll
        for (int dt = 0; dt < 4; ++dt) o[dt] = (f32x4){0.f, 0.f, 0.f, 0.f};
        const LAS unsigned char* vb = KV + (4 * g + (q16 >> 2)) * NA_KS + (q16 & 3) * 8;
#pragma unroll
        for (int kk = 0; kk < 16; ++kk) {
            const int kidx0 = (kk < 8) ? (kr0 + kk) * 64 + hs : 576 + 32 * (kk - 8);
            const bf16x8 pa = __builtin_bit_cast(bf16x8, P[kk]);
#pragma unroll
            for (int dt = 0; dt < 4; ++dt) { const s16x4 lo = lds_tr16(vb + kidx0 * NA_KS + dt * 32), hi = lds_tr16(vb + (kidx0 + 16) * NA_KS + dt * 32);
                const bf16x8 vf = {lo[0], lo[1], lo[2], lo[3], hi[0], hi[1], hi[2], hi[3]};
                o[dt] = __builtin_amdgcn_mfma_f32_16x16x32_bf16(vf, pa, o[dt], 0, 0, 0); }
            if ((kk & 1) == 1) __builtin_amdgcn_sched_barrier(0);
        }
        { bf16_t* op = MIX + (size_t)(qrow + q16) * D + h * 64 + 4 * g;
#pragma unroll
          for (int dt = 0; dt < 4; ++dt) { u32x2 ow; ow.x = pk2(o[dt][0] * inv, o[dt][1] * inv); ow.y = pk2(o[dt][2] * inv, o[dt][3] * inv); *(u32x2*)(op + dt * 16) = ow; } }
    }
#undef NA_RB
#undef NA_NL
#undef NA_LOAD
#undef NA_WRITE
}
__device__ __forceinline__ void p_mixa(const Frame& F, int layer, bool last) {
    TPS_BEGIN;
    { PrepassW W; ssd_prepass_weights(F, layer, W);
      for (int u = F.bid; u < NTOK / 16; u += F.G) ssd_prepass_unit(F, u, W); }
    TPS(4);
    na_run(F, layer);
    TPS(5);
    if (!last) for (int u = F.bid; u < 256; u += F.G) na_unit(F, layer, u >> 4, (u >> 1) & 7, 1, u & 1);
    TPS(6);
}
__device__ __forceinline__ void p_mixb(const Frame& F, int layer) {
    for (int u0 = F.bid; u0 < 256 * REP_SSD; u0 += F.G) { const int u = u0 & 255; ssd_mfma_unit(F, layer, u >> 4, (u >> 1) & 7, u & 1); }
}

__device__ __forceinline__ void p_ssdcomb(const Frame& F, int layer, bool last) {
    const bf16_t* PROJ = (const bf16_t*)(F.ws + WS_PROJ); bf16_t* MIX = (bf16_t*)(F.ws + WS_MIX);
    const bf16_t* YF = (const bf16_t*)(F.ws + WS_YF); const bf16_t* YB = (const bf16_t*)(F.ws + WS_YB);
    const float* nw = F.in[I_NORMW] + layer * 512 + F.lane * 8;
    const f32x4 nw0 = *(const f32x4*)nw, nw1 = *(const f32x4*)(nw + 4);
    const int nrows = last ? NLAT : NTOK;
    u32x4 pyf = {0u, 0u, 0u, 0u}, pyb = pyf, pz = pyf;
#define SC_LOAD(r_) do { const size_t o_ = (size_t)(r_) * 512 + F.lane * 8; pyf = *(const u32x4*)(YF + o_); pyb = *(const u32x4*)(YB + o_); \
        pz = *(const u32x4*)(PROJ + (size_t)(r_) * NPROJ + OFF_Z + F.lane * 8); } while (0)
    if (F.gw < nrows) SC_LOAD(F.gw);
    for (int row = F.gw; row < nrows; row += F.NGW) {
        const f32x4 a0 = {bflo(pyf.x) + bflo(pyb.x), bfhi(pyf.x) + bfhi(pyb.x), bflo(pyf.y) + bflo(pyb.y), bfhi(pyf.y) + bfhi(pyb.y)}, a1 = {bflo(pyf.z) + bflo(pyb.z), bfhi(pyf.z) + bfhi(pyb.z), bflo(pyf.w) + bflo(pyb.w), bfhi(pyf.w) + bfhi(pyb.w)}; const u32x4 zv = pz;
        if (row + F.NGW < nrows) SC_LOAD(row + F.NGW);
        float y[8] = {a0[0] * silu_f(bflo(zv.x)), a0[1] * silu_f(bfhi(zv.x)), a0[2] * silu_f(bflo(zv.y)), a0[3] * silu_f(bfhi(zv.y)),
                      a1[0] * silu_f(bflo(zv.z)), a1[1] * silu_f(bfhi(zv.z)), a1[2] * silu_f(bflo(zv.w)), a1[3] * silu_f(bfhi(zv.w))};
        float ss = 0.f;
#pragma unroll
        for (int k = 0; k < 8; ++k) ss += y[k] * y[k];
#pragma unroll
        for (int of = 1; of < 32; of <<= 1) ss += __shfl_xor(ss, of);
        const float rs = 1.0f / sqrtf(ss * (1.0f / 256.0f) + RMS_EPS);
        u32x4 w; w.x = pk2(y[0] * rs * nw0[0], y[1] * rs * nw0[1]); w.y = pk2(y[2] * rs * nw0[2], y[3] * rs * nw0[3]);
        w.z = pk2(y[4] * rs * nw1[0], y[5] * rs * nw1[1]); w.w = pk2(y[6] * rs * nw1[2], y[7] * rs * nw1[3]);
        *(u32x4*)(MIX + (size_t)row * D + 512 + F.lane * 8) = w;
    }
}

__device__ __forceinline__ void p_outproj(const Frame& F, int layer, bool last) {
    pg8::Gemm g{(const bf16_t*)(F.ws + WS_MIX), (const bf16_t*)(F.ws + WS_WOUT) + (size_t)layer * D * D, D};
    pg8::DenseOrder S; S.init(last ? NLAT : NTOK, D, D, F.G, F.bid);
    pg8::EpiGate E{(bf16_t*)(F.ws + WS_DELTA1), (const float*)(F.ws + WS_MOD) + (size_t)layer * 17 * MODW, 2 * D};
    pg8::gemm_phase<pg8::EpiGate, pg8::DenseOrder, true, true>(F.lds, g, S, E, F.tid);
    if (layer == 0) deferred_conv(F, (NTOK / 256) * (D / 256), DW_L0_OUT, DW_Q); else if (layer == 1) deferred_conv(F, (NTOK / 256) * (D / 256), DW_L1_OUT, DW_Q);
}

__device__ __forceinline__ unsigned* cnt_word(const Frame& F, int slot, int hf, int e) { return (unsigned*)(F.ws + WS_CTL) + CW_CNT + ((slot * 2 + hf) * 8 + e) * 64; }
template <bool MOE> __device__ __forceinline__ void ln1_body(const Frame& F, int layer, bool last) {
    constexpr bool moe = MOE;
    bf16_t* X = (bf16_t*)(F.ws + WS_X); bf16_t* H = (bf16_t*)(F.ws + WS_H);
    const float* MOD = (const float*)(F.ws + WS_MOD) + (size_t)layer * 17 * MODW;
    const float* lg = F.in[I_LNG] + (size_t)(layer * 2) * D; const float* lb = F.in[I_LNB] + (size_t)(layer * 2) * D;
    const int slot = layer >> 1;
    const int nrows = last ? NLAT : NTOK;
    float rw[16][8];
    if (moe) { const float* R = F.in[I_RW] + (size_t)slot * D * 8;
#pragma unroll
        for (int j = 0; j < 4; ++j)
#pragma unroll
            for (int k = 0; k < 4; ++k) { const int lane = F.lane; const f32x4 a = *(const f32x4*)(R + (size_t)(RIDX(j) + k) * 8), b2 = *(const f32x4*)(R + (size_t)(RIDX(j) + k) * 8 + 4);
                rw[j * 4 + k][0] = a[0]; rw[j * 4 + k][1] = a[1]; rw[j * 4 + k][2] = a[2]; rw[j * 4 + k][3] = a[3]; rw[j * 4 + k][4] = b2[0]; rw[j * 4 + k][5] = b2[1]; rw[j * 4 + k][6] = b2[2]; rw[j * 4 + k][7] = b2[3]; } }
    int nrec = 0;
    if (moe) { __syncthreads(); if (F.tid < 32) ((LAS unsigned*)F.lds)[F.tid] = 0u; __syncthreads(); }
    const bf16_t* DL = (const bf16_t*)(F.ws + WS_DELTA1);
    const int rpw = (nrows + F.NGW - 1) / F.NGW, rbeg = F.gw * rpw, rend = (rbeg + rpw < nrows) ? rbeg + rpw : nrows;
    f32x4 G[4], B[4], SC[4], SH[4]; int mcur = -1;
    if (!moe) { col_load(lg, F.lane, G); col_load(lb, F.lane, B); }
    RowRaw r0 = {}, r1 = {};
    if (rbeg < rend) row_issue<true>(X, DL, rbeg, F.lane, r0);
    if (rbeg + 1 < rend) row_issue<true>(X, DL, rbeg + 1, F.lane, r1);
    for (int row = rbeg; row < rend; ++row) {
        f32x4 v[4], hv[4];
        row_combine(r0, v); r0 = r1;
        if (row + 2 < rend) row_issue<true>(X, DL, row + 2, F.lane, r1);
        const float* m = MOD + (size_t)mod_row_of(row) * MODW;
        if (moe) {
            row_ln(v, lg, lb, F.lane);
            row_store_h(X + (size_t)row * D, F.lane, v);
            row_mod_store8((unsigned char*)H + (size_t)row * D, F.lane, v, m + 3 * D, m + 4 * D, hv);
        } else {
            row_ln_r(v, G, B);
            row_store_h(X + (size_t)row * D, F.lane, v);
            const int mr = mod_row_of(row);
            if (mr != mcur) { col_load(m + 4 * D, F.lane, SC, 1.0f); col_load(m + 3 * D, F.lane, SH); mcur = mr; }
#pragma unroll
            for (int q = 0; q < 4; ++q) hv[q] = v[q] * SC[q] + SH[q];
            if ((FP8_DENSE1_MASK >> slot) & 1) {
#pragma unroll
                for (int j = 0; j < 2; ++j) { const f32x4 t0 = hv[2 * j] * (float)(1 << S8_ACT), t1 = hv[2 * j + 1] * (float)(1 << S8_ACT); u32x2 w8; w8.x = pk8(t0[0], t0[1], t0[2], t0[3]); w8.y = pk8(t1[0], t1[1], t1[2], t1[3]);
                    *(u32x2*)((unsigned char*)H + (size_t)row * D + 8 * F.lane + 512 * j) = w8; }
            } else row_store_h(H + (size_t)row * D, F.lane, hv);
        }
        if (moe) {
            float lg8[8];
#pragma unroll
            for (int e = 0; e < 8; ++e) { float s = 0.f;
#pragma unroll
                for (int j = 0; j < 4; ++j)
#pragma unroll
                    for (int k = 0; k < 4; ++k) s += hv[j][k] * rw[j * 4 + k][e];
                lg8[e] = wave_sum(s); }
            int e0 = 0; float v0 = lg8[0];
#pragma unroll
            for (int e = 1; e < 8; ++e) if (lg8[e] > v0) { v0 = lg8[e]; e0 = e; }
            int e1 = -1; float v1 = -INFINITY;
#pragma unroll
            for (int e = 0; e < 8; ++e) if (e != e0 && lg8[e] > v1) { v1 = lg8[e]; e1 = e; }
            if (F.lane == 0) {
                const unsigned s0 = __hip_atomic_fetch_add((LAS unsigned*)F.lds + e0, 1u, __ATOMIC_RELAXED, __HIP_MEMORY_SCOPE_WORKGROUP), s1 = __hip_atomic_fetch_add((LAS unsigned*)F.lds + e1, 1u, __ATOMIC_RELAXED, __HIP_MEMORY_SCOPE_WORKGROUP);
                const float ex = __expf(v1 - v0), g0 = 1.0f / (1.0f + ex);
                ((LAS u32x4*)(F.lds + 256))[F.wave * 32 + nrec] = (u32x4){(unsigned)e0 | ((unsigned)e1 << 8), s0, s1, (unsigned)row};
                *(f32x2*)(F.ws + WS_GATES + (size_t)row * 8) = (f32x2){g0, ex * g0};
            }
            ++nrec;
        }
    }
    if (moe) {
        __syncthreads();
        if (F.tid < 8) ((LAS unsigned*)F.lds)[16 + F.tid] = atomicAdd(cnt_word(F, slot, 0, F.tid), ((LAS unsigned*)F.lds)[F.tid]);
        __syncthreads();
        int* list = (int*)(F.ws + WS_LIST);
        if (F.lane < nrec) { const u32x4 rc = ((LAS u32x4*)(F.lds + 256))[F.wave * 32 + F.lane]; const int e0 = rc.x & 255, e1 = (rc.x >> 8) & 255; const int row = (int)rc.w;
            const unsigned s0 = ((LAS unsigned*)F.lds)[16 + e0] + rc.y, s1 = ((LAS unsigned*)F.lds)[16 + e1] + rc.z;
            list[e0 * NTOK + s0] = row; list[e1 * NTOK + s1] = row;
            *(u32x4*)(F.ws + WS_ROUTE + (size_t)row * 16) = (u32x4){rc.x, s0, s1, 0u}; }
    }
}

__device__ __forceinline__ void p_ln1(const Frame& F, int layer, bool last) { if (layer & 1) ln1_body<true>(F, layer, last); else ln1_body<false>(F, layer, last); }

__device__ __forceinline__ void p_ffn1_dense(const Frame& F, int layer, bool last) {
    const int s = layer >> 1;
#if USE_FP8 && FP8_DENSE2
    typedef pg8::EpiSwiGLU8 EpiH; EpiH E{F.ws + WS_HID, DFF};
#else
    typedef pg8::EpiSwiGLU EpiH; EpiH E{(bf16_t*)(F.ws + WS_HID), DFF};
#endif
    if ((FP8_DENSE1_MASK >> s) & 1) {
        pg8::Gemm g{(const bf16_t*)(F.ws + WS_H), (const bf16_t*)(F.ws + WS_WFGU + (size_t)s * 2 * DFF * D * 2), D / 2};
        pg8::DenseOrder S; S.init(last ? NLAT : NTOK, 2 * DFF, D / 2, F.G, F.bid, REP_GEMM);
        pg8::gemm_phase<EpiH, pg8::DenseOrder, true, FP8_SP2, true>(F.lds, g, S, E, F.tid, (127 - S8_WGU) * 0x01010101, (127 - S8_ACT) * 0x01010101);
    } else {
        pg8::Gemm g{(const bf16_t*)(F.ws + WS_H), (const bf16_t*)(F.ws + WS_WFGU) + (size_t)s * 2 * DFF * D, D};
        pg8::DenseOrder S; S.init(last ? NLAT : NTOK, 2 * DFF, D, F.G, F.bid, REP_GEMM);
        pg8::gemm_phase<EpiH, pg8::DenseOrder, true, true>(F.lds, g, S, E, F.tid);
    }
    if (layer == 0) deferred_conv(F, (NTOK / 256) * (2 * DFF / 256), DW_L0_F1, DW_Q);
}
__device__ __forceinline__ void p_ffn2_dense(const Frame& F, int layer, bool last) {
    const int s = layer >> 1;
    pg8::EpiGate E{(bf16_t*)(F.ws + WS_DELTA2), (const float*)(F.ws + WS_MOD) + (size_t)layer * 17 * MODW, 5 * D};
#if USE_FP8 && FP8_DENSE2
    pg8::Gemm g{(const bf16_t*)(F.ws + WS_HID), (const bf16_t*)(F.ws + WS_WFD + (size_t)s * D * DFF), DFF / 2};
    pg8::DenseOrder S; S.init(last ? NLAT : NTOK, D, DFF / 2, F.G, F.bid);
    pg8::gemm_phase<pg8::EpiGate, pg8::DenseOrder, true, FP8_SP2, true>(F.lds, g, S, E, F.tid, (127 - S8_WD) * 0x01010101, (127 - S8_HID) * 0x01010101);
#else
    pg8::Gemm g{(const bf16_t*)(F.ws + WS_HID), (const bf16_t*)(F.ws + WS_WFD) + (size_t)s * D * DFF, DFF};
    pg8::DenseOrder S; S.init(last ? NLAT : NTOK, D, DFF, F.G, F.bid);
    pg8::gemm_phase<pg8::EpiGate, pg8::DenseOrder, true, true>(F.lds, g, S, E, F.tid);
#endif
    if (layer == 0) deferred_conv(F, (NTOK / 256) * (D / 256), DW_L0_F2, DW_Q2);
}
__device__ __forceinline__ void moe_prefix(const Frame& F, int slot, int hf, int (&ts)[9], int (&cn)[8]) {
    int a = 0;
#pragma unroll
    for (int e = 0; e < 8; ++e) { cn[e] = (int)*cnt_word(F, slot, hf, e); ts[e] = a; a += (cn[e] + 255) >> 8; }
    ts[8] = a;
}
__device__ __forceinline__ void p_ffn1_moe(const Frame& F, int layer) {
    const int slot = layer >> 1; int cn[8];
    pg8::MoeOrder<true> S; moe_prefix(F, slot, 0, S.ts, cn);
    S.nM = S.ts[8]; S.nN = 2 * DFFE / 256; S.G = F.G; S.c = F.bid; S.K = D / 2; S.estride = (long)2 * DFFE * D; S.rowoff = (const LAS unsigned short*)(F.lds + LDS_ROWOFF); S.rowbytes = D;
    {
        const int* list = (const int*)(F.ws + WS_LIST); LAS unsigned short* ro = (LAS unsigned short*)(F.lds + LDS_ROWOFF); pg8::Unit u;
        for (int i = F.wave; i < 36 && S.next(i, u); i += NWAVES) { const int e = S.expert_of(u.pm); int tse = 0, cne = 0;
#pragma unroll
            for (int j = 0; j < 8; ++j) { tse = (j == e) ? S.ts[j] : tse; cne = (j == e) ? cn[j] : cne; }
            int tk[4];
#pragma unroll
            for (int q = 0; q < 4; ++q) { const int sl = (u.pm - tse) * 256 + F.lane + 64 * q; tk[q] = sl < cne ? list[e * NTOK + sl] : 0; }
#pragma unroll
            for (int q = 0; q < 4; ++q) ro[i * 256 + F.lane + 64 * q] = (unsigned short)tk[q]; }
        __syncthreads();
    }
    pg8::Gemm g{(const bf16_t*)(F.ws + WS_H), (const bf16_t*)(F.ws + WS_WMGU + (size_t)slot * NEXP * 2 * DFFE * D), D / 2};
    pg8::EpiSwiGLU8 E{F.ws + WS_HID, DFFE};
    pg8::gemm_phase<pg8::EpiSwiGLU8, pg8::MoeOrder<true>, true, FP8_SP2, true>(F.lds, g, S, E, F.tid, (127 - S8_WGU) * 0x01010101, (127 - S8_ACT) * 0x01010101);
}
__device__ __forceinline__ void p_ffn2_moe(const Frame& F, int layer) {
    const int slot = layer >> 1; int cn[8];
    pg8::MoeOrder<false> S; moe_prefix(F, slot, 0, S.ts, cn);
    S.nM = S.ts[8]; S.nN = D / 256; S.G = F.G; S.c = F.bid; S.K = DFFE / 2; S.estride = (long)D * DFFE; S.rowoff = nullptr; S.rowbytes = 0;
    pg8::EpiBf16 E{(bf16_t*)(F.ws + WS_YP), D};
    pg8::Gemm g{(const bf16_t*)(F.ws + WS_HID), (const bf16_t*)(F.ws + WS_WMD + (size_t)slot * NEXP * D * DFFE), DFFE / 2};
    pg8::gemm_phase<pg8::EpiBf16, pg8::MoeOrder<false>, true, FP8_SP2, true>(F.lds, g, S, E, F.tid, (127 - S8_WD) * 0x01010101, (127 - S8_HID) * 0x01010101);
}

template <bool MOE> __device__ __forceinline__ void ln2_body(const Frame& F, int layer, bool last) {
    bf16_t* X = (bf16_t*)(F.ws + WS_X); bf16_t* H = (bf16_t*)(F.ws + WS_H);
    const float* MOD = (const float*)(F.ws + WS_MOD) + (size_t)layer * 17 * MODW;
    const float* lg = F.in[I_LNG] + (size_t)(layer * 2 + 1) * D; const float* lb = F.in[I_LNB] + (size_t)(layer * 2 + 1) * D;
    const int slot = layer >> 1;
    const int nrows = last ? NLAT : NTOK;
    int ts0[9], cn[8];
    if (MOE) moe_prefix(F, slot, 0, ts0, cn);
    const bf16_t* YP = (const bf16_t*)(F.ws + WS_YP); const bf16_t* DL = (const bf16_t*)(F.ws + WS_DELTA2);
    const int rpw = (nrows + F.NGW - 1) / F.NGW, rbeg = F.gw * rpw, rend = (rbeg + rpw < nrows) ? rbeg + rpw : nrows;
    f32x4 G[4], B[4], SC[4], SH[4], Q[4]; int mcur = -1;
    col_load(lg, F.lane, G); col_load(lb, F.lane, B);
    RowRaw r0 = {}, r1 = {}; u32x4 rt0 = {0u, 0u, 0u, 0u}, rt1 = {0u, 0u, 0u, 0u}; f32x2 g0 = {0.f, 0.f}, g1 = {0.f, 0.f}; u32x4 ya[2] = {}, yb[2] = {};
#define LN2_ISSUE(row_, r_, rt_, g_) do { row_issue<!MOE>(X, DL, (row_), F.lane, r_); \
        if (MOE) { rt_ = *(const u32x4*)(F.ws + WS_ROUTE + (size_t)(row_) * 16); g_ = *(const f32x2*)(F.ws + WS_GATES + (size_t)(row_) * 8); } } while (0)
#define LN2_ISSUE_Y(rt_) do { const int e0_ = (rt_).x & 255, e1_ = ((rt_).x >> 8) & 255; int t0_ = 0, t1_ = 0; \
        _Pragma("unroll") for (int e = 0; e < 8; ++e) { const int tv = ts0[e]; t0_ = (e == e0_) ? tv : t0_; t1_ = (e == e1_) ? tv : t1_; } \
        const bf16_t* y0_ = YP + ((size_t)t0_ * 256 + (rt_).y) * D; const bf16_t* y1_ = YP + ((size_t)t1_ * 256 + (rt_).z) * D; \
        _Pragma("unroll") for (int j = 0; j < 2; ++j) { ya[j] = *(const u32x4*)(y0_ + 8 * F.lane + 512 * j); yb[j] = *(const u32x4*)(y1_ + 8 * F.lane + 512 * j); } } while (0)
    if (rbeg < rend) LN2_ISSUE(rbeg, r0, rt0, g0);
    if (rbeg + 1 < rend) LN2_ISSUE(rbeg + 1, r1, rt1, g1);
    if (MOE) { if (rbeg < rend) LN2_ISSUE_Y(rt0); }
    for (int row = rbeg; row < rend; ++row) {
        f32x4 v[4], hv[4];
        const int mr = mod_row_of(row);
        if (mr != mcur) { const float* m = MOD + (size_t)mr * MODW; if (MOE) col_load(m + 5 * D, F.lane, Q, 1.0f);
            if (!last) { const float* mn = m + (size_t)17 * MODW; col_load(mn + D, F.lane, SC, 1.0f); col_load(mn, F.lane, SH); }
            mcur = mr; }
        if (MOE) {
#pragma unroll
            for (int j = 0; j < 2; ++j) { f32x4 x0, x1, a0, a1, b0, b1; unpack8(r0.x[j], x0, x1); unpack8(ya[j], a0, a1); unpack8(yb[j], b0, b1);
                v[2 * j] = x0 * ALPHA + Q[2 * j] * (a0 * g0[0] + b0 * g0[1]); v[2 * j + 1] = x1 * ALPHA + Q[2 * j + 1] * (a1 * g0[0] + b1 * g0[1]); }
        } else row_combine(r0, v);
        r0 = r1; rt0 = rt1; g0 = g1;
        if (MOE) { if (row + 1 < rend) LN2_ISSUE_Y(rt0); }
        if (row + 2 < rend) LN2_ISSUE(row + 2, r1, rt1, g1);
        row_ln_r(v, G, B);
        if (last) row_store(F.out + (size_t)row * D, F.lane, v);
        else { row_store_h(X + (size_t)row * D, F.lane, v);
#pragma unroll
            for (int q = 0; q < 4; ++q) hv[q] = v[q] * SC[q] + SH[q];
            row_store_h(H + (size_t)row * D, F.lane, hv); }
    }
#undef LN2_ISSUE
#undef LN2_ISSUE_Y
}
__device__ __forceinline__ void p_ln2(const Frame& F, int layer, bool last) { if (layer & 1) ln2_body<true>(F, layer, last); else ln2_body<false>(F, layer, last); }

constexpr int NPL = 9;
constexpr int NPH = 2 + NPL * DEPTH;
#ifndef SITE_MASK
#define SITE_MASK 0xFFFFF
#endif
#ifndef TPROBE_MULT
#define TPROBE_MULT 4
#endif
#define SITE(n) (((SITE_MASK) >> (n)) & 1)
__global__ void __launch_bounds__(NT, 2) fwd_kernel(Args args) {
    extern __shared__ __attribute__((aligned(16))) unsigned char lds_raw[];
    Frame F;
    F.lds = (LAS unsigned char*)lds_raw; F.in = args.in; F.out = args.out; F.ws = args.ws;
    F.tid = threadIdx.x; F.lane = F.tid & 63; F.wave = __builtin_amdgcn_readfirstlane(F.tid >> 6); F.bid = blockIdx.x; F.G = gridDim.x;
    F.gw = F.bid * NWAVES + F.wave; F.NGW = F.G * NWAVES;
    volatile LAS unsigned* MISC = (volatile LAS unsigned*)(F.lds + LDS_MISC);
    if (F.tid < 64) MISC[F.tid] = 0u;
    __syncthreads();
    XcdBarrier bar; bar.bar = (unsigned*)(F.ws + WS_CTL) + CW_BAR; bar.x = 0; bar.st = MISC + 8;
#if MK_SINGLE
    bar = xcd_barrier_post((unsigned*)(F.ws + WS_CTL) + CW_BAR, MISC + 8);
#endif
    const int lo = args.ph_lo, hi = args.ph_hi;
#define IN(k) (lo <= (k) && (k) < hi)
#if TPROBE >= 0
    unsigned long long tp_prev = __builtin_amdgcn_s_memrealtime(), tp_acc = 0ull;
#define TP(type) do { const unsigned long long t_ = __builtin_amdgcn_s_memrealtime(); if ((type) == TPROBE) tp_acc += t_ - tp_prev; tp_prev = t_; } while (0)
#else
#define TP(type) do { } while (0)
#endif
#if MK_SINGLE
#define SEAM(k) do { if (IN(k) && IN((k) + 1)) { XcdBarrier b2_ = bar; int z_; asm volatile("s_mov_b32 %0, 0" : "=s"(z_)); b2_.bar = bar.bar + z_; int ln_; asm volatile("v_mbcnt_lo_u32_b32 %0, -1, 0\n\tv_mbcnt_hi_u32_b32 %0, -1, %0" : "=v"(ln_)); xcd_barrier(b2_, F.wave == 0 && ln_ == 0); } } while (0)
#else
#define SEAM(k) do { } while (0)
#endif
    if constexpr (SITE(0)) if (IN(0)) p_pro_a(fresh(F));
    SEAM(0); TP(0);
    if constexpr (SITE(1)) if (IN(1)) p_pro_b(fresh(F));
    SEAM(1); TP(1);
    for (int layer = 0; layer < DEPTH; ++layer) {
        const int pb = 2 + NPL * layer; const bool last = layer == DEPTH - 1; const bool moe = layer & 1;
        if constexpr (SITE(2)) if (IN(pb + 0)) p_inproj(fresh(F), layer);
        SEAM(pb + 0); TP(2);
        if constexpr (SITE(3)) if (IN(pb + 1)) p_mixa(fresh(F), layer, last);
        SEAM(pb + 1); TP(3);
        if constexpr (SITE(12)) if (IN(pb + 2)) p_mixb(fresh(F), layer);
        SEAM(pb + 2); TP(4);
        if constexpr (SITE(4)) if (IN(pb + 3)) { p_ssdcomb(fresh(F), layer, last); if (!USE_FP8 && layer == 2) { int rot = 0; conv_moe(fresh(F), 1, rot); } }
        SEAM(pb + 3); TP(5);
        if constexpr (SITE(5)) if (IN(pb + 4)) p_outproj(fresh(F), layer, last);
        SEAM(pb + 4); TP(6);
        if constexpr (SITE(6)) if (IN(pb + 5)) p_ln1(fresh(F), layer, last);
        SEAM(pb + 5); TP(7);
        if (moe) {
            if constexpr (SITE(7)) if (IN(pb + 6)) p_ffn1_moe(fresh(F), layer);
            SEAM(pb + 6); TP(8);
            if constexpr (SITE(8)) if (IN(pb + 7)) p_ffn2_moe(fresh(F), layer);
            SEAM(pb + 7); TP(9);
        } else {
            if constexpr (SITE(9)) if (IN(pb + 6)) p_ffn1_dense(fresh(F), layer, last);
            SEAM(pb + 6); TP(10);
            if constexpr (SITE(10)) if (IN(pb + 7)) p_ffn2_dense(fresh(F), layer, last);
            SEAM(pb + 7); TP(11);
        }
        if constexpr (SITE(11)) if (IN(pb + 8)) p_ln2(fresh(F), layer, last);
        if (!last) SEAM(pb + 8);
        TP(12);
    }
#if TPROBE >= 100
    __syncthreads(); tp_acc = ((volatile LAS unsigned*)(F.lds + LDS_MISC))[40];
#endif
#if TPROBE >= 0
    { const unsigned long long t_end = __builtin_amdgcn_s_memrealtime(); while (__builtin_amdgcn_s_memrealtime() - t_end < (unsigned long long)TPROBE_MULT * tp_acc) __builtin_amdgcn_s_sleep(8); }
#endif
#undef IN
#undef SEAM
}

extern "C" void kernel_launch(void* const* d_in, const int* in_sizes, int n_in, void* d_out, int out_size, void* d_ws, size_t ws_size, hipStream_t stream) {
    static int grid = 0;
    if (grid == 0) {
        if (n_in != 24 || out_size != NLAT * D || ws_size < WS_END) { fprintf(stderr, "kernel_launch: unexpected shapes (n_in %d, out %d, ws %zu < %zu)\n", n_in, out_size, ws_size, (size_t)WS_END); grid = -1; return; }
        int dev = 0, cus = 0, per_cu = 0;
        if (hipGetDevice(&dev) != hipSuccess || hipDeviceGetAttribute(&cus, hipDeviceAttributeMultiprocessorCount, dev) != hipSuccess) { grid = -1; return; }
        if (hipFuncSetAttribute((const void*)fwd_kernel, hipFuncAttributeMaxDynamicSharedMemorySize, LDS_BYTES) != hipSuccess) { fprintf(stderr, "kernel_launch: hipFuncSetAttribute failed\n"); grid = -1; return; }
        if (hipOccupancyMaxActiveBlocksPerMultiprocessor(&per_cu, (const void*)fwd_kernel, NT, LDS_BYTES) != hipSuccess || per_cu < 1) { fprintf(stderr, "kernel_launch: occupancy query says %d\n", per_cu); }
        (void)hipGetLastError();
        grid = cus;
    }
    if (grid < 0) return;
    (void)in_sizes;
    if (hipMemsetAsync((char*)d_ws + WS_CTL, 0, CTL_BYTES, stream) != hipSuccess) return;
    Args a{};
    for (int i = 0; i < 24; ++i) a.in[i] = (const float*)d_in[i];
    a.out = (float*)d_out; a.ws = (unsigned char*)d_ws;
#if MK_SINGLE
    a.ph_lo = 0; a.ph_hi = NPH;
    hipLaunchKernelGGL(fwd_kernel, dim3(grid), dim3(NT), LDS_BYTES, stream, a);
#else
    for (int ph = 0; ph < NPH; ++ph) {

        a.ph_lo = ph; a.ph_hi = ph + 1;
        hipLaunchKernelGGL(fwd_kernel, dim3(grid), dim3(NT), LDS_BYTES, stream, a);
    }
#endif
}
```

```cpp
#include <hip/hip_runtime.h>
#include <cstdio>
#include <cstdint>

#ifndef MK_SINGLE
#define MK_SINGLE 1
#endif

#ifndef FP8_INPROJ
#define FP8_INPROJ 0
#endif
#ifndef FP8_DENSE1_MASK
#define FP8_DENSE1_MASK 2
#endif
#ifndef FP8_DENSE2
#define FP8_DENSE2 1
#endif
#ifndef USE_FP8
#define USE_FP8 1
#endif
#ifndef FP8_SP2
#define FP8_SP2 true
#endif
#ifndef REP_SSD
#define REP_SSD 1
#endif
#ifndef REP_NA
#define REP_NA 1
#endif
#ifndef REP_GEMM
#define REP_GEMM 1
#endif
#define GAS __attribute__((address_space(1)))
#define LAS __attribute__((address_space(3)))
typedef unsigned short bf16_t;
typedef short bf16x8 __attribute__((ext_vector_type(8)));
typedef float f32x4 __attribute__((ext_vector_type(4)));
typedef float f32x2 __attribute__((ext_vector_type(2)));
typedef unsigned u32x4 __attribute__((ext_vector_type(4)));
typedef unsigned u32x2 __attribute__((ext_vector_type(2)));
typedef int i32x4 __attribute__((ext_vector_type(4)));
typedef int i32x8 __attribute__((ext_vector_type(8)));

constexpr int D = 1024, BATCH = 16, SEQ = 2048, DEPTH = 4, GRID_W = 64, CTX = 256;
constexpr int NLAT = BATCH * SEQ;
constexpr int NCTX = BATCH * CTX;
constexpr int NTOK = NLAT + NCTX;
constexpr int NPROJ = 3072;
constexpr int OFF_K = 512, OFF_V = 1024, OFF_Z = 1536, OFF_XBC = 2048;
constexpr int D_IN_PROJ = 3088;
constexpr int DFF = 2816, DFFE = 3584, NEXP = 8;
constexpr float ALPHA = 1.6817928305074290f;
constexpr float LN_EPS = 1e-5f, RMS_EPS = 1e-5f;
constexpr int MODW = 6 * D;

constexpr size_t MiB = 1u << 20;
constexpr size_t WS_CTL = 0, CTL_BYTES = 1 * MiB;
constexpr size_t WS_MOD = 1 * MiB;
constexpr size_t WS_ROUTE = 3 * MiB;
constexpr size_t WS_GATES = 4 * MiB;
constexpr size_t WS_LIST = 5 * MiB;
constexpr size_t WS_WDT = 7 * MiB;
constexpr size_t WS_WIN = 8 * MiB;
constexpr size_t WS_WOUT = 32 * MiB;
constexpr size_t WS_WFGU = 40 * MiB;
constexpr size_t WS_WFD = 62 * MiB;
constexpr size_t WS_WMGU = 73 * MiB;
constexpr size_t WS_WMD = 185 * MiB;
constexpr size_t WS_X = 241 * MiB;
constexpr size_t WS_H = 385 * MiB;
constexpr size_t WS_R = 457 * MiB;
constexpr size_t WS_PROJ = WS_R;
constexpr size_t WS_DT = WS_R + 216 * MiB;
constexpr size_t WS_YF = WS_R + 219 * MiB;
constexpr size_t WS_YB = WS_R + 291 * MiB;
constexpr size_t WS_MIX = WS_R + 363 * MiB;
constexpr size_t WS_HID = WS_R;
constexpr size_t WS_YP = WS_R + 270 * MiB;
constexpr size_t WS_DELTA1 = WS_R;
constexpr size_t WS_DELTA2 = WS_R + 270 * MiB;
constexpr size_t WS_U = WS_R + 435 * MiB;
constexpr size_t WS_H8IN = WS_U;
constexpr size_t WS_END = WS_R + 507 * MiB;
constexpr int MOE_PAD = 2 * NTOK + 2048;
static_assert(USE_FP8 == 1, "the single-phase MoE needs the e4m3 hidden (the bf16 one does not fit the workspace)");
static_assert(WS_HID + (size_t)MOE_PAD * 3584 <= WS_YP && WS_YP + (size_t)MOE_PAD * 1024 * 2 <= WS_END, "MoE buffers");

constexpr int CW_TMO = 0;
constexpr int CW_BAR = 4096;
constexpr int CW_CNT = 16384;

constexpr int LDS_STAGE = 131072;
constexpr int LDS_ROWOFF = 131072;
constexpr int LDS_MISC = 131072 + 18432;
constexpr int LDS_BYTES = 155648;

constexpr int S8_ACT = 3, S8_WGU = 8, S8_HID = 2, S8_WD = 9;
#ifndef TPROBE
#define TPROBE (-1)
#endif
#if TPROBE >= 100
#define TPS_BEGIN unsigned long long tps_t_ = __builtin_amdgcn_s_memrealtime()
#define TPS(k) do { const unsigned long long t_ = __builtin_amdgcn_s_memrealtime(); if (TPROBE == 100 + (k) && F.tid == 0) ((volatile LAS unsigned*)(F.lds + LDS_MISC))[40] += (unsigned)(t_ - tps_t_); tps_t_ = t_; } while (0)
#else
#define TPS_BEGIN do { } while (0)
#define TPS(k) do { } while (0)
#endif
#define GATE_PRESCALE (-1.4426950408889634f)
__device__ __forceinline__ unsigned f2bf(float f) { unsigned u = __builtin_bit_cast(unsigned, f); return (u + 0x7fffu + ((u >> 16) & 1u)) >> 16; }
typedef __bf16 bf16x2_t __attribute__((ext_vector_type(2)));
__device__ __forceinline__ unsigned pk2(float lo, float hi) { const f32x2 v = {lo, hi}; const bf16x2_t b = __builtin_convertvector(v, bf16x2_t); return __builtin_bit_cast(unsigned, b); }
__device__ __forceinline__ float bf2f(unsigned short b) { return __builtin_bit_cast(float, ((unsigned)b) << 16); }
__device__ __forceinline__ float bflo(unsigned w) { return __builtin_bit_cast(float, w << 16); }
__device__ __forceinline__ float bfhi(unsigned w) { return __builtin_bit_cast(float, w & 0xffff0000u); }
__device__ __forceinline__ float silu_f(float v) { return v / (1.0f + __expf(-v)); }
__device__ __forceinline__ float clamp8(float v) { return fminf(fmaxf(v, -448.0f), 448.0f); }
__device__ __forceinline__ unsigned pk8(float a, float b, float c, float d) {
    int w = 0; w = __builtin_amdgcn_cvt_pk_fp8_f32(clamp8(a), clamp8(b), w, false); w = __builtin_amdgcn_cvt_pk_fp8_f32(clamp8(c), clamp8(d), w, true); return (unsigned)w; }
template <int CTRL, int ROWMASK = 0xF, bool BC = false>
__device__ __forceinline__ float dpp_f(float v) { return __builtin_bit_cast(float, __builtin_amdgcn_update_dpp(0, __builtin_bit_cast(int, v), CTRL, ROWMASK, 0xF, BC)); }
__device__ __forceinline__ float row16_sum(float v) {
    v += dpp_f<0xB1>(v); v += dpp_f<0x4E>(v); v += dpp_f<0x141>(v); v += dpp_f<0x140>(v);
    return v;
}
__device__ __forceinline__ float wave_sum(float v) {
    v = row16_sum(v);
    v += dpp_f<0x142, 0xA>(v); v += dpp_f<0x143, 0xC>(v);
    return __builtin_bit_cast(float, __builtin_amdgcn_readlane(__builtin_bit_cast(int, v), 63));
}
__device__ __forceinline__ float xrow_max(float v) {
    unsigned u = __builtin_bit_cast(unsigned, v); auto r = __builtin_amdgcn_permlane16_swap(u, u, false, false);
    v = fmaxf(__builtin_bit_cast(float, r[0]), __builtin_bit_cast(float, r[1]));
    u = __builtin_bit_cast(unsigned, v); auto r2 = __builtin_amdgcn_permlane32_swap(u, u, false, false);
    return fmaxf(__builtin_bit_cast(float, r2[0]), __builtin_bit_cast(float, r2[1]));
}
__device__ __forceinline__ float xrow_sum(float v) {
    unsigned u = __builtin_bit_cast(unsigned, v); auto r = __builtin_amdgcn_permlane16_swap(u, u, false, false);
    v = __builtin_bit_cast(float, r[0]) + __builtin_bit_cast(float, r[1]);
    u = __builtin_bit_cast(unsigned, v); auto r2 = __builtin_amdgcn_permlane32_swap(u, u, false, false);
    return __builtin_bit_cast(float, r2[0]) + __builtin_bit_cast(float, r2[1]);
}
__device__ __forceinline__ float wave_scan(float v) {
    v += dpp_f<0x111, 0xF, true>(v); v += dpp_f<0x112, 0xF, true>(v); v += dpp_f<0x114, 0xF, true>(v); v += dpp_f<0x118, 0xF, true>(v);
    v += dpp_f<0x142, 0xA>(v); v += dpp_f<0x143, 0xC>(v);
    return v;
}

namespace pg8 {
constexpr int BM = 256, BK = 64, HALF = 128, HTB = HALF * BK * 2, STAGE_BYTES = 8 * HTB, NXCD = 8, WGM = 8;
__host__ __device__ __forceinline__ int lds_byte(int r, int c) { const int st = (r >> 4) * 2 + (c >> 5), rr = r & 15, cc = c & 31, ob = rr * 64 + cc * 2; return st * 1024 + (ob ^ (((ob >> 9) & 1) << 5)); }
__host__ __device__ __forceinline__ void stage_rc(int b, int& R, int& C) { const int st = b / 1024, sb = b % 1024, swz = sb ^ (((sb >> 9) & 1) << 5); R = (st >> 1) * 16 + swz / 64; C = (st & 1) * 32 + (swz % 64) / 2; }
__host__ __device__ __forceinline__ int perm32(int rho) { const int n = rho >> 4, i = rho & 15; return 8 * (i >> 2) + 4 * n + (i & 3); }

struct Unit { int pm, pn; long bofs; };
struct Gemm { const bf16_t* A; const bf16_t* Bt; int K; };

__device__ __forceinline__ unsigned cvt_pk_bf16(float lo, float hi) { return pk2(lo, hi); }
__device__ __forceinline__ unsigned cvt_pk_bf16_pin(float lo, float hi) { unsigned r; asm volatile("v_cvt_pk_bf16_f32 %0, %1, %2" : "=v"(r) : "v"(lo), "v"(hi)); return r; }

__device__ __forceinline__ bool static_tile(int i, int G, int c, int nM, int nN, int& pm, int& pn, int rep = 1) {
    const int nwg = nM * nN;
#if REP_GEMM > 1
    { const int cnt = (nwg - c + G - 1) / G; if (cnt <= 0 || i >= rep * cnt) return false; i %= cnt; }
#endif
    const long L = (long)i * G + c; if (L >= nwg) return false;
    int wgid = (int)L; { const int q = nwg / NXCD, r = nwg % NXCD, xcd = wgid % NXCD, off = wgid / NXCD; wgid = (xcd < r ? xcd * (q + 1) : r * (q + 1) + (xcd - r) * q) + off; }
    const int nig = WGM * nN, gid = wgid / nig, fm = gid * WGM, gsz = (nM - fm) < WGM ? (nM - fm) : WGM;
    pm = fm + ((wgid % nig) % gsz); pn = (wgid % nig) / gsz; return true;
}
struct DenseOrder {
    int nM, nN, G, c, K, rep;
    __device__ __forceinline__ void init(int M, int N, int K_, int G_, int c_, int rep_ = 1) { nM = M / BM; nN = N / BM; G = G_; c = c_; K = K_; rep = rep_; }
    __device__ __forceinline__ bool next(int i, Unit& u) const { if (!static_tile(i, G, c, nM, nN, u.pm, u.pn, rep)) return false; u.bofs = (long)u.pn * BM * K * 2; return true; }
    static constexpr bool GATHER = false;
    __device__ __forceinline__ long a_base(const Unit& u) const { return (long)u.pm * BM * K * 2; }
    __device__ __forceinline__ void a_offs(int, const Unit&, int, unsigned (&)[2][2]) const {}
};
template <bool GATHER_> struct MoeOrder {
    int nM, nN, G, c, K; int ts[9]; long estride; const LAS unsigned short* rowoff; unsigned rowbytes;
    __device__ __forceinline__ int expert_of(int pm) const { int e = 0;
#pragma unroll
        for (int j = 1; j < 8; ++j) e += (pm >= ts[j]) ? 1 : 0; return e; }
    __device__ __forceinline__ bool next(int i, Unit& u) const { if (!static_tile(i, G, c, nM, nN, u.pm, u.pn, REP_GEMM)) return false; u.bofs = (long)expert_of(u.pm) * estride + (long)u.pn * BM * K * 2; return true; }
    static constexpr bool GATHER = GATHER_;
    __device__ __forceinline__ long a_base(const Unit& u) const { return GATHER_ ? 0l : (long)u.pm * BM * K * 2; }
    __device__ __forceinline__ void a_offs(int ui, const Unit&, int tid, unsigned (&o)[2][2]) const {
        int uix = ui;
#if REP_GEMM > 1
        { const int cnt = (nM * nN - c + G - 1) / G; uix = ui % cnt; }
#endif
        if (GATHER_) {
#pragma unroll
            for (int i = 0; i < 2; ++i) { int R, C; stage_rc(tid * 16 + i * 8192, R, C);
#pragma unroll
                for (int h = 0; h < 2; ++h) o[h][i] = (unsigned)rowoff[uix * 256 + h * HALF + R] * rowbytes + (unsigned)(C * 2); }
        }
    }
};

struct EpiBf16 {
    static constexpr bool PERM = true;
    bf16_t* O; int ldc;
    __device__ __forceinline__ void operator()(const f32x4 (&acc)[2][2][4][2], const Unit& u, int wr, int wc, int fr, int fq) const {
        const int row0 = u.pm * BM + wr * 64 + fr; const int col0 = u.pn * BM + wc * 32 + 8 * fq;
#pragma unroll
        for (int ai = 0; ai < 2; ++ai)
#pragma unroll
            for (int m = 0; m < 4; ++m) { bf16_t* rowp = O + (size_t)(row0 + ai * HALF + m * 16) * ldc + col0;
#pragma unroll
                for (int bj = 0; bj < 2; ++bj) { const f32x4 v0 = acc[ai][bj][m][0], v1 = acc[ai][bj][m][1];
                    u32x4 w; w.x = cvt_pk_bf16(v0[0], v0[1]); w.y = cvt_pk_bf16(v0[2], v0[3]); w.z = cvt_pk_bf16(v1[0], v1[1]); w.w = cvt_pk_bf16(v1[2], v1[3]);
                    *(u32x4*)(rowp + bj * HALF) = w; } }
    }
};
struct EpiSwiGLU {
    static constexpr bool PERM = true;
    bf16_t* O; int ldc;
    __device__ __forceinline__ void operator()(const f32x4 (&acc)[2][2][4][2], const Unit& u, int wr, int wc, int fr, int fq) const {
        const int row0 = u.pm * BM + wr * 64 + fr; const int col0 = u.pn * HALF + wc * 32 + 8 * fq;
#pragma unroll
        for (int ai = 0; ai < 2; ++ai)
#pragma unroll
            for (int m = 0; m < 4; ++m) { bf16_t* rowp = O + (size_t)(row0 + ai * HALF + m * 16) * ldc + col0;
                float h[8];
#pragma unroll
                for (int n = 0; n < 2; ++n)
#pragma unroll
                    for (int j = 0; j < 4; ++j) { const float gp = acc[ai][0][m][n][j], up = acc[ai][1][m][n][j];
                        h[n * 4 + j] = (gp * up) * __builtin_amdgcn_rcpf(__builtin_fmaf(__builtin_amdgcn_exp2f(gp), GATE_PRESCALE, GATE_PRESCALE)); }
                u32x4 w; w.x = cvt_pk_bf16(h[0], h[1]); w.y = cvt_pk_bf16(h[2], h[3]); w.z = cvt_pk_bf16(h[4], h[5]); w.w = cvt_pk_bf16(h[6], h[7]);
                *(u32x4*)rowp = w; }
    }
};
struct EpiSwiGLU8 {
    static constexpr bool PERM = true;
    unsigned char* O; int ldc;
    __device__ __forceinline__ void operator()(const f32x4 (&acc)[2][2][4][2], const Unit& u, int wr, int wc, int fr, int fq) const {
        const int row0 = u.pm * BM + wr * 64 + fr; const int col0 = u.pn * HALF + wc * 32 + 8 * fq;
#pragma unroll
        for (int ai = 0; ai < 2; ++ai)
#pragma unroll
            for (int m = 0; m < 4; ++m) { unsigned char* rowp = O + (size_t)(row0 + ai * HALF + m * 16) * ldc + col0;
                float h[8];
#pragma unroll
                for (int n = 0; n < 2; ++n)
#pragma unroll
                    for (int j = 0; j < 4; ++j) { const float gp = acc[ai][0][m][n][j], up = acc[ai][1][m][n][j];
                        constexpr float C8 = GATE_PRESCALE / (float)(1 << S8_HID); h[n * 4 + j] = (gp * up) * __builtin_amdgcn_rcpf((__builtin_amdgcn_exp2f(gp) + 1.0f) * C8); }
                u32x2 w; w.x = pk8(h[0], h[1], h[2], h[3]); w.y = pk8(h[4], h[5], h[6], h[7]);
                *(u32x2*)rowp = w; }
    }
};
struct EpiGate {
    static constexpr bool PERM = true;
    bf16_t* O; const float* mod; int gate_off;
    __device__ __forceinline__ void operator()(const f32x4 (&acc)[2][2][4][2], const Unit& u, int wr, int wc, int fr, int fq) const {
        const int rt = u.pm * BM; const int bi = rt >= NLAT ? 16 : (rt >> 11);
        const int col0 = u.pn * BM + wc * 32 + 8 * fq; const float* gt = mod + bi * MODW + gate_off + col0;
        f32x4 gv[2][2];
#pragma unroll
        for (int bj = 0; bj < 2; ++bj)
#pragma unroll
            for (int n = 0; n < 2; ++n) gv[bj][n] = *(const f32x4*)(gt + bj * HALF + 4 * n) + 1.0f;
        const int row0 = rt + wr * 64 + fr;
#pragma unroll
        for (int ai = 0; ai < 2; ++ai)
#pragma unroll
            for (int m = 0; m < 4; ++m) { bf16_t* rowp = O + (size_t)(row0 + ai * HALF + m * 16) * D + col0;
#pragma unroll
                for (int bj = 0; bj < 2; ++bj) { const f32x4 v0 = acc[ai][bj][m][0] * gv[bj][0], v1 = acc[ai][bj][m][1] * gv[bj][1];
                    u32x4 w; w.x = cvt_pk_bf16(v0[0], v0[1]); w.y = cvt_pk_bf16(v0[2], v0[3]); w.z = cvt_pk_bf16(v1[0], v1[1]); w.w = cvt_pk_bf16(v1[2], v1[3]);
                    *(u32x4*)(rowp + bj * HALF) = w; } }
    }
};

template <class Epi, class Sched, bool ALIGN_EPI, bool SP2, bool FP8 = false>
__device__ __forceinline__ void gemm_phase(LAS unsigned char* lds, const Gemm g, const Sched& S, const Epi& E, int tid_in, int sw = 0x7f7f7f7f, int sa = 0x7f7f7f7f) {
    int tid_ = tid_in; asm volatile("" : "+v"(tid_));
    const int tid = tid_, wid = __builtin_amdgcn_readfirstlane(tid >> 6), lane = tid & 63, wr = wid >> 2, wc = wid & 3, fr = lane & 15, fq = lane >> 4;
    const int K = g.K, nt = K / BK;
    constexpr bool GA = Sched::GATHER;
    unsigned voffA[2], voffB[2];
#pragma unroll
    for (int i = 0; i < 2; ++i) { int R, C; stage_rc(tid * 16 + i * 8192, R, C); const int Rb = Epi::PERM ? ((R & ~31) + perm32(R & 31)) : R;
        voffA[i] = (unsigned)(R * K + C) * 2u; voffB[i] = (unsigned)(Rb * K + C) * 2u; }
    const size_t kstep = (size_t)(BK * 2);
    const size_t hstep = (size_t)HALF * K * 2;
    const unsigned ldsw = (unsigned)wid * 1024u;
    const int aoff = lds_byte(wr * 64 + fr, fq * 8), boff = lds_byte(wc * 32 + fr, fq * 8);
#define PG8_SA(b, h) (((b) * 2 + (h)) * HTB)
#define PG8_SB(b, h) ((4 + (b) * 2 + (h)) * HTB)
#define PG8_STAGE(bufoff, gbase, voff) do { _Pragma("unroll") for (int _i = 0; _i < 2; ++_i) \
        __builtin_amdgcn_global_load_lds((const unsigned*)((const char*)(gbase) + (voff)[_i]), (LAS unsigned*)(lds + (bufoff) + ldsw + _i * 8192), 16, 0, 0); } while (0)
#define PG8_LDA(dst, b, h) do { _Pragma("unroll") for (int m = 0; m < 4; ++m) _Pragma("unroll") for (int k = 0; k < 2; ++k) dst[m][k] = *(const LAS bf16x8*)(lds + PG8_SA(b, h) + aoff + m * 2048 + k * 1024); } while (0)
#define PG8_LDB(dst, b, h) do { _Pragma("unroll") for (int n = 0; n < 2; ++n) _Pragma("unroll") for (int k = 0; k < 2; ++k) dst[n][k] = *(const LAS bf16x8*)(lds + PG8_SB(b, h) + boff + n * 2048 + k * 1024); } while (0)
#define PG8_CAT(x) __builtin_shufflevector(__builtin_bit_cast(i32x4, (x)[0]), __builtin_bit_cast(i32x4, (x)[1]), 0, 1, 2, 3, 4, 5, 6, 7)
#define PG8_MMA(ai, bj, At, Bt) do { __builtin_amdgcn_s_setprio(1); _Pragma("unroll") for (int m = 0; m < 4; ++m) _Pragma("unroll") for (int n = 0; n < 2; ++n) { \
        if constexpr (FP8) { const i32x8 a8_ = PG8_CAT(Bt[n]), b8_ = PG8_CAT(At[m]); \
            asm volatile("v_mfma_scale_f32_16x16x128_f8f6f4 %0, %1, %2, %0, %3, %4 op_sel_hi:[0,0,0]" : "+v"(acc[ai][bj][m][n]) : "v"(a8_), "v"(b8_), "v"(sw), "v"(sa)); } \
        else { _Pragma("unroll") for (int k = 0; k < 2; ++k) acc[ai][bj][m][n] = __builtin_amdgcn_mfma_f32_16x16x32_bf16(Bt[n][k], At[m][k], acc[ai][bj][m][n], 0, 0, 0); } } \
        __builtin_amdgcn_s_setprio(0); } while (0)
#define PG8_WAIT_V(n) asm volatile("s_waitcnt vmcnt(" #n ")" ::: "memory")
#define PG8_WAIT_L(n) asm volatile("s_waitcnt lgkmcnt(" #n ")" ::: "memory")
#define PG8_BAR __builtin_amdgcn_s_barrier()
#define PG8_SCHED __builtin_amdgcn_sched_barrier(0)
    Unit cur, nxt; int ui = 0;
    if (!S.next(0, cur)) return;
    f32x4 acc[2][2][4][2];
#pragma unroll
    for (int a = 0; a < 2; ++a)
#pragma unroll
        for (int b = 0; b < 2; ++b)
#pragma unroll
            for (int m = 0; m < 4; ++m)
#pragma unroll
                for (int n = 0; n < 2; ++n) acc[a][b][m][n] = (f32x4){0.f, 0.f, 0.f, 0.f};
    bf16x8 At[4][2], B0[2][2], B1[2][2];
    const char* Ab = (const char*)g.A + S.a_base(cur);
    unsigned oc[2][2];
    S.a_offs(0, cur, tid, oc);
    const size_t hsA = GA ? (size_t)0 : hstep;
#define PG8_STAGE_A(bufoff, gbase, h) do { if constexpr (GA) PG8_STAGE(bufoff, gbase, oc[h]); else PG8_STAGE(bufoff, (gbase) + (h) * hsA, voffA); } while (0)
    const char* cB = (const char*)g.Bt + cur.bofs;
    if constexpr (SP2) {
        PG8_STAGE(PG8_SB(0, 0), cB, voffB); PG8_STAGE(PG8_SB(0, 1), cB + hstep, voffB); PG8_STAGE_A(PG8_SA(0, 0), Ab, 0); PG8_STAGE_A(PG8_SA(0, 1), Ab, 1);
        if (wr == 1) PG8_BAR;
        PG8_WAIT_V(2); PG8_BAR;
        PG8_STAGE(PG8_SB(1, 0), cB + kstep, voffB); PG8_STAGE_A(PG8_SA(1, 0), Ab + kstep, 0); PG8_STAGE(PG8_SB(1, 1), cB + hstep + kstep, voffB);
        PG8_WAIT_V(6); PG8_BAR;
    } else {
        PG8_STAGE(PG8_SB(0, 0), cB, voffB); PG8_STAGE_A(PG8_SA(0, 0), Ab, 0); PG8_STAGE(PG8_SB(0, 1), cB + hstep, voffB); PG8_STAGE_A(PG8_SA(0, 1), Ab, 1);
        if (wr == 1) PG8_BAR;
        PG8_WAIT_V(4); PG8_BAR;
        PG8_STAGE(PG8_SB(1, 0), cB + kstep, voffB); PG8_STAGE_A(PG8_SA(1, 0), Ab + kstep, 0); PG8_STAGE(PG8_SB(1, 1), cB + hstep + kstep, voffB);
        PG8_WAIT_V(6); PG8_BAR;
    }
    for (;;) {
        const bool has_next = S.next(ui + 1, nxt);
        const char* nB = has_next ? (const char*)g.Bt + nxt.bofs : cB;
        for (int t = 0; t < nt; t += 2) {
            const bool last = (t == nt - 2);
            const char* a1 = Ab + (size_t)(t + 1) * kstep;
            const char* b2 = last ? nB : cB + (size_t)(t + 2) * kstep; const char* b3 = b2 + kstep;
            if constexpr (SP2) {
            PG8_LDB(B0, 0, 0); PG8_LDB(B1, 0, 1); PG8_SCHED; PG8_LDA(At, 0, 0); PG8_STAGE_A(PG8_SA(1, 1), a1, 1);
            if (last && has_next) { S.a_offs(ui + 1, nxt, tid, oc); Ab = (const char*)g.A + S.a_base(nxt); }
            const char* a2 = last ? Ab : Ab + (size_t)(t + 2) * kstep; const char* a3 = a2 + kstep;
            PG8_WAIT_V(8); PG8_WAIT_L(0); PG8_BAR; PG8_MMA(0, 0, At, B0); PG8_MMA(0, 1, At, B1); PG8_BAR; PG8_SCHED;
            PG8_LDA(At, 0, 1); PG8_STAGE(PG8_SB(0, 0), b2, voffB); PG8_STAGE(PG8_SB(0, 1), b2 + hstep, voffB); PG8_STAGE_A(PG8_SA(0, 0), a2, 0);
            PG8_WAIT_V(8); PG8_WAIT_L(0); PG8_BAR; PG8_MMA(1, 0, At, B0); PG8_MMA(1, 1, At, B1); PG8_BAR; PG8_SCHED;
            PG8_LDB(B0, 1, 0); PG8_LDB(B1, 1, 1); PG8_SCHED; PG8_LDA(At, 1, 0); PG8_STAGE_A(PG8_SA(0, 1), a2, 1);
            PG8_WAIT_V(8); PG8_WAIT_L(0); PG8_BAR; PG8_MMA(0, 0, At, B0); PG8_MMA(0, 1, At, B1); PG8_BAR; PG8_SCHED;
            PG8_LDA(At, 1, 1); PG8_STAGE(PG8_SB(1, 0), b3, voffB); PG8_STAGE(PG8_SB(1, 1), b3 + hstep, voffB); PG8_STAGE_A(PG8_SA(1, 0), a3, 0);
            PG8_WAIT_V(8); PG8_WAIT_L(0); PG8_BAR; PG8_MMA(1, 0, At, B0); PG8_MMA(1, 1, At, B1); PG8_BAR; PG8_SCHED;
            } else {
            PG8_LDB(B0, 0, 0); PG8_SCHED; PG8_LDA(At, 0, 0); PG8_STAGE_A(PG8_SA(1, 1), a1, 1);
            if (last && has_next) { S.a_offs(ui + 1, nxt, tid, oc); Ab = (const char*)g.A + S.a_base(nxt); }
            const char* a2 = last ? Ab : Ab + (size_t)(t + 2) * kstep; const char* a3 = a2 + kstep;
            PG8_WAIT_L(8); PG8_BAR; PG8_WAIT_L(0); PG8_MMA(0, 0, At, B0); PG8_BAR; PG8_SCHED;
            PG8_LDB(B1, 0, 1); PG8_STAGE(PG8_SB(0, 0), b2, voffB);
            PG8_BAR; PG8_WAIT_L(0); PG8_MMA(0, 1, At, B1); PG8_BAR;
            PG8_LDA(At, 0, 1); PG8_STAGE_A(PG8_SA(0, 0), a2, 0);
            PG8_BAR; PG8_WAIT_L(0); PG8_MMA(1, 0, At, B0); PG8_BAR; PG8_SCHED;
            PG8_STAGE(PG8_SB(0, 1), b2 + hstep, voffB);
            PG8_WAIT_V(6); PG8_BAR; PG8_MMA(1, 1, At, B1); PG8_BAR;
            PG8_LDB(B0, 1, 0); PG8_SCHED; PG8_LDA(At, 1, 0); PG8_STAGE_A(PG8_SA(0, 1), a2, 1);
            PG8_WAIT_L(8); PG8_BAR; PG8_WAIT_L(0); PG8_MMA(0, 0, At, B0); PG8_BAR; PG8_SCHED;
            PG8_LDB(B1, 1, 1); PG8_STAGE(PG8_SB(1, 0), b3, voffB);
            PG8_BAR; PG8_WAIT_L(0); PG8_MMA(0, 1, At, B1); PG8_BAR;
            PG8_LDA(At, 1, 1); PG8_STAGE_A(PG8_SA(1, 0), a3, 0);
            PG8_BAR; PG8_WAIT_L(0); PG8_MMA(1, 0, At, B0); PG8_BAR; PG8_SCHED;
            PG8_STAGE(PG8_SB(1, 1), b3 + hstep, voffB);
            PG8_WAIT_V(6); PG8_BAR; PG8_MMA(1, 1, At, B1); PG8_BAR;
            }
        }
        if constexpr (ALIGN_EPI) { if (wr == 0) PG8_BAR; }
        if constexpr (FP8) asm volatile("s_nop 15\n\ts_nop 15\n\ts_nop 15" ::: "memory");
        E(acc, cur, wr, wc, fr, fq);
        if (!has_next) break;
#pragma unroll
        for (int a = 0; a < 2; ++a)
#pragma unroll
            for (int b = 0; b < 2; ++b)
#pragma unroll
                for (int m = 0; m < 4; ++m)
#pragma unroll
                    for (int n = 0; n < 2; ++n) acc[a][b][m][n] = (f32x4){0.f, 0.f, 0.f, 0.f};
        cur = nxt; cB = nB; ++ui;
        if constexpr (ALIGN_EPI) { if (wr == 1) PG8_BAR; }
    }
    PG8_WAIT_V(0);
    if constexpr (!ALIGN_EPI) { if (wr == 0) PG8_BAR; }
    PG8_BAR;
#undef PG8_SA
#undef PG8_SB
#undef PG8_STAGE
#undef PG8_STAGE_A
#undef PG8_LDA
#undef PG8_LDB
#undef PG8_MMA
#undef PG8_CAT
#undef PG8_WAIT_V
#undef PG8_WAIT_L
#undef PG8_BAR
#undef PG8_SCHED
}
}

#define XB_TMO      128
#define XB_XCNT(j)  (256  + 64 * (j))
#define XB_XSUB(j)  (1280 + 64 * (j))
#define XB_XGEN(j)  (2304 + 64 * (j))
#define XB_TOP      3328
#define XB_TOPGEN   3392
#define XCD_BAR_WORDS 3456
#define XB_SPIN_CAP (1u << 18)
__device__ __forceinline__ unsigned xb_ld(unsigned* p)              { return __hip_atomic_load(p, __ATOMIC_RELAXED, __HIP_MEMORY_SCOPE_AGENT); }
__device__ __forceinline__ unsigned xb_add(unsigned* p, unsigned v) { return __hip_atomic_fetch_add(p, v, __ATOMIC_RELAXED, __HIP_MEMORY_SCOPE_AGENT); }
__device__ __forceinline__ unsigned xb_xcc_id() { return (unsigned)__builtin_amdgcn_s_getreg((3 << 11) | 20) & 0xFu; }
#define XB_SPIN(cond, bar) do { unsigned _sp = 0; while (cond) { __builtin_amdgcn_s_sleep(1); \
    if ((++_sp & 255u) == 0u) { if (xb_ld(&(bar)[XB_TMO])) break; if (_sp > XB_SPIN_CAP) { atomicAdd(&(bar)[XB_TMO], 1u); break; } } } } while (0)
struct XcdBarrier { unsigned* bar; unsigned x; volatile LAS unsigned* st; };
__device__ __forceinline__ XcdBarrier xcd_barrier_post(unsigned* bar, volatile LAS unsigned* st) {
    XcdBarrier b; b.bar = bar; b.x = xb_xcc_id(); b.st = st;
    if (threadIdx.x == 0) (void)xb_add(&bar[XB_XCNT(b.x)], 1u);
    return b;
}
__device__ __forceinline__ void xcd_barrier_complete(unsigned* bar, unsigned x, unsigned& nloc, unsigned& nx) {
    const unsigned G = gridDim.x * gridDim.y * gridDim.z;
    unsigned sum, cnt, mine, sp = 0u;
    for (;;) {
        sum = 0u; cnt = 0u; mine = 0u;
#pragma unroll
        for (unsigned j = 0; j < 16; ++j) { const unsigned c = xb_ld(&bar[XB_XCNT(j)]); sum += c; cnt += (c > 0u) ? 1u : 0u; }
        mine = xb_ld(&bar[XB_XCNT(x)]);
        if (sum == G) break;
        __builtin_amdgcn_s_sleep(1);
        if ((++sp & 255u) == 0u) { if (xb_ld(&bar[XB_TMO])) break; if (sp > XB_SPIN_CAP) { atomicAdd(&bar[XB_TMO], 1u); break; } }
    }
    nloc = mine > 0u ? mine : 1u; nx = cnt > 0u ? cnt : 1u;
}
__device__ __forceinline__ void xcd_barrier(const XcdBarrier& b, bool leader) {
    asm volatile("s_waitcnt vmcnt(0)" ::: "memory");
    __syncthreads();
    if (leader) {
        unsigned* bar = b.bar;
        __builtin_amdgcn_s_waitcnt(0);
        unsigned nloc = b.st[0], nx = b.st[1];
        if (nloc == 0u) { xcd_barrier_complete(bar, b.x, nloc, nx); b.st[0] = nloc; b.st[1] = nx; }
        const unsigned old = xb_add(&bar[XB_XSUB(b.x)], 1u);
        const unsigned gen = old / nloc;
        if (old + 1u == (gen + 1u) * nloc) {
            __builtin_amdgcn_fence(__ATOMIC_RELEASE, "agent");
            asm volatile("s_waitcnt vmcnt(0)" ::: "memory");
            const unsigned og = xb_add(&bar[XB_TOP], 1u);
            const unsigned tg = og / nx;
            if (og + 1u == (tg + 1u) * nx) xb_add(&bar[XB_TOPGEN], 1u);
            else XB_SPIN(xb_ld(&bar[XB_TOPGEN]) == tg, bar);
            __builtin_amdgcn_fence(__ATOMIC_ACQUIRE, "agent");
            xb_add(&bar[XB_XGEN(b.x)], 1u);
            asm volatile("s_waitcnt vmcnt(0)" ::: "memory");
        } else {
            XB_SPIN(xb_ld(&bar[XB_XGEN(b.x)]) == gen, bar);
            __builtin_amdgcn_fence(__ATOMIC_ACQUIRE, "agent");
            asm volatile("s_waitcnt vmcnt(0)" ::: "memory");
        }
    }
    __syncthreads();
}

constexpr int NT = 512, NWAVES = 8;
struct Args { const float* in[24]; float* out; unsigned char* ws; int ph_lo, ph_hi; };
enum { I_X = 0, I_C, I_CTX, I_CCTX, I_WMOD, I_BMOD, I_WIN, I_WOUT, I_RPB, I_CONVW, I_CONVB, I_DTB, I_ALOG, I_DSKIP, I_NORMW, I_LNG, I_LNB, I_FG, I_FU, I_FD, I_RW, I_MG, I_MU, I_MD };
struct Frame {
    LAS unsigned char* lds;
    const float* const* in; float* out; unsigned char* ws;
    int tid, lane, wave, bid, G, gw, NGW;
};
#define LDS_WAIT() asm volatile("s_waitcnt lgkmcnt(0)" ::: "memory")
__device__ __forceinline__ Frame fresh(const Frame& F0) {
    Frame F = F0; int z; asm volatile("s_mov_b32 %0, 0" : "=s"(z)); F.ws = F0.ws + z; F.in = F0.in + z; F.out = F0.out + z;
    int ln; asm volatile("v_mbcnt_lo_u32_b32 %0, -1, 0\n\tv_mbcnt_hi_u32_b32 %0, -1, %0" : "=v"(ln));     int t = F0.wave * 64 + ln;
    F.tid = t; F.lane = t & 63; return F;
}

__device__ __forceinline__ void conv_item(const float* W, int ldn, int k0, int n0, bf16_t* dst, int K, int drow0, float scale, LAS float* scr, int lane) {
    f32x4 ld[8];
#pragma unroll
    for (int i = 0; i < 8; ++i) ld[i] = *(const f32x4*)(W + (size_t)(k0 + 8 * i + (lane >> 3)) * ldn + n0 + 4 * (lane & 7));
#pragma unroll
    for (int i = 0; i < 8; ++i) { LAS float* d = scr + (8 * i + (lane >> 3)) * 33 + 4 * (lane & 7); d[0] = ld[i][0] * scale; d[1] = ld[i][1] * scale; d[2] = ld[i][2] * scale; d[3] = ld[i][3] * scale; }
    LDS_WAIT(); asm volatile("" ::: "memory");
    const int c = lane & 7;
#pragma unroll
    for (int j = 0; j < 4; ++j) { const int n = (lane >> 3) + 8 * j; const LAS float* s = scr + (8 * c) * 33 + n;
        u32x4 o; o.x = pk2(s[0 * 33], s[1 * 33]); o.y = pk2(s[2 * 33], s[3 * 33]); o.z = pk2(s[4 * 33], s[5 * 33]); o.w = pk2(s[6 * 33], s[7 * 33]);
        *(u32x4*)(dst + (size_t)(drow0 + n) * K + k0 + 8 * c) = o; }
    LDS_WAIT(); asm volatile("" ::: "memory");
}
__device__ __forceinline__ void conv_item8(const float* W, int ldn, int k0, int n0, unsigned char* dst, int K, int drow0, float scale, LAS float* scr, int lane) {
    f32x4 ld[8];
#pragma unroll
    for (int i = 0; i < 8; ++i) ld[i] = *(const f32x4*)(W + (size_t)(k0 + 8 * i + (lane >> 3)) * ldn + n0 + 4 * (lane & 7));
#pragma unroll
    for (int i = 0; i < 8; ++i) { LAS float* d = scr + (8 * i + (lane >> 3)) * 33 + 4 * (lane & 7); d[0] = ld[i][0] * scale; d[1] = ld[i][1] * scale; d[2] = ld[i][2] * scale; d[3] = ld[i][3] * scale; }
    LDS_WAIT(); asm volatile("" ::: "memory");
    const int c = lane & 7;
#pragma unroll
    for (int j = 0; j < 4; ++j) { const int n = (lane >> 3) + 8 * j; const LAS float* sp = scr + (8 * c) * 33 + n;
        u32x2 o; o.x = pk8(sp[0 * 33], sp[1 * 33], sp[2 * 33], sp[3 * 33]); o.y = pk8(sp[4 * 33], sp[5 * 33], sp[6 * 33], sp[7 * 33]);
        *(u32x2*)(dst + (size_t)(drow0 + n) * K + k0 + 8 * c) = o; }
    LDS_WAIT(); asm volatile("" ::: "memory");
}
__device__ __forceinline__ void conv_seg(const Frame& F, const float* W, int K, int ldn, int ncols, bf16_t* dst, int mode, int& rot, int s8 = -1) {
    LAS float* scr = (LAS float*)(F.lds + F.wave * 16384);
    const int nblk = ncols / 32, nitems = (K / 64) * nblk;
    int start = F.gw - rot; if (start < 0) start += F.NGW;
    for (int it = start; it < nitems; it += F.NGW) {
        const int kb = it / nblk, nb = it % nblk, n0 = nb * 32;
        const int drow0 = (mode == 0) ? n0 : ((n0 >> 7) * 256 + (n0 & 127) + (mode == 2 ? 128 : 0));
        const float gs = (mode == 1) ? GATE_PRESCALE : 1.0f;
        if (s8 >= 0) conv_item8(W, ldn, kb * 64, n0, (unsigned char*)dst, K, drow0, (float)(1 << s8) * gs, scr, F.lane);
        else conv_item(W, ldn, kb * 64, n0, dst, K, drow0, gs, scr, F.lane);
    }
    rot = (rot + nitems) % F.NGW;
}
__device__ __forceinline__ void conv_moe(const Frame& F, int slot, int& rot) {
#if USE_FP8
    unsigned char* gu = F.ws + WS_WMGU + (size_t)slot * NEXP * 2 * DFFE * D; unsigned char* dn = F.ws + WS_WMD + (size_t)slot * NEXP * D * DFFE;
    for (int e = 0; e < NEXP; ++e) {
        const size_t so = ((size_t)slot * NEXP + e) * (size_t)D * DFFE;
        conv_seg(F, F.in[I_MG] + so, D, DFFE, DFFE, (bf16_t*)(gu + (size_t)e * 2 * DFFE * D), 1, rot, S8_WGU);
        conv_seg(F, F.in[I_MU] + so, D, DFFE, DFFE, (bf16_t*)(gu + (size_t)e * 2 * DFFE * D), 2, rot, S8_WGU);
        conv_seg(F, F.in[I_MD] + so, DFFE, D, D, (bf16_t*)(dn + (size_t)e * D * DFFE), 0, rot, S8_WD);
    }
#else
    bf16_t* gu = (bf16_t*)(F.ws + WS_WMGU); bf16_t* dn = (bf16_t*)(F.ws + WS_WMD);
    for (int e = 0; e < NEXP; ++e) {
        const size_t so = ((size_t)slot * NEXP + e) * (size_t)D * DFFE;
        conv_seg(F, F.in[I_MG] + so, D, DFFE, DFFE, gu + (size_t)e * 2 * DFFE * D, 1, rot);
        conv_seg(F, F.in[I_MU] + so, D, DFFE, DFFE, gu + (size_t)e * 2 * DFFE * D, 2, rot);
        conv_seg(F, F.in[I_MD] + so, DFFE, D, D, dn + (size_t)e * D * DFFE, 0, rot);
    }
#endif
}

constexpr int MOE_ITEMS_MAT = 1792, MOE_ITEMS_EXP = 3 * MOE_ITEMS_MAT, MOE_ITEMS_SLOT = 8 * MOE_ITEMS_EXP, MOE_ITEMS = 2 * MOE_ITEMS_SLOT;
__device__ __forceinline__ void conv_moe_item(const Frame& F, int gidx) {
    LAS float* scr = (LAS float*)(F.lds + F.wave * 16384);
    const int slot = gidx / MOE_ITEMS_SLOT, r = gidx % MOE_ITEMS_SLOT, e = r / MOE_ITEMS_EXP, r2 = r % MOE_ITEMS_EXP, mat = r2 / MOE_ITEMS_MAT, it = r2 % MOE_ITEMS_MAT;
    const size_t so = ((size_t)slot * NEXP + e) * (size_t)D * DFFE;
    if (mat < 2) { const int kb = it / 112, nb = it % 112, n0 = nb * 32; const int drow0 = (n0 >> 7) * 256 + (n0 & 127) + (mat == 1 ? 128 : 0);
        conv_item8((mat ? F.in[I_MU] : F.in[I_MG]) + so, DFFE, kb * 64, n0, F.ws + WS_WMGU + ((size_t)slot * NEXP + e) * 2 * DFFE * D, D, drow0, (float)(1 << S8_WGU) * (mat ? 1.0f : GATE_PRESCALE), scr, F.lane); }
    else { const int kb = it / 32, nb = it % 32, n0 = nb * 32;
        conv_item8(F.in[I_MD] + so, D, kb * 64, n0, F.ws + WS_WMD + ((size_t)slot * NEXP + e) * D * DFFE, DFFE, n0, (float)(1 << S8_WD), scr, F.lane); }
}
__device__ __forceinline__ void deferred_conv(const Frame& F, int nwg, int base, int quota) {
    if (F.G != 256) return;
    const int maxu = (nwg + F.G - 1) / F.G, c0 = nwg - (maxu - 1) * F.G;
    if (c0 >= F.G || F.bid < c0) return;
    const int first = base + ((F.bid - c0) * NWAVES + F.wave) * quota;
    for (int j = 0; j < quota; ++j) { const int gidx = first + j; if (gidx < MOE_ITEMS) conv_moe_item(F, gidx); }
}
constexpr int DW_Q = 12, DW_Q2 = 10;
constexpr int DW_L0_OUT = 0, DW_L0_F1 = DW_L0_OUT + 192 * 8 * DW_Q, DW_L0_F2 = DW_L0_F1 + 160 * 8 * DW_Q, DW_L1_OUT = DW_L0_F2 + 192 * 8 * DW_Q2, DW_L2_OUT = DW_L1_OUT + 192 * 8 * DW_Q, DW_END = DW_L2_OUT + 192 * 8 * DW_Q;
static_assert(DW_L1_OUT >= MOE_ITEMS_SLOT && DW_END >= MOE_ITEMS, "deferred conversion: layer-1 experts must be done before layer 1's FFN, all before layer 3's");
__device__ __forceinline__ void p_pro_a(const Frame& F) {
    {
        LAS float* sc = (LAS float*)F.lds; LAS float* red = sc + 17 * 1024;
        const float* c = F.in[I_C]; const float* cc = F.in[I_CCTX];
        for (int i = F.tid; i < 17 * 1024; i += NT) { const int r = i >> 10, k = i & 1023; const float v = (r < 16) ? c[r * 1024 + k] : cc[k]; sc[i] = silu_f(v); }
        __syncthreads();
        float* MOD = (float*)(F.ws + WS_MOD);
        const int col = F.tid & 31, ks = F.tid >> 5;
        for (int u = F.bid; u < 4 * 192; u += F.G) {
            const int l = u / 192, cb = u % 192;
            const float* W = F.in[I_WMOD] + (size_t)l * D * MODW + cb * 32 + col;
            float acc[17];
#pragma unroll
            for (int r = 0; r < 17; ++r) acc[r] = 0.f;
#pragma unroll 1
            for (int kb = 0; kb < 4; ++kb) { float w[16];
#pragma unroll
                for (int i = 0; i < 16; ++i) w[i] = W[(size_t)(ks * 64 + kb * 16 + i) * MODW];
#pragma unroll
                for (int i = 0; i < 16; ++i) { const int k = ks * 64 + kb * 16 + i;
#pragma unroll
                    for (int r = 0; r < 17; ++r) acc[r] += sc[r * 1024 + k] * w[i]; } }
#pragma unroll
            for (int r = 0; r < 17; ++r) red[(ks * 17 + r) * 32 + col] = acc[r];
            __syncthreads();
            for (int i = F.tid; i < 17 * 32; i += NT) { const int r = i >> 5, c2 = i & 31; float sm = 0.f;
#pragma unroll
                for (int k2 = 0; k2 < 16; ++k2) sm += red[(k2 * 17 + r) * 32 + c2];
                MOD[(size_t)(l * 17 + r) * MODW + cb * 32 + c2] = sm + F.in[I_BMOD][l * MODW + cb * 32 + c2]; }
            __syncthreads();
        }
    }
    int rot = 0;
    for (int l = 0; l < DEPTH; ++l) {
#if USE_FP8 && FP8_INPROJ
        conv_seg(F, F.in[I_WIN] + (size_t)l * D * D_IN_PROJ, D, D_IN_PROJ, NPROJ, (bf16_t*)(F.ws + WS_WIN + (size_t)l * NPROJ * D), 0, rot, S8_WGU);
#else
        conv_seg(F, F.in[I_WIN] + (size_t)l * D * D_IN_PROJ, D, D_IN_PROJ, NPROJ, (bf16_t*)(F.ws + WS_WIN) + (size_t)l * NPROJ * D, 0, rot);
#endif
        conv_seg(F, F.in[I_WOUT] + (size_t)l * D * D, D, D, D, (bf16_t*)(F.ws + WS_WOUT) + (size_t)l * D * D, 0, rot);
    }
    for (int s = 0; s < 2; ++s) {
        if ((FP8_DENSE1_MASK >> s) & 1) {
            conv_seg(F, F.in[I_FG] + (size_t)s * D * DFF, D, DFF, DFF, (bf16_t*)(F.ws + WS_WFGU + (size_t)s * 2 * DFF * D * 2), 1, rot, S8_WGU);
            conv_seg(F, F.in[I_FU] + (size_t)s * D * DFF, D, DFF, DFF, (bf16_t*)(F.ws + WS_WFGU + (size_t)s * 2 * DFF * D * 2), 2, rot, S8_WGU);
        } else {
            conv_seg(F, F.in[I_FG] + (size_t)s * D * DFF, D, DFF, DFF, (bf16_t*)(F.ws + WS_WFGU) + (size_t)s * 2 * DFF * D, 1, rot);
            conv_seg(F, F.in[I_FU] + (size_t)s * D * DFF, D, DFF, DFF, (bf16_t*)(F.ws + WS_WFGU) + (size_t)s * 2 * DFF * D, 2, rot);
        }
#if USE_FP8 && FP8_DENSE2
        conv_seg(F, F.in[I_FD] + (size_t)s * DFF * D, DFF, D, D, (bf16_t*)(F.ws + WS_WFD + (size_t)s * D * DFF), 0, rot, S8_WD);
#else
        conv_seg(F, F.in[I_FD] + (size_t)s * DFF * D, DFF, D, D, (bf16_t*)(F.ws + WS_WFD) + (size_t)s * D * DFF, 0, rot);
#endif
    }
    if (F.G != 256) { conv_moe(F, 0, rot); conv_moe(F, 1, rot); }
    { bf16_t* wdt = (bf16_t*)(F.ws + WS_WDT);
      for (int i = F.bid * NT + F.tid; i < DEPTH * 16 * D; i += F.G * NT) { const int l = i / (16 * D), n = (i / D) & 15, k = i % D;
          wdt[i] = (bf16_t)f2bf(F.in[I_WIN][((size_t)l * D + k) * D_IN_PROJ + NPROJ + n]); } }
}

#define RIDX(q) (8 * lane + 512 * ((q) >> 1) + 4 * ((q) & 1))
__device__ __forceinline__ void row_load(const float* p, int lane, f32x4 (&v)[4]) {
#pragma unroll
    for (int q = 0; q < 4; ++q) v[q] = *(const f32x4*)(p + RIDX(q));
}
__device__ __forceinline__ void row_store(float* p, int lane, const f32x4 (&v)[4]) {
#pragma unroll
    for (int q = 0; q < 4; ++q) *(f32x4*)(p + RIDX(q)) = v[q];
}
__device__ __forceinline__ void row_mod_store8(unsigned char* hrow, int lane, const f32x4 (&v)[4], const float* sh, const float* sc, f32x4 (&hv)[4]) {
#pragma unroll
    for (int j = 0; j < 2; ++j) { u32x2 w;
#pragma unroll
        for (int h = 0; h < 2; ++h) { const int q = 2 * j + h; const f32x4 a = *(const f32x4*)(sc + RIDX(q)), b = *(const f32x4*)(sh + RIDX(q));
            hv[q] = v[q] * (a + 1.0f) + b; const f32x4 t = hv[q] * (float)(1 << S8_ACT); const unsigned pw = pk8(t[0], t[1], t[2], t[3]); if (h == 0) w.x = pw; else w.y = pw; }
        *(u32x2*)(hrow + 8 * lane + 512 * j) = w; }
}
__device__ __forceinline__ void row_load_h(const bf16_t* p, int lane, f32x4 (&v)[4]) {
#pragma unroll
    for (int j = 0; j < 2; ++j) { const u32x4 w = *(const u32x4*)(p + 8 * lane + 512 * j); v[2 * j] = (f32x4){bflo(w.x), bfhi(w.x), bflo(w.y), bfhi(w.y)}; v[2 * j + 1] = (f32x4){bflo(w.z), bfhi(w.z), bflo(w.w), bfhi(w.w)}; }
}
__device__ __forceinline__ void row_store_h(bf16_t* p, int lane, const f32x4 (&v)[4]) {
#pragma unroll
    for (int j = 0; j < 2; ++j) { u32x4 w; w.x = pk2(v[2 * j][0], v[2 * j][1]); w.y = pk2(v[2 * j][2], v[2 * j][3]); w.z = pk2(v[2 * j + 1][0], v[2 * j + 1][1]); w.w = pk2(v[2 * j + 1][2], v[2 * j + 1][3]);
        *(u32x4*)(p + 8 * lane + 512 * j) = w; }
}
__device__ __forceinline__ void row_mod_store(bf16_t* hrow, int lane, const f32x4 (&v)[4], const float* sh, const float* sc, f32x4 (&hv)[4]) {
#pragma unroll
    for (int q = 0; q < 4; ++q) { const f32x4 a = *(const f32x4*)(sc + RIDX(q)), b = *(const f32x4*)(sh + RIDX(q)); hv[q] = v[q] * (a + 1.0f) + b; }
    row_store_h(hrow, lane, hv);
}
__device__ __forceinline__ void row_ln(f32x4 (&v)[4], const float* g, const float* b, int lane) {
    float s = 0.f;
#pragma unroll
    for (int j = 0; j < 4; ++j) s += (v[j][0] + v[j][1]) + (v[j][2] + v[j][3]);
    const float mean = wave_sum(s) * (1.0f / D); float q2 = 0.f;
#pragma unroll
    for (int j = 0; j < 4; ++j) { v[j] = v[j] - mean; q2 += (v[j][0] * v[j][0] + v[j][1] * v[j][1]) + (v[j][2] * v[j][2] + v[j][3] * v[j][3]); }
    const float rstd = 1.0f / sqrtf(wave_sum(q2) * (1.0f / D) + LN_EPS);
#pragma unroll
    for (int q = 0; q < 4; ++q) { const f32x4 gg = *(const f32x4*)(g + RIDX(q)), bb = *(const f32x4*)(b + RIDX(q)); v[q] = v[q] * rstd * gg + bb; }
}
__device__ __forceinline__ int mod_row_of(int row) { return row < NLAT ? (row >> 11) : 16; }
__device__ __forceinline__ void col_load(const float* p, int lane, f32x4 (&c)[4], float add = 0.f) {
#pragma unroll
    for (int q = 0; q < 4; ++q) c[q] = *(const f32x4*)(p + RIDX(q)) + add;
}
__device__ __forceinline__ void row_ln_r(f32x4 (&v)[4], const f32x4 (&G)[4], const f32x4 (&B)[4]) {
    float s = 0.f;
#pragma unroll
    for (int j = 0; j < 4; ++j) s += (v[j][0] + v[j][1]) + (v[j][2] + v[j][3]);
    const float mean = wave_sum(s) * (1.0f / D); float q2 = 0.f;
#pragma unroll
    for (int j = 0; j < 4; ++j) { v[j] = v[j] - mean; q2 += (v[j][0] * v[j][0] + v[j][1] * v[j][1]) + (v[j][2] * v[j][2] + v[j][3] * v[j][3]); }
    const float rstd = 1.0f / sqrtf(wave_sum(q2) * (1.0f / D) + LN_EPS);
#pragma unroll
    for (int q = 0; q < 4; ++q) v[q] = v[q] * rstd * G[q] + B[q];
}
struct RowRaw { u32x4 x[2], d[2]; };
template <bool WITH_D> __device__ __forceinline__ void row_issue(const bf16_t* X, const bf16_t* Dl, int row, int lane, RowRaw& r) {
#pragma unroll
    for (int j = 0; j < 2; ++j) { r.x[j] = *(const u32x4*)(X + (size_t)row * D + 8 * lane + 512 * j); if (WITH_D) r.d[j] = *(const u32x4*)(Dl + (size_t)row * D + 8 * lane + 512 * j); }
}
__device__ __forceinline__ void unpack8(const u32x4 w, f32x4& lo, f32x4& hi) { lo = (f32x4){bflo(w.x), bfhi(w.x), bflo(w.y), bfhi(w.y)}; hi = (f32x4){bflo(w.z), bfhi(w.z), bflo(w.w), bfhi(w.w)}; }
__device__ __forceinline__ void row_combine(const RowRaw& r, f32x4 (&v)[4]) {
#pragma unroll
    for (int j = 0; j < 2; ++j) { f32x4 x0, x1, d0, d1; unpack8(r.x[j], x0, x1); unpack8(r.d[j], d0, d1); v[2 * j] = x0 * ALPHA + d0; v[2 * j + 1] = x1 * ALPHA + d1; }
}

__device__ __forceinline__ void p_pro_b(const Frame& F) {
    const float* MOD = (const float*)(F.ws + WS_MOD); bf16_t* H = (bf16_t*)(F.ws + WS_H); bf16_t* X = (bf16_t*)(F.ws + WS_X);
    const int rpw = (NTOK + F.NGW - 1) / F.NGW, rbeg = F.gw * rpw, rend = (rbeg + rpw < NTOK) ? rbeg + rpw : NTOK;
    f32x4 SC[4], SH[4]; int mcur = -1;
#define PB_SRC(row_) ((row_) < NLAT ? F.in[I_X] + (size_t)(row_) * D : F.in[I_CTX] + (size_t)((row_) - NLAT) * D)
    f32x4 vn[4];
    if (rbeg < rend) row_load(PB_SRC(rbeg), F.lane, vn);
    for (int row = rbeg; row < rend; ++row) {
        f32x4 v[4], hv[4];
#pragma unroll
        for (int q = 0; q < 4; ++q) v[q] = vn[q];
        if (row + 1 < rend) row_load(PB_SRC(row + 1), F.lane, vn);
        row_store_h(X + (size_t)row * D, F.lane, v);
        const int mr = mod_row_of(row);
        if (mr != mcur) { const float* m = MOD + (size_t)mr * MODW; col_load(m + D, F.lane, SC, 1.0f); col_load(m, F.lane, SH); mcur = mr; }
#pragma unroll
        for (int q = 0; q < 4; ++q) hv[q] = v[q] * SC[q] + SH[q];
        row_store_h(H + (size_t)row * D, F.lane, hv);
    }
#undef PB_SRC
}

__device__ __forceinline__ void dt_gemm(const Frame& F, int layer, int first, int stride, int end) {
    const bf16_t* H = (const bf16_t*)(F.ws + WS_H);
    const bf16_t* wdt = (const bf16_t*)(F.ws + WS_WDT) + (size_t)layer * 16 * D; float* DT = (float*)(F.ws + WS_DT);
    LAS unsigned char* WB = F.lds;
    __syncthreads();
    for (int i = F.tid; i < 16 * 128; i += NT) { const int n = i >> 7, c = i & 127; *(LAS u32x4*)(WB + n * 2064 + c * 16) = *(const u32x4*)(wdt + (size_t)n * D + c * 8); }
    __syncthreads();
    const int fr = F.lane & 15, fq = F.lane >> 4; const float dtb = F.in[I_DTB][layer * 16 + fr];
    for (int g = first; g < end; g += stride) {
        const bf16_t* ap = H + (size_t)(g * 16 + fr) * D + fq * 8;
        bf16x8 a[32];
#pragma unroll
        for (int ks = 0; ks < 32; ++ks) a[ks] = *(const bf16x8*)(ap + ks * 32);
        f32x4 acc = {0.f, 0.f, 0.f, 0.f};
#pragma unroll
        for (int ks = 0; ks < 32; ++ks) { const bf16x8 bb = *(const LAS bf16x8*)(WB + fr * 2064 + (ks * 32 + fq * 8) * 2); acc = __builtin_amdgcn_mfma_f32_16x16x32_bf16(a[ks], bb, acc, 0, 0, 0); }
#pragma unroll
        for (int r = 0; r < 4; ++r) { const float x = acc[r] + dtb; DT[(size_t)(g * 16 + fq * 4 + r) * 16 + fr] = fmaxf(x, 0.f) + __logf(1.0f + __expf(-fabsf(x))); }
    }
    __syncthreads();
}
__device__ __forceinline__ void p_inproj(const Frame& F, int layer) {
    const bf16_t* H = (const bf16_t*)(F.ws + WS_H);
    TPS_BEGIN;
    constexpr int NWG_IN = (NTOK / 256) * (NPROJ / 256), C0_IN = NWG_IN - (NWG_IN / 256) * 256;
    const bool tail_dt = (F.G == 256) && (C0_IN > 0);
    constexpr int DT_HEAD = 1280;
    dt_gemm(F, layer, F.gw, F.NGW, tail_dt ? DT_HEAD : NTOK / 16);
    TPS(20);
    pg8::EpiBf16 E{(bf16_t*)(F.ws + WS_PROJ), NPROJ};
#if USE_FP8 && FP8_INPROJ
    pg8::Gemm g{(const bf16_t*)(F.ws + WS_H8IN), (const bf16_t*)(F.ws + WS_WIN + (size_t)layer * NPROJ * D), D / 2};
    pg8::DenseOrder S; S.init(NTOK, NPROJ, D / 2, F.G, F.bid, REP_GEMM);
    pg8::gemm_phase<pg8::EpiBf16, pg8::DenseOrder, true, FP8_SP2, true>(F.lds, g, S, E, F.tid, (127 - S8_WGU) * 0x01010101, (127 - S8_ACT) * 0x01010101);
#else
    pg8::Gemm g{H, (const bf16_t*)(F.ws + WS_WIN) + (size_t)layer * NPROJ * D, D};
    pg8::DenseOrder S; S.init(NTOK, NPROJ, D, F.G, F.bid, REP_GEMM);
    pg8::gemm_phase<pg8::EpiBf16, pg8::DenseOrder, true, true>(F.lds, g, S, E, F.tid);
#endif
    TPS(21);
    if (tail_dt && F.bid >= C0_IN) dt_gemm(F, layer, DT_HEAD + (F.bid - C0_IN) * NWAVES + F.wave, (256 - C0_IN) * NWAVES, NTOK / 16);
    TPS(22);
}

typedef short s16x4 __attribute__((ext_vector_type(4)));
__device__ __forceinline__ s16x4 lds_tr16(LAS const unsigned char* p) { return __builtin_bit_cast(s16x4, __builtin_amdgcn_ds_read_tr16_b64_v4i16((LAS s16x4*)p)); }
constexpr int NA_KS = 144;
constexpr float LOG2E = 1.4426950408889634f;
__device__ __forceinline__ void na_unit(const Frame& F, int layer, int b, int h, int mode, int m) {
    LAS unsigned char* KV = F.lds;
    LAS float* rp = (LAS float*)(F.lds + 120832);
    const bf16_t* PROJ = (const bf16_t*)(F.ws + WS_PROJ); bf16_t* MIX = (bf16_t*)(F.ws + WS_MIX);
    const int tid = F.tid, lane = F.lane, w = F.wave, q16 = lane & 15, g = lane >> 4;
    int rbase = 0, nk = 0;
    if (mode == 0) { rbase = 2 * m - 4; rbase = rbase < 0 ? 0 : (rbase > 24 ? 24 : rbase); nk = 32 - rbase; nk = nk > 9 ? 9 : nk; }
    const int kfirst = (mode == 0) ? 0 : 576 * 8, nloc8 = nk * 64 * 8;
#define NA_STAGE(OFFS) do { int stid_ = tid; asm volatile("" : "+v"(stid_));     \
        NA_STAGE_PART(OFFS, 0, 7); __builtin_amdgcn_sched_barrier(0); NA_STAGE_PART(OFFS, 7, 13); __builtin_amdgcn_sched_barrier(0); } while (0)
#define NA_STAGE_PART(OFFS, K0, K1) do { u32x4 st_[13]; \
        _Pragma("unroll") for (int k_ = K0; k_ < K1; ++k_) { const int i_ = stid_ + kfirst + k_ * NT, key_ = i_ >> 3, ch_ = i_ & 7; const bool ok_ = (i_ < 832 * 8) && !(key_ < 576 && i_ >= nloc8); \
            const int grow_ = key_ < 576 ? b * SEQ + rbase * 64 + key_ : NLAT + b * CTX + (key_ - 576); \
            st_[k_] = ok_ ? *(const u32x4*)(PROJ + (size_t)grow_ * NPROJ + (OFFS) + h * 64 + ch_ * 8) : (u32x4){0u, 0u, 0u, 0u}; } \
        _Pragma("unroll") for (int k_ = K0; k_ < K1; ++k_) { const int i_ = stid_ + kfirst + k_ * NT, key_ = i_ >> 3, ch_ = i_ & 7; const bool ok_ = (i_ < 832 * 8) && !(key_ < 576 && i_ >= nloc8); \
            if (ok_) *(LAS u32x4*)(KV + key_ * NA_KS + ch_ * 16) = st_[k_]; } } while (0)
    __syncthreads();
    NA_STAGE(OFF_K);
    if (mode == 0 && tid < 465) rp[tid] = F.in[I_RPB][(size_t)(layer * 8 + h) * 465 + tid] * LOG2E;
    __syncthreads();
    int i = 0, j0 = 0, hs = 0, kr0 = 0, qrow;
    if (mode == 0) { i = 2 * m + (w >> 2); j0 = (w & 3) * 16; qrow = b * SEQ + i * 64 + j0; hs = j0 - 8; hs = hs < 0 ? 0 : (hs > 32 ? 32 : hs);
        int r0 = i - 4; r0 = r0 < 0 ? 0 : (r0 > 24 ? 24 : r0); kr0 = r0 - rbase; }
    else qrow = NLAT + b * CTX + m * 128 + w * 16;
    bf16x8 qf[2];
#pragma unroll
    for (int ks = 0; ks < 2; ++ks) qf[ks] = *(const bf16x8*)(PROJ + (size_t)(qrow + q16) * NPROJ + h * 64 + ks * 32 + g * 8);
    f32x4 S[32];
    const LAS unsigned char* kb = KV + q16 * NA_KS + g * 16;
    if (mode == 0) {
        const int j = j0 + q16; int cs = j - 8; cs = cs < 0 ? 0 : (cs > 48 ? 48 : cs);
        const int rb0 = (kr0 + rbase) - i + 7;
#pragma unroll
        for (int tl = 0; tl < 16; ++tl) { const int kr = tl >> 1, half = tl & 1; const int kidx0 = (kr0 + kr) * 64 + hs + 16 * half;
            f32x4 a = {0.f, 0.f, 0.f, 0.f};
#pragma unroll
            for (int ks = 0; ks < 2; ++ks) { const bf16x8 kf = *(const LAS bf16x8*)(kb + kidx0 * NA_KS + ks * 64); a = __builtin_amdgcn_mfma_f32_16x16x32_bf16(kf, qf[ks], a, 0, 0, 0); }
#pragma unroll
            for (int r = 0; r < 4; ++r) { const int kc = hs + 16 * half + 4 * g + r; const bool inw = (kc >= cs) && (kc < cs + 16);
                int cbi = kc - j + 15; cbi = cbi < 0 ? 0 : (cbi > 30 ? 30 : cbi);
                a[r] = inw ? a[r] * (0.125f * LOG2E) + rp[(rb0 + kr) * 31 + cbi] : -INFINITY; }
            S[tl] = a; if ((tl & 1) == 1) __builtin_amdgcn_sched_barrier(0); }
    } else {
#pragma unroll
        for (int tl = 0; tl < 16; ++tl) S[tl] = (f32x4){-INFINITY, -INFINITY, -INFINITY, -INFINITY};
    }
#pragma unroll
    for (int tc = 0; tc < 16; ++tc) { const int kidx0 = 576 + 16 * tc; f32x4 a = {0.f, 0.f, 0.f, 0.f};
#pragma unroll
        for (int ks = 0; ks < 2; ++ks) { const bf16x8 kf = *(const LAS bf16x8*)(kb + kidx0 * NA_KS + ks * 64); a = __builtin_amdgcn_mfma_f32_16x16x32_bf16(kf, qf[ks], a, 0, 0, 0); }
        S[16 + tc] = a * (0.125f * LOG2E); if ((tc & 1) == 1) __builtin_amdgcn_sched_barrier(0); }
    float mx = -INFINITY;
#pragma unroll
    for (int t = 0; t < 32; ++t) mx = fmaxf(fmaxf(fmaxf(S[t][0], S[t][1]), fmaxf(S[t][2], S[t][3])), mx);
    mx = fmaxf(mx, __shfl_xor(mx, 16)); mx = fmaxf(mx, __shfl_xor(mx, 32));
    float sum = 0.f; u32x4 P[16];
#pragma unroll
    for (int kk = 0; kk < 16; ++kk) { float e[8];
#pragma unroll
        for (int r = 0; r < 4; ++r) { e[r] = __builtin_amdgcn_exp2f(S[2 * kk][r] - mx); e[4 + r] = __builtin_amdgcn_exp2f(S[2 * kk + 1][r] - mx); }
        sum += ((e[0] + e[1]) + (e[2] + e[3])) + ((e[4] + e[5]) + (e[6] + e[7]));
        P[kk].x = pg8::cvt_pk_bf16_pin(e[0], e[1]); P[kk].y = pg8::cvt_pk_bf16_pin(e[2], e[3]); P[kk].z = pg8::cvt_pk_bf16_pin(e[4], e[5]); P[kk].w = pg8::cvt_pk_bf16_pin(e[6], e[7]); }
    sum += __shfl_xor(sum, 16); sum += __shfl_xor(sum, 32);
    const float inv = 1.0f / sum;
    __syncthreads();
    NA_STAGE(OFF_V);
    __syncthreads();
    f32x4 o[4];
#pragma unroll
    for (int dt = 0; dt < 4; ++dt) o[dt] = (f32x4){0.f, 0.f, 0.f, 0.f};
    const LAS unsigned char* vb = KV + (4 * g + (q16 >> 2)) * NA_KS + (q16 & 3) * 8;
#pragma unroll
    for (int kk = 0; kk < 16; ++kk) {
        if (kk < 8 && mode != 0) continue;
        const int kidx0 = (kk < 8) ? (kr0 + kk) * 64 + hs : 576 + 32 * (kk - 8);
        const bf16x8 pa = __builtin_bit_cast(bf16x8, P[kk]);
#pragma unroll
        for (int dt = 0; dt < 4; ++dt) { const s16x4 lo = lds_tr16(vb + kidx0 * NA_KS + dt * 32), hi = lds_tr16(vb + (kidx0 + 16) * NA_KS + dt * 32);
            const bf16x8 vf = {lo[0], lo[1], lo[2], lo[3], hi[0], hi[1], hi[2], hi[3]};
            o[dt] = __builtin_amdgcn_mfma_f32_16x16x32_bf16(pa, vf, o[dt], 0, 0, 0); }
    }
#undef NA_STAGE
#undef NA_STAGE_PART
#pragma unroll
    for (int r = 0; r < 4; ++r) { const float ir = __shfl(inv, 4 * g + r);
        bf16_t* op = MIX + (size_t)(qrow + 4 * g + r) * D + h * 64 + q16;
#pragma unroll
        for (int dt = 0; dt < 4; dt += 2) { const unsigned pw = pk2(o[dt][r] * ir, o[dt + 1][r] * ir); op[dt * 16] = (bf16_t)(pw & 0xffffu); op[dt * 16 + 16] = (bf16_t)(pw >> 16); } }
}

struct PrepassW { f32x4 w[5][2]; f32x4 b[2]; float ifq[8]; };
__device__ __forceinline__ void ssd_prepass_unit(const Frame& F, int u, const PrepassW& W) {
    const bf16_t* PROJ = (const bf16_t*)(F.ws + WS_PROJ); bf16_t* U = (bf16_t*)(F.ws + WS_U);
    int rowbase, t0, L; bool lat;
    if (u < NLAT / 16) { rowbase = (u >> 7) * SEQ; t0 = (u & 127) * 16; L = SEQ; lat = true; }
    else { const int v = u - NLAT / 16; rowbase = NLAT + (v >> 4) * CTX; t0 = (v & 15) * 16; L = CTX; lat = false; }
    const int cg = F.tid & 127, tq = F.tid >> 7, c0 = 8 * cg, tb = t0 + 4 * tq;
    u32x4 win[8];
#pragma unroll
    for (int j = 0; j < 8; ++j) { const int t = tb - 2 + j; win[j] = (t >= 0 && t < L) ? *(const u32x4*)(PROJ + (size_t)(rowbase + t) * NPROJ + OFF_XBC + c0) : (u32x4){0u, 0u, 0u, 0u}; }
    const int lc = c0 & 127, hf = lc >> 6, role = (lc >> 5) & 1; const bool rope = lat && (c0 >= 512);
#pragma unroll
    for (int tt = 0; tt < 4; ++tt) {
        f32x4 a0 = W.b[0], a1 = W.b[1];
#pragma unroll
        for (int j = 0; j < 5; ++j) { const u32x4 r = win[tt + j];
            a0 += W.w[j][0] * (f32x4){bflo(r.x), bfhi(r.x), bflo(r.y), bfhi(r.y)}; a1 += W.w[j][1] * (f32x4){bflo(r.z), bfhi(r.z), bflo(r.w), bfhi(r.w)}; }
        float uu[8];
#pragma unroll
        for (int k = 0; k < 4; ++k) { uu[k] = silu_f(a0[k]); uu[4 + k] = silu_f(a1[k]); }
        if (rope) {
            const int tk = tb + tt; const float pos = (float)(hf ? (tk & 63) : (tk >> 6));
#pragma unroll
            for (int k = 0; k < 8; ++k) { const float o = __shfl_xor(uu[k], 4); const float sn = __builtin_amdgcn_sinf(pos * W.ifq[k]), cs = __builtin_amdgcn_cosf(pos * W.ifq[k]);
                uu[k] = role ? (o * sn + uu[k] * cs) : (uu[k] * cs - o * sn); }
        }
        u32x4 o; o.x = pk2(uu[0], uu[1]); o.y = pk2(uu[2], uu[3]); o.z = pk2(uu[4], uu[5]); o.w = pk2(uu[6], uu[7]);
        *(u32x4*)(U + (size_t)(rowbase + tb + tt) * 1024 + c0) = o;
    }
}
__device__ __forceinline__ void ssd_prepass_weights(const Frame& F, int layer, PrepassW& W) {
    const int c0 = 8 * (F.tid & 127);
    const float* cwp = F.in[I_CONVW] + (size_t)layer * 5 * 1024 + c0;
#pragma unroll
    for (int j = 0; j < 5; ++j) { W.w[j][0] = *(const f32x4*)(cwp + j * 1024); W.w[j][1] = *(const f32x4*)(cwp + j * 1024 + 4); }
    W.b[0] = *(const f32x4*)(F.in[I_CONVB] + (size_t)layer * 1024 + c0); W.b[1] = *(const f32x4*)(F.in[I_CONVB] + (size_t)layer * 1024 + c0 + 4);
    const int n0 = c0 & 31;
#pragma unroll
    for (int k = 0; k < 8; ++k) W.ifq[k] = __builtin_amdgcn_exp2f(-(float)(n0 + k) * (13.287712379549449f / 32.0f)) * 0.15915494309189535f;
}

constexpr int S_CQ = 0, S_BQ = 17408, S_XN = 34816, S_XW = 44032, S_OPS = 53248, S_HB = 2 * S_OPS, S_MISC = S_HB + 2 * 17408, S_END = S_MISC + 3 * 1088;
static_assert(S_END <= LDS_ROWOFF + 18432, "SSD LDS image must stay below the control words");
__device__ __forceinline__ void ssd_chunk_compute(const LAS unsigned char* O, const LAS float* misc, const LAS unsigned char* HB, LAS unsigned char* HN, f32x4 (&Hacc)[4],
                                                  bf16_t* yp, int w, int q16, int gq, bool skip, float dsk) {
    const int lt = w >> 1, t2 = (w & 1) * 2;
    bf16x8 cfr[4];
#pragma unroll
    for (int ks = 0; ks < 4; ++ks) cfr[ks] = *(const LAS bf16x8*)(O + S_CQ + (16 * lt + q16) * 272 + ks * 64 + gq * 16);
    u32x4 pm[2];
    {
        const float csl = misc[64 + 16 * lt + q16];
#pragma unroll
        for (int pr = 0; pr < 2; ++pr) {
            f32x4 v[2];
#pragma unroll
            for (int hh = 0; hh < 2; ++hh) { const int st = 2 * pr + hh; f32x4 a = {0.f, 0.f, 0.f, 0.f};
#pragma unroll
                for (int ks = 0; ks < 4; ++ks) { const bf16x8 bfr = *(const LAS bf16x8*)(O + S_BQ + (16 * st + q16) * 272 + ks * 64 + gq * 16); a = __builtin_amdgcn_mfma_f32_16x16x32_bf16(bfr, cfr[ks], a, 0, 0, 0); }
                const f32x4 css = *(const LAS f32x4*)(misc + 64 + 16 * st + 4 * gq), dts = *(const LAS f32x4*)(misc + 16 * st + 4 * gq);
#pragma unroll
                for (int r = 0; r < 4; ++r) { const int sidx = 16 * st + 4 * gq + r; const float e = __expf(fminf(csl - css[r], 0.f)); a[r] = (sidx <= 16 * lt + q16) ? a[r] * e * dts[r] : 0.f; }
                v[hh] = a; }
            pm[pr].x = pk2(v[0][0], v[0][1]); pm[pr].y = pk2(v[0][2], v[0][3]); pm[pr].z = pk2(v[1][0], v[1][1]); pm[pr].w = pk2(v[1][2], v[1][3]);
        }
    }
    {
        const float ecs = misc[128 + 16 * lt + q16];
        const LAS unsigned char* xtr = O + S_XN + (4 * gq + (q16 >> 2)) * 144 + (q16 & 3) * 8;
#pragma unroll
        for (int k = 0; k < 2; ++k) { const int pt = t2 + k; f32x4 a = {0.f, 0.f, 0.f, 0.f};
#pragma unroll
            for (int ks = 0; ks < 4; ++ks) { const bf16x8 hfr = *(const LAS bf16x8*)(HB + (16 * pt + q16) * 272 + ks * 64 + gq * 16); a = __builtin_amdgcn_mfma_f32_16x16x32_bf16(hfr, cfr[ks], a, 0, 0, 0); }
            a = a * ecs;
#pragma unroll
            for (int pr = 0; pr < 2; ++pr) { const s16x4 lo = lds_tr16(xtr + (32 * pr) * 144 + pt * 32), hi = lds_tr16(xtr + (32 * pr + 16) * 144 + pt * 32);
                const bf16x8 xf = {lo[0], lo[1], lo[2], lo[3], hi[0], hi[1], hi[2], hi[3]};
                a = __builtin_amdgcn_mfma_f32_16x16x32_bf16(xf, __builtin_bit_cast(bf16x8, pm[pr]), a, 0, 0, 0); }
            { const u32x2 xv = *(const LAS u32x2*)(O + S_XN + (16 * lt + q16) * 144 + (16 * pt + 4 * gq) * 2); const float ds = skip ? dsk : 0.f;
                a[0] += ds * bflo(xv.x); a[1] += ds * bfhi(xv.x); a[2] += ds * bflo(xv.y); a[3] += ds * bfhi(xv.y); }
            { u32x2 ow; ow.x = pk2(a[0], a[1]); ow.y = pk2(a[2], a[3]); *(u32x2*)(yp + 16 * pt + 4 * gq) = ow; } }
    }
    {
        const int pt2 = w & 3, nb = (w >> 2) * 4; const float et = misc[256];
        const LAS unsigned char* xwtr = O + S_XW + (4 * gq + (q16 >> 2)) * 144 + (q16 & 3) * 8 + pt2 * 32;
        const LAS unsigned char* btr = O + S_BQ + (4 * gq + (q16 >> 2)) * 272 + (q16 & 3) * 8;
        bf16x8 xf2[2];
#pragma unroll
        for (int kk = 0; kk < 2; ++kk) { const s16x4 lo = lds_tr16(xwtr + (32 * kk) * 144), hi = lds_tr16(xwtr + (32 * kk + 16) * 144); xf2[kk] = (bf16x8){lo[0], lo[1], lo[2], lo[3], hi[0], hi[1], hi[2], hi[3]}; }
#pragma unroll
        for (int j = 0; j < 4; ++j) { const int nt = nb + j; Hacc[j] = Hacc[j] * et;
#pragma unroll
            for (int kk = 0; kk < 2; ++kk) { const s16x4 lo = lds_tr16(btr + (32 * kk) * 272 + nt * 32), hi = lds_tr16(btr + (32 * kk + 16) * 272 + nt * 32);
                const bf16x8 bT = {lo[0], lo[1], lo[2], lo[3], hi[0], hi[1], hi[2], hi[3]};
                Hacc[j] = __builtin_amdgcn_mfma_f32_16x16x32_bf16(bT, xf2[kk], Hacc[j], 0, 0, 0); }
            u32x2 hw; hw.x = pk2(Hacc[j][0], Hacc[j][1]); hw.y = pk2(Hacc[j][2], Hacc[j][3]);
            *(LAS u32x2*)(HN + (16 * pt2 + q16) * 272 + (16 * nt + 4 * gq) * 2) = hw; }
    }
}
struct SsdPre { u32x4 x, b[2], c[2]; float dt; };
__device__ __forceinline__ void ssd_mfma_unit(const Frame& F, int layer, int b, int h, int dir) {
    const int g = h >> 2, tid = F.tid, lane = F.lane, w = F.wave, q16 = lane & 15, gq = lane >> 4;
    const bf16_t* U = (const bf16_t*)(F.ws + WS_U); const float* DTS = (const float*)(F.ws + WS_DT);
    bf16_t* Y = (bf16_t*)(F.ws + (dir ? WS_YB : WS_YF));
    const float aneg = -__expf(F.in[I_ALOG][layer * 16 + dir * 8 + h]), dsk = F.in[I_DSKIP][layer * 8 + h];
    LAS unsigned char* L = F.lds;
    __syncthreads();
    { unsigned z_; asm volatile("v_mov_b32 %0, 0" : "=v"(z_));
      for (int i = tid; i < 64 * 272 / 16; i += NT) *(LAS u32x4*)(L + S_HB + i * 16) = (u32x4){z_, z_, z_, z_}; }
    f32x4 Hacc[4];
#pragma unroll
    for (int j = 0; j < 4; ++j) Hacc[j] = (f32x4){0.f, 0.f, 0.f, 0.f};
    SsdPre P0, P1;
    P0.dt = 0.f; P1.dt = 0.f;
    const int xt = tid >> 3, xp = tid & 7;
    const int bt = tid >> 4, bp = tid & 15;
#define SSD_ROW(ci_, l_) ({ const int s_ = (ci_) < 4 ? 0 : 1, k_ = s_ ? (ci_) - 4 : (ci_), nc_ = s_ ? 32 : 4, c_ = dir ? nc_ - 1 - k_ : k_; \
        (s_ ? b * SEQ : NLAT + b * CTX) + c_ * 64 + (dir ? 63 - (l_) : (l_)); })
#define SSD_PREFETCH(ci_, P_) do { P_.x = *(const u32x4*)(U + (size_t)SSD_ROW(ci_, xt) * 1024 + h * 64 + xp * 8); \
        if (w == 0) P_.dt = DTS[(size_t)SSD_ROW(ci_, lane) * 16 + dir * 8 + h]; \
        _Pragma("unroll") for (int j2_ = 0; j2_ < 2; ++j2_) { const int tok_ = bt + 32 * j2_; const size_t ro_ = (size_t)SSD_ROW(ci_, tok_) * 1024; \
            P_.b[j2_] = *(const u32x4*)(U + ro_ + 512 + g * 128 + bp * 8); P_.c[j2_] = *(const u32x4*)(U + ro_ + 768 + g * 128 + bp * 8); } } while (0)
#define SSD_MISC(slot_, P_) do { LAS float* m_ = (LAS float*)(L + S_MISC) + (slot_) * 272; const float dt_ = P_.dt; const float cs_ = wave_scan(dt_ * aneg); \
        const float tot_ = __builtin_bit_cast(float, __builtin_amdgcn_readlane(__builtin_bit_cast(int, cs_), 63)); \
        m_[lane] = dt_; m_[64 + lane] = cs_; m_[128 + lane] = __expf(cs_); m_[192 + lane] = __expf(tot_ - cs_) * dt_; if (lane == 0) m_[256] = __expf(tot_); } while (0)
#define SSD_STAGE(set_, slot_, P_) do { LAS unsigned char* O_ = L + (set_) * S_OPS; const float wl = ((const LAS float*)(L + S_MISC))[(slot_) * 272 + 192 + xt]; \
        *(LAS u32x4*)(O_ + S_XN + xt * 144 + xp * 16) = P_.x; \
        u32x4 xw; xw.x = pk2(bflo(P_.x.x) * wl, bfhi(P_.x.x) * wl); xw.y = pk2(bflo(P_.x.y) * wl, bfhi(P_.x.y) * wl); xw.z = pk2(bflo(P_.x.z) * wl, bfhi(P_.x.z) * wl); xw.w = pk2(bflo(P_.x.w) * wl, bfhi(P_.x.w) * wl); \
        *(LAS u32x4*)(O_ + S_XW + xt * 144 + xp * 16) = xw; \
        _Pragma("unroll") for (int k = 0; k < 2; ++k) { *(LAS u32x4*)(O_ + S_BQ + (bt + 32 * k) * 272 + bp * 16) = P_.b[k]; *(LAS u32x4*)(O_ + S_CQ + (bt + 32 * k) * 272 + bp * 16) = P_.c[k]; } } while (0)
#define SSD_ITER(ci_, PN_, PC_) do { const int ci = (ci_); const int ms1 = ms == 2 ? 0 : ms + 1, ms2 = ms1 == 2 ? 0 : ms1 + 1; \
        if (ci + 1 < 36) SSD_STAGE(cur ^ 1, ms1, PN_); \
        if (ci + 3 < 36) SSD_PREFETCH(ci + 3, PN_); \
        TPS(0); \
        { const int row0 = SSD_ROW(ci, 16 * (w >> 1) + q16); \
          ssd_chunk_compute(L + cur * S_OPS, (const LAS float*)(L + S_MISC) + ms * 272, L + S_HB + cur * 17408, L + S_HB + (cur ^ 1) * 17408, Hacc, Y + (size_t)row0 * 512 + h * 64, w, q16, gq, dir == 0, dsk); } \
        TPS(2); \
        if (w == 0 && ci + 2 < 36) SSD_MISC(ms2, PC_); \
        __syncthreads(); \
        TPS(3); \
        cur ^= 1; ms = ms1; } while (0)
    SSD_PREFETCH(0, P0);
    if (w == 0) SSD_MISC(0, P0);
    __syncthreads();
    SSD_STAGE(0, 0, P0);
    SSD_PREFETCH(1, P1);
    SSD_PREFETCH(2, P0);
    if (w == 0) SSD_MISC(1, P1);
    __syncthreads();
    TPS_BEGIN;
    int cur = 0, ms = 0;
    for (int c2 = 0; c2 < 36; c2 += 2) { SSD_ITER(c2, P1, P0); SSD_ITER(c2 + 1, P0, P1); }
#undef SSD_ROW
#undef SSD_PREFETCH
#undef SSD_MISC
#undef SSD_STAGE
#undef SSD_ITER
}

__device__ __forceinline__ void na_run(const Frame& F, int layer) {
    LAS unsigned char* KV = F.lds; LAS float* rp = (LAS float*)(F.lds + 120832);
    const bf16_t* PROJ = (const bf16_t*)(F.ws + WS_PROJ); bf16_t* MIX = (bf16_t*)(F.ws + WS_MIX);
    const int tid = F.tid, lane = F.lane, w = F.wave, q16 = lane & 15, g = lane >> 4;
    u32x4 pre[13];
#define NA_VPRE 13
#define NA_RB(m_) ({ int rb_ = 2 * (m_) - 4; rb_ = rb_ < 0 ? 0 : (rb_ > 24 ? 24 : rb_); __builtin_amdgcn_readfirstlane(rb_); })
#define NA_NL(rb_) ({ int nk_ = 32 - (rb_); nk_ = nk_ > 9 ? 9 : nk_; __builtin_amdgcn_readfirstlane(nk_ * 64 * 8); })
#define NA_LOAD(OFFS, b_, h_, rb_, nl_, K0, K1) do { int stid_ = tid; asm volatile("" : "+v"(stid_)); \
        _Pragma("unroll") for (int k_ = K0; k_ < K1; ++k_) { const int i_ = stid_ + k_ * NT, key_ = i_ >> 3, ch_ = i_ & 7; const bool ok_ = !(key_ < 576 && i_ >= (nl_)); \
            const int grow_ = key_ < 576 ? (b_) * SEQ + (rb_) * 64 + key_ : NLAT + (b_) * CTX + (key_ - 576); \
            pre[k_] = ok_ ? *(const u32x4*)(PROJ + (size_t)grow_ * NPROJ + (OFFS) + (h_) * 64 + ch_ * 8) : (u32x4){0u, 0u, 0u, 0u}; } } while (0)
#define NA_WRITE(nl_, K0, K1) do { int stid_ = tid; asm volatile("" : "+v"(stid_)); \
        _Pragma("unroll") for (int k_ = K0; k_ < K1; ++k_) { const int i_ = stid_ + k_ * NT, key_ = i_ >> 3, ch_ = i_ & 7; const bool ok_ = !(key_ < 576 && i_ >= (nl_)); \
            if (ok_) *(LAS u32x4*)(KV + key_ * NA_KS + ch_ * 16) = pre[k_]; } } while (0)
    int u = __builtin_amdgcn_readfirstlane(F.bid); int hprev = -1;
    if (u < 2048) { const int b = u >> 7, h = (u >> 4) & 7, m = u & 15, rb = NA_RB(m); NA_LOAD(OFF_K, b, h, rb, NA_NL(rb), 0, 13); }
    TPS_BEGIN;
    for (; u < 2048; u += F.G) {
        const int b = u >> 7, h = (u >> 4) & 7, m = u & 15, rbase = NA_RB(m), nloc8 = NA_NL(rbase);
        TPS(14);
        __syncthreads();
        TPS(10);
        NA_WRITE(nloc8, 0, 13);
        if (h != hprev) { if (tid < 465) rp[tid] = F.in[I_RPB][(size_t)(layer * 8 + h) * 465 + tid] * LOG2E; hprev = h; }
        NA_LOAD(OFF_V, b, h, rbase, nloc8, 0, NA_VPRE);
        __syncthreads();
        TPS(11);
        const int i = 2 * m + (w >> 2), j0 = (w & 3) * 16, qrow = b * SEQ + i * 64 + j0; int hs = j0 - 8; hs = hs < 0 ? 0 : (hs > 32 ? 32 : hs);
        int r0 = i - 4; r0 = r0 < 0 ? 0 : (r0 > 24 ? 24 : r0); const int kr0 = r0 - rbase;
        bf16x8 qf[2];
#pragma unroll
        for (int ks = 0; ks < 2; ++ks) qf[ks] = *(const bf16x8*)(PROJ + (size_t)(qrow + q16) * NPROJ + h * 64 + ks * 32 + g * 8);
        f32x4 S[32];
        const LAS unsigned char* kb = KV + q16 * NA_KS + g * 16;
        { const int j = j0 + q16; int cs = j - 8; cs = cs < 0 ? 0 : (cs > 48 ? 48 : cs);
          const int rb0 = (kr0 + rbase) - i + 7;
#pragma unroll
          for (int tl = 0; tl < 16; ++tl) { const int kr = tl >> 1, half = tl & 1; const int kidx0 = (kr0 + kr) * 64 + hs + 16 * half;
              f32x4 a = {0.f, 0.f, 0.f, 0.f};
#pragma unroll
              for (int ks = 0; ks < 2; ++ks) { const bf16x8 kf = *(const LAS bf16x8*)(kb + kidx0 * NA_KS + ks * 64); a = __builtin_amdgcn_mfma_f32_16x16x32_bf16(kf, qf[ks], a, 0, 0, 0); }
#pragma unroll
              for (int r = 0; r < 4; ++r) { const int kc = hs + 16 * half + 4 * g + r; const bool inw = (kc >= cs) && (kc < cs + 16);
                  int cbi = kc - j + 15; cbi = cbi < 0 ? 0 : (cbi > 30 ? 30 : cbi);
                  const float bias = rp[(rb0 + kr) * 31 + cbi];
                  const float t = a[r] * (0.125f * LOG2E) + bias; a[r] = inw ? t : -INFINITY; }
              S[tl] = a; if ((tl & 1) == 1) __builtin_amdgcn_sched_barrier(0); } }
#pragma unroll
        for (int tc = 0; tc < 16; ++tc) { const int kidx0 = 576 + 16 * tc; f32x4 a = {0.f, 0.f, 0.f, 0.f};
#pragma unroll
            for (int ks = 0; ks < 2; ++ks) { const bf16x8 kf = *(const LAS bf16x8*)(kb + kidx0 * NA_KS + ks * 64); a = __builtin_amdgcn_mfma_f32_16x16x32_bf16(kf, qf[ks], a, 0, 0, 0); }
            S[16 + tc] = a * (0.125f * LOG2E); if ((tc & 1) == 1) __builtin_amdgcn_sched_barrier(0); }
        float mx = -INFINITY;
#pragma unroll
        for (int t = 0; t < 32; ++t) mx = fmaxf(fmaxf(fmaxf(S[t][0], S[t][1]), fmaxf(S[t][2], S[t][3])), mx);
        mx = fmaxf(mx, __shfl_xor(mx, 16)); mx = fmaxf(mx, __shfl_xor(mx, 32));
        float sum = 0.f; u32x4 P[16];
#pragma unroll
        for (int kk = 0; kk < 16; ++kk) { float e[8];
#pragma unroll
            for (int r = 0; r < 4; ++r) { e[r] = __builtin_amdgcn_exp2f(S[2 * kk][r] - mx); e[4 + r] = __builtin_amdgcn_exp2f(S[2 * kk + 1][r] - mx); }
            sum += ((e[0] + e[1]) + (e[2] + e[3])) + ((e[4] + e[5]) + (e[6] + e[7]));
            P[kk].x = pg8::cvt_pk_bf16_pin(e[0], e[1]); P[kk].y = pg8::cvt_pk_bf16_pin(e[2], e[3]); P[kk].z = pg8::cvt_pk_bf16_pin(e[4], e[5]); P[kk].w = pg8::cvt_pk_bf16_pin(e[6], e[7]); }
        sum += __shfl_xor(sum, 16); sum += __shfl_xor(sum, 32);
        const float inv = 1.0f / sum;
        TPS(12);
        __syncthreads();
        NA_WRITE(nloc8, 0, NA_VPRE); NA_LOAD(OFF_V, b, h, rbase, nloc8, NA_VPRE, 13); NA_WRITE(nloc8, NA_VPRE, 13);
        { const int un = u + F.G; if (un < 2048) { const int bn = un >> 7, hn = (un >> 4) & 7, mn = un & 15, rbn = NA_RB(mn); NA_LOAD(OFF_K, bn, hn, rbn, NA_NL(rbn), 0, 13); } }
        __syncthreads();
        TPS(13);
        f32x4 o[4];
#pragma unroll
        for (int dt = 0; dt < 4; ++dt) o[dt] = (f32x4){0.f, 0.f, 0.f, 0.f};
        const LAS unsigned char* vb = KV + (4 * g + (q16 >> 2)) * NA_KS + (q16 & 3) * 8;
#pragma unroll
        for (int kk = 0; kk < 16; ++kk) {
            const int kidx0 = (kk < 8) ? (kr0 + kk) * 64 + hs : 576 + 32 * (kk - 8);
            const bf16x8 pa = __builtin_bit_cast(bf16x8, P[kk]);
#pragma unroll
            for (int dt = 0; dt < 4; ++dt) { const s16x4 lo = lds_tr16(vb + kidx0 * NA_KS + dt * 32), hi = lds_tr16(vb + (kidx0 + 16) * NA_KS + dt * 32);
                const bf16x8 vf = {lo[0], lo[1], lo[2], lo[3], hi[0], hi[1], hi[2], hi[3]};
                o[dt] = __builtin_amdgcn_mfma_f32_16x16x32_bf16(vf, pa, o[dt], 0, 0, 0); }
            if ((kk & 1) == 1) __builtin_amdgcn_sched_barrier(0);
        }
        { bf16_t* op = MIX + (size_t)(qrow + q16) * D + h * 64 + 4 * g;
#pragma unroll
          for (int dt = 0; dt < 4; ++dt) { u32x2 ow; ow.x = pk2(o[dt][0] * inv, o[dt][1] * inv); ow.y = pk2(o[dt][2] * inv, o[dt][3] * inv); *(u32x2*)(op + dt * 16) = ow; } }
    }
#undef NA_RB
#undef NA_NL
#undef NA_LOAD
#undef NA_WRITE
}
__device__ __forceinline__ void p_mixa(const Frame& F, int layer, bool last) {
    TPS_BEGIN;
    { PrepassW W; ssd_prepass_weights(F, layer, W);
      for (int u = F.bid; u < NTOK / 16; u += F.G) ssd_prepass_unit(F, u, W); }
    TPS(4);
    na_run(F, layer);
    TPS(5);
    if (!last) for (int u = F.bid; u < 256; u += F.G) na_unit(F, layer, u >> 4, (u >> 1) & 7, 1, u & 1);
    TPS(6);
}
__device__ __forceinline__ void p_mixb(const Frame& F, int layer) {
    for (int u0 = F.bid; u0 < 256 * REP_SSD; u0 += F.G) { const int u = u0 & 255; ssd_mfma_unit(F, layer, u >> 4, (u >> 1) & 7, u & 1); }
}

__device__ __forceinline__ void p_ssdcomb(const Frame& F, int layer, bool last) {
    const bf16_t* PROJ = (const bf16_t*)(F.ws + WS_PROJ); bf16_t* MIX = (bf16_t*)(F.ws + WS_MIX);
    const bf16_t* YF = (const bf16_t*)(F.ws + WS_YF); const bf16_t* YB = (const bf16_t*)(F.ws + WS_YB);
    const float* nw = F.in[I_NORMW] + layer * 512 + F.lane * 8;
    const f32x4 nw0 = *(const f32x4*)nw, nw1 = *(const f32x4*)(nw + 4);
    const int nrows = last ? NLAT : NTOK;
    u32x4 pyf = {0u, 0u, 0u, 0u}, pyb = pyf, pz = pyf;
#define SC_LOAD(r_) do { const size_t o_ = (size_t)(r_) * 512 + F.lane * 8; pyf = *(const u32x4*)(YF + o_); pyb = *(const u32x4*)(YB + o_); \
        pz = *(const u32x4*)(PROJ + (size_t)(r_) * NPROJ + OFF_Z + F.lane * 8); } while (0)
    if (F.gw < nrows) SC_LOAD(F.gw);
    for (int row = F.gw; row < nrows; row += F.NGW) {
        const f32x4 a0 = {bflo(pyf.x) + bflo(pyb.x), bfhi(pyf.x) + bfhi(pyb.x), bflo(pyf.y) + bflo(pyb.y), bfhi(pyf.y) + bfhi(pyb.y)}, a1 = {bflo(pyf.z) + bflo(pyb.z), bfhi(pyf.z) + bfhi(pyb.z), bflo(pyf.w) + bflo(pyb.w), bfhi(pyf.w) + bfhi(pyb.w)}; const u32x4 zv = pz;
        if (row + F.NGW < nrows) SC_LOAD(row + F.NGW);
        float y[8] = {a0[0] * silu_f(bflo(zv.x)), a0[1] * silu_f(bfhi(zv.x)), a0[2] * silu_f(bflo(zv.y)), a0[3] * silu_f(bfhi(zv.y)),
                      a1[0] * silu_f(bflo(zv.z)), a1[1] * silu_f(bfhi(zv.z)), a1[2] * silu_f(bflo(zv.w)), a1[3] * silu_f(bfhi(zv.w))};
        float ss = 0.f;
#pragma unroll
        for (int k = 0; k < 8; ++k) ss += y[k] * y[k];
#pragma unroll
        for (int of = 1; of < 32; of <<= 1) ss += __shfl_xor(ss, of);
        const float rs = 1.0f / sqrtf(ss * (1.0f / 256.0f) + RMS_EPS);
        u32x4 w; w.x = pk2(y[0] * rs * nw0[0], y[1] * rs * nw0[1]); w.y = pk2(y[2] * rs * nw0[2], y[3] * rs * nw0[3]);
        w.z = pk2(y[4] * rs * nw1[0], y[5] * rs * nw1[1]); w.w = pk2(y[6] * rs * nw1[2], y[7] * rs * nw1[3]);
        *(u32x4*)(MIX + (size_t)row * D + 512 + F.lane * 8) = w;
    }
}

__device__ __forceinline__ void p_outproj(const Frame& F, int layer, bool last) {
    pg8::Gemm g{(const bf16_t*)(F.ws + WS_MIX), (const bf16_t*)(F.ws + WS_WOUT) + (size_t)layer * D * D, D};
    pg8::DenseOrder S; S.init(last ? NLAT : NTOK, D, D, F.G, F.bid);
    pg8::EpiGate E{(bf16_t*)(F.ws + WS_DELTA1), (const float*)(F.ws + WS_MOD) + (size_t)layer * 17 * MODW, 2 * D};
    pg8::gemm_phase<pg8::EpiGate, pg8::DenseOrder, true, true>(F.lds, g, S, E, F.tid);
    if (layer < 3) deferred_conv(F, (NTOK / 256) * (D / 256), layer == 0 ? DW_L0_OUT : (layer == 1 ? DW_L1_OUT : DW_L2_OUT), DW_Q);
}

__device__ __forceinline__ unsigned* cnt_word(const Frame& F, int slot, int hf, int e) { return (unsigned*)(F.ws + WS_CTL) + CW_CNT + ((slot * 2 + hf) * 8 + e) * 64; }
template <bool MOE> __device__ __forceinline__ void ln1_body(const Frame& F, int layer, bool last) {
    constexpr bool moe = MOE;
    bf16_t* X = (bf16_t*)(F.ws + WS_X); bf16_t* H = (bf16_t*)(F.ws + WS_H);
    const float* MOD = (const float*)(F.ws + WS_MOD) + (size_t)layer * 17 * MODW;
    const float* lg = F.in[I_LNG] + (size_t)(layer * 2) * D; const float* lb = F.in[I_LNB] + (size_t)(layer * 2) * D;
    const int slot = layer >> 1;
    const int nrows = last ? NLAT : NTOK;
    float rw[16][8];
    if (moe) { const float* R = F.in[I_RW] + (size_t)slot * D * 8;
#pragma unroll
        for (int j = 0; j < 4; ++j)
#pragma unroll
            for (int k = 0; k < 4; ++k) { const int lane = F.lane; const f32x4 a = *(const f32x4*)(R + (size_t)(RIDX(j) + k) * 8), b2 = *(const f32x4*)(R + (size_t)(RIDX(j) + k) * 8 + 4);
                rw[j * 4 + k][0] = a[0]; rw[j * 4 + k][1] = a[1]; rw[j * 4 + k][2] = a[2]; rw[j * 4 + k][3] = a[3]; rw[j * 4 + k][4] = b2[0]; rw[j * 4 + k][5] = b2[1]; rw[j * 4 + k][6] = b2[2]; rw[j * 4 + k][7] = b2[3]; } }
    int nrec = 0;
    if (moe) { __syncthreads(); if (F.tid < 32) ((LAS unsigned*)F.lds)[F.tid] = 0u; __syncthreads(); }
    const bf16_t* DL = (const bf16_t*)(F.ws + WS_DELTA1);
    const int rpw = (nrows + F.NGW - 1) / F.NGW, rbeg = F.gw * rpw, rend = (rbeg + rpw < nrows) ? rbeg + rpw : nrows;
    f32x4 G[4], B[4], SC[4], SH[4]; int mcur = -1;
    if (!moe) { col_load(lg, F.lane, G); col_load(lb, F.lane, B); }
    RowRaw r0 = {}, r1 = {};
    if (rbeg < rend) row_issue<true>(X, DL, rbeg, F.lane, r0);
    if (rbeg + 1 < rend) row_issue<true>(X, DL, rbeg + 1, F.lane, r1);
    for (int row = rbeg; row < rend; ++row) {
        f32x4 v[4], hv[4];
        row_combine(r0, v); r0 = r1;
        if (row + 2 < rend) row_issue<true>(X, DL, row + 2, F.lane, r1);
        const float* m = MOD + (size_t)mod_row_of(row) * MODW;
        if (moe) {
            row_ln(v, lg, lb, F.lane);
            row_store_h(X + (size_t)row * D, F.lane, v);
            row_mod_store8((unsigned char*)H + (size_t)row * D, F.lane, v, m + 3 * D, m + 4 * D, hv);
        } else {
            row_ln_r(v, G, B);
            row_store_h(X + (size_t)row * D, F.lane, v);
            const int mr = mod_row_of(row);
            if (mr != mcur) { col_load(m + 4 * D, F.lane, SC, 1.0f); col_load(m + 3 * D, F.lane, SH); mcur = mr; }
#pragma unroll
            for (int q = 0; q < 4; ++q) hv[q] = v[q] * SC[q] + SH[q];
            if ((FP8_DENSE1_MASK >> slot) & 1) {
#pragma unroll
                for (int j = 0; j < 2; ++j) { const f32x4 t0 = hv[2 * j] * (float)(1 << S8_ACT), t1 = hv[2 * j + 1] * (float)(1 << S8_ACT); u32x2 w8; w8.x = pk8(t0[0], t0[1], t0[2], t0[3]); w8.y = pk8(t1[0], t1[1], t1[2], t1[3]);
                    *(u32x2*)((unsigned char*)H + (size_t)row * D + 8 * F.lane + 512 * j) = w8; }
            } else row_store_h(H + (size_t)row * D, F.lane, hv);
        }
        if (moe) {
            float lg8[8];
#pragma unroll
            for (int e = 0; e < 8; ++e) { float s = 0.f;
#pragma unroll
                for (int j = 0; j < 4; ++j)
#pragma unroll
                    for (int k = 0; k < 4; ++k) s += hv[j][k] * rw[j * 4 + k][e];
                lg8[e] = wave_sum(s); }
            int e0 = 0; float v0 = lg8[0];
#pragma unroll
            for (int e = 1; e < 8; ++e) if (lg8[e] > v0) { v0 = lg8[e]; e0 = e; }
            int e1 = -1; float v1 = -INFINITY;
#pragma unroll
            for (int e = 0; e < 8; ++e) if (e != e0 && lg8[e] > v1) { v1 = lg8[e]; e1 = e; }
            if (F.lane == 0) {
                const unsigned s0 = __hip_atomic_fetch_add((LAS unsigned*)F.lds + e0, 1u, __ATOMIC_RELAXED, __HIP_MEMORY_SCOPE_WORKGROUP), s1 = __hip_atomic_fetch_add((LAS unsigned*)F.lds + e1, 1u, __ATOMIC_RELAXED, __HIP_MEMORY_SCOPE_WORKGROUP);
                const float ex = __expf(v1 - v0), g0 = 1.0f / (1.0f + ex);
                ((LAS u32x4*)(F.lds + 256))[F.wave * 32 + nrec] = (u32x4){(unsigned)e0 | ((unsigned)e1 << 8), s0, s1, (unsigned)row};
                *(f32x2*)(F.ws + WS_GATES + (size_t)row * 8) = (f32x2){g0, ex * g0};
            }
            ++nrec;
        }
    }
    if (moe) {
        __syncthreads();
        if (F.tid < 8) ((LAS unsigned*)F.lds)[16 + F.tid] = atomicAdd(cnt_word(F, slot, 0, F.tid), ((LAS unsigned*)F.lds)[F.tid]);
        __syncthreads();
        int* list = (int*)(F.ws + WS_LIST);
        if (F.lane < nrec) { const u32x4 rc = ((LAS u32x4*)(F.lds + 256))[F.wave * 32 + F.lane]; const int e0 = rc.x & 255, e1 = (rc.x >> 8) & 255; const int row = (int)rc.w;
            const unsigned s0 = ((LAS unsigned*)F.lds)[16 + e0] + rc.y, s1 = ((LAS unsigned*)F.lds)[16 + e1] + rc.z;
            list[e0 * NTOK + s0] = row; list[e1 * NTOK + s1] = row;
            *(u32x4*)(F.ws + WS_ROUTE + (size_t)row * 16) = (u32x4){rc.x, s0, s1, 0u}; }
    }
}

__device__ __forceinline__ void p_ln1(const Frame& F, int layer, bool last) { if (layer & 1) ln1_body<true>(F, layer, last); else ln1_body<false>(F, layer, last); }

__device__ __forceinline__ void p_ffn1_dense(const Frame& F, int layer, bool last) {
    const int s = layer >> 1;
#if USE_FP8 && FP8_DENSE2
    typedef pg8::EpiSwiGLU8 EpiH; EpiH E{F.ws + WS_HID, DFF};
#else
    typedef pg8::EpiSwiGLU EpiH; EpiH E{(bf16_t*)(F.ws + WS_HID), DFF};
#endif
    if ((FP8_DENSE1_MASK >> s) & 1) {
        pg8::Gemm g{(const bf16_t*)(F.ws + WS_H), (const bf16_t*)(F.ws + WS_WFGU + (size_t)s * 2 * DFF * D * 2), D / 2};
        pg8::DenseOrder S; S.init(last ? NLAT : NTOK, 2 * DFF, D / 2, F.G, F.bid, REP_GEMM);
        pg8::gemm_phase<EpiH, pg8::DenseOrder, true, FP8_SP2, true>(F.lds, g, S, E, F.tid, (127 - S8_WGU) * 0x01010101, (127 - S8_ACT) * 0x01010101);
    } else {
        pg8::Gemm g{(const bf16_t*)(F.ws + WS_H), (const bf16_t*)(F.ws + WS_WFGU) + (size_t)s * 2 * DFF * D, D};
        pg8::DenseOrder S; S.init(last ? NLAT : NTOK, 2 * DFF, D, F.G, F.bid, REP_GEMM);
        pg8::gemm_phase<EpiH, pg8::DenseOrder, true, true>(F.lds, g, S, E, F.tid);
    }
    if (layer == 0) deferred_conv(F, (NTOK / 256) * (2 * DFF / 256), DW_L0_F1, DW_Q);
}
__device__ __forceinline__ void p_ffn2_dense(const Frame& F, int layer, bool last) {
    const int s = layer >> 1;
    pg8::EpiGate E{(bf16_t*)(F.ws + WS_DELTA2), (const float*)(F.ws + WS_MOD) + (size_t)layer * 17 * MODW, 5 * D};
#if USE_FP8 && FP8_DENSE2
    pg8::Gemm g{(const bf16_t*)(F.ws + WS_HID), (const bf16_t*)(F.ws + WS_WFD + (size_t)s * D * DFF), DFF / 2};
    pg8::DenseOrder S; S.init(last ? NLAT : NTOK, D, DFF / 2, F.G, F.bid);
    pg8::gemm_phase<pg8::EpiGate, pg8::DenseOrder, true, FP8_SP2, true>(F.lds, g, S, E, F.tid, (127 - S8_WD) * 0x01010101, (127 - S8_HID) * 0x01010101);
#else
    pg8::Gemm g{(const bf16_t*)(F.ws + WS_HID), (const bf16_t*)(F.ws + WS_WFD) + (size_t)s * D * DFF, DFF};
    pg8::DenseOrder S; S.init(last ? NLAT : NTOK, D, DFF, F.G, F.bid);
    pg8::gemm_phase<pg8::EpiGate, pg8::DenseOrder, true, true>(F.lds, g, S, E, F.tid);
#endif
    if (layer == 0) deferred_conv(F, (NTOK / 256) * (D / 256), DW_L0_F2, DW_Q2);
}
__device__ __forceinline__ void moe_prefix(const Frame& F, int slot, int hf, int (&ts)[9], int (&cn)[8]) {
    int a = 0;
#pragma unroll
    for (int e = 0; e < 8; ++e) { cn[e] = (int)*cnt_word(F, slot, hf, e); ts[e] = a; a += (cn[e] + 255) >> 8; }
    ts[8] = a;
}
__device__ __forceinline__ void p_ffn1_moe(const Frame& F, int layer) {
    const int slot = layer >> 1; int cn[8];
    pg8::MoeOrder<true> S; moe_prefix(F, slot, 0, S.ts, cn);
    S.nM = S.ts[8]; S.nN = 2 * DFFE / 256; S.G = F.G; S.c = F.bid; S.K = D / 2; S.estride = (long)2 * DFFE * D; S.rowoff = (const LAS unsigned short*)(F.lds + LDS_ROWOFF); S.rowbytes = D;
    {
        const int* list = (const int*)(F.ws + WS_LIST); LAS unsigned short* ro = (LAS unsigned short*)(F.lds + LDS_ROWOFF); pg8::Unit u;
        for (int i = F.wave; i < 36 && S.next(i, u); i += NWAVES) { const int e = S.expert_of(u.pm); int tse = 0, cne = 0;
#pragma unroll
            for (int j = 0; j < 8; ++j) { tse = (j == e) ? S.ts[j] : tse; cne = (j == e) ? cn[j] : cne; }
            int tk[4];
#pragma unroll
            for (int q = 0; q < 4; ++q) { const int sl = (u.pm - tse) * 256 + F.lane + 64 * q; tk[q] = sl < cne ? list[e * NTOK + sl] : 0; }
#pragma unroll
            for (int q = 0; q < 4; ++q) ro[i * 256 + F.lane + 64 * q] = (unsigned short)tk[q]; }
        __syncthreads();
    }
    pg8::Gemm g{(const bf16_t*)(F.ws + WS_H), (const bf16_t*)(F.ws + WS_WMGU + (size_t)slot * NEXP * 2 * DFFE * D), D / 2};
    pg8::EpiSwiGLU8 E{F.ws + WS_HID, DFFE};
    pg8::gemm_phase<pg8::EpiSwiGLU8, pg8::MoeOrder<true>, true, FP8_SP2, true>(F.lds, g, S, E, F.tid, (127 - S8_WGU) * 0x01010101, (127 - S8_ACT) * 0x01010101);
}
__device__ __forceinline__ void p_ffn2_moe(const Frame& F, int layer) {
    const int slot = layer >> 1; int cn[8];
    pg8::MoeOrder<false> S; moe_prefix(F, slot, 0, S.ts, cn);
    S.nM = S.ts[8]; S.nN = D / 256; S.G = F.G; S.c = F.bid; S.K = DFFE / 2; S.estride = (long)D * DFFE; S.rowoff = nullptr; S.rowbytes = 0;
    pg8::EpiBf16 E{(bf16_t*)(F.ws + WS_YP), D};
    pg8::Gemm g{(const bf16_t*)(F.ws + WS_HID), (const bf16_t*)(F.ws + WS_WMD + (size_t)slot * NEXP * D * DFFE), DFFE / 2};
    pg8::gemm_phase<pg8::EpiBf16, pg8::MoeOrder<false>, true, FP8_SP2, true>(F.lds, g, S, E, F.tid, (127 - S8_WD) * 0x01010101, (127 - S8_HID) * 0x01010101);
}

template <bool MOE> __device__ __forceinline__ void ln2_body(const Frame& F, int layer, bool last) {
    bf16_t* X = (bf16_t*)(F.ws + WS_X); bf16_t* H = (bf16_t*)(F.ws + WS_H);
    const float* MOD = (const float*)(F.ws + WS_MOD) + (size_t)layer * 17 * MODW;
    const float* lg = F.in[I_LNG] + (size_t)(layer * 2 + 1) * D; const float* lb = F.in[I_LNB] + (size_t)(layer * 2 + 1) * D;
    const int slot = layer >> 1;
    const int nrows = last ? NLAT : NTOK;
    int ts0[9], cn[8];
    if (MOE) moe_prefix(F, slot, 0, ts0, cn);
    const bf16_t* YP = (const bf16_t*)(F.ws + WS_YP); const bf16_t* DL = (const bf16_t*)(F.ws + WS_DELTA2);
    const int rpw = (nrows + F.NGW - 1) / F.NGW, rbeg = F.gw * rpw, rend = (rbeg + rpw < nrows) ? rbeg + rpw : nrows;
    f32x4 G[4], B[4], SC[4], SH[4], Q[4]; int mcur = -1;
    col_load(lg, F.lane, G); col_load(lb, F.lane, B);
    RowRaw r0 = {}, r1 = {}; u32x4 rt0 = {0u, 0u, 0u, 0u}, rt1 = {0u, 0u, 0u, 0u}; f32x2 g0 = {0.f, 0.f}, g1 = {0.f, 0.f}; u32x4 ya[2] = {}, yb[2] = {};
#define LN2_ISSUE(row_, r_, rt_, g_) do { row_issue<!MOE>(X, DL, (row_), F.lane, r_); \
        if (MOE) { rt_ = *(const u32x4*)(F.ws + WS_ROUTE + (size_t)(row_) * 16); g_ = *(const f32x2*)(F.ws + WS_GATES + (size_t)(row_) * 8); } } while (0)
#define LN2_ISSUE_Y(rt_) do { const int e0_ = (rt_).x & 255, e1_ = ((rt_).x >> 8) & 255; int t0_ = 0, t1_ = 0; \
        _Pragma("unroll") for (int e = 0; e < 8; ++e) { const int tv = ts0[e]; t0_ = (e == e0_) ? tv : t0_; t1_ = (e == e1_) ? tv : t1_; } \
        const bf16_t* y0_ = YP + ((size_t)t0_ * 256 + (rt_).y) * D; const bf16_t* y1_ = YP + ((size_t)t1_ * 256 + (rt_).z) * D; \
        _Pragma("unroll") for (int j = 0; j < 2; ++j) { ya[j] = *(const u32x4*)(y0_ + 8 * F.lane + 512 * j); yb[j] = *(const u32x4*)(y1_ + 8 * F.lane + 512 * j); } } while (0)
    if (rbeg < rend) LN2_ISSUE(rbeg, r0, rt0, g0);
    if (rbeg + 1 < rend) LN2_ISSUE(rbeg + 1, r1, rt1, g1);
    if (MOE) { if (rbeg < rend) LN2_ISSUE_Y(rt0); }
    for (int row = rbeg; row < rend; ++row) {
        f32x4 v[4], hv[4];
        const int mr = mod_row_of(row);
        if (mr != mcur) { const float* m = MOD + (size_t)mr * MODW; if (MOE) col_load(m + 5 * D, F.lane, Q, 1.0f);
            if (!last) { const float* mn = m + (size_t)17 * MODW; col_load(mn + D, F.lane, SC, 1.0f); col_load(mn, F.lane, SH); }
            mcur = mr; }
        if (MOE) {
#pragma unroll
            for (int j = 0; j < 2; ++j) { f32x4 x0, x1, a0, a1, b0, b1; unpack8(r0.x[j], x0, x1); unpack8(ya[j], a0, a1); unpack8(yb[j], b0, b1);
                v[2 * j] = x0 * ALPHA + Q[2 * j] * (a0 * g0[0] + b0 * g0[1]); v[2 * j + 1] = x1 * ALPHA + Q[2 * j + 1] * (a1 * g0[0] + b1 * g0[1]); }
        } else row_combine(r0, v);
        r0 = r1; rt0 = rt1; g0 = g1;
        if (MOE) { if (row + 1 < rend) LN2_ISSUE_Y(rt0); }
        if (row + 2 < rend) LN2_ISSUE(row + 2, r1, rt1, g1);
        row_ln_r(v, G, B);
        if (last) row_store(F.out + (size_t)row * D, F.lane, v);
        else { row_store_h(X + (size_t)row * D, F.lane, v);
#pragma unroll
            for (int q = 0; q < 4; ++q) hv[q] = v[q] * SC[q] + SH[q];
            row_store_h(H + (size_t)row * D, F.lane, hv); }
    }
#undef LN2_ISSUE
#undef LN2_ISSUE_Y
}
__device__ __forceinline__ void p_ln2(const Frame& F, int layer, bool last) { if (layer & 1) ln2_body<true>(F, layer, last); else ln2_body<false>(F, layer, last); }

constexpr int NPL = 9;
constexpr int NPH = 2 + NPL * DEPTH;
#ifndef SITE_MASK
#define SITE_MASK 0xFFFFF
#endif
#ifndef TPROBE_MULT
#define TPROBE_MULT 4
#endif
#define SITE(n) (((SITE_MASK) >> (n)) & 1)
__global__ void __launch_bounds__(NT, 2) fwd_kernel(Args args) {
    extern __shared__ __attribute__((aligned(16))) unsigned char lds_raw[];
    Frame F;
    F.lds = (LAS unsigned char*)lds_raw; F.in = args.in; F.out = args.out; F.ws = args.ws;
    F.tid = threadIdx.x; F.lane = F.tid & 63; F.wave = __builtin_amdgcn_readfirstlane(F.tid >> 6); F.bid = blockIdx.x; F.G = gridDim.x;
    F.gw = F.bid * NWAVES + F.wave; F.NGW = F.G * NWAVES;
    volatile LAS unsigned* MISC = (volatile LAS unsigned*)(F.lds + LDS_MISC);
    if (F.tid < 64) MISC[F.tid] = 0u;
    __syncthreads();
    XcdBarrier bar; bar.bar = (unsigned*)(F.ws + WS_CTL) + CW_BAR; bar.x = 0; bar.st = MISC + 8;
#if MK_SINGLE
    bar = xcd_barrier_post((unsigned*)(F.ws + WS_CTL) + CW_BAR, MISC + 8);
#endif
    const int lo = args.ph_lo, hi = args.ph_hi;
#define IN(k) (lo <= (k) && (k) < hi)
#if TPROBE >= 0
    unsigned long long tp_prev = __builtin_amdgcn_s_memrealtime(), tp_acc = 0ull;
#define TP(type) do { const unsigned long long t_ = __builtin_amdgcn_s_memrealtime(); if ((type) == TPROBE) tp_acc += t_ - tp_prev; tp_prev = t_; } while (0)
#else
#define TP(type) do { } while (0)
#endif
#if MK_SINGLE
#define SEAM(k) do { if (IN(k) && IN((k) + 1)) { XcdBarrier b2_ = bar; int z_; asm volatile("s_mov_b32 %0, 0" : "=s"(z_)); b2_.bar = bar.bar + z_; int ln_; asm volatile("v_mbcnt_lo_u32_b32 %0, -1, 0\n\tv_mbcnt_hi_u32_b32 %0, -1, %0" : "=v"(ln_)); xcd_barrier(b2_, F.wave == 0 && ln_ == 0); } } while (0)
#else
#define SEAM(k) do { } while (0)
#endif
    if constexpr (SITE(0)) if (IN(0)) p_pro_a(fresh(F));
    SEAM(0); TP(0);
    if constexpr (SITE(1)) if (IN(1)) p_pro_b(fresh(F));
    SEAM(1); TP(1);
    for (int layer = 0; layer < DEPTH; ++layer) {
        const int pb = 2 + NPL * layer; const bool last = layer == DEPTH - 1; const bool moe = layer & 1;
        if constexpr (SITE(2)) if (IN(pb + 0)) p_inproj(fresh(F), layer);
        SEAM(pb + 0); TP(2);
        if constexpr (SITE(3)) if (IN(pb + 1)) p_mixa(fresh(F), layer, last);
        SEAM(pb + 1); TP(3);
        if constexpr (SITE(12)) if (IN(pb + 2)) p_mixb(fresh(F), layer);
        SEAM(pb + 2); TP(4);
        if constexpr (SITE(4)) if (IN(pb + 3)) { p_ssdcomb(fresh(F), layer, last); if (!USE_FP8 && layer == 2) { int rot = 0; conv_moe(fresh(F), 1, rot); } }
        SEAM(pb + 3); TP(5);
        if constexpr (SITE(5)) if (IN(pb + 4)) p_outproj(fresh(F), layer, last);
        SEAM(pb + 4); TP(6);
        if constexpr (SITE(6)) if (IN(pb + 5)) p_ln1(fresh(F), layer, last);
        SEAM(pb + 5); TP(7);
        if (moe) {
            if constexpr (SITE(7)) if (IN(pb + 6)) p_ffn1_moe(fresh(F), layer);
            SEAM(pb + 6); TP(8);
            if constexpr (SITE(8)) if (IN(pb + 7)) p_ffn2_moe(fresh(F), layer);
            SEAM(pb + 7); TP(9);
        } else {
            if constexpr (SITE(9)) if (IN(pb + 6)) p_ffn1_dense(fresh(F), layer, last);
            SEAM(pb + 6); TP(10);
            if constexpr (SITE(10)) if (IN(pb + 7)) p_ffn2_dense(fresh(F), layer, last);
            SEAM(pb + 7); TP(11);
        }
        if constexpr (SITE(11)) if (IN(pb + 8)) p_ln2(fresh(F), layer, last);
        if (!last) SEAM(pb + 8);
        TP(12);
    }
#if TPROBE >= 100
    __syncthreads(); tp_acc = ((volatile LAS unsigned*)(F.lds + LDS_MISC))[40];
#endif
#if TPROBE >= 0
    { const unsigned long long t_end = __builtin_amdgcn_s_memrealtime(); while (__builtin_amdgcn_s_memrealtime() - t_end < (unsigned long long)TPROBE_MULT * tp_acc) __builtin_amdgcn_s_sleep(8); }
#endif
#undef IN
#undef SEAM
}

extern "C" void kernel_launch(void* const* d_in, const int* in_sizes, int n_in, void* d_out, int out_size, void* d_ws, size_t ws_size, hipStream_t stream) {
    static int grid = 0;
    if (grid == 0) {
        if (n_in != 24 || out_size != NLAT * D || ws_size < WS_END) { fprintf(stderr, "kernel_launch: unexpected shapes (n_in %d, out %d, ws %zu < %zu)\n", n_in, out_size, ws_size, (size_t)WS_END); grid = -1; return; }
        int dev = 0, cus = 0, per_cu = 0;
        if (hipGetDevice(&dev) != hipSuccess || hipDeviceGetAttribute(&cus, hipDeviceAttributeMultiprocessorCount, dev) != hipSuccess) { grid = -1; return; }
        if (hipFuncSetAttribute((const void*)fwd_kernel, hipFuncAttributeMaxDynamicSharedMemorySize, LDS_BYTES) != hipSuccess) { fprintf(stderr, "kernel_launch: hipFuncSetAttribute failed\n"); grid = -1; return; }
        if (hipOccupancyMaxActiveBlocksPerMultiprocessor(&per_cu, (const void*)fwd_kernel, NT, LDS_BYTES) != hipSuccess || per_cu < 1) { fprintf(stderr, "kernel_launch: occupancy query says %d\n", per_cu); }
        (void)hipGetLastError();
        grid = cus;
    }
    if (grid < 0) return;
    (void)in_sizes;
    if (hipMemsetAsync((char*)d_ws + WS_CTL, 0, CTL_BYTES, stream) != hipSuccess) return;
    Args a{};
    for (int i = 0; i < 24; ++i) a.in[i] = (const float*)d_in[i];
    a.out = (float*)d_out; a.ws = (unsigned char*)d_ws;
#if MK_SINGLE
    a.ph_lo = 0; a.ph_hi = NPH;
    hipLaunchKernelGGL(fwd_kernel, dim3(grid), dim3(NT), LDS_BYTES, stream, a);
#else
    for (int ph = 0; ph < NPH; ++ph) {

        a.ph_lo = ph; a.ph_hi = ph + 1;
        hipLaunchKernelGGL(fwd_kernel, dim3(grid), dim3(NT), LDS_BYTES, stream, a);
    }
#endif
}
```

```cpp
#include <hip/hip_runtime.h>
#include <cstdio>
#include <cstdint>

#ifndef MK_SINGLE
#define MK_SINGLE 1
#endif

#ifndef FP8_INPROJ
#define FP8_INPROJ 0
#endif
#ifndef FP8_DENSE1_MASK
#define FP8_DENSE1_MASK 2
#endif
#ifndef FP8_DENSE2
#define FP8_DENSE2 1
#endif
#ifndef USE_FP8
#define USE_FP8 1
#endif
#ifndef FP8_SP2
#define FP8_SP2 true
#endif
#ifndef REP_SSD
#define REP_SSD 1
#endif
#ifndef REP_NA
#define REP_NA 1
#endif
#ifndef REP_GEMM
#define REP_GEMM 1
#endif
#define GAS __attribute__((address_space(1)))
#define LAS __attribute__((address_space(3)))
typedef unsigned short bf16_t;
typedef short bf16x8 __attribute__((ext_vector_type(8)));
typedef float f32x4 __attribute__((ext_vector_type(4)));
typedef float f32x2 __attribute__((ext_vector_type(2)));
typedef unsigned u32x4 __attribute__((ext_vector_type(4)));
typedef unsigned u32x2 __attribute__((ext_vector_type(2)));
typedef int i32x4 __attribute__((ext_vector_type(4)));
typedef int i32x8 __attribute__((ext_vector_type(8)));

constexpr int D = 1024, BATCH = 16, SEQ = 2048, DEPTH = 4, GRID_W = 64, CTX = 256;
constexpr int NLAT = BATCH * SEQ;
constexpr int NCTX = BATCH * CTX;
constexpr int NTOK = NLAT + NCTX;
constexpr int NPROJ = 3072;
constexpr int OFF_K = 512, OFF_V = 1024, OFF_Z = 1536, OFF_XBC = 2048;
constexpr int D_IN_PROJ = 3088;
constexpr int DFF = 2816, DFFE = 3584, NEXP = 8;
constexpr float ALPHA = 1.6817928305074290f;
constexpr float LN_EPS = 1e-5f, RMS_EPS = 1e-5f;
constexpr int MODW = 6 * D;

constexpr size_t MiB = 1u << 20;
constexpr size_t WS_CTL = 0, CTL_BYTES = 1 * MiB;
constexpr size_t WS_MOD = 1 * MiB;
constexpr size_t WS_ROUTE = 3 * MiB;
constexpr size_t WS_GATES = 4 * MiB;
constexpr size_t WS_LIST = 5 * MiB;
constexpr size_t WS_WDT = 7 * MiB;
constexpr size_t WS_WIN = 8 * MiB;
constexpr size_t WS_WOUT = 32 * MiB;
constexpr size_t WS_WFGU = 40 * MiB;
constexpr size_t WS_WFD = 62 * MiB;
constexpr size_t WS_WMGU = 73 * MiB;
constexpr size_t WS_WMD = 185 * MiB;
constexpr size_t WS_X = 241 * MiB;
constexpr size_t WS_H = 385 * MiB;
constexpr size_t WS_R = 457 * MiB;
constexpr size_t WS_PROJ = WS_R;
constexpr size_t WS_DT = WS_R + 216 * MiB;
constexpr size_t WS_YF = WS_R + 219 * MiB;
constexpr size_t WS_YB = WS_R + 291 * MiB;
constexpr size_t WS_MIX = WS_R + 363 * MiB;
constexpr size_t WS_HID = WS_R;
constexpr size_t WS_YP = WS_R + 270 * MiB;
constexpr size_t WS_DELTA1 = WS_R;
constexpr size_t WS_DELTA2 = WS_R + 270 * MiB;
constexpr size_t WS_U = WS_R + 435 * MiB;
constexpr size_t WS_H8IN = WS_U;
constexpr size_t WS_END = WS_R + 507 * MiB;
constexpr int MOE_PAD = 2 * NTOK + 2048;
static_assert(USE_FP8 == 1, "the single-phase MoE needs the e4m3 hidden (the bf16 one does not fit the workspace)");
static_assert(WS_HID + (size_t)MOE_PAD * 3584 <= WS_YP && WS_YP + (size_t)MOE_PAD * 1024 * 2 <= WS_END, "MoE buffers");

constexpr int CW_TMO = 0;
constexpr int CW_BAR = 4096;
constexpr int CW_CNT = 16384;

constexpr int LDS_STAGE = 131072;
constexpr int LDS_ROWOFF = 131072;
constexpr int LDS_MISC = 131072 + 18432;
constexpr int LDS_BYTES = 155648;

constexpr int S8_ACT = 3, S8_WGU = 8, S8_HID = 2, S8_WD = 9;
#ifndef TPROBE
#define TPROBE (-1)
#endif
#if TPROBE >= 100
#define TPS_BEGIN unsigned long long tps_t_ = __builtin_amdgcn_s_memrealtime()
#define TPS(k) do { const unsigned long long t_ = __builtin_amdgcn_s_memrealtime(); if (TPROBE == 100 + (k) && F.tid == 0) ((volatile LAS unsigned*)(F.lds + LDS_MISC))[40] += (unsigned)(t_ - tps_t_); tps_t_ = t_; } while (0)
#else
#define TPS_BEGIN do { } while (0)
#define TPS(k) do { } while (0)
#endif
#define GATE_PRESCALE (-1.4426950408889634f)
__device__ __forceinline__ unsigned f2bf(float f) { unsigned u = __builtin_bit_cast(unsigned, f); return (u + 0x7fffu + ((u >> 16) & 1u)) >> 16; }
typedef __bf16 bf16x2_t __attribute__((ext_vector_type(2)));
__device__ __forceinline__ unsigned pk2(float lo, float hi) { const f32x2 v = {lo, hi}; const bf16x2_t b = __builtin_convertvector(v, bf16x2_t); return __builtin_bit_cast(unsigned, b); }
__device__ __forceinline__ float bf2f(unsigned short b) { return __builtin_bit_cast(float, ((unsigned)b) << 16); }
__device__ __forceinline__ float bflo(unsigned w) { return __builtin_bit_cast(float, w << 16); }
__device__ __forceinline__ float bfhi(unsigned w) { return __builtin_bit_cast(float, w & 0xffff0000u); }
__device__ __forceinline__ float silu_f(float v) { return v / (1.0f + __expf(-v)); }
__device__ __forceinline__ float clamp8(float v) { return fminf(fmaxf(v, -448.0f), 448.0f); }
__device__ __forceinline__ unsigned pk8(float a, float b, float c, float d) {
    int w = 0; w = __builtin_amdgcn_cvt_pk_fp8_f32(clamp8(a), clamp8(b), w, false); w = __builtin_amdgcn_cvt_pk_fp8_f32(clamp8(c), clamp8(d), w, true); return (unsigned)w; }
template <int CTRL, int ROWMASK = 0xF, bool BC = false>
__device__ __forceinline__ float dpp_f(float v) { return __builtin_bit_cast(float, __builtin_amdgcn_update_dpp(0, __builtin_bit_cast(int, v), CTRL, ROWMASK, 0xF, BC)); }
__device__ __forceinline__ float row16_sum(float v) {
    v += dpp_f<0xB1>(v); v += dpp_f<0x4E>(v); v += dpp_f<0x141>(v); v += dpp_f<0x140>(v);
    return v;
}
__device__ __forceinline__ float wave_sum(float v) {
    v = row16_sum(v);
    v += dpp_f<0x142, 0xA>(v); v += dpp_f<0x143, 0xC>(v);
    return __builtin_bit_cast(float, __builtin_amdgcn_readlane(__builtin_bit_cast(int, v), 63));
}
__device__ __forceinline__ float xrow_max(float v) {
    unsigned u = __builtin_bit_cast(unsigned, v); auto r = __builtin_amdgcn_permlane16_swap(u, u, false, false);
    v = fmaxf(__builtin_bit_cast(float, r[0]), __builtin_bit_cast(float, r[1]));
    u = __builtin_bit_cast(unsigned, v); auto r2 = __builtin_amdgcn_permlane32_swap(u, u, false, false);
    return fmaxf(__builtin_bit_cast(float, r2[0]), __builtin_bit_cast(float, r2[1]));
}
__device__ __forceinline__ float xrow_sum(float v) {
    unsigned u = __builtin_bit_cast(unsigned, v); auto r = __builtin_amdgcn_permlane16_swap(u, u, false, false);
    v = __builtin_bit_cast(float, r[0]) + __builtin_bit_cast(float, r[1]);
    u = __builtin_bit_cast(unsigned, v); auto r2 = __builtin_amdgcn_permlane32_swap(u, u, false, false);
    return __builtin_bit_cast(float, r2[0]) + __builtin_bit_cast(float, r2[1]);
}
__device__ __forceinline__ float wave_scan(float v) {
    v += dpp_f<0x111, 0xF, true>(v); v += dpp_f<0x112, 0xF, true>(v); v += dpp_f<0x114, 0xF, true>(v); v += dpp_f<0x118, 0xF, true>(v);
    v += dpp_f<0x142, 0xA>(v); v += dpp_f<0x143, 0xC>(v);
    return v;
}

namespace pg8 {
constexpr int BM = 256, BK = 64, HALF = 128, HTB = HALF * BK * 2, STAGE_BYTES = 8 * HTB, NXCD = 8, WGM = 8;
__host__ __device__ __forceinline__ int lds_byte(int r, int c) { const int st = (r >> 4) * 2 + (c >> 5), rr = r & 15, cc = c & 31, ob = rr * 64 + cc * 2; return st * 1024 + (ob ^ (((ob >> 9) & 1) << 5)); }
__host__ __device__ __forceinline__ void stage_rc(int b, int& R, int& C) { const int st = b / 1024, sb = b % 1024, swz = sb ^ (((sb >> 9) & 1) << 5); R = (st >> 1) * 16 + swz / 64; C = (st & 1) * 32 + (swz % 64) / 2; }
__host__ __device__ __forceinline__ int perm32(int rho) { const int n = rho >> 4, i = rho & 15; return 8 * (i >> 2) + 4 * n + (i & 3); }

struct Unit { int pm, pn; long bofs; };
struct Gemm { const bf16_t* A; const bf16_t* Bt; int K; };

__device__ __forceinline__ unsigned cvt_pk_bf16(float lo, float hi) { return pk2(lo, hi); }
__device__ __forceinline__ unsigned cvt_pk_bf16_pin(float lo, float hi) { unsigned r; asm volatile("v_cvt_pk_bf16_f32 %0, %1, %2" : "=v"(r) : "v"(lo), "v"(hi)); return r; }

__device__ __forceinline__ bool static_tile(int i, int G, int c, int nM, int nN, int& pm, int& pn, int rep = 1) {
    const int nwg = nM * nN;
#if REP_GEMM > 1
    { const int cnt = (nwg - c + G - 1) / G; if (cnt <= 0 || i >= rep * cnt) return false; i %= cnt; }
#endif
    const long L = (long)i * G + c; if (L >= nwg) return false;
    int wgid = (int)L; { const int q = nwg / NXCD, r = nwg % NXCD, xcd = wgid % NXCD, off = wgid / NXCD; wgid = (xcd < r ? xcd * (q + 1) : r * (q + 1) + (xcd - r) * q) + off; }
    const int nig = WGM * nN, gid = wgid / nig, fm = gid * WGM, gsz = (nM - fm) < WGM ? (nM - fm) : WGM;
    pm = fm + ((wgid % nig) % gsz); pn = (wgid % nig) / gsz; return true;
}
struct DenseOrder {
    int nM, nN, G, c, K, rep;
    __device__ __forceinline__ void init(int M, int N, int K_, int G_, int c_, int rep_ = 1) { nM = M / BM; nN = N / BM; G = G_; c = c_; K = K_; rep = rep_; }
    __device__ __forceinline__ bool next(int i, Unit& u) const { if (!static_tile(i, G, c, nM, nN, u.pm, u.pn, rep)) return false; u.bofs = (long)u.pn * BM * K * 2; return true; }
    static constexpr bool GATHER = false;
    __device__ __forceinline__ long a_base(const Unit& u) const { return (long)u.pm * BM * K * 2; }
    __device__ __forceinline__ void a_offs(int, const Unit&, int, unsigned (&)[2][2]) const {}
};
template <bool GATHER_> struct MoeOrder {
    int nM, nN, G, c, K; int ts[9]; long estride; const LAS unsigned short* rowoff; unsigned rowbytes;
    __device__ __forceinline__ int expert_of(int pm) const { int e = 0;
#pragma unroll
        for (int j = 1; j < 8; ++j) e += (pm >= ts[j]) ? 1 : 0; return e; }
    __device__ __forceinline__ bool next(int i, Unit& u) const { if (!static_tile(i, G, c, nM, nN, u.pm, u.pn, REP_GEMM)) return false; u.bofs = (long)expert_of(u.pm) * estride + (long)u.pn * BM * K * 2; return true; }
    static constexpr bool GATHER = GATHER_;
    __device__ __forceinline__ long a_base(const Unit& u) const { return GATHER_ ? 0l : (long)u.pm * BM * K * 2; }
    __device__ __forceinline__ void a_offs(int ui, const Unit&, int tid, unsigned (&o)[2][2]) const {
        int uix = ui;
#if REP_GEMM > 1
        { const int cnt = (nM * nN - c + G - 1) / G; uix = ui % cnt; }
#endif
        if (GATHER_) {
#pragma unroll
            for (int i = 0; i < 2; ++i) { int R, C; stage_rc(tid * 16 + i * 8192, R, C);
#pragma unroll
                for (int h = 0; h < 2; ++h) o[h][i] = (unsigned)rowoff[uix * 256 + h * HALF + R] * rowbytes + (unsigned)(C * 2); }
        }
    }
};

struct EpiBf16 {
    static constexpr bool PERM = true;
    bf16_t* O; int ldc;
    __device__ __forceinline__ void operator()(const f32x4 (&acc)[2][2][4][2], const Unit& u, int wr, int wc, int fr, int fq) const {
        const int row0 = u.pm * BM + wr * 64 + fr; const int col0 = u.pn * BM + wc * 32 + 8 * fq;
#pragma unroll
        for (int ai = 0; ai < 2; ++ai)
#pragma unroll
            for (int m = 0; m < 4; ++m) { bf16_t* rowp = O + (size_t)(row0 + ai * HALF + m * 16) * ldc + col0;
#pragma unroll
                for (int bj = 0; bj < 2; ++bj) { const f32x4 v0 = acc[ai][bj][m][0], v1 = acc[ai][bj][m][1];
                    u32x4 w; w.x = cvt_pk_bf16(v0[0], v0[1]); w.y = cvt_pk_bf16(v0[2], v0[3]); w.z = cvt_pk_bf16(v1[0], v1[1]); w.w = cvt_pk_bf16(v1[2], v1[3]);
                    *(u32x4*)(rowp + bj * HALF) = w; } }
    }
};
struct EpiSwiGLU {
    static constexpr bool PERM = true;
    bf16_t* O; int ldc;
    __device__ __forceinline__ void operator()(const f32x4 (&acc)[2][2][4][2], const Unit& u, int wr, int wc, int fr, int fq) const {
        const int row0 = u.pm * BM + wr * 64 + fr; const int col0 = u.pn * HALF + wc * 32 + 8 * fq;
#pragma unroll
        for (int ai = 0; ai < 2; ++ai)
#pragma unroll
            for (int m = 0; m < 4; ++m) { bf16_t* rowp = O + (size_t)(row0 + ai * HALF + m * 16) * ldc + col0;
                float h[8];
#pragma unroll
                for (int n = 0; n < 2; ++n)
#pragma unroll
                    for (int j = 0; j < 4; ++j) { const float gp = acc[ai][0][m][n][j], up = acc[ai][1][m][n][j];
                        h[n * 4 + j] = (gp * up) * __builtin_amdgcn_rcpf(__builtin_fmaf(__builtin_amdgcn_exp2f(gp), GATE_PRESCALE, GATE_PRESCALE)); }
                u32x4 w; w.x = cvt_pk_bf16(h[0], h[1]); w.y = cvt_pk_bf16(h[2], h[3]); w.z = cvt_pk_bf16(h[4], h[5]); w.w = cvt_pk_bf16(h[6], h[7]);
                *(u32x4*)rowp = w; }
    }
};
struct EpiSwiGLU8 {
    static constexpr bool PERM = true;
    unsigned char* O; int ldc;
    __device__ __forceinline__ void operator()(const f32x4 (&acc)[2][2][4][2], const Unit& u, int wr, int wc, int fr, int fq) const {
        const int row0 = u.pm * BM + wr * 64 + fr; const int col0 = u.pn * HALF + wc * 32 + 8 * fq;
#pragma unroll
        for (int ai = 0; ai < 2; ++ai)
#pragma unroll
            for (int m = 0; m < 4; ++m) { unsigned char* rowp = O + (size_t)(row0 + ai * HALF + m * 16) * ldc + col0;
                float h[8];
#pragma unroll
                for (int n = 0; n < 2; ++n)
#pragma unroll
                    for (int j = 0; j < 4; ++j) { const float gp = acc[ai][0][m][n][j], up = acc[ai][1][m][n][j];
                        constexpr float C8 = GATE_PRESCALE / (float)(1 << S8_HID); h[n * 4 + j] = (gp * up) * __builtin_amdgcn_rcpf(__builtin_fmaf(__builtin_amdgcn_exp2f(gp), C8, C8)); }
                u32x2 w; w.x = pk8(h[0], h[1], h[2], h[3]); w.y = pk8(h[4], h[5], h[6], h[7]);
                *(u32x2*)rowp = w; }
    }
};
struct EpiGate {
    static constexpr bool PERM = true;
    bf16_t* O; const float* mod; int gate_off;
    __device__ __forceinline__ void operator()(const f32x4 (&acc)[2][2][4][2], const Unit& u, int wr, int wc, int fr, int fq) const {
        const int rt = u.pm * BM; const int bi = rt >= NLAT ? 16 : (rt >> 11);
        const int col0 = u.pn * BM + wc * 32 + 8 * fq; const float* gt = mod + bi * MODW + gate_off + col0;
        f32x4 gv[2][2];
#pragma unroll
        for (int bj = 0; bj < 2; ++bj)
#pragma unroll
            for (int n = 0; n < 2; ++n) gv[bj][n] = *(const f32x4*)(gt + bj * HALF + 4 * n) + 1.0f;
        const int row0 = rt + wr * 64 + fr;
#pragma unroll
        for (int ai = 0; ai < 2; ++ai)
#pragma unroll
            for (int m = 0; m < 4; ++m) { bf16_t* rowp = O + (size_t)(row0 + ai * HALF + m * 16) * D + col0;
#pragma unroll
                for (int bj = 0; bj < 2; ++bj) { const f32x4 v0 = acc[ai][bj][m][0] * gv[bj][0], v1 = acc[ai][bj][m][1] * gv[bj][1];
                    u32x4 w; w.x = cvt_pk_bf16(v0[0], v0[1]); w.y = cvt_pk_bf16(v0[2], v0[3]); w.z = cvt_pk_bf16(v1[0], v1[1]); w.w = cvt_pk_bf16(v1[2], v1[3]);
                    *(u32x4*)(rowp + bj * HALF) = w; } }
    }
};

template <class Epi, class Sched, bool ALIGN_EPI, bool SP2, bool FP8 = false>
__device__ __forceinline__ void gemm_phase(LAS unsigned char* lds, const Gemm g, const Sched& S, const Epi& E, int tid_in, int sw = 0x7f7f7f7f, int sa = 0x7f7f7f7f) {
    int tid_ = tid_in; asm volatile("" : "+v"(tid_));
    const int tid = tid_, wid = __builtin_amdgcn_readfirstlane(tid >> 6), lane = tid & 63, wr = wid >> 2, wc = wid & 3, fr = lane & 15, fq = lane >> 4;
    const int K = g.K, nt = K / BK;
    constexpr bool GA = Sched::GATHER;
    unsigned voffA[2], voffB[2];
#pragma unroll
    for (int i = 0; i < 2; ++i) { int R, C; stage_rc(tid * 16 + i * 8192, R, C); const int Rb = Epi::PERM ? ((R & ~31) + perm32(R & 31)) : R;
        voffA[i] = (unsigned)(R * K + C) * 2u; voffB[i] = (unsigned)(Rb * K + C) * 2u; }
    const size_t kstep = (size_t)(BK * 2);
    const size_t hstep = (size_t)HALF * K * 2;
    const unsigned ldsw = (unsigned)wid * 1024u;
    const int aoff = lds_byte(wr * 64 + fr, fq * 8), boff = lds_byte(wc * 32 + fr, fq * 8);
#define PG8_SA(b, h) (((b) * 2 + (h)) * HTB)
#define PG8_SB(b, h) ((4 + (b) * 2 + (h)) * HTB)
#define PG8_STAGE(bufoff, gbase, voff) do { _Pragma("unroll") for (int _i = 0; _i < 2; ++_i) \
        __builtin_amdgcn_global_load_lds((const unsigned*)((const char*)(gbase) + (voff)[_i]), (LAS unsigned*)(lds + (bufoff) + ldsw + _i * 8192), 16, 0, 0); } while (0)
#define PG8_LDA(dst, b, h) do { _Pragma("unroll") for (int m = 0; m < 4; ++m) _Pragma("unroll") for (int k = 0; k < 2; ++k) dst[m][k] = *(const LAS bf16x8*)(lds + PG8_SA(b, h) + aoff + m * 2048 + k * 1024); } while (0)
#define PG8_LDB(dst, b, h) do { _Pragma("unroll") for (int n = 0; n < 2; ++n) _Pragma("unroll") for (int k = 0; k < 2; ++k) dst[n][k] = *(const LAS bf16x8*)(lds + PG8_SB(b, h) + boff + n * 2048 + k * 1024); } while (0)
#define PG8_CAT(x) __builtin_shufflevector(__builtin_bit_cast(i32x4, (x)[0]), __builtin_bit_cast(i32x4, (x)[1]), 0, 1, 2, 3, 4, 5, 6, 7)
#define PG8_MMA(ai, bj, At, Bt) do { __builtin_amdgcn_s_setprio(1); _Pragma("unroll") for (int m = 0; m < 4; ++m) _Pragma("unroll") for (int n = 0; n < 2; ++n) { \
        if constexpr (FP8) { const i32x8 a8_ = PG8_CAT(Bt[n]), b8_ = PG8_CAT(At[m]); \
            asm volatile("v_mfma_scale_f32_16x16x128_f8f6f4 %0, %1, %2, %0, %3, %4 op_sel_hi:[0,0,0]" : "+v"(acc[ai][bj][m][n]) : "v"(a8_), "v"(b8_), "v"(sw), "v"(sa)); } \
        else { _Pragma("unroll") for (int k = 0; k < 2; ++k) acc[ai][bj][m][n] = __builtin_amdgcn_mfma_f32_16x16x32_bf16(Bt[n][k], At[m][k], acc[ai][bj][m][n], 0, 0, 0); } } \
        __builtin_amdgcn_s_setprio(0); } while (0)
#define PG8_WAIT_V(n) asm volatile("s_waitcnt vmcnt(" #n ")" ::: "memory")
#define PG8_WAIT_L(n) asm volatile("s_waitcnt lgkmcnt(" #n ")" ::: "memory")
#define PG8_BAR __builtin_amdgcn_s_barrier()
#define PG8_SCHED __builtin_amdgcn_sched_barrier(0)
    Unit cur, nxt; int ui = 0;
    if (!S.next(0, cur)) return;
    f32x4 acc[2][2][4][2];
#pragma unroll
    for (int a = 0; a < 2; ++a)
#pragma unroll
        for (int b = 0; b < 2; ++b)
#pragma unroll
            for (int m = 0; m < 4; ++m)
#pragma unroll
                for (int n = 0; n < 2; ++n) acc[a][b][m][n] = (f32x4){0.f, 0.f, 0.f, 0.f};
    bf16x8 At[4][2], B0[2][2], B1[2][2];
    const char* Ab = (const char*)g.A + S.a_base(cur);
    unsigned oc[2][2];
    S.a_offs(0, cur, tid, oc);
    const size_t hsA = GA ? (size_t)0 : hstep;
#define PG8_STAGE_A(bufoff, gbase, h) do { if constexpr (GA) PG8_STAGE(bufoff, gbase, oc[h]); else PG8_STAGE(bufoff, (gbase) + (h) * hsA, voffA); } while (0)
    const char* cB = (const char*)g.Bt + cur.bofs;
    if constexpr (SP2) {
        PG8_STAGE(PG8_SB(0, 0), cB, voffB); PG8_STAGE(PG8_SB(0, 1), cB + hstep, voffB); PG8_STAGE_A(PG8_SA(0, 0), Ab, 0); PG8_STAGE_A(PG8_SA(0, 1), Ab, 1);
        if (wr == 1) PG8_BAR;
        PG8_WAIT_V(2); PG8_BAR;
        PG8_STAGE(PG8_SB(1, 0), cB + kstep, voffB); PG8_STAGE_A(PG8_SA(1, 0), Ab + kstep, 0); PG8_STAGE(PG8_SB(1, 1), cB + hstep + kstep, voffB);
        PG8_WAIT_V(6); PG8_BAR;
    } else {
        PG8_STAGE(PG8_SB(0, 0), cB, voffB); PG8_STAGE_A(PG8_SA(0, 0), Ab, 0); PG8_STAGE(PG8_SB(0, 1), cB + hstep, voffB); PG8_STAGE_A(PG8_SA(0, 1), Ab, 1);
        if (wr == 1) PG8_BAR;
        PG8_WAIT_V(4); PG8_BAR;
        PG8_STAGE(PG8_SB(1, 0), cB + kstep, voffB); PG8_STAGE_A(PG8_SA(1, 0), Ab + kstep, 0); PG8_STAGE(PG8_SB(1, 1), cB + hstep + kstep, voffB);
        PG8_WAIT_V(6); PG8_BAR;
    }
    for (;;) {
        const bool has_next = S.next(ui + 1, nxt);
        const char* nB = has_next ? (const char*)g.Bt + nxt.bofs : cB;
        for (int t = 0; t < nt; t += 2) {
            const bool last = (t == nt - 2);
            const char* a1 = Ab + (size_t)(t + 1) * kstep;
            const char* b2 = last ? nB : cB + (size_t)(t + 2) * kstep; const char* b3 = b2 + kstep;
            if constexpr (SP2) {
            PG8_LDB(B0, 0, 0); PG8_LDB(B1, 0, 1); PG8_SCHED; PG8_LDA(At, 0, 0); PG8_STAGE_A(PG8_SA(1, 1), a1, 1);
            if (last && has_next) { S.a_offs(ui + 1, nxt, tid, oc); Ab = (const char*)g.A + S.a_base(nxt); }
            const char* a2 = last ? Ab : Ab + (size_t)(t + 2) * kstep; const char* a3 = a2 + kstep;
            PG8_WAIT_V(8); PG8_WAIT_L(0); PG8_BAR; PG8_MMA(0, 0, At, B0); PG8_MMA(0, 1, At, B1); PG8_BAR; PG8_SCHED;
            PG8_LDA(At, 0, 1); PG8_STAGE(PG8_SB(0, 0), b2, voffB); PG8_STAGE(PG8_SB(0, 1), b2 + hstep, voffB); PG8_STAGE_A(PG8_SA(0, 0), a2, 0);
            PG8_WAIT_V(8); PG8_WAIT_L(0); PG8_BAR; PG8_MMA(1, 0, At, B0); PG8_MMA(1, 1, At, B1); PG8_BAR; PG8_SCHED;
            PG8_LDB(B0, 1, 0); PG8_LDB(B1, 1, 1); PG8_SCHED; PG8_LDA(At, 1, 0); PG8_STAGE_A(PG8_SA(0, 1), a2, 1);
            PG8_WAIT_V(8); PG8_WAIT_L(0); PG8_BAR; PG8_MMA(0, 0, At, B0); PG8_MMA(0, 1, At, B1); PG8_BAR; PG8_SCHED;
            PG8_LDA(At, 1, 1); PG8_STAGE(PG8_SB(1, 0), b3, voffB); PG8_STAGE(PG8_SB(1, 1), b3 + hstep, voffB); PG8_STAGE_A(PG8_SA(1, 0), a3, 0);
            PG8_WAIT_V(8); PG8_WAIT_L(0); PG8_BAR; PG8_MMA(1, 0, At, B0); PG8_MMA(1, 1, At, B1); PG8_BAR; PG8_SCHED;
            } else {
            PG8_LDB(B0, 0, 0); PG8_SCHED; PG8_LDA(At, 0, 0); PG8_STAGE_A(PG8_SA(1, 1), a1, 1);
            if (last && has_next) { S.a_offs(ui + 1, nxt, tid, oc); Ab = (const char*)g.A + S.a_base(nxt); }
            const char* a2 = last ? Ab : Ab + (size_t)(t + 2) * kstep; const char* a3 = a2 + kstep;
            PG8_WAIT_L(8); PG8_BAR; PG8_WAIT_L(0); PG8_MMA(0, 0, At, B0); PG8_BAR; PG8_SCHED;
            PG8_LDB(B1, 0, 1); PG8_STAGE(PG8_SB(0, 0), b2, voffB);
            PG8_BAR; PG8_WAIT_L(0); PG8_MMA(0, 1, At, B1); PG8_BAR;
            PG8_LDA(At, 0, 1); PG8_STAGE_A(PG8_SA(0, 0), a2, 0);
            PG8_BAR; PG8_WAIT_L(0); PG8_MMA(1, 0, At, B0); PG8_BAR; PG8_SCHED;
            PG8_STAGE(PG8_SB(0, 1), b2 + hstep, voffB);
            PG8_WAIT_V(6); PG8_BAR; PG8_MMA(1, 1, At, B1); PG8_BAR;
            PG8_LDB(B0, 1, 0); PG8_SCHED; PG8_LDA(At, 1, 0); PG8_STAGE_A(PG8_SA(0, 1), a2, 1);
            PG8_WAIT_L(8); PG8_BAR; PG8_WAIT_L(0); PG8_MMA(0, 0, At, B0); PG8_BAR; PG8_SCHED;
            PG8_LDB(B1, 1, 1); PG8_STAGE(PG8_SB(1, 0), b3, voffB);
            PG8_BAR; PG8_WAIT_L(0); PG8_MMA(0, 1, At, B1); PG8_BAR;
            PG8_LDA(At, 1, 1); PG8_STAGE_A(PG8_SA(1, 0), a3, 0);
            PG8_BAR; PG8_WAIT_L(0); PG8_MMA(1, 0, At, B0); PG8_BAR; PG8_SCHED;
            PG8_STAGE(PG8_SB(1, 1), b3 + hstep, voffB);
            PG8_WAIT_V(6); PG8_BAR; PG8_MMA(1, 1, At, B1); PG8_BAR;
            }
        }
        if constexpr (ALIGN_EPI) { if (wr == 0) PG8_BAR; }
        if constexpr (FP8) asm volatile("s_nop 15\n\ts_nop 15\n\ts_nop 15" ::: "memory");
        E(acc, cur, wr, wc, fr, fq);
        if (!has_next) break;
#pragma unroll
        for (int a = 0; a < 2; ++a)
#pragma unroll
            for (int b = 0; b < 2; ++b)
#pragma unroll
                for (int m = 0; m < 4; ++m)
#pragma unroll
                    for (int n = 0; n < 2; ++n) acc[a][b][m][n] = (f32x4){0.f, 0.f, 0.f, 0.f};
        cur = nxt; cB = nB; ++ui;
        if constexpr (ALIGN_EPI) { if (wr == 1) PG8_BAR; }
    }
    PG8_WAIT_V(0);
    if constexpr (!ALIGN_EPI) { if (wr == 0) PG8_BAR; }
    PG8_BAR;
#undef PG8_SA
#undef PG8_SB
#undef PG8_STAGE
#undef PG8_STAGE_A
#undef PG8_LDA
#undef PG8_LDB
#undef PG8_MMA
#undef PG8_CAT
#undef PG8_WAIT_V
#undef PG8_WAIT_L
#undef PG8_BAR
#undef PG8_SCHED
}
}

#define XB_TMO      128
#define XB_XCNT(j)  (256  + 64 * (j))
#define XB_XSUB(j)  (1280 + 64 * (j))
#define XB_XGEN(j)  (2304 + 64 * (j))
#define XB_TOP      3328
#define XB_TOPGEN   3392
#define XCD_BAR_WORDS 3456
#define XB_SPIN_CAP (1u << 18)
__device__ __forceinline__ unsigned xb_ld(unsigned* p)              { return __hip_atomic_load(p, __ATOMIC_RELAXED, __HIP_MEMORY_SCOPE_AGENT); }
__device__ __forceinline__ unsigned xb_add(unsigned* p, unsigned v) { return __hip_atomic_fetch_add(p, v, __ATOMIC_RELAXED, __HIP_MEMORY_SCOPE_AGENT); }
__device__ __forceinline__ unsigned xb_xcc_id() { return (unsigned)__builtin_amdgcn_s_getreg((3 << 11) | 20) & 0xFu; }
#define XB_SPIN(cond, bar) do { unsigned _sp = 0; while (cond) { __builtin_amdgcn_s_sleep(1); \
    if ((++_sp & 255u) == 0u) { if (xb_ld(&(bar)[XB_TMO])) break; if (_sp > XB_SPIN_CAP) { atomicAdd(&(bar)[XB_TMO], 1u); break; } } } } while (0)
struct XcdBarrier { unsigned* bar; unsigned x; volatile LAS unsigned* st; };
__device__ __forceinline__ XcdBarrier xcd_barrier_post(unsigned* bar, volatile LAS unsigned* st) {
    XcdBarrier b; b.bar = bar; b.x = xb_xcc_id(); b.st = st;
    if (threadIdx.x == 0) (void)xb_add(&bar[XB_XCNT(b.x)], 1u);
    return b;
}
__device__ __forceinline__ void xcd_barrier_complete(unsigned* bar, unsigned x, unsigned& nloc, unsigned& nx) {
    const unsigned G = gridDim.x * gridDim.y * gridDim.z;
    unsigned sum, cnt, mine, sp = 0u;
    for (;;) {
        sum = 0u; cnt = 0u; mine = 0u;
#pragma unroll
        for (unsigned j = 0; j < 16; ++j) { const unsigned c = xb_ld(&bar[XB_XCNT(j)]); sum += c; cnt += (c > 0u) ? 1u : 0u; }
        mine = xb_ld(&bar[XB_XCNT(x)]);
        if (sum == G) break;
        __builtin_amdgcn_s_sleep(1);
        if ((++sp & 255u) == 0u) { if (xb_ld(&bar[XB_TMO])) break; if (sp > XB_SPIN_CAP) { atomicAdd(&bar[XB_TMO], 1u); break; } }
    }
    nloc = mine > 0u ? mine : 1u; nx = cnt > 0u ? cnt : 1u;
}
__device__ __forceinline__ void xcd_barrier(const XcdBarrier& b, bool leader) {
    asm volatile("s_waitcnt vmcnt(0)" ::: "memory");
    __syncthreads();
    if (leader) {
        unsigned* bar = b.bar;
        __builtin_amdgcn_s_waitcnt(0);
        unsigned nloc = b.st[0], nx = b.st[1];
        if (nloc == 0u) { xcd_barrier_complete(bar, b.x, nloc, nx); b.st[0] = nloc; b.st[1] = nx; }
        const unsigned old = xb_add(&bar[XB_XSUB(b.x)], 1u);
        const unsigned gen = old / nloc;
        if (old + 1u == (gen + 1u) * nloc) {
            __builtin_amdgcn_fence(__ATOMIC_RELEASE, "agent");
            asm volatile("s_waitcnt vmcnt(0)" ::: "memory");
            const unsigned og = xb_add(&bar[XB_TOP], 1u);
            const unsigned tg = og / nx;
            if (og + 1u == (tg + 1u) * nx) xb_add(&bar[XB_TOPGEN], 1u);
            else XB_SPIN(xb_ld(&bar[XB_TOPGEN]) == tg, bar);
            __builtin_amdgcn_fence(__ATOMIC_ACQUIRE, "agent");
            xb_add(&bar[XB_XGEN(b.x)], 1u);
            asm volatile("s_waitcnt vmcnt(0)" ::: "memory");
        } else {
            XB_SPIN(xb_ld(&bar[XB_XGEN(b.x)]) == gen, bar);
            __builtin_amdgcn_fence(__ATOMIC_ACQUIRE, "agent");
            asm volatile("s_waitcnt vmcnt(0)" ::: "memory");
        }
    }
    __syncthreads();
}

constexpr int NT = 512, NWAVES = 8;
struct Args { const float* in[24]; float* out; unsigned char* ws; int ph_lo, ph_hi; };
enum { I_X = 0, I_C, I_CTX, I_CCTX, I_WMOD, I_BMOD, I_WIN, I_WOUT, I_RPB, I_CONVW, I_CONVB, I_DTB, I_ALOG, I_DSKIP, I_NORMW, I_LNG, I_LNB, I_FG, I_FU, I_FD, I_RW, I_MG, I_MU, I_MD };
struct Frame {
    LAS unsigned char* lds;
    const float* const* in; float* out; unsigned char* ws;
    int tid, lane, wave, bid, G, gw, NGW;
};
#define LDS_WAIT() asm volatile("s_waitcnt lgkmcnt(0)" ::: "memory")
__device__ __forceinline__ Frame fresh(const Frame& F0) {
    Frame F = F0; int z; asm volatile("s_mov_b32 %0, 0" : "=s"(z)); F.ws = F0.ws + z; F.in = F0.in + z; F.out = F0.out + z;
    int ln; asm volatile("v_mbcnt_lo_u32_b32 %0, -1, 0\n\tv_mbcnt_hi_u32_b32 %0, -1, %0" : "=v"(ln));     int t = F0.wave * 64 + ln;
    F.tid = t; F.lane = t & 63; return F;
}

constexpr int CONV_SCR = 17408, CONV_SCR2 = 64 * 33;
__device__ __forceinline__ void conv_load(const float* W, int ldn, int k0, int n0, int lane, f32x4 (&ld)[8]) {
#pragma unroll
    for (int i = 0; i < 8; ++i) ld[i] = *(const f32x4*)(W + (size_t)(k0 + 8 * i + (lane >> 3)) * ldn + n0 + 4 * (lane & 7));
}
__device__ __forceinline__ void conv_fin(const f32x4 (&ld)[8], int k0, bf16_t* dst, int K, int drow0, float scale, LAS float* scr, int lane) {
#pragma unroll
    for (int i = 0; i < 8; ++i) { LAS float* d = scr + (8 * i + (lane >> 3)) * 33 + 4 * (lane & 7); d[0] = ld[i][0] * scale; d[1] = ld[i][1] * scale; d[2] = ld[i][2] * scale; d[3] = ld[i][3] * scale; }
    LDS_WAIT(); asm volatile("" ::: "memory");
    const int c = lane & 7;
#pragma unroll
    for (int j = 0; j < 4; ++j) { const int n = (lane >> 3) + 8 * j; const LAS float* s = scr + (8 * c) * 33 + n;
        u32x4 o; o.x = pk2(s[0 * 33], s[1 * 33]); o.y = pk2(s[2 * 33], s[3 * 33]); o.z = pk2(s[4 * 33], s[5 * 33]); o.w = pk2(s[6 * 33], s[7 * 33]);
        *(u32x4*)(dst + (size_t)(drow0 + n) * K + k0 + 8 * c) = o; }
    LDS_WAIT(); asm volatile("" ::: "memory");
}
__device__ __forceinline__ void conv_fin8(const f32x4 (&ld)[8], int k0, unsigned char* dst, int K, int drow0, float scale, LAS float* scr, int lane) {
#pragma unroll
    for (int i = 0; i < 8; ++i) { LAS float* d = scr + (8 * i + (lane >> 3)) * 33 + 4 * (lane & 7); d[0] = ld[i][0] * scale; d[1] = ld[i][1] * scale; d[2] = ld[i][2] * scale; d[3] = ld[i][3] * scale; }
    LDS_WAIT(); asm volatile("" ::: "memory");
    const int c = lane & 7;
#pragma unroll
    for (int j = 0; j < 4; ++j) { const int n = (lane >> 3) + 8 * j; const LAS float* sp = scr + (8 * c) * 33 + n;
        u32x2 o; o.x = pk8(sp[0 * 33], sp[1 * 33], sp[2 * 33], sp[3 * 33]); o.y = pk8(sp[4 * 33], sp[5 * 33], sp[6 * 33], sp[7 * 33]);
        *(u32x2*)(dst + (size_t)(drow0 + n) * K + k0 + 8 * c) = o; }
    LDS_WAIT(); asm volatile("" ::: "memory");
}
__device__ __forceinline__ void conv_seg(const Frame& F, const float* W, int K, int ldn, int ncols, bf16_t* dst, int mode, int& rot, int s8 = -1) {
    LAS float* scr = (LAS float*)(F.lds + F.wave * CONV_SCR);
    const int nblk = ncols / 32, nitems = (K / 64) * nblk;
    int start = F.gw - rot; if (start < 0) start += F.NGW;
    const float gs = ((mode == 1) ? GATE_PRESCALE : 1.0f) * (s8 >= 0 ? (float)(1 << (s8 >= 0 ? s8 : 0)) : 1.0f);
    for (int it = start; it < nitems; it += 2 * F.NGW) {
        const int it2 = it + F.NGW; const bool two = it2 < nitems;
        const int kbA = it / nblk, n0A = (it % nblk) * 32, kbB = two ? it2 / nblk : kbA, n0B = two ? (it2 % nblk) * 32 : n0A;
        f32x4 la[8], lb[8];
        conv_load(W, ldn, kbA * 64, n0A, F.lane, la); if (two) conv_load(W, ldn, kbB * 64, n0B, F.lane, lb);
        const int drA = (mode == 0) ? n0A : ((n0A >> 7) * 256 + (n0A & 127) + (mode == 2 ? 128 : 0)), drB = (mode == 0) ? n0B : ((n0B >> 7) * 256 + (n0B & 127) + (mode == 2 ? 128 : 0));
        if (s8 >= 0) { conv_fin8(la, kbA * 64, (unsigned char*)dst, K, drA, gs, scr, F.lane); if (two) conv_fin8(lb, kbB * 64, (unsigned char*)dst, K, drB, gs, scr + CONV_SCR2, F.lane); }
        else { conv_fin(la, kbA * 64, dst, K, drA, gs, scr, F.lane); if (two) conv_fin(lb, kbB * 64, dst, K, drB, gs, scr + CONV_SCR2, F.lane); }
    }
    rot = (rot + nitems) % F.NGW;
}
__device__ __forceinline__ void conv_moe(const Frame& F, int slot, int& rot) {
#if USE_FP8
    unsigned char* gu = F.ws + WS_WMGU + (size_t)slot * NEXP * 2 * DFFE * D; unsigned char* dn = F.ws + WS_WMD + (size_t)slot * NEXP * D * DFFE;
    for (int e = 0; e < NEXP; ++e) {
        const size_t so = ((size_t)slot * NEXP + e) * (size_t)D * DFFE;
        conv_seg(F, F.in[I_MG] + so, D, DFFE, DFFE, (bf16_t*)(gu + (size_t)e * 2 * DFFE * D), 1, rot, S8_WGU);
        conv_seg(F, F.in[I_MU] + so, D, DFFE, DFFE, (bf16_t*)(gu + (size_t)e * 2 * DFFE * D), 2, rot, S8_WGU);
        conv_seg(F, F.in[I_MD] + so, DFFE, D, D, (bf16_t*)(dn + (size_t)e * D * DFFE), 0, rot, S8_WD);
    }
#else
    bf16_t* gu = (bf16_t*)(F.ws + WS_WMGU); bf16_t* dn = (bf16_t*)(F.ws + WS_WMD);
    for (int e = 0; e < NEXP; ++e) {
        const size_t so = ((size_t)slot * NEXP + e) * (size_t)D * DFFE;
        conv_seg(F, F.in[I_MG] + so, D, DFFE, DFFE, gu + (size_t)e * 2 * DFFE * D, 1, rot);
        conv_seg(F, F.in[I_MU] + so, D, DFFE, DFFE, gu + (size_t)e * 2 * DFFE * D, 2, rot);
        conv_seg(F, F.in[I_MD] + so, DFFE, D, D, dn + (size_t)e * D * DFFE, 0, rot);
    }
#endif
}

constexpr int MOE_ITEMS_MAT = 1792, MOE_ITEMS_EXP = 3 * MOE_ITEMS_MAT, MOE_ITEMS_SLOT = 8 * MOE_ITEMS_EXP, MOE_ITEMS = 2 * MOE_ITEMS_SLOT;
struct MoeItem { const float* W; int ldn, k0, n0; unsigned char* dst; int K, drow0; float scale; };
__device__ __forceinline__ MoeItem moe_item(const Frame& F, int gidx) {
    const int slot = gidx / MOE_ITEMS_SLOT, r = gidx % MOE_ITEMS_SLOT, e = r / MOE_ITEMS_EXP, r2 = r % MOE_ITEMS_EXP, mat = r2 / MOE_ITEMS_MAT, it = r2 % MOE_ITEMS_MAT;
    const size_t so = ((size_t)slot * NEXP + e) * (size_t)D * DFFE; MoeItem m;
    if (mat < 2) { const int kb = it / 112, nb = it % 112, n0 = nb * 32;
        m.W = (mat ? F.in[I_MU] : F.in[I_MG]) + so; m.ldn = DFFE; m.k0 = kb * 64; m.n0 = n0; m.dst = F.ws + WS_WMGU + ((size_t)slot * NEXP + e) * 2 * DFFE * D; m.K = D;
        m.drow0 = (n0 >> 7) * 256 + (n0 & 127) + (mat == 1 ? 128 : 0); m.scale = (float)(1 << S8_WGU) * (mat ? 1.0f : GATE_PRESCALE); }
    else { const int kb = it / 32, nb = it % 32, n0 = nb * 32;
        m.W = F.in[I_MD] + so; m.ldn = D; m.k0 = kb * 64; m.n0 = n0; m.dst = F.ws + WS_WMD + ((size_t)slot * NEXP + e) * D * DFFE; m.K = DFFE; m.drow0 = n0; m.scale = (float)(1 << S8_WD); }
    return m;
}
__device__ __forceinline__ void conv_moe_pair(const Frame& F, int g0, int g1) {
    LAS float* scr = (LAS float*)(F.lds + F.wave * CONV_SCR);
    const bool two = g1 >= 0 && g1 < MOE_ITEMS;
    const MoeItem A = moe_item(F, g0), B = moe_item(F, two ? g1 : g0);
    f32x4 la[8], lb[8];
    conv_load(A.W, A.ldn, A.k0, A.n0, F.lane, la); if (two) conv_load(B.W, B.ldn, B.k0, B.n0, F.lane, lb);
    conv_fin8(la, A.k0, A.dst, A.K, A.drow0, A.scale, scr, F.lane);
    if (two) conv_fin8(lb, B.k0, B.dst, B.K, B.drow0, B.scale, scr + CONV_SCR2, F.lane);
}
__device__ __forceinline__ void deferred_conv(const Frame& F, int nwg, int base, int quota) {
    if (F.G != 256) return;
    const int maxu = (nwg + F.G - 1) / F.G, c0 = nwg - (maxu - 1) * F.G;
    if (c0 >= F.G || F.bid < c0) return;
    const int first = base + ((F.bid - c0) * NWAVES + F.wave) * quota;
    for (int j = 0; j < quota; j += 2) { const int gidx = first + j; if (gidx < MOE_ITEMS) conv_moe_pair(F, gidx, j + 1 < quota ? gidx + 1 : -1); }
}
constexpr int DQ_OUT = 7, DQ_F1 = 8, DQ_F2 = 10, DW_PRO = 12800;
constexpr int DW_L0_OUT = DW_PRO, DW_L0_F1 = DW_L0_OUT + 192 * 8 * DQ_OUT, DW_L0_F2 = DW_L0_F1 + 160 * 8 * DQ_F1, DW_L1_OUT = DW_L0_F2 + 192 * 8 * DQ_F2, DW_L2_OUT = DW_L1_OUT + 192 * 8 * DQ_OUT,
              DW_L2_F2 = DW_L2_OUT + 192 * 8 * DQ_OUT, DW_END = DW_L2_F2 + 192 * 8 * DQ_F2;
static_assert(DW_L1_OUT >= MOE_ITEMS_SLOT && DW_END >= MOE_ITEMS, "deferred conversion: layer-1 experts must be done before layer 1's FFN, all before layer 3's");
__device__ __forceinline__ void p_pro_a(const Frame& F) {
    {
        LAS float* sc = (LAS float*)F.lds; LAS float* red = sc + 17 * 1024;
        const float* c = F.in[I_C]; const float* cc = F.in[I_CCTX];
        { float cv[34];
#pragma unroll
          for (int j = 0; j < 34; ++j) { const int i = F.tid + j * NT, r = i >> 10, k = i & 1023; cv[j] = (r < 16) ? c[r * 1024 + k] : cc[k]; }
#pragma unroll
          for (int j = 0; j < 34; ++j) sc[F.tid + j * NT] = silu_f(cv[j]); }
        __syncthreads();
        float* MOD = (float*)(F.ws + WS_MOD);
        const int col = F.tid & 31, ks = F.tid >> 5;
        for (int u = F.bid; u < 4 * 192; u += F.G) {
            const int l = u / 192, cb = u % 192;
            const float* W = F.in[I_WMOD] + (size_t)l * D * MODW + cb * 32 + col;
            float acc[17];
#pragma unroll
            for (int r = 0; r < 17; ++r) acc[r] = 0.f;
#pragma unroll 1
            for (int kb = 0; kb < 4; ++kb) { float w[16];
#pragma unroll
                for (int i = 0; i < 16; ++i) w[i] = W[(size_t)(ks * 64 + kb * 16 + i) * MODW];
#pragma unroll
                for (int i = 0; i < 16; ++i) { const int k = ks * 64 + kb * 16 + i;
#pragma unroll
                    for (int r = 0; r < 17; ++r) acc[r] += sc[r * 1024 + k] * w[i]; } }
#pragma unroll
            for (int r = 0; r < 17; ++r) red[(ks * 17 + r) * 32 + col] = acc[r];
            __syncthreads();
            for (int i = F.tid; i < 17 * 32; i += NT) { const int r = i >> 5, c2 = i & 31; float sm = 0.f;
#pragma unroll
                for (int k2 = 0; k2 < 16; ++k2) sm += red[(k2 * 17 + r) * 32 + c2];
                MOD[(size_t)(l * 17 + r) * MODW + cb * 32 + c2] = sm + F.in[I_BMOD][l * MODW + cb * 32 + c2]; }
            __syncthreads();
        }
    }
    int rot = 0;
    for (int l = 0; l < DEPTH; ++l) {
#if USE_FP8 && FP8_INPROJ
        conv_seg(F, F.in[I_WIN] + (size_t)l * D * D_IN_PROJ, D, D_IN_PROJ, NPROJ, (bf16_t*)(F.ws + WS_WIN + (size_t)l * NPROJ * D), 0, rot, S8_WGU);
#else
        conv_seg(F, F.in[I_WIN] + (size_t)l * D * D_IN_PROJ, D, D_IN_PROJ, NPROJ, (bf16_t*)(F.ws + WS_WIN) + (size_t)l * NPROJ * D, 0, rot);
#endif
        conv_seg(F, F.in[I_WOUT] + (size_t)l * D * D, D, D, D, (bf16_t*)(F.ws + WS_WOUT) + (size_t)l * D * D, 0, rot);
    }
    for (int s = 0; s < 2; ++s) {
        if ((FP8_DENSE1_MASK >> s) & 1) {
            conv_seg(F, F.in[I_FG] + (size_t)s * D * DFF, D, DFF, DFF, (bf16_t*)(F.ws + WS_WFGU + (size_t)s * 2 * DFF * D * 2), 1, rot, S8_WGU);
            conv_seg(F, F.in[I_FU] + (size_t)s * D * DFF, D, DFF, DFF, (bf16_t*)(F.ws + WS_WFGU + (size_t)s * 2 * DFF * D * 2), 2, rot, S8_WGU);
        } else {
            conv_seg(F, F.in[I_FG] + (size_t)s * D * DFF, D, DFF, DFF, (bf16_t*)(F.ws + WS_WFGU) + (size_t)s * 2 * DFF * D, 1, rot);
            conv_seg(F, F.in[I_FU] + (size_t)s * D * DFF, D, DFF, DFF, (bf16_t*)(F.ws + WS_WFGU) + (size_t)s * 2 * DFF * D, 2, rot);
        }
#if USE_FP8 && FP8_DENSE2
        conv_seg(F, F.in[I_FD] + (size_t)s * DFF * D, DFF, D, D, (bf16_t*)(F.ws + WS_WFD + (size_t)s * D * DFF), 0, rot, S8_WD);
#else
        conv_seg(F, F.in[I_FD] + (size_t)s * DFF * D, DFF, D, D, (bf16_t*)(F.ws + WS_WFD) + (size_t)s * D * DFF, 0, rot);
#endif
    }
    if (F.G != 256) { conv_moe(F, 0, rot); conv_moe(F, 1, rot); }
    else for (int gidx = F.gw; gidx < DW_PRO; gidx += 2 * F.NGW) conv_moe_pair(F, gidx, gidx + F.NGW < DW_PRO ? gidx + F.NGW : -1);
    { bf16_t* wdt = (bf16_t*)(F.ws + WS_WDT);
      for (int i = F.bid * 16 + (F.tid & 15) + (F.tid >> 4) * 16 * F.G; i < DEPTH * D; i += 32 * 16 * F.G) { const int l = i / D, k = i % D;
          const float* src = F.in[I_WIN] + ((size_t)l * D + k) * D_IN_PROJ + NPROJ; f32x4 v[4];
#pragma unroll
          for (int q = 0; q < 4; ++q) v[q] = *(const f32x4*)(src + 4 * q);
#pragma unroll
          for (int n = 0; n < 16; ++n) wdt[((size_t)l * 16 + n) * D + k] = (bf16_t)f2bf(v[n >> 2][n & 3]); } }
}

#define RIDX(q) (8 * lane + 512 * ((q) >> 1) + 4 * ((q) & 1))
__device__ __forceinline__ void row_load(const float* p, int lane, f32x4 (&v)[4]) {
#pragma unroll
    for (int q = 0; q < 4; ++q) v[q] = *(const f32x4*)(p + RIDX(q));
}
__device__ __forceinline__ void row_store(float* p, int lane, const f32x4 (&v)[4]) {
#pragma unroll
    for (int q = 0; q < 4; ++q) *(f32x4*)(p + RIDX(q)) = v[q];
}
__device__ __forceinline__ void row_mod_store8(unsigned char* hrow, int lane, const f32x4 (&v)[4], const float* sh, const float* sc, f32x4 (&hv)[4]) {
#pragma unroll
    for (int j = 0; j < 2; ++j) { u32x2 w;
#pragma unroll
        for (int h = 0; h < 2; ++h) { const int q = 2 * j + h; const f32x4 a = *(const f32x4*)(sc + RIDX(q)), b = *(const f32x4*)(sh + RIDX(q));
            hv[q] = v[q] * (a + 1.0f) + b; const f32x4 t = hv[q] * (float)(1 << S8_ACT); const unsigned pw = pk8(t[0], t[1], t[2], t[3]); if (h == 0) w.x = pw; else w.y = pw; }
        *(u32x2*)(hrow + 8 * lane + 512 * j) = w; }
}
__device__ __forceinline__ void row_load_h(const bf16_t* p, int lane, f32x4 (&v)[4]) {
#pragma unroll
    for (int j = 0; j < 2; ++j) { const u32x4 w = *(const u32x4*)(p + 8 * lane + 512 * j); v[2 * j] = (f32x4){bflo(w.x), bfhi(w.x), bflo(w.y), bfhi(w.y)}; v[2 * j + 1] = (f32x4){bflo(w.z), bfhi(w.z), bflo(w.w), bfhi(w.w)}; }
}
__device__ __forceinline__ void row_store_h(bf16_t* p, int lane, const f32x4 (&v)[4]) {
#pragma unroll
    for (int j = 0; j < 2; ++j) { u32x4 w; w.x = pk2(v[2 * j][0], v[2 * j][1]); w.y = pk2(v[2 * j][2], v[2 * j][3]); w.z = pk2(v[2 * j + 1][0], v[2 * j + 1][1]); w.w = pk2(v[2 * j + 1][2], v[2 * j + 1][3]);
        *(u32x4*)(p + 8 * lane + 512 * j) = w; }
}
__device__ __forceinline__ void row_mod_store(bf16_t* hrow, int lane, const f32x4 (&v)[4], const float* sh, const float* sc, f32x4 (&hv)[4]) {
#pragma unroll
    for (int q = 0; q < 4; ++q) { const f32x4 a = *(const f32x4*)(sc + RIDX(q)), b = *(const f32x4*)(sh + RIDX(q)); hv[q] = v[q] * (a + 1.0f) + b; }
    row_store_h(hrow, lane, hv);
}
__device__ __forceinline__ void row_ln(f32x4 (&v)[4], const float* g, const float* b, int lane) {
    float s = 0.f;
#pragma unroll
    for (int j = 0; j < 4; ++j) s += (v[j][0] + v[j][1]) + (v[j][2] + v[j][3]);
    const float mean = wave_sum(s) * (1.0f / D); float q2 = 0.f;
#pragma unroll
    for (int j = 0; j < 4; ++j) { v[j] = v[j] - mean; q2 += (v[j][0] * v[j][0] + v[j][1] * v[j][1]) + (v[j][2] * v[j][2] + v[j][3] * v[j][3]); }
    const float rstd = 1.0f / sqrtf(wave_sum(q2) * (1.0f / D) + LN_EPS);
#pragma unroll
    for (int q = 0; q < 4; ++q) { const f32x4 gg = *(const f32x4*)(g + RIDX(q)), bb = *(const f32x4*)(b + RIDX(q)); v[q] = v[q] * rstd * gg + bb; }
}
__device__ __forceinline__ int mod_row_of(int row) { return row < NLAT ? (row >> 11) : 16; }
__device__ __forceinline__ void col_load(const float* p, int lane, f32x4 (&c)[4], float add = 0.f) {
#pragma unroll
    for (int q = 0; q < 4; ++q) c[q] = *(const f32x4*)(p + RIDX(q)) + add;
}
__device__ __forceinline__ void row_ln_r(f32x4 (&v)[4], const f32x4 (&G)[4], const f32x4 (&B)[4]) {
    float s = 0.f;
#pragma unroll
    for (int j = 0; j < 4; ++j) s += (v[j][0] + v[j][1]) + (v[j][2] + v[j][3]);
    const float mean = wave_sum(s) * (1.0f / D); float q2 = 0.f;
#pragma unroll
    for (int j = 0; j < 4; ++j) { v[j] = v[j] - mean; q2 += (v[j][0] * v[j][0] + v[j][1] * v[j][1]) + (v[j][2] * v[j][2] + v[j][3] * v[j][3]); }
    const float rstd = 1.0f / sqrtf(wave_sum(q2) * (1.0f / D) + LN_EPS);
#pragma unroll
    for (int q = 0; q < 4; ++q) v[q] = v[q] * rstd * G[q] + B[q];
}
struct RowRaw { u32x4 x[2], d[2]; };
template <bool WITH_D> __device__ __forceinline__ void row_issue(const bf16_t* X, const bf16_t* Dl, int row, int lane, RowRaw& r) {
#pragma unroll
    for (int j = 0; j < 2; ++j) { r.x[j] = *(const u32x4*)(X + (size_t)row * D + 8 * lane + 512 * j); if (WITH_D) r.d[j] = *(const u32x4*)(Dl + (size_t)row * D + 8 * lane + 512 * j); }
}
__device__ __forceinline__ void unpack8(const u32x4 w, f32x4& lo, f32x4& hi) { lo = (f32x4){bflo(w.x), bfhi(w.x), bflo(w.y), bfhi(w.y)}; hi = (f32x4){bflo(w.z), bfhi(w.z), bflo(w.w), bfhi(w.w)}; }
__device__ __forceinline__ void row_combine(const RowRaw& r, f32x4 (&v)[4]) {
#pragma unroll
    for (int j = 0; j < 2; ++j) { f32x4 x0, x1, d0, d1; unpack8(r.x[j], x0, x1); unpack8(r.d[j], d0, d1); v[2 * j] = x0 * ALPHA + d0; v[2 * j + 1] = x1 * ALPHA + d1; }
}

__device__ __forceinline__ void p_pro_b(const Frame& F) {
    const float* MOD = (const float*)(F.ws + WS_MOD); bf16_t* H = (bf16_t*)(F.ws + WS_H); bf16_t* X = (bf16_t*)(F.ws + WS_X);
    const int rpw = (NTOK + F.NGW - 1) / F.NGW, rbeg = F.gw * rpw, rend = (rbeg + rpw < NTOK) ? rbeg + rpw : NTOK;
    f32x4 SC[4], SH[4]; int mcur = -1;
#define PB_SRC(row_) ((row_) < NLAT ? F.in[I_X] + (size_t)(row_) * D : F.in[I_CTX] + (size_t)((row_) - NLAT) * D)
    f32x4 vn[4];
    if (rbeg < rend) row_load(PB_SRC(rbeg), F.lane, vn);
    for (int row = rbeg; row < rend; ++row) {
        f32x4 v[4], hv[4];
#pragma unroll
        for (int q = 0; q < 4; ++q) v[q] = vn[q];
        if (row + 1 < rend) row_load(PB_SRC(row + 1), F.lane, vn);
        row_store_h(X + (size_t)row * D, F.lane, v);
        const int mr = mod_row_of(row);
        if (mr != mcur) { const float* m = MOD + (size_t)mr * MODW; col_load(m + D, F.lane, SC, 1.0f); col_load(m, F.lane, SH); mcur = mr; }
#pragma unroll
        for (int q = 0; q < 4; ++q) hv[q] = v[q] * SC[q] + SH[q];
        row_store_h(H + (size_t)row * D, F.lane, hv);
    }
#undef PB_SRC
}

__device__ __forceinline__ void dt_gemm(const Frame& F, int layer, int first, int stride, int end) {
    const bf16_t* H = (const bf16_t*)(F.ws + WS_H);
    const bf16_t* wdt = (const bf16_t*)(F.ws + WS_WDT) + (size_t)layer * 16 * D; float* DT = (float*)(F.ws + WS_DT);
    LAS unsigned char* WB = F.lds;
    __syncthreads();
    for (int i = F.tid; i < 16 * 128; i += NT) { const int n = i >> 7, c = i & 127; *(LAS u32x4*)(WB + n * 2064 + c * 16) = *(const u32x4*)(wdt + (size_t)n * D + c * 8); }
    __syncthreads();
    const int fr = F.lane & 15, fq = F.lane >> 4; const float dtb = F.in[I_DTB][layer * 16 + fr];
    for (int g = first; g < end; g += stride) {
        const bf16_t* ap = H + (size_t)(g * 16 + fr) * D + fq * 8;
        bf16x8 a[32];
#pragma unroll
        for (int ks = 0; ks < 32; ++ks) a[ks] = *(const bf16x8*)(ap + ks * 32);
        f32x4 acc = {0.f, 0.f, 0.f, 0.f};
#pragma unroll
        for (int ks = 0; ks < 32; ++ks) { const bf16x8 bb = *(const LAS bf16x8*)(WB + fr * 2064 + (ks * 32 + fq * 8) * 2); acc = __builtin_amdgcn_mfma_f32_16x16x32_bf16(a[ks], bb, acc, 0, 0, 0); }
#pragma unroll
        for (int r = 0; r < 4; ++r) { const float x = acc[r] + dtb; DT[(size_t)(g * 16 + fq * 4 + r) * 16 + fr] = fmaxf(x, 0.f) + __logf(1.0f + __expf(-fabsf(x))); }
    }
    __syncthreads();
}
__device__ __forceinline__ void p_inproj(const Frame& F, int layer) {
    const bf16_t* H = (const bf16_t*)(F.ws + WS_H);
    TPS_BEGIN;
    constexpr int NWG_IN = (NTOK / 256) * (NPROJ / 256), C0_IN = NWG_IN - (NWG_IN / 256) * 256;
    const bool tail_dt = (F.G == 256) && (C0_IN > 0);
    constexpr int DT_HEAD = 1280;
    dt_gemm(F, layer, F.gw, F.NGW, tail_dt ? DT_HEAD : NTOK / 16);
    TPS(20);
    pg8::EpiBf16 E{(bf16_t*)(F.ws + WS_PROJ), NPROJ};
#if USE_FP8 && FP8_INPROJ
    pg8::Gemm g{(const bf16_t*)(F.ws + WS_H8IN), (const bf16_t*)(F.ws + WS_WIN + (size_t)layer * NPROJ * D), D / 2};
    pg8::DenseOrder S; S.init(NTOK, NPROJ, D / 2, F.G, F.bid, REP_GEMM);
    pg8::gemm_phase<pg8::EpiBf16, pg8::DenseOrder, true, FP8_SP2, true>(F.lds, g, S, E, F.tid, (127 - S8_WGU) * 0x01010101, (127 - S8_ACT) * 0x01010101);
#else
    pg8::Gemm g{H, (const bf16_t*)(F.ws + WS_WIN) + (size_t)layer * NPROJ * D, D};
    pg8::DenseOrder S; S.init(NTOK, NPROJ, D, F.G, F.bid, REP_GEMM);
    pg8::gemm_phase<pg8::EpiBf16, pg8::DenseOrder, true, true>(F.lds, g, S, E, F.tid);
#endif
    TPS(21);
    if (tail_dt && F.bid >= C0_IN) dt_gemm(F, layer, DT_HEAD + (F.bid - C0_IN) * NWAVES + F.wave, (256 - C0_IN) * NWAVES, NTOK / 16);
    TPS(22);
}

typedef short s16x4 __attribute__((ext_vector_type(4)));
__device__ __forceinline__ s16x4 lds_tr16(LAS const unsigned char* p) { return __builtin_bit_cast(s16x4, __builtin_amdgcn_ds_read_tr16_b64_v4i16((LAS s16x4*)p)); }
constexpr int NA_KS = 144;
constexpr float LOG2E = 1.4426950408889634f;
__device__ __forceinline__ void na_unit(const Frame& F, int layer, int b, int h, int mode, int m) {
    LAS unsigned char* KV = F.lds;
    LAS float* rp = (LAS float*)(F.lds + 120832);
    const bf16_t* PROJ = (const bf16_t*)(F.ws + WS_PROJ); bf16_t* MIX = (bf16_t*)(F.ws + WS_MIX);
    const int tid = F.tid, lane = F.lane, w = F.wave, q16 = lane & 15, g = lane >> 4;
    int rbase = 0, nk = 0;
    if (mode == 0) { rbase = 2 * m - 4; rbase = rbase < 0 ? 0 : (rbase > 24 ? 24 : rbase); nk = 32 - rbase; nk = nk > 9 ? 9 : nk; }
    const int kfirst = (mode == 0) ? 0 : 576 * 8, nloc8 = nk * 64 * 8;
#define NA_STAGE(OFFS) do { int stid_ = tid; asm volatile("" : "+v"(stid_));     \
        NA_STAGE_PART(OFFS, 0, 7); __builtin_amdgcn_sched_barrier(0); NA_STAGE_PART(OFFS, 7, 13); __builtin_amdgcn_sched_barrier(0); } while (0)
#define NA_STAGE_PART(OFFS, K0, K1) do { u32x4 st_[13]; \
        _Pragma("unroll") for (int k_ = K0; k_ < K1; ++k_) { const int i_ = stid_ + kfirst + k_ * NT, key_ = i_ >> 3, ch_ = i_ & 7; const bool ok_ = (i_ < 832 * 8) && !(key_ < 576 && i_ >= nloc8); \
            const int grow_ = key_ < 576 ? b * SEQ + rbase * 64 + key_ : NLAT + b * CTX + (key_ - 576); \
            st_[k_] = ok_ ? *(const u32x4*)(PROJ + (size_t)grow_ * NPROJ + (OFFS) + h * 64 + ch_ * 8) : (u32x4){0u, 0u, 0u, 0u}; } \
        _Pragma("unroll") for (int k_ = K0; k_ < K1; ++k_) { const int i_ = stid_ + kfirst + k_ * NT, key_ = i_ >> 3, ch_ = i_ & 7; const bool ok_ = (i_ < 832 * 8) && !(key_ < 576 && i_ >= nloc8); \
            if (ok_) *(LAS u32x4*)(KV + key_ * NA_KS + ch_ * 16) = st_[k_]; } } while (0)
    __syncthreads();
    NA_STAGE(OFF_K);
    if (mode == 0 && tid < 465) rp[tid] = F.in[I_RPB][(size_t)(layer * 8 + h) * 465 + tid] * LOG2E;
    __syncthreads();
    int i = 0, j0 = 0, hs = 0, kr0 = 0, qrow;
    if (mode == 0) { i = 2 * m + (w >> 2); j0 = (w & 3) * 16; qrow = b * SEQ + i * 64 + j0; hs = j0 - 8; hs = hs < 0 ? 0 : (hs > 32 ? 32 : hs);
        int r0 = i - 4; r0 = r0 < 0 ? 0 : (r0 > 24 ? 24 : r0); kr0 = r0 - rbase; }
    else qrow = NLAT + b * CTX + m * 128 + w * 16;
    bf16x8 qf[2];
#pragma unroll
    for (int ks = 0; ks < 2; ++ks) qf[ks] = *(const bf16x8*)(PROJ + (size_t)(qrow + q16) * NPROJ + h * 64 + ks * 32 + g * 8);
    f32x4 S[32];
    const LAS unsigned char* kb = KV + q16 * NA_KS + g * 16;
    if (mode == 0) {
        const int j = j0 + q16; int cs = j - 8; cs = cs < 0 ? 0 : (cs > 48 ? 48 : cs);
        const int rb0 = (kr0 + rbase) - i + 7;
#pragma unroll
        for (int tl = 0; tl < 16; ++tl) { const int kr = tl >> 1, half = tl & 1; const int kidx0 = (kr0 + kr) * 64 + hs + 16 * half;
            f32x4 a = {0.f, 0.f, 0.f, 0.f};
#pragma unroll
            for (int ks = 0; ks < 2; ++ks) { const bf16x8 kf = *(const LAS bf16x8*)(kb + kidx0 * NA_KS + ks * 64); a = __builtin_amdgcn_mfma_f32_16x16x32_bf16(kf, qf[ks], a, 0, 0, 0); }
#pragma unroll
            for (int r = 0; r < 4; ++r) { const int kc = hs + 16 * half + 4 * g + r; const bool inw = (kc >= cs) && (kc < cs + 16);
                int cbi = kc - j + 15; cbi = cbi < 0 ? 0 : (cbi > 30 ? 30 : cbi);
                a[r] = inw ? a[r] * (0.125f * LOG2E) + rp[(rb0 + kr) * 31 + cbi] : -INFINITY; }
            S[tl] = a; if ((tl & 1) == 1) __builtin_amdgcn_sched_barrier(0); }
    } else {
#pragma unroll
        for (int tl = 0; tl < 16; ++tl) S[tl] = (f32x4){-INFINITY, -INFINITY, -INFINITY, -INFINITY};
    }
#pragma unroll
    for (int tc = 0; tc < 16; ++tc) { const int kidx0 = 576 + 16 * tc; f32x4 a = {0.f, 0.f, 0.f, 0.f};
#pragma unroll
        for (int ks = 0; ks < 2; ++ks) { const bf16x8 kf = *(const LAS bf16x8*)(kb + kidx0 * NA_KS + ks * 64); a = __builtin_amdgcn_mfma_f32_16x16x32_bf16(kf, qf[ks], a, 0, 0, 0); }
        S[16 + tc] = a * (0.125f * LOG2E); if ((tc & 1) == 1) __builtin_amdgcn_sched_barrier(0); }
    float mx = -INFINITY;
#pragma unroll
    for (int t = 0; t < 32; ++t) mx = fmaxf(fmaxf(fmaxf(S[t][0], S[t][1]), fmaxf(S[t][2], S[t][3])), mx);
    mx = fmaxf(mx, __shfl_xor(mx, 16)); mx = fmaxf(mx, __shfl_xor(mx, 32));
    float sum = 0.f; u32x4 P[16];
#pragma unroll
    for (int kk = 0; kk < 16; ++kk) { float e[8];
#pragma unroll
        for (int r = 0; r < 4; ++r) { e[r] = __builtin_amdgcn_exp2f(S[2 * kk][r] - mx); e[4 + r] = __builtin_amdgcn_exp2f(S[2 * kk + 1][r] - mx); }
        sum += ((e[0] + e[1]) + (e[2] + e[3])) + ((e[4] + e[5]) + (e[6] + e[7]));
        P[kk].x = pg8::cvt_pk_bf16_pin(e[0], e[1]); P[kk].y = pg8::cvt_pk_bf16_pin(e[2], e[3]); P[kk].z = pg8::cvt_pk_bf16_pin(e[4], e[5]); P[kk].w = pg8::cvt_pk_bf16_pin(e[6], e[7]); }
    sum += __shfl_xor(sum, 16); sum += __shfl_xor(sum, 32);
    const float inv = 1.0f / sum;
    __syncthreads();
    NA_STAGE(OFF_V);
    __syncthreads();
    f32x4 o[4];
#pragma unroll
    for (int dt = 0; dt < 4; ++dt) o[dt] = (f32x4){0.f, 0.f, 0.f, 0.f};
    const LAS unsigned char* vb = KV + (4 * g + (q16 >> 2)) * NA_KS + (q16 & 3) * 8;
#pragma unroll
    for (int kk = 0; kk < 16; ++kk) {
        if (kk < 8 && mode != 0) continue;
        const int kidx0 = (kk < 8) ? (kr0 + kk) * 64 + hs : 576 + 32 * (kk - 8);
        const bf16x8 pa = __builtin_bit_cast(bf16x8, P[kk]);
#pragma unroll
        for (int dt = 0; dt < 4; ++dt) { const s16x4 lo = lds_tr16(vb + kidx0 * NA_KS + dt * 32), hi = lds_tr16(vb + (kidx0 + 16) * NA_KS + dt * 32);
            const bf16x8 vf = {lo[0], lo[1], lo[2], lo[3], hi[0], hi[1], hi[2], hi[3]};
            o[dt] = __builtin_amdgcn_mfma_f32_16x16x32_bf16(pa, vf, o[dt], 0, 0, 0); }
    }
#undef NA_STAGE
#undef NA_STAGE_PART
#pragma unroll
    for (int r = 0; r < 4; ++r) { const float ir = __shfl(inv, 4 * g + r);
        bf16_t* op = MIX + (size_t)(qrow + 4 * g + r) * D + h * 64 + q16;
#pragma unroll
        for (int dt = 0; dt < 4; dt += 2) { const unsigned pw = pk2(o[dt][r] * ir, o[dt + 1][r] * ir); op[dt * 16] = (bf16_t)(pw & 0xffffu); op[dt * 16 + 16] = (bf16_t)(pw >> 16); } }
}

struct PrepassW { f32x4 w[5][2]; f32x4 b[2]; float ifq[8]; };
__device__ __forceinline__ void ssd_prepass_unit(const Frame& F, int u, const PrepassW& W) {
    const bf16_t* PROJ = (const bf16_t*)(F.ws + WS_PROJ); bf16_t* U = (bf16_t*)(F.ws + WS_U);
    int rowbase, t0, L; bool lat;
    if (u < NLAT / 16) { rowbase = (u >> 7) * SEQ; t0 = (u & 127) * 16; L = SEQ; lat = true; }
    else { const int v = u - NLAT / 16; rowbase = NLAT + (v >> 4) * CTX; t0 = (v & 15) * 16; L = CTX; lat = false; }
    const int cg = F.tid & 127, tq = F.tid >> 7, c0 = 8 * cg, tb = t0 + 4 * tq;
    u32x4 win[8];
#pragma unroll
    for (int j = 0; j < 8; ++j) { const int t = tb - 2 + j; win[j] = (t >= 0 && t < L) ? *(const u32x4*)(PROJ + (size_t)(rowbase + t) * NPROJ + OFF_XBC + c0) : (u32x4){0u, 0u, 0u, 0u}; }
    const int lc = c0 & 127, hf = lc >> 6, role = (lc >> 5) & 1; const bool rope = lat && (c0 >= 512);
#pragma unroll
    for (int tt = 0; tt < 4; ++tt) {
        f32x4 a0 = W.b[0], a1 = W.b[1];
#pragma unroll
        for (int j = 0; j < 5; ++j) { const u32x4 r = win[tt + j];
            a0 += W.w[j][0] * (f32x4){bflo(r.x), bfhi(r.x), bflo(r.y), bfhi(r.y)}; a1 += W.w[j][1] * (f32x4){bflo(r.z), bfhi(r.z), bflo(r.w), bfhi(r.w)}; }
        float uu[8];
#pragma unroll
        for (int k = 0; k < 4; ++k) { uu[k] = silu_f(a0[k]); uu[4 + k] = silu_f(a1[k]); }
        if (rope) {
            const int tk = tb + tt; const float pos = (float)(hf ? (tk & 63) : (tk >> 6));
#pragma unroll
            for (int k = 0; k < 8; ++k) { const float o = __shfl_xor(uu[k], 4); const float sn = __builtin_amdgcn_sinf(pos * W.ifq[k]), cs = __builtin_amdgcn_cosf(pos * W.ifq[k]);
                uu[k] = role ? (o * sn + uu[k] * cs) : (uu[k] * cs - o * sn); }
        }
        u32x4 o; o.x = pk2(uu[0], uu[1]); o.y = pk2(uu[2], uu[3]); o.z = pk2(uu[4], uu[5]); o.w = pk2(uu[6], uu[7]);
        *(u32x4*)(U + (size_t)(rowbase + tb + tt) * 1024 + c0) = o;
    }
}
__device__ __forceinline__ void ssd_prepass_weights(const Frame& F, int layer, PrepassW& W) {
    const int c0 = 8 * (F.tid & 127);
    const float* cwp = F.in[I_CONVW] + (size_t)layer * 5 * 1024 + c0;
#pragma unroll
    for (int j = 0; j < 5; ++j) { W.w[j][0] = *(const f32x4*)(cwp + j * 1024); W.w[j][1] = *(const f32x4*)(cwp + j * 1024 + 4); }
    W.b[0] = *(const f32x4*)(F.in[I_CONVB] + (size_t)layer * 1024 + c0); W.b[1] = *(const f32x4*)(F.in[I_CONVB] + (size_t)layer * 1024 + c0 + 4);
    const int n0 = c0 & 31;
#pragma unroll
    for (int k = 0; k < 8; ++k) W.ifq[k] = __builtin_amdgcn_exp2f(-(float)(n0 + k) * (13.287712379549449f / 32.0f)) * 0.15915494309189535f;
}

constexpr int S_CQ = 0, S_BQ = 17408, S_XN = 34816, S_XW = 44032, S_OPS = 53248, S_HB = 2 * S_OPS, S_MISC = S_HB + 2 * 17408, S_END = S_MISC + 3 * 1088;
static_assert(S_END <= LDS_ROWOFF + 18432, "SSD LDS image must stay below the control words");
__device__ __forceinline__ void ssd_chunk_compute(const LAS unsigned char* O, const LAS float* misc, const LAS unsigned char* HB, LAS unsigned char* HN, f32x4 (&Hacc)[4],
                                                  bf16_t* yp, int w, int q16, int gq, bool skip, float dsk) {
    const int lt = w >> 1, t2 = (w & 1) * 2;
    bf16x8 cfr[4];
#pragma unroll
    for (int ks = 0; ks < 4; ++ks) cfr[ks] = *(const LAS bf16x8*)(O + S_CQ + (16 * lt + q16) * 272 + ks * 64 + gq * 16);
    u32x4 pm[2];
    {
        const float csl = misc[64 + 16 * lt + q16];
#pragma unroll
        for (int pr = 0; pr < 2; ++pr) {
            f32x4 v[2];
#pragma unroll
            for (int hh = 0; hh < 2; ++hh) { const int st = 2 * pr + hh; f32x4 a = {0.f, 0.f, 0.f, 0.f};
#pragma unroll
                for (int ks = 0; ks < 4; ++ks) { const bf16x8 bfr = *(const LAS bf16x8*)(O + S_BQ + (16 * st + q16) * 272 + ks * 64 + gq * 16); a = __builtin_amdgcn_mfma_f32_16x16x32_bf16(bfr, cfr[ks], a, 0, 0, 0); }
                const f32x4 css = *(const LAS f32x4*)(misc + 64 + 16 * st + 4 * gq), dts = *(const LAS f32x4*)(misc + 16 * st + 4 * gq);
#pragma unroll
                for (int r = 0; r < 4; ++r) { const int sidx = 16 * st + 4 * gq + r; const float e = __expf(fminf(csl - css[r], 0.f)); a[r] = (sidx <= 16 * lt + q16) ? a[r] * e * dts[r] : 0.f; }
                v[hh] = a; }
            pm[pr].x = pk2(v[0][0], v[0][1]); pm[pr].y = pk2(v[0][2], v[0][3]); pm[pr].z = pk2(v[1][0], v[1][1]); pm[pr].w = pk2(v[1][2], v[1][3]);
        }
    }
    {
        const float ecs = misc[128 + 16 * lt + q16];
        const LAS unsigned char* xtr = O + S_XN + (4 * gq + (q16 >> 2)) * 144 + (q16 & 3) * 8;
#pragma unroll
        for (int k = 0; k < 2; ++k) { const int pt = t2 + k; f32x4 a = {0.f, 0.f, 0.f, 0.f};
#pragma unroll
            for (int ks = 0; ks < 4; ++ks) { const bf16x8 hfr = *(const LAS bf16x8*)(HB + (16 * pt + q16) * 272 + ks * 64 + gq * 16); a = __builtin_amdgcn_mfma_f32_16x16x32_bf16(hfr, cfr[ks], a, 0, 0, 0); }
            a = a * ecs;
#pragma unroll
            for (int pr = 0; pr < 2; ++pr) { const s16x4 lo = lds_tr16(xtr + (32 * pr) * 144 + pt * 32), hi = lds_tr16(xtr + (32 * pr + 16) * 144 + pt * 32);
                const bf16x8 xf = {lo[0], lo[1], lo[2], lo[3], hi[0], hi[1], hi[2], hi[3]};
                a = __builtin_amdgcn_mfma_f32_16x16x32_bf16(xf, __builtin_bit_cast(bf16x8, pm[pr]), a, 0, 0, 0); }
            { const u32x2 xv = *(const LAS u32x2*)(O + S_XN + (16 * lt + q16) * 144 + (16 * pt + 4 * gq) * 2); const float ds = skip ? dsk : 0.f;
                a[0] += ds * bflo(xv.x); a[1] += ds * bfhi(xv.x); a[2] += ds * bflo(xv.y); a[3] += ds * bfhi(xv.y); }
            { u32x2 ow; ow.x = pk2(a[0], a[1]); ow.y = pk2(a[2], a[3]); *(u32x2*)(yp + 16 * pt + 4 * gq) = ow; } }
    }
    {
        const int pt2 = w & 3, nb = (w >> 2) * 4; const float et = misc[256];
        const LAS unsigned char* xwtr = O + S_XW + (4 * gq + (q16 >> 2)) * 144 + (q16 & 3) * 8 + pt2 * 32;
        const LAS unsigned char* btr = O + S_BQ + (4 * gq + (q16 >> 2)) * 272 + (q16 & 3) * 8;
        bf16x8 xf2[2];
#pragma unroll
        for (int kk = 0; kk < 2; ++kk) { const s16x4 lo = lds_tr16(xwtr + (32 * kk) * 144), hi = lds_tr16(xwtr + (32 * kk + 16) * 144); xf2[kk] = (bf16x8){lo[0], lo[1], lo[2], lo[3], hi[0], hi[1], hi[2], hi[3]}; }
#pragma unroll
        for (int j = 0; j < 4; ++j) { const int nt = nb + j; Hacc[j] = Hacc[j] * et;
#pragma unroll
            for (int kk = 0; kk < 2; ++kk) { const s16x4 lo = lds_tr16(btr + (32 * kk) * 272 + nt * 32), hi = lds_tr16(btr + (32 * kk + 16) * 272 + nt * 32);
                const bf16x8 bT = {lo[0], lo[1], lo[2], lo[3], hi[0], hi[1], hi[2], hi[3]};
                Hacc[j] = __builtin_amdgcn_mfma_f32_16x16x32_bf16(bT, xf2[kk], Hacc[j], 0, 0, 0); }
            u32x2 hw; hw.x = pk2(Hacc[j][0], Hacc[j][1]); hw.y = pk2(Hacc[j][2], Hacc[j][3]);
            *(LAS u32x2*)(HN + (16 * pt2 + q16) * 272 + (16 * nt + 4 * gq) * 2) = hw; }
    }
}
struct SsdPre { u32x4 x, b[2], c[2]; float dt; };
__device__ __forceinline__ void ssd_mfma_unit(const Frame& F, int layer, int b, int h, int dir) {
    const int g = h >> 2, tid = F.tid, lane = F.lane, w = F.wave, q16 = lane & 15, gq = lane >> 4;
    const bf16_t* U = (const bf16_t*)(F.ws + WS_U); const float* DTS = (const float*)(F.ws + WS_DT);
    bf16_t* Y = (bf16_t*)(F.ws + (dir ? WS_YB : WS_YF));
    const float aneg = -__expf(F.in[I_ALOG][layer * 16 + dir * 8 + h]), dsk = F.in[I_DSKIP][layer * 8 + h];
    LAS unsigned char* L = F.lds;
    __syncthreads();
    { unsigned z_; asm volatile("v_mov_b32 %0, 0" : "=v"(z_));
      for (int i = tid; i < 64 * 272 / 16; i += NT) *(LAS u32x4*)(L + S_HB + i * 16) = (u32x4){z_, z_, z_, z_}; }
    f32x4 Hacc[4];
#pragma unroll
    for (int j = 0; j < 4; ++j) Hacc[j] = (f32x4){0.f, 0.f, 0.f, 0.f};
    SsdPre P0, P1;
    P0.dt = 0.f; P1.dt = 0.f;
    const int xt = tid >> 3, xp = tid & 7;
    const int bt = tid >> 4, bp = tid & 15;
#define SSD_ROW(ci_, l_) ({ const int s_ = (ci_) < 4 ? 0 : 1, k_ = s_ ? (ci_) - 4 : (ci_), nc_ = s_ ? 32 : 4, c_ = dir ? nc_ - 1 - k_ : k_; \
        (s_ ? b * SEQ : NLAT + b * CTX) + c_ * 64 + (dir ? 63 - (l_) : (l_)); })
#define SSD_PREFETCH(ci_, P_) do { P_.x = *(const u32x4*)(U + (size_t)SSD_ROW(ci_, xt) * 1024 + h * 64 + xp * 8); \
        if (w == 0) P_.dt = DTS[(size_t)SSD_ROW(ci_, lane) * 16 + dir * 8 + h]; \
        _Pragma("unroll") for (int j2_ = 0; j2_ < 2; ++j2_) { const int tok_ = bt + 32 * j2_; const size_t ro_ = (size_t)SSD_ROW(ci_, tok_) * 1024; \
            P_.b[j2_] = *(const u32x4*)(U + ro_ + 512 + g * 128 + bp * 8); P_.c[j2_] = *(const u32x4*)(U + ro_ + 768 + g * 128 + bp * 8); } } while (0)
#define SSD_MISC(slot_, P_) do { LAS float* m_ = (LAS float*)(L + S_MISC) + (slot_) * 272; const float dt_ = P_.dt; const float cs_ = wave_scan(dt_ * aneg); \
        const float tot_ = __builtin_bit_cast(float, __builtin_amdgcn_readlane(__builtin_bit_cast(int, cs_), 63)); \
        m_[lane] = dt_; m_[64 + lane] = cs_; m_[128 + lane] = __expf(cs_); m_[192 + lane] = __expf(tot_ - cs_) * dt_; if (lane == 0) m_[256] = __expf(tot_); } while (0)
#define SSD_STAGE(set_, slot_, P_) do { LAS unsigned char* O_ = L + (set_) * S_OPS; const float wl = ((const LAS float*)(L + S_MISC))[(slot_) * 272 + 192 + xt]; \
        *(LAS u32x4*)(O_ + S_XN + xt * 144 + xp * 16) = P_.x; \
        u32x4 xw; xw.x = pk2(bflo(P_.x.x) * wl, bfhi(P_.x.x) * wl); xw.y = pk2(bflo(P_.x.y) * wl, bfhi(P_.x.y) * wl); xw.z = pk2(bflo(P_.x.z) * wl, bfhi(P_.x.z) * wl); xw.w = pk2(bflo(P_.x.w) * wl, bfhi(P_.x.w) * wl); \
        *(LAS u32x4*)(O_ + S_XW + xt * 144 + xp * 16) = xw; \
        _Pragma("unroll") for (int k = 0; k < 2; ++k) { *(LAS u32x4*)(O_ + S_BQ + (bt + 32 * k) * 272 + bp * 16) = P_.b[k]; *(LAS u32x4*)(O_ + S_CQ + (bt + 32 * k) * 272 + bp * 16) = P_.c[k]; } } while (0)
#define SSD_ITER(ci_, PN_, PC_) do { const int ci = (ci_); const int ms1 = ms == 2 ? 0 : ms + 1, ms2 = ms1 == 2 ? 0 : ms1 + 1; \
        if (ci + 1 < 36) SSD_STAGE(cur ^ 1, ms1, PN_); \
        if (ci + 3 < 36) SSD_PREFETCH(ci + 3, PN_); \
        TPS(0); \
        { const int row0 = SSD_ROW(ci, 16 * (w >> 1) + q16); \
          ssd_chunk_compute(L + cur * S_OPS, (const LAS float*)(L + S_MISC) + ms * 272, L + S_HB + cur * 17408, L + S_HB + (cur ^ 1) * 17408, Hacc, Y + (size_t)row0 * 512 + h * 64, w, q16, gq, dir == 0, dsk); } \
        TPS(2); \
        if (w == 0 && ci + 2 < 36) SSD_MISC(ms2, PC_); \
        __syncthreads(); \
        TPS(3); \
        cur ^= 1; ms = ms1; } while (0)
    SSD_PREFETCH(0, P0);
    SSD_PREFETCH(1, P1);
    if (w == 0) SSD_MISC(0, P0);
    __syncthreads();
    SSD_STAGE(0, 0, P0);
    SSD_PREFETCH(2, P0);
    if (w == 0) SSD_MISC(1, P1);
    __syncthreads();
    TPS_BEGIN;
    int cur = 0, ms = 0;
    for (int c2 = 0; c2 < 36; c2 += 2) { SSD_ITER(c2, P1, P0); SSD_ITER(c2 + 1, P0, P1); }
#undef SSD_ROW
#undef SSD_PREFETCH
#undef SSD_MISC
#undef SSD_STAGE
#undef SSD_ITER
}

__device__ __forceinline__ void na_run(const Frame& F, int layer) {
    LAS unsigned char* KV = F.lds; LAS float* rp = (LAS float*)(F.lds + 120832);
    const bf16_t* PROJ = (const bf16_t*)(F.ws + WS_PROJ); bf16_t* MIX = (bf16_t*)(F.ws + WS_MIX);
    const int tid = F.tid, lane = F.lane, w = F.wave, q16 = lane & 15, g = lane >> 4;
    u32x4 pre[13];
#define NA_VPRE 13
#define NA_RB(m_) ({ int rb_ = 2 * (m_) - 4; rb_ = rb_ < 0 ? 0 : (rb_ > 24 ? 24 : rb_); __builtin_amdgcn_readfirstlane(rb_); })
#define NA_NL(rb_) ({ int nk_ = 32 - (rb_); nk_ = nk_ > 9 ? 9 : nk_; __builtin_amdgcn_readfirstlane(nk_ * 64 * 8); })
#define NA_LOAD(OFFS, b_, h_, rb_, nl_, K0, K1) do { int stid_ = tid; asm volatile("" : "+v"(stid_)); \
        _Pragma("unroll") for (int k_ = K0; k_ < K1; ++k_) { const int i_ = stid_ + k_ * NT, key_ = i_ >> 3, ch_ = i_ & 7; const bool ok_ = !(key_ < 576 && i_ >= (nl_)); \
            const int grow_ = key_ < 576 ? (b_) * SEQ + (rb_) * 64 + key_ : NLAT + (b_) * CTX + (key_ - 576); \
            (void)ok_; pre[k_] = *(const u32x4*)(PROJ + (size_t)grow_ * NPROJ + (OFFS) + (h_) * 64 + ch_ * 8); } } while (0)
#define NA_WRITE(nl_, K0, K1) do { int stid_ = tid; asm volatile("" : "+v"(stid_)); \
        _Pragma("unroll") for (int k_ = K0; k_ < K1; ++k_) { const int i_ = stid_ + k_ * NT, key_ = i_ >> 3, ch_ = i_ & 7; const bool ok_ = !(key_ < 576 && i_ >= (nl_)); \
            (void)ok_; *(LAS u32x4*)(KV + key_ * NA_KS + ch_ * 16) = pre[k_]; } } while (0)
    int u = __builtin_amdgcn_readfirstlane(F.bid); int hprev = -1;
    if (u < 2048) { const int b = u >> 7, h = (u >> 4) & 7, m = u & 15, rb = NA_RB(m); NA_LOAD(OFF_K, b, h, rb, NA_NL(rb), 0, 13); }
    { PrepassW W; ssd_prepass_weights(F, layer, W);
      for (int pu = F.bid; pu < NTOK / 16; pu += F.G) ssd_prepass_unit(F, pu, W); }
    TPS_BEGIN;
    for (; u < 2048; u += F.G) {
        const int b = u >> 7, h = (u >> 4) & 7, m = u & 15, rbase = NA_RB(m), nloc8 = NA_NL(rbase);
        TPS(14);
        __syncthreads();
        TPS(10);
        const int i = 2 * m + (w >> 2), j0 = (w & 3) * 16, qrow = b * SEQ + i * 64 + j0;
        bf16x8 qf[2];
#pragma unroll
        for (int ks = 0; ks < 2; ++ks) qf[ks] = *(const bf16x8*)(PROJ + (size_t)(qrow + q16) * NPROJ + h * 64 + ks * 32 + g * 8);
        NA_WRITE(nloc8, 0, 13);
        if (h != hprev) { if (tid < 465) rp[tid] = F.in[I_RPB][(size_t)(layer * 8 + h) * 465 + tid] * LOG2E; hprev = h; }
        NA_LOAD(OFF_V, b, h, rbase, nloc8, 0, NA_VPRE);
        __syncthreads();
        TPS(11);
        int hs = j0 - 8; hs = hs < 0 ? 0 : (hs > 32 ? 32 : hs);
        int r0 = i - 4; r0 = r0 < 0 ? 0 : (r0 > 24 ? 24 : r0); const int kr0 = r0 - rbase;
        f32x4 S[32];
        const LAS unsigned char* kb = KV + q16 * NA_KS + g * 16;
        { const int j = j0 + q16; int cs = j - 8; cs = cs < 0 ? 0 : (cs > 48 ? 48 : cs);
          const int rb0 = (kr0 + rbase) - i + 7;
#pragma unroll
          for (int tl = 0; tl < 16; ++tl) { const int kr = tl >> 1, half = tl & 1; const int kidx0 = (kr0 + kr) * 64 + hs + 16 * half;
              f32x4 a = {0.f, 0.f, 0.f, 0.f};
#pragma unroll
              for (int ks = 0; ks < 2; ++ks) { const bf16x8 kf = *(const LAS bf16x8*)(kb + kidx0 * NA_KS + ks * 64); a = __builtin_amdgcn_mfma_f32_16x16x32_bf16(kf, qf[ks], a, 0, 0, 0); }
#pragma unroll
              for (int r = 0; r < 4; ++r) { const int kc = hs + 16 * half + 4 * g + r; const bool inw = (kc >= cs) && (kc < cs + 16);
                  int cbi = kc - j + 15; cbi = cbi < 0 ? 0 : (cbi > 30 ? 30 : cbi);
                  const float bias = rp[(rb0 + kr) * 31 + cbi];
                  const float t = a[r] * (0.125f * LOG2E) + bias; a[r] = inw ? t : -INFINITY; }
              S[tl] = a; if ((tl & 1) == 1) __builtin_amdgcn_sched_barrier(0); } }
#pragma unroll
        for (int tc = 0; tc < 16; ++tc) { const int kidx0 = 576 + 16 * tc; f32x4 a = {0.f, 0.f, 0.f, 0.f};
#pragma unroll
            for (int ks = 0; ks < 2; ++ks) { const bf16x8 kf = *(const LAS bf16x8*)(kb + kidx0 * NA_KS + ks * 64); a = __builtin_amdgcn_mfma_f32_16x16x32_bf16(kf, qf[ks], a, 0, 0, 0); }
            S[16 + tc] = a * (0.125f * LOG2E); if ((tc & 1) == 1) __builtin_amdgcn_sched_barrier(0); }
        float mx;
        { float m4[4] = {-INFINITY, -INFINITY, -INFINITY, -INFINITY};
#pragma unroll
          for (int t = 0; t < 32; ++t) { m4[t & 3] = fmaxf(fmaxf(S[t][0], S[t][1]), m4[t & 3]); m4[t & 3] = fmaxf(fmaxf(S[t][2], S[t][3]), m4[t & 3]); }
          mx = fmaxf(fmaxf(m4[0], m4[1]), fmaxf(m4[2], m4[3])); }
        mx = fmaxf(mx, __shfl_xor(mx, 16)); mx = fmaxf(mx, __shfl_xor(mx, 32));
        u32x4 P[16];
#pragma unroll
        for (int kk = 0; kk < 16; ++kk) { float e[8];
#pragma unroll
            for (int r = 0; r < 4; ++r) { e[r] = __builtin_amdgcn_exp2f(S[2 * kk][r] - mx); e[4 + r] = __builtin_amdgcn_exp2f(S[2 * kk + 1][r] - mx); }
            P[kk].x = pg8::cvt_pk_bf16_pin(e[0], e[1]); P[kk].y = pg8::cvt_pk_bf16_pin(e[2], e[3]); P[kk].z = pg8::cvt_pk_bf16_pin(e[4], e[5]); P[kk].w = pg8::cvt_pk_bf16_pin(e[6], e[7]); }
        TPS(12);
        __syncthreads();
        NA_WRITE(nloc8, 0, NA_VPRE); NA_LOAD(OFF_V, b, h, rbase, nloc8, NA_VPRE, 13); NA_WRITE(nloc8, NA_VPRE, 13);
        { const int un = u + F.G; if (un < 2048) { const int bn = un >> 7, hn = (un >> 4) & 7, mn = un & 15, rbn = NA_RB(mn); NA_LOAD(OFF_K, bn, hn, rbn, NA_NL(rbn), 0, 13); } }
        __syncthreads();
        TPS(13);
        f32x4 o[4], osum = {0.f, 0.f, 0.f, 0.f};
#pragma unroll
        for (int dt = 0; dt < 4; ++dt) o[dt] = (f32x4){0.f, 0.f, 0.f, 0.f};
        const bf16x8 ones = {0x3f80, 0x3f80, 0x3f80, 0x3f80, 0x3f80, 0x3f80, 0x3f80, 0x3f80};
        const LAS unsigned char* vb = KV + (4 * g + (q16 >> 2)) * NA_KS + (q16 & 3) * 8;
#pragma unroll
        for (int kk = 0; kk < 16; ++kk) {
            const int kidx0 = (kk < 8) ? (kr0 + kk) * 64 + hs : 576 + 32 * (kk - 8);
            const bf16x8 pa = __builtin_bit_cast(bf16x8, P[kk]);
            osum = __builtin_amdgcn_mfma_f32_16x16x32_bf16(ones, pa, osum, 0, 0, 0);
#pragma unroll
            for (int dt = 0; dt < 4; ++dt) { const s16x4 lo = lds_tr16(vb + kidx0 * NA_KS + dt * 32), hi = lds_tr16(vb + (kidx0 + 16) * NA_KS + dt * 32);
                const bf16x8 vf = {lo[0], lo[1], lo[2], lo[3], hi[0], hi[1], hi[2], hi[3]};
                o[dt] = __builtin_amdgcn_mfma_f32_16x16x32_bf16(vf, pa, o[dt], 0, 0, 0); }
            if ((kk & 1) == 1) __builtin_amdgcn_sched_barrier(0);
        }
        const float inv = 1.0f / osum[0];
        { bf16_t* op = MIX + (size_t)(qrow + q16) * D + h * 64 + 4 * g;
#pragma unroll
          for (int dt = 0; dt < 4; ++dt) { u32x2 ow; ow.x = pk2(o[dt][0] * inv, o[dt][1] * inv); ow.y = pk2(o[dt][2] * inv, o[dt][3] * inv); *(u32x2*)(op + dt * 16) = ow; } }
    }
#undef NA_RB
#undef NA_NL
#undef NA_LOAD
#undef NA_WRITE
}
__device__ __forceinline__ void p_mixa(const Frame& F, int layer, bool last) {
    TPS_BEGIN;
    TPS(4);
    na_run(F, layer);
    TPS(5);
    if (!last) for (int u = F.bid; u < 256; u += F.G) na_unit(F, layer, u >> 4, (u >> 1) & 7, 1, u & 1);
    TPS(6);
}
__device__ __forceinline__ void p_mixb(const Frame& F, int layer) {
    for (int u0 = F.bid; u0 < 256 * REP_SSD; u0 += F.G) { const int u = u0 & 255; ssd_mfma_unit(F, layer, u >> 4, (u >> 1) & 7, u & 1); }
}

__device__ __forceinline__ void p_ssdcomb(const Frame& F, int layer, bool last) {
    const bf16_t* PROJ = (const bf16_t*)(F.ws + WS_PROJ); bf16_t* MIX = (bf16_t*)(F.ws + WS_MIX);
    const bf16_t* YF = (const bf16_t*)(F.ws + WS_YF); const bf16_t* YB = (const bf16_t*)(F.ws + WS_YB);
    const float* nw = F.in[I_NORMW] + layer * 512 + F.lane * 8;
    const f32x4 nw0 = *(const f32x4*)nw, nw1 = *(const f32x4*)(nw + 4);
    const int nrows = last ? NLAT : NTOK;
    u32x4 pyf = {0u, 0u, 0u, 0u}, pyb = pyf, pz = pyf;
#define SC_LOAD(r_) do { const size_t o_ = (size_t)(r_) * 512 + F.lane * 8; pyf = *(const u32x4*)(YF + o_); pyb = *(const u32x4*)(YB + o_); \
        pz = *(const u32x4*)(PROJ + (size_t)(r_) * NPROJ + OFF_Z + F.lane * 8); } while (0)
    if (F.gw < nrows) SC_LOAD(F.gw);
    for (int row = F.gw; row < nrows; row += F.NGW) {
        const f32x4 a0 = {bflo(pyf.x) + bflo(pyb.x), bfhi(pyf.x) + bfhi(pyb.x), bflo(pyf.y) + bflo(pyb.y), bfhi(pyf.y) + bfhi(pyb.y)}, a1 = {bflo(pyf.z) + bflo(pyb.z), bfhi(pyf.z) + bfhi(pyb.z), bflo(pyf.w) + bflo(pyb.w), bfhi(pyf.w) + bfhi(pyb.w)}; const u32x4 zv = pz;
        if (row + F.NGW < nrows) SC_LOAD(row + F.NGW);
        float y[8] = {a0[0] * silu_f(bflo(zv.x)), a0[1] * silu_f(bfhi(zv.x)), a0[2] * silu_f(bflo(zv.y)), a0[3] * silu_f(bfhi(zv.y)),
                      a1[0] * silu_f(bflo(zv.z)), a1[1] * silu_f(bfhi(zv.z)), a1[2] * silu_f(bflo(zv.w)), a1[3] * silu_f(bfhi(zv.w))};
        float ss = 0.f;
#pragma unroll
        for (int k = 0; k < 8; ++k) ss += y[k] * y[k];
#pragma unroll
        for (int of = 1; of < 32; of <<= 1) ss += __shfl_xor(ss, of);
        const float rs = 1.0f / sqrtf(ss * (1.0f / 256.0f) + RMS_EPS);
        u32x4 w; w.x = pk2(y[0] * rs * nw0[0], y[1] * rs * nw0[1]); w.y = pk2(y[2] * rs * nw0[2], y[3] * rs * nw0[3]);
        w.z = pk2(y[4] * rs * nw1[0], y[5] * rs * nw1[1]); w.w = pk2(y[6] * rs * nw1[2], y[7] * rs * nw1[3]);
        *(u32x4*)(MIX + (size_t)row * D + 512 + F.lane * 8) = w;
    }
}

__device__ __forceinline__ void p_outproj(const Frame& F, int layer, bool last) {
    pg8::Gemm g{(const bf16_t*)(F.ws + WS_MIX), (const bf16_t*)(F.ws + WS_WOUT) + (size_t)layer * D * D, D};
    pg8::DenseOrder S; S.init(last ? NLAT : NTOK, D, D, F.G, F.bid);
    pg8::EpiGate E{(bf16_t*)(F.ws + WS_DELTA1), (const float*)(F.ws + WS_MOD) + (size_t)layer * 17 * MODW, 2 * D};
    pg8::gemm_phase<pg8::EpiGate, pg8::DenseOrder, true, true>(F.lds, g, S, E, F.tid);
    if (layer < 3) deferred_conv(F, (NTOK / 256) * (D / 256), layer == 0 ? DW_L0_OUT : (layer == 1 ? DW_L1_OUT : DW_L2_OUT), DQ_OUT);
}

__device__ __forceinline__ unsigned* cnt_word(const Frame& F, int slot, int hf, int e) { return (unsigned*)(F.ws + WS_CTL) + CW_CNT + ((slot * 2 + hf) * 8 + e) * 64; }
template <bool MOE> __device__ __forceinline__ void ln1_body(const Frame& F, int layer, bool last) {
    constexpr bool moe = MOE;
    bf16_t* X = (bf16_t*)(F.ws + WS_X); bf16_t* H = (bf16_t*)(F.ws + WS_H);
    const float* MOD = (const float*)(F.ws + WS_MOD) + (size_t)layer * 17 * MODW;
    const float* lg = F.in[I_LNG] + (size_t)(layer * 2) * D; const float* lb = F.in[I_LNB] + (size_t)(layer * 2) * D;
    const int slot = layer >> 1;
    const int nrows = last ? NLAT : NTOK;
    float rw[16][8];
    int nrec = 0;
    if (moe) { const float* R = F.in[I_RW] + (size_t)slot * D * 8;
        LAS unsigned char* T = F.lds + 8192;
        __syncthreads();
        if (F.tid < 32) ((LAS unsigned*)F.lds)[F.tid] = 0u;
#pragma unroll
        for (int i = 0; i < 4; ++i) { const int gq = F.tid + NT * i, c = gq >> 1, half = gq & 1;
            const int L = (c & 511) >> 3, j = 2 * (c >> 9) + ((c >> 2) & 1), k = c & 3, q = (4 * j + k) * 2 + half;
            *(LAS f32x4*)(T + (q * 64 + L) * 16) = *(const f32x4*)(R + 4 * gq); }
        __syncthreads();
#pragma unroll
        for (int jk = 0; jk < 16; ++jk) { const f32x4 a = *(const LAS f32x4*)(T + ((2 * jk) * 64 + F.lane) * 16), b2 = *(const LAS f32x4*)(T + ((2 * jk + 1) * 64 + F.lane) * 16);
            rw[jk][0] = a[0]; rw[jk][1] = a[1]; rw[jk][2] = a[2]; rw[jk][3] = a[3]; rw[jk][4] = b2[0]; rw[jk][5] = b2[1]; rw[jk][6] = b2[2]; rw[jk][7] = b2[3]; }
    }
    const bf16_t* DL = (const bf16_t*)(F.ws + WS_DELTA1);
    const int rpw = (nrows + F.NGW - 1) / F.NGW, rbeg = F.gw * rpw, rend = (rbeg + rpw < nrows) ? rbeg + rpw : nrows;
    f32x4 G[4], B[4], SC[4], SH[4]; int mcur = -1;
    if (!moe) { col_load(lg, F.lane, G); col_load(lb, F.lane, B); }
    RowRaw r0 = {}, r1 = {};
    if (rbeg < rend) row_issue<true>(X, DL, rbeg, F.lane, r0);
    if (rbeg + 1 < rend) row_issue<true>(X, DL, rbeg + 1, F.lane, r1);
    for (int row = rbeg; row < rend; ++row) {
        f32x4 v[4], hv[4];
        row_combine(r0, v); r0 = r1;
        if (row + 2 < rend) row_issue<true>(X, DL, row + 2, F.lane, r1);
        const float* m = MOD + (size_t)mod_row_of(row) * MODW;
        if (moe) {
            row_ln(v, lg, lb, F.lane);
            row_store_h(X + (size_t)row * D, F.lane, v);
            row_mod_store8((unsigned char*)H + (size_t)row * D, F.lane, v, m + 3 * D, m + 4 * D, hv);
        } else {
            row_ln_r(v, G, B);
            row_store_h(X + (size_t)row * D, F.lane, v);
            const int mr = mod_row_of(row);
            if (mr != mcur) { col_load(m + 4 * D, F.lane, SC, 1.0f); col_load(m + 3 * D, F.lane, SH); mcur = mr; }
#pragma unroll
            for (int q = 0; q < 4; ++q) hv[q] = v[q] * SC[q] + SH[q];
            if ((FP8_DENSE1_MASK >> slot) & 1) {
#pragma unroll
                for (int j = 0; j < 2; ++j) { const f32x4 t0 = hv[2 * j] * (float)(1 << S8_ACT), t1 = hv[2 * j + 1] * (float)(1 << S8_ACT); u32x2 w8; w8.x = pk8(t0[0], t0[1], t0[2], t0[3]); w8.y = pk8(t1[0], t1[1], t1[2], t1[3]);
                    *(u32x2*)((unsigned char*)H + (size_t)row * D + 8 * F.lane + 512 * j) = w8; }
            } else row_store_h(H + (size_t)row * D, F.lane, hv);
        }
        if (moe) {
            float lg8[8];
#pragma unroll
            for (int e = 0; e < 8; ++e) { float s = 0.f;
#pragma unroll
                for (int j = 0; j < 4; ++j)
#pragma unroll
                    for (int k = 0; k < 4; ++k) s += hv[j][k] * rw[j * 4 + k][e];
                lg8[e] = wave_sum(s); }
            int e0 = 0; float v0 = lg8[0];
#pragma unroll
            for (int e = 1; e < 8; ++e) if (lg8[e] > v0) { v0 = lg8[e]; e0 = e; }
            int e1 = -1; float v1 = -INFINITY;
#pragma unroll
            for (int e = 0; e < 8; ++e) if (e != e0 && lg8[e] > v1) { v1 = lg8[e]; e1 = e; }
            if (F.lane == 0) {
                const unsigned s0 = __hip_atomic_fetch_add((LAS unsigned*)F.lds + e0, 1u, __ATOMIC_RELAXED, __HIP_MEMORY_SCOPE_WORKGROUP), s1 = __hip_atomic_fetch_add((LAS unsigned*)F.lds + e1, 1u, __ATOMIC_RELAXED, __HIP_MEMORY_SCOPE_WORKGROUP);
                const float ex = __expf(v1 - v0), g0 = 1.0f / (1.0f + ex);
                ((LAS u32x4*)(F.lds + 256))[F.wave * 32 + nrec] = (u32x4){(unsigned)e0 | ((unsigned)e1 << 8), s0, s1, (unsigned)row};
                *(f32x2*)(F.ws + WS_GATES + (size_t)row * 8) = (f32x2){g0, ex * g0};
            }
            ++nrec;
        }
    }
    if (moe) {
        __syncthreads();
        if (F.tid < 8) ((LAS unsigned*)F.lds)[16 + F.tid] = atomicAdd(cnt_word(F, slot, 0, F.tid), ((LAS unsigned*)F.lds)[F.tid]);
        __syncthreads();
        int* list = (int*)(F.ws + WS_LIST);
        if (F.lane < nrec) { const u32x4 rc = ((LAS u32x4*)(F.lds + 256))[F.wave * 32 + F.lane]; const int e0 = rc.x & 255, e1 = (rc.x >> 8) & 255; const int row = (int)rc.w;
            const unsigned s0 = ((LAS unsigned*)F.lds)[16 + e0] + rc.y, s1 = ((LAS unsigned*)F.lds)[16 + e1] + rc.z;
            list[e0 * NTOK + s0] = row; list[e1 * NTOK + s1] = row;
            *(u32x4*)(F.ws + WS_ROUTE + (size_t)row * 16) = (u32x4){rc.x, s0, s1, 0u}; }
    }
}

__device__ __forceinline__ void p_ln1(const Frame& F, int layer, bool last) { if (layer & 1) ln1_body<true>(F, layer, last); else ln1_body<false>(F, layer, last); }

__device__ __forceinline__ void p_ffn1_dense(const Frame& F, int layer, bool last) {
    const int s = layer >> 1;
#if USE_FP8 && FP8_DENSE2
    typedef pg8::EpiSwiGLU8 EpiH; EpiH E{F.ws + WS_HID, DFF};
#else
    typedef pg8::EpiSwiGLU EpiH; EpiH E{(bf16_t*)(F.ws + WS_HID), DFF};
#endif
    if ((FP8_DENSE1_MASK >> s) & 1) {
        pg8::Gemm g{(const bf16_t*)(F.ws + WS_H), (const bf16_t*)(F.ws + WS_WFGU + (size_t)s * 2 * DFF * D * 2), D / 2};
        pg8::DenseOrder S; S.init(last ? NLAT : NTOK, 2 * DFF, D / 2, F.G, F.bid, REP_GEMM);
        pg8::gemm_phase<EpiH, pg8::DenseOrder, true, FP8_SP2, true>(F.lds, g, S, E, F.tid, (127 - S8_WGU) * 0x01010101, (127 - S8_ACT) * 0x01010101);
    } else {
        pg8::Gemm g{(const bf16_t*)(F.ws + WS_H), (const bf16_t*)(F.ws + WS_WFGU) + (size_t)s * 2 * DFF * D, D};
        pg8::DenseOrder S; S.init(last ? NLAT : NTOK, 2 * DFF, D, F.G, F.bid, REP_GEMM);
        pg8::gemm_phase<EpiH, pg8::DenseOrder, true, true>(F.lds, g, S, E, F.tid);
    }
    if (layer == 0) deferred_conv(F, (NTOK / 256) * (2 * DFF / 256), DW_L0_F1, DQ_F1);
}
__device__ __forceinline__ void p_ffn2_dense(const Frame& F, int layer, bool last) {
    const int s = layer >> 1;
    pg8::EpiBf16 E{(bf16_t*)(F.ws + WS_DELTA2), D};
#if USE_FP8 && FP8_DENSE2
    pg8::Gemm g{(const bf16_t*)(F.ws + WS_HID), (const bf16_t*)(F.ws + WS_WFD + (size_t)s * D * DFF), DFF / 2};
    pg8::DenseOrder S; S.init(last ? NLAT : NTOK, D, DFF / 2, F.G, F.bid);
    pg8::gemm_phase<pg8::EpiBf16, pg8::DenseOrder, true, FP8_SP2, true>(F.lds, g, S, E, F.tid, (127 - S8_WD) * 0x01010101, (127 - S8_HID) * 0x01010101);
#else
    pg8::Gemm g{(const bf16_t*)(F.ws + WS_HID), (const bf16_t*)(F.ws + WS_WFD) + (size_t)s * D * DFF, DFF};
    pg8::DenseOrder S; S.init(last ? NLAT : NTOK, D, DFF, F.G, F.bid);
    pg8::gemm_phase<pg8::EpiBf16, pg8::DenseOrder, true, true>(F.lds, g, S, E, F.tid);
#endif
    if (layer == 0 || layer == 2) deferred_conv(F, (NTOK / 256) * (D / 256), layer == 0 ? DW_L0_F2 : DW_L2_F2, DQ_F2);
}
__device__ __forceinline__ void moe_prefix(const Frame& F, int slot, int hf, int (&ts)[9], int (&cn)[8]) {
    int a = 0;
#pragma unroll
    for (int e = 0; e < 8; ++e) { cn[e] = (int)*cnt_word(F, slot, hf, e); ts[e] = a; a += (cn[e] + 255) >> 8; }
    ts[8] = a;
}
__device__ __forceinline__ void p_ffn1_moe(const Frame& F, int layer) {
    const int slot = layer >> 1; int cn[8];
    pg8::MoeOrder<true> S; moe_prefix(F, slot, 0, S.ts, cn);
    S.nM = S.ts[8]; S.nN = 2 * DFFE / 256; S.G = F.G; S.c = F.bid; S.K = D / 2; S.estride = (long)2 * DFFE * D; S.rowoff = (const LAS unsigned short*)(F.lds + LDS_ROWOFF); S.rowbytes = D;
    {
        const int* list = (const int*)(F.ws + WS_LIST); LAS unsigned short* ro = (LAS unsigned short*)(F.lds + LDS_ROWOFF); pg8::Unit u;
        int tk[5][4]; bool ok[5];
#pragma unroll
        for (int k = 0; k < 5; ++k) { const int i = F.wave + NWAVES * k; ok[k] = i < 36 && S.next(i, u);
            const int e = ok[k] ? S.expert_of(u.pm) : 0; int tse = 0, cne = 0;
#pragma unroll
            for (int j = 0; j < 8; ++j) { tse = (j == e) ? S.ts[j] : tse; cne = (j == e) ? cn[j] : cne; }
#pragma unroll
            for (int q = 0; q < 4; ++q) { const int sl = (u.pm - tse) * 256 + F.lane + 64 * q; tk[k][q] = (ok[k] && sl < cne) ? list[e * NTOK + sl] : 0; } }
#pragma unroll
        for (int k = 0; k < 5; ++k) if (ok[k]) { const int i = F.wave + NWAVES * k;
#pragma unroll
            for (int q = 0; q < 4; ++q) ro[i * 256 + F.lane + 64 * q] = (unsigned short)tk[k][q]; }
        __syncthreads();
    }
    pg8::Gemm g{(const bf16_t*)(F.ws + WS_H), (const bf16_t*)(F.ws + WS_WMGU + (size_t)slot * NEXP * 2 * DFFE * D), D / 2};
    pg8::EpiSwiGLU8 E{F.ws + WS_HID, DFFE};
    pg8::gemm_phase<pg8::EpiSwiGLU8, pg8::MoeOrder<true>, true, FP8_SP2, true>(F.lds, g, S, E, F.tid, (127 - S8_WGU) * 0x01010101, (127 - S8_ACT) * 0x01010101);
}
__device__ __forceinline__ void p_ffn2_moe(const Frame& F, int layer) {
    const int slot = layer >> 1; int cn[8];
    pg8::MoeOrder<false> S; moe_prefix(F, slot, 0, S.ts, cn);
    S.nM = S.ts[8]; S.nN = D / 256; S.G = F.G; S.c = F.bid; S.K = DFFE / 2; S.estride = (long)D * DFFE; S.rowoff = nullptr; S.rowbytes = 0;
    pg8::EpiBf16 E{(bf16_t*)(F.ws + WS_YP), D};
    pg8::Gemm g{(const bf16_t*)(F.ws + WS_HID), (const bf16_t*)(F.ws + WS_WMD + (size_t)slot * NEXP * D * DFFE), DFFE / 2};
    pg8::gemm_phase<pg8::EpiBf16, pg8::MoeOrder<false>, true, FP8_SP2, true>(F.lds, g, S, E, F.tid, (127 - S8_WD) * 0x01010101, (127 - S8_HID) * 0x01010101);
}

template <bool MOE> __device__ __forceinline__ void ln2_body(const Frame& F, int layer, bool last) {
    bf16_t* X = (bf16_t*)(F.ws + WS_X); bf16_t* H = (bf16_t*)(F.ws + WS_H);
    const float* MOD = (const float*)(F.ws + WS_MOD) + (size_t)layer * 17 * MODW;
    const float* lg = F.in[I_LNG] + (size_t)(layer * 2 + 1) * D; const float* lb = F.in[I_LNB] + (size_t)(layer * 2 + 1) * D;
    const int slot = layer >> 1;
    const int nrows = last ? NLAT : NTOK;
    int ts0[9], cn[8];
    if (MOE) moe_prefix(F, slot, 0, ts0, cn);
    const bf16_t* YP = (const bf16_t*)(F.ws + WS_YP); const bf16_t* DL = (const bf16_t*)(F.ws + WS_DELTA2);
    const int rpw = (nrows + F.NGW - 1) / F.NGW, rbeg = F.gw * rpw, rend = (rbeg + rpw < nrows) ? rbeg + rpw : nrows;
    f32x4 G[4], B[4], SC[4], SH[4], Q[4]; int mcur = -1;
    col_load(lg, F.lane, G); col_load(lb, F.lane, B);
    RowRaw r0 = {}, r1 = {}; u32x4 rt0 = {0u, 0u, 0u, 0u}, rt1 = {0u, 0u, 0u, 0u}; f32x2 g0 = {0.f, 0.f}, g1 = {0.f, 0.f}; u32x4 ya[2] = {}, yb[2] = {};
#define LN2_ISSUE(row_, r_, rt_, g_) do { row_issue<!MOE>(X, DL, (row_), F.lane, r_); \
        if (MOE) { rt_ = *(const u32x4*)(F.ws + WS_ROUTE + (size_t)(row_) * 16); g_ = *(const f32x2*)(F.ws + WS_GATES + (size_t)(row_) * 8); } } while (0)
#define LN2_ISSUE_Y(rt_) do { const int e0_ = (rt_).x & 255, e1_ = ((rt_).x >> 8) & 255; int t0_ = 0, t1_ = 0; \
        _Pragma("unroll") for (int e = 0; e < 8; ++e) { const int tv = ts0[e]; t0_ = (e == e0_) ? tv : t0_; t1_ = (e == e1_) ? tv : t1_; } \
        const bf16_t* y0_ = YP + ((size_t)t0_ * 256 + (rt_).y) * D; const bf16_t* y1_ = YP + ((size_t)t1_ * 256 + (rt_).z) * D; \
        _Pragma("unroll") for (int j = 0; j < 2; ++j) { ya[j] = *(const u32x4*)(y0_ + 8 * F.lane + 512 * j); yb[j] = *(const u32x4*)(y1_ + 8 * F.lane + 512 * j); } } while (0)
    if (rbeg < rend) LN2_ISSUE(rbeg, r0, rt0, g0);
    if (rbeg + 1 < rend) LN2_ISSUE(rbeg + 1, r1, rt1, g1);
    if (MOE) { if (rbeg < rend) LN2_ISSUE_Y(rt0); }
    for (int row = rbeg; row < rend; ++row) {
        f32x4 v[4], hv[4];
        const int mr = mod_row_of(row);
        if (mr != mcur) { const float* m = MOD + (size_t)mr * MODW; col_load(m + 5 * D, F.lane, Q, 1.0f);
            if (!last) { const float* mn = m + (size_t)17 * MODW; col_load(mn + D, F.lane, SC, 1.0f); col_load(mn, F.lane, SH); }
            mcur = mr; }
        if (MOE) {
#pragma unroll
            for (int j = 0; j < 2; ++j) { f32x4 x0, x1, a0, a1, b0, b1; unpack8(r0.x[j], x0, x1); unpack8(ya[j], a0, a1); unpack8(yb[j], b0, b1);
                v[2 * j] = x0 * ALPHA + Q[2 * j] * (a0 * g0[0] + b0 * g0[1]); v[2 * j + 1] = x1 * ALPHA + Q[2 * j + 1] * (a1 * g0[0] + b1 * g0[1]); }
        } else {
#pragma unroll
            for (int j = 0; j < 2; ++j) { f32x4 x0, x1, d0, d1; unpack8(r0.x[j], x0, x1); unpack8(r0.d[j], d0, d1); v[2 * j] = x0 * ALPHA + Q[2 * j] * d0; v[2 * j + 1] = x1 * ALPHA + Q[2 * j + 1] * d1; }
        }
        r0 = r1; rt0 = rt1; g0 = g1;
        if (MOE) { if (row + 1 < rend) LN2_ISSUE_Y(rt0); }
        if (row + 2 < rend) LN2_ISSUE(row + 2, r1, rt1, g1);
        row_ln_r(v, G, B);
        if (last) row_store(F.out + (size_t)row * D, F.lane, v);
        else { row_store_h(X + (size_t)row * D, F.lane, v);
#pragma unroll
            for (int q = 0; q < 4; ++q) hv[q] = v[q] * SC[q] + SH[q];
            row_store_h(H + (size_t)row * D, F.lane, hv); }
    }
#undef LN2_ISSUE
#undef LN2_ISSUE_Y
}
__device__ __forceinline__ void p_ln2(const Frame& F, int layer, bool last) { if (layer & 1) ln2_body<true>(F, layer, last); else ln2_body<false>(F, layer, last); }

constexpr int NPL = 9;
constexpr int NPH = 2 + NPL * DEPTH;
#ifndef SITE_MASK
#define SITE_MASK 0xFFFFF
#endif
#ifndef TPROBE_MULT
#define TPROBE_MULT 4
#endif
#define SITE(n) (((SITE_MASK) >> (n)) & 1)
__global__ void __launch_bounds__(NT, 2) fwd_kernel(Args args) {
    extern __shared__ __attribute__((aligned(16))) unsigned char lds_raw[];
    Frame F;
    F.lds = (LAS unsigned char*)lds_raw; F.in = args.in; F.out = args.out; F.ws = args.ws;
    F.tid = threadIdx.x; F.lane = F.tid & 63; F.wave = __builtin_amdgcn_readfirstlane(F.tid >> 6); F.bid = blockIdx.x; F.G = gridDim.x;
    F.gw = F.bid * NWAVES + F.wave; F.NGW = F.G * NWAVES;
    volatile LAS unsigned* MISC = (volatile LAS unsigned*)(F.lds + LDS_MISC);
    if (F.tid < 64) MISC[F.tid] = 0u;
    __syncthreads();
    XcdBarrier bar; bar.bar = (unsigned*)(F.ws + WS_CTL) + CW_BAR; bar.x = 0; bar.st = MISC + 8;
#if MK_SINGLE
    bar = xcd_barrier_post((unsigned*)(F.ws + WS_CTL) + CW_BAR, MISC + 8);
#endif
    const int lo = args.ph_lo, hi = args.ph_hi;
#define IN(k) (lo <= (k) && (k) < hi)
#if TPROBE >= 0
    unsigned long long tp_prev = __builtin_amdgcn_s_memrealtime(), tp_acc = 0ull;
#define TP(type) do { const unsigned long long t_ = __builtin_amdgcn_s_memrealtime(); if ((type) == TPROBE) tp_acc += t_ - tp_prev; tp_prev = t_; } while (0)
#else
#define TP(type) do { } while (0)
#endif
#if MK_SINGLE
#define SEAM(k) do { if (IN(k) && IN((k) + 1)) { XcdBarrier b2_ = bar; int z_; asm volatile("s_mov_b32 %0, 0" : "=s"(z_)); b2_.bar = bar.bar + z_; int ln_; asm volatile("v_mbcnt_lo_u32_b32 %0, -1, 0\n\tv_mbcnt_hi_u32_b32 %0, -1, %0" : "=v"(ln_)); xcd_barrier(b2_, F.wave == 0 && ln_ == 0); } } while (0)
#else
#define SEAM(k) do { } while (0)
#endif
    if constexpr (SITE(0)) if (IN(0)) p_pro_a(fresh(F));
    SEAM(0); TP(0);
    if constexpr (SITE(1)) if (IN(1)) p_pro_b(fresh(F));
    SEAM(1); TP(1);
    for (int layer = 0; layer < DEPTH; ++layer) {
        const int pb = 2 + NPL * layer; const bool last = layer == DEPTH - 1; const bool moe = layer & 1;
        if constexpr (SITE(2)) if (IN(pb + 0)) p_inproj(fresh(F), layer);
        SEAM(pb + 0); TP(2);
        if constexpr (SITE(3)) if (IN(pb + 1)) p_mixa(fresh(F), layer, last);
        SEAM(pb + 1); TP(3);
        if constexpr (SITE(12)) if (IN(pb + 2)) p_mixb(fresh(F), layer);
        SEAM(pb + 2); TP(4);
        if constexpr (SITE(4)) if (IN(pb + 3)) { p_ssdcomb(fresh(F), layer, last); if (!USE_FP8 && layer == 2) { int rot = 0; conv_moe(fresh(F), 1, rot); } }
        SEAM(pb + 3); TP(5);
        if constexpr (SITE(5)) if (IN(pb + 4)) p_outproj(fresh(F), layer, last);
        SEAM(pb + 4); TP(6);
        if constexpr (SITE(6)) if (IN(pb + 5)) p_ln1(fresh(F), layer, last);
        SEAM(pb + 5); TP(7);
        if (moe) {
            if constexpr (SITE(7)) if (IN(pb + 6)) p_ffn1_moe(fresh(F), layer);
            SEAM(pb + 6); TP(8);
            if constexpr (SITE(8)) if (IN(pb + 7)) p_ffn2_moe(fresh(F), layer);
            SEAM(pb + 7); TP(9);
        } else {
            if constexpr (SITE(9)) if (IN(pb + 6)) p_ffn1_dense(fresh(F), layer, last);
            SEAM(pb + 6); TP(10);
            if constexpr (SITE(10)) if (IN(pb + 7)) p_ffn2_dense(fresh(F), layer, last);
            SEAM(pb + 7); TP(11);
        }
        if constexpr (SITE(11)) if (IN(pb + 8)) p_ln2(fresh(F), layer, last);
        if (!last) SEAM(pb + 8);
        TP(12);
    }
#if TPROBE >= 100
    __syncthreads(); tp_acc = ((volatile LAS unsigned*)(F.lds + LDS_MISC))[40];
#endif
#if TPROBE >= 0
    { const unsigned long long t_end = __builtin_amdgcn_s_memrealtime(); while (__builtin_amdgcn_s_memrealtime() - t_end < (unsigned long long)TPROBE_MULT * tp_acc) __builtin_amdgcn_s_sleep(8); }
#endif
#undef IN
#undef SEAM
}

extern "C" void kernel_launch(void* const* d_in, const int* in_sizes, int n_in, void* d_out, int out_size, void* d_ws, size_t ws_size, hipStream_t stream) {
    static int grid = 0;
    if (grid == 0) {
        if (n_in != 24 || out_size != NLAT * D || ws_size < WS_END) { fprintf(stderr, "kernel_launch: unexpected shapes (n_in %d, out %d, ws %zu < %zu)\n", n_in, out_size, ws_size, (size_t)WS_END); grid = -1; return; }
        int dev = 0, cus = 0, per_cu = 0;
        if (hipGetDevice(&dev) != hipSuccess || hipDeviceGetAttribute(&cus, hipDeviceAttributeMultiprocessorCount, dev) != hipSuccess) { grid = -1; return; }
        if (hipFuncSetAttribute((const void*)fwd_kernel, hipFuncAttributeMaxDynamicSharedMemorySize, LDS_BYTES) != hipSuccess) { fprintf(stderr, "kernel_launch: hipFuncSetAttribute failed\n"); grid = -1; return; }
        if (hipOccupancyMaxActiveBlocksPerMultiprocessor(&per_cu, (const void*)fwd_kernel, NT, LDS_BYTES) != hipSuccess || per_cu < 1) { fprintf(stderr, "kernel_launch: occupancy query says %d\n", per_cu); }
        (void)hipGetLastError();
        grid = cus;
    }
    if (grid < 0) return;
    (void)in_sizes;
    if (hipMemsetAsync((char*)d_ws + WS_CTL, 0, 96 * 1024, stream) != hipSuccess) return;
    Args a{};
    for (int i = 0; i < 24; ++i) a.in[i] = (const float*)d_in[i];
    a.out = (float*)d_out; a.ws = (unsigned char*)d_ws;
#if MK_SINGLE
    a.ph_lo = 0; a.ph_hi = NPH;
    hipLaunchKernelGGL(fwd_kernel, dim3(grid), dim3(NT), LDS_BYTES, stream, a);
#else
    for (int ph = 0; ph < NPH; ++ph) {

        a.ph_lo = ph; a.ph_hi = ph + 1;
        hipLaunchKernelGGL(fwd_kernel, dim3(grid), dim3(NT), LDS_BYTES, stream, a);
    }
#endif
}
```
